# Optimizing an MI355X kernel written in HIP

```python
import math
import jax
import jax.numpy as jnp
from jax import lax
import numpy as np


D_MODEL = 1024
BATCH = 4
SEQ = 4096
DEPTH = 2

GRID_W = 64
CTX_LEN = 256
HEAD_DIM = 64
N_GROUP_HEADS = 4
GROUP_WIDTH = N_GROUP_HEADS * HEAD_DIM
N_MIXERS = 4
MIX_WIDTH = N_MIXERS * GROUP_WIDTH
A_K_OFF = 1 * GROUP_WIDTH
A_V_OFF = 2 * GROUP_WIDTH
POOL_OFF = 3 * GROUP_WIDTH
SGU_OFF = 4 * GROUP_WIDTH
N_Q_OFF = 6 * GROUP_WIDTH
N_K_OFF = 7 * GROUP_WIDTH
N_V_OFF = 8 * GROUP_WIDTH
PROJ_WIDTH = 9 * GROUP_WIDTH
PROJ_SPLITS = [A_K_OFF, A_V_OFF, POOL_OFF, SGU_OFF, N_Q_OFF, N_K_OFF, N_V_OFF]
DA_QK = HEAD_DIM // 2
ROPE_BASE = 10000.0
Q_BLOCK = 128
POOL_WINDOWS = (2, 4, 8, 16)
POOL_CH = GROUP_WIDTH // len(POOL_WINDOWS)
SGU_CHUNK = 128
WIN_R = 8
WIN_C = 16
NA_QCOLS = 16
NA_SPAN = 2 * WIN_C
N_EXPERTS = 32
TOP_K = 4
D_EXPERT = D_MODEL
SWIGLU_LIMIT = 7.0
SWIGLU_ALPHA = 1.702
MOE_BLOCK = 256
EPS = 1e-6
NEG_INF = -1e30

kernel_name = 'hybrid_parallel_heads_diffusion_block'


def rms_norm(x, g):
    xf = x.astype(jnp.float32)
    y = xf * lax.rsqrt(jnp.mean(xf * xf, axis=-1, keepdims=True) + EPS)
    return (y * g.astype(jnp.float32)).astype(x.dtype)


def _heads(t):
    return None if t is None else t.reshape(t.shape[:-1] + (N_GROUP_HEADS, HEAD_DIM))


def rope_1d(x, pos):
    n = x.shape[-1] // 2
    inv = ROPE_BASE ** (-jnp.arange(n, dtype=jnp.float32) / n)
    ang = pos.astype(jnp.float32)[:, None] * inv[None, :]
    cos = jnp.cos(ang)[None, :, None, :].astype(x.dtype)
    sin = jnp.sin(ang)[None, :, None, :].astype(x.dtype)
    x1, x2 = x[..., :n], x[..., n:]
    return jnp.concatenate([x1 * cos - x2 * sin, x1 * sin + x2 * cos], axis=-1)


def axial_rope(x, row_pos, col_pos):
    h = x.shape[-1] // 2
    return jnp.concatenate([rope_1d(x[..., :h], row_pos), rope_1d(x[..., h:], col_pos)], axis=-1)


def diff_attention(q, k, v, q_ctx, k_ctx, v_ctx, lam_q1, lam_k1, lam_q2, lam_k2, g_sub,
                   lam_init, row_pos, col_pos):
    B, S, H, Dv = v.shape
    lam = (jnp.exp(jnp.sum(lam_q1.astype(jnp.float32) * lam_k1.astype(jnp.float32)))
           - jnp.exp(jnp.sum(lam_q2.astype(jnp.float32) * lam_k2.astype(jnp.float32)))
           + lam_init)
    scale = DA_QK ** -0.5

    def two_maps(qq, kk, vv):
        s1 = jnp.einsum('bqhd,bkhd->bhqk', qq[..., :DA_QK], kk[..., :DA_QK]).astype(jnp.float32) * scale
        s2 = jnp.einsum('bqhd,bkhd->bhqk', qq[..., DA_QK:], kk[..., DA_QK:]).astype(jnp.float32) * scale
        a = jax.nn.softmax(s1, axis=-1) - lam * jax.nn.softmax(s2, axis=-1)
        o = jnp.einsum('bhqk,bkhd->bqhd', a, vv)
        return (rms_norm(o, g_sub) * (1.0 - lam_init)).astype(vv.dtype)

    def rot(t):
        return jnp.concatenate([axial_rope(t[..., :DA_QK], row_pos, col_pos),
                                axial_rope(t[..., DA_QK:], row_pos, col_pos)], axis=-1)

    k_all = jnp.concatenate([rot(k), k_ctx], axis=1)
    v_all = jnp.concatenate([v, v_ctx], axis=1)
    q_blocks = jnp.moveaxis(rot(q).reshape(B, S // Q_BLOCK, Q_BLOCK, H, 2 * DA_QK), 1, 0)
    o = lax.map(lambda qb: two_maps(qb, k_all, v_all), q_blocks)
    o = jnp.moveaxis(o, 0, 1).reshape(B, S, H * Dv)
    o_ctx = None if q_ctx is None else two_maps(q_ctx, k_ctx, v_ctx).reshape(B, -1, H * Dv)
    return o, o_ctx


def ctx_attention(q, k, v):
    s = jnp.einsum('bqhd,bkhd->bhqk', q, k).astype(jnp.float32) * q.shape[-1] ** -0.5
    o = jnp.einsum('bhqk,bkhd->bqhd', jax.nn.softmax(s, axis=-1), v).astype(q.dtype)
    return o.reshape(q.shape[0], q.shape[1], -1)


def neighbourhood_attention(q, k, v, q_ctx, k_ctx, v_ctx, rpb):
    B, S, H, Dh = q.shape
    rows = S // GRID_W
    kr = min(WIN_R, rows)
    ncb = GRID_W // NA_QCOLS
    scale = Dh ** -0.5
    r = jnp.arange(rows)
    blk = jnp.arange(ncb)
    row_idx = jnp.clip(r - kr // 2, 0, rows - kr)[:, None] + jnp.arange(kr)[None, :]
    span_idx = (jnp.clip(blk * NA_QCOLS - WIN_C // 2, 0, GRID_W - NA_SPAN)[:, None]
                + jnp.arange(NA_SPAN)[None, :])
    qcol = blk[:, None] * NA_QCOLS + jnp.arange(NA_QCOLS)[None, :]
    win_start = jnp.clip(qcol - WIN_C // 2, 0, GRID_W - WIN_C)
    kc = span_idx[:, None, :]
    col_ok = (kc >= win_start[..., None]) & (kc < win_start[..., None] + WIN_C)
    mask = jnp.broadcast_to(col_ok[:, :, None, :], (ncb, NA_QCOLS, kr, NA_SPAN))
    mask = mask.reshape(ncb, NA_QCOLS, kr * NA_SPAN)
    rel_r = row_idx - r[:, None] + (WIN_R - 1)
    rel_c = jnp.clip(kc - qcol[..., None], -(WIN_C - 1), WIN_C - 1) + (WIN_C - 1)
    bias = rpb[:, rel_r[:, None, None, :, None], rel_c[None, :, :, None, :]]
    bias = jnp.moveaxis(bias, 0, 2).reshape(rows, ncb, H, NA_QCOLS, kr * NA_SPAN)

    def gather(t):
        tg = t.reshape(B, rows, GRID_W, H, Dh)[:, row_idx[:, None, :, None], span_idx[None, :, None, :]]
        return tg.reshape(B, rows, ncb, kr * NA_SPAN, H, Dh)

    kg, vg = gather(k), gather(v)
    qg = q.reshape(B, rows, ncb, NA_QCOLS, H, Dh)
    s_n = jnp.einsum('brnqhd,brnkhd->brnhqk', qg, kg).astype(jnp.float32) * scale + bias[None]
    s_n = jnp.where(mask[None, None, :, None], s_n, NEG_INF)
    s_c = jnp.einsum('brnqhd,bchd->brnhqc', qg, k_ctx).astype(jnp.float32) * scale
    p = jax.nn.softmax(jnp.concatenate([s_n, s_c], axis=-1), axis=-1)
    nk = kr * NA_SPAN
    o = (jnp.einsum('brnhqk,brnkhd->brnqhd', p[..., :nk], vg)
         + jnp.einsum('brnhqc,bchd->brnqhd', p[..., nk:], v_ctx))
    o = o.astype(q.dtype).reshape(B, S, H * Dh)
    o_ctx = None if q_ctx is None else ctx_attention(q_ctx, k_ctx, v_ctx)
    return o, o_ctx


def pool_mixer(y, w_pool, s_pool):
    L = y.shape[1]
    t = jnp.arange(L)
    yf = y.astype(jnp.float32)
    csum = jnp.concatenate([jnp.zeros_like(yf[:, :1]), jnp.cumsum(yf, axis=1)], axis=1)
    outs = []
    for g, w in enumerate(POOL_WINDOWS):
        sl = slice(g * POOL_CH, (g + 1) * POOL_CH)
        lo = jnp.clip(t - w // 2, 0, L - 1)
        hi = jnp.clip(t + (w - w // 2 - 1), 0, L - 1)
        cnt = (hi - lo + 1).astype(jnp.float32)[None, :, None]
        mean = (csum[:, hi + 1, sl] - csum[:, lo, sl]) / cnt
        outs.append((mean - yf[..., sl]).astype(y.dtype) @ w_pool[g])
    return jnp.concatenate(outs, axis=-1) * s_pool


def sgu_mixer(z, g_sgu, w_sgu, b_sgu):
    B, L, _ = z.shape
    z = jax.nn.gelu(z)
    u, v = z[..., :GROUP_WIDTH], z[..., GROUP_WIDTH:]
    v = rms_norm(v, g_sgu).reshape(B, L // SGU_CHUNK, SGU_CHUNK, N_GROUP_HEADS, HEAD_DIM)
    s = jnp.einsum('gts,bnsgc->bntgc', w_sgu, v) + b_sgu.T[:, :, None]
    return u * s.reshape(B, L, GROUP_WIDTH)


def moe_ffn(h, w_router, b_router, w_gu, b_gu, w_down, b_down):
    T, D = h.shape
    logits = h.astype(jnp.float32) @ w_router.astype(jnp.float32) + b_router.astype(jnp.float32)
    top_val, top_idx = lax.top_k(logits, TOP_K)
    gates = jax.nn.softmax(top_val, axis=-1)
    M = T * TOP_K
    flat_e = top_idx.reshape(-1)
    order = jnp.argsort(flat_e)
    sorted_e = flat_e[order]
    counts = jnp.bincount(flat_e, length=N_EXPERTS)
    padded = (counts + MOE_BLOCK - 1) // MOE_BLOCK * MOE_BLOCK
    start = jnp.cumsum(counts) - counts
    cum_pad = jnp.cumsum(padded)
    pstart = cum_pad - padded
    dest = pstart[sorted_e] + jnp.arange(M) - start[sorted_e]
    nb = -(-M // MOE_BLOCK) + N_EXPERTS
    slot_tok = jnp.zeros((nb * MOE_BLOCK,), jnp.int32).at[dest].set((order // TOP_K).astype(jnp.int32))
    blk_e = jnp.minimum(jnp.searchsorted(cum_pad, jnp.arange(nb) * MOE_BLOCK, side='right'), N_EXPERTS - 1)

    def expert_block(args):
        tok, e = args
        xb = h[tok]
        gu = xb @ w_gu[e] + b_gu[e]
        gt = jnp.minimum(gu[..., :D_EXPERT], SWIGLU_LIMIT)
        up = jnp.clip(gu[..., D_EXPERT:], -SWIGLU_LIMIT, SWIGLU_LIMIT)
        act = (up + 1.0) * gt * jax.nn.sigmoid(SWIGLU_ALPHA * gt)
        return act @ w_down[e] + b_down[e]

    yb = lax.map(expert_block, (slot_tok.reshape(nb, MOE_BLOCK), blk_e)).reshape(nb * MOE_BLOCK, D)
    y = jnp.zeros((M, D), yb.dtype).at[order].set(yb[dest]).reshape(T, TOP_K, D)
    return jnp.einsum('tkd,tk->td', y, gates.astype(y.dtype))


def hybrid_layer(x, xc, c, c_ctx, p, layer_idx, update_ctx):
    B, S, D = x.shape
    t = jnp.arange(S)
    row_pos, col_pos = t // GRID_W, t % GRID_W
    lam_init = 0.8 - 0.6 * math.exp(-0.3 * layer_idx)
    mod = (jax.nn.silu(c) @ p['w_mod'] + p['b_mod'])[:, None, :]
    sh1, sc1, gt1, sh2, sc2, gt2 = jnp.split(mod, 6, axis=-1)
    n_cm = 6 if update_ctx else 2
    modc = jnp.split(jax.nn.silu(c_ctx) @ p['w_mod'][:, :n_cm * D] + p['b_mod'][:n_cm * D], n_cm, axis=-1)

    h = rms_norm(x, p['g_mix']) * (1 + sc1) + sh1
    hc = rms_norm(xc, p['g_mix']) * (1 + modc[1]) + modc[0]
    aq, ak, av, pool_in, sgu_in, nq, nk, nv = jnp.split(h @ p['w_in'], PROJ_SPLITS, axis=-1)
    if update_ctx:
        aqc, akc, avc, pool_c, sgu_c, nqc, nkc, nvc = jnp.split(hc @ p['w_in'], PROJ_SPLITS, axis=-1)
    else:
        akc, avc = jnp.split(hc @ p['w_in'][:, A_K_OFF:POOL_OFF], 2, axis=-1)
        nkc, nvc = jnp.split(hc @ p['w_in'][:, N_K_OFF:], 2, axis=-1)
        aqc = nqc = None
    oa, oa_c = diff_attention(_heads(aq), _heads(ak), _heads(av), _heads(aqc), _heads(akc), _heads(avc),
                              p['lam_q1'], p['lam_k1'], p['lam_q2'], p['lam_k2'], p['g_sub'],
                              lam_init, row_pos, col_pos)
    od, od_c = neighbourhood_attention(_heads(nq), _heads(nk), _heads(nv), _heads(nqc), _heads(nkc),
                                       _heads(nvc), p['rpb'])
    mix = jnp.concatenate([oa, pool_mixer(pool_in, p['w_pool'], p['s_pool']),
                           sgu_mixer(sgu_in, p['g_sgu'], p['w_sgu'], p['b_sgu']), od], axis=-1)
    x = x + gt1 * (mix @ p['w_out'])

    hf = rms_norm(x, p['g_ffn']) * (1 + sc2) + sh2
    if update_ctx:
        mixc = jnp.concatenate([oa_c, pool_mixer(pool_c, p['w_pool'], p['s_pool']),
                                sgu_mixer(sgu_c, p['g_sgu'], p['w_sgu'], p['b_sgu']), od_c], axis=-1)
        xc = xc + modc[2] * (mixc @ p['w_out'])
        hfc = rms_norm(xc, p['g_ffn']) * (1 + modc[4]) + modc[3]
        y = moe_ffn(jnp.concatenate([hf.reshape(-1, D), hfc.reshape(-1, D)], axis=0), p['w_router'],
                    p['b_router'], p['w_gu'], p['b_gu'], p['w_down'], p['b_down'])
        x = x + gt2 * y[:B * S].reshape(B, S, D)
        xc = xc + modc[5] * y[B * S:].reshape(xc.shape)
    else:
        y = moe_ffn(hf.reshape(-1, D), p['w_router'], p['b_router'], p['w_gu'], p['b_gu'],
                    p['w_down'], p['b_down'])
        x = x + gt2 * y.reshape(B, S, D)
    return x, xc


def setup_inputs(seed: int = 0) -> dict:
    key = jax.random.key(seed)
    ks = jax.random.split(key, 32)
    f32 = jnp.float32

    def nrm(i, shape, s):
        return jax.random.normal(ks[i], shape, f32) * s

    L, D, G, E, F = DEPTH, D_MODEL, GROUP_WIDTH, N_EXPERTS, D_EXPERT
    return {
        'x': nrm(0, (BATCH, SEQ, D), 1.0),
        'c': nrm(1, (BATCH, D), 1.0),
        'ctx': nrm(2, (BATCH, CTX_LEN, D), 1.0),
        'c_ctx': nrm(3, (D,), 1.0),
        'w_mod': nrm(4, (L, D, 6 * D), 0.5 * D ** -0.5),
        'b_mod': nrm(5, (L, 6 * D), 0.02),
        'g_mix': 1.0 + nrm(6, (L, D), 0.05),
        'g_ffn': 1.0 + nrm(7, (L, D), 0.05),
        'w_in': nrm(8, (L, D, PROJ_WIDTH), D ** -0.5),
        'w_out': nrm(9, (L, MIX_WIDTH, D), MIX_WIDTH ** -0.5),
        'lam_q1': nrm(10, (L, DA_QK), 0.1),
        'lam_k1': nrm(11, (L, DA_QK), 0.1),
        'lam_q2': nrm(12, (L, DA_QK), 0.1),
        'lam_k2': nrm(13, (L, DA_QK), 0.1),
        'g_sub': 1.0 + nrm(14, (L, HEAD_DIM), 0.05),
        'w_pool': nrm(15, (L, len(POOL_WINDOWS), POOL_CH, POOL_CH), POOL_CH ** -0.5),
        's_pool': 1.0 + nrm(16, (L, G), 0.1),
        'g_sgu': 1.0 + nrm(17, (L, G), 0.05),
        'w_sgu': nrm(18, (L, N_GROUP_HEADS, SGU_CHUNK, SGU_CHUNK), SGU_CHUNK ** -0.5),
        'b_sgu': 1.0 + nrm(19, (L, N_GROUP_HEADS, SGU_CHUNK), 0.1),
        'rpb': nrm(20, (L, N_GROUP_HEADS, 2 * WIN_R - 1, 2 * WIN_C - 1), 0.1),
        'w_router': nrm(21, (L, D, E), D ** -0.5),
        'b_router': nrm(22, (L, E), 0.01),
        'w_gu': nrm(23, (L, E, D, 2 * F), D ** -0.5),
        'b_gu': nrm(24, (L, E, 2 * F), 0.01),
        'w_down': nrm(25, (L, E, F, D), F ** -0.5),
        'b_down': nrm(26, (L, E, D), 0.01),
        'g_final': 1.0 + nrm(27, (D,), 0.05),
    }


def reference(x, c, ctx, c_ctx, w_mod, b_mod, g_mix, g_ffn, w_in, w_out, lam_q1, lam_k1, lam_q2,
              lam_k2, g_sub, w_pool, s_pool, g_sgu, w_sgu, b_sgu, rpb, w_router, b_router, w_gu,
              b_gu, w_down, b_down, g_final):
    xc = ctx
    for l in range(DEPTH):
        p = dict(w_mod=w_mod[l], b_mod=b_mod[l], g_mix=g_mix[l], g_ffn=g_ffn[l], w_in=w_in[l],
                 w_out=w_out[l], lam_q1=lam_q1[l], lam_k1=lam_k1[l], lam_q2=lam_q2[l],
                 lam_k2=lam_k2[l], g_sub=g_sub[l], w_pool=w_pool[l], s_pool=s_pool[l],
                 g_sgu=g_sgu[l], w_sgu=w_sgu[l], b_sgu=b_sgu[l], rpb=rpb[l],
                 w_router=w_router[l], b_router=b_router[l], w_gu=w_gu[l], b_gu=b_gu[l],
                 w_down=w_down[l], b_down=b_down[l])
        x, xc = hybrid_layer(x, xc, c, c_ctx, p, l, l < DEPTH - 1)
    return rms_norm(x, g_final)
```

```cpp
#include <hip/hip_runtime.h>
#include <stdint.h>

typedef unsigned short bf16_t;
typedef short bf16x8 __attribute__((ext_vector_type(8)));
typedef float f32x4 __attribute__((ext_vector_type(4)));

constexpr int D = 1024, NB = 4, S = 4096, T = NB * S, CL = 256, TC = NB * CL, R = T + TC;
constexpr int PW = 2304, NE = 32, TOPK = 4, FF = 1024;
constexpr int MAXSLOT = R * TOPK;
constexpr float EPS = 1e-6f;

__device__ __forceinline__ bf16_t f2bf(float f) { unsigned u = __float_as_uint(f); return (bf16_t)((u + 0x7fffu + ((u >> 16) & 1u)) >> 16); }
__device__ __forceinline__ float bf2f(bf16_t h) { return __uint_as_float(((unsigned)h) << 16); }
__device__ __forceinline__ float wave_sum(float v) {
#pragma unroll
    for (int o = 32; o >= 1; o >>= 1) v += __shfl_xor(v, o);
    return v;
}
__device__ __forceinline__ int mod_row(int row) { return row < T ? (row >> 12) : 4; }

struct P {
    const float *x, *c, *ctx, *c_ctx, *w_mod, *b_mod, *g_mix, *g_ffn, *w_in, *w_out, *lam_q1, *lam_k1, *lam_q2, *lam_k2, *g_sub,
        *w_pool, *s_pool, *g_sgu, *w_sgu, *b_sgu, *rpb, *w_router, *b_router, *w_gu, *b_gu, *w_down, *b_down, *g_final;
    float* out;
    float* mod;
    float* rope;
    float* X;
    bf16_t* H;
    float* PROJ;
    bf16_t* MIX;
    float* OA;
    bf16_t* WinT;
    bf16_t* WoutT;
    bf16_t* WguT;
    bf16_t* WdnT;
    int* cnt;
    int* topi;
    float* topg;
    int* tok_slot;
    int* slot_tok;
    bf16_t* ACT;
    float* YB;
};

__global__ void __launch_bounds__(256) k_transpose(const float* __restrict__ W, bf16_t* __restrict__ Wt, int K, int N, int perm) {
    __shared__ float tile[64][65];
    const size_t mat = blockIdx.z;
    const float* Wm = W + mat * (size_t)K * N;
    bf16_t* Wtm = Wt + mat * (size_t)K * N;
    const int n0 = blockIdx.x * 64, k0 = blockIdx.y * 64, tx = threadIdx.x & 63, ty = threadIdx.x >> 6;
    for (int i = ty; i < 64; i += 4) tile[i][tx] = Wm[(size_t)(k0 + i) * N + n0 + tx];
    __syncthreads();
    for (int i = ty; i < 64; i += 4) {
        int n = n0 + i;
        int np = perm ? (n < N / 2 ? 2 * n : 2 * (n - N / 2) + 1) : n;
        Wtm[(size_t)np * K + k0 + tx] = f2bf(tile[tx][i]);
    }
}

__global__ void __launch_bounds__(256) k_mod(P p) {
    __shared__ float sc[5][1024];
    const int l = blockIdx.y, j = blockIdx.x * 256 + threadIdx.x;
    for (int i = threadIdx.x; i < 5 * 1024; i += 256) {
        int r = i >> 10, k = i & 1023;
        float v = r < 4 ? p.c[r * 1024 + k] : p.c_ctx[k];
        sc[r][k] = v / (1.f + __expf(-v));
    }
    __syncthreads();
    const float* W = p.w_mod + (size_t)l * 1024 * 6144;
    float a0 = 0, a1 = 0, a2 = 0, a3 = 0, a4 = 0;
    for (int k = 0; k < 1024; ++k) {
        float w = W[(size_t)k * 6144 + j];
        a0 += sc[0][k] * w; a1 += sc[1][k] * w; a2 += sc[2][k] * w; a3 += sc[3][k] * w; a4 += sc[4][k] * w;
    }
    float b = p.b_mod[l * 6144 + j];
    float* m = p.mod + (size_t)l * 5 * 6144;
    m[0 * 6144 + j] = a0 + b; m[1 * 6144 + j] = a1 + b; m[2 * 6144 + j] = a2 + b; m[3 * 6144 + j] = a3 + b; m[4 * 6144 + j] = a4 + b;
}

__global__ void k_rope_table(P p) {
    int i = threadIdx.x;
    int pos = i >> 3, f = i & 7;
    float inv = powf(10000.0f, -(float)f / 8.0f);
    float ang = (float)pos * inv;
    p.rope[i * 2] = cosf(ang); p.rope[i * 2 + 1] = sinf(ang);
}

__global__ void __launch_bounds__(256) k_norm1(P p, int l) {
    const int wave = threadIdx.x >> 6, lane = threadIdx.x & 63;
    const int row = blockIdx.x * 4 + wave;
    if (row >= R) return;
    const float* xr = p.X + (size_t)row * D;
    float4 v[4]; float ss = 0;
#pragma unroll
    for (int i = 0; i < 4; ++i) { v[i] = *(const float4*)(xr + lane * 4 + 256 * i); ss += v[i].x * v[i].x + v[i].y * v[i].y + v[i].z * v[i].z + v[i].w * v[i].w; }
    ss = wave_sum(ss);
    const float rstd = rsqrtf(ss * (1.f / D) + EPS);
    const float* m = p.mod + ((size_t)l * 5 + mod_row(row)) * 6144;
    const float* g = p.g_mix + l * D;
#pragma unroll
    for (int i = 0; i < 4; ++i) {
        int k = lane * 4 + 256 * i;
        float4 gg = *(const float4*)(g + k), sh = *(const float4*)(m + k), sc = *(const float4*)(m + 1024 + k);
        ushort4 o;
        o.x = f2bf(v[i].x * rstd * gg.x * (1.f + sc.x) + sh.x); o.y = f2bf(v[i].y * rstd * gg.y * (1.f + sc.y) + sh.y);
        o.z = f2bf(v[i].z * rstd * gg.z * (1.f + sc.z) + sh.z); o.w = f2bf(v[i].w * rstd * gg.w * (1.f + sc.w) + sh.w);
        *(ushort4*)(p.H + (size_t)row * D + k) = o;
    }
}

constexpr int LSTR = 40;
template <class ARow, class Epi>
__device__ __forceinline__ void gemm_tile_128(const ARow& arow, int mvalid, const bf16_t* __restrict__ Bt, int K, const Epi& epi, bf16_t* lds) {
    const int tid = threadIdx.x, lane = tid & 63, wid = tid >> 6, wm = wid >> 1, wn = wid & 1;
    bf16_t* As = lds;
    bf16_t* Bs = lds + 2 * 128 * LSTR;
    const bf16_t* pa[2]; const bf16_t* pb[2]; int lo[2];
#pragma unroll
    for (int i = 0; i < 2; ++i) {
        int c = tid + 256 * i, row = c >> 2, kc = (c & 3) * 8;
        pa[i] = arow(row) + kc; pb[i] = Bt + (size_t)row * K + kc; lo[i] = row * LSTR + kc;
    }
    f32x4 acc[4][4];
#pragma unroll
    for (int m = 0; m < 4; ++m)
#pragma unroll
        for (int n = 0; n < 4; ++n) acc[m][n] = (f32x4){0.f, 0.f, 0.f, 0.f};
    uint4 ra[2], rb[2];
#pragma unroll
    for (int i = 0; i < 2; ++i) { ra[i] = *(const uint4*)pa[i]; rb[i] = *(const uint4*)pb[i]; }
#pragma unroll
    for (int i = 0; i < 2; ++i) { *(uint4*)(As + lo[i]) = ra[i]; *(uint4*)(Bs + lo[i]) = rb[i]; }
    __syncthreads();
    const int nk = K / 32;
    const int fr = lane & 15, fq = lane >> 4;
    for (int kt = 0; kt < nk; ++kt) {
        const int cur = kt & 1;
        if (kt + 1 < nk) {
#pragma unroll
            for (int i = 0; i < 2; ++i) { ra[i] = *(const uint4*)(pa[i] + (kt + 1) * 32); rb[i] = *(const uint4*)(pb[i] + (kt + 1) * 32); }
        }
        const bf16_t* Ac = As + cur * 128 * LSTR; const bf16_t* Bc = Bs + cur * 128 * LSTR;
        bf16x8 af[4], bfr[4];
#pragma unroll
        for (int m = 0; m < 4; ++m) af[m] = *(const bf16x8*)(Ac + (wm * 64 + m * 16 + fr) * LSTR + fq * 8);
#pragma unroll
        for (int n = 0; n < 4; ++n) bfr[n] = *(const bf16x8*)(Bc + (wn * 64 + n * 16 + fr) * LSTR + fq * 8);
#pragma unroll
        for (int m = 0; m < 4; ++m)
#pragma unroll
            for (int n = 0; n < 4; ++n) acc[m][n] = __builtin_amdgcn_mfma_f32_16x16x32_bf16(bfr[n], af[m], acc[m][n], 0, 0, 0);
        if (kt + 1 < nk) {
            const int nx = cur ^ 1;
#pragma unroll
            for (int i = 0; i < 2; ++i) { *(uint4*)(As + nx * 128 * LSTR + lo[i]) = ra[i]; *(uint4*)(Bs + nx * 128 * LSTR + lo[i]) = rb[i]; }
        }
        __syncthreads();
    }
#pragma unroll
    for (int m = 0; m < 4; ++m) {
        const int row = wm * 64 + m * 16 + fr;
        if (row < mvalid) {
#pragma unroll
            for (int n = 0; n < 4; ++n) epi(row, wn * 64 + n * 16 + fq * 4, acc[m][n]);
        }
    }
}
constexpr int GEMM_LDS_ELEMS = 4 * 128 * LSTR;

struct ARowDense { const bf16_t* A; int K; __device__ __forceinline__ const bf16_t* operator()(int r) const { return A + (size_t)r * K; } };

__global__ void __launch_bounds__(256) k_gemm_proj(P p, int l) {
    __shared__ __attribute__((aligned(16))) bf16_t lds[GEMM_LDS_ELEMS];
    const int n0 = blockIdx.x * 128, m0 = blockIdx.y * 128;
    ARowDense ar{p.H + (size_t)m0 * D, D};
    float* C = p.PROJ;
    auto epi = [&](int r, int c, f32x4 v) { *(f32x4*)(C + (size_t)(m0 + r) * PW + n0 + c) = v; };
    gemm_tile_128(ar, 128, p.WinT + ((size_t)l * PW + n0) * D, D, epi, lds);
}
__global__ void __launch_bounds__(256) k_gemm_out(P p, int l) {
    __shared__ __attribute__((aligned(16))) bf16_t lds[GEMM_LDS_ELEMS];
    const int n0 = blockIdx.x * 128, m0 = blockIdx.y * 128;
    ARowDense ar{p.MIX + (size_t)m0 * D, D};
    const float* m = p.mod + (size_t)l * 5 * 6144;
    float* X = p.X;
    auto epi = [&](int r, int c, f32x4 v) {
        const int row = m0 + r, col = n0 + c;
        const f32x4 g = *(const f32x4*)(m + (size_t)mod_row(row) * 6144 + 2 * 1024 + col);
        f32x4* xp = (f32x4*)(X + (size_t)row * D + col);
        *xp = *xp + g * v;
    };
    gemm_tile_128(ar, 128, p.WoutT + ((size_t)l * D + n0) * D, D, epi, lds);
}

__global__ void __launch_bounds__(256) k_rope(P p) {
    const int idx = blockIdx.x * 256 + threadIdx.x;
    const int i = idx & 7, grp = (idx >> 3) & 3, hb = (idx >> 5) & 7, row = idx >> 8;
    if (row >= T) return;
    const int s = row & 4095, pos = (grp & 1) ? (s & 63) : (s >> 6);
    const float cs = p.rope[(pos * 8 + i) * 2], sn = p.rope[(pos * 8 + i) * 2 + 1];
    float* q = p.PROJ + (size_t)row * PW + hb * 64 + grp * 16 + i;
    const float x1 = q[0], x2 = q[8];
    q[0] = x1 * cs - x2 * sn; q[8] = x1 * sn + x2 * cs;
}

__global__ void __launch_bounds__(256) k_dattn(P p) {
    __shared__ __attribute__((aligned(16))) float Ks[64][32];
    __shared__ __attribute__((aligned(16))) float Vs[64][64];
    const int tid = threadIdx.x, h = blockIdx.y, map = blockIdx.z;
    const int qrow = blockIdx.x * 256 + tid;
    const bool isctx = qrow >= T;
    const int b = isctx ? ((qrow - T) >> 8) : (qrow >> 12);
    float q[32], o[64];
    {
        const float* qp = p.PROJ + (size_t)qrow * PW + h * 64 + map * 32;
#pragma unroll
        for (int d = 0; d < 32; d += 4) { float4 t = *(const float4*)(qp + d); q[d] = t.x; q[d + 1] = t.y; q[d + 2] = t.z; q[d + 3] = t.w; }
    }
#pragma unroll
    for (int d = 0; d < 64; ++d) o[d] = 0.f;
    float mrun = -1e30f, lrun = 0.f;
    const float scale = 0.17677669529663687f;
    const int nkeys = isctx ? 256 : (4096 + 256);
    for (int k0 = 0; k0 < nkeys; k0 += 64) {
        int kbase;
        if (isctx) kbase = T + b * 256 + k0;
        else kbase = (k0 < 4096) ? (b * 4096 + k0) : (T + b * 256 + (k0 - 4096));
        __syncthreads();
#pragma unroll
        for (int i = 0; i < 2; ++i) {
            int c = tid + 256 * i, r = c >> 3, d = (c & 7) * 4;
            *(float4*)&Ks[r][d] = *(const float4*)(p.PROJ + (size_t)(kbase + r) * PW + 256 + h * 64 + map * 32 + d);
        }
#pragma unroll
        for (int i = 0; i < 4; ++i) {
            int c = tid + 256 * i, r = c >> 4, d = (c & 15) * 4;
            *(float4*)&Vs[r][d] = *(const float4*)(p.PROJ + (size_t)(kbase + r) * PW + 512 + h * 64 + d);
        }
        __syncthreads();
        for (int j0 = 0; j0 < 64; j0 += 16) {
            float sc[16]; float mx = -1e30f;
#pragma unroll
            for (int j = 0; j < 16; ++j) {
                float a = 0.f;
#pragma unroll
                for (int d = 0; d < 32; d += 4) { float4 kk = *(const float4*)&Ks[j0 + j][d]; a += q[d] * kk.x + q[d + 1] * kk.y + q[d + 2] * kk.z + q[d + 3] * kk.w; }
                sc[j] = a * scale; mx = fmaxf(mx, sc[j]);
            }
            const float mnew = fmaxf(mrun, mx), corr = __expf(mrun - mnew);
            mrun = mnew; lrun *= corr;
#pragma unroll
            for (int d = 0; d < 64; ++d) o[d] *= corr;
#pragma unroll
            for (int j = 0; j < 16; ++j) {
                const float pj = __expf(sc[j] - mnew); lrun += pj;
#pragma unroll
                for (int d = 0; d < 64; d += 4) { float4 vv = *(const float4*)&Vs[j0 + j][d]; o[d] += pj * vv.x; o[d + 1] += pj * vv.y; o[d + 2] += pj * vv.z; o[d + 3] += pj * vv.w; }
            }
        }
    }
    const float il = 1.f / lrun;
    float* op = p.OA + (((size_t)qrow * 4 + h) * 2 + map) * 64;
#pragma unroll
    for (int d = 0; d < 64; d += 4) *(float4*)(op + d) = make_float4(o[d] * il, o[d + 1] * il, o[d + 2] * il, o[d + 3] * il);
}
__global__ void __launch_bounds__(256) k_dattn_fin(P p, int l, int nrows) {
    const int wave = threadIdx.x >> 6, lane = threadIdx.x & 63;
    const int item = blockIdx.x * 4 + wave;
    if (item >= nrows * 4) return;
    const int row = item >> 2, h = item & 3;
    float a = lane < 32 ? p.lam_q1[l * 32 + lane] * p.lam_k1[l * 32 + lane] : 0.f;
    float b = lane < 32 ? p.lam_q2[l * 32 + lane] * p.lam_k2[l * 32 + lane] : 0.f;
    a = wave_sum(a); b = wave_sum(b);
    const float lam_init = 0.8f - 0.6f * expf(-0.3f * (float)l);
    const float lam = expf(a) - expf(b) + lam_init;
    const float* op = p.OA + ((size_t)row * 4 + h) * 2 * 64;
    const float o = op[lane] - lam * op[64 + lane];
    const float ss = wave_sum(o * o);
    const float v = o * rsqrtf(ss * (1.f / 64.f) + EPS) * p.g_sub[l * 64 + lane] * (1.f - lam_init);
    p.MIX[(size_t)row * D + h * 64 + lane] = f2bf(v);
}

__global__ void __launch_bounds__(256) k_na(P p, int l) {
    const int tid = threadIdx.x, h = tid & 3;
    const int qrow = blockIdx.x * 64 + (tid >> 2);
    const bool isctx = qrow >= T;
    const int b = isctx ? ((qrow - T) >> 8) : (qrow >> 12);
    float q[64], o[64];
    {
        const float* qp = p.PROJ + (size_t)qrow * PW + 1536 + h * 64;
#pragma unroll
        for (int d = 0; d < 64; d += 4) { float4 t = *(const float4*)(qp + d); q[d] = t.x * 0.125f; q[d + 1] = t.y * 0.125f; q[d + 2] = t.z * 0.125f; q[d + 3] = t.w * 0.125f; }
    }
#pragma unroll
    for (int d = 0; d < 64; ++d) o[d] = 0.f;
    float mrun = -1e30f, lrun = 0.f;
    int r = 0, c = 0, rs = 0, ws = 0;
    if (!isctx) { const int s = qrow & 4095; r = s >> 6; c = s & 63; rs = min(max(r - 4, 0), 56); ws = min(max(c - 8, 0), 48); }
    const int nk = isctx ? 256 : 384;
    const float* rp = p.rpb + ((size_t)l * 4 + h) * 15 * 31;
    for (int j = 0; j < nk; ++j) {
        int krow; float bias = 0.f;
        if (isctx) krow = T + b * 256 + j;
        else if (j < 128) { const int kr = j >> 4, kc = j & 15; krow = b * 4096 + (rs + kr) * 64 + ws + kc; bias = rp[(rs + kr - r + 7) * 31 + (ws + kc - c + 15)]; }
        else krow = T + b * 256 + (j - 128);
        const float* kp = p.PROJ + (size_t)krow * PW + 1792 + h * 64;
        float a = bias;
#pragma unroll
        for (int d = 0; d < 64; d += 4) { float4 kk = *(const float4*)(kp + d); a += q[d] * kk.x + q[d + 1] * kk.y + q[d + 2] * kk.z + q[d + 3] * kk.w; }
        const float mnew = fmaxf(mrun, a), corr = __expf(mrun - mnew), pj = __expf(a - mnew);
        mrun = mnew; lrun = lrun * corr + pj;
        const float* vp = kp + 256;
#pragma unroll
        for (int d = 0; d < 64; d += 4) { float4 vv = *(const float4*)(vp + d); o[d] = o[d] * corr + pj * vv.x; o[d + 1] = o[d + 1] * corr + pj * vv.y; o[d + 2] = o[d + 2] * corr + pj * vv.z; o[d + 3] = o[d + 3] * corr + pj * vv.w; }
    }
    const float il = 1.f / lrun;
    bf16_t* op = p.MIX + (size_t)qrow * D + 768 + h * 64;
#pragma unroll
    for (int d = 0; d < 64; d += 4) { ushort4 w; w.x = f2bf(o[d] * il); w.y = f2bf(o[d + 1] * il); w.z = f2bf(o[d + 2] * il); w.w = f2bf(o[d + 3] * il); *(ushort4*)(op + d) = w; }
}

__global__ void __launch_bounds__(256) k_pool(P p, int l) {
    __shared__ float dsh[256];
    const int row = blockIdx.x, ch = threadIdx.x, g = ch >> 6, w = 2 << g;
    const int L = row < T ? 4096 : 256;
    const int t = row < T ? (row & 4095) : ((row - T) & 255);
    const int base = row - t;
    const int lo = max(t - w / 2, 0), hi = min(t + w / 2 - 1, L - 1);
    float sum = 0.f;
    for (int rr = lo; rr <= hi; ++rr) sum += p.PROJ[(size_t)(base + rr) * PW + 768 + ch];
    const float y = p.PROJ[(size_t)row * PW + 768 + ch];
    dsh[ch] = sum / (float)(hi - lo + 1) - y;
    __syncthreads();
    const float* wp = p.w_pool + ((size_t)l * 4 + g) * 64 * 64;
    float a = 0.f;
#pragma unroll 8
    for (int i = 0; i < 64; ++i) a += dsh[g * 64 + i] * wp[i * 64 + (ch & 63)];
    p.MIX[(size_t)row * D + 256 + ch] = f2bf(a * p.s_pool[l * 256 + ch]);
}

__device__ __forceinline__ float gelu_tanh(float x) { return 0.5f * x * (1.f + tanhf(0.7978845608028654f * (x + 0.044715f * x * x * x))); }
__global__ void __launch_bounds__(256) k_sgu(P p, int l) {
    __shared__ float vn[128][64];
    __shared__ float rstd[128];
    const int chunk = blockIdx.x, g = blockIdx.y, tid = threadIdx.x;
    const int row0 = chunk * 128;
    {
        const int t = tid >> 1, half = tid & 1;
        const float* zp = p.PROJ + (size_t)(row0 + t) * PW + 1024 + 256 + half * 128;
        float ss = 0.f;
        for (int i = 0; i < 128; ++i) { float v = gelu_tanh(zp[i]); ss += v * v; }
        ss += __shfl_xor(ss, 1);
        if (half == 0) rstd[t] = rsqrtf(ss * (1.f / 256.f) + EPS);
    }
    __syncthreads();
    for (int i = tid; i < 128 * 64; i += 256) {
        const int s = i >> 6, cc = i & 63;
        const float v = gelu_tanh(p.PROJ[(size_t)(row0 + s) * PW + 1024 + 256 + g * 64 + cc]);
        vn[s][cc] = v * rstd[s] * p.g_sgu[l * 256 + g * 64 + cc];
    }
    __syncthreads();
    const int cc = tid & 63;
    const float* ws = p.w_sgu + ((size_t)l * 4 + g) * 128 * 128;
    for (int t = tid >> 6; t < 128; t += 4) {
        float a = 0.f;
        const float* wr = ws + t * 128;
#pragma unroll 8
        for (int s = 0; s < 128; ++s) a += wr[s] * vn[s][cc];
        a += p.b_sgu[(l * 4 + g) * 128 + t];
        const float u = gelu_tanh(p.PROJ[(size_t)(row0 + t) * PW + 1024 + g * 64 + cc]);
        p.MIX[(size_t)(row0 + t) * D + 512 + g * 64 + cc] = f2bf(u * a);
    }
}

__global__ void __launch_bounds__(256) k_router(P p, int l, int nrows) {
    const int wave = threadIdx.x >> 6, lane = threadIdx.x & 63;
    const int row = blockIdx.x * 4 + wave;
    if (row >= nrows) return;
    const float* xr = p.X + (size_t)row * D;
    float hf[16]; float ss = 0;
#pragma unroll
    for (int i = 0; i < 4; ++i) { float4 v = *(const float4*)(xr + lane * 4 + 256 * i); hf[4 * i] = v.x; hf[4 * i + 1] = v.y; hf[4 * i + 2] = v.z; hf[4 * i + 3] = v.w; ss += v.x * v.x + v.y * v.y + v.z * v.z + v.w * v.w; }
    ss = wave_sum(ss);
    const float rstd = rsqrtf(ss * (1.f / D) + EPS);
    const float* m = p.mod + ((size_t)l * 5 + mod_row(row)) * 6144;
    const float* g = p.g_ffn + l * D;
#pragma unroll
    for (int i = 0; i < 4; ++i) {
        const int k = lane * 4 + 256 * i;
        float4 gg = *(const float4*)(g + k), sh = *(const float4*)(m + 3 * 1024 + k), sc = *(const float4*)(m + 4 * 1024 + k);
        hf[4 * i] = hf[4 * i] * rstd * gg.x * (1.f + sc.x) + sh.x; hf[4 * i + 1] = hf[4 * i + 1] * rstd * gg.y * (1.f + sc.y) + sh.y;
        hf[4 * i + 2] = hf[4 * i + 2] * rstd * gg.z * (1.f + sc.z) + sh.z; hf[4 * i + 3] = hf[4 * i + 3] * rstd * gg.w * (1.f + sc.w) + sh.w;
        ushort4 o; o.x = f2bf(hf[4 * i]); o.y = f2bf(hf[4 * i + 1]); o.z = f2bf(hf[4 * i + 2]); o.w = f2bf(hf[4 * i + 3]);
        *(ushort4*)(p.H + (size_t)row * D + k) = o;
    }
    float lg[32];
#pragma unroll
    for (int e = 0; e < 32; ++e) lg[e] = 0.f;
    const float* wr = p.w_router + (size_t)l * D * NE;
#pragma unroll
    for (int i = 0; i < 4; ++i)
#pragma unroll
        for (int j = 0; j < 4; ++j) {
            const int k = lane * 4 + 256 * i + j;
            const float hv = hf[4 * i + j];
#pragma unroll
            for (int e = 0; e < 32; e += 4) { float4 w = *(const float4*)(wr + (size_t)k * NE + e); lg[e] += hv * w.x; lg[e + 1] += hv * w.y; lg[e + 2] += hv * w.z; lg[e + 3] += hv * w.w; }
        }
#pragma unroll
    for (int e = 0; e < 32; ++e) lg[e] = wave_sum(lg[e]) + p.b_router[l * NE + e];
    unsigned taken = 0u; float tv[4]; int ti[4];
#pragma unroll
    for (int k = 0; k < 4; ++k) {
        float best = -3.0e38f; int bi = 0;
#pragma unroll
        for (int e = 0; e < 32; ++e) { const bool ok = !((taken >> e) & 1u) && (lg[e] > best); best = ok ? lg[e] : best; bi = ok ? e : bi; }
        taken |= 1u << bi; tv[k] = best; ti[k] = bi;
    }
    const float e1 = __expf(tv[1] - tv[0]), e2 = __expf(tv[2] - tv[0]), e3 = __expf(tv[3] - tv[0]);
    const float inv = 1.f / (1.f + e1 + e2 + e3);
    if (lane == 0) {
        *(int4*)(p.topi + (size_t)row * 4) = make_int4(ti[0], ti[1], ti[2], ti[3]);
        *(float4*)(p.topg + (size_t)row * 4) = make_float4(inv, e1 * inv, e2 * inv, e3 * inv);
        int* cnt = p.cnt + l * 64;
        atomicAdd(&cnt[ti[0]], 1); atomicAdd(&cnt[ti[1]], 1); atomicAdd(&cnt[ti[2]], 1); atomicAdd(&cnt[ti[3]], 1);
    }
}
__global__ void __launch_bounds__(256) k_assign(P p, int l, int nrows) {
    __shared__ int lcnt[32], lbase[32], off[32];
    const int tid = threadIdx.x, row = blockIdx.x * 256 + tid;
    int* cnt = p.cnt + l * 64; int* cursor = cnt + 32;
    if (tid < 32) lcnt[tid] = 0;
    if (tid == 0) { int a = 0; for (int e = 0; e < 32; ++e) { off[e] = a; a += cnt[e]; } }
    __syncthreads();
    int4 ti = make_int4(0, 0, 0, 0); int rk[4] = {0, 0, 0, 0};
    if (row < nrows) {
        ti = *(const int4*)(p.topi + (size_t)row * 4);
        rk[0] = atomicAdd(&lcnt[ti.x], 1); rk[1] = atomicAdd(&lcnt[ti.y], 1); rk[2] = atomicAdd(&lcnt[ti.z], 1); rk[3] = atomicAdd(&lcnt[ti.w], 1);
    }
    __syncthreads();
    if (tid < 32) lbase[tid] = off[tid] + (lcnt[tid] ? atomicAdd(&cursor[tid], lcnt[tid]) : 0);
    __syncthreads();
    if (row < nrows) {
        const int s0 = lbase[ti.x] + rk[0], s1 = lbase[ti.y] + rk[1], s2 = lbase[ti.z] + rk[2], s3 = lbase[ti.w] + rk[3];
        *(int4*)(p.tok_slot + (size_t)row * 4) = make_int4(s0, s1, s2, s3);
        p.slot_tok[s0] = row; p.slot_tok[s1] = row; p.slot_tok[s2] = row; p.slot_tok[s3] = row;
    }
}

struct MoeTile { int e, row0, mvalid; };
__device__ __forceinline__ bool moe_find_tile(const int* cnt, int mt, MoeTile& t, int* sh) {
    if (threadIdx.x == 0) {
        int acc_t = 0, acc_r = 0, fe = -1, fr0 = 0, fmv = 0;
        for (int e = 0; e < 32; ++e) {
            const int c = cnt[e], nt = (c + 127) >> 7;
            if (fe < 0 && mt < acc_t + nt) { fe = e; const int lt = mt - acc_t; fr0 = acc_r + lt * 128; fmv = min(128, c - lt * 128); }
            acc_t += nt; acc_r += c;
        }
        sh[0] = fe; sh[1] = fr0; sh[2] = fmv;
    }
    __syncthreads();
    t.e = sh[0]; t.row0 = sh[1]; t.mvalid = sh[2];
    return t.e >= 0;
}
struct ARowGather { const bf16_t* A; const int* idx; int mvalid; __device__ __forceinline__ const bf16_t* operator()(int r) const { return A + (size_t)idx[r < mvalid ? r : 0] * D; } };
struct ARowClamp { const bf16_t* A; int mvalid; __device__ __forceinline__ const bf16_t* operator()(int r) const { return A + (size_t)(r < mvalid ? r : 0) * D; } };

__global__ void __launch_bounds__(256) k_moe1(P p, int l) {
    __shared__ __attribute__((aligned(16))) bf16_t lds[GEMM_LDS_ELEMS];
    __shared__ int sh[4];
    MoeTile t;
    if (!moe_find_tile(p.cnt + l * 64, blockIdx.y, t, sh)) return;
    const int n0 = blockIdx.x * 128;
    ARowGather ar{p.H, p.slot_tok + t.row0, t.mvalid};
    const float* bg = p.b_gu + ((size_t)l * NE + t.e) * 2048;
    bf16_t* ACT = p.ACT;
    auto epi = [&](int r, int c, f32x4 v) {
        const int j = (n0 + c) >> 1;
        float o2[2];
#pragma unroll
        for (int q = 0; q < 2; ++q) {
            const float gt = fminf(v[2 * q] + bg[j + q], 7.0f);
            const float up = fminf(fmaxf(v[2 * q + 1] + bg[1024 + j + q], -7.0f), 7.0f);
            o2[q] = (up + 1.0f) * gt / (1.0f + __expf(-1.702f * gt));
        }
        ushort2 w; w.x = f2bf(o2[0]); w.y = f2bf(o2[1]);
        *(ushort2*)(ACT + (size_t)(t.row0 + r) * FF + j) = w;
    };
    gemm_tile_128(ar, t.mvalid, p.WguT + (((size_t)l * NE + t.e) * 2048 + n0) * D, D, epi, lds);
}
__global__ void __launch_bounds__(256) k_moe2(P p, int l) {
    __shared__ __attribute__((aligned(16))) bf16_t lds[GEMM_LDS_ELEMS];
    __shared__ int sh[4];
    MoeTile t;
    if (!moe_find_tile(p.cnt + l * 64, blockIdx.y, t, sh)) return;
    const int n0 = blockIdx.x * 128;
    ARowClamp ar{p.ACT + (size_t)t.row0 * FF, t.mvalid};
    const float* bd = p.b_down + ((size_t)l * NE + t.e) * D;
    float* YB = p.YB;
    auto epi = [&](int r, int c, f32x4 v) {
        const f32x4 bb = *(const f32x4*)(bd + n0 + c);
        *(f32x4*)(YB + (size_t)(t.row0 + r) * D + n0 + c) = v + bb;
    };
    gemm_tile_128(ar, t.mvalid, p.WdnT + (((size_t)l * NE + t.e) * D + n0) * FF, FF, epi, lds);
}
__global__ void __launch_bounds__(256) k_combine(P p, int l, int nrows) {
    const int wave = threadIdx.x >> 6, lane = threadIdx.x & 63;
    const int row = blockIdx.x * 4 + wave;
    if (row >= nrows) return;
    const int4 sl = *(const int4*)(p.tok_slot + (size_t)row * 4);
    const float4 g = *(const float4*)(p.topg + (size_t)row * 4);
    const float* m = p.mod + ((size_t)l * 5 + mod_row(row)) * 6144 + 5 * 1024;
#pragma unroll
    for (int i = 0; i < 4; ++i) {
        const int k = lane * 4 + 256 * i;
        const float4 y0 = *(const float4*)(p.YB + (size_t)sl.x * D + k), y1 = *(const float4*)(p.YB + (size_t)sl.y * D + k);
        const float4 y2 = *(const float4*)(p.YB + (size_t)sl.z * D + k), y3 = *(const float4*)(p.YB + (size_t)sl.w * D + k);
        const float4 gt = *(const float4*)(m + k);
        float4* xp = (float4*)(p.X + (size_t)row * D + k);
        float4 xv = *xp;
        xv.x += gt.x * (g.x * y0.x + g.y * y1.x + g.z * y2.x + g.w * y3.x);
        xv.y += gt.y * (g.x * y0.y + g.y * y1.y + g.z * y2.y + g.w * y3.y);
        xv.z += gt.z * (g.x * y0.z + g.y * y1.z + g.z * y2.z + g.w * y3.z);
        xv.w += gt.w * (g.x * y0.w + g.y * y1.w + g.z * y2.w + g.w * y3.w);
        *xp = xv;
    }
}
__global__ void __launch_bounds__(256) k_final(P p) {
    const int wave = threadIdx.x >> 6, lane = threadIdx.x & 63;
    const int row = blockIdx.x * 4 + wave;
    if (row >= T) return;
    const float* xr = p.X + (size_t)row * D;
    float4 v[4]; float ss = 0;
#pragma unroll
    for (int i = 0; i < 4; ++i) { v[i] = *(const float4*)(xr + lane * 4 + 256 * i); ss += v[i].x * v[i].x + v[i].y * v[i].y + v[i].z * v[i].z + v[i].w * v[i].w; }
    ss = wave_sum(ss);
    const float rstd = rsqrtf(ss * (1.f / D) + EPS);
#pragma unroll
    for (int i = 0; i < 4; ++i) {
        const int k = lane * 4 + 256 * i;
        const float4 gg = *(const float4*)(p.g_final + k);
        *(float4*)(p.out + (size_t)row * D + k) = make_float4(v[i].x * rstd * gg.x, v[i].y * rstd * gg.y, v[i].z * rstd * gg.z, v[i].w * rstd * gg.w);
    }
}

static inline size_t align_up(size_t v, size_t a) { return (v + a - 1) / a * a; }

extern "C" void kernel_launch(void* const* d_in, const int* in_sizes, int n_in, void* d_out, int out_size, void* d_ws, size_t ws_size, hipStream_t stream) {
    P p{};
    const float** ins = (const float**)&p.x;
    for (int i = 0; i < 28; ++i) ins[i] = (const float*)d_in[i];
    p.out = (float*)d_out;
    char* w = (char*)d_ws; size_t off = 0;
    auto carve = [&](size_t bytes) { void* r = w + off; off = align_up(off + bytes, 256); return r; };
    p.cnt = (int*)carve(2 * 64 * 4);
    p.mod = (float*)carve((size_t)2 * 5 * 6144 * 4);
    p.rope = (float*)carve(64 * 8 * 2 * 4);
    p.X = (float*)carve((size_t)R * D * 4);
    p.H = (bf16_t*)carve((size_t)R * D * 2);
    p.PROJ = (float*)carve((size_t)R * PW * 4);
    p.MIX = (bf16_t*)carve((size_t)R * D * 2);
    p.OA = (float*)carve((size_t)R * 4 * 2 * 64 * 4);
    p.WinT = (bf16_t*)carve((size_t)2 * PW * D * 2);
    p.WoutT = (bf16_t*)carve((size_t)2 * D * D * 2);
    p.WguT = (bf16_t*)carve((size_t)2 * NE * 2048 * D * 2);
    p.WdnT = (bf16_t*)carve((size_t)2 * NE * D * FF * 2);
    p.topi = (int*)carve((size_t)R * 4 * 4);
    p.topg = (float*)carve((size_t)R * 4 * 4);
    p.tok_slot = (int*)carve((size_t)R * 4 * 4);
    p.slot_tok = (int*)carve((size_t)MAXSLOT * 4);
    p.ACT = (bf16_t*)carve((size_t)MAXSLOT * FF * 2);
    p.YB = (float*)carve((size_t)MAXSLOT * D * 4);

    hipMemsetAsync(p.cnt, 0, 2 * 64 * 4, stream);
    hipMemcpyAsync(p.X, p.x, (size_t)T * D * 4, hipMemcpyDeviceToDevice, stream);
    hipMemcpyAsync(p.X + (size_t)T * D, p.ctx, (size_t)TC * D * 4, hipMemcpyDeviceToDevice, stream);
    k_transpose<<<dim3(PW / 64, D / 64, 2), 256, 0, stream>>>(p.w_in, p.WinT, D, PW, 0);
    k_transpose<<<dim3(D / 64, D / 64, 2), 256, 0, stream>>>(p.w_out, p.WoutT, D, D, 0);
    k_transpose<<<dim3(2048 / 64, D / 64, 2 * NE), 256, 0, stream>>>(p.w_gu, p.WguT, D, 2048, 1);
    k_transpose<<<dim3(D / 64, FF / 64, 2 * NE), 256, 0, stream>>>(p.w_down, p.WdnT, FF, D, 0);
    k_mod<<<dim3(6144 / 256, 2), 256, 0, stream>>>(p);
    k_rope_table<<<1, 512, 0, stream>>>(p);
    for (int l = 0; l < 2; ++l) {
        const bool uc = (l == 0);
        const int nrows = uc ? R : T;
        k_norm1<<<R / 4, 256, 0, stream>>>(p, l);
        k_gemm_proj<<<dim3(PW / 128, R / 128), 256, 0, stream>>>(p, l);
        k_rope<<<T, 256, 0, stream>>>(p);
        k_dattn<<<dim3(nrows / 256, 4, 2), 256, 0, stream>>>(p);
        k_dattn_fin<<<nrows, 256, 0, stream>>>(p, l, nrows);
        k_na<<<nrows / 64, 256, 0, stream>>>(p, l);
        k_pool<<<nrows, 256, 0, stream>>>(p, l);
        k_sgu<<<dim3(nrows / 128, 4), 256, 0, stream>>>(p, l);
        k_gemm_out<<<dim3(D / 128, nrows / 128), 256, 0, stream>>>(p, l);
        k_router<<<nrows / 4, 256, 0, stream>>>(p, l, nrows);
        k_assign<<<nrows / 256, 256, 0, stream>>>(p, l, nrows);
        const int max_mt = nrows * 4 / 128 + NE;
        k_moe1<<<dim3(2048 / 128, max_mt), 256, 0, stream>>>(p, l);
        k_moe2<<<dim3(D / 128, max_mt), 256, 0, stream>>>(p, l);
        k_combine<<<nrows / 4, 256, 0, stream>>>(p, l, nrows);
    }
    k_final<<<T / 4, 256, 0, stream>>>(p);
}
```

```cpp
#include <hip/hip_runtime.h>
#include <stdint.h>
#include <cstdio>

typedef unsigned short bf16_t;
typedef short bf16x8 __attribute__((ext_vector_type(8)));
typedef float f32x4 __attribute__((ext_vector_type(4)));

constexpr int D = 1024, NB = 4, S = 4096, T = NB * S, CL = 256, TC = NB * CL, R = T + TC;
constexpr int PW = 2304, NE = 32, TOPK = 4, FF = 1024;
constexpr int MAXSLOT = R * TOPK;
constexpr float EPS = 1e-6f;
constexpr int NT = 512;
constexpr int LDS_BYTES = 96 * 1024;

__device__ __forceinline__ bf16_t f2bf(float f) { unsigned u = __float_as_uint(f); return (bf16_t)((u + 0x7fffu + ((u >> 16) & 1u)) >> 16); }
__device__ __forceinline__ float bf2f(bf16_t h) { return __uint_as_float(((unsigned)h) << 16); }
__device__ __forceinline__ float wave_sum(float v) {
#pragma unroll
    for (int o = 32; o >= 1; o >>= 1) v += __shfl_xor(v, o);
    return v;
}
__device__ __forceinline__ int mod_row(int row) { return row < T ? (row >> 12) : 4; }

#define XB_TMO      128
#define XB_XCNT(j)  (256  + 64 * (j))
#define XB_XSUB(j)  (1280 + 64 * (j))
#define XB_XGEN(j)  (2304 + 64 * (j))
#define XB_TOP      3328
#define XB_TOPGEN   3392
#define XCD_BAR_WORDS 3456
#define XB_SPIN_CAP (1u << 18)
#define LAS __attribute__((address_space(3)))

__device__ __forceinline__ unsigned xb_ld(unsigned* p)              { return __hip_atomic_load(p, __ATOMIC_RELAXED, __HIP_MEMORY_SCOPE_AGENT); }
__device__ __forceinline__ unsigned xb_add(unsigned* p, unsigned v) { return __hip_atomic_fetch_add(p, v, __ATOMIC_RELAXED, __HIP_MEMORY_SCOPE_AGENT); }
__device__ __forceinline__ unsigned xb_xcc_id() { return (unsigned)__builtin_amdgcn_s_getreg((3 << 11) | 20) & 0xFu; }
#define XB_SPIN(cond, bar) do { unsigned _sp = 0; while (cond) { __builtin_amdgcn_s_sleep(1); \
    if ((++_sp & 255u) == 0u) { if (xb_ld(&(bar)[XB_TMO])) break; if (_sp > XB_SPIN_CAP) { atomicAdd(&(bar)[XB_TMO], 1u); break; } } } } while (0)

struct XcdBarrier {
    unsigned* bar; unsigned x;
    volatile LAS unsigned* st;
};
__device__ __forceinline__ XcdBarrier xcd_barrier_post(unsigned* bar, volatile LAS unsigned* st) {
    XcdBarrier b; b.bar = bar; b.x = xb_xcc_id(); b.st = st;
    if (threadIdx.x == 0) (void)xb_add(&bar[XB_XCNT(b.x)], 1u);
    return b;
}
__device__ __forceinline__ void xcd_barrier_complete(unsigned* bar, unsigned x, unsigned& nloc, unsigned& nx) {
    const unsigned G = gridDim.x * gridDim.y * gridDim.z;
    unsigned sum, cnt, mine, sp = 0u;
    for (;;) {
        sum = 0u; cnt = 0u; mine = 0u;
#pragma unroll
        for (unsigned j = 0; j < 16; ++j) { const unsigned c = xb_ld(&bar[XB_XCNT(j)]); sum += c; cnt += (c > 0u) ? 1u : 0u; mine = (j == x) ? c : mine; }
        if (sum == G) break;
        __builtin_amdgcn_s_sleep(1);
        if ((++sp & 255u) == 0u) { if (xb_ld(&bar[XB_TMO])) break; if (sp > XB_SPIN_CAP) { atomicAdd(&bar[XB_TMO], 1u); break; } }
    }
    nloc = mine > 0u ? mine : 1u; nx = cnt > 0u ? cnt : 1u;
}
__device__ __forceinline__ void xcd_barrier(const XcdBarrier& b) {
    asm volatile("s_waitcnt vmcnt(0)" ::: "memory");
    __syncthreads();
    if (threadIdx.x == 0) {
        unsigned* bar = b.bar;
        __builtin_amdgcn_s_waitcnt(0);
        unsigned nloc = b.st[0], nx = b.st[1];
        if (nloc == 0u) { xcd_barrier_complete(bar, b.x, nloc, nx); b.st[0] = nloc; b.st[1] = nx; }
        const unsigned old = xb_add(&bar[XB_XSUB(b.x)], 1u);
        const unsigned gen = old / nloc;
        if (old + 1u == (gen + 1u) * nloc) {
            __builtin_amdgcn_fence(__ATOMIC_RELEASE, "agent");
            asm volatile("s_waitcnt vmcnt(0)" ::: "memory");
            const unsigned og = xb_add(&bar[XB_TOP], 1u);
            const unsigned tg = og / nx;
            if (og + 1u == (tg + 1u) * nx) xb_add(&bar[XB_TOPGEN], 1u);
            else XB_SPIN(xb_ld(&bar[XB_TOPGEN]) == tg, bar);
            __builtin_amdgcn_fence(__ATOMIC_ACQUIRE, "agent");
            xb_add(&bar[XB_XGEN(b.x)], 1u);
            asm volatile("s_waitcnt vmcnt(0)" ::: "memory");
        } else {
            XB_SPIN(xb_ld(&bar[XB_XGEN(b.x)]) == gen, bar);
            __builtin_amdgcn_fence(__ATOMIC_ACQUIRE, "agent");
            asm volatile("s_waitcnt vmcnt(0)" ::: "memory");
        }
    }
    __syncthreads();
}

struct P {
    const float *x, *c, *ctx, *c_ctx, *w_mod, *b_mod, *g_mix, *g_ffn, *w_in, *w_out, *lam_q1, *lam_k1, *lam_q2, *lam_k2, *g_sub,
        *w_pool, *s_pool, *g_sgu, *w_sgu, *b_sgu, *rpb, *w_router, *b_router, *w_gu, *b_gu, *w_down, *b_down, *g_final;
    float* out;
    unsigned* bar;
    int* cnt;
    float* mod;
    float* rope;
    float* X;
    bf16_t* H;
    float* PROJ;
    bf16_t* MIX;
    float* OA;
    bf16_t* WinT;
    bf16_t* WoutT;
    bf16_t* WguT;
    bf16_t* WdnT;
    int* topi;
    float* topg;
    int* tok_slot;
    int* slot_tok;
    bf16_t* ACT;
    float* YB;
};

__device__ __forceinline__ int ltid() { int t = threadIdx.x; asm volatile("" : "+v"(t)); return t; }
__device__ __forceinline__ void transpose_tile(const float* __restrict__ Wm, bf16_t* __restrict__ Wtm, int K, int N, int perm, int tn, int tk, float* tile  ) {
    const int n0 = tn * 64, k0 = tk * 64, tx = ltid() & 63, ty = ltid() >> 6;
    __syncthreads();
    for (int i = ty; i < 64; i += 8) tile[i * 65 + tx] = Wm[(size_t)(k0 + i) * N + n0 + tx];
    __syncthreads();
    for (int i = ty; i < 64; i += 8) {
        const int n = n0 + i;
        const int np = perm ? (n < N / 2 ? 2 * n : 2 * (n - N / 2) + 1) : n;
        Wtm[(size_t)np * K + k0 + tx] = f2bf(tile[tx * 65 + i]);
    }
}
__device__ __forceinline__ void ph_prologue(const P& p, char* lds) {
    const int tid = ltid();
    float* fl = (float*)lds;
    for (int it = blockIdx.x; it < 96; it += gridDim.x) {
        const int l = it / 48, cg = it % 48;
        float* sc = fl;
        float* part = fl + 5 * 1024;
        __syncthreads();
        for (int i = tid; i < 5 * 1024; i += NT) {
            const int r = i >> 10, k = i & 1023;
            const float v = r < 4 ? p.c[r * 1024 + k] : p.c_ctx[k];
            sc[i] = v / (1.f + __expf(-v));
        }
        __syncthreads();
        const int kq = tid >> 7, col = tid & 127, j = cg * 128 + col;
        const float* W = p.w_mod + (size_t)l * 1024 * 6144;
        float a0 = 0, a1 = 0, a2 = 0, a3 = 0, a4 = 0;
        for (int k = kq * 256; k < kq * 256 + 256; ++k) {
            const float w = W[(size_t)k * 6144 + j];
            a0 += sc[k] * w; a1 += sc[1024 + k] * w; a2 += sc[2048 + k] * w; a3 += sc[3072 + k] * w; a4 += sc[4096 + k] * w;
        }
        part[(kq * 5 + 0) * 128 + col] = a0; part[(kq * 5 + 1) * 128 + col] = a1; part[(kq * 5 + 2) * 128 + col] = a2;
        part[(kq * 5 + 3) * 128 + col] = a3; part[(kq * 5 + 4) * 128 + col] = a4;
        __syncthreads();
        for (int i = tid; i < 5 * 128; i += NT) {
            const int r = i >> 7, cc = i & 127, jj = cg * 128 + cc;
            const float v = part[(0 * 5 + r) * 128 + cc] + part[(1 * 5 + r) * 128 + cc] + part[(2 * 5 + r) * 128 + cc] + part[(3 * 5 + r) * 128 + cc];
            p.mod[((size_t)l * 5 + r) * 6144 + jj] = v + p.b_mod[l * 6144 + jj];
        }
    }
    if (blockIdx.x == gridDim.x - 1) {
        const int pos = tid >> 3, f = tid & 7;
        const float inv = powf(10000.0f, -(float)f / 8.0f);
        const float ang = (float)pos * inv;
        p.rope[tid * 2] = cosf(ang); p.rope[tid * 2 + 1] = sinf(ang);
    }
    {
        const size_t n4 = (size_t)R * D / 4, t4 = (size_t)T * D / 4;
        const float4* x4 = (const float4*)p.x; const float4* c4 = (const float4*)p.ctx; float4* X4 = (float4*)p.X;
        for (size_t i = (size_t)blockIdx.x * NT + tid; i < n4; i += (size_t)gridDim.x * NT) X4[i] = i < t4 ? x4[i] : c4[i - t4];
    }
    {
        const int n_in = 2 * 36 * 16, n_out = 2 * 16 * 16, n_gu = 64 * 32 * 16, n_dn = 64 * 16 * 16;
        const int total = n_in + n_out + n_gu + n_dn;
        for (int it = blockIdx.x; it < total; it += gridDim.x) {
            int i = it;
            if (i < n_in) { const int m = i / 576, r = i % 576; transpose_tile(p.w_in + (size_t)m * D * PW, p.WinT + (size_t)m * D * PW, D, PW, 0, r % 36, r / 36, fl); continue; }
            i -= n_in;
            if (i < n_out) { const int m = i / 256, r = i % 256; transpose_tile(p.w_out + (size_t)m * D * D, p.WoutT + (size_t)m * D * D, D, D, 0, r % 16, r / 16, fl); continue; }
            i -= n_out;
            if (i < n_gu) { const int m = i / 512, r = i % 512; transpose_tile(p.w_gu + (size_t)m * D * 2048, p.WguT + (size_t)m * D * 2048, D, 2048, 1, r % 32, r / 32, fl); continue; }
            i -= n_gu;
            { const int m = i / 256, r = i % 256; transpose_tile(p.w_down + (size_t)m * FF * D, p.WdnT + (size_t)m * FF * D, FF, D, 0, r % 16, r / 16, fl); }
        }
    }
}

__device__ __forceinline__ void ph_norm1(const P& p, int l) {
    const int wave = ltid() >> 6, lane = ltid() & 63;
    for (int row = blockIdx.x * 8 + wave; row < R; row += gridDim.x * 8) {
        const float* xr = p.X + (size_t)row * D;
        float4 v[4]; float ss = 0;
#pragma unroll
        for (int i = 0; i < 4; ++i) { v[i] = *(const float4*)(xr + lane * 4 + 256 * i); ss += v[i].x * v[i].x + v[i].y * v[i].y + v[i].z * v[i].z + v[i].w * v[i].w; }
        ss = wave_sum(ss);
        const float rstd = rsqrtf(ss * (1.f / D) + EPS);
        const float* m = p.mod + ((size_t)l * 5 + mod_row(row)) * 6144;
        const float* g = p.g_mix + l * D;
#pragma unroll
        for (int i = 0; i < 4; ++i) {
            const int k = lane * 4 + 256 * i;
            const float4 gg = *(const float4*)(g + k), sh = *(const float4*)(m + k), sc = *(const float4*)(m + 1024 + k);
            ushort4 o;
            o.x = f2bf(v[i].x * rstd * gg.x * (1.f + sc.x) + sh.x); o.y = f2bf(v[i].y * rstd * gg.y * (1.f + sc.y) + sh.y);
            o.z = f2bf(v[i].z * rstd * gg.z * (1.f + sc.z) + sh.z); o.w = f2bf(v[i].w * rstd * gg.w * (1.f + sc.w) + sh.w);
            *(ushort4*)(p.H + (size_t)row * D + k) = o;
        }
    }
}

constexpr int LSTR = 40;
constexpr int GEMM_LDS_ELEMS = 2 * (128 + 256) * LSTR;
template <class ARow, class Epi>
__device__ __forceinline__ void gemm_tile(const ARow& arow, int mvalid, const bf16_t* __restrict__ Bt, int K, const Epi& epi, bf16_t* lds) {
    const int tid = ltid(), lane = tid & 63, wid = tid >> 6, wm = wid >> 2, wn = wid & 3;
    bf16_t* As = lds;
    bf16_t* Bs = lds + 2 * 128 * LSTR;
    const int rowA = tid >> 2, kc = (tid & 3) * 8;
    const bf16_t* pa = arow(rowA) + kc;
    const bf16_t* pb0 = Bt + (size_t)rowA * K + kc;
    const bf16_t* pb1 = Bt + (size_t)(rowA + 128) * K + kc;
    const int lo = rowA * LSTR + kc;
    f32x4 acc[4][4];
#pragma unroll
    for (int m = 0; m < 4; ++m)
#pragma unroll
        for (int n = 0; n < 4; ++n) acc[m][n] = (f32x4){0.f, 0.f, 0.f, 0.f};
    uint4 ra = *(const uint4*)pa, rb0 = *(const uint4*)pb0, rb1 = *(const uint4*)pb1;
    __syncthreads();
    *(uint4*)(As + lo) = ra; *(uint4*)(Bs + lo) = rb0; *(uint4*)(Bs + 128 * LSTR + lo) = rb1;
    __syncthreads();
    const int nk = K / 32;
    const int fr = lane & 15, fq = lane >> 4;
    for (int kt = 0; kt < nk; ++kt) {
        const int cur = kt & 1;
        if (kt + 1 < nk) { ra = *(const uint4*)(pa + (kt + 1) * 32); rb0 = *(const uint4*)(pb0 + (kt + 1) * 32); rb1 = *(const uint4*)(pb1 + (kt + 1) * 32); }
        const bf16_t* Ac = As + cur * 128 * LSTR; const bf16_t* Bc = Bs + cur * 256 * LSTR;
        bf16x8 af[4], bfr[4];
#pragma unroll
        for (int m = 0; m < 4; ++m) af[m] = *(const bf16x8*)(Ac + (wm * 64 + m * 16 + fr) * LSTR + fq * 8);
#pragma unroll
        for (int n = 0; n < 4; ++n) bfr[n] = *(const bf16x8*)(Bc + (wn * 64 + n * 16 + fr) * LSTR + fq * 8);
#pragma unroll
        for (int m = 0; m < 4; ++m)
#pragma unroll
            for (int n = 0; n < 4; ++n) acc[m][n] = __builtin_amdgcn_mfma_f32_16x16x32_bf16(bfr[n], af[m], acc[m][n], 0, 0, 0);
        if (kt + 1 < nk) {
            const int nx = cur ^ 1;
            *(uint4*)(As + nx * 128 * LSTR + lo) = ra; *(uint4*)(Bs + nx * 256 * LSTR + lo) = rb0; *(uint4*)(Bs + nx * 256 * LSTR + 128 * LSTR + lo) = rb1;
        }
        __syncthreads();
    }
#pragma unroll
    for (int m = 0; m < 4; ++m) {
        const int row = wm * 64 + m * 16 + fr;
        if (row < mvalid) {
#pragma unroll
            for (int n = 0; n < 4; ++n) epi(row, wn * 64 + n * 16 + fq * 4, acc[m][n]);
        }
    }
}
struct ARowDense { const bf16_t* A; int K; __device__ __forceinline__ const bf16_t* operator()(int r) const { return A + (size_t)r * K; } };

__device__ __forceinline__ void ph_gemm_proj(const P& p, int l, char* lds) {
    const int ntn = PW / 256, ntm = R / 128;
    for (int it = blockIdx.x; it < ntn * ntm; it += gridDim.x) {
        const int n0 = (it % ntn) * 256, m0 = (it / ntn) * 128;
        ARowDense ar{p.H + (size_t)m0 * D, D};
        float* C = p.PROJ;
        auto epi = [&](int r, int c, f32x4 v) { *(f32x4*)(C + (size_t)(m0 + r) * PW + n0 + c) = v; };
        gemm_tile(ar, 128, p.WinT + ((size_t)l * PW + n0) * D, D, epi, (bf16_t*)lds);
    }
}
__device__ __forceinline__ void ph_gemm_out(const P& p, int l, int nrows, char* lds) {
    const int ntn = D / 256, ntm = nrows / 128;
    for (int it = blockIdx.x; it < ntn * ntm; it += gridDim.x) {
        const int n0 = (it % ntn) * 256, m0 = (it / ntn) * 128;
        ARowDense ar{p.MIX + (size_t)m0 * D, D};
        const float* m = p.mod + (size_t)l * 5 * 6144;
        float* X = p.X;
        auto epi = [&](int r, int c, f32x4 v) {
            const int row = m0 + r, col = n0 + c;
            const f32x4 g = *(const f32x4*)(m + (size_t)mod_row(row) * 6144 + 2 * 1024 + col);
            f32x4* xp = (f32x4*)(X + (size_t)row * D + col);
            *xp = *xp + g * v;
        };
        gemm_tile(ar, 128, p.WoutT + ((size_t)l * D + n0) * D, D, epi, (bf16_t*)lds);
    }
}

__device__ __forceinline__ void ph_rope(const P& p) {
    for (int idx = blockIdx.x * NT + ltid(); idx < T * 256; idx += gridDim.x * NT) {
        const int i = idx & 7, grp = (idx >> 3) & 3, hb = (idx >> 5) & 7, row = idx >> 8;
        const int s = row & 4095, pos = (grp & 1) ? (s & 63) : (s >> 6);
        const float cs = p.rope[(pos * 8 + i) * 2], sn = p.rope[(pos * 8 + i) * 2 + 1];
        float* q = p.PROJ + (size_t)row * PW + hb * 64 + grp * 16 + i;
        const float x1 = q[0], x2 = q[8];
        q[0] = x1 * cs - x2 * sn; q[8] = x1 * sn + x2 * cs;
    }
}

__device__ __forceinline__ void ph_dattn(const P& p, int nrows, char* lds) {
    const int tid = ltid(), half = tid >> 8, ht = tid & 255;
    float* Ks = (float*)lds + half * (64 * 32 + 64 * 32);
    float* Vs = Ks + 64 * 32;
    const int nlat = (T / 256) * 16, nall = (nrows / 256) * 16;
    for (int pit = blockIdx.x; pit < nall / 2; pit += gridDim.x) {
        const int vb = pit * 2 + half;
        const int qb = vb >> 4, h = (vb >> 2) & 3, map = (vb >> 1) & 1, dh = vb & 1;
        const bool isctx = vb >= nlat;
        const int qrow = qb * 256 + ht;
        const int b = isctx ? ((qrow - T) >> 8) : (qrow >> 12);
        float q[32], o[32];
        {
            const float* qp = p.PROJ + (size_t)qrow * PW + h * 64 + map * 32;
#pragma unroll
            for (int d = 0; d < 32; d += 4) { float4 t = *(const float4*)(qp + d); q[d] = t.x; q[d + 1] = t.y; q[d + 2] = t.z; q[d + 3] = t.w; }
        }
#pragma unroll
        for (int d = 0; d < 32; ++d) o[d] = 0.f;
        float mrun = -1e30f, lrun = 0.f;
        const float scale = 0.17677669529663687f;
        const int nkeys = isctx ? 256 : (4096 + 256);
        for (int k0 = 0; k0 < nkeys; k0 += 64) {
            int kbase;
            if (isctx) kbase = T + b * 256 + k0;
            else kbase = (k0 < 4096) ? (b * 4096 + k0) : (T + b * 256 + (k0 - 4096));
            __syncthreads();
#pragma unroll
            for (int i = 0; i < 2; ++i) {
                const int c = ht + 256 * i, r = c >> 3, d = (c & 7) * 4;
                *(float4*)&Ks[r * 32 + d] = *(const float4*)(p.PROJ + (size_t)(kbase + r) * PW + 256 + h * 64 + map * 32 + d);
                *(float4*)&Vs[r * 32 + d] = *(const float4*)(p.PROJ + (size_t)(kbase + r) * PW + 512 + h * 64 + dh * 32 + d);
            }
            __syncthreads();
#pragma unroll 1
            for (int j0 = 0; j0 < 64; j0 += 8) {
                float sc[8]; float mx = -1e30f;
#pragma unroll
                for (int j = 0; j < 8; ++j) {
                    float a = 0.f;
#pragma unroll
                    for (int d = 0; d < 32; d += 4) { float4 kk = *(const float4*)&Ks[(j0 + j) * 32 + d]; a += q[d] * kk.x + q[d + 1] * kk.y + q[d + 2] * kk.z + q[d + 3] * kk.w; }
                    sc[j] = a * scale; mx = fmaxf(mx, sc[j]);
                }
                const float mnew = fmaxf(mrun, mx), corr = __expf(mrun - mnew);
                mrun = mnew; lrun *= corr;
#pragma unroll
                for (int d = 0; d < 32; ++d) o[d] *= corr;
#pragma unroll
                for (int j = 0; j < 8; ++j) {
                    const float pj = __expf(sc[j] - mnew); lrun += pj;
#pragma unroll
                    for (int d = 0; d < 32; d += 4) { float4 vv = *(const float4*)&Vs[(j0 + j) * 32 + d]; o[d] += pj * vv.x; o[d + 1] += pj * vv.y; o[d + 2] += pj * vv.z; o[d + 3] += pj * vv.w; }
                }
            }
        }
        const float il = 1.f / lrun;
        float* op = p.OA + (((size_t)qrow * 4 + h) * 2 + map) * 64 + dh * 32;
#pragma unroll
        for (int d = 0; d < 32; d += 4) *(float4*)(op + d) = make_float4(o[d] * il, o[d + 1] * il, o[d + 2] * il, o[d + 3] * il);
    }
}
__device__ __forceinline__ void ph_dattn_fin(const P& p, int l, int nrows) {
    const int wave = ltid() >> 6, lane = ltid() & 63;
    float a = lane < 32 ? p.lam_q1[l * 32 + lane] * p.lam_k1[l * 32 + lane] : 0.f;
    float b = lane < 32 ? p.lam_q2[l * 32 + lane] * p.lam_k2[l * 32 + lane] : 0.f;
    a = wave_sum(a); b = wave_sum(b);
    const float lam_init = 0.8f - 0.6f * expf(-0.3f * (float)l);
    const float lam = expf(a) - expf(b) + lam_init;
    const float gs = p.g_sub[l * 64 + lane] * (1.f - lam_init);
    for (int item = blockIdx.x * 8 + wave; item < nrows * 4; item += gridDim.x * 8) {
        const int row = item >> 2, h = item & 3;
        const float* op = p.OA + ((size_t)row * 4 + h) * 2 * 64;
        const float o = op[lane] - lam * op[64 + lane];
        const float ss = wave_sum(o * o);
        p.MIX[(size_t)row * D + h * 64 + lane] = f2bf(o * rsqrtf(ss * (1.f / 64.f) + EPS) * gs);
    }
}

__device__ __forceinline__ void ph_na(const P& p, int l, int nrows) {
    const int tid = ltid(), dh = tid & 1, h = (tid >> 1) & 3;
    for (int qb = blockIdx.x; qb < nrows / 64; qb += gridDim.x) {
        const int qrow = qb * 64 + (tid >> 3);
        const bool isctx = qrow >= T;
        const int b = isctx ? ((qrow - T) >> 8) : (qrow >> 12);
        float q[64], o[32];
        {
            const float* qp = p.PROJ + (size_t)qrow * PW + 1536 + h * 64;
#pragma unroll
            for (int d = 0; d < 64; d += 4) { float4 t = *(const float4*)(qp + d); q[d] = t.x * 0.125f; q[d + 1] = t.y * 0.125f; q[d + 2] = t.z * 0.125f; q[d + 3] = t.w * 0.125f; }
        }
#pragma unroll
        for (int d = 0; d < 32; ++d) o[d] = 0.f;
        float mrun = -1e30f, lrun = 0.f;
        int r = 0, c = 0, rs = 0, ws = 0;
        if (!isctx) { const int s = qrow & 4095; r = s >> 6; c = s & 63; rs = min(max(r - 4, 0), 56); ws = min(max(c - 8, 0), 48); }
        const int nk = isctx ? 256 : 384;
        const float* rp = p.rpb + ((size_t)l * 4 + h) * 15 * 31;
#pragma unroll 1
        for (int j = 0; j < nk; ++j) {
            int krow; float bias = 0.f;
            if (isctx) krow = T + b * 256 + j;
            else if (j < 128) { const int kr = j >> 4, kc = j & 15; krow = b * 4096 + (rs + kr) * 64 + ws + kc; bias = rp[(rs + kr - r + 7) * 31 + (ws + kc - c + 15)]; }
            else krow = T + b * 256 + (j - 128);
            const float* kp = p.PROJ + (size_t)krow * PW + 1792 + h * 64;
            float a = bias;
#pragma unroll
            for (int d = 0; d < 64; d += 4) { float4 kk = *(const float4*)(kp + d); a += q[d] * kk.x + q[d + 1] * kk.y + q[d + 2] * kk.z + q[d + 3] * kk.w; }
            const float mnew = fmaxf(mrun, a), corr = __expf(mrun - mnew), pj = __expf(a - mnew);
            mrun = mnew; lrun = lrun * corr + pj;
            const float* vp = kp + 256 + dh * 32;
#pragma unroll
            for (int d = 0; d < 32; d += 4) { float4 vv = *(const float4*)(vp + d); o[d] = o[d] * corr + pj * vv.x; o[d + 1] = o[d + 1] * corr + pj * vv.y; o[d + 2] = o[d + 2] * corr + pj * vv.z; o[d + 3] = o[d + 3] * corr + pj * vv.w; }
        }
        const float il = 1.f / lrun;
        bf16_t* op = p.MIX + (size_t)qrow * D + 768 + h * 64 + dh * 32;
#pragma unroll
        for (int d = 0; d < 32; d += 4) { ushort4 w; w.x = f2bf(o[d] * il); w.y = f2bf(o[d + 1] * il); w.z = f2bf(o[d + 2] * il); w.w = f2bf(o[d + 3] * il); *(ushort4*)(op + d) = w; }
    }
}

__device__ __forceinline__ void ph_pool(const P& p, int l, int nrows, char* lds) {
    const int tid = ltid(), half = tid >> 8, ch = tid & 255, g = ch >> 6, w = 2 << g;
    float* dsh = (float*)lds + half * 256;
    const float* wp = p.w_pool + ((size_t)l * 4 + g) * 64 * 64;
    const float sp = p.s_pool[l * 256 + ch];
    for (int it = blockIdx.x; it < nrows / 2; it += gridDim.x) {
        const int row = it * 2 + half;
        const int L = row < T ? 4096 : 256;
        const int t = row < T ? (row & 4095) : ((row - T) & 255);
        const int base = row - t;
        const int lo = max(t - w / 2, 0), hi = min(t + w / 2 - 1, L - 1);
        float sum = 0.f;
        for (int rr = lo; rr <= hi; ++rr) sum += p.PROJ[(size_t)(base + rr) * PW + 768 + ch];
        const float y = p.PROJ[(size_t)row * PW + 768 + ch];
        __syncthreads();
        dsh[ch] = sum / (float)(hi - lo + 1) - y;
        __syncthreads();
        float a = 0.f;
#pragma unroll 8
        for (int i = 0; i < 64; ++i) a += dsh[g * 64 + i] * wp[i * 64 + (ch & 63)];
        p.MIX[(size_t)row * D + 256 + ch] = f2bf(a * sp);
    }
}

__device__ __forceinline__ float gelu_tanh(float x) { return 0.5f * x * (1.f + tanhf(0.7978845608028654f * (x + 0.044715f * x * x * x))); }
__device__ __forceinline__ void ph_sgu(const P& p, int l, int nrows, char* lds) {
    float* vn = (float*)lds;
    float* rstd = vn + 128 * 64;
    const int tid = ltid();
    for (int it = blockIdx.x; it < (nrows / 128) * 4; it += gridDim.x) {
        const int chunk = it >> 2, g = it & 3, row0 = chunk * 128;
        __syncthreads();
        {
            const int t = tid >> 2, qtr = tid & 3;
            const float* zp = p.PROJ + (size_t)(row0 + t) * PW + 1024 + 256 + qtr * 64;
            float ss = 0.f;
            for (int i = 0; i < 64; ++i) { const float v = gelu_tanh(zp[i]); ss += v * v; }
            ss += __shfl_xor(ss, 1); ss += __shfl_xor(ss, 2);
            if (qtr == 0) rstd[t] = rsqrtf(ss * (1.f / 256.f) + EPS);
        }
        __syncthreads();
        for (int i = tid; i < 128 * 64; i += NT) {
            const int s = i >> 6, cc = i & 63;
            const float v = gelu_tanh(p.PROJ[(size_t)(row0 + s) * PW + 1024 + 256 + g * 64 + cc]);
            vn[i] = v * rstd[s] * p.g_sgu[l * 256 + g * 64 + cc];
        }
        __syncthreads();
        const int cc = tid & 63;
        const float* ws = p.w_sgu + ((size_t)l * 4 + g) * 128 * 128;
        for (int t = tid >> 6; t < 128; t += 8) {
            float a = 0.f;
            const float* wr = ws + t * 128;
#pragma unroll 8
            for (int s = 0; s < 128; ++s) a += wr[s] * vn[s * 64 + cc];
            a += p.b_sgu[(l * 4 + g) * 128 + t];
            const float u = gelu_tanh(p.PROJ[(size_t)(row0 + t) * PW + 1024 + g * 64 + cc]);
            p.MIX[(size_t)(row0 + t) * D + 512 + g * 64 + cc] = f2bf(u * a);
        }
    }
}

__device__ __forceinline__ void ph_router(const P& p, int l, int nrows) {
    const int wave = ltid() >> 6, lane = ltid() & 63;
    for (int row = blockIdx.x * 8 + wave; row < nrows; row += gridDim.x * 8) {
        const float* xr = p.X + (size_t)row * D;
        float hf[16]; float ss = 0;
#pragma unroll
        for (int i = 0; i < 4; ++i) { float4 v = *(const float4*)(xr + lane * 4 + 256 * i); hf[4 * i] = v.x; hf[4 * i + 1] = v.y; hf[4 * i + 2] = v.z; hf[4 * i + 3] = v.w; ss += v.x * v.x + v.y * v.y + v.z * v.z + v.w * v.w; }
        ss = wave_sum(ss);
        const float rstd = rsqrtf(ss * (1.f / D) + EPS);
        const float* m = p.mod + ((size_t)l * 5 + mod_row(row)) * 6144;
        const float* g = p.g_ffn + l * D;
#pragma unroll
        for (int i = 0; i < 4; ++i) {
            const int k = lane * 4 + 256 * i;
            const float4 gg = *(const float4*)(g + k), sh = *(const float4*)(m + 3 * 1024 + k), sc = *(const float4*)(m + 4 * 1024 + k);
            hf[4 * i] = hf[4 * i] * rstd * gg.x * (1.f + sc.x) + sh.x; hf[4 * i + 1] = hf[4 * i + 1] * rstd * gg.y * (1.f + sc.y) + sh.y;
            hf[4 * i + 2] = hf[4 * i + 2] * rstd * gg.z * (1.f + sc.z) + sh.z; hf[4 * i + 3] = hf[4 * i + 3] * rstd * gg.w * (1.f + sc.w) + sh.w;
            ushort4 o; o.x = f2bf(hf[4 * i]); o.y = f2bf(hf[4 * i + 1]); o.z = f2bf(hf[4 * i + 2]); o.w = f2bf(hf[4 * i + 3]);
            *(ushort4*)(p.H + (size_t)row * D + k) = o;
        }
        float lg[32];
#pragma unroll
        for (int e = 0; e < 32; ++e) lg[e] = 0.f;
        const float* wr = p.w_router + (size_t)l * D * NE;
#pragma unroll
        for (int i = 0; i < 4; ++i)
#pragma unroll
            for (int j = 0; j < 4; ++j) {
                const int k = lane * 4 + 256 * i + j;
                const float hv = hf[4 * i + j];
#pragma unroll
                for (int e = 0; e < 32; e += 4) { const float4 w = *(const float4*)(wr + (size_t)k * NE + e); lg[e] += hv * w.x; lg[e + 1] += hv * w.y; lg[e + 2] += hv * w.z; lg[e + 3] += hv * w.w; }
            }
#pragma unroll
        for (int e = 0; e < 32; ++e) lg[e] = wave_sum(lg[e]) + p.b_router[l * NE + e];
        unsigned taken = 0u; float tv[4]; int ti[4];
#pragma unroll
        for (int k = 0; k < 4; ++k) {
            float best = -3.0e38f; int bi = 0;
#pragma unroll
            for (int e = 0; e < 32; ++e) { const bool ok = !((taken >> e) & 1u) && (lg[e] > best); best = ok ? lg[e] : best; bi = ok ? e : bi; }
            taken |= 1u << bi; tv[k] = best; ti[k] = bi;
        }
        const float e1 = __expf(tv[1] - tv[0]), e2 = __expf(tv[2] - tv[0]), e3 = __expf(tv[3] - tv[0]);
        const float inv = 1.f / (1.f + e1 + e2 + e3);
        if (lane == 0) {
            *(int4*)(p.topi + (size_t)row * 4) = make_int4(ti[0], ti[1], ti[2], ti[3]);
            *(float4*)(p.topg + (size_t)row * 4) = make_float4(inv, e1 * inv, e2 * inv, e3 * inv);
            int* cnt = p.cnt + l * 64;
            atomicAdd(&cnt[ti[0]], 1); atomicAdd(&cnt[ti[1]], 1); atomicAdd(&cnt[ti[2]], 1); atomicAdd(&cnt[ti[3]], 1);
        }
    }
}
__device__ __forceinline__ void ph_assign(const P& p, int l, int nrows, char* lds) {
    int* lcnt = (int*)lds; int* lbase = lcnt + 32; int* off = lbase + 32;
    const int tid = ltid();
    int* cnt = p.cnt + l * 64; int* cursor = cnt + 32;
    for (int it = blockIdx.x; it < nrows / NT; it += gridDim.x) {
        const int row = it * NT + tid;
        __syncthreads();
        if (tid < 32) lcnt[tid] = 0;
        if (tid == 0) { int a = 0; for (int e = 0; e < 32; ++e) { off[e] = a; a += cnt[e]; } }
        __syncthreads();
        const int4 ti = *(const int4*)(p.topi + (size_t)row * 4);
        const int r0 = atomicAdd(&lcnt[ti.x], 1), r1 = atomicAdd(&lcnt[ti.y], 1), r2 = atomicAdd(&lcnt[ti.z], 1), r3 = atomicAdd(&lcnt[ti.w], 1);
        __syncthreads();
        if (tid < 32) lbase[tid] = off[tid] + (lcnt[tid] ? atomicAdd(&cursor[tid], lcnt[tid]) : 0);
        __syncthreads();
        const int s0 = lbase[ti.x] + r0, s1 = lbase[ti.y] + r1, s2 = lbase[ti.z] + r2, s3 = lbase[ti.w] + r3;
        *(int4*)(p.tok_slot + (size_t)row * 4) = make_int4(s0, s1, s2, s3);
        p.slot_tok[s0] = row; p.slot_tok[s1] = row; p.slot_tok[s2] = row; p.slot_tok[s3] = row;
    }
}

struct MoeTile { int e, row0, mvalid; };
__device__ __forceinline__ bool moe_find_tile(const int* cnt, int mt, MoeTile& t, int* sh) {
    __syncthreads();
    if (ltid() == 0) {
        int acc_t = 0, acc_r = 0, fe = -1, fr0 = 0, fmv = 0;
        for (int e = 0; e < 32; ++e) {
            const int c = cnt[e], nt = (c + 127) >> 7;
            if (fe < 0 && mt < acc_t + nt) { fe = e; const int lt = mt - acc_t; fr0 = acc_r + lt * 128; fmv = min(128, c - lt * 128); }
            acc_t += nt; acc_r += c;
        }
        sh[0] = fe; sh[1] = fr0; sh[2] = fmv;
    }
    __syncthreads();
    t.e = sh[0]; t.row0 = sh[1]; t.mvalid = sh[2];
    return t.e >= 0;
}
struct ARowGather { const bf16_t* A; const int* idx; int mvalid; __device__ __forceinline__ const bf16_t* operator()(int r) const { return A + (size_t)idx[r < mvalid ? r : 0] * D; } };
struct ARowClamp { const bf16_t* A; int mvalid; __device__ __forceinline__ const bf16_t* operator()(int r) const { return A + (size_t)(r < mvalid ? r : 0) * D; } };

__device__ __forceinline__ void ph_moe1(const P& p, int l, int nrows, char* lds) {
    int* sh = (int*)(lds + GEMM_LDS_ELEMS * 2);
    const int ntn = 2048 / 256, max_mt = nrows * 4 / 128 + NE;
    for (int it = blockIdx.x; it < ntn * max_mt; it += gridDim.x) {
        MoeTile t;
        if (!moe_find_tile(p.cnt + l * 64, it / ntn, t, sh)) break;
        const int n0 = (it % ntn) * 256;
        ARowGather ar{p.H, p.slot_tok + t.row0, t.mvalid};
        const float* bg = p.b_gu + ((size_t)l * NE + t.e) * 2048;
        bf16_t* ACT = p.ACT;
        auto epi = [&](int r, int c, f32x4 v) {
            const int j = (n0 + c) >> 1;
            float o2[2];
#pragma unroll
            for (int q = 0; q < 2; ++q) {
                const float gt = fminf(v[2 * q] + bg[j + q], 7.0f);
                const float up = fminf(fmaxf(v[2 * q + 1] + bg[1024 + j + q], -7.0f), 7.0f);
                o2[q] = (up + 1.0f) * gt / (1.0f + __expf(-1.702f * gt));
            }
            ushort2 w; w.x = f2bf(o2[0]); w.y = f2bf(o2[1]);
            *(ushort2*)(ACT + (size_t)(t.row0 + r) * FF + j) = w;
        };
        gemm_tile(ar, t.mvalid, p.WguT + (((size_t)l * NE + t.e) * 2048 + n0) * D, D, epi, (bf16_t*)lds);
    }
}
__device__ __forceinline__ void ph_moe2(const P& p, int l, int nrows, char* lds) {
    int* sh = (int*)(lds + GEMM_LDS_ELEMS * 2);
    const int ntn = D / 256, max_mt = nrows * 4 / 128 + NE;
    for (int it = blockIdx.x; it < ntn * max_mt; it += gridDim.x) {
        MoeTile t;
        if (!moe_find_tile(p.cnt + l * 64, it / ntn, t, sh)) break;
        const int n0 = (it % ntn) * 256;
        ARowClamp ar{p.ACT + (size_t)t.row0 * FF, t.mvalid};
        const float* bd = p.b_down + ((size_t)l * NE + t.e) * D;
        float* YB = p.YB;
        auto epi = [&](int r, int c, f32x4 v) {
            const f32x4 bb = *(const f32x4*)(bd + n0 + c);
            *(f32x4*)(YB + (size_t)(t.row0 + r) * D + n0 + c) = v + bb;
        };
        gemm_tile(ar, t.mvalid, p.WdnT + (((size_t)l * NE + t.e) * D + n0) * FF, FF, epi, (bf16_t*)lds);
    }
}
__device__ __forceinline__ void ph_combine(const P& p, int l, int nrows) {
    const int wave = ltid() >> 6, lane = ltid() & 63;
    for (int row = blockIdx.x * 8 + wave; row < nrows; row += gridDim.x * 8) {
        const int4 sl = *(const int4*)(p.tok_slot + (size_t)row * 4);
        const float4 g = *(const float4*)(p.topg + (size_t)row * 4);
        const float* m = p.mod + ((size_t)l * 5 + mod_row(row)) * 6144 + 5 * 1024;
#pragma unroll
        for (int i = 0; i < 4; ++i) {
            const int k = lane * 4 + 256 * i;
            const float4 y0 = *(const float4*)(p.YB + (size_t)sl.x * D + k), y1 = *(const float4*)(p.YB + (size_t)sl.y * D + k);
            const float4 y2 = *(const float4*)(p.YB + (size_t)sl.z * D + k), y3 = *(const float4*)(p.YB + (size_t)sl.w * D + k);
            const float4 gt = *(const float4*)(m + k);
            float4* xp = (float4*)(p.X + (size_t)row * D + k);
            float4 xv = *xp;
            xv.x += gt.x * (g.x * y0.x + g.y * y1.x + g.z * y2.x + g.w * y3.x);
            xv.y += gt.y * (g.x * y0.y + g.y * y1.y + g.z * y2.y + g.w * y3.y);
            xv.z += gt.z * (g.x * y0.z + g.y * y1.z + g.z * y2.z + g.w * y3.z);
            xv.w += gt.w * (g.x * y0.w + g.y * y1.w + g.z * y2.w + g.w * y3.w);
            *xp = xv;
        }
    }
}
__device__ __forceinline__ void ph_final(const P& p) {
    const int wave = ltid() >> 6, lane = ltid() & 63;
    for (int row = blockIdx.x * 8 + wave; row < T; row += gridDim.x * 8) {
        const float* xr = p.X + (size_t)row * D;
        float4 v[4]; float ss = 0;
#pragma unroll
        for (int i = 0; i < 4; ++i) { v[i] = *(const float4*)(xr + lane * 4 + 256 * i); ss += v[i].x * v[i].x + v[i].y * v[i].y + v[i].z * v[i].z + v[i].w * v[i].w; }
        ss = wave_sum(ss);
        const float rstd = rsqrtf(ss * (1.f / D) + EPS);
#pragma unroll
        for (int i = 0; i < 4; ++i) {
            const int k = lane * 4 + 256 * i;
            const float4 gg = *(const float4*)(p.g_final + k);
            *(float4*)(p.out + (size_t)row * D + k) = make_float4(v[i].x * rstd * gg.x, v[i].y * rstd * gg.y, v[i].z * rstd * gg.z, v[i].w * rstd * gg.w);
        }
    }
}

extern __shared__ __attribute__((aligned(16))) char smem[];
__global__ void __launch_bounds__(NT, 2) mega(P p) {
    char* lds = smem + 16;
    if (threadIdx.x == 0) *(uint4*)smem = make_uint4(0u, 0u, 0u, 0u);
    __syncthreads();
    XcdBarrier bar = xcd_barrier_post(p.bar, (volatile LAS unsigned*)smem);
    ph_prologue(p, lds);
    xcd_barrier(bar);
#pragma unroll
    for (int l = 0; l < 2; ++l) {
        const int nrows = l == 0 ? R : T;
        ph_norm1(p, l);
        xcd_barrier(bar);
        ph_gemm_proj(p, l, lds);
        xcd_barrier(bar);
        ph_rope(p);
        xcd_barrier(bar);
        ph_dattn(p, nrows, lds);
        ph_na(p, l, nrows);
        ph_pool(p, l, nrows, lds);
        ph_sgu(p, l, nrows, lds);
        xcd_barrier(bar);
        ph_dattn_fin(p, l, nrows);
        xcd_barrier(bar);
        ph_gemm_out(p, l, nrows, lds);
        xcd_barrier(bar);
        ph_router(p, l, nrows);
        xcd_barrier(bar);
        ph_assign(p, l, nrows, lds);
        xcd_barrier(bar);
        ph_moe1(p, l, nrows, lds);
        xcd_barrier(bar);
        ph_moe2(p, l, nrows, lds);
        xcd_barrier(bar);
        ph_combine(p, l, nrows);
        xcd_barrier(bar);
    }
    ph_final(p);
}

static inline size_t align_up(size_t v, size_t a) { return (v + a - 1) / a * a; }

extern "C" void kernel_launch(void* const* d_in, const int* in_sizes, int n_in, void* d_out, int out_size, void* d_ws, size_t ws_size, hipStream_t stream) {
    P p{};
    const float** ins = (const float**)&p.x;
    for (int i = 0; i < 28; ++i) ins[i] = (const float*)d_in[i];
    p.out = (float*)d_out;
    char* w = (char*)d_ws; size_t off = 0;
    auto carve = [&](size_t bytes) { void* r = w + off; off = align_up(off + bytes, 256); return r; };
    const size_t ctl_bytes = XCD_BAR_WORDS * 4 + 2 * 64 * 4;
    p.bar = (unsigned*)carve(ctl_bytes);
    p.cnt = (int*)(p.bar + XCD_BAR_WORDS);
    p.mod = (float*)carve((size_t)2 * 5 * 6144 * 4);
    p.rope = (float*)carve(64 * 8 * 2 * 4);
    p.X = (float*)carve((size_t)R * D * 4);
    p.H = (bf16_t*)carve((size_t)R * D * 2);
    p.PROJ = (float*)carve((size_t)R * PW * 4);
    p.MIX = (bf16_t*)carve((size_t)R * D * 2);
    p.OA = (float*)carve((size_t)R * 4 * 2 * 64 * 4);
    p.WinT = (bf16_t*)carve((size_t)2 * PW * D * 2);
    p.WoutT = (bf16_t*)carve((size_t)2 * D * D * 2);
    p.WguT = (bf16_t*)carve((size_t)2 * NE * 2048 * D * 2);
    p.WdnT = (bf16_t*)carve((size_t)2 * NE * D * FF * 2);
    p.topi = (int*)carve((size_t)R * 4 * 4);
    p.topg = (float*)carve((size_t)R * 4 * 4);
    p.tok_slot = (int*)carve((size_t)R * 4 * 4);
    p.slot_tok = (int*)carve((size_t)MAXSLOT * 4);
    p.ACT = (bf16_t*)carve((size_t)MAXSLOT * FF * 2);
    p.YB = (float*)carve((size_t)MAXSLOT * D * 4);

    static int grid = 0;
    if (!grid) {
        int dev = 0, cus = 0, per_cu = 0;
        (void)hipGetDevice(&dev);
        (void)hipDeviceGetAttribute(&cus, hipDeviceAttributeMultiprocessorCount, dev);
        (void)hipFuncSetAttribute((const void*)mega, hipFuncAttributeMaxDynamicSharedMemorySize, LDS_BYTES);
        (void)hipOccupancyMaxActiveBlocksPerMultiprocessor(&per_cu, mega, NT, LDS_BYTES);
        grid = cus * (per_cu < 1 ? per_cu : 1);
        if (grid <= 0) { fprintf(stderr, "mega: occupancy query returned %d blocks per CU\n", per_cu); grid = 0; return; }
    }
    (void)hipMemsetAsync(p.bar, 0, ctl_bytes, stream);
    mega<<<grid, NT, LDS_BYTES, stream>>>(p);
}
```

```cpp
#include <hip/hip_runtime.h>
#include <stdint.h>
#include <cstdio>

typedef unsigned short bf16_t;
typedef short bf16x8 __attribute__((ext_vector_type(8)));
typedef float f32x4 __attribute__((ext_vector_type(4)));

constexpr int D = 1024, NB = 4, S = 4096, T = NB * S, CL = 256, TC = NB * CL, R = T + TC;
constexpr int PW = 2304, NE = 32, TOPK = 4, FF = 1024;
constexpr int MAXSLOT = R * TOPK;
constexpr float EPS = 1e-6f;
constexpr int NT = 512;
constexpr int LDS_BYTES = 96 * 1024;

__device__ __forceinline__ bf16_t f2bf(float f) { unsigned u = __float_as_uint(f); return (bf16_t)((u + 0x7fffu + ((u >> 16) & 1u)) >> 16); }
__device__ __forceinline__ float bf2f(bf16_t h) { return __uint_as_float(((unsigned)h) << 16); }
__device__ __forceinline__ float wave_sum(float v) {
#pragma unroll
    for (int o = 32; o >= 1; o >>= 1) v += __shfl_xor(v, o);
    return v;
}
__device__ __forceinline__ int mod_row(int row) { return row < T ? (row >> 12) : 4; }

#define XB_TMO      128
#define XB_XCNT(j)  (256  + 64 * (j))
#define XB_XSUB(j)  (1280 + 64 * (j))
#define XB_XGEN(j)  (2304 + 64 * (j))
#define XB_TOP      3328
#define XB_TOPGEN   3392
#define XCD_BAR_WORDS 3456
#define XB_SPIN_CAP (1u << 18)
#define LAS __attribute__((address_space(3)))

__device__ __forceinline__ unsigned xb_ld(unsigned* p)              { return __hip_atomic_load(p, __ATOMIC_RELAXED, __HIP_MEMORY_SCOPE_AGENT); }
__device__ __forceinline__ unsigned xb_add(unsigned* p, unsigned v) { return __hip_atomic_fetch_add(p, v, __ATOMIC_RELAXED, __HIP_MEMORY_SCOPE_AGENT); }
__device__ __forceinline__ unsigned xb_xcc_id() { return (unsigned)__builtin_amdgcn_s_getreg((3 << 11) | 20) & 0xFu; }
#define XB_SPIN(cond, bar) do { unsigned _sp = 0; while (cond) { __builtin_amdgcn_s_sleep(1); \
    if ((++_sp & 255u) == 0u) { if (xb_ld(&(bar)[XB_TMO])) break; if (_sp > XB_SPIN_CAP) { atomicAdd(&(bar)[XB_TMO], 1u); break; } } } } while (0)

struct XcdBarrier {
    unsigned* bar; unsigned x;
    volatile LAS unsigned* st;
};
__device__ __forceinline__ XcdBarrier xcd_barrier_post(unsigned* bar, volatile LAS unsigned* st) {
    XcdBarrier b; b.bar = bar; b.x = xb_xcc_id(); b.st = st;
    if (threadIdx.x == 0) (void)xb_add(&bar[XB_XCNT(b.x)], 1u);
    return b;
}
__device__ __forceinline__ void xcd_barrier_complete(unsigned* bar, unsigned x, unsigned& nloc, unsigned& nx) {
    const unsigned G = gridDim.x * gridDim.y * gridDim.z;
    unsigned sum, cnt, mine, sp = 0u;
    for (;;) {
        sum = 0u; cnt = 0u; mine = 0u;
#pragma unroll
        for (unsigned j = 0; j < 16; ++j) { const unsigned c = xb_ld(&bar[XB_XCNT(j)]); sum += c; cnt += (c > 0u) ? 1u : 0u; mine = (j == x) ? c : mine; }
        if (sum == G) break;
        __builtin_amdgcn_s_sleep(1);
        if ((++sp & 255u) == 0u) { if (xb_ld(&bar[XB_TMO])) break; if (sp > XB_SPIN_CAP) { atomicAdd(&bar[XB_TMO], 1u); break; } }
    }
    nloc = mine > 0u ? mine : 1u; nx = cnt > 0u ? cnt : 1u;
}
__device__ __forceinline__ void xcd_barrier(const XcdBarrier& b) {
    asm volatile("s_waitcnt vmcnt(0)" ::: "memory");
    __syncthreads();
    if (threadIdx.x == 0) {
        unsigned* bar = b.bar;
        __builtin_amdgcn_s_waitcnt(0);
        unsigned nloc = b.st[0], nx = b.st[1];
        if (nloc == 0u) { xcd_barrier_complete(bar, b.x, nloc, nx); b.st[0] = nloc; b.st[1] = nx; }
        const unsigned old = xb_add(&bar[XB_XSUB(b.x)], 1u);
        const unsigned gen = old / nloc;
        if (old + 1u == (gen + 1u) * nloc) {
            __builtin_amdgcn_fence(__ATOMIC_RELEASE, "agent");
            asm volatile("s_waitcnt vmcnt(0)" ::: "memory");
            const unsigned og = xb_add(&bar[XB_TOP], 1u);
            const unsigned tg = og / nx;
            if (og + 1u == (tg + 1u) * nx) xb_add(&bar[XB_TOPGEN], 1u);
            else XB_SPIN(xb_ld(&bar[XB_TOPGEN]) == tg, bar);
            __builtin_amdgcn_fence(__ATOMIC_ACQUIRE, "agent");
            xb_add(&bar[XB_XGEN(b.x)], 1u);
            asm volatile("s_waitcnt vmcnt(0)" ::: "memory");
        } else {
            XB_SPIN(xb_ld(&bar[XB_XGEN(b.x)]) == gen, bar);
            __builtin_amdgcn_fence(__ATOMIC_ACQUIRE, "agent");
            asm volatile("s_waitcnt vmcnt(0)" ::: "memory");
        }
    }
    __syncthreads();
}

struct P {
    const float *x, *c, *ctx, *c_ctx, *w_mod, *b_mod, *g_mix, *g_ffn, *w_in, *w_out, *lam_q1, *lam_k1, *lam_q2, *lam_k2, *g_sub,
        *w_pool, *s_pool, *g_sgu, *w_sgu, *b_sgu, *rpb, *w_router, *b_router, *w_gu, *b_gu, *w_down, *b_down, *g_final;
    float* out;
    unsigned* bar;
    int* cnt;
    float* mod;
    float* rope;
    float* X;
    bf16_t* H;
    bf16_t* PROJ;
    bf16_t* MIX;
    bf16_t* WinT;
    bf16_t* WoutT;
    bf16_t* WguT;
    bf16_t* WdnT;
    int* topi;
    float* topg;
    int* tok_slot;
    int* slot_tok;
    bf16_t* ACT;
    float* YB;
};

__device__ __forceinline__ int ltid() { int t = threadIdx.x; asm volatile("" : "+v"(t)); return t; }
__device__ __forceinline__ void transpose_tile(const float* __restrict__ Wm, bf16_t* __restrict__ Wtm, int K, int N, int perm, int tn, int tk, float* tile  ) {
    const int n0 = tn * 64, k0 = tk * 64, tx = ltid() & 63, ty = ltid() >> 6;
    __syncthreads();
    for (int i = ty; i < 64; i += 8) tile[i * 65 + tx] = Wm[(size_t)(k0 + i) * N + n0 + tx];
    __syncthreads();
    for (int i = ty; i < 64; i += 8) {
        const int n = n0 + i;
        const int np = perm ? (n < N / 2 ? 2 * n : 2 * (n - N / 2) + 1) : n;
        Wtm[(size_t)np * K + k0 + tx] = f2bf(tile[tx * 65 + i]);
    }
}
__device__ __forceinline__ void ph_prologue(const P& p, char* lds) {
    const int tid = ltid();
    float* fl = (float*)lds;
    for (int it = blockIdx.x; it < 96; it += gridDim.x) {
        const int l = it / 48, cg = it % 48;
        float* sc = fl;
        float* part = fl + 5 * 1024;
        __syncthreads();
        for (int i = tid; i < 5 * 1024; i += NT) {
            const int r = i >> 10, k = i & 1023;
            const float v = r < 4 ? p.c[r * 1024 + k] : p.c_ctx[k];
            sc[i] = v / (1.f + __expf(-v));
        }
        __syncthreads();
        const int kq = tid >> 7, col = tid & 127, j = cg * 128 + col;
        const float* W = p.w_mod + (size_t)l * 1024 * 6144;
        float a0 = 0, a1 = 0, a2 = 0, a3 = 0, a4 = 0;
        for (int k = kq * 256; k < kq * 256 + 256; ++k) {
            const float w = W[(size_t)k * 6144 + j];
            a0 += sc[k] * w; a1 += sc[1024 + k] * w; a2 += sc[2048 + k] * w; a3 += sc[3072 + k] * w; a4 += sc[4096 + k] * w;
        }
        part[(kq * 5 + 0) * 128 + col] = a0; part[(kq * 5 + 1) * 128 + col] = a1; part[(kq * 5 + 2) * 128 + col] = a2;
        part[(kq * 5 + 3) * 128 + col] = a3; part[(kq * 5 + 4) * 128 + col] = a4;
        __syncthreads();
        for (int i = tid; i < 5 * 128; i += NT) {
            const int r = i >> 7, cc = i & 127, jj = cg * 128 + cc;
            const float v = part[(0 * 5 + r) * 128 + cc] + part[(1 * 5 + r) * 128 + cc] + part[(2 * 5 + r) * 128 + cc] + part[(3 * 5 + r) * 128 + cc];
            p.mod[((size_t)l * 5 + r) * 6144 + jj] = v + p.b_mod[l * 6144 + jj];
        }
    }
    if (blockIdx.x == gridDim.x - 1) {
        const int pos = tid >> 3, f = tid & 7;
        const float inv = powf(10000.0f, -(float)f / 8.0f);
        const float ang = (float)pos * inv;
        p.rope[tid * 2] = cosf(ang); p.rope[tid * 2 + 1] = sinf(ang);
    }
    {
        const size_t n4 = (size_t)R * D / 4, t4 = (size_t)T * D / 4;
        const float4* x4 = (const float4*)p.x; const float4* c4 = (const float4*)p.ctx; float4* X4 = (float4*)p.X;
        for (size_t i = (size_t)blockIdx.x * NT + tid; i < n4; i += (size_t)gridDim.x * NT) X4[i] = i < t4 ? x4[i] : c4[i - t4];
    }
    {
        const int n_in = 2 * 36 * 16, n_out = 2 * 16 * 16, n_gu = 64 * 32 * 16, n_dn = 64 * 16 * 16;
        const int total = n_in + n_out + n_gu + n_dn;
        for (int it = blockIdx.x; it < total; it += gridDim.x) {
            int i = it;
            if (i < n_in) { const int m = i / 576, r = i % 576; transpose_tile(p.w_in + (size_t)m * D * PW, p.WinT + (size_t)m * D * PW, D, PW, 0, r % 36, r / 36, fl); continue; }
            i -= n_in;
            if (i < n_out) { const int m = i / 256, r = i % 256; transpose_tile(p.w_out + (size_t)m * D * D, p.WoutT + (size_t)m * D * D, D, D, 0, r % 16, r / 16, fl); continue; }
            i -= n_out;
            if (i < n_gu) { const int m = i / 512, r = i % 512; transpose_tile(p.w_gu + (size_t)m * D * 2048, p.WguT + (size_t)m * D * 2048, D, 2048, 1, r % 32, r / 32, fl); continue; }
            i -= n_gu;
            { const int m = i / 256, r = i % 256; transpose_tile(p.w_down + (size_t)m * FF * D, p.WdnT + (size_t)m * FF * D, FF, D, 0, r % 16, r / 16, fl); }
        }
    }
}

__device__ __forceinline__ void ph_norm1(const P& p, int l) {
    const int wave = ltid() >> 6, lane = ltid() & 63;
    for (int row = blockIdx.x * 8 + wave; row < R; row += gridDim.x * 8) {
        const float* xr = p.X + (size_t)row * D;
        float4 v[4]; float ss = 0;
#pragma unroll
        for (int i = 0; i < 4; ++i) { v[i] = *(const float4*)(xr + lane * 4 + 256 * i); ss += v[i].x * v[i].x + v[i].y * v[i].y + v[i].z * v[i].z + v[i].w * v[i].w; }
        ss = wave_sum(ss);
        const float rstd = rsqrtf(ss * (1.f / D) + EPS);
        const float* m = p.mod + ((size_t)l * 5 + mod_row(row)) * 6144;
        const float* g = p.g_mix + l * D;
#pragma unroll
        for (int i = 0; i < 4; ++i) {
            const int k = lane * 4 + 256 * i;
            const float4 gg = *(const float4*)(g + k), sh = *(const float4*)(m + k), sc = *(const float4*)(m + 1024 + k);
            ushort4 o;
            o.x = f2bf(v[i].x * rstd * gg.x * (1.f + sc.x) + sh.x); o.y = f2bf(v[i].y * rstd * gg.y * (1.f + sc.y) + sh.y);
            o.z = f2bf(v[i].z * rstd * gg.z * (1.f + sc.z) + sh.z); o.w = f2bf(v[i].w * rstd * gg.w * (1.f + sc.w) + sh.w);
            *(ushort4*)(p.H + (size_t)row * D + k) = o;
        }
    }
}

constexpr int LSTR = 40;
constexpr int GEMM_LDS_ELEMS = 2 * (128 + 256) * LSTR;
template <class ARow, class Epi>
__device__ __forceinline__ void gemm_tile(const ARow& arow, int mvalid, const bf16_t* __restrict__ Bt, int K, const Epi& epi, bf16_t* lds) {
    const int tid = ltid(), lane = tid & 63, wid = tid >> 6, wm = wid >> 2, wn = wid & 3;
    bf16_t* As = lds;
    bf16_t* Bs = lds + 2 * 128 * LSTR;
    const int rowA = tid >> 2, kc = (tid & 3) * 8;
    const bf16_t* pa = arow(rowA) + kc;
    const bf16_t* pb0 = Bt + (size_t)rowA * K + kc;
    const bf16_t* pb1 = Bt + (size_t)(rowA + 128) * K + kc;
    const int lo = rowA * LSTR + kc;
    f32x4 acc[4][4];
#pragma unroll
    for (int m = 0; m < 4; ++m)
#pragma unroll
        for (int n = 0; n < 4; ++n) acc[m][n] = (f32x4){0.f, 0.f, 0.f, 0.f};
    uint4 ra = *(const uint4*)pa, rb0 = *(const uint4*)pb0, rb1 = *(const uint4*)pb1;
    __syncthreads();
    *(uint4*)(As + lo) = ra; *(uint4*)(Bs + lo) = rb0; *(uint4*)(Bs + 128 * LSTR + lo) = rb1;
    __syncthreads();
    const int nk = K / 32;
    const int fr = lane & 15, fq = lane >> 4;
    for (int kt = 0; kt < nk; ++kt) {
        const int cur = kt & 1;
        if (kt + 1 < nk) { ra = *(const uint4*)(pa + (kt + 1) * 32); rb0 = *(const uint4*)(pb0 + (kt + 1) * 32); rb1 = *(const uint4*)(pb1 + (kt + 1) * 32); }
        const bf16_t* Ac = As + cur * 128 * LSTR; const bf16_t* Bc = Bs + cur * 256 * LSTR;
        bf16x8 af[4], bfr[4];
#pragma unroll
        for (int m = 0; m < 4; ++m) af[m] = *(const bf16x8*)(Ac + (wm * 64 + m * 16 + fr) * LSTR + fq * 8);
#pragma unroll
        for (int n = 0; n < 4; ++n) bfr[n] = *(const bf16x8*)(Bc + (wn * 64 + n * 16 + fr) * LSTR + fq * 8);
#pragma unroll
        for (int m = 0; m < 4; ++m)
#pragma unroll
            for (int n = 0; n < 4; ++n) acc[m][n] = __builtin_amdgcn_mfma_f32_16x16x32_bf16(bfr[n], af[m], acc[m][n], 0, 0, 0);
        if (kt + 1 < nk) {
            const int nx = cur ^ 1;
            *(uint4*)(As + nx * 128 * LSTR + lo) = ra; *(uint4*)(Bs + nx * 256 * LSTR + lo) = rb0; *(uint4*)(Bs + nx * 256 * LSTR + 128 * LSTR + lo) = rb1;
        }
        __syncthreads();
    }
#pragma unroll
    for (int m = 0; m < 4; ++m) {
        const int row = wm * 64 + m * 16 + fr;
        if (row < mvalid) {
#pragma unroll
            for (int n = 0; n < 4; ++n) epi(row, wn * 64 + n * 16 + fq * 4, acc[m][n]);
        }
    }
}
struct ARowDense { const bf16_t* A; int K; __device__ __forceinline__ const bf16_t* operator()(int r) const { return A + (size_t)r * K; } };

__device__ __forceinline__ void ph_gemm_proj(const P& p, int l, char* lds) {
    const int ntn = PW / 256, ntm = R / 128;
    for (int it = blockIdx.x; it < ntn * ntm; it += gridDim.x) {
        const int n0 = (it % ntn) * 256, m0 = (it / ntn) * 128;
        ARowDense ar{p.H + (size_t)m0 * D, D};
        bf16_t* C = p.PROJ;
        auto epi = [&](int r, int c, f32x4 v) { ushort4 w; w.x = f2bf(v[0]); w.y = f2bf(v[1]); w.z = f2bf(v[2]); w.w = f2bf(v[3]); *(ushort4*)(C + (size_t)(m0 + r) * PW + n0 + c) = w; };
        gemm_tile(ar, 128, p.WinT + ((size_t)l * PW + n0) * D, D, epi, (bf16_t*)lds);
    }
}
__device__ __forceinline__ void ph_gemm_out(const P& p, int l, int nrows, char* lds) {
    const int ntn = D / 256, ntm = nrows / 128;
    for (int it = blockIdx.x; it < ntn * ntm; it += gridDim.x) {
        const int n0 = (it % ntn) * 256, m0 = (it / ntn) * 128;
        ARowDense ar{p.MIX + (size_t)m0 * D, D};
        const float* m = p.mod + (size_t)l * 5 * 6144;
        float* X = p.X;
        auto epi = [&](int r, int c, f32x4 v) {
            const int row = m0 + r, col = n0 + c;
            const f32x4 g = *(const f32x4*)(m + (size_t)mod_row(row) * 6144 + 2 * 1024 + col);
            f32x4* xp = (f32x4*)(X + (size_t)row * D + col);
            *xp = *xp + g * v;
        };
        gemm_tile(ar, 128, p.WoutT + ((size_t)l * D + n0) * D, D, epi, (bf16_t*)lds);
    }
}

constexpr float QSCALE = 0.17677669529663687f * 1.4426950408889634f;
__device__ __forceinline__ void ph_rope(const P& p, int nrows) {
    for (int idx = blockIdx.x * NT + ltid(); idx < nrows * 256; idx += gridDim.x * NT) {
        const int i = idx & 7, grp = (idx >> 3) & 3, hb = (idx >> 5) & 7, row = idx >> 8;
        if (row >= T && hb >= 4) continue;
        bf16_t* q = p.PROJ + (size_t)row * PW + hb * 64 + grp * 16 + i;
        float x1 = bf2f(q[0]), x2 = bf2f(q[8]);
        if (row < T) {
            const int s = row & 4095, pos = (grp & 1) ? (s & 63) : (s >> 6);
            const float cs = p.rope[(pos * 8 + i) * 2], sn = p.rope[(pos * 8 + i) * 2 + 1];
            const float y1 = x1 * cs - x2 * sn, y2 = x1 * sn + x2 * cs; x1 = y1; x2 = y2;
        }
        if (hb < 4) { x1 *= QSCALE; x2 *= QSCALE; }
        q[0] = f2bf(x1); q[8] = f2bf(x2);
    }
}

typedef float f32x16 __attribute__((ext_vector_type(16)));
typedef short s16x4 __attribute__((ext_vector_type(4)));
typedef short v4i16_t __attribute__((ext_vector_type(4)));
typedef float f32x2_t __attribute__((ext_vector_type(2)));
typedef __bf16 bf16x2_t __attribute__((ext_vector_type(2)));
typedef __attribute__((address_space(3))) const char* lds_cptr;
typedef unsigned u32x4 __attribute__((ext_vector_type(4)));
__device__ __forceinline__ unsigned cvtpk(float lo, float hi) { f32x2_t v = {lo, hi}; bf16x2_t b = __builtin_convertvector(v, bf16x2_t); return __builtin_bit_cast(unsigned, b); }
__device__ __forceinline__ s16x4 vtr(lds_cptr q) { return __builtin_bit_cast(s16x4, __builtin_amdgcn_ds_read_tr16_b64_v4i16((__attribute__((address_space(3))) v4i16_t*)q)); }
__device__ __forceinline__ float xhalf_max(float v) { auto rr = __builtin_amdgcn_permlane32_swap(__float_as_uint(v), __float_as_uint(v), false, false); return fmaxf(__uint_as_float(rr[0]), __uint_as_float(rr[1])); }
__device__ __forceinline__ float xhalf_sum(float v) { auto rr = __builtin_amdgcn_permlane32_swap(__float_as_uint(v), __float_as_uint(v), false, false); return __uint_as_float(rr[0]) + __uint_as_float(rr[1]); }
__device__ __forceinline__ void dsoftmax(const f32x16& s, float& m, float& l, f32x16& o0, f32x16& o1, bf16x8& pa, bf16x8& pb) {
    float mx = fmaxf(fmaxf(fmaxf(s[0], s[1]), fmaxf(s[2], s[3])), fmaxf(fmaxf(s[4], s[5]), fmaxf(s[6], s[7])));
    mx = fmaxf(mx, fmaxf(fmaxf(fmaxf(s[8], s[9]), fmaxf(s[10], s[11])), fmaxf(fmaxf(s[12], s[13]), fmaxf(s[14], s[15]))));
    mx = xhalf_max(mx);
    if (__any(mx > m)) {
        const float mn = fmaxf(m, mx), alpha = __builtin_amdgcn_exp2f(m - mn);
        o0 *= alpha; o1 *= alpha; l *= alpha; m = mn;
    }
    float pr[16]; float sum = 0.f;
#pragma unroll
    for (int r = 0; r < 16; ++r) { pr[r] = __builtin_amdgcn_exp2f(s[r] - m); sum += pr[r]; }
    l += sum;
    u32x4 a, b;
    a[0] = cvtpk(pr[0], pr[1]); a[1] = cvtpk(pr[2], pr[3]); a[2] = cvtpk(pr[4], pr[5]); a[3] = cvtpk(pr[6], pr[7]);
    b[0] = cvtpk(pr[8], pr[9]); b[1] = cvtpk(pr[10], pr[11]); b[2] = cvtpk(pr[12], pr[13]); b[3] = cvtpk(pr[14], pr[15]);
    pa = __builtin_bit_cast(bf16x8, a); pb = __builtin_bit_cast(bf16x8, b);
}
__device__ __forceinline__ void ph_dattn(const P& p, int l, int nrows, char* lds) {
    const int tid = ltid(), lane = tid & 63, wid = tid >> 6, r32 = lane & 31, hi = lane >> 5;
    float la = lane < 32 ? p.lam_q1[l * 32 + lane] * p.lam_k1[l * 32 + lane] : 0.f;
    float lb = lane < 32 ? p.lam_q2[l * 32 + lane] * p.lam_k2[l * 32 + lane] : 0.f;
    la = wave_sum(la); lb = wave_sum(lb);
    const float lam_init = 0.8f - 0.6f * expf(-0.3f * (float)l);
    const float lam = expf(la) - expf(lb) + lam_init;
    const bf16_t* PR = p.PROJ;
    const int nunits = (nrows == R) ? 256 + 16 : 256;
    const int skey = 8 * wid + (lane & 7), schunk = lane >> 3;
    const int ldsK = schunk * 1024 + skey * 16;
    const int ldsV = 8192 + (schunk >> 2) * 4096 + (skey >> 3) * 512 + (skey & 7) * 64 + (schunk & 3) * 16;
    const int vb = ((lane >> 4) & 1) * 32 + (lane & 3) * 8 + (4 * hi + ((lane & 15) >> 2)) * 64;
    for (int uu = blockIdx.x; uu < nunits; uu += gridDim.x) {
        int b, h, q0, nt; bool isctx;
        if (uu < 256) { const int u = (uu & 7) * 32 + (uu >> 3); b = u >> 6; h = (u >> 4) & 3; q0 = b * 4096 + (u & 15) * 256; nt = 68; isctx = false; }
        else { const int v = uu - 256; b = v >> 2; h = v & 3; q0 = T + b * 256; nt = 4; isctx = true; }
        bf16x8 qf[4];
        {
            const bf16_t* qp = PR + (size_t)(q0 + wid * 32 + r32) * PW + h * 64 + hi * 8;
#pragma unroll
            for (int ks = 0; ks < 4; ++ks) qf[ks] = *(const bf16x8*)(qp + ks * 16);
        }
        f32x16 O00, O01, O10, O11;
#pragma unroll
        for (int r = 0; r < 16; ++r) { O00[r] = 0.f; O01[r] = 0.f; O10[r] = 0.f; O11[r] = 0.f; }
        float m1 = -1e30f, m2 = -1e30f, l1 = 0.f, l2 = 0.f;
        const size_t gK = 256 + h * 64 + schunk * 8, gV = 512 + h * 64 + schunk * 8;
        uint4 rk, rv;
        {
            const int kr = (isctx ? T + b * 256 : b * 4096) + skey;
            rk = *(const uint4*)(PR + (size_t)kr * PW + gK); rv = *(const uint4*)(PR + (size_t)kr * PW + gV);
        }
        __syncthreads();
        *(uint4*)(lds + ldsK) = rk; *(uint4*)(lds + ldsV) = rv;
        __syncthreads();
        for (int t = 0; t < nt; ++t) {
            char* buf = lds + (t & 1) * 16384;
            if (t + 1 < nt) {
                const int tn = t + 1;
                const int kr = ((isctx || tn >= 64) ? T + b * 256 + (isctx ? tn : tn - 64) * 64 : b * 4096 + tn * 64) + skey;
                rk = *(const uint4*)(PR + (size_t)kr * PW + gK); rv = *(const uint4*)(PR + (size_t)kr * PW + gV);
            }
#pragma unroll
            for (int kb = 0; kb < 2; ++kb) {
                const lds_cptr kp = (lds_cptr)buf + hi * 1024 + (kb * 32 + r32) * 16;
                const bf16x8 kf0 = *(const __attribute__((address_space(3))) bf16x8*)(kp);
                const bf16x8 kf1 = *(const __attribute__((address_space(3))) bf16x8*)(kp + 2048);
                const bf16x8 kf2 = *(const __attribute__((address_space(3))) bf16x8*)(kp + 4096);
                const bf16x8 kf3 = *(const __attribute__((address_space(3))) bf16x8*)(kp + 6144);
                f32x16 s1, s2;
#pragma unroll
                for (int r = 0; r < 16; ++r) { s1[r] = 0.f; s2[r] = 0.f; }
                s1 = __builtin_amdgcn_mfma_f32_32x32x16_bf16(kf0, qf[0], s1, 0, 0, 0);
                s1 = __builtin_amdgcn_mfma_f32_32x32x16_bf16(kf1, qf[1], s1, 0, 0, 0);
                s2 = __builtin_amdgcn_mfma_f32_32x32x16_bf16(kf2, qf[2], s2, 0, 0, 0);
                s2 = __builtin_amdgcn_mfma_f32_32x32x16_bf16(kf3, qf[3], s2, 0, 0, 0);
                bf16x8 p1a, p1b, p2a, p2b;
                dsoftmax(s1, m1, l1, O00, O01, p1a, p1b);
                dsoftmax(s2, m2, l2, O10, O11, p2a, p2b);
                const lds_cptr vp = (lds_cptr)buf + 8192 + vb + kb * 2048;
#pragma unroll
                for (int dt = 0; dt < 2; ++dt) {
#pragma unroll
                    for (int ss = 0; ss < 2; ++ss) {
                        const s16x4 lo = vtr(vp + dt * 4096 + ss * 1024), hh = vtr(vp + dt * 4096 + ss * 1024 + 512);
                        const bf16x8 va = (bf16x8){lo[0], lo[1], lo[2], lo[3], hh[0], hh[1], hh[2], hh[3]};
                        if (dt == 0) { O00 = __builtin_amdgcn_mfma_f32_32x32x16_bf16(va, ss ? p1b : p1a, O00, 0, 0, 0); O10 = __builtin_amdgcn_mfma_f32_32x32x16_bf16(va, ss ? p2b : p2a, O10, 0, 0, 0); }
                        else         { O01 = __builtin_amdgcn_mfma_f32_32x32x16_bf16(va, ss ? p1b : p1a, O01, 0, 0, 0); O11 = __builtin_amdgcn_mfma_f32_32x32x16_bf16(va, ss ? p2b : p2a, O11, 0, 0, 0); }
                    }
                }
            }
            if (t + 1 < nt) { char* nb = lds + ((t + 1) & 1) * 16384; *(uint4*)(nb + ldsK) = rk; *(uint4*)(nb + ldsV) = rv; }
            __syncthreads();
        }
        l1 = xhalf_sum(l1); l2 = xhalf_sum(l2);
        const float i1 = 1.f / l1, i2 = lam / l2;
        float ss = 0.f;
#pragma unroll
        for (int r = 0; r < 16; ++r) { O00[r] = O00[r] * i1 - O10[r] * i2; O01[r] = O01[r] * i1 - O11[r] * i2; ss += O00[r] * O00[r] + O01[r] * O01[r]; }
        ss = xhalf_sum(ss);
        const float rstd = rsqrtf(ss * (1.f / 64.f) + EPS) * (1.f - lam_init);
        const float* gs = p.g_sub + l * 64;
        bf16_t* op = p.MIX + (size_t)(q0 + wid * 32 + r32) * D + h * 64;
#pragma unroll
        for (int g4 = 0; g4 < 4; ++g4) {
            const int d = 8 * g4 + 4 * hi;
            const float4 ga = *(const float4*)(gs + d), gb = *(const float4*)(gs + 32 + d);
            uint2 wa, wb;
            wa.x = cvtpk(O00[4 * g4] * rstd * ga.x, O00[4 * g4 + 1] * rstd * ga.y); wa.y = cvtpk(O00[4 * g4 + 2] * rstd * ga.z, O00[4 * g4 + 3] * rstd * ga.w);
            wb.x = cvtpk(O01[4 * g4] * rstd * gb.x, O01[4 * g4 + 1] * rstd * gb.y); wb.y = cvtpk(O01[4 * g4 + 2] * rstd * gb.z, O01[4 * g4 + 3] * rstd * gb.w);
            *(uint2*)(op + d) = wa; *(uint2*)(op + 32 + d) = wb;
        }
    }
}

__device__ __forceinline__ void ph_na(const P& p, int l, int nrows) {
    const int tid = ltid(), dh = tid & 1, h = (tid >> 1) & 3;
    for (int qb = blockIdx.x; qb < nrows / 64; qb += gridDim.x) {
        const int qrow = qb * 64 + (tid >> 3);
        const bool isctx = qrow >= T;
        const int b = isctx ? ((qrow - T) >> 8) : (qrow >> 12);
        float q[64], o[32];
        {
            const bf16_t* qp = p.PROJ + (size_t)qrow * PW + 1536 + h * 64;
#pragma unroll
            for (int d = 0; d < 64; d += 4) { ushort4 t = *(const ushort4*)(qp + d); q[d] = bf2f(t.x) * 0.125f; q[d + 1] = bf2f(t.y) * 0.125f; q[d + 2] = bf2f(t.z) * 0.125f; q[d + 3] = bf2f(t.w) * 0.125f; }
        }
#pragma unroll
        for (int d = 0; d < 32; ++d) o[d] = 0.f;
        float mrun = -1e30f, lrun = 0.f;
        int r = 0, c = 0, rs = 0, ws = 0;
        if (!isctx) { const int s = qrow & 4095; r = s >> 6; c = s & 63; rs = min(max(r - 4, 0), 56); ws = min(max(c - 8, 0), 48); }
        const int nk = isctx ? 256 : 384;
        const float* rp = p.rpb + ((size_t)l * 4 + h) * 15 * 31;
#pragma unroll 1
        for (int j = 0; j < nk; ++j) {
            int krow; float bias = 0.f;
            if (isctx) krow = T + b * 256 + j;
            else if (j < 128) { const int kr = j >> 4, kc = j & 15; krow = b * 4096 + (rs + kr) * 64 + ws + kc; bias = rp[(rs + kr - r + 7) * 31 + (ws + kc - c + 15)]; }
            else krow = T + b * 256 + (j - 128);
            const bf16_t* kp = p.PROJ + (size_t)krow * PW + 1792 + h * 64;
            float a = bias;
#pragma unroll
            for (int d = 0; d < 64; d += 4) { ushort4 kk = *(const ushort4*)(kp + d); a += q[d] * bf2f(kk.x) + q[d + 1] * bf2f(kk.y) + q[d + 2] * bf2f(kk.z) + q[d + 3] * bf2f(kk.w); }
            const float mnew = fmaxf(mrun, a), corr = __expf(mrun - mnew), pj = __expf(a - mnew);
            mrun = mnew; lrun = lrun * corr + pj;
            const bf16_t* vp = kp + 256 + dh * 32;
#pragma unroll
            for (int d = 0; d < 32; d += 4) { ushort4 vv = *(const ushort4*)(vp + d); o[d] = o[d] * corr + pj * bf2f(vv.x); o[d + 1] = o[d + 1] * corr + pj * bf2f(vv.y); o[d + 2] = o[d + 2] * corr + pj * bf2f(vv.z); o[d + 3] = o[d + 3] * corr + pj * bf2f(vv.w); }
        }
        const float il = 1.f / lrun;
        bf16_t* op = p.MIX + (size_t)qrow * D + 768 + h * 64 + dh * 32;
#pragma unroll
        for (int d = 0; d < 32; d += 4) { ushort4 w; w.x = f2bf(o[d] * il); w.y = f2bf(o[d + 1] * il); w.z = f2bf(o[d + 2] * il); w.w = f2bf(o[d + 3] * il); *(ushort4*)(op + d) = w; }
    }
}

__device__ __forceinline__ void ph_pool(const P& p, int l, int nrows, char* lds) {
    const int tid = ltid(), half = tid >> 8, ch = tid & 255, g = ch >> 6, w = 2 << g;
    float* dsh = (float*)lds + half * 256;
    const float* wp = p.w_pool + ((size_t)l * 4 + g) * 64 * 64;
    const float sp = p.s_pool[l * 256 + ch];
    for (int it = blockIdx.x; it < nrows / 2; it += gridDim.x) {
        const int row = it * 2 + half;
        const int L = row < T ? 4096 : 256;
        const int t = row < T ? (row & 4095) : ((row - T) & 255);
        const int base = row - t;
        const int lo = max(t - w / 2, 0), hi = min(t + w / 2 - 1, L - 1);
        float sum = 0.f;
        for (int rr = lo; rr <= hi; ++rr) sum += bf2f(p.PROJ[(size_t)(base + rr) * PW + 768 + ch]);
        const float y = bf2f(p.PROJ[(size_t)row * PW + 768 + ch]);
        __syncthreads();
        dsh[ch] = sum / (float)(hi - lo + 1) - y;
        __syncthreads();
        float a = 0.f;
#pragma unroll 8
        for (int i = 0; i < 64; ++i) a += dsh[g * 64 + i] * wp[i * 64 + (ch & 63)];
        p.MIX[(size_t)row * D + 256 + ch] = f2bf(a * sp);
    }
}

__device__ __forceinline__ float gelu_tanh(float x) { return 0.5f * x * (1.f + tanhf(0.7978845608028654f * (x + 0.044715f * x * x * x))); }
__device__ __forceinline__ void ph_sgu(const P& p, int l, int nrows, char* lds) {
    float* vn = (float*)lds;
    float* rstd = vn + 128 * 64;
    const int tid = ltid();
    for (int it = blockIdx.x; it < (nrows / 128) * 4; it += gridDim.x) {
        const int chunk = it >> 2, g = it & 3, row0 = chunk * 128;
        __syncthreads();
        {
            const int t = tid >> 2, qtr = tid & 3;
            const bf16_t* zp = p.PROJ + (size_t)(row0 + t) * PW + 1024 + 256 + qtr * 64;
            float ss = 0.f;
            for (int i = 0; i < 64; ++i) { const float v = gelu_tanh(bf2f(zp[i])); ss += v * v; }
            ss += __shfl_xor(ss, 1); ss += __shfl_xor(ss, 2);
            if (qtr == 0) rstd[t] = rsqrtf(ss * (1.f / 256.f) + EPS);
        }
        __syncthreads();
        for (int i = tid; i < 128 * 64; i += NT) {
            const int s = i >> 6, cc = i & 63;
            const float v = gelu_tanh(bf2f(p.PROJ[(size_t)(row0 + s) * PW + 1024 + 256 + g * 64 + cc]));
            vn[i] = v * rstd[s] * p.g_sgu[l * 256 + g * 64 + cc];
        }
        __syncthreads();
        const int cc = tid & 63;
        const float* ws = p.w_sgu + ((size_t)l * 4 + g) * 128 * 128;
        for (int t = tid >> 6; t < 128; t += 8) {
            float a = 0.f;
            const float* wr = ws + t * 128;
#pragma unroll 8
            for (int s = 0; s < 128; ++s) a += wr[s] * vn[s * 64 + cc];
            a += p.b_sgu[(l * 4 + g) * 128 + t];
            const float u = gelu_tanh(bf2f(p.PROJ[(size_t)(row0 + t) * PW + 1024 + g * 64 + cc]));
            p.MIX[(size_t)(row0 + t) * D + 512 + g * 64 + cc] = f2bf(u * a);
        }
    }
}

__device__ __forceinline__ void ph_router(const P& p, int l, int nrows) {
    const int wave = ltid() >> 6, lane = ltid() & 63;
    for (int row = blockIdx.x * 8 + wave; row < nrows; row += gridDim.x * 8) {
        const float* xr = p.X + (size_t)row * D;
        float hf[16]; float ss = 0;
#pragma unroll
        for (int i = 0; i < 4; ++i) { float4 v = *(const float4*)(xr + lane * 4 + 256 * i); hf[4 * i] = v.x; hf[4 * i + 1] = v.y; hf[4 * i + 2] = v.z; hf[4 * i + 3] = v.w; ss += v.x * v.x + v.y * v.y + v.z * v.z + v.w * v.w; }
        ss = wave_sum(ss);
        const float rstd = rsqrtf(ss * (1.f / D) + EPS);
        const float* m = p.mod + ((size_t)l * 5 + mod_row(row)) * 6144;
        const float* g = p.g_ffn + l * D;
#pragma unroll
        for (int i = 0; i < 4; ++i) {
            const int k = lane * 4 + 256 * i;
            const float4 gg = *(const float4*)(g + k), sh = *(const float4*)(m + 3 * 1024 + k), sc = *(const float4*)(m + 4 * 1024 + k);
            hf[4 * i] = hf[4 * i] * rstd * gg.x * (1.f + sc.x) + sh.x; hf[4 * i + 1] = hf[4 * i + 1] * rstd * gg.y * (1.f + sc.y) + sh.y;
            hf[4 * i + 2] = hf[4 * i + 2] * rstd * gg.z * (1.f + sc.z) + sh.z; hf[4 * i + 3] = hf[4 * i + 3] * rstd * gg.w * (1.f + sc.w) + sh.w;
            ushort4 o; o.x = f2bf(hf[4 * i]); o.y = f2bf(hf[4 * i + 1]); o.z = f2bf(hf[4 * i + 2]); o.w = f2bf(hf[4 * i + 3]);
            *(ushort4*)(p.H + (size_t)row * D + k) = o;
        }
        float lg[32];
#pragma unroll
        for (int e = 0; e < 32; ++e) lg[e] = 0.f;
        const float* wr = p.w_router + (size_t)l * D * NE;
#pragma unroll
        for (int i = 0; i < 4; ++i)
#pragma unroll
            for (int j = 0; j < 4; ++j) {
                const int k = lane * 4 + 256 * i + j;
                const float hv = hf[4 * i + j];
#pragma unroll
                for (int e = 0; e < 32; e += 4) { const float4 w = *(const float4*)(wr + (size_t)k * NE + e); lg[e] += hv * w.x; lg[e + 1] += hv * w.y; lg[e + 2] += hv * w.z; lg[e + 3] += hv * w.w; }
            }
#pragma unroll
        for (int e = 0; e < 32; ++e) lg[e] = wave_sum(lg[e]) + p.b_router[l * NE + e];
        unsigned taken = 0u; float tv[4]; int ti[4];
#pragma unroll
        for (int k = 0; k < 4; ++k) {
            float best = -3.0e38f; int bi = 0;
#pragma unroll
            for (int e = 0; e < 32; ++e) { const bool ok = !((taken >> e) & 1u) && (lg[e] > best); best = ok ? lg[e] : best; bi = ok ? e : bi; }
            taken |= 1u << bi; tv[k] = best; ti[k] = bi;
        }
        const float e1 = __expf(tv[1] - tv[0]), e2 = __expf(tv[2] - tv[0]), e3 = __expf(tv[3] - tv[0]);
        const float inv = 1.f / (1.f + e1 + e2 + e3);
        if (lane == 0) {
            *(int4*)(p.topi + (size_t)row * 4) = make_int4(ti[0], ti[1], ti[2], ti[3]);
            *(float4*)(p.topg + (size_t)row * 4) = make_float4(inv, e1 * inv, e2 * inv, e3 * inv);
            int* cnt = p.cnt + l * 64;
            atomicAdd(&cnt[ti[0]], 1); atomicAdd(&cnt[ti[1]], 1); atomicAdd(&cnt[ti[2]], 1); atomicAdd(&cnt[ti[3]], 1);
        }
    }
}
__device__ __forceinline__ void ph_assign(const P& p, int l, int nrows, char* lds) {
    int* lcnt = (int*)lds; int* lbase = lcnt + 32; int* off = lbase + 32;
    const int tid = ltid();
    int* cnt = p.cnt + l * 64; int* cursor = cnt + 32;
    for (int it = blockIdx.x; it < nrows / NT; it += gridDim.x) {
        const int row = it * NT + tid;
        __syncthreads();
        if (tid < 32) lcnt[tid] = 0;
        if (tid == 0) { int a = 0; for (int e = 0; e < 32; ++e) { off[e] = a; a += cnt[e]; } }
        __syncthreads();
        const int4 ti = *(const int4*)(p.topi + (size_t)row * 4);
        const int r0 = atomicAdd(&lcnt[ti.x], 1), r1 = atomicAdd(&lcnt[ti.y], 1), r2 = atomicAdd(&lcnt[ti.z], 1), r3 = atomicAdd(&lcnt[ti.w], 1);
        __syncthreads();
        if (tid < 32) lbase[tid] = off[tid] + (lcnt[tid] ? atomicAdd(&cursor[tid], lcnt[tid]) : 0);
        __syncthreads();
        const int s0 = lbase[ti.x] + r0, s1 = lbase[ti.y] + r1, s2 = lbase[ti.z] + r2, s3 = lbase[ti.w] + r3;
        *(int4*)(p.tok_slot + (size_t)row * 4) = make_int4(s0, s1, s2, s3);
        p.slot_tok[s0] = row; p.slot_tok[s1] = row; p.slot_tok[s2] = row; p.slot_tok[s3] = row;
    }
}

struct MoeTile { int e, row0, mvalid; };
__device__ __forceinline__ bool moe_find_tile(const int* cnt, int mt, MoeTile& t, int* sh) {
    __syncthreads();
    if (ltid() == 0) {
        int acc_t = 0, acc_r = 0, fe = -1, fr0 = 0, fmv = 0;
        for (int e = 0; e < 32; ++e) {
            const int c = cnt[e], nt = (c + 127) >> 7;
            if (fe < 0 && mt < acc_t + nt) { fe = e; const int lt = mt - acc_t; fr0 = acc_r + lt * 128; fmv = min(128, c - lt * 128); }
            acc_t += nt; acc_r += c;
        }
        sh[0] = fe; sh[1] = fr0; sh[2] = fmv;
    }
    __syncthreads();
    t.e = sh[0]; t.row0 = sh[1]; t.mvalid = sh[2];
    return t.e >= 0;
}
struct ARowGather { const bf16_t* A; const int* idx; int mvalid; __device__ __forceinline__ const bf16_t* operator()(int r) const { return A + (size_t)idx[r < mvalid ? r : 0] * D; } };
struct ARowClamp { const bf16_t* A; int mvalid; __device__ __forceinline__ const bf16_t* operator()(int r) const { return A + (size_t)(r < mvalid ? r : 0) * D; } };

__device__ __forceinline__ void ph_moe1(const P& p, int l, int nrows, char* lds) {
    int* sh = (int*)(lds + GEMM_LDS_ELEMS * 2);
    const int ntn = 2048 / 256, max_mt = nrows * 4 / 128 + NE;
    for (int it = blockIdx.x; it < ntn * max_mt; it += gridDim.x) {
        MoeTile t;
        if (!moe_find_tile(p.cnt + l * 64, it / ntn, t, sh)) break;
        const int n0 = (it % ntn) * 256;
        ARowGather ar{p.H, p.slot_tok + t.row0, t.mvalid};
        const float* bg = p.b_gu + ((size_t)l * NE + t.e) * 2048;
        bf16_t* ACT = p.ACT;
        auto epi = [&](int r, int c, f32x4 v) {
            const int j = (n0 + c) >> 1;
            float o2[2];
#pragma unroll
            for (int q = 0; q < 2; ++q) {
                const float gt = fminf(v[2 * q] + bg[j + q], 7.0f);
                const float up = fminf(fmaxf(v[2 * q + 1] + bg[1024 + j + q], -7.0f), 7.0f);
                o2[q] = (up + 1.0f) * gt / (1.0f + __expf(-1.702f * gt));
            }
            ushort2 w; w.x = f2bf(o2[0]); w.y = f2bf(o2[1]);
            *(ushort2*)(ACT + (size_t)(t.row0 + r) * FF + j) = w;
        };
        gemm_tile(ar, t.mvalid, p.WguT + (((size_t)l * NE + t.e) * 2048 + n0) * D, D, epi, (bf16_t*)lds);
    }
}
__device__ __forceinline__ void ph_moe2(const P& p, int l, int nrows, char* lds) {
    int* sh = (int*)(lds + GEMM_LDS_ELEMS * 2);
    const int ntn = D / 256, max_mt = nrows * 4 / 128 + NE;
    for (int it = blockIdx.x; it < ntn * max_mt; it += gridDim.x) {
        MoeTile t;
        if (!moe_find_tile(p.cnt + l * 64, it / ntn, t, sh)) break;
        const int n0 = (it % ntn) * 256;
        ARowClamp ar{p.ACT + (size_t)t.row0 * FF, t.mvalid};
        const float* bd = p.b_down + ((size_t)l * NE + t.e) * D;
        float* YB = p.YB;
        auto epi = [&](int r, int c, f32x4 v) {
            const f32x4 bb = *(const f32x4*)(bd + n0 + c);
            *(f32x4*)(YB + (size_t)(t.row0 + r) * D + n0 + c) = v + bb;
        };
        gemm_tile(ar, t.mvalid, p.WdnT + (((size_t)l * NE + t.e) * D + n0) * FF, FF, epi, (bf16_t*)lds);
    }
}
__device__ __forceinline__ void ph_combine(const P& p, int l, int nrows) {
    const int wave = ltid() >> 6, lane = ltid() & 63;
    for (int row = blockIdx.x * 8 + wave; row < nrows; row += gridDim.x * 8) {
        const int4 sl = *(const int4*)(p.tok_slot + (size_t)row * 4);
        const float4 g = *(const float4*)(p.topg + (size_t)row * 4);
        const float* m = p.mod + ((size_t)l * 5 + mod_row(row)) * 6144 + 5 * 1024;
#pragma unroll
        for (int i = 0; i < 4; ++i) {
            const int k = lane * 4 + 256 * i;
            const float4 y0 = *(const float4*)(p.YB + (size_t)sl.x * D + k), y1 = *(const float4*)(p.YB + (size_t)sl.y * D + k);
            const float4 y2 = *(const float4*)(p.YB + (size_t)sl.z * D + k), y3 = *(const float4*)(p.YB + (size_t)sl.w * D + k);
            const float4 gt = *(const float4*)(m + k);
            float4* xp = (float4*)(p.X + (size_t)row * D + k);
            float4 xv = *xp;
            xv.x += gt.x * (g.x * y0.x + g.y * y1.x + g.z * y2.x + g.w * y3.x);
            xv.y += gt.y * (g.x * y0.y + g.y * y1.y + g.z * y2.y + g.w * y3.y);
            xv.z += gt.z * (g.x * y0.z + g.y * y1.z + g.z * y2.z + g.w * y3.z);
            xv.w += gt.w * (g.x * y0.w + g.y * y1.w + g.z * y2.w + g.w * y3.w);
            *xp = xv;
        }
    }
}
__device__ __forceinline__ void ph_final(const P& p) {
    const int wave = ltid() >> 6, lane = ltid() & 63;
    for (int row = blockIdx.x * 8 + wave; row < T; row += gridDim.x * 8) {
        const float* xr = p.X + (size_t)row * D;
        float4 v[4]; float ss = 0;
#pragma unroll
        for (int i = 0; i < 4; ++i) { v[i] = *(const float4*)(xr + lane * 4 + 256 * i); ss += v[i].x * v[i].x + v[i].y * v[i].y + v[i].z * v[i].z + v[i].w * v[i].w; }
        ss = wave_sum(ss);
        const float rstd = rsqrtf(ss * (1.f / D) + EPS);
#pragma unroll
        for (int i = 0; i < 4; ++i) {
            const int k = lane * 4 + 256 * i;
            const float4 gg = *(const float4*)(p.g_final + k);
            *(float4*)(p.out + (size_t)row * D + k) = make_float4(v[i].x * rstd * gg.x, v[i].y * rstd * gg.y, v[i].z * rstd * gg.z, v[i].w * rstd * gg.w);
        }
    }
}

extern __shared__ __attribute__((aligned(16))) char smem[];
__global__ void __launch_bounds__(NT, 2) mega(P p) {
    char* lds = smem + 16;
    if (threadIdx.x == 0) *(uint4*)smem = make_uint4(0u, 0u, 0u, 0u);
    __syncthreads();
    XcdBarrier bar = xcd_barrier_post(p.bar, (volatile LAS unsigned*)smem);
    ph_prologue(p, lds);
    xcd_barrier(bar);
#pragma unroll
    for (int l = 0; l < 2; ++l) {
        const int nrows = l == 0 ? R : T;
        ph_norm1(p, l);
        xcd_barrier(bar);
        ph_gemm_proj(p, l, lds);
        xcd_barrier(bar);
        ph_rope(p, nrows);
        xcd_barrier(bar);
        ph_dattn(p, l, nrows, lds);
        ph_na(p, l, nrows);
        ph_pool(p, l, nrows, lds);
        ph_sgu(p, l, nrows, lds);
        xcd_barrier(bar);
        ph_gemm_out(p, l, nrows, lds);
        xcd_barrier(bar);
        ph_router(p, l, nrows);
        xcd_barrier(bar);
        ph_assign(p, l, nrows, lds);
        xcd_barrier(bar);
        ph_moe1(p, l, nrows, lds);
        xcd_barrier(bar);
        ph_moe2(p, l, nrows, lds);
        xcd_barrier(bar);
        ph_combine(p, l, nrows);
        xcd_barrier(bar);
    }
    ph_final(p);
}

static inline size_t align_up(size_t v, size_t a) { return (v + a - 1) / a * a; }

extern "C" void kernel_launch(void* const* d_in, const int* in_sizes, int n_in, void* d_out, int out_size, void* d_ws, size_t ws_size, hipStream_t stream) {
    P p{};
    const float** ins = (const float**)&p.x;
    for (int i = 0; i < 28; ++i) ins[i] = (const float*)d_in[i];
    p.out = (float*)d_out;
    char* w = (char*)d_ws; size_t off = 0;
    auto carve = [&](size_t bytes) { void* r = w + off; off = align_up(off + bytes, 256); return r; };
    const size_t ctl_bytes = XCD_BAR_WORDS * 4 + 2 * 64 * 4;
    p.bar = (unsigned*)carve(ctl_bytes);
    p.cnt = (int*)(p.bar + XCD_BAR_WORDS);
    p.mod = (float*)carve((size_t)2 * 5 * 6144 * 4);
    p.rope = (float*)carve(64 * 8 * 2 * 4);
    p.X = (float*)carve((size_t)R * D * 4);
    p.H = (bf16_t*)carve((size_t)R * D * 2);
    p.PROJ = (bf16_t*)carve((size_t)R * PW * 2);
    p.MIX = (bf16_t*)carve((size_t)R * D * 2);
    p.WinT = (bf16_t*)carve((size_t)2 * PW * D * 2);
    p.WoutT = (bf16_t*)carve((size_t)2 * D * D * 2);
    p.WguT = (bf16_t*)carve((size_t)2 * NE * 2048 * D * 2);
    p.WdnT = (bf16_t*)carve((size_t)2 * NE * D * FF * 2);
    p.topi = (int*)carve((size_t)R * 4 * 4);
    p.topg = (float*)carve((size_t)R * 4 * 4);
    p.tok_slot = (int*)carve((size_t)R * 4 * 4);
    p.slot_tok = (int*)carve((size_t)MAXSLOT * 4);
    p.ACT = (bf16_t*)carve((size_t)MAXSLOT * FF * 2);
    p.YB = (float*)carve((size_t)MAXSLOT * D * 4);

    static int grid = 0;
    if (!grid) {
        int dev = 0, cus = 0, per_cu = 0;
        (void)hipGetDevice(&dev);
        (void)hipDeviceGetAttribute(&cus, hipDeviceAttributeMultiprocessorCount, dev);
        (void)hipFuncSetAttribute((const void*)mega, hipFuncAttributeMaxDynamicSharedMemorySize, LDS_BYTES);
        (void)hipOccupancyMaxActiveBlocksPerMultiprocessor(&per_cu, mega, NT, LDS_BYTES);
        grid = cus * (per_cu < 1 ? per_cu : 1);
        if (grid <= 0) { fprintf(stderr, "mega: occupancy query returned %d blocks per CU\n", per_cu); grid = 0; return; }
    }
    (void)hipMemsetAsync(p.bar, 0, ctl_bytes, stream);
    mega<<<grid, NT, LDS_BYTES, stream>>>(p);
}
```

```cpp
#include <hip/hip_runtime.h>
#include <stdint.h>
#include <cstdio>

typedef unsigned short bf16_t;
typedef short bf16x8 __attribute__((ext_vector_type(8)));
typedef float f32x4 __attribute__((ext_vector_type(4)));

constexpr int D = 1024, NB = 4, S = 4096, T = NB * S, CL = 256, TC = NB * CL, R = T + TC;
constexpr int PW = 2304, NE = 32, TOPK = 4, FF = 1024;
constexpr int MAXSLOT = R * TOPK;
constexpr int NSLOT = MAXSLOT + NE * 256;
constexpr float EPS = 1e-6f;
constexpr int NT = 512;
constexpr int LDS_BYTES = 128 * 1024 + 1024;

__device__ __forceinline__ bf16_t f2bf(float f) { unsigned u = __float_as_uint(f); return (bf16_t)((u + 0x7fffu + ((u >> 16) & 1u)) >> 16); }
__device__ __forceinline__ float bf2f(bf16_t h) { return __uint_as_float(((unsigned)h) << 16); }
__device__ __forceinline__ float wave_sum(float v) {
#pragma unroll
    for (int o = 32; o >= 1; o >>= 1) v += __shfl_xor(v, o);
    return v;
}
__device__ __forceinline__ int mod_row(int row) { return row < T ? (row >> 12) : 4; }

#define XB_TMO      128
#define XB_XCNT(j)  (256  + 64 * (j))
#define XB_XSUB(j)  (1280 + 64 * (j))
#define XB_XGEN(j)  (2304 + 64 * (j))
#define XB_TOP      3328
#define XB_TOPGEN   3392
#define XCD_BAR_WORDS 3456
#define XB_SPIN_CAP (1u << 18)
#define LAS __attribute__((address_space(3)))

__device__ __forceinline__ unsigned xb_ld(unsigned* p)              { return __hip_atomic_load(p, __ATOMIC_RELAXED, __HIP_MEMORY_SCOPE_AGENT); }
__device__ __forceinline__ unsigned xb_add(unsigned* p, unsigned v) { return __hip_atomic_fetch_add(p, v, __ATOMIC_RELAXED, __HIP_MEMORY_SCOPE_AGENT); }
__device__ __forceinline__ unsigned xb_xcc_id() { return (unsigned)__builtin_amdgcn_s_getreg((3 << 11) | 20) & 0xFu; }
#define XB_SPIN(cond, bar) do { unsigned _sp = 0; while (cond) { __builtin_amdgcn_s_sleep(1); \
    if ((++_sp & 255u) == 0u) { if (xb_ld(&(bar)[XB_TMO])) break; if (_sp > XB_SPIN_CAP) { atomicAdd(&(bar)[XB_TMO], 1u); break; } } } } while (0)

struct XcdBarrier {
    unsigned* bar; unsigned x;
    volatile LAS unsigned* st;
};
__device__ __forceinline__ XcdBarrier xcd_barrier_post(unsigned* bar, volatile LAS unsigned* st) {
    XcdBarrier b; b.bar = bar; b.x = xb_xcc_id(); b.st = st;
    if (threadIdx.x == 0) (void)xb_add(&bar[XB_XCNT(b.x)], 1u);
    return b;
}
__device__ __forceinline__ void xcd_barrier_complete(unsigned* bar, unsigned x, unsigned& nloc, unsigned& nx) {
    const unsigned G = gridDim.x * gridDim.y * gridDim.z;
    unsigned sum, cnt, mine, sp = 0u;
    for (;;) {
        sum = 0u; cnt = 0u; mine = 0u;
#pragma unroll
        for (unsigned j = 0; j < 16; ++j) { const unsigned c = xb_ld(&bar[XB_XCNT(j)]); sum += c; cnt += (c > 0u) ? 1u : 0u; mine = (j == x) ? c : mine; }
        if (sum == G) break;
        __builtin_amdgcn_s_sleep(1);
        if ((++sp & 255u) == 0u) { if (xb_ld(&bar[XB_TMO])) break; if (sp > XB_SPIN_CAP) { atomicAdd(&bar[XB_TMO], 1u); break; } }
    }
    nloc = mine > 0u ? mine : 1u; nx = cnt > 0u ? cnt : 1u;
}
__device__ __forceinline__ void xcd_barrier(const XcdBarrier& b) {
    asm volatile("s_waitcnt vmcnt(0)" ::: "memory");
    __syncthreads();
    if (threadIdx.x == 0) {
        unsigned* bar = b.bar;
        __builtin_amdgcn_s_waitcnt(0);
        unsigned nloc = b.st[0], nx = b.st[1];
        if (nloc == 0u) { xcd_barrier_complete(bar, b.x, nloc, nx); b.st[0] = nloc; b.st[1] = nx; }
        const unsigned old = xb_add(&bar[XB_XSUB(b.x)], 1u);
        const unsigned gen = old / nloc;
        if (old + 1u == (gen + 1u) * nloc) {
            __builtin_amdgcn_fence(__ATOMIC_RELEASE, "agent");
            asm volatile("s_waitcnt vmcnt(0)" ::: "memory");
            const unsigned og = xb_add(&bar[XB_TOP], 1u);
            const unsigned tg = og / nx;
            if (og + 1u == (tg + 1u) * nx) xb_add(&bar[XB_TOPGEN], 1u);
            else XB_SPIN(xb_ld(&bar[XB_TOPGEN]) == tg, bar);
            __builtin_amdgcn_fence(__ATOMIC_ACQUIRE, "agent");
            xb_add(&bar[XB_XGEN(b.x)], 1u);
            asm volatile("s_waitcnt vmcnt(0)" ::: "memory");
        } else {
            XB_SPIN(xb_ld(&bar[XB_XGEN(b.x)]) == gen, bar);
            __builtin_amdgcn_fence(__ATOMIC_ACQUIRE, "agent");
            asm volatile("s_waitcnt vmcnt(0)" ::: "memory");
        }
    }
    __syncthreads();
}

struct P {
    const float *x, *c, *ctx, *c_ctx, *w_mod, *b_mod, *g_mix, *g_ffn, *w_in, *w_out, *lam_q1, *lam_k1, *lam_q2, *lam_k2, *g_sub,
        *w_pool, *s_pool, *g_sgu, *w_sgu, *b_sgu, *rpb, *w_router, *b_router, *w_gu, *b_gu, *w_down, *b_down, *g_final;
    float* out;
    unsigned* bar;
    int* cnt;
    float* mod;
    float* rope;
    float* X;
    bf16_t* H;
    bf16_t* PROJ;
    bf16_t* MIX;
    bf16_t* WinT;
    bf16_t* WoutT;
    bf16_t* WguT;
    bf16_t* WdnT;
    int* topi;
    float* topg;
    int* tok_slot;
    int* moe_meta;
    bf16_t* HS;
    bf16_t* ACT;
    bf16_t* YB;
};

__device__ __forceinline__ int ltid() { int t = threadIdx.x; asm volatile("" : "+v"(t)); return t; }
typedef float f32x16 __attribute__((ext_vector_type(16)));
typedef short s16x4 __attribute__((ext_vector_type(4)));
typedef short v4i16_t __attribute__((ext_vector_type(4)));
typedef float f32x2_t __attribute__((ext_vector_type(2)));
typedef __bf16 bf16x2_t __attribute__((ext_vector_type(2)));
typedef __attribute__((address_space(3))) const char* lds_cptr;
typedef unsigned u32x4 __attribute__((ext_vector_type(4)));
__device__ __forceinline__ unsigned cvtpk(float lo, float hi) { f32x2_t v = {lo, hi}; bf16x2_t b = __builtin_convertvector(v, bf16x2_t); return __builtin_bit_cast(unsigned, b); }
__device__ __forceinline__ s16x4 vtr(lds_cptr q) { return __builtin_bit_cast(s16x4, __builtin_amdgcn_ds_read_tr16_b64_v4i16((__attribute__((address_space(3))) v4i16_t*)q)); }
__device__ __forceinline__ float xhalf_max(float v) { auto rr = __builtin_amdgcn_permlane32_swap(__float_as_uint(v), __float_as_uint(v), false, false); return fmaxf(__uint_as_float(rr[0]), __uint_as_float(rr[1])); }
__device__ __forceinline__ float xhalf_sum(float v) { auto rr = __builtin_amdgcn_permlane32_swap(__float_as_uint(v), __float_as_uint(v), false, false); return __uint_as_float(rr[0]) + __uint_as_float(rr[1]); }
namespace pg8 {
#define PG8_LAS __attribute__((address_space(3)))
constexpr int BM = 256, BK = 64, HALF = 128, HTB = HALF * BK * 2  , STAGE_BYTES = 8 * HTB, NXCD = 8, WGM = 8;
__host__ __device__ __forceinline__ int lds_byte(int r, int c) { const int st = (r >> 4) * 2 + (c >> 5), rr = r & 15, cc = c & 31, ob = rr * 64 + cc * 2; return st * 1024 + (ob ^ (((ob >> 9) & 1) << 5)); }
__host__ __device__ __forceinline__ void stage_rc(int b, int& R, int& C) { const int st = b / 1024, sb = b % 1024, swz = sb ^ (((sb >> 9) & 1) << 5); R = (st >> 1) * 16 + swz / 64; C = (st & 1) * 32 + (swz % 64) / 2; }
__host__ __device__ __forceinline__ int perm32(int rho) { const int n = rho >> 4, i = rho & 15; return 8 * (i >> 2) + 4 * n + (i & 3); }
struct Unit { int pm, pn, e; };
struct Gemm { const bf16_t* A; const bf16_t* Bt; int M, N, K; };
struct StaticOrder {
    int nM, nN, nwg, G, c;
    __host__ __device__ void init(int M, int N, int G_, int c_) { nM = M / BM; nN = N / BM; nwg = nM * nN; G = G_; c = c_; }
    __host__ __device__ bool next(int i, Unit& u) const {
        const long L = (long)i * G + c; if (L >= nwg) return false;
        int wgid = (int)L; { const int q = nwg / NXCD, r = nwg % NXCD, xcd = wgid % NXCD, off = wgid / NXCD; wgid = (xcd < r ? xcd * (q + 1) : r * (q + 1) + (xcd - r) * q) + off; }
        const int nig = WGM * nN, gid = wgid / nig, fm = gid * WGM, gsz = (nM - fm) < WGM ? (nM - fm) : WGM;
        u.pm = fm + ((wgid % nig) % gsz); u.pn = (wgid % nig) / gsz; u.e = 0; return true;
    }
    __device__ __forceinline__ const bf16_t* bt(const Gemm& g, const Unit&) const { return g.Bt; }
    __device__ __forceinline__ void a_ready(const Unit&) const {}
    __device__ __forceinline__ void done(const Unit&) const {}
};
template <class Epi, class Sched, bool ALIGN_EPI = false, bool SP2 = false>
__device__ __forceinline__ void gemm_phase(PG8_LAS unsigned char* lds, const Gemm g, const Sched& S, const Epi& E) {
    const int tid = ltid(), wid = __builtin_amdgcn_readfirstlane(tid >> 6), lane = tid & 63, wr = wid >> 2, wc = wid & 3, fr = lane & 15, fq = lane >> 4;
    const int K = g.K, nt = K / BK;
    unsigned voffA[2], voffB[2];
#pragma unroll
    for (int i = 0; i < 2; ++i) { int R, C; stage_rc(tid * 16 + i * 8192, R, C); const int Rb = Epi::PERM ? ((R & ~31) + perm32(R & 31)) : R;
        voffA[i] = (unsigned)(R * K + C) * 2u; voffB[i] = (unsigned)(Rb * K + C) * 2u; }
    const size_t kstep = (size_t)(BK * 2);
    const size_t hstep = (size_t)HALF * K * 2;
    const size_t tstep = 2 * hstep;
    const unsigned ldsw = (unsigned)wid * 1024u;
    const int aoff = lds_byte(wr * 64 + fr, fq * 8), boff = lds_byte(wc * 32 + fr, fq * 8);
#define PG8_SA(b, h) (((b) * 2 + (h)) * HTB)
#define PG8_SB(b, h) ((4 + (b) * 2 + (h)) * HTB)
#define PG8_STAGE(bufoff, gbase, voff) do { _Pragma("unroll") for (int _i = 0; _i < 2; ++_i) \
        __builtin_amdgcn_global_load_lds((const unsigned*)((const char*)(gbase) + (voff)[_i]), (PG8_LAS unsigned*)(lds + (bufoff) + ldsw + _i * 8192), 16, 0, 0); } while (0)
#define PG8_LDA(dst, b, h) do { _Pragma("unroll") for (int m = 0; m < 4; ++m) _Pragma("unroll") for (int k = 0; k < 2; ++k) dst[m][k] = *(const PG8_LAS bf16x8*)(lds + PG8_SA(b, h) + aoff + m * 2048 + k * 1024); } while (0)
#define PG8_LDB(dst, b, h) do { _Pragma("unroll") for (int n = 0; n < 2; ++n) _Pragma("unroll") for (int k = 0; k < 2; ++k) dst[n][k] = *(const PG8_LAS bf16x8*)(lds + PG8_SB(b, h) + boff + n * 2048 + k * 1024); } while (0)
#define PG8_MMA(ai, bj, At, Bt) do { __builtin_amdgcn_s_setprio(1); _Pragma("unroll") for (int m = 0; m < 4; ++m) _Pragma("unroll") for (int n = 0; n < 2; ++n) _Pragma("unroll") for (int k = 0; k < 2; ++k) \
        acc[ai][bj][m][n] = __builtin_amdgcn_mfma_f32_16x16x32_bf16(Bt[n][k], At[m][k], acc[ai][bj][m][n], 0, 0, 0); __builtin_amdgcn_s_setprio(0); } while (0)
#define PG8_WAIT_V(n) asm volatile("s_waitcnt vmcnt(" #n ")" ::: "memory")
#define PG8_WAIT_L(n) asm volatile("s_waitcnt lgkmcnt(" #n ")" ::: "memory")
#define PG8_BAR __builtin_amdgcn_s_barrier()
#define PG8_SCHED __builtin_amdgcn_sched_barrier(0)
    Unit cur, nxt; int ui = 0;
    if (!S.next(0, cur)) return;
    f32x4 acc[2][2][4][2];
#pragma unroll
    for (int a = 0; a < 2; ++a)
#pragma unroll
        for (int b = 0; b < 2; ++b)
#pragma unroll
            for (int m = 0; m < 4; ++m)
#pragma unroll
                for (int n = 0; n < 2; ++n) acc[a][b][m][n] = (f32x4){0.f, 0.f, 0.f, 0.f};
    bf16x8 At[4][2], B0[2][2], B1[2][2];
    const char* cA = (const char*)g.A + (size_t)cur.pm * tstep; const char* cB = (const char*)S.bt(g, cur) + (size_t)cur.pn * tstep;
    S.a_ready(cur);
    if constexpr (SP2) {
        PG8_STAGE(PG8_SB(0, 0), cB, voffB); PG8_STAGE(PG8_SB(0, 1), cB + hstep, voffB); PG8_STAGE(PG8_SA(0, 0), cA, voffA); PG8_STAGE(PG8_SA(0, 1), cA + hstep, voffA);
        if (wr == 1) PG8_BAR;
        PG8_WAIT_V(2); PG8_BAR;
        PG8_STAGE(PG8_SB(1, 0), cB + kstep, voffB); PG8_STAGE(PG8_SA(1, 0), cA + kstep, voffA); PG8_STAGE(PG8_SB(1, 1), cB + hstep + kstep, voffB);
        PG8_WAIT_V(6); PG8_BAR;
    } else {
        PG8_STAGE(PG8_SB(0, 0), cB, voffB); PG8_STAGE(PG8_SA(0, 0), cA, voffA); PG8_STAGE(PG8_SB(0, 1), cB + hstep, voffB); PG8_STAGE(PG8_SA(0, 1), cA + hstep, voffA);
        if (wr == 1) PG8_BAR;
        PG8_WAIT_V(4); PG8_BAR;
        PG8_STAGE(PG8_SB(1, 0), cB + kstep, voffB); PG8_STAGE(PG8_SA(1, 0), cA + kstep, voffA); PG8_STAGE(PG8_SB(1, 1), cB + hstep + kstep, voffB);
        PG8_WAIT_V(6); PG8_BAR;
    }
    for (;;) {
        const bool has_next = S.next(ui + 1, nxt);
        const char* nA = has_next ? (const char*)g.A + (size_t)nxt.pm * tstep : cA; const char* nB = has_next ? (const char*)S.bt(g, nxt) + (size_t)nxt.pn * tstep : cB;
        for (int t = 0; t < nt; t += 2) {
            const bool last = (t == nt - 2);
            const char* a1 = cA + (size_t)(t + 1) * kstep;
            const char* a2 = last ? nA : cA + (size_t)(t + 2) * kstep; const char* b2 = last ? nB : cB + (size_t)(t + 2) * kstep;
            const char* a3 = a2 + kstep; const char* b3 = b2 + kstep;
            if (last && has_next) S.a_ready(nxt);
            if constexpr (SP2) {
            PG8_LDB(B0, 0, 0); PG8_LDB(B1, 0, 1); PG8_SCHED; PG8_LDA(At, 0, 0); PG8_STAGE(PG8_SA(1, 1), a1 + hstep, voffA);
            PG8_WAIT_V(8); PG8_WAIT_L(0); PG8_BAR; PG8_MMA(0, 0, At, B0); PG8_MMA(0, 1, At, B1); PG8_BAR; PG8_SCHED;
            PG8_LDA(At, 0, 1); PG8_STAGE(PG8_SB(0, 0), b2, voffB); PG8_STAGE(PG8_SB(0, 1), b2 + hstep, voffB); PG8_STAGE(PG8_SA(0, 0), a2, voffA);
            PG8_WAIT_V(8); PG8_WAIT_L(0); PG8_BAR; PG8_MMA(1, 0, At, B0); PG8_MMA(1, 1, At, B1); PG8_BAR; PG8_SCHED;
            PG8_LDB(B0, 1, 0); PG8_LDB(B1, 1, 1); PG8_SCHED; PG8_LDA(At, 1, 0); PG8_STAGE(PG8_SA(0, 1), a2 + hstep, voffA);
            PG8_WAIT_V(8); PG8_WAIT_L(0); PG8_BAR; PG8_MMA(0, 0, At, B0); PG8_MMA(0, 1, At, B1); PG8_BAR; PG8_SCHED;
            PG8_LDA(At, 1, 1); PG8_STAGE(PG8_SB(1, 0), b3, voffB); PG8_STAGE(PG8_SB(1, 1), b3 + hstep, voffB); PG8_STAGE(PG8_SA(1, 0), a3, voffA);
            PG8_WAIT_V(8); PG8_WAIT_L(0); PG8_BAR; PG8_MMA(1, 0, At, B0); PG8_MMA(1, 1, At, B1); PG8_BAR; PG8_SCHED;
            } else {
            PG8_LDB(B0, 0, 0); PG8_SCHED; PG8_LDA(At, 0, 0); PG8_STAGE(PG8_SA(1, 1), a1 + hstep, voffA);
            PG8_WAIT_L(8); PG8_BAR; PG8_WAIT_L(0); PG8_MMA(0, 0, At, B0); PG8_BAR; PG8_SCHED;
            PG8_LDB(B1, 0, 1); PG8_STAGE(PG8_SB(0, 0), b2, voffB);
            PG8_BAR; PG8_WAIT_L(0); PG8_MMA(0, 1, At, B1); PG8_BAR;
            PG8_LDA(At, 0, 1); PG8_STAGE(PG8_SA(0, 0), a2, voffA);
            PG8_BAR; PG8_WAIT_L(0); PG8_MMA(1, 0, At, B0); PG8_BAR; PG8_SCHED;
            PG8_STAGE(PG8_SB(0, 1), b2 + hstep, voffB);
            PG8_WAIT_V(6); PG8_BAR; PG8_MMA(1, 1, At, B1); PG8_BAR;
            PG8_LDB(B0, 1, 0); PG8_SCHED; PG8_LDA(At, 1, 0); PG8_STAGE(PG8_SA(0, 1), a2 + hstep, voffA);
            PG8_WAIT_L(8); PG8_BAR; PG8_WAIT_L(0); PG8_MMA(0, 0, At, B0); PG8_BAR; PG8_SCHED;
            PG8_LDB(B1, 1, 1); PG8_STAGE(PG8_SB(1, 0), b3, voffB);
            PG8_BAR; PG8_WAIT_L(0); PG8_MMA(0, 1, At, B1); PG8_BAR;
            PG8_LDA(At, 1, 1); PG8_STAGE(PG8_SA(1, 0), a3, voffA);
            PG8_BAR; PG8_WAIT_L(0); PG8_MMA(1, 0, At, B0); PG8_BAR; PG8_SCHED;
            PG8_STAGE(PG8_SB(1, 1), b3 + hstep, voffB);
            PG8_WAIT_V(6); PG8_BAR; PG8_MMA(1, 1, At, B1); PG8_BAR;
            }
        }
        if constexpr (ALIGN_EPI) { if (wr == 0) PG8_BAR; }
        if constexpr (!Epi::AFTER_DRAIN) { E(acc, cur, wr, wc, fr, fq); S.done(cur); }
        if (!has_next) break;
#pragma unroll
        for (int a = 0; a < 2; ++a)
#pragma unroll
            for (int b = 0; b < 2; ++b)
#pragma unroll
                for (int m = 0; m < 4; ++m)
#pragma unroll
                    for (int n = 0; n < 2; ++n) acc[a][b][m][n] = (f32x4){0.f, 0.f, 0.f, 0.f};
        cur = nxt; cA = nA; cB = nB; ++ui;
        if constexpr (ALIGN_EPI) { if (wr == 1) PG8_BAR; }
    }
    PG8_WAIT_V(0);
    if constexpr (!ALIGN_EPI) { if (wr == 0) PG8_BAR; }
    PG8_BAR;
    if constexpr (Epi::AFTER_DRAIN) { E.fused(acc, cur, wr, wc, fr, fq, lds, wid, lane); S.done(cur); }
#undef PG8_SA
#undef PG8_SB
#undef PG8_STAGE
#undef PG8_LDA
#undef PG8_LDB
#undef PG8_MMA
#undef PG8_WAIT_V
#undef PG8_WAIT_L
#undef PG8_BAR
#undef PG8_SCHED
}
}

__device__ __forceinline__ void transpose_tile(const float* __restrict__ Wm, bf16_t* __restrict__ Wtm, int K, int N, int perm, int tn, int tk, float* tile  ) {
    const int n0 = tn * 64, k0 = tk * 64, tx = ltid() & 63, ty = ltid() >> 6;
    __syncthreads();
    for (int i = ty; i < 64; i += 8) tile[i * 65 + tx] = Wm[(size_t)(k0 + i) * N + n0 + tx];
    __syncthreads();
    for (int i = ty; i < 64; i += 8) {
        const int n = n0 + i;
        const int np = perm ? (n < N / 2 ? 2 * n : 2 * (n - N / 2) + 1) : n;
        Wtm[(size_t)np * K + k0 + tx] = f2bf(tile[tx * 65 + i]);
    }
}
__device__ __forceinline__ void ph_prologue(const P& p, char* lds) {
    const int tid = ltid();
    float* fl = (float*)lds;
    for (int it = blockIdx.x; it < 96; it += gridDim.x) {
        const int l = it / 48, cg = it % 48;
        float* sc = fl;
        float* part = fl + 5 * 1024;
        __syncthreads();
        for (int i = tid; i < 5 * 1024; i += NT) {
            const int r = i >> 10, k = i & 1023;
            const float v = r < 4 ? p.c[r * 1024 + k] : p.c_ctx[k];
            sc[i] = v / (1.f + __expf(-v));
        }
        __syncthreads();
        const int kq = tid >> 7, col = tid & 127, j = cg * 128 + col;
        const float* W = p.w_mod + (size_t)l * 1024 * 6144;
        float a0 = 0, a1 = 0, a2 = 0, a3 = 0, a4 = 0;
        for (int k = kq * 256; k < kq * 256 + 256; ++k) {
            const float w = W[(size_t)k * 6144 + j];
            a0 += sc[k] * w; a1 += sc[1024 + k] * w; a2 += sc[2048 + k] * w; a3 += sc[3072 + k] * w; a4 += sc[4096 + k] * w;
        }
        part[(kq * 5 + 0) * 128 + col] = a0; part[(kq * 5 + 1) * 128 + col] = a1; part[(kq * 5 + 2) * 128 + col] = a2;
        part[(kq * 5 + 3) * 128 + col] = a3; part[(kq * 5 + 4) * 128 + col] = a4;
        __syncthreads();
        for (int i = tid; i < 5 * 128; i += NT) {
            const int r = i >> 7, cc = i & 127, jj = cg * 128 + cc;
            const float v = part[(0 * 5 + r) * 128 + cc] + part[(1 * 5 + r) * 128 + cc] + part[(2 * 5 + r) * 128 + cc] + part[(3 * 5 + r) * 128 + cc];
            p.mod[((size_t)l * 5 + r) * 6144 + jj] = v + p.b_mod[l * 6144 + jj];
        }
    }
    if (blockIdx.x == gridDim.x - 1) {
        const int pos = tid >> 3, f = tid & 7;
        const float inv = powf(10000.0f, -(float)f / 8.0f);
        const float ang = (float)pos * inv;
        p.rope[tid * 2] = cosf(ang); p.rope[tid * 2 + 1] = sinf(ang);
    }
    {
        const size_t n4 = (size_t)R * D / 4, t4 = (size_t)T * D / 4;
        const float4* x4 = (const float4*)p.x; const float4* c4 = (const float4*)p.ctx; float4* X4 = (float4*)p.X;
        for (size_t i = (size_t)blockIdx.x * NT + tid; i < n4; i += (size_t)gridDim.x * NT) X4[i] = i < t4 ? x4[i] : c4[i - t4];
    }
    {
        const int n_in = 2 * 36 * 16, n_out = 2 * 16 * 16, n_gu = 64 * 32 * 16, n_dn = 64 * 16 * 16;
        const int total = n_in + n_out + n_gu + n_dn;
        for (int it = blockIdx.x; it < total; it += gridDim.x) {
            int i = it;
            if (i < n_in) { const int m = i / 576, r = i % 576; transpose_tile(p.w_in + (size_t)m * D * PW, p.WinT + (size_t)m * D * PW, D, PW, 0, r % 36, r / 36, fl); continue; }
            i -= n_in;
            if (i < n_out) { const int m = i / 256, r = i % 256; transpose_tile(p.w_out + (size_t)m * D * D, p.WoutT + (size_t)m * D * D, D, D, 0, r % 16, r / 16, fl); continue; }
            i -= n_out;
            if (i < n_gu) { const int m = i / 512, r = i % 512; transpose_tile(p.w_gu + (size_t)m * D * 2048, p.WguT + (size_t)m * D * 2048, D, 2048, 1, r % 32, r / 32, fl); continue; }
            i -= n_gu;
            { const int m = i / 256, r = i % 256; transpose_tile(p.w_down + (size_t)m * FF * D, p.WdnT + (size_t)m * FF * D, FF, D, 0, r % 16, r / 16, fl); }
        }
    }
}

__device__ __forceinline__ void ph_norm1(const P& p, int l) {
    const int wave = ltid() >> 6, lane = ltid() & 63;
    for (int row = blockIdx.x * 8 + wave; row < R; row += gridDim.x * 8) {
        const float* xr = p.X + (size_t)row * D;
        float4 v[4]; float ss = 0;
#pragma unroll
        for (int i = 0; i < 4; ++i) { v[i] = *(const float4*)(xr + lane * 4 + 256 * i); ss += v[i].x * v[i].x + v[i].y * v[i].y + v[i].z * v[i].z + v[i].w * v[i].w; }
        ss = wave_sum(ss);
        const float rstd = rsqrtf(ss * (1.f / D) + EPS);
        const float* m = p.mod + ((size_t)l * 5 + mod_row(row)) * 6144;
        const float* g = p.g_mix + l * D;
#pragma unroll
        for (int i = 0; i < 4; ++i) {
            const int k = lane * 4 + 256 * i;
            const float4 gg = *(const float4*)(g + k), sh = *(const float4*)(m + k), sc = *(const float4*)(m + 1024 + k);
            ushort4 o;
            o.x = f2bf(v[i].x * rstd * gg.x * (1.f + sc.x) + sh.x); o.y = f2bf(v[i].y * rstd * gg.y * (1.f + sc.y) + sh.y);
            o.z = f2bf(v[i].z * rstd * gg.z * (1.f + sc.z) + sh.z); o.w = f2bf(v[i].w * rstd * gg.w * (1.f + sc.w) + sh.w);
            *(ushort4*)(p.H + (size_t)row * D + k) = o;
        }
    }
}

constexpr float QSCALE = 0.17677669529663687f * 1.4426950408889634f;
__device__ __forceinline__ void ph_rope(const P& p, int nrows) {
    for (int idx = blockIdx.x * NT + ltid(); idx < nrows * 256; idx += gridDim.x * NT) {
        const int i = idx & 7, grp = (idx >> 3) & 3, hb = (idx >> 5) & 7, row = idx >> 8;
        if (row >= T && hb >= 4) continue;
        bf16_t* q = p.PROJ + (size_t)row * PW + hb * 64 + grp * 16 + i;
        float x1 = bf2f(q[0]), x2 = bf2f(q[8]);
        if (row < T) {
            const int s = row & 4095, pos = (grp & 1) ? (s & 63) : (s >> 6);
            const float cs = p.rope[(pos * 8 + i) * 2], sn = p.rope[(pos * 8 + i) * 2 + 1];
            const float y1 = x1 * cs - x2 * sn, y2 = x1 * sn + x2 * cs; x1 = y1; x2 = y2;
        }
        if (hb < 4) { x1 *= QSCALE; x2 *= QSCALE; }
        q[0] = f2bf(x1); q[8] = f2bf(x2);
    }
}

__device__ __forceinline__ void dsoftmax(const f32x16& s, float& m, float& l, f32x16& o0, f32x16& o1, bf16x8& pa, bf16x8& pb) {
    float mx = fmaxf(fmaxf(fmaxf(s[0], s[1]), fmaxf(s[2], s[3])), fmaxf(fmaxf(s[4], s[5]), fmaxf(s[6], s[7])));
    mx = fmaxf(mx, fmaxf(fmaxf(fmaxf(s[8], s[9]), fmaxf(s[10], s[11])), fmaxf(fmaxf(s[12], s[13]), fmaxf(s[14], s[15]))));
    mx = xhalf_max(mx);
    if (__any(mx > m)) {
        const float mn = fmaxf(m, mx), alpha = __builtin_amdgcn_exp2f(m - mn);
        o0 *= alpha; o1 *= alpha; l *= alpha; m = mn;
    }
    float pr[16]; float sum = 0.f;
#pragma unroll
    for (int r = 0; r < 16; ++r) { pr[r] = __builtin_amdgcn_exp2f(s[r] - m); sum += pr[r]; }
    l += sum;
    u32x4 a, b;
    a[0] = cvtpk(pr[0], pr[1]); a[1] = cvtpk(pr[2], pr[3]); a[2] = cvtpk(pr[4], pr[5]); a[3] = cvtpk(pr[6], pr[7]);
    b[0] = cvtpk(pr[8], pr[9]); b[1] = cvtpk(pr[10], pr[11]); b[2] = cvtpk(pr[12], pr[13]); b[3] = cvtpk(pr[14], pr[15]);
    pa = __builtin_bit_cast(bf16x8, a); pb = __builtin_bit_cast(bf16x8, b);
}
__device__ __forceinline__ void ph_dattn(const P& p, int l, int nrows, char* lds) {
    const int tid = ltid(), lane = tid & 63, wid = tid >> 6, r32 = lane & 31, hi = lane >> 5;
    float la = lane < 32 ? p.lam_q1[l * 32 + lane] * p.lam_k1[l * 32 + lane] : 0.f;
    float lb = lane < 32 ? p.lam_q2[l * 32 + lane] * p.lam_k2[l * 32 + lane] : 0.f;
    la = wave_sum(la); lb = wave_sum(lb);
    const float lam_init = 0.8f - 0.6f * expf(-0.3f * (float)l);
    const float lam = expf(la) - expf(lb) + lam_init;
    const bf16_t* PR = p.PROJ;
    const int nunits = (nrows == R) ? 256 + 16 : 256;
    const int skey = 8 * wid + (lane & 7), schunk = lane >> 3;
    const int ldsK = schunk * 1024 + skey * 16;
    const int ldsV = 8192 + (schunk >> 2) * 4096 + (skey >> 3) * 512 + (skey & 7) * 64 + (schunk & 3) * 16;
    const int vb = ((lane >> 4) & 1) * 32 + (lane & 3) * 8 + (4 * hi + ((lane & 15) >> 2)) * 64;
    for (int uu = blockIdx.x; uu < nunits; uu += gridDim.x) {
        int b, h, q0, nt; bool isctx;
        if (uu < 256) { const int u = (uu & 7) * 32 + (uu >> 3); b = u >> 6; h = (u >> 4) & 3; q0 = b * 4096 + (u & 15) * 256; nt = 68; isctx = false; }
        else { const int v = uu - 256; b = v >> 2; h = v & 3; q0 = T + b * 256; nt = 4; isctx = true; }
        bf16x8 qf[4];
        {
            const bf16_t* qp = PR + (size_t)(q0 + wid * 32 + r32) * PW + h * 64 + hi * 8;
#pragma unroll
            for (int ks = 0; ks < 4; ++ks) qf[ks] = *(const bf16x8*)(qp + ks * 16);
        }
        f32x16 O00, O01, O10, O11;
#pragma unroll
        for (int r = 0; r < 16; ++r) { O00[r] = 0.f; O01[r] = 0.f; O10[r] = 0.f; O11[r] = 0.f; }
        float m1 = -1e30f, m2 = -1e30f, l1 = 0.f, l2 = 0.f;
        const size_t gK = 256 + h * 64 + schunk * 8, gV = 512 + h * 64 + schunk * 8;
        uint4 rk, rv;
        {
            const int kr = (isctx ? T + b * 256 : b * 4096) + skey;
            rk = *(const uint4*)(PR + (size_t)kr * PW + gK); rv = *(const uint4*)(PR + (size_t)kr * PW + gV);
        }
        __syncthreads();
        *(uint4*)(lds + ldsK) = rk; *(uint4*)(lds + ldsV) = rv;
        __syncthreads();
        for (int t = 0; t < nt; ++t) {
            char* buf = lds + (t & 1) * 16384;
            if (t + 1 < nt) {
                const int tn = t + 1;
                const int kr = ((isctx || tn >= 64) ? T + b * 256 + (isctx ? tn : tn - 64) * 64 : b * 4096 + tn * 64) + skey;
                rk = *(const uint4*)(PR + (size_t)kr * PW + gK); rv = *(const uint4*)(PR + (size_t)kr * PW + gV);
            }
#pragma unroll
            for (int kb = 0; kb < 2; ++kb) {
                const lds_cptr kp = (lds_cptr)buf + hi * 1024 + (kb * 32 + r32) * 16;
                const bf16x8 kf0 = *(const __attribute__((address_space(3))) bf16x8*)(kp);
                const bf16x8 kf1 = *(const __attribute__((address_space(3))) bf16x8*)(kp + 2048);
                const bf16x8 kf2 = *(const __attribute__((address_space(3))) bf16x8*)(kp + 4096);
                const bf16x8 kf3 = *(const __attribute__((address_space(3))) bf16x8*)(kp + 6144);
                f32x16 s1, s2;
#pragma unroll
                for (int r = 0; r < 16; ++r) { s1[r] = 0.f; s2[r] = 0.f; }
                s1 = __builtin_amdgcn_mfma_f32_32x32x16_bf16(kf0, qf[0], s1, 0, 0, 0);
                s1 = __builtin_amdgcn_mfma_f32_32x32x16_bf16(kf1, qf[1], s1, 0, 0, 0);
                s2 = __builtin_amdgcn_mfma_f32_32x32x16_bf16(kf2, qf[2], s2, 0, 0, 0);
                s2 = __builtin_amdgcn_mfma_f32_32x32x16_bf16(kf3, qf[3], s2, 0, 0, 0);
                bf16x8 p1a, p1b, p2a, p2b;
                dsoftmax(s1, m1, l1, O00, O01, p1a, p1b);
                dsoftmax(s2, m2, l2, O10, O11, p2a, p2b);
                const lds_cptr vp = (lds_cptr)buf + 8192 + vb + kb * 2048;
#pragma unroll
                for (int dt = 0; dt < 2; ++dt) {
#pragma unroll
                    for (int ss = 0; ss < 2; ++ss) {
                        const s16x4 lo = vtr(vp + dt * 4096 + ss * 1024), hh = vtr(vp + dt * 4096 + ss * 1024 + 512);
                        const bf16x8 va = (bf16x8){lo[0], lo[1], lo[2], lo[3], hh[0], hh[1], hh[2], hh[3]};
                        if (dt == 0) { O00 = __builtin_amdgcn_mfma_f32_32x32x16_bf16(va, ss ? p1b : p1a, O00, 0, 0, 0); O10 = __builtin_amdgcn_mfma_f32_32x32x16_bf16(va, ss ? p2b : p2a, O10, 0, 0, 0); }
                        else         { O01 = __builtin_amdgcn_mfma_f32_32x32x16_bf16(va, ss ? p1b : p1a, O01, 0, 0, 0); O11 = __builtin_amdgcn_mfma_f32_32x32x16_bf16(va, ss ? p2b : p2a, O11, 0, 0, 0); }
                    }
                }
            }
            if (t + 1 < nt) { char* nb = lds + ((t + 1) & 1) * 16384; *(uint4*)(nb + ldsK) = rk; *(uint4*)(nb + ldsV) = rv; }
            __syncthreads();
        }
        l1 = xhalf_sum(l1); l2 = xhalf_sum(l2);
        const float i1 = 1.f / l1, i2 = lam / l2;
        float ss = 0.f;
#pragma unroll
        for (int r = 0; r < 16; ++r) { O00[r] = O00[r] * i1 - O10[r] * i2; O01[r] = O01[r] * i1 - O11[r] * i2; ss += O00[r] * O00[r] + O01[r] * O01[r]; }
        ss = xhalf_sum(ss);
        const float rstd = rsqrtf(ss * (1.f / 64.f) + EPS) * (1.f - lam_init);
        const float* gs = p.g_sub + l * 64;
        bf16_t* op = p.MIX + (size_t)(q0 + wid * 32 + r32) * D + h * 64;
#pragma unroll
        for (int g4 = 0; g4 < 4; ++g4) {
            const int d = 8 * g4 + 4 * hi;
            const float4 ga = *(const float4*)(gs + d), gb = *(const float4*)(gs + 32 + d);
            uint2 wa, wb;
            wa.x = cvtpk(O00[4 * g4] * rstd * ga.x, O00[4 * g4 + 1] * rstd * ga.y); wa.y = cvtpk(O00[4 * g4 + 2] * rstd * ga.z, O00[4 * g4 + 3] * rstd * ga.w);
            wb.x = cvtpk(O01[4 * g4] * rstd * gb.x, O01[4 * g4 + 1] * rstd * gb.y); wb.y = cvtpk(O01[4 * g4 + 2] * rstd * gb.z, O01[4 * g4 + 3] * rstd * gb.w);
            *(uint2*)(op + d) = wa; *(uint2*)(op + 32 + d) = wb;
        }
    }
}

__device__ __forceinline__ void ph_na(const P& p, int l, int nrows, char* lds) {
    const int tid = ltid(), lane = tid & 63, wid = tid >> 6, r32 = lane & 31, hi = lane >> 5;
    const bf16_t* PR = p.PROJ;
    const int nunits = (nrows == R) ? 256 + 16 : 256;
    const int skey = 8 * wid + (lane & 7), schunk = lane >> 3;
    const int ldsK = schunk * 1024 + skey * 16;
    const int ldsV = 8192 + (schunk >> 2) * 4096 + (skey >> 3) * 512 + (skey & 7) * 64 + (schunk & 3) * 16;
    const int vb = ((lane >> 4) & 1) * 32 + (lane & 3) * 8 + (4 * hi + ((lane & 15) >> 2)) * 64;
    float* btab = (float*)(lds + 32768);
    constexpr float LOG2E = 1.4426950408889634f;
    for (int uu = blockIdx.x; uu < nunits; uu += gridDim.x) {
        int b, h, q0, kr_lo, nlat, rs = 0, rq = 0; bool isctx;
        if (uu < 256) {
            const int u = (uu & 7) * 32 + (uu >> 3); b = u >> 6; h = (u >> 4) & 3; const int rg = u & 15;
            rq = 4 * rg + (wid >> 1); q0 = b * 4096 + rq * 64 + (wid & 1) * 32;
            kr_lo = min(max(4 * rg - 4, 0), 56); const int kr_hi = min(max(4 * rg - 1, 0), 56) + 7; nlat = kr_hi - kr_lo + 1;
            rs = min(max(rq - 4, 0), 56); isctx = false;
        } else { const int v = uu - 256; b = v >> 2; h = v & 3; q0 = T + b * 256 + wid * 32; kr_lo = 0; nlat = 0; isctx = true; }
        const int nt = nlat + 4;
        const int cq = (wid & 1) * 32 + r32, wsc = min(max(cq - 8, 0), 48);
        bf16x8 qf[4];
        {
            const bf16_t* qp = PR + (size_t)(q0 + r32) * PW + 1536 + h * 64 + hi * 8;
#pragma unroll
            for (int ks = 0; ks < 4; ++ks) {
                const uint4 raw = *(const uint4*)(qp + ks * 16);
                const unsigned w4[4] = {raw.x, raw.y, raw.z, raw.w}; u32x4 o;
#pragma unroll
                for (int j = 0; j < 4; ++j) o[j] = cvtpk(__uint_as_float(w4[j] << 16) * (0.125f * LOG2E), __uint_as_float(w4[j] & 0xffff0000u) * (0.125f * LOG2E));
                qf[ks] = __builtin_bit_cast(bf16x8, o);
            }
        }
        f32x16 O0, O1;
#pragma unroll
        for (int r = 0; r < 16; ++r) { O0[r] = 0.f; O1[r] = 0.f; }
        float m1 = -1e30f, l1 = 0.f;
        const size_t gK = 1792 + h * 64 + schunk * 8, gV = 2048 + h * 64 + schunk * 8;
        uint4 rk, rv;
        {
            const int kr = (nlat ? b * 4096 + kr_lo * 64 : T + b * 256) + skey;
            rk = *(const uint4*)(PR + (size_t)kr * PW + gK); rv = *(const uint4*)(PR + (size_t)kr * PW + gV);
        }
        __syncthreads();
        *(uint4*)(lds + ldsK) = rk; *(uint4*)(lds + ldsV) = rv;
        if (tid < 465) btab[tid] = p.rpb[((size_t)l * 4 + h) * 465 + tid] * LOG2E;
        __syncthreads();
        for (int t = 0; t < nt; ++t) {
            char* buf = lds + (t & 1) * 16384;
            if (t + 1 < nt) {
                const int tn = t + 1;
                const int kr = (tn < nlat ? b * 4096 + (kr_lo + tn) * 64 : T + b * 256 + (tn - nlat) * 64) + skey;
                rk = *(const uint4*)(PR + (size_t)kr * PW + gK); rv = *(const uint4*)(PR + (size_t)kr * PW + gV);
            }
            const bool lat = t < nlat;
            const int krow = kr_lo + t;
            const bool active = !lat || (krow >= rs && krow <= rs + 7);
            if (active) {
                const float* brow = btab + (krow - rq + 7) * 31 + 15 - cq;
#pragma unroll
                for (int kb = 0; kb < 2; ++kb) {
                    const lds_cptr kp = (lds_cptr)buf + hi * 1024 + (kb * 32 + r32) * 16;
                    f32x16 s1;
#pragma unroll
                    for (int r = 0; r < 16; ++r) s1[r] = 0.f;
#pragma unroll
                    for (int ks = 0; ks < 4; ++ks) {
                        const bf16x8 kf = *(const __attribute__((address_space(3))) bf16x8*)(kp + ks * 2048);
                        s1 = __builtin_amdgcn_mfma_f32_32x32x16_bf16(kf, qf[ks], s1, 0, 0, 0);
                    }
                    if (lat) {
#pragma unroll
                        for (int r = 0; r < 16; ++r) {
                            const int kc = 32 * kb + (r & 3) + 8 * (r >> 2) + 4 * hi;
                            const bool ok = (unsigned)(kc - wsc) < 16u;
                            const float bv = brow[ok ? kc : cq];
                            s1[r] = ok ? s1[r] + bv : -INFINITY;
                        }
                    }
                    bf16x8 pa, pb;
                    dsoftmax(s1, m1, l1, O0, O1, pa, pb);
                    const lds_cptr vp = (lds_cptr)buf + 8192 + vb + kb * 2048;
#pragma unroll
                    for (int ss = 0; ss < 2; ++ss) {
                        const s16x4 lo0 = vtr(vp + ss * 1024), hh0 = vtr(vp + ss * 1024 + 512);
                        const s16x4 lo1 = vtr(vp + 4096 + ss * 1024), hh1 = vtr(vp + 4096 + ss * 1024 + 512);
                        const bf16x8 va0 = (bf16x8){lo0[0], lo0[1], lo0[2], lo0[3], hh0[0], hh0[1], hh0[2], hh0[3]};
                        const bf16x8 va1 = (bf16x8){lo1[0], lo1[1], lo1[2], lo1[3], hh1[0], hh1[1], hh1[2], hh1[3]};
                        O0 = __builtin_amdgcn_mfma_f32_32x32x16_bf16(va0, ss ? pb : pa, O0, 0, 0, 0);
                        O1 = __builtin_amdgcn_mfma_f32_32x32x16_bf16(va1, ss ? pb : pa, O1, 0, 0, 0);
                    }
                }
            }
            if (t + 1 < nt) { char* nb = lds + ((t + 1) & 1) * 16384; *(uint4*)(nb + ldsK) = rk; *(uint4*)(nb + ldsV) = rv; }
            __syncthreads();
        }
        l1 = xhalf_sum(l1);
        const float il = 1.f / l1;
        bf16_t* op = p.MIX + (size_t)(q0 + r32) * D + 768 + h * 64;
#pragma unroll
        for (int g4 = 0; g4 < 4; ++g4) {
            const int d = 8 * g4 + 4 * hi;
            uint2 wa, wb;
            wa.x = cvtpk(O0[4 * g4] * il, O0[4 * g4 + 1] * il); wa.y = cvtpk(O0[4 * g4 + 2] * il, O0[4 * g4 + 3] * il);
            wb.x = cvtpk(O1[4 * g4] * il, O1[4 * g4 + 1] * il); wb.y = cvtpk(O1[4 * g4 + 2] * il, O1[4 * g4 + 3] * il);
            *(uint2*)(op + d) = wa; *(uint2*)(op + 32 + d) = wb;
        }
    }
}

__device__ __forceinline__ void ph_pool(const P& p, int l, int nrows, char* lds) {
    const int tid = ltid(), half = tid >> 8, ch = tid & 255, g = ch >> 6, w = 2 << g;
    float* dsh = (float*)lds + half * 256;
    const float* wp = p.w_pool + ((size_t)l * 4 + g) * 64 * 64;
    const float sp = p.s_pool[l * 256 + ch];
    for (int it = blockIdx.x; it < nrows / 2; it += gridDim.x) {
        const int row = it * 2 + half;
        const int L = row < T ? 4096 : 256;
        const int t = row < T ? (row & 4095) : ((row - T) & 255);
        const int base = row - t;
        const int lo = max(t - w / 2, 0), hi = min(t + w / 2 - 1, L - 1);
        float sum = 0.f;
        for (int rr = lo; rr <= hi; ++rr) sum += bf2f(p.PROJ[(size_t)(base + rr) * PW + 768 + ch]);
        const float y = bf2f(p.PROJ[(size_t)row * PW + 768 + ch]);
        __syncthreads();
        dsh[ch] = sum / (float)(hi - lo + 1) - y;
        __syncthreads();
        float a = 0.f;
#pragma unroll 8
        for (int i = 0; i < 64; ++i) a += dsh[g * 64 + i] * wp[i * 64 + (ch & 63)];
        p.MIX[(size_t)row * D + 256 + ch] = f2bf(a * sp);
    }
}

__device__ __forceinline__ float gelu_tanh(float x) { return 0.5f * x * (1.f + tanhf(0.7978845608028654f * (x + 0.044715f * x * x * x))); }
__device__ __forceinline__ void ph_sgu(const P& p, int l, int nrows, char* lds) {
    float* vn = (float*)lds;
    float* rstd = vn + 128 * 64;
    const int tid = ltid();
    for (int it = blockIdx.x; it < (nrows / 128) * 4; it += gridDim.x) {
        const int chunk = it >> 2, g = it & 3, row0 = chunk * 128;
        __syncthreads();
        {
            const int t = tid >> 2, qtr = tid & 3;
            const bf16_t* zp = p.PROJ + (size_t)(row0 + t) * PW + 1024 + 256 + qtr * 64;
            float ss = 0.f;
            for (int i = 0; i < 64; ++i) { const float v = gelu_tanh(bf2f(zp[i])); ss += v * v; }
            ss += __shfl_xor(ss, 1); ss += __shfl_xor(ss, 2);
            if (qtr == 0) rstd[t] = rsqrtf(ss * (1.f / 256.f) + EPS);
        }
        __syncthreads();
        for (int i = tid; i < 128 * 64; i += NT) {
            const int s = i >> 6, cc = i & 63;
            const float v = gelu_tanh(bf2f(p.PROJ[(size_t)(row0 + s) * PW + 1024 + 256 + g * 64 + cc]));
            vn[i] = v * rstd[s] * p.g_sgu[l * 256 + g * 64 + cc];
        }
        __syncthreads();
        const int cc = tid & 63;
        const float* ws = p.w_sgu + ((size_t)l * 4 + g) * 128 * 128;
        for (int t = tid >> 6; t < 128; t += 8) {
            float a = 0.f;
            const float* wr = ws + t * 128;
#pragma unroll 8
            for (int s = 0; s < 128; ++s) a += wr[s] * vn[s * 64 + cc];
            a += p.b_sgu[(l * 4 + g) * 128 + t];
            const float u = gelu_tanh(bf2f(p.PROJ[(size_t)(row0 + t) * PW + 1024 + g * 64 + cc]));
            p.MIX[(size_t)(row0 + t) * D + 512 + g * 64 + cc] = f2bf(u * a);
        }
    }
}

__device__ __forceinline__ void ph_router(const P& p, int l, int nrows) {
    const int wave = ltid() >> 6, lane = ltid() & 63;
    for (int row = blockIdx.x * 8 + wave; row < nrows; row += gridDim.x * 8) {
        const float* xr = p.X + (size_t)row * D;
        float hf[16]; float ss = 0;
#pragma unroll
        for (int i = 0; i < 4; ++i) { float4 v = *(const float4*)(xr + lane * 4 + 256 * i); hf[4 * i] = v.x; hf[4 * i + 1] = v.y; hf[4 * i + 2] = v.z; hf[4 * i + 3] = v.w; ss += v.x * v.x + v.y * v.y + v.z * v.z + v.w * v.w; }
        ss = wave_sum(ss);
        const float rstd = rsqrtf(ss * (1.f / D) + EPS);
        const float* m = p.mod + ((size_t)l * 5 + mod_row(row)) * 6144;
        const float* g = p.g_ffn + l * D;
#pragma unroll
        for (int i = 0; i < 4; ++i) {
            const int k = lane * 4 + 256 * i;
            const float4 gg = *(const float4*)(g + k), sh = *(const float4*)(m + 3 * 1024 + k), sc = *(const float4*)(m + 4 * 1024 + k);
            hf[4 * i] = hf[4 * i] * rstd * gg.x * (1.f + sc.x) + sh.x; hf[4 * i + 1] = hf[4 * i + 1] * rstd * gg.y * (1.f + sc.y) + sh.y;
            hf[4 * i + 2] = hf[4 * i + 2] * rstd * gg.z * (1.f + sc.z) + sh.z; hf[4 * i + 3] = hf[4 * i + 3] * rstd * gg.w * (1.f + sc.w) + sh.w;
            ushort4 o; o.x = f2bf(hf[4 * i]); o.y = f2bf(hf[4 * i + 1]); o.z = f2bf(hf[4 * i + 2]); o.w = f2bf(hf[4 * i + 3]);
            *(ushort4*)(p.H + (size_t)row * D + k) = o;
        }
        float lg[32];
#pragma unroll
        for (int e = 0; e < 32; ++e) lg[e] = 0.f;
        const float* wr = p.w_router + (size_t)l * D * NE;
#pragma unroll
        for (int i = 0; i < 4; ++i)
#pragma unroll
            for (int j = 0; j < 4; ++j) {
                const int k = lane * 4 + 256 * i + j;
                const float hv = hf[4 * i + j];
#pragma unroll
                for (int e = 0; e < 32; e += 4) { const float4 w = *(const float4*)(wr + (size_t)k * NE + e); lg[e] += hv * w.x; lg[e + 1] += hv * w.y; lg[e + 2] += hv * w.z; lg[e + 3] += hv * w.w; }
            }
#pragma unroll
        for (int e = 0; e < 32; ++e) lg[e] = wave_sum(lg[e]) + p.b_router[l * NE + e];
        unsigned taken = 0u; float tv[4]; int ti[4];
#pragma unroll
        for (int k = 0; k < 4; ++k) {
            float best = -3.0e38f; int bi = 0;
#pragma unroll
            for (int e = 0; e < 32; ++e) { const bool ok = !((taken >> e) & 1u) && (lg[e] > best); best = ok ? lg[e] : best; bi = ok ? e : bi; }
            taken |= 1u << bi; tv[k] = best; ti[k] = bi;
        }
        const float e1 = __expf(tv[1] - tv[0]), e2 = __expf(tv[2] - tv[0]), e3 = __expf(tv[3] - tv[0]);
        const float inv = 1.f / (1.f + e1 + e2 + e3);
        if (lane == 0) {
            *(int4*)(p.topi + (size_t)row * 4) = make_int4(ti[0], ti[1], ti[2], ti[3]);
            *(float4*)(p.topg + (size_t)row * 4) = make_float4(inv, e1 * inv, e2 * inv, e3 * inv);
            int* cnt = p.cnt + l * 64;
            atomicAdd(&cnt[ti[0]], 1); atomicAdd(&cnt[ti[1]], 1); atomicAdd(&cnt[ti[2]], 1); atomicAdd(&cnt[ti[3]], 1);
        }
    }
}
__device__ __forceinline__ void ph_assign(const P& p, int l, int nrows, char* lds) {
    int* lcnt = (int*)lds; int* lbase = lcnt + 32; int* pst = lbase + 32; int* slots = pst + 32;
    const int tid = ltid(), wave = tid >> 6, lane = tid & 63;
    int* cnt = p.cnt + l * 64; int* cursor = cnt + 32;
    int* meta = p.moe_meta + l * 512;
    __syncthreads();
    if (tid == 0) { int a = 0; for (int e = 0; e < 32; ++e) { pst[e] = a; a += (cnt[e] + 255) & ~255; } if (blockIdx.x == 0) meta[0] = a >> 8; }
    __syncthreads();
    if (blockIdx.x == 0 && tid < 320) { int e = 0; for (int k = 1; k < 32; ++k) if (tid * 256 >= pst[k]) e = k; meta[1 + tid] = e; }
    for (int it = blockIdx.x; it < nrows / NT; it += gridDim.x) {
        const int row = it * NT + tid;
        __syncthreads();
        if (tid < 32) lcnt[tid] = 0;
        __syncthreads();
        const int4 ti = *(const int4*)(p.topi + (size_t)row * 4);
        const int r0 = atomicAdd(&lcnt[ti.x], 1), r1 = atomicAdd(&lcnt[ti.y], 1), r2 = atomicAdd(&lcnt[ti.z], 1), r3 = atomicAdd(&lcnt[ti.w], 1);
        __syncthreads();
        if (tid < 32) lbase[tid] = pst[tid] + (lcnt[tid] ? atomicAdd(&cursor[tid], lcnt[tid]) : 0);
        __syncthreads();
        const int4 sl = make_int4(lbase[ti.x] + r0, lbase[ti.y] + r1, lbase[ti.z] + r2, lbase[ti.w] + r3);
        *(int4*)(p.tok_slot + (size_t)row * 4) = sl;
        *(int4*)(slots + tid * 4) = sl;
        __syncthreads();
        for (int rr = 0; rr < 64; ++rr) {
            const int lr = wave * 64 + rr;
            const int4 s4 = *(const int4*)(slots + lr * 4);
            const bf16_t* src = p.H + (size_t)(it * NT + lr) * D + lane * 8;
            const uint4 v0 = *(const uint4*)src, v1 = *(const uint4*)(src + 512);
            bf16_t* d0 = p.HS + (size_t)s4.x * D + lane * 8; *(uint4*)d0 = v0; *(uint4*)(d0 + 512) = v1;
            bf16_t* d1 = p.HS + (size_t)s4.y * D + lane * 8; *(uint4*)d1 = v0; *(uint4*)(d1 + 512) = v1;
            bf16_t* d2 = p.HS + (size_t)s4.z * D + lane * 8; *(uint4*)d2 = v0; *(uint4*)(d2 + 512) = v1;
            bf16_t* d3 = p.HS + (size_t)s4.w * D + lane * 8; *(uint4*)d3 = v0; *(uint4*)(d3 + 512) = v1;
        }
    }
}

struct EpiProj {
    static constexpr bool PERM = true, AFTER_DRAIN = false;
    bf16_t* O;
    __device__ __forceinline__ void operator()(const f32x4 (&acc)[2][2][4][2], const pg8::Unit& u, int wr, int wc, int fr, int fq) const {
        const int row0 = u.pm * 256 + wr * 64 + fr, col0 = u.pn * 256 + wc * 32 + 8 * fq;
#pragma unroll
        for (int ai = 0; ai < 2; ++ai)
#pragma unroll
            for (int m = 0; m < 4; ++m) { bf16_t* rowp = O + (size_t)(row0 + ai * 128 + m * 16) * PW + col0;
#pragma unroll
                for (int bj = 0; bj < 2; ++bj) { const f32x4 v0 = acc[ai][bj][m][0], v1 = acc[ai][bj][m][1];
                    u32x4 w; w.x = cvtpk(v0[0], v0[1]); w.y = cvtpk(v0[2], v0[3]); w.z = cvtpk(v1[0], v1[1]); w.w = cvtpk(v1[2], v1[3]);
                    *(u32x4*)(rowp + bj * 128) = w; } }
    }
};
struct EpiOut {
    static constexpr bool PERM = false, AFTER_DRAIN = false;
    float* X; const float* gate;
    __device__ __forceinline__ void operator()(const f32x4 (&acc)[2][2][4][2], const pg8::Unit& u, int wr, int wc, int fr, int fq) const {
        const int row0 = u.pm * 256 + wr * 64 + fr, col0 = u.pn * 256 + wc * 32 + 4 * fq;
        const float* g = gate + (size_t)mod_row(u.pm * 256) * 6144 + col0;
        f32x4 gv[2][2];
#pragma unroll
        for (int bj = 0; bj < 2; ++bj)
#pragma unroll
            for (int n = 0; n < 2; ++n) gv[bj][n] = *(const f32x4*)(g + bj * 128 + n * 16);
#pragma unroll
        for (int ai = 0; ai < 2; ++ai)
#pragma unroll
            for (int m = 0; m < 4; ++m) { float* xp = X + (size_t)(row0 + ai * 128 + m * 16) * D + col0;
#pragma unroll
                for (int bj = 0; bj < 2; ++bj)
#pragma unroll
                    for (int n = 0; n < 2; ++n) { f32x4* q = (f32x4*)(xp + bj * 128 + n * 16); *q = *q + gv[bj][n] * acc[ai][bj][m][n]; } }
    }
};
__device__ __forceinline__ float swiglu(float g, float u) {
    const float gt = fminf(g, 7.0f), up = fminf(fmaxf(u, -7.0f), 7.0f);
    return (up + 1.0f) * gt / (1.0f + __expf(-1.702f * gt));
}
struct EpiAct {
    static constexpr bool PERM = true, AFTER_DRAIN = false;
    bf16_t* ACT; const float* bgu;
    __device__ __forceinline__ void operator()(const f32x4 (&acc)[2][2][4][2], const pg8::Unit& u, int wr, int wc, int fr, int fq) const {
        const int row0 = u.pm * 256 + wr * 64 + fr, j0 = (u.pn * 256 + wc * 32 + 8 * fq) >> 1;
        const float* bp = bgu + (size_t)u.e * 2048 + j0;
        f32x4 bg[2], bu[2];
#pragma unroll
        for (int bj = 0; bj < 2; ++bj) { bg[bj] = *(const f32x4*)(bp + bj * 64); bu[bj] = *(const f32x4*)(bp + 1024 + bj * 64); }
#pragma unroll
        for (int ai = 0; ai < 2; ++ai)
#pragma unroll
            for (int m = 0; m < 4; ++m) { bf16_t* rowp = ACT + (size_t)(row0 + ai * 128 + m * 16) * FF + j0;
#pragma unroll
                for (int bj = 0; bj < 2; ++bj) { const f32x4 v0 = acc[ai][bj][m][0], v1 = acc[ai][bj][m][1];
                    const float a0 = swiglu(v0[0] + bg[bj][0], v0[1] + bu[bj][0]), a1 = swiglu(v0[2] + bg[bj][1], v0[3] + bu[bj][1]);
                    const float a2 = swiglu(v1[0] + bg[bj][2], v1[1] + bu[bj][2]), a3 = swiglu(v1[2] + bg[bj][3], v1[3] + bu[bj][3]);
                    uint2 w; w.x = cvtpk(a0, a1); w.y = cvtpk(a2, a3);
                    *(uint2*)(rowp + bj * 64) = w; } }
    }
};
struct EpiYB {
    static constexpr bool PERM = true, AFTER_DRAIN = false;
    bf16_t* YB; const float* bdn;
    __device__ __forceinline__ void operator()(const f32x4 (&acc)[2][2][4][2], const pg8::Unit& u, int wr, int wc, int fr, int fq) const {
        const int row0 = u.pm * 256 + wr * 64 + fr, col0 = u.pn * 256 + wc * 32 + 8 * fq;
        const float* bp = bdn + (size_t)u.e * D + col0;
        f32x4 bv[2][2];
#pragma unroll
        for (int bj = 0; bj < 2; ++bj)
#pragma unroll
            for (int n = 0; n < 2; ++n) bv[bj][n] = *(const f32x4*)(bp + bj * 128 + n * 4);
#pragma unroll
        for (int ai = 0; ai < 2; ++ai)
#pragma unroll
            for (int m = 0; m < 4; ++m) { bf16_t* rowp = YB + (size_t)(row0 + ai * 128 + m * 16) * D + col0;
#pragma unroll
                for (int bj = 0; bj < 2; ++bj) { const f32x4 v0 = acc[ai][bj][m][0] + bv[bj][0], v1 = acc[ai][bj][m][1] + bv[bj][1];
                    u32x4 w; w.x = cvtpk(v0[0], v0[1]); w.y = cvtpk(v0[2], v0[3]); w.z = cvtpk(v1[0], v1[1]); w.w = cvtpk(v1[2], v1[3]);
                    *(u32x4*)(rowp + bj * 128) = w; } }
    }
};
struct MoeOrder {
    int nN, nunits, G, v; const int* tile_e;
    __device__ void init(int ntiles, int nN_, int G_, int c, const int* te) { nN = nN_; nunits = ntiles * nN_; G = G_; v = (G_ % 8 == 0) ? (c % 8) * (G_ / 8) + c / 8 : c; tile_e = te; }
    __device__ bool next(int i, pg8::Unit& u) const {
        const int L = i * G + v; if (L >= nunits) return false;
        u.pm = L / nN; u.pn = L % nN; u.e = tile_e[u.pm]; return true;
    }
    __device__ __forceinline__ const bf16_t* bt(const pg8::Gemm& g, const pg8::Unit& u) const { return g.Bt + (size_t)u.e * g.N * g.K; }
    __device__ __forceinline__ void a_ready(const pg8::Unit&) const {}
    __device__ __forceinline__ void done(const pg8::Unit&) const {}
};

__device__ __forceinline__ void ph_gemm_proj(const P& p, int l, char* lds) {
    pg8::Gemm g{p.H, p.WinT + (size_t)l * PW * D, R, PW, D}; pg8::StaticOrder S; S.init(R, PW, (int)gridDim.x, (int)blockIdx.x);
    EpiProj E{p.PROJ};
    pg8::gemm_phase<EpiProj, pg8::StaticOrder, true, true>((PG8_LAS unsigned char*)lds, g, S, E);
}
__device__ __forceinline__ void ph_gemm_out(const P& p, int l, int nrows, char* lds) {
    pg8::Gemm g{p.MIX, p.WoutT + (size_t)l * D * D, nrows, D, D}; pg8::StaticOrder S; S.init(nrows, D, (int)gridDim.x, (int)blockIdx.x);
    EpiOut E{p.X, p.mod + (size_t)l * 5 * 6144 + 2 * 1024};
    pg8::gemm_phase<EpiOut, pg8::StaticOrder, true, true>((PG8_LAS unsigned char*)lds, g, S, E);
}
__device__ __forceinline__ void ph_moe1(const P& p, int l, char* lds) {
    const int* meta = p.moe_meta + l * 512;
    const int ntiles = meta[0];
    pg8::Gemm g{p.HS, p.WguT + (size_t)l * NE * 2048 * D, ntiles * 256, 2048, D}; MoeOrder S; S.init(ntiles, 8, (int)gridDim.x, (int)blockIdx.x, meta + 1);
    EpiAct E{p.ACT, p.b_gu + (size_t)l * NE * 2048};
    pg8::gemm_phase<EpiAct, MoeOrder, true, true>((PG8_LAS unsigned char*)lds, g, S, E);
}
__device__ __forceinline__ void ph_moe2(const P& p, int l, char* lds) {
    const int* meta = p.moe_meta + l * 512;
    const int ntiles = meta[0];
    pg8::Gemm g{p.ACT, p.WdnT + (size_t)l * NE * D * FF, ntiles * 256, D, FF}; MoeOrder S; S.init(ntiles, 4, (int)gridDim.x, (int)blockIdx.x, meta + 1);
    EpiYB E{p.YB, p.b_down + (size_t)l * NE * D};
    pg8::gemm_phase<EpiYB, MoeOrder, true, true>((PG8_LAS unsigned char*)lds, g, S, E);
}
__device__ __forceinline__ void ph_combine(const P& p, int l, int nrows) {
    const int wave = ltid() >> 6, lane = ltid() & 63;
    for (int row = blockIdx.x * 8 + wave; row < nrows; row += gridDim.x * 8) {
        const int4 sl = *(const int4*)(p.tok_slot + (size_t)row * 4);
        const float4 g = *(const float4*)(p.topg + (size_t)row * 4);
        const float* m = p.mod + ((size_t)l * 5 + mod_row(row)) * 6144 + 5 * 1024;
#pragma unroll
        for (int i = 0; i < 2; ++i) {
            const int k = lane * 8 + 512 * i;
            const uint4 y0 = *(const uint4*)(p.YB + (size_t)sl.x * D + k), y1 = *(const uint4*)(p.YB + (size_t)sl.y * D + k);
            const uint4 y2 = *(const uint4*)(p.YB + (size_t)sl.z * D + k), y3 = *(const uint4*)(p.YB + (size_t)sl.w * D + k);
            const unsigned a0[4] = {y0.x, y0.y, y0.z, y0.w}, a1[4] = {y1.x, y1.y, y1.z, y1.w}, a2[4] = {y2.x, y2.y, y2.z, y2.w}, a3[4] = {y3.x, y3.y, y3.z, y3.w};
            float* xp = p.X + (size_t)row * D + k;
#pragma unroll
            for (int q = 0; q < 2; ++q) {
                const float4 gt = *(const float4*)(m + k + 4 * q);
                float4 xv = *(const float4*)(xp + 4 * q);
                const unsigned w0a = a0[2 * q], w0b = a0[2 * q + 1], w1a = a1[2 * q], w1b = a1[2 * q + 1], w2a = a2[2 * q], w2b = a2[2 * q + 1], w3a = a3[2 * q], w3b = a3[2 * q + 1];
                xv.x += gt.x * (g.x * __uint_as_float(w0a << 16) + g.y * __uint_as_float(w1a << 16) + g.z * __uint_as_float(w2a << 16) + g.w * __uint_as_float(w3a << 16));
                xv.y += gt.y * (g.x * __uint_as_float(w0a & 0xffff0000u) + g.y * __uint_as_float(w1a & 0xffff0000u) + g.z * __uint_as_float(w2a & 0xffff0000u) + g.w * __uint_as_float(w3a & 0xffff0000u));
                xv.z += gt.z * (g.x * __uint_as_float(w0b << 16) + g.y * __uint_as_float(w1b << 16) + g.z * __uint_as_float(w2b << 16) + g.w * __uint_as_float(w3b << 16));
                xv.w += gt.w * (g.x * __uint_as_float(w0b & 0xffff0000u) + g.y * __uint_as_float(w1b & 0xffff0000u) + g.z * __uint_as_float(w2b & 0xffff0000u) + g.w * __uint_as_float(w3b & 0xffff0000u));
                *(float4*)(xp + 4 * q) = xv;
            }
        }
    }
}
__device__ __forceinline__ void ph_final(const P& p) {
    const int wave = ltid() >> 6, lane = ltid() & 63;
    for (int row = blockIdx.x * 8 + wave; row < T; row += gridDim.x * 8) {
        const float* xr = p.X + (size_t)row * D;
        float4 v[4]; float ss = 0;
#pragma unroll
        for (int i = 0; i < 4; ++i) { v[i] = *(const float4*)(xr + lane * 4 + 256 * i); ss += v[i].x * v[i].x + v[i].y * v[i].y + v[i].z * v[i].z + v[i].w * v[i].w; }
        ss = wave_sum(ss);
        const float rstd = rsqrtf(ss * (1.f / D) + EPS);
#pragma unroll
        for (int i = 0; i < 4; ++i) {
            const int k = lane * 4 + 256 * i;
            const float4 gg = *(const float4*)(p.g_final + k);
            *(float4*)(p.out + (size_t)row * D + k) = make_float4(v[i].x * rstd * gg.x, v[i].y * rstd * gg.y, v[i].z * rstd * gg.z, v[i].w * rstd * gg.w);
        }
    }
}

extern __shared__ __attribute__((aligned(16))) char smem[];
__global__ void __launch_bounds__(NT, 2) mega(P p) {
    char* lds = smem;
    if (threadIdx.x == 0) *(uint4*)(smem + 131072) = make_uint4(0u, 0u, 0u, 0u);
    __syncthreads();
    XcdBarrier bar = xcd_barrier_post(p.bar, (volatile LAS unsigned*)(smem + 131072));
    ph_prologue(p, lds);
    xcd_barrier(bar);
#pragma unroll
    for (int l = 0; l < 2; ++l) {
        const int nrows = l == 0 ? R : T;
        ph_norm1(p, l);
        xcd_barrier(bar);
        ph_gemm_proj(p, l, lds);
        xcd_barrier(bar);
        ph_rope(p, nrows);
        xcd_barrier(bar);
        ph_dattn(p, l, nrows, lds);
        ph_na(p, l, nrows, lds);
        ph_pool(p, l, nrows, lds);
        ph_sgu(p, l, nrows, lds);
        xcd_barrier(bar);
        ph_gemm_out(p, l, nrows, lds);
        xcd_barrier(bar);
        ph_router(p, l, nrows);
        xcd_barrier(bar);
        ph_assign(p, l, nrows, lds);
        xcd_barrier(bar);
        ph_moe1(p, l, lds);
        xcd_barrier(bar);
        ph_moe2(p, l, lds);
        xcd_barrier(bar);
        ph_combine(p, l, nrows);
        xcd_barrier(bar);
    }
    ph_final(p);
}

static inline size_t align_up(size_t v, size_t a) { return (v + a - 1) / a * a; }

extern "C" void kernel_launch(void* const* d_in, const int* in_sizes, int n_in, void* d_out, int out_size, void* d_ws, size_t ws_size, hipStream_t stream) {
    P p{};
    const float** ins = (const float**)&p.x;
    for (int i = 0; i < 28; ++i) ins[i] = (const float*)d_in[i];
    p.out = (float*)d_out;
    char* w = (char*)d_ws; size_t off = 0;
    auto carve = [&](size_t bytes) { void* r = w + off; off = align_up(off + bytes, 256); return r; };
    const size_t ctl_bytes = XCD_BAR_WORDS * 4 + 2 * 64 * 4;
    p.bar = (unsigned*)carve(ctl_bytes);
    p.cnt = (int*)(p.bar + XCD_BAR_WORDS);
    p.mod = (float*)carve((size_t)2 * 5 * 6144 * 4);
    p.rope = (float*)carve(64 * 8 * 2 * 4);
    p.X = (float*)carve((size_t)R * D * 4);
    p.H = (bf16_t*)carve((size_t)R * D * 2);
    p.PROJ = (bf16_t*)carve((size_t)R * PW * 2);
    p.MIX = (bf16_t*)carve((size_t)R * D * 2);
    p.WinT = (bf16_t*)carve((size_t)2 * PW * D * 2);
    p.WoutT = (bf16_t*)carve((size_t)2 * D * D * 2);
    p.WguT = (bf16_t*)carve((size_t)2 * NE * 2048 * D * 2);
    p.WdnT = (bf16_t*)carve((size_t)2 * NE * D * FF * 2);
    p.topi = (int*)carve((size_t)R * 4 * 4);
    p.topg = (float*)carve((size_t)R * 4 * 4);
    p.tok_slot = (int*)carve((size_t)R * 4 * 4);
    p.moe_meta = (int*)carve(2 * 512 * 4);
    p.HS = (bf16_t*)carve((size_t)NSLOT * D * 2);
    p.ACT = (bf16_t*)carve((size_t)NSLOT * FF * 2);
    p.YB = (bf16_t*)carve((size_t)NSLOT * D * 2);

    static int grid = 0;
    if (!grid) {
        int dev = 0, cus = 0, per_cu = 0;
        (void)hipGetDevice(&dev);
        (void)hipDeviceGetAttribute(&cus, hipDeviceAttributeMultiprocessorCount, dev);
        (void)hipFuncSetAttribute((const void*)mega, hipFuncAttributeMaxDynamicSharedMemorySize, LDS_BYTES);
        (void)hipOccupancyMaxActiveBlocksPerMultiprocessor(&per_cu, mega, NT, LDS_BYTES);
        grid = cus * (per_cu < 1 ? per_cu : 1);
        if (grid <= 0) { fprintf(stderr, "mega: occupancy query returned %d blocks per CU\n", per_cu); grid = 0; return; }
    }
    (void)hipMemsetAsync(p.bar, 0, ctl_bytes, stream);
    mega<<<grid, NT, LDS_BYTES, stream>>>(p);
}
```

```cpp
#include <hip/hip_runtime.h>
#include <stdint.h>
#include <cstdio>

typedef unsigned short bf16_t;
typedef short bf16x8 __attribute__((ext_vector_type(8)));
typedef float f32x4 __attribute__((ext_vector_type(4)));

constexpr int D = 1024, NB = 4, S = 4096, T = NB * S, CL = 256, TC = NB * CL, R = T + TC;
constexpr int PW = 2304, NE = 32, TOPK = 4, FF = 1024;
constexpr int MAXSLOT = R * TOPK;
constexpr int NSLOT = MAXSLOT + NE * 256;
constexpr float EPS = 1e-6f;
constexpr int NT = 512;
constexpr int LDS_MAIN = 150 * 1024;
constexpr int LDS_BYTES = LDS_MAIN + 1024;

__device__ __forceinline__ bf16_t f2bf(float f) { unsigned u = __float_as_uint(f); return (bf16_t)((u + 0x7fffu + ((u >> 16) & 1u)) >> 16); }
__device__ __forceinline__ float bf2f(bf16_t h) { return __uint_as_float(((unsigned)h) << 16); }
__device__ __forceinline__ float wave_sum(float v) {
#pragma unroll
    for (int o = 32; o >= 1; o >>= 1) v += __shfl_xor(v, o);
    return v;
}
__device__ __forceinline__ int mod_row(int row) { return row < T ? (row >> 12) : 4; }

#define XB_TMO      128
#define XB_XCNT(j)  (256  + 64 * (j))
#define XB_XSUB(j)  (1280 + 64 * (j))
#define XB_XGEN(j)  (2304 + 64 * (j))
#define XB_TOP      3328
#define XB_TOPGEN   3392
#define XCD_BAR_WORDS 3456
#define XB_SPIN_CAP (1u << 18)
#define LAS __attribute__((address_space(3)))

__device__ __forceinline__ unsigned xb_ld(unsigned* p)              { return __hip_atomic_load(p, __ATOMIC_RELAXED, __HIP_MEMORY_SCOPE_AGENT); }
__device__ __forceinline__ unsigned xb_add(unsigned* p, unsigned v) { return __hip_atomic_fetch_add(p, v, __ATOMIC_RELAXED, __HIP_MEMORY_SCOPE_AGENT); }
__device__ __forceinline__ unsigned xb_xcc_id() { return (unsigned)__builtin_amdgcn_s_getreg((3 << 11) | 20) & 0xFu; }
#define XB_SPIN(cond, bar) do { unsigned _sp = 0; while (cond) { __builtin_amdgcn_s_sleep(1); \
    if ((++_sp & 255u) == 0u) { if (xb_ld(&(bar)[XB_TMO])) break; if (_sp > XB_SPIN_CAP) { atomicAdd(&(bar)[XB_TMO], 1u); break; } } } } while (0)

struct XcdBarrier {
    unsigned* bar; unsigned x;
    volatile LAS unsigned* st;
};
__device__ __forceinline__ XcdBarrier xcd_barrier_post(unsigned* bar, volatile LAS unsigned* st) {
    XcdBarrier b; b.bar = bar; b.x = xb_xcc_id(); b.st = st;
    if (threadIdx.x == 0) (void)xb_add(&bar[XB_XCNT(b.x)], 1u);
    return b;
}
__device__ __forceinline__ void xcd_barrier_complete(unsigned* bar, unsigned x, unsigned& nloc, unsigned& nx) {
    const unsigned G = gridDim.x * gridDim.y * gridDim.z;
    unsigned sum, cnt, mine, sp = 0u;
    for (;;) {
        sum = 0u; cnt = 0u; mine = 0u;
#pragma unroll
        for (unsigned j = 0; j < 16; ++j) { const unsigned c = xb_ld(&bar[XB_XCNT(j)]); sum += c; cnt += (c > 0u) ? 1u : 0u; mine = (j == x) ? c : mine; }
        if (sum == G) break;
        __builtin_amdgcn_s_sleep(1);
        if ((++sp & 255u) == 0u) { if (xb_ld(&bar[XB_TMO])) break; if (sp > XB_SPIN_CAP) { atomicAdd(&bar[XB_TMO], 1u); break; } }
    }
    nloc = mine > 0u ? mine : 1u; nx = cnt > 0u ? cnt : 1u;
}
__device__ __forceinline__ void xcd_barrier(const XcdBarrier& b) {
    asm volatile("s_waitcnt vmcnt(0)" ::: "memory");
    __syncthreads();
    if (threadIdx.x == 0) {
        unsigned* bar = b.bar;
        __builtin_amdgcn_s_waitcnt(0);
        unsigned nloc = b.st[0], nx = b.st[1];
        if (nloc == 0u) { xcd_barrier_complete(bar, b.x, nloc, nx); b.st[0] = nloc; b.st[1] = nx; }
        const unsigned old = xb_add(&bar[XB_XSUB(b.x)], 1u);
        const unsigned gen = old / nloc;
        if (old + 1u == (gen + 1u) * nloc) {
            __builtin_amdgcn_fence(__ATOMIC_RELEASE, "agent");
            asm volatile("s_waitcnt vmcnt(0)" ::: "memory");
            const unsigned og = xb_add(&bar[XB_TOP], 1u);
            const unsigned tg = og / nx;
            if (og + 1u == (tg + 1u) * nx) xb_add(&bar[XB_TOPGEN], 1u);
            else XB_SPIN(xb_ld(&bar[XB_TOPGEN]) == tg, bar);
            __builtin_amdgcn_fence(__ATOMIC_ACQUIRE, "agent");
            xb_add(&bar[XB_XGEN(b.x)], 1u);
            asm volatile("s_waitcnt vmcnt(0)" ::: "memory");
        } else {
            XB_SPIN(xb_ld(&bar[XB_XGEN(b.x)]) == gen, bar);
            __builtin_amdgcn_fence(__ATOMIC_ACQUIRE, "agent");
            asm volatile("s_waitcnt vmcnt(0)" ::: "memory");
        }
    }
    __syncthreads();
}

struct P {
    const float *x, *c, *ctx, *c_ctx, *w_mod, *b_mod, *g_mix, *g_ffn, *w_in, *w_out, *lam_q1, *lam_k1, *lam_q2, *lam_k2, *g_sub,
        *w_pool, *s_pool, *g_sgu, *w_sgu, *b_sgu, *rpb, *w_router, *b_router, *w_gu, *b_gu, *w_down, *b_down, *g_final;
    float* out;
    unsigned* bar;
    int* cnt;
    float* mod;
    float* rope;
    float* X;
    bf16_t* H;
    bf16_t* PROJ;
    bf16_t* MIX;
    bf16_t* WinT;
    bf16_t* WoutT;
    bf16_t* WguT;
    bf16_t* WdnT;
    bf16_t* WpT;
    bf16_t* WsB;
    int* topi;
    float* topg;
    int* tok_slot;
    int* moe_meta;
    bf16_t* HS;
    bf16_t* ACT;
    bf16_t* YB;
};

__device__ __forceinline__ int ltid() { int t = threadIdx.x; asm volatile("" : "+v"(t)); return t; }
typedef float f32x16 __attribute__((ext_vector_type(16)));
typedef short s16x4 __attribute__((ext_vector_type(4)));
typedef short v4i16_t __attribute__((ext_vector_type(4)));
typedef float f32x2_t __attribute__((ext_vector_type(2)));
typedef __bf16 bf16x2_t __attribute__((ext_vector_type(2)));
typedef __attribute__((address_space(3))) const char* lds_cptr;
typedef unsigned u32x4 __attribute__((ext_vector_type(4)));
__device__ __forceinline__ unsigned cvtpk(float lo, float hi) { f32x2_t v = {lo, hi}; bf16x2_t b = __builtin_convertvector(v, bf16x2_t); return __builtin_bit_cast(unsigned, b); }
__device__ __forceinline__ s16x4 vtr(lds_cptr q) { return __builtin_bit_cast(s16x4, __builtin_amdgcn_ds_read_tr16_b64_v4i16((__attribute__((address_space(3))) v4i16_t*)q)); }
__device__ __forceinline__ float xhalf_max(float v) { auto rr = __builtin_amdgcn_permlane32_swap(__float_as_uint(v), __float_as_uint(v), false, false); return fmaxf(__uint_as_float(rr[0]), __uint_as_float(rr[1])); }
__device__ __forceinline__ float xhalf_sum(float v) { auto rr = __builtin_amdgcn_permlane32_swap(__float_as_uint(v), __float_as_uint(v), false, false); return __uint_as_float(rr[0]) + __uint_as_float(rr[1]); }
namespace pg8 {
#define PG8_LAS __attribute__((address_space(3)))
constexpr int BM = 256, BK = 64, HALF = 128, HTB = HALF * BK * 2  , STAGE_BYTES = 8 * HTB, NXCD = 8, WGM = 8;
__host__ __device__ __forceinline__ int lds_byte(int r, int c) { const int st = (r >> 4) * 2 + (c >> 5), rr = r & 15, cc = c & 31, ob = rr * 64 + cc * 2; return st * 1024 + (ob ^ (((ob >> 9) & 1) << 5)); }
__host__ __device__ __forceinline__ void stage_rc(int b, int& R, int& C) { const int st = b / 1024, sb = b % 1024, swz = sb ^ (((sb >> 9) & 1) << 5); R = (st >> 1) * 16 + swz / 64; C = (st & 1) * 32 + (swz % 64) / 2; }
__host__ __device__ __forceinline__ int perm32(int rho) { const int n = rho >> 4, i = rho & 15; return 8 * (i >> 2) + 4 * n + (i & 3); }
struct Unit { int pm, pn, e; };
struct Gemm { const bf16_t* A; const bf16_t* Bt; int M, N, K; };
struct StaticOrder {
    int nM, nN, nwg, G, c;
    __host__ __device__ void init(int M, int N, int G_, int c_) { nM = M / BM; nN = N / BM; nwg = nM * nN; G = G_; c = c_; }
    __host__ __device__ bool next(int i, Unit& u) const {
        const long L = (long)i * G + c; if (L >= nwg) return false;
        int wgid = (int)L; { const int q = nwg / NXCD, r = nwg % NXCD, xcd = wgid % NXCD, off = wgid / NXCD; wgid = (xcd < r ? xcd * (q + 1) : r * (q + 1) + (xcd - r) * q) + off; }
        const int nig = WGM * nN, gid = wgid / nig, fm = gid * WGM, gsz = (nM - fm) < WGM ? (nM - fm) : WGM;
        u.pm = fm + ((wgid % nig) % gsz); u.pn = (wgid % nig) / gsz; u.e = 0; return true;
    }
    __device__ __forceinline__ const bf16_t* bt(const Gemm& g, const Unit&) const { return g.Bt; }
    __device__ __forceinline__ void a_ready(const Unit&) const {}
    __device__ __forceinline__ void done(const Unit&) const {}
};
template <class Epi, class Sched, bool ALIGN_EPI = false, bool SP2 = false>
__device__ __forceinline__ void gemm_phase(PG8_LAS unsigned char* lds, const Gemm g, const Sched& S, const Epi& E) {
    const int tid = ltid(), wid = __builtin_amdgcn_readfirstlane(tid >> 6), lane = tid & 63, wr = wid >> 2, wc = wid & 3, fr = lane & 15, fq = lane >> 4;
    const int K = g.K, nt = K / BK;
    unsigned voffA[2], voffB[2];
#pragma unroll
    for (int i = 0; i < 2; ++i) { int R, C; stage_rc(tid * 16 + i * 8192, R, C); const int Rb = Epi::PERM ? ((R & ~31) + perm32(R & 31)) : R;
        voffA[i] = (unsigned)(R * K + C) * 2u; voffB[i] = (unsigned)(Rb * K + C) * 2u; }
    const size_t kstep = (size_t)(BK * 2);
    const size_t hstep = (size_t)HALF * K * 2;
    const size_t tstep = 2 * hstep;
    const unsigned ldsw = (unsigned)wid * 1024u;
    const int aoff = lds_byte(wr * 64 + fr, fq * 8), boff = lds_byte(wc * 32 + fr, fq * 8);
#define PG8_SA(b, h) (((b) * 2 + (h)) * HTB)
#define PG8_SB(b, h) ((4 + (b) * 2 + (h)) * HTB)
#define PG8_STAGE(bufoff, gbase, voff) do { _Pragma("unroll") for (int _i = 0; _i < 2; ++_i) \
        __builtin_amdgcn_global_load_lds((const unsigned*)((const char*)(gbase) + (voff)[_i]), (PG8_LAS unsigned*)(lds + (bufoff) + ldsw + _i * 8192), 16, 0, 0); } while (0)
#define PG8_LDA(dst, b, h) do { _Pragma("unroll") for (int m = 0; m < 4; ++m) _Pragma("unroll") for (int k = 0; k < 2; ++k) dst[m][k] = *(const PG8_LAS bf16x8*)(lds + PG8_SA(b, h) + aoff + m * 2048 + k * 1024); } while (0)
#define PG8_LDB(dst, b, h) do { _Pragma("unroll") for (int n = 0; n < 2; ++n) _Pragma("unroll") for (int k = 0; k < 2; ++k) dst[n][k] = *(const PG8_LAS bf16x8*)(lds + PG8_SB(b, h) + boff + n * 2048 + k * 1024); } while (0)
#define PG8_MMA(ai, bj, At, Bt) do { __builtin_amdgcn_s_setprio(1); _Pragma("unroll") for (int m = 0; m < 4; ++m) _Pragma("unroll") for (int n = 0; n < 2; ++n) _Pragma("unroll") for (int k = 0; k < 2; ++k) \
        acc[ai][bj][m][n] = __builtin_amdgcn_mfma_f32_16x16x32_bf16(Bt[n][k], At[m][k], acc[ai][bj][m][n], 0, 0, 0); __builtin_amdgcn_s_setprio(0); } while (0)
#define PG8_WAIT_V(n) asm volatile("s_waitcnt vmcnt(" #n ")" ::: "memory")
#define PG8_WAIT_L(n) asm volatile("s_waitcnt lgkmcnt(" #n ")" ::: "memory")
#define PG8_BAR __builtin_amdgcn_s_barrier()
#define PG8_SCHED __builtin_amdgcn_sched_barrier(0)
    Unit cur, nxt; int ui = 0;
    if (!S.next(0, cur)) return;
    f32x4 acc[2][2][4][2];
#pragma unroll
    for (int a = 0; a < 2; ++a)
#pragma unroll
        for (int b = 0; b < 2; ++b)
#pragma unroll
            for (int m = 0; m < 4; ++m)
#pragma unroll
                for (int n = 0; n < 2; ++n) acc[a][b][m][n] = (f32x4){0.f, 0.f, 0.f, 0.f};
    bf16x8 At[4][2], B0[2][2], B1[2][2];
    const char* cA = (const char*)g.A + (size_t)cur.pm * tstep; const char* cB = (const char*)S.bt(g, cur) + (size_t)cur.pn * tstep;
    S.a_ready(cur);
    if constexpr (SP2) {
        PG8_STAGE(PG8_SB(0, 0), cB, voffB); PG8_STAGE(PG8_SB(0, 1), cB + hstep, voffB); PG8_STAGE(PG8_SA(0, 0), cA, voffA); PG8_STAGE(PG8_SA(0, 1), cA + hstep, voffA);
        if (wr == 1) PG8_BAR;
        PG8_WAIT_V(2); PG8_BAR;
        PG8_STAGE(PG8_SB(1, 0), cB + kstep, voffB); PG8_STAGE(PG8_SA(1, 0), cA + kstep, voffA); PG8_STAGE(PG8_SB(1, 1), cB + hstep + kstep, voffB);
        PG8_WAIT_V(6); PG8_BAR;
    } else {
        PG8_STAGE(PG8_SB(0, 0), cB, voffB); PG8_STAGE(PG8_SA(0, 0), cA, voffA); PG8_STAGE(PG8_SB(0, 1), cB + hstep, voffB); PG8_STAGE(PG8_SA(0, 1), cA + hstep, voffA);
        if (wr == 1) PG8_BAR;
        PG8_WAIT_V(4); PG8_BAR;
        PG8_STAGE(PG8_SB(1, 0), cB + kstep, voffB); PG8_STAGE(PG8_SA(1, 0), cA + kstep, voffA); PG8_STAGE(PG8_SB(1, 1), cB + hstep + kstep, voffB);
        PG8_WAIT_V(6); PG8_BAR;
    }
    for (;;) {
        const bool has_next = S.next(ui + 1, nxt);
        const char* nA = has_next ? (const char*)g.A + (size_t)nxt.pm * tstep : cA; const char* nB = has_next ? (const char*)S.bt(g, nxt) + (size_t)nxt.pn * tstep : cB;
        for (int t = 0; t < nt; t += 2) {
            const bool last = (t == nt - 2);
            const char* a1 = cA + (size_t)(t + 1) * kstep;
            const char* a2 = last ? nA : cA + (size_t)(t + 2) * kstep; const char* b2 = last ? nB : cB + (size_t)(t + 2) * kstep;
            const char* a3 = a2 + kstep; const char* b3 = b2 + kstep;
            if (last && has_next) S.a_ready(nxt);
            if constexpr (SP2) {
            PG8_LDB(B0, 0, 0); PG8_LDB(B1, 0, 1); PG8_SCHED; PG8_LDA(At, 0, 0); PG8_STAGE(PG8_SA(1, 1), a1 + hstep, voffA);
            PG8_WAIT_V(8); PG8_WAIT_L(0); PG8_BAR; PG8_MMA(0, 0, At, B0); PG8_MMA(0, 1, At, B1); PG8_BAR; PG8_SCHED;
            PG8_LDA(At, 0, 1); PG8_STAGE(PG8_SB(0, 0), b2, voffB); PG8_STAGE(PG8_SB(0, 1), b2 + hstep, voffB); PG8_STAGE(PG8_SA(0, 0), a2, voffA);
            PG8_WAIT_V(8); PG8_WAIT_L(0); PG8_BAR; PG8_MMA(1, 0, At, B0); PG8_MMA(1, 1, At, B1); PG8_BAR; PG8_SCHED;
            PG8_LDB(B0, 1, 0); PG8_LDB(B1, 1, 1); PG8_SCHED; PG8_LDA(At, 1, 0); PG8_STAGE(PG8_SA(0, 1), a2 + hstep, voffA);
            PG8_WAIT_V(8); PG8_WAIT_L(0); PG8_BAR; PG8_MMA(0, 0, At, B0); PG8_MMA(0, 1, At, B1); PG8_BAR; PG8_SCHED;
            PG8_LDA(At, 1, 1); PG8_STAGE(PG8_SB(1, 0), b3, voffB); PG8_STAGE(PG8_SB(1, 1), b3 + hstep, voffB); PG8_STAGE(PG8_SA(1, 0), a3, voffA);
            PG8_WAIT_V(8); PG8_WAIT_L(0); PG8_BAR; PG8_MMA(1, 0, At, B0); PG8_MMA(1, 1, At, B1); PG8_BAR; PG8_SCHED;
            } else {
            PG8_LDB(B0, 0, 0); PG8_SCHED; PG8_LDA(At, 0, 0); PG8_STAGE(PG8_SA(1, 1), a1 + hstep, voffA);
            PG8_WAIT_L(8); PG8_BAR; PG8_WAIT_L(0); PG8_MMA(0, 0, At, B0); PG8_BAR; PG8_SCHED;
            PG8_LDB(B1, 0, 1); PG8_STAGE(PG8_SB(0, 0), b2, voffB);
            PG8_BAR; PG8_WAIT_L(0); PG8_MMA(0, 1, At, B1); PG8_BAR;
            PG8_LDA(At, 0, 1); PG8_STAGE(PG8_SA(0, 0), a2, voffA);
            PG8_BAR; PG8_WAIT_L(0); PG8_MMA(1, 0, At, B0); PG8_BAR; PG8_SCHED;
            PG8_STAGE(PG8_SB(0, 1), b2 + hstep, voffB);
            PG8_WAIT_V(6); PG8_BAR; PG8_MMA(1, 1, At, B1); PG8_BAR;
            PG8_LDB(B0, 1, 0); PG8_SCHED; PG8_LDA(At, 1, 0); PG8_STAGE(PG8_SA(0, 1), a2 + hstep, voffA);
            PG8_WAIT_L(8); PG8_BAR; PG8_WAIT_L(0); PG8_MMA(0, 0, At, B0); PG8_BAR; PG8_SCHED;
            PG8_LDB(B1, 1, 1); PG8_STAGE(PG8_SB(1, 0), b3, voffB);
            PG8_BAR; PG8_WAIT_L(0); PG8_MMA(0, 1, At, B1); PG8_BAR;
            PG8_LDA(At, 1, 1); PG8_STAGE(PG8_SA(1, 0), a3, voffA);
            PG8_BAR; PG8_WAIT_L(0); PG8_MMA(1, 0, At, B0); PG8_BAR; PG8_SCHED;
            PG8_STAGE(PG8_SB(1, 1), b3 + hstep, voffB);
            PG8_WAIT_V(6); PG8_BAR; PG8_MMA(1, 1, At, B1); PG8_BAR;
            }
        }
        if constexpr (ALIGN_EPI) { if (wr == 0) PG8_BAR; }
        if constexpr (!Epi::AFTER_DRAIN) { E(acc, cur, wr, wc, fr, fq); S.done(cur); }
        if (!has_next) break;
#pragma unroll
        for (int a = 0; a < 2; ++a)
#pragma unroll
            for (int b = 0; b < 2; ++b)
#pragma unroll
                for (int m = 0; m < 4; ++m)
#pragma unroll
                    for (int n = 0; n < 2; ++n) acc[a][b][m][n] = (f32x4){0.f, 0.f, 0.f, 0.f};
        cur = nxt; cA = nA; cB = nB; ++ui;
        if constexpr (ALIGN_EPI) { if (wr == 1) PG8_BAR; }
    }
    PG8_WAIT_V(0);
    if constexpr (!ALIGN_EPI) { if (wr == 0) PG8_BAR; }
    PG8_BAR;
    if constexpr (Epi::AFTER_DRAIN) { E.fused(acc, cur, wr, wc, fr, fq, lds, wid, lane); S.done(cur); }
#undef PG8_SA
#undef PG8_SB
#undef PG8_STAGE
#undef PG8_LDA
#undef PG8_LDB
#undef PG8_MMA
#undef PG8_WAIT_V
#undef PG8_WAIT_L
#undef PG8_BAR
#undef PG8_SCHED
}
}

__device__ __forceinline__ void transpose_tile(const float* __restrict__ Wm, bf16_t* __restrict__ Wtm, int K, int N, int perm, int tn, int tk, float* tile  ) {
    const int n0 = tn * 64, k0 = tk * 64, tx = ltid() & 63, ty = ltid() >> 6;
    __syncthreads();
    for (int i = ty; i < 64; i += 8) tile[i * 65 + tx] = Wm[(size_t)(k0 + i) * N + n0 + tx];
    __syncthreads();
    for (int i = ty; i < 64; i += 8) {
        const int n = n0 + i;
        const int np = perm ? (n < N / 2 ? 2 * n : 2 * (n - N / 2) + 1) : n;
        Wtm[(size_t)np * K + k0 + tx] = f2bf(tile[tx * 65 + i]);
    }
}
__device__ __forceinline__ void ph_prologue(const P& p, char* lds) {
    const int tid = ltid();
    float* fl = (float*)lds;
    for (int it = blockIdx.x; it < 96; it += gridDim.x) {
        const int l = it / 48, cg = it % 48;
        float* sc = fl;
        float* part = fl + 5 * 1024;
        __syncthreads();
        for (int i = tid; i < 5 * 1024; i += NT) {
            const int r = i >> 10, k = i & 1023;
            const float v = r < 4 ? p.c[r * 1024 + k] : p.c_ctx[k];
            sc[i] = v / (1.f + __expf(-v));
        }
        __syncthreads();
        const int kq = tid >> 7, col = tid & 127, j = cg * 128 + col;
        const float* W = p.w_mod + (size_t)l * 1024 * 6144;
        float a0 = 0, a1 = 0, a2 = 0, a3 = 0, a4 = 0;
        for (int k = kq * 256; k < kq * 256 + 256; ++k) {
            const float w = W[(size_t)k * 6144 + j];
            a0 += sc[k] * w; a1 += sc[1024 + k] * w; a2 += sc[2048 + k] * w; a3 += sc[3072 + k] * w; a4 += sc[4096 + k] * w;
        }
        part[(kq * 5 + 0) * 128 + col] = a0; part[(kq * 5 + 1) * 128 + col] = a1; part[(kq * 5 + 2) * 128 + col] = a2;
        part[(kq * 5 + 3) * 128 + col] = a3; part[(kq * 5 + 4) * 128 + col] = a4;
        __syncthreads();
        for (int i = tid; i < 5 * 128; i += NT) {
            const int r = i >> 7, cc = i & 127, jj = cg * 128 + cc;
            const float v = part[(0 * 5 + r) * 128 + cc] + part[(1 * 5 + r) * 128 + cc] + part[(2 * 5 + r) * 128 + cc] + part[(3 * 5 + r) * 128 + cc];
            p.mod[((size_t)l * 5 + r) * 6144 + jj] = v + p.b_mod[l * 6144 + jj];
        }
    }
    if (blockIdx.x == gridDim.x - 1) {
        const int pos = tid >> 3, f = tid & 7;
        const float inv = powf(10000.0f, -(float)f / 8.0f);
        const float ang = (float)pos * inv;
        p.rope[tid * 2] = cosf(ang); p.rope[tid * 2 + 1] = sinf(ang);
    }
    for (int i = blockIdx.x * NT + tid; i < 2 * 4 * 64 * 64; i += gridDim.x * NT) { const int ii = i & 63, j = (i >> 6) & 63, lg = i >> 12; p.WpT[i] = f2bf(p.w_pool[(size_t)lg * 4096 + ii * 64 + j]); }
    for (int i = blockIdx.x * NT + tid; i < 2 * 4 * 128 * 128; i += gridDim.x * NT) p.WsB[i] = f2bf(p.w_sgu[i]);
    {
        const size_t n4 = (size_t)R * D / 4, t4 = (size_t)T * D / 4;
        const float4* x4 = (const float4*)p.x; const float4* c4 = (const float4*)p.ctx; float4* X4 = (float4*)p.X;
        for (size_t i = (size_t)blockIdx.x * NT + tid; i < n4; i += (size_t)gridDim.x * NT) X4[i] = i < t4 ? x4[i] : c4[i - t4];
    }
    {
        const int n_in = 2 * 36 * 16, n_out = 2 * 16 * 16, n_gu = 64 * 32 * 16, n_dn = 64 * 16 * 16;
        const int total = n_in + n_out + n_gu + n_dn;
        for (int it = blockIdx.x; it < total; it += gridDim.x) {
            int i = it;
            if (i < n_in) { const int m = i / 576, r = i % 576; transpose_tile(p.w_in + (size_t)m * D * PW, p.WinT + (size_t)m * D * PW, D, PW, 0, r % 36, r / 36, fl); continue; }
            i -= n_in;
            if (i < n_out) { const int m = i / 256, r = i % 256; transpose_tile(p.w_out + (size_t)m * D * D, p.WoutT + (size_t)m * D * D, D, D, 0, r % 16, r / 16, fl); continue; }
            i -= n_out;
            if (i < n_gu) { const int m = i / 512, r = i % 512; transpose_tile(p.w_gu + (size_t)m * D * 2048, p.WguT + (size_t)m * D * 2048, D, 2048, 1, r % 32, r / 32, fl); continue; }
            i -= n_gu;
            { const int m = i / 256, r = i % 256; transpose_tile(p.w_down + (size_t)m * FF * D, p.WdnT + (size_t)m * FF * D, FF, D, 0, r % 16, r / 16, fl); }
        }
    }
}

__device__ __forceinline__ void ph_norm1(const P& p, int l) {
    const int wave = ltid() >> 6, lane = ltid() & 63;
    for (int row = blockIdx.x * 8 + wave; row < R; row += gridDim.x * 8) {
        const float* xr = p.X + (size_t)row * D;
        float4 v[4]; float ss = 0;
#pragma unroll
        for (int i = 0; i < 4; ++i) { v[i] = *(const float4*)(xr + lane * 4 + 256 * i); ss += v[i].x * v[i].x + v[i].y * v[i].y + v[i].z * v[i].z + v[i].w * v[i].w; }
        ss = wave_sum(ss);
        const float rstd = rsqrtf(ss * (1.f / D) + EPS);
        const float* m = p.mod + ((size_t)l * 5 + mod_row(row)) * 6144;
        const float* g = p.g_mix + l * D;
#pragma unroll
        for (int i = 0; i < 4; ++i) {
            const int k = lane * 4 + 256 * i;
            const float4 gg = *(const float4*)(g + k), sh = *(const float4*)(m + k), sc = *(const float4*)(m + 1024 + k);
            ushort4 o;
            o.x = f2bf(v[i].x * rstd * gg.x * (1.f + sc.x) + sh.x); o.y = f2bf(v[i].y * rstd * gg.y * (1.f + sc.y) + sh.y);
            o.z = f2bf(v[i].z * rstd * gg.z * (1.f + sc.z) + sh.z); o.w = f2bf(v[i].w * rstd * gg.w * (1.f + sc.w) + sh.w);
            *(ushort4*)(p.H + (size_t)row * D + k) = o;
        }
    }
}

constexpr float QSCALE = 0.17677669529663687f * 1.4426950408889634f;
__device__ __forceinline__ void ph_rope(const P& p, int nrows) {
    for (int idx = blockIdx.x * NT + ltid(); idx < nrows * 256; idx += gridDim.x * NT) {
        const int i = idx & 7, grp = (idx >> 3) & 3, hb = (idx >> 5) & 7, row = idx >> 8;
        if (row >= T && hb >= 4) continue;
        bf16_t* q = p.PROJ + (size_t)row * PW + hb * 64 + grp * 16 + i;
        float x1 = bf2f(q[0]), x2 = bf2f(q[8]);
        if (row < T) {
            const int s = row & 4095, pos = (grp & 1) ? (s & 63) : (s >> 6);
            const float cs = p.rope[(pos * 8 + i) * 2], sn = p.rope[(pos * 8 + i) * 2 + 1];
            const float y1 = x1 * cs - x2 * sn, y2 = x1 * sn + x2 * cs; x1 = y1; x2 = y2;
        }
        if (hb < 4) { x1 *= QSCALE; x2 *= QSCALE; }
        q[0] = f2bf(x1); q[8] = f2bf(x2);
    }
}

__device__ __forceinline__ void dsoftmax(const f32x16& s, float& m, float& l, f32x16& o0, f32x16& o1, bf16x8& pa, bf16x8& pb) {
    float mx = fmaxf(fmaxf(fmaxf(s[0], s[1]), fmaxf(s[2], s[3])), fmaxf(fmaxf(s[4], s[5]), fmaxf(s[6], s[7])));
    mx = fmaxf(mx, fmaxf(fmaxf(fmaxf(s[8], s[9]), fmaxf(s[10], s[11])), fmaxf(fmaxf(s[12], s[13]), fmaxf(s[14], s[15]))));
    mx = xhalf_max(mx);
    if (__any(mx > m)) {
        const float mn = fmaxf(m, mx), alpha = __builtin_amdgcn_exp2f(m - mn);
        o0 *= alpha; o1 *= alpha; l *= alpha; m = mn;
    }
    float pr[16]; float sum = 0.f;
#pragma unroll
    for (int r = 0; r < 16; ++r) { pr[r] = __builtin_amdgcn_exp2f(s[r] - m); sum += pr[r]; }
    l += sum;
    u32x4 a, b;
    a[0] = cvtpk(pr[0], pr[1]); a[1] = cvtpk(pr[2], pr[3]); a[2] = cvtpk(pr[4], pr[5]); a[3] = cvtpk(pr[6], pr[7]);
    b[0] = cvtpk(pr[8], pr[9]); b[1] = cvtpk(pr[10], pr[11]); b[2] = cvtpk(pr[12], pr[13]); b[3] = cvtpk(pr[14], pr[15]);
    pa = __builtin_bit_cast(bf16x8, a); pb = __builtin_bit_cast(bf16x8, b);
}
__device__ __forceinline__ void ph_dattn(const P& p, int l, int nrows, char* lds) {
    const int tid = ltid(), lane = tid & 63, wid = tid >> 6, r32 = lane & 31, hi = lane >> 5;
    float la = lane < 32 ? p.lam_q1[l * 32 + lane] * p.lam_k1[l * 32 + lane] : 0.f;
    float lb = lane < 32 ? p.lam_q2[l * 32 + lane] * p.lam_k2[l * 32 + lane] : 0.f;
    la = wave_sum(la); lb = wave_sum(lb);
    const float lam_init = 0.8f - 0.6f * expf(-0.3f * (float)l);
    const float lam = expf(la) - expf(lb) + lam_init;
    const bf16_t* PR = p.PROJ;
    const int nunits = (nrows == R) ? 256 + 16 : 256;
    const int skey = 8 * wid + (lane & 7), schunk = lane >> 3;
    const int ldsK = schunk * 1024 + skey * 16;
    const int ldsV = 8192 + (schunk >> 2) * 4096 + (skey >> 3) * 512 + (skey & 7) * 64 + (schunk & 3) * 16;
    const int vb = ((lane >> 4) & 1) * 32 + (lane & 3) * 8 + (4 * hi + ((lane & 15) >> 2)) * 64;
    for (int uu = blockIdx.x; uu < nunits; uu += gridDim.x) {
        int b, h, q0, nt; bool isctx;
        if (uu < 256) { const int u = (uu & 7) * 32 + (uu >> 3); b = u >> 6; h = (u >> 4) & 3; q0 = b * 4096 + (u & 15) * 256; nt = 68; isctx = false; }
        else { const int v = uu - 256; b = v >> 2; h = v & 3; q0 = T + b * 256; nt = 4; isctx = true; }
        bf16x8 qf[4];
        {
            const bf16_t* qp = PR + (size_t)(q0 + wid * 32 + r32) * PW + h * 64 + hi * 8;
#pragma unroll
            for (int ks = 0; ks < 4; ++ks) qf[ks] = *(const bf16x8*)(qp + ks * 16);
        }
        f32x16 O00, O01, O10, O11;
#pragma unroll
        for (int r = 0; r < 16; ++r) { O00[r] = 0.f; O01[r] = 0.f; O10[r] = 0.f; O11[r] = 0.f; }
        float m1 = -1e30f, m2 = -1e30f, l1 = 0.f, l2 = 0.f;
        const size_t gK = 256 + h * 64 + schunk * 8, gV = 512 + h * 64 + schunk * 8;
        uint4 rk, rv;
        {
            const int kr = (isctx ? T + b * 256 : b * 4096) + skey;
            rk = *(const uint4*)(PR + (size_t)kr * PW + gK); rv = *(const uint4*)(PR + (size_t)kr * PW + gV);
        }
        __syncthreads();
        *(uint4*)(lds + ldsK) = rk; *(uint4*)(lds + ldsV) = rv;
        __syncthreads();
        for (int t = 0; t < nt; ++t) {
            char* buf = lds + (t & 1) * 16384;
            if (t + 1 < nt) {
                const int tn = t + 1;
                const int kr = ((isctx || tn >= 64) ? T + b * 256 + (isctx ? tn : tn - 64) * 64 : b * 4096 + tn * 64) + skey;
                rk = *(const uint4*)(PR + (size_t)kr * PW + gK); rv = *(const uint4*)(PR + (size_t)kr * PW + gV);
            }
#pragma unroll
            for (int kb = 0; kb < 2; ++kb) {
                const lds_cptr kp = (lds_cptr)buf + hi * 1024 + (kb * 32 + r32) * 16;
                const bf16x8 kf0 = *(const __attribute__((address_space(3))) bf16x8*)(kp);
                const bf16x8 kf1 = *(const __attribute__((address_space(3))) bf16x8*)(kp + 2048);
                const bf16x8 kf2 = *(const __attribute__((address_space(3))) bf16x8*)(kp + 4096);
                const bf16x8 kf3 = *(const __attribute__((address_space(3))) bf16x8*)(kp + 6144);
                f32x16 s1, s2;
#pragma unroll
                for (int r = 0; r < 16; ++r) { s1[r] = 0.f; s2[r] = 0.f; }
                s1 = __builtin_amdgcn_mfma_f32_32x32x16_bf16(kf0, qf[0], s1, 0, 0, 0);
                s1 = __builtin_amdgcn_mfma_f32_32x32x16_bf16(kf1, qf[1], s1, 0, 0, 0);
                s2 = __builtin_amdgcn_mfma_f32_32x32x16_bf16(kf2, qf[2], s2, 0, 0, 0);
                s2 = __builtin_amdgcn_mfma_f32_32x32x16_bf16(kf3, qf[3], s2, 0, 0, 0);
                bf16x8 p1a, p1b, p2a, p2b;
                dsoftmax(s1, m1, l1, O00, O01, p1a, p1b);
                dsoftmax(s2, m2, l2, O10, O11, p2a, p2b);
                const lds_cptr vp = (lds_cptr)buf + 8192 + vb + kb * 2048;
#pragma unroll
                for (int dt = 0; dt < 2; ++dt) {
#pragma unroll
                    for (int ss = 0; ss < 2; ++ss) {
                        const s16x4 lo = vtr(vp + dt * 4096 + ss * 1024), hh = vtr(vp + dt * 4096 + ss * 1024 + 512);
                        const bf16x8 va = (bf16x8){lo[0], lo[1], lo[2], lo[3], hh[0], hh[1], hh[2], hh[3]};
                        if (dt == 0) { O00 = __builtin_amdgcn_mfma_f32_32x32x16_bf16(va, ss ? p1b : p1a, O00, 0, 0, 0); O10 = __builtin_amdgcn_mfma_f32_32x32x16_bf16(va, ss ? p2b : p2a, O10, 0, 0, 0); }
                        else         { O01 = __builtin_amdgcn_mfma_f32_32x32x16_bf16(va, ss ? p1b : p1a, O01, 0, 0, 0); O11 = __builtin_amdgcn_mfma_f32_32x32x16_bf16(va, ss ? p2b : p2a, O11, 0, 0, 0); }
                    }
                }
            }
            if (t + 1 < nt) { char* nb = lds + ((t + 1) & 1) * 16384; *(uint4*)(nb + ldsK) = rk; *(uint4*)(nb + ldsV) = rv; }
            __syncthreads();
        }
        l1 = xhalf_sum(l1); l2 = xhalf_sum(l2);
        const float i1 = 1.f / l1, i2 = lam / l2;
        float ss = 0.f;
#pragma unroll
        for (int r = 0; r < 16; ++r) { O00[r] = O00[r] * i1 - O10[r] * i2; O01[r] = O01[r] * i1 - O11[r] * i2; ss += O00[r] * O00[r] + O01[r] * O01[r]; }
        ss = xhalf_sum(ss);
        const float rstd = rsqrtf(ss * (1.f / 64.f) + EPS) * (1.f - lam_init);
        const float* gs = p.g_sub + l * 64;
        bf16_t* op = p.MIX + (size_t)(q0 + wid * 32 + r32) * D + h * 64;
#pragma unroll
        for (int g4 = 0; g4 < 4; ++g4) {
            const int d = 8 * g4 + 4 * hi;
            const float4 ga = *(const float4*)(gs + d), gb = *(const float4*)(gs + 32 + d);
            uint2 wa, wb;
            wa.x = cvtpk(O00[4 * g4] * rstd * ga.x, O00[4 * g4 + 1] * rstd * ga.y); wa.y = cvtpk(O00[4 * g4 + 2] * rstd * ga.z, O00[4 * g4 + 3] * rstd * ga.w);
            wb.x = cvtpk(O01[4 * g4] * rstd * gb.x, O01[4 * g4 + 1] * rstd * gb.y); wb.y = cvtpk(O01[4 * g4 + 2] * rstd * gb.z, O01[4 * g4 + 3] * rstd * gb.w);
            *(uint2*)(op + d) = wa; *(uint2*)(op + 32 + d) = wb;
        }
    }
}

__device__ __forceinline__ void ph_na(const P& p, int l, int nrows, char* lds) {
    const int tid = ltid(), lane = tid & 63, wid = tid >> 6, r32 = lane & 31, hi = lane >> 5;
    const bf16_t* PR = p.PROJ;
    const int nunits = (nrows == R) ? 256 + 16 : 256;
    const int skey = 8 * wid + (lane & 7), schunk = lane >> 3;
    const int ldsK = schunk * 1024 + skey * 16;
    const int ldsV = 8192 + (schunk >> 2) * 4096 + (skey >> 3) * 512 + (skey & 7) * 64 + (schunk & 3) * 16;
    const int vb = ((lane >> 4) & 1) * 32 + (lane & 3) * 8 + (4 * hi + ((lane & 15) >> 2)) * 64;
    float* btab = (float*)(lds + 32768);
    constexpr float LOG2E = 1.4426950408889634f;
    for (int uu = blockIdx.x; uu < nunits; uu += gridDim.x) {
        int b, h, q0, kr_lo, nlat, rs = 0, rq = 0; bool isctx;
        if (uu < 256) {
            const int u = (uu & 7) * 32 + (uu >> 3); b = u >> 6; h = (u >> 4) & 3; const int rg = u & 15;
            rq = 4 * rg + (wid >> 1); q0 = b * 4096 + rq * 64 + (wid & 1) * 32;
            kr_lo = min(max(4 * rg - 4, 0), 56); const int kr_hi = min(max(4 * rg - 1, 0), 56) + 7; nlat = kr_hi - kr_lo + 1;
            rs = min(max(rq - 4, 0), 56); isctx = false;
        } else { const int v = uu - 256; b = v >> 2; h = v & 3; q0 = T + b * 256 + wid * 32; kr_lo = 0; nlat = 0; isctx = true; }
        const int nt = nlat + 4;
        const int cq = (wid & 1) * 32 + r32, wsc = min(max(cq - 8, 0), 48);
        bf16x8 qf[4];
        {
            const bf16_t* qp = PR + (size_t)(q0 + r32) * PW + 1536 + h * 64 + hi * 8;
#pragma unroll
            for (int ks = 0; ks < 4; ++ks) qf[ks] = *(const bf16x8*)(qp + ks * 16);
        }
        f32x16 O0, O1;
#pragma unroll
        for (int r = 0; r < 16; ++r) { O0[r] = 0.f; O1[r] = 0.f; }
        float m1 = -1e30f, l1 = 0.f;
        const size_t gK = 1792 + h * 64 + schunk * 8, gV = 2048 + h * 64 + schunk * 8;
        uint4 rk, rv;
        {
            const int kr = (nlat ? b * 4096 + kr_lo * 64 : T + b * 256) + skey;
            rk = *(const uint4*)(PR + (size_t)kr * PW + gK); rv = *(const uint4*)(PR + (size_t)kr * PW + gV);
        }
        __syncthreads();
        *(uint4*)(lds + ldsK) = rk; *(uint4*)(lds + ldsV) = rv;
        if (tid < 465) btab[tid] = p.rpb[((size_t)l * 4 + h) * 465 + tid] * LOG2E;
        __syncthreads();
        for (int t = 0; t < nt; ++t) {
            char* buf = lds + (t & 1) * 16384;
            if (t + 1 < nt) {
                const int tn = t + 1;
                const int kr = (tn < nlat ? b * 4096 + (kr_lo + tn) * 64 : T + b * 256 + (tn - nlat) * 64) + skey;
                rk = *(const uint4*)(PR + (size_t)kr * PW + gK); rv = *(const uint4*)(PR + (size_t)kr * PW + gV);
            }
            const bool lat = t < nlat;
            const int krow = kr_lo + t;
            const bool active = !lat || (krow >= rs && krow <= rs + 7);
            if (active) {
                const float* brow = btab + (krow - rq + 7) * 31 + 15 - cq;
#pragma unroll
                for (int kb = 0; kb < 2; ++kb) {
                    const lds_cptr kp = (lds_cptr)buf + hi * 1024 + (kb * 32 + r32) * 16;
                    f32x16 s1;
#pragma unroll
                    for (int r = 0; r < 16; ++r) s1[r] = 0.f;
#pragma unroll
                    for (int ks = 0; ks < 4; ++ks) {
                        const bf16x8 kf = *(const __attribute__((address_space(3))) bf16x8*)(kp + ks * 2048);
                        s1 = __builtin_amdgcn_mfma_f32_32x32x16_bf16(kf, qf[ks], s1, 0, 0, 0);
                    }
                    if (lat) {
#pragma unroll
                        for (int r = 0; r < 16; ++r) {
                            const int kc = 32 * kb + (r & 3) + 8 * (r >> 2) + 4 * hi;
                            const bool ok = (unsigned)(kc - wsc) < 16u;
                            const float bv = brow[ok ? kc : cq];
                            s1[r] = ok ? s1[r] + bv : -INFINITY;
                        }
                    }
                    bf16x8 pa, pb;
                    dsoftmax(s1, m1, l1, O0, O1, pa, pb);
                    const lds_cptr vp = (lds_cptr)buf + 8192 + vb + kb * 2048;
#pragma unroll
                    for (int ss = 0; ss < 2; ++ss) {
                        const s16x4 lo0 = vtr(vp + ss * 1024), hh0 = vtr(vp + ss * 1024 + 512);
                        const s16x4 lo1 = vtr(vp + 4096 + ss * 1024), hh1 = vtr(vp + 4096 + ss * 1024 + 512);
                        const bf16x8 va0 = (bf16x8){lo0[0], lo0[1], lo0[2], lo0[3], hh0[0], hh0[1], hh0[2], hh0[3]};
                        const bf16x8 va1 = (bf16x8){lo1[0], lo1[1], lo1[2], lo1[3], hh1[0], hh1[1], hh1[2], hh1[3]};
                        O0 = __builtin_amdgcn_mfma_f32_32x32x16_bf16(va0, ss ? pb : pa, O0, 0, 0, 0);
                        O1 = __builtin_amdgcn_mfma_f32_32x32x16_bf16(va1, ss ? pb : pa, O1, 0, 0, 0);
                    }
                }
            }
            if (t + 1 < nt) { char* nb = lds + ((t + 1) & 1) * 16384; *(uint4*)(nb + ldsK) = rk; *(uint4*)(nb + ldsV) = rv; }
            __syncthreads();
        }
        l1 = xhalf_sum(l1);
        const float il = 1.f / l1;
        bf16_t* op = p.MIX + (size_t)(q0 + r32) * D + 768 + h * 64;
#pragma unroll
        for (int g4 = 0; g4 < 4; ++g4) {
            const int d = 8 * g4 + 4 * hi;
            uint2 wa, wb;
            wa.x = cvtpk(O0[4 * g4] * il, O0[4 * g4 + 1] * il); wa.y = cvtpk(O0[4 * g4 + 2] * il, O0[4 * g4 + 3] * il);
            wb.x = cvtpk(O1[4 * g4] * il, O1[4 * g4 + 1] * il); wb.y = cvtpk(O1[4 * g4 + 2] * il, O1[4 * g4 + 3] * il);
            *(uint2*)(op + d) = wa; *(uint2*)(op + 32 + d) = wb;
        }
    }
}

__device__ __forceinline__ void ph_pool(const P& p, int l, int nrows, char* lds) {
    const int tid = ltid(), lane = tid & 63, wid = tid >> 6, fr = lane & 15, fq = lane >> 4;
    float* ysh = (float*)lds;
    bf16_t* dsh = (bf16_t*)(lds + 80 * 256 * 4);
    const bf16_t* PR = p.PROJ;
    for (int it = blockIdx.x; it < nrows / 64; it += gridDim.x) {
        const int row0 = it * 64;
        const int L = row0 < T ? 4096 : 256;
        const int t0 = row0 < T ? (row0 & 4095) : ((row0 - T) & 255);
        const int base = row0 - t0;
        __syncthreads();
        for (int c = tid; c < 80 * 32; c += NT) {
            const int rr = c >> 5, ch = (c & 31) * 8, t = t0 - 8 + rr;
            float4 a = make_float4(0.f, 0.f, 0.f, 0.f), b = a;
            if (t >= 0 && t < L) {
                const uint4 raw = *(const uint4*)(PR + (size_t)(base + t) * PW + 768 + ch);
                a = make_float4(__uint_as_float(raw.x << 16), __uint_as_float(raw.x & 0xffff0000u), __uint_as_float(raw.y << 16), __uint_as_float(raw.y & 0xffff0000u));
                b = make_float4(__uint_as_float(raw.z << 16), __uint_as_float(raw.z & 0xffff0000u), __uint_as_float(raw.w << 16), __uint_as_float(raw.w & 0xffff0000u));
            }
            *(float4*)(ysh + rr * 256 + ch) = a; *(float4*)(ysh + rr * 256 + ch + 4) = b;
        }
        __syncthreads();
        {
            const int r = tid >> 3, cg = tid & 7;
            const int g = cg >> 1, w = 2 << g, t = t0 + r;
            const int lo = max(t - w / 2, 0), hi = min(t + w / 2 - 1, L - 1);
            const float inv = 1.f / (float)(hi - lo + 1);
#pragma unroll
            for (int q = 0; q < 8; ++q) {
                const int ch = cg * 32 + q * 4;
                float4 s = make_float4(0.f, 0.f, 0.f, 0.f);
                for (int tt = lo; tt <= hi; ++tt) { const float4 v = *(const float4*)(ysh + (tt - t0 + 8) * 256 + ch); s.x += v.x; s.y += v.y; s.z += v.z; s.w += v.w; }
                const float4 y = *(const float4*)(ysh + (r + 8) * 256 + ch);
                uint2 o; o.x = cvtpk(s.x * inv - y.x, s.y * inv - y.y); o.y = cvtpk(s.z * inv - y.z, s.w * inv - y.w);
                *(uint2*)(dsh + r * 264 + ch) = o;
            }
        }
        __syncthreads();
        {
            const int g = wid >> 1, mb = (wid & 1) * 2;
            const bf16_t* W = p.WpT + ((size_t)l * 4 + g) * 64 * 64;
            f32x4 acc[2][4];
#pragma unroll
            for (int mt = 0; mt < 2; ++mt)
#pragma unroll
                for (int nt = 0; nt < 4; ++nt) acc[mt][nt] = (f32x4){0.f, 0.f, 0.f, 0.f};
#pragma unroll
            for (int ks = 0; ks < 2; ++ks) {
                bf16x8 af[2], bfr[4];
#pragma unroll
                for (int mt = 0; mt < 2; ++mt) af[mt] = *(const bf16x8*)(dsh + ((mb + mt) * 16 + fr) * 264 + g * 64 + ks * 32 + fq * 8);
#pragma unroll
                for (int nt = 0; nt < 4; ++nt) bfr[nt] = *(const bf16x8*)(W + (nt * 16 + fr) * 64 + ks * 32 + fq * 8);
#pragma unroll
                for (int mt = 0; mt < 2; ++mt)
#pragma unroll
                    for (int nt = 0; nt < 4; ++nt) acc[mt][nt] = __builtin_amdgcn_mfma_f32_16x16x32_bf16(bfr[nt], af[mt], acc[mt][nt], 0, 0, 0);
            }
#pragma unroll
            for (int mt = 0; mt < 2; ++mt)
#pragma unroll
                for (int nt = 0; nt < 4; ++nt) {
                    const int row = row0 + (mb + mt) * 16 + fr, j = g * 64 + nt * 16 + fq * 4;
                    const float4 sp = *(const float4*)(p.s_pool + l * 256 + j);
                    uint2 o; o.x = cvtpk(acc[mt][nt][0] * sp.x, acc[mt][nt][1] * sp.y); o.y = cvtpk(acc[mt][nt][2] * sp.z, acc[mt][nt][3] * sp.w);
                    *(uint2*)(p.MIX + (size_t)row * D + 256 + j) = o;
                }
        }
    }
}

__device__ __forceinline__ float gelu_fast(float x) {
    const float u = 0.7978845608028654f * (x + 0.044715f * x * x * x);
    return x / (1.f + __builtin_amdgcn_exp2f(-2.885390081777927f * u));
}
__device__ __forceinline__ void ph_sgu(const P& p, int l, int nrows, char* lds) {
    const int tid = ltid(), lane = tid & 63, wid = tid >> 6, fr = lane & 15, fq = lane >> 4;
    bf16_t* vnT = (bf16_t*)lds;
    float* rstd = (float*)(lds + 128 * 136 * 2);
    const bf16_t* PR = p.PROJ;
    for (int it = blockIdx.x; it < (nrows / 128) * 2; it += gridDim.x) {
        const int chunk = it >> 1, hp = it & 1, row0 = chunk * 128;
        __syncthreads();
        {
            const int t = tid >> 2, qtr = tid & 3;
            const bf16_t* zp = PR + (size_t)(row0 + t) * PW + 1280 + qtr * 64;
            float ss = 0.f;
#pragma unroll
            for (int i = 0; i < 8; ++i) {
                const uint4 raw = *(const uint4*)(zp + i * 8);
                const unsigned w4[4] = {raw.x, raw.y, raw.z, raw.w};
#pragma unroll
                for (int j = 0; j < 4; ++j) { const float a = __uint_as_float(w4[j] << 16), b = __uint_as_float(w4[j] & 0xffff0000u); ss += a * a + b * b; }
            }
            ss += __shfl_xor(ss, 1); ss += __shfl_xor(ss, 2);
            if (qtr == 0) rstd[t] = rsqrtf(ss * (1.f / 256.f) + EPS);
        }
        __syncthreads();
        {
            const int s = tid >> 2, cb = (tid & 3) * 32;
            const bf16_t* zp = PR + (size_t)(row0 + s) * PW + 1280 + hp * 128 + cb;
            const float rs = rstd[s];
            const float* gg = p.g_sgu + l * 256 + hp * 128 + cb;
#pragma unroll
            for (int i = 0; i < 4; ++i) {
                const uint4 raw = *(const uint4*)(zp + i * 8);
                const unsigned w4[4] = {raw.x, raw.y, raw.z, raw.w};
#pragma unroll
                for (int j = 0; j < 4; ++j) {
                    const int c = cb + i * 8 + j * 2;
                    vnT[c * 136 + s] = f2bf(__uint_as_float(w4[j] << 16) * rs * gg[i * 8 + j * 2]);
                    vnT[(c + 1) * 136 + s] = f2bf(__uint_as_float(w4[j] & 0xffff0000u) * rs * gg[i * 8 + j * 2 + 1]);
                }
            }
        }
        __syncthreads();
        {
            const int hl = wid >> 2, g = hp * 2 + hl, mb = (wid & 3) * 2;
            const bf16_t* Wg = p.WsB + ((size_t)l * 4 + g) * 128 * 128;
            f32x4 acc[2][4];
#pragma unroll
            for (int mt = 0; mt < 2; ++mt)
#pragma unroll
                for (int nt = 0; nt < 4; ++nt) acc[mt][nt] = (f32x4){0.f, 0.f, 0.f, 0.f};
#pragma unroll
            for (int ks = 0; ks < 4; ++ks) {
                bf16x8 af[2], bfr[4];
#pragma unroll
                for (int mt = 0; mt < 2; ++mt) af[mt] = *(const bf16x8*)(Wg + ((mb + mt) * 16 + fr) * 128 + ks * 32 + fq * 8);
#pragma unroll
                for (int nt = 0; nt < 4; ++nt) bfr[nt] = *(const bf16x8*)(vnT + (hl * 64 + nt * 16 + fr) * 136 + ks * 32 + fq * 8);
#pragma unroll
                for (int mt = 0; mt < 2; ++mt)
#pragma unroll
                    for (int nt = 0; nt < 4; ++nt) acc[mt][nt] = __builtin_amdgcn_mfma_f32_16x16x32_bf16(bfr[nt], af[mt], acc[mt][nt], 0, 0, 0);
            }
#pragma unroll
            for (int mt = 0; mt < 2; ++mt) {
                const int t = (mb + mt) * 16 + fr;
                const float bias = p.b_sgu[(l * 4 + g) * 128 + t];
#pragma unroll
                for (int nt = 0; nt < 4; ++nt) {
                    const int c = g * 64 + nt * 16 + fq * 4;
                    const uint2 ur = *(const uint2*)(PR + (size_t)(row0 + t) * PW + 1024 + c);
                    const float u0 = __uint_as_float(ur.x << 16), u1 = __uint_as_float(ur.x & 0xffff0000u);
                    const float u2 = __uint_as_float(ur.y << 16), u3 = __uint_as_float(ur.y & 0xffff0000u);
                    uint2 o; o.x = cvtpk(u0 * (acc[mt][nt][0] + bias), u1 * (acc[mt][nt][1] + bias)); o.y = cvtpk(u2 * (acc[mt][nt][2] + bias), u3 * (acc[mt][nt][3] + bias));
                    *(uint2*)(p.MIX + (size_t)(row0 + t) * D + 512 + c) = o;
                }
            }
        }
    }
}

__device__ __forceinline__ void ph_router(const P& p, int l, int nrows, char* lds) {
    const int tid = ltid(), wave = tid >> 6, lane = tid & 63;
    float* wl = (float*)lds;
    float* wsc = (float*)(lds + 1024 * 36 * 4) + wave * 64;
    int* lcnt = (int*)(lds + 1024 * 36 * 4 + 8 * 64 * 4);
    __syncthreads();
    {
        const float* wr = p.w_router + (size_t)l * D * NE;
        for (int i = tid; i < 1024 * 8; i += NT) { const int k = i >> 3, e4 = (i & 7) * 4; *(float4*)(wl + k * 36 + e4) = *(const float4*)(wr + k * 32 + e4); }
        if (tid < 32) lcnt[tid] = 0;
    }
    __syncthreads();
    const float* g = p.g_ffn + l * D;
    const float brt = p.b_router[l * NE + (lane & 31)];
    for (int pr = blockIdx.x * 8 + wave; pr < nrows / 2; pr += gridDim.x * 8) {
        const int ra = 2 * pr;
        const float* xa = p.X + (size_t)ra * D; const float* xb = xa + D;
        float ha[16], hb[16]; float sa = 0.f, sb = 0.f;
#pragma unroll
        for (int i = 0; i < 16; ++i) { ha[i] = xa[lane + 64 * i]; hb[i] = xb[lane + 64 * i]; sa += ha[i] * ha[i]; sb += hb[i] * hb[i]; }
        sa = wave_sum(sa); sb = wave_sum(sb);
        const float rsa = rsqrtf(sa * (1.f / D) + EPS), rsb = rsqrtf(sb * (1.f / D) + EPS);
        const float* m = p.mod + ((size_t)l * 5 + mod_row(ra)) * 6144;
#pragma unroll
        for (int i = 0; i < 16; ++i) {
            const int k = lane + 64 * i;
            const float gs = g[k] * (1.f + m[4 * 1024 + k]), sh = m[3 * 1024 + k];
            ha[i] = ha[i] * rsa * gs + sh; hb[i] = hb[i] * rsb * gs + sh;
            p.H[(size_t)ra * D + k] = f2bf(ha[i]); p.H[(size_t)(ra + 1) * D + k] = f2bf(hb[i]);
        }
        float la[32], lb[32];
#pragma unroll
        for (int e = 0; e < 32; ++e) { la[e] = 0.f; lb[e] = 0.f; }
#pragma unroll
        for (int i = 0; i < 16; ++i) {
            const float* wk = wl + (lane + 64 * i) * 36;
#pragma unroll
            for (int e = 0; e < 32; e += 4) {
                const float4 w = *(const float4*)(wk + e);
                la[e] += ha[i] * w.x; la[e + 1] += ha[i] * w.y; la[e + 2] += ha[i] * w.z; la[e + 3] += ha[i] * w.w;
                lb[e] += hb[i] * w.x; lb[e + 1] += hb[i] * w.y; lb[e + 2] += hb[i] * w.z; lb[e + 3] += hb[i] * w.w;
            }
        }
        float r32v[32];
        {
            const bool up = lane >= 32;
#pragma unroll
            for (int e = 0; e < 32; ++e) { const float keep = up ? lb[e] : la[e], send = up ? la[e] : lb[e]; r32v[e] = keep + __shfl_xor(send, 32); }
        }
        float r16[16], r8[8], r4[4], r2[2];
        { const bool up = (lane & 16) != 0;
#pragma unroll
          for (int e = 0; e < 16; ++e) { const float keep = up ? r32v[e + 16] : r32v[e], send = up ? r32v[e] : r32v[e + 16]; r16[e] = keep + __shfl_xor(send, 16); } }
        { const bool up = (lane & 8) != 0;
#pragma unroll
          for (int e = 0; e < 8; ++e) { const float keep = up ? r16[e + 8] : r16[e], send = up ? r16[e] : r16[e + 8]; r8[e] = keep + __shfl_xor(send, 8); } }
        { const bool up = (lane & 4) != 0;
#pragma unroll
          for (int e = 0; e < 4; ++e) { const float keep = up ? r8[e + 4] : r8[e], send = up ? r8[e] : r8[e + 4]; r4[e] = keep + __shfl_xor(send, 4); } }
        { const bool up = (lane & 2) != 0;
#pragma unroll
          for (int e = 0; e < 2; ++e) { const float keep = up ? r4[e + 2] : r4[e], send = up ? r4[e] : r4[e + 2]; r2[e] = keep + __shfl_xor(send, 2); } }
        float mine;
        { const bool up = (lane & 1) != 0; const float keep = up ? r2[1] : r2[0], send = up ? r2[0] : r2[1]; mine = keep + __shfl_xor(send, 1); }
        wsc[lane] = mine + brt;
        float lg[32];
        {
            const float* wp = wsc + (lane & 32);
#pragma unroll
            for (int e = 0; e < 32; e += 4) { const float4 v = *(const float4*)(wp + e); lg[e] = v.x; lg[e + 1] = v.y; lg[e + 2] = v.z; lg[e + 3] = v.w; }
        }
        unsigned taken = 0u; float tv[4]; int ti[4];
#pragma unroll
        for (int k = 0; k < 4; ++k) {
            float best = -3.0e38f; int bi = 0;
#pragma unroll
            for (int e = 0; e < 32; ++e) { const bool ok = !((taken >> e) & 1u) && (lg[e] > best); best = ok ? lg[e] : best; bi = ok ? e : bi; }
            taken |= 1u << bi; tv[k] = best; ti[k] = bi;
        }
        const float e1 = __expf(tv[1] - tv[0]), e2 = __expf(tv[2] - tv[0]), e3 = __expf(tv[3] - tv[0]);
        const float inv = 1.f / (1.f + e1 + e2 + e3);
        if ((lane & 31) == 0) {
            const int row = ra + (lane >> 5);
            *(int4*)(p.topi + (size_t)row * 4) = make_int4(ti[0], ti[1], ti[2], ti[3]);
            *(float4*)(p.topg + (size_t)row * 4) = make_float4(inv, e1 * inv, e2 * inv, e3 * inv);
            atomicAdd(&lcnt[ti[0]], 1); atomicAdd(&lcnt[ti[1]], 1); atomicAdd(&lcnt[ti[2]], 1); atomicAdd(&lcnt[ti[3]], 1);
        }
    }
    __syncthreads();
    if (tid < 32 && lcnt[tid]) atomicAdd(&p.cnt[l * 64 + tid], lcnt[tid]);
}
__device__ __forceinline__ void ph_assign(const P& p, int l, int nrows, char* lds) {
    int* lcnt = (int*)lds; int* lbase = lcnt + 32; int* pst = lbase + 32; int* slots = pst + 32;
    const int tid = ltid(), wave = tid >> 6, lane = tid & 63;
    int* cnt = p.cnt + l * 64; int* cursor = cnt + 32;
    int* meta = p.moe_meta + l * 512;
    __syncthreads();
    if (tid == 0) { int a = 0; for (int e = 0; e < 32; ++e) { pst[e] = a; a += (cnt[e] + 255) & ~255; } if (blockIdx.x == 0) meta[0] = a >> 8; }
    __syncthreads();
    if (blockIdx.x == 0 && tid < 320) { int e = 0; for (int k = 1; k < 32; ++k) if (tid * 256 >= pst[k]) e = k; meta[1 + tid] = e; }
    for (int it = blockIdx.x; it < nrows / NT; it += gridDim.x) {
        const int row = it * NT + tid;
        __syncthreads();
        if (tid < 32) lcnt[tid] = 0;
        __syncthreads();
        const int4 ti = *(const int4*)(p.topi + (size_t)row * 4);
        const int r0 = atomicAdd(&lcnt[ti.x], 1), r1 = atomicAdd(&lcnt[ti.y], 1), r2 = atomicAdd(&lcnt[ti.z], 1), r3 = atomicAdd(&lcnt[ti.w], 1);
        __syncthreads();
        if (tid < 32) lbase[tid] = pst[tid] + (lcnt[tid] ? atomicAdd(&cursor[tid], lcnt[tid]) : 0);
        __syncthreads();
        const int4 sl = make_int4(lbase[ti.x] + r0, lbase[ti.y] + r1, lbase[ti.z] + r2, lbase[ti.w] + r3);
        *(int4*)(p.tok_slot + (size_t)row * 4) = sl;
        *(int4*)(slots + tid * 4) = sl;
        __syncthreads();
        for (int rr = 0; rr < 64; ++rr) {
            const int lr = wave * 64 + rr;
            const int4 s4 = *(const int4*)(slots + lr * 4);
            const bf16_t* src = p.H + (size_t)(it * NT + lr) * D + lane * 8;
            const uint4 v0 = *(const uint4*)src, v1 = *(const uint4*)(src + 512);
            bf16_t* d0 = p.HS + (size_t)s4.x * D + lane * 8; *(uint4*)d0 = v0; *(uint4*)(d0 + 512) = v1;
            bf16_t* d1 = p.HS + (size_t)s4.y * D + lane * 8; *(uint4*)d1 = v0; *(uint4*)(d1 + 512) = v1;
            bf16_t* d2 = p.HS + (size_t)s4.z * D + lane * 8; *(uint4*)d2 = v0; *(uint4*)(d2 + 512) = v1;
            bf16_t* d3 = p.HS + (size_t)s4.w * D + lane * 8; *(uint4*)d3 = v0; *(uint4*)(d3 + 512) = v1;
        }
    }
}

struct EpiProj {
    static constexpr bool PERM = true, AFTER_DRAIN = false;
    bf16_t* O; const float* rope;
    __device__ __forceinline__ void operator()(const f32x4 (&acc)[2][2][4][2], const pg8::Unit& u, int wr, int wc, int fr, int fq) const {
        const int row0 = u.pm * 256 + wr * 64 + fr, col0 = u.pn * 256 + wc * 32 + 8 * fq;
        const bool do_rope = (u.pn < 2) && (u.pm < T / 256), do_gelu = (u.pn == 4) || (u.pn == 5);
        const float sc = u.pn == 0 ? QSCALE : (u.pn == 6 ? 0.125f * 1.4426950408889634f : 1.f);
        const float sgn = (fq & 1) ? 1.f : -1.f;
#pragma unroll
        for (int ai = 0; ai < 2; ++ai)
#pragma unroll
            for (int m = 0; m < 4; ++m) {
                const int row = row0 + ai * 128 + m * 16;
                bf16_t* rowp = O + (size_t)row * PW + col0;
                f32x4 cs[4];
                if (do_rope) {
                    const int s = row & 4095, pos = (fq >> 1) ? (s & 63) : (s >> 6);
                    const f32x4* rp = (const f32x4*)(rope + pos * 16);
                    cs[0] = rp[0]; cs[1] = rp[1]; cs[2] = rp[2]; cs[3] = rp[3];
                }
#pragma unroll
                for (int bj = 0; bj < 2; ++bj) {
                    f32x4 v0 = acc[ai][bj][m][0], v1 = acc[ai][bj][m][1];
                    if (do_rope) {
                        f32x4 b0, b1;
#pragma unroll
                        for (int j = 0; j < 4; ++j) { b0[j] = __shfl_xor(v0[j], 16); b1[j] = __shfl_xor(v1[j], 16); }
                        v0[0] = v0[0] * cs[0][0] + sgn * b0[0] * cs[0][1]; v0[1] = v0[1] * cs[0][2] + sgn * b0[1] * cs[0][3];
                        v0[2] = v0[2] * cs[1][0] + sgn * b0[2] * cs[1][1]; v0[3] = v0[3] * cs[1][2] + sgn * b0[3] * cs[1][3];
                        v1[0] = v1[0] * cs[2][0] + sgn * b1[0] * cs[2][1]; v1[1] = v1[1] * cs[2][2] + sgn * b1[1] * cs[2][3];
                        v1[2] = v1[2] * cs[3][0] + sgn * b1[2] * cs[3][1]; v1[3] = v1[3] * cs[3][2] + sgn * b1[3] * cs[3][3];
                    }
                    if (do_gelu) {
#pragma unroll
                        for (int j = 0; j < 4; ++j) { v0[j] = gelu_fast(v0[j]); v1[j] = gelu_fast(v1[j]); }
                    }
                    v0 = v0 * sc; v1 = v1 * sc;
                    u32x4 w; w.x = cvtpk(v0[0], v0[1]); w.y = cvtpk(v0[2], v0[3]); w.z = cvtpk(v1[0], v1[1]); w.w = cvtpk(v1[2], v1[3]);
                    *(u32x4*)(rowp + bj * 128) = w;
                }
            }
    }
};
struct EpiOut {
    static constexpr bool PERM = false, AFTER_DRAIN = false;
    float* X; const float* gate;
    __device__ __forceinline__ void operator()(const f32x4 (&acc)[2][2][4][2], const pg8::Unit& u, int wr, int wc, int fr, int fq) const {
        const int row0 = u.pm * 256 + wr * 64 + fr, col0 = u.pn * 256 + wc * 32 + 4 * fq;
        const float* g = gate + (size_t)mod_row(u.pm * 256) * 6144 + col0;
        f32x4 gv[2][2];
#pragma unroll
        for (int bj = 0; bj < 2; ++bj)
#pragma unroll
            for (int n = 0; n < 2; ++n) gv[bj][n] = *(const f32x4*)(g + bj * 128 + n * 16);
#pragma unroll
        for (int ai = 0; ai < 2; ++ai)
#pragma unroll
            for (int m = 0; m < 4; ++m) { float* xp = X + (size_t)(row0 + ai * 128 + m * 16) * D + col0;
#pragma unroll
                for (int bj = 0; bj < 2; ++bj)
#pragma unroll
                    for (int n = 0; n < 2; ++n) { f32x4* q = (f32x4*)(xp + bj * 128 + n * 16); *q = *q + gv[bj][n] * acc[ai][bj][m][n]; } }
    }
};
__device__ __forceinline__ float swiglu(float g, float u) {
    const float gt = fminf(g, 7.0f), up = fminf(fmaxf(u, -7.0f), 7.0f);
    return (up + 1.0f) * gt / (1.0f + __expf(-1.702f * gt));
}
struct EpiAct {
    static constexpr bool PERM = true, AFTER_DRAIN = false;
    bf16_t* ACT; const float* bgu;
    __device__ __forceinline__ void operator()(const f32x4 (&acc)[2][2][4][2], const pg8::Unit& u, int wr, int wc, int fr, int fq) const {
        const int row0 = u.pm * 256 + wr * 64 + fr, j0 = (u.pn * 256 + wc * 32 + 8 * fq) >> 1;
        const float* bp = bgu + (size_t)u.e * 2048 + j0;
        f32x4 bg[2], bu[2];
#pragma unroll
        for (int bj = 0; bj < 2; ++bj) { bg[bj] = *(const f32x4*)(bp + bj * 64); bu[bj] = *(const f32x4*)(bp + 1024 + bj * 64); }
#pragma unroll
        for (int ai = 0; ai < 2; ++ai)
#pragma unroll
            for (int m = 0; m < 4; ++m) { bf16_t* rowp = ACT + (size_t)(row0 + ai * 128 + m * 16) * FF + j0;
#pragma unroll
                for (int bj = 0; bj < 2; ++bj) { const f32x4 v0 = acc[ai][bj][m][0], v1 = acc[ai][bj][m][1];
                    const float a0 = swiglu(v0[0] + bg[bj][0], v0[1] + bu[bj][0]), a1 = swiglu(v0[2] + bg[bj][1], v0[3] + bu[bj][1]);
                    const float a2 = swiglu(v1[0] + bg[bj][2], v1[1] + bu[bj][2]), a3 = swiglu(v1[2] + bg[bj][3], v1[3] + bu[bj][3]);
                    uint2 w; w.x = cvtpk(a0, a1); w.y = cvtpk(a2, a3);
                    *(uint2*)(rowp + bj * 64) = w; } }
    }
};
struct EpiYB {
    static constexpr bool PERM = true, AFTER_DRAIN = false;
    bf16_t* YB; const float* bdn;
    __device__ __forceinline__ void operator()(const f32x4 (&acc)[2][2][4][2], const pg8::Unit& u, int wr, int wc, int fr, int fq) const {
        const int row0 = u.pm * 256 + wr * 64 + fr, col0 = u.pn * 256 + wc * 32 + 8 * fq;
        const float* bp = bdn + (size_t)u.e * D + col0;
        f32x4 bv[2][2];
#pragma unroll
        for (int bj = 0; bj < 2; ++bj)
#pragma unroll
            for (int n = 0; n < 2; ++n) bv[bj][n] = *(const f32x4*)(bp + bj * 128 + n * 4);
#pragma unroll
        for (int ai = 0; ai < 2; ++ai)
#pragma unroll
            for (int m = 0; m < 4; ++m) { bf16_t* rowp = YB + (size_t)(row0 + ai * 128 + m * 16) * D + col0;
#pragma unroll
                for (int bj = 0; bj < 2; ++bj) { const f32x4 v0 = acc[ai][bj][m][0] + bv[bj][0], v1 = acc[ai][bj][m][1] + bv[bj][1];
                    u32x4 w; w.x = cvtpk(v0[0], v0[1]); w.y = cvtpk(v0[2], v0[3]); w.z = cvtpk(v1[0], v1[1]); w.w = cvtpk(v1[2], v1[3]);
                    *(u32x4*)(rowp + bj * 128) = w; } }
    }
};
struct MoeOrder {
    int nN, nunits, G, v; const int* tile_e;
    __device__ void init(int ntiles, int nN_, int G_, int c, const int* te) { nN = nN_; nunits = ntiles * nN_; G = G_; v = (G_ % 8 == 0) ? (c % 8) * (G_ / 8) + c / 8 : c; tile_e = te; }
    __device__ bool next(int i, pg8::Unit& u) const {
        const int L = i * G + v; if (L >= nunits) return false;
        u.pm = L / nN; u.pn = L % nN; u.e = tile_e[u.pm]; return true;
    }
    __device__ __forceinline__ const bf16_t* bt(const pg8::Gemm& g, const pg8::Unit& u) const { return g.Bt + (size_t)u.e * g.N * g.K; }
    __device__ __forceinline__ void a_ready(const pg8::Unit&) const {}
    __device__ __forceinline__ void done(const pg8::Unit&) const {}
};

__device__ __forceinline__ void ph_gemm_proj(const P& p, int l, char* lds) {
    pg8::Gemm g{p.H, p.WinT + (size_t)l * PW * D, R, PW, D}; pg8::StaticOrder S; S.init(R, PW, (int)gridDim.x, (int)blockIdx.x);
    EpiProj E{p.PROJ, p.rope};
    pg8::gemm_phase<EpiProj, pg8::StaticOrder, true, true>((PG8_LAS unsigned char*)lds, g, S, E);
}
__device__ __forceinline__ void ph_gemm_out(const P& p, int l, int nrows, char* lds) {
    pg8::Gemm g{p.MIX, p.WoutT + (size_t)l * D * D, nrows, D, D}; pg8::StaticOrder S; S.init(nrows, D, (int)gridDim.x, (int)blockIdx.x);
    EpiOut E{p.X, p.mod + (size_t)l * 5 * 6144 + 2 * 1024};
    pg8::gemm_phase<EpiOut, pg8::StaticOrder, true, true>((PG8_LAS unsigned char*)lds, g, S, E);
}
__device__ __forceinline__ void ph_moe1(const P& p, int l, char* lds) {
    const int* meta = p.moe_meta + l * 512;
    const int ntiles = meta[0];
    pg8::Gemm g{p.HS, p.WguT + (size_t)l * NE * 2048 * D, ntiles * 256, 2048, D}; MoeOrder S; S.init(ntiles, 8, (int)gridDim.x, (int)blockIdx.x, meta + 1);
    EpiAct E{p.ACT, p.b_gu + (size_t)l * NE * 2048};
    pg8::gemm_phase<EpiAct, MoeOrder, true, true>((PG8_LAS unsigned char*)lds, g, S, E);
}
__device__ __forceinline__ void ph_moe2(const P& p, int l, char* lds) {
    const int* meta = p.moe_meta + l * 512;
    const int ntiles = meta[0];
    pg8::Gemm g{p.ACT, p.WdnT + (size_t)l * NE * D * FF, ntiles * 256, D, FF}; MoeOrder S; S.init(ntiles, 4, (int)gridDim.x, (int)blockIdx.x, meta + 1);
    EpiYB E{p.YB, p.b_down + (size_t)l * NE * D};
    pg8::gemm_phase<EpiYB, MoeOrder, true, true>((PG8_LAS unsigned char*)lds, g, S, E);
}
__device__ __forceinline__ void ph_combine(const P& p, int l, int nrows) {
    const int wave = ltid() >> 6, lane = ltid() & 63;
    for (int row = blockIdx.x * 8 + wave; row < nrows; row += gridDim.x * 8) {
        const int4 sl = *(const int4*)(p.tok_slot + (size_t)row * 4);
        const float4 g = *(const float4*)(p.topg + (size_t)row * 4);
        const float* m = p.mod + ((size_t)l * 5 + mod_row(row)) * 6144 + 5 * 1024;
#pragma unroll
        for (int i = 0; i < 2; ++i) {
            const int k = lane * 8 + 512 * i;
            const uint4 y0 = *(const uint4*)(p.YB + (size_t)sl.x * D + k), y1 = *(const uint4*)(p.YB + (size_t)sl.y * D + k);
            const uint4 y2 = *(const uint4*)(p.YB + (size_t)sl.z * D + k), y3 = *(const uint4*)(p.YB + (size_t)sl.w * D + k);
            const unsigned a0[4] = {y0.x, y0.y, y0.z, y0.w}, a1[4] = {y1.x, y1.y, y1.z, y1.w}, a2[4] = {y2.x, y2.y, y2.z, y2.w}, a3[4] = {y3.x, y3.y, y3.z, y3.w};
            float* xp = p.X + (size_t)row * D + k;
#pragma unroll
            for (int q = 0; q < 2; ++q) {
                const float4 gt = *(const float4*)(m + k + 4 * q);
                float4 xv = *(const float4*)(xp + 4 * q);
                const unsigned w0a = a0[2 * q], w0b = a0[2 * q + 1], w1a = a1[2 * q], w1b = a1[2 * q + 1], w2a = a2[2 * q], w2b = a2[2 * q + 1], w3a = a3[2 * q], w3b = a3[2 * q + 1];
                xv.x += gt.x * (g.x * __uint_as_float(w0a << 16) + g.y * __uint_as_float(w1a << 16) + g.z * __uint_as_float(w2a << 16) + g.w * __uint_as_float(w3a << 16));
                xv.y += gt.y * (g.x * __uint_as_float(w0a & 0xffff0000u) + g.y * __uint_as_float(w1a & 0xffff0000u) + g.z * __uint_as_float(w2a & 0xffff0000u) + g.w * __uint_as_float(w3a & 0xffff0000u));
                xv.z += gt.z * (g.x * __uint_as_float(w0b << 16) + g.y * __uint_as_float(w1b << 16) + g.z * __uint_as_float(w2b << 16) + g.w * __uint_as_float(w3b << 16));
                xv.w += gt.w * (g.x * __uint_as_float(w0b & 0xffff0000u) + g.y * __uint_as_float(w1b & 0xffff0000u) + g.z * __uint_as_float(w2b & 0xffff0000u) + g.w * __uint_as_float(w3b & 0xffff0000u));
                *(float4*)(xp + 4 * q) = xv;
            }
        }
    }
}
__device__ __forceinline__ void ph_final(const P& p) {
    const int wave = ltid() >> 6, lane = ltid() & 63;
    for (int row = blockIdx.x * 8 + wave; row < T; row += gridDim.x * 8) {
        const float* xr = p.X + (size_t)row * D;
        float4 v[4]; float ss = 0;
#pragma unroll
        for (int i = 0; i < 4; ++i) { v[i] = *(const float4*)(xr + lane * 4 + 256 * i); ss += v[i].x * v[i].x + v[i].y * v[i].y + v[i].z * v[i].z + v[i].w * v[i].w; }
        ss = wave_sum(ss);
        const float rstd = rsqrtf(ss * (1.f / D) + EPS);
#pragma unroll
        for (int i = 0; i < 4; ++i) {
            const int k = lane * 4 + 256 * i;
            const float4 gg = *(const float4*)(p.g_final + k);
            *(float4*)(p.out + (size_t)row * D + k) = make_float4(v[i].x * rstd * gg.x, v[i].y * rstd * gg.y, v[i].z * rstd * gg.z, v[i].w * rstd * gg.w);
        }
    }
}

#ifndef PROBE_DUP
#define PROBE_DUP 0
#endif
extern __shared__ __attribute__((aligned(16))) char smem[];
__global__ void __launch_bounds__(NT, 2) mega(P p) {
    char* lds = smem;
    if (threadIdx.x == 0) *(uint4*)(smem + LDS_MAIN) = make_uint4(0u, 0u, 0u, 0u);
    __syncthreads();
    XcdBarrier bar = xcd_barrier_post(p.bar, (volatile LAS unsigned*)(smem + LDS_MAIN));
    ph_prologue(p, lds);
    if (PROBE_DUP == 1) ph_prologue(p, lds);
    xcd_barrier(bar);
#pragma unroll
    for (int l = 0; l < 2; ++l) {
        const int nrows = l == 0 ? R : T;
        ph_norm1(p, l);
        if (PROBE_DUP == 5) ph_norm1(p, l);
        xcd_barrier(bar);
        ph_gemm_proj(p, l, lds);
        if (PROBE_DUP == 4) ph_gemm_proj(p, l, lds);
        xcd_barrier(bar);
        ph_dattn(p, l, nrows, lds);
        if (PROBE_DUP == 2) ph_dattn(p, l, nrows, lds);
        ph_na(p, l, nrows, lds);
        if (PROBE_DUP == 5) ph_na(p, l, nrows, lds);
        ph_pool(p, l, nrows, lds);
        ph_sgu(p, l, nrows, lds);
        if (PROBE_DUP == 3) { ph_pool(p, l, nrows, lds); ph_sgu(p, l, nrows, lds); }
        xcd_barrier(bar);
        ph_gemm_out(p, l, nrows, lds);
        xcd_barrier(bar);
        ph_router(p, l, nrows, lds);
        xcd_barrier(bar);
        ph_assign(p, l, nrows, lds);
        xcd_barrier(bar);
        ph_moe1(p, l, lds);
        if (PROBE_DUP == 4) ph_moe1(p, l, lds);
        xcd_barrier(bar);
        ph_moe2(p, l, lds);
        if (PROBE_DUP == 4) ph_moe2(p, l, lds);
        xcd_barrier(bar);
        ph_combine(p, l, nrows);
        xcd_barrier(bar);
    }
    ph_final(p);
}

static inline size_t align_up(size_t v, size_t a) { return (v + a - 1) / a * a; }

extern "C" void kernel_launch(void* const* d_in, const int* in_sizes, int n_in, void* d_out, int out_size, void* d_ws, size_t ws_size, hipStream_t stream) {
    P p{};
    const float** ins = (const float**)&p.x;
    for (int i = 0; i < 28; ++i) ins[i] = (const float*)d_in[i];
    p.out = (float*)d_out;
    char* w = (char*)d_ws; size_t off = 0;
    auto carve = [&](size_t bytes) { void* r = w + off; off = align_up(off + bytes, 256); return r; };
    const size_t ctl_bytes = XCD_BAR_WORDS * 4 + 2 * 64 * 4;
    p.bar = (unsigned*)carve(ctl_bytes);
    p.cnt = (int*)(p.bar + XCD_BAR_WORDS);
    p.mod = (float*)carve((size_t)2 * 5 * 6144 * 4);
    p.rope = (float*)carve(64 * 8 * 2 * 4);
    p.X = (float*)carve((size_t)R * D * 4);
    p.H = (bf16_t*)carve((size_t)R * D * 2);
    p.PROJ = (bf16_t*)carve((size_t)R * PW * 2);
    p.MIX = (bf16_t*)carve((size_t)R * D * 2);
    p.WinT = (bf16_t*)carve((size_t)2 * PW * D * 2);
    p.WoutT = (bf16_t*)carve((size_t)2 * D * D * 2);
    p.WguT = (bf16_t*)carve((size_t)2 * NE * 2048 * D * 2);
    p.WdnT = (bf16_t*)carve((size_t)2 * NE * D * FF * 2);
    p.WpT = (bf16_t*)carve((size_t)2 * 4 * 64 * 64 * 2);
    p.WsB = (bf16_t*)carve((size_t)2 * 4 * 128 * 128 * 2);
    p.topi = (int*)carve((size_t)R * 4 * 4);
    p.topg = (float*)carve((size_t)R * 4 * 4);
    p.tok_slot = (int*)carve((size_t)R * 4 * 4);
    p.moe_meta = (int*)carve(2 * 512 * 4);
    p.HS = (bf16_t*)carve((size_t)NSLOT * D * 2);
    p.ACT = (bf16_t*)carve((size_t)NSLOT * FF * 2);
    p.YB = (bf16_t*)carve((size_t)NSLOT * D * 2);

    static int grid = 0;
    if (!grid) {
        int dev = 0, cus = 0, per_cu = 0;
        (void)hipGetDevice(&dev);
        (void)hipDeviceGetAttribute(&cus, hipDeviceAttributeMultiprocessorCount, dev);
        (void)hipFuncSetAttribute((const void*)mega, hipFuncAttributeMaxDynamicSharedMemorySize, LDS_BYTES);
        (void)hipOccupancyMaxActiveBlocksPerMultiprocessor(&per_cu, mega, NT, LDS_BYTES);
        grid = cus * (per_cu < 1 ? per_cu : 1);
        if (grid <= 0) { fprintf(stderr, "mega: occupancy query returned %d blocks per CU\n", per_cu); grid = 0; return; }
    }
    (void)hipMemsetAsync(p.bar, 0, ctl_bytes, stream);
    mega<<<grid, NT, LDS_BYTES, stream>>>(p);
}
```

```cpp
#include <hip/hip_runtime.h>
#include <stdint.h>
#include <cstdio>

typedef unsigned short bf16_t;
typedef short bf16x8 __attribute__((ext_vector_type(8)));
typedef float f32x4 __attribute__((ext_vector_type(4)));

constexpr int D = 1024, NB = 4, S = 4096, T = NB * S, CL = 256, TC = NB * CL, R = T + TC;
constexpr int PW = 2304, NE = 32, TOPK = 4, FF = 1024;
constexpr int MAXSLOT = R * TOPK;
constexpr int NSLOT = MAXSLOT + NE * 256;
constexpr float EPS = 1e-6f;
constexpr int NT = 512;
constexpr int LDS_MAIN = 150 * 1024;
constexpr int LDS_BYTES = LDS_MAIN + 1024;

__device__ __forceinline__ bf16_t f2bf(float f) { unsigned u = __float_as_uint(f); return (bf16_t)((u + 0x7fffu + ((u >> 16) & 1u)) >> 16); }
__device__ __forceinline__ float bf2f(bf16_t h) { return __uint_as_float(((unsigned)h) << 16); }
__device__ __forceinline__ float wave_sum(float v) {
#pragma unroll
    for (int o = 32; o >= 1; o >>= 1) v += __shfl_xor(v, o);
    return v;
}
__device__ __forceinline__ int mod_row(int row) { return row < T ? (row >> 12) : 4; }

#define XB_TMO      128
#define XB_XCNT(j)  (256  + 64 * (j))
#define XB_XSUB(j)  (1280 + 64 * (j))
#define XB_XGEN(j)  (2304 + 64 * (j))
#define XB_TOP      3328
#define XB_TOPGEN   3392
#define XCD_BAR_WORDS 3456
#define XB_SPIN_CAP (1u << 18)
#define LAS __attribute__((address_space(3)))

__device__ __forceinline__ unsigned xb_ld(unsigned* p)              { return __hip_atomic_load(p, __ATOMIC_RELAXED, __HIP_MEMORY_SCOPE_AGENT); }
__device__ __forceinline__ unsigned xb_add(unsigned* p, unsigned v) { return __hip_atomic_fetch_add(p, v, __ATOMIC_RELAXED, __HIP_MEMORY_SCOPE_AGENT); }
__device__ __forceinline__ unsigned xb_xcc_id() { return (unsigned)__builtin_amdgcn_s_getreg((3 << 11) | 20) & 0xFu; }
#define XB_SPIN(cond, bar) do { unsigned _sp = 0; while (cond) { __builtin_amdgcn_s_sleep(1); \
    if ((++_sp & 255u) == 0u) { if (xb_ld(&(bar)[XB_TMO])) break; if (_sp > XB_SPIN_CAP) { atomicAdd(&(bar)[XB_TMO], 1u); break; } } } } while (0)

struct XcdBarrier {
    unsigned* bar; unsigned x;
    volatile LAS unsigned* st;
};
__device__ __forceinline__ XcdBarrier xcd_barrier_post(unsigned* bar, volatile LAS unsigned* st) {
    XcdBarrier b; b.bar = bar; b.x = xb_xcc_id(); b.st = st;
    if (threadIdx.x == 0) (void)xb_add(&bar[XB_XCNT(b.x)], 1u);
    return b;
}
__device__ __forceinline__ void xcd_barrier_complete(unsigned* bar, unsigned x, unsigned& nloc, unsigned& nx) {
    const unsigned G = gridDim.x * gridDim.y * gridDim.z;
    unsigned sum, cnt, mine, sp = 0u;
    for (;;) {
        sum = 0u; cnt = 0u; mine = 0u;
#pragma unroll
        for (unsigned j = 0; j < 16; ++j) { const unsigned c = xb_ld(&bar[XB_XCNT(j)]); sum += c; cnt += (c > 0u) ? 1u : 0u; mine = (j == x) ? c : mine; }
        if (sum == G) break;
        __builtin_amdgcn_s_sleep(1);
        if ((++sp & 255u) == 0u) { if (xb_ld(&bar[XB_TMO])) break; if (sp > XB_SPIN_CAP) { atomicAdd(&bar[XB_TMO], 1u); break; } }
    }
    nloc = mine > 0u ? mine : 1u; nx = cnt > 0u ? cnt : 1u;
}
__device__ __forceinline__ void xcd_barrier(const XcdBarrier& b) {
    asm volatile("s_waitcnt vmcnt(0)" ::: "memory");
    __syncthreads();
    if (threadIdx.x == 0) {
        unsigned* bar = b.bar;
        __builtin_amdgcn_s_waitcnt(0);
        unsigned nloc = b.st[0], nx = b.st[1];
        if (nloc == 0u) { xcd_barrier_complete(bar, b.x, nloc, nx); b.st[0] = nloc; b.st[1] = nx; }
        const unsigned old = xb_add(&bar[XB_XSUB(b.x)], 1u);
        const unsigned gen = old / nloc;
        if (old + 1u == (gen + 1u) * nloc) {
            __builtin_amdgcn_fence(__ATOMIC_RELEASE, "agent");
            asm volatile("s_waitcnt vmcnt(0)" ::: "memory");
            const unsigned og = xb_add(&bar[XB_TOP], 1u);
            const unsigned tg = og / nx;
            if (og + 1u == (tg + 1u) * nx) xb_add(&bar[XB_TOPGEN], 1u);
            else XB_SPIN(xb_ld(&bar[XB_TOPGEN]) == tg, bar);
            __builtin_amdgcn_fence(__ATOMIC_ACQUIRE, "agent");
            xb_add(&bar[XB_XGEN(b.x)], 1u);
            asm volatile("s_waitcnt vmcnt(0)" ::: "memory");
        } else {
            XB_SPIN(xb_ld(&bar[XB_XGEN(b.x)]) == gen, bar);
            __builtin_amdgcn_fence(__ATOMIC_ACQUIRE, "agent");
            asm volatile("s_waitcnt vmcnt(0)" ::: "memory");
        }
    }
    __syncthreads();
}

struct P {
    const float *x, *c, *ctx, *c_ctx, *w_mod, *b_mod, *g_mix, *g_ffn, *w_in, *w_out, *lam_q1, *lam_k1, *lam_q2, *lam_k2, *g_sub,
        *w_pool, *s_pool, *g_sgu, *w_sgu, *b_sgu, *rpb, *w_router, *b_router, *w_gu, *b_gu, *w_down, *b_down, *g_final;
    float* out;
    unsigned* bar;
    int* cnt;
    float* mod;
    float* rope;
    float* X;
    bf16_t* H;
    bf16_t* PROJ;
    bf16_t* MIX;
    bf16_t* WinT;
    bf16_t* WoutT;
    bf16_t* WguT;
    bf16_t* WdnT;
    bf16_t* WpT;
    bf16_t* WsB;
    int* topi;
    float* topg;
    int* tok_slot;
    int* moe_meta;
    bf16_t* HS;
    bf16_t* ACT;
    bf16_t* YB;
};

__device__ __forceinline__ int ltid() { int t = threadIdx.x; asm volatile("" : "+v"(t)); return t; }
typedef float f32x16 __attribute__((ext_vector_type(16)));
typedef short s16x4 __attribute__((ext_vector_type(4)));
typedef short v4i16_t __attribute__((ext_vector_type(4)));
typedef float f32x2_t __attribute__((ext_vector_type(2)));
typedef __bf16 bf16x2_t __attribute__((ext_vector_type(2)));
typedef __attribute__((address_space(3))) const char* lds_cptr;
typedef unsigned u32x4 __attribute__((ext_vector_type(4)));
__device__ __forceinline__ unsigned cvtpk(float lo, float hi) { f32x2_t v = {lo, hi}; bf16x2_t b = __builtin_convertvector(v, bf16x2_t); return __builtin_bit_cast(unsigned, b); }
__device__ __forceinline__ s16x4 vtr(lds_cptr q) { return __builtin_bit_cast(s16x4, __builtin_amdgcn_ds_read_tr16_b64_v4i16((__attribute__((address_space(3))) v4i16_t*)q)); }
__device__ __forceinline__ float xhalf_max(float v) { auto rr = __builtin_amdgcn_permlane32_swap(__float_as_uint(v), __float_as_uint(v), false, false); return fmaxf(__uint_as_float(rr[0]), __uint_as_float(rr[1])); }
__device__ __forceinline__ float xhalf_sum(float v) { auto rr = __builtin_amdgcn_permlane32_swap(__float_as_uint(v), __float_as_uint(v), false, false); return __uint_as_float(rr[0]) + __uint_as_float(rr[1]); }
namespace pg8 {
#define PG8_LAS __attribute__((address_space(3)))
constexpr int BM = 256, BK = 64, HALF = 128, HTB = HALF * BK * 2  , STAGE_BYTES = 8 * HTB, NXCD = 8, WGM = 8;
__host__ __device__ __forceinline__ int lds_byte(int r, int c) { const int st = (r >> 4) * 2 + (c >> 5), rr = r & 15, cc = c & 31, ob = rr * 64 + cc * 2; return st * 1024 + (ob ^ (((ob >> 9) & 1) << 5)); }
__host__ __device__ __forceinline__ void stage_rc(int b, int& R, int& C) { const int st = b / 1024, sb = b % 1024, swz = sb ^ (((sb >> 9) & 1) << 5); R = (st >> 1) * 16 + swz / 64; C = (st & 1) * 32 + (swz % 64) / 2; }
__host__ __device__ __forceinline__ int perm32(int rho) { const int n = rho >> 4, i = rho & 15; return 8 * (i >> 2) + 4 * n + (i & 3); }
struct Unit { int pm, pn, e; };
struct Gemm { const bf16_t* A; const bf16_t* Bt; int M, N, K; };
struct StaticOrder {
    int nM, nN, nwg, G, c;
    __host__ __device__ void init(int M, int N, int G_, int c_) { nM = M / BM; nN = N / BM; nwg = nM * nN; G = G_; c = c_; }
    __host__ __device__ bool next(int i, Unit& u) const {
        const long L = (long)i * G + c; if (L >= nwg) return false;
        int wgid = (int)L; { const int q = nwg / NXCD, r = nwg % NXCD, xcd = wgid % NXCD, off = wgid / NXCD; wgid = (xcd < r ? xcd * (q + 1) : r * (q + 1) + (xcd - r) * q) + off; }
        const int nig = WGM * nN, gid = wgid / nig, fm = gid * WGM, gsz = (nM - fm) < WGM ? (nM - fm) : WGM;
        u.pm = fm + ((wgid % nig) % gsz); u.pn = (wgid % nig) / gsz; u.e = 0; return true;
    }
    __device__ __forceinline__ const bf16_t* bt(const Gemm& g, const Unit&) const { return g.Bt; }
    __device__ __forceinline__ void a_ready(const Unit&) const {}
    __device__ __forceinline__ void done(const Unit&) const {}
};
template <class Epi, class Sched, bool ALIGN_EPI = false, bool SP2 = false>
__device__ __forceinline__ void gemm_phase(PG8_LAS unsigned char* lds, const Gemm g, const Sched& S, const Epi& E) {
    const int tid = ltid(), wid = __builtin_amdgcn_readfirstlane(tid >> 6), lane = tid & 63, wr = wid >> 2, wc = wid & 3, fr = lane & 15, fq = lane >> 4;
    const int K = g.K, nt = K / BK;
    unsigned voffA[2], voffB[2];
#pragma unroll
    for (int i = 0; i < 2; ++i) { int R, C; stage_rc(tid * 16 + i * 8192, R, C); const int Rb = Epi::PERM ? ((R & ~31) + perm32(R & 31)) : R;
        voffA[i] = (unsigned)(R * K + C) * 2u; voffB[i] = (unsigned)(Rb * K + C) * 2u; }
    const size_t kstep = (size_t)(BK * 2);
    const size_t hstep = (size_t)HALF * K * 2;
    const size_t tstep = 2 * hstep;
    const unsigned ldsw = (unsigned)wid * 1024u;
    const int aoff = lds_byte(wr * 64 + fr, fq * 8), boff = lds_byte(wc * 32 + fr, fq * 8);
#define PG8_SA(b, h) (((b) * 2 + (h)) * HTB)
#define PG8_SB(b, h) ((4 + (b) * 2 + (h)) * HTB)
#define PG8_STAGE(bufoff, gbase, voff) do { _Pragma("unroll") for (int _i = 0; _i < 2; ++_i) \
        __builtin_amdgcn_global_load_lds((const unsigned*)((const char*)(gbase) + (voff)[_i]), (PG8_LAS unsigned*)(lds + (bufoff) + ldsw + _i * 8192), 16, 0, 0); } while (0)
#define PG8_LDA(dst, b, h) do { _Pragma("unroll") for (int m = 0; m < 4; ++m) _Pragma("unroll") for (int k = 0; k < 2; ++k) dst[m][k] = *(const PG8_LAS bf16x8*)(lds + PG8_SA(b, h) + aoff + m * 2048 + k * 1024); } while (0)
#define PG8_LDB(dst, b, h) do { _Pragma("unroll") for (int n = 0; n < 2; ++n) _Pragma("unroll") for (int k = 0; k < 2; ++k) dst[n][k] = *(const PG8_LAS bf16x8*)(lds + PG8_SB(b, h) + boff + n * 2048 + k * 1024); } while (0)
#define PG8_MMA(ai, bj, At, Bt) do { __builtin_amdgcn_s_setprio(1); _Pragma("unroll") for (int m = 0; m < 4; ++m) _Pragma("unroll") for (int n = 0; n < 2; ++n) _Pragma("unroll") for (int k = 0; k < 2; ++k) \
        acc[ai][bj][m][n] = __builtin_amdgcn_mfma_f32_16x16x32_bf16(Bt[n][k], At[m][k], acc[ai][bj][m][n], 0, 0, 0); __builtin_amdgcn_s_setprio(0); } while (0)
#define PG8_WAIT_V(n) asm volatile("s_waitcnt vmcnt(" #n ")" ::: "memory")
#define PG8_WAIT_L(n) asm volatile("s_waitcnt lgkmcnt(" #n ")" ::: "memory")
#define PG8_BAR __builtin_amdgcn_s_barrier()
#define PG8_SCHED __builtin_amdgcn_sched_barrier(0)
    Unit cur, nxt; int ui = 0;
    if (!S.next(0, cur)) return;
    f32x4 acc[2][2][4][2];
#pragma unroll
    for (int a = 0; a < 2; ++a)
#pragma unroll
        for (int b = 0; b < 2; ++b)
#pragma unroll
            for (int m = 0; m < 4; ++m)
#pragma unroll
                for (int n = 0; n < 2; ++n) acc[a][b][m][n] = (f32x4){0.f, 0.f, 0.f, 0.f};
    bf16x8 At[4][2], B0[2][2], B1[2][2];
    const char* cA = (const char*)g.A + (size_t)cur.pm * tstep; const char* cB = (const char*)S.bt(g, cur) + (size_t)cur.pn * tstep;
    S.a_ready(cur);
    if constexpr (SP2) {
        PG8_STAGE(PG8_SB(0, 0), cB, voffB); PG8_STAGE(PG8_SB(0, 1), cB + hstep, voffB); PG8_STAGE(PG8_SA(0, 0), cA, voffA); PG8_STAGE(PG8_SA(0, 1), cA + hstep, voffA);
        if (wr == 1) PG8_BAR;
        PG8_WAIT_V(2); PG8_BAR;
        PG8_STAGE(PG8_SB(1, 0), cB + kstep, voffB); PG8_STAGE(PG8_SA(1, 0), cA + kstep, voffA); PG8_STAGE(PG8_SB(1, 1), cB + hstep + kstep, voffB);
        PG8_WAIT_V(6); PG8_BAR;
    } else {
        PG8_STAGE(PG8_SB(0, 0), cB, voffB); PG8_STAGE(PG8_SA(0, 0), cA, voffA); PG8_STAGE(PG8_SB(0, 1), cB + hstep, voffB); PG8_STAGE(PG8_SA(0, 1), cA + hstep, voffA);
        if (wr == 1) PG8_BAR;
        PG8_WAIT_V(4); PG8_BAR;
        PG8_STAGE(PG8_SB(1, 0), cB + kstep, voffB); PG8_STAGE(PG8_SA(1, 0), cA + kstep, voffA); PG8_STAGE(PG8_SB(1, 1), cB + hstep + kstep, voffB);
        PG8_WAIT_V(6); PG8_BAR;
    }
    for (;;) {
        const bool has_next = S.next(ui + 1, nxt);
        const char* nA = has_next ? (const char*)g.A + (size_t)nxt.pm * tstep : cA; const char* nB = has_next ? (const char*)S.bt(g, nxt) + (size_t)nxt.pn * tstep : cB;
        for (int t = 0; t < nt; t += 2) {
            const bool last = (t == nt - 2);
            const char* a1 = cA + (size_t)(t + 1) * kstep;
            const char* a2 = last ? nA : cA + (size_t)(t + 2) * kstep; const char* b2 = last ? nB : cB + (size_t)(t + 2) * kstep;
            const char* a3 = a2 + kstep; const char* b3 = b2 + kstep;
            if (last && has_next) S.a_ready(nxt);
            if constexpr (SP2) {
            PG8_LDB(B0, 0, 0); PG8_LDB(B1, 0, 1); PG8_SCHED; PG8_LDA(At, 0, 0); PG8_STAGE(PG8_SA(1, 1), a1 + hstep, voffA);
            PG8_WAIT_V(8); PG8_WAIT_L(0); PG8_BAR; PG8_MMA(0, 0, At, B0); PG8_MMA(0, 1, At, B1); PG8_BAR; PG8_SCHED;
            PG8_LDA(At, 0, 1); PG8_STAGE(PG8_SB(0, 0), b2, voffB); PG8_STAGE(PG8_SB(0, 1), b2 + hstep, voffB); PG8_STAGE(PG8_SA(0, 0), a2, voffA);
            PG8_WAIT_V(8); PG8_WAIT_L(0); PG8_BAR; PG8_MMA(1, 0, At, B0); PG8_MMA(1, 1, At, B1); PG8_BAR; PG8_SCHED;
            PG8_LDB(B0, 1, 0); PG8_LDB(B1, 1, 1); PG8_SCHED; PG8_LDA(At, 1, 0); PG8_STAGE(PG8_SA(0, 1), a2 + hstep, voffA);
            PG8_WAIT_V(8); PG8_WAIT_L(0); PG8_BAR; PG8_MMA(0, 0, At, B0); PG8_MMA(0, 1, At, B1); PG8_BAR; PG8_SCHED;
            PG8_LDA(At, 1, 1); PG8_STAGE(PG8_SB(1, 0), b3, voffB); PG8_STAGE(PG8_SB(1, 1), b3 + hstep, voffB); PG8_STAGE(PG8_SA(1, 0), a3, voffA);
            PG8_WAIT_V(8); PG8_WAIT_L(0); PG8_BAR; PG8_MMA(1, 0, At, B0); PG8_MMA(1, 1, At, B1); PG8_BAR; PG8_SCHED;
            } else {
            PG8_LDB(B0, 0, 0); PG8_SCHED; PG8_LDA(At, 0, 0); PG8_STAGE(PG8_SA(1, 1), a1 + hstep, voffA);
            PG8_WAIT_L(8); PG8_BAR; PG8_WAIT_L(0); PG8_MMA(0, 0, At, B0); PG8_BAR; PG8_SCHED;
            PG8_LDB(B1, 0, 1); PG8_STAGE(PG8_SB(0, 0), b2, voffB);
            PG8_BAR; PG8_WAIT_L(0); PG8_MMA(0, 1, At, B1); PG8_BAR;
            PG8_LDA(At, 0, 1); PG8_STAGE(PG8_SA(0, 0), a2, voffA);
            PG8_BAR; PG8_WAIT_L(0); PG8_MMA(1, 0, At, B0); PG8_BAR; PG8_SCHED;
            PG8_STAGE(PG8_SB(0, 1), b2 + hstep, voffB);
            PG8_WAIT_V(6); PG8_BAR; PG8_MMA(1, 1, At, B1); PG8_BAR;
            PG8_LDB(B0, 1, 0); PG8_SCHED; PG8_LDA(At, 1, 0); PG8_STAGE(PG8_SA(0, 1), a2 + hstep, voffA);
            PG8_WAIT_L(8); PG8_BAR; PG8_WAIT_L(0); PG8_MMA(0, 0, At, B0); PG8_BAR; PG8_SCHED;
            PG8_LDB(B1, 1, 1); PG8_STAGE(PG8_SB(1, 0), b3, voffB);
            PG8_BAR; PG8_WAIT_L(0); PG8_MMA(0, 1, At, B1); PG8_BAR;
            PG8_LDA(At, 1, 1); PG8_STAGE(PG8_SA(1, 0), a3, voffA);
            PG8_BAR; PG8_WAIT_L(0); PG8_MMA(1, 0, At, B0); PG8_BAR; PG8_SCHED;
            PG8_STAGE(PG8_SB(1, 1), b3 + hstep, voffB);
            PG8_WAIT_V(6); PG8_BAR; PG8_MMA(1, 1, At, B1); PG8_BAR;
            }
        }
        if constexpr (ALIGN_EPI) { if (wr == 0) PG8_BAR; }
        if constexpr (!Epi::AFTER_DRAIN) { E(acc, cur, wr, wc, fr, fq); S.done(cur); }
        if (!has_next) break;
#pragma unroll
        for (int a = 0; a < 2; ++a)
#pragma unroll
            for (int b = 0; b < 2; ++b)
#pragma unroll
                for (int m = 0; m < 4; ++m)
#pragma unroll
                    for (int n = 0; n < 2; ++n) acc[a][b][m][n] = (f32x4){0.f, 0.f, 0.f, 0.f};
        cur = nxt; cA = nA; cB = nB; ++ui;
        if constexpr (ALIGN_EPI) { if (wr == 1) PG8_BAR; }
    }
    PG8_WAIT_V(0);
    if constexpr (!ALIGN_EPI) { if (wr == 0) PG8_BAR; }
    PG8_BAR;
    if constexpr (Epi::AFTER_DRAIN) { E.fused(acc, cur, wr, wc, fr, fq, lds, wid, lane); S.done(cur); }
#undef PG8_SA
#undef PG8_SB
#undef PG8_STAGE
#undef PG8_LDA
#undef PG8_LDB
#undef PG8_MMA
#undef PG8_WAIT_V
#undef PG8_WAIT_L
#undef PG8_BAR
#undef PG8_SCHED
}
}

__device__ __forceinline__ void ph_prologue(const P& p, char* lds, const int part) {
    const int tid = ltid();
    float* fl = (float*)lds;
    if (part == 0) {
    for (int it = blockIdx.x; it < 96; it += gridDim.x) {
        const int l = it / 48, cg = it % 48;
        float* sc = fl;
        float* part = fl + 5 * 1024;
        __syncthreads();
        for (int i = tid; i < 5 * 1024; i += NT) {
            const int r = i >> 10, k = i & 1023;
            const float v = r < 4 ? p.c[r * 1024 + k] : p.c_ctx[k];
            sc[i] = v / (1.f + __expf(-v));
        }
        __syncthreads();
        const int kq = tid >> 7, col = tid & 127, j = cg * 128 + col;
        const float* W = p.w_mod + (size_t)l * 1024 * 6144;
        float a0 = 0, a1 = 0, a2 = 0, a3 = 0, a4 = 0;
        for (int k = kq * 256; k < kq * 256 + 256; ++k) {
            const float w = W[(size_t)k * 6144 + j];
            a0 += sc[k] * w; a1 += sc[1024 + k] * w; a2 += sc[2048 + k] * w; a3 += sc[3072 + k] * w; a4 += sc[4096 + k] * w;
        }
        part[(kq * 5 + 0) * 128 + col] = a0; part[(kq * 5 + 1) * 128 + col] = a1; part[(kq * 5 + 2) * 128 + col] = a2;
        part[(kq * 5 + 3) * 128 + col] = a3; part[(kq * 5 + 4) * 128 + col] = a4;
        __syncthreads();
        for (int i = tid; i < 5 * 128; i += NT) {
            const int r = i >> 7, cc = i & 127, jj = cg * 128 + cc;
            const float v = part[(0 * 5 + r) * 128 + cc] + part[(1 * 5 + r) * 128 + cc] + part[(2 * 5 + r) * 128 + cc] + part[(3 * 5 + r) * 128 + cc];
            p.mod[((size_t)l * 5 + r) * 6144 + jj] = v + p.b_mod[l * 6144 + jj];
        }
    }
    if (blockIdx.x == gridDim.x - 1) {
        const int pos = tid >> 3, f = tid & 7;
        const float inv = powf(10000.0f, -(float)f / 8.0f);
        const float ang = (float)pos * inv;
        p.rope[tid * 2] = cosf(ang); p.rope[tid * 2 + 1] = sinf(ang);
    }
    for (int i = blockIdx.x * NT + tid; i < 2 * 4 * 64 * 64; i += gridDim.x * NT) { const int ii = i & 63, j = (i >> 6) & 63, lg = i >> 12; p.WpT[i] = f2bf(p.w_pool[(size_t)lg * 4096 + ii * 64 + j]); }
    for (int i = blockIdx.x * NT + tid; i < 2 * 4 * 128 * 128; i += gridDim.x * NT) p.WsB[i] = f2bf(p.w_sgu[i]);
    }
    {
        const int n_in = 2 * 9 * 16, n_out = 2 * 4 * 16, n_gu = 64 * 8 * 16, n_dn = 64 * 4 * 16;
        const int total = part == 0 ? n_in : n_in + n_out + n_gu + n_dn;
        const int kr = tid >> 6, n4 = tid & 63, kg = tid & 7, nl = tid >> 3;
        float4 rg[8];
        const float* src = nullptr; bf16_t* dst = nullptr; int N = 0, K = 0, n0 = 0, perm = 0;
        const float* nsrc = nullptr; bf16_t* ndst = nullptr; int nN = 0, nK = 0, nn0 = 0, nperm = 0;
#define TR_DECODE(IT, SRC, DST, NN, KK, N0, PERM) do { int i_ = (IT); const float* W_; bf16_t* Wt_; int ntn_; \
        if (i_ < n_in) { W_ = p.w_in; Wt_ = p.WinT; NN = PW; KK = D; PERM = 0; } \
        else if ((i_ -= n_in) < n_out) { W_ = p.w_out; Wt_ = p.WoutT; NN = D; KK = D; PERM = 0; } \
        else if ((i_ -= n_out) < n_gu) { W_ = p.w_gu; Wt_ = p.WguT; NN = 2048; KK = D; PERM = 1; } \
        else { i_ -= n_gu; W_ = p.w_down; Wt_ = p.WdnT; NN = D; KK = FF; PERM = 0; } \
        ntn_ = NN / 256; const int per_ = ntn_ * (KK / 64), m_ = i_ / per_, r_ = i_ % per_, tn_ = r_ % ntn_, tk_ = r_ / ntn_; \
        N0 = tn_ * 256; SRC = W_ + (size_t)m_ * KK * NN + (size_t)(tk_ * 64) * NN + N0; DST = Wt_ + (size_t)m_ * KK * NN + tk_ * 64; } while (0)
        int it = (part == 0 ? 0 : n_in) + blockIdx.x;
        if (it < total) {
            TR_DECODE(it, src, dst, N, K, n0, perm);
#pragma unroll
            for (int i = 0; i < 8; ++i) rg[i] = *(const float4*)(src + (size_t)(kr + 8 * i) * N + n4 * 4);
        }
        for (; it < total; it += gridDim.x) {
            __syncthreads();
#pragma unroll
            for (int i = 0; i < 8; ++i) { float* q = fl + (kr + 8 * i) * 257 + n4 * 4; q[0] = rg[i].x; q[1] = rg[i].y; q[2] = rg[i].z; q[3] = rg[i].w; }
            __syncthreads();
            const int nit = it + gridDim.x;
            if (nit < total) {
                TR_DECODE(nit, nsrc, ndst, nN, nK, nn0, nperm);
#pragma unroll
                for (int i = 0; i < 8; ++i) rg[i] = *(const float4*)(nsrc + (size_t)(kr + 8 * i) * nN + n4 * 4);
            }
#pragma unroll
            for (int j = 0; j < 4; ++j) {
                const int n = nl + 64 * j;
                const float* q = fl + (8 * kg) * 257 + n;
                u32x4 w;
                w.x = cvtpk(q[0], q[257]); w.y = cvtpk(q[2 * 257], q[3 * 257]); w.z = cvtpk(q[4 * 257], q[5 * 257]); w.w = cvtpk(q[6 * 257], q[7 * 257]);
                const int ng = n0 + n;
                const int np = perm ? (ng < N / 2 ? 2 * ng : 2 * (ng - N / 2) + 1) : ng;
                *(u32x4*)(dst + (size_t)np * K + 8 * kg) = w;
            }
            src = nsrc; dst = ndst; N = nN; K = nK; n0 = nn0; perm = nperm;
        }
#undef TR_DECODE
    }
}

__device__ __forceinline__ void ph_norm1(const P& p, int l) {
    const int wave = ltid() >> 6, lane = ltid() & 63;
    for (int row = blockIdx.x * 8 + wave; row < R; row += gridDim.x * 8) {
        const float* xr = row < T ? p.x + (size_t)row * D : p.ctx + (size_t)(row - T) * D;
        float4 v[4]; float ss = 0;
#pragma unroll
        for (int i = 0; i < 4; ++i) { v[i] = *(const float4*)(xr + lane * 4 + 256 * i); ss += v[i].x * v[i].x + v[i].y * v[i].y + v[i].z * v[i].z + v[i].w * v[i].w; }
        ss = wave_sum(ss);
        const float rstd = rsqrtf(ss * (1.f / D) + EPS);
        const float* m = p.mod + ((size_t)l * 5 + mod_row(row)) * 6144;
        const float* g = p.g_mix + l * D;
#pragma unroll
        for (int i = 0; i < 4; ++i) {
            const int k = lane * 4 + 256 * i;
            const float4 gg = *(const float4*)(g + k), sh = *(const float4*)(m + k), sc = *(const float4*)(m + 1024 + k);
            uint2 o;
            o.x = cvtpk(v[i].x * rstd * gg.x * (1.f + sc.x) + sh.x, v[i].y * rstd * gg.y * (1.f + sc.y) + sh.y);
            o.y = cvtpk(v[i].z * rstd * gg.z * (1.f + sc.z) + sh.z, v[i].w * rstd * gg.w * (1.f + sc.w) + sh.w);
            *(uint2*)(p.H + (size_t)row * D + k) = o;
        }
    }
}

constexpr float QSCALE = 0.17677669529663687f * 1.4426950408889634f;
__device__ __forceinline__ void dsoftmax(const f32x16& s, float& m, float& l, f32x16& o0, f32x16& o1, bf16x8& pa, bf16x8& pb) {
    float mx = fmaxf(fmaxf(fmaxf(s[0], s[1]), fmaxf(s[2], s[3])), fmaxf(fmaxf(s[4], s[5]), fmaxf(s[6], s[7])));
    mx = fmaxf(mx, fmaxf(fmaxf(fmaxf(s[8], s[9]), fmaxf(s[10], s[11])), fmaxf(fmaxf(s[12], s[13]), fmaxf(s[14], s[15]))));
    mx = xhalf_max(mx);
    if (__any(mx > m)) {
        const float mn = fmaxf(m, mx), alpha = __builtin_amdgcn_exp2f(m - mn);
        o0 *= alpha; o1 *= alpha; l *= alpha; m = mn;
    }
    float pr[16]; float sum = 0.f;
#pragma unroll
    for (int r = 0; r < 16; ++r) { pr[r] = __builtin_amdgcn_exp2f(s[r] - m); sum += pr[r]; }
    l += sum;
    u32x4 a, b;
    a[0] = cvtpk(pr[0], pr[1]); a[1] = cvtpk(pr[2], pr[3]); a[2] = cvtpk(pr[4], pr[5]); a[3] = cvtpk(pr[6], pr[7]);
    b[0] = cvtpk(pr[8], pr[9]); b[1] = cvtpk(pr[10], pr[11]); b[2] = cvtpk(pr[12], pr[13]); b[3] = cvtpk(pr[14], pr[15]);
    pa = __builtin_bit_cast(bf16x8, a); pb = __builtin_bit_cast(bf16x8, b);
}
__device__ __forceinline__ void ph_dattn(const P& p, int l, int nrows, char* lds) {
    const int tid = ltid(), lane = tid & 63, wid = tid >> 6, r32 = lane & 31, hi = lane >> 5;
    float la = lane < 32 ? p.lam_q1[l * 32 + lane] * p.lam_k1[l * 32 + lane] : 0.f;
    float lb = lane < 32 ? p.lam_q2[l * 32 + lane] * p.lam_k2[l * 32 + lane] : 0.f;
    la = wave_sum(la); lb = wave_sum(lb);
    const float lam_init = 0.8f - 0.6f * expf(-0.3f * (float)l);
    const float lam = expf(la) - expf(lb) + lam_init;
    const bf16_t* PR = p.PROJ;
    const int nunits = (nrows == R) ? 256 + 16 : 256;
    const int skey = 8 * wid + (lane & 7), schunk = lane >> 3;
    const int ldsK = schunk * 1024 + skey * 16;
    const int ldsV = 8192 + (schunk >> 2) * 4096 + (skey >> 3) * 512 + (skey & 7) * 64 + (schunk & 3) * 16;
    const int vb = ((lane >> 4) & 1) * 32 + (lane & 3) * 8 + (4 * hi + ((lane & 15) >> 2)) * 64;
    for (int uu = blockIdx.x; uu < nunits; uu += gridDim.x) {
        int b, h, q0, nt; bool isctx;
        if (uu < 256) { const int u = (uu & 7) * 32 + (uu >> 3); b = u >> 6; h = (u >> 4) & 3; q0 = b * 4096 + (u & 15) * 256; nt = 68; isctx = false; }
        else { const int v = uu - 256; b = v >> 2; h = v & 3; q0 = T + b * 256; nt = 4; isctx = true; }
        bf16x8 qf[4];
        {
            const bf16_t* qp = PR + (size_t)(q0 + wid * 32 + r32) * PW + h * 64 + hi * 8;
#pragma unroll
            for (int ks = 0; ks < 4; ++ks) qf[ks] = *(const bf16x8*)(qp + ks * 16);
        }
        f32x16 O00, O01, O10, O11;
#pragma unroll
        for (int r = 0; r < 16; ++r) { O00[r] = 0.f; O01[r] = 0.f; O10[r] = 0.f; O11[r] = 0.f; }
        float m1 = -1e30f, m2 = -1e30f, l1 = 0.f, l2 = 0.f;
        const size_t gK = 256 + h * 64 + schunk * 8, gV = 512 + h * 64 + schunk * 8;
        uint4 rk, rv;
        {
            const int kr = (isctx ? T + b * 256 : b * 4096) + skey;
            rk = *(const uint4*)(PR + (size_t)kr * PW + gK); rv = *(const uint4*)(PR + (size_t)kr * PW + gV);
        }
        __syncthreads();
        *(uint4*)(lds + ldsK) = rk; *(uint4*)(lds + ldsV) = rv;
        __syncthreads();
        for (int t = 0; t < nt; ++t) {
            char* buf = lds + (t & 1) * 16384;
            if (t + 1 < nt) {
                const int tn = t + 1;
                const int kr = ((isctx || tn >= 64) ? T + b * 256 + (isctx ? tn : tn - 64) * 64 : b * 4096 + tn * 64) + skey;
                rk = *(const uint4*)(PR + (size_t)kr * PW + gK); rv = *(const uint4*)(PR + (size_t)kr * PW + gV);
            }
#pragma unroll
            for (int kb = 0; kb < 2; ++kb) {
                const lds_cptr kp = (lds_cptr)buf + hi * 1024 + (kb * 32 + r32) * 16;
                const bf16x8 kf0 = *(const __attribute__((address_space(3))) bf16x8*)(kp);
                const bf16x8 kf1 = *(const __attribute__((address_space(3))) bf16x8*)(kp + 2048);
                const bf16x8 kf2 = *(const __attribute__((address_space(3))) bf16x8*)(kp + 4096);
                const bf16x8 kf3 = *(const __attribute__((address_space(3))) bf16x8*)(kp + 6144);
                f32x16 s1, s2;
#pragma unroll
                for (int r = 0; r < 16; ++r) { s1[r] = 0.f; s2[r] = 0.f; }
                s1 = __builtin_amdgcn_mfma_f32_32x32x16_bf16(kf0, qf[0], s1, 0, 0, 0);
                s1 = __builtin_amdgcn_mfma_f32_32x32x16_bf16(kf1, qf[1], s1, 0, 0, 0);
                s2 = __builtin_amdgcn_mfma_f32_32x32x16_bf16(kf2, qf[2], s2, 0, 0, 0);
                s2 = __builtin_amdgcn_mfma_f32_32x32x16_bf16(kf3, qf[3], s2, 0, 0, 0);
                bf16x8 p1a, p1b, p2a, p2b;
                dsoftmax(s1, m1, l1, O00, O01, p1a, p1b);
                dsoftmax(s2, m2, l2, O10, O11, p2a, p2b);
                const lds_cptr vp = (lds_cptr)buf + 8192 + vb + kb * 2048;
#pragma unroll
                for (int dt = 0; dt < 2; ++dt) {
#pragma unroll
                    for (int ss = 0; ss < 2; ++ss) {
                        const s16x4 lo = vtr(vp + dt * 4096 + ss * 1024), hh = vtr(vp + dt * 4096 + ss * 1024 + 512);
                        const bf16x8 va = (bf16x8){lo[0], lo[1], lo[2], lo[3], hh[0], hh[1], hh[2], hh[3]};
                        if (dt == 0) { O00 = __builtin_amdgcn_mfma_f32_32x32x16_bf16(va, ss ? p1b : p1a, O00, 0, 0, 0); O10 = __builtin_amdgcn_mfma_f32_32x32x16_bf16(va, ss ? p2b : p2a, O10, 0, 0, 0); }
                        else         { O01 = __builtin_amdgcn_mfma_f32_32x32x16_bf16(va, ss ? p1b : p1a, O01, 0, 0, 0); O11 = __builtin_amdgcn_mfma_f32_32x32x16_bf16(va, ss ? p2b : p2a, O11, 0, 0, 0); }
                    }
                }
            }
            if (t + 1 < nt) { char* nb = lds + ((t + 1) & 1) * 16384; *(uint4*)(nb + ldsK) = rk; *(uint4*)(nb + ldsV) = rv; }
            __syncthreads();
        }
        l1 = xhalf_sum(l1); l2 = xhalf_sum(l2);
        const float i1 = 1.f / l1, i2 = lam / l2;
        float ss = 0.f;
#pragma unroll
        for (int r = 0; r < 16; ++r) { O00[r] = O00[r] * i1 - O10[r] * i2; O01[r] = O01[r] * i1 - O11[r] * i2; ss += O00[r] * O00[r] + O01[r] * O01[r]; }
        ss = xhalf_sum(ss);
        const float rstd = rsqrtf(ss * (1.f / 64.f) + EPS) * (1.f - lam_init);
        const float* gs = p.g_sub + l * 64;
        bf16_t* op = p.MIX + (size_t)(q0 + wid * 32 + r32) * D + h * 64;
#pragma unroll
        for (int g4 = 0; g4 < 4; ++g4) {
            const int d = 8 * g4 + 4 * hi;
            const float4 ga = *(const float4*)(gs + d), gb = *(const float4*)(gs + 32 + d);
            uint2 wa, wb;
            wa.x = cvtpk(O00[4 * g4] * rstd * ga.x, O00[4 * g4 + 1] * rstd * ga.y); wa.y = cvtpk(O00[4 * g4 + 2] * rstd * ga.z, O00[4 * g4 + 3] * rstd * ga.w);
            wb.x = cvtpk(O01[4 * g4] * rstd * gb.x, O01[4 * g4 + 1] * rstd * gb.y); wb.y = cvtpk(O01[4 * g4 + 2] * rstd * gb.z, O01[4 * g4 + 3] * rstd * gb.w);
            *(uint2*)(op + d) = wa; *(uint2*)(op + 32 + d) = wb;
        }
    }
}

__device__ __forceinline__ void ph_na(const P& p, int l, int nrows, char* lds) {
    const int tid = ltid(), lane = tid & 63, wid = tid >> 6, r32 = lane & 31, hi = lane >> 5;
    const bf16_t* PR = p.PROJ;
    const int nunits = (nrows == R) ? 256 + 16 : 256;
    const int skey = 8 * wid + (lane & 7), schunk = lane >> 3;
    const int ldsK = schunk * 1024 + skey * 16;
    const int ldsV = 8192 + (schunk >> 2) * 4096 + (skey >> 3) * 512 + (skey & 7) * 64 + (schunk & 3) * 16;
    const int vb = ((lane >> 4) & 1) * 32 + (lane & 3) * 8 + (4 * hi + ((lane & 15) >> 2)) * 64;
    float* btab = (float*)(lds + 32768);
    constexpr float LOG2E = 1.4426950408889634f;
    for (int uu = blockIdx.x; uu < nunits; uu += gridDim.x) {
        int b, h, q0, kr_lo, nlat, rs = 0, rq = 0; bool isctx;
        if (uu < 256) {
            const int u = (uu & 7) * 32 + (uu >> 3); b = u >> 6; h = (u >> 4) & 3; const int rg = u & 15;
            rq = 4 * rg + (wid >> 1); q0 = b * 4096 + rq * 64 + (wid & 1) * 32;
            kr_lo = min(max(4 * rg - 4, 0), 56); const int kr_hi = min(max(4 * rg - 1, 0), 56) + 7; nlat = kr_hi - kr_lo + 1;
            rs = min(max(rq - 4, 0), 56); isctx = false;
        } else { const int v = uu - 256; b = v >> 2; h = v & 3; q0 = T + b * 256 + wid * 32; kr_lo = 0; nlat = 0; isctx = true; }
        const int nt = nlat + 4;
        const int cq = (wid & 1) * 32 + r32, wsc = min(max(cq - 8, 0), 48);
        bf16x8 qf[4];
        {
            const bf16_t* qp = PR + (size_t)(q0 + r32) * PW + 1536 + h * 64 + hi * 8;
#pragma unroll
            for (int ks = 0; ks < 4; ++ks) qf[ks] = *(const bf16x8*)(qp + ks * 16);
        }
        f32x16 O0, O1;
#pragma unroll
        for (int r = 0; r < 16; ++r) { O0[r] = 0.f; O1[r] = 0.f; }
        float m1 = -1e30f, l1 = 0.f;
        const size_t gK = 1792 + h * 64 + schunk * 8, gV = 2048 + h * 64 + schunk * 8;
        uint4 rk, rv;
        {
            const int kr = (nlat ? b * 4096 + kr_lo * 64 : T + b * 256) + skey;
            rk = *(const uint4*)(PR + (size_t)kr * PW + gK); rv = *(const uint4*)(PR + (size_t)kr * PW + gV);
        }
        __syncthreads();
        *(uint4*)(lds + ldsK) = rk; *(uint4*)(lds + ldsV) = rv;
        if (tid < 465) btab[tid] = p.rpb[((size_t)l * 4 + h) * 465 + tid] * LOG2E;
        __syncthreads();
        for (int t = 0; t < nt; ++t) {
            char* buf = lds + (t & 1) * 16384;
            if (t + 1 < nt) {
                const int tn = t + 1;
                const int kr = (tn < nlat ? b * 4096 + (kr_lo + tn) * 64 : T + b * 256 + (tn - nlat) * 64) + skey;
                rk = *(const uint4*)(PR + (size_t)kr * PW + gK); rv = *(const uint4*)(PR + (size_t)kr * PW + gV);
            }
            const bool lat = t < nlat;
            const int krow = kr_lo + t;
            const bool active = !lat || (krow >= rs && krow <= rs + 7);
            if (active) {
                const float* brow = btab + (krow - rq + 7) * 31 + 15 - cq;
#pragma unroll
                for (int kb = 0; kb < 2; ++kb) {
                    const lds_cptr kp = (lds_cptr)buf + hi * 1024 + (kb * 32 + r32) * 16;
                    f32x16 s1;
#pragma unroll
                    for (int r = 0; r < 16; ++r) s1[r] = 0.f;
#pragma unroll
                    for (int ks = 0; ks < 4; ++ks) {
                        const bf16x8 kf = *(const __attribute__((address_space(3))) bf16x8*)(kp + ks * 2048);
                        s1 = __builtin_amdgcn_mfma_f32_32x32x16_bf16(kf, qf[ks], s1, 0, 0, 0);
                    }
                    if (lat) {
#pragma unroll
                        for (int r = 0; r < 16; ++r) {
                            const int kc = 32 * kb + (r & 3) + 8 * (r >> 2) + 4 * hi;
                            const bool ok = (unsigned)(kc - wsc) < 16u;
                            const float bv = brow[ok ? kc : cq];
                            s1[r] = ok ? s1[r] + bv : -INFINITY;
                        }
                    }
                    bf16x8 pa, pb;
                    dsoftmax(s1, m1, l1, O0, O1, pa, pb);
                    const lds_cptr vp = (lds_cptr)buf + 8192 + vb + kb * 2048;
#pragma unroll
                    for (int ss = 0; ss < 2; ++ss) {
                        const s16x4 lo0 = vtr(vp + ss * 1024), hh0 = vtr(vp + ss * 1024 + 512);
                        const s16x4 lo1 = vtr(vp + 4096 + ss * 1024), hh1 = vtr(vp + 4096 + ss * 1024 + 512);
                        const bf16x8 va0 = (bf16x8){lo0[0], lo0[1], lo0[2], lo0[3], hh0[0], hh0[1], hh0[2], hh0[3]};
                        const bf16x8 va1 = (bf16x8){lo1[0], lo1[1], lo1[2], lo1[3], hh1[0], hh1[1], hh1[2], hh1[3]};
                        O0 = __builtin_amdgcn_mfma_f32_32x32x16_bf16(va0, ss ? pb : pa, O0, 0, 0, 0);
                        O1 = __builtin_amdgcn_mfma_f32_32x32x16_bf16(va1, ss ? pb : pa, O1, 0, 0, 0);
                    }
                }
            }
            if (t + 1 < nt) { char* nb = lds + ((t + 1) & 1) * 16384; *(uint4*)(nb + ldsK) = rk; *(uint4*)(nb + ldsV) = rv; }
            __syncthreads();
        }
        l1 = xhalf_sum(l1);
        const float il = 1.f / l1;
        bf16_t* op = p.MIX + (size_t)(q0 + r32) * D + 768 + h * 64;
#pragma unroll
        for (int g4 = 0; g4 < 4; ++g4) {
            const int d = 8 * g4 + 4 * hi;
            uint2 wa, wb;
            wa.x = cvtpk(O0[4 * g4] * il, O0[4 * g4 + 1] * il); wa.y = cvtpk(O0[4 * g4 + 2] * il, O0[4 * g4 + 3] * il);
            wb.x = cvtpk(O1[4 * g4] * il, O1[4 * g4 + 1] * il); wb.y = cvtpk(O1[4 * g4 + 2] * il, O1[4 * g4 + 3] * il);
            *(uint2*)(op + d) = wa; *(uint2*)(op + 32 + d) = wb;
        }
    }
}

__device__ __forceinline__ void ph_pool(const P& p, int l, int nrows, char* lds) {
    const int tid = ltid(), lane = tid & 63, wid = tid >> 6, fr = lane & 15, fq = lane >> 4;
    float* ysh = (float*)lds;
    bf16_t* dsh = (bf16_t*)(lds + 80 * 256 * 4);
    const bf16_t* PR = p.PROJ;
    for (int it = blockIdx.x; it < nrows / 64; it += gridDim.x) {
        const int row0 = it * 64;
        const int L = row0 < T ? 4096 : 256;
        const int t0 = row0 < T ? (row0 & 4095) : ((row0 - T) & 255);
        const int base = row0 - t0;
        __syncthreads();
        for (int c = tid; c < 80 * 32; c += NT) {
            const int rr = c >> 5, ch = (c & 31) * 8, t = t0 - 8 + rr;
            float4 a = make_float4(0.f, 0.f, 0.f, 0.f), b = a;
            if (t >= 0 && t < L) {
                const uint4 raw = *(const uint4*)(PR + (size_t)(base + t) * PW + 768 + ch);
                a = make_float4(__uint_as_float(raw.x << 16), __uint_as_float(raw.x & 0xffff0000u), __uint_as_float(raw.y << 16), __uint_as_float(raw.y & 0xffff0000u));
                b = make_float4(__uint_as_float(raw.z << 16), __uint_as_float(raw.z & 0xffff0000u), __uint_as_float(raw.w << 16), __uint_as_float(raw.w & 0xffff0000u));
            }
            *(float4*)(ysh + rr * 256 + ch) = a; *(float4*)(ysh + rr * 256 + ch + 4) = b;
        }
        __syncthreads();
        {
            const int r = tid >> 3, cg = tid & 7;
            const int g = cg >> 1, w = 2 << g, t = t0 + r;
            const int lo = max(t - w / 2, 0), hi = min(t + w / 2 - 1, L - 1);
            const float inv = 1.f / (float)(hi - lo + 1);
#pragma unroll
            for (int q = 0; q < 8; ++q) {
                const int ch = cg * 32 + q * 4;
                float4 s = make_float4(0.f, 0.f, 0.f, 0.f);
                for (int tt = lo; tt <= hi; ++tt) { const float4 v = *(const float4*)(ysh + (tt - t0 + 8) * 256 + ch); s.x += v.x; s.y += v.y; s.z += v.z; s.w += v.w; }
                const float4 y = *(const float4*)(ysh + (r + 8) * 256 + ch);
                uint2 o; o.x = cvtpk(s.x * inv - y.x, s.y * inv - y.y); o.y = cvtpk(s.z * inv - y.z, s.w * inv - y.w);
                *(uint2*)(dsh + r * 264 + ch) = o;
            }
        }
        __syncthreads();
        {
            const int g = wid >> 1, mb = (wid & 1) * 2;
            const bf16_t* W = p.WpT + ((size_t)l * 4 + g) * 64 * 64;
            f32x4 acc[2][4];
#pragma unroll
            for (int mt = 0; mt < 2; ++mt)
#pragma unroll
                for (int nt = 0; nt < 4; ++nt) acc[mt][nt] = (f32x4){0.f, 0.f, 0.f, 0.f};
#pragma unroll
            for (int ks = 0; ks < 2; ++ks) {
                bf16x8 af[2], bfr[4];
#pragma unroll
                for (int mt = 0; mt < 2; ++mt) af[mt] = *(const bf16x8*)(dsh + ((mb + mt) * 16 + fr) * 264 + g * 64 + ks * 32 + fq * 8);
#pragma unroll
                for (int nt = 0; nt < 4; ++nt) bfr[nt] = *(const bf16x8*)(W + (nt * 16 + fr) * 64 + ks * 32 + fq * 8);
#pragma unroll
                for (int mt = 0; mt < 2; ++mt)
#pragma unroll
                    for (int nt = 0; nt < 4; ++nt) acc[mt][nt] = __builtin_amdgcn_mfma_f32_16x16x32_bf16(bfr[nt], af[mt], acc[mt][nt], 0, 0, 0);
            }
#pragma unroll
            for (int mt = 0; mt < 2; ++mt)
#pragma unroll
                for (int nt = 0; nt < 4; ++nt) {
                    const int row = row0 + (mb + mt) * 16 + fr, j = g * 64 + nt * 16 + fq * 4;
                    const float4 sp = *(const float4*)(p.s_pool + l * 256 + j);
                    uint2 o; o.x = cvtpk(acc[mt][nt][0] * sp.x, acc[mt][nt][1] * sp.y); o.y = cvtpk(acc[mt][nt][2] * sp.z, acc[mt][nt][3] * sp.w);
                    *(uint2*)(p.MIX + (size_t)row * D + 256 + j) = o;
                }
        }
    }
}

__device__ __forceinline__ float gelu_fast(float x) {
    const float u = 0.7978845608028654f * (x + 0.044715f * x * x * x);
    return x / (1.f + __builtin_amdgcn_exp2f(-2.885390081777927f * u));
}
__device__ __forceinline__ void ph_sgu(const P& p, int l, int nrows, char* lds) {
    const int tid = ltid(), lane = tid & 63, wid = tid >> 6, fr = lane & 15, fq = lane >> 4;
    bf16_t* vnT = (bf16_t*)lds;
    float* rstd = (float*)(lds + 128 * 136 * 2);
    const bf16_t* PR = p.PROJ;
    for (int it = blockIdx.x; it < (nrows / 128) * 2; it += gridDim.x) {
        const int chunk = it >> 1, hp = it & 1, row0 = chunk * 128;
        __syncthreads();
        {
            const int t = tid >> 2, qtr = tid & 3;
            const bf16_t* zp = PR + (size_t)(row0 + t) * PW + 1280 + qtr * 64;
            float ss = 0.f;
#pragma unroll
            for (int i = 0; i < 8; ++i) {
                const uint4 raw = *(const uint4*)(zp + i * 8);
                const unsigned w4[4] = {raw.x, raw.y, raw.z, raw.w};
#pragma unroll
                for (int j = 0; j < 4; ++j) { const float a = __uint_as_float(w4[j] << 16), b = __uint_as_float(w4[j] & 0xffff0000u); ss += a * a + b * b; }
            }
            ss += __shfl_xor(ss, 1); ss += __shfl_xor(ss, 2);
            if (qtr == 0) rstd[t] = rsqrtf(ss * (1.f / 256.f) + EPS);
        }
        __syncthreads();
        {
            const int s = tid >> 2, cb = (tid & 3) * 32;
            const bf16_t* zp = PR + (size_t)(row0 + s) * PW + 1280 + hp * 128 + cb;
            const float rs = rstd[s];
            const float* gg = p.g_sgu + l * 256 + hp * 128 + cb;
#pragma unroll
            for (int i = 0; i < 4; ++i) {
                const uint4 raw = *(const uint4*)(zp + i * 8);
                const unsigned w4[4] = {raw.x, raw.y, raw.z, raw.w};
#pragma unroll
                for (int j = 0; j < 4; ++j) {
                    const int c = cb + i * 8 + j * 2;
                    vnT[c * 136 + s] = f2bf(__uint_as_float(w4[j] << 16) * rs * gg[i * 8 + j * 2]);
                    vnT[(c + 1) * 136 + s] = f2bf(__uint_as_float(w4[j] & 0xffff0000u) * rs * gg[i * 8 + j * 2 + 1]);
                }
            }
        }
        __syncthreads();
        {
            const int hl = wid >> 2, g = hp * 2 + hl, mb = (wid & 3) * 2;
            const bf16_t* Wg = p.WsB + ((size_t)l * 4 + g) * 128 * 128;
            f32x4 acc[2][4];
#pragma unroll
            for (int mt = 0; mt < 2; ++mt)
#pragma unroll
                for (int nt = 0; nt < 4; ++nt) acc[mt][nt] = (f32x4){0.f, 0.f, 0.f, 0.f};
#pragma unroll
            for (int ks = 0; ks < 4; ++ks) {
                bf16x8 af[2], bfr[4];
#pragma unroll
                for (int mt = 0; mt < 2; ++mt) af[mt] = *(const bf16x8*)(Wg + ((mb + mt) * 16 + fr) * 128 + ks * 32 + fq * 8);
#pragma unroll
                for (int nt = 0; nt < 4; ++nt) bfr[nt] = *(const bf16x8*)(vnT + (hl * 64 + nt * 16 + fr) * 136 + ks * 32 + fq * 8);
#pragma unroll
                for (int mt = 0; mt < 2; ++mt)
#pragma unroll
                    for (int nt = 0; nt < 4; ++nt) acc[mt][nt] = __builtin_amdgcn_mfma_f32_16x16x32_bf16(bfr[nt], af[mt], acc[mt][nt], 0, 0, 0);
            }
#pragma unroll
            for (int mt = 0; mt < 2; ++mt) {
                const int t = (mb + mt) * 16 + fr;
                const float bias = p.b_sgu[(l * 4 + g) * 128 + t];
#pragma unroll
                for (int nt = 0; nt < 4; ++nt) {
                    const int c = g * 64 + nt * 16 + fq * 4;
                    const uint2 ur = *(const uint2*)(PR + (size_t)(row0 + t) * PW + 1024 + c);
                    const float u0 = __uint_as_float(ur.x << 16), u1 = __uint_as_float(ur.x & 0xffff0000u);
                    const float u2 = __uint_as_float(ur.y << 16), u3 = __uint_as_float(ur.y & 0xffff0000u);
                    uint2 o; o.x = cvtpk(u0 * (acc[mt][nt][0] + bias), u1 * (acc[mt][nt][1] + bias)); o.y = cvtpk(u2 * (acc[mt][nt][2] + bias), u3 * (acc[mt][nt][3] + bias));
                    *(uint2*)(p.MIX + (size_t)(row0 + t) * D + 512 + c) = o;
                }
            }
        }
    }
}

__device__ __forceinline__ void ph_router(const P& p, int l, int nrows, char* lds) {
    const int tid = ltid(), wave = tid >> 6, lane = tid & 63;
    float* wl = (float*)lds;
    float* wsc = (float*)(lds + 1024 * 36 * 4) + wave * 64;
    int* lcnt = (int*)(lds + 1024 * 36 * 4 + 8 * 64 * 4);
    __syncthreads();
    {
        const float* wr = p.w_router + (size_t)l * D * NE;
        for (int i = tid; i < 1024 * 8; i += NT) { const int k = i >> 3, e4 = (i & 7) * 4; *(float4*)(wl + k * 36 + e4) = *(const float4*)(wr + k * 32 + e4); }
        if (tid < 32) lcnt[tid] = 0;
    }
    __syncthreads();
    const float* g = p.g_ffn + l * D;
    const float brt = p.b_router[l * NE + (lane & 31)];
    for (int pr = blockIdx.x * 8 + wave; pr < nrows / 2; pr += gridDim.x * 8) {
        const int ra = 2 * pr;
        const float* xa = p.X + (size_t)ra * D; const float* xb = xa + D;
        float ha[16], hb[16]; float sa = 0.f, sb = 0.f;
#pragma unroll
        for (int i = 0; i < 16; ++i) { ha[i] = xa[lane + 64 * i]; hb[i] = xb[lane + 64 * i]; sa += ha[i] * ha[i]; sb += hb[i] * hb[i]; }
        sa = wave_sum(sa); sb = wave_sum(sb);
        const float rsa = rsqrtf(sa * (1.f / D) + EPS), rsb = rsqrtf(sb * (1.f / D) + EPS);
        const float* m = p.mod + ((size_t)l * 5 + mod_row(ra)) * 6144;
#pragma unroll
        for (int i = 0; i < 16; ++i) {
            const int k = lane + 64 * i;
            const float gs = g[k] * (1.f + m[4 * 1024 + k]), sh = m[3 * 1024 + k];
            ha[i] = ha[i] * rsa * gs + sh; hb[i] = hb[i] * rsb * gs + sh;
            p.H[(size_t)ra * D + k] = f2bf(ha[i]); p.H[(size_t)(ra + 1) * D + k] = f2bf(hb[i]);
        }
        float la[32], lb[32];
#pragma unroll
        for (int e = 0; e < 32; ++e) { la[e] = 0.f; lb[e] = 0.f; }
#pragma unroll
        for (int i = 0; i < 16; ++i) {
            const float* wk = wl + (lane + 64 * i) * 36;
#pragma unroll
            for (int e = 0; e < 32; e += 4) {
                const float4 w = *(const float4*)(wk + e);
                la[e] += ha[i] * w.x; la[e + 1] += ha[i] * w.y; la[e + 2] += ha[i] * w.z; la[e + 3] += ha[i] * w.w;
                lb[e] += hb[i] * w.x; lb[e + 1] += hb[i] * w.y; lb[e + 2] += hb[i] * w.z; lb[e + 3] += hb[i] * w.w;
            }
        }
        float r32v[32];
        {
            const bool up = lane >= 32;
#pragma unroll
            for (int e = 0; e < 32; ++e) { const float keep = up ? lb[e] : la[e], send = up ? la[e] : lb[e]; r32v[e] = keep + __shfl_xor(send, 32); }
        }
        float r16[16], r8[8], r4[4], r2[2];
        { const bool up = (lane & 16) != 0;
#pragma unroll
          for (int e = 0; e < 16; ++e) { const float keep = up ? r32v[e + 16] : r32v[e], send = up ? r32v[e] : r32v[e + 16]; r16[e] = keep + __shfl_xor(send, 16); } }
        { const bool up = (lane & 8) != 0;
#pragma unroll
          for (int e = 0; e < 8; ++e) { const float keep = up ? r16[e + 8] : r16[e], send = up ? r16[e] : r16[e + 8]; r8[e] = keep + __shfl_xor(send, 8); } }
        { const bool up = (lane & 4) != 0;
#pragma unroll
          for (int e = 0; e < 4; ++e) { const float keep = up ? r8[e + 4] : r8[e], send = up ? r8[e] : r8[e + 4]; r4[e] = keep + __shfl_xor(send, 4); } }
        { const bool up = (lane & 2) != 0;
#pragma unroll
          for (int e = 0; e < 2; ++e) { const float keep = up ? r4[e + 2] : r4[e], send = up ? r4[e] : r4[e + 2]; r2[e] = keep + __shfl_xor(send, 2); } }
        float mine;
        { const bool up = (lane & 1) != 0; const float keep = up ? r2[1] : r2[0], send = up ? r2[0] : r2[1]; mine = keep + __shfl_xor(send, 1); }
        wsc[lane] = mine + brt;
        float lg[32];
        {
            const float* wp = wsc + (lane & 32);
#pragma unroll
            for (int e = 0; e < 32; e += 4) { const float4 v = *(const float4*)(wp + e); lg[e] = v.x; lg[e + 1] = v.y; lg[e + 2] = v.z; lg[e + 3] = v.w; }
        }
        unsigned taken = 0u; float tv[4]; int ti[4];
#pragma unroll
        for (int k = 0; k < 4; ++k) {
            float best = -3.0e38f; int bi = 0;
#pragma unroll
            for (int e = 0; e < 32; ++e) { const bool ok = !((taken >> e) & 1u) && (lg[e] > best); best = ok ? lg[e] : best; bi = ok ? e : bi; }
            taken |= 1u << bi; tv[k] = best; ti[k] = bi;
        }
        const float e1 = __expf(tv[1] - tv[0]), e2 = __expf(tv[2] - tv[0]), e3 = __expf(tv[3] - tv[0]);
        const float inv = 1.f / (1.f + e1 + e2 + e3);
        if ((lane & 31) == 0) {
            const int row = ra + (lane >> 5);
            *(int4*)(p.topi + (size_t)row * 4) = make_int4(ti[0], ti[1], ti[2], ti[3]);
            *(float4*)(p.topg + (size_t)row * 4) = make_float4(inv, e1 * inv, e2 * inv, e3 * inv);
            atomicAdd(&lcnt[ti[0]], 1); atomicAdd(&lcnt[ti[1]], 1); atomicAdd(&lcnt[ti[2]], 1); atomicAdd(&lcnt[ti[3]], 1);
        }
    }
    __syncthreads();
    if (tid < 32 && lcnt[tid]) atomicAdd(&p.cnt[l * 64 + tid], lcnt[tid]);
}
__device__ __forceinline__ void ph_assign(const P& p, int l, int nrows, char* lds) {
    int* lcnt = (int*)lds; int* lbase = lcnt + 32; int* pst = lbase + 32; int* slots = pst + 32;
    const int tid = ltid(), wave = tid >> 6, lane = tid & 63;
    int* cnt = p.cnt + l * 64; int* cursor = cnt + 32;
    int* meta = p.moe_meta + l * 512;
    __syncthreads();
    if (tid == 0) { int a = 0; for (int e = 0; e < 32; ++e) { pst[e] = a; a += (cnt[e] + 255) & ~255; } if (blockIdx.x == 0) meta[0] = a >> 8; }
    __syncthreads();
    if (blockIdx.x == 0 && tid < 320) { int e = 0; for (int k = 1; k < 32; ++k) if (tid * 256 >= pst[k]) e = k; meta[1 + tid] = e; }
    for (int it = blockIdx.x; it < nrows / NT; it += gridDim.x) {
        const int row = it * NT + tid;
        __syncthreads();
        if (tid < 32) lcnt[tid] = 0;
        __syncthreads();
        const int4 ti = *(const int4*)(p.topi + (size_t)row * 4);
        const int r0 = atomicAdd(&lcnt[ti.x], 1), r1 = atomicAdd(&lcnt[ti.y], 1), r2 = atomicAdd(&lcnt[ti.z], 1), r3 = atomicAdd(&lcnt[ti.w], 1);
        __syncthreads();
        if (tid < 32) lbase[tid] = pst[tid] + (lcnt[tid] ? atomicAdd(&cursor[tid], lcnt[tid]) : 0);
        __syncthreads();
        const int4 sl = make_int4(lbase[ti.x] + r0, lbase[ti.y] + r1, lbase[ti.z] + r2, lbase[ti.w] + r3);
        *(int4*)(p.tok_slot + (size_t)row * 4) = sl;
        *(int4*)(slots + tid * 4) = sl;
        __syncthreads();
        for (int rr = 0; rr < 64; ++rr) {
            const int lr = wave * 64 + rr;
            const int4 s4 = *(const int4*)(slots + lr * 4);
            const bf16_t* src = p.H + (size_t)(it * NT + lr) * D + lane * 8;
            const uint4 v0 = *(const uint4*)src, v1 = *(const uint4*)(src + 512);
            bf16_t* d0 = p.HS + (size_t)s4.x * D + lane * 8; *(uint4*)d0 = v0; *(uint4*)(d0 + 512) = v1;
            bf16_t* d1 = p.HS + (size_t)s4.y * D + lane * 8; *(uint4*)d1 = v0; *(uint4*)(d1 + 512) = v1;
            bf16_t* d2 = p.HS + (size_t)s4.z * D + lane * 8; *(uint4*)d2 = v0; *(uint4*)(d2 + 512) = v1;
            bf16_t* d3 = p.HS + (size_t)s4.w * D + lane * 8; *(uint4*)d3 = v0; *(uint4*)(d3 + 512) = v1;
        }
    }
}

struct EpiProj {
    static constexpr bool PERM = true, AFTER_DRAIN = false;
    bf16_t* O; const float* rope;
    __device__ __forceinline__ void operator()(const f32x4 (&acc)[2][2][4][2], const pg8::Unit& u, int wr, int wc, int fr, int fq) const {
        const int row0 = u.pm * 256 + wr * 64 + fr, col0 = u.pn * 256 + wc * 32 + 8 * fq;
        const bool do_rope = (u.pn < 2) && (u.pm < T / 256), do_gelu = (u.pn == 4) || (u.pn == 5);
        const float sc = u.pn == 0 ? QSCALE : (u.pn == 6 ? 0.125f * 1.4426950408889634f : 1.f);
        const float sgn = (fq & 1) ? 1.f : -1.f;
#pragma unroll
        for (int ai = 0; ai < 2; ++ai)
#pragma unroll
            for (int m = 0; m < 4; ++m) {
                const int row = row0 + ai * 128 + m * 16;
                bf16_t* rowp = O + (size_t)row * PW + col0;
                f32x4 cs[4];
                if (do_rope) {
                    const int s = row & 4095, pos = (fq >> 1) ? (s & 63) : (s >> 6);
                    const f32x4* rp = (const f32x4*)(rope + pos * 16);
                    cs[0] = rp[0]; cs[1] = rp[1]; cs[2] = rp[2]; cs[3] = rp[3];
                }
#pragma unroll
                for (int bj = 0; bj < 2; ++bj) {
                    f32x4 v0 = acc[ai][bj][m][0], v1 = acc[ai][bj][m][1];
                    if (do_rope) {
                        f32x4 b0, b1;
#pragma unroll
                        for (int j = 0; j < 4; ++j) { b0[j] = __shfl_xor(v0[j], 16); b1[j] = __shfl_xor(v1[j], 16); }
                        v0[0] = v0[0] * cs[0][0] + sgn * b0[0] * cs[0][1]; v0[1] = v0[1] * cs[0][2] + sgn * b0[1] * cs[0][3];
                        v0[2] = v0[2] * cs[1][0] + sgn * b0[2] * cs[1][1]; v0[3] = v0[3] * cs[1][2] + sgn * b0[3] * cs[1][3];
                        v1[0] = v1[0] * cs[2][0] + sgn * b1[0] * cs[2][1]; v1[1] = v1[1] * cs[2][2] + sgn * b1[1] * cs[2][3];
                        v1[2] = v1[2] * cs[3][0] + sgn * b1[2] * cs[3][1]; v1[3] = v1[3] * cs[3][2] + sgn * b1[3] * cs[3][3];
                    }
                    if (do_gelu) {
#pragma unroll
                        for (int j = 0; j < 4; ++j) { v0[j] = gelu_fast(v0[j]); v1[j] = gelu_fast(v1[j]); }
                    }
                    v0 = v0 * sc; v1 = v1 * sc;
                    u32x4 w; w.x = cvtpk(v0[0], v0[1]); w.y = cvtpk(v0[2], v0[3]); w.z = cvtpk(v1[0], v1[1]); w.w = cvtpk(v1[2], v1[3]);
                    *(u32x4*)(rowp + bj * 128) = w;
                }
            }
    }
};
struct EpiOut {
    static constexpr bool PERM = false, AFTER_DRAIN = false;
    float* X; const float* gate; const float* res_lat; const float* res_ctx;
    __device__ __forceinline__ void operator()(const f32x4 (&acc)[2][2][4][2], const pg8::Unit& u, int wr, int wc, int fr, int fq) const {
        const int row0 = u.pm * 256 + wr * 64 + fr, col0 = u.pn * 256 + wc * 32 + 4 * fq;
        const float* g = gate + (size_t)mod_row(u.pm * 256) * 6144 + col0;
        f32x4 gv[2][2];
#pragma unroll
        for (int bj = 0; bj < 2; ++bj)
#pragma unroll
            for (int n = 0; n < 2; ++n) gv[bj][n] = *(const f32x4*)(g + bj * 128 + n * 16);
#pragma unroll
        for (int ai = 0; ai < 2; ++ai)
#pragma unroll
            for (int m = 0; m < 4; ++m) { const size_t off = (size_t)(row0 + ai * 128 + m * 16) * D + col0; float* xp = X + off; const float* rp = (u.pm < T / 256 ? res_lat : res_ctx) + off;
#pragma unroll
                for (int bj = 0; bj < 2; ++bj)
#pragma unroll
                    for (int n = 0; n < 2; ++n) { *(f32x4*)(xp + bj * 128 + n * 16) = *(const f32x4*)(rp + bj * 128 + n * 16) + gv[bj][n] * acc[ai][bj][m][n]; } }
    }
};
__device__ __forceinline__ float swiglu(float g, float u) {
    const float gt = fminf(g, 7.0f), up = fminf(fmaxf(u, -7.0f), 7.0f);
    return (up + 1.0f) * gt / (1.0f + __expf(-1.702f * gt));
}
struct EpiAct {
    static constexpr bool PERM = true, AFTER_DRAIN = false;
    bf16_t* ACT; const float* bgu;
    __device__ __forceinline__ void operator()(const f32x4 (&acc)[2][2][4][2], const pg8::Unit& u, int wr, int wc, int fr, int fq) const {
        const int row0 = u.pm * 256 + wr * 64 + fr, j0 = (u.pn * 256 + wc * 32 + 8 * fq) >> 1;
        const float* bp = bgu + (size_t)u.e * 2048 + j0;
        f32x4 bg[2], bu[2];
#pragma unroll
        for (int bj = 0; bj < 2; ++bj) { bg[bj] = *(const f32x4*)(bp + bj * 64); bu[bj] = *(const f32x4*)(bp + 1024 + bj * 64); }
#pragma unroll
        for (int ai = 0; ai < 2; ++ai)
#pragma unroll
            for (int m = 0; m < 4; ++m) { bf16_t* rowp = ACT + (size_t)(row0 + ai * 128 + m * 16) * FF + j0;
#pragma unroll
                for (int bj = 0; bj < 2; ++bj) { const f32x4 v0 = acc[ai][bj][m][0], v1 = acc[ai][bj][m][1];
                    const float a0 = swiglu(v0[0] + bg[bj][0], v0[1] + bu[bj][0]), a1 = swiglu(v0[2] + bg[bj][1], v0[3] + bu[bj][1]);
                    const float a2 = swiglu(v1[0] + bg[bj][2], v1[1] + bu[bj][2]), a3 = swiglu(v1[2] + bg[bj][3], v1[3] + bu[bj][3]);
                    uint2 w; w.x = cvtpk(a0, a1); w.y = cvtpk(a2, a3);
                    *(uint2*)(rowp + bj * 64) = w; } }
    }
};
struct EpiYB {
    static constexpr bool PERM = true, AFTER_DRAIN = false;
    bf16_t* YB; const float* bdn;
    __device__ __forceinline__ void operator()(const f32x4 (&acc)[2][2][4][2], const pg8::Unit& u, int wr, int wc, int fr, int fq) const {
        const int row0 = u.pm * 256 + wr * 64 + fr, col0 = u.pn * 256 + wc * 32 + 8 * fq;
        const float* bp = bdn + (size_t)u.e * D + col0;
        f32x4 bv[2][2];
#pragma unroll
        for (int bj = 0; bj < 2; ++bj)
#pragma unroll
            for (int n = 0; n < 2; ++n) bv[bj][n] = *(const f32x4*)(bp + bj * 128 + n * 4);
#pragma unroll
        for (int ai = 0; ai < 2; ++ai)
#pragma unroll
            for (int m = 0; m < 4; ++m) { bf16_t* rowp = YB + (size_t)(row0 + ai * 128 + m * 16) * D + col0;
#pragma unroll
                for (int bj = 0; bj < 2; ++bj) { const f32x4 v0 = acc[ai][bj][m][0] + bv[bj][0], v1 = acc[ai][bj][m][1] + bv[bj][1];
                    u32x4 w; w.x = cvtpk(v0[0], v0[1]); w.y = cvtpk(v0[2], v0[3]); w.z = cvtpk(v1[0], v1[1]); w.w = cvtpk(v1[2], v1[3]);
                    *(u32x4*)(rowp + bj * 128) = w; } }
    }
};
struct MoeOrder {
    int nN, nunits, G, v; const int* tile_e;
    __device__ void init(int ntiles, int nN_, int G_, int c, const int* te) { nN = nN_; nunits = ntiles * nN_; G = G_; v = (G_ % 8 == 0) ? (c % 8) * (G_ / 8) + c / 8 : c; tile_e = te; }
    __device__ bool next(int i, pg8::Unit& u) const {
        const int L = i * G + v; if (L >= nunits) return false;
        u.pm = L / nN; u.pn = L % nN; u.e = tile_e[u.pm]; return true;
    }
    __device__ __forceinline__ const bf16_t* bt(const pg8::Gemm& g, const pg8::Unit& u) const { return g.Bt + (size_t)u.e * g.N * g.K; }
    __device__ __forceinline__ void a_ready(const pg8::Unit&) const {}
    __device__ __forceinline__ void done(const pg8::Unit&) const {}
};

__device__ __forceinline__ void ph_gemm_proj(const P& p, int l, char* lds) {
    pg8::Gemm g{p.H, p.WinT + (size_t)l * PW * D, R, PW, D}; pg8::StaticOrder S; S.init(R, PW, (int)gridDim.x, (int)blockIdx.x);
    EpiProj E{p.PROJ, p.rope};
    pg8::gemm_phase<EpiProj, pg8::StaticOrder, true, true>((PG8_LAS unsigned char*)lds, g, S, E);
}
__device__ __forceinline__ void ph_gemm_out(const P& p, int l, int nrows, char* lds) {
    pg8::Gemm g{p.MIX, p.WoutT + (size_t)l * D * D, nrows, D, D}; pg8::StaticOrder S; S.init(nrows, D, (int)gridDim.x, (int)blockIdx.x);
    EpiOut E{p.X, p.mod + (size_t)l * 5 * 6144 + 2 * 1024, l == 0 ? p.x : p.X, l == 0 ? p.ctx - (size_t)T * D : p.X};
    pg8::gemm_phase<EpiOut, pg8::StaticOrder, true, true>((PG8_LAS unsigned char*)lds, g, S, E);
}
__device__ __forceinline__ void ph_moe1(const P& p, int l, char* lds) {
    const int* meta = p.moe_meta + l * 512;
    const int ntiles = meta[0];
    pg8::Gemm g{p.HS, p.WguT + (size_t)l * NE * 2048 * D, ntiles * 256, 2048, D}; MoeOrder S; S.init(ntiles, 8, (int)gridDim.x, (int)blockIdx.x, meta + 1);
    EpiAct E{p.ACT, p.b_gu + (size_t)l * NE * 2048};
    pg8::gemm_phase<EpiAct, MoeOrder, true, true>((PG8_LAS unsigned char*)lds, g, S, E);
}
__device__ __forceinline__ void ph_moe2(const P& p, int l, char* lds) {
    const int* meta = p.moe_meta + l * 512;
    const int ntiles = meta[0];
    pg8::Gemm g{p.ACT, p.WdnT + (size_t)l * NE * D * FF, ntiles * 256, D, FF}; MoeOrder S; S.init(ntiles, 4, (int)gridDim.x, (int)blockIdx.x, meta + 1);
    EpiYB E{p.YB, p.b_down + (size_t)l * NE * D};
    pg8::gemm_phase<EpiYB, MoeOrder, true, true>((PG8_LAS unsigned char*)lds, g, S, E);
}
__device__ __forceinline__ void ph_combine(const P& p, int l, int nrows) {
    const int wave = ltid() >> 6, lane = ltid() & 63;
    for (int row = blockIdx.x * 8 + wave; row < nrows; row += gridDim.x * 8) {
        const int4 sl = *(const int4*)(p.tok_slot + (size_t)row * 4);
        const float4 g = *(const float4*)(p.topg + (size_t)row * 4);
        const float* m = p.mod + ((size_t)l * 5 + mod_row(row)) * 6144 + 5 * 1024;
        float xv[16]; float ss = 0.f;
#pragma unroll
        for (int i = 0; i < 2; ++i) {
            const int k = lane * 8 + 512 * i;
            const uint4 y0 = *(const uint4*)(p.YB + (size_t)sl.x * D + k), y1 = *(const uint4*)(p.YB + (size_t)sl.y * D + k);
            const uint4 y2 = *(const uint4*)(p.YB + (size_t)sl.z * D + k), y3 = *(const uint4*)(p.YB + (size_t)sl.w * D + k);
            const unsigned a0[4] = {y0.x, y0.y, y0.z, y0.w}, a1[4] = {y1.x, y1.y, y1.z, y1.w}, a2[4] = {y2.x, y2.y, y2.z, y2.w}, a3[4] = {y3.x, y3.y, y3.z, y3.w};
            const float* xp = p.X + (size_t)row * D + k;
            const float4 gta = *(const float4*)(m + k), gtb = *(const float4*)(m + k + 4);
            const float4 xa = *(const float4*)xp, xb = *(const float4*)(xp + 4);
            const float gt[8] = {gta.x, gta.y, gta.z, gta.w, gtb.x, gtb.y, gtb.z, gtb.w};
            const float x8[8] = {xa.x, xa.y, xa.z, xa.w, xb.x, xb.y, xb.z, xb.w};
#pragma unroll
            for (int q = 0; q < 4; ++q) {
                const float ylo = g.x * __uint_as_float(a0[q] << 16) + g.y * __uint_as_float(a1[q] << 16) + g.z * __uint_as_float(a2[q] << 16) + g.w * __uint_as_float(a3[q] << 16);
                const float yhi = g.x * __uint_as_float(a0[q] & 0xffff0000u) + g.y * __uint_as_float(a1[q] & 0xffff0000u) + g.z * __uint_as_float(a2[q] & 0xffff0000u) + g.w * __uint_as_float(a3[q] & 0xffff0000u);
                const float v0 = x8[2 * q] + gt[2 * q] * ylo, v1 = x8[2 * q + 1] + gt[2 * q + 1] * yhi;
                xv[8 * i + 2 * q] = v0; xv[8 * i + 2 * q + 1] = v1; ss += v0 * v0 + v1 * v1;
            }
        }
        ss = wave_sum(ss);
        const float rstd = rsqrtf(ss * (1.f / D) + EPS);
        if (l == 0) {
            const float* m1 = p.mod + ((size_t)5 + mod_row(row)) * 6144;
            const float* g1 = p.g_mix + D;
#pragma unroll
            for (int i = 0; i < 2; ++i) {
                const int k = lane * 8 + 512 * i;
                float* xp = p.X + (size_t)row * D + k;
                *(float4*)xp = make_float4(xv[8 * i], xv[8 * i + 1], xv[8 * i + 2], xv[8 * i + 3]);
                *(float4*)(xp + 4) = make_float4(xv[8 * i + 4], xv[8 * i + 5], xv[8 * i + 6], xv[8 * i + 7]);
                const float4 ga = *(const float4*)(g1 + k), gb = *(const float4*)(g1 + k + 4);
                const float4 sha = *(const float4*)(m1 + k), shb = *(const float4*)(m1 + k + 4);
                const float4 sca = *(const float4*)(m1 + 1024 + k), scb = *(const float4*)(m1 + 1024 + k + 4);
                u32x4 o;
                o.x = cvtpk(xv[8 * i] * rstd * ga.x * (1.f + sca.x) + sha.x, xv[8 * i + 1] * rstd * ga.y * (1.f + sca.y) + sha.y);
                o.y = cvtpk(xv[8 * i + 2] * rstd * ga.z * (1.f + sca.z) + sha.z, xv[8 * i + 3] * rstd * ga.w * (1.f + sca.w) + sha.w);
                o.z = cvtpk(xv[8 * i + 4] * rstd * gb.x * (1.f + scb.x) + shb.x, xv[8 * i + 5] * rstd * gb.y * (1.f + scb.y) + shb.y);
                o.w = cvtpk(xv[8 * i + 6] * rstd * gb.z * (1.f + scb.z) + shb.z, xv[8 * i + 7] * rstd * gb.w * (1.f + scb.w) + shb.w);
                *(u32x4*)(p.H + (size_t)row * D + k) = o;
            }
        } else {
#pragma unroll
            for (int i = 0; i < 2; ++i) {
                const int k = lane * 8 + 512 * i;
                const float4 ga = *(const float4*)(p.g_final + k), gb = *(const float4*)(p.g_final + k + 4);
                float* op = p.out + (size_t)row * D + k;
                *(float4*)op = make_float4(xv[8 * i] * rstd * ga.x, xv[8 * i + 1] * rstd * ga.y, xv[8 * i + 2] * rstd * ga.z, xv[8 * i + 3] * rstd * ga.w);
                *(float4*)(op + 4) = make_float4(xv[8 * i + 4] * rstd * gb.x, xv[8 * i + 5] * rstd * gb.y, xv[8 * i + 6] * rstd * gb.z, xv[8 * i + 7] * rstd * gb.w);
            }
        }
    }
}
#ifndef PROBE_DUP
#define PROBE_DUP 0
#endif
extern __shared__ __attribute__((aligned(16))) char smem[];
__global__ void __launch_bounds__(NT, 2) mega(P p) {
    char* lds = smem;
    if (threadIdx.x == 0) *(uint4*)(smem + LDS_MAIN) = make_uint4(0u, 0u, 0u, 0u);
    __syncthreads();
    XcdBarrier bar = xcd_barrier_post(p.bar, (volatile LAS unsigned*)(smem + LDS_MAIN));
    ph_prologue(p, lds, 0);
    xcd_barrier(bar);
    ph_norm1(p, 0);
    ph_prologue(p, lds, 1);
    xcd_barrier(bar);
#pragma unroll
    for (int l = 0; l < 2; ++l) {
        const int nrows = l == 0 ? R : T;
        ph_gemm_proj(p, l, lds);
        xcd_barrier(bar);
        ph_dattn(p, l, nrows, lds);
        ph_na(p, l, nrows, lds);
        ph_pool(p, l, nrows, lds);
        ph_sgu(p, l, nrows, lds);
        xcd_barrier(bar);
        ph_gemm_out(p, l, nrows, lds);
        xcd_barrier(bar);
        ph_router(p, l, nrows, lds);
        xcd_barrier(bar);
        ph_assign(p, l, nrows, lds);
        xcd_barrier(bar);
        ph_moe1(p, l, lds);
        xcd_barrier(bar);
        ph_moe2(p, l, lds);
        xcd_barrier(bar);
        ph_combine(p, l, nrows);
        if (l == 0) xcd_barrier(bar);
    }
}

static inline size_t align_up(size_t v, size_t a) { return (v + a - 1) / a * a; }

extern "C" void kernel_launch(void* const* d_in, const int* in_sizes, int n_in, void* d_out, int out_size, void* d_ws, size_t ws_size, hipStream_t stream) {
    P p{};
    const float** ins = (const float**)&p.x;
    for (int i = 0; i < 28; ++i) ins[i] = (const float*)d_in[i];
    p.out = (float*)d_out;
    char* w = (char*)d_ws; size_t off = 0;
    auto carve = [&](size_t bytes) { void* r = w + off; off = align_up(off + bytes, 256); return r; };
    const size_t ctl_bytes = XCD_BAR_WORDS * 4 + 2 * 64 * 4;
    p.bar = (unsigned*)carve(ctl_bytes);
    p.cnt = (int*)(p.bar + XCD_BAR_WORDS);
    p.mod = (float*)carve((size_t)2 * 5 * 6144 * 4);
    p.rope = (float*)carve(64 * 8 * 2 * 4);
    p.X = (float*)carve((size_t)R * D * 4);
    p.H = (bf16_t*)carve((size_t)R * D * 2);
    p.PROJ = (bf16_t*)carve((size_t)R * PW * 2);
    p.MIX = (bf16_t*)carve((size_t)R * D * 2);
    p.WinT = (bf16_t*)carve((size_t)2 * PW * D * 2);
    p.WoutT = (bf16_t*)carve((size_t)2 * D * D * 2);
    p.WguT = (bf16_t*)carve((size_t)2 * NE * 2048 * D * 2);
    p.WdnT = (bf16_t*)carve((size_t)2 * NE * D * FF * 2);
    p.WpT = (bf16_t*)carve((size_t)2 * 4 * 64 * 64 * 2);
    p.WsB = (bf16_t*)carve((size_t)2 * 4 * 128 * 128 * 2);
    p.topi = (int*)carve((size_t)R * 4 * 4);
    p.topg = (float*)carve((size_t)R * 4 * 4);
    p.tok_slot = (int*)carve((size_t)R * 4 * 4);
    p.moe_meta = (int*)carve(2 * 512 * 4);
    p.HS = (bf16_t*)carve((size_t)NSLOT * D * 2);
    p.ACT = (bf16_t*)carve((size_t)NSLOT * FF * 2);
    p.YB = (bf16_t*)carve((size_t)NSLOT * D * 2);

    static int grid = 0;
    if (!grid) {
        int dev = 0, cus = 0, per_cu = 0;
        (void)hipGetDevice(&dev);
        (void)hipDeviceGetAttribute(&cus, hipDeviceAttributeMultiprocessorCount, dev);
        (void)hipFuncSetAttribute((const void*)mega, hipFuncAttributeMaxDynamicSharedMemorySize, LDS_BYTES);
        (void)hipOccupancyMaxActiveBlocksPerMultiprocessor(&per_cu, mega, NT, LDS_BYTES);
        grid = cus * (per_cu < 1 ? per_cu : 1);
        if (grid <= 0) { fprintf(stderr, "mega: occupancy query returned %d blocks per CU\n", per_cu); grid = 0; return; }
    }
    (void)hipMemsetAsync(p.bar, 0, ctl_bytes, stream);
    mega<<<grid, NT, LDS_BYTES, stream>>>(p);
}
```

```cpp
#include <hip/hip_runtime.h>
#include <stdint.h>
#include <cstdio>

typedef unsigned short bf16_t;
typedef short bf16x8 __attribute__((ext_vector_type(8)));
typedef float f32x4 __attribute__((ext_vector_type(4)));

constexpr int D = 1024, NB = 4, S = 4096, T = NB * S, CL = 256, TC = NB * CL, R = T + TC;
constexpr int PW = 2304, NE = 32, TOPK = 4, FF = 1024;
constexpr int MAXSLOT = R * TOPK;
constexpr int NSLOT = MAXSLOT + NE * 256;
constexpr float EPS = 1e-6f;
constexpr int NT = 512;
constexpr int LDS_MAIN = 150 * 1024;
constexpr int LDS_BYTES = LDS_MAIN + 1024;

__device__ __forceinline__ bf16_t f2bf(float f) { unsigned u = __float_as_uint(f); return (bf16_t)((u + 0x7fffu + ((u >> 16) & 1u)) >> 16); }
__device__ __forceinline__ float bf2f(bf16_t h) { return __uint_as_float(((unsigned)h) << 16); }
__device__ __forceinline__ float wave_sum(float v) {
#pragma unroll
    for (int o = 32; o >= 1; o >>= 1) v += __shfl_xor(v, o);
    return v;
}
__device__ __forceinline__ int mod_row(int row) { return row < T ? (row >> 12) : 4; }

#define XB_TMO      128
#define XB_XCNT(j)  (256  + 64 * (j))
#define XB_XSUB(j)  (1280 + 64 * (j))
#define XB_XGEN(j)  (2304 + 64 * (j))
#define XB_TOP      3328
#define XB_TOPGEN   3392
#define XCD_BAR_WORDS 3456
#define XB_SPIN_CAP (1u << 18)
#define LAS __attribute__((address_space(3)))

__device__ __forceinline__ unsigned xb_ld(unsigned* p)              { return __hip_atomic_load(p, __ATOMIC_RELAXED, __HIP_MEMORY_SCOPE_AGENT); }
__device__ __forceinline__ unsigned xb_add(unsigned* p, unsigned v) { return __hip_atomic_fetch_add(p, v, __ATOMIC_RELAXED, __HIP_MEMORY_SCOPE_AGENT); }
__device__ __forceinline__ unsigned xb_xcc_id() { return (unsigned)__builtin_amdgcn_s_getreg((3 << 11) | 20) & 0xFu; }
#define XB_SPIN(cond, bar) do { unsigned _sp = 0; while (cond) { __builtin_amdgcn_s_sleep(1); \
    if ((++_sp & 255u) == 0u) { if (xb_ld(&(bar)[XB_TMO])) break; if (_sp > XB_SPIN_CAP) { atomicAdd(&(bar)[XB_TMO], 1u); break; } } } } while (0)

struct XcdBarrier {
    unsigned* bar; unsigned x;
    volatile LAS unsigned* st;
};
__device__ __forceinline__ XcdBarrier xcd_barrier_post(unsigned* bar, volatile LAS unsigned* st) {
    XcdBarrier b; b.bar = bar; b.x = xb_xcc_id(); b.st = st;
    if (threadIdx.x == 0) (void)xb_add(&bar[XB_XCNT(b.x)], 1u);
    return b;
}
__device__ __forceinline__ void xcd_barrier_complete(unsigned* bar, unsigned x, unsigned& nloc, unsigned& nx) {
    const unsigned G = gridDim.x * gridDim.y * gridDim.z;
    unsigned sum, cnt, mine, sp = 0u;
    for (;;) {
        sum = 0u; cnt = 0u; mine = 0u;
#pragma unroll
        for (unsigned j = 0; j < 16; ++j) { const unsigned c = xb_ld(&bar[XB_XCNT(j)]); sum += c; cnt += (c > 0u) ? 1u : 0u; mine = (j == x) ? c : mine; }
        if (sum == G) break;
        __builtin_amdgcn_s_sleep(1);
        if ((++sp & 255u) == 0u) { if (xb_ld(&bar[XB_TMO])) break; if (sp > XB_SPIN_CAP) { atomicAdd(&bar[XB_TMO], 1u); break; } }
    }
    nloc = mine > 0u ? mine : 1u; nx = cnt > 0u ? cnt : 1u;
}
__device__ __forceinline__ void xcd_barrier(const XcdBarrier& b) {
    asm volatile("s_waitcnt vmcnt(0)" ::: "memory");
    __syncthreads();
    if (threadIdx.x == 0) {
        unsigned* bar = b.bar;
        __builtin_amdgcn_s_waitcnt(0);
        unsigned nloc = b.st[0], nx = b.st[1];
        if (nloc == 0u) { xcd_barrier_complete(bar, b.x, nloc, nx); b.st[0] = nloc; b.st[1] = nx; }
        const unsigned old = xb_add(&bar[XB_XSUB(b.x)], 1u);
        const unsigned gen = old / nloc;
        if (old + 1u == (gen + 1u) * nloc) {
            __builtin_amdgcn_fence(__ATOMIC_RELEASE, "agent");
            asm volatile("s_waitcnt vmcnt(0)" ::: "memory");
            const unsigned og = xb_add(&bar[XB_TOP], 1u);
            const unsigned tg = og / nx;
            if (og + 1u == (tg + 1u) * nx) xb_add(&bar[XB_TOPGEN], 1u);
            else XB_SPIN(xb_ld(&bar[XB_TOPGEN]) == tg, bar);
            __builtin_amdgcn_fence(__ATOMIC_ACQUIRE, "agent");
            xb_add(&bar[XB_XGEN(b.x)], 1u);
            asm volatile("s_waitcnt vmcnt(0)" ::: "memory");
        } else {
            XB_SPIN(xb_ld(&bar[XB_XGEN(b.x)]) == gen, bar);
            __builtin_amdgcn_fence(__ATOMIC_ACQUIRE, "agent");
            asm volatile("s_waitcnt vmcnt(0)" ::: "memory");
        }
    }
    __syncthreads();
}

struct P {
    const float *x, *c, *ctx, *c_ctx, *w_mod, *b_mod, *g_mix, *g_ffn, *w_in, *w_out, *lam_q1, *lam_k1, *lam_q2, *lam_k2, *g_sub,
        *w_pool, *s_pool, *g_sgu, *w_sgu, *b_sgu, *rpb, *w_router, *b_router, *w_gu, *b_gu, *w_down, *b_down, *g_final;
    float* out;
    unsigned* bar;
    int* cnt;
    float* mod;
    float* rope;
    float* X;
    bf16_t* H;
    bf16_t* PROJ;
    bf16_t* MIX;
    bf16_t* WinT;
    bf16_t* WoutT;
    unsigned char* WguT;
    unsigned char* WdnT;
    bf16_t* WpT;
    bf16_t* WsB;
    int* topi;
    float* topg;
    int* tok_slot;
    int* moe_meta;
    unsigned char* HS;
    unsigned char* ACT;
    bf16_t* YB;
};

__device__ __forceinline__ int ltid() { int t = threadIdx.x; asm volatile("" : "+v"(t)); return t; }
typedef float f32x16 __attribute__((ext_vector_type(16)));
typedef short s16x4 __attribute__((ext_vector_type(4)));
typedef short v4i16_t __attribute__((ext_vector_type(4)));
typedef float f32x2_t __attribute__((ext_vector_type(2)));
typedef __bf16 bf16x2_t __attribute__((ext_vector_type(2)));
typedef __attribute__((address_space(3))) const char* lds_cptr;
typedef unsigned u32x4 __attribute__((ext_vector_type(4)));
__device__ __forceinline__ unsigned cvtpk(float lo, float hi) { f32x2_t v = {lo, hi}; bf16x2_t b = __builtin_convertvector(v, bf16x2_t); return __builtin_bit_cast(unsigned, b); }
__device__ __forceinline__ s16x4 vtr(lds_cptr q) { return __builtin_bit_cast(s16x4, __builtin_amdgcn_ds_read_tr16_b64_v4i16((__attribute__((address_space(3))) v4i16_t*)q)); }
__device__ __forceinline__ float xhalf_max(float v) { auto rr = __builtin_amdgcn_permlane32_swap(__float_as_uint(v), __float_as_uint(v), false, false); return fmaxf(__uint_as_float(rr[0]), __uint_as_float(rr[1])); }
__device__ __forceinline__ float xhalf_sum(float v) { auto rr = __builtin_amdgcn_permlane32_swap(__float_as_uint(v), __float_as_uint(v), false, false); return __uint_as_float(rr[0]) + __uint_as_float(rr[1]); }
namespace pg8 {
#define PG8_LAS __attribute__((address_space(3)))
constexpr int BM = 256, BK = 64, HALF = 128, HTB = HALF * BK * 2  , STAGE_BYTES = 8 * HTB, NXCD = 8, WGM = 8;
__host__ __device__ __forceinline__ int lds_byte(int r, int c) { const int st = (r >> 4) * 2 + (c >> 5), rr = r & 15, cc = c & 31, ob = rr * 64 + cc * 2; return st * 1024 + (ob ^ (((ob >> 9) & 1) << 5)); }
__host__ __device__ __forceinline__ void stage_rc(int b, int& R, int& C) { const int st = b / 1024, sb = b % 1024, swz = sb ^ (((sb >> 9) & 1) << 5); R = (st >> 1) * 16 + swz / 64; C = (st & 1) * 32 + (swz % 64) / 2; }
__host__ __device__ __forceinline__ int perm32(int rho) { const int n = rho >> 4, i = rho & 15; return 8 * (i >> 2) + 4 * n + (i & 3); }
struct Unit { int pm, pn, e; };
struct Gemm { const bf16_t* A; const bf16_t* Bt; int M, N, K; };
struct StaticOrder {
    int nM, nN, nwg, G, c;
    __host__ __device__ void init(int M, int N, int G_, int c_) { nM = M / BM; nN = N / BM; nwg = nM * nN; G = G_; c = c_; }
    __host__ __device__ bool next(int i, Unit& u) const {
        const long L = (long)i * G + c; if (L >= nwg) return false;
        int wgid = (int)L; { const int q = nwg / NXCD, r = nwg % NXCD, xcd = wgid % NXCD, off = wgid / NXCD; wgid = (xcd < r ? xcd * (q + 1) : r * (q + 1) + (xcd - r) * q) + off; }
        const int nig = WGM * nN, gid = wgid / nig, fm = gid * WGM, gsz = (nM - fm) < WGM ? (nM - fm) : WGM;
        u.pm = fm + ((wgid % nig) % gsz); u.pn = (wgid % nig) / gsz; u.e = 0; return true;
    }
    __device__ __forceinline__ const bf16_t* bt(const Gemm& g, const Unit&) const { return g.Bt; }
    __device__ __forceinline__ void a_ready(const Unit&) const {}
    __device__ __forceinline__ void done(const Unit&) const {}
};
typedef int v4i_t __attribute__((ext_vector_type(4)));
typedef int v8i_t __attribute__((ext_vector_type(8)));
__device__ __forceinline__ v8i_t cat8(bf16x8 a, bf16x8 b) { const v4i_t x = __builtin_bit_cast(v4i_t, a), y = __builtin_bit_cast(v4i_t, b); return __builtin_shufflevector(x, y, 0, 1, 2, 3, 4, 5, 6, 7); }
template <class Epi, class Sched, bool ALIGN_EPI = false, bool SP2 = false, bool F8 = false>
__device__ __forceinline__ void gemm_phase(PG8_LAS unsigned char* lds, const Gemm g, const Sched& S, const Epi& E) {
    const int tid = ltid(), wid = __builtin_amdgcn_readfirstlane(tid >> 6), lane = tid & 63, wr = wid >> 2, wc = wid & 3, fr = lane & 15, fq = lane >> 4;
    const int K = g.K, nt = K / BK;
    unsigned voffA[2], voffB[2];
#pragma unroll
    for (int i = 0; i < 2; ++i) { int R, C; stage_rc(tid * 16 + i * 8192, R, C); const int Rb = Epi::PERM ? ((R & ~31) + perm32(R & 31)) : R;
        voffA[i] = (unsigned)(R * K + C) * 2u; voffB[i] = (unsigned)(Rb * K + C) * 2u; }
    const size_t kstep = (size_t)(BK * 2);
    const size_t hstep = (size_t)HALF * K * 2;
    const size_t tstep = 2 * hstep;
    const unsigned ldsw = (unsigned)wid * 1024u;
    const int aoff = lds_byte(wr * 64 + fr, fq * 8), boff = lds_byte(wc * 32 + fr, fq * 8);
#define PG8_SA(b, h) (((b) * 2 + (h)) * HTB)
#define PG8_SB(b, h) ((4 + (b) * 2 + (h)) * HTB)
#define PG8_STAGE(bufoff, gbase, voff) do { _Pragma("unroll") for (int _i = 0; _i < 2; ++_i) \
        __builtin_amdgcn_global_load_lds((const unsigned*)((const char*)(gbase) + (voff)[_i]), (PG8_LAS unsigned*)(lds + (bufoff) + ldsw + _i * 8192), 16, 0, 0); } while (0)
#define PG8_LDA(dst, b, h) do { _Pragma("unroll") for (int m = 0; m < 4; ++m) _Pragma("unroll") for (int k = 0; k < 2; ++k) dst[m][k] = *(const PG8_LAS bf16x8*)(lds + PG8_SA(b, h) + aoff + m * 2048 + k * 1024); \
        if constexpr (F8) { _Pragma("unroll") for (int m = 0; m < 4; ++m) dst##8[m] = cat8(dst[m][0], dst[m][1]); } } while (0)
#define PG8_LDB(dst, b, h) do { _Pragma("unroll") for (int n = 0; n < 2; ++n) _Pragma("unroll") for (int k = 0; k < 2; ++k) dst[n][k] = *(const PG8_LAS bf16x8*)(lds + PG8_SB(b, h) + boff + n * 2048 + k * 1024); \
        if constexpr (F8) { _Pragma("unroll") for (int n = 0; n < 2; ++n) dst##8[n] = cat8(dst[n][0], dst[n][1]); } } while (0)
#define PG8_MMA(ai, bj, At, Bt) do { __builtin_amdgcn_s_setprio(1); \
        if constexpr (F8) { _Pragma("unroll") for (int m = 0; m < 4; ++m) _Pragma("unroll") for (int n = 0; n < 2; ++n) \
            asm volatile("v_mfma_scale_f32_16x16x128_f8f6f4 %0, %1, %2, %0, %3, %4 op_sel_hi:[0,0,0]" : "+v"(acc[ai][bj][m][n]) : "v"(Bt##8[n]), "v"(At##8[m]), "v"(sclW), "v"(sclX)); } \
        else { _Pragma("unroll") for (int m = 0; m < 4; ++m) _Pragma("unroll") for (int n = 0; n < 2; ++n) _Pragma("unroll") for (int k = 0; k < 2; ++k) \
            acc[ai][bj][m][n] = __builtin_amdgcn_mfma_f32_16x16x32_bf16(Bt[n][k], At[m][k], acc[ai][bj][m][n], 0, 0, 0); } \
        __builtin_amdgcn_s_setprio(0); } while (0)
#define PG8_WAIT_V(n) asm volatile("s_waitcnt vmcnt(" #n ")" ::: "memory")
#define PG8_WAIT_L(n) asm volatile("s_waitcnt lgkmcnt(" #n ")" ::: "memory")
#define PG8_BAR __builtin_amdgcn_s_barrier()
#define PG8_SCHED __builtin_amdgcn_sched_barrier(0)
    Unit cur, nxt; int ui = 0;
    if (!S.next(0, cur)) return;
    f32x4 acc[2][2][4][2];
#pragma unroll
    for (int a = 0; a < 2; ++a)
#pragma unroll
        for (int b = 0; b < 2; ++b)
#pragma unroll
            for (int m = 0; m < 4; ++m)
#pragma unroll
                for (int n = 0; n < 2; ++n) { acc[a][b][m][n] = (f32x4){0.f, 0.f, 0.f, 0.f}; }
    bf16x8 At[4][2], B0[2][2], B1[2][2];
    v8i_t At8[4], B08[2], B18[2];
    const int sclW = 0x79797979, sclX = 0x7f7f7f7f;
    const char* cA = (const char*)g.A + (size_t)cur.pm * tstep; const char* cB = (const char*)S.bt(g, cur) + (size_t)cur.pn * tstep;
    S.a_ready(cur);
    if constexpr (SP2) {
        PG8_STAGE(PG8_SB(0, 0), cB, voffB); PG8_STAGE(PG8_SB(0, 1), cB + hstep, voffB); PG8_STAGE(PG8_SA(0, 0), cA, voffA); PG8_STAGE(PG8_SA(0, 1), cA + hstep, voffA);
        if (wr == 1) PG8_BAR;
        PG8_WAIT_V(2); PG8_BAR;
        PG8_STAGE(PG8_SB(1, 0), cB + kstep, voffB); PG8_STAGE(PG8_SA(1, 0), cA + kstep, voffA); PG8_STAGE(PG8_SB(1, 1), cB + hstep + kstep, voffB);
        PG8_WAIT_V(6); PG8_BAR;
    } else {
        PG8_STAGE(PG8_SB(0, 0), cB, voffB); PG8_STAGE(PG8_SA(0, 0), cA, voffA); PG8_STAGE(PG8_SB(0, 1), cB + hstep, voffB); PG8_STAGE(PG8_SA(0, 1), cA + hstep, voffA);
        if (wr == 1) PG8_BAR;
        PG8_WAIT_V(4); PG8_BAR;
        PG8_STAGE(PG8_SB(1, 0), cB + kstep, voffB); PG8_STAGE(PG8_SA(1, 0), cA + kstep, voffA); PG8_STAGE(PG8_SB(1, 1), cB + hstep + kstep, voffB);
        PG8_WAIT_V(6); PG8_BAR;
    }
    for (;;) {
        const bool has_next = S.next(ui + 1, nxt);
        const char* nA = has_next ? (const char*)g.A + (size_t)nxt.pm * tstep : cA; const char* nB = has_next ? (const char*)S.bt(g, nxt) + (size_t)nxt.pn * tstep : cB;
#pragma unroll 1
        for (int t = 0; t < nt; t += 2) {
            const bool last = (t == nt - 2);
            const char* a1 = cA + (size_t)(t + 1) * kstep;
            const char* a2 = last ? nA : cA + (size_t)(t + 2) * kstep; const char* b2 = last ? nB : cB + (size_t)(t + 2) * kstep;
            const char* a3 = a2 + kstep; const char* b3 = b2 + kstep;
            if (last && has_next) S.a_ready(nxt);
            if constexpr (SP2) {
            PG8_LDB(B0, 0, 0); PG8_LDB(B1, 0, 1); PG8_SCHED; PG8_LDA(At, 0, 0); PG8_STAGE(PG8_SA(1, 1), a1 + hstep, voffA);
            PG8_WAIT_V(8); PG8_WAIT_L(0); PG8_BAR; PG8_MMA(0, 0, At, B0); PG8_MMA(0, 1, At, B1); PG8_BAR; PG8_SCHED;
            PG8_LDA(At, 0, 1); PG8_STAGE(PG8_SB(0, 0), b2, voffB); PG8_STAGE(PG8_SB(0, 1), b2 + hstep, voffB); PG8_STAGE(PG8_SA(0, 0), a2, voffA);
            PG8_WAIT_V(8); PG8_WAIT_L(0); PG8_BAR; PG8_MMA(1, 0, At, B0); PG8_MMA(1, 1, At, B1); PG8_BAR; PG8_SCHED;
            PG8_LDB(B0, 1, 0); PG8_LDB(B1, 1, 1); PG8_SCHED; PG8_LDA(At, 1, 0); PG8_STAGE(PG8_SA(0, 1), a2 + hstep, voffA);
            PG8_WAIT_V(8); PG8_WAIT_L(0); PG8_BAR; PG8_MMA(0, 0, At, B0); PG8_MMA(0, 1, At, B1); PG8_BAR; PG8_SCHED;
            PG8_LDA(At, 1, 1); PG8_STAGE(PG8_SB(1, 0), b3, voffB); PG8_STAGE(PG8_SB(1, 1), b3 + hstep, voffB); PG8_STAGE(PG8_SA(1, 0), a3, voffA);
            PG8_WAIT_V(8); PG8_WAIT_L(0); PG8_BAR; PG8_MMA(1, 0, At, B0); PG8_MMA(1, 1, At, B1); PG8_BAR; PG8_SCHED;
            } else {
            PG8_LDB(B0, 0, 0); PG8_SCHED; PG8_LDA(At, 0, 0); PG8_STAGE(PG8_SA(1, 1), a1 + hstep, voffA);
            PG8_WAIT_L(8); PG8_BAR; PG8_WAIT_L(0); PG8_MMA(0, 0, At, B0); PG8_BAR; PG8_SCHED;
            PG8_LDB(B1, 0, 1); PG8_STAGE(PG8_SB(0, 0), b2, voffB);
            PG8_BAR; PG8_WAIT_L(0); PG8_MMA(0, 1, At, B1); PG8_BAR;
            PG8_LDA(At, 0, 1); PG8_STAGE(PG8_SA(0, 0), a2, voffA);
            PG8_BAR; PG8_WAIT_L(0); PG8_MMA(1, 0, At, B0); PG8_BAR; PG8_SCHED;
            PG8_STAGE(PG8_SB(0, 1), b2 + hstep, voffB);
            PG8_WAIT_V(6); PG8_BAR; PG8_MMA(1, 1, At, B1); PG8_BAR;
            PG8_LDB(B0, 1, 0); PG8_SCHED; PG8_LDA(At, 1, 0); PG8_STAGE(PG8_SA(0, 1), a2 + hstep, voffA);
            PG8_WAIT_L(8); PG8_BAR; PG8_WAIT_L(0); PG8_MMA(0, 0, At, B0); PG8_BAR; PG8_SCHED;
            PG8_LDB(B1, 1, 1); PG8_STAGE(PG8_SB(1, 0), b3, voffB);
            PG8_BAR; PG8_WAIT_L(0); PG8_MMA(0, 1, At, B1); PG8_BAR;
            PG8_LDA(At, 1, 1); PG8_STAGE(PG8_SA(1, 0), a3, voffA);
            PG8_BAR; PG8_WAIT_L(0); PG8_MMA(1, 0, At, B0); PG8_BAR; PG8_SCHED;
            PG8_STAGE(PG8_SB(1, 1), b3 + hstep, voffB);
            PG8_WAIT_V(6); PG8_BAR; PG8_MMA(1, 1, At, B1); PG8_BAR;
            }
        }
        if constexpr (ALIGN_EPI) { if (wr == 0) PG8_BAR; }
        if constexpr (F8) asm volatile("s_nop 15\n\ts_nop 15" ::: "memory");
        if constexpr (!Epi::AFTER_DRAIN) { E(acc, cur, wr, wc, fr, fq); S.done(cur); }
        if (!has_next) break;
#pragma unroll
        for (int a = 0; a < 2; ++a)
#pragma unroll
            for (int b = 0; b < 2; ++b)
#pragma unroll
                for (int m = 0; m < 4; ++m)
#pragma unroll
                    for (int n = 0; n < 2; ++n) { acc[a][b][m][n] = (f32x4){0.f, 0.f, 0.f, 0.f}; }
        cur = nxt; cA = nA; cB = nB; ++ui;
        if constexpr (ALIGN_EPI) { if (wr == 1) PG8_BAR; }
    }
    PG8_WAIT_V(0);
    if constexpr (!ALIGN_EPI) { if (wr == 0) PG8_BAR; }
    PG8_BAR;
    if constexpr (Epi::AFTER_DRAIN) { E.fused(acc, cur, wr, wc, fr, fq, lds, wid, lane); S.done(cur); }
#undef PG8_SA
#undef PG8_SB
#undef PG8_STAGE
#undef PG8_LDA
#undef PG8_LDB
#undef PG8_MMA
#undef PG8_WAIT_V
#undef PG8_WAIT_L
#undef PG8_BAR
#undef PG8_SCHED
}
}

__device__ __forceinline__ void ph_prologue(const P& p, char* lds, const int part) {
    const int tid = ltid();
    float* fl = (float*)lds;
    if (part == 0) {
    for (int it = blockIdx.x; it < 96; it += gridDim.x) {
        const int l = it / 48, cg = it % 48;
        float* sc = fl;
        float* part = fl + 5 * 1024;
        __syncthreads();
        for (int i = tid; i < 5 * 1024; i += NT) {
            const int r = i >> 10, k = i & 1023;
            const float v = r < 4 ? p.c[r * 1024 + k] : p.c_ctx[k];
            sc[i] = v / (1.f + __expf(-v));
        }
        __syncthreads();
        const int kq = tid >> 7, col = tid & 127, j = cg * 128 + col;
        const float* W = p.w_mod + (size_t)l * 1024 * 6144;
        float a0 = 0, a1 = 0, a2 = 0, a3 = 0, a4 = 0;
        for (int k = kq * 256; k < kq * 256 + 256; ++k) {
            const float w = W[(size_t)k * 6144 + j];
            a0 += sc[k] * w; a1 += sc[1024 + k] * w; a2 += sc[2048 + k] * w; a3 += sc[3072 + k] * w; a4 += sc[4096 + k] * w;
        }
        part[(kq * 5 + 0) * 128 + col] = a0; part[(kq * 5 + 1) * 128 + col] = a1; part[(kq * 5 + 2) * 128 + col] = a2;
        part[(kq * 5 + 3) * 128 + col] = a3; part[(kq * 5 + 4) * 128 + col] = a4;
        __syncthreads();
        for (int i = tid; i < 5 * 128; i += NT) {
            const int r = i >> 7, cc = i & 127, jj = cg * 128 + cc;
            const float v = part[(0 * 5 + r) * 128 + cc] + part[(1 * 5 + r) * 128 + cc] + part[(2 * 5 + r) * 128 + cc] + part[(3 * 5 + r) * 128 + cc];
            p.mod[((size_t)l * 5 + r) * 6144 + jj] = v + p.b_mod[l * 6144 + jj];
        }
    }
    if (blockIdx.x == gridDim.x - 1) {
        const int pos = tid >> 3, f = tid & 7;
        const float inv = powf(10000.0f, -(float)f / 8.0f);
        const float ang = (float)pos * inv;
        p.rope[tid * 2] = cosf(ang); p.rope[tid * 2 + 1] = sinf(ang);
    }
    for (int i = blockIdx.x * NT + tid; i < 2 * 4 * 64 * 64; i += gridDim.x * NT) { const int ii = i & 63, j = (i >> 6) & 63, lg = i >> 12; p.WpT[i] = f2bf(p.w_pool[(size_t)lg * 4096 + ii * 64 + j]); }
    for (int i = blockIdx.x * NT + tid; i < 2 * 4 * 128 * 128; i += gridDim.x * NT) p.WsB[i] = f2bf(p.w_sgu[i]);
    }
    if (part == 0) {
        const int n_in = 2 * 9 * 16, n_out = 2 * 4 * 16, total = n_in + n_out;
        const int kr = tid >> 6, n4 = tid & 63, kg = tid & 7, nl = tid >> 3;
        for (int it = blockIdx.x; it < total; it += gridDim.x) {
            int i_ = it; const float* W_; bf16_t* Wt_; int N, K;
            if (i_ < n_in) { W_ = p.w_in; Wt_ = p.WinT; N = PW; K = D; } else { i_ -= n_in; W_ = p.w_out; Wt_ = p.WoutT; N = D; K = D; }
            const int ntn = N / 256, per = ntn * (K / 64), m_ = i_ / per, r_ = i_ % per, tn = r_ % ntn, tk = r_ / ntn, n0 = tn * 256;
            const float* src = W_ + (size_t)m_ * K * N + (size_t)(tk * 64) * N + n0; bf16_t* dst = Wt_ + (size_t)m_ * K * N + tk * 64;
            float4 rg[8];
#pragma unroll
            for (int i = 0; i < 8; ++i) rg[i] = *(const float4*)(src + (size_t)(kr + 8 * i) * N + n4 * 4);
            __syncthreads();
#pragma unroll
            for (int i = 0; i < 8; ++i) { float* q = fl + (kr + 8 * i) * 257 + n4 * 4; q[0] = rg[i].x; q[1] = rg[i].y; q[2] = rg[i].z; q[3] = rg[i].w; }
            __syncthreads();
#pragma unroll
            for (int j = 0; j < 4; ++j) {
                const int n = nl + 64 * j;
                const float* q = fl + (8 * kg) * 257 + n;
                u32x4 w;
                w.x = cvtpk(q[0], q[257]); w.y = cvtpk(q[2 * 257], q[3 * 257]); w.z = cvtpk(q[4 * 257], q[5 * 257]); w.w = cvtpk(q[6 * 257], q[7 * 257]);
                *(u32x4*)(dst + (size_t)(n0 + n) * K + 8 * kg) = w;
            }
        }
    } else {
        const int n_gu = 64 * 16 * 8, n_dn = 64 * 8 * 8, total = n_gu + n_dn;
        const int kr = tid >> 5, n4 = tid & 31, kg = (tid >> 3) & 7, nl = (tid & 7) + 8 * (tid >> 6);
        float4 rg[8];
        const float* src = nullptr; unsigned char* dst = nullptr; int N = 0, K = 0, n0 = 0, perm = 0;
        const float* nsrc = nullptr; unsigned char* ndst = nullptr; int nN = 0, nK = 0, nn0 = 0, nperm = 0;
#define TR_DECODE(IT, SRC, DST, NN, KK, N0, PERM) do { int i_ = (IT); const float* W_; unsigned char* Wt_; \
        if (i_ < n_gu) { W_ = p.w_gu; Wt_ = p.WguT; NN = 2048; KK = D; PERM = 1; } else { i_ -= n_gu; W_ = p.w_down; Wt_ = p.WdnT; NN = D; KK = FF; PERM = 0; } \
        const int ntn_ = NN / 128, per_ = ntn_ * (KK / 128), m_ = i_ / per_, r_ = i_ % per_, tn_ = r_ % ntn_, tk_ = r_ / ntn_; \
        N0 = tn_ * 128; SRC = W_ + (size_t)m_ * KK * NN + (size_t)(tk_ * 128) * NN + N0; DST = Wt_ + (size_t)m_ * KK * NN + tk_ * 128; } while (0)
        int it = blockIdx.x;
        if (it < total) {
            TR_DECODE(it, src, dst, N, K, n0, perm);
#pragma unroll
            for (int i = 0; i < 8; ++i) rg[i] = *(const float4*)(src + (size_t)(kr + 16 * i) * N + n4 * 4);
        }
        for (; it < total; it += gridDim.x) {
            __syncthreads();
#pragma unroll
            for (int i = 0; i < 8; ++i) { float* q = fl + (kr + 16 * i) * 129 + n4 * 4; q[0] = rg[i].x; q[1] = rg[i].y; q[2] = rg[i].z; q[3] = rg[i].w; }
            __syncthreads();
            const int nit = it + gridDim.x;
            if (nit < total) {
                TR_DECODE(nit, nsrc, ndst, nN, nK, nn0, nperm);
#pragma unroll
                for (int i = 0; i < 8; ++i) rg[i] = *(const float4*)(nsrc + (size_t)(kr + 16 * i) * nN + n4 * 4);
            }
#pragma unroll
            for (int j = 0; j < 2; ++j) {
                const int n = nl + 64 * j;
                const float* q = fl + (16 * kg) * 129 + n;
                u32x4 w;
#pragma unroll
                for (int d = 0; d < 4; ++d) {
                    unsigned r = __builtin_amdgcn_cvt_pk_fp8_f32(q[(4 * d) * 129] * 64.f, q[(4 * d + 1) * 129] * 64.f, 0u, false);
                    w[d] = __builtin_amdgcn_cvt_pk_fp8_f32(q[(4 * d + 2) * 129] * 64.f, q[(4 * d + 3) * 129] * 64.f, r, true);
                }
                const int ng = n0 + n;
                const int np = perm ? (ng < N / 2 ? 2 * ng : 2 * (ng - N / 2) + 1) : ng;
                *(u32x4*)(dst + (size_t)np * K + 16 * kg) = w;
            }
            src = nsrc; dst = ndst; N = nN; K = nK; n0 = nn0; perm = nperm;
        }
#undef TR_DECODE
    }
}

__device__ __forceinline__ void ph_norm1(const P& p, int l) {
    const int wave = ltid() >> 6, lane = ltid() & 63;
    for (int row = blockIdx.x * 8 + wave; row < R; row += gridDim.x * 8) {
        const float* xr = row < T ? p.x + (size_t)row * D : p.ctx + (size_t)(row - T) * D;
        float4 v[4]; float ss = 0;
#pragma unroll
        for (int i = 0; i < 4; ++i) { v[i] = *(const float4*)(xr + lane * 4 + 256 * i); ss += v[i].x * v[i].x + v[i].y * v[i].y + v[i].z * v[i].z + v[i].w * v[i].w; }
        ss = wave_sum(ss);
        const float rstd = rsqrtf(ss * (1.f / D) + EPS);
        const float* m = p.mod + ((size_t)l * 5 + mod_row(row)) * 6144;
        const float* g = p.g_mix + l * D;
#pragma unroll
        for (int i = 0; i < 4; ++i) {
            const int k = lane * 4 + 256 * i;
            const float4 gg = *(const float4*)(g + k), sh = *(const float4*)(m + k), sc = *(const float4*)(m + 1024 + k);
            uint2 o;
            o.x = cvtpk(v[i].x * rstd * gg.x * (1.f + sc.x) + sh.x, v[i].y * rstd * gg.y * (1.f + sc.y) + sh.y);
            o.y = cvtpk(v[i].z * rstd * gg.z * (1.f + sc.z) + sh.z, v[i].w * rstd * gg.w * (1.f + sc.w) + sh.w);
            *(uint2*)(p.H + (size_t)row * D + k) = o;
        }
    }
}

constexpr float QSCALE = 0.17677669529663687f * 1.4426950408889634f;
__device__ __forceinline__ void dsoftmax(const f32x16& s, float& m, float& l, f32x16& o0, f32x16& o1, bf16x8& pa, bf16x8& pb) {
    float mx = fmaxf(fmaxf(fmaxf(s[0], s[1]), fmaxf(s[2], s[3])), fmaxf(fmaxf(s[4], s[5]), fmaxf(s[6], s[7])));
    mx = fmaxf(mx, fmaxf(fmaxf(fmaxf(s[8], s[9]), fmaxf(s[10], s[11])), fmaxf(fmaxf(s[12], s[13]), fmaxf(s[14], s[15]))));
    mx = xhalf_max(mx);
    if (__any(mx > m)) {
        const float mn = fmaxf(m, mx), alpha = __builtin_amdgcn_exp2f(m - mn);
        o0 *= alpha; o1 *= alpha; l *= alpha; m = mn;
    }
    float pr[16]; float sum = 0.f;
#pragma unroll
    for (int r = 0; r < 16; ++r) { pr[r] = __builtin_amdgcn_exp2f(s[r] - m); sum += pr[r]; }
    l += sum;
    u32x4 a, b;
    a[0] = cvtpk(pr[0], pr[1]); a[1] = cvtpk(pr[2], pr[3]); a[2] = cvtpk(pr[4], pr[5]); a[3] = cvtpk(pr[6], pr[7]);
    b[0] = cvtpk(pr[8], pr[9]); b[1] = cvtpk(pr[10], pr[11]); b[2] = cvtpk(pr[12], pr[13]); b[3] = cvtpk(pr[14], pr[15]);
    pa = __builtin_bit_cast(bf16x8, a); pb = __builtin_bit_cast(bf16x8, b);
}
#define MX3(a, b, c) __builtin_fmaxf(__builtin_fmaxf((a), (b)), (c))
template <int THR>
__device__ __forceinline__ void dsoftmax2(f32x16& s, f32x16& negm, float& m, float& l, f32x16& o0, f32x16& o1, bf16x8& pa, bf16x8& pb, const bool first) {
    float a = MX3(s[0], s[1], s[2]), b = MX3(s[3], s[4], s[5]);
    a = MX3(a, s[6], s[7]); b = MX3(b, s[8], s[9]); a = MX3(a, s[10], s[11]); b = MX3(b, s[12], s[13]); a = MX3(a, s[14], s[15]);
    const float mx = xhalf_max(__builtin_fmaxf(a, b));
    if (first || __any(mx > (float)THR)) {
        const float delta = first ? mx : __builtin_fmaxf(mx, 0.f), alpha = first ? 1.f : __builtin_amdgcn_exp2f(-delta);
        m += delta;
#pragma unroll
        for (int r = 0; r < 16; ++r) { s[r] -= delta; negm[r] = -m; }
        o0 *= alpha; o1 *= alpha; l *= alpha;
    }
    float sum = 0.f;
#pragma unroll
    for (int r = 0; r < 16; ++r) { s[r] = __builtin_amdgcn_exp2f(s[r]); sum += s[r]; }
    l += sum;
    u32x4 wa, wb;
    wa[0] = cvtpk(s[0], s[1]); wa[1] = cvtpk(s[2], s[3]); wa[2] = cvtpk(s[4], s[5]); wa[3] = cvtpk(s[6], s[7]);
    wb[0] = cvtpk(s[8], s[9]); wb[1] = cvtpk(s[10], s[11]); wb[2] = cvtpk(s[12], s[13]); wb[3] = cvtpk(s[14], s[15]);
    pa = __builtin_bit_cast(bf16x8, wa); pb = __builtin_bit_cast(bf16x8, wb);
}
__device__ __forceinline__ void ph_dattn(const P& p, int l, int nrows, char* lds) {
    const int tid = ltid(), lane = tid & 63, wid = tid >> 6, r32 = lane & 31, hi = lane >> 5;
    float la = lane < 32 ? p.lam_q1[l * 32 + lane] * p.lam_k1[l * 32 + lane] : 0.f;
    float lb = lane < 32 ? p.lam_q2[l * 32 + lane] * p.lam_k2[l * 32 + lane] : 0.f;
    la = wave_sum(la); lb = wave_sum(lb);
    const float lam_init = 0.8f - 0.6f * expf(-0.3f * (float)l);
    const float lam = expf(la) - expf(lb) + lam_init;
    const bf16_t* PR = p.PROJ;
    const int nunits = (nrows == R) ? 256 + 16 : 256;
    const int skey = 8 * wid + (lane & 7), schunk = lane >> 3;
    const int ldsK = schunk * 1024 + skey * 16;
    const int ldsV = 8192 + (schunk >> 2) * 4096 + (skey >> 3) * 512 + (skey & 7) * 64 + (schunk & 3) * 16;
    const int vb = ((lane >> 4) & 1) * 32 + (lane & 3) * 8 + (4 * hi + ((lane & 15) >> 2)) * 64;
    for (int uu = blockIdx.x; uu < nunits; uu += gridDim.x) {
        int b, h, q0, nt; bool isctx;
        if (uu < 256) { const int u = (uu & 7) * 32 + (uu >> 3); b = u >> 6; h = (u >> 4) & 3; q0 = b * 4096 + (u & 15) * 256; nt = 68; isctx = false; }
        else { const int v = uu - 256; b = v >> 2; h = v & 3; q0 = T + b * 256; nt = 4; isctx = true; }
        bf16x8 qf[4];
        {
            const bf16_t* qp = PR + (size_t)(q0 + wid * 32 + r32) * PW + h * 64 + hi * 8;
#pragma unroll
            for (int ks = 0; ks < 4; ++ks) qf[ks] = *(const bf16x8*)(qp + ks * 16);
        }
        f32x16 O00, O01, O10, O11, ng1, ng2;
#pragma unroll
        for (int r = 0; r < 16; ++r) { O00[r] = 0.f; O01[r] = 0.f; O10[r] = 0.f; O11[r] = 0.f; ng1[r] = 0.f; ng2[r] = 0.f; }
        float m1 = 0.f, m2 = 0.f, l1 = 0.f, l2 = 0.f;
        const size_t gK = 256 + h * 64 + schunk * 8, gV = 512 + h * 64 + schunk * 8;
        uint4 rk, rv;
        {
            const int kr = (isctx ? T + b * 256 : b * 4096) + skey;
            rk = *(const uint4*)(PR + (size_t)kr * PW + gK); rv = *(const uint4*)(PR + (size_t)kr * PW + gV);
        }
        __syncthreads();
        *(uint4*)(lds + ldsK) = rk; *(uint4*)(lds + ldsV) = rv;
        __syncthreads();
        for (int t = 0; t < nt; ++t) {
            char* buf = lds + (t & 1) * 16384;
            if (t + 1 < nt) {
                const int tn = t + 1;
                const int kr = ((isctx || tn >= 64) ? T + b * 256 + (isctx ? tn : tn - 64) * 64 : b * 4096 + tn * 64) + skey;
                rk = *(const uint4*)(PR + (size_t)kr * PW + gK); rv = *(const uint4*)(PR + (size_t)kr * PW + gV);
            }
#pragma unroll
            for (int kb = 0; kb < 2; ++kb) {
                const lds_cptr kp = (lds_cptr)buf + hi * 1024 + (kb * 32 + r32) * 16;
                const bf16x8 kf0 = *(const __attribute__((address_space(3))) bf16x8*)(kp);
                const bf16x8 kf1 = *(const __attribute__((address_space(3))) bf16x8*)(kp + 2048);
                const bf16x8 kf2 = *(const __attribute__((address_space(3))) bf16x8*)(kp + 4096);
                const bf16x8 kf3 = *(const __attribute__((address_space(3))) bf16x8*)(kp + 6144);
                f32x16 s1 = __builtin_amdgcn_mfma_f32_32x32x16_bf16(kf0, qf[0], ng1, 0, 0, 0);
                f32x16 s2 = __builtin_amdgcn_mfma_f32_32x32x16_bf16(kf2, qf[2], ng2, 0, 0, 0);
                s1 = __builtin_amdgcn_mfma_f32_32x32x16_bf16(kf1, qf[1], s1, 0, 0, 0);
                s2 = __builtin_amdgcn_mfma_f32_32x32x16_bf16(kf3, qf[3], s2, 0, 0, 0);
                const bool first = (t == 0) && (kb == 0);
                bf16x8 p1a, p1b, p2a, p2b;
                dsoftmax2<8>(s1, ng1, m1, l1, O00, O01, p1a, p1b, first);
                dsoftmax2<8>(s2, ng2, m2, l2, O10, O11, p2a, p2b, first);
                const lds_cptr vp = (lds_cptr)buf + 8192 + vb + kb * 2048;
#pragma unroll
                for (int dt = 0; dt < 2; ++dt) {
#pragma unroll
                    for (int ss = 0; ss < 2; ++ss) {
                        const s16x4 lo = vtr(vp + dt * 4096 + ss * 1024), hh = vtr(vp + dt * 4096 + ss * 1024 + 512);
                        const bf16x8 va = (bf16x8){lo[0], lo[1], lo[2], lo[3], hh[0], hh[1], hh[2], hh[3]};
                        if (dt == 0) { O00 = __builtin_amdgcn_mfma_f32_32x32x16_bf16(va, ss ? p1b : p1a, O00, 0, 0, 0); O10 = __builtin_amdgcn_mfma_f32_32x32x16_bf16(va, ss ? p2b : p2a, O10, 0, 0, 0); }
                        else         { O01 = __builtin_amdgcn_mfma_f32_32x32x16_bf16(va, ss ? p1b : p1a, O01, 0, 0, 0); O11 = __builtin_amdgcn_mfma_f32_32x32x16_bf16(va, ss ? p2b : p2a, O11, 0, 0, 0); }
                    }
                }
            }
            if (t + 1 < nt) { char* nb = lds + ((t + 1) & 1) * 16384; *(uint4*)(nb + ldsK) = rk; *(uint4*)(nb + ldsV) = rv; }
            __syncthreads();
        }
        l1 = xhalf_sum(l1); l2 = xhalf_sum(l2);
        const float i1 = 1.f / l1, i2 = lam / l2;
        float ss = 0.f;
#pragma unroll
        for (int r = 0; r < 16; ++r) { O00[r] = O00[r] * i1 - O10[r] * i2; O01[r] = O01[r] * i1 - O11[r] * i2; ss += O00[r] * O00[r] + O01[r] * O01[r]; }
        ss = xhalf_sum(ss);
        const float rstd = rsqrtf(ss * (1.f / 64.f) + EPS) * (1.f - lam_init);
        const float* gs = p.g_sub + l * 64;
        bf16_t* op = p.MIX + (size_t)(q0 + wid * 32 + r32) * D + h * 64;
#pragma unroll
        for (int g4 = 0; g4 < 4; ++g4) {
            const int d = 8 * g4 + 4 * hi;
            const float4 ga = *(const float4*)(gs + d), gb = *(const float4*)(gs + 32 + d);
            uint2 wa, wb;
            wa.x = cvtpk(O00[4 * g4] * rstd * ga.x, O00[4 * g4 + 1] * rstd * ga.y); wa.y = cvtpk(O00[4 * g4 + 2] * rstd * ga.z, O00[4 * g4 + 3] * rstd * ga.w);
            wb.x = cvtpk(O01[4 * g4] * rstd * gb.x, O01[4 * g4 + 1] * rstd * gb.y); wb.y = cvtpk(O01[4 * g4 + 2] * rstd * gb.z, O01[4 * g4 + 3] * rstd * gb.w);
            *(uint2*)(op + d) = wa; *(uint2*)(op + 32 + d) = wb;
        }
    }
}

__device__ __forceinline__ void ph_na(const P& p, int l, int nrows, char* lds) {
    const int tid = ltid(), lane = tid & 63, wid = tid >> 6, r32 = lane & 31, hi = lane >> 5;
    const bf16_t* PR = p.PROJ;
    const int nunits = (nrows == R) ? 256 + 16 : 256;
    const int skey = 8 * wid + (lane & 7), schunk = lane >> 3;
    const int ldsK = schunk * 1024 + skey * 16;
    const int ldsV = 8192 + (schunk >> 2) * 4096 + (skey >> 3) * 512 + (skey & 7) * 64 + (schunk & 3) * 16;
    const int vb = ((lane >> 4) & 1) * 32 + (lane & 3) * 8 + (4 * hi + ((lane & 15) >> 2)) * 64;
    float* btab = (float*)(lds + 32768);
    constexpr float LOG2E = 1.4426950408889634f;
    for (int uu = (blockIdx.x + gridDim.x - 16) % gridDim.x; uu < nunits; uu += gridDim.x) {
        int b, h, q0, kr_lo, nlat, rs = 0, rq = 0; bool isctx;
        if (uu < 256) {
            const int u = (uu & 7) * 32 + (uu >> 3); b = u >> 6; h = (u >> 4) & 3; const int rg = u & 15;
            rq = 4 * rg + (wid >> 1); q0 = b * 4096 + rq * 64 + (wid & 1) * 32;
            kr_lo = min(max(4 * rg - 4, 0), 56); const int kr_hi = min(max(4 * rg - 1, 0), 56) + 7; nlat = kr_hi - kr_lo + 1;
            rs = min(max(rq - 4, 0), 56); isctx = false;
        } else { const int v = uu - 256; b = v >> 2; h = v & 3; q0 = T + b * 256 + wid * 32; kr_lo = 0; nlat = 0; isctx = true; }
        const int nt = nlat + 4;
        const int cq = (wid & 1) * 32 + r32, wsc = min(max(cq - 8, 0), 48);
        bf16x8 qf[4];
        {
            const bf16_t* qp = PR + (size_t)(q0 + r32) * PW + 1536 + h * 64 + hi * 8;
#pragma unroll
            for (int ks = 0; ks < 4; ++ks) qf[ks] = *(const bf16x8*)(qp + ks * 16);
        }
        f32x16 O0, O1;
#pragma unroll
        for (int r = 0; r < 16; ++r) { O0[r] = 0.f; O1[r] = 0.f; }
        float m1 = -1e30f, l1 = 0.f;
        const size_t gK = 1792 + h * 64 + schunk * 8, gV = 2048 + h * 64 + schunk * 8;
        uint4 rk, rv;
        {
            const int kr = (nlat ? b * 4096 + kr_lo * 64 : T + b * 256) + skey;
            rk = *(const uint4*)(PR + (size_t)kr * PW + gK); rv = *(const uint4*)(PR + (size_t)kr * PW + gV);
        }
        __syncthreads();
        *(uint4*)(lds + ldsK) = rk; *(uint4*)(lds + ldsV) = rv;
        if (tid < 465) btab[tid] = p.rpb[((size_t)l * 4 + h) * 465 + tid] * LOG2E;
        __syncthreads();
        for (int t = 0; t < nt; ++t) {
            char* buf = lds + (t & 1) * 16384;
            if (t + 1 < nt) {
                const int tn = t + 1;
                const int kr = (tn < nlat ? b * 4096 + (kr_lo + tn) * 64 : T + b * 256 + (tn - nlat) * 64) + skey;
                rk = *(const uint4*)(PR + (size_t)kr * PW + gK); rv = *(const uint4*)(PR + (size_t)kr * PW + gV);
            }
            const bool lat = t < nlat;
            const int krow = kr_lo + t;
            const bool active = !lat || (krow >= rs && krow <= rs + 7);
            if (active) {
                const float* brow = btab + (krow - rq + 7) * 31 + 15 - cq;
#pragma unroll
                for (int kb = 0; kb < 2; ++kb) {
                    const lds_cptr kp = (lds_cptr)buf + hi * 1024 + (kb * 32 + r32) * 16;
                    f32x16 s1;
#pragma unroll
                    for (int r = 0; r < 16; ++r) s1[r] = 0.f;
#pragma unroll
                    for (int ks = 0; ks < 4; ++ks) {
                        const bf16x8 kf = *(const __attribute__((address_space(3))) bf16x8*)(kp + ks * 2048);
                        s1 = __builtin_amdgcn_mfma_f32_32x32x16_bf16(kf, qf[ks], s1, 0, 0, 0);
                    }
                    if (lat) {
#pragma unroll
                        for (int r = 0; r < 16; ++r) {
                            const int kc = 32 * kb + (r & 3) + 8 * (r >> 2) + 4 * hi;
                            const bool ok = (unsigned)(kc - wsc) < 16u;
                            const float bv = brow[ok ? kc : cq];
                            s1[r] = ok ? s1[r] + bv : -INFINITY;
                        }
                    }
                    bf16x8 pa, pb;
                    dsoftmax(s1, m1, l1, O0, O1, pa, pb);
                    const lds_cptr vp = (lds_cptr)buf + 8192 + vb + kb * 2048;
#pragma unroll
                    for (int ss = 0; ss < 2; ++ss) {
                        const s16x4 lo0 = vtr(vp + ss * 1024), hh0 = vtr(vp + ss * 1024 + 512);
                        const s16x4 lo1 = vtr(vp + 4096 + ss * 1024), hh1 = vtr(vp + 4096 + ss * 1024 + 512);
                        const bf16x8 va0 = (bf16x8){lo0[0], lo0[1], lo0[2], lo0[3], hh0[0], hh0[1], hh0[2], hh0[3]};
                        const bf16x8 va1 = (bf16x8){lo1[0], lo1[1], lo1[2], lo1[3], hh1[0], hh1[1], hh1[2], hh1[3]};
                        O0 = __builtin_amdgcn_mfma_f32_32x32x16_bf16(va0, ss ? pb : pa, O0, 0, 0, 0);
                        O1 = __builtin_amdgcn_mfma_f32_32x32x16_bf16(va1, ss ? pb : pa, O1, 0, 0, 0);
                    }
                }
            }
            if (t + 1 < nt) { char* nb = lds + ((t + 1) & 1) * 16384; *(uint4*)(nb + ldsK) = rk; *(uint4*)(nb + ldsV) = rv; }
            __syncthreads();
        }
        l1 = xhalf_sum(l1);
        const float il = 1.f / l1;
        bf16_t* op = p.MIX + (size_t)(q0 + r32) * D + 768 + h * 64;
#pragma unroll
        for (int g4 = 0; g4 < 4; ++g4) {
            const int d = 8 * g4 + 4 * hi;
            uint2 wa, wb;
            wa.x = cvtpk(O0[4 * g4] * il, O0[4 * g4 + 1] * il); wa.y = cvtpk(O0[4 * g4 + 2] * il, O0[4 * g4 + 3] * il);
            wb.x = cvtpk(O1[4 * g4] * il, O1[4 * g4 + 1] * il); wb.y = cvtpk(O1[4 * g4 + 2] * il, O1[4 * g4 + 3] * il);
            *(uint2*)(op + d) = wa; *(uint2*)(op + 32 + d) = wb;
        }
    }
}

__device__ __forceinline__ void ph_pool(const P& p, int l, int nrows, char* lds) {
    const int tid = ltid(), lane = tid & 63, wid = tid >> 6, fr = lane & 15, fq = lane >> 4;
    float* ysh = (float*)lds;
    bf16_t* dsh = (bf16_t*)(lds + 80 * 256 * 4);
    const bf16_t* PR = p.PROJ;
    for (int it = (blockIdx.x + gridDim.x - 32) % gridDim.x; it < nrows / 64; it += gridDim.x) {
        const int row0 = it * 64;
        const int L = row0 < T ? 4096 : 256;
        const int t0 = row0 < T ? (row0 & 4095) : ((row0 - T) & 255);
        const int base = row0 - t0;
        __syncthreads();
        for (int c = tid; c < 80 * 32; c += NT) {
            const int rr = c >> 5, ch = (c & 31) * 8, t = t0 - 8 + rr;
            float4 a = make_float4(0.f, 0.f, 0.f, 0.f), b = a;
            if (t >= 0 && t < L) {
                const uint4 raw = *(const uint4*)(PR + (size_t)(base + t) * PW + 768 + ch);
                a = make_float4(__uint_as_float(raw.x << 16), __uint_as_float(raw.x & 0xffff0000u), __uint_as_float(raw.y << 16), __uint_as_float(raw.y & 0xffff0000u));
                b = make_float4(__uint_as_float(raw.z << 16), __uint_as_float(raw.z & 0xffff0000u), __uint_as_float(raw.w << 16), __uint_as_float(raw.w & 0xffff0000u));
            }
            *(float4*)(ysh + rr * 256 + ch) = a; *(float4*)(ysh + rr * 256 + ch + 4) = b;
        }
        __syncthreads();
        {
            const int r = tid >> 3, cg = tid & 7;
            const int g = cg >> 1, w = 2 << g, t = t0 + r;
            const int lo = max(t - w / 2, 0), hi = min(t + w / 2 - 1, L - 1);
            const float inv = 1.f / (float)(hi - lo + 1);
#pragma unroll
            for (int q = 0; q < 8; ++q) {
                const int ch = cg * 32 + q * 4;
                float4 s = make_float4(0.f, 0.f, 0.f, 0.f);
                for (int tt = lo; tt <= hi; ++tt) { const float4 v = *(const float4*)(ysh + (tt - t0 + 8) * 256 + ch); s.x += v.x; s.y += v.y; s.z += v.z; s.w += v.w; }
                const float4 y = *(const float4*)(ysh + (r + 8) * 256 + ch);
                uint2 o; o.x = cvtpk(s.x * inv - y.x, s.y * inv - y.y); o.y = cvtpk(s.z * inv - y.z, s.w * inv - y.w);
                *(uint2*)(dsh + r * 264 + ch) = o;
            }
        }
        __syncthreads();
        {
            const int g = wid >> 1, mb = (wid & 1) * 2;
            const bf16_t* W = p.WpT + ((size_t)l * 4 + g) * 64 * 64;
            f32x4 acc[2][4];
#pragma unroll
            for (int mt = 0; mt < 2; ++mt)
#pragma unroll
                for (int nt = 0; nt < 4; ++nt) acc[mt][nt] = (f32x4){0.f, 0.f, 0.f, 0.f};
#pragma unroll
            for (int ks = 0; ks < 2; ++ks) {
                bf16x8 af[2], bfr[4];
#pragma unroll
                for (int mt = 0; mt < 2; ++mt) af[mt] = *(const bf16x8*)(dsh + ((mb + mt) * 16 + fr) * 264 + g * 64 + ks * 32 + fq * 8);
#pragma unroll
                for (int nt = 0; nt < 4; ++nt) bfr[nt] = *(const bf16x8*)(W + (nt * 16 + fr) * 64 + ks * 32 + fq * 8);
#pragma unroll
                for (int mt = 0; mt < 2; ++mt)
#pragma unroll
                    for (int nt = 0; nt < 4; ++nt) acc[mt][nt] = __builtin_amdgcn_mfma_f32_16x16x32_bf16(bfr[nt], af[mt], acc[mt][nt], 0, 0, 0);
            }
#pragma unroll
            for (int mt = 0; mt < 2; ++mt)
#pragma unroll
                for (int nt = 0; nt < 4; ++nt) {
                    const int row = row0 + (mb + mt) * 16 + fr, j = g * 64 + nt * 16 + fq * 4;
                    const float4 sp = *(const float4*)(p.s_pool + l * 256 + j);
                    uint2 o; o.x = cvtpk(acc[mt][nt][0] * sp.x, acc[mt][nt][1] * sp.y); o.y = cvtpk(acc[mt][nt][2] * sp.z, acc[mt][nt][3] * sp.w);
                    *(uint2*)(p.MIX + (size_t)row * D + 256 + j) = o;
                }
        }
    }
}

__device__ __forceinline__ float gelu_fast(float x) {
    const float u = 0.7978845608028654f * (x + 0.044715f * x * x * x);
    return x / (1.f + __builtin_amdgcn_exp2f(-2.885390081777927f * u));
}
__device__ __forceinline__ void ph_sgu(const P& p, int l, int nrows, char* lds) {
    const int tid = ltid(), lane = tid & 63, wid = tid >> 6, fr = lane & 15, fq = lane >> 4;
    bf16_t* vnT = (bf16_t*)lds;
    float* rstd = (float*)(lds + 128 * 136 * 2);
    const bf16_t* PR = p.PROJ;
    for (int it = (blockIdx.x + gridDim.x - 48) % gridDim.x; it < (nrows / 128) * 2; it += gridDim.x) {
        const int chunk = it >> 1, hp = it & 1, row0 = chunk * 128;
        __syncthreads();
        {
            const int t = tid >> 2, qtr = tid & 3;
            const bf16_t* zp = PR + (size_t)(row0 + t) * PW + 1280 + qtr * 64;
            float ss = 0.f;
#pragma unroll
            for (int i = 0; i < 8; ++i) {
                const uint4 raw = *(const uint4*)(zp + i * 8);
                const unsigned w4[4] = {raw.x, raw.y, raw.z, raw.w};
#pragma unroll
                for (int j = 0; j < 4; ++j) { const float a = __uint_as_float(w4[j] << 16), b = __uint_as_float(w4[j] & 0xffff0000u); ss += a * a + b * b; }
            }
            ss += __shfl_xor(ss, 1); ss += __shfl_xor(ss, 2);
            if (qtr == 0) rstd[t] = rsqrtf(ss * (1.f / 256.f) + EPS);
        }
        __syncthreads();
        {
            const int s = tid >> 2, cb = (tid & 3) * 32;
            const bf16_t* zp = PR + (size_t)(row0 + s) * PW + 1280 + hp * 128 + cb;
            const float rs = rstd[s];
            const float* gg = p.g_sgu + l * 256 + hp * 128 + cb;
#pragma unroll
            for (int i = 0; i < 4; ++i) {
                const uint4 raw = *(const uint4*)(zp + i * 8);
                const unsigned w4[4] = {raw.x, raw.y, raw.z, raw.w};
#pragma unroll
                for (int j = 0; j < 4; ++j) {
                    const int c = cb + i * 8 + j * 2;
                    vnT[c * 136 + s] = f2bf(__uint_as_float(w4[j] << 16) * rs * gg[i * 8 + j * 2]);
                    vnT[(c + 1) * 136 + s] = f2bf(__uint_as_float(w4[j] & 0xffff0000u) * rs * gg[i * 8 + j * 2 + 1]);
                }
            }
        }
        __syncthreads();
        {
            const int hl = wid >> 2, g = hp * 2 + hl, mb = (wid & 3) * 2;
            const bf16_t* Wg = p.WsB + ((size_t)l * 4 + g) * 128 * 128;
            f32x4 acc[2][4];
#pragma unroll
            for (int mt = 0; mt < 2; ++mt)
#pragma unroll
                for (int nt = 0; nt < 4; ++nt) acc[mt][nt] = (f32x4){0.f, 0.f, 0.f, 0.f};
#pragma unroll
            for (int ks = 0; ks < 4; ++ks) {
                bf16x8 af[2], bfr[4];
#pragma unroll
                for (int mt = 0; mt < 2; ++mt) af[mt] = *(const bf16x8*)(Wg + ((mb + mt) * 16 + fr) * 128 + ks * 32 + fq * 8);
#pragma unroll
                for (int nt = 0; nt < 4; ++nt) bfr[nt] = *(const bf16x8*)(vnT + (hl * 64 + nt * 16 + fr) * 136 + ks * 32 + fq * 8);
#pragma unroll
                for (int mt = 0; mt < 2; ++mt)
#pragma unroll
                    for (int nt = 0; nt < 4; ++nt) acc[mt][nt] = __builtin_amdgcn_mfma_f32_16x16x32_bf16(bfr[nt], af[mt], acc[mt][nt], 0, 0, 0);
            }
#pragma unroll
            for (int mt = 0; mt < 2; ++mt) {
                const int t = (mb + mt) * 16 + fr;
                const float bias = p.b_sgu[(l * 4 + g) * 128 + t];
#pragma unroll
                for (int nt = 0; nt < 4; ++nt) {
                    const int c = g * 64 + nt * 16 + fq * 4;
                    const uint2 ur = *(const uint2*)(PR + (size_t)(row0 + t) * PW + 1024 + c);
                    const float u0 = __uint_as_float(ur.x << 16), u1 = __uint_as_float(ur.x & 0xffff0000u);
                    const float u2 = __uint_as_float(ur.y << 16), u3 = __uint_as_float(ur.y & 0xffff0000u);
                    uint2 o; o.x = cvtpk(u0 * (acc[mt][nt][0] + bias), u1 * (acc[mt][nt][1] + bias)); o.y = cvtpk(u2 * (acc[mt][nt][2] + bias), u3 * (acc[mt][nt][3] + bias));
                    *(uint2*)(p.MIX + (size_t)(row0 + t) * D + 512 + c) = o;
                }
            }
        }
    }
}

__device__ __forceinline__ void ph_router(const P& p, int l, int nrows, char* lds) {
    const int tid = ltid(), wave = tid >> 6, lane = tid & 63;
    float* wl = (float*)lds;
    float* wsc = (float*)(lds + 1024 * 36 * 4) + wave * 64;
    int* lcnt = (int*)(lds + 1024 * 36 * 4 + 8 * 64 * 4);
    __syncthreads();
    {
        const float* wr = p.w_router + (size_t)l * D * NE;
        for (int i = tid; i < 1024 * 8; i += NT) { const int k = i >> 3, e4 = (i & 7) * 4; *(float4*)(wl + k * 36 + e4) = *(const float4*)(wr + k * 32 + e4); }
        if (tid < 32) lcnt[tid] = 0;
    }
    __syncthreads();
    const float* g = p.g_ffn + l * D;
    const float brt = p.b_router[l * NE + (lane & 31)];
    for (int pr = blockIdx.x * 8 + wave; pr < nrows / 2; pr += gridDim.x * 8) {
        const int ra = 2 * pr;
        const float* xa = p.X + (size_t)ra * D; const float* xb = xa + D;
        float ha[16], hb[16]; float sa = 0.f, sb = 0.f;
#pragma unroll
        for (int i = 0; i < 16; ++i) { ha[i] = xa[lane + 64 * i]; hb[i] = xb[lane + 64 * i]; sa += ha[i] * ha[i]; sb += hb[i] * hb[i]; }
        sa = wave_sum(sa); sb = wave_sum(sb);
        const float rsa = rsqrtf(sa * (1.f / D) + EPS), rsb = rsqrtf(sb * (1.f / D) + EPS);
        const float* m = p.mod + ((size_t)l * 5 + mod_row(ra)) * 6144;
#pragma unroll
        for (int i = 0; i < 16; ++i) {
            const int k = lane + 64 * i;
            const float gs = g[k] * (1.f + m[4 * 1024 + k]), sh = m[3 * 1024 + k];
            ha[i] = ha[i] * rsa * gs + sh; hb[i] = hb[i] * rsb * gs + sh;
            p.H[(size_t)ra * D + k] = f2bf(ha[i]); p.H[(size_t)(ra + 1) * D + k] = f2bf(hb[i]);
        }
        float la[32], lb[32];
#pragma unroll
        for (int e = 0; e < 32; ++e) { la[e] = 0.f; lb[e] = 0.f; }
#pragma unroll
        for (int i = 0; i < 16; ++i) {
            const float* wk = wl + (lane + 64 * i) * 36;
#pragma unroll
            for (int e = 0; e < 32; e += 4) {
                const float4 w = *(const float4*)(wk + e);
                la[e] += ha[i] * w.x; la[e + 1] += ha[i] * w.y; la[e + 2] += ha[i] * w.z; la[e + 3] += ha[i] * w.w;
                lb[e] += hb[i] * w.x; lb[e + 1] += hb[i] * w.y; lb[e + 2] += hb[i] * w.z; lb[e + 3] += hb[i] * w.w;
            }
        }
        float r32v[32];
        {
            const bool up = lane >= 32;
#pragma unroll
            for (int e = 0; e < 32; ++e) { const float keep = up ? lb[e] : la[e], send = up ? la[e] : lb[e]; r32v[e] = keep + __shfl_xor(send, 32); }
        }
        float r16[16], r8[8], r4[4], r2[2];
        { const bool up = (lane & 16) != 0;
#pragma unroll
          for (int e = 0; e < 16; ++e) { const float keep = up ? r32v[e + 16] : r32v[e], send = up ? r32v[e] : r32v[e + 16]; r16[e] = keep + __shfl_xor(send, 16); } }
        { const bool up = (lane & 8) != 0;
#pragma unroll
          for (int e = 0; e < 8; ++e) { const float keep = up ? r16[e + 8] : r16[e], send = up ? r16[e] : r16[e + 8]; r8[e] = keep + __shfl_xor(send, 8); } }
        { const bool up = (lane & 4) != 0;
#pragma unroll
          for (int e = 0; e < 4; ++e) { const float keep = up ? r8[e + 4] : r8[e], send = up ? r8[e] : r8[e + 4]; r4[e] = keep + __shfl_xor(send, 4); } }
        { const bool up = (lane & 2) != 0;
#pragma unroll
          for (int e = 0; e < 2; ++e) { const float keep = up ? r4[e + 2] : r4[e], send = up ? r4[e] : r4[e + 2]; r2[e] = keep + __shfl_xor(send, 2); } }
        float mine;
        { const bool up = (lane & 1) != 0; const float keep = up ? r2[1] : r2[0], send = up ? r2[0] : r2[1]; mine = keep + __shfl_xor(send, 1); }
        wsc[lane] = mine + brt;
        float lg[32];
        {
            const float* wp = wsc + (lane & 32);
#pragma unroll
            for (int e = 0; e < 32; e += 4) { const float4 v = *(const float4*)(wp + e); lg[e] = v.x; lg[e + 1] = v.y; lg[e + 2] = v.z; lg[e + 3] = v.w; }
        }
        unsigned taken = 0u; float tv[4]; int ti[4];
#pragma unroll
        for (int k = 0; k < 4; ++k) {
            float best = -3.0e38f; int bi = 0;
#pragma unroll
            for (int e = 0; e < 32; ++e) { const bool ok = !((taken >> e) & 1u) && (lg[e] > best); best = ok ? lg[e] : best; bi = ok ? e : bi; }
            taken |= 1u << bi; tv[k] = best; ti[k] = bi;
        }
        const float e1 = __expf(tv[1] - tv[0]), e2 = __expf(tv[2] - tv[0]), e3 = __expf(tv[3] - tv[0]);
        const float inv = 1.f / (1.f + e1 + e2 + e3);
        if ((lane & 31) == 0) {
            const int row = ra + (lane >> 5);
            *(int4*)(p.topi + (size_t)row * 4) = make_int4(ti[0], ti[1], ti[2], ti[3]);
            *(float4*)(p.topg + (size_t)row * 4) = make_float4(inv, e1 * inv, e2 * inv, e3 * inv);
            atomicAdd(&lcnt[ti[0]], 1); atomicAdd(&lcnt[ti[1]], 1); atomicAdd(&lcnt[ti[2]], 1); atomicAdd(&lcnt[ti[3]], 1);
        }
    }
    __syncthreads();
    if (tid < 32 && lcnt[tid]) atomicAdd(&p.cnt[l * 64 + tid], lcnt[tid]);
}
__device__ __forceinline__ void ph_assign(const P& p, int l, int nrows, char* lds) {
    int* lcnt = (int*)lds; int* lbase = lcnt + 32; int* pst = lbase + 32; int* slots = pst + 32;
    const int tid = ltid(), wave = tid >> 6, lane = tid & 63;
    int* cnt = p.cnt + l * 64; int* cursor = cnt + 32;
    int* meta = p.moe_meta + l * 512;
    __syncthreads();
    if (tid == 0) { int a = 0; for (int e = 0; e < 32; ++e) { pst[e] = a; a += (cnt[e] + 255) & ~255; } if (blockIdx.x == 0) meta[0] = a >> 8; }
    __syncthreads();
    if (blockIdx.x == 0 && tid < 320) { int e = 0; for (int k = 1; k < 32; ++k) if (tid * 256 >= pst[k]) e = k; meta[1 + tid] = e; }
    const int blk0 = (blockIdx.x + gridDim.x - 64) % gridDim.x;
    for (int it = blk0; it < nrows / 64; it += gridDim.x) {
        __syncthreads();
        if (tid < 32) lcnt[tid] = 0;
        __syncthreads();
        if (wave == 0) {
            const int row = it * 64 + lane;
            const int4 ti = *(const int4*)(p.topi + (size_t)row * 4);
            const int r0 = atomicAdd(&lcnt[ti.x], 1), r1 = atomicAdd(&lcnt[ti.y], 1), r2 = atomicAdd(&lcnt[ti.z], 1), r3 = atomicAdd(&lcnt[ti.w], 1);
            __builtin_amdgcn_s_waitcnt(0xc07f);
            if (lane < 32) lbase[lane] = pst[lane] + (lcnt[lane] ? atomicAdd(&cursor[lane], lcnt[lane]) : 0);
            __builtin_amdgcn_s_waitcnt(0xc07f);
            const int4 sl = make_int4(lbase[ti.x] + r0, lbase[ti.y] + r1, lbase[ti.z] + r2, lbase[ti.w] + r3);
            *(int4*)(p.tok_slot + (size_t)row * 4) = sl;
            *(int4*)(slots + lane * 4) = sl;
        }
        __syncthreads();
        {
            const bf16_t* __restrict__ Hs = p.H; unsigned char* __restrict__ HSd = p.HS;
#define AS_LD(rr, A, B) const uint4 A = *(const uint4*)(Hs + (size_t)(it * 64 + wave * 8 + (rr)) * D + lane * 8), B = *(const uint4*)(Hs + (size_t)(it * 64 + wave * 8 + (rr)) * D + lane * 8 + 512)
#define AS_CV(V) make_uint2(__builtin_amdgcn_cvt_pk_fp8_f32(__uint_as_float(V.y << 16), __uint_as_float(V.y & 0xffff0000u), __builtin_amdgcn_cvt_pk_fp8_f32(__uint_as_float(V.x << 16), __uint_as_float(V.x & 0xffff0000u), 0u, false), true), \
                            __builtin_amdgcn_cvt_pk_fp8_f32(__uint_as_float(V.w << 16), __uint_as_float(V.w & 0xffff0000u), __builtin_amdgcn_cvt_pk_fp8_f32(__uint_as_float(V.z << 16), __uint_as_float(V.z & 0xffff0000u), 0u, false), true))
#define AS_ST(rr, A, B) do { const int4 s4 = *(const int4*)(slots + (wave * 8 + (rr)) * 4); const uint2 fa = AS_CV(A), fb = AS_CV(B); \
            unsigned char* d0 = HSd + (size_t)s4.x * D + lane * 8; *(uint2*)d0 = fa; *(uint2*)(d0 + 512) = fb; \
            unsigned char* d1 = HSd + (size_t)s4.y * D + lane * 8; *(uint2*)d1 = fa; *(uint2*)(d1 + 512) = fb; \
            unsigned char* d2 = HSd + (size_t)s4.z * D + lane * 8; *(uint2*)d2 = fa; *(uint2*)(d2 + 512) = fb; \
            unsigned char* d3 = HSd + (size_t)s4.w * D + lane * 8; *(uint2*)d3 = fa; *(uint2*)(d3 + 512) = fb; } while (0)
            AS_LD(0, a0, b0); AS_LD(1, a1, b1); AS_LD(2, a2, b2); AS_LD(3, a3, b3); AS_LD(4, a4, b4); AS_LD(5, a5, b5); AS_LD(6, a6, b6); AS_LD(7, a7, b7);
            AS_ST(0, a0, b0); AS_ST(1, a1, b1); AS_ST(2, a2, b2); AS_ST(3, a3, b3); AS_ST(4, a4, b4); AS_ST(5, a5, b5); AS_ST(6, a6, b6); AS_ST(7, a7, b7);
#undef AS_CV
#undef AS_LD
#undef AS_ST
        }
    }
}

struct EpiProj {
    static constexpr bool PERM = true, AFTER_DRAIN = false;
    bf16_t* O; const float* rope;
    __device__ __forceinline__ void operator()(const f32x4 (&acc)[2][2][4][2], const pg8::Unit& u, int wr, int wc, int fr, int fq) const {
        const int row0 = u.pm * 256 + wr * 64 + fr, col0 = u.pn * 256 + wc * 32 + 8 * fq;
        const bool do_rope = (u.pn < 2) && (u.pm < T / 256), do_gelu = (u.pn == 4) || (u.pn == 5);
        const float sc = u.pn == 0 ? QSCALE : (u.pn == 6 ? 0.125f * 1.4426950408889634f : 1.f);
        const float sgn = (fq & 1) ? 1.f : -1.f;
#pragma unroll
        for (int ai = 0; ai < 2; ++ai)
#pragma unroll
            for (int m = 0; m < 4; ++m) {
                const int row = row0 + ai * 128 + m * 16;
                bf16_t* rowp = O + (size_t)row * PW + col0;
                f32x4 cs[4];
                if (do_rope) {
                    const int s = row & 4095, pos = (fq >> 1) ? (s & 63) : (s >> 6);
                    const f32x4* rp = (const f32x4*)(rope + pos * 16);
                    cs[0] = rp[0]; cs[1] = rp[1]; cs[2] = rp[2]; cs[3] = rp[3];
                }
#pragma unroll
                for (int bj = 0; bj < 2; ++bj) {
                    f32x4 v0 = acc[ai][bj][m][0], v1 = acc[ai][bj][m][1];
                    if (do_rope) {
                        f32x4 b0, b1;
#pragma unroll
                        for (int j = 0; j < 4; ++j) { b0[j] = __shfl_xor(v0[j], 16); b1[j] = __shfl_xor(v1[j], 16); }
                        v0[0] = v0[0] * cs[0][0] + sgn * b0[0] * cs[0][1]; v0[1] = v0[1] * cs[0][2] + sgn * b0[1] * cs[0][3];
                        v0[2] = v0[2] * cs[1][0] + sgn * b0[2] * cs[1][1]; v0[3] = v0[3] * cs[1][2] + sgn * b0[3] * cs[1][3];
                        v1[0] = v1[0] * cs[2][0] + sgn * b1[0] * cs[2][1]; v1[1] = v1[1] * cs[2][2] + sgn * b1[1] * cs[2][3];
                        v1[2] = v1[2] * cs[3][0] + sgn * b1[2] * cs[3][1]; v1[3] = v1[3] * cs[3][2] + sgn * b1[3] * cs[3][3];
                    }
                    if (do_gelu) {
#pragma unroll
                        for (int j = 0; j < 4; ++j) { v0[j] = gelu_fast(v0[j]); v1[j] = gelu_fast(v1[j]); }
                    }
                    v0 = v0 * sc; v1 = v1 * sc;
                    u32x4 w; w.x = cvtpk(v0[0], v0[1]); w.y = cvtpk(v0[2], v0[3]); w.z = cvtpk(v1[0], v1[1]); w.w = cvtpk(v1[2], v1[3]);
                    *(u32x4*)(rowp + bj * 128) = w;
                }
            }
    }
};
struct EpiOut {
    static constexpr bool PERM = false, AFTER_DRAIN = false;
    float* X; const float* gate; const float* res_lat; const float* res_ctx;
    __device__ __forceinline__ void operator()(const f32x4 (&acc)[2][2][4][2], const pg8::Unit& u, int wr, int wc, int fr, int fq) const {
        const int row0 = u.pm * 256 + wr * 64 + fr, col0 = u.pn * 256 + wc * 32 + 4 * fq;
        const float* g = gate + (size_t)mod_row(u.pm * 256) * 6144 + col0;
        f32x4 gv[2][2];
#pragma unroll
        for (int bj = 0; bj < 2; ++bj)
#pragma unroll
            for (int n = 0; n < 2; ++n) gv[bj][n] = *(const f32x4*)(g + bj * 128 + n * 16);
#pragma unroll
        for (int ai = 0; ai < 2; ++ai)
#pragma unroll
            for (int m = 0; m < 4; ++m) { const size_t off = (size_t)(row0 + ai * 128 + m * 16) * D + col0; float* xp = X + off; const float* rp = (u.pm < T / 256 ? res_lat : res_ctx) + off;
#pragma unroll
                for (int bj = 0; bj < 2; ++bj)
#pragma unroll
                    for (int n = 0; n < 2; ++n) { *(f32x4*)(xp + bj * 128 + n * 16) = *(const f32x4*)(rp + bj * 128 + n * 16) + gv[bj][n] * acc[ai][bj][m][n]; } }
    }
};
__device__ __forceinline__ float swiglu(float g, float u) {
    const float gt = fminf(g, 7.0f), up = fminf(fmaxf(u, -7.0f), 7.0f);
    return (up + 1.0f) * gt / (1.0f + __expf(-1.702f * gt));
}
struct EpiAct {
    static constexpr bool PERM = true, AFTER_DRAIN = false;
    unsigned char* ACT; const float* bgu;
    __device__ __forceinline__ void operator()(const f32x4 (&acc)[2][2][4][2], const pg8::Unit& u, int wr, int wc, int fr, int fq) const {
        const int row0 = u.pm * 256 + wr * 64 + fr, j0 = (u.pn * 256 + wc * 32 + 8 * fq) >> 1;
        const float* bp = bgu + (size_t)u.e * 2048 + j0;
        f32x4 bg[2], bu[2];
#pragma unroll
        for (int bj = 0; bj < 2; ++bj) { bg[bj] = *(const f32x4*)(bp + bj * 64); bu[bj] = *(const f32x4*)(bp + 1024 + bj * 64); }
#pragma unroll
        for (int ai = 0; ai < 2; ++ai)
#pragma unroll
            for (int m = 0; m < 4; ++m) { unsigned char* rowp = ACT + (size_t)(row0 + ai * 128 + m * 16) * FF + j0;
#pragma unroll
                for (int bj = 0; bj < 2; ++bj) { const f32x4 v0 = acc[ai][bj][m][0], v1 = acc[ai][bj][m][1];
                    const float a0 = swiglu(v0[0] + bg[bj][0], v0[1] + bu[bj][0]), a1 = swiglu(v0[2] + bg[bj][1], v0[3] + bu[bj][1]);
                    const float a2 = swiglu(v1[0] + bg[bj][2], v1[1] + bu[bj][2]), a3 = swiglu(v1[2] + bg[bj][3], v1[3] + bu[bj][3]);
                    const unsigned w = __builtin_amdgcn_cvt_pk_fp8_f32(a2, a3, __builtin_amdgcn_cvt_pk_fp8_f32(a0, a1, 0u, false), true);
                    *(unsigned*)(rowp + bj * 64) = w; } }
    }
};
struct EpiYB {
    static constexpr bool PERM = true, AFTER_DRAIN = false;
    bf16_t* YB; const float* bdn;
    __device__ __forceinline__ void operator()(const f32x4 (&acc)[2][2][4][2], const pg8::Unit& u, int wr, int wc, int fr, int fq) const {
        const int row0 = u.pm * 256 + wr * 64 + fr, col0 = u.pn * 256 + wc * 32 + 8 * fq;
        const float* bp = bdn + (size_t)u.e * D + col0;
        f32x4 bv[2][2];
#pragma unroll
        for (int bj = 0; bj < 2; ++bj)
#pragma unroll
            for (int n = 0; n < 2; ++n) bv[bj][n] = *(const f32x4*)(bp + bj * 128 + n * 4);
#pragma unroll
        for (int ai = 0; ai < 2; ++ai)
#pragma unroll
            for (int m = 0; m < 4; ++m) { bf16_t* rowp = YB + (size_t)(row0 + ai * 128 + m * 16) * D + col0;
#pragma unroll
                for (int bj = 0; bj < 2; ++bj) { const f32x4 v0 = acc[ai][bj][m][0] + bv[bj][0], v1 = acc[ai][bj][m][1] + bv[bj][1];
                    u32x4 w; w.x = cvtpk(v0[0], v0[1]); w.y = cvtpk(v0[2], v0[3]); w.z = cvtpk(v1[0], v1[1]); w.w = cvtpk(v1[2], v1[3]);
                    *(u32x4*)(rowp + bj * 128) = w; } }
    }
};
struct MoeOrder {
    int nN, nunits, G, v; const int* tile_e;
    __device__ void init(int ntiles, int nN_, int G_, int c, const int* te) { nN = nN_; nunits = ntiles * nN_; G = G_; v = (G_ % 8 == 0) ? (c % 8) * (G_ / 8) + c / 8 : c; tile_e = te; }
    __device__ bool next(int i, pg8::Unit& u) const {
        const int L = i * G + v; if (L >= nunits) return false;
        u.pm = L / nN; u.pn = L % nN; u.e = tile_e[u.pm]; return true;
    }
    __device__ __forceinline__ const bf16_t* bt(const pg8::Gemm& g, const pg8::Unit& u) const { return g.Bt + (size_t)u.e * g.N * g.K; }
    __device__ __forceinline__ void a_ready(const pg8::Unit&) const {}
    __device__ __forceinline__ void done(const pg8::Unit&) const {}
};

__device__ __forceinline__ void ph_gemm_proj(const P& p, int l, char* lds) {
    pg8::Gemm g{p.H, p.WinT + (size_t)l * PW * D, R, PW, D}; pg8::StaticOrder S; S.init(R, PW, (int)gridDim.x, (int)blockIdx.x);
    EpiProj E{p.PROJ, p.rope};
    pg8::gemm_phase<EpiProj, pg8::StaticOrder, true, true>((PG8_LAS unsigned char*)lds, g, S, E);
}
__device__ __forceinline__ void ph_gemm_out(const P& p, int l, int nrows, char* lds) {
    pg8::Gemm g{p.MIX, p.WoutT + (size_t)l * D * D, nrows, D, D}; pg8::StaticOrder S; S.init(nrows, D, (int)gridDim.x, (int)blockIdx.x);
    EpiOut E{p.X, p.mod + (size_t)l * 5 * 6144 + 2 * 1024, l == 0 ? p.x : p.X, l == 0 ? p.ctx - (size_t)T * D : p.X};
    pg8::gemm_phase<EpiOut, pg8::StaticOrder, true, true>((PG8_LAS unsigned char*)lds, g, S, E);
}
__device__ __forceinline__ void ph_moe1(const P& p, int l, char* lds) {
    const int* meta = p.moe_meta + l * 512;
    const int ntiles = meta[0];
    pg8::Gemm g{(const bf16_t*)p.HS, (const bf16_t*)(p.WguT + (size_t)l * NE * 2048 * D), ntiles * 256, 2048, D / 2}; MoeOrder S; S.init(ntiles, 8, (int)gridDim.x, (int)blockIdx.x, meta + 1);
    EpiAct E{p.ACT, p.b_gu + (size_t)l * NE * 2048};
    pg8::gemm_phase<EpiAct, MoeOrder, false, true, true>((PG8_LAS unsigned char*)lds, g, S, E);
}
__device__ __forceinline__ void ph_moe2(const P& p, int l, char* lds) {
    const int* meta = p.moe_meta + l * 512;
    const int ntiles = meta[0];
    pg8::Gemm g{(const bf16_t*)p.ACT, (const bf16_t*)(p.WdnT + (size_t)l * NE * D * FF), ntiles * 256, D, FF / 2}; MoeOrder S; S.init(ntiles, 4, (int)gridDim.x, (int)blockIdx.x, meta + 1);
    EpiYB E{p.YB, p.b_down + (size_t)l * NE * D};
    pg8::gemm_phase<EpiYB, MoeOrder, false, true, true>((PG8_LAS unsigned char*)lds, g, S, E);
}
__device__ __forceinline__ void ph_combine(const P& p, int l, int nrows) {
    const int wave = ltid() >> 6, lane = ltid() & 63;
    for (int row = blockIdx.x * 8 + wave; row < nrows; row += gridDim.x * 8) {
        const int4 sl = *(const int4*)(p.tok_slot + (size_t)row * 4);
        const float4 g = *(const float4*)(p.topg + (size_t)row * 4);
        const float* m = p.mod + ((size_t)l * 5 + mod_row(row)) * 6144 + 5 * 1024;
        float xv[16]; float ss = 0.f;
#pragma unroll
        for (int i = 0; i < 2; ++i) {
            const int k = lane * 8 + 512 * i;
            const uint4 y0 = *(const uint4*)(p.YB + (size_t)sl.x * D + k), y1 = *(const uint4*)(p.YB + (size_t)sl.y * D + k);
            const uint4 y2 = *(const uint4*)(p.YB + (size_t)sl.z * D + k), y3 = *(const uint4*)(p.YB + (size_t)sl.w * D + k);
            const unsigned a0[4] = {y0.x, y0.y, y0.z, y0.w}, a1[4] = {y1.x, y1.y, y1.z, y1.w}, a2[4] = {y2.x, y2.y, y2.z, y2.w}, a3[4] = {y3.x, y3.y, y3.z, y3.w};
            const float* xp = p.X + (size_t)row * D + k;
            const float4 gta = *(const float4*)(m + k), gtb = *(const float4*)(m + k + 4);
            const float4 xa = *(const float4*)xp, xb = *(const float4*)(xp + 4);
            const float gt[8] = {gta.x, gta.y, gta.z, gta.w, gtb.x, gtb.y, gtb.z, gtb.w};
            const float x8[8] = {xa.x, xa.y, xa.z, xa.w, xb.x, xb.y, xb.z, xb.w};
#pragma unroll
            for (int q = 0; q < 4; ++q) {
                const float ylo = g.x * __uint_as_float(a0[q] << 16) + g.y * __uint_as_float(a1[q] << 16) + g.z * __uint_as_float(a2[q] << 16) + g.w * __uint_as_float(a3[q] << 16);
                const float yhi = g.x * __uint_as_float(a0[q] & 0xffff0000u) + g.y * __uint_as_float(a1[q] & 0xffff0000u) + g.z * __uint_as_float(a2[q] & 0xffff0000u) + g.w * __uint_as_float(a3[q] & 0xffff0000u);
                const float v0 = x8[2 * q] + gt[2 * q] * ylo, v1 = x8[2 * q + 1] + gt[2 * q + 1] * yhi;
                xv[8 * i + 2 * q] = v0; xv[8 * i + 2 * q + 1] = v1; ss += v0 * v0 + v1 * v1;
            }
        }
        ss = wave_sum(ss);
        const float rstd = rsqrtf(ss * (1.f / D) + EPS);
        if (l == 0) {
            const float* m1 = p.mod + ((size_t)5 + mod_row(row)) * 6144;
            const float* g1 = p.g_mix + D;
#pragma unroll
            for (int i = 0; i < 2; ++i) {
                const int k = lane * 8 + 512 * i;
                float* xp = p.X + (size_t)row * D + k;
                *(float4*)xp = make_float4(xv[8 * i], xv[8 * i + 1], xv[8 * i + 2], xv[8 * i + 3]);
                *(float4*)(xp + 4) = make_float4(xv[8 * i + 4], xv[8 * i + 5], xv[8 * i + 6], xv[8 * i + 7]);
                const float4 ga = *(const float4*)(g1 + k), gb = *(const float4*)(g1 + k + 4);
                const float4 sha = *(const float4*)(m1 + k), shb = *(const float4*)(m1 + k + 4);
                const float4 sca = *(const float4*)(m1 + 1024 + k), scb = *(const float4*)(m1 + 1024 + k + 4);
                u32x4 o;
                o.x = cvtpk(xv[8 * i] * rstd * ga.x * (1.f + sca.x) + sha.x, xv[8 * i + 1] * rstd * ga.y * (1.f + sca.y) + sha.y);
                o.y = cvtpk(xv[8 * i + 2] * rstd * ga.z * (1.f + sca.z) + sha.z, xv[8 * i + 3] * rstd * ga.w * (1.f + sca.w) + sha.w);
                o.z = cvtpk(xv[8 * i + 4] * rstd * gb.x * (1.f + scb.x) + shb.x, xv[8 * i + 5] * rstd * gb.y * (1.f + scb.y) + shb.y);
                o.w = cvtpk(xv[8 * i + 6] * rstd * gb.z * (1.f + scb.z) + shb.z, xv[8 * i + 7] * rstd * gb.w * (1.f + scb.w) + shb.w);
                *(u32x4*)(p.H + (size_t)row * D + k) = o;
            }
        } else {
#pragma unroll
            for (int i = 0; i < 2; ++i) {
                const int k = lane * 8 + 512 * i;
                const float4 ga = *(const float4*)(p.g_final + k), gb = *(const float4*)(p.g_final + k + 4);
                float* op = p.out + (size_t)row * D + k;
                *(float4*)op = make_float4(xv[8 * i] * rstd * ga.x, xv[8 * i + 1] * rstd * ga.y, xv[8 * i + 2] * rstd * ga.z, xv[8 * i + 3] * rstd * ga.w);
                *(float4*)(op + 4) = make_float4(xv[8 * i + 4] * rstd * gb.x, xv[8 * i + 5] * rstd * gb.y, xv[8 * i + 6] * rstd * gb.z, xv[8 * i + 7] * rstd * gb.w);
            }
        }
    }
}
#ifndef PROBE_DUP
#define PROBE_DUP 0
#endif
#ifndef PROBE_DUP
#define PROBE_DUP 0
#endif
extern __shared__ __attribute__((aligned(16))) char smem[];
__global__ void __launch_bounds__(NT, 2) mega(P p) {
    char* lds = smem;
    if (threadIdx.x == 0) *(uint4*)(smem + LDS_MAIN) = make_uint4(0u, 0u, 0u, 0u);
    __syncthreads();
    XcdBarrier bar = xcd_barrier_post(p.bar, (volatile LAS unsigned*)(smem + LDS_MAIN));
    ph_prologue(p, lds, 0);
    xcd_barrier(bar);
    ph_norm1(p, 0);
    ph_prologue(p, lds, 1);
    if (PROBE_DUP == 1) ph_prologue(p, lds, 1);
    if (PROBE_DUP == 5) ph_norm1(p, 0);
    xcd_barrier(bar);
#pragma unroll
    for (int l = 0; l < 2; ++l) {
        const int nrows = l == 0 ? R : T;
        ph_gemm_proj(p, l, lds);
        if (PROBE_DUP == 4) ph_gemm_proj(p, l, lds);
        xcd_barrier(bar);
        ph_dattn(p, l, nrows, lds);
        if (PROBE_DUP == 2) ph_dattn(p, l, nrows, lds);
        ph_na(p, l, nrows, lds);
        if (PROBE_DUP == 5) ph_na(p, l, nrows, lds);
        ph_pool(p, l, nrows, lds);
        ph_sgu(p, l, nrows, lds);
        if (PROBE_DUP == 3) { ph_pool(p, l, nrows, lds); ph_sgu(p, l, nrows, lds); }
        xcd_barrier(bar);
        ph_gemm_out(p, l, nrows, lds);
        xcd_barrier(bar);
        ph_router(p, l, nrows, lds);
        xcd_barrier(bar);
        ph_assign(p, l, nrows, lds);
        xcd_barrier(bar);
        if (PROBE_DUP == 8) { xcd_barrier(bar); xcd_barrier(bar); xcd_barrier(bar); xcd_barrier(bar); xcd_barrier(bar); }
        ph_moe1(p, l, lds);
        if (PROBE_DUP == 6) ph_moe1(p, l, lds);
        xcd_barrier(bar);
        ph_moe2(p, l, lds);
        if (PROBE_DUP == 7) ph_moe2(p, l, lds);
        xcd_barrier(bar);
        ph_combine(p, l, nrows);
        if (l == 0) xcd_barrier(bar);
    }
}

static inline size_t align_up(size_t v, size_t a) { return (v + a - 1) / a * a; }

extern "C" void kernel_launch(void* const* d_in, const int* in_sizes, int n_in, void* d_out, int out_size, void* d_ws, size_t ws_size, hipStream_t stream) {
    P p{};
    const float** ins = (const float**)&p.x;
    for (int i = 0; i < 28; ++i) ins[i] = (const float*)d_in[i];
    p.out = (float*)d_out;
    char* w = (char*)d_ws; size_t off = 0;
    auto carve = [&](size_t bytes) { void* r = w + off; off = align_up(off + bytes, 256); return r; };
    const size_t ctl_bytes = XCD_BAR_WORDS * 4 + 2 * 64 * 4;
    p.bar = (unsigned*)carve(ctl_bytes);
    p.cnt = (int*)(p.bar + XCD_BAR_WORDS);
    p.mod = (float*)carve((size_t)2 * 5 * 6144 * 4);
    p.rope = (float*)carve(64 * 8 * 2 * 4);
    p.X = (float*)carve((size_t)R * D * 4);
    p.H = (bf16_t*)carve((size_t)R * D * 2);
    p.PROJ = (bf16_t*)carve((size_t)R * PW * 2);
    p.MIX = (bf16_t*)carve((size_t)R * D * 2);
    p.WinT = (bf16_t*)carve((size_t)2 * PW * D * 2);
    p.WoutT = (bf16_t*)carve((size_t)2 * D * D * 2);
    p.WguT = (unsigned char*)carve((size_t)2 * NE * 2048 * D);
    p.WdnT = (unsigned char*)carve((size_t)2 * NE * D * FF);
    p.WpT = (bf16_t*)carve((size_t)2 * 4 * 64 * 64 * 2);
    p.WsB = (bf16_t*)carve((size_t)2 * 4 * 128 * 128 * 2);
    p.topi = (int*)carve((size_t)R * 4 * 4);
    p.topg = (float*)carve((size_t)R * 4 * 4);
    p.tok_slot = (int*)carve((size_t)R * 4 * 4);
    p.moe_meta = (int*)carve(2 * 512 * 4);
    p.HS = (unsigned char*)carve((size_t)NSLOT * D);
    p.ACT = (unsigned char*)carve((size_t)NSLOT * FF);
    p.YB = (bf16_t*)carve((size_t)NSLOT * D * 2);

    static int grid = 0;
    if (!grid) {
        int dev = 0, cus = 0, per_cu = 0;
        (void)hipGetDevice(&dev);
        (void)hipDeviceGetAttribute(&cus, hipDeviceAttributeMultiprocessorCount, dev);
        (void)hipFuncSetAttribute((const void*)mega, hipFuncAttributeMaxDynamicSharedMemorySize, LDS_BYTES);
        (void)hipOccupancyMaxActiveBlocksPerMultiprocessor(&per_cu, mega, NT, LDS_BYTES);
        grid = cus * (per_cu < 1 ? per_cu : 1);
        if (grid <= 0) { fprintf(stderr, "mega: occupancy query returned %d blocks per CU\n", per_cu); grid = 0; return; }
    }
    (void)hipMemsetAsync(p.bar, 0, ctl_bytes, stream);
    mega<<<grid, NT, LDS_BYTES, stream>>>(p);
}
```

```cpp
#include <hip/hip_runtime.h>
#include <stdint.h>
#include <cstdio>

typedef unsigned short bf16_t;
typedef short bf16x8 __attribute__((ext_vector_type(8)));
typedef float f32x4 __attribute__((ext_vector_type(4)));

constexpr int D = 1024, NB = 4, S = 4096, T = NB * S, CL = 256, TC = NB * CL, R = T + TC;
constexpr int PW = 2304, NE = 32, TOPK = 4, FF = 1024;
constexpr int MAXSLOT = R * TOPK;
constexpr int NSLOT = MAXSLOT + NE * 256;
constexpr float EPS = 1e-6f;
constexpr int NT = 512;
constexpr int LDS_MAIN = 150 * 1024;
constexpr int LDS_BYTES = LDS_MAIN + 1024;

__device__ __forceinline__ bf16_t f2bf(float f) { unsigned u = __float_as_uint(f); return (bf16_t)((u + 0x7fffu + ((u >> 16) & 1u)) >> 16); }
__device__ __forceinline__ float bf2f(bf16_t h) { return __uint_as_float(((unsigned)h) << 16); }
__device__ __forceinline__ float wave_sum(float v) {
#pragma unroll
    for (int o = 32; o >= 1; o >>= 1) v += __shfl_xor(v, o);
    return v;
}
__device__ __forceinline__ int mod_row(int row) { return row < T ? (row >> 12) : 4; }

#define XB_TMO      128
#define XB_XCNT(j)  (256  + 64 * (j))
#define XB_XSUB(j)  (1280 + 64 * (j))
#define XB_XGEN(j)  (2304 + 64 * (j))
#define XB_TOP      3328
#define XB_TOPGEN   3392
#define XCD_BAR_WORDS 3456
#define XB_SPIN_CAP (1u << 18)
#define LAS __attribute__((address_space(3)))

__device__ __forceinline__ unsigned xb_ld(unsigned* p)              { return __hip_atomic_load(p, __ATOMIC_RELAXED, __HIP_MEMORY_SCOPE_AGENT); }
__device__ __forceinline__ unsigned xb_add(unsigned* p, unsigned v) { return __hip_atomic_fetch_add(p, v, __ATOMIC_RELAXED, __HIP_MEMORY_SCOPE_AGENT); }
__device__ __forceinline__ unsigned xb_xcc_id() { return (unsigned)__builtin_amdgcn_s_getreg((3 << 11) | 20) & 0xFu; }
#define XB_SPIN(cond, bar) do { unsigned _sp = 0; while (cond) { __builtin_amdgcn_s_sleep(1); \
    if ((++_sp & 255u) == 0u) { if (xb_ld(&(bar)[XB_TMO])) break; if (_sp > XB_SPIN_CAP) { atomicAdd(&(bar)[XB_TMO], 1u); break; } } } } while (0)

struct XcdBarrier {
    unsigned* bar; unsigned x;
    volatile LAS unsigned* st;
};
__device__ __forceinline__ XcdBarrier xcd_barrier_post(unsigned* bar, volatile LAS unsigned* st) {
    XcdBarrier b; b.bar = bar; b.x = xb_xcc_id(); b.st = st;
    if (threadIdx.x == 0) (void)xb_add(&bar[XB_XCNT(b.x)], 1u);
    return b;
}
__device__ __forceinline__ void xcd_barrier_complete(unsigned* bar, unsigned x, unsigned& nloc, unsigned& nx) {
    const unsigned G = gridDim.x * gridDim.y * gridDim.z;
    unsigned sum, cnt, mine, sp = 0u;
    for (;;) {
        sum = 0u; cnt = 0u; mine = 0u;
#pragma unroll
        for (unsigned j = 0; j < 16; ++j) { const unsigned c = xb_ld(&bar[XB_XCNT(j)]); sum += c; cnt += (c > 0u) ? 1u : 0u; mine = (j == x) ? c : mine; }
        if (sum == G) break;
        __builtin_amdgcn_s_sleep(1);
        if ((++sp & 255u) == 0u) { if (xb_ld(&bar[XB_TMO])) break; if (sp > XB_SPIN_CAP) { atomicAdd(&bar[XB_TMO], 1u); break; } }
    }
    nloc = mine > 0u ? mine : 1u; nx = cnt > 0u ? cnt : 1u;
}
__device__ __forceinline__ void xcd_barrier(const XcdBarrier& b) {
    asm volatile("s_waitcnt vmcnt(0)" ::: "memory");
    __syncthreads();
    if (threadIdx.x == 0) {
        unsigned* bar = b.bar;
        __builtin_amdgcn_s_waitcnt(0);
        unsigned nloc = b.st[0], nx = b.st[1];
        if (nloc == 0u) { xcd_barrier_complete(bar, b.x, nloc, nx); b.st[0] = nloc; b.st[1] = nx; }
        const unsigned old = xb_add(&bar[XB_XSUB(b.x)], 1u);
        const unsigned gen = old / nloc;
        if (old + 1u == (gen + 1u) * nloc) {
            __builtin_amdgcn_fence(__ATOMIC_RELEASE, "agent");
            asm volatile("s_waitcnt vmcnt(0)" ::: "memory");
            const unsigned og = xb_add(&bar[XB_TOP], 1u);
            const unsigned tg = og / nx;
            if (og + 1u == (tg + 1u) * nx) xb_add(&bar[XB_TOPGEN], 1u);
            else XB_SPIN(xb_ld(&bar[XB_TOPGEN]) == tg, bar);
            __builtin_amdgcn_fence(__ATOMIC_ACQUIRE, "agent");
            xb_add(&bar[XB_XGEN(b.x)], 1u);
            asm volatile("s_waitcnt vmcnt(0)" ::: "memory");
        } else {
            XB_SPIN(xb_ld(&bar[XB_XGEN(b.x)]) == gen, bar);
            __builtin_amdgcn_fence(__ATOMIC_ACQUIRE, "agent");
            asm volatile("s_waitcnt vmcnt(0)" ::: "memory");
        }
    }
    __syncthreads();
}

struct P {
    const float *x, *c, *ctx, *c_ctx, *w_mod, *b_mod, *g_mix, *g_ffn, *w_in, *w_out, *lam_q1, *lam_k1, *lam_q2, *lam_k2, *g_sub,
        *w_pool, *s_pool, *g_sgu, *w_sgu, *b_sgu, *rpb, *w_router, *b_router, *w_gu, *b_gu, *w_down, *b_down, *g_final;
    float* out;
    unsigned* bar;
    int* cnt;
    float* mod;
    float* rope;
    float* X;
    bf16_t* H;
    bf16_t* PROJ;
    bf16_t* MIX;
    bf16_t* WinT;
    bf16_t* WoutT;
    unsigned char* WguT;
    unsigned char* WdnT;
    bf16_t* WpT;
    bf16_t* WsB;
    int* topi;
    float* topg;
    int* tok_slot;
    int* moe_meta;
    unsigned char* HS;
    unsigned char* ACT;
    bf16_t* YB;
};

__device__ __forceinline__ int ltid() { int t = threadIdx.x; asm volatile("" : "+v"(t)); return t; }
typedef float f32x16 __attribute__((ext_vector_type(16)));
typedef short s16x4 __attribute__((ext_vector_type(4)));
typedef short v4i16_t __attribute__((ext_vector_type(4)));
typedef float f32x2_t __attribute__((ext_vector_type(2)));
typedef __bf16 bf16x2_t __attribute__((ext_vector_type(2)));
typedef __attribute__((address_space(3))) const char* lds_cptr;
typedef unsigned u32x4 __attribute__((ext_vector_type(4)));
__device__ __forceinline__ unsigned cvtpk(float lo, float hi) { f32x2_t v = {lo, hi}; bf16x2_t b = __builtin_convertvector(v, bf16x2_t); return __builtin_bit_cast(unsigned, b); }
__device__ __forceinline__ s16x4 vtr(lds_cptr q) { return __builtin_bit_cast(s16x4, __builtin_amdgcn_ds_read_tr16_b64_v4i16((__attribute__((address_space(3))) v4i16_t*)q)); }
__device__ __forceinline__ float xhalf_max(float v) { auto rr = __builtin_amdgcn_permlane32_swap(__float_as_uint(v), __float_as_uint(v), false, false); return fmaxf(__uint_as_float(rr[0]), __uint_as_float(rr[1])); }
__device__ __forceinline__ float xhalf_sum(float v) { auto rr = __builtin_amdgcn_permlane32_swap(__float_as_uint(v), __float_as_uint(v), false, false); return __uint_as_float(rr[0]) + __uint_as_float(rr[1]); }
namespace pg8 {
#define PG8_LAS __attribute__((address_space(3)))
constexpr int BM = 256, BK = 64, HALF = 128, HTB = HALF * BK * 2  , STAGE_BYTES = 8 * HTB, NXCD = 8, WGM = 8;
__host__ __device__ __forceinline__ int lds_byte(int r, int c) { const int st = (r >> 4) * 2 + (c >> 5), rr = r & 15, cc = c & 31, ob = rr * 64 + cc * 2; return st * 1024 + (ob ^ (((ob >> 9) & 1) << 5)); }
__host__ __device__ __forceinline__ void stage_rc(int b, int& R, int& C) { const int st = b / 1024, sb = b % 1024, swz = sb ^ (((sb >> 9) & 1) << 5); R = (st >> 1) * 16 + swz / 64; C = (st & 1) * 32 + (swz % 64) / 2; }
__host__ __device__ __forceinline__ int perm32(int rho) { const int n = rho >> 4, i = rho & 15; return 8 * (i >> 2) + 4 * n + (i & 3); }
struct Unit { int pm, pn, e; };
struct Gemm { const bf16_t* A; const bf16_t* Bt; int M, N, K; };
struct StaticOrder {
    int nM, nN, nwg, G, c;
    __host__ __device__ void init(int M, int N, int G_, int c_) { nM = M / BM; nN = N / BM; nwg = nM * nN; G = G_; c = c_; }
    __host__ __device__ bool next(int i, Unit& u) const {
        const long L = (long)i * G + c; if (L >= nwg) return false;
        int wgid = (int)L; { const int q = nwg / NXCD, r = nwg % NXCD, xcd = wgid % NXCD, off = wgid / NXCD; wgid = (xcd < r ? xcd * (q + 1) : r * (q + 1) + (xcd - r) * q) + off; }
        const int nig = WGM * nN, gid = wgid / nig, fm = gid * WGM, gsz = (nM - fm) < WGM ? (nM - fm) : WGM;
        u.pm = fm + ((wgid % nig) % gsz); u.pn = (wgid % nig) / gsz; u.e = 0; return true;
    }
    __device__ __forceinline__ const bf16_t* bt(const Gemm& g, const Unit&) const { return g.Bt; }
    __device__ __forceinline__ void a_ready(const Unit&) const {}
    __device__ __forceinline__ void done(const Unit&) const {}
};
typedef int v4i_t __attribute__((ext_vector_type(4)));
typedef int v8i_t __attribute__((ext_vector_type(8)));
__device__ __forceinline__ v8i_t cat8(bf16x8 a, bf16x8 b) { const v4i_t x = __builtin_bit_cast(v4i_t, a), y = __builtin_bit_cast(v4i_t, b); return __builtin_shufflevector(x, y, 0, 1, 2, 3, 4, 5, 6, 7); }
template <class Epi, class Sched, bool ALIGN_EPI = false, bool SP2 = false, bool F8 = false>
__device__ __forceinline__ void gemm_phase(PG8_LAS unsigned char* lds, const Gemm g, const Sched& S, const Epi& E) {
    const int tid = ltid(), wid = __builtin_amdgcn_readfirstlane(tid >> 6), lane = tid & 63, wr = wid >> 2, wc = wid & 3, fr = lane & 15, fq = lane >> 4;
    const int K = g.K, nt = K / BK;
    unsigned voffA[2], voffB[2];
#pragma unroll
    for (int i = 0; i < 2; ++i) { int R, C; stage_rc(tid * 16 + i * 8192, R, C); const int Rb = Epi::PERM ? ((R & ~31) + perm32(R & 31)) : R;
        voffA[i] = (unsigned)(R * K + C) * 2u; voffB[i] = (unsigned)(Rb * K + C) * 2u; }
    const size_t kstep = (size_t)(BK * 2);
    const size_t hstep = (size_t)HALF * K * 2;
    const size_t tstep = 2 * hstep;
    const unsigned ldsw = (unsigned)wid * 1024u;
    const int aoff = lds_byte(wr * 64 + fr, fq * 8), boff = lds_byte(wc * 32 + fr, fq * 8);
#define PG8_SA(b, h) (((b) * 2 + (h)) * HTB)
#define PG8_SB(b, h) ((4 + (b) * 2 + (h)) * HTB)
#define PG8_STAGE(bufoff, gbase, voff) do { _Pragma("unroll") for (int _i = 0; _i < 2; ++_i) \
        __builtin_amdgcn_global_load_lds((const unsigned*)((const char*)(gbase) + (voff)[_i]), (PG8_LAS unsigned*)(lds + (bufoff) + ldsw + _i * 8192), 16, 0, 0); } while (0)
#define PG8_LDA(dst, b, h) do { _Pragma("unroll") for (int m = 0; m < 4; ++m) _Pragma("unroll") for (int k = 0; k < 2; ++k) dst[m][k] = *(const PG8_LAS bf16x8*)(lds + PG8_SA(b, h) + aoff + m * 2048 + k * 1024); \
        if constexpr (F8) { _Pragma("unroll") for (int m = 0; m < 4; ++m) dst##8[m] = cat8(dst[m][0], dst[m][1]); } } while (0)
#define PG8_LDB(dst, b, h) do { _Pragma("unroll") for (int n = 0; n < 2; ++n) _Pragma("unroll") for (int k = 0; k < 2; ++k) dst[n][k] = *(const PG8_LAS bf16x8*)(lds + PG8_SB(b, h) + boff + n * 2048 + k * 1024); \
        if constexpr (F8) { _Pragma("unroll") for (int n = 0; n < 2; ++n) dst##8[n] = cat8(dst[n][0], dst[n][1]); } } while (0)
#define PG8_MMA(ai, bj, At, Bt) do { __builtin_amdgcn_s_setprio(1); \
        if constexpr (F8) { _Pragma("unroll") for (int m = 0; m < 4; ++m) _Pragma("unroll") for (int n = 0; n < 2; ++n) \
            asm volatile("v_mfma_scale_f32_16x16x128_f8f6f4 %0, %1, %2, %0, %3, %4 op_sel_hi:[0,0,0]" : "+v"(acc[ai][bj][m][n]) : "v"(Bt##8[n]), "v"(At##8[m]), "v"(sclW), "v"(sclX)); } \
        else { _Pragma("unroll") for (int m = 0; m < 4; ++m) _Pragma("unroll") for (int n = 0; n < 2; ++n) _Pragma("unroll") for (int k = 0; k < 2; ++k) \
            acc[ai][bj][m][n] = __builtin_amdgcn_mfma_f32_16x16x32_bf16(Bt[n][k], At[m][k], acc[ai][bj][m][n], 0, 0, 0); } \
        __builtin_amdgcn_s_setprio(0); } while (0)
#define PG8_WAIT_V(n) asm volatile("s_waitcnt vmcnt(" #n ")" ::: "memory")
#define PG8_WAIT_L(n) asm volatile("s_waitcnt lgkmcnt(" #n ")" ::: "memory")
#define PG8_BAR __builtin_amdgcn_s_barrier()
#define PG8_SCHED __builtin_amdgcn_sched_barrier(0)
    Unit cur, nxt; int ui = 0;
    if (!S.next(0, cur)) return;
    f32x4 acc[2][2][4][2];
#pragma unroll
    for (int a = 0; a < 2; ++a)
#pragma unroll
        for (int b = 0; b < 2; ++b)
#pragma unroll
            for (int m = 0; m < 4; ++m)
#pragma unroll
                for (int n = 0; n < 2; ++n) { acc[a][b][m][n] = (f32x4){0.f, 0.f, 0.f, 0.f}; }
    bf16x8 At[4][2], B0[2][2], B1[2][2];
    v8i_t At8[4], B08[2], B18[2];
    const int sclW = 0x79797979, sclX = 0x7f7f7f7f;
    const char* cA = (const char*)g.A + (size_t)cur.pm * tstep; const char* cB = (const char*)S.bt(g, cur) + (size_t)cur.pn * tstep;
    S.a_ready(cur);
    if constexpr (SP2) {
        PG8_STAGE(PG8_SB(0, 0), cB, voffB); PG8_STAGE(PG8_SB(0, 1), cB + hstep, voffB); PG8_STAGE(PG8_SA(0, 0), cA, voffA); PG8_STAGE(PG8_SA(0, 1), cA + hstep, voffA);
        if (wr == 1) PG8_BAR;
        PG8_WAIT_V(2); PG8_BAR;
        PG8_STAGE(PG8_SB(1, 0), cB + kstep, voffB); PG8_STAGE(PG8_SA(1, 0), cA + kstep, voffA); PG8_STAGE(PG8_SB(1, 1), cB + hstep + kstep, voffB);
        PG8_WAIT_V(6); PG8_BAR;
    } else {
        PG8_STAGE(PG8_SB(0, 0), cB, voffB); PG8_STAGE(PG8_SA(0, 0), cA, voffA); PG8_STAGE(PG8_SB(0, 1), cB + hstep, voffB); PG8_STAGE(PG8_SA(0, 1), cA + hstep, voffA);
        if (wr == 1) PG8_BAR;
        PG8_WAIT_V(4); PG8_BAR;
        PG8_STAGE(PG8_SB(1, 0), cB + kstep, voffB); PG8_STAGE(PG8_SA(1, 0), cA + kstep, voffA); PG8_STAGE(PG8_SB(1, 1), cB + hstep + kstep, voffB);
        PG8_WAIT_V(6); PG8_BAR;
    }
    for (;;) {
        const bool has_next = S.next(ui + 1, nxt);
        const char* nA = has_next ? (const char*)g.A + (size_t)nxt.pm * tstep : cA; const char* nB = has_next ? (const char*)S.bt(g, nxt) + (size_t)nxt.pn * tstep : cB;
#pragma unroll 1
        for (int t = 0; t < nt; t += 2) {
            const bool last = (t == nt - 2);
            const char* a1 = cA + (size_t)(t + 1) * kstep;
            const char* a2 = last ? nA : cA + (size_t)(t + 2) * kstep; const char* b2 = last ? nB : cB + (size_t)(t + 2) * kstep;
            const char* a3 = a2 + kstep; const char* b3 = b2 + kstep;
            if (last && has_next) S.a_ready(nxt);
            if constexpr (SP2) {
            PG8_LDB(B0, 0, 0); PG8_LDB(B1, 0, 1); PG8_SCHED; PG8_LDA(At, 0, 0); PG8_STAGE(PG8_SA(1, 1), a1 + hstep, voffA);
            PG8_WAIT_V(8); PG8_WAIT_L(0); PG8_BAR; PG8_MMA(0, 0, At, B0); PG8_MMA(0, 1, At, B1); PG8_BAR; PG8_SCHED;
            PG8_LDA(At, 0, 1); PG8_STAGE(PG8_SB(0, 0), b2, voffB); PG8_STAGE(PG8_SB(0, 1), b2 + hstep, voffB); PG8_STAGE(PG8_SA(0, 0), a2, voffA);
            PG8_WAIT_V(8); PG8_WAIT_L(0); PG8_BAR; PG8_MMA(1, 0, At, B0); PG8_MMA(1, 1, At, B1); PG8_BAR; PG8_SCHED;
            PG8_LDB(B0, 1, 0); PG8_LDB(B1, 1, 1); PG8_SCHED; PG8_LDA(At, 1, 0); PG8_STAGE(PG8_SA(0, 1), a2 + hstep, voffA);
            PG8_WAIT_V(8); PG8_WAIT_L(0); PG8_BAR; PG8_MMA(0, 0, At, B0); PG8_MMA(0, 1, At, B1); PG8_BAR; PG8_SCHED;
            PG8_LDA(At, 1, 1); PG8_STAGE(PG8_SB(1, 0), b3, voffB); PG8_STAGE(PG8_SB(1, 1), b3 + hstep, voffB); PG8_STAGE(PG8_SA(1, 0), a3, voffA);
            PG8_WAIT_V(8); PG8_WAIT_L(0); PG8_BAR; PG8_MMA(1, 0, At, B0); PG8_MMA(1, 1, At, B1); PG8_BAR; PG8_SCHED;
            } else {
            PG8_LDB(B0, 0, 0); PG8_SCHED; PG8_LDA(At, 0, 0); PG8_STAGE(PG8_SA(1, 1), a1 + hstep, voffA);
            PG8_WAIT_L(8); PG8_BAR; PG8_WAIT_L(0); PG8_MMA(0, 0, At, B0); PG8_BAR; PG8_SCHED;
            PG8_LDB(B1, 0, 1); PG8_STAGE(PG8_SB(0, 0), b2, voffB);
            PG8_BAR; PG8_WAIT_L(0); PG8_MMA(0, 1, At, B1); PG8_BAR;
            PG8_LDA(At, 0, 1); PG8_STAGE(PG8_SA(0, 0), a2, voffA);
            PG8_BAR; PG8_WAIT_L(0); PG8_MMA(1, 0, At, B0); PG8_BAR; PG8_SCHED;
            PG8_STAGE(PG8_SB(0, 1), b2 + hstep, voffB);
            PG8_WAIT_V(6); PG8_BAR; PG8_MMA(1, 1, At, B1); PG8_BAR;
            PG8_LDB(B0, 1, 0); PG8_SCHED; PG8_LDA(At, 1, 0); PG8_STAGE(PG8_SA(0, 1), a2 + hstep, voffA);
            PG8_WAIT_L(8); PG8_BAR; PG8_WAIT_L(0); PG8_MMA(0, 0, At, B0); PG8_BAR; PG8_SCHED;
            PG8_LDB(B1, 1, 1); PG8_STAGE(PG8_SB(1, 0), b3, voffB);
            PG8_BAR; PG8_WAIT_L(0); PG8_MMA(0, 1, At, B1); PG8_BAR;
            PG8_LDA(At, 1, 1); PG8_STAGE(PG8_SA(1, 0), a3, voffA);
            PG8_BAR; PG8_WAIT_L(0); PG8_MMA(1, 0, At, B0); PG8_BAR; PG8_SCHED;
            PG8_STAGE(PG8_SB(1, 1), b3 + hstep, voffB);
            PG8_WAIT_V(6); PG8_BAR; PG8_MMA(1, 1, At, B1); PG8_BAR;
            }
        }
        if constexpr (ALIGN_EPI) { if (wr == 0) PG8_BAR; }
        if constexpr (F8) asm volatile("s_nop 15\n\ts_nop 15" ::: "memory");
        if constexpr (!Epi::AFTER_DRAIN) { E(acc, cur, wr, wc, fr, fq); S.done(cur); }
        if (!has_next) break;
#pragma unroll
        for (int a = 0; a < 2; ++a)
#pragma unroll
            for (int b = 0; b < 2; ++b)
#pragma unroll
                for (int m = 0; m < 4; ++m)
#pragma unroll
                    for (int n = 0; n < 2; ++n) { acc[a][b][m][n] = (f32x4){0.f, 0.f, 0.f, 0.f}; }
        cur = nxt; cA = nA; cB = nB; ++ui;
        if constexpr (ALIGN_EPI) { if (wr == 1) PG8_BAR; }
    }
    PG8_WAIT_V(0);
    if constexpr (!ALIGN_EPI) { if (wr == 0) PG8_BAR; }
    PG8_BAR;
    if constexpr (Epi::AFTER_DRAIN) { E.fused(acc, cur, wr, wc, fr, fq, lds, wid, lane); S.done(cur); }
#undef PG8_SA
#undef PG8_SB
#undef PG8_STAGE
#undef PG8_LDA
#undef PG8_LDB
#undef PG8_MMA
#undef PG8_WAIT_V
#undef PG8_WAIT_L
#undef PG8_BAR
#undef PG8_SCHED
}
}

__device__ __forceinline__ void ph_prologue(const P& p, char* lds, const int part) {
    const int tid = ltid();
    float* fl = (float*)lds;
    if (part == 0) {
    for (int it = blockIdx.x; it < 96; it += gridDim.x) {
        const int l = it / 48, cg = it % 48;
        float* sc = fl;
        float* part = fl + 5 * 1024;
        __syncthreads();
        for (int i = tid; i < 5 * 1024; i += NT) {
            const int r = i >> 10, k = i & 1023;
            const float v = r < 4 ? p.c[r * 1024 + k] : p.c_ctx[k];
            sc[i] = v / (1.f + __expf(-v));
        }
        __syncthreads();
        const int kq = tid >> 7, col = tid & 127, j = cg * 128 + col;
        const float* W = p.w_mod + (size_t)l * 1024 * 6144;
        float a0 = 0, a1 = 0, a2 = 0, a3 = 0, a4 = 0;
        for (int k = kq * 256; k < kq * 256 + 256; ++k) {
            const float w = W[(size_t)k * 6144 + j];
            a0 += sc[k] * w; a1 += sc[1024 + k] * w; a2 += sc[2048 + k] * w; a3 += sc[3072 + k] * w; a4 += sc[4096 + k] * w;
        }
        part[(kq * 5 + 0) * 128 + col] = a0; part[(kq * 5 + 1) * 128 + col] = a1; part[(kq * 5 + 2) * 128 + col] = a2;
        part[(kq * 5 + 3) * 128 + col] = a3; part[(kq * 5 + 4) * 128 + col] = a4;
        __syncthreads();
        for (int i = tid; i < 5 * 128; i += NT) {
            const int r = i >> 7, cc = i & 127, jj = cg * 128 + cc;
            const float v = part[(0 * 5 + r) * 128 + cc] + part[(1 * 5 + r) * 128 + cc] + part[(2 * 5 + r) * 128 + cc] + part[(3 * 5 + r) * 128 + cc];
            p.mod[((size_t)l * 5 + r) * 6144 + jj] = v + p.b_mod[l * 6144 + jj];
        }
    }
    if (blockIdx.x == gridDim.x - 1) {
        const int pos = tid >> 3, f = tid & 7;
        const float inv = powf(10000.0f, -(float)f / 8.0f);
        const float ang = (float)pos * inv;
        p.rope[tid * 2] = cosf(ang); p.rope[tid * 2 + 1] = sinf(ang);
    }
    for (int i = blockIdx.x * NT + tid; i < 2 * 4 * 64 * 64; i += gridDim.x * NT) { const int ii = i & 63, j = (i >> 6) & 63, lg = i >> 12; p.WpT[i] = f2bf(p.w_pool[(size_t)lg * 4096 + ii * 64 + j]); }
    for (int i = blockIdx.x * NT + tid; i < 2 * 4 * 128 * 128; i += gridDim.x * NT) p.WsB[i] = f2bf(p.w_sgu[i]);
    }
    if (part == 0) {
        const int n_in = 2 * 9 * 16, n_out = 2 * 4 * 16, total = n_in + n_out;
        const int kr = tid >> 6, n4 = tid & 63, kg = tid & 7, nl = tid >> 3;
        for (int it = blockIdx.x; it < total; it += gridDim.x) {
            int i_ = it; const float* W_; bf16_t* Wt_; int N, K;
            if (i_ < n_in) { W_ = p.w_in; Wt_ = p.WinT; N = PW; K = D; } else { i_ -= n_in; W_ = p.w_out; Wt_ = p.WoutT; N = D; K = D; }
            const int ntn = N / 256, per = ntn * (K / 64), m_ = i_ / per, r_ = i_ % per, tn = r_ % ntn, tk = r_ / ntn, n0 = tn * 256;
            const float* src = W_ + (size_t)m_ * K * N + (size_t)(tk * 64) * N + n0; bf16_t* dst = Wt_ + (size_t)m_ * K * N + tk * 64;
            float4 rg[8];
#pragma unroll
            for (int i = 0; i < 8; ++i) rg[i] = *(const float4*)(src + (size_t)(kr + 8 * i) * N + n4 * 4);
            __syncthreads();
#pragma unroll
            for (int i = 0; i < 8; ++i) { float* q = fl + (kr + 8 * i) * 257 + n4 * 4; q[0] = rg[i].x; q[1] = rg[i].y; q[2] = rg[i].z; q[3] = rg[i].w; }
            __syncthreads();
#pragma unroll
            for (int j = 0; j < 4; ++j) {
                const int n = nl + 64 * j;
                const float* q = fl + (8 * kg) * 257 + n;
                u32x4 w;
                w.x = cvtpk(q[0], q[257]); w.y = cvtpk(q[2 * 257], q[3 * 257]); w.z = cvtpk(q[4 * 257], q[5 * 257]); w.w = cvtpk(q[6 * 257], q[7 * 257]);
                *(u32x4*)(dst + (size_t)(n0 + n) * K + 8 * kg) = w;
            }
        }
    } else {
        const int n_gu = 64 * 16 * 8, n_dn = 64 * 8 * 8, total = n_gu + n_dn;
        const int kr = tid >> 5, n4 = tid & 31, kg = (tid >> 3) & 7, nl = (tid & 7) + 8 * (tid >> 6);
        float4 rg[8];
        const float* src = nullptr; unsigned char* dst = nullptr; int N = 0, K = 0, n0 = 0, perm = 0;
        const float* nsrc = nullptr; unsigned char* ndst = nullptr; int nN = 0, nK = 0, nn0 = 0, nperm = 0;
#define TR_DECODE(IT, SRC, DST, NN, KK, N0, PERM) do { int i_ = (IT); const float* W_; unsigned char* Wt_; \
        if (i_ < n_gu) { W_ = p.w_gu; Wt_ = p.WguT; NN = 2048; KK = D; PERM = 1; } else { i_ -= n_gu; W_ = p.w_down; Wt_ = p.WdnT; NN = D; KK = FF; PERM = 0; } \
        const int ntn_ = NN / 128, per_ = ntn_ * (KK / 128), m_ = i_ / per_, r_ = i_ % per_, tn_ = r_ % ntn_, tk_ = r_ / ntn_; \
        N0 = tn_ * 128; SRC = W_ + (size_t)m_ * KK * NN + (size_t)(tk_ * 128) * NN + N0; DST = Wt_ + (size_t)m_ * KK * NN + tk_ * 128; } while (0)
        int it = blockIdx.x;
        if (it < total) {
            TR_DECODE(it, src, dst, N, K, n0, perm);
#pragma unroll
            for (int i = 0; i < 8; ++i) rg[i] = *(const float4*)(src + (size_t)(kr + 16 * i) * N + n4 * 4);
        }
        for (; it < total; it += gridDim.x) {
            __syncthreads();
#pragma unroll
            for (int i = 0; i < 8; ++i) { float* q = fl + (kr + 16 * i) * 129 + n4 * 4; q[0] = rg[i].x; q[1] = rg[i].y; q[2] = rg[i].z; q[3] = rg[i].w; }
            __syncthreads();
            const int nit = it + gridDim.x;
            if (nit < total) {
                TR_DECODE(nit, nsrc, ndst, nN, nK, nn0, nperm);
#pragma unroll
                for (int i = 0; i < 8; ++i) rg[i] = *(const float4*)(nsrc + (size_t)(kr + 16 * i) * nN + n4 * 4);
            }
#pragma unroll
            for (int j = 0; j < 2; ++j) {
                const int n = nl + 64 * j;
                const float* q = fl + (16 * kg) * 129 + n;
                u32x4 w;
#pragma unroll
                for (int d = 0; d < 4; ++d) {
                    unsigned r = __builtin_amdgcn_cvt_pk_fp8_f32(q[(4 * d) * 129] * 64.f, q[(4 * d + 1) * 129] * 64.f, 0u, false);
                    w[d] = __builtin_amdgcn_cvt_pk_fp8_f32(q[(4 * d + 2) * 129] * 64.f, q[(4 * d + 3) * 129] * 64.f, r, true);
                }
                const int ng = n0 + n;
                const int np = perm ? (ng < N / 2 ? 2 * ng : 2 * (ng - N / 2) + 1) : ng;
                *(u32x4*)(dst + (size_t)np * K + 16 * kg) = w;
            }
            src = nsrc; dst = ndst; N = nN; K = nK; n0 = nn0; perm = nperm;
        }
#undef TR_DECODE
    }
}

__device__ __forceinline__ void ph_norm1(const P& p, int l) {
    const int wave = ltid() >> 6, lane = ltid() & 63;
    for (int row = blockIdx.x * 8 + wave; row < R; row += gridDim.x * 8) {
        const float* xr = row < T ? p.x + (size_t)row * D : p.ctx + (size_t)(row - T) * D;
        float4 v[4]; float ss = 0;
#pragma unroll
        for (int i = 0; i < 4; ++i) { v[i] = *(const float4*)(xr + lane * 4 + 256 * i); ss += v[i].x * v[i].x + v[i].y * v[i].y + v[i].z * v[i].z + v[i].w * v[i].w; }
        ss = wave_sum(ss);
        const float rstd = rsqrtf(ss * (1.f / D) + EPS);
        const float* m = p.mod + ((size_t)l * 5 + mod_row(row)) * 6144;
        const float* g = p.g_mix + l * D;
#pragma unroll
        for (int i = 0; i < 4; ++i) {
            const int k = lane * 4 + 256 * i;
            const float4 gg = *(const float4*)(g + k), sh = *(const float4*)(m + k), sc = *(const float4*)(m + 1024 + k);
            uint2 o;
            o.x = cvtpk(v[i].x * rstd * gg.x * (1.f + sc.x) + sh.x, v[i].y * rstd * gg.y * (1.f + sc.y) + sh.y);
            o.y = cvtpk(v[i].z * rstd * gg.z * (1.f + sc.z) + sh.z, v[i].w * rstd * gg.w * (1.f + sc.w) + sh.w);
            *(uint2*)(p.H + (size_t)row * D + k) = o;
        }
    }
}

constexpr float QSCALE = 0.17677669529663687f * 1.4426950408889634f;
__device__ __forceinline__ void dsoftmax(const f32x16& s, float& m, float& l, f32x16& o0, f32x16& o1, bf16x8& pa, bf16x8& pb) {
    float mx = fmaxf(fmaxf(fmaxf(s[0], s[1]), fmaxf(s[2], s[3])), fmaxf(fmaxf(s[4], s[5]), fmaxf(s[6], s[7])));
    mx = fmaxf(mx, fmaxf(fmaxf(fmaxf(s[8], s[9]), fmaxf(s[10], s[11])), fmaxf(fmaxf(s[12], s[13]), fmaxf(s[14], s[15]))));
    mx = xhalf_max(mx);
    if (__any(mx > m)) {
        const float mn = fmaxf(m, mx), alpha = __builtin_amdgcn_exp2f(m - mn);
        o0 *= alpha; o1 *= alpha; l *= alpha; m = mn;
    }
    float pr[16]; float sum = 0.f;
#pragma unroll
    for (int r = 0; r < 16; ++r) { pr[r] = __builtin_amdgcn_exp2f(s[r] - m); sum += pr[r]; }
    l += sum;
    u32x4 a, b;
    a[0] = cvtpk(pr[0], pr[1]); a[1] = cvtpk(pr[2], pr[3]); a[2] = cvtpk(pr[4], pr[5]); a[3] = cvtpk(pr[6], pr[7]);
    b[0] = cvtpk(pr[8], pr[9]); b[1] = cvtpk(pr[10], pr[11]); b[2] = cvtpk(pr[12], pr[13]); b[3] = cvtpk(pr[14], pr[15]);
    pa = __builtin_bit_cast(bf16x8, a); pb = __builtin_bit_cast(bf16x8, b);
}
#define MX3(a, b, c) __builtin_fmaxf(__builtin_fmaxf((a), (b)), (c))
template <int THR>
__device__ __forceinline__ void dsoftmax2(f32x16& s, f32x16& negm, float& m, float& l, f32x16& o0, f32x16& o1, bf16x8& pa, bf16x8& pb, const bool first) {
    float a = MX3(s[0], s[1], s[2]), b = MX3(s[3], s[4], s[5]);
    a = MX3(a, s[6], s[7]); b = MX3(b, s[8], s[9]); a = MX3(a, s[10], s[11]); b = MX3(b, s[12], s[13]); a = MX3(a, s[14], s[15]);
    const float mx = xhalf_max(__builtin_fmaxf(a, b));
    if (first || __any(mx > (float)THR)) {
        const float delta = first ? mx : __builtin_fmaxf(mx, 0.f), alpha = first ? 1.f : __builtin_amdgcn_exp2f(-delta);
        m += delta;
#pragma unroll
        for (int r = 0; r < 16; ++r) { s[r] -= delta; negm[r] = -m; }
        o0 *= alpha; o1 *= alpha; l *= alpha;
    }
    float sum = 0.f;
#pragma unroll
    for (int r = 0; r < 16; ++r) { s[r] = __builtin_amdgcn_exp2f(s[r]); sum += s[r]; }
    l += sum;
    u32x4 wa, wb;
    wa[0] = cvtpk(s[0], s[1]); wa[1] = cvtpk(s[2], s[3]); wa[2] = cvtpk(s[4], s[5]); wa[3] = cvtpk(s[6], s[7]);
    wb[0] = cvtpk(s[8], s[9]); wb[1] = cvtpk(s[10], s[11]); wb[2] = cvtpk(s[12], s[13]); wb[3] = cvtpk(s[14], s[15]);
    pa = __builtin_bit_cast(bf16x8, wa); pb = __builtin_bit_cast(bf16x8, wb);
}
__device__ __forceinline__ void ph_dattn(const P& p, int l, int nrows, char* lds) {
    const int tid = ltid(), lane = tid & 63, wid = tid >> 6, r32 = lane & 31, hi = lane >> 5;
    float la = lane < 32 ? p.lam_q1[l * 32 + lane] * p.lam_k1[l * 32 + lane] : 0.f;
    float lb = lane < 32 ? p.lam_q2[l * 32 + lane] * p.lam_k2[l * 32 + lane] : 0.f;
    la = wave_sum(la); lb = wave_sum(lb);
    const float lam_init = 0.8f - 0.6f * expf(-0.3f * (float)l);
    const float lam = expf(la) - expf(lb) + lam_init;
    const bf16_t* PR = p.PROJ;
    const int nunits = (nrows == R) ? 256 + 16 : 256;
    const int skey = 8 * wid + (lane & 7), schunk = lane >> 3;
    const int ldsK = schunk * 1024 + skey * 16;
    const int ldsV = 8192 + (schunk >> 2) * 4096 + (skey >> 3) * 512 + (skey & 7) * 64 + (schunk & 3) * 16;
    const int vb = ((lane >> 4) & 1) * 32 + (lane & 3) * 8 + (4 * hi + ((lane & 15) >> 2)) * 64;
    for (int uu = blockIdx.x; uu < nunits; uu += gridDim.x) {
        int b, h, q0, nt; bool isctx;
        if (uu < 256) { const int u = (uu & 7) * 32 + (uu >> 3); b = u >> 6; h = (u >> 4) & 3; q0 = b * 4096 + (u & 15) * 256; nt = 68; isctx = false; }
        else { const int v = uu - 256; b = v >> 2; h = v & 3; q0 = T + b * 256; nt = 4; isctx = true; }
        bf16x8 qf[4];
        {
            const bf16_t* qp = PR + (size_t)(q0 + wid * 32 + r32) * PW + h * 64 + hi * 8;
#pragma unroll
            for (int ks = 0; ks < 4; ++ks) qf[ks] = *(const bf16x8*)(qp + ks * 16);
        }
        f32x16 O00, O01, O10, O11, ng1, ng2;
#pragma unroll
        for (int r = 0; r < 16; ++r) { O00[r] = 0.f; O01[r] = 0.f; O10[r] = 0.f; O11[r] = 0.f; ng1[r] = 0.f; ng2[r] = 0.f; }
        float m1 = 0.f, m2 = 0.f, l1 = 0.f, l2 = 0.f;
        const size_t gK = 256 + h * 64 + schunk * 8, gV = 512 + h * 64 + schunk * 8;
        uint4 rk, rv;
        {
            const int kr = (isctx ? T + b * 256 : b * 4096) + skey;
            rk = *(const uint4*)(PR + (size_t)kr * PW + gK); rv = *(const uint4*)(PR + (size_t)kr * PW + gV);
        }
        __syncthreads();
        *(uint4*)(lds + ldsK) = rk; *(uint4*)(lds + ldsV) = rv;
        __syncthreads();
        for (int t = 0; t < nt; ++t) {
            char* buf = lds + (t & 1) * 16384;
            if (t + 1 < nt) {
                const int tn = t + 1;
                const int kr = ((isctx || tn >= 64) ? T + b * 256 + (isctx ? tn : tn - 64) * 64 : b * 4096 + tn * 64) + skey;
                rk = *(const uint4*)(PR + (size_t)kr * PW + gK); rv = *(const uint4*)(PR + (size_t)kr * PW + gV);
            }
#pragma unroll
            for (int kb = 0; kb < 2; ++kb) {
                const lds_cptr kp = (lds_cptr)buf + hi * 1024 + (kb * 32 + r32) * 16;
                const bf16x8 kf0 = *(const __attribute__((address_space(3))) bf16x8*)(kp);
                const bf16x8 kf1 = *(const __attribute__((address_space(3))) bf16x8*)(kp + 2048);
                const bf16x8 kf2 = *(const __attribute__((address_space(3))) bf16x8*)(kp + 4096);
                const bf16x8 kf3 = *(const __attribute__((address_space(3))) bf16x8*)(kp + 6144);
                f32x16 s1 = __builtin_amdgcn_mfma_f32_32x32x16_bf16(kf0, qf[0], ng1, 0, 0, 0);
                f32x16 s2 = __builtin_amdgcn_mfma_f32_32x32x16_bf16(kf2, qf[2], ng2, 0, 0, 0);
                s1 = __builtin_amdgcn_mfma_f32_32x32x16_bf16(kf1, qf[1], s1, 0, 0, 0);
                s2 = __builtin_amdgcn_mfma_f32_32x32x16_bf16(kf3, qf[3], s2, 0, 0, 0);
                const bool first = (t == 0) && (kb == 0);
                bf16x8 p1a, p1b, p2a, p2b;
                dsoftmax2<8>(s1, ng1, m1, l1, O00, O01, p1a, p1b, first);
                dsoftmax2<8>(s2, ng2, m2, l2, O10, O11, p2a, p2b, first);
                const lds_cptr vp = (lds_cptr)buf + 8192 + vb + kb * 2048;
#pragma unroll
                for (int dt = 0; dt < 2; ++dt) {
#pragma unroll
                    for (int ss = 0; ss < 2; ++ss) {
                        const s16x4 lo = vtr(vp + dt * 4096 + ss * 1024), hh = vtr(vp + dt * 4096 + ss * 1024 + 512);
                        const bf16x8 va = (bf16x8){lo[0], lo[1], lo[2], lo[3], hh[0], hh[1], hh[2], hh[3]};
                        if (dt == 0) { O00 = __builtin_amdgcn_mfma_f32_32x32x16_bf16(va, ss ? p1b : p1a, O00, 0, 0, 0); O10 = __builtin_amdgcn_mfma_f32_32x32x16_bf16(va, ss ? p2b : p2a, O10, 0, 0, 0); }
                        else         { O01 = __builtin_amdgcn_mfma_f32_32x32x16_bf16(va, ss ? p1b : p1a, O01, 0, 0, 0); O11 = __builtin_amdgcn_mfma_f32_32x32x16_bf16(va, ss ? p2b : p2a, O11, 0, 0, 0); }
                    }
                }
            }
            if (t + 1 < nt) { char* nb = lds + ((t + 1) & 1) * 16384; *(uint4*)(nb + ldsK) = rk; *(uint4*)(nb + ldsV) = rv; }
            __syncthreads();
        }
        l1 = xhalf_sum(l1); l2 = xhalf_sum(l2);
        const float i1 = 1.f / l1, i2 = lam / l2;
        float ss = 0.f;
#pragma unroll
        for (int r = 0; r < 16; ++r) { O00[r] = O00[r] * i1 - O10[r] * i2; O01[r] = O01[r] * i1 - O11[r] * i2; ss += O00[r] * O00[r] + O01[r] * O01[r]; }
        ss = xhalf_sum(ss);
        const float rstd = rsqrtf(ss * (1.f / 64.f) + EPS) * (1.f - lam_init);
        const float* gs = p.g_sub + l * 64;
        bf16_t* op = p.MIX + (size_t)(q0 + wid * 32 + r32) * D + h * 64;
#pragma unroll
        for (int g4 = 0; g4 < 4; ++g4) {
            const int d = 8 * g4 + 4 * hi;
            const float4 ga = *(const float4*)(gs + d), gb = *(const float4*)(gs + 32 + d);
            uint2 wa, wb;
            wa.x = cvtpk(O00[4 * g4] * rstd * ga.x, O00[4 * g4 + 1] * rstd * ga.y); wa.y = cvtpk(O00[4 * g4 + 2] * rstd * ga.z, O00[4 * g4 + 3] * rstd * ga.w);
            wb.x = cvtpk(O01[4 * g4] * rstd * gb.x, O01[4 * g4 + 1] * rstd * gb.y); wb.y = cvtpk(O01[4 * g4 + 2] * rstd * gb.z, O01[4 * g4 + 3] * rstd * gb.w);
            *(uint2*)(op + d) = wa; *(uint2*)(op + 32 + d) = wb;
        }
    }
}

__device__ __forceinline__ void ph_na(const P& p, int l, int nrows, char* lds) {
    const int tid = ltid(), lane = tid & 63, wid = tid >> 6, r32 = lane & 31, hi = lane >> 5;
    const bf16_t* PR = p.PROJ;
    const int nunits = (nrows == R) ? 256 + 16 : 256;
    const int skey = 8 * wid + (lane & 7), schunk = lane >> 3;
    const int ldsK = schunk * 1024 + skey * 16;
    const int ldsV = 8192 + (schunk >> 2) * 4096 + (skey >> 3) * 512 + (skey & 7) * 64 + (schunk & 3) * 16;
    const int vb = ((lane >> 4) & 1) * 32 + (lane & 3) * 8 + (4 * hi + ((lane & 15) >> 2)) * 64;
    float* btab = (float*)(lds + 32768);
    constexpr float LOG2E = 1.4426950408889634f;
    for (int uu = (blockIdx.x + gridDim.x - 16) % gridDim.x; uu < nunits; uu += gridDim.x) {
        int b, h, q0, kr_lo, nlat, rs = 0, rq = 0; bool isctx;
        if (uu < 256) {
            const int u = (uu & 7) * 32 + (uu >> 3); b = u >> 6; h = (u >> 4) & 3; const int rg = u & 15;
            rq = 4 * rg + (wid >> 1); q0 = b * 4096 + rq * 64 + (wid & 1) * 32;
            kr_lo = min(max(4 * rg - 4, 0), 56); const int kr_hi = min(max(4 * rg - 1, 0), 56) + 7; nlat = kr_hi - kr_lo + 1;
            rs = min(max(rq - 4, 0), 56); isctx = false;
        } else { const int v = uu - 256; b = v >> 2; h = v & 3; q0 = T + b * 256 + wid * 32; kr_lo = 0; nlat = 0; isctx = true; }
        const int nt = nlat + 4;
        const int cq = (wid & 1) * 32 + r32, wsc = min(max(cq - 8, 0), 48);
        bf16x8 qf[4];
        {
            const bf16_t* qp = PR + (size_t)(q0 + r32) * PW + 1536 + h * 64 + hi * 8;
#pragma unroll
            for (int ks = 0; ks < 4; ++ks) qf[ks] = *(const bf16x8*)(qp + ks * 16);
        }
        f32x16 O0, O1;
#pragma unroll
        for (int r = 0; r < 16; ++r) { O0[r] = 0.f; O1[r] = 0.f; }
        float m1 = -1e30f, l1 = 0.f;
        const size_t gK = 1792 + h * 64 + schunk * 8, gV = 2048 + h * 64 + schunk * 8;
        uint4 rk, rv;
        {
            const int kr = (nlat ? b * 4096 + kr_lo * 64 : T + b * 256) + skey;
            rk = *(const uint4*)(PR + (size_t)kr * PW + gK); rv = *(const uint4*)(PR + (size_t)kr * PW + gV);
        }
        __syncthreads();
        *(uint4*)(lds + ldsK) = rk; *(uint4*)(lds + ldsV) = rv;
        if (tid < 465) btab[tid] = p.rpb[((size_t)l * 4 + h) * 465 + tid] * LOG2E;
        __syncthreads();
        for (int t = 0; t < nt; ++t) {
            char* buf = lds + (t & 1) * 16384;
            if (t + 1 < nt) {
                const int tn = t + 1;
                const int kr = (tn < nlat ? b * 4096 + (kr_lo + tn) * 64 : T + b * 256 + (tn - nlat) * 64) + skey;
                rk = *(const uint4*)(PR + (size_t)kr * PW + gK); rv = *(const uint4*)(PR + (size_t)kr * PW + gV);
            }
            const bool lat = t < nlat;
            const int krow = kr_lo + t;
            const bool active = !lat || (krow >= rs && krow <= rs + 7);
            if (active) {
                const float* brow = btab + (krow - rq + 7) * 31 + 15 - cq;
#pragma unroll
                for (int kb = 0; kb < 2; ++kb) {
                    const lds_cptr kp = (lds_cptr)buf + hi * 1024 + (kb * 32 + r32) * 16;
                    f32x16 s1;
#pragma unroll
                    for (int r = 0; r < 16; ++r) s1[r] = 0.f;
#pragma unroll
                    for (int ks = 0; ks < 4; ++ks) {
                        const bf16x8 kf = *(const __attribute__((address_space(3))) bf16x8*)(kp + ks * 2048);
                        s1 = __builtin_amdgcn_mfma_f32_32x32x16_bf16(kf, qf[ks], s1, 0, 0, 0);
                    }
                    if (lat) {
#pragma unroll
                        for (int r = 0; r < 16; ++r) {
                            const int kc = 32 * kb + (r & 3) + 8 * (r >> 2) + 4 * hi;
                            const bool ok = (unsigned)(kc - wsc) < 16u;
                            const float bv = brow[ok ? kc : cq];
                            s1[r] = ok ? s1[r] + bv : -INFINITY;
                        }
                    }
                    bf16x8 pa, pb;
                    dsoftmax(s1, m1, l1, O0, O1, pa, pb);
                    const lds_cptr vp = (lds_cptr)buf + 8192 + vb + kb * 2048;
#pragma unroll
                    for (int ss = 0; ss < 2; ++ss) {
                        const s16x4 lo0 = vtr(vp + ss * 1024), hh0 = vtr(vp + ss * 1024 + 512);
                        const s16x4 lo1 = vtr(vp + 4096 + ss * 1024), hh1 = vtr(vp + 4096 + ss * 1024 + 512);
                        const bf16x8 va0 = (bf16x8){lo0[0], lo0[1], lo0[2], lo0[3], hh0[0], hh0[1], hh0[2], hh0[3]};
                        const bf16x8 va1 = (bf16x8){lo1[0], lo1[1], lo1[2], lo1[3], hh1[0], hh1[1], hh1[2], hh1[3]};
                        O0 = __builtin_amdgcn_mfma_f32_32x32x16_bf16(va0, ss ? pb : pa, O0, 0, 0, 0);
                        O1 = __builtin_amdgcn_mfma_f32_32x32x16_bf16(va1, ss ? pb : pa, O1, 0, 0, 0);
                    }
                }
            }
            if (t + 1 < nt) { char* nb = lds + ((t + 1) & 1) * 16384; *(uint4*)(nb + ldsK) = rk; *(uint4*)(nb + ldsV) = rv; }
            __syncthreads();
        }
        l1 = xhalf_sum(l1);
        const float il = 1.f / l1;
        bf16_t* op = p.MIX + (size_t)(q0 + r32) * D + 768 + h * 64;
#pragma unroll
        for (int g4 = 0; g4 < 4; ++g4) {
            const int d = 8 * g4 + 4 * hi;
            uint2 wa, wb;
            wa.x = cvtpk(O0[4 * g4] * il, O0[4 * g4 + 1] * il); wa.y = cvtpk(O0[4 * g4 + 2] * il, O0[4 * g4 + 3] * il);
            wb.x = cvtpk(O1[4 * g4] * il, O1[4 * g4 + 1] * il); wb.y = cvtpk(O1[4 * g4 + 2] * il, O1[4 * g4 + 3] * il);
            *(uint2*)(op + d) = wa; *(uint2*)(op + 32 + d) = wb;
        }
    }
}

__device__ __forceinline__ void ph_pool(const P& p, int l, int nrows, char* lds) {
    const int tid = ltid(), lane = tid & 63, wid = tid >> 6, fr = lane & 15, fq = lane >> 4;
    float* ysh = (float*)lds;
    bf16_t* dsh = (bf16_t*)(lds + 80 * 256 * 4);
    const bf16_t* PR = p.PROJ;
    for (int it = (blockIdx.x + gridDim.x - 32) % gridDim.x; it < nrows / 64; it += gridDim.x) {
        const int row0 = it * 64;
        const int L = row0 < T ? 4096 : 256;
        const int t0 = row0 < T ? (row0 & 4095) : ((row0 - T) & 255);
        const int base = row0 - t0;
        __syncthreads();
        for (int c = tid; c < 80 * 32; c += NT) {
            const int rr = c >> 5, ch = (c & 31) * 8, t = t0 - 8 + rr;
            float4 a = make_float4(0.f, 0.f, 0.f, 0.f), b = a;
            if (t >= 0 && t < L) {
                const uint4 raw = *(const uint4*)(PR + (size_t)(base + t) * PW + 768 + ch);
                a = make_float4(__uint_as_float(raw.x << 16), __uint_as_float(raw.x & 0xffff0000u), __uint_as_float(raw.y << 16), __uint_as_float(raw.y & 0xffff0000u));
                b = make_float4(__uint_as_float(raw.z << 16), __uint_as_float(raw.z & 0xffff0000u), __uint_as_float(raw.w << 16), __uint_as_float(raw.w & 0xffff0000u));
            }
            *(float4*)(ysh + rr * 256 + ch) = a; *(float4*)(ysh + rr * 256 + ch + 4) = b;
        }
        __syncthreads();
        {
            const int r = tid >> 3, cg = tid & 7;
            const int g = cg >> 1, w = 2 << g, t = t0 + r;
            const int lo = max(t - w / 2, 0), hi = min(t + w / 2 - 1, L - 1);
            const float inv = 1.f / (float)(hi - lo + 1);
#pragma unroll
            for (int q = 0; q < 8; ++q) {
                const int ch = cg * 32 + q * 4;
                float4 s = make_float4(0.f, 0.f, 0.f, 0.f);
                for (int tt = lo; tt <= hi; ++tt) { const float4 v = *(const float4*)(ysh + (tt - t0 + 8) * 256 + ch); s.x += v.x; s.y += v.y; s.z += v.z; s.w += v.w; }
                const float4 y = *(const float4*)(ysh + (r + 8) * 256 + ch);
                uint2 o; o.x = cvtpk(s.x * inv - y.x, s.y * inv - y.y); o.y = cvtpk(s.z * inv - y.z, s.w * inv - y.w);
                *(uint2*)(dsh + r * 264 + ch) = o;
            }
        }
        __syncthreads();
        {
            const int g = wid >> 1, mb = (wid & 1) * 2;
            const bf16_t* W = p.WpT + ((size_t)l * 4 + g) * 64 * 64;
            f32x4 acc[2][4];
#pragma unroll
            for (int mt = 0; mt < 2; ++mt)
#pragma unroll
                for (int nt = 0; nt < 4; ++nt) acc[mt][nt] = (f32x4){0.f, 0.f, 0.f, 0.f};
#pragma unroll
            for (int ks = 0; ks < 2; ++ks) {
                bf16x8 af[2], bfr[4];
#pragma unroll
                for (int mt = 0; mt < 2; ++mt) af[mt] = *(const bf16x8*)(dsh + ((mb + mt) * 16 + fr) * 264 + g * 64 + ks * 32 + fq * 8);
#pragma unroll
                for (int nt = 0; nt < 4; ++nt) bfr[nt] = *(const bf16x8*)(W + (nt * 16 + fr) * 64 + ks * 32 + fq * 8);
#pragma unroll
                for (int mt = 0; mt < 2; ++mt)
#pragma unroll
                    for (int nt = 0; nt < 4; ++nt) acc[mt][nt] = __builtin_amdgcn_mfma_f32_16x16x32_bf16(bfr[nt], af[mt], acc[mt][nt], 0, 0, 0);
            }
#pragma unroll
            for (int mt = 0; mt < 2; ++mt)
#pragma unroll
                for (int nt = 0; nt < 4; ++nt) {
                    const int row = row0 + (mb + mt) * 16 + fr, j = g * 64 + nt * 16 + fq * 4;
                    const float4 sp = *(const float4*)(p.s_pool + l * 256 + j);
                    uint2 o; o.x = cvtpk(acc[mt][nt][0] * sp.x, acc[mt][nt][1] * sp.y); o.y = cvtpk(acc[mt][nt][2] * sp.z, acc[mt][nt][3] * sp.w);
                    *(uint2*)(p.MIX + (size_t)row * D + 256 + j) = o;
                }
        }
    }
}

__device__ __forceinline__ float gelu_fast(float x) {
    const float u = 0.7978845608028654f * (x + 0.044715f * x * x * x);
    return x / (1.f + __builtin_amdgcn_exp2f(-2.885390081777927f * u));
}
__device__ __forceinline__ void ph_sgu(const P& p, int l, int nrows, char* lds) {
    const int tid = ltid(), lane = tid & 63, wid = tid >> 6, fr = lane & 15, fq = lane >> 4;
    bf16_t* vnT = (bf16_t*)lds;
    float* rstd = (float*)(lds + 128 * 136 * 2);
    const bf16_t* PR = p.PROJ;
    for (int it = (blockIdx.x + gridDim.x - 48) % gridDim.x; it < (nrows / 128) * 2; it += gridDim.x) {
        const int chunk = it >> 1, hp = it & 1, row0 = chunk * 128;
        __syncthreads();
        {
            const int t = tid >> 2, qtr = tid & 3;
            const bf16_t* zp = PR + (size_t)(row0 + t) * PW + 1280 + qtr * 64;
            float ss = 0.f;
#pragma unroll
            for (int i = 0; i < 8; ++i) {
                const uint4 raw = *(const uint4*)(zp + i * 8);
                const unsigned w4[4] = {raw.x, raw.y, raw.z, raw.w};
#pragma unroll
                for (int j = 0; j < 4; ++j) { const float a = __uint_as_float(w4[j] << 16), b = __uint_as_float(w4[j] & 0xffff0000u); ss += a * a + b * b; }
            }
            ss += __shfl_xor(ss, 1); ss += __shfl_xor(ss, 2);
            if (qtr == 0) rstd[t] = rsqrtf(ss * (1.f / 256.f) + EPS);
        }
        __syncthreads();
        {
            const int s = tid >> 2, cb = (tid & 3) * 32;
            const bf16_t* zp = PR + (size_t)(row0 + s) * PW + 1280 + hp * 128 + cb;
            const float rs = rstd[s];
            const float* gg = p.g_sgu + l * 256 + hp * 128 + cb;
#pragma unroll
            for (int i = 0; i < 4; ++i) {
                const uint4 raw = *(const uint4*)(zp + i * 8);
                const unsigned w4[4] = {raw.x, raw.y, raw.z, raw.w};
#pragma unroll
                for (int j = 0; j < 4; ++j) {
                    const int c = cb + i * 8 + j * 2;
                    vnT[c * 136 + s] = f2bf(__uint_as_float(w4[j] << 16) * rs * gg[i * 8 + j * 2]);
                    vnT[(c + 1) * 136 + s] = f2bf(__uint_as_float(w4[j] & 0xffff0000u) * rs * gg[i * 8 + j * 2 + 1]);
                }
            }
        }
        __syncthreads();
        {
            const int hl = wid >> 2, g = hp * 2 + hl, mb = (wid & 3) * 2;
            const bf16_t* Wg = p.WsB + ((size_t)l * 4 + g) * 128 * 128;
            f32x4 acc[2][4];
#pragma unroll
            for (int mt = 0; mt < 2; ++mt)
#pragma unroll
                for (int nt = 0; nt < 4; ++nt) acc[mt][nt] = (f32x4){0.f, 0.f, 0.f, 0.f};
#pragma unroll
            for (int ks = 0; ks < 4; ++ks) {
                bf16x8 af[2], bfr[4];
#pragma unroll
                for (int mt = 0; mt < 2; ++mt) af[mt] = *(const bf16x8*)(Wg + ((mb + mt) * 16 + fr) * 128 + ks * 32 + fq * 8);
#pragma unroll
                for (int nt = 0; nt < 4; ++nt) bfr[nt] = *(const bf16x8*)(vnT + (hl * 64 + nt * 16 + fr) * 136 + ks * 32 + fq * 8);
#pragma unroll
                for (int mt = 0; mt < 2; ++mt)
#pragma unroll
                    for (int nt = 0; nt < 4; ++nt) acc[mt][nt] = __builtin_amdgcn_mfma_f32_16x16x32_bf16(bfr[nt], af[mt], acc[mt][nt], 0, 0, 0);
            }
#pragma unroll
            for (int mt = 0; mt < 2; ++mt) {
                const int t = (mb + mt) * 16 + fr;
                const float bias = p.b_sgu[(l * 4 + g) * 128 + t];
#pragma unroll
                for (int nt = 0; nt < 4; ++nt) {
                    const int c = g * 64 + nt * 16 + fq * 4;
                    const uint2 ur = *(const uint2*)(PR + (size_t)(row0 + t) * PW + 1024 + c);
                    const float u0 = __uint_as_float(ur.x << 16), u1 = __uint_as_float(ur.x & 0xffff0000u);
                    const float u2 = __uint_as_float(ur.y << 16), u3 = __uint_as_float(ur.y & 0xffff0000u);
                    uint2 o; o.x = cvtpk(u0 * (acc[mt][nt][0] + bias), u1 * (acc[mt][nt][1] + bias)); o.y = cvtpk(u2 * (acc[mt][nt][2] + bias), u3 * (acc[mt][nt][3] + bias));
                    *(uint2*)(p.MIX + (size_t)(row0 + t) * D + 512 + c) = o;
                }
            }
        }
    }
}

__device__ __forceinline__ void ph_router(const P& p, int l, int nrows, char* lds) {
    const int tid = ltid(), wave = tid >> 6, lane = tid & 63;
    float* wl = (float*)lds;
    float* wsc = (float*)(lds + 1024 * 36 * 4) + wave * 64;
    int* lcnt = (int*)(lds + 1024 * 36 * 4 + 8 * 64 * 4);
    __syncthreads();
    {
        const float* wr = p.w_router + (size_t)l * D * NE;
        for (int i = tid; i < 1024 * 8; i += NT) { const int k = i >> 3, e4 = (i & 7) * 4; *(float4*)(wl + k * 36 + e4) = *(const float4*)(wr + k * 32 + e4); }
        if (tid < 32) lcnt[tid] = 0;
    }
    __syncthreads();
    const float* g = p.g_ffn + l * D;
    const float brt = p.b_router[l * NE + (lane & 31)];
    for (int pr = blockIdx.x * 8 + wave; pr < nrows / 2; pr += gridDim.x * 8) {
        const int ra = 2 * pr;
        const float* xa = p.X + (size_t)ra * D; const float* xb = xa + D;
        float ha[16], hb[16]; float sa = 0.f, sb = 0.f;
#pragma unroll
        for (int i = 0; i < 16; ++i) { ha[i] = xa[lane + 64 * i]; hb[i] = xb[lane + 64 * i]; sa += ha[i] * ha[i]; sb += hb[i] * hb[i]; }
        sa = wave_sum(sa); sb = wave_sum(sb);
        const float rsa = rsqrtf(sa * (1.f / D) + EPS), rsb = rsqrtf(sb * (1.f / D) + EPS);
        const float* m = p.mod + ((size_t)l * 5 + mod_row(ra)) * 6144;
#pragma unroll
        for (int i = 0; i < 16; ++i) {
            const int k = lane + 64 * i;
            const float gs = g[k] * (1.f + m[4 * 1024 + k]), sh = m[3 * 1024 + k];
            ha[i] = ha[i] * rsa * gs + sh; hb[i] = hb[i] * rsb * gs + sh;
            p.H[(size_t)ra * D + k] = f2bf(ha[i]); p.H[(size_t)(ra + 1) * D + k] = f2bf(hb[i]);
        }
        float la[32], lb[32];
#pragma unroll
        for (int e = 0; e < 32; ++e) { la[e] = 0.f; lb[e] = 0.f; }
#pragma unroll
        for (int i = 0; i < 16; ++i) {
            const float* wk = wl + (lane + 64 * i) * 36;
#pragma unroll
            for (int e = 0; e < 32; e += 4) {
                const float4 w = *(const float4*)(wk + e);
                la[e] += ha[i] * w.x; la[e + 1] += ha[i] * w.y; la[e + 2] += ha[i] * w.z; la[e + 3] += ha[i] * w.w;
                lb[e] += hb[i] * w.x; lb[e + 1] += hb[i] * w.y; lb[e + 2] += hb[i] * w.z; lb[e + 3] += hb[i] * w.w;
            }
        }
        float r32v[32];
        {
            const bool up = lane >= 32;
#pragma unroll
            for (int e = 0; e < 32; ++e) { const float keep = up ? lb[e] : la[e], send = up ? la[e] : lb[e]; r32v[e] = keep + __shfl_xor(send, 32); }
        }
        float r16[16], r8[8], r4[4], r2[2];
        { const bool up = (lane & 16) != 0;
#pragma unroll
          for (int e = 0; e < 16; ++e) { const float keep = up ? r32v[e + 16] : r32v[e], send = up ? r32v[e] : r32v[e + 16]; r16[e] = keep + __shfl_xor(send, 16); } }
        { const bool up = (lane & 8) != 0;
#pragma unroll
          for (int e = 0; e < 8; ++e) { const float keep = up ? r16[e + 8] : r16[e], send = up ? r16[e] : r16[e + 8]; r8[e] = keep + __shfl_xor(send, 8); } }
        { const bool up = (lane & 4) != 0;
#pragma unroll
          for (int e = 0; e < 4; ++e) { const float keep = up ? r8[e + 4] : r8[e], send = up ? r8[e] : r8[e + 4]; r4[e] = keep + __shfl_xor(send, 4); } }
        { const bool up = (lane & 2) != 0;
#pragma unroll
          for (int e = 0; e < 2; ++e) { const float keep = up ? r4[e + 2] : r4[e], send = up ? r4[e] : r4[e + 2]; r2[e] = keep + __shfl_xor(send, 2); } }
        float mine;
        { const bool up = (lane & 1) != 0; const float keep = up ? r2[1] : r2[0], send = up ? r2[0] : r2[1]; mine = keep + __shfl_xor(send, 1); }
        wsc[lane] = mine + brt;
        float lg[32];
        {
            const float* wp = wsc + (lane & 32);
#pragma unroll
            for (int e = 0; e < 32; e += 4) { const float4 v = *(const float4*)(wp + e); lg[e] = v.x; lg[e + 1] = v.y; lg[e + 2] = v.z; lg[e + 3] = v.w; }
        }
        unsigned taken = 0u; float tv[4]; int ti[4];
#pragma unroll
        for (int k = 0; k < 4; ++k) {
            float best = -3.0e38f; int bi = 0;
#pragma unroll
            for (int e = 0; e < 32; ++e) { const bool ok = !((taken >> e) & 1u) && (lg[e] > best); best = ok ? lg[e] : best; bi = ok ? e : bi; }
            taken |= 1u << bi; tv[k] = best; ti[k] = bi;
        }
        const float e1 = __expf(tv[1] - tv[0]), e2 = __expf(tv[2] - tv[0]), e3 = __expf(tv[3] - tv[0]);
        const float inv = 1.f / (1.f + e1 + e2 + e3);
        if ((lane & 31) == 0) {
            const int row = ra + (lane >> 5);
            *(int4*)(p.topi + (size_t)row * 4) = make_int4(ti[0], ti[1], ti[2], ti[3]);
            *(float4*)(p.topg + (size_t)row * 4) = make_float4(inv, e1 * inv, e2 * inv, e3 * inv);
            atomicAdd(&lcnt[ti[0]], 1); atomicAdd(&lcnt[ti[1]], 1); atomicAdd(&lcnt[ti[2]], 1); atomicAdd(&lcnt[ti[3]], 1);
        }
    }
    __syncthreads();
    if (tid < 32 && lcnt[tid]) atomicAdd(&p.cnt[l * 64 + tid], lcnt[tid]);
}
__device__ __forceinline__ void ph_assign(const P& p, int l, int nrows, char* lds) {
    int* lcnt = (int*)lds; int* lbase = lcnt + 32; int* pst = lbase + 32; int* slots = pst + 32;
    const int tid = ltid(), wave = tid >> 6, lane = tid & 63;
    int* cnt = p.cnt + l * 64; int* cursor = cnt + 32;
    int* meta = p.moe_meta + l * 512;
    __syncthreads();
    if (tid == 0) { int a = 0; for (int e = 0; e < 32; ++e) { pst[e] = a; a += (cnt[e] + 255) & ~255; } if (blockIdx.x == 0) meta[0] = a >> 8; }
    __syncthreads();
    if (blockIdx.x == 0 && tid < 320) { int e = 0; for (int k = 1; k < 32; ++k) if (tid * 256 >= pst[k]) e = k; meta[1 + tid] = e; }
    const int blk0 = (blockIdx.x + gridDim.x - 64) % gridDim.x;
    for (int it = blk0; it < nrows / 64; it += gridDim.x) {
        __syncthreads();
        if (tid < 32) lcnt[tid] = 0;
        __syncthreads();
        if (wave == 0) {
            const int row = it * 64 + lane;
            const int4 ti = *(const int4*)(p.topi + (size_t)row * 4);
            const int r0 = atomicAdd(&lcnt[ti.x], 1), r1 = atomicAdd(&lcnt[ti.y], 1), r2 = atomicAdd(&lcnt[ti.z], 1), r3 = atomicAdd(&lcnt[ti.w], 1);
            __builtin_amdgcn_s_waitcnt(0xc07f);
            if (lane < 32) lbase[lane] = pst[lane] + (lcnt[lane] ? atomicAdd(&cursor[lane], lcnt[lane]) : 0);
            __builtin_amdgcn_s_waitcnt(0xc07f);
            const int4 sl = make_int4(lbase[ti.x] + r0, lbase[ti.y] + r1, lbase[ti.z] + r2, lbase[ti.w] + r3);
            *(int4*)(p.tok_slot + (size_t)row * 4) = sl;
            *(int4*)(slots + lane * 4) = sl;
        }
        __syncthreads();
        {
            const bf16_t* __restrict__ Hs = p.H; unsigned char* __restrict__ HSd = p.HS;
#define AS_LD(rr, A, B) const uint4 A = *(const uint4*)(Hs + (size_t)(it * 64 + wave * 8 + (rr)) * D + lane * 8), B = *(const uint4*)(Hs + (size_t)(it * 64 + wave * 8 + (rr)) * D + lane * 8 + 512)
#define AS_CV(V) make_uint2(__builtin_amdgcn_cvt_pk_fp8_f32(__uint_as_float(V.y << 16), __uint_as_float(V.y & 0xffff0000u), __builtin_amdgcn_cvt_pk_fp8_f32(__uint_as_float(V.x << 16), __uint_as_float(V.x & 0xffff0000u), 0u, false), true), \
                            __builtin_amdgcn_cvt_pk_fp8_f32(__uint_as_float(V.w << 16), __uint_as_float(V.w & 0xffff0000u), __builtin_amdgcn_cvt_pk_fp8_f32(__uint_as_float(V.z << 16), __uint_as_float(V.z & 0xffff0000u), 0u, false), true))
#define AS_ST(rr, A, B) do { const int4 s4 = *(const int4*)(slots + (wave * 8 + (rr)) * 4); const uint2 fa = AS_CV(A), fb = AS_CV(B); \
            unsigned char* d0 = HSd + (size_t)s4.x * D + lane * 8; *(uint2*)d0 = fa; *(uint2*)(d0 + 512) = fb; \
            unsigned char* d1 = HSd + (size_t)s4.y * D + lane * 8; *(uint2*)d1 = fa; *(uint2*)(d1 + 512) = fb; \
            unsigned char* d2 = HSd + (size_t)s4.z * D + lane * 8; *(uint2*)d2 = fa; *(uint2*)(d2 + 512) = fb; \
            unsigned char* d3 = HSd + (size_t)s4.w * D + lane * 8; *(uint2*)d3 = fa; *(uint2*)(d3 + 512) = fb; } while (0)
            AS_LD(0, a0, b0); AS_LD(1, a1, b1); AS_LD(2, a2, b2); AS_LD(3, a3, b3); AS_LD(4, a4, b4); AS_LD(5, a5, b5); AS_LD(6, a6, b6); AS_LD(7, a7, b7);
            AS_ST(0, a0, b0); AS_ST(1, a1, b1); AS_ST(2, a2, b2); AS_ST(3, a3, b3); AS_ST(4, a4, b4); AS_ST(5, a5, b5); AS_ST(6, a6, b6); AS_ST(7, a7, b7);
#undef AS_CV
#undef AS_LD
#undef AS_ST
        }
    }
}

struct EpiProj {
    static constexpr bool PERM = true, AFTER_DRAIN = false;
    bf16_t* O; const float* rope;
    __device__ __forceinline__ void operator()(const f32x4 (&acc)[2][2][4][2], const pg8::Unit& u, int wr, int wc, int fr, int fq) const {
        const int row0 = u.pm * 256 + wr * 64 + fr, col0 = u.pn * 256 + wc * 32 + 8 * fq;
        const bool do_rope = (u.pn < 2) && (u.pm < T / 256), do_gelu = (u.pn == 4) || (u.pn == 5);
        const float sc = u.pn == 0 ? QSCALE : (u.pn == 6 ? 0.125f * 1.4426950408889634f : 1.f);
        const float sgn = (fq & 1) ? 1.f : -1.f;
#pragma unroll
        for (int ai = 0; ai < 2; ++ai)
#pragma unroll
            for (int m = 0; m < 4; ++m) {
                const int row = row0 + ai * 128 + m * 16;
                bf16_t* rowp = O + (size_t)row * PW + col0;
                f32x4 cs[4];
                if (do_rope) {
                    const int s = row & 4095, pos = (fq >> 1) ? (s & 63) : (s >> 6);
                    const f32x4* rp = (const f32x4*)(rope + pos * 16);
                    cs[0] = rp[0]; cs[1] = rp[1]; cs[2] = rp[2]; cs[3] = rp[3];
                }
#pragma unroll
                for (int bj = 0; bj < 2; ++bj) {
                    f32x4 v0 = acc[ai][bj][m][0], v1 = acc[ai][bj][m][1];
                    if (do_rope) {
                        f32x4 b0, b1;
#pragma unroll
                        for (int j = 0; j < 4; ++j) { b0[j] = __shfl_xor(v0[j], 16); b1[j] = __shfl_xor(v1[j], 16); }
                        v0[0] = v0[0] * cs[0][0] + sgn * b0[0] * cs[0][1]; v0[1] = v0[1] * cs[0][2] + sgn * b0[1] * cs[0][3];
                        v0[2] = v0[2] * cs[1][0] + sgn * b0[2] * cs[1][1]; v0[3] = v0[3] * cs[1][2] + sgn * b0[3] * cs[1][3];
                        v1[0] = v1[0] * cs[2][0] + sgn * b1[0] * cs[2][1]; v1[1] = v1[1] * cs[2][2] + sgn * b1[1] * cs[2][3];
                        v1[2] = v1[2] * cs[3][0] + sgn * b1[2] * cs[3][1]; v1[3] = v1[3] * cs[3][2] + sgn * b1[3] * cs[3][3];
                    }
                    if (do_gelu) {
#pragma unroll
                        for (int j = 0; j < 4; ++j) { v0[j] = gelu_fast(v0[j]); v1[j] = gelu_fast(v1[j]); }
                    }
                    v0 = v0 * sc; v1 = v1 * sc;
                    u32x4 w; w.x = cvtpk(v0[0], v0[1]); w.y = cvtpk(v0[2], v0[3]); w.z = cvtpk(v1[0], v1[1]); w.w = cvtpk(v1[2], v1[3]);
                    *(u32x4*)(rowp + bj * 128) = w;
                }
            }
    }
};
struct EpiOut {
    static constexpr bool PERM = false, AFTER_DRAIN = false;
    float* X; const float* gate; const float* res_lat; const float* res_ctx;
    __device__ __forceinline__ void operator()(const f32x4 (&acc)[2][2][4][2], const pg8::Unit& u, int wr, int wc, int fr, int fq) const {
        const int row0 = u.pm * 256 + wr * 64 + fr, col0 = u.pn * 256 + wc * 32 + 4 * fq;
        const float* g = gate + (size_t)mod_row(u.pm * 256) * 6144 + col0;
        f32x4 gv[2][2];
#pragma unroll
        for (int bj = 0; bj < 2; ++bj)
#pragma unroll
            for (int n = 0; n < 2; ++n) gv[bj][n] = *(const f32x4*)(g + bj * 128 + n * 16);
#pragma unroll
        for (int ai = 0; ai < 2; ++ai)
#pragma unroll
            for (int m = 0; m < 4; ++m) { const size_t off = (size_t)(row0 + ai * 128 + m * 16) * D + col0; float* xp = X + off; const float* rp = (u.pm < T / 256 ? res_lat : res_ctx) + off;
#pragma unroll
                for (int bj = 0; bj < 2; ++bj)
#pragma unroll
                    for (int n = 0; n < 2; ++n) { *(f32x4*)(xp + bj * 128 + n * 16) = *(const f32x4*)(rp + bj * 128 + n * 16) + gv[bj][n] * acc[ai][bj][m][n]; } }
    }
};
__device__ __forceinline__ float swiglu(float g, float u) {
    const float gt = fminf(g, 7.0f), up = fminf(fmaxf(u, -7.0f), 7.0f);
    return (up + 1.0f) * gt * __builtin_amdgcn_rcpf(1.0f + __builtin_amdgcn_exp2f(-1.702f * 1.4426950408889634f * gt));
}
struct EpiAct {
    static constexpr bool PERM = true, AFTER_DRAIN = false;
    unsigned char* ACT; const float* bgu;
    __device__ __forceinline__ void operator()(const f32x4 (&acc)[2][2][4][2], const pg8::Unit& u, int wr, int wc, int fr, int fq) const {
        const int row0 = u.pm * 256 + wr * 64 + fr, j0 = (u.pn * 256 + wc * 32 + 8 * fq) >> 1;
        const float* bp = bgu + (size_t)u.e * 2048 + j0;
        f32x4 bg[2], bu[2];
#pragma unroll
        for (int bj = 0; bj < 2; ++bj) { bg[bj] = *(const f32x4*)(bp + bj * 64); bu[bj] = *(const f32x4*)(bp + 1024 + bj * 64); }
#pragma unroll
        for (int ai = 0; ai < 2; ++ai)
#pragma unroll
            for (int m = 0; m < 4; ++m) { unsigned char* rowp = ACT + (size_t)(row0 + ai * 128 + m * 16) * FF + j0;
#pragma unroll
                for (int bj = 0; bj < 2; ++bj) { const f32x4 v0 = acc[ai][bj][m][0], v1 = acc[ai][bj][m][1];
                    const float a0 = swiglu(v0[0] + bg[bj][0], v0[1] + bu[bj][0]), a1 = swiglu(v0[2] + bg[bj][1], v0[3] + bu[bj][1]);
                    const float a2 = swiglu(v1[0] + bg[bj][2], v1[1] + bu[bj][2]), a3 = swiglu(v1[2] + bg[bj][3], v1[3] + bu[bj][3]);
                    const unsigned w = __builtin_amdgcn_cvt_pk_fp8_f32(a2, a3, __builtin_amdgcn_cvt_pk_fp8_f32(a0, a1, 0u, false), true);
                    *(unsigned*)(rowp + bj * 64) = w; } }
    }
};
struct EpiYB {
    static constexpr bool PERM = true, AFTER_DRAIN = false;
    bf16_t* YB; const float* bdn;
    __device__ __forceinline__ void operator()(const f32x4 (&acc)[2][2][4][2], const pg8::Unit& u, int wr, int wc, int fr, int fq) const {
        const int row0 = u.pm * 256 + wr * 64 + fr, col0 = u.pn * 256 + wc * 32 + 8 * fq;
        const float* bp = bdn + (size_t)u.e * D + col0;
        f32x4 bv[2][2];
#pragma unroll
        for (int bj = 0; bj < 2; ++bj)
#pragma unroll
            for (int n = 0; n < 2; ++n) bv[bj][n] = *(const f32x4*)(bp + bj * 128 + n * 4);
#pragma unroll
        for (int ai = 0; ai < 2; ++ai)
#pragma unroll
            for (int m = 0; m < 4; ++m) { bf16_t* rowp = YB + (size_t)(row0 + ai * 128 + m * 16) * D + col0;
#pragma unroll
                for (int bj = 0; bj < 2; ++bj) { const f32x4 v0 = acc[ai][bj][m][0] + bv[bj][0], v1 = acc[ai][bj][m][1] + bv[bj][1];
                    u32x4 w; w.x = cvtpk(v0[0], v0[1]); w.y = cvtpk(v0[2], v0[3]); w.z = cvtpk(v1[0], v1[1]); w.w = cvtpk(v1[2], v1[3]);
                    *(u32x4*)(rowp + bj * 128) = w; } }
    }
};
struct MoeOrder {
    int nN, nunits, G, v; const int* tile_e;
    __device__ void init(int ntiles, int nN_, int G_, int c, const int* te) { nN = nN_; nunits = ntiles * nN_; G = G_; v = (G_ % 8 == 0) ? (c % 8) * (G_ / 8) + c / 8 : c; tile_e = te; }
    __device__ bool next(int i, pg8::Unit& u) const {
        const int L = i * G + v; if (L >= nunits) return false;
        u.pm = L / nN; u.pn = L % nN; u.e = tile_e[u.pm]; return true;
    }
    __device__ __forceinline__ const bf16_t* bt(const pg8::Gemm& g, const pg8::Unit& u) const { return g.Bt + (size_t)u.e * g.N * g.K; }
    __device__ __forceinline__ void a_ready(const pg8::Unit&) const {}
    __device__ __forceinline__ void done(const pg8::Unit&) const {}
};

__device__ __forceinline__ void ph_gemm_proj(const P& p, int l, char* lds) {
    pg8::Gemm g{p.H, p.WinT + (size_t)l * PW * D, R, PW, D}; pg8::StaticOrder S; S.init(R, PW, (int)gridDim.x, (int)blockIdx.x);
    EpiProj E{p.PROJ, p.rope};
    pg8::gemm_phase<EpiProj, pg8::StaticOrder, true, true>((PG8_LAS unsigned char*)lds, g, S, E);
}
__device__ __forceinline__ void ph_gemm_out(const P& p, int l, int nrows, char* lds) {
    pg8::Gemm g{p.MIX, p.WoutT + (size_t)l * D * D, nrows, D, D}; pg8::StaticOrder S; S.init(nrows, D, (int)gridDim.x, (int)blockIdx.x);
    EpiOut E{p.X, p.mod + (size_t)l * 5 * 6144 + 2 * 1024, l == 0 ? p.x : p.X, l == 0 ? p.ctx - (size_t)T * D : p.X};
    pg8::gemm_phase<EpiOut, pg8::StaticOrder, true, true>((PG8_LAS unsigned char*)lds, g, S, E);
}
__device__ __forceinline__ void ph_moe1(const P& p, int l, char* lds) {
    const int* meta = p.moe_meta + l * 512;
    const int ntiles = meta[0];
    pg8::Gemm g{(const bf16_t*)p.HS, (const bf16_t*)(p.WguT + (size_t)l * NE * 2048 * D), ntiles * 256, 2048, D / 2}; MoeOrder S; S.init(ntiles, 8, (int)gridDim.x, (int)blockIdx.x, meta + 1);
    EpiAct E{p.ACT, p.b_gu + (size_t)l * NE * 2048};
    pg8::gemm_phase<EpiAct, MoeOrder, true, true, true>((PG8_LAS unsigned char*)lds, g, S, E);
}
__device__ __forceinline__ void ph_moe2(const P& p, int l, char* lds) {
    const int* meta = p.moe_meta + l * 512;
    const int ntiles = meta[0];
    pg8::Gemm g{(const bf16_t*)p.ACT, (const bf16_t*)(p.WdnT + (size_t)l * NE * D * FF), ntiles * 256, D, FF / 2}; MoeOrder S; S.init(ntiles, 4, (int)gridDim.x, (int)blockIdx.x, meta + 1);
    EpiYB E{p.YB, p.b_down + (size_t)l * NE * D};
    pg8::gemm_phase<EpiYB, MoeOrder, true, true, true>((PG8_LAS unsigned char*)lds, g, S, E);
}
__device__ __forceinline__ void ph_combine(const P& p, int l, int nrows) {
    const int wave = ltid() >> 6, lane = ltid() & 63;
    for (int row = blockIdx.x * 8 + wave; row < nrows; row += gridDim.x * 8) {
        const int4 sl = *(const int4*)(p.tok_slot + (size_t)row * 4);
        const float4 g = *(const float4*)(p.topg + (size_t)row * 4);
        const float* m = p.mod + ((size_t)l * 5 + mod_row(row)) * 6144 + 5 * 1024;
        float xv[16]; float ss = 0.f;
#pragma unroll
        for (int i = 0; i < 2; ++i) {
            const int k = lane * 8 + 512 * i;
            const uint4 y0 = *(const uint4*)(p.YB + (size_t)sl.x * D + k), y1 = *(const uint4*)(p.YB + (size_t)sl.y * D + k);
            const uint4 y2 = *(const uint4*)(p.YB + (size_t)sl.z * D + k), y3 = *(const uint4*)(p.YB + (size_t)sl.w * D + k);
            const unsigned a0[4] = {y0.x, y0.y, y0.z, y0.w}, a1[4] = {y1.x, y1.y, y1.z, y1.w}, a2[4] = {y2.x, y2.y, y2.z, y2.w}, a3[4] = {y3.x, y3.y, y3.z, y3.w};
            const float* xp = p.X + (size_t)row * D + k;
            const float4 gta = *(const float4*)(m + k), gtb = *(const float4*)(m + k + 4);
            const float4 xa = *(const float4*)xp, xb = *(const float4*)(xp + 4);
            const float gt[8] = {gta.x, gta.y, gta.z, gta.w, gtb.x, gtb.y, gtb.z, gtb.w};
            const float x8[8] = {xa.x, xa.y, xa.z, xa.w, xb.x, xb.y, xb.z, xb.w};
#pragma unroll
            for (int q = 0; q < 4; ++q) {
                const float ylo = g.x * __uint_as_float(a0[q] << 16) + g.y * __uint_as_float(a1[q] << 16) + g.z * __uint_as_float(a2[q] << 16) + g.w * __uint_as_float(a3[q] << 16);
                const float yhi = g.x * __uint_as_float(a0[q] & 0xffff0000u) + g.y * __uint_as_float(a1[q] & 0xffff0000u) + g.z * __uint_as_float(a2[q] & 0xffff0000u) + g.w * __uint_as_float(a3[q] & 0xffff0000u);
                const float v0 = x8[2 * q] + gt[2 * q] * ylo, v1 = x8[2 * q + 1] + gt[2 * q + 1] * yhi;
                xv[8 * i + 2 * q] = v0; xv[8 * i + 2 * q + 1] = v1; ss += v0 * v0 + v1 * v1;
            }
        }
        ss = wave_sum(ss);
        const float rstd = rsqrtf(ss * (1.f / D) + EPS);
        if (l == 0) {
            const float* m1 = p.mod + ((size_t)5 + mod_row(row)) * 6144;
            const float* g1 = p.g_mix + D;
#pragma unroll
            for (int i = 0; i < 2; ++i) {
                const int k = lane * 8 + 512 * i;
                float* xp = p.X + (size_t)row * D + k;
                *(float4*)xp = make_float4(xv[8 * i], xv[8 * i + 1], xv[8 * i + 2], xv[8 * i + 3]);
                *(float4*)(xp + 4) = make_float4(xv[8 * i + 4], xv[8 * i + 5], xv[8 * i + 6], xv[8 * i + 7]);
                const float4 ga = *(const float4*)(g1 + k), gb = *(const float4*)(g1 + k + 4);
                const float4 sha = *(const float4*)(m1 + k), shb = *(const float4*)(m1 + k + 4);
                const float4 sca = *(const float4*)(m1 + 1024 + k), scb = *(const float4*)(m1 + 1024 + k + 4);
                u32x4 o;
                o.x = cvtpk(xv[8 * i] * rstd * ga.x * (1.f + sca.x) + sha.x, xv[8 * i + 1] * rstd * ga.y * (1.f + sca.y) + sha.y);
                o.y = cvtpk(xv[8 * i + 2] * rstd * ga.z * (1.f + sca.z) + sha.z, xv[8 * i + 3] * rstd * ga.w * (1.f + sca.w) + sha.w);
                o.z = cvtpk(xv[8 * i + 4] * rstd * gb.x * (1.f + scb.x) + shb.x, xv[8 * i + 5] * rstd * gb.y * (1.f + scb.y) + shb.y);
                o.w = cvtpk(xv[8 * i + 6] * rstd * gb.z * (1.f + scb.z) + shb.z, xv[8 * i + 7] * rstd * gb.w * (1.f + scb.w) + shb.w);
                *(u32x4*)(p.H + (size_t)row * D + k) = o;
            }
        } else {
#pragma unroll
            for (int i = 0; i < 2; ++i) {
                const int k = lane * 8 + 512 * i;
                const float4 ga = *(const float4*)(p.g_final + k), gb = *(const float4*)(p.g_final + k + 4);
                float* op = p.out + (size_t)row * D + k;
                *(float4*)op = make_float4(xv[8 * i] * rstd * ga.x, xv[8 * i + 1] * rstd * ga.y, xv[8 * i + 2] * rstd * ga.z, xv[8 * i + 3] * rstd * ga.w);
                *(float4*)(op + 4) = make_float4(xv[8 * i + 4] * rstd * gb.x, xv[8 * i + 5] * rstd * gb.y, xv[8 * i + 6] * rstd * gb.z, xv[8 * i + 7] * rstd * gb.w);
            }
        }
    }
}
#ifndef PROBE_DUP
#define PROBE_DUP 0
#endif
#ifndef PROBE_DUP
#define PROBE_DUP 0
#endif
extern __shared__ __attribute__((aligned(16))) char smem[];
__global__ void __launch_bounds__(NT, 2) mega(P p) {
    char* lds = smem;
    if (threadIdx.x == 0) *(uint4*)(smem + LDS_MAIN) = make_uint4(0u, 0u, 0u, 0u);
    __syncthreads();
    XcdBarrier bar = xcd_barrier_post(p.bar, (volatile LAS unsigned*)(smem + LDS_MAIN));
    ph_prologue(p, lds, 0);
    xcd_barrier(bar);
    ph_norm1(p, 0);
    ph_prologue(p, lds, 1);
    if (PROBE_DUP == 1) ph_prologue(p, lds, 1);
    if (PROBE_DUP == 5) ph_norm1(p, 0);
    xcd_barrier(bar);
#pragma unroll
    for (int l = 0; l < 2; ++l) {
        const int nrows = l == 0 ? R : T;
        ph_gemm_proj(p, l, lds);
        if (PROBE_DUP == 4) ph_gemm_proj(p, l, lds);
        xcd_barrier(bar);
        ph_dattn(p, l, nrows, lds);
        if (PROBE_DUP == 2) ph_dattn(p, l, nrows, lds);
        ph_na(p, l, nrows, lds);
        if (PROBE_DUP == 5) ph_na(p, l, nrows, lds);
        ph_pool(p, l, nrows, lds);
        ph_sgu(p, l, nrows, lds);
        if (PROBE_DUP == 3) { ph_pool(p, l, nrows, lds); ph_sgu(p, l, nrows, lds); }
        xcd_barrier(bar);
        ph_gemm_out(p, l, nrows, lds);
        xcd_barrier(bar);
        ph_router(p, l, nrows, lds);
        xcd_barrier(bar);
        ph_assign(p, l, nrows, lds);
        xcd_barrier(bar);
        if (PROBE_DUP == 8) { xcd_barrier(bar); xcd_barrier(bar); xcd_barrier(bar); xcd_barrier(bar); xcd_barrier(bar); }
        ph_moe1(p, l, lds);
        if (PROBE_DUP == 6) ph_moe1(p, l, lds);
        xcd_barrier(bar);
        ph_moe2(p, l, lds);
        if (PROBE_DUP == 7) ph_moe2(p, l, lds);
        xcd_barrier(bar);
        ph_combine(p, l, nrows);
        if (l == 0) xcd_barrier(bar);
    }
}

static inline size_t align_up(size_t v, size_t a) { return (v + a - 1) / a * a; }

extern "C" void kernel_launch(void* const* d_in, const int* in_sizes, int n_in, void* d_out, int out_size, void* d_ws, size_t ws_size, hipStream_t stream) {
    P p{};
    const float** ins = (const float**)&p.x;
    for (int i = 0; i < 28; ++i) ins[i] = (const float*)d_in[i];
    p.out = (float*)d_out;
    char* w = (char*)d_ws; size_t off = 0;
    auto carve = [&](size_t bytes) { void* r = w + off; off = align_up(off + bytes, 256); return r; };
    const size_t ctl_bytes = XCD_BAR_WORDS * 4 + 2 * 64 * 4;
    p.bar = (unsigned*)carve(ctl_bytes);
    p.cnt = (int*)(p.bar + XCD_BAR_WORDS);
    p.mod = (float*)carve((size_t)2 * 5 * 6144 * 4);
    p.rope = (float*)carve(64 * 8 * 2 * 4);
    p.X = (float*)carve((size_t)R * D * 4);
    p.H = (bf16_t*)carve((size_t)R * D * 2);
    p.PROJ = (bf16_t*)carve((size_t)R * PW * 2);
    p.MIX = (bf16_t*)carve((size_t)R * D * 2);
    p.WinT = (bf16_t*)carve((size_t)2 * PW * D * 2);
    p.WoutT = (bf16_t*)carve((size_t)2 * D * D * 2);
    p.WguT = (unsigned char*)carve((size_t)2 * NE * 2048 * D);
    p.WdnT = (unsigned char*)carve((size_t)2 * NE * D * FF);
    p.WpT = (bf16_t*)carve((size_t)2 * 4 * 64 * 64 * 2);
    p.WsB = (bf16_t*)carve((size_t)2 * 4 * 128 * 128 * 2);
    p.topi = (int*)carve((size_t)R * 4 * 4);
    p.topg = (float*)carve((size_t)R * 4 * 4);
    p.tok_slot = (int*)carve((size_t)R * 4 * 4);
    p.moe_meta = (int*)carve(2 * 512 * 4);
    p.HS = (unsigned char*)carve((size_t)NSLOT * D);
    p.ACT = (unsigned char*)carve((size_t)NSLOT * FF);
    p.YB = (bf16_t*)carve((size_t)NSLOT * D * 2);

    static int grid = 0;
    if (!grid) {
        int dev = 0, cus = 0, per_cu = 0;
        (void)hipGetDevice(&dev);
        (void)hipDeviceGetAttribute(&cus, hipDeviceAttributeMultiprocessorCount, dev);
        (void)hipFuncSetAttribute((const void*)mega, hipFuncAttributeMaxDynamicSharedMemorySize, LDS_BYTES);
        (void)hipOccupancyMaxActiveBlocksPerMultiprocessor(&per_cu, mega, NT, LDS_BYTES);
        grid = cus * (per_cu < 1 ? per_cu : 1);
        if (grid <= 0) { fprintf(stderr, "mega: occupancy query returned %d blocks per CU\n", per_cu); grid = 0; return; }
    }
    (void)hipMemsetAsync(p.bar, 0, ctl_bytes, stream);
    mega<<<grid, NT, LDS_BYTES, stream>>>(p);
}
```

```cpp
#include <hip/hip_runtime.h>
#include <stdint.h>
#include <cstdio>

typedef unsigned short bf16_t;
typedef short bf16x8 __attribute__((ext_vector_type(8)));
typedef float f32x4 __attribute__((ext_vector_type(4)));

constexpr int D = 1024, NB = 4, S = 4096, T = NB * S, CL = 256, TC = NB * CL, R = T + TC;
constexpr int PW = 2304, NE = 32, TOPK = 4, FF = 1024;
constexpr int MAXSLOT = R * TOPK;
constexpr int NSLOT = MAXSLOT + NE * 256;
constexpr float EPS = 1e-6f;
constexpr int NT = 512;
constexpr int LDS_MAIN = 150 * 1024;
constexpr int LDS_BYTES = LDS_MAIN + 1024;

__device__ __forceinline__ bf16_t f2bf(float f) { unsigned u = __float_as_uint(f); return (bf16_t)((u + 0x7fffu + ((u >> 16) & 1u)) >> 16); }
__device__ __forceinline__ float bf2f(bf16_t h) { return __uint_as_float(((unsigned)h) << 16); }
__device__ __forceinline__ float wave_sum(float v) {
#pragma unroll
    for (int o = 32; o >= 1; o >>= 1) v += __shfl_xor(v, o);
    return v;
}
__device__ __forceinline__ int mod_row(int row) { return row < T ? (row >> 12) : 4; }

#define XB_TMO      128
#define XB_XCNT(j)  (256  + 64 * (j))
#define XB_XSUB(j)  (1280 + 64 * (j))
#define XB_XGEN(j)  (2304 + 64 * (j))
#define XB_TOP      3328
#define XB_TOPGEN   3392
#define XCD_BAR_WORDS 3456
#define XB_SPIN_CAP (1u << 18)
#define LAS __attribute__((address_space(3)))

__device__ __forceinline__ unsigned xb_ld(unsigned* p)              { return __hip_atomic_load(p, __ATOMIC_RELAXED, __HIP_MEMORY_SCOPE_AGENT); }
__device__ __forceinline__ unsigned xb_add(unsigned* p, unsigned v) { return __hip_atomic_fetch_add(p, v, __ATOMIC_RELAXED, __HIP_MEMORY_SCOPE_AGENT); }
__device__ __forceinline__ unsigned xb_xcc_id() { return (unsigned)__builtin_amdgcn_s_getreg((3 << 11) | 20) & 0xFu; }
#define XB_SPIN(cond, bar) do { unsigned _sp = 0; while (cond) { __builtin_amdgcn_s_sleep(1); \
    if ((++_sp & 255u) == 0u) { if (xb_ld(&(bar)[XB_TMO])) break; if (_sp > XB_SPIN_CAP) { atomicAdd(&(bar)[XB_TMO], 1u); break; } } } } while (0)

struct XcdBarrier {
    unsigned* bar; unsigned x;
    volatile LAS unsigned* st;
};
__device__ __forceinline__ XcdBarrier xcd_barrier_post(unsigned* bar, volatile LAS unsigned* st) {
    XcdBarrier b; b.bar = bar; b.x = xb_xcc_id(); b.st = st;
    if (threadIdx.x == 0) (void)xb_add(&bar[XB_XCNT(b.x)], 1u);
    return b;
}
__device__ __forceinline__ void xcd_barrier_complete(unsigned* bar, unsigned x, unsigned& nloc, unsigned& nx) {
    const unsigned G = gridDim.x * gridDim.y * gridDim.z;
    unsigned sum, cnt, mine, sp = 0u;
    for (;;) {
        sum = 0u; cnt = 0u; mine = 0u;
#pragma unroll
        for (unsigned j = 0; j < 16; ++j) { const unsigned c = xb_ld(&bar[XB_XCNT(j)]); sum += c; cnt += (c > 0u) ? 1u : 0u; mine = (j == x) ? c : mine; }
        if (sum == G) break;
        __builtin_amdgcn_s_sleep(1);
        if ((++sp & 255u) == 0u) { if (xb_ld(&bar[XB_TMO])) break; if (sp > XB_SPIN_CAP) { atomicAdd(&bar[XB_TMO], 1u); break; } }
    }
    nloc = mine > 0u ? mine : 1u; nx = cnt > 0u ? cnt : 1u;
}
__device__ __forceinline__ void xcd_barrier(const XcdBarrier& b) {
    asm volatile("s_waitcnt vmcnt(0)" ::: "memory");
    __syncthreads();
    if (threadIdx.x == 0) {
        unsigned* bar = b.bar;
        __builtin_amdgcn_s_waitcnt(0);
        unsigned nloc = b.st[0], nx = b.st[1];
        if (nloc == 0u) { xcd_barrier_complete(bar, b.x, nloc, nx); b.st[0] = nloc; b.st[1] = nx; }
        const unsigned old = xb_add(&bar[XB_XSUB(b.x)], 1u);
        const unsigned gen = old / nloc;
        if (old + 1u == (gen + 1u) * nloc) {
            __builtin_amdgcn_fence(__ATOMIC_RELEASE, "agent");
            asm volatile("s_waitcnt vmcnt(0)" ::: "memory");
            const unsigned og = xb_add(&bar[XB_TOP], 1u);
            const unsigned tg = og / nx;
            if (og + 1u == (tg + 1u) * nx) xb_add(&bar[XB_TOPGEN], 1u);
            else XB_SPIN(xb_ld(&bar[XB_TOPGEN]) == tg, bar);
            __builtin_amdgcn_fence(__ATOMIC_ACQUIRE, "agent");
            xb_add(&bar[XB_XGEN(b.x)], 1u);
            asm volatile("s_waitcnt vmcnt(0)" ::: "memory");
        } else {
            XB_SPIN(xb_ld(&bar[XB_XGEN(b.x)]) == gen, bar);
            __builtin_amdgcn_fence(__ATOMIC_ACQUIRE, "agent");
            asm volatile("s_waitcnt vmcnt(0)" ::: "memory");
        }
    }
    __syncthreads();
}

struct P {
    const float *x, *c, *ctx, *c_ctx, *w_mod, *b_mod, *g_mix, *g_ffn, *w_in, *w_out, *lam_q1, *lam_k1, *lam_q2, *lam_k2, *g_sub,
        *w_pool, *s_pool, *g_sgu, *w_sgu, *b_sgu, *rpb, *w_router, *b_router, *w_gu, *b_gu, *w_down, *b_down, *g_final;
    float* out;
    unsigned* bar;
    int* cnt;
    float* mod;
    float* rope;
    float* X;
    bf16_t* H;
    bf16_t* PROJ;
    bf16_t* MIX;
    bf16_t* WinT;
    bf16_t* WoutT;
    unsigned char* WguT;
    unsigned char* WdnT;
    bf16_t* WpT;
    bf16_t* WsB;
    int* topi;
    float* topg;
    int* tok_slot;
    int* moe_meta;
    unsigned char* HS;
    unsigned char* ACT;
    bf16_t* YB;
};

__device__ __forceinline__ int ltid() { int t = threadIdx.x; asm volatile("" : "+v"(t)); return t; }
typedef float f32x16 __attribute__((ext_vector_type(16)));
typedef short s16x4 __attribute__((ext_vector_type(4)));
typedef short v4i16_t __attribute__((ext_vector_type(4)));
typedef float f32x2_t __attribute__((ext_vector_type(2)));
typedef __bf16 bf16x2_t __attribute__((ext_vector_type(2)));
typedef __attribute__((address_space(3))) const char* lds_cptr;
typedef unsigned u32x4 __attribute__((ext_vector_type(4)));
__device__ __forceinline__ unsigned cvtpk(float lo, float hi) { f32x2_t v = {lo, hi}; bf16x2_t b = __builtin_convertvector(v, bf16x2_t); return __builtin_bit_cast(unsigned, b); }
__device__ __forceinline__ s16x4 vtr(lds_cptr q) { return __builtin_bit_cast(s16x4, __builtin_amdgcn_ds_read_tr16_b64_v4i16((__attribute__((address_space(3))) v4i16_t*)q)); }
__device__ __forceinline__ float xhalf_max(float v) { auto rr = __builtin_amdgcn_permlane32_swap(__float_as_uint(v), __float_as_uint(v), false, false); return fmaxf(__uint_as_float(rr[0]), __uint_as_float(rr[1])); }
__device__ __forceinline__ float xhalf_sum(float v) { auto rr = __builtin_amdgcn_permlane32_swap(__float_as_uint(v), __float_as_uint(v), false, false); return __uint_as_float(rr[0]) + __uint_as_float(rr[1]); }
namespace pg8 {
#define PG8_LAS __attribute__((address_space(3)))
constexpr int BM = 256, BK = 64, HALF = 128, HTB = HALF * BK * 2  , STAGE_BYTES = 8 * HTB, NXCD = 8, WGM = 8;
__host__ __device__ __forceinline__ int lds_byte(int r, int c) { const int st = (r >> 4) * 2 + (c >> 5), rr = r & 15, cc = c & 31, ob = rr * 64 + cc * 2; return st * 1024 + (ob ^ (((ob >> 9) & 1) << 5)); }
__host__ __device__ __forceinline__ void stage_rc(int b, int& R, int& C) { const int st = b / 1024, sb = b % 1024, swz = sb ^ (((sb >> 9) & 1) << 5); R = (st >> 1) * 16 + swz / 64; C = (st & 1) * 32 + (swz % 64) / 2; }
__host__ __device__ __forceinline__ int perm32(int rho) { const int n = rho >> 4, i = rho & 15; return 8 * (i >> 2) + 4 * n + (i & 3); }
struct Unit { int pm, pn, e; };
struct Gemm { const bf16_t* A; const bf16_t* Bt; int M, N, K; };
struct StaticOrder {
    int nM, nN, nwg, G, c;
    __host__ __device__ void init(int M, int N, int G_, int c_) { nM = M / BM; nN = N / BM; nwg = nM * nN; G = G_; c = c_; }
    __host__ __device__ bool next(int i, Unit& u) const {
        const long L = (long)i * G + c; if (L >= nwg) return false;
        int wgid = (int)L; { const int q = nwg / NXCD, r = nwg % NXCD, xcd = wgid % NXCD, off = wgid / NXCD; wgid = (xcd < r ? xcd * (q + 1) : r * (q + 1) + (xcd - r) * q) + off; }
        const int nig = WGM * nN, gid = wgid / nig, fm = gid * WGM, gsz = (nM - fm) < WGM ? (nM - fm) : WGM;
        u.pm = fm + ((wgid % nig) % gsz); u.pn = (wgid % nig) / gsz; u.e = 0; return true;
    }
    __device__ __forceinline__ const bf16_t* bt(const Gemm& g, const Unit&) const { return g.Bt; }
    __device__ __forceinline__ void a_ready(const Unit&) const {}
    __device__ __forceinline__ void done(const Unit&) const {}
};
typedef int v4i_t __attribute__((ext_vector_type(4)));
typedef int v8i_t __attribute__((ext_vector_type(8)));
__device__ __forceinline__ v8i_t cat8(bf16x8 a, bf16x8 b) { const v4i_t x = __builtin_bit_cast(v4i_t, a), y = __builtin_bit_cast(v4i_t, b); return __builtin_shufflevector(x, y, 0, 1, 2, 3, 4, 5, 6, 7); }
template <class Epi, class Sched, bool ALIGN_EPI = false, bool SP2 = false, bool F8 = false>
__device__ __forceinline__ void gemm_phase(PG8_LAS unsigned char* lds, const Gemm g, const Sched& S, const Epi& E) {
    const int tid = ltid(), wid = __builtin_amdgcn_readfirstlane(tid >> 6), lane = tid & 63, wr = wid >> 2, wc = wid & 3, fr = lane & 15, fq = lane >> 4;
    const int K = g.K, nt = K / BK;
    unsigned voffA[2], voffB[2];
#pragma unroll
    for (int i = 0; i < 2; ++i) { int R, C; stage_rc(tid * 16 + i * 8192, R, C); const int Rb = Epi::PERM ? ((R & ~31) + perm32(R & 31)) : R;
        voffA[i] = (unsigned)(R * K + C) * 2u; voffB[i] = (unsigned)(Rb * K + C) * 2u; }
    const size_t kstep = (size_t)(BK * 2);
    const size_t hstep = (size_t)HALF * K * 2;
    const size_t tstep = 2 * hstep;
    const unsigned ldsw = (unsigned)wid * 1024u;
    const int aoff = lds_byte(wr * 64 + fr, fq * 8), boff = lds_byte(wc * 32 + fr, fq * 8);
#define PG8_SA(b, h) (((b) * 2 + (h)) * HTB)
#define PG8_SB(b, h) ((4 + (b) * 2 + (h)) * HTB)
#define PG8_STAGE(bufoff, gbase, voff) do { _Pragma("unroll") for (int _i = 0; _i < 2; ++_i) \
        __builtin_amdgcn_global_load_lds((const unsigned*)((const char*)(gbase) + (voff)[_i]), (PG8_LAS unsigned*)(lds + (bufoff) + ldsw + _i * 8192), 16, 0, 0); } while (0)
#define PG8_LDA(dst, b, h) do { _Pragma("unroll") for (int m = 0; m < 4; ++m) _Pragma("unroll") for (int k = 0; k < 2; ++k) dst[m][k] = *(const PG8_LAS bf16x8*)(lds + PG8_SA(b, h) + aoff + m * 2048 + k * 1024); \
        if constexpr (F8) { _Pragma("unroll") for (int m = 0; m < 4; ++m) dst##8[m] = cat8(dst[m][0], dst[m][1]); } } while (0)
#define PG8_LDB(dst, b, h) do { _Pragma("unroll") for (int n = 0; n < 2; ++n) _Pragma("unroll") for (int k = 0; k < 2; ++k) dst[n][k] = *(const PG8_LAS bf16x8*)(lds + PG8_SB(b, h) + boff + n * 2048 + k * 1024); \
        if constexpr (F8) { _Pragma("unroll") for (int n = 0; n < 2; ++n) dst##8[n] = cat8(dst[n][0], dst[n][1]); } } while (0)
#define PG8_MMA(ai, bj, At, Bt) do { __builtin_amdgcn_s_setprio(1); \
        if constexpr (F8) { _Pragma("unroll") for (int m = 0; m < 4; ++m) _Pragma("unroll") for (int n = 0; n < 2; ++n) \
            asm volatile("v_mfma_scale_f32_16x16x128_f8f6f4 %0, %1, %2, %0, %3, %4 op_sel_hi:[0,0,0]" : "+v"(acc[ai][bj][m][n]) : "v"(Bt##8[n]), "v"(At##8[m]), "v"(sclW), "v"(sclX)); } \
        else { _Pragma("unroll") for (int m = 0; m < 4; ++m) _Pragma("unroll") for (int n = 0; n < 2; ++n) _Pragma("unroll") for (int k = 0; k < 2; ++k) \
            acc[ai][bj][m][n] = __builtin_amdgcn_mfma_f32_16x16x32_bf16(Bt[n][k], At[m][k], acc[ai][bj][m][n], 0, 0, 0); } \
        __builtin_amdgcn_s_setprio(0); } while (0)
#define PG8_WAIT_V(n) asm volatile("s_waitcnt vmcnt(" #n ")" ::: "memory")
#define PG8_WAIT_L(n) asm volatile("s_waitcnt lgkmcnt(" #n ")" ::: "memory")
#define PG8_BAR __builtin_amdgcn_s_barrier()
#define PG8_SCHED __builtin_amdgcn_sched_barrier(0)
    Unit cur, nxt; int ui = 0;
    if (!S.next(0, cur)) return;
    f32x4 acc[2][2][4][2];
#pragma unroll
    for (int a = 0; a < 2; ++a)
#pragma unroll
        for (int b = 0; b < 2; ++b)
#pragma unroll
            for (int m = 0; m < 4; ++m)
#pragma unroll
                for (int n = 0; n < 2; ++n) { acc[a][b][m][n] = (f32x4){0.f, 0.f, 0.f, 0.f}; }
    bf16x8 At[4][2], B0[2][2], B1[2][2];
    v8i_t At8[4], B08[2], B18[2];
    const int sclW = 0x79797979, sclX = 0x7f7f7f7f;
    const char* cA = (const char*)g.A + (size_t)cur.pm * tstep; const char* cB = (const char*)S.bt(g, cur) + (size_t)cur.pn * tstep;
    S.a_ready(cur);
    if constexpr (SP2) {
        PG8_STAGE(PG8_SB(0, 0), cB, voffB); PG8_STAGE(PG8_SB(0, 1), cB + hstep, voffB); PG8_STAGE(PG8_SA(0, 0), cA, voffA); PG8_STAGE(PG8_SA(0, 1), cA + hstep, voffA);
        if (wr == 1) PG8_BAR;
        PG8_WAIT_V(2); PG8_BAR;
        PG8_STAGE(PG8_SB(1, 0), cB + kstep, voffB); PG8_STAGE(PG8_SA(1, 0), cA + kstep, voffA); PG8_STAGE(PG8_SB(1, 1), cB + hstep + kstep, voffB);
        PG8_WAIT_V(6); PG8_BAR;
    } else {
        PG8_STAGE(PG8_SB(0, 0), cB, voffB); PG8_STAGE(PG8_SA(0, 0), cA, voffA); PG8_STAGE(PG8_SB(0, 1), cB + hstep, voffB); PG8_STAGE(PG8_SA(0, 1), cA + hstep, voffA);
        if (wr == 1) PG8_BAR;
        PG8_WAIT_V(4); PG8_BAR;
        PG8_STAGE(PG8_SB(1, 0), cB + kstep, voffB); PG8_STAGE(PG8_SA(1, 0), cA + kstep, voffA); PG8_STAGE(PG8_SB(1, 1), cB + hstep + kstep, voffB);
        PG8_WAIT_V(6); PG8_BAR;
    }
    for (;;) {
        const bool has_next = S.next(ui + 1, nxt);
        const char* nA = has_next ? (const char*)g.A + (size_t)nxt.pm * tstep : cA; const char* nB = has_next ? (const char*)S.bt(g, nxt) + (size_t)nxt.pn * tstep : cB;
#pragma unroll 1
        for (int t = 0; t < nt; t += 2) {
            const bool last = (t == nt - 2);
            const char* a1 = cA + (size_t)(t + 1) * kstep;
            const char* a2 = last ? nA : cA + (size_t)(t + 2) * kstep; const char* b2 = last ? nB : cB + (size_t)(t + 2) * kstep;
            const char* a3 = a2 + kstep; const char* b3 = b2 + kstep;
            if (last && has_next) S.a_ready(nxt);
            if constexpr (SP2) {
            PG8_LDB(B0, 0, 0); PG8_LDB(B1, 0, 1); PG8_SCHED; PG8_LDA(At, 0, 0); PG8_STAGE(PG8_SA(1, 1), a1 + hstep, voffA);
            PG8_WAIT_V(8); PG8_WAIT_L(0); PG8_BAR; PG8_MMA(0, 0, At, B0); PG8_MMA(0, 1, At, B1); PG8_BAR; PG8_SCHED;
            PG8_LDA(At, 0, 1); PG8_STAGE(PG8_SB(0, 0), b2, voffB); PG8_STAGE(PG8_SB(0, 1), b2 + hstep, voffB); PG8_STAGE(PG8_SA(0, 0), a2, voffA);
            PG8_WAIT_V(8); PG8_WAIT_L(0); PG8_BAR; PG8_MMA(1, 0, At, B0); PG8_MMA(1, 1, At, B1); PG8_BAR; PG8_SCHED;
            PG8_LDB(B0, 1, 0); PG8_LDB(B1, 1, 1); PG8_SCHED; PG8_LDA(At, 1, 0); PG8_STAGE(PG8_SA(0, 1), a2 + hstep, voffA);
            PG8_WAIT_V(8); PG8_WAIT_L(0); PG8_BAR; PG8_MMA(0, 0, At, B0); PG8_MMA(0, 1, At, B1); PG8_BAR; PG8_SCHED;
            PG8_LDA(At, 1, 1); PG8_STAGE(PG8_SB(1, 0), b3, voffB); PG8_STAGE(PG8_SB(1, 1), b3 + hstep, voffB); PG8_STAGE(PG8_SA(1, 0), a3, voffA);
            PG8_WAIT_V(8); PG8_WAIT_L(0); PG8_BAR; PG8_MMA(1, 0, At, B0); PG8_MMA(1, 1, At, B1); PG8_BAR; PG8_SCHED;
            } else {
            PG8_LDB(B0, 0, 0); PG8_SCHED; PG8_LDA(At, 0, 0); PG8_STAGE(PG8_SA(1, 1), a1 + hstep, voffA);
            PG8_WAIT_L(8); PG8_BAR; PG8_WAIT_L(0); PG8_MMA(0, 0, At, B0); PG8_BAR; PG8_SCHED;
            PG8_LDB(B1, 0, 1); PG8_STAGE(PG8_SB(0, 0), b2, voffB);
            PG8_BAR; PG8_WAIT_L(0); PG8_MMA(0, 1, At, B1); PG8_BAR;
            PG8_LDA(At, 0, 1); PG8_STAGE(PG8_SA(0, 0), a2, voffA);
            PG8_BAR; PG8_WAIT_L(0); PG8_MMA(1, 0, At, B0); PG8_BAR; PG8_SCHED;
            PG8_STAGE(PG8_SB(0, 1), b2 + hstep, voffB);
            PG8_WAIT_V(6); PG8_BAR; PG8_MMA(1, 1, At, B1); PG8_BAR;
            PG8_LDB(B0, 1, 0); PG8_SCHED; PG8_LDA(At, 1, 0); PG8_STAGE(PG8_SA(0, 1), a2 + hstep, voffA);
            PG8_WAIT_L(8); PG8_BAR; PG8_WAIT_L(0); PG8_MMA(0, 0, At, B0); PG8_BAR; PG8_SCHED;
            PG8_LDB(B1, 1, 1); PG8_STAGE(PG8_SB(1, 0), b3, voffB);
            PG8_BAR; PG8_WAIT_L(0); PG8_MMA(0, 1, At, B1); PG8_BAR;
            PG8_LDA(At, 1, 1); PG8_STAGE(PG8_SA(1, 0), a3, voffA);
            PG8_BAR; PG8_WAIT_L(0); PG8_MMA(1, 0, At, B0); PG8_BAR; PG8_SCHED;
            PG8_STAGE(PG8_SB(1, 1), b3 + hstep, voffB);
            PG8_WAIT_V(6); PG8_BAR; PG8_MMA(1, 1, At, B1); PG8_BAR;
            }
        }
        if constexpr (ALIGN_EPI) { if (wr == 0) PG8_BAR; }
        if constexpr (F8) asm volatile("s_nop 15\n\ts_nop 15" ::: "memory");
        if constexpr (!Epi::AFTER_DRAIN) { E(acc, cur, wr, wc, fr, fq); S.done(cur); }
        if (!has_next) break;
#pragma unroll
        for (int a = 0; a < 2; ++a)
#pragma unroll
            for (int b = 0; b < 2; ++b)
#pragma unroll
                for (int m = 0; m < 4; ++m)
#pragma unroll
                    for (int n = 0; n < 2; ++n) { acc[a][b][m][n] = (f32x4){0.f, 0.f, 0.f, 0.f}; }
        cur = nxt; cA = nA; cB = nB; ++ui;
        if constexpr (ALIGN_EPI) { if (wr == 1) PG8_BAR; }
    }
    PG8_WAIT_V(0);
    if constexpr (!ALIGN_EPI) { if (wr == 0) PG8_BAR; }
    PG8_BAR;
    if constexpr (Epi::AFTER_DRAIN) { E.fused(acc, cur, wr, wc, fr, fq, lds, wid, lane); S.done(cur); }
#undef PG8_SA
#undef PG8_SB
#undef PG8_STAGE
#undef PG8_LDA
#undef PG8_LDB
#undef PG8_MMA
#undef PG8_WAIT_V
#undef PG8_WAIT_L
#undef PG8_BAR
#undef PG8_SCHED
}
}

__device__ __forceinline__ void ph_prologue(const P& p, char* lds, const int part) {
    const int tid = ltid();
    float* fl = (float*)lds;
    if (part == 0) {
    for (int it = blockIdx.x; it < 96; it += gridDim.x) {
        const int l = it / 48, cg = it % 48;
        float* sc = fl;
        float* part = fl + 5 * 1024;
        __syncthreads();
        for (int i = tid; i < 5 * 1024; i += NT) {
            const int r = i >> 10, k = i & 1023;
            const float v = r < 4 ? p.c[r * 1024 + k] : p.c_ctx[k];
            sc[i] = v / (1.f + __expf(-v));
        }
        __syncthreads();
        const int kq = tid >> 7, col = tid & 127, j = cg * 128 + col;
        const float* W = p.w_mod + (size_t)l * 1024 * 6144;
        float a0 = 0, a1 = 0, a2 = 0, a3 = 0, a4 = 0;
        for (int k = kq * 256; k < kq * 256 + 256; ++k) {
            const float w = W[(size_t)k * 6144 + j];
            a0 += sc[k] * w; a1 += sc[1024 + k] * w; a2 += sc[2048 + k] * w; a3 += sc[3072 + k] * w; a4 += sc[4096 + k] * w;
        }
        part[(kq * 5 + 0) * 128 + col] = a0; part[(kq * 5 + 1) * 128 + col] = a1; part[(kq * 5 + 2) * 128 + col] = a2;
        part[(kq * 5 + 3) * 128 + col] = a3; part[(kq * 5 + 4) * 128 + col] = a4;
        __syncthreads();
        for (int i = tid; i < 5 * 128; i += NT) {
            const int r = i >> 7, cc = i & 127, jj = cg * 128 + cc;
            const float v = part[(0 * 5 + r) * 128 + cc] + part[(1 * 5 + r) * 128 + cc] + part[(2 * 5 + r) * 128 + cc] + part[(3 * 5 + r) * 128 + cc];
            p.mod[((size_t)l * 5 + r) * 6144 + jj] = v + p.b_mod[l * 6144 + jj];
        }
    }
    if (blockIdx.x == gridDim.x - 1) {
        const int pos = tid >> 3, f = tid & 7;
        const float inv = powf(10000.0f, -(float)f / 8.0f);
        const float ang = (float)pos * inv;
        p.rope[tid * 2] = cosf(ang); p.rope[tid * 2 + 1] = sinf(ang);
    }
    for (int i = blockIdx.x * NT + tid; i < 2 * 4 * 64 * 64; i += gridDim.x * NT) { const int ii = i & 63, j = (i >> 6) & 63, lg = i >> 12; p.WpT[i] = f2bf(p.w_pool[(size_t)lg * 4096 + ii * 64 + j]); }
    for (int i = blockIdx.x * NT + tid; i < 2 * 4 * 128 * 128; i += gridDim.x * NT) p.WsB[i] = f2bf(p.w_sgu[i]);
    }
    if (part == 0) {
        const int n_in = 2 * 9 * 16, n_out = 2 * 4 * 16, total = n_in + n_out;
        const int kr = tid >> 6, n4 = tid & 63, kg = tid & 7, nl = tid >> 3;
        for (int it = blockIdx.x; it < total; it += gridDim.x) {
            int i_ = it; const float* W_; bf16_t* Wt_; int N, K;
            if (i_ < n_in) { W_ = p.w_in; Wt_ = p.WinT; N = PW; K = D; } else { i_ -= n_in; W_ = p.w_out; Wt_ = p.WoutT; N = D; K = D; }
            const int ntn = N / 256, per = ntn * (K / 64), m_ = i_ / per, r_ = i_ % per, tn = r_ % ntn, tk = r_ / ntn, n0 = tn * 256;
            const float* src = W_ + (size_t)m_ * K * N + (size_t)(tk * 64) * N + n0; bf16_t* dst = Wt_ + (size_t)m_ * K * N + tk * 64;
            float4 rg[8];
#pragma unroll
            for (int i = 0; i < 8; ++i) rg[i] = *(const float4*)(src + (size_t)(kr + 8 * i) * N + n4 * 4);
            __syncthreads();
#pragma unroll
            for (int i = 0; i < 8; ++i) { float* q = fl + (kr + 8 * i) * 257 + n4 * 4; q[0] = rg[i].x; q[1] = rg[i].y; q[2] = rg[i].z; q[3] = rg[i].w; }
            __syncthreads();
#pragma unroll
            for (int j = 0; j < 4; ++j) {
                const int n = nl + 64 * j;
                const float* q = fl + (8 * kg) * 257 + n;
                u32x4 w;
                w.x = cvtpk(q[0], q[257]); w.y = cvtpk(q[2 * 257], q[3 * 257]); w.z = cvtpk(q[4 * 257], q[5 * 257]); w.w = cvtpk(q[6 * 257], q[7 * 257]);
                *(u32x4*)(dst + (size_t)(n0 + n) * K + 8 * kg) = w;
            }
        }
    } else {
        const int n_gu = 64 * 16 * 8, n_dn = 64 * 8 * 8, total = n_gu + n_dn;
        const int kr = tid >> 5, n4 = tid & 31, kg = (tid >> 3) & 7, nl = (tid & 7) + 8 * (tid >> 6);
        float4 rg[8];
        const float* src = nullptr; unsigned char* dst = nullptr; int N = 0, K = 0, n0 = 0, perm = 0;
        const float* nsrc = nullptr; unsigned char* ndst = nullptr; int nN = 0, nK = 0, nn0 = 0, nperm = 0;
#define TR_DECODE(IT, SRC, DST, NN, KK, N0, PERM) do { int i_ = (IT); const float* W_; unsigned char* Wt_; \
        if (i_ < n_gu) { W_ = p.w_gu; Wt_ = p.WguT; NN = 2048; KK = D; PERM = 1; } else { i_ -= n_gu; W_ = p.w_down; Wt_ = p.WdnT; NN = D; KK = FF; PERM = 0; } \
        const int ntn_ = NN / 128, per_ = ntn_ * (KK / 128), m_ = i_ / per_, r_ = i_ % per_, tn_ = r_ % ntn_, tk_ = r_ / ntn_; \
        N0 = tn_ * 128; SRC = W_ + (size_t)m_ * KK * NN + (size_t)(tk_ * 128) * NN + N0; DST = Wt_ + (size_t)m_ * KK * NN + tk_ * 128; } while (0)
        int it = blockIdx.x;
        if (it < total) {
            TR_DECODE(it, src, dst, N, K, n0, perm);
#pragma unroll
            for (int i = 0; i < 8; ++i) rg[i] = *(const float4*)(src + (size_t)(kr + 16 * i) * N + n4 * 4);
        }
        for (; it < total; it += gridDim.x) {
            __syncthreads();
#pragma unroll
            for (int i = 0; i < 8; ++i) { float* q = fl + (kr + 16 * i) * 129 + n4 * 4; q[0] = rg[i].x; q[1] = rg[i].y; q[2] = rg[i].z; q[3] = rg[i].w; }
            __syncthreads();
            const int nit = it + gridDim.x;
            if (nit < total) {
                TR_DECODE(nit, nsrc, ndst, nN, nK, nn0, nperm);
#pragma unroll
                for (int i = 0; i < 8; ++i) rg[i] = *(const float4*)(nsrc + (size_t)(kr + 16 * i) * nN + n4 * 4);
            }
#pragma unroll
            for (int j = 0; j < 2; ++j) {
                const int n = nl + 64 * j;
                const float* q = fl + (16 * kg) * 129 + n;
                u32x4 w;
#pragma unroll
                for (int d = 0; d < 4; ++d) {
                    unsigned r = __builtin_amdgcn_cvt_pk_fp8_f32(q[(4 * d) * 129] * 64.f, q[(4 * d + 1) * 129] * 64.f, 0u, false);
                    w[d] = __builtin_amdgcn_cvt_pk_fp8_f32(q[(4 * d + 2) * 129] * 64.f, q[(4 * d + 3) * 129] * 64.f, r, true);
                }
                const int ng = n0 + n;
                const int np = perm ? ((ng & (N / 2 - 1)) >> 7) * 256 + (ng >= N / 2 ? 128 : 0) + (ng & 127) : ng;
                *(u32x4*)(dst + (size_t)np * K + 16 * kg) = w;
            }
            src = nsrc; dst = ndst; N = nN; K = nK; n0 = nn0; perm = nperm;
        }
#undef TR_DECODE
    }
}

__device__ __forceinline__ void ph_norm1(const P& p, int l) {
    const int wave = ltid() >> 6, lane = ltid() & 63;
    for (int row = blockIdx.x * 8 + wave; row < R; row += gridDim.x * 8) {
        const float* xr = row < T ? p.x + (size_t)row * D : p.ctx + (size_t)(row - T) * D;
        float4 v[4]; float ss = 0;
#pragma unroll
        for (int i = 0; i < 4; ++i) { v[i] = *(const float4*)(xr + lane * 4 + 256 * i); ss += v[i].x * v[i].x + v[i].y * v[i].y + v[i].z * v[i].z + v[i].w * v[i].w; }
        ss = wave_sum(ss);
        const float rstd = rsqrtf(ss * (1.f / D) + EPS);
        const float* m = p.mod + ((size_t)l * 5 + mod_row(row)) * 6144;
        const float* g = p.g_mix + l * D;
#pragma unroll
        for (int i = 0; i < 4; ++i) {
            const int k = lane * 4 + 256 * i;
            const float4 gg = *(const float4*)(g + k), sh = *(const float4*)(m + k), sc = *(const float4*)(m + 1024 + k);
            uint2 o;
            o.x = cvtpk(v[i].x * rstd * gg.x * (1.f + sc.x) + sh.x, v[i].y * rstd * gg.y * (1.f + sc.y) + sh.y);
            o.y = cvtpk(v[i].z * rstd * gg.z * (1.f + sc.z) + sh.z, v[i].w * rstd * gg.w * (1.f + sc.w) + sh.w);
            *(uint2*)(p.H + (size_t)row * D + k) = o;
        }
    }
}

constexpr float QSCALE = 0.17677669529663687f * 1.4426950408889634f;
__device__ __forceinline__ void dsoftmax(const f32x16& s, float& m, float& l, f32x16& o0, f32x16& o1, bf16x8& pa, bf16x8& pb) {
    float mx = fmaxf(fmaxf(fmaxf(s[0], s[1]), fmaxf(s[2], s[3])), fmaxf(fmaxf(s[4], s[5]), fmaxf(s[6], s[7])));
    mx = fmaxf(mx, fmaxf(fmaxf(fmaxf(s[8], s[9]), fmaxf(s[10], s[11])), fmaxf(fmaxf(s[12], s[13]), fmaxf(s[14], s[15]))));
    mx = xhalf_max(mx);
    if (__any(mx > m)) {
        const float mn = fmaxf(m, mx), alpha = __builtin_amdgcn_exp2f(m - mn);
        o0 *= alpha; o1 *= alpha; l *= alpha; m = mn;
    }
    float pr[16]; float sum = 0.f;
#pragma unroll
    for (int r = 0; r < 16; ++r) { pr[r] = __builtin_amdgcn_exp2f(s[r] - m); sum += pr[r]; }
    l += sum;
    u32x4 a, b;
    a[0] = cvtpk(pr[0], pr[1]); a[1] = cvtpk(pr[2], pr[3]); a[2] = cvtpk(pr[4], pr[5]); a[3] = cvtpk(pr[6], pr[7]);
    b[0] = cvtpk(pr[8], pr[9]); b[1] = cvtpk(pr[10], pr[11]); b[2] = cvtpk(pr[12], pr[13]); b[3] = cvtpk(pr[14], pr[15]);
    pa = __builtin_bit_cast(bf16x8, a); pb = __builtin_bit_cast(bf16x8, b);
}
#define MX3(a, b, c) __builtin_fmaxf(__builtin_fmaxf((a), (b)), (c))
template <int THR>
__device__ __forceinline__ void dsoftmax2(f32x16& s, float& m, float& l, f32x16& o0, f32x16& o1, bf16x8& pa, bf16x8& pb, const bool first) {
    float a = MX3(s[0], s[1], s[2]), b = MX3(s[3], s[4], s[5]);
    a = MX3(a, s[6], s[7]); b = MX3(b, s[8], s[9]); a = MX3(a, s[10], s[11]); b = MX3(b, s[12], s[13]); a = MX3(a, s[14], s[15]);
    const float mx = xhalf_max(__builtin_fmaxf(a, b));
    if (first || __any(mx > m + (float)THR)) {
        const float mn = first ? mx : __builtin_fmaxf(mx, m), alpha = first ? 1.f : __builtin_amdgcn_exp2f(m - mn);
        m = mn; o0 *= alpha; o1 *= alpha; l *= alpha;
    }
    float sum = 0.f;
#pragma unroll
    for (int r = 0; r < 16; ++r) { s[r] = __builtin_amdgcn_exp2f(s[r] - m); sum += s[r]; }
    l += sum;
    u32x4 wa, wb;
    wa[0] = cvtpk(s[0], s[1]); wa[1] = cvtpk(s[2], s[3]); wa[2] = cvtpk(s[4], s[5]); wa[3] = cvtpk(s[6], s[7]);
    wb[0] = cvtpk(s[8], s[9]); wb[1] = cvtpk(s[10], s[11]); wb[2] = cvtpk(s[12], s[13]); wb[3] = cvtpk(s[14], s[15]);
    pa = __builtin_bit_cast(bf16x8, wa); pb = __builtin_bit_cast(bf16x8, wb);
}
__device__ __forceinline__ void ph_dattn(const P& p, int l, int nrows, char* lds) {
    const int tid = ltid(), lane = tid & 63, wid = tid >> 6, r32 = lane & 31, hi = lane >> 5;
    float la = lane < 32 ? p.lam_q1[l * 32 + lane] * p.lam_k1[l * 32 + lane] : 0.f;
    float lb = lane < 32 ? p.lam_q2[l * 32 + lane] * p.lam_k2[l * 32 + lane] : 0.f;
    la = wave_sum(la); lb = wave_sum(lb);
    const float lam_init = 0.8f - 0.6f * expf(-0.3f * (float)l);
    const float lam = expf(la) - expf(lb) + lam_init;
    const bf16_t* PR = p.PROJ;
    const int nunits = (nrows == R) ? 256 + 16 : 256;
    const int skey = 8 * wid + (lane & 7), schunk = lane >> 3;
    const int ldsK = schunk * 1024 + skey * 16;
    const int ldsV = 8192 + (schunk >> 2) * 4096 + (skey >> 3) * 512 + (skey & 7) * 64 + (schunk & 3) * 16;
    const int vb = ((lane >> 4) & 1) * 32 + (lane & 3) * 8 + (4 * hi + ((lane & 15) >> 2)) * 64;
    for (int uu = blockIdx.x; uu < nunits; uu += gridDim.x) {
        int b, h, q0, nt; bool isctx;
        if (uu < 256) { const int u = (uu & 7) * 32 + (uu >> 3); b = u >> 6; h = (u >> 4) & 3; q0 = b * 4096 + (u & 15) * 256; nt = 68; isctx = false; }
        else { const int v = uu - 256; b = v >> 2; h = v & 3; q0 = T + b * 256; nt = 4; isctx = true; }
        bf16x8 qf[4];
        {
            const bf16_t* qp = PR + (size_t)(q0 + wid * 32 + r32) * PW + h * 64 + hi * 8;
#pragma unroll
            for (int ks = 0; ks < 4; ++ks) qf[ks] = *(const bf16x8*)(qp + ks * 16);
        }
        f32x16 O00, O01, O10, O11, zero16;
#pragma unroll
        for (int r = 0; r < 16; ++r) { O00[r] = 0.f; O01[r] = 0.f; O10[r] = 0.f; O11[r] = 0.f; zero16[r] = 0.f; }
        float m1 = 0.f, m2 = 0.f, l1 = 0.f, l2 = 0.f;
        const size_t gK = 256 + h * 64 + schunk * 8, gV = 512 + h * 64 + schunk * 8;
        uint4 rk, rv;
        {
            const int kr = (isctx ? T + b * 256 : b * 4096) + skey;
            rk = *(const uint4*)(PR + (size_t)kr * PW + gK); rv = *(const uint4*)(PR + (size_t)kr * PW + gV);
        }
        __syncthreads();
        *(uint4*)(lds + ldsK) = rk; *(uint4*)(lds + ldsV) = rv;
        __syncthreads();
#pragma unroll 1
        for (int t = 0; t < nt; ++t) {
            char* buf = lds + (t & 1) * 16384;
            if (t + 1 < nt) {
                const int tn = t + 1;
                const int kr = ((isctx || tn >= 64) ? T + b * 256 + (isctx ? tn : tn - 64) * 64 : b * 4096 + tn * 64) + skey;
                rk = *(const uint4*)(PR + (size_t)kr * PW + gK); rv = *(const uint4*)(PR + (size_t)kr * PW + gV);
            }
            {
                typedef const __attribute__((address_space(3))) bf16x8* kfp_t;
                const lds_cptr kp = (lds_cptr)buf + hi * 1024 + r32 * 16;
                const lds_cptr vp = (lds_cptr)buf + 8192 + vb;
                bf16x8 kf0 = *(kfp_t)(kp), kf1 = *(kfp_t)(kp + 2048), kf2 = *(kfp_t)(kp + 4096), kf3 = *(kfp_t)(kp + 6144);
#pragma unroll
                for (int kb = 0; kb < 2; ++kb) {
                    f32x16 s1 = __builtin_amdgcn_mfma_f32_32x32x16_bf16(kf0, qf[0], zero16, 0, 0, 0);
                    f32x16 s2 = __builtin_amdgcn_mfma_f32_32x32x16_bf16(kf2, qf[2], zero16, 0, 0, 0);
                    s1 = __builtin_amdgcn_mfma_f32_32x32x16_bf16(kf1, qf[1], s1, 0, 0, 0);
                    s2 = __builtin_amdgcn_mfma_f32_32x32x16_bf16(kf3, qf[3], s2, 0, 0, 0);
                    s16x4 vlo[4], vhi[4];
#pragma unroll
                    for (int i = 0; i < 4; ++i) { vlo[i] = vtr(vp + kb * 2048 + (i >> 1) * 4096 + (i & 1) * 1024); vhi[i] = vtr(vp + kb * 2048 + (i >> 1) * 4096 + (i & 1) * 1024 + 512); }
                    if (kb == 0) { kf0 = *(kfp_t)(kp + 512); kf1 = *(kfp_t)(kp + 512 + 2048); kf2 = *(kfp_t)(kp + 512 + 4096); kf3 = *(kfp_t)(kp + 512 + 6144); }
                    __builtin_amdgcn_sched_barrier(0);
                    const bool first = (t == 0) && (kb == 0);
                    bf16x8 p1a, p1b, p2a, p2b;
                    dsoftmax2<8>(s1, m1, l1, O00, O01, p1a, p1b, first);
                    dsoftmax2<8>(s2, m2, l2, O10, O11, p2a, p2b, first);
#pragma unroll
                    for (int i = 0; i < 4; ++i) {
                        const bf16x8 va = (bf16x8){vlo[i][0], vlo[i][1], vlo[i][2], vlo[i][3], vhi[i][0], vhi[i][1], vhi[i][2], vhi[i][3]};
                        if (i < 2) { O00 = __builtin_amdgcn_mfma_f32_32x32x16_bf16(va, (i & 1) ? p1b : p1a, O00, 0, 0, 0); O10 = __builtin_amdgcn_mfma_f32_32x32x16_bf16(va, (i & 1) ? p2b : p2a, O10, 0, 0, 0); }
                        else       { O01 = __builtin_amdgcn_mfma_f32_32x32x16_bf16(va, (i & 1) ? p1b : p1a, O01, 0, 0, 0); O11 = __builtin_amdgcn_mfma_f32_32x32x16_bf16(va, (i & 1) ? p2b : p2a, O11, 0, 0, 0); }
                    }
                }
            }
            if (t + 1 < nt) { char* nb = lds + ((t + 1) & 1) * 16384; *(uint4*)(nb + ldsK) = rk; *(uint4*)(nb + ldsV) = rv; }
            __syncthreads();
        }
        l1 = xhalf_sum(l1); l2 = xhalf_sum(l2);
        const float i1 = 1.f / l1, i2 = lam / l2;
        float ss = 0.f;
#pragma unroll
        for (int r = 0; r < 16; ++r) { O00[r] = O00[r] * i1 - O10[r] * i2; O01[r] = O01[r] * i1 - O11[r] * i2; ss += O00[r] * O00[r] + O01[r] * O01[r]; }
        ss = xhalf_sum(ss);
        const float rstd = rsqrtf(ss * (1.f / 64.f) + EPS) * (1.f - lam_init);
        const float* gs = p.g_sub + l * 64;
        bf16_t* op = p.MIX + (size_t)(q0 + wid * 32 + r32) * D + h * 64;
#pragma unroll
        for (int g4 = 0; g4 < 4; ++g4) {
            const int d = 8 * g4 + 4 * hi;
            const float4 ga = *(const float4*)(gs + d), gb = *(const float4*)(gs + 32 + d);
            uint2 wa, wb;
            wa.x = cvtpk(O00[4 * g4] * rstd * ga.x, O00[4 * g4 + 1] * rstd * ga.y); wa.y = cvtpk(O00[4 * g4 + 2] * rstd * ga.z, O00[4 * g4 + 3] * rstd * ga.w);
            wb.x = cvtpk(O01[4 * g4] * rstd * gb.x, O01[4 * g4 + 1] * rstd * gb.y); wb.y = cvtpk(O01[4 * g4 + 2] * rstd * gb.z, O01[4 * g4 + 3] * rstd * gb.w);
            *(uint2*)(op + d) = wa; *(uint2*)(op + 32 + d) = wb;
        }
    }
}

__device__ __forceinline__ void ph_na(const P& p, int l, int nrows, char* lds) {
    const int tid = ltid(), lane = tid & 63, wid = tid >> 6, r32 = lane & 31, hi = lane >> 5;
    const bf16_t* PR = p.PROJ;
    const int nunits = (nrows == R) ? 256 + 16 : 256;
    const int skey = 8 * wid + (lane & 7), schunk = lane >> 3;
    const int ldsK = schunk * 1024 + skey * 16;
    const int ldsV = 8192 + (schunk >> 2) * 4096 + (skey >> 3) * 512 + (skey & 7) * 64 + (schunk & 3) * 16;
    const int vb = ((lane >> 4) & 1) * 32 + (lane & 3) * 8 + (4 * hi + ((lane & 15) >> 2)) * 64;
    float* btab = (float*)(lds + 32768);
    constexpr float LOG2E = 1.4426950408889634f;
    for (int uu = (blockIdx.x + gridDim.x - 16) % gridDim.x; uu < nunits; uu += gridDim.x) {
        int b, h, q0, kr_lo, nlat, rs = 0, rq = 0; bool isctx;
        if (uu < 256) {
            const int u = (uu & 7) * 32 + (uu >> 3); b = u >> 6; h = (u >> 4) & 3; const int rg = u & 15;
            rq = 4 * rg + (wid >> 1); q0 = b * 4096 + rq * 64 + (wid & 1) * 32;
            kr_lo = min(max(4 * rg - 4, 0), 56); const int kr_hi = min(max(4 * rg - 1, 0), 56) + 7; nlat = kr_hi - kr_lo + 1;
            rs = min(max(rq - 4, 0), 56); isctx = false;
        } else { const int v = uu - 256; b = v >> 2; h = v & 3; q0 = T + b * 256 + wid * 32; kr_lo = 0; nlat = 0; isctx = true; }
        const int nt = nlat + 4;
        const int cq = (wid & 1) * 32 + r32, wsc = min(max(cq - 8, 0), 48);
        bf16x8 qf[4];
        {
            const bf16_t* qp = PR + (size_t)(q0 + r32) * PW + 1536 + h * 64 + hi * 8;
#pragma unroll
            for (int ks = 0; ks < 4; ++ks) qf[ks] = *(const bf16x8*)(qp + ks * 16);
        }
        f32x16 O0, O1;
#pragma unroll
        for (int r = 0; r < 16; ++r) { O0[r] = 0.f; O1[r] = 0.f; }
        float m1 = -1e30f, l1 = 0.f;
        const size_t gK = 1792 + h * 64 + schunk * 8, gV = 2048 + h * 64 + schunk * 8;
        uint4 rk, rv;
        {
            const int kr = (nlat ? b * 4096 + kr_lo * 64 : T + b * 256) + skey;
            rk = *(const uint4*)(PR + (size_t)kr * PW + gK); rv = *(const uint4*)(PR + (size_t)kr * PW + gV);
        }
        __syncthreads();
        *(uint4*)(lds + ldsK) = rk; *(uint4*)(lds + ldsV) = rv;
        if (tid < 465) btab[tid] = p.rpb[((size_t)l * 4 + h) * 465 + tid] * LOG2E;
        __syncthreads();
        for (int t = 0; t < nt; ++t) {
            char* buf = lds + (t & 1) * 16384;
            if (t + 1 < nt) {
                const int tn = t + 1;
                const int kr = (tn < nlat ? b * 4096 + (kr_lo + tn) * 64 : T + b * 256 + (tn - nlat) * 64) + skey;
                rk = *(const uint4*)(PR + (size_t)kr * PW + gK); rv = *(const uint4*)(PR + (size_t)kr * PW + gV);
            }
            const bool lat = t < nlat;
            const int krow = kr_lo + t;
            const bool active = !lat || (krow >= rs && krow <= rs + 7);
            if (active) {
                const float* brow = btab + (krow - rq + 7) * 31 + 15 - cq;
#pragma unroll
                for (int kb = 0; kb < 2; ++kb) {
                    const lds_cptr kp = (lds_cptr)buf + hi * 1024 + (kb * 32 + r32) * 16;
                    f32x16 s1;
#pragma unroll
                    for (int r = 0; r < 16; ++r) s1[r] = 0.f;
#pragma unroll
                    for (int ks = 0; ks < 4; ++ks) {
                        const bf16x8 kf = *(const __attribute__((address_space(3))) bf16x8*)(kp + ks * 2048);
                        s1 = __builtin_amdgcn_mfma_f32_32x32x16_bf16(kf, qf[ks], s1, 0, 0, 0);
                    }
                    if (lat) {
#pragma unroll
                        for (int r = 0; r < 16; ++r) {
                            const int kc = 32 * kb + (r & 3) + 8 * (r >> 2) + 4 * hi;
                            const bool ok = (unsigned)(kc - wsc) < 16u;
                            const float bv = brow[ok ? kc : cq];
                            s1[r] = ok ? s1[r] + bv : -INFINITY;
                        }
                    }
                    bf16x8 pa, pb;
                    dsoftmax(s1, m1, l1, O0, O1, pa, pb);
                    const lds_cptr vp = (lds_cptr)buf + 8192 + vb + kb * 2048;
#pragma unroll
                    for (int ss = 0; ss < 2; ++ss) {
                        const s16x4 lo0 = vtr(vp + ss * 1024), hh0 = vtr(vp + ss * 1024 + 512);
                        const s16x4 lo1 = vtr(vp + 4096 + ss * 1024), hh1 = vtr(vp + 4096 + ss * 1024 + 512);
                        const bf16x8 va0 = (bf16x8){lo0[0], lo0[1], lo0[2], lo0[3], hh0[0], hh0[1], hh0[2], hh0[3]};
                        const bf16x8 va1 = (bf16x8){lo1[0], lo1[1], lo1[2], lo1[3], hh1[0], hh1[1], hh1[2], hh1[3]};
                        O0 = __builtin_amdgcn_mfma_f32_32x32x16_bf16(va0, ss ? pb : pa, O0, 0, 0, 0);
                        O1 = __builtin_amdgcn_mfma_f32_32x32x16_bf16(va1, ss ? pb : pa, O1, 0, 0, 0);
                    }
                }
            }
            if (t + 1 < nt) { char* nb = lds + ((t + 1) & 1) * 16384; *(uint4*)(nb + ldsK) = rk; *(uint4*)(nb + ldsV) = rv; }
            __syncthreads();
        }
        l1 = xhalf_sum(l1);
        const float il = 1.f / l1;
        bf16_t* op = p.MIX + (size_t)(q0 + r32) * D + 768 + h * 64;
#pragma unroll
        for (int g4 = 0; g4 < 4; ++g4) {
            const int d = 8 * g4 + 4 * hi;
            uint2 wa, wb;
            wa.x = cvtpk(O0[4 * g4] * il, O0[4 * g4 + 1] * il); wa.y = cvtpk(O0[4 * g4 + 2] * il, O0[4 * g4 + 3] * il);
            wb.x = cvtpk(O1[4 * g4] * il, O1[4 * g4 + 1] * il); wb.y = cvtpk(O1[4 * g4 + 2] * il, O1[4 * g4 + 3] * il);
            *(uint2*)(op + d) = wa; *(uint2*)(op + 32 + d) = wb;
        }
    }
}

__device__ __forceinline__ void ph_pool(const P& p, int l, int nrows, char* lds) {
    const int tid = ltid(), lane = tid & 63, wid = tid >> 6, fr = lane & 15, fq = lane >> 4;
    float* ysh = (float*)lds;
    bf16_t* dsh = (bf16_t*)(lds + 80 * 256 * 4);
    const bf16_t* PR = p.PROJ;
    for (int it = (blockIdx.x + gridDim.x - 32) % gridDim.x; it < nrows / 64; it += gridDim.x) {
        const int row0 = it * 64;
        const int L = row0 < T ? 4096 : 256;
        const int t0 = row0 < T ? (row0 & 4095) : ((row0 - T) & 255);
        const int base = row0 - t0;
        __syncthreads();
        for (int c = tid; c < 80 * 32; c += NT) {
            const int rr = c >> 5, ch = (c & 31) * 8, t = t0 - 8 + rr;
            float4 a = make_float4(0.f, 0.f, 0.f, 0.f), b = a;
            if (t >= 0 && t < L) {
                const uint4 raw = *(const uint4*)(PR + (size_t)(base + t) * PW + 768 + ch);
                a = make_float4(__uint_as_float(raw.x << 16), __uint_as_float(raw.x & 0xffff0000u), __uint_as_float(raw.y << 16), __uint_as_float(raw.y & 0xffff0000u));
                b = make_float4(__uint_as_float(raw.z << 16), __uint_as_float(raw.z & 0xffff0000u), __uint_as_float(raw.w << 16), __uint_as_float(raw.w & 0xffff0000u));
            }
            *(float4*)(ysh + rr * 256 + ch) = a; *(float4*)(ysh + rr * 256 + ch + 4) = b;
        }
        __syncthreads();
        {
            const int r = tid >> 3, cg = tid & 7;
            const int g = cg >> 1, w = 2 << g, t = t0 + r;
            const int lo = max(t - w / 2, 0), hi = min(t + w / 2 - 1, L - 1);
            const float inv = 1.f / (float)(hi - lo + 1);
#pragma unroll
            for (int q = 0; q < 8; ++q) {
                const int ch = cg * 32 + q * 4;
                float4 s = make_float4(0.f, 0.f, 0.f, 0.f);
                for (int tt = lo; tt <= hi; ++tt) { const float4 v = *(const float4*)(ysh + (tt - t0 + 8) * 256 + ch); s.x += v.x; s.y += v.y; s.z += v.z; s.w += v.w; }
                const float4 y = *(const float4*)(ysh + (r + 8) * 256 + ch);
                uint2 o; o.x = cvtpk(s.x * inv - y.x, s.y * inv - y.y); o.y = cvtpk(s.z * inv - y.z, s.w * inv - y.w);
                *(uint2*)(dsh + r * 264 + ch) = o;
            }
        }
        __syncthreads();
        {
            const int g = wid >> 1, mb = (wid & 1) * 2;
            const bf16_t* W = p.WpT + ((size_t)l * 4 + g) * 64 * 64;
            f32x4 acc[2][4];
#pragma unroll
            for (int mt = 0; mt < 2; ++mt)
#pragma unroll
                for (int nt = 0; nt < 4; ++nt) acc[mt][nt] = (f32x4){0.f, 0.f, 0.f, 0.f};
#pragma unroll
            for (int ks = 0; ks < 2; ++ks) {
                bf16x8 af[2], bfr[4];
#pragma unroll
                for (int mt = 0; mt < 2; ++mt) af[mt] = *(const bf16x8*)(dsh + ((mb + mt) * 16 + fr) * 264 + g * 64 + ks * 32 + fq * 8);
#pragma unroll
                for (int nt = 0; nt < 4; ++nt) bfr[nt] = *(const bf16x8*)(W + (nt * 16 + fr) * 64 + ks * 32 + fq * 8);
#pragma unroll
                for (int mt = 0; mt < 2; ++mt)
#pragma unroll
                    for (int nt = 0; nt < 4; ++nt) acc[mt][nt] = __builtin_amdgcn_mfma_f32_16x16x32_bf16(bfr[nt], af[mt], acc[mt][nt], 0, 0, 0);
            }
#pragma unroll
            for (int mt = 0; mt < 2; ++mt)
#pragma unroll
                for (int nt = 0; nt < 4; ++nt) {
                    const int row = row0 + (mb + mt) * 16 + fr, j = g * 64 + nt * 16 + fq * 4;
                    const float4 sp = *(const float4*)(p.s_pool + l * 256 + j);
                    uint2 o; o.x = cvtpk(acc[mt][nt][0] * sp.x, acc[mt][nt][1] * sp.y); o.y = cvtpk(acc[mt][nt][2] * sp.z, acc[mt][nt][3] * sp.w);
                    *(uint2*)(p.MIX + (size_t)row * D + 256 + j) = o;
                }
        }
    }
}

__device__ __forceinline__ float gelu_fast(float x) {
    const float u = 0.7978845608028654f * (x + 0.044715f * x * x * x);
    return x / (1.f + __builtin_amdgcn_exp2f(-2.885390081777927f * u));
}
__device__ __forceinline__ void ph_sgu(const P& p, int l, int nrows, char* lds) {
    const int tid = ltid(), lane = tid & 63, wid = tid >> 6, fr = lane & 15, fq = lane >> 4;
    bf16_t* vnT = (bf16_t*)lds;
    float* rstd = (float*)(lds + 128 * 136 * 2);
    const bf16_t* PR = p.PROJ;
    for (int it = (blockIdx.x + gridDim.x - 48) % gridDim.x; it < (nrows / 128) * 2; it += gridDim.x) {
        const int chunk = it >> 1, hp = it & 1, row0 = chunk * 128;
        __syncthreads();
        {
            const int t = tid >> 2, qtr = tid & 3;
            const bf16_t* zp = PR + (size_t)(row0 + t) * PW + 1280 + qtr * 64;
            float ss = 0.f;
#pragma unroll
            for (int i = 0; i < 8; ++i) {
                const uint4 raw = *(const uint4*)(zp + i * 8);
                const unsigned w4[4] = {raw.x, raw.y, raw.z, raw.w};
#pragma unroll
                for (int j = 0; j < 4; ++j) { const float a = __uint_as_float(w4[j] << 16), b = __uint_as_float(w4[j] & 0xffff0000u); ss += a * a + b * b; }
            }
            ss += __shfl_xor(ss, 1); ss += __shfl_xor(ss, 2);
            if (qtr == 0) rstd[t] = rsqrtf(ss * (1.f / 256.f) + EPS);
        }
        __syncthreads();
        {
            const int s = tid >> 2, cb = (tid & 3) * 32;
            const bf16_t* zp = PR + (size_t)(row0 + s) * PW + 1280 + hp * 128 + cb;
            const float rs = rstd[s];
            const float* gg = p.g_sgu + l * 256 + hp * 128 + cb;
#pragma unroll
            for (int i = 0; i < 4; ++i) {
                const uint4 raw = *(const uint4*)(zp + i * 8);
                const unsigned w4[4] = {raw.x, raw.y, raw.z, raw.w};
#pragma unroll
                for (int j = 0; j < 4; ++j) {
                    const int c = cb + i * 8 + j * 2;
                    vnT[c * 136 + s] = f2bf(__uint_as_float(w4[j] << 16) * rs * gg[i * 8 + j * 2]);
                    vnT[(c + 1) * 136 + s] = f2bf(__uint_as_float(w4[j] & 0xffff0000u) * rs * gg[i * 8 + j * 2 + 1]);
                }
            }
        }
        __syncthreads();
        {
            const int hl = wid >> 2, g = hp * 2 + hl, mb = (wid & 3) * 2;
            const bf16_t* Wg = p.WsB + ((size_t)l * 4 + g) * 128 * 128;
            f32x4 acc[2][4];
#pragma unroll
            for (int mt = 0; mt < 2; ++mt)
#pragma unroll
                for (int nt = 0; nt < 4; ++nt) acc[mt][nt] = (f32x4){0.f, 0.f, 0.f, 0.f};
#pragma unroll
            for (int ks = 0; ks < 4; ++ks) {
                bf16x8 af[2], bfr[4];
#pragma unroll
                for (int mt = 0; mt < 2; ++mt) af[mt] = *(const bf16x8*)(Wg + ((mb + mt) * 16 + fr) * 128 + ks * 32 + fq * 8);
#pragma unroll
                for (int nt = 0; nt < 4; ++nt) bfr[nt] = *(const bf16x8*)(vnT + (hl * 64 + nt * 16 + fr) * 136 + ks * 32 + fq * 8);
#pragma unroll
                for (int mt = 0; mt < 2; ++mt)
#pragma unroll
                    for (int nt = 0; nt < 4; ++nt) acc[mt][nt] = __builtin_amdgcn_mfma_f32_16x16x32_bf16(bfr[nt], af[mt], acc[mt][nt], 0, 0, 0);
            }
#pragma unroll
            for (int mt = 0; mt < 2; ++mt) {
                const int t = (mb + mt) * 16 + fr;
                const float bias = p.b_sgu[(l * 4 + g) * 128 + t];
#pragma unroll
                for (int nt = 0; nt < 4; ++nt) {
                    const int c = g * 64 + nt * 16 + fq * 4;
                    const uint2 ur = *(const uint2*)(PR + (size_t)(row0 + t) * PW + 1024 + c);
                    const float u0 = __uint_as_float(ur.x << 16), u1 = __uint_as_float(ur.x & 0xffff0000u);
                    const float u2 = __uint_as_float(ur.y << 16), u3 = __uint_as_float(ur.y & 0xffff0000u);
                    uint2 o; o.x = cvtpk(u0 * (acc[mt][nt][0] + bias), u1 * (acc[mt][nt][1] + bias)); o.y = cvtpk(u2 * (acc[mt][nt][2] + bias), u3 * (acc[mt][nt][3] + bias));
                    *(uint2*)(p.MIX + (size_t)(row0 + t) * D + 512 + c) = o;
                }
            }
        }
    }
}

__device__ __forceinline__ void ph_router(const P& p, int l, int nrows, char* lds) {
    const int tid = ltid(), wave = tid >> 6, lane = tid & 63;
    float* wl = (float*)lds;
    float* wsc = (float*)(lds + 1024 * 36 * 4) + wave * 64;
    int* lcnt = (int*)(lds + 1024 * 36 * 4 + 8 * 64 * 4);
    __syncthreads();
    {
        const float* wr = p.w_router + (size_t)l * D * NE;
        float4 t[16];
#pragma unroll
        for (int i = 0; i < 16; ++i) t[i] = *(const float4*)(wr + (size_t)(tid + NT * i) * 4);
#pragma unroll
        for (int i = 0; i < 16; ++i) { const int idx = (tid + NT * i) * 4, k = idx >> 5, e = idx & 31; *(float4*)(wl + ((k & 3) * 256 + (k >> 2)) * 36 + e) = t[i]; }
        if (tid < 32) lcnt[tid] = 0;
    }
    __syncthreads();
    const float* g = p.g_ffn + l * D;
    const float brt = p.b_router[l * NE + (lane & 31)];
    for (int pr = blockIdx.x * 8 + wave; pr < nrows / 2; pr += gridDim.x * 8) {
        const int ra = 2 * pr;
        const float* xa = p.X + (size_t)ra * D; const float* xb = xa + D;
        float ha[16], hb[16]; float sa = 0.f, sb = 0.f;
#pragma unroll
        for (int i = 0; i < 4; ++i) {
            const float4 va = *(const float4*)(xa + 4 * (lane + 64 * i)), vb = *(const float4*)(xb + 4 * (lane + 64 * i));
            ha[4 * i] = va.x; ha[4 * i + 1] = va.y; ha[4 * i + 2] = va.z; ha[4 * i + 3] = va.w; hb[4 * i] = vb.x; hb[4 * i + 1] = vb.y; hb[4 * i + 2] = vb.z; hb[4 * i + 3] = vb.w;
            sa += va.x * va.x + va.y * va.y + va.z * va.z + va.w * va.w; sb += vb.x * vb.x + vb.y * vb.y + vb.z * vb.z + vb.w * vb.w;
        }
        sa = wave_sum(sa); sb = wave_sum(sb);
        const float rsa = rsqrtf(sa * (1.f / D) + EPS), rsb = rsqrtf(sb * (1.f / D) + EPS);
        const float* m = p.mod + ((size_t)l * 5 + mod_row(ra)) * 6144;
#pragma unroll
        for (int i = 0; i < 4; ++i) {
            const int k = 4 * (lane + 64 * i);
            const float4 gg = *(const float4*)(g + k), sc = *(const float4*)(m + 4 * 1024 + k), sh = *(const float4*)(m + 3 * 1024 + k);
            const float gs[4] = {gg.x * (1.f + sc.x), gg.y * (1.f + sc.y), gg.z * (1.f + sc.z), gg.w * (1.f + sc.w)}, s4[4] = {sh.x, sh.y, sh.z, sh.w};
#pragma unroll
            for (int j = 0; j < 4; ++j) { ha[4 * i + j] = ha[4 * i + j] * rsa * gs[j] + s4[j]; hb[4 * i + j] = hb[4 * i + j] * rsb * gs[j] + s4[j]; }
            uint2 oa, ob; oa.x = cvtpk(ha[4 * i], ha[4 * i + 1]); oa.y = cvtpk(ha[4 * i + 2], ha[4 * i + 3]); ob.x = cvtpk(hb[4 * i], hb[4 * i + 1]); ob.y = cvtpk(hb[4 * i + 2], hb[4 * i + 3]);
            *(uint2*)(p.H + (size_t)ra * D + k) = oa; *(uint2*)(p.H + (size_t)(ra + 1) * D + k) = ob;
        }
        float la[32], lb[32];
#pragma unroll
        for (int e = 0; e < 32; ++e) { la[e] = 0.f; lb[e] = 0.f; }
#pragma unroll
        for (int i = 0; i < 4; ++i)
#pragma unroll
            for (int j = 0; j < 4; ++j) {
                const float* wk = wl + (j * 256 + lane + 64 * i) * 36;
                const float xv = ha[4 * i + j], yv = hb[4 * i + j];
#pragma unroll
                for (int e = 0; e < 32; e += 4) {
                    const float4 w = *(const float4*)(wk + e);
                    la[e] += xv * w.x; la[e + 1] += xv * w.y; la[e + 2] += xv * w.z; la[e + 3] += xv * w.w;
                    lb[e] += yv * w.x; lb[e + 1] += yv * w.y; lb[e + 2] += yv * w.z; lb[e + 3] += yv * w.w;
                }
            }
        float r32v[32];
        {
            const bool up = lane >= 32;
#pragma unroll
            for (int e = 0; e < 32; ++e) { const float keep = up ? lb[e] : la[e], send = up ? la[e] : lb[e]; r32v[e] = keep + __shfl_xor(send, 32); }
        }
        float r16[16], r8[8], r4[4], r2[2];
        { const bool up = (lane & 16) != 0;
#pragma unroll
          for (int e = 0; e < 16; ++e) { const float keep = up ? r32v[e + 16] : r32v[e], send = up ? r32v[e] : r32v[e + 16]; r16[e] = keep + __shfl_xor(send, 16); } }
        { const bool up = (lane & 8) != 0;
#pragma unroll
          for (int e = 0; e < 8; ++e) { const float keep = up ? r16[e + 8] : r16[e], send = up ? r16[e] : r16[e + 8]; r8[e] = keep + __shfl_xor(send, 8); } }
        { const bool up = (lane & 4) != 0;
#pragma unroll
          for (int e = 0; e < 4; ++e) { const float keep = up ? r8[e + 4] : r8[e], send = up ? r8[e] : r8[e + 4]; r4[e] = keep + __shfl_xor(send, 4); } }
        { const bool up = (lane & 2) != 0;
#pragma unroll
          for (int e = 0; e < 2; ++e) { const float keep = up ? r4[e + 2] : r4[e], send = up ? r4[e] : r4[e + 2]; r2[e] = keep + __shfl_xor(send, 2); } }
        float mine;
        { const bool up = (lane & 1) != 0; const float keep = up ? r2[1] : r2[0], send = up ? r2[0] : r2[1]; mine = keep + __shfl_xor(send, 1); }
        wsc[lane] = mine + brt;
        float lg[32];
        {
            const float* wp = wsc + (lane & 32);
#pragma unroll
            for (int e = 0; e < 32; e += 4) { const float4 v = *(const float4*)(wp + e); lg[e] = v.x; lg[e + 1] = v.y; lg[e + 2] = v.z; lg[e + 3] = v.w; }
        }
        unsigned taken = 0u; float tv[4]; int ti[4];
#pragma unroll
        for (int k = 0; k < 4; ++k) {
            float best = -3.0e38f; int bi = 0;
#pragma unroll
            for (int e = 0; e < 32; ++e) { const bool ok = !((taken >> e) & 1u) && (lg[e] > best); best = ok ? lg[e] : best; bi = ok ? e : bi; }
            taken |= 1u << bi; tv[k] = best; ti[k] = bi;
        }
        const float e1 = __expf(tv[1] - tv[0]), e2 = __expf(tv[2] - tv[0]), e3 = __expf(tv[3] - tv[0]);
        const float inv = 1.f / (1.f + e1 + e2 + e3);
        if ((lane & 31) == 0) {
            const int row = ra + (lane >> 5);
            *(int4*)(p.topi + (size_t)row * 4) = make_int4(ti[0], ti[1], ti[2], ti[3]);
            *(float4*)(p.topg + (size_t)row * 4) = make_float4(inv, e1 * inv, e2 * inv, e3 * inv);
            atomicAdd(&lcnt[ti[0]], 1); atomicAdd(&lcnt[ti[1]], 1); atomicAdd(&lcnt[ti[2]], 1); atomicAdd(&lcnt[ti[3]], 1);
        }
    }
    __syncthreads();
    if (tid < 32 && lcnt[tid]) atomicAdd(&p.cnt[l * 64 + tid], lcnt[tid]);
}
__device__ __forceinline__ void ph_assign(const P& p, int l, int nrows, char* lds) {
    int* lcnt = (int*)lds; int* lbase = lcnt + 32; int* pst = lbase + 32; int* slots = pst + 32;
    const int tid = ltid(), wave = tid >> 6, lane = tid & 63;
    int* cnt = p.cnt + l * 64; int* cursor = cnt + 32;
    int* meta = p.moe_meta + l * 512;
    __syncthreads();
    if (tid == 0) { int a = 0; for (int e = 0; e < 32; ++e) { pst[e] = a; a += (cnt[e] + 255) & ~255; } if (blockIdx.x == 0) meta[0] = a >> 8; }
    __syncthreads();
    if (blockIdx.x == 0 && tid < 320) { int e = 0; for (int k = 1; k < 32; ++k) if (tid * 256 >= pst[k]) e = k; meta[1 + tid] = e; }
    const int blk0 = (blockIdx.x + gridDim.x - 64) % gridDim.x;
    for (int it = blk0; it < nrows / 64; it += gridDim.x) {
        __syncthreads();
        if (tid < 32) lcnt[tid] = 0;
        __syncthreads();
        if (wave == 0) {
            const int row = it * 64 + lane;
            const int4 ti = *(const int4*)(p.topi + (size_t)row * 4);
            const int r0 = atomicAdd(&lcnt[ti.x], 1), r1 = atomicAdd(&lcnt[ti.y], 1), r2 = atomicAdd(&lcnt[ti.z], 1), r3 = atomicAdd(&lcnt[ti.w], 1);
            __builtin_amdgcn_s_waitcnt(0xc07f);
            if (lane < 32) lbase[lane] = pst[lane] + (lcnt[lane] ? atomicAdd(&cursor[lane], lcnt[lane]) : 0);
            __builtin_amdgcn_s_waitcnt(0xc07f);
            const int4 sl = make_int4(lbase[ti.x] + r0, lbase[ti.y] + r1, lbase[ti.z] + r2, lbase[ti.w] + r3);
            *(int4*)(p.tok_slot + (size_t)row * 4) = sl;
            *(int4*)(slots + lane * 4) = sl;
        }
        __syncthreads();
        {
            const bf16_t* __restrict__ Hs = p.H; unsigned char* __restrict__ HSd = p.HS;
#define AS_LD(rr, A, B) const uint4 A = *(const uint4*)(Hs + (size_t)(it * 64 + wave * 8 + (rr)) * D + lane * 8), B = *(const uint4*)(Hs + (size_t)(it * 64 + wave * 8 + (rr)) * D + lane * 8 + 512)
#define AS_CV(V) make_uint2(__builtin_amdgcn_cvt_pk_fp8_f32(__uint_as_float(V.y << 16), __uint_as_float(V.y & 0xffff0000u), __builtin_amdgcn_cvt_pk_fp8_f32(__uint_as_float(V.x << 16), __uint_as_float(V.x & 0xffff0000u), 0u, false), true), \
                            __builtin_amdgcn_cvt_pk_fp8_f32(__uint_as_float(V.w << 16), __uint_as_float(V.w & 0xffff0000u), __builtin_amdgcn_cvt_pk_fp8_f32(__uint_as_float(V.z << 16), __uint_as_float(V.z & 0xffff0000u), 0u, false), true))
#define AS_ST(rr, A, B) do { const int4 s4 = *(const int4*)(slots + (wave * 8 + (rr)) * 4); const uint2 fa = AS_CV(A), fb = AS_CV(B); \
            unsigned char* d0 = HSd + (size_t)s4.x * D + lane * 8; *(uint2*)d0 = fa; *(uint2*)(d0 + 512) = fb; \
            unsigned char* d1 = HSd + (size_t)s4.y * D + lane * 8; *(uint2*)d1 = fa; *(uint2*)(d1 + 512) = fb; \
            unsigned char* d2 = HSd + (size_t)s4.z * D + lane * 8; *(uint2*)d2 = fa; *(uint2*)(d2 + 512) = fb; \
            unsigned char* d3 = HSd + (size_t)s4.w * D + lane * 8; *(uint2*)d3 = fa; *(uint2*)(d3 + 512) = fb; } while (0)
            AS_LD(0, a0, b0); AS_LD(1, a1, b1); AS_LD(2, a2, b2); AS_LD(3, a3, b3); AS_LD(4, a4, b4); AS_LD(5, a5, b5); AS_LD(6, a6, b6); AS_LD(7, a7, b7);
            AS_ST(0, a0, b0); AS_ST(1, a1, b1); AS_ST(2, a2, b2); AS_ST(3, a3, b3); AS_ST(4, a4, b4); AS_ST(5, a5, b5); AS_ST(6, a6, b6); AS_ST(7, a7, b7);
#undef AS_CV
#undef AS_LD
#undef AS_ST
        }
    }
}

struct EpiProj {
    static constexpr bool PERM = true, AFTER_DRAIN = false;
    bf16_t* O; const float* rope;
    __device__ __forceinline__ void operator()(const f32x4 (&acc)[2][2][4][2], const pg8::Unit& u, int wr, int wc, int fr, int fq) const {
        const int row0 = u.pm * 256 + wr * 64 + fr, col0 = u.pn * 256 + wc * 32 + 8 * fq;
        const bool do_rope = (u.pn < 2) && (u.pm < T / 256), do_gelu = (u.pn == 4) || (u.pn == 5);
        const float sc = u.pn == 0 ? QSCALE : (u.pn == 6 ? 0.125f * 1.4426950408889634f : 1.f);
        const float sgn = (fq & 1) ? 1.f : -1.f;
#pragma unroll
        for (int ai = 0; ai < 2; ++ai)
#pragma unroll
            for (int m = 0; m < 4; ++m) {
                const int row = row0 + ai * 128 + m * 16;
                bf16_t* rowp = O + (size_t)row * PW + col0;
                f32x4 cs[4];
                if (do_rope) {
                    const int s = row & 4095, pos = (fq >> 1) ? (s & 63) : (s >> 6);
                    const f32x4* rp = (const f32x4*)(rope + pos * 16);
                    cs[0] = rp[0]; cs[1] = rp[1]; cs[2] = rp[2]; cs[3] = rp[3];
                }
#pragma unroll
                for (int bj = 0; bj < 2; ++bj) {
                    f32x4 v0 = acc[ai][bj][m][0], v1 = acc[ai][bj][m][1];
                    if (do_rope) {
                        f32x4 b0, b1;
#pragma unroll
                        for (int j = 0; j < 4; ++j) { b0[j] = __shfl_xor(v0[j], 16); b1[j] = __shfl_xor(v1[j], 16); }
                        v0[0] = v0[0] * cs[0][0] + sgn * b0[0] * cs[0][1]; v0[1] = v0[1] * cs[0][2] + sgn * b0[1] * cs[0][3];
                        v0[2] = v0[2] * cs[1][0] + sgn * b0[2] * cs[1][1]; v0[3] = v0[3] * cs[1][2] + sgn * b0[3] * cs[1][3];
                        v1[0] = v1[0] * cs[2][0] + sgn * b1[0] * cs[2][1]; v1[1] = v1[1] * cs[2][2] + sgn * b1[1] * cs[2][3];
                        v1[2] = v1[2] * cs[3][0] + sgn * b1[2] * cs[3][1]; v1[3] = v1[3] * cs[3][2] + sgn * b1[3] * cs[3][3];
                    }
                    if (do_gelu) {
#pragma unroll
                        for (int j = 0; j < 4; ++j) { v0[j] = gelu_fast(v0[j]); v1[j] = gelu_fast(v1[j]); }
                    }
                    v0 = v0 * sc; v1 = v1 * sc;
                    u32x4 w; w.x = cvtpk(v0[0], v0[1]); w.y = cvtpk(v0[2], v0[3]); w.z = cvtpk(v1[0], v1[1]); w.w = cvtpk(v1[2], v1[3]);
                    *(u32x4*)(rowp + bj * 128) = w;
                }
            }
    }
};
struct EpiOut {
    static constexpr bool PERM = false, AFTER_DRAIN = false;
    float* X; const float* gate; const float* res_lat; const float* res_ctx;
    __device__ __forceinline__ void operator()(const f32x4 (&acc)[2][2][4][2], const pg8::Unit& u, int wr, int wc, int fr, int fq) const {
        const int row0 = u.pm * 256 + wr * 64 + fr, col0 = u.pn * 256 + wc * 32 + 4 * fq;
        const float* g = gate + (size_t)mod_row(u.pm * 256) * 6144 + col0;
        f32x4 gv[2][2];
#pragma unroll
        for (int bj = 0; bj < 2; ++bj)
#pragma unroll
            for (int n = 0; n < 2; ++n) gv[bj][n] = *(const f32x4*)(g + bj * 128 + n * 16);
#pragma unroll
        for (int ai = 0; ai < 2; ++ai)
#pragma unroll
            for (int m = 0; m < 4; ++m) { const size_t off = (size_t)(row0 + ai * 128 + m * 16) * D + col0; float* xp = X + off; const float* rp = (u.pm < T / 256 ? res_lat : res_ctx) + off;
#pragma unroll
                for (int bj = 0; bj < 2; ++bj)
#pragma unroll
                    for (int n = 0; n < 2; ++n) { *(f32x4*)(xp + bj * 128 + n * 16) = *(const f32x4*)(rp + bj * 128 + n * 16) + gv[bj][n] * acc[ai][bj][m][n]; } }
    }
};
__device__ __forceinline__ float swiglu(float g, float u) {
    const float gt = fminf(g, 7.0f), up = fminf(fmaxf(u, -7.0f), 7.0f);
    return (up + 1.0f) * gt * __builtin_amdgcn_rcpf(1.0f + __builtin_amdgcn_exp2f(-1.702f * 1.4426950408889634f * gt));
}
struct EpiAct {
    static constexpr bool PERM = true, AFTER_DRAIN = false;
    unsigned char* ACT; const float* bgu;
    __device__ __forceinline__ void operator()(const f32x4 (&acc)[2][2][4][2], const pg8::Unit& u, int wr, int wc, int fr, int fq) const {
        const int row0 = u.pm * 256 + wr * 64 + fr, j0 = u.pn * 128 + wc * 32 + 8 * fq;
        const float* bp = bgu + (size_t)u.e * 2048 + j0;
        const f32x4 bg0 = *(const f32x4*)(bp), bg1 = *(const f32x4*)(bp + 4), bu0 = *(const f32x4*)(bp + 1024), bu1 = *(const f32x4*)(bp + 1028);
#pragma unroll
        for (int ai = 0; ai < 2; ++ai)
#pragma unroll
            for (int m = 0; m < 4; ++m) {
                const f32x4 g0 = acc[ai][0][m][0] + bg0, g1 = acc[ai][0][m][1] + bg1, u0 = acc[ai][1][m][0] + bu0, u1 = acc[ai][1][m][1] + bu1;
                uint2 w;
                w.x = __builtin_amdgcn_cvt_pk_fp8_f32(swiglu(g0[2], u0[2]), swiglu(g0[3], u0[3]), __builtin_amdgcn_cvt_pk_fp8_f32(swiglu(g0[0], u0[0]), swiglu(g0[1], u0[1]), 0u, false), true);
                w.y = __builtin_amdgcn_cvt_pk_fp8_f32(swiglu(g1[2], u1[2]), swiglu(g1[3], u1[3]), __builtin_amdgcn_cvt_pk_fp8_f32(swiglu(g1[0], u1[0]), swiglu(g1[1], u1[1]), 0u, false), true);
                *(uint2*)(ACT + (size_t)(row0 + ai * 128 + m * 16) * FF + j0) = w;
            }
    }
};
struct EpiYB {
    static constexpr bool PERM = true, AFTER_DRAIN = false;
    bf16_t* YB; const float* bdn;
    __device__ __forceinline__ void operator()(const f32x4 (&acc)[2][2][4][2], const pg8::Unit& u, int wr, int wc, int fr, int fq) const {
        const int row0 = u.pm * 256 + wr * 64 + fr, col0 = u.pn * 256 + wc * 32 + 8 * fq;
        const float* bp = bdn + (size_t)u.e * D + col0;
        f32x4 bv[2][2];
#pragma unroll
        for (int bj = 0; bj < 2; ++bj)
#pragma unroll
            for (int n = 0; n < 2; ++n) bv[bj][n] = *(const f32x4*)(bp + bj * 128 + n * 4);
#pragma unroll
        for (int ai = 0; ai < 2; ++ai)
#pragma unroll
            for (int m = 0; m < 4; ++m) { bf16_t* rowp = YB + (size_t)(row0 + ai * 128 + m * 16) * D + col0;
#pragma unroll
                for (int bj = 0; bj < 2; ++bj) { const f32x4 v0 = acc[ai][bj][m][0] + bv[bj][0], v1 = acc[ai][bj][m][1] + bv[bj][1];
                    u32x4 w; w.x = cvtpk(v0[0], v0[1]); w.y = cvtpk(v0[2], v0[3]); w.z = cvtpk(v1[0], v1[1]); w.w = cvtpk(v1[2], v1[3]);
                    *(u32x4*)(rowp + bj * 128) = w; } }
    }
};
struct EpiDry {
    static constexpr bool PERM = true, AFTER_DRAIN = false;
    __device__ __forceinline__ void operator()(const f32x4 (&acc)[2][2][4][2], const pg8::Unit& u, int wr, int wc, int fr, int fq) const {
#pragma unroll
        for (int ai = 0; ai < 2; ++ai)
#pragma unroll
            for (int m = 0; m < 4; ++m)
#pragma unroll
                for (int bj = 0; bj < 2; ++bj) { asm volatile("" :: "v"(acc[ai][bj][m][0]), "v"(acc[ai][bj][m][1])); }
    }
};
struct MoeOrder {
    int nN, nunits, G, v; const int* tile_e;
    __device__ void init(int ntiles, int nN_, int G_, int c, const int* te) { nN = nN_; nunits = ntiles * nN_; G = G_; v = (G_ % 8 == 0) ? (c % 8) * (G_ / 8) + c / 8 : c; tile_e = te; }
    __device__ bool next(int i, pg8::Unit& u) const {
        const int L = i * G + v; if (L >= nunits) return false;
        u.pm = L / nN; u.pn = L % nN; u.e = tile_e[u.pm]; return true;
    }
    __device__ __forceinline__ const bf16_t* bt(const pg8::Gemm& g, const pg8::Unit& u) const { return g.Bt + (size_t)u.e * g.N * g.K; }
    __device__ __forceinline__ void a_ready(const pg8::Unit&) const {}
    __device__ __forceinline__ void done(const pg8::Unit&) const {}
};

__device__ __forceinline__ void ph_gemm_proj(const P& p, int l, char* lds) {
    pg8::Gemm g{p.H, p.WinT + (size_t)l * PW * D, R, PW, D}; pg8::StaticOrder S; S.init(R, PW, (int)gridDim.x, (int)blockIdx.x);
    EpiProj E{p.PROJ, p.rope};
    pg8::gemm_phase<EpiProj, pg8::StaticOrder, true, true>((PG8_LAS unsigned char*)lds, g, S, E);
}
__device__ __forceinline__ void ph_gemm_out(const P& p, int l, int nrows, char* lds) {
    pg8::Gemm g{p.MIX, p.WoutT + (size_t)l * D * D, T, D, D}; pg8::StaticOrder S; S.init(T, D, (int)gridDim.x, (int)blockIdx.x);
    EpiOut E{p.X, p.mod + (size_t)l * 5 * 6144 + 2 * 1024, l == 0 ? p.x : p.X, l == 0 ? p.ctx - (size_t)T * D : p.X};
    pg8::gemm_phase<EpiOut, pg8::StaticOrder, true, true>((PG8_LAS unsigned char*)lds, g, S, E);
    if (nrows > T) {
        const int tid = ltid(), lane = tid & 63, wid = tid >> 6, fr = lane & 15, fq = lane >> 4;
        const bf16_t* Wt = p.WoutT + (size_t)l * D * D;
        const float* gate = p.mod + ((size_t)l * 5 + 4) * 6144 + 2 * 1024;
        for (int it = blockIdx.x; it < (TC / 64) * (D / 64); it += gridDim.x) {
            const int m0 = T + (it >> 4) * 64 + (wid & 3) * 16, n0 = (it & 15) * 64 + (wid >> 2) * 32;
            const bf16_t* ap = p.MIX + (size_t)(m0 + fr) * D + fq * 8;
            const bf16_t* bp0 = Wt + (size_t)(n0 + fr) * D + fq * 8;
            const bf16_t* bp1 = bp0 + (size_t)16 * D;
            f32x4 acc0 = (f32x4){0.f, 0.f, 0.f, 0.f}, acc1 = acc0;
#pragma unroll 8
            for (int ks = 0; ks < D / 32; ++ks) {
                const bf16x8 af = *(const bf16x8*)(ap + ks * 32), b0 = *(const bf16x8*)(bp0 + ks * 32), b1 = *(const bf16x8*)(bp1 + ks * 32);
                acc0 = __builtin_amdgcn_mfma_f32_16x16x32_bf16(b0, af, acc0, 0, 0, 0);
                acc1 = __builtin_amdgcn_mfma_f32_16x16x32_bf16(b1, af, acc1, 0, 0, 0);
            }
            const int row = m0 + fr, c0 = n0 + fq * 4;
            const size_t off = (size_t)row * D + c0;
            const float* res = p.ctx - (size_t)T * D;
            *(f32x4*)(p.X + off) = *(const f32x4*)(res + off) + *(const f32x4*)(gate + c0) * acc0;
            *(f32x4*)(p.X + off + 16) = *(const f32x4*)(res + off + 16) + *(const f32x4*)(gate + c0 + 16) * acc1;
        }
    }
}
__device__ __forceinline__ void ph_moe1(const P& p, int l, char* lds, const bool dry = false) {
    const int* meta = p.moe_meta + l * 512;
    const int ntiles = meta[0];
    pg8::Gemm g{(const bf16_t*)p.HS, (const bf16_t*)(p.WguT + (size_t)l * NE * 2048 * D), ntiles * 256, 2048, D / 2}; MoeOrder S; S.init(ntiles, 8, (int)gridDim.x, (int)blockIdx.x, meta + 1);
    EpiAct E{p.ACT, p.b_gu + (size_t)l * NE * 2048};
    if (dry) { EpiDry ED; pg8::gemm_phase<EpiDry, MoeOrder, true, true, true>((PG8_LAS unsigned char*)lds, g, S, ED); }
    else pg8::gemm_phase<EpiAct, MoeOrder, true, true, true>((PG8_LAS unsigned char*)lds, g, S, E);
}
__device__ __forceinline__ void ph_moe2(const P& p, int l, char* lds) {
    const int* meta = p.moe_meta + l * 512;
    const int ntiles = meta[0];
    pg8::Gemm g{(const bf16_t*)p.ACT, (const bf16_t*)(p.WdnT + (size_t)l * NE * D * FF), ntiles * 256, D, FF / 2}; MoeOrder S; S.init(ntiles, 4, (int)gridDim.x, (int)blockIdx.x, meta + 1);
    EpiYB E{p.YB, p.b_down + (size_t)l * NE * D};
    pg8::gemm_phase<EpiYB, MoeOrder, true, true, true>((PG8_LAS unsigned char*)lds, g, S, E);
}
__device__ __forceinline__ void ph_combine(const P& p, int l, int nrows) {
    const int wave = ltid() >> 6, lane = ltid() & 63;
    for (int row = blockIdx.x * 8 + wave; row < nrows; row += gridDim.x * 8) {
        const int4 sl = *(const int4*)(p.tok_slot + (size_t)row * 4);
        const float4 g = *(const float4*)(p.topg + (size_t)row * 4);
        const float* m = p.mod + ((size_t)l * 5 + mod_row(row)) * 6144 + 5 * 1024;
        float xv[16]; float ss = 0.f;
#pragma unroll
        for (int i = 0; i < 2; ++i) {
            const int k = lane * 8 + 512 * i;
            const uint4 y0 = *(const uint4*)(p.YB + (size_t)sl.x * D + k), y1 = *(const uint4*)(p.YB + (size_t)sl.y * D + k);
            const uint4 y2 = *(const uint4*)(p.YB + (size_t)sl.z * D + k), y3 = *(const uint4*)(p.YB + (size_t)sl.w * D + k);
            const unsigned a0[4] = {y0.x, y0.y, y0.z, y0.w}, a1[4] = {y1.x, y1.y, y1.z, y1.w}, a2[4] = {y2.x, y2.y, y2.z, y2.w}, a3[4] = {y3.x, y3.y, y3.z, y3.w};
            const float* xp = p.X + (size_t)row * D + k;
            const float4 gta = *(const float4*)(m + k), gtb = *(const float4*)(m + k + 4);
            const float4 xa = *(const float4*)xp, xb = *(const float4*)(xp + 4);
            const float gt[8] = {gta.x, gta.y, gta.z, gta.w, gtb.x, gtb.y, gtb.z, gtb.w};
            const float x8[8] = {xa.x, xa.y, xa.z, xa.w, xb.x, xb.y, xb.z, xb.w};
#pragma unroll
            for (int q = 0; q < 4; ++q) {
                const float ylo = g.x * __uint_as_float(a0[q] << 16) + g.y * __uint_as_float(a1[q] << 16) + g.z * __uint_as_float(a2[q] << 16) + g.w * __uint_as_float(a3[q] << 16);
                const float yhi = g.x * __uint_as_float(a0[q] & 0xffff0000u) + g.y * __uint_as_float(a1[q] & 0xffff0000u) + g.z * __uint_as_float(a2[q] & 0xffff0000u) + g.w * __uint_as_float(a3[q] & 0xffff0000u);
                const float v0 = x8[2 * q] + gt[2 * q] * ylo, v1 = x8[2 * q + 1] + gt[2 * q + 1] * yhi;
                xv[8 * i + 2 * q] = v0; xv[8 * i + 2 * q + 1] = v1; ss += v0 * v0 + v1 * v1;
            }
        }
        ss = wave_sum(ss);
        const float rstd = rsqrtf(ss * (1.f / D) + EPS);
        if (l == 0) {
            const float* m1 = p.mod + ((size_t)5 + mod_row(row)) * 6144;
            const float* g1 = p.g_mix + D;
#pragma unroll
            for (int i = 0; i < 2; ++i) {
                const int k = lane * 8 + 512 * i;
                float* xp = p.X + (size_t)row * D + k;
                *(float4*)xp = make_float4(xv[8 * i], xv[8 * i + 1], xv[8 * i + 2], xv[8 * i + 3]);
                *(float4*)(xp + 4) = make_float4(xv[8 * i + 4], xv[8 * i + 5], xv[8 * i + 6], xv[8 * i + 7]);
                const float4 ga = *(const float4*)(g1 + k), gb = *(const float4*)(g1 + k + 4);
                const float4 sha = *(const float4*)(m1 + k), shb = *(const float4*)(m1 + k + 4);
                const float4 sca = *(const float4*)(m1 + 1024 + k), scb = *(const float4*)(m1 + 1024 + k + 4);
                u32x4 o;
                o.x = cvtpk(xv[8 * i] * rstd * ga.x * (1.f + sca.x) + sha.x, xv[8 * i + 1] * rstd * ga.y * (1.f + sca.y) + sha.y);
                o.y = cvtpk(xv[8 * i + 2] * rstd * ga.z * (1.f + sca.z) + sha.z, xv[8 * i + 3] * rstd * ga.w * (1.f + sca.w) + sha.w);
                o.z = cvtpk(xv[8 * i + 4] * rstd * gb.x * (1.f + scb.x) + shb.x, xv[8 * i + 5] * rstd * gb.y * (1.f + scb.y) + shb.y);
                o.w = cvtpk(xv[8 * i + 6] * rstd * gb.z * (1.f + scb.z) + shb.z, xv[8 * i + 7] * rstd * gb.w * (1.f + scb.w) + shb.w);
                *(u32x4*)(p.H + (size_t)row * D + k) = o;
            }
        } else {
#pragma unroll
            for (int i = 0; i < 2; ++i) {
                const int k = lane * 8 + 512 * i;
                const float4 ga = *(const float4*)(p.g_final + k), gb = *(const float4*)(p.g_final + k + 4);
                float* op = p.out + (size_t)row * D + k;
                *(float4*)op = make_float4(xv[8 * i] * rstd * ga.x, xv[8 * i + 1] * rstd * ga.y, xv[8 * i + 2] * rstd * ga.z, xv[8 * i + 3] * rstd * ga.w);
                *(float4*)(op + 4) = make_float4(xv[8 * i + 4] * rstd * gb.x, xv[8 * i + 5] * rstd * gb.y, xv[8 * i + 6] * rstd * gb.z, xv[8 * i + 7] * rstd * gb.w);
            }
        }
    }
}
#ifndef PROBE_DUP
#define PROBE_DUP 0
#endif
#ifndef PROBE_DUP
#define PROBE_DUP 0
#endif
extern __shared__ __attribute__((aligned(16))) char smem[];
__global__ void __launch_bounds__(NT, 2) mega(P p) {
    char* lds = smem;
    if (threadIdx.x == 0) *(uint4*)(smem + LDS_MAIN) = make_uint4(0u, 0u, 0u, 0u);
    __syncthreads();
    XcdBarrier bar = xcd_barrier_post(p.bar, (volatile LAS unsigned*)(smem + LDS_MAIN));
    ph_prologue(p, lds, 0);
    if (PROBE_DUP == 11) ph_prologue(p, lds, 0);
    xcd_barrier(bar);
    ph_norm1(p, 0);
    ph_prologue(p, lds, 1);
    if (PROBE_DUP == 1) ph_prologue(p, lds, 1);
    if (PROBE_DUP == 5) ph_norm1(p, 0);
    xcd_barrier(bar);
#pragma unroll
    for (int l = 0; l < 2; ++l) {
        const int nrows = l == 0 ? R : T;
        ph_gemm_proj(p, l, lds);
        if (PROBE_DUP == 4) ph_gemm_proj(p, l, lds);
        xcd_barrier(bar);
        ph_dattn(p, l, nrows, lds);
        if (PROBE_DUP == 2) ph_dattn(p, l, nrows, lds);
        ph_na(p, l, nrows, lds);
        if (PROBE_DUP == 5) ph_na(p, l, nrows, lds);
        ph_pool(p, l, nrows, lds);
        ph_sgu(p, l, nrows, lds);
        if (PROBE_DUP == 3) { ph_pool(p, l, nrows, lds); ph_sgu(p, l, nrows, lds); }
        xcd_barrier(bar);
        ph_gemm_out(p, l, nrows, lds);
        if (PROBE_DUP == 12 && l == 0) ph_gemm_out(p, l, nrows, lds);
        xcd_barrier(bar);
        ph_router(p, l, nrows, lds);
        xcd_barrier(bar);
        ph_assign(p, l, nrows, lds);
        xcd_barrier(bar);
        if (PROBE_DUP == 8) { xcd_barrier(bar); xcd_barrier(bar); xcd_barrier(bar); xcd_barrier(bar); xcd_barrier(bar); }
        ph_moe1(p, l, lds);
        if (PROBE_DUP == 6) ph_moe1(p, l, lds);
        if (PROBE_DUP == 13) ph_moe1(p, l, lds, true);
        xcd_barrier(bar);
        ph_moe2(p, l, lds);
        if (PROBE_DUP == 7) ph_moe2(p, l, lds);
        xcd_barrier(bar);
        ph_combine(p, l, nrows);
        if (l == 0) xcd_barrier(bar);
    }
}

static inline size_t align_up(size_t v, size_t a) { return (v + a - 1) / a * a; }

extern "C" void kernel_launch(void* const* d_in, const int* in_sizes, int n_in, void* d_out, int out_size, void* d_ws, size_t ws_size, hipStream_t stream) {
    P p{};
    const float** ins = (const float**)&p.x;
    for (int i = 0; i < 28; ++i) ins[i] = (const float*)d_in[i];
    p.out = (float*)d_out;
    char* w = (char*)d_ws; size_t off = 0;
    auto carve = [&](size_t bytes) { void* r = w + off; off = align_up(off + bytes, 256); return r; };
    const size_t ctl_bytes = XCD_BAR_WORDS * 4 + 2 * 64 * 4;
    p.bar = (unsigned*)carve(ctl_bytes);
    p.cnt = (int*)(p.bar + XCD_BAR_WORDS);
    p.mod = (float*)carve((size_t)2 * 5 * 6144 * 4);
    p.rope = (float*)carve(64 * 8 * 2 * 4);
    p.X = (float*)carve((size_t)R * D * 4);
    p.H = (bf16_t*)carve((size_t)R * D * 2);
    p.PROJ = (bf16_t*)carve((size_t)R * PW * 2);
    p.MIX = (bf16_t*)carve((size_t)R * D * 2);
    p.WinT = (bf16_t*)carve((size_t)2 * PW * D * 2);
    p.WoutT = (bf16_t*)carve((size_t)2 * D * D * 2);
    p.WguT = (unsigned char*)carve((size_t)2 * NE * 2048 * D);
    p.WdnT = (unsigned char*)carve((size_t)2 * NE * D * FF);
    p.WpT = (bf16_t*)carve((size_t)2 * 4 * 64 * 64 * 2);
    p.WsB = (bf16_t*)carve((size_t)2 * 4 * 128 * 128 * 2);
    p.topi = (int*)carve((size_t)R * 4 * 4);
    p.topg = (float*)carve((size_t)R * 4 * 4);
    p.tok_slot = (int*)carve((size_t)R * 4 * 4);
    p.moe_meta = (int*)carve(2 * 512 * 4);
    p.HS = (unsigned char*)carve((size_t)NSLOT * D);
    p.ACT = (unsigned char*)carve((size_t)NSLOT * FF);
    p.YB = (bf16_t*)carve((size_t)NSLOT * D * 2);

    static int grid = 0;
    if (!grid) {
        int dev = 0, cus = 0, per_cu = 0;
        (void)hipGetDevice(&dev);
        (void)hipDeviceGetAttribute(&cus, hipDeviceAttributeMultiprocessorCount, dev);
        (void)hipFuncSetAttribute((const void*)mega, hipFuncAttributeMaxDynamicSharedMemorySize, LDS_BYTES);
        (void)hipOccupancyMaxActiveBlocksPerMultiprocessor(&per_cu, mega, NT, LDS_BYTES);
        grid = cus * (per_cu < 1 ? per_cu : 1);
        if (grid <= 0) { fprintf(stderr, "mega: occupancy query returned %d blocks per CU\n", per_cu); grid = 0; return; }
    }
    (void)hipMemsetAsync(p.bar, 0, ctl_bytes, stream);
    mega<<<grid, NT, LDS_BYTES, stream>>>(p);
}
```

```cpp
#include <hip/hip_runtime.h>
#include <stdint.h>
#include <cstdio>

typedef unsigned short bf16_t;
typedef short bf16x8 __attribute__((ext_vector_type(8)));
typedef float f32x4 __attribute__((ext_vector_type(4)));

constexpr int D = 1024, NB = 4, S = 4096, T = NB * S, CL = 256, TC = NB * CL, R = T + TC;
constexpr int PW = 2304, NE = 32, TOPK = 4, FF = 1024;
constexpr int MAXSLOT = R * TOPK;
constexpr int NSLOT = MAXSLOT + NE * 256;
constexpr float EPS = 1e-6f;
constexpr int NT = 512;
constexpr int LDS_MAIN = 150 * 1024;
constexpr int LDS_BYTES = LDS_MAIN + 1024;

__device__ __forceinline__ bf16_t f2bf(float f) { unsigned u = __float_as_uint(f); return (bf16_t)((u + 0x7fffu + ((u >> 16) & 1u)) >> 16); }
__device__ __forceinline__ float bf2f(bf16_t h) { return __uint_as_float(((unsigned)h) << 16); }
__device__ __forceinline__ float wave_sum(float v) {
#pragma unroll
    for (int o = 32; o >= 1; o >>= 1) v += __shfl_xor(v, o);
    return v;
}
__device__ __forceinline__ int mod_row(int row) { return row < T ? (row >> 12) : 4; }

#define XB_TMO      128
#define XB_XCNT(j)  (256  + 64 * (j))
#define XB_XSUB(j)  (1280 + 64 * (j))
#define XB_XGEN(j)  (2304 + 64 * (j))
#define XB_TOP      3328
#define XB_TOPGEN   3392
#define XCD_BAR_WORDS 3456
#define XB_SPIN_CAP (1u << 18)
#define LAS __attribute__((address_space(3)))

__device__ __forceinline__ unsigned xb_ld(unsigned* p)              { return __hip_atomic_load(p, __ATOMIC_RELAXED, __HIP_MEMORY_SCOPE_AGENT); }
__device__ __forceinline__ unsigned xb_add(unsigned* p, unsigned v) { return __hip_atomic_fetch_add(p, v, __ATOMIC_RELAXED, __HIP_MEMORY_SCOPE_AGENT); }
__device__ __forceinline__ unsigned xb_xcc_id() { return (unsigned)__builtin_amdgcn_s_getreg((3 << 11) | 20) & 0xFu; }
#define XB_SPIN(cond, bar) do { unsigned _sp = 0; while (cond) { __builtin_amdgcn_s_sleep(1); \
    if ((++_sp & 255u) == 0u) { if (xb_ld(&(bar)[XB_TMO])) break; if (_sp > XB_SPIN_CAP) { atomicAdd(&(bar)[XB_TMO], 1u); break; } } } } while (0)

struct XcdBarrier {
    unsigned* bar; unsigned x;
    volatile LAS unsigned* st;
};
__device__ __forceinline__ XcdBarrier xcd_barrier_post(unsigned* bar, volatile LAS unsigned* st) {
    XcdBarrier b; b.bar = bar; b.x = xb_xcc_id(); b.st = st;
    if (threadIdx.x == 0) (void)xb_add(&bar[XB_XCNT(b.x)], 1u);
    return b;
}
__device__ __forceinline__ void xcd_barrier_complete(unsigned* bar, unsigned x, unsigned& nloc, unsigned& nx) {
    const unsigned G = gridDim.x * gridDim.y * gridDim.z;
    unsigned sum, cnt, mine, sp = 0u;
    for (;;) {
        sum = 0u; cnt = 0u; mine = 0u;
#pragma unroll
        for (unsigned j = 0; j < 16; ++j) { const unsigned c = xb_ld(&bar[XB_XCNT(j)]); sum += c; cnt += (c > 0u) ? 1u : 0u; mine = (j == x) ? c : mine; }
        if (sum == G) break;
        __builtin_amdgcn_s_sleep(1);
        if ((++sp & 255u) == 0u) { if (xb_ld(&bar[XB_TMO])) break; if (sp > XB_SPIN_CAP) { atomicAdd(&bar[XB_TMO], 1u); break; } }
    }
    nloc = mine > 0u ? mine : 1u; nx = cnt > 0u ? cnt : 1u;
}
__device__ __forceinline__ void xcd_barrier(const XcdBarrier& b) {
    asm volatile("s_waitcnt vmcnt(0)" ::: "memory");
    __syncthreads();
    if (threadIdx.x == 0) {
        unsigned* bar = b.bar;
        __builtin_amdgcn_s_waitcnt(0);
        unsigned nloc = b.st[0], nx = b.st[1];
        if (nloc == 0u) { xcd_barrier_complete(bar, b.x, nloc, nx); b.st[0] = nloc; b.st[1] = nx; }
        const unsigned old = xb_add(&bar[XB_XSUB(b.x)], 1u);
        const unsigned gen = old / nloc;
        if (old + 1u == (gen + 1u) * nloc) {
            __builtin_amdgcn_fence(__ATOMIC_RELEASE, "agent");
            asm volatile("s_waitcnt vmcnt(0)" ::: "memory");
            const unsigned og = xb_add(&bar[XB_TOP], 1u);
            const unsigned tg = og / nx;
            if (og + 1u == (tg + 1u) * nx) xb_add(&bar[XB_TOPGEN], 1u);
            else XB_SPIN(xb_ld(&bar[XB_TOPGEN]) == tg, bar);
            __builtin_amdgcn_fence(__ATOMIC_ACQUIRE, "agent");
            xb_add(&bar[XB_XGEN(b.x)], 1u);
            asm volatile("s_waitcnt vmcnt(0)" ::: "memory");
        } else {
            XB_SPIN(xb_ld(&bar[XB_XGEN(b.x)]) == gen, bar);
            __builtin_amdgcn_fence(__ATOMIC_ACQUIRE, "agent");
            asm volatile("s_waitcnt vmcnt(0)" ::: "memory");
        }
    }
    __syncthreads();
}

struct P {
    const float *x, *c, *ctx, *c_ctx, *w_mod, *b_mod, *g_mix, *g_ffn, *w_in, *w_out, *lam_q1, *lam_k1, *lam_q2, *lam_k2, *g_sub,
        *w_pool, *s_pool, *g_sgu, *w_sgu, *b_sgu, *rpb, *w_router, *b_router, *w_gu, *b_gu, *w_down, *b_down, *g_final;
    float* out;
    unsigned* bar;
    int* cnt;
    float* mod;
    float* rope;
    bf16_t* X;
    bf16_t* H;
    bf16_t* PROJ;
    bf16_t* MIX;
    bf16_t* WinT;
    bf16_t* WoutT;
    unsigned char* WguT;
    unsigned char* WdnT;
    bf16_t* WpT;
    bf16_t* WsB;
    int* topi;
    float* topg;
    int* tok_slot;
    int* moe_meta;
    unsigned char* HS;
    unsigned char* ACT;
    bf16_t* YB;
};

__device__ __forceinline__ int ltid() { int t = threadIdx.x; asm volatile("" : "+v"(t)); return t; }
typedef float f32x16 __attribute__((ext_vector_type(16)));
typedef short s16x4 __attribute__((ext_vector_type(4)));
typedef short v4i16_t __attribute__((ext_vector_type(4)));
typedef float f32x2_t __attribute__((ext_vector_type(2)));
typedef __bf16 bf16x2_t __attribute__((ext_vector_type(2)));
typedef __attribute__((address_space(3))) const char* lds_cptr;
typedef unsigned u32x4 __attribute__((ext_vector_type(4)));
__device__ __forceinline__ unsigned cvtpk(float lo, float hi) { f32x2_t v = {lo, hi}; bf16x2_t b = __builtin_convertvector(v, bf16x2_t); return __builtin_bit_cast(unsigned, b); }
__device__ __forceinline__ s16x4 vtr(lds_cptr q) { return __builtin_bit_cast(s16x4, __builtin_amdgcn_ds_read_tr16_b64_v4i16((__attribute__((address_space(3))) v4i16_t*)q)); }
__device__ __forceinline__ float xhalf_max(float v) { auto rr = __builtin_amdgcn_permlane32_swap(__float_as_uint(v), __float_as_uint(v), false, false); return fmaxf(__uint_as_float(rr[0]), __uint_as_float(rr[1])); }
__device__ __forceinline__ float xhalf_sum(float v) { auto rr = __builtin_amdgcn_permlane32_swap(__float_as_uint(v), __float_as_uint(v), false, false); return __uint_as_float(rr[0]) + __uint_as_float(rr[1]); }
namespace pg8 {
#define PG8_LAS __attribute__((address_space(3)))
constexpr int BM = 256, BK = 64, HALF = 128, HTB = HALF * BK * 2  , STAGE_BYTES = 8 * HTB, NXCD = 8, WGM = 8;
__host__ __device__ __forceinline__ int lds_byte(int r, int c) { const int st = (r >> 4) * 2 + (c >> 5), rr = r & 15, cc = c & 31, ob = rr * 64 + cc * 2; return st * 1024 + (ob ^ (((ob >> 9) & 1) << 5)); }
__host__ __device__ __forceinline__ void stage_rc(int b, int& R, int& C) { const int st = b / 1024, sb = b % 1024, swz = sb ^ (((sb >> 9) & 1) << 5); R = (st >> 1) * 16 + swz / 64; C = (st & 1) * 32 + (swz % 64) / 2; }
__host__ __device__ __forceinline__ int perm32(int rho) { const int n = rho >> 4, i = rho & 15; return 8 * (i >> 2) + 4 * n + (i & 3); }
struct Unit { int pm, pn, e; };
struct Gemm { const bf16_t* A; const bf16_t* Bt; int M, N, K; };
struct StaticOrder {
    int nM, nN, nwg, G, c;
    __host__ __device__ void init(int M, int N, int G_, int c_) { nM = M / BM; nN = N / BM; nwg = nM * nN; G = G_; c = c_; }
    __host__ __device__ bool next(int i, Unit& u) const {
        const long L = (long)i * G + c; if (L >= nwg) return false;
        int wgid = (int)L; { const int q = nwg / NXCD, r = nwg % NXCD, xcd = wgid % NXCD, off = wgid / NXCD; wgid = (xcd < r ? xcd * (q + 1) : r * (q + 1) + (xcd - r) * q) + off; }
        const int nig = WGM * nN, gid = wgid / nig, fm = gid * WGM, gsz = (nM - fm) < WGM ? (nM - fm) : WGM;
        u.pm = fm + ((wgid % nig) % gsz); u.pn = (wgid % nig) / gsz; u.e = 0; return true;
    }
    __device__ __forceinline__ const bf16_t* bt(const Gemm& g, const Unit&) const { return g.Bt; }
    __device__ __forceinline__ void a_ready(const Unit&) const {}
    __device__ __forceinline__ void done(const Unit&) const {}
};
typedef int v4i_t __attribute__((ext_vector_type(4)));
typedef int v8i_t __attribute__((ext_vector_type(8)));
__device__ __forceinline__ v8i_t cat8(bf16x8 a, bf16x8 b) { const v4i_t x = __builtin_bit_cast(v4i_t, a), y = __builtin_bit_cast(v4i_t, b); return __builtin_shufflevector(x, y, 0, 1, 2, 3, 4, 5, 6, 7); }
template <class Epi, class Sched, bool ALIGN_EPI = false, bool SP2 = false, bool F8 = false>
__device__ __forceinline__ void gemm_phase(PG8_LAS unsigned char* lds, const Gemm g, const Sched& S, const Epi& E) {
    const int tid = ltid(), wid = __builtin_amdgcn_readfirstlane(tid >> 6), lane = tid & 63, wr = wid >> 2, wc = wid & 3, fr = lane & 15, fq = lane >> 4;
    const int K = g.K, nt = K / BK;
    unsigned voffA[2], voffB[2];
#pragma unroll
    for (int i = 0; i < 2; ++i) { int R, C; stage_rc(tid * 16 + i * 8192, R, C); const int Rb = Epi::PERM ? ((R & ~31) + perm32(R & 31)) : R;
        voffA[i] = (unsigned)(R * K + C) * 2u; voffB[i] = (unsigned)(Rb * K + C) * 2u; }
    const size_t kstep = (size_t)(BK * 2);
    const size_t hstep = (size_t)HALF * K * 2;
    const size_t tstep = 2 * hstep;
    const unsigned ldsw = (unsigned)wid * 1024u;
    const int aoff = lds_byte(wr * 64 + fr, fq * 8), boff = lds_byte(wc * 32 + fr, fq * 8);
#define PG8_SA(b, h) (((b) * 2 + (h)) * HTB)
#define PG8_SB(b, h) ((4 + (b) * 2 + (h)) * HTB)
#define PG8_STAGE(bufoff, gbase, voff) do { _Pragma("unroll") for (int _i = 0; _i < 2; ++_i) \
        __builtin_amdgcn_global_load_lds((const unsigned*)((const char*)(gbase) + (voff)[_i]), (PG8_LAS unsigned*)(lds + (bufoff) + ldsw + _i * 8192), 16, 0, 0); } while (0)
#define PG8_LDA(dst, b, h) do { _Pragma("unroll") for (int m = 0; m < 4; ++m) _Pragma("unroll") for (int k = 0; k < 2; ++k) dst[m][k] = *(const PG8_LAS bf16x8*)(lds + PG8_SA(b, h) + aoff + m * 2048 + k * 1024); \
        if constexpr (F8) { _Pragma("unroll") for (int m = 0; m < 4; ++m) dst##8[m] = cat8(dst[m][0], dst[m][1]); } } while (0)
#define PG8_LDB(dst, b, h) do { _Pragma("unroll") for (int n = 0; n < 2; ++n) _Pragma("unroll") for (int k = 0; k < 2; ++k) dst[n][k] = *(const PG8_LAS bf16x8*)(lds + PG8_SB(b, h) + boff + n * 2048 + k * 1024); \
        if constexpr (F8) { _Pragma("unroll") for (int n = 0; n < 2; ++n) dst##8[n] = cat8(dst[n][0], dst[n][1]); } } while (0)
#define PG8_MMA(ai, bj, At, Bt) do { __builtin_amdgcn_s_setprio(1); \
        if constexpr (F8) { _Pragma("unroll") for (int m = 0; m < 4; ++m) _Pragma("unroll") for (int n = 0; n < 2; ++n) \
            asm volatile("v_mfma_scale_f32_16x16x128_f8f6f4 %0, %1, %2, %0, %3, %4 op_sel_hi:[0,0,0]" : "+v"(acc[ai][bj][m][n]) : "v"(Bt##8[n]), "v"(At##8[m]), "v"(sclW), "v"(sclX)); } \
        else { _Pragma("unroll") for (int m = 0; m < 4; ++m) _Pragma("unroll") for (int n = 0; n < 2; ++n) _Pragma("unroll") for (int k = 0; k < 2; ++k) \
            acc[ai][bj][m][n] = __builtin_amdgcn_mfma_f32_16x16x32_bf16(Bt[n][k], At[m][k], acc[ai][bj][m][n], 0, 0, 0); } \
        __builtin_amdgcn_s_setprio(0); } while (0)
#define PG8_WAIT_V(n) asm volatile("s_waitcnt vmcnt(" #n ")" ::: "memory")
#define PG8_WAIT_L(n) asm volatile("s_waitcnt lgkmcnt(" #n ")" ::: "memory")
#define PG8_BAR __builtin_amdgcn_s_barrier()
#define PG8_SCHED __builtin_amdgcn_sched_barrier(0)
    Unit cur, nxt; int ui = 0;
    if (!S.next(0, cur)) return;
    f32x4 acc[2][2][4][2];
#pragma unroll
    for (int a = 0; a < 2; ++a)
#pragma unroll
        for (int b = 0; b < 2; ++b)
#pragma unroll
            for (int m = 0; m < 4; ++m)
#pragma unroll
                for (int n = 0; n < 2; ++n) { acc[a][b][m][n] = (f32x4){0.f, 0.f, 0.f, 0.f}; }
    bf16x8 At[4][2], B0[2][2], B1[2][2];
    v8i_t At8[4], B08[2], B18[2];
    const int sclW = 0x79797979, sclX = 0x7f7f7f7f;
    const char* cA = (const char*)g.A + (size_t)cur.pm * tstep; const char* cB = (const char*)S.bt(g, cur) + (size_t)cur.pn * tstep;
    S.a_ready(cur);
    if constexpr (SP2) {
        PG8_STAGE(PG8_SB(0, 0), cB, voffB); PG8_STAGE(PG8_SB(0, 1), cB + hstep, voffB); PG8_STAGE(PG8_SA(0, 0), cA, voffA); PG8_STAGE(PG8_SA(0, 1), cA + hstep, voffA);
        if (wr == 1) PG8_BAR;
        PG8_WAIT_V(2); PG8_BAR;
        PG8_STAGE(PG8_SB(1, 0), cB + kstep, voffB); PG8_STAGE(PG8_SA(1, 0), cA + kstep, voffA); PG8_STAGE(PG8_SB(1, 1), cB + hstep + kstep, voffB);
        PG8_WAIT_V(6); PG8_BAR;
    } else {
        PG8_STAGE(PG8_SB(0, 0), cB, voffB); PG8_STAGE(PG8_SA(0, 0), cA, voffA); PG8_STAGE(PG8_SB(0, 1), cB + hstep, voffB); PG8_STAGE(PG8_SA(0, 1), cA + hstep, voffA);
        if (wr == 1) PG8_BAR;
        PG8_WAIT_V(4); PG8_BAR;
        PG8_STAGE(PG8_SB(1, 0), cB + kstep, voffB); PG8_STAGE(PG8_SA(1, 0), cA + kstep, voffA); PG8_STAGE(PG8_SB(1, 1), cB + hstep + kstep, voffB);
        PG8_WAIT_V(6); PG8_BAR;
    }
    for (;;) {
        const bool has_next = S.next(ui + 1, nxt);
        const char* nA = has_next ? (const char*)g.A + (size_t)nxt.pm * tstep : cA; const char* nB = has_next ? (const char*)S.bt(g, nxt) + (size_t)nxt.pn * tstep : cB;
#pragma unroll 1
        for (int t = 0; t < nt; t += 2) {
            const bool last = (t == nt - 2);
            const char* a1 = cA + (size_t)(t + 1) * kstep;
            const char* a2 = last ? nA : cA + (size_t)(t + 2) * kstep; const char* b2 = last ? nB : cB + (size_t)(t + 2) * kstep;
            const char* a3 = a2 + kstep; const char* b3 = b2 + kstep;
            if (last && has_next) S.a_ready(nxt);
            if constexpr (SP2) {
            PG8_LDB(B0, 0, 0); PG8_LDB(B1, 0, 1); PG8_SCHED; PG8_LDA(At, 0, 0); PG8_STAGE(PG8_SA(1, 1), a1 + hstep, voffA);
            PG8_WAIT_V(8); PG8_WAIT_L(0); PG8_BAR; PG8_MMA(0, 0, At, B0); PG8_MMA(0, 1, At, B1); PG8_BAR; PG8_SCHED;
            PG8_LDA(At, 0, 1); PG8_STAGE(PG8_SB(0, 0), b2, voffB); PG8_STAGE(PG8_SB(0, 1), b2 + hstep, voffB); PG8_STAGE(PG8_SA(0, 0), a2, voffA);
            PG8_WAIT_V(8); PG8_WAIT_L(0); PG8_BAR; PG8_MMA(1, 0, At, B0); PG8_MMA(1, 1, At, B1); PG8_BAR; PG8_SCHED;
            PG8_LDB(B0, 1, 0); PG8_LDB(B1, 1, 1); PG8_SCHED; PG8_LDA(At, 1, 0); PG8_STAGE(PG8_SA(0, 1), a2 + hstep, voffA);
            PG8_WAIT_V(8); PG8_WAIT_L(0); PG8_BAR; PG8_MMA(0, 0, At, B0); PG8_MMA(0, 1, At, B1); PG8_BAR; PG8_SCHED;
            PG8_LDA(At, 1, 1); PG8_STAGE(PG8_SB(1, 0), b3, voffB); PG8_STAGE(PG8_SB(1, 1), b3 + hstep, voffB); PG8_STAGE(PG8_SA(1, 0), a3, voffA);
            PG8_WAIT_V(8); PG8_WAIT_L(0); PG8_BAR; PG8_MMA(1, 0, At, B0); PG8_MMA(1, 1, At, B1); PG8_BAR; PG8_SCHED;
            } else {
            PG8_LDB(B0, 0, 0); PG8_SCHED; PG8_LDA(At, 0, 0); PG8_STAGE(PG8_SA(1, 1), a1 + hstep, voffA);
            PG8_WAIT_L(8); PG8_BAR; PG8_WAIT_L(0); PG8_MMA(0, 0, At, B0); PG8_BAR; PG8_SCHED;
            PG8_LDB(B1, 0, 1); PG8_STAGE(PG8_SB(0, 0), b2, voffB);
            PG8_BAR; PG8_WAIT_L(0); PG8_MMA(0, 1, At, B1); PG8_BAR;
            PG8_LDA(At, 0, 1); PG8_STAGE(PG8_SA(0, 0), a2, voffA);
            PG8_BAR; PG8_WAIT_L(0); PG8_MMA(1, 0, At, B0); PG8_BAR; PG8_SCHED;
            PG8_STAGE(PG8_SB(0, 1), b2 + hstep, voffB);
            PG8_WAIT_V(6); PG8_BAR; PG8_MMA(1, 1, At, B1); PG8_BAR;
            PG8_LDB(B0, 1, 0); PG8_SCHED; PG8_LDA(At, 1, 0); PG8_STAGE(PG8_SA(0, 1), a2 + hstep, voffA);
            PG8_WAIT_L(8); PG8_BAR; PG8_WAIT_L(0); PG8_MMA(0, 0, At, B0); PG8_BAR; PG8_SCHED;
            PG8_LDB(B1, 1, 1); PG8_STAGE(PG8_SB(1, 0), b3, voffB);
            PG8_BAR; PG8_WAIT_L(0); PG8_MMA(0, 1, At, B1); PG8_BAR;
            PG8_LDA(At, 1, 1); PG8_STAGE(PG8_SA(1, 0), a3, voffA);
            PG8_BAR; PG8_WAIT_L(0); PG8_MMA(1, 0, At, B0); PG8_BAR; PG8_SCHED;
            PG8_STAGE(PG8_SB(1, 1), b3 + hstep, voffB);
            PG8_WAIT_V(6); PG8_BAR; PG8_MMA(1, 1, At, B1); PG8_BAR;
            }
        }
        if constexpr (ALIGN_EPI) { if (wr == 0) PG8_BAR; }
        if constexpr (F8) asm volatile("s_nop 15\n\ts_nop 15" ::: "memory");
        if constexpr (!Epi::AFTER_DRAIN) { E(acc, cur, wr, wc, fr, fq); S.done(cur); }
        if (!has_next) break;
#pragma unroll
        for (int a = 0; a < 2; ++a)
#pragma unroll
            for (int b = 0; b < 2; ++b)
#pragma unroll
                for (int m = 0; m < 4; ++m)
#pragma unroll
                    for (int n = 0; n < 2; ++n) { acc[a][b][m][n] = (f32x4){0.f, 0.f, 0.f, 0.f}; }
        cur = nxt; cA = nA; cB = nB; ++ui;
        if constexpr (ALIGN_EPI) { if (wr == 1) PG8_BAR; }
    }
    PG8_WAIT_V(0);
    if constexpr (!ALIGN_EPI) { if (wr == 0) PG8_BAR; }
    PG8_BAR;
    if constexpr (Epi::AFTER_DRAIN) { E.fused(acc, cur, wr, wc, fr, fq, lds, wid, lane); S.done(cur); }
#undef PG8_SA
#undef PG8_SB
#undef PG8_STAGE
#undef PG8_LDA
#undef PG8_LDB
#undef PG8_MMA
#undef PG8_WAIT_V
#undef PG8_WAIT_L
#undef PG8_BAR
#undef PG8_SCHED
}
}

__device__ __forceinline__ void ph_prologue(const P& p, char* lds, const int part) {
    const int tid = ltid();
    float* fl = (float*)lds;
    if (part == 0) {
    for (int it = blockIdx.x; it < 96; it += gridDim.x) {
        const int l = it / 48, cg = it % 48;
        float* sc = fl;
        float* part = fl + 5 * 1024;
        __syncthreads();
        for (int i = tid; i < 5 * 1024; i += NT) {
            const int r = i >> 10, k = i & 1023;
            const float v = r < 4 ? p.c[r * 1024 + k] : p.c_ctx[k];
            sc[i] = v / (1.f + __expf(-v));
        }
        __syncthreads();
        const int kq = tid >> 7, col = tid & 127, j = cg * 128 + col;
        const float* W = p.w_mod + (size_t)l * 1024 * 6144;
        float a0 = 0, a1 = 0, a2 = 0, a3 = 0, a4 = 0;
        for (int k = kq * 256; k < kq * 256 + 256; ++k) {
            const float w = W[(size_t)k * 6144 + j];
            a0 += sc[k] * w; a1 += sc[1024 + k] * w; a2 += sc[2048 + k] * w; a3 += sc[3072 + k] * w; a4 += sc[4096 + k] * w;
        }
        part[(kq * 5 + 0) * 128 + col] = a0; part[(kq * 5 + 1) * 128 + col] = a1; part[(kq * 5 + 2) * 128 + col] = a2;
        part[(kq * 5 + 3) * 128 + col] = a3; part[(kq * 5 + 4) * 128 + col] = a4;
        __syncthreads();
        for (int i = tid; i < 5 * 128; i += NT) {
            const int r = i >> 7, cc = i & 127, jj = cg * 128 + cc;
            const float v = part[(0 * 5 + r) * 128 + cc] + part[(1 * 5 + r) * 128 + cc] + part[(2 * 5 + r) * 128 + cc] + part[(3 * 5 + r) * 128 + cc];
            p.mod[((size_t)l * 5 + r) * 6144 + jj] = v + p.b_mod[l * 6144 + jj];
        }
    }
    if (blockIdx.x == gridDim.x - 1) {
        const int pos = tid >> 3, f = tid & 7;
        const float inv = powf(10000.0f, -(float)f / 8.0f);
        const float ang = (float)pos * inv;
        p.rope[tid * 2] = cosf(ang); p.rope[tid * 2 + 1] = sinf(ang);
    }
    for (int i = blockIdx.x * NT + tid; i < 2 * 4 * 64 * 64; i += gridDim.x * NT) { const int ii = i & 63, j = (i >> 6) & 63, lg = i >> 12; p.WpT[i] = f2bf(p.w_pool[(size_t)lg * 4096 + ii * 64 + j]); }
    for (int i = blockIdx.x * NT + tid; i < 2 * 4 * 128 * 128; i += gridDim.x * NT) p.WsB[i] = f2bf(p.w_sgu[i]);
    }
    if (part == 0) {
        const int n_in = 2 * 9 * 16, n_out = 2 * 4 * 16, total = n_in + n_out;
        const int kr = tid >> 6, n4 = tid & 63, kg = tid & 7, nl = tid >> 3;
        for (int it = blockIdx.x; it < total; it += gridDim.x) {
            int i_ = it; const float* W_; bf16_t* Wt_; int N, K;
            if (i_ < n_in) { W_ = p.w_in; Wt_ = p.WinT; N = PW; K = D; } else { i_ -= n_in; W_ = p.w_out; Wt_ = p.WoutT; N = D; K = D; }
            const int ntn = N / 256, per = ntn * (K / 64), m_ = i_ / per, r_ = i_ % per, tn = r_ % ntn, tk = r_ / ntn, n0 = tn * 256;
            const float* src = W_ + (size_t)m_ * K * N + (size_t)(tk * 64) * N + n0; bf16_t* dst = Wt_ + (size_t)m_ * K * N + tk * 64;
            float4 rg[8];
#pragma unroll
            for (int i = 0; i < 8; ++i) rg[i] = *(const float4*)(src + (size_t)(kr + 8 * i) * N + n4 * 4);
            __syncthreads();
#pragma unroll
            for (int i = 0; i < 8; ++i) { float* q = fl + (kr + 8 * i) * 257 + n4 * 4; q[0] = rg[i].x; q[1] = rg[i].y; q[2] = rg[i].z; q[3] = rg[i].w; }
            __syncthreads();
#pragma unroll
            for (int j = 0; j < 4; ++j) {
                const int n = nl + 64 * j;
                const float* q = fl + (8 * kg) * 257 + n;
                u32x4 w;
                w.x = cvtpk(q[0], q[257]); w.y = cvtpk(q[2 * 257], q[3 * 257]); w.z = cvtpk(q[4 * 257], q[5 * 257]); w.w = cvtpk(q[6 * 257], q[7 * 257]);
                *(u32x4*)(dst + (size_t)(n0 + n) * K + 8 * kg) = w;
            }
        }
    } else {
        const int n_gu = 64 * 16 * 8, n_dn = 64 * 8 * 8, total = n_gu + n_dn;
        const int kr = tid >> 5, n4 = tid & 31, kg = (tid >> 3) & 7, nl = (tid & 7) + 8 * (tid >> 6);
        float4 rg[8];
        const float* src = nullptr; unsigned char* dst = nullptr; int N = 0, K = 0, n0 = 0, perm = 0;
        const float* nsrc = nullptr; unsigned char* ndst = nullptr; int nN = 0, nK = 0, nn0 = 0, nperm = 0;
#define TR_DECODE(IT, SRC, DST, NN, KK, N0, PERM) do { int i_ = (IT); const float* W_; unsigned char* Wt_; \
        if (i_ < n_gu) { W_ = p.w_gu; Wt_ = p.WguT; NN = 2048; KK = D; PERM = 1; } else { i_ -= n_gu; W_ = p.w_down; Wt_ = p.WdnT; NN = D; KK = FF; PERM = 0; } \
        const int ntn_ = NN / 128, per_ = ntn_ * (KK / 128), m_ = i_ / per_, r_ = i_ % per_, tn_ = r_ % ntn_, tk_ = r_ / ntn_; \
        N0 = tn_ * 128; SRC = W_ + (size_t)m_ * KK * NN + (size_t)(tk_ * 128) * NN + N0; DST = Wt_ + (size_t)m_ * KK * NN + tk_ * 128; } while (0)
        int it = blockIdx.x;
        if (it < total) {
            TR_DECODE(it, src, dst, N, K, n0, perm);
#pragma unroll
            for (int i = 0; i < 8; ++i) rg[i] = *(const float4*)(src + (size_t)(kr + 16 * i) * N + n4 * 4);
        }
        for (; it < total; it += gridDim.x) {
            __syncthreads();
#pragma unroll
            for (int i = 0; i < 8; ++i) { float* q = fl + (kr + 16 * i) * 129 + n4 * 4; q[0] = rg[i].x; q[1] = rg[i].y; q[2] = rg[i].z; q[3] = rg[i].w; }
            __syncthreads();
            const int nit = it + gridDim.x;
            if (nit < total) {
                TR_DECODE(nit, nsrc, ndst, nN, nK, nn0, nperm);
#pragma unroll
                for (int i = 0; i < 8; ++i) rg[i] = *(const float4*)(nsrc + (size_t)(kr + 16 * i) * nN + n4 * 4);
            }
#pragma unroll
            for (int j = 0; j < 2; ++j) {
                const int n = nl + 64 * j;
                const float* q = fl + (16 * kg) * 129 + n;
                u32x4 w;
#pragma unroll
                for (int d = 0; d < 4; ++d) {
                    unsigned r = __builtin_amdgcn_cvt_pk_fp8_f32(q[(4 * d) * 129] * 64.f, q[(4 * d + 1) * 129] * 64.f, 0u, false);
                    w[d] = __builtin_amdgcn_cvt_pk_fp8_f32(q[(4 * d + 2) * 129] * 64.f, q[(4 * d + 3) * 129] * 64.f, r, true);
                }
                const int ng = n0 + n;
                const int np = perm ? ((ng & (N / 2 - 1)) >> 7) * 256 + (ng >= N / 2 ? 128 : 0) + (ng & 127) : ng;
                *(u32x4*)(dst + (size_t)np * K + 16 * kg) = w;
            }
            src = nsrc; dst = ndst; N = nN; K = nK; n0 = nn0; perm = nperm;
        }
#undef TR_DECODE
    }
}

__device__ __forceinline__ void ph_norm1(const P& p, int l) {
    const int wave = ltid() >> 6, lane = ltid() & 63;
    for (int row = blockIdx.x * 8 + wave; row < R; row += gridDim.x * 8) {
        const float* xr = row < T ? p.x + (size_t)row * D : p.ctx + (size_t)(row - T) * D;
        float4 v[4]; float ss = 0;
#pragma unroll
        for (int i = 0; i < 4; ++i) { v[i] = *(const float4*)(xr + lane * 4 + 256 * i); ss += v[i].x * v[i].x + v[i].y * v[i].y + v[i].z * v[i].z + v[i].w * v[i].w; }
        ss = wave_sum(ss);
        const float rstd = rsqrtf(ss * (1.f / D) + EPS);
        const float* m = p.mod + ((size_t)l * 5 + mod_row(row)) * 6144;
        const float* g = p.g_mix + l * D;
#pragma unroll
        for (int i = 0; i < 4; ++i) {
            const int k = lane * 4 + 256 * i;
            const float4 gg = *(const float4*)(g + k), sh = *(const float4*)(m + k), sc = *(const float4*)(m + 1024 + k);
            uint2 o;
            o.x = cvtpk(v[i].x * rstd * gg.x * (1.f + sc.x) + sh.x, v[i].y * rstd * gg.y * (1.f + sc.y) + sh.y);
            o.y = cvtpk(v[i].z * rstd * gg.z * (1.f + sc.z) + sh.z, v[i].w * rstd * gg.w * (1.f + sc.w) + sh.w);
            *(uint2*)(p.H + (size_t)row * D + k) = o;
        }
    }
}

constexpr float QSCALE = 0.17677669529663687f * 1.4426950408889634f;
__device__ __forceinline__ void dsoftmax(const f32x16& s, float& m, float& l, f32x16& o0, f32x16& o1, bf16x8& pa, bf16x8& pb) {
    float mx = fmaxf(fmaxf(fmaxf(s[0], s[1]), fmaxf(s[2], s[3])), fmaxf(fmaxf(s[4], s[5]), fmaxf(s[6], s[7])));
    mx = fmaxf(mx, fmaxf(fmaxf(fmaxf(s[8], s[9]), fmaxf(s[10], s[11])), fmaxf(fmaxf(s[12], s[13]), fmaxf(s[14], s[15]))));
    mx = xhalf_max(mx);
    if (__any(mx > m)) {
        const float mn = fmaxf(m, mx), alpha = __builtin_amdgcn_exp2f(m - mn);
        o0 *= alpha; o1 *= alpha; l *= alpha; m = mn;
    }
    float pr[16]; float sum = 0.f;
#pragma unroll
    for (int r = 0; r < 16; ++r) { pr[r] = __builtin_amdgcn_exp2f(s[r] - m); sum += pr[r]; }
    l += sum;
    u32x4 a, b;
    a[0] = cvtpk(pr[0], pr[1]); a[1] = cvtpk(pr[2], pr[3]); a[2] = cvtpk(pr[4], pr[5]); a[3] = cvtpk(pr[6], pr[7]);
    b[0] = cvtpk(pr[8], pr[9]); b[1] = cvtpk(pr[10], pr[11]); b[2] = cvtpk(pr[12], pr[13]); b[3] = cvtpk(pr[14], pr[15]);
    pa = __builtin_bit_cast(bf16x8, a); pb = __builtin_bit_cast(bf16x8, b);
}
#define MX3(a, b, c) __builtin_fmaxf(__builtin_fmaxf((a), (b)), (c))
template <int THR>
__device__ __forceinline__ void dsoftmax2(f32x16& s, float& m, float& l, f32x16& o0, f32x16& o1, bf16x8& pa, bf16x8& pb, const bool first) {
    float a = MX3(s[0], s[1], s[2]), b = MX3(s[3], s[4], s[5]);
    a = MX3(a, s[6], s[7]); b = MX3(b, s[8], s[9]); a = MX3(a, s[10], s[11]); b = MX3(b, s[12], s[13]); a = MX3(a, s[14], s[15]);
    const float mx = xhalf_max(__builtin_fmaxf(a, b));
    if (first || __any(mx > m + (float)THR)) {
        const float mn = first ? mx : __builtin_fmaxf(mx, m), alpha = first ? 1.f : __builtin_amdgcn_exp2f(m - mn);
        m = mn; o0 *= alpha; o1 *= alpha; l *= alpha;
    }
    float sum = 0.f;
#pragma unroll
    for (int r = 0; r < 16; ++r) { s[r] = __builtin_amdgcn_exp2f(s[r] - m); sum += s[r]; }
    l += sum;
    u32x4 wa, wb;
    wa[0] = cvtpk(s[0], s[1]); wa[1] = cvtpk(s[2], s[3]); wa[2] = cvtpk(s[4], s[5]); wa[3] = cvtpk(s[6], s[7]);
    wb[0] = cvtpk(s[8], s[9]); wb[1] = cvtpk(s[10], s[11]); wb[2] = cvtpk(s[12], s[13]); wb[3] = cvtpk(s[14], s[15]);
    pa = __builtin_bit_cast(bf16x8, wa); pb = __builtin_bit_cast(bf16x8, wb);
}
__device__ __forceinline__ void ph_dattn(const P& p, int l, int nrows, char* lds) {
    const int tid = ltid(), lane = tid & 63, wid = tid >> 6, r32 = lane & 31, hi = lane >> 5;
    float la = lane < 32 ? p.lam_q1[l * 32 + lane] * p.lam_k1[l * 32 + lane] : 0.f;
    float lb = lane < 32 ? p.lam_q2[l * 32 + lane] * p.lam_k2[l * 32 + lane] : 0.f;
    la = wave_sum(la); lb = wave_sum(lb);
    const float lam_init = 0.8f - 0.6f * expf(-0.3f * (float)l);
    const float lam = expf(la) - expf(lb) + lam_init;
    const bf16_t* PR = p.PROJ;
    const int nunits = (nrows == R) ? 256 + 16 : 256;
    const int skey = 8 * wid + (lane & 7), schunk = lane >> 3;
    const int ldsK = schunk * 1024 + skey * 16;
    const int ldsV = 8192 + (schunk >> 2) * 4096 + (skey >> 3) * 512 + (skey & 7) * 64 + (schunk & 3) * 16;
    const int vb = ((lane >> 4) & 1) * 32 + (lane & 3) * 8 + (4 * hi + ((lane & 15) >> 2)) * 64;
    for (int uu = blockIdx.x; uu < nunits; uu += gridDim.x) {
        int b, h, q0, nt; bool isctx;
        if (uu < 256) { const int u = (uu & 7) * 32 + (uu >> 3); b = u >> 6; h = (u >> 4) & 3; q0 = b * 4096 + (u & 15) * 256; nt = 68; isctx = false; }
        else { const int v = uu - 256; b = v >> 2; h = v & 3; q0 = T + b * 256; nt = 4; isctx = true; }
        bf16x8 qf[4];
        {
            const bf16_t* qp = PR + (size_t)(q0 + wid * 32 + r32) * PW + h * 64 + hi * 8;
#pragma unroll
            for (int ks = 0; ks < 4; ++ks) qf[ks] = *(const bf16x8*)(qp + ks * 16);
        }
        f32x16 O00, O01, O10, O11, zero16;
#pragma unroll
        for (int r = 0; r < 16; ++r) { O00[r] = 0.f; O01[r] = 0.f; O10[r] = 0.f; O11[r] = 0.f; zero16[r] = 0.f; }
        float m1 = 0.f, m2 = 0.f, l1 = 0.f, l2 = 0.f;
        const size_t gK = 256 + h * 64 + schunk * 8, gV = 512 + h * 64 + schunk * 8;
        uint4 rk, rv;
        {
            const int kr = (isctx ? T + b * 256 : b * 4096) + skey;
            rk = *(const uint4*)(PR + (size_t)kr * PW + gK); rv = *(const uint4*)(PR + (size_t)kr * PW + gV);
        }
        __syncthreads();
        *(uint4*)(lds + ldsK) = rk; *(uint4*)(lds + ldsV) = rv;
        __syncthreads();
#pragma unroll 1
        for (int t = 0; t < nt; ++t) {
            char* buf = lds + (t & 1) * 16384;
            if (t + 1 < nt) {
                const int tn = t + 1;
                const int kr = ((isctx || tn >= 64) ? T + b * 256 + (isctx ? tn : tn - 64) * 64 : b * 4096 + tn * 64) + skey;
                rk = *(const uint4*)(PR + (size_t)kr * PW + gK); rv = *(const uint4*)(PR + (size_t)kr * PW + gV);
            }
            {
                typedef const __attribute__((address_space(3))) bf16x8* kfp_t;
                const lds_cptr kp = (lds_cptr)buf + hi * 1024 + r32 * 16;
                const lds_cptr vp = (lds_cptr)buf + 8192 + vb;
                bf16x8 kf0 = *(kfp_t)(kp), kf1 = *(kfp_t)(kp + 2048), kf2 = *(kfp_t)(kp + 4096), kf3 = *(kfp_t)(kp + 6144);
#pragma unroll
                for (int kb = 0; kb < 2; ++kb) {
                    f32x16 s1 = __builtin_amdgcn_mfma_f32_32x32x16_bf16(kf0, qf[0], zero16, 0, 0, 0);
                    f32x16 s2 = __builtin_amdgcn_mfma_f32_32x32x16_bf16(kf2, qf[2], zero16, 0, 0, 0);
                    s1 = __builtin_amdgcn_mfma_f32_32x32x16_bf16(kf1, qf[1], s1, 0, 0, 0);
                    s2 = __builtin_amdgcn_mfma_f32_32x32x16_bf16(kf3, qf[3], s2, 0, 0, 0);
                    s16x4 vlo[4], vhi[4];
#pragma unroll
                    for (int i = 0; i < 4; ++i) { vlo[i] = vtr(vp + kb * 2048 + (i >> 1) * 4096 + (i & 1) * 1024); vhi[i] = vtr(vp + kb * 2048 + (i >> 1) * 4096 + (i & 1) * 1024 + 512); }
                    if (kb == 0) { kf0 = *(kfp_t)(kp + 512); kf1 = *(kfp_t)(kp + 512 + 2048); kf2 = *(kfp_t)(kp + 512 + 4096); kf3 = *(kfp_t)(kp + 512 + 6144); }
                    __builtin_amdgcn_sched_barrier(0);
                    const bool first = (t == 0) && (kb == 0);
                    bf16x8 p1a, p1b, p2a, p2b;
                    dsoftmax2<8>(s1, m1, l1, O00, O01, p1a, p1b, first);
                    dsoftmax2<8>(s2, m2, l2, O10, O11, p2a, p2b, first);
#pragma unroll
                    for (int i = 0; i < 4; ++i) {
                        const bf16x8 va = (bf16x8){vlo[i][0], vlo[i][1], vlo[i][2], vlo[i][3], vhi[i][0], vhi[i][1], vhi[i][2], vhi[i][3]};
                        if (i < 2) { O00 = __builtin_amdgcn_mfma_f32_32x32x16_bf16(va, (i & 1) ? p1b : p1a, O00, 0, 0, 0); O10 = __builtin_amdgcn_mfma_f32_32x32x16_bf16(va, (i & 1) ? p2b : p2a, O10, 0, 0, 0); }
                        else       { O01 = __builtin_amdgcn_mfma_f32_32x32x16_bf16(va, (i & 1) ? p1b : p1a, O01, 0, 0, 0); O11 = __builtin_amdgcn_mfma_f32_32x32x16_bf16(va, (i & 1) ? p2b : p2a, O11, 0, 0, 0); }
                    }
                }
            }
            if (t + 1 < nt) { char* nb = lds + ((t + 1) & 1) * 16384; *(uint4*)(nb + ldsK) = rk; *(uint4*)(nb + ldsV) = rv; }
            __syncthreads();
        }
        l1 = xhalf_sum(l1); l2 = xhalf_sum(l2);
        const float i1 = 1.f / l1, i2 = lam / l2;
        float ss = 0.f;
#pragma unroll
        for (int r = 0; r < 16; ++r) { O00[r] = O00[r] * i1 - O10[r] * i2; O01[r] = O01[r] * i1 - O11[r] * i2; ss += O00[r] * O00[r] + O01[r] * O01[r]; }
        ss = xhalf_sum(ss);
        const float rstd = rsqrtf(ss * (1.f / 64.f) + EPS) * (1.f - lam_init);
        const float* gs = p.g_sub + l * 64;
        bf16_t* op = p.MIX + (size_t)(q0 + wid * 32 + r32) * D + h * 64;
#pragma unroll
        for (int g4 = 0; g4 < 4; ++g4) {
            const int d = 8 * g4 + 4 * hi;
            const float4 ga = *(const float4*)(gs + d), gb = *(const float4*)(gs + 32 + d);
            uint2 wa, wb;
            wa.x = cvtpk(O00[4 * g4] * rstd * ga.x, O00[4 * g4 + 1] * rstd * ga.y); wa.y = cvtpk(O00[4 * g4 + 2] * rstd * ga.z, O00[4 * g4 + 3] * rstd * ga.w);
            wb.x = cvtpk(O01[4 * g4] * rstd * gb.x, O01[4 * g4 + 1] * rstd * gb.y); wb.y = cvtpk(O01[4 * g4 + 2] * rstd * gb.z, O01[4 * g4 + 3] * rstd * gb.w);
            *(uint2*)(op + d) = wa; *(uint2*)(op + 32 + d) = wb;
        }
    }
}

__device__ __forceinline__ void ph_na(const P& p, int l, int nrows, char* lds) {
    const int tid = ltid(), lane = tid & 63, wid = tid >> 6, r32 = lane & 31, hi = lane >> 5;
    const bf16_t* PR = p.PROJ;
    const int nunits = (nrows == R) ? 256 + 16 : 256;
    const int skey = 8 * wid + (lane & 7), schunk = lane >> 3;
    const int ldsK = schunk * 1024 + skey * 16;
    const int ldsV = 8192 + (schunk >> 2) * 4096 + (skey >> 3) * 512 + (skey & 7) * 64 + (schunk & 3) * 16;
    const int vb = ((lane >> 4) & 1) * 32 + (lane & 3) * 8 + (4 * hi + ((lane & 15) >> 2)) * 64;
    float* btab = (float*)(lds + 32768);
    constexpr float LOG2E = 1.4426950408889634f;
    for (int uu = (blockIdx.x + gridDim.x - 16) % gridDim.x; uu < nunits; uu += gridDim.x) {
        int b, h, q0, kr_lo, nlat, rs = 0, rq = 0; bool isctx;
        if (uu < 256) {
            const int u = (uu & 7) * 32 + (uu >> 3); b = u >> 6; h = (u >> 4) & 3; const int rg = u & 15;
            rq = 4 * rg + (wid >> 1); q0 = b * 4096 + rq * 64 + (wid & 1) * 32;
            kr_lo = min(max(4 * rg - 4, 0), 56); const int kr_hi = min(max(4 * rg - 1, 0), 56) + 7; nlat = kr_hi - kr_lo + 1;
            rs = min(max(rq - 4, 0), 56); isctx = false;
        } else { const int v = uu - 256; b = v >> 2; h = v & 3; q0 = T + b * 256 + wid * 32; kr_lo = 0; nlat = 0; isctx = true; }
        const int nt = nlat + 4;
        const int cq = (wid & 1) * 32 + r32, wsc = min(max(cq - 8, 0), 48);
        bf16x8 qf[4];
        {
            const bf16_t* qp = PR + (size_t)(q0 + r32) * PW + 1536 + h * 64 + hi * 8;
#pragma unroll
            for (int ks = 0; ks < 4; ++ks) qf[ks] = *(const bf16x8*)(qp + ks * 16);
        }
        f32x16 O0, O1;
#pragma unroll
        for (int r = 0; r < 16; ++r) { O0[r] = 0.f; O1[r] = 0.f; }
        float m1 = -1e30f, l1 = 0.f;
        const size_t gK = 1792 + h * 64 + schunk * 8, gV = 2048 + h * 64 + schunk * 8;
        uint4 rk, rv;
        {
            const int kr = (nlat ? b * 4096 + kr_lo * 64 : T + b * 256) + skey;
            rk = *(const uint4*)(PR + (size_t)kr * PW + gK); rv = *(const uint4*)(PR + (size_t)kr * PW + gV);
        }
        __syncthreads();
        *(uint4*)(lds + ldsK) = rk; *(uint4*)(lds + ldsV) = rv;
        if (tid < 465) btab[tid] = p.rpb[((size_t)l * 4 + h) * 465 + tid] * LOG2E;
        __syncthreads();
        for (int t = 0; t < nt; ++t) {
            char* buf = lds + (t & 1) * 16384;
            if (t + 1 < nt) {
                const int tn = t + 1;
                const int kr = (tn < nlat ? b * 4096 + (kr_lo + tn) * 64 : T + b * 256 + (tn - nlat) * 64) + skey;
                rk = *(const uint4*)(PR + (size_t)kr * PW + gK); rv = *(const uint4*)(PR + (size_t)kr * PW + gV);
            }
            const bool lat = t < nlat;
            const int krow = kr_lo + t;
            const bool active = !lat || (krow >= rs && krow <= rs + 7);
            if (active) {
                const float* brow = btab + (krow - rq + 7) * 31 + 15 - cq;
#pragma unroll
                for (int kb = 0; kb < 2; ++kb) {
                    const lds_cptr kp = (lds_cptr)buf + hi * 1024 + (kb * 32 + r32) * 16;
                    f32x16 s1;
#pragma unroll
                    for (int r = 0; r < 16; ++r) s1[r] = 0.f;
#pragma unroll
                    for (int ks = 0; ks < 4; ++ks) {
                        const bf16x8 kf = *(const __attribute__((address_space(3))) bf16x8*)(kp + ks * 2048);
                        s1 = __builtin_amdgcn_mfma_f32_32x32x16_bf16(kf, qf[ks], s1, 0, 0, 0);
                    }
                    if (lat) {
#pragma unroll
                        for (int r = 0; r < 16; ++r) {
                            const int kc = 32 * kb + (r & 3) + 8 * (r >> 2) + 4 * hi;
                            const bool ok = (unsigned)(kc - wsc) < 16u;
                            const float bv = brow[ok ? kc : cq];
                            s1[r] = ok ? s1[r] + bv : -INFINITY;
                        }
                    }
                    bf16x8 pa, pb;
                    dsoftmax(s1, m1, l1, O0, O1, pa, pb);
                    const lds_cptr vp = (lds_cptr)buf + 8192 + vb + kb * 2048;
#pragma unroll
                    for (int ss = 0; ss < 2; ++ss) {
                        const s16x4 lo0 = vtr(vp + ss * 1024), hh0 = vtr(vp + ss * 1024 + 512);
                        const s16x4 lo1 = vtr(vp + 4096 + ss * 1024), hh1 = vtr(vp + 4096 + ss * 1024 + 512);
                        const bf16x8 va0 = (bf16x8){lo0[0], lo0[1], lo0[2], lo0[3], hh0[0], hh0[1], hh0[2], hh0[3]};
                        const bf16x8 va1 = (bf16x8){lo1[0], lo1[1], lo1[2], lo1[3], hh1[0], hh1[1], hh1[2], hh1[3]};
                        O0 = __builtin_amdgcn_mfma_f32_32x32x16_bf16(va0, ss ? pb : pa, O0, 0, 0, 0);
                        O1 = __builtin_amdgcn_mfma_f32_32x32x16_bf16(va1, ss ? pb : pa, O1, 0, 0, 0);
                    }
                }
            }
            if (t + 1 < nt) { char* nb = lds + ((t + 1) & 1) * 16384; *(uint4*)(nb + ldsK) = rk; *(uint4*)(nb + ldsV) = rv; }
            __syncthreads();
        }
        l1 = xhalf_sum(l1);
        const float il = 1.f / l1;
        bf16_t* op = p.MIX + (size_t)(q0 + r32) * D + 768 + h * 64;
#pragma unroll
        for (int g4 = 0; g4 < 4; ++g4) {
            const int d = 8 * g4 + 4 * hi;
            uint2 wa, wb;
            wa.x = cvtpk(O0[4 * g4] * il, O0[4 * g4 + 1] * il); wa.y = cvtpk(O0[4 * g4 + 2] * il, O0[4 * g4 + 3] * il);
            wb.x = cvtpk(O1[4 * g4] * il, O1[4 * g4 + 1] * il); wb.y = cvtpk(O1[4 * g4 + 2] * il, O1[4 * g4 + 3] * il);
            *(uint2*)(op + d) = wa; *(uint2*)(op + 32 + d) = wb;
        }
    }
}

__device__ __forceinline__ void ph_pool(const P& p, int l, int nrows, char* lds) {
    const int tid = ltid(), lane = tid & 63, wid = tid >> 6, fr = lane & 15, fq = lane >> 4;
    float* ysh = (float*)lds;
    bf16_t* dsh = (bf16_t*)(lds + 80 * 256 * 4);
    const bf16_t* PR = p.PROJ;
    for (int it = (blockIdx.x + gridDim.x - 32) % gridDim.x; it < nrows / 64; it += gridDim.x) {
        const int row0 = it * 64;
        const int L = row0 < T ? 4096 : 256;
        const int t0 = row0 < T ? (row0 & 4095) : ((row0 - T) & 255);
        const int base = row0 - t0;
        __syncthreads();
        for (int c = tid; c < 80 * 32; c += NT) {
            const int rr = c >> 5, ch = (c & 31) * 8, t = t0 - 8 + rr;
            float4 a = make_float4(0.f, 0.f, 0.f, 0.f), b = a;
            if (t >= 0 && t < L) {
                const uint4 raw = *(const uint4*)(PR + (size_t)(base + t) * PW + 768 + ch);
                a = make_float4(__uint_as_float(raw.x << 16), __uint_as_float(raw.x & 0xffff0000u), __uint_as_float(raw.y << 16), __uint_as_float(raw.y & 0xffff0000u));
                b = make_float4(__uint_as_float(raw.z << 16), __uint_as_float(raw.z & 0xffff0000u), __uint_as_float(raw.w << 16), __uint_as_float(raw.w & 0xffff0000u));
            }
            *(float4*)(ysh + rr * 256 + ch) = a; *(float4*)(ysh + rr * 256 + ch + 4) = b;
        }
        __syncthreads();
        {
            const int r = tid >> 3, cg = tid & 7;
            const int g = cg >> 1, w = 2 << g, t = t0 + r;
            const int lo = max(t - w / 2, 0), hi = min(t + w / 2 - 1, L - 1);
            const float inv = 1.f / (float)(hi - lo + 1);
#pragma unroll
            for (int q = 0; q < 8; ++q) {
                const int ch = cg * 32 + q * 4;
                float4 s = make_float4(0.f, 0.f, 0.f, 0.f);
                for (int tt = lo; tt <= hi; ++tt) { const float4 v = *(const float4*)(ysh + (tt - t0 + 8) * 256 + ch); s.x += v.x; s.y += v.y; s.z += v.z; s.w += v.w; }
                const float4 y = *(const float4*)(ysh + (r + 8) * 256 + ch);
                uint2 o; o.x = cvtpk(s.x * inv - y.x, s.y * inv - y.y); o.y = cvtpk(s.z * inv - y.z, s.w * inv - y.w);
                *(uint2*)(dsh + r * 264 + ch) = o;
            }
        }
        __syncthreads();
        {
            const int g = wid >> 1, mb = (wid & 1) * 2;
            const bf16_t* W = p.WpT + ((size_t)l * 4 + g) * 64 * 64;
            f32x4 acc[2][4];
#pragma unroll
            for (int mt = 0; mt < 2; ++mt)
#pragma unroll
                for (int nt = 0; nt < 4; ++nt) acc[mt][nt] = (f32x4){0.f, 0.f, 0.f, 0.f};
#pragma unroll
            for (int ks = 0; ks < 2; ++ks) {
                bf16x8 af[2], bfr[4];
#pragma unroll
                for (int mt = 0; mt < 2; ++mt) af[mt] = *(const bf16x8*)(dsh + ((mb + mt) * 16 + fr) * 264 + g * 64 + ks * 32 + fq * 8);
#pragma unroll
                for (int nt = 0; nt < 4; ++nt) bfr[nt] = *(const bf16x8*)(W + (nt * 16 + fr) * 64 + ks * 32 + fq * 8);
#pragma unroll
                for (int mt = 0; mt < 2; ++mt)
#pragma unroll
                    for (int nt = 0; nt < 4; ++nt) acc[mt][nt] = __builtin_amdgcn_mfma_f32_16x16x32_bf16(bfr[nt], af[mt], acc[mt][nt], 0, 0, 0);
            }
#pragma unroll
            for (int mt = 0; mt < 2; ++mt)
#pragma unroll
                for (int nt = 0; nt < 4; ++nt) {
                    const int row = row0 + (mb + mt) * 16 + fr, j = g * 64 + nt * 16 + fq * 4;
                    const float4 sp = *(const float4*)(p.s_pool + l * 256 + j);
                    uint2 o; o.x = cvtpk(acc[mt][nt][0] * sp.x, acc[mt][nt][1] * sp.y); o.y = cvtpk(acc[mt][nt][2] * sp.z, acc[mt][nt][3] * sp.w);
                    *(uint2*)(p.MIX + (size_t)row * D + 256 + j) = o;
                }
        }
    }
}

__device__ __forceinline__ float gelu_fast(float x) {
    const float u = 0.7978845608028654f * (x + 0.044715f * x * x * x);
    return x / (1.f + __builtin_amdgcn_exp2f(-2.885390081777927f * u));
}
__device__ __forceinline__ void ph_sgu(const P& p, int l, int nrows, char* lds) {
    const int tid = ltid(), lane = tid & 63, wid = tid >> 6, fr = lane & 15, fq = lane >> 4;
    bf16_t* vnT = (bf16_t*)lds;
    float* rstd = (float*)(lds + 128 * 136 * 2);
    const bf16_t* PR = p.PROJ;
    for (int it = (blockIdx.x + gridDim.x - 48) % gridDim.x; it < (nrows / 128) * 2; it += gridDim.x) {
        const int chunk = it >> 1, hp = it & 1, row0 = chunk * 128;
        __syncthreads();
        {
            const int t = tid >> 2, qtr = tid & 3;
            const bf16_t* zp = PR + (size_t)(row0 + t) * PW + 1280 + qtr * 64;
            float ss = 0.f;
#pragma unroll
            for (int i = 0; i < 8; ++i) {
                const uint4 raw = *(const uint4*)(zp + i * 8);
                const unsigned w4[4] = {raw.x, raw.y, raw.z, raw.w};
#pragma unroll
                for (int j = 0; j < 4; ++j) { const float a = __uint_as_float(w4[j] << 16), b = __uint_as_float(w4[j] & 0xffff0000u); ss += a * a + b * b; }
            }
            ss += __shfl_xor(ss, 1); ss += __shfl_xor(ss, 2);
            if (qtr == 0) rstd[t] = rsqrtf(ss * (1.f / 256.f) + EPS);
        }
        __syncthreads();
        {
            const int s = tid >> 2, cb = (tid & 3) * 32;
            const bf16_t* zp = PR + (size_t)(row0 + s) * PW + 1280 + hp * 128 + cb;
            const float rs = rstd[s];
            const float* gg = p.g_sgu + l * 256 + hp * 128 + cb;
#pragma unroll
            for (int i = 0; i < 4; ++i) {
                const uint4 raw = *(const uint4*)(zp + i * 8);
                const unsigned w4[4] = {raw.x, raw.y, raw.z, raw.w};
#pragma unroll
                for (int j = 0; j < 4; ++j) {
                    const int c = cb + i * 8 + j * 2;
                    vnT[c * 136 + s] = f2bf(__uint_as_float(w4[j] << 16) * rs * gg[i * 8 + j * 2]);
                    vnT[(c + 1) * 136 + s] = f2bf(__uint_as_float(w4[j] & 0xffff0000u) * rs * gg[i * 8 + j * 2 + 1]);
                }
            }
        }
        __syncthreads();
        {
            const int hl = wid >> 2, g = hp * 2 + hl, mb = (wid & 3) * 2;
            const bf16_t* Wg = p.WsB + ((size_t)l * 4 + g) * 128 * 128;
            f32x4 acc[2][4];
#pragma unroll
            for (int mt = 0; mt < 2; ++mt)
#pragma unroll
                for (int nt = 0; nt < 4; ++nt) acc[mt][nt] = (f32x4){0.f, 0.f, 0.f, 0.f};
#pragma unroll
            for (int ks = 0; ks < 4; ++ks) {
                bf16x8 af[2], bfr[4];
#pragma unroll
                for (int mt = 0; mt < 2; ++mt) af[mt] = *(const bf16x8*)(Wg + ((mb + mt) * 16 + fr) * 128 + ks * 32 + fq * 8);
#pragma unroll
                for (int nt = 0; nt < 4; ++nt) bfr[nt] = *(const bf16x8*)(vnT + (hl * 64 + nt * 16 + fr) * 136 + ks * 32 + fq * 8);
#pragma unroll
                for (int mt = 0; mt < 2; ++mt)
#pragma unroll
                    for (int nt = 0; nt < 4; ++nt) acc[mt][nt] = __builtin_amdgcn_mfma_f32_16x16x32_bf16(bfr[nt], af[mt], acc[mt][nt], 0, 0, 0);
            }
#pragma unroll
            for (int mt = 0; mt < 2; ++mt) {
                const int t = (mb + mt) * 16 + fr;
                const float bias = p.b_sgu[(l * 4 + g) * 128 + t];
#pragma unroll
                for (int nt = 0; nt < 4; ++nt) {
                    const int c = g * 64 + nt * 16 + fq * 4;
                    const uint2 ur = *(const uint2*)(PR + (size_t)(row0 + t) * PW + 1024 + c);
                    const float u0 = __uint_as_float(ur.x << 16), u1 = __uint_as_float(ur.x & 0xffff0000u);
                    const float u2 = __uint_as_float(ur.y << 16), u3 = __uint_as_float(ur.y & 0xffff0000u);
                    uint2 o; o.x = cvtpk(u0 * (acc[mt][nt][0] + bias), u1 * (acc[mt][nt][1] + bias)); o.y = cvtpk(u2 * (acc[mt][nt][2] + bias), u3 * (acc[mt][nt][3] + bias));
                    *(uint2*)(p.MIX + (size_t)(row0 + t) * D + 512 + c) = o;
                }
            }
        }
    }
}

__device__ __forceinline__ void ph_router(const P& p, int l, int nrows, char* lds) {
    const int tid = ltid(), wave = tid >> 6, lane = tid & 63;
    float* wl = (float*)lds;
    float* wsc = (float*)(lds + 1024 * 36 * 4) + wave * 64;
    int* lcnt = (int*)(lds + 1024 * 36 * 4 + 8 * 64 * 4);
    __syncthreads();
    {
        const float* wr = p.w_router + (size_t)l * D * NE;
        float4 t[16];
#pragma unroll
        for (int i = 0; i < 16; ++i) t[i] = *(const float4*)(wr + (size_t)(tid + NT * i) * 4);
#pragma unroll
        for (int i = 0; i < 16; ++i) { const int idx = (tid + NT * i) * 4, k = idx >> 5, e = idx & 31; *(float4*)(wl + ((k & 3) * 256 + (k >> 2)) * 36 + e) = t[i]; }
        if (tid < 32) lcnt[tid] = 0;
    }
    __syncthreads();
    const float* g = p.g_ffn + l * D;
    const float brt = p.b_router[l * NE + (lane & 31)];
    for (int pr = blockIdx.x * 8 + wave; pr < nrows / 2; pr += gridDim.x * 8) {
        const int ra = 2 * pr;
        const bf16_t* xa = p.X + (size_t)ra * D; const bf16_t* xb = xa + D;
        float ha[16], hb[16]; float sa = 0.f, sb = 0.f;
#pragma unroll
        for (int i = 0; i < 4; ++i) {
            const uint2 ua = *(const uint2*)(xa + 4 * (lane + 64 * i)), ub = *(const uint2*)(xb + 4 * (lane + 64 * i));
            const float4 va = make_float4(__uint_as_float(ua.x << 16), __uint_as_float(ua.x & 0xffff0000u), __uint_as_float(ua.y << 16), __uint_as_float(ua.y & 0xffff0000u));
            const float4 vb = make_float4(__uint_as_float(ub.x << 16), __uint_as_float(ub.x & 0xffff0000u), __uint_as_float(ub.y << 16), __uint_as_float(ub.y & 0xffff0000u));
            ha[4 * i] = va.x; ha[4 * i + 1] = va.y; ha[4 * i + 2] = va.z; ha[4 * i + 3] = va.w; hb[4 * i] = vb.x; hb[4 * i + 1] = vb.y; hb[4 * i + 2] = vb.z; hb[4 * i + 3] = vb.w;
            sa += va.x * va.x + va.y * va.y + va.z * va.z + va.w * va.w; sb += vb.x * vb.x + vb.y * vb.y + vb.z * vb.z + vb.w * vb.w;
        }
        sa = wave_sum(sa); sb = wave_sum(sb);
        const float rsa = rsqrtf(sa * (1.f / D) + EPS), rsb = rsqrtf(sb * (1.f / D) + EPS);
        const float* m = p.mod + ((size_t)l * 5 + mod_row(ra)) * 6144;
#pragma unroll
        for (int i = 0; i < 4; ++i) {
            const int k = 4 * (lane + 64 * i);
            const float4 gg = *(const float4*)(g + k), sc = *(const float4*)(m + 4 * 1024 + k), sh = *(const float4*)(m + 3 * 1024 + k);
            const float gs[4] = {gg.x * (1.f + sc.x), gg.y * (1.f + sc.y), gg.z * (1.f + sc.z), gg.w * (1.f + sc.w)}, s4[4] = {sh.x, sh.y, sh.z, sh.w};
#pragma unroll
            for (int j = 0; j < 4; ++j) { ha[4 * i + j] = ha[4 * i + j] * rsa * gs[j] + s4[j]; hb[4 * i + j] = hb[4 * i + j] * rsb * gs[j] + s4[j]; }
            uint2 oa, ob; oa.x = cvtpk(ha[4 * i], ha[4 * i + 1]); oa.y = cvtpk(ha[4 * i + 2], ha[4 * i + 3]); ob.x = cvtpk(hb[4 * i], hb[4 * i + 1]); ob.y = cvtpk(hb[4 * i + 2], hb[4 * i + 3]);
            *(uint2*)(p.H + (size_t)ra * D + k) = oa; *(uint2*)(p.H + (size_t)(ra + 1) * D + k) = ob;
        }
        float la[32], lb[32];
#pragma unroll
        for (int e = 0; e < 32; ++e) { la[e] = 0.f; lb[e] = 0.f; }
#pragma unroll
        for (int i = 0; i < 4; ++i)
#pragma unroll
            for (int j = 0; j < 4; ++j) {
                const float* wk = wl + (j * 256 + lane + 64 * i) * 36;
                const float xv = ha[4 * i + j], yv = hb[4 * i + j];
#pragma unroll
                for (int e = 0; e < 32; e += 4) {
                    const float4 w = *(const float4*)(wk + e);
                    la[e] += xv * w.x; la[e + 1] += xv * w.y; la[e + 2] += xv * w.z; la[e + 3] += xv * w.w;
                    lb[e] += yv * w.x; lb[e + 1] += yv * w.y; lb[e + 2] += yv * w.z; lb[e + 3] += yv * w.w;
                }
            }
        float r32v[32];
        {
            const bool up = lane >= 32;
#pragma unroll
            for (int e = 0; e < 32; ++e) { const float keep = up ? lb[e] : la[e], send = up ? la[e] : lb[e]; r32v[e] = keep + __shfl_xor(send, 32); }
        }
        float r16[16], r8[8], r4[4], r2[2];
        { const bool up = (lane & 16) != 0;
#pragma unroll
          for (int e = 0; e < 16; ++e) { const float keep = up ? r32v[e + 16] : r32v[e], send = up ? r32v[e] : r32v[e + 16]; r16[e] = keep + __shfl_xor(send, 16); } }
        { const bool up = (lane & 8) != 0;
#pragma unroll
          for (int e = 0; e < 8; ++e) { const float keep = up ? r16[e + 8] : r16[e], send = up ? r16[e] : r16[e + 8]; r8[e] = keep + __shfl_xor(send, 8); } }
        { const bool up = (lane & 4) != 0;
#pragma unroll
          for (int e = 0; e < 4; ++e) { const float keep = up ? r8[e + 4] : r8[e], send = up ? r8[e] : r8[e + 4]; r4[e] = keep + __shfl_xor(send, 4); } }
        { const bool up = (lane & 2) != 0;
#pragma unroll
          for (int e = 0; e < 2; ++e) { const float keep = up ? r4[e + 2] : r4[e], send = up ? r4[e] : r4[e + 2]; r2[e] = keep + __shfl_xor(send, 2); } }
        float mine;
        { const bool up = (lane & 1) != 0; const float keep = up ? r2[1] : r2[0], send = up ? r2[0] : r2[1]; mine = keep + __shfl_xor(send, 1); }
        wsc[lane] = mine + brt;
        float lg[32];
        {
            const float* wp = wsc + (lane & 32);
#pragma unroll
            for (int e = 0; e < 32; e += 4) { const float4 v = *(const float4*)(wp + e); lg[e] = v.x; lg[e + 1] = v.y; lg[e + 2] = v.z; lg[e + 3] = v.w; }
        }
        unsigned taken = 0u; float tv[4]; int ti[4];
#pragma unroll
        for (int k = 0; k < 4; ++k) {
            float best = -3.0e38f; int bi = 0;
#pragma unroll
            for (int e = 0; e < 32; ++e) { const bool ok = !((taken >> e) & 1u) && (lg[e] > best); best = ok ? lg[e] : best; bi = ok ? e : bi; }
            taken |= 1u << bi; tv[k] = best; ti[k] = bi;
        }
        const float e1 = __expf(tv[1] - tv[0]), e2 = __expf(tv[2] - tv[0]), e3 = __expf(tv[3] - tv[0]);
        const float inv = 1.f / (1.f + e1 + e2 + e3);
        if ((lane & 31) == 0) {
            const int row = ra + (lane >> 5);
            *(int4*)(p.topi + (size_t)row * 4) = make_int4(ti[0], ti[1], ti[2], ti[3]);
            *(float4*)(p.topg + (size_t)row * 4) = make_float4(inv, e1 * inv, e2 * inv, e3 * inv);
            atomicAdd(&lcnt[ti[0]], 1); atomicAdd(&lcnt[ti[1]], 1); atomicAdd(&lcnt[ti[2]], 1); atomicAdd(&lcnt[ti[3]], 1);
        }
    }
    __syncthreads();
    if (tid < 32 && lcnt[tid]) atomicAdd(&p.cnt[l * 64 + tid], lcnt[tid]);
}
__device__ __forceinline__ void ph_assign(const P& p, int l, int nrows, char* lds) {
    int* lcnt = (int*)lds; int* lbase = lcnt + 32; int* pst = lbase + 32; int* slots = pst + 32;
    const int tid = ltid(), wave = tid >> 6, lane = tid & 63;
    int* cnt = p.cnt + l * 64; int* cursor = cnt + 32;
    int* meta = p.moe_meta + l * 512;
    __syncthreads();
    if (tid == 0) { int a = 0; for (int e = 0; e < 32; ++e) { pst[e] = a; a += (cnt[e] + 255) & ~255; } if (blockIdx.x == 0) meta[0] = a >> 8; }
    __syncthreads();
    if (blockIdx.x == 0 && tid < 320) { int e = 0; for (int k = 1; k < 32; ++k) if (tid * 256 >= pst[k]) e = k; meta[1 + tid] = e; }
    const int blk0 = (blockIdx.x + gridDim.x - 64) % gridDim.x;
    for (int it = blk0; it < nrows / 64; it += gridDim.x) {
        __syncthreads();
        if (tid < 32) lcnt[tid] = 0;
        __syncthreads();
        if (wave == 0) {
            const int row = it * 64 + lane;
            const int4 ti = *(const int4*)(p.topi + (size_t)row * 4);
            const int r0 = atomicAdd(&lcnt[ti.x], 1), r1 = atomicAdd(&lcnt[ti.y], 1), r2 = atomicAdd(&lcnt[ti.z], 1), r3 = atomicAdd(&lcnt[ti.w], 1);
            __builtin_amdgcn_s_waitcnt(0xc07f);
            if (lane < 32) lbase[lane] = pst[lane] + (lcnt[lane] ? atomicAdd(&cursor[lane], lcnt[lane]) : 0);
            __builtin_amdgcn_s_waitcnt(0xc07f);
            const int4 sl = make_int4(lbase[ti.x] + r0, lbase[ti.y] + r1, lbase[ti.z] + r2, lbase[ti.w] + r3);
            *(int4*)(p.tok_slot + (size_t)row * 4) = sl;
            *(int4*)(slots + lane * 4) = sl;
        }
        __syncthreads();
        {
            const bf16_t* __restrict__ Hs = p.H; unsigned char* __restrict__ HSd = p.HS;
#define AS_LD(rr, A, B) const uint4 A = *(const uint4*)(Hs + (size_t)(it * 64 + wave * 8 + (rr)) * D + lane * 8), B = *(const uint4*)(Hs + (size_t)(it * 64 + wave * 8 + (rr)) * D + lane * 8 + 512)
#define AS_CV(V) make_uint2(__builtin_amdgcn_cvt_pk_fp8_f32(__uint_as_float(V.y << 16), __uint_as_float(V.y & 0xffff0000u), __builtin_amdgcn_cvt_pk_fp8_f32(__uint_as_float(V.x << 16), __uint_as_float(V.x & 0xffff0000u), 0u, false), true), \
                            __builtin_amdgcn_cvt_pk_fp8_f32(__uint_as_float(V.w << 16), __uint_as_float(V.w & 0xffff0000u), __builtin_amdgcn_cvt_pk_fp8_f32(__uint_as_float(V.z << 16), __uint_as_float(V.z & 0xffff0000u), 0u, false), true))
#define AS_ST(rr, A, B) do { const int4 s4 = *(const int4*)(slots + (wave * 8 + (rr)) * 4); const uint2 fa = AS_CV(A), fb = AS_CV(B); \
            unsigned char* d0 = HSd + (size_t)s4.x * D + lane * 8; *(uint2*)d0 = fa; *(uint2*)(d0 + 512) = fb; \
            unsigned char* d1 = HSd + (size_t)s4.y * D + lane * 8; *(uint2*)d1 = fa; *(uint2*)(d1 + 512) = fb; \
            unsigned char* d2 = HSd + (size_t)s4.z * D + lane * 8; *(uint2*)d2 = fa; *(uint2*)(d2 + 512) = fb; \
            unsigned char* d3 = HSd + (size_t)s4.w * D + lane * 8; *(uint2*)d3 = fa; *(uint2*)(d3 + 512) = fb; } while (0)
            AS_LD(0, a0, b0); AS_LD(1, a1, b1); AS_LD(2, a2, b2); AS_LD(3, a3, b3); AS_LD(4, a4, b4); AS_LD(5, a5, b5); AS_LD(6, a6, b6); AS_LD(7, a7, b7);
            AS_ST(0, a0, b0); AS_ST(1, a1, b1); AS_ST(2, a2, b2); AS_ST(3, a3, b3); AS_ST(4, a4, b4); AS_ST(5, a5, b5); AS_ST(6, a6, b6); AS_ST(7, a7, b7);
#undef AS_CV
#undef AS_LD
#undef AS_ST
        }
    }
}

struct EpiProj {
    static constexpr bool PERM = true, AFTER_DRAIN = false;
    bf16_t* O; const float* rope;
    __device__ __forceinline__ void operator()(const f32x4 (&acc)[2][2][4][2], const pg8::Unit& u, int wr, int wc, int fr, int fq) const {
        const int row0 = u.pm * 256 + wr * 64 + fr, col0 = u.pn * 256 + wc * 32 + 8 * fq;
        const bool do_rope = (u.pn < 2) && (u.pm < T / 256), do_gelu = (u.pn == 4) || (u.pn == 5);
        const float sc = u.pn == 0 ? QSCALE : (u.pn == 6 ? 0.125f * 1.4426950408889634f : 1.f);
        const float sgn = (fq & 1) ? 1.f : -1.f;
#pragma unroll
        for (int ai = 0; ai < 2; ++ai)
#pragma unroll
            for (int m = 0; m < 4; ++m) {
                const int row = row0 + ai * 128 + m * 16;
                bf16_t* rowp = O + (size_t)row * PW + col0;
                f32x4 cs[4];
                if (do_rope) {
                    const int s = row & 4095, pos = (fq >> 1) ? (s & 63) : (s >> 6);
                    const f32x4* rp = (const f32x4*)(rope + pos * 16);
                    cs[0] = rp[0]; cs[1] = rp[1]; cs[2] = rp[2]; cs[3] = rp[3];
                }
#pragma unroll
                for (int bj = 0; bj < 2; ++bj) {
                    f32x4 v0 = acc[ai][bj][m][0], v1 = acc[ai][bj][m][1];
                    if (do_rope) {
                        f32x4 b0, b1;
#pragma unroll
                        for (int j = 0; j < 4; ++j) { b0[j] = __shfl_xor(v0[j], 16); b1[j] = __shfl_xor(v1[j], 16); }
                        v0[0] = v0[0] * cs[0][0] + sgn * b0[0] * cs[0][1]; v0[1] = v0[1] * cs[0][2] + sgn * b0[1] * cs[0][3];
                        v0[2] = v0[2] * cs[1][0] + sgn * b0[2] * cs[1][1]; v0[3] = v0[3] * cs[1][2] + sgn * b0[3] * cs[1][3];
                        v1[0] = v1[0] * cs[2][0] + sgn * b1[0] * cs[2][1]; v1[1] = v1[1] * cs[2][2] + sgn * b1[1] * cs[2][3];
                        v1[2] = v1[2] * cs[3][0] + sgn * b1[2] * cs[3][1]; v1[3] = v1[3] * cs[3][2] + sgn * b1[3] * cs[3][3];
                    }
                    if (do_gelu) {
#pragma unroll
                        for (int j = 0; j < 4; ++j) { v0[j] = gelu_fast(v0[j]); v1[j] = gelu_fast(v1[j]); }
                    }
                    v0 = v0 * sc; v1 = v1 * sc;
                    u32x4 w; w.x = cvtpk(v0[0], v0[1]); w.y = cvtpk(v0[2], v0[3]); w.z = cvtpk(v1[0], v1[1]); w.w = cvtpk(v1[2], v1[3]);
                    *(u32x4*)(rowp + bj * 128) = w;
                }
            }
    }
};
template <bool RES_F32>
struct EpiOut {
    static constexpr bool PERM = true, AFTER_DRAIN = false;
    bf16_t* X; const float* gate; const float* res_lat; const float* res_ctx;
    __device__ __forceinline__ void operator()(const f32x4 (&acc)[2][2][4][2], const pg8::Unit& u, int wr, int wc, int fr, int fq) const {
        const int row0 = u.pm * 256 + wr * 64 + fr, col0 = u.pn * 256 + wc * 32 + 8 * fq;
        const float* g = gate + (size_t)mod_row(u.pm * 256) * 6144 + col0;
        f32x4 gv[2][2];
#pragma unroll
        for (int bj = 0; bj < 2; ++bj)
#pragma unroll
            for (int n = 0; n < 2; ++n) gv[bj][n] = *(const f32x4*)(g + bj * 128 + n * 4);
#pragma unroll
        for (int ai = 0; ai < 2; ++ai)
#pragma unroll
            for (int m = 0; m < 4; ++m) { const size_t off = (size_t)(row0 + ai * 128 + m * 16) * D + col0;
#pragma unroll
                for (int bj = 0; bj < 2; ++bj) {
                    f32x4 r0, r1;
                    if (RES_F32) { const float* rp = (u.pm < T / 256 ? res_lat : res_ctx) + off + bj * 128; r0 = *(const f32x4*)rp; r1 = *(const f32x4*)(rp + 4); }
                    else { const u32x4 w = *(const u32x4*)(X + off + bj * 128);
                        r0 = (f32x4){__uint_as_float(w.x << 16), __uint_as_float(w.x & 0xffff0000u), __uint_as_float(w.y << 16), __uint_as_float(w.y & 0xffff0000u)};
                        r1 = (f32x4){__uint_as_float(w.z << 16), __uint_as_float(w.z & 0xffff0000u), __uint_as_float(w.w << 16), __uint_as_float(w.w & 0xffff0000u)}; }
                    const f32x4 v0 = r0 + gv[bj][0] * acc[ai][bj][m][0], v1 = r1 + gv[bj][1] * acc[ai][bj][m][1];
                    u32x4 o; o.x = cvtpk(v0[0], v0[1]); o.y = cvtpk(v0[2], v0[3]); o.z = cvtpk(v1[0], v1[1]); o.w = cvtpk(v1[2], v1[3]);
                    *(u32x4*)(X + off + bj * 128) = o; } }
    }
};
__device__ __forceinline__ float swiglu(float g, float u) {
    const float gt = fminf(g, 7.0f), up = fminf(fmaxf(u, -7.0f), 7.0f);
    return (up + 1.0f) * gt * __builtin_amdgcn_rcpf(1.0f + __builtin_amdgcn_exp2f(-1.702f * 1.4426950408889634f * gt));
}
struct EpiAct {
    static constexpr bool PERM = true, AFTER_DRAIN = false;
    unsigned char* ACT; const float* bgu;
    __device__ __forceinline__ void operator()(const f32x4 (&acc)[2][2][4][2], const pg8::Unit& u, int wr, int wc, int fr, int fq) const {
        const int row0 = u.pm * 256 + wr * 64 + fr, j0 = u.pn * 128 + wc * 32 + 8 * fq;
        const float* bp = bgu + (size_t)u.e * 2048 + j0;
        const f32x4 bg0 = *(const f32x4*)(bp), bg1 = *(const f32x4*)(bp + 4), bu0 = *(const f32x4*)(bp + 1024), bu1 = *(const f32x4*)(bp + 1028);
#pragma unroll
        for (int ai = 0; ai < 2; ++ai)
#pragma unroll
            for (int m = 0; m < 4; ++m) {
                const f32x4 g0 = acc[ai][0][m][0] + bg0, g1 = acc[ai][0][m][1] + bg1, u0 = acc[ai][1][m][0] + bu0, u1 = acc[ai][1][m][1] + bu1;
                uint2 w;
                w.x = __builtin_amdgcn_cvt_pk_fp8_f32(swiglu(g0[2], u0[2]), swiglu(g0[3], u0[3]), __builtin_amdgcn_cvt_pk_fp8_f32(swiglu(g0[0], u0[0]), swiglu(g0[1], u0[1]), 0u, false), true);
                w.y = __builtin_amdgcn_cvt_pk_fp8_f32(swiglu(g1[2], u1[2]), swiglu(g1[3], u1[3]), __builtin_amdgcn_cvt_pk_fp8_f32(swiglu(g1[0], u1[0]), swiglu(g1[1], u1[1]), 0u, false), true);
                *(uint2*)(ACT + (size_t)(row0 + ai * 128 + m * 16) * FF + j0) = w;
            }
    }
};
struct EpiYB {
    static constexpr bool PERM = true, AFTER_DRAIN = false;
    bf16_t* YB; const float* bdn;
    __device__ __forceinline__ void operator()(const f32x4 (&acc)[2][2][4][2], const pg8::Unit& u, int wr, int wc, int fr, int fq) const {
        const int row0 = u.pm * 256 + wr * 64 + fr, col0 = u.pn * 256 + wc * 32 + 8 * fq;
        const float* bp = bdn + (size_t)u.e * D + col0;
        f32x4 bv[2][2];
#pragma unroll
        for (int bj = 0; bj < 2; ++bj)
#pragma unroll
            for (int n = 0; n < 2; ++n) bv[bj][n] = *(const f32x4*)(bp + bj * 128 + n * 4);
#pragma unroll
        for (int ai = 0; ai < 2; ++ai)
#pragma unroll
            for (int m = 0; m < 4; ++m) { bf16_t* rowp = YB + (size_t)(row0 + ai * 128 + m * 16) * D + col0;
#pragma unroll
                for (int bj = 0; bj < 2; ++bj) { const f32x4 v0 = acc[ai][bj][m][0] + bv[bj][0], v1 = acc[ai][bj][m][1] + bv[bj][1];
                    u32x4 w; w.x = cvtpk(v0[0], v0[1]); w.y = cvtpk(v0[2], v0[3]); w.z = cvtpk(v1[0], v1[1]); w.w = cvtpk(v1[2], v1[3]);
                    *(u32x4*)(rowp + bj * 128) = w; } }
    }
};
struct EpiDry {
    static constexpr bool PERM = true, AFTER_DRAIN = false;
    __device__ __forceinline__ void operator()(const f32x4 (&acc)[2][2][4][2], const pg8::Unit& u, int wr, int wc, int fr, int fq) const {
#pragma unroll
        for (int ai = 0; ai < 2; ++ai)
#pragma unroll
            for (int m = 0; m < 4; ++m)
#pragma unroll
                for (int bj = 0; bj < 2; ++bj) { asm volatile("" :: "v"(acc[ai][bj][m][0]), "v"(acc[ai][bj][m][1])); }
    }
};
struct MoeOrder {
    int nN, nunits, G, v; const int* tile_e;
    __device__ void init(int ntiles, int nN_, int G_, int c, const int* te) { nN = nN_; nunits = ntiles * nN_; G = G_; v = (G_ % 8 == 0) ? (c % 8) * (G_ / 8) + c / 8 : c; tile_e = te; }
    __device__ bool next(int i, pg8::Unit& u) const {
        const int L = i * G + v; if (L >= nunits) return false;
        u.pm = L / nN; u.pn = L % nN; u.e = tile_e[u.pm]; return true;
    }
    __device__ __forceinline__ const bf16_t* bt(const pg8::Gemm& g, const pg8::Unit& u) const { return g.Bt + (size_t)u.e * g.N * g.K; }
    __device__ __forceinline__ void a_ready(const pg8::Unit&) const {}
    __device__ __forceinline__ void done(const pg8::Unit&) const {}
};

__device__ __forceinline__ void ph_gemm_proj(const P& p, int l, char* lds) {
    pg8::Gemm g{p.H, p.WinT + (size_t)l * PW * D, R, PW, D}; pg8::StaticOrder S; S.init(R, PW, (int)gridDim.x, (int)blockIdx.x);
    EpiProj E{p.PROJ, p.rope};
    pg8::gemm_phase<EpiProj, pg8::StaticOrder, true, true>((PG8_LAS unsigned char*)lds, g, S, E);
}
__device__ __forceinline__ void ph_gemm_out(const P& p, int l, int nrows, char* lds) {
    pg8::Gemm g{p.MIX, p.WoutT + (size_t)l * D * D, T, D, D}; pg8::StaticOrder S; S.init(T, D, (int)gridDim.x, (int)blockIdx.x);
    if (l == 0) { EpiOut<true> E{p.X, p.mod + (size_t)l * 5 * 6144 + 2 * 1024, p.x, p.ctx - (size_t)T * D}; pg8::gemm_phase<EpiOut<true>, pg8::StaticOrder, true, true>((PG8_LAS unsigned char*)lds, g, S, E); }
    else { EpiOut<false> E{p.X, p.mod + (size_t)l * 5 * 6144 + 2 * 1024, nullptr, nullptr}; pg8::gemm_phase<EpiOut<false>, pg8::StaticOrder, true, true>((PG8_LAS unsigned char*)lds, g, S, E); }
    if (nrows > T) {
        const int tid = ltid(), lane = tid & 63, wid = tid >> 6, fr = lane & 15, fq = lane >> 4;
        const bf16_t* Wt = p.WoutT + (size_t)l * D * D;
        const float* gate = p.mod + ((size_t)l * 5 + 4) * 6144 + 2 * 1024;
        for (int it = blockIdx.x; it < (TC / 64) * (D / 64); it += gridDim.x) {
            const int m0 = T + (it >> 4) * 64 + (wid & 3) * 16, n0 = (it & 15) * 64 + (wid >> 2) * 32;
            const bf16_t* ap = p.MIX + (size_t)(m0 + fr) * D + fq * 8;
            const bf16_t* bp0 = Wt + (size_t)(n0 + fr) * D + fq * 8;
            const bf16_t* bp1 = bp0 + (size_t)16 * D;
            f32x4 acc0 = (f32x4){0.f, 0.f, 0.f, 0.f}, acc1 = acc0;
#pragma unroll 8
            for (int ks = 0; ks < D / 32; ++ks) {
                const bf16x8 af = *(const bf16x8*)(ap + ks * 32), b0 = *(const bf16x8*)(bp0 + ks * 32), b1 = *(const bf16x8*)(bp1 + ks * 32);
                acc0 = __builtin_amdgcn_mfma_f32_16x16x32_bf16(b0, af, acc0, 0, 0, 0);
                acc1 = __builtin_amdgcn_mfma_f32_16x16x32_bf16(b1, af, acc1, 0, 0, 0);
            }
            const int row = m0 + fr, c0 = n0 + fq * 4;
            const size_t off = (size_t)row * D + c0;
            const float* res = p.ctx - (size_t)T * D;
            const f32x4 v0 = *(const f32x4*)(res + off) + *(const f32x4*)(gate + c0) * acc0, v1 = *(const f32x4*)(res + off + 16) + *(const f32x4*)(gate + c0 + 16) * acc1;
            uint2 o0, o1; o0.x = cvtpk(v0[0], v0[1]); o0.y = cvtpk(v0[2], v0[3]); o1.x = cvtpk(v1[0], v1[1]); o1.y = cvtpk(v1[2], v1[3]);
            *(uint2*)(p.X + off) = o0; *(uint2*)(p.X + off + 16) = o1;
        }
    }
}
__device__ __forceinline__ void ph_moe1(const P& p, int l, char* lds, const bool dry = false) {
    const int* meta = p.moe_meta + l * 512;
    const int ntiles = meta[0];
    pg8::Gemm g{(const bf16_t*)p.HS, (const bf16_t*)(p.WguT + (size_t)l * NE * 2048 * D), ntiles * 256, 2048, D / 2}; MoeOrder S; S.init(ntiles, 8, (int)gridDim.x, (int)blockIdx.x, meta + 1);
    EpiAct E{p.ACT, p.b_gu + (size_t)l * NE * 2048};
    if (dry) { EpiDry ED; pg8::gemm_phase<EpiDry, MoeOrder, true, true, true>((PG8_LAS unsigned char*)lds, g, S, ED); }
    else pg8::gemm_phase<EpiAct, MoeOrder, true, true, true>((PG8_LAS unsigned char*)lds, g, S, E);
}
__device__ __forceinline__ void ph_moe2(const P& p, int l, char* lds) {
    const int* meta = p.moe_meta + l * 512;
    const int ntiles = meta[0];
    pg8::Gemm g{(const bf16_t*)p.ACT, (const bf16_t*)(p.WdnT + (size_t)l * NE * D * FF), ntiles * 256, D, FF / 2}; MoeOrder S; S.init(ntiles, 4, (int)gridDim.x, (int)blockIdx.x, meta + 1);
    EpiYB E{p.YB, p.b_down + (size_t)l * NE * D};
    pg8::gemm_phase<EpiYB, MoeOrder, true, true, true>((PG8_LAS unsigned char*)lds, g, S, E);
}
__device__ __forceinline__ void ph_combine(const P& p, int l, int nrows) {
    const int wave = ltid() >> 6, lane = ltid() & 63;
    for (int row = blockIdx.x * 8 + wave; row < nrows; row += gridDim.x * 8) {
        const int4 sl = *(const int4*)(p.tok_slot + (size_t)row * 4);
        const float4 g = *(const float4*)(p.topg + (size_t)row * 4);
        const float* m = p.mod + ((size_t)l * 5 + mod_row(row)) * 6144 + 5 * 1024;
        float xv[16]; float ss = 0.f;
#pragma unroll
        for (int i = 0; i < 2; ++i) {
            const int k = lane * 8 + 512 * i;
            const uint4 y0 = *(const uint4*)(p.YB + (size_t)sl.x * D + k), y1 = *(const uint4*)(p.YB + (size_t)sl.y * D + k);
            const uint4 y2 = *(const uint4*)(p.YB + (size_t)sl.z * D + k), y3 = *(const uint4*)(p.YB + (size_t)sl.w * D + k);
            const unsigned a0[4] = {y0.x, y0.y, y0.z, y0.w}, a1[4] = {y1.x, y1.y, y1.z, y1.w}, a2[4] = {y2.x, y2.y, y2.z, y2.w}, a3[4] = {y3.x, y3.y, y3.z, y3.w};
            const uint4 xw = *(const uint4*)(p.X + (size_t)row * D + k);
            const float4 gta = *(const float4*)(m + k), gtb = *(const float4*)(m + k + 4);
            const float4 xa = make_float4(__uint_as_float(xw.x << 16), __uint_as_float(xw.x & 0xffff0000u), __uint_as_float(xw.y << 16), __uint_as_float(xw.y & 0xffff0000u));
            const float4 xb = make_float4(__uint_as_float(xw.z << 16), __uint_as_float(xw.z & 0xffff0000u), __uint_as_float(xw.w << 16), __uint_as_float(xw.w & 0xffff0000u));
            const float gt[8] = {gta.x, gta.y, gta.z, gta.w, gtb.x, gtb.y, gtb.z, gtb.w};
            const float x8[8] = {xa.x, xa.y, xa.z, xa.w, xb.x, xb.y, xb.z, xb.w};
#pragma unroll
            for (int q = 0; q < 4; ++q) {
                const float ylo = g.x * __uint_as_float(a0[q] << 16) + g.y * __uint_as_float(a1[q] << 16) + g.z * __uint_as_float(a2[q] << 16) + g.w * __uint_as_float(a3[q] << 16);
                const float yhi = g.x * __uint_as_float(a0[q] & 0xffff0000u) + g.y * __uint_as_float(a1[q] & 0xffff0000u) + g.z * __uint_as_float(a2[q] & 0xffff0000u) + g.w * __uint_as_float(a3[q] & 0xffff0000u);
                const float v0 = x8[2 * q] + gt[2 * q] * ylo, v1 = x8[2 * q + 1] + gt[2 * q + 1] * yhi;
                xv[8 * i + 2 * q] = v0; xv[8 * i + 2 * q + 1] = v1; ss += v0 * v0 + v1 * v1;
            }
        }
        ss = wave_sum(ss);
        const float rstd = rsqrtf(ss * (1.f / D) + EPS);
        if (l == 0) {
            const float* m1 = p.mod + ((size_t)5 + mod_row(row)) * 6144;
            const float* g1 = p.g_mix + D;
#pragma unroll
            for (int i = 0; i < 2; ++i) {
                const int k = lane * 8 + 512 * i;
                { u32x4 xo; xo.x = cvtpk(xv[8 * i], xv[8 * i + 1]); xo.y = cvtpk(xv[8 * i + 2], xv[8 * i + 3]); xo.z = cvtpk(xv[8 * i + 4], xv[8 * i + 5]); xo.w = cvtpk(xv[8 * i + 6], xv[8 * i + 7]); *(u32x4*)(p.X + (size_t)row * D + k) = xo; }
                const float4 ga = *(const float4*)(g1 + k), gb = *(const float4*)(g1 + k + 4);
                const float4 sha = *(const float4*)(m1 + k), shb = *(const float4*)(m1 + k + 4);
                const float4 sca = *(const float4*)(m1 + 1024 + k), scb = *(const float4*)(m1 + 1024 + k + 4);
                u32x4 o;
                o.x = cvtpk(xv[8 * i] * rstd * ga.x * (1.f + sca.x) + sha.x, xv[8 * i + 1] * rstd * ga.y * (1.f + sca.y) + sha.y);
                o.y = cvtpk(xv[8 * i + 2] * rstd * ga.z * (1.f + sca.z) + sha.z, xv[8 * i + 3] * rstd * ga.w * (1.f + sca.w) + sha.w);
                o.z = cvtpk(xv[8 * i + 4] * rstd * gb.x * (1.f + scb.x) + shb.x, xv[8 * i + 5] * rstd * gb.y * (1.f + scb.y) + shb.y);
                o.w = cvtpk(xv[8 * i + 6] * rstd * gb.z * (1.f + scb.z) + shb.z, xv[8 * i + 7] * rstd * gb.w * (1.f + scb.w) + shb.w);
                *(u32x4*)(p.H + (size_t)row * D + k) = o;
            }
        } else {
#pragma unroll
            for (int i = 0; i < 2; ++i) {
                const int k = lane * 8 + 512 * i;
                const float4 ga = *(const float4*)(p.g_final + k), gb = *(const float4*)(p.g_final + k + 4);
                float* op = p.out + (size_t)row * D + k;
                *(float4*)op = make_float4(xv[8 * i] * rstd * ga.x, xv[8 * i + 1] * rstd * ga.y, xv[8 * i + 2] * rstd * ga.z, xv[8 * i + 3] * rstd * ga.w);
                *(float4*)(op + 4) = make_float4(xv[8 * i + 4] * rstd * gb.x, xv[8 * i + 5] * rstd * gb.y, xv[8 * i + 6] * rstd * gb.z, xv[8 * i + 7] * rstd * gb.w);
            }
        }
    }
}
#ifndef PROBE_DUP
#define PROBE_DUP 0
#endif
#ifndef PROBE_DUP
#define PROBE_DUP 0
#endif
extern __shared__ __attribute__((aligned(16))) char smem[];
__global__ void __launch_bounds__(NT, 2) mega(P p) {
    char* lds = smem;
    if (threadIdx.x == 0) *(uint4*)(smem + LDS_MAIN) = make_uint4(0u, 0u, 0u, 0u);
    __syncthreads();
    XcdBarrier bar = xcd_barrier_post(p.bar, (volatile LAS unsigned*)(smem + LDS_MAIN));
    ph_prologue(p, lds, 0);
    if (PROBE_DUP == 11) ph_prologue(p, lds, 0);
    xcd_barrier(bar);
    ph_norm1(p, 0);
    ph_prologue(p, lds, 1);
    if (PROBE_DUP == 1) ph_prologue(p, lds, 1);
    if (PROBE_DUP == 5) ph_norm1(p, 0);
    xcd_barrier(bar);
#pragma unroll
    for (int l = 0; l < 2; ++l) {
        const int nrows = l == 0 ? R : T;
        ph_gemm_proj(p, l, lds);
        if (PROBE_DUP == 4) ph_gemm_proj(p, l, lds);
        xcd_barrier(bar);
        ph_dattn(p, l, nrows, lds);
        if (PROBE_DUP == 2) ph_dattn(p, l, nrows, lds);
        ph_na(p, l, nrows, lds);
        if (PROBE_DUP == 5) ph_na(p, l, nrows, lds);
        ph_pool(p, l, nrows, lds);
        ph_sgu(p, l, nrows, lds);
        if (PROBE_DUP == 3) { ph_pool(p, l, nrows, lds); ph_sgu(p, l, nrows, lds); }
        xcd_barrier(bar);
        ph_gemm_out(p, l, nrows, lds);
        if (PROBE_DUP == 12 && l == 0) ph_gemm_out(p, l, nrows, lds);
        xcd_barrier(bar);
        ph_router(p, l, nrows, lds);
        xcd_barrier(bar);
        ph_assign(p, l, nrows, lds);
        xcd_barrier(bar);
        if (PROBE_DUP == 8) { xcd_barrier(bar); xcd_barrier(bar); xcd_barrier(bar); xcd_barrier(bar); xcd_barrier(bar); }
        ph_moe1(p, l, lds);
        if (PROBE_DUP == 6) ph_moe1(p, l, lds);
        if (PROBE_DUP == 13) ph_moe1(p, l, lds, true);
        xcd_barrier(bar);
        ph_moe2(p, l, lds);
        if (PROBE_DUP == 7) ph_moe2(p, l, lds);
        xcd_barrier(bar);
        ph_combine(p, l, nrows);
        if (l == 0) xcd_barrier(bar);
    }
}

static inline size_t align_up(size_t v, size_t a) { return (v + a - 1) / a * a; }

extern "C" void kernel_launch(void* const* d_in, const int* in_sizes, int n_in, void* d_out, int out_size, void* d_ws, size_t ws_size, hipStream_t stream) {
    P p{};
    const float** ins = (const float**)&p.x;
    for (int i = 0; i < 28; ++i) ins[i] = (const float*)d_in[i];
    p.out = (float*)d_out;
    char* w = (char*)d_ws; size_t off = 0;
    auto carve = [&](size_t bytes) { void* r = w + off; off = align_up(off + bytes, 256); return r; };
    const size_t ctl_bytes = XCD_BAR_WORDS * 4 + 2 * 64 * 4;
    p.bar = (unsigned*)carve(ctl_bytes);
    p.cnt = (int*)(p.bar + XCD_BAR_WORDS);
    p.mod = (float*)carve((size_t)2 * 5 * 6144 * 4);
    p.rope = (float*)carve(64 * 8 * 2 * 4);
    p.X = (bf16_t*)carve((size_t)R * D * 2);
    p.H = (bf16_t*)carve((size_t)R * D * 2);
    p.PROJ = (bf16_t*)carve((size_t)R * PW * 2);
    p.MIX = (bf16_t*)carve((size_t)R * D * 2);
    p.WinT = (bf16_t*)carve((size_t)2 * PW * D * 2);
    p.WoutT = (bf16_t*)carve((size_t)2 * D * D * 2);
    p.WguT = (unsigned char*)carve((size_t)2 * NE * 2048 * D);
    p.WdnT = (unsigned char*)carve((size_t)2 * NE * D * FF);
    p.WpT = (bf16_t*)carve((size_t)2 * 4 * 64 * 64 * 2);
    p.WsB = (bf16_t*)carve((size_t)2 * 4 * 128 * 128 * 2);
    p.topi = (int*)carve((size_t)R * 4 * 4);
    p.topg = (float*)carve((size_t)R * 4 * 4);
    p.tok_slot = (int*)carve((size_t)R * 4 * 4);
    p.moe_meta = (int*)carve(2 * 512 * 4);
    p.HS = (unsigned char*)carve((size_t)NSLOT * D);
    p.ACT = (unsigned char*)carve((size_t)NSLOT * FF);
    p.YB = (bf16_t*)carve((size_t)NSLOT * D * 2);

    static int grid = 0;
    if (!grid) {
        int dev = 0, cus = 0, per_cu = 0;
        (void)hipGetDevice(&dev);
        (void)hipDeviceGetAttribute(&cus, hipDeviceAttributeMultiprocessorCount, dev);
        (void)hipFuncSetAttribute((const void*)mega, hipFuncAttributeMaxDynamicSharedMemorySize, LDS_BYTES);
        (void)hipOccupancyMaxActiveBlocksPerMultiprocessor(&per_cu, mega, NT, LDS_BYTES);
        grid = cus * (per_cu < 1 ? per_cu : 1);
        if (grid <= 0) { fprintf(stderr, "mega: occupancy query returned %d blocks per CU\n", per_cu); grid = 0; return; }
    }
    (void)hipMemsetAsync(p.bar, 0, ctl_bytes, stream);
    mega<<<grid, NT, LDS_BYTES, stream>>>(p);
}
```

```cpp
#include <hip/hip_runtime.h>
#include <stdint.h>
#include <cstdio>

typedef unsigned short bf16_t;
typedef short bf16x8 __attribute__((ext_vector_type(8)));
typedef float f32x4 __attribute__((ext_vector_type(4)));

constexpr int D = 1024, NB = 4, S = 4096, T = NB * S, CL = 256, TC = NB * CL, R = T + TC;
constexpr int PW = 2304, NE = 32, TOPK = 4, FF = 1024;
constexpr int MAXSLOT = R * TOPK;
constexpr int NSLOT = MAXSLOT + NE * 256;
constexpr float EPS = 1e-6f;
constexpr int NT = 512;
constexpr int LDS_MAIN = 150 * 1024;
constexpr int LDS_BYTES = LDS_MAIN + 1024;

__device__ __forceinline__ bf16_t f2bf(float f) { unsigned u = __float_as_uint(f); return (bf16_t)((u + 0x7fffu + ((u >> 16) & 1u)) >> 16); }
__device__ __forceinline__ float bf2f(bf16_t h) { return __uint_as_float(((unsigned)h) << 16); }
__device__ __forceinline__ float wave_sum(float v) {
#pragma unroll
    for (int o = 32; o >= 1; o >>= 1) v += __shfl_xor(v, o);
    return v;
}
__device__ __forceinline__ int mod_row(int row) { return row < T ? (row >> 12) : 4; }

#define XB_TMO      128
#define XB_XCNT(j)  (256  + 64 * (j))
#define XB_XSUB(j)  (1280 + 64 * (j))
#define XB_XGEN(j)  (2304 + 64 * (j))
#define XB_TOP      3328
#define XB_TOPGEN   3392
#define XCD_BAR_WORDS 3456
#define XB_SPIN_CAP (1u << 18)
#define LAS __attribute__((address_space(3)))

__device__ __forceinline__ unsigned xb_ld(unsigned* p)              { return __hip_atomic_load(p, __ATOMIC_RELAXED, __HIP_MEMORY_SCOPE_AGENT); }
__device__ __forceinline__ unsigned xb_add(unsigned* p, unsigned v) { return __hip_atomic_fetch_add(p, v, __ATOMIC_RELAXED, __HIP_MEMORY_SCOPE_AGENT); }
__device__ __forceinline__ unsigned xb_xcc_id() { return (unsigned)__builtin_amdgcn_s_getreg((3 << 11) | 20) & 0xFu; }
#define XB_SPIN(cond, bar) do { unsigned _sp = 0; while (cond) { __builtin_amdgcn_s_sleep(1); \
    if ((++_sp & 255u) == 0u) { if (xb_ld(&(bar)[XB_TMO])) break; if (_sp > XB_SPIN_CAP) { atomicAdd(&(bar)[XB_TMO], 1u); break; } } } } while (0)

struct XcdBarrier {
    unsigned* bar; unsigned x;
    volatile LAS unsigned* st;
};
__device__ __forceinline__ XcdBarrier xcd_barrier_post(unsigned* bar, volatile LAS unsigned* st) {
    XcdBarrier b; b.bar = bar; b.x = xb_xcc_id(); b.st = st;
    if (threadIdx.x == 0) (void)xb_add(&bar[XB_XCNT(b.x)], 1u);
    return b;
}
__device__ __forceinline__ void xcd_barrier_complete(unsigned* bar, unsigned x, unsigned& nloc, unsigned& nx) {
    const unsigned G = gridDim.x * gridDim.y * gridDim.z;
    unsigned sum, cnt, mine, sp = 0u;
    for (;;) {
        sum = 0u; cnt = 0u; mine = 0u;
#pragma unroll
        for (unsigned j = 0; j < 16; ++j) { const unsigned c = xb_ld(&bar[XB_XCNT(j)]); sum += c; cnt += (c > 0u) ? 1u : 0u; mine = (j == x) ? c : mine; }
        if (sum == G) break;
        __builtin_amdgcn_s_sleep(1);
        if ((++sp & 255u) == 0u) { if (xb_ld(&bar[XB_TMO])) break; if (sp > XB_SPIN_CAP) { atomicAdd(&bar[XB_TMO], 1u); break; } }
    }
    nloc = mine > 0u ? mine : 1u; nx = cnt > 0u ? cnt : 1u;
}
__device__ __forceinline__ void xcd_barrier(const XcdBarrier& b) {
    asm volatile("s_waitcnt vmcnt(0)" ::: "memory");
    __syncthreads();
    if (threadIdx.x == 0) {
        unsigned* bar = b.bar;
        __builtin_amdgcn_s_waitcnt(0);
        unsigned nloc = b.st[0], nx = b.st[1];
        if (nloc == 0u) { xcd_barrier_complete(bar, b.x, nloc, nx); b.st[0] = nloc; b.st[1] = nx; }
        const unsigned old = xb_add(&bar[XB_XSUB(b.x)], 1u);
        const unsigned gen = old / nloc;
        if (old + 1u == (gen + 1u) * nloc) {
            __builtin_amdgcn_fence(__ATOMIC_RELEASE, "agent");
            asm volatile("s_waitcnt vmcnt(0)" ::: "memory");
            const unsigned og = xb_add(&bar[XB_TOP], 1u);
            const unsigned tg = og / nx;
            if (og + 1u == (tg + 1u) * nx) xb_add(&bar[XB_TOPGEN], 1u);
            else XB_SPIN(xb_ld(&bar[XB_TOPGEN]) == tg, bar);
            __builtin_amdgcn_fence(__ATOMIC_ACQUIRE, "agent");
            xb_add(&bar[XB_XGEN(b.x)], 1u);
            asm volatile("s_waitcnt vmcnt(0)" ::: "memory");
        } else {
            XB_SPIN(xb_ld(&bar[XB_XGEN(b.x)]) == gen, bar);
            __builtin_amdgcn_fence(__ATOMIC_ACQUIRE, "agent");
            asm volatile("s_waitcnt vmcnt(0)" ::: "memory");
        }
    }
    __syncthreads();
}

struct P {
    const float *x, *c, *ctx, *c_ctx, *w_mod, *b_mod, *g_mix, *g_ffn, *w_in, *w_out, *lam_q1, *lam_k1, *lam_q2, *lam_k2, *g_sub,
        *w_pool, *s_pool, *g_sgu, *w_sgu, *b_sgu, *rpb, *w_router, *b_router, *w_gu, *b_gu, *w_down, *b_down, *g_final;
    float* out;
    unsigned* bar;
    int* cnt;
    float* mod;
    float* rope;
    bf16_t* X;
    bf16_t* H;
    bf16_t* PROJ;
    bf16_t* MIX;
    bf16_t* WinT;
    bf16_t* WoutT;
    unsigned char* WguT;
    unsigned char* WdnT;
    bf16_t* WpT;
    bf16_t* WsB;
    int* topi;
    float* topg;
    int* tok_slot;
    int* moe_meta;
    unsigned char* HS;
    unsigned char* ACT;
    bf16_t* YB;
};

__device__ __forceinline__ int ltid() { int t = threadIdx.x; asm volatile("" : "+v"(t)); return t; }
typedef float f32x16 __attribute__((ext_vector_type(16)));
typedef short s16x4 __attribute__((ext_vector_type(4)));
typedef short v4i16_t __attribute__((ext_vector_type(4)));
typedef float f32x2_t __attribute__((ext_vector_type(2)));
typedef __bf16 bf16x2_t __attribute__((ext_vector_type(2)));
typedef __attribute__((address_space(3))) const char* lds_cptr;
typedef unsigned u32x4 __attribute__((ext_vector_type(4)));
__device__ __forceinline__ unsigned cvtpk(float lo, float hi) { f32x2_t v = {lo, hi}; bf16x2_t b = __builtin_convertvector(v, bf16x2_t); return __builtin_bit_cast(unsigned, b); }
__device__ __forceinline__ s16x4 vtr(lds_cptr q) { return __builtin_bit_cast(s16x4, __builtin_amdgcn_ds_read_tr16_b64_v4i16((__attribute__((address_space(3))) v4i16_t*)q)); }
__device__ __forceinline__ float xhalf_max(float v) { auto rr = __builtin_amdgcn_permlane32_swap(__float_as_uint(v), __float_as_uint(v), false, false); return fmaxf(__uint_as_float(rr[0]), __uint_as_float(rr[1])); }
__device__ __forceinline__ float xhalf_sum(float v) { auto rr = __builtin_amdgcn_permlane32_swap(__float_as_uint(v), __float_as_uint(v), false, false); return __uint_as_float(rr[0]) + __uint_as_float(rr[1]); }
namespace pg8 {
#define PG8_LAS __attribute__((address_space(3)))
constexpr int BM = 256, BK = 64, HALF = 128, HTB = HALF * BK * 2  , STAGE_BYTES = 8 * HTB, NXCD = 8, WGM = 8;
__host__ __device__ __forceinline__ int lds_byte(int r, int c) { const int st = (r >> 4) * 2 + (c >> 5), rr = r & 15, cc = c & 31, ob = rr * 64 + cc * 2; return st * 1024 + (ob ^ (((ob >> 9) & 1) << 5)); }
__host__ __device__ __forceinline__ void stage_rc(int b, int& R, int& C) { const int st = b / 1024, sb = b % 1024, swz = sb ^ (((sb >> 9) & 1) << 5); R = (st >> 1) * 16 + swz / 64; C = (st & 1) * 32 + (swz % 64) / 2; }
__host__ __device__ __forceinline__ int perm32(int rho) { const int n = rho >> 4, i = rho & 15; return 8 * (i >> 2) + 4 * n + (i & 3); }
struct Unit { int pm, pn, e; };
struct Gemm { const bf16_t* A; const bf16_t* Bt; int M, N, K; };
struct StaticOrder {
    int nM, nN, nwg, G, c;
    __host__ __device__ void init(int M, int N, int G_, int c_) { nM = M / BM; nN = N / BM; nwg = nM * nN; G = G_; c = c_; }
    __host__ __device__ bool next(int i, Unit& u) const {
        const long L = (long)i * G + c; if (L >= nwg) return false;
        int wgid = (int)L; { const int q = nwg / NXCD, r = nwg % NXCD, xcd = wgid % NXCD, off = wgid / NXCD; wgid = (xcd < r ? xcd * (q + 1) : r * (q + 1) + (xcd - r) * q) + off; }
        const int nig = WGM * nN, gid = wgid / nig, fm = gid * WGM, gsz = (nM - fm) < WGM ? (nM - fm) : WGM;
        u.pm = fm + ((wgid % nig) % gsz); u.pn = (wgid % nig) / gsz; u.e = 0; return true;
    }
    __device__ __forceinline__ const bf16_t* bt(const Gemm& g, const Unit&) const { return g.Bt; }
    __device__ __forceinline__ void a_ready(const Unit&) const {}
    __device__ __forceinline__ void done(const Unit&) const {}
};
typedef int v4i_t __attribute__((ext_vector_type(4)));
typedef int v8i_t __attribute__((ext_vector_type(8)));
__device__ __forceinline__ v8i_t cat8(bf16x8 a, bf16x8 b) { const v4i_t x = __builtin_bit_cast(v4i_t, a), y = __builtin_bit_cast(v4i_t, b); return __builtin_shufflevector(x, y, 0, 1, 2, 3, 4, 5, 6, 7); }
template <class Epi, class Sched, bool ALIGN_EPI = false, bool SP2 = false, bool F8 = false>
__device__ __forceinline__ void gemm_phase(PG8_LAS unsigned char* lds, const Gemm g, const Sched& S, const Epi& E) {
    const int tid = ltid(), wid = __builtin_amdgcn_readfirstlane(tid >> 6), lane = tid & 63, wr = wid >> 2, wc = wid & 3, fr = lane & 15, fq = lane >> 4;
    const int K = g.K, nt = K / BK;
    unsigned voffA[2], voffB[2];
#pragma unroll
    for (int i = 0; i < 2; ++i) { int R, C; stage_rc(tid * 16 + i * 8192, R, C); const int Rb = Epi::PERM ? ((R & ~31) + perm32(R & 31)) : R;
        voffA[i] = (unsigned)(R * K + C) * 2u; voffB[i] = (unsigned)(Rb * K + C) * 2u; }
    const size_t kstep = (size_t)(BK * 2);
    const size_t hstep = (size_t)HALF * K * 2;
    const size_t tstep = 2 * hstep;
    const unsigned ldsw = (unsigned)wid * 1024u;
    const int aoff = lds_byte(wr * 64 + fr, fq * 8), boff = lds_byte(wc * 32 + fr, fq * 8);
#define PG8_SA(b, h) (((b) * 2 + (h)) * HTB)
#define PG8_SB(b, h) ((4 + (b) * 2 + (h)) * HTB)
#define PG8_STAGE(bufoff, gbase, voff) do { _Pragma("unroll") for (int _i = 0; _i < 2; ++_i) \
        __builtin_amdgcn_global_load_lds((const unsigned*)((const char*)(gbase) + (voff)[_i]), (PG8_LAS unsigned*)(lds + (bufoff) + ldsw + _i * 8192), 16, 0, 0); } while (0)
#define PG8_LDA(dst, b, h) do { _Pragma("unroll") for (int m = 0; m < 4; ++m) _Pragma("unroll") for (int k = 0; k < 2; ++k) dst[m][k] = *(const PG8_LAS bf16x8*)(lds + PG8_SA(b, h) + aoff + m * 2048 + k * 1024); \
        if constexpr (F8) { _Pragma("unroll") for (int m = 0; m < 4; ++m) dst##8[m] = cat8(dst[m][0], dst[m][1]); } } while (0)
#define PG8_LDB(dst, b, h) do { _Pragma("unroll") for (int n = 0; n < 2; ++n) _Pragma("unroll") for (int k = 0; k < 2; ++k) dst[n][k] = *(const PG8_LAS bf16x8*)(lds + PG8_SB(b, h) + boff + n * 2048 + k * 1024); \
        if constexpr (F8) { _Pragma("unroll") for (int n = 0; n < 2; ++n) dst##8[n] = cat8(dst[n][0], dst[n][1]); } } while (0)
#define PG8_MMA(ai, bj, At, Bt) do { __builtin_amdgcn_s_setprio(1); \
        if constexpr (F8) { _Pragma("unroll") for (int m = 0; m < 4; ++m) _Pragma("unroll") for (int n = 0; n < 2; ++n) \
            asm volatile("v_mfma_scale_f32_16x16x128_f8f6f4 %0, %1, %2, %0, %3, %4 op_sel_hi:[0,0,0]" : "+v"(acc[ai][bj][m][n]) : "v"(Bt##8[n]), "v"(At##8[m]), "v"(sclW), "v"(sclX)); } \
        else { _Pragma("unroll") for (int m = 0; m < 4; ++m) _Pragma("unroll") for (int n = 0; n < 2; ++n) _Pragma("unroll") for (int k = 0; k < 2; ++k) \
            acc[ai][bj][m][n] = __builtin_amdgcn_mfma_f32_16x16x32_bf16(Bt[n][k], At[m][k], acc[ai][bj][m][n], 0, 0, 0); } \
        __builtin_amdgcn_s_setprio(0); } while (0)
#define PG8_WAIT_V(n) asm volatile("s_waitcnt vmcnt(" #n ")" ::: "memory")
#define PG8_WAIT_L(n) asm volatile("s_waitcnt lgkmcnt(" #n ")" ::: "memory")
#define PG8_BAR __builtin_amdgcn_s_barrier()
#define PG8_SCHED __builtin_amdgcn_sched_barrier(0)
    Unit cur, nxt; int ui = 0;
    if (!S.next(0, cur)) return;
    f32x4 acc[2][2][4][2];
#pragma unroll
    for (int a = 0; a < 2; ++a)
#pragma unroll
        for (int b = 0; b < 2; ++b)
#pragma unroll
            for (int m = 0; m < 4; ++m)
#pragma unroll
                for (int n = 0; n < 2; ++n) { acc[a][b][m][n] = (f32x4){0.f, 0.f, 0.f, 0.f}; }
    bf16x8 At[4][2], B0[2][2], B1[2][2];
    v8i_t At8[4], B08[2], B18[2];
    const int sclW = 0x79797979, sclX = 0x7f7f7f7f;
    const char* cA = (const char*)g.A + (size_t)cur.pm * tstep; const char* cB = (const char*)S.bt(g, cur) + (size_t)cur.pn * tstep;
    S.a_ready(cur);
    if constexpr (SP2) {
        PG8_STAGE(PG8_SB(0, 0), cB, voffB); PG8_STAGE(PG8_SB(0, 1), cB + hstep, voffB); PG8_STAGE(PG8_SA(0, 0), cA, voffA); PG8_STAGE(PG8_SA(0, 1), cA + hstep, voffA);
        if (wr == 1) PG8_BAR;
        PG8_WAIT_V(2); PG8_BAR;
        PG8_STAGE(PG8_SB(1, 0), cB + kstep, voffB); PG8_STAGE(PG8_SA(1, 0), cA + kstep, voffA); PG8_STAGE(PG8_SB(1, 1), cB + hstep + kstep, voffB);
        PG8_WAIT_V(6); PG8_BAR;
    } else {
        PG8_STAGE(PG8_SB(0, 0), cB, voffB); PG8_STAGE(PG8_SA(0, 0), cA, voffA); PG8_STAGE(PG8_SB(0, 1), cB + hstep, voffB); PG8_STAGE(PG8_SA(0, 1), cA + hstep, voffA);
        if (wr == 1) PG8_BAR;
        PG8_WAIT_V(4); PG8_BAR;
        PG8_STAGE(PG8_SB(1, 0), cB + kstep, voffB); PG8_STAGE(PG8_SA(1, 0), cA + kstep, voffA); PG8_STAGE(PG8_SB(1, 1), cB + hstep + kstep, voffB);
        PG8_WAIT_V(6); PG8_BAR;
    }
    for (;;) {
        const bool has_next = S.next(ui + 1, nxt);
        const char* nA = has_next ? (const char*)g.A + (size_t)nxt.pm * tstep : cA; const char* nB = has_next ? (const char*)S.bt(g, nxt) + (size_t)nxt.pn * tstep : cB;
#pragma unroll 1
        for (int t = 0; t < nt; t += 2) {
            const bool last = (t == nt - 2);
            const char* a1 = cA + (size_t)(t + 1) * kstep;
            const char* a2 = last ? nA : cA + (size_t)(t + 2) * kstep; const char* b2 = last ? nB : cB + (size_t)(t + 2) * kstep;
            const char* a3 = a2 + kstep; const char* b3 = b2 + kstep;
            if (last && has_next) S.a_ready(nxt);
            if constexpr (SP2) {
            PG8_LDB(B0, 0, 0); PG8_LDB(B1, 0, 1); PG8_SCHED; PG8_LDA(At, 0, 0); PG8_STAGE(PG8_SA(1, 1), a1 + hstep, voffA);
            PG8_WAIT_V(8); PG8_WAIT_L(0); PG8_BAR; PG8_MMA(0, 0, At, B0); PG8_MMA(0, 1, At, B1); PG8_BAR; PG8_SCHED;
            PG8_LDA(At, 0, 1); PG8_STAGE(PG8_SB(0, 0), b2, voffB); PG8_STAGE(PG8_SB(0, 1), b2 + hstep, voffB); PG8_STAGE(PG8_SA(0, 0), a2, voffA);
            PG8_WAIT_V(8); PG8_WAIT_L(0); PG8_BAR; PG8_MMA(1, 0, At, B0); PG8_MMA(1, 1, At, B1); PG8_BAR; PG8_SCHED;
            PG8_LDB(B0, 1, 0); PG8_LDB(B1, 1, 1); PG8_SCHED; PG8_LDA(At, 1, 0); PG8_STAGE(PG8_SA(0, 1), a2 + hstep, voffA);
            PG8_WAIT_V(8); PG8_WAIT_L(0); PG8_BAR; PG8_MMA(0, 0, At, B0); PG8_MMA(0, 1, At, B1); PG8_BAR; PG8_SCHED;
            PG8_LDA(At, 1, 1); PG8_STAGE(PG8_SB(1, 0), b3, voffB); PG8_STAGE(PG8_SB(1, 1), b3 + hstep, voffB); PG8_STAGE(PG8_SA(1, 0), a3, voffA);
            PG8_WAIT_V(8); PG8_WAIT_L(0); PG8_BAR; PG8_MMA(1, 0, At, B0); PG8_MMA(1, 1, At, B1); PG8_BAR; PG8_SCHED;
            } else {
            PG8_LDB(B0, 0, 0); PG8_SCHED; PG8_LDA(At, 0, 0); PG8_STAGE(PG8_SA(1, 1), a1 + hstep, voffA);
            PG8_WAIT_L(8); PG8_BAR; PG8_WAIT_L(0); PG8_MMA(0, 0, At, B0); PG8_BAR; PG8_SCHED;
            PG8_LDB(B1, 0, 1); PG8_STAGE(PG8_SB(0, 0), b2, voffB);
            PG8_BAR; PG8_WAIT_L(0); PG8_MMA(0, 1, At, B1); PG8_BAR;
            PG8_LDA(At, 0, 1); PG8_STAGE(PG8_SA(0, 0), a2, voffA);
            PG8_BAR; PG8_WAIT_L(0); PG8_MMA(1, 0, At, B0); PG8_BAR; PG8_SCHED;
            PG8_STAGE(PG8_SB(0, 1), b2 + hstep, voffB);
            PG8_WAIT_V(6); PG8_BAR; PG8_MMA(1, 1, At, B1); PG8_BAR;
            PG8_LDB(B0, 1, 0); PG8_SCHED; PG8_LDA(At, 1, 0); PG8_STAGE(PG8_SA(0, 1), a2 + hstep, voffA);
            PG8_WAIT_L(8); PG8_BAR; PG8_WAIT_L(0); PG8_MMA(0, 0, At, B0); PG8_BAR; PG8_SCHED;
            PG8_LDB(B1, 1, 1); PG8_STAGE(PG8_SB(1, 0), b3, voffB);
            PG8_BAR; PG8_WAIT_L(0); PG8_MMA(0, 1, At, B1); PG8_BAR;
            PG8_LDA(At, 1, 1); PG8_STAGE(PG8_SA(1, 0), a3, voffA);
            PG8_BAR; PG8_WAIT_L(0); PG8_MMA(1, 0, At, B0); PG8_BAR; PG8_SCHED;
            PG8_STAGE(PG8_SB(1, 1), b3 + hstep, voffB);
            PG8_WAIT_V(6); PG8_BAR; PG8_MMA(1, 1, At, B1); PG8_BAR;
            }
        }
        if constexpr (ALIGN_EPI) { if (wr == 0) PG8_BAR; }
        if constexpr (F8) asm volatile("s_nop 15\n\ts_nop 15" ::: "memory");
        if constexpr (!Epi::AFTER_DRAIN) { E(acc, cur, wr, wc, fr, fq); S.done(cur); }
        if (!has_next) break;
#pragma unroll
        for (int a = 0; a < 2; ++a)
#pragma unroll
            for (int b = 0; b < 2; ++b)
#pragma unroll
                for (int m = 0; m < 4; ++m)
#pragma unroll
                    for (int n = 0; n < 2; ++n) { acc[a][b][m][n] = (f32x4){0.f, 0.f, 0.f, 0.f}; }
        cur = nxt; cA = nA; cB = nB; ++ui;
        if constexpr (ALIGN_EPI) { if (wr == 1) PG8_BAR; }
    }
    PG8_WAIT_V(0);
    if constexpr (!ALIGN_EPI) { if (wr == 0) PG8_BAR; }
    PG8_BAR;
    if constexpr (Epi::AFTER_DRAIN) { E.fused(acc, cur, wr, wc, fr, fq, lds, wid, lane); S.done(cur); }
#undef PG8_SA
#undef PG8_SB
#undef PG8_STAGE
#undef PG8_LDA
#undef PG8_LDB
#undef PG8_MMA
#undef PG8_WAIT_V
#undef PG8_WAIT_L
#undef PG8_BAR
#undef PG8_SCHED
}
}

__device__ __forceinline__ void ph_prologue(const P& p, char* lds, const int part) {
    const int tid = ltid();
    float* fl = (float*)lds;
    if (part == 0) {
    for (int it = blockIdx.x; it < 192; it += gridDim.x) {
        const int l = it / 96, cg = it % 96;
        float* sc = fl;
        float* part = fl + 5 * 1024;
        __syncthreads();
        for (int i = tid; i < 5 * 1024; i += NT) {
            const int r = i >> 10, k = i & 1023;
            const float v = r < 4 ? p.c[r * 1024 + k] : p.c_ctx[k];
            sc[i] = v / (1.f + __expf(-v));
        }
        __syncthreads();
        const int kq = tid >> 6, col = tid & 63, j = cg * 64 + col;
        const float* W = p.w_mod + (size_t)l * 1024 * 6144 + j;
        float a0 = 0, a1 = 0, a2 = 0, a3 = 0, a4 = 0;
#pragma unroll 16
        for (int k = kq * 128; k < kq * 128 + 128; ++k) {
            const float w = W[(size_t)k * 6144];
            a0 += sc[k] * w; a1 += sc[1024 + k] * w; a2 += sc[2048 + k] * w; a3 += sc[3072 + k] * w; a4 += sc[4096 + k] * w;
        }
        part[(kq * 5 + 0) * 64 + col] = a0; part[(kq * 5 + 1) * 64 + col] = a1; part[(kq * 5 + 2) * 64 + col] = a2;
        part[(kq * 5 + 3) * 64 + col] = a3; part[(kq * 5 + 4) * 64 + col] = a4;
        __syncthreads();
        if (tid < 5 * 64) {
            const int r = tid >> 6, cc = tid & 63, jj = cg * 64 + cc;
            float v = 0.f;
#pragma unroll
            for (int q = 0; q < 8; ++q) v += part[(q * 5 + r) * 64 + cc];
            p.mod[((size_t)l * 5 + r) * 6144 + jj] = v + p.b_mod[l * 6144 + jj];
        }
    }
    if (blockIdx.x == gridDim.x - 1) {
        const int pos = tid >> 3, f = tid & 7;
        const float inv = powf(10000.0f, -(float)f / 8.0f);
        const float ang = (float)pos * inv;
        p.rope[tid * 2] = cosf(ang); p.rope[tid * 2 + 1] = sinf(ang);
    }
    for (int i = blockIdx.x * NT + tid; i < 2 * 4 * 64 * 64; i += gridDim.x * NT) { const int ii = i & 63, j = (i >> 6) & 63, lg = i >> 12; p.WpT[i] = f2bf(p.w_pool[(size_t)lg * 4096 + ii * 64 + j]); }
    for (int i = blockIdx.x * NT + tid; i < 2 * 4 * 128 * 128; i += gridDim.x * NT) p.WsB[i] = f2bf(p.w_sgu[i]);
    }
    if (part == 0) {
        const int n_in = 2 * 9 * 16, n_out = 2 * 4 * 16, total = n_in + n_out;
        const int kr = tid >> 6, n4 = tid & 63, kg = tid & 7, nl = tid >> 3;
        for (int it = blockIdx.x; it < total; it += gridDim.x) {
            int i_ = it; const float* W_; bf16_t* Wt_; int N, K;
            if (i_ < n_in) { W_ = p.w_in; Wt_ = p.WinT; N = PW; K = D; } else { i_ -= n_in; W_ = p.w_out; Wt_ = p.WoutT; N = D; K = D; }
            const int ntn = N / 256, per = ntn * (K / 64), m_ = i_ / per, r_ = i_ % per, tn = r_ % ntn, tk = r_ / ntn, n0 = tn * 256;
            const float* src = W_ + (size_t)m_ * K * N + (size_t)(tk * 64) * N + n0; bf16_t* dst = Wt_ + (size_t)m_ * K * N + tk * 64;
            float4 rg[8];
#pragma unroll
            for (int i = 0; i < 8; ++i) rg[i] = *(const float4*)(src + (size_t)(kr + 8 * i) * N + n4 * 4);
            __syncthreads();
#pragma unroll
            for (int i = 0; i < 8; ++i) { float* q = fl + (kr + 8 * i) * 257 + n4 * 4; q[0] = rg[i].x; q[1] = rg[i].y; q[2] = rg[i].z; q[3] = rg[i].w; }
            __syncthreads();
#pragma unroll
            for (int j = 0; j < 4; ++j) {
                const int n = nl + 64 * j;
                const float* q = fl + (8 * kg) * 257 + n;
                u32x4 w;
                w.x = cvtpk(q[0], q[257]); w.y = cvtpk(q[2 * 257], q[3 * 257]); w.z = cvtpk(q[4 * 257], q[5 * 257]); w.w = cvtpk(q[6 * 257], q[7 * 257]);
                *(u32x4*)(dst + (size_t)(n0 + n) * K + 8 * kg) = w;
            }
        }
    } else {
        const int n_gu = 64 * 16 * 8, n_dn = 64 * 8 * 8, total = n_gu + n_dn;
        const int kr = tid >> 5, n4 = tid & 31, kg = (tid >> 3) & 7, nl = (tid & 7) + 8 * (tid >> 6);
        float4 rg[8];
        const float* src = nullptr; unsigned char* dst = nullptr; int N = 0, K = 0, n0 = 0, perm = 0;
        const float* nsrc = nullptr; unsigned char* ndst = nullptr; int nN = 0, nK = 0, nn0 = 0, nperm = 0;
#define TR_DECODE(IT, SRC, DST, NN, KK, N0, PERM) do { int i_ = (IT); const float* W_; unsigned char* Wt_; \
        if (i_ < n_gu) { W_ = p.w_gu; Wt_ = p.WguT; NN = 2048; KK = D; PERM = 1; } else { i_ -= n_gu; W_ = p.w_down; Wt_ = p.WdnT; NN = D; KK = FF; PERM = 0; } \
        const int ntn_ = NN / 128, per_ = ntn_ * (KK / 128), m_ = i_ / per_, r_ = i_ % per_, tn_ = r_ % ntn_, tk_ = r_ / ntn_; \
        N0 = tn_ * 128; SRC = W_ + (size_t)m_ * KK * NN + (size_t)(tk_ * 128) * NN + N0; DST = Wt_ + (size_t)m_ * KK * NN + tk_ * 128; } while (0)
        int it = blockIdx.x;
        if (it < total) {
            TR_DECODE(it, src, dst, N, K, n0, perm);
#pragma unroll
            for (int i = 0; i < 8; ++i) rg[i] = *(const float4*)(src + (size_t)(kr + 16 * i) * N + n4 * 4);
        }
        for (; it < total; it += gridDim.x) {
            __syncthreads();
#pragma unroll
            for (int i = 0; i < 8; ++i) { float* q = fl + (kr + 16 * i) * 129 + n4 * 4; q[0] = rg[i].x; q[1] = rg[i].y; q[2] = rg[i].z; q[3] = rg[i].w; }
            __syncthreads();
            const int nit = it + gridDim.x;
            if (nit < total) {
                TR_DECODE(nit, nsrc, ndst, nN, nK, nn0, nperm);
#pragma unroll
                for (int i = 0; i < 8; ++i) rg[i] = *(const float4*)(nsrc + (size_t)(kr + 16 * i) * nN + n4 * 4);
            }
#pragma unroll
            for (int j = 0; j < 2; ++j) {
                const int n = nl + 64 * j;
                const float* q = fl + (16 * kg) * 129 + n;
                u32x4 w;
#pragma unroll
                for (int d = 0; d < 4; ++d) {
                    unsigned r = __builtin_amdgcn_cvt_pk_fp8_f32(q[(4 * d) * 129] * 64.f, q[(4 * d + 1) * 129] * 64.f, 0u, false);
                    w[d] = __builtin_amdgcn_cvt_pk_fp8_f32(q[(4 * d + 2) * 129] * 64.f, q[(4 * d + 3) * 129] * 64.f, r, true);
                }
                const int ng = n0 + n;
                const int np = perm ? ((ng & (N / 2 - 1)) >> 7) * 256 + (ng >= N / 2 ? 128 : 0) + (ng & 127) : ng;
                *(u32x4*)(dst + (size_t)np * K + 16 * kg) = w;
            }
            src = nsrc; dst = ndst; N = nN; K = nK; n0 = nn0; perm = nperm;
        }
#undef TR_DECODE
    }
}

__device__ __forceinline__ void ph_norm1(const P& p, int l) {
    const int wave = ltid() >> 6, lane = ltid() & 63;
    for (int row = blockIdx.x * 8 + wave; row < R; row += gridDim.x * 8) {
        const float* xr = row < T ? p.x + (size_t)row * D : p.ctx + (size_t)(row - T) * D;
        float4 v[4]; float ss = 0;
#pragma unroll
        for (int i = 0; i < 4; ++i) { v[i] = *(const float4*)(xr + lane * 4 + 256 * i); ss += v[i].x * v[i].x + v[i].y * v[i].y + v[i].z * v[i].z + v[i].w * v[i].w; }
        ss = wave_sum(ss);
        const float rstd = rsqrtf(ss * (1.f / D) + EPS);
        const float* m = p.mod + ((size_t)l * 5 + mod_row(row)) * 6144;
        const float* g = p.g_mix + l * D;
#pragma unroll
        for (int i = 0; i < 4; ++i) {
            const int k = lane * 4 + 256 * i;
            const float4 gg = *(const float4*)(g + k), sh = *(const float4*)(m + k), sc = *(const float4*)(m + 1024 + k);
            uint2 o;
            o.x = cvtpk(v[i].x * rstd * gg.x * (1.f + sc.x) + sh.x, v[i].y * rstd * gg.y * (1.f + sc.y) + sh.y);
            o.y = cvtpk(v[i].z * rstd * gg.z * (1.f + sc.z) + sh.z, v[i].w * rstd * gg.w * (1.f + sc.w) + sh.w);
            *(uint2*)(p.H + (size_t)row * D + k) = o;
        }
    }
}

constexpr float QSCALE = 0.17677669529663687f * 1.4426950408889634f;
__device__ __forceinline__ void dsoftmax(const f32x16& s, float& m, float& l, f32x16& o0, f32x16& o1, bf16x8& pa, bf16x8& pb) {
    float mx = fmaxf(fmaxf(fmaxf(s[0], s[1]), fmaxf(s[2], s[3])), fmaxf(fmaxf(s[4], s[5]), fmaxf(s[6], s[7])));
    mx = fmaxf(mx, fmaxf(fmaxf(fmaxf(s[8], s[9]), fmaxf(s[10], s[11])), fmaxf(fmaxf(s[12], s[13]), fmaxf(s[14], s[15]))));
    mx = xhalf_max(mx);
    if (__any(mx > m)) {
        const float mn = fmaxf(m, mx), alpha = __builtin_amdgcn_exp2f(m - mn);
        o0 *= alpha; o1 *= alpha; l *= alpha; m = mn;
    }
    float pr[16]; float sum = 0.f;
#pragma unroll
    for (int r = 0; r < 16; ++r) { pr[r] = __builtin_amdgcn_exp2f(s[r] - m); sum += pr[r]; }
    l += sum;
    u32x4 a, b;
    a[0] = cvtpk(pr[0], pr[1]); a[1] = cvtpk(pr[2], pr[3]); a[2] = cvtpk(pr[4], pr[5]); a[3] = cvtpk(pr[6], pr[7]);
    b[0] = cvtpk(pr[8], pr[9]); b[1] = cvtpk(pr[10], pr[11]); b[2] = cvtpk(pr[12], pr[13]); b[3] = cvtpk(pr[14], pr[15]);
    pa = __builtin_bit_cast(bf16x8, a); pb = __builtin_bit_cast(bf16x8, b);
}
#define MX3(a, b, c) __builtin_fmaxf(__builtin_fmaxf((a), (b)), (c))
template <int THR>
__device__ __forceinline__ void dsoftmax2(f32x16& s, float& m, float& l, f32x16& o0, f32x16& o1, bf16x8& pa, bf16x8& pb, const bool first) {
    float a = MX3(s[0], s[1], s[2]), b = MX3(s[3], s[4], s[5]);
    a = MX3(a, s[6], s[7]); b = MX3(b, s[8], s[9]); a = MX3(a, s[10], s[11]); b = MX3(b, s[12], s[13]); a = MX3(a, s[14], s[15]);
    const float mx = xhalf_max(__builtin_fmaxf(a, b));
    if (first || __any(mx > m + (float)THR)) {
        const float mn = first ? mx : __builtin_fmaxf(mx, m), alpha = first ? 1.f : __builtin_amdgcn_exp2f(m - mn);
        m = mn; o0 *= alpha; o1 *= alpha; l *= alpha;
    }
    float sum = 0.f;
#pragma unroll
    for (int r = 0; r < 16; ++r) { s[r] = __builtin_amdgcn_exp2f(s[r] - m); sum += s[r]; }
    l += sum;
    u32x4 wa, wb;
    wa[0] = cvtpk(s[0], s[1]); wa[1] = cvtpk(s[2], s[3]); wa[2] = cvtpk(s[4], s[5]); wa[3] = cvtpk(s[6], s[7]);
    wb[0] = cvtpk(s[8], s[9]); wb[1] = cvtpk(s[10], s[11]); wb[2] = cvtpk(s[12], s[13]); wb[3] = cvtpk(s[14], s[15]);
    pa = __builtin_bit_cast(bf16x8, wa); pb = __builtin_bit_cast(bf16x8, wb);
}
__device__ __forceinline__ void ph_dattn(const P& p, int l, int nrows, char* lds) {
    const int tid = ltid(), lane = tid & 63, wid = tid >> 6, r32 = lane & 31, hi = lane >> 5;
    float la = lane < 32 ? p.lam_q1[l * 32 + lane] * p.lam_k1[l * 32 + lane] : 0.f;
    float lb = lane < 32 ? p.lam_q2[l * 32 + lane] * p.lam_k2[l * 32 + lane] : 0.f;
    la = wave_sum(la); lb = wave_sum(lb);
    const float lam_init = 0.8f - 0.6f * expf(-0.3f * (float)l);
    const float lam = expf(la) - expf(lb) + lam_init;
    const bf16_t* PR = p.PROJ;
    const int nunits = (nrows == R) ? 256 + 16 : 256;
    const int skey = 8 * wid + (lane & 7), schunk = lane >> 3;
    const int ldsK = schunk * 1024 + skey * 16;
    const int ldsV = 8192 + (schunk >> 2) * 4096 + (skey >> 3) * 512 + (skey & 7) * 64 + (schunk & 3) * 16;
    const int vb = ((lane >> 4) & 1) * 32 + (lane & 3) * 8 + (4 * hi + ((lane & 15) >> 2)) * 64;
    for (int uu = blockIdx.x; uu < nunits; uu += gridDim.x) {
        int b, h, q0, nt; bool isctx;
        if (uu < 256) { const int u = (uu & 7) * 32 + (uu >> 3); b = u >> 6; h = (u >> 4) & 3; q0 = b * 4096 + (u & 15) * 256; nt = 68; isctx = false; }
        else { const int v = uu - 256; b = v >> 2; h = v & 3; q0 = T + b * 256; nt = 4; isctx = true; }
        bf16x8 qf[4];
        {
            const bf16_t* qp = PR + (size_t)(q0 + wid * 32 + r32) * PW + h * 64 + hi * 8;
#pragma unroll
            for (int ks = 0; ks < 4; ++ks) qf[ks] = *(const bf16x8*)(qp + ks * 16);
        }
        f32x16 O00, O01, O10, O11, zero16;
#pragma unroll
        for (int r = 0; r < 16; ++r) { O00[r] = 0.f; O01[r] = 0.f; O10[r] = 0.f; O11[r] = 0.f; zero16[r] = 0.f; }
        float m1 = 0.f, m2 = 0.f, l1 = 0.f, l2 = 0.f;
        const size_t gK = 256 + h * 64 + schunk * 8, gV = 512 + h * 64 + schunk * 8;
        uint4 rk, rv;
        {
            const int kr = (isctx ? T + b * 256 : b * 4096) + skey;
            rk = *(const uint4*)(PR + (size_t)kr * PW + gK); rv = *(const uint4*)(PR + (size_t)kr * PW + gV);
        }
        __syncthreads();
        *(uint4*)(lds + ldsK) = rk; *(uint4*)(lds + ldsV) = rv;
        __syncthreads();
#pragma unroll 1
        for (int t = 0; t < nt; ++t) {
            char* buf = lds + (t & 1) * 16384;
            if (t + 1 < nt) {
                const int tn = t + 1;
                const int kr = ((isctx || tn >= 64) ? T + b * 256 + (isctx ? tn : tn - 64) * 64 : b * 4096 + tn * 64) + skey;
                rk = *(const uint4*)(PR + (size_t)kr * PW + gK); rv = *(const uint4*)(PR + (size_t)kr * PW + gV);
            }
            {
                typedef const __attribute__((address_space(3))) bf16x8* kfp_t;
                const lds_cptr kp = (lds_cptr)buf + hi * 1024 + r32 * 16;
                const lds_cptr vp = (lds_cptr)buf + 8192 + vb;
                bf16x8 kf0 = *(kfp_t)(kp), kf1 = *(kfp_t)(kp + 2048), kf2 = *(kfp_t)(kp + 4096), kf3 = *(kfp_t)(kp + 6144);
#pragma unroll
                for (int kb = 0; kb < 2; ++kb) {
                    f32x16 s1 = __builtin_amdgcn_mfma_f32_32x32x16_bf16(kf0, qf[0], zero16, 0, 0, 0);
                    f32x16 s2 = __builtin_amdgcn_mfma_f32_32x32x16_bf16(kf2, qf[2], zero16, 0, 0, 0);
                    s1 = __builtin_amdgcn_mfma_f32_32x32x16_bf16(kf1, qf[1], s1, 0, 0, 0);
                    s2 = __builtin_amdgcn_mfma_f32_32x32x16_bf16(kf3, qf[3], s2, 0, 0, 0);
                    s16x4 vlo[4], vhi[4];
#pragma unroll
                    for (int i = 0; i < 4; ++i) { vlo[i] = vtr(vp + kb * 2048 + (i >> 1) * 4096 + (i & 1) * 1024); vhi[i] = vtr(vp + kb * 2048 + (i >> 1) * 4096 + (i & 1) * 1024 + 512); }
                    if (kb == 0) { kf0 = *(kfp_t)(kp + 512); kf1 = *(kfp_t)(kp + 512 + 2048); kf2 = *(kfp_t)(kp + 512 + 4096); kf3 = *(kfp_t)(kp + 512 + 6144); }
                    __builtin_amdgcn_sched_barrier(0);
                    const bool first = (t == 0) && (kb == 0);
                    bf16x8 p1a, p1b, p2a, p2b;
                    dsoftmax2<8>(s1, m1, l1, O00, O01, p1a, p1b, first);
                    dsoftmax2<8>(s2, m2, l2, O10, O11, p2a, p2b, first);
#pragma unroll
                    for (int i = 0; i < 4; ++i) {
                        const bf16x8 va = (bf16x8){vlo[i][0], vlo[i][1], vlo[i][2], vlo[i][3], vhi[i][0], vhi[i][1], vhi[i][2], vhi[i][3]};
                        if (i < 2) { O00 = __builtin_amdgcn_mfma_f32_32x32x16_bf16(va, (i & 1) ? p1b : p1a, O00, 0, 0, 0); O10 = __builtin_amdgcn_mfma_f32_32x32x16_bf16(va, (i & 1) ? p2b : p2a, O10, 0, 0, 0); }
                        else       { O01 = __builtin_amdgcn_mfma_f32_32x32x16_bf16(va, (i & 1) ? p1b : p1a, O01, 0, 0, 0); O11 = __builtin_amdgcn_mfma_f32_32x32x16_bf16(va, (i & 1) ? p2b : p2a, O11, 0, 0, 0); }
                    }
                }
            }
            if (t + 1 < nt) { char* nb = lds + ((t + 1) & 1) * 16384; *(uint4*)(nb + ldsK) = rk; *(uint4*)(nb + ldsV) = rv; }
            __syncthreads();
        }
        l1 = xhalf_sum(l1); l2 = xhalf_sum(l2);
        const float i1 = 1.f / l1, i2 = lam / l2;
        float ss = 0.f;
#pragma unroll
        for (int r = 0; r < 16; ++r) { O00[r] = O00[r] * i1 - O10[r] * i2; O01[r] = O01[r] * i1 - O11[r] * i2; ss += O00[r] * O00[r] + O01[r] * O01[r]; }
        ss = xhalf_sum(ss);
        const float rstd = rsqrtf(ss * (1.f / 64.f) + EPS) * (1.f - lam_init);
        const float* gs = p.g_sub + l * 64;
        bf16_t* op = p.MIX + (size_t)(q0 + wid * 32 + r32) * D + h * 64;
#pragma unroll
        for (int g4 = 0; g4 < 4; ++g4) {
            const int d = 8 * g4 + 4 * hi;
            const float4 ga = *(const float4*)(gs + d), gb = *(const float4*)(gs + 32 + d);
            uint2 wa, wb;
            wa.x = cvtpk(O00[4 * g4] * rstd * ga.x, O00[4 * g4 + 1] * rstd * ga.y); wa.y = cvtpk(O00[4 * g4 + 2] * rstd * ga.z, O00[4 * g4 + 3] * rstd * ga.w);
            wb.x = cvtpk(O01[4 * g4] * rstd * gb.x, O01[4 * g4 + 1] * rstd * gb.y); wb.y = cvtpk(O01[4 * g4 + 2] * rstd * gb.z, O01[4 * g4 + 3] * rstd * gb.w);
            *(uint2*)(op + d) = wa; *(uint2*)(op + 32 + d) = wb;
        }
    }
}

__device__ __forceinline__ void ph_na(const P& p, int l, int nrows, char* lds) {
    const int tid = ltid(), lane = tid & 63, wid = tid >> 6, r32 = lane & 31, hi = lane >> 5;
    const bf16_t* PR = p.PROJ;
    const int nunits = (nrows == R) ? 256 + 16 : 256;
    const int skey = 8 * wid + (lane & 7), schunk = lane >> 3;
    const int ldsK = schunk * 1024 + skey * 16;
    const int ldsV = 8192 + (schunk >> 2) * 4096 + (skey >> 3) * 512 + (skey & 7) * 64 + (schunk & 3) * 16;
    const int vb = ((lane >> 4) & 1) * 32 + (lane & 3) * 8 + (4 * hi + ((lane & 15) >> 2)) * 64;
    float* btab = (float*)(lds + 32768);
    constexpr float LOG2E = 1.4426950408889634f;
    for (int uu = (blockIdx.x + gridDim.x - 16) % gridDim.x; uu < nunits; uu += gridDim.x) {
        int b, h, q0, kr_lo, nlat, rs = 0, rq = 0; bool isctx;
        if (uu < 256) {
            const int u = (uu & 7) * 32 + (uu >> 3); b = u >> 6; h = (u >> 4) & 3; const int rg = u & 15;
            rq = 4 * rg + (wid >> 1); q0 = b * 4096 + rq * 64 + (wid & 1) * 32;
            kr_lo = min(max(4 * rg - 4, 0), 56); const int kr_hi = min(max(4 * rg - 1, 0), 56) + 7; nlat = kr_hi - kr_lo + 1;
            rs = min(max(rq - 4, 0), 56); isctx = false;
        } else { const int v = uu - 256; b = v >> 2; h = v & 3; q0 = T + b * 256 + wid * 32; kr_lo = 0; nlat = 0; isctx = true; }
        const int nt = nlat + 4;
        const int cq = (wid & 1) * 32 + r32, wsc = min(max(cq - 8, 0), 48);
        bf16x8 qf[4];
        {
            const bf16_t* qp = PR + (size_t)(q0 + r32) * PW + 1536 + h * 64 + hi * 8;
#pragma unroll
            for (int ks = 0; ks < 4; ++ks) qf[ks] = *(const bf16x8*)(qp + ks * 16);
        }
        f32x16 O0, O1;
#pragma unroll
        for (int r = 0; r < 16; ++r) { O0[r] = 0.f; O1[r] = 0.f; }
        float m1 = -1e30f, l1 = 0.f;
        const size_t gK = 1792 + h * 64 + schunk * 8, gV = 2048 + h * 64 + schunk * 8;
        uint4 rk, rv;
        {
            const int kr = (nlat ? b * 4096 + kr_lo * 64 : T + b * 256) + skey;
            rk = *(const uint4*)(PR + (size_t)kr * PW + gK); rv = *(const uint4*)(PR + (size_t)kr * PW + gV);
        }
        __syncthreads();
        *(uint4*)(lds + ldsK) = rk; *(uint4*)(lds + ldsV) = rv;
        if (tid < 465) btab[tid] = p.rpb[((size_t)l * 4 + h) * 465 + tid] * LOG2E;
        __syncthreads();
        for (int t = 0; t < nt; ++t) {
            char* buf = lds + (t & 1) * 16384;
            if (t + 1 < nt) {
                const int tn = t + 1;
                const int kr = (tn < nlat ? b * 4096 + (kr_lo + tn) * 64 : T + b * 256 + (tn - nlat) * 64) + skey;
                rk = *(const uint4*)(PR + (size_t)kr * PW + gK); rv = *(const uint4*)(PR + (size_t)kr * PW + gV);
            }
            const bool lat = t < nlat;
            const int krow = kr_lo + t;
            const bool active = !lat || (krow >= rs && krow <= rs + 7);
            if (active) {
                const float* brow = btab + (krow - rq + 7) * 31 + 15 - cq;
#pragma unroll
                for (int kb = 0; kb < 2; ++kb) {
                    const lds_cptr kp = (lds_cptr)buf + hi * 1024 + (kb * 32 + r32) * 16;
                    f32x16 s1;
#pragma unroll
                    for (int r = 0; r < 16; ++r) s1[r] = 0.f;
#pragma unroll
                    for (int ks = 0; ks < 4; ++ks) {
                        const bf16x8 kf = *(const __attribute__((address_space(3))) bf16x8*)(kp + ks * 2048);
                        s1 = __builtin_amdgcn_mfma_f32_32x32x16_bf16(kf, qf[ks], s1, 0, 0, 0);
                    }
                    if (lat) {
#pragma unroll
                        for (int r = 0; r < 16; ++r) {
                            const int kc = 32 * kb + (r & 3) + 8 * (r >> 2) + 4 * hi;
                            const bool ok = (unsigned)(kc - wsc) < 16u;
                            const float bv = brow[ok ? kc : cq];
                            s1[r] = ok ? s1[r] + bv : -INFINITY;
                        }
                    }
                    bf16x8 pa, pb;
                    dsoftmax(s1, m1, l1, O0, O1, pa, pb);
                    const lds_cptr vp = (lds_cptr)buf + 8192 + vb + kb * 2048;
#pragma unroll
                    for (int ss = 0; ss < 2; ++ss) {
                        const s16x4 lo0 = vtr(vp + ss * 1024), hh0 = vtr(vp + ss * 1024 + 512);
                        const s16x4 lo1 = vtr(vp + 4096 + ss * 1024), hh1 = vtr(vp + 4096 + ss * 1024 + 512);
                        const bf16x8 va0 = (bf16x8){lo0[0], lo0[1], lo0[2], lo0[3], hh0[0], hh0[1], hh0[2], hh0[3]};
                        const bf16x8 va1 = (bf16x8){lo1[0], lo1[1], lo1[2], lo1[3], hh1[0], hh1[1], hh1[2], hh1[3]};
                        O0 = __builtin_amdgcn_mfma_f32_32x32x16_bf16(va0, ss ? pb : pa, O0, 0, 0, 0);
                        O1 = __builtin_amdgcn_mfma_f32_32x32x16_bf16(va1, ss ? pb : pa, O1, 0, 0, 0);
                    }
                }
            }
            if (t + 1 < nt) { char* nb = lds + ((t + 1) & 1) * 16384; *(uint4*)(nb + ldsK) = rk; *(uint4*)(nb + ldsV) = rv; }
            __syncthreads();
        }
        l1 = xhalf_sum(l1);
        const float il = 1.f / l1;
        bf16_t* op = p.MIX + (size_t)(q0 + r32) * D + 768 + h * 64;
#pragma unroll
        for (int g4 = 0; g4 < 4; ++g4) {
            const int d = 8 * g4 + 4 * hi;
            uint2 wa, wb;
            wa.x = cvtpk(O0[4 * g4] * il, O0[4 * g4 + 1] * il); wa.y = cvtpk(O0[4 * g4 + 2] * il, O0[4 * g4 + 3] * il);
            wb.x = cvtpk(O1[4 * g4] * il, O1[4 * g4 + 1] * il); wb.y = cvtpk(O1[4 * g4 + 2] * il, O1[4 * g4 + 3] * il);
            *(uint2*)(op + d) = wa; *(uint2*)(op + 32 + d) = wb;
        }
    }
}

__device__ __forceinline__ void ph_pool(const P& p, int l, int nrows, char* lds) {
    const int tid = ltid(), lane = tid & 63, wid = tid >> 6, fr = lane & 15, fq = lane >> 4;
    float* ysh = (float*)lds;
    bf16_t* dsh = (bf16_t*)(lds + 80 * 256 * 4);
    const bf16_t* PR = p.PROJ;
    for (int it = (blockIdx.x + gridDim.x - 32) % gridDim.x; it < nrows / 64; it += gridDim.x) {
        const int row0 = it * 64;
        const int L = row0 < T ? 4096 : 256;
        const int t0 = row0 < T ? (row0 & 4095) : ((row0 - T) & 255);
        const int base = row0 - t0;
        __syncthreads();
        for (int c = tid; c < 80 * 32; c += NT) {
            const int rr = c >> 5, ch = (c & 31) * 8, t = t0 - 8 + rr;
            float4 a = make_float4(0.f, 0.f, 0.f, 0.f), b = a;
            if (t >= 0 && t < L) {
                const uint4 raw = *(const uint4*)(PR + (size_t)(base + t) * PW + 768 + ch);
                a = make_float4(__uint_as_float(raw.x << 16), __uint_as_float(raw.x & 0xffff0000u), __uint_as_float(raw.y << 16), __uint_as_float(raw.y & 0xffff0000u));
                b = make_float4(__uint_as_float(raw.z << 16), __uint_as_float(raw.z & 0xffff0000u), __uint_as_float(raw.w << 16), __uint_as_float(raw.w & 0xffff0000u));
            }
            *(float4*)(ysh + rr * 256 + ch) = a; *(float4*)(ysh + rr * 256 + ch + 4) = b;
        }
        __syncthreads();
        {
            const int r = tid >> 3, cg = tid & 7;
            const int g = cg >> 1, w = 2 << g, t = t0 + r;
            const int lo = max(t - w / 2, 0), hi = min(t + w / 2 - 1, L - 1);
            const float inv = 1.f / (float)(hi - lo + 1);
#pragma unroll
            for (int q = 0; q < 8; ++q) {
                const int ch = cg * 32 + q * 4;
                float4 s = make_float4(0.f, 0.f, 0.f, 0.f);
                for (int tt = lo; tt <= hi; ++tt) { const float4 v = *(const float4*)(ysh + (tt - t0 + 8) * 256 + ch); s.x += v.x; s.y += v.y; s.z += v.z; s.w += v.w; }
                const float4 y = *(const float4*)(ysh + (r + 8) * 256 + ch);
                uint2 o; o.x = cvtpk(s.x * inv - y.x, s.y * inv - y.y); o.y = cvtpk(s.z * inv - y.z, s.w * inv - y.w);
                *(uint2*)(dsh + r * 264 + ch) = o;
            }
        }
        __syncthreads();
        {
            const int g = wid >> 1, mb = (wid & 1) * 2;
            const bf16_t* W = p.WpT + ((size_t)l * 4 + g) * 64 * 64;
            f32x4 acc[2][4];
#pragma unroll
            for (int mt = 0; mt < 2; ++mt)
#pragma unroll
                for (int nt = 0; nt < 4; ++nt) acc[mt][nt] = (f32x4){0.f, 0.f, 0.f, 0.f};
#pragma unroll
            for (int ks = 0; ks < 2; ++ks) {
                bf16x8 af[2], bfr[4];
#pragma unroll
                for (int mt = 0; mt < 2; ++mt) af[mt] = *(const bf16x8*)(dsh + ((mb + mt) * 16 + fr) * 264 + g * 64 + ks * 32 + fq * 8);
#pragma unroll
                for (int nt = 0; nt < 4; ++nt) bfr[nt] = *(const bf16x8*)(W + (nt * 16 + fr) * 64 + ks * 32 + fq * 8);
#pragma unroll
                for (int mt = 0; mt < 2; ++mt)
#pragma unroll
                    for (int nt = 0; nt < 4; ++nt) acc[mt][nt] = __builtin_amdgcn_mfma_f32_16x16x32_bf16(bfr[nt], af[mt], acc[mt][nt], 0, 0, 0);
            }
#pragma unroll
            for (int mt = 0; mt < 2; ++mt)
#pragma unroll
                for (int nt = 0; nt < 4; ++nt) {
                    const int row = row0 + (mb + mt) * 16 + fr, j = g * 64 + nt * 16 + fq * 4;
                    const float4 sp = *(const float4*)(p.s_pool + l * 256 + j);
                    uint2 o; o.x = cvtpk(acc[mt][nt][0] * sp.x, acc[mt][nt][1] * sp.y); o.y = cvtpk(acc[mt][nt][2] * sp.z, acc[mt][nt][3] * sp.w);
                    *(uint2*)(p.MIX + (size_t)row * D + 256 + j) = o;
                }
        }
    }
}

__device__ __forceinline__ float gelu_fast(float x) {
    const float u = 0.7978845608028654f * (x + 0.044715f * x * x * x);
    return x / (1.f + __builtin_amdgcn_exp2f(-2.885390081777927f * u));
}
__device__ __forceinline__ void ph_sgu(const P& p, int l, int nrows, char* lds) {
    const int tid = ltid(), lane = tid & 63, wid = tid >> 6, fr = lane & 15, fq = lane >> 4;
    bf16_t* vnT = (bf16_t*)lds;
    float* rstd = (float*)(lds + 128 * 136 * 2);
    const bf16_t* PR = p.PROJ;
    for (int it = (blockIdx.x + gridDim.x - 48) % gridDim.x; it < (nrows / 128) * 2; it += gridDim.x) {
        const int chunk = it >> 1, hp = it & 1, row0 = chunk * 128;
        __syncthreads();
        {
            const int t = tid >> 2, qtr = tid & 3;
            const bf16_t* zp = PR + (size_t)(row0 + t) * PW + 1280 + qtr * 64;
            float ss = 0.f;
#pragma unroll
            for (int i = 0; i < 8; ++i) {
                const uint4 raw = *(const uint4*)(zp + i * 8);
                const unsigned w4[4] = {raw.x, raw.y, raw.z, raw.w};
#pragma unroll
                for (int j = 0; j < 4; ++j) { const float a = __uint_as_float(w4[j] << 16), b = __uint_as_float(w4[j] & 0xffff0000u); ss += a * a + b * b; }
            }
            ss += __shfl_xor(ss, 1); ss += __shfl_xor(ss, 2);
            if (qtr == 0) rstd[t] = rsqrtf(ss * (1.f / 256.f) + EPS);
        }
        __syncthreads();
        {
            const int s = tid >> 2, cb = (tid & 3) * 32;
            const bf16_t* zp = PR + (size_t)(row0 + s) * PW + 1280 + hp * 128 + cb;
            const float rs = rstd[s];
            const float* gg = p.g_sgu + l * 256 + hp * 128 + cb;
#pragma unroll
            for (int i = 0; i < 4; ++i) {
                const uint4 raw = *(const uint4*)(zp + i * 8);
                const unsigned w4[4] = {raw.x, raw.y, raw.z, raw.w};
#pragma unroll
                for (int j = 0; j < 4; ++j) {
                    const int c = cb + i * 8 + j * 2;
                    vnT[c * 136 + s] = f2bf(__uint_as_float(w4[j] << 16) * rs * gg[i * 8 + j * 2]);
                    vnT[(c + 1) * 136 + s] = f2bf(__uint_as_float(w4[j] & 0xffff0000u) * rs * gg[i * 8 + j * 2 + 1]);
                }
            }
        }
        __syncthreads();
        {
            const int hl = wid >> 2, g = hp * 2 + hl, mb = (wid & 3) * 2;
            const bf16_t* Wg = p.WsB + ((size_t)l * 4 + g) * 128 * 128;
            f32x4 acc[2][4];
#pragma unroll
            for (int mt = 0; mt < 2; ++mt)
#pragma unroll
                for (int nt = 0; nt < 4; ++nt) acc[mt][nt] = (f32x4){0.f, 0.f, 0.f, 0.f};
#pragma unroll
            for (int ks = 0; ks < 4; ++ks) {
                bf16x8 af[2], bfr[4];
#pragma unroll
                for (int mt = 0; mt < 2; ++mt) af[mt] = *(const bf16x8*)(Wg + ((mb + mt) * 16 + fr) * 128 + ks * 32 + fq * 8);
#pragma unroll
                for (int nt = 0; nt < 4; ++nt) bfr[nt] = *(const bf16x8*)(vnT + (hl * 64 + nt * 16 + fr) * 136 + ks * 32 + fq * 8);
#pragma unroll
                for (int mt = 0; mt < 2; ++mt)
#pragma unroll
                    for (int nt = 0; nt < 4; ++nt) acc[mt][nt] = __builtin_amdgcn_mfma_f32_16x16x32_bf16(bfr[nt], af[mt], acc[mt][nt], 0, 0, 0);
            }
#pragma unroll
            for (int mt = 0; mt < 2; ++mt) {
                const int t = (mb + mt) * 16 + fr;
                const float bias = p.b_sgu[(l * 4 + g) * 128 + t];
#pragma unroll
                for (int nt = 0; nt < 4; ++nt) {
                    const int c = g * 64 + nt * 16 + fq * 4;
                    const uint2 ur = *(const uint2*)(PR + (size_t)(row0 + t) * PW + 1024 + c);
                    const float u0 = __uint_as_float(ur.x << 16), u1 = __uint_as_float(ur.x & 0xffff0000u);
                    const float u2 = __uint_as_float(ur.y << 16), u3 = __uint_as_float(ur.y & 0xffff0000u);
                    uint2 o; o.x = cvtpk(u0 * (acc[mt][nt][0] + bias), u1 * (acc[mt][nt][1] + bias)); o.y = cvtpk(u2 * (acc[mt][nt][2] + bias), u3 * (acc[mt][nt][3] + bias));
                    *(uint2*)(p.MIX + (size_t)(row0 + t) * D + 512 + c) = o;
                }
            }
        }
    }
}

__device__ __forceinline__ void ph_router(const P& p, int l, int nrows, char* lds) {
    const int tid = ltid(), wave = tid >> 6, lane = tid & 63;
    float* wl = (float*)lds;
    float* wsc = (float*)(lds + 1024 * 36 * 4) + wave * 64;
    int* lcnt = (int*)(lds + 1024 * 36 * 4 + 8 * 64 * 4);
    __syncthreads();
    {
        const float* wr = p.w_router + (size_t)l * D * NE;
        float4 t[16];
#pragma unroll
        for (int i = 0; i < 16; ++i) t[i] = *(const float4*)(wr + (size_t)(tid + NT * i) * 4);
#pragma unroll
        for (int i = 0; i < 16; ++i) { const int idx = (tid + NT * i) * 4, k = idx >> 5, e = idx & 31; *(float4*)(wl + ((k & 3) * 256 + (k >> 2)) * 36 + e) = t[i]; }
        if (tid < 32) lcnt[tid] = 0;
    }
    __syncthreads();
    const float* g = p.g_ffn + l * D;
    const float brt = p.b_router[l * NE + (lane & 31)];
    for (int pr = blockIdx.x * 8 + wave; pr < nrows / 2; pr += gridDim.x * 8) {
        const int ra = 2 * pr;
        const bf16_t* xa = p.X + (size_t)ra * D; const bf16_t* xb = xa + D;
        float ha[16], hb[16]; float sa = 0.f, sb = 0.f;
#pragma unroll
        for (int i = 0; i < 4; ++i) {
            const uint2 ua = *(const uint2*)(xa + 4 * (lane + 64 * i)), ub = *(const uint2*)(xb + 4 * (lane + 64 * i));
            const float4 va = make_float4(__uint_as_float(ua.x << 16), __uint_as_float(ua.x & 0xffff0000u), __uint_as_float(ua.y << 16), __uint_as_float(ua.y & 0xffff0000u));
            const float4 vb = make_float4(__uint_as_float(ub.x << 16), __uint_as_float(ub.x & 0xffff0000u), __uint_as_float(ub.y << 16), __uint_as_float(ub.y & 0xffff0000u));
            ha[4 * i] = va.x; ha[4 * i + 1] = va.y; ha[4 * i + 2] = va.z; ha[4 * i + 3] = va.w; hb[4 * i] = vb.x; hb[4 * i + 1] = vb.y; hb[4 * i + 2] = vb.z; hb[4 * i + 3] = vb.w;
            sa += va.x * va.x + va.y * va.y + va.z * va.z + va.w * va.w; sb += vb.x * vb.x + vb.y * vb.y + vb.z * vb.z + vb.w * vb.w;
        }
        sa = wave_sum(sa); sb = wave_sum(sb);
        const float rsa = rsqrtf(sa * (1.f / D) + EPS), rsb = rsqrtf(sb * (1.f / D) + EPS);
        const float* m = p.mod + ((size_t)l * 5 + mod_row(ra)) * 6144;
#pragma unroll
        for (int i = 0; i < 4; ++i) {
            const int k = 4 * (lane + 64 * i);
            const float4 gg = *(const float4*)(g + k), sc = *(const float4*)(m + 4 * 1024 + k), sh = *(const float4*)(m + 3 * 1024 + k);
            const float gs[4] = {gg.x * (1.f + sc.x), gg.y * (1.f + sc.y), gg.z * (1.f + sc.z), gg.w * (1.f + sc.w)}, s4[4] = {sh.x, sh.y, sh.z, sh.w};
#pragma unroll
            for (int j = 0; j < 4; ++j) { ha[4 * i + j] = ha[4 * i + j] * rsa * gs[j] + s4[j]; hb[4 * i + j] = hb[4 * i + j] * rsb * gs[j] + s4[j]; }
            uint2 oa, ob; oa.x = cvtpk(ha[4 * i], ha[4 * i + 1]); oa.y = cvtpk(ha[4 * i + 2], ha[4 * i + 3]); ob.x = cvtpk(hb[4 * i], hb[4 * i + 1]); ob.y = cvtpk(hb[4 * i + 2], hb[4 * i + 3]);
            *(uint2*)(p.H + (size_t)ra * D + k) = oa; *(uint2*)(p.H + (size_t)(ra + 1) * D + k) = ob;
        }
        float la[32], lb[32];
#pragma unroll
        for (int e = 0; e < 32; ++e) { la[e] = 0.f; lb[e] = 0.f; }
#pragma unroll
        for (int i = 0; i < 4; ++i)
#pragma unroll
            for (int j = 0; j < 4; ++j) {
                const float* wk = wl + (j * 256 + lane + 64 * i) * 36;
                const float xv = ha[4 * i + j], yv = hb[4 * i + j];
#pragma unroll
                for (int e = 0; e < 32; e += 4) {
                    const float4 w = *(const float4*)(wk + e);
                    la[e] += xv * w.x; la[e + 1] += xv * w.y; la[e + 2] += xv * w.z; la[e + 3] += xv * w.w;
                    lb[e] += yv * w.x; lb[e + 1] += yv * w.y; lb[e + 2] += yv * w.z; lb[e + 3] += yv * w.w;
                }
            }
        float r32v[32];
        {
            const bool up = lane >= 32;
#pragma unroll
            for (int e = 0; e < 32; ++e) { const float keep = up ? lb[e] : la[e], send = up ? la[e] : lb[e]; r32v[e] = keep + __shfl_xor(send, 32); }
        }
        float r16[16], r8[8], r4[4], r2[2];
        { const bool up = (lane & 16) != 0;
#pragma unroll
          for (int e = 0; e < 16; ++e) { const float keep = up ? r32v[e + 16] : r32v[e], send = up ? r32v[e] : r32v[e + 16]; r16[e] = keep + __shfl_xor(send, 16); } }
        { const bool up = (lane & 8) != 0;
#pragma unroll
          for (int e = 0; e < 8; ++e) { const float keep = up ? r16[e + 8] : r16[e], send = up ? r16[e] : r16[e + 8]; r8[e] = keep + __shfl_xor(send, 8); } }
        { const bool up = (lane & 4) != 0;
#pragma unroll
          for (int e = 0; e < 4; ++e) { const float keep = up ? r8[e + 4] : r8[e], send = up ? r8[e] : r8[e + 4]; r4[e] = keep + __shfl_xor(send, 4); } }
        { const bool up = (lane & 2) != 0;
#pragma unroll
          for (int e = 0; e < 2; ++e) { const float keep = up ? r4[e + 2] : r4[e], send = up ? r4[e] : r4[e + 2]; r2[e] = keep + __shfl_xor(send, 2); } }
        float mine;
        { const bool up = (lane & 1) != 0; const float keep = up ? r2[1] : r2[0], send = up ? r2[0] : r2[1]; mine = keep + __shfl_xor(send, 1); }
        wsc[lane] = mine + brt;
        float lg[32];
        {
            const float* wp = wsc + (lane & 32);
#pragma unroll
            for (int e = 0; e < 32; e += 4) { const float4 v = *(const float4*)(wp + e); lg[e] = v.x; lg[e + 1] = v.y; lg[e + 2] = v.z; lg[e + 3] = v.w; }
        }
        unsigned taken = 0u; float tv[4]; int ti[4];
#pragma unroll
        for (int k = 0; k < 4; ++k) {
            float best = -3.0e38f; int bi = 0;
#pragma unroll
            for (int e = 0; e < 32; ++e) { const bool ok = !((taken >> e) & 1u) && (lg[e] > best); best = ok ? lg[e] : best; bi = ok ? e : bi; }
            taken |= 1u << bi; tv[k] = best; ti[k] = bi;
        }
        const float e1 = __expf(tv[1] - tv[0]), e2 = __expf(tv[2] - tv[0]), e3 = __expf(tv[3] - tv[0]);
        const float inv = 1.f / (1.f + e1 + e2 + e3);
        if ((lane & 31) == 0) {
            const int row = ra + (lane >> 5);
            *(int4*)(p.topi + (size_t)row * 4) = make_int4(ti[0], ti[1], ti[2], ti[3]);
            *(float4*)(p.topg + (size_t)row * 4) = make_float4(inv, e1 * inv, e2 * inv, e3 * inv);
            atomicAdd(&lcnt[ti[0]], 1); atomicAdd(&lcnt[ti[1]], 1); atomicAdd(&lcnt[ti[2]], 1); atomicAdd(&lcnt[ti[3]], 1);
        }
    }
    __syncthreads();
    if (tid < 32 && lcnt[tid]) atomicAdd(&p.cnt[l * 64 + tid], lcnt[tid]);
}
__device__ __forceinline__ void ph_assign(const P& p, int l, int nrows, char* lds) {
    int* lcnt = (int*)lds; int* lbase = lcnt + 32; int* pst = lbase + 32; int* slots = pst + 32;
    const int tid = ltid(), wave = tid >> 6, lane = tid & 63;
    int* cnt = p.cnt + l * 64; int* cursor = cnt + 32;
    int* meta = p.moe_meta + l * 512;
    __syncthreads();
    if (tid == 0) { int a = 0; for (int e = 0; e < 32; ++e) { pst[e] = a; a += (cnt[e] + 255) & ~255; } if (blockIdx.x == 0) meta[0] = a >> 8; }
    __syncthreads();
    if (blockIdx.x == 0 && tid < 320) { int e = 0; for (int k = 1; k < 32; ++k) if (tid * 256 >= pst[k]) e = k; meta[1 + tid] = e; }
    const int blk0 = (blockIdx.x + gridDim.x - 64) % gridDim.x;
    for (int it = blk0; it < nrows / 64; it += gridDim.x) {
        __syncthreads();
        if (tid < 32) lcnt[tid] = 0;
        __syncthreads();
        if (wave == 0) {
            const int row = it * 64 + lane;
            const int4 ti = *(const int4*)(p.topi + (size_t)row * 4);
            const int r0 = atomicAdd(&lcnt[ti.x], 1), r1 = atomicAdd(&lcnt[ti.y], 1), r2 = atomicAdd(&lcnt[ti.z], 1), r3 = atomicAdd(&lcnt[ti.w], 1);
            __builtin_amdgcn_s_waitcnt(0xc07f);
            if (lane < 32) lbase[lane] = pst[lane] + (lcnt[lane] ? atomicAdd(&cursor[lane], lcnt[lane]) : 0);
            __builtin_amdgcn_s_waitcnt(0xc07f);
            const int4 sl = make_int4(lbase[ti.x] + r0, lbase[ti.y] + r1, lbase[ti.z] + r2, lbase[ti.w] + r3);
            *(int4*)(p.tok_slot + (size_t)row * 4) = sl;
            *(int4*)(slots + lane * 4) = sl;
        }
        __syncthreads();
        {
            const bf16_t* __restrict__ Hs = p.H; unsigned char* __restrict__ HSd = p.HS;
#define AS_LD(rr, A, B) const uint4 A = *(const uint4*)(Hs + (size_t)(it * 64 + wave * 8 + (rr)) * D + lane * 8), B = *(const uint4*)(Hs + (size_t)(it * 64 + wave * 8 + (rr)) * D + lane * 8 + 512)
#define AS_CV(V) make_uint2(__builtin_amdgcn_cvt_pk_fp8_f32(__uint_as_float(V.y << 16), __uint_as_float(V.y & 0xffff0000u), __builtin_amdgcn_cvt_pk_fp8_f32(__uint_as_float(V.x << 16), __uint_as_float(V.x & 0xffff0000u), 0u, false), true), \
                            __builtin_amdgcn_cvt_pk_fp8_f32(__uint_as_float(V.w << 16), __uint_as_float(V.w & 0xffff0000u), __builtin_amdgcn_cvt_pk_fp8_f32(__uint_as_float(V.z << 16), __uint_as_float(V.z & 0xffff0000u), 0u, false), true))
#define AS_ST(rr, A, B) do { const int4 s4 = *(const int4*)(slots + (wave * 8 + (rr)) * 4); const uint2 fa = AS_CV(A), fb = AS_CV(B); \
            unsigned char* d0 = HSd + (size_t)s4.x * D + lane * 8; *(uint2*)d0 = fa; *(uint2*)(d0 + 512) = fb; \
            unsigned char* d1 = HSd + (size_t)s4.y * D + lane * 8; *(uint2*)d1 = fa; *(uint2*)(d1 + 512) = fb; \
            unsigned char* d2 = HSd + (size_t)s4.z * D + lane * 8; *(uint2*)d2 = fa; *(uint2*)(d2 + 512) = fb; \
            unsigned char* d3 = HSd + (size_t)s4.w * D + lane * 8; *(uint2*)d3 = fa; *(uint2*)(d3 + 512) = fb; } while (0)
            AS_LD(0, a0, b0); AS_LD(1, a1, b1); AS_LD(2, a2, b2); AS_LD(3, a3, b3); AS_LD(4, a4, b4); AS_LD(5, a5, b5); AS_LD(6, a6, b6); AS_LD(7, a7, b7);
            AS_ST(0, a0, b0); AS_ST(1, a1, b1); AS_ST(2, a2, b2); AS_ST(3, a3, b3); AS_ST(4, a4, b4); AS_ST(5, a5, b5); AS_ST(6, a6, b6); AS_ST(7, a7, b7);
#undef AS_CV
#undef AS_LD
#undef AS_ST
        }
    }
}

struct EpiProj {
    static constexpr bool PERM = true, AFTER_DRAIN = false;
    bf16_t* O; const float* rope;
    __device__ __forceinline__ void operator()(const f32x4 (&acc)[2][2][4][2], const pg8::Unit& u, int wr, int wc, int fr, int fq) const {
        const int row0 = u.pm * 256 + wr * 64 + fr, col0 = u.pn * 256 + wc * 32 + 8 * fq;
        const bool do_rope = (u.pn < 2) && (u.pm < T / 256), do_gelu = (u.pn == 4) || (u.pn == 5);
        const float sc = u.pn == 0 ? QSCALE : (u.pn == 6 ? 0.125f * 1.4426950408889634f : 1.f);
        const float sgn = (fq & 1) ? 1.f : -1.f;
#pragma unroll
        for (int ai = 0; ai < 2; ++ai)
#pragma unroll
            for (int m = 0; m < 4; ++m) {
                const int row = row0 + ai * 128 + m * 16;
                bf16_t* rowp = O + (size_t)row * PW + col0;
                f32x4 cs[4];
                if (do_rope) {
                    const int s = row & 4095, pos = (fq >> 1) ? (s & 63) : (s >> 6);
                    const f32x4* rp = (const f32x4*)(rope + pos * 16);
                    cs[0] = rp[0]; cs[1] = rp[1]; cs[2] = rp[2]; cs[3] = rp[3];
                }
#pragma unroll
                for (int bj = 0; bj < 2; ++bj) {
                    f32x4 v0 = acc[ai][bj][m][0], v1 = acc[ai][bj][m][1];
                    if (do_rope) {
                        f32x4 b0, b1;
#pragma unroll
                        for (int j = 0; j < 4; ++j) { b0[j] = __shfl_xor(v0[j], 16); b1[j] = __shfl_xor(v1[j], 16); }
                        v0[0] = v0[0] * cs[0][0] + sgn * b0[0] * cs[0][1]; v0[1] = v0[1] * cs[0][2] + sgn * b0[1] * cs[0][3];
                        v0[2] = v0[2] * cs[1][0] + sgn * b0[2] * cs[1][1]; v0[3] = v0[3] * cs[1][2] + sgn * b0[3] * cs[1][3];
                        v1[0] = v1[0] * cs[2][0] + sgn * b1[0] * cs[2][1]; v1[1] = v1[1] * cs[2][2] + sgn * b1[1] * cs[2][3];
                        v1[2] = v1[2] * cs[3][0] + sgn * b1[2] * cs[3][1]; v1[3] = v1[3] * cs[3][2] + sgn * b1[3] * cs[3][3];
                    }
                    if (do_gelu) {
#pragma unroll
                        for (int j = 0; j < 4; ++j) { v0[j] = gelu_fast(v0[j]); v1[j] = gelu_fast(v1[j]); }
                    }
                    v0 = v0 * sc; v1 = v1 * sc;
                    u32x4 w; w.x = cvtpk(v0[0], v0[1]); w.y = cvtpk(v0[2], v0[3]); w.z = cvtpk(v1[0], v1[1]); w.w = cvtpk(v1[2], v1[3]);
                    *(u32x4*)(rowp + bj * 128) = w;
                }
            }
    }
};
template <bool RES_F32>
struct EpiOut {
    static constexpr bool PERM = true, AFTER_DRAIN = false;
    bf16_t* X; const float* gate; const float* res_lat; const float* res_ctx;
    __device__ __forceinline__ void operator()(const f32x4 (&acc)[2][2][4][2], const pg8::Unit& u, int wr, int wc, int fr, int fq) const {
        const int row0 = u.pm * 256 + wr * 64 + fr, col0 = u.pn * 256 + wc * 32 + 8 * fq;
        const float* g = gate + (size_t)mod_row(u.pm * 256) * 6144 + col0;
        f32x4 gv[2][2];
#pragma unroll
        for (int bj = 0; bj < 2; ++bj)
#pragma unroll
            for (int n = 0; n < 2; ++n) gv[bj][n] = *(const f32x4*)(g + bj * 128 + n * 4);
#pragma unroll
        for (int ai = 0; ai < 2; ++ai)
#pragma unroll
            for (int m = 0; m < 4; ++m) { const size_t off = (size_t)(row0 + ai * 128 + m * 16) * D + col0;
#pragma unroll
                for (int bj = 0; bj < 2; ++bj) {
                    f32x4 r0, r1;
                    if (RES_F32) { const float* rp = (u.pm < T / 256 ? res_lat : res_ctx) + off + bj * 128; r0 = *(const f32x4*)rp; r1 = *(const f32x4*)(rp + 4); }
                    else { const u32x4 w = *(const u32x4*)(X + off + bj * 128);
                        r0 = (f32x4){__uint_as_float(w.x << 16), __uint_as_float(w.x & 0xffff0000u), __uint_as_float(w.y << 16), __uint_as_float(w.y & 0xffff0000u)};
                        r1 = (f32x4){__uint_as_float(w.z << 16), __uint_as_float(w.z & 0xffff0000u), __uint_as_float(w.w << 16), __uint_as_float(w.w & 0xffff0000u)}; }
                    const f32x4 v0 = r0 + gv[bj][0] * acc[ai][bj][m][0], v1 = r1 + gv[bj][1] * acc[ai][bj][m][1];
                    u32x4 o; o.x = cvtpk(v0[0], v0[1]); o.y = cvtpk(v0[2], v0[3]); o.z = cvtpk(v1[0], v1[1]); o.w = cvtpk(v1[2], v1[3]);
                    *(u32x4*)(X + off + bj * 128) = o; } }
    }
};
__device__ __forceinline__ float swiglu(float g, float u) {
    const float gt = fminf(g, 7.0f), up = fminf(fmaxf(u, -7.0f), 7.0f);
    return (up + 1.0f) * gt * __builtin_amdgcn_rcpf(1.0f + __builtin_amdgcn_exp2f(-1.702f * 1.4426950408889634f * gt));
}
struct EpiAct {
    static constexpr bool PERM = true, AFTER_DRAIN = false;
    unsigned char* ACT; const float* bgu;
    __device__ __forceinline__ void operator()(const f32x4 (&acc)[2][2][4][2], const pg8::Unit& u, int wr, int wc, int fr, int fq) const {
        const int row0 = u.pm * 256 + wr * 64 + fr, j0 = u.pn * 128 + wc * 32 + 8 * fq;
        const float* bp = bgu + (size_t)u.e * 2048 + j0;
        const f32x4 bg0 = *(const f32x4*)(bp), bg1 = *(const f32x4*)(bp + 4), bu0 = *(const f32x4*)(bp + 1024), bu1 = *(const f32x4*)(bp + 1028);
#pragma unroll
        for (int ai = 0; ai < 2; ++ai)
#pragma unroll
            for (int m = 0; m < 4; ++m) {
                const f32x4 g0 = acc[ai][0][m][0] + bg0, g1 = acc[ai][0][m][1] + bg1, u0 = acc[ai][1][m][0] + bu0, u1 = acc[ai][1][m][1] + bu1;
                uint2 w;
                w.x = __builtin_amdgcn_cvt_pk_fp8_f32(swiglu(g0[2], u0[2]), swiglu(g0[3], u0[3]), __builtin_amdgcn_cvt_pk_fp8_f32(swiglu(g0[0], u0[0]), swiglu(g0[1], u0[1]), 0u, false), true);
                w.y = __builtin_amdgcn_cvt_pk_fp8_f32(swiglu(g1[2], u1[2]), swiglu(g1[3], u1[3]), __builtin_amdgcn_cvt_pk_fp8_f32(swiglu(g1[0], u1[0]), swiglu(g1[1], u1[1]), 0u, false), true);
                *(uint2*)(ACT + (size_t)(row0 + ai * 128 + m * 16) * FF + j0) = w;
            }
    }
};
struct EpiYB {
    static constexpr bool PERM = true, AFTER_DRAIN = false;
    bf16_t* YB; const float* bdn;
    __device__ __forceinline__ void operator()(const f32x4 (&acc)[2][2][4][2], const pg8::Unit& u, int wr, int wc, int fr, int fq) const {
        const int row0 = u.pm * 256 + wr * 64 + fr, col0 = u.pn * 256 + wc * 32 + 8 * fq;
        const float* bp = bdn + (size_t)u.e * D + col0;
        f32x4 bv[2][2];
#pragma unroll
        for (int bj = 0; bj < 2; ++bj)
#pragma unroll
            for (int n = 0; n < 2; ++n) bv[bj][n] = *(const f32x4*)(bp + bj * 128 + n * 4);
#pragma unroll
        for (int ai = 0; ai < 2; ++ai)
#pragma unroll
            for (int m = 0; m < 4; ++m) { bf16_t* rowp = YB + (size_t)(row0 + ai * 128 + m * 16) * D + col0;
#pragma unroll
                for (int bj = 0; bj < 2; ++bj) { const f32x4 v0 = acc[ai][bj][m][0] + bv[bj][0], v1 = acc[ai][bj][m][1] + bv[bj][1];
                    u32x4 w; w.x = cvtpk(v0[0], v0[1]); w.y = cvtpk(v0[2], v0[3]); w.z = cvtpk(v1[0], v1[1]); w.w = cvtpk(v1[2], v1[3]);
                    *(u32x4*)(rowp + bj * 128) = w; } }
    }
};
struct EpiDry {
    static constexpr bool PERM = true, AFTER_DRAIN = false;
    __device__ __forceinline__ void operator()(const f32x4 (&acc)[2][2][4][2], const pg8::Unit& u, int wr, int wc, int fr, int fq) const {
#pragma unroll
        for (int ai = 0; ai < 2; ++ai)
#pragma unroll
            for (int m = 0; m < 4; ++m)
#pragma unroll
                for (int bj = 0; bj < 2; ++bj) { asm volatile("" :: "v"(acc[ai][bj][m][0]), "v"(acc[ai][bj][m][1])); }
    }
};
struct MoeOrder {
    int nN, nunits, G, v; const int* tile_e;
    __device__ void init(int ntiles, int nN_, int G_, int c, const int* te) { nN = nN_; nunits = ntiles * nN_; G = G_; v = (G_ % 8 == 0) ? (c % 8) * (G_ / 8) + c / 8 : c; tile_e = te; }
    __device__ bool next(int i, pg8::Unit& u) const {
        const int L = i * G + v; if (L >= nunits) return false;
        u.pm = L / nN; u.pn = L % nN; u.e = tile_e[u.pm]; return true;
    }
    __device__ __forceinline__ const bf16_t* bt(const pg8::Gemm& g, const pg8::Unit& u) const { return g.Bt + (size_t)u.e * g.N * g.K; }
    __device__ __forceinline__ void a_ready(const pg8::Unit&) const {}
    __device__ __forceinline__ void done(const pg8::Unit&) const {}
};

__device__ __forceinline__ void ph_gemm_proj(const P& p, int l, char* lds) {
    pg8::Gemm g{p.H, p.WinT + (size_t)l * PW * D, R, PW, D}; pg8::StaticOrder S; S.init(R, PW, (int)gridDim.x, (int)blockIdx.x);
    EpiProj E{p.PROJ, p.rope};
    pg8::gemm_phase<EpiProj, pg8::StaticOrder, true, true>((PG8_LAS unsigned char*)lds, g, S, E);
}
__device__ __forceinline__ void ph_gemm_out(const P& p, int l, int nrows, char* lds) {
    pg8::Gemm g{p.MIX, p.WoutT + (size_t)l * D * D, T, D, D}; pg8::StaticOrder S; S.init(T, D, (int)gridDim.x, (int)blockIdx.x);
    if (l == 0) { EpiOut<true> E{p.X, p.mod + (size_t)l * 5 * 6144 + 2 * 1024, p.x, p.ctx - (size_t)T * D}; pg8::gemm_phase<EpiOut<true>, pg8::StaticOrder, true, true>((PG8_LAS unsigned char*)lds, g, S, E); }
    else { EpiOut<false> E{p.X, p.mod + (size_t)l * 5 * 6144 + 2 * 1024, nullptr, nullptr}; pg8::gemm_phase<EpiOut<false>, pg8::StaticOrder, true, true>((PG8_LAS unsigned char*)lds, g, S, E); }
    if (nrows > T) {
        const int tid = ltid(), lane = tid & 63, wid = tid >> 6, fr = lane & 15, fq = lane >> 4;
        const bf16_t* Wt = p.WoutT + (size_t)l * D * D;
        const float* gate = p.mod + ((size_t)l * 5 + 4) * 6144 + 2 * 1024;
        for (int it = blockIdx.x; it < (TC / 64) * (D / 64); it += gridDim.x) {
            const int m0 = T + (it >> 4) * 64 + (wid & 3) * 16, n0 = (it & 15) * 64 + (wid >> 2) * 32;
            const bf16_t* ap = p.MIX + (size_t)(m0 + fr) * D + fq * 8;
            const bf16_t* bp0 = Wt + (size_t)(n0 + fr) * D + fq * 8;
            const bf16_t* bp1 = bp0 + (size_t)16 * D;
            f32x4 acc0 = (f32x4){0.f, 0.f, 0.f, 0.f}, acc1 = acc0;
#pragma unroll 8
            for (int ks = 0; ks < D / 32; ++ks) {
                const bf16x8 af = *(const bf16x8*)(ap + ks * 32), b0 = *(const bf16x8*)(bp0 + ks * 32), b1 = *(const bf16x8*)(bp1 + ks * 32);
                acc0 = __builtin_amdgcn_mfma_f32_16x16x32_bf16(b0, af, acc0, 0, 0, 0);
                acc1 = __builtin_amdgcn_mfma_f32_16x16x32_bf16(b1, af, acc1, 0, 0, 0);
            }
            const int row = m0 + fr, c0 = n0 + fq * 4;
            const size_t off = (size_t)row * D + c0;
            const float* res = p.ctx - (size_t)T * D;
            const f32x4 v0 = *(const f32x4*)(res + off) + *(const f32x4*)(gate + c0) * acc0, v1 = *(const f32x4*)(res + off + 16) + *(const f32x4*)(gate + c0 + 16) * acc1;
            uint2 o0, o1; o0.x = cvtpk(v0[0], v0[1]); o0.y = cvtpk(v0[2], v0[3]); o1.x = cvtpk(v1[0], v1[1]); o1.y = cvtpk(v1[2], v1[3]);
            *(uint2*)(p.X + off) = o0; *(uint2*)(p.X + off + 16) = o1;
        }
    }
}
__device__ __forceinline__ void ph_moe1(const P& p, int l, char* lds, const bool dry = false) {
    const int* meta = p.moe_meta + l * 512;
    const int ntiles = meta[0];
    pg8::Gemm g{(const bf16_t*)p.HS, (const bf16_t*)(p.WguT + (size_t)l * NE * 2048 * D), ntiles * 256, 2048, D / 2}; MoeOrder S; S.init(ntiles, 8, (int)gridDim.x, (int)blockIdx.x, meta + 1);
    EpiAct E{p.ACT, p.b_gu + (size_t)l * NE * 2048};
    if (dry) { EpiDry ED; pg8::gemm_phase<EpiDry, MoeOrder, true, true, true>((PG8_LAS unsigned char*)lds, g, S, ED); }
    else pg8::gemm_phase<EpiAct, MoeOrder, true, true, true>((PG8_LAS unsigned char*)lds, g, S, E);
}
__device__ __forceinline__ void ph_moe2(const P& p, int l, char* lds) {
    const int* meta = p.moe_meta + l * 512;
    const int ntiles = meta[0];
    pg8::Gemm g{(const bf16_t*)p.ACT, (const bf16_t*)(p.WdnT + (size_t)l * NE * D * FF), ntiles * 256, D, FF / 2}; MoeOrder S; S.init(ntiles, 4, (int)gridDim.x, (int)blockIdx.x, meta + 1);
    EpiYB E{p.YB, p.b_down + (size_t)l * NE * D};
    pg8::gemm_phase<EpiYB, MoeOrder, true, true, true>((PG8_LAS unsigned char*)lds, g, S, E);
}
struct CombRow { uint4 y0[2], y1[2], y2[2], y3[2], xw[2]; float4 g; };
__device__ __forceinline__ void comb_load(CombRow& c, const bf16_t* __restrict__ YB, const bf16_t* __restrict__ X, const int* __restrict__ tok_slot, const float* __restrict__ topg, int row, int lane) {
    const int4 sl = *(const int4*)(tok_slot + (size_t)row * 4);
    c.g = *(const float4*)(topg + (size_t)row * 4);
#pragma unroll
    for (int i = 0; i < 2; ++i) {
        const int k = lane * 8 + 512 * i;
        c.y0[i] = *(const uint4*)(YB + (size_t)sl.x * D + k); c.y1[i] = *(const uint4*)(YB + (size_t)sl.y * D + k);
        c.y2[i] = *(const uint4*)(YB + (size_t)sl.z * D + k); c.y3[i] = *(const uint4*)(YB + (size_t)sl.w * D + k);
        c.xw[i] = *(const uint4*)(X + (size_t)row * D + k);
    }
}
__device__ __forceinline__ void comb_finish(const P& p, const CombRow& c, int l, int row, int lane) {
    const float* m = p.mod + ((size_t)l * 5 + mod_row(row)) * 6144 + 5 * 1024;
    const float4 g = c.g;
    float xv[16]; float ss = 0.f;
#pragma unroll
    for (int i = 0; i < 2; ++i) {
        const int k = lane * 8 + 512 * i;
        const unsigned a0[4] = {c.y0[i].x, c.y0[i].y, c.y0[i].z, c.y0[i].w}, a1[4] = {c.y1[i].x, c.y1[i].y, c.y1[i].z, c.y1[i].w};
        const unsigned a2[4] = {c.y2[i].x, c.y2[i].y, c.y2[i].z, c.y2[i].w}, a3[4] = {c.y3[i].x, c.y3[i].y, c.y3[i].z, c.y3[i].w};
        const unsigned xq[4] = {c.xw[i].x, c.xw[i].y, c.xw[i].z, c.xw[i].w};
        const float4 gta = *(const float4*)(m + k), gtb = *(const float4*)(m + k + 4);
        const float gt[8] = {gta.x, gta.y, gta.z, gta.w, gtb.x, gtb.y, gtb.z, gtb.w};
#pragma unroll
        for (int q = 0; q < 4; ++q) {
            const float ylo = g.x * __uint_as_float(a0[q] << 16) + g.y * __uint_as_float(a1[q] << 16) + g.z * __uint_as_float(a2[q] << 16) + g.w * __uint_as_float(a3[q] << 16);
            const float yhi = g.x * __uint_as_float(a0[q] & 0xffff0000u) + g.y * __uint_as_float(a1[q] & 0xffff0000u) + g.z * __uint_as_float(a2[q] & 0xffff0000u) + g.w * __uint_as_float(a3[q] & 0xffff0000u);
            const float v0 = __uint_as_float(xq[q] << 16) + gt[2 * q] * ylo, v1 = __uint_as_float(xq[q] & 0xffff0000u) + gt[2 * q + 1] * yhi;
            xv[8 * i + 2 * q] = v0; xv[8 * i + 2 * q + 1] = v1; ss += v0 * v0 + v1 * v1;
        }
    }
    ss = wave_sum(ss);
    const float rstd = rsqrtf(ss * (1.f / D) + EPS);
    if (l == 0) {
        const float* m1 = p.mod + ((size_t)5 + mod_row(row)) * 6144;
        const float* g1 = p.g_mix + D;
#pragma unroll
        for (int i = 0; i < 2; ++i) {
            const int k = lane * 8 + 512 * i;
            { u32x4 xo; xo.x = cvtpk(xv[8 * i], xv[8 * i + 1]); xo.y = cvtpk(xv[8 * i + 2], xv[8 * i + 3]); xo.z = cvtpk(xv[8 * i + 4], xv[8 * i + 5]); xo.w = cvtpk(xv[8 * i + 6], xv[8 * i + 7]); *(u32x4*)(p.X + (size_t)row * D + k) = xo; }
            const float4 ga = *(const float4*)(g1 + k), gb = *(const float4*)(g1 + k + 4);
            const float4 sha = *(const float4*)(m1 + k), shb = *(const float4*)(m1 + k + 4);
            const float4 sca = *(const float4*)(m1 + 1024 + k), scb = *(const float4*)(m1 + 1024 + k + 4);
            u32x4 o;
            o.x = cvtpk(xv[8 * i] * rstd * ga.x * (1.f + sca.x) + sha.x, xv[8 * i + 1] * rstd * ga.y * (1.f + sca.y) + sha.y);
            o.y = cvtpk(xv[8 * i + 2] * rstd * ga.z * (1.f + sca.z) + sha.z, xv[8 * i + 3] * rstd * ga.w * (1.f + sca.w) + sha.w);
            o.z = cvtpk(xv[8 * i + 4] * rstd * gb.x * (1.f + scb.x) + shb.x, xv[8 * i + 5] * rstd * gb.y * (1.f + scb.y) + shb.y);
            o.w = cvtpk(xv[8 * i + 6] * rstd * gb.z * (1.f + scb.z) + shb.z, xv[8 * i + 7] * rstd * gb.w * (1.f + scb.w) + shb.w);
            *(u32x4*)(p.H + (size_t)row * D + k) = o;
        }
    } else {
#pragma unroll
        for (int i = 0; i < 2; ++i) {
            const int k = lane * 8 + 512 * i;
            const float4 ga = *(const float4*)(p.g_final + k), gb = *(const float4*)(p.g_final + k + 4);
            float* op = p.out + (size_t)row * D + k;
            *(float4*)op = make_float4(xv[8 * i] * rstd * ga.x, xv[8 * i + 1] * rstd * ga.y, xv[8 * i + 2] * rstd * ga.z, xv[8 * i + 3] * rstd * ga.w);
            *(float4*)(op + 4) = make_float4(xv[8 * i + 4] * rstd * gb.x, xv[8 * i + 5] * rstd * gb.y, xv[8 * i + 6] * rstd * gb.z, xv[8 * i + 7] * rstd * gb.w);
        }
    }
}
__device__ __forceinline__ void ph_combine(const P& p, int l, int nrows) {
    const int wave = ltid() >> 6, lane = ltid() & 63;
    for (int pr = blockIdx.x * 8 + wave; pr < nrows / 2; pr += gridDim.x * 8) {
        CombRow ca, cb;
        comb_load(ca, p.YB, p.X, p.tok_slot, p.topg, 2 * pr, lane);
        comb_load(cb, p.YB, p.X, p.tok_slot, p.topg, 2 * pr + 1, lane);
        comb_finish(p, ca, l, 2 * pr, lane);
        comb_finish(p, cb, l, 2 * pr + 1, lane);
    }
}
#ifndef PROBE_DUP
#define PROBE_DUP 0
#endif
#ifndef PROBE_DUP
#define PROBE_DUP 0
#endif
extern __shared__ __attribute__((aligned(16))) char smem[];
__global__ void __launch_bounds__(NT, 2) mega(P p) {
    char* lds = smem;
    if (threadIdx.x == 0) *(uint4*)(smem + LDS_MAIN) = make_uint4(0u, 0u, 0u, 0u);
    __syncthreads();
    XcdBarrier bar = xcd_barrier_post(p.bar, (volatile LAS unsigned*)(smem + LDS_MAIN));
    ph_prologue(p, lds, 0);
    if (PROBE_DUP == 11) ph_prologue(p, lds, 0);
    xcd_barrier(bar);
    ph_norm1(p, 0);
    ph_prologue(p, lds, 1);
    if (PROBE_DUP == 1) ph_prologue(p, lds, 1);
    if (PROBE_DUP == 5) ph_norm1(p, 0);
    xcd_barrier(bar);
#pragma unroll
    for (int l = 0; l < 2; ++l) {
        const int nrows = l == 0 ? R : T;
        ph_gemm_proj(p, l, lds);
        if (PROBE_DUP == 4) ph_gemm_proj(p, l, lds);
        xcd_barrier(bar);
        ph_dattn(p, l, nrows, lds);
        if (PROBE_DUP == 2) ph_dattn(p, l, nrows, lds);
        ph_na(p, l, nrows, lds);
        if (PROBE_DUP == 5) ph_na(p, l, nrows, lds);
        ph_pool(p, l, nrows, lds);
        ph_sgu(p, l, nrows, lds);
        if (PROBE_DUP == 3) { ph_pool(p, l, nrows, lds); ph_sgu(p, l, nrows, lds); }
        xcd_barrier(bar);
        ph_gemm_out(p, l, nrows, lds);
        if (PROBE_DUP == 12 && l == 0) ph_gemm_out(p, l, nrows, lds);
        xcd_barrier(bar);
        ph_router(p, l, nrows, lds);
        xcd_barrier(bar);
        ph_assign(p, l, nrows, lds);
        xcd_barrier(bar);
        if (PROBE_DUP == 8) { xcd_barrier(bar); xcd_barrier(bar); xcd_barrier(bar); xcd_barrier(bar); xcd_barrier(bar); }
        ph_moe1(p, l, lds);
        if (PROBE_DUP == 6) ph_moe1(p, l, lds);
        if (PROBE_DUP == 13) ph_moe1(p, l, lds, true);
        xcd_barrier(bar);
        ph_moe2(p, l, lds);
        if (PROBE_DUP == 7) ph_moe2(p, l, lds);
        xcd_barrier(bar);
        ph_combine(p, l, nrows);
        if (l == 0) xcd_barrier(bar);
    }
}

static inline size_t align_up(size_t v, size_t a) { return (v + a - 1) / a * a; }

extern "C" void kernel_launch(void* const* d_in, const int* in_sizes, int n_in, void* d_out, int out_size, void* d_ws, size_t ws_size, hipStream_t stream) {
    P p{};
    const float** ins = (const float**)&p.x;
    for (int i = 0; i < 28; ++i) ins[i] = (const float*)d_in[i];
    p.out = (float*)d_out;
    char* w = (char*)d_ws; size_t off = 0;
    auto carve = [&](size_t bytes) { void* r = w + off; off = align_up(off + bytes, 256); return r; };
    const size_t ctl_bytes = XCD_BAR_WORDS * 4 + 2 * 64 * 4;
    p.bar = (unsigned*)carve(ctl_bytes);
    p.cnt = (int*)(p.bar + XCD_BAR_WORDS);
    p.mod = (float*)carve((size_t)2 * 5 * 6144 * 4);
    p.rope = (float*)carve(64 * 8 * 2 * 4);
    p.X = (bf16_t*)carve((size_t)R * D * 2);
    p.H = (bf16_t*)carve((size_t)R * D * 2);
    p.PROJ = (bf16_t*)carve((size_t)R * PW * 2);
    p.MIX = (bf16_t*)carve((size_t)R * D * 2);
    p.WinT = (bf16_t*)carve((size_t)2 * PW * D * 2);
    p.WoutT = (bf16_t*)carve((size_t)2 * D * D * 2);
    p.WguT = (unsigned char*)carve((size_t)2 * NE * 2048 * D);
    p.WdnT = (unsigned char*)carve((size_t)2 * NE * D * FF);
    p.WpT = (bf16_t*)carve((size_t)2 * 4 * 64 * 64 * 2);
    p.WsB = (bf16_t*)carve((size_t)2 * 4 * 128 * 128 * 2);
    p.topi = (int*)carve((size_t)R * 4 * 4);
    p.topg = (float*)carve((size_t)R * 4 * 4);
    p.tok_slot = (int*)carve((size_t)R * 4 * 4);
    p.moe_meta = (int*)carve(2 * 512 * 4);
    p.HS = (unsigned char*)carve((size_t)NSLOT * D);
    p.ACT = (unsigned char*)carve((size_t)NSLOT * FF);
    p.YB = (bf16_t*)carve((size_t)NSLOT * D * 2);

    static int grid = 0;
    if (!grid) {
        int dev = 0, cus = 0, per_cu = 0;
        (void)hipGetDevice(&dev);
        (void)hipDeviceGetAttribute(&cus, hipDeviceAttributeMultiprocessorCount, dev);
        (void)hipFuncSetAttribute((const void*)mega, hipFuncAttributeMaxDynamicSharedMemorySize, LDS_BYTES);
        (void)hipOccupancyMaxActiveBlocksPerMultiprocessor(&per_cu, mega, NT, LDS_BYTES);
        grid = cus * (per_cu < 1 ? per_cu : 1);
        if (grid <= 0) { fprintf(stderr, "mega: occupancy query returned %d blocks per CU\n", per_cu); grid = 0; return; }
    }
    (void)hipMemsetAsync(p.bar, 0, ctl_bytes, stream);
    mega<<<grid, NT, LDS_BYTES, stream>>>(p);
}
```

```cpp
#include <hip/hip_runtime.h>
#include <stdint.h>
#include <cstdio>

typedef unsigned short bf16_t;
typedef short bf16x8 __attribute__((ext_vector_type(8)));
typedef float f32x4 __attribute__((ext_vector_type(4)));

constexpr int D = 1024, NB = 4, S = 4096, T = NB * S, CL = 256, TC = NB * CL, R = T + TC;
constexpr int PW = 2304, NE = 32, TOPK = 4, FF = 1024;
constexpr int MAXSLOT = R * TOPK;
constexpr int NSLOT = MAXSLOT + NE * 256;
constexpr float EPS = 1e-6f;
constexpr int NT = 512;
constexpr int LDS_MAIN = 150 * 1024;
constexpr int LDS_BYTES = LDS_MAIN + 1024;

__device__ __forceinline__ bf16_t f2bf(float f) { unsigned u = __float_as_uint(f); return (bf16_t)((u + 0x7fffu + ((u >> 16) & 1u)) >> 16); }
__device__ __forceinline__ float bf2f(bf16_t h) { return __uint_as_float(((unsigned)h) << 16); }
__device__ __forceinline__ float wave_sum(float v) {
#pragma unroll
    for (int o = 32; o >= 1; o >>= 1) v += __shfl_xor(v, o);
    return v;
}
__device__ __forceinline__ int mod_row(int row) { return row < T ? (row >> 12) : 4; }

#define XB_TMO      128
#define XB_XCNT(j)  (256  + 64 * (j))
#define XB_XSUB(j)  (1280 + 64 * (j))
#define XB_XGEN(j)  (2304 + 64 * (j))
#define XB_TOP      3328
#define XB_TOPGEN   3392
#define XCD_BAR_WORDS 3456
#define XB_SPIN_CAP (1u << 18)
#define LAS __attribute__((address_space(3)))

__device__ __forceinline__ unsigned xb_ld(unsigned* p)              { return __hip_atomic_load(p, __ATOMIC_RELAXED, __HIP_MEMORY_SCOPE_AGENT); }
__device__ __forceinline__ unsigned xb_add(unsigned* p, unsigned v) { return __hip_atomic_fetch_add(p, v, __ATOMIC_RELAXED, __HIP_MEMORY_SCOPE_AGENT); }
__device__ __forceinline__ unsigned xb_xcc_id() { return (unsigned)__builtin_amdgcn_s_getreg((3 << 11) | 20) & 0xFu; }
#define XB_SPIN(cond, bar) do { unsigned _sp = 0; while (cond) { __builtin_amdgcn_s_sleep(1); \
    if ((++_sp & 255u) == 0u) { if (xb_ld(&(bar)[XB_TMO])) break; if (_sp > XB_SPIN_CAP) { atomicAdd(&(bar)[XB_TMO], 1u); break; } } } } while (0)

struct XcdBarrier {
    unsigned* bar; unsigned x;
    volatile LAS unsigned* st;
};
__device__ __forceinline__ XcdBarrier xcd_barrier_post(unsigned* bar, volatile LAS unsigned* st) {
    XcdBarrier b; b.bar = bar; b.x = xb_xcc_id(); b.st = st;
    if (threadIdx.x == 0) (void)xb_add(&bar[XB_XCNT(b.x)], 1u);
    return b;
}
__device__ __forceinline__ void xcd_barrier_complete(unsigned* bar, unsigned x, unsigned& nloc, unsigned& nx) {
    const unsigned G = gridDim.x * gridDim.y * gridDim.z;
    unsigned sum, cnt, mine, sp = 0u;
    for (;;) {
        sum = 0u; cnt = 0u; mine = 0u;
#pragma unroll
        for (unsigned j = 0; j < 16; ++j) { const unsigned c = xb_ld(&bar[XB_XCNT(j)]); sum += c; cnt += (c > 0u) ? 1u : 0u; mine = (j == x) ? c : mine; }
        if (sum == G) break;
        __builtin_amdgcn_s_sleep(1);
        if ((++sp & 255u) == 0u) { if (xb_ld(&bar[XB_TMO])) break; if (sp > XB_SPIN_CAP) { atomicAdd(&bar[XB_TMO], 1u); break; } }
    }
    nloc = mine > 0u ? mine : 1u; nx = cnt > 0u ? cnt : 1u;
}
__device__ __forceinline__ void xcd_barrier(const XcdBarrier& b) {
    asm volatile("s_waitcnt vmcnt(0)" ::: "memory");
    __syncthreads();
    if (threadIdx.x == 0) {
        unsigned* bar = b.bar;
        __builtin_amdgcn_s_waitcnt(0);
        unsigned nloc = b.st[0], nx = b.st[1];
        if (nloc == 0u) { xcd_barrier_complete(bar, b.x, nloc, nx); b.st[0] = nloc; b.st[1] = nx; }
        const unsigned old = xb_add(&bar[XB_XSUB(b.x)], 1u);
        const unsigned gen = old / nloc;
        if (old + 1u == (gen + 1u) * nloc) {
            __builtin_amdgcn_fence(__ATOMIC_RELEASE, "agent");
            asm volatile("s_waitcnt vmcnt(0)" ::: "memory");
            const unsigned og = xb_add(&bar[XB_TOP], 1u);
            const unsigned tg = og / nx;
            if (og + 1u == (tg + 1u) * nx) xb_add(&bar[XB_TOPGEN], 1u);
            else XB_SPIN(xb_ld(&bar[XB_TOPGEN]) == tg, bar);
            __builtin_amdgcn_fence(__ATOMIC_ACQUIRE, "agent");
            xb_add(&bar[XB_XGEN(b.x)], 1u);
            asm volatile("s_waitcnt vmcnt(0)" ::: "memory");
        } else {
            XB_SPIN(xb_ld(&bar[XB_XGEN(b.x)]) == gen, bar);
            __builtin_amdgcn_fence(__ATOMIC_ACQUIRE, "agent");
            asm volatile("s_waitcnt vmcnt(0)" ::: "memory");
        }
    }
    __syncthreads();
}

struct P {
    const float *x, *c, *ctx, *c_ctx, *w_mod, *b_mod, *g_mix, *g_ffn, *w_in, *w_out, *lam_q1, *lam_k1, *lam_q2, *lam_k2, *g_sub,
        *w_pool, *s_pool, *g_sgu, *w_sgu, *b_sgu, *rpb, *w_router, *b_router, *w_gu, *b_gu, *w_down, *b_down, *g_final;
    float* out;
    unsigned* bar;
    int* cnt;
    float* mod;
    float* rope;
    bf16_t* X;
    bf16_t* H;
    bf16_t* PROJ;
    bf16_t* MIX;
    bf16_t* WinT;
    bf16_t* WoutT;
    unsigned char* WguT;
    unsigned char* WdnT;
    bf16_t* WpT;
    bf16_t* WsB;
    int* topi;
    float* topg;
    int* tok_slot;
    int* moe_meta;
    unsigned char* HS;
    unsigned char* ACT;
    bf16_t* YB;
};

__device__ __forceinline__ int ltid() { int t = threadIdx.x; asm volatile("" : "+v"(t)); return t; }
typedef float f32x16 __attribute__((ext_vector_type(16)));
typedef short s16x4 __attribute__((ext_vector_type(4)));
typedef short v4i16_t __attribute__((ext_vector_type(4)));
typedef float f32x2_t __attribute__((ext_vector_type(2)));
typedef __bf16 bf16x2_t __attribute__((ext_vector_type(2)));
typedef __attribute__((address_space(3))) const char* lds_cptr;
typedef unsigned u32x4 __attribute__((ext_vector_type(4)));
__device__ __forceinline__ unsigned cvtpk(float lo, float hi) { f32x2_t v = {lo, hi}; bf16x2_t b = __builtin_convertvector(v, bf16x2_t); return __builtin_bit_cast(unsigned, b); }
__device__ __forceinline__ s16x4 vtr(lds_cptr q) { return __builtin_bit_cast(s16x4, __builtin_amdgcn_ds_read_tr16_b64_v4i16((__attribute__((address_space(3))) v4i16_t*)q)); }
__device__ __forceinline__ float xhalf_max(float v) { auto rr = __builtin_amdgcn_permlane32_swap(__float_as_uint(v), __float_as_uint(v), false, false); return fmaxf(__uint_as_float(rr[0]), __uint_as_float(rr[1])); }
__device__ __forceinline__ float xhalf_sum(float v) { auto rr = __builtin_amdgcn_permlane32_swap(__float_as_uint(v), __float_as_uint(v), false, false); return __uint_as_float(rr[0]) + __uint_as_float(rr[1]); }
namespace pg8 {
#define PG8_LAS __attribute__((address_space(3)))
constexpr int BM = 256, BK = 64, HALF = 128, HTB = HALF * BK * 2  , STAGE_BYTES = 8 * HTB, NXCD = 8, WGM = 8;
__host__ __device__ __forceinline__ int lds_byte(int r, int c) { const int st = (r >> 4) * 2 + (c >> 5), rr = r & 15, cc = c & 31, ob = rr * 64 + cc * 2; return st * 1024 + (ob ^ (((ob >> 9) & 1) << 5)); }
__host__ __device__ __forceinline__ void stage_rc(int b, int& R, int& C) { const int st = b / 1024, sb = b % 1024, swz = sb ^ (((sb >> 9) & 1) << 5); R = (st >> 1) * 16 + swz / 64; C = (st & 1) * 32 + (swz % 64) / 2; }
__host__ __device__ __forceinline__ int perm32(int rho) { const int n = rho >> 4, i = rho & 15; return 8 * (i >> 2) + 4 * n + (i & 3); }
struct Unit { int pm, pn, e; };
struct Gemm { const bf16_t* A; const bf16_t* Bt; int M, N, K; };
struct StaticOrder {
    int nM, nN, nwg, G, c;
    __host__ __device__ void init(int M, int N, int G_, int c_) { nM = M / BM; nN = N / BM; nwg = nM * nN; G = G_; c = c_; }
    __host__ __device__ bool next(int i, Unit& u) const {
        const long L = (long)i * G + c; if (L >= nwg) return false;
        int wgid = (int)L; { const int q = nwg / NXCD, r = nwg % NXCD, xcd = wgid % NXCD, off = wgid / NXCD; wgid = (xcd < r ? xcd * (q + 1) : r * (q + 1) + (xcd - r) * q) + off; }
        const int nig = WGM * nN, gid = wgid / nig, fm = gid * WGM, gsz = (nM - fm) < WGM ? (nM - fm) : WGM;
        u.pm = fm + ((wgid % nig) % gsz); u.pn = (wgid % nig) / gsz; u.e = 0; return true;
    }
    __device__ __forceinline__ const bf16_t* bt(const Gemm& g, const Unit&) const { return g.Bt; }
    __device__ __forceinline__ void a_ready(const Unit&) const {}
    __device__ __forceinline__ void done(const Unit&) const {}
};
typedef int v4i_t __attribute__((ext_vector_type(4)));
typedef int v8i_t __attribute__((ext_vector_type(8)));
__device__ __forceinline__ v8i_t cat8(bf16x8 a, bf16x8 b) { const v4i_t x = __builtin_bit_cast(v4i_t, a), y = __builtin_bit_cast(v4i_t, b); return __builtin_shufflevector(x, y, 0, 1, 2, 3, 4, 5, 6, 7); }
template <class Epi, class Sched, bool ALIGN_EPI = false, bool SP2 = false, bool F8 = false>
__device__ __forceinline__ void gemm_phase(PG8_LAS unsigned char* lds, const Gemm g, const Sched& S, const Epi& E) {
    const int tid = ltid(), wid = __builtin_amdgcn_readfirstlane(tid >> 6), lane = tid & 63, wr = wid >> 2, wc = wid & 3, fr = lane & 15, fq = lane >> 4;
    const int K = g.K, nt = K / BK;
    unsigned voffA[2], voffB[2];
#pragma unroll
    for (int i = 0; i < 2; ++i) { int R, C; stage_rc(tid * 16 + i * 8192, R, C); const int Rb = Epi::PERM ? ((R & ~31) + perm32(R & 31)) : R;
        voffA[i] = (unsigned)(R * K + C) * 2u; voffB[i] = (unsigned)(Rb * K + C) * 2u; }
    const size_t kstep = (size_t)(BK * 2);
    const size_t hstep = (size_t)HALF * K * 2;
    const size_t tstep = 2 * hstep;
    const unsigned ldsw = (unsigned)wid * 1024u;
    const int aoff = lds_byte(wr * 64 + fr, fq * 8), boff = lds_byte(wc * 32 + fr, fq * 8);
#define PG8_SA(b, h) (((b) * 2 + (h)) * HTB)
#define PG8_SB(b, h) ((4 + (b) * 2 + (h)) * HTB)
#define PG8_STAGE(bufoff, gbase, voff) do { _Pragma("unroll") for (int _i = 0; _i < 2; ++_i) \
        __builtin_amdgcn_global_load_lds((const unsigned*)((const char*)(gbase) + (voff)[_i]), (PG8_LAS unsigned*)(lds + (bufoff) + ldsw + _i * 8192), 16, 0, 0); } while (0)
#define PG8_LDA(dst, b, h) do { _Pragma("unroll") for (int m = 0; m < 4; ++m) _Pragma("unroll") for (int k = 0; k < 2; ++k) dst[m][k] = *(const PG8_LAS bf16x8*)(lds + PG8_SA(b, h) + aoff + m * 2048 + k * 1024); \
        if constexpr (F8) { _Pragma("unroll") for (int m = 0; m < 4; ++m) dst##8[m] = cat8(dst[m][0], dst[m][1]); } } while (0)
#define PG8_LDB(dst, b, h) do { _Pragma("unroll") for (int n = 0; n < 2; ++n) _Pragma("unroll") for (int k = 0; k < 2; ++k) dst[n][k] = *(const PG8_LAS bf16x8*)(lds + PG8_SB(b, h) + boff + n * 2048 + k * 1024); \
        if constexpr (F8) { _Pragma("unroll") for (int n = 0; n < 2; ++n) dst##8[n] = cat8(dst[n][0], dst[n][1]); } } while (0)
#define PG8_MMA(ai, bj, At, Bt) do { __builtin_amdgcn_s_setprio(1); \
        if constexpr (F8) { _Pragma("unroll") for (int m = 0; m < 4; ++m) _Pragma("unroll") for (int n = 0; n < 2; ++n) \
            asm volatile("v_mfma_scale_f32_16x16x128_f8f6f4 %0, %1, %2, %0, %3, %4 op_sel_hi:[0,0,0]" : "+v"(acc[ai][bj][m][n]) : "v"(Bt##8[n]), "v"(At##8[m]), "v"(sclW), "v"(sclX)); } \
        else { _Pragma("unroll") for (int m = 0; m < 4; ++m) _Pragma("unroll") for (int n = 0; n < 2; ++n) _Pragma("unroll") for (int k = 0; k < 2; ++k) \
            acc[ai][bj][m][n] = __builtin_amdgcn_mfma_f32_16x16x32_bf16(Bt[n][k], At[m][k], acc[ai][bj][m][n], 0, 0, 0); } \
        __builtin_amdgcn_s_setprio(0); } while (0)
#define PG8_WAIT_V(n) asm volatile("s_waitcnt vmcnt(" #n ")" ::: "memory")
#define PG8_WAIT_L(n) asm volatile("s_waitcnt lgkmcnt(" #n ")" ::: "memory")
#define PG8_BAR __builtin_amdgcn_s_barrier()
#define PG8_SCHED __builtin_amdgcn_sched_barrier(0)
    Unit cur, nxt; int ui = 0;
    if (!S.next(0, cur)) return;
    f32x4 acc[2][2][4][2];
#pragma unroll
    for (int a = 0; a < 2; ++a)
#pragma unroll
        for (int b = 0; b < 2; ++b)
#pragma unroll
            for (int m = 0; m < 4; ++m)
#pragma unroll
                for (int n = 0; n < 2; ++n) { acc[a][b][m][n] = (f32x4){0.f, 0.f, 0.f, 0.f}; }
    bf16x8 At[4][2], B0[2][2], B1[2][2];
    v8i_t At8[4], B08[2], B18[2];
    const int sclW = 0x79797979, sclX = 0x7f7f7f7f;
    const char* cA = (const char*)g.A + (size_t)cur.pm * tstep; const char* cB = (const char*)S.bt(g, cur) + (size_t)cur.pn * tstep;
    S.a_ready(cur);
    if constexpr (SP2) {
        PG8_STAGE(PG8_SB(0, 0), cB, voffB); PG8_STAGE(PG8_SB(0, 1), cB + hstep, voffB); PG8_STAGE(PG8_SA(0, 0), cA, voffA); PG8_STAGE(PG8_SA(0, 1), cA + hstep, voffA);
        if (wr == 1) PG8_BAR;
        PG8_WAIT_V(2); PG8_BAR;
        PG8_STAGE(PG8_SB(1, 0), cB + kstep, voffB); PG8_STAGE(PG8_SA(1, 0), cA + kstep, voffA); PG8_STAGE(PG8_SB(1, 1), cB + hstep + kstep, voffB);
        PG8_WAIT_V(6); PG8_BAR;
    } else {
        PG8_STAGE(PG8_SB(0, 0), cB, voffB); PG8_STAGE(PG8_SA(0, 0), cA, voffA); PG8_STAGE(PG8_SB(0, 1), cB + hstep, voffB); PG8_STAGE(PG8_SA(0, 1), cA + hstep, voffA);
        if (wr == 1) PG8_BAR;
        PG8_WAIT_V(4); PG8_BAR;
        PG8_STAGE(PG8_SB(1, 0), cB + kstep, voffB); PG8_STAGE(PG8_SA(1, 0), cA + kstep, voffA); PG8_STAGE(PG8_SB(1, 1), cB + hstep + kstep, voffB);
        PG8_WAIT_V(6); PG8_BAR;
    }
    for (;;) {
        const bool has_next = S.next(ui + 1, nxt);
        const char* nA = has_next ? (const char*)g.A + (size_t)nxt.pm * tstep : cA; const char* nB = has_next ? (const char*)S.bt(g, nxt) + (size_t)nxt.pn * tstep : cB;
#pragma unroll 1
        for (int t = 0; t < nt; t += 2) {
            const bool last = (t == nt - 2);
            const char* a1 = cA + (size_t)(t + 1) * kstep;
            const char* a2 = last ? nA : cA + (size_t)(t + 2) * kstep; const char* b2 = last ? nB : cB + (size_t)(t + 2) * kstep;
            const char* a3 = a2 + kstep; const char* b3 = b2 + kstep;
            if (last && has_next) S.a_ready(nxt);
            if constexpr (SP2) {
            PG8_LDB(B0, 0, 0); PG8_LDB(B1, 0, 1); PG8_SCHED; PG8_LDA(At, 0, 0); PG8_STAGE(PG8_SA(1, 1), a1 + hstep, voffA);
            PG8_WAIT_V(8); PG8_WAIT_L(0); PG8_BAR; PG8_MMA(0, 0, At, B0); PG8_MMA(0, 1, At, B1); PG8_BAR; PG8_SCHED;
            PG8_LDA(At, 0, 1); PG8_STAGE(PG8_SB(0, 0), b2, voffB); PG8_STAGE(PG8_SB(0, 1), b2 + hstep, voffB); PG8_STAGE(PG8_SA(0, 0), a2, voffA);
            PG8_WAIT_V(8); PG8_WAIT_L(0); PG8_BAR; PG8_MMA(1, 0, At, B0); PG8_MMA(1, 1, At, B1); PG8_BAR; PG8_SCHED;
            PG8_LDB(B0, 1, 0); PG8_LDB(B1, 1, 1); PG8_SCHED; PG8_LDA(At, 1, 0); PG8_STAGE(PG8_SA(0, 1), a2 + hstep, voffA);
            PG8_WAIT_V(8); PG8_WAIT_L(0); PG8_BAR; PG8_MMA(0, 0, At, B0); PG8_MMA(0, 1, At, B1); PG8_BAR; PG8_SCHED;
            PG8_LDA(At, 1, 1); PG8_STAGE(PG8_SB(1, 0), b3, voffB); PG8_STAGE(PG8_SB(1, 1), b3 + hstep, voffB); PG8_STAGE(PG8_SA(1, 0), a3, voffA);
            PG8_WAIT_V(8); PG8_WAIT_L(0); PG8_BAR; PG8_MMA(1, 0, At, B0); PG8_MMA(1, 1, At, B1); PG8_BAR; PG8_SCHED;
            } else {
            PG8_LDB(B0, 0, 0); PG8_SCHED; PG8_LDA(At, 0, 0); PG8_STAGE(PG8_SA(1, 1), a1 + hstep, voffA);
            PG8_WAIT_L(8); PG8_BAR; PG8_WAIT_L(0); PG8_MMA(0, 0, At, B0); PG8_BAR; PG8_SCHED;
            PG8_LDB(B1, 0, 1); PG8_STAGE(PG8_SB(0, 0), b2, voffB);
            PG8_BAR; PG8_WAIT_L(0); PG8_MMA(0, 1, At, B1); PG8_BAR;
            PG8_LDA(At, 0, 1); PG8_STAGE(PG8_SA(0, 0), a2, voffA);
            PG8_BAR; PG8_WAIT_L(0); PG8_MMA(1, 0, At, B0); PG8_BAR; PG8_SCHED;
            PG8_STAGE(PG8_SB(0, 1), b2 + hstep, voffB);
            PG8_WAIT_V(6); PG8_BAR; PG8_MMA(1, 1, At, B1); PG8_BAR;
            PG8_LDB(B0, 1, 0); PG8_SCHED; PG8_LDA(At, 1, 0); PG8_STAGE(PG8_SA(0, 1), a2 + hstep, voffA);
            PG8_WAIT_L(8); PG8_BAR; PG8_WAIT_L(0); PG8_MMA(0, 0, At, B0); PG8_BAR; PG8_SCHED;
            PG8_LDB(B1, 1, 1); PG8_STAGE(PG8_SB(1, 0), b3, voffB);
            PG8_BAR; PG8_WAIT_L(0); PG8_MMA(0, 1, At, B1); PG8_BAR;
            PG8_LDA(At, 1, 1); PG8_STAGE(PG8_SA(1, 0), a3, voffA);
            PG8_BAR; PG8_WAIT_L(0); PG8_MMA(1, 0, At, B0); PG8_BAR; PG8_SCHED;
            PG8_STAGE(PG8_SB(1, 1), b3 + hstep, voffB);
            PG8_WAIT_V(6); PG8_BAR; PG8_MMA(1, 1, At, B1); PG8_BAR;
            }
        }
        if constexpr (ALIGN_EPI) { if (wr == 0) PG8_BAR; }
        if constexpr (F8) asm volatile("s_nop 15\n\ts_nop 15" ::: "memory");
        if constexpr (!Epi::AFTER_DRAIN) { E(acc, cur, wr, wc, fr, fq); S.done(cur); }
        if (!has_next) break;
#pragma unroll
        for (int a = 0; a < 2; ++a)
#pragma unroll
            for (int b = 0; b < 2; ++b)
#pragma unroll
                for (int m = 0; m < 4; ++m)
#pragma unroll
                    for (int n = 0; n < 2; ++n) { acc[a][b][m][n] = (f32x4){0.f, 0.f, 0.f, 0.f}; }
        cur = nxt; cA = nA; cB = nB; ++ui;
        if constexpr (ALIGN_EPI) { if (wr == 1) PG8_BAR; }
    }
    PG8_WAIT_V(0);
    if constexpr (!ALIGN_EPI) { if (wr == 0) PG8_BAR; }
    PG8_BAR;
    if constexpr (Epi::AFTER_DRAIN) { E.fused(acc, cur, wr, wc, fr, fq, lds, wid, lane); S.done(cur); }
#undef PG8_SA
#undef PG8_SB
#undef PG8_STAGE
#undef PG8_LDA
#undef PG8_LDB
#undef PG8_MMA
#undef PG8_WAIT_V
#undef PG8_WAIT_L
#undef PG8_BAR
#undef PG8_SCHED
}
}

__device__ __forceinline__ void ph_prologue(const P& p, char* lds, const int part) {
    const int tid = ltid();
    float* fl = (float*)lds;
    if (part == 0) {
    for (int it = blockIdx.x; it < 192; it += gridDim.x) {
        const int l = it / 96, cg = it % 96;
        float* sc = fl;
        float* part = fl + 5 * 1024;
        __syncthreads();
        for (int i = tid; i < 5 * 1024; i += NT) {
            const int r = i >> 10, k = i & 1023;
            const float v = r < 4 ? p.c[r * 1024 + k] : p.c_ctx[k];
            sc[i] = v / (1.f + __expf(-v));
        }
        __syncthreads();
        const int kq = tid >> 6, col = tid & 63, j = cg * 64 + col;
        const float* W = p.w_mod + (size_t)l * 1024 * 6144 + j;
        float a0 = 0, a1 = 0, a2 = 0, a3 = 0, a4 = 0;
#pragma unroll 16
        for (int k = kq * 128; k < kq * 128 + 128; ++k) {
            const float w = W[(size_t)k * 6144];
            a0 += sc[k] * w; a1 += sc[1024 + k] * w; a2 += sc[2048 + k] * w; a3 += sc[3072 + k] * w; a4 += sc[4096 + k] * w;
        }
        part[(kq * 5 + 0) * 64 + col] = a0; part[(kq * 5 + 1) * 64 + col] = a1; part[(kq * 5 + 2) * 64 + col] = a2;
        part[(kq * 5 + 3) * 64 + col] = a3; part[(kq * 5 + 4) * 64 + col] = a4;
        __syncthreads();
        if (tid < 5 * 64) {
            const int r = tid >> 6, cc = tid & 63, jj = cg * 64 + cc;
            float v = 0.f;
#pragma unroll
            for (int q = 0; q < 8; ++q) v += part[(q * 5 + r) * 64 + cc];
            p.mod[((size_t)l * 5 + r) * 6144 + jj] = v + p.b_mod[l * 6144 + jj];
        }
    }
    if (blockIdx.x == gridDim.x - 1) {
        const int pos = tid >> 3, f = tid & 7;
        const float inv = powf(10000.0f, -(float)f / 8.0f);
        const float ang = (float)pos * inv;
        p.rope[tid * 2] = cosf(ang); p.rope[tid * 2 + 1] = sinf(ang);
    }
    for (int i = blockIdx.x * NT + tid; i < 2 * 4 * 64 * 64; i += gridDim.x * NT) { const int ii = i & 63, j = (i >> 6) & 63, lg = i >> 12; p.WpT[i] = f2bf(p.w_pool[(size_t)lg * 4096 + ii * 64 + j]); }
    for (int i = blockIdx.x * NT + tid; i < 2 * 4 * 128 * 128; i += gridDim.x * NT) p.WsB[i] = f2bf(p.w_sgu[i]);
    }
    if (part == 0) {
        const int n_in = 2 * 9 * 16, n_out = 2 * 4 * 16, total = n_in + n_out;
        const int kr = tid >> 6, n4 = tid & 63, kg = tid & 7, nl = tid >> 3;
        for (int it = blockIdx.x; it < total; it += gridDim.x) {
            int i_ = it; const float* W_; bf16_t* Wt_; int N, K;
            if (i_ < n_in) { W_ = p.w_in; Wt_ = p.WinT; N = PW; K = D; } else { i_ -= n_in; W_ = p.w_out; Wt_ = p.WoutT; N = D; K = D; }
            const int ntn = N / 256, per = ntn * (K / 64), m_ = i_ / per, r_ = i_ % per, tn = r_ % ntn, tk = r_ / ntn, n0 = tn * 256;
            const float* src = W_ + (size_t)m_ * K * N + (size_t)(tk * 64) * N + n0; bf16_t* dst = Wt_ + (size_t)m_ * K * N + tk * 64;
            float4 rg[8];
#pragma unroll
            for (int i = 0; i < 8; ++i) rg[i] = *(const float4*)(src + (size_t)(kr + 8 * i) * N + n4 * 4);
            __syncthreads();
#pragma unroll
            for (int i = 0; i < 8; ++i) { float* q = fl + (kr + 8 * i) * 257 + n4 * 4; q[0] = rg[i].x; q[1] = rg[i].y; q[2] = rg[i].z; q[3] = rg[i].w; }
            __syncthreads();
#pragma unroll
            for (int j = 0; j < 4; ++j) {
                const int n = nl + 64 * j;
                const float* q = fl + (8 * kg) * 257 + n;
                u32x4 w;
                w.x = cvtpk(q[0], q[257]); w.y = cvtpk(q[2 * 257], q[3 * 257]); w.z = cvtpk(q[4 * 257], q[5 * 257]); w.w = cvtpk(q[6 * 257], q[7 * 257]);
                *(u32x4*)(dst + (size_t)(n0 + n) * K + 8 * kg) = w;
            }
        }
    } else {
        const int n_gu = 64 * 16 * 8, n_dn = 64 * 8 * 8, total = n_gu + n_dn;
        const int kr = tid >> 5, n4 = tid & 31, kg = (tid >> 3) & 7, nl = (tid & 7) + 8 * (tid >> 6);
        float4 rg[8];
        const float* src = nullptr; unsigned char* dst = nullptr; int N = 0, K = 0, n0 = 0, perm = 0;
        const float* nsrc = nullptr; unsigned char* ndst = nullptr; int nN = 0, nK = 0, nn0 = 0, nperm = 0;
#define TR_DECODE(IT, SRC, DST, NN, KK, N0, PERM) do { int i_ = (IT); const float* W_; unsigned char* Wt_; \
        if (i_ < n_gu) { W_ = p.w_gu; Wt_ = p.WguT; NN = 2048; KK = D; PERM = 1; } else { i_ -= n_gu; W_ = p.w_down; Wt_ = p.WdnT; NN = D; KK = FF; PERM = 0; } \
        const int ntn_ = NN / 128, per_ = ntn_ * (KK / 128), m_ = i_ / per_, r_ = i_ % per_, tn_ = r_ % ntn_, tk_ = r_ / ntn_; \
        N0 = tn_ * 128; SRC = W_ + (size_t)m_ * KK * NN + (size_t)(tk_ * 128) * NN + N0; DST = Wt_ + (size_t)m_ * KK * NN + tk_ * 128; } while (0)
        float4 rh[8];
        const float* src2 = nullptr; unsigned char* dst2 = nullptr; int N2 = 0, K2 = 0, n02 = 0, perm2 = 0;
        int it = blockIdx.x;
        if (it < total) {
            TR_DECODE(it, src, dst, N, K, n0, perm);
#pragma unroll
            for (int i = 0; i < 8; ++i) rg[i] = *(const float4*)(src + (size_t)(kr + 16 * i) * N + n4 * 4);
        }
        if (it + (int)gridDim.x < total) {
            TR_DECODE(it + (int)gridDim.x, src2, dst2, N2, K2, n02, perm2);
#pragma unroll
            for (int i = 0; i < 8; ++i) rh[i] = *(const float4*)(src2 + (size_t)(kr + 16 * i) * N2 + n4 * 4);
        }
#define TR_EMIT(RG, DSTP, NN, KK, N0, PERM) do { \
            __syncthreads(); \
            _Pragma("unroll") for (int i = 0; i < 8; ++i) { float* q = fl + (kr + 16 * i) * 129 + n4 * 4; q[0] = RG[i].x; q[1] = RG[i].y; q[2] = RG[i].z; q[3] = RG[i].w; } \
            __syncthreads(); } while (0)
#define TR_STORE(DSTP, NN, KK, N0, PERM) do { \
            _Pragma("unroll") for (int j = 0; j < 2; ++j) { \
                const int n = nl + 64 * j; const float* q = fl + (16 * kg) * 129 + n; u32x4 w; \
                _Pragma("unroll") for (int d = 0; d < 4; ++d) { \
                    unsigned r = __builtin_amdgcn_cvt_pk_fp8_f32(q[(4 * d) * 129] * 64.f, q[(4 * d + 1) * 129] * 64.f, 0u, false); \
                    w[d] = __builtin_amdgcn_cvt_pk_fp8_f32(q[(4 * d + 2) * 129] * 64.f, q[(4 * d + 3) * 129] * 64.f, r, true); } \
                const int ng = (N0) + n; \
                const int np = (PERM) ? ((ng & ((NN) / 2 - 1)) >> 7) * 256 + (ng >= (NN) / 2 ? 128 : 0) + (ng & 127) : ng;     \
                *(u32x4*)((DSTP) + (size_t)np * (KK) + 16 * kg) = w; } } while (0)
        for (; it < total; it += 2 * (int)gridDim.x) {
            TR_EMIT(rg, dst, N, K, n0, perm);
            unsigned char* dcur = dst; const int Nc = N, Kc = K, n0c = n0, pc = perm;
            if (it + 2 * (int)gridDim.x < total) {
                TR_DECODE(it + 2 * (int)gridDim.x, src, dst, N, K, n0, perm);
#pragma unroll
                for (int i = 0; i < 8; ++i) rg[i] = *(const float4*)(src + (size_t)(kr + 16 * i) * N + n4 * 4);
            }
            TR_STORE(dcur, Nc, Kc, n0c, pc);
            if (it + (int)gridDim.x < total) {
                TR_EMIT(rh, dst2, N2, K2, n02, perm2);
                unsigned char* dcur2 = dst2; const int Nd = N2, Kd = K2, n0d = n02, pd = perm2;
                if (it + 3 * (int)gridDim.x < total) {
                    TR_DECODE(it + 3 * (int)gridDim.x, src2, dst2, N2, K2, n02, perm2);
#pragma unroll
                    for (int i = 0; i < 8; ++i) rh[i] = *(const float4*)(src2 + (size_t)(kr + 16 * i) * N2 + n4 * 4);
                }
                TR_STORE(dcur2, Nd, Kd, n0d, pd);
            }
        }
#undef TR_EMIT
#undef TR_STORE
#undef TR_DECODE
    }
}

__device__ __forceinline__ void ph_norm1(const P& p, int l) {
    const int wave = ltid() >> 6, lane = ltid() & 63;
    for (int row = blockIdx.x * 8 + wave; row < R; row += gridDim.x * 8) {
        const float* xr = row < T ? p.x + (size_t)row * D : p.ctx + (size_t)(row - T) * D;
        float4 v[4]; float ss = 0;
#pragma unroll
        for (int i = 0; i < 4; ++i) { v[i] = *(const float4*)(xr + lane * 4 + 256 * i); ss += v[i].x * v[i].x + v[i].y * v[i].y + v[i].z * v[i].z + v[i].w * v[i].w; }
        ss = wave_sum(ss);
        const float rstd = rsqrtf(ss * (1.f / D) + EPS);
        const float* m = p.mod + ((size_t)l * 5 + mod_row(row)) * 6144;
        const float* g = p.g_mix + l * D;
#pragma unroll
        for (int i = 0; i < 4; ++i) {
            const int k = lane * 4 + 256 * i;
            const float4 gg = *(const float4*)(g + k), sh = *(const float4*)(m + k), sc = *(const float4*)(m + 1024 + k);
            uint2 o;
            o.x = cvtpk(v[i].x * rstd * gg.x * (1.f + sc.x) + sh.x, v[i].y * rstd * gg.y * (1.f + sc.y) + sh.y);
            o.y = cvtpk(v[i].z * rstd * gg.z * (1.f + sc.z) + sh.z, v[i].w * rstd * gg.w * (1.f + sc.w) + sh.w);
            *(uint2*)(p.H + (size_t)row * D + k) = o;
        }
    }
}

constexpr float QSCALE = 0.17677669529663687f * 1.4426950408889634f;
__device__ __forceinline__ void dsoftmax(const f32x16& s, float& m, float& l, f32x16& o0, f32x16& o1, bf16x8& pa, bf16x8& pb) {
    float mx = fmaxf(fmaxf(fmaxf(s[0], s[1]), fmaxf(s[2], s[3])), fmaxf(fmaxf(s[4], s[5]), fmaxf(s[6], s[7])));
    mx = fmaxf(mx, fmaxf(fmaxf(fmaxf(s[8], s[9]), fmaxf(s[10], s[11])), fmaxf(fmaxf(s[12], s[13]), fmaxf(s[14], s[15]))));
    mx = xhalf_max(mx);
    if (__any(mx > m)) {
        const float mn = fmaxf(m, mx), alpha = __builtin_amdgcn_exp2f(m - mn);
        o0 *= alpha; o1 *= alpha; l *= alpha; m = mn;
    }
    float pr[16]; float sum = 0.f;
#pragma unroll
    for (int r = 0; r < 16; ++r) { pr[r] = __builtin_amdgcn_exp2f(s[r] - m); sum += pr[r]; }
    l += sum;
    u32x4 a, b;
    a[0] = cvtpk(pr[0], pr[1]); a[1] = cvtpk(pr[2], pr[3]); a[2] = cvtpk(pr[4], pr[5]); a[3] = cvtpk(pr[6], pr[7]);
    b[0] = cvtpk(pr[8], pr[9]); b[1] = cvtpk(pr[10], pr[11]); b[2] = cvtpk(pr[12], pr[13]); b[3] = cvtpk(pr[14], pr[15]);
    pa = __builtin_bit_cast(bf16x8, a); pb = __builtin_bit_cast(bf16x8, b);
}
#define MX3(a, b, c) __builtin_fmaxf(__builtin_fmaxf((a), (b)), (c))
template <int THR>
__device__ __forceinline__ void dsoftmax2(f32x16& s, float& m, float& l, f32x16& o0, f32x16& o1, bf16x8& pa, bf16x8& pb, const bool first) {
    float a = MX3(s[0], s[1], s[2]), b = MX3(s[3], s[4], s[5]);
    a = MX3(a, s[6], s[7]); b = MX3(b, s[8], s[9]); a = MX3(a, s[10], s[11]); b = MX3(b, s[12], s[13]); a = MX3(a, s[14], s[15]);
    const float mx = xhalf_max(__builtin_fmaxf(a, b));
    if (first || __any(mx > m + (float)THR)) {
        const float mn = first ? mx : __builtin_fmaxf(mx, m), alpha = first ? 1.f : __builtin_amdgcn_exp2f(m - mn);
        m = mn; o0 *= alpha; o1 *= alpha; l *= alpha;
    }
    float sum = 0.f;
#pragma unroll
    for (int r = 0; r < 16; ++r) { s[r] = __builtin_amdgcn_exp2f(s[r] - m); sum += s[r]; }
    l += sum;
    u32x4 wa, wb;
    wa[0] = cvtpk(s[0], s[1]); wa[1] = cvtpk(s[2], s[3]); wa[2] = cvtpk(s[4], s[5]); wa[3] = cvtpk(s[6], s[7]);
    wb[0] = cvtpk(s[8], s[9]); wb[1] = cvtpk(s[10], s[11]); wb[2] = cvtpk(s[12], s[13]); wb[3] = cvtpk(s[14], s[15]);
    pa = __builtin_bit_cast(bf16x8, wa); pb = __builtin_bit_cast(bf16x8, wb);
}
__device__ __forceinline__ void ph_dattn(const P& p, int l, int nrows, char* lds) {
    const int tid = ltid(), lane = tid & 63, wid = tid >> 6, r32 = lane & 31, hi = lane >> 5;
    float la = lane < 32 ? p.lam_q1[l * 32 + lane] * p.lam_k1[l * 32 + lane] : 0.f;
    float lb = lane < 32 ? p.lam_q2[l * 32 + lane] * p.lam_k2[l * 32 + lane] : 0.f;
    la = wave_sum(la); lb = wave_sum(lb);
    const float lam_init = 0.8f - 0.6f * expf(-0.3f * (float)l);
    const float lam = expf(la) - expf(lb) + lam_init;
    const bf16_t* PR = p.PROJ;
    const int nunits = (nrows == R) ? 256 + 16 : 256;
    const int skey = 8 * wid + (lane & 7), schunk = lane >> 3;
    const int ldsK = schunk * 1024 + skey * 16;
    const int ldsV = 8192 + (schunk >> 2) * 4096 + (skey >> 3) * 512 + (skey & 7) * 64 + (schunk & 3) * 16;
    const int vb = ((lane >> 4) & 1) * 32 + (lane & 3) * 8 + (4 * hi + ((lane & 15) >> 2)) * 64;
    for (int uu = blockIdx.x; uu < nunits; uu += gridDim.x) {
        int b, h, q0, nt; bool isctx;
        if (uu < 256) { const int u = (uu & 7) * 32 + (uu >> 3); b = u >> 6; h = (u >> 4) & 3; q0 = b * 4096 + (u & 15) * 256; nt = 68; isctx = false; }
        else { const int v = uu - 256; b = v >> 2; h = v & 3; q0 = T + b * 256; nt = 4; isctx = true; }
        bf16x8 qf[4];
        {
            const bf16_t* qp = PR + (size_t)(q0 + wid * 32 + r32) * PW + h * 64 + hi * 8;
#pragma unroll
            for (int ks = 0; ks < 4; ++ks) qf[ks] = *(const bf16x8*)(qp + ks * 16);
        }
        f32x16 O00, O01, O10, O11, zero16;
#pragma unroll
        for (int r = 0; r < 16; ++r) { O00[r] = 0.f; O01[r] = 0.f; O10[r] = 0.f; O11[r] = 0.f; zero16[r] = 0.f; }
        float m1 = 0.f, m2 = 0.f, l1 = 0.f, l2 = 0.f;
        const size_t gK = 256 + h * 64 + schunk * 8, gV = 512 + h * 64 + schunk * 8;
        uint4 rk, rv;
        {
            const int kr = (isctx ? T + b * 256 : b * 4096) + skey;
            rk = *(const uint4*)(PR + (size_t)kr * PW + gK); rv = *(const uint4*)(PR + (size_t)kr * PW + gV);
        }
        __syncthreads();
        *(uint4*)(lds + ldsK) = rk; *(uint4*)(lds + ldsV) = rv;
        __syncthreads();
#pragma unroll 1
        for (int t = 0; t < nt; ++t) {
            char* buf = lds + (t & 1) * 16384;
            if (t + 1 < nt) {
                const int tn = t + 1;
                const int kr = ((isctx || tn >= 64) ? T + b * 256 + (isctx ? tn : tn - 64) * 64 : b * 4096 + tn * 64) + skey;
                rk = *(const uint4*)(PR + (size_t)kr * PW + gK); rv = *(const uint4*)(PR + (size_t)kr * PW + gV);
            }
            {
                typedef const __attribute__((address_space(3))) bf16x8* kfp_t;
                const lds_cptr kp = (lds_cptr)buf + hi * 1024 + r32 * 16;
                const lds_cptr vp = (lds_cptr)buf + 8192 + vb;
                bf16x8 kf0 = *(kfp_t)(kp), kf1 = *(kfp_t)(kp + 2048), kf2 = *(kfp_t)(kp + 4096), kf3 = *(kfp_t)(kp + 6144);
#pragma unroll
                for (int kb = 0; kb < 2; ++kb) {
                    f32x16 s1 = __builtin_amdgcn_mfma_f32_32x32x16_bf16(kf0, qf[0], zero16, 0, 0, 0);
                    f32x16 s2 = __builtin_amdgcn_mfma_f32_32x32x16_bf16(kf2, qf[2], zero16, 0, 0, 0);
                    s1 = __builtin_amdgcn_mfma_f32_32x32x16_bf16(kf1, qf[1], s1, 0, 0, 0);
                    s2 = __builtin_amdgcn_mfma_f32_32x32x16_bf16(kf3, qf[3], s2, 0, 0, 0);
                    s16x4 vlo[4], vhi[4];
#pragma unroll
                    for (int i = 0; i < 4; ++i) { vlo[i] = vtr(vp + kb * 2048 + (i >> 1) * 4096 + (i & 1) * 1024); vhi[i] = vtr(vp + kb * 2048 + (i >> 1) * 4096 + (i & 1) * 1024 + 512); }
                    if (kb == 0) { kf0 = *(kfp_t)(kp + 512); kf1 = *(kfp_t)(kp + 512 + 2048); kf2 = *(kfp_t)(kp + 512 + 4096); kf3 = *(kfp_t)(kp + 512 + 6144); }
                    __builtin_amdgcn_sched_barrier(0);
                    const bool first = (t == 0) && (kb == 0);
                    bf16x8 p1a, p1b, p2a, p2b;
                    dsoftmax2<8>(s1, m1, l1, O00, O01, p1a, p1b, first);
                    dsoftmax2<8>(s2, m2, l2, O10, O11, p2a, p2b, first);
#pragma unroll
                    for (int i = 0; i < 4; ++i) {
                        const bf16x8 va = (bf16x8){vlo[i][0], vlo[i][1], vlo[i][2], vlo[i][3], vhi[i][0], vhi[i][1], vhi[i][2], vhi[i][3]};
                        if (i < 2) { O00 = __builtin_amdgcn_mfma_f32_32x32x16_bf16(va, (i & 1) ? p1b : p1a, O00, 0, 0, 0); O10 = __builtin_amdgcn_mfma_f32_32x32x16_bf16(va, (i & 1) ? p2b : p2a, O10, 0, 0, 0); }
                        else       { O01 = __builtin_amdgcn_mfma_f32_32x32x16_bf16(va, (i & 1) ? p1b : p1a, O01, 0, 0, 0); O11 = __builtin_amdgcn_mfma_f32_32x32x16_bf16(va, (i & 1) ? p2b : p2a, O11, 0, 0, 0); }
                    }
                }
            }
            if (t + 1 < nt) { char* nb = lds + ((t + 1) & 1) * 16384; *(uint4*)(nb + ldsK) = rk; *(uint4*)(nb + ldsV) = rv; }
            __syncthreads();
        }
        l1 = xhalf_sum(l1); l2 = xhalf_sum(l2);
        const float i1 = 1.f / l1, i2 = lam / l2;
        float ss = 0.f;
#pragma unroll
        for (int r = 0; r < 16; ++r) { O00[r] = O00[r] * i1 - O10[r] * i2; O01[r] = O01[r] * i1 - O11[r] * i2; ss += O00[r] * O00[r] + O01[r] * O01[r]; }
        ss = xhalf_sum(ss);
        const float rstd = rsqrtf(ss * (1.f / 64.f) + EPS) * (1.f - lam_init);
        const float* gs = p.g_sub + l * 64;
        bf16_t* op = p.MIX + (size_t)(q0 + wid * 32 + r32) * D + h * 64;
#pragma unroll
        for (int g4 = 0; g4 < 4; ++g4) {
            const int d = 8 * g4 + 4 * hi;
            const float4 ga = *(const float4*)(gs + d), gb = *(const float4*)(gs + 32 + d);
            uint2 wa, wb;
            wa.x = cvtpk(O00[4 * g4] * rstd * ga.x, O00[4 * g4 + 1] * rstd * ga.y); wa.y = cvtpk(O00[4 * g4 + 2] * rstd * ga.z, O00[4 * g4 + 3] * rstd * ga.w);
            wb.x = cvtpk(O01[4 * g4] * rstd * gb.x, O01[4 * g4 + 1] * rstd * gb.y); wb.y = cvtpk(O01[4 * g4 + 2] * rstd * gb.z, O01[4 * g4 + 3] * rstd * gb.w);
            *(uint2*)(op + d) = wa; *(uint2*)(op + 32 + d) = wb;
        }
    }
}

__device__ __forceinline__ void ph_na(const P& p, int l, int nrows, char* lds) {
    const int tid = ltid(), lane = tid & 63, wid = tid >> 6, r32 = lane & 31, hi = lane >> 5;
    const bf16_t* PR = p.PROJ;
    const int nunits = (nrows == R) ? 256 + 16 : 256;
    const int skey = 8 * wid + (lane & 7), schunk = lane >> 3;
    const int ldsK = schunk * 1024 + skey * 16;
    const int ldsV = 8192 + (schunk >> 2) * 4096 + (skey >> 3) * 512 + (skey & 7) * 64 + (schunk & 3) * 16;
    const int vb = ((lane >> 4) & 1) * 32 + (lane & 3) * 8 + (4 * hi + ((lane & 15) >> 2)) * 64;
    float* btab = (float*)(lds + 32768);
    constexpr float LOG2E = 1.4426950408889634f;
    for (int uu = (blockIdx.x + gridDim.x - 16) % gridDim.x; uu < nunits; uu += gridDim.x) {
        int b, h, q0, kr_lo, nlat, rs = 0, rq = 0; bool isctx;
        if (uu < 256) {
            const int u = (uu & 7) * 32 + (uu >> 3); b = u >> 6; h = (u >> 4) & 3; const int rg = u & 15;
            rq = 4 * rg + (wid >> 1); q0 = b * 4096 + rq * 64 + (wid & 1) * 32;
            kr_lo = min(max(4 * rg - 4, 0), 56); const int kr_hi = min(max(4 * rg - 1, 0), 56) + 7; nlat = kr_hi - kr_lo + 1;
            rs = min(max(rq - 4, 0), 56); isctx = false;
        } else { const int v = uu - 256; b = v >> 2; h = v & 3; q0 = T + b * 256 + wid * 32; kr_lo = 0; nlat = 0; isctx = true; }
        const int nt = nlat + 4;
        const int cq = (wid & 1) * 32 + r32, wsc = min(max(cq - 8, 0), 48);
        bf16x8 qf[4];
        {
            const bf16_t* qp = PR + (size_t)(q0 + r32) * PW + 1536 + h * 64 + hi * 8;
#pragma unroll
            for (int ks = 0; ks < 4; ++ks) qf[ks] = *(const bf16x8*)(qp + ks * 16);
        }
        f32x16 O0, O1;
#pragma unroll
        for (int r = 0; r < 16; ++r) { O0[r] = 0.f; O1[r] = 0.f; }
        float m1 = -1e30f, l1 = 0.f;
        const size_t gK = 1792 + h * 64 + schunk * 8, gV = 2048 + h * 64 + schunk * 8;
        uint4 rk, rv;
        {
            const int kr = (nlat ? b * 4096 + kr_lo * 64 : T + b * 256) + skey;
            rk = *(const uint4*)(PR + (size_t)kr * PW + gK); rv = *(const uint4*)(PR + (size_t)kr * PW + gV);
        }
        __syncthreads();
        *(uint4*)(lds + ldsK) = rk; *(uint4*)(lds + ldsV) = rv;
        if (tid < 465) btab[tid] = p.rpb[((size_t)l * 4 + h) * 465 + tid] * LOG2E;
        __syncthreads();
        for (int t = 0; t < nt; ++t) {
            char* buf = lds + (t & 1) * 16384;
            if (t + 1 < nt) {
                const int tn = t + 1;
                const int kr = (tn < nlat ? b * 4096 + (kr_lo + tn) * 64 : T + b * 256 + (tn - nlat) * 64) + skey;
                rk = *(const uint4*)(PR + (size_t)kr * PW + gK); rv = *(const uint4*)(PR + (size_t)kr * PW + gV);
            }
            const bool lat = t < nlat;
            const int krow = kr_lo + t;
            const bool active = !lat || (krow >= rs && krow <= rs + 7);
            if (active) {
                const float* brow = btab + (krow - rq + 7) * 31 + 15 - cq;
#pragma unroll
                for (int kb = 0; kb < 2; ++kb) {
                    const lds_cptr kp = (lds_cptr)buf + hi * 1024 + (kb * 32 + r32) * 16;
                    f32x16 s1;
#pragma unroll
                    for (int r = 0; r < 16; ++r) s1[r] = 0.f;
#pragma unroll
                    for (int ks = 0; ks < 4; ++ks) {
                        const bf16x8 kf = *(const __attribute__((address_space(3))) bf16x8*)(kp + ks * 2048);
                        s1 = __builtin_amdgcn_mfma_f32_32x32x16_bf16(kf, qf[ks], s1, 0, 0, 0);
                    }
                    if (lat) {
#pragma unroll
                        for (int r = 0; r < 16; ++r) {
                            const int kc = 32 * kb + (r & 3) + 8 * (r >> 2) + 4 * hi;
                            const bool ok = (unsigned)(kc - wsc) < 16u;
                            const float bv = brow[ok ? kc : cq];
                            s1[r] = ok ? s1[r] + bv : -INFINITY;
                        }
                    }
                    bf16x8 pa, pb;
                    dsoftmax2<8>(s1, m1, l1, O0, O1, pa, pb, false);
                    const lds_cptr vp = (lds_cptr)buf + 8192 + vb + kb * 2048;
#pragma unroll
                    for (int ss = 0; ss < 2; ++ss) {
                        const s16x4 lo0 = vtr(vp + ss * 1024), hh0 = vtr(vp + ss * 1024 + 512);
                        const s16x4 lo1 = vtr(vp + 4096 + ss * 1024), hh1 = vtr(vp + 4096 + ss * 1024 + 512);
                        const bf16x8 va0 = (bf16x8){lo0[0], lo0[1], lo0[2], lo0[3], hh0[0], hh0[1], hh0[2], hh0[3]};
                        const bf16x8 va1 = (bf16x8){lo1[0], lo1[1], lo1[2], lo1[3], hh1[0], hh1[1], hh1[2], hh1[3]};
                        O0 = __builtin_amdgcn_mfma_f32_32x32x16_bf16(va0, ss ? pb : pa, O0, 0, 0, 0);
                        O1 = __builtin_amdgcn_mfma_f32_32x32x16_bf16(va1, ss ? pb : pa, O1, 0, 0, 0);
                    }
                }
            }
            if (t + 1 < nt) { char* nb = lds + ((t + 1) & 1) * 16384; *(uint4*)(nb + ldsK) = rk; *(uint4*)(nb + ldsV) = rv; }
            __syncthreads();
        }
        l1 = xhalf_sum(l1);
        const float il = 1.f / l1;
        bf16_t* op = p.MIX + (size_t)(q0 + r32) * D + 768 + h * 64;
#pragma unroll
        for (int g4 = 0; g4 < 4; ++g4) {
            const int d = 8 * g4 + 4 * hi;
            uint2 wa, wb;
            wa.x = cvtpk(O0[4 * g4] * il, O0[4 * g4 + 1] * il); wa.y = cvtpk(O0[4 * g4 + 2] * il, O0[4 * g4 + 3] * il);
            wb.x = cvtpk(O1[4 * g4] * il, O1[4 * g4 + 1] * il); wb.y = cvtpk(O1[4 * g4 + 2] * il, O1[4 * g4 + 3] * il);
            *(uint2*)(op + d) = wa; *(uint2*)(op + 32 + d) = wb;
        }
    }
}

__device__ __forceinline__ void ph_pool(const P& p, int l, int nrows, char* lds) {
    const int tid = ltid(), lane = tid & 63, wid = tid >> 6, fr = lane & 15, fq = lane >> 4;
    float* ysh = (float*)lds;
    bf16_t* dsh = (bf16_t*)(lds + 80 * 256 * 4);
    const bf16_t* PR = p.PROJ;
    for (int it = (blockIdx.x + gridDim.x - 32) % gridDim.x; it < nrows / 64; it += gridDim.x) {
        const int row0 = it * 64;
        const int L = row0 < T ? 4096 : 256;
        const int t0 = row0 < T ? (row0 & 4095) : ((row0 - T) & 255);
        const int base = row0 - t0;
        __syncthreads();
        for (int c = tid; c < 80 * 32; c += NT) {
            const int rr = c >> 5, ch = (c & 31) * 8, t = t0 - 8 + rr;
            float4 a = make_float4(0.f, 0.f, 0.f, 0.f), b = a;
            if (t >= 0 && t < L) {
                const uint4 raw = *(const uint4*)(PR + (size_t)(base + t) * PW + 768 + ch);
                a = make_float4(__uint_as_float(raw.x << 16), __uint_as_float(raw.x & 0xffff0000u), __uint_as_float(raw.y << 16), __uint_as_float(raw.y & 0xffff0000u));
                b = make_float4(__uint_as_float(raw.z << 16), __uint_as_float(raw.z & 0xffff0000u), __uint_as_float(raw.w << 16), __uint_as_float(raw.w & 0xffff0000u));
            }
            *(float4*)(ysh + rr * 256 + ch) = a; *(float4*)(ysh + rr * 256 + ch + 4) = b;
        }
        __syncthreads();
        {
            const int r = tid >> 3, cg = tid & 7;
            const int g = cg >> 1, w = 2 << g, t = t0 + r;
            const int lo = max(t - w / 2, 0), hi = min(t + w / 2 - 1, L - 1);
            const float inv = 1.f / (float)(hi - lo + 1);
#pragma unroll
            for (int q = 0; q < 8; ++q) {
                const int ch = cg * 32 + q * 4;
                float4 s = make_float4(0.f, 0.f, 0.f, 0.f);
                for (int tt = lo; tt <= hi; ++tt) { const float4 v = *(const float4*)(ysh + (tt - t0 + 8) * 256 + ch); s.x += v.x; s.y += v.y; s.z += v.z; s.w += v.w; }
                const float4 y = *(const float4*)(ysh + (r + 8) * 256 + ch);
                uint2 o; o.x = cvtpk(s.x * inv - y.x, s.y * inv - y.y); o.y = cvtpk(s.z * inv - y.z, s.w * inv - y.w);
                *(uint2*)(dsh + r * 264 + ch) = o;
            }
        }
        __syncthreads();
        {
            const int g = wid >> 1, mb = (wid & 1) * 2;
            const bf16_t* W = p.WpT + ((size_t)l * 4 + g) * 64 * 64;
            f32x4 acc[2][4];
#pragma unroll
            for (int mt = 0; mt < 2; ++mt)
#pragma unroll
                for (int nt = 0; nt < 4; ++nt) acc[mt][nt] = (f32x4){0.f, 0.f, 0.f, 0.f};
#pragma unroll
            for (int ks = 0; ks < 2; ++ks) {
                bf16x8 af[2], bfr[4];
#pragma unroll
                for (int mt = 0; mt < 2; ++mt) af[mt] = *(const bf16x8*)(dsh + ((mb + mt) * 16 + fr) * 264 + g * 64 + ks * 32 + fq * 8);
#pragma unroll
                for (int nt = 0; nt < 4; ++nt) bfr[nt] = *(const bf16x8*)(W + (nt * 16 + fr) * 64 + ks * 32 + fq * 8);
#pragma unroll
                for (int mt = 0; mt < 2; ++mt)
#pragma unroll
                    for (int nt = 0; nt < 4; ++nt) acc[mt][nt] = __builtin_amdgcn_mfma_f32_16x16x32_bf16(bfr[nt], af[mt], acc[mt][nt], 0, 0, 0);
            }
#pragma unroll
            for (int mt = 0; mt < 2; ++mt)
#pragma unroll
                for (int nt = 0; nt < 4; ++nt) {
                    const int row = row0 + (mb + mt) * 16 + fr, j = g * 64 + nt * 16 + fq * 4;
                    const float4 sp = *(const float4*)(p.s_pool + l * 256 + j);
                    uint2 o; o.x = cvtpk(acc[mt][nt][0] * sp.x, acc[mt][nt][1] * sp.y); o.y = cvtpk(acc[mt][nt][2] * sp.z, acc[mt][nt][3] * sp.w);
                    *(uint2*)(p.MIX + (size_t)row * D + 256 + j) = o;
                }
        }
    }
}

__device__ __forceinline__ float gelu_fast(float x) {
    const float u = 0.7978845608028654f * (x + 0.044715f * x * x * x);
    return x / (1.f + __builtin_amdgcn_exp2f(-2.885390081777927f * u));
}
__device__ __forceinline__ void ph_sgu(const P& p, int l, int nrows, char* lds) {
    const int tid = ltid(), lane = tid & 63, wid = tid >> 6, fr = lane & 15, fq = lane >> 4;
    bf16_t* vnT = (bf16_t*)lds;
    float* rstd = (float*)(lds + 128 * 136 * 2);
    const bf16_t* PR = p.PROJ;
    for (int it = (blockIdx.x + gridDim.x - 48) % gridDim.x; it < (nrows / 128) * 2; it += gridDim.x) {
        const int chunk = it >> 1, hp = it & 1, row0 = chunk * 128;
        __syncthreads();
        {
            const int t = tid >> 2, qtr = tid & 3;
            const bf16_t* zp = PR + (size_t)(row0 + t) * PW + 1280 + qtr * 64;
            float ss = 0.f;
#pragma unroll
            for (int i = 0; i < 8; ++i) {
                const uint4 raw = *(const uint4*)(zp + i * 8);
                const unsigned w4[4] = {raw.x, raw.y, raw.z, raw.w};
#pragma unroll
                for (int j = 0; j < 4; ++j) { const float a = __uint_as_float(w4[j] << 16), b = __uint_as_float(w4[j] & 0xffff0000u); ss += a * a + b * b; }
            }
            ss += __shfl_xor(ss, 1); ss += __shfl_xor(ss, 2);
            if (qtr == 0) rstd[t] = rsqrtf(ss * (1.f / 256.f) + EPS);
        }
        __syncthreads();
        {
            const int s = tid >> 2, cb = (tid & 3) * 32;
            const bf16_t* zp = PR + (size_t)(row0 + s) * PW + 1280 + hp * 128 + cb;
            const float rs = rstd[s];
            const float* gg = p.g_sgu + l * 256 + hp * 128 + cb;
#pragma unroll
            for (int i = 0; i < 4; ++i) {
                const uint4 raw = *(const uint4*)(zp + i * 8);
                const unsigned w4[4] = {raw.x, raw.y, raw.z, raw.w};
#pragma unroll
                for (int j = 0; j < 4; ++j) {
                    const int c = cb + i * 8 + j * 2;
                    vnT[c * 136 + s] = f2bf(__uint_as_float(w4[j] << 16) * rs * gg[i * 8 + j * 2]);
                    vnT[(c + 1) * 136 + s] = f2bf(__uint_as_float(w4[j] & 0xffff0000u) * rs * gg[i * 8 + j * 2 + 1]);
                }
            }
        }
        __syncthreads();
        {
            const int hl = wid >> 2, g = hp * 2 + hl, mb = (wid & 3) * 2;
            const bf16_t* Wg = p.WsB + ((size_t)l * 4 + g) * 128 * 128;
            f32x4 acc[2][4];
#pragma unroll
            for (int mt = 0; mt < 2; ++mt)
#pragma unroll
                for (int nt = 0; nt < 4; ++nt) acc[mt][nt] = (f32x4){0.f, 0.f, 0.f, 0.f};
#pragma unroll
            for (int ks = 0; ks < 4; ++ks) {
                bf16x8 af[2], bfr[4];
#pragma unroll
                for (int mt = 0; mt < 2; ++mt) af[mt] = *(const bf16x8*)(Wg + ((mb + mt) * 16 + fr) * 128 + ks * 32 + fq * 8);
#pragma unroll
                for (int nt = 0; nt < 4; ++nt) bfr[nt] = *(const bf16x8*)(vnT + (hl * 64 + nt * 16 + fr) * 136 + ks * 32 + fq * 8);
#pragma unroll
                for (int mt = 0; mt < 2; ++mt)
#pragma unroll
                    for (int nt = 0; nt < 4; ++nt) acc[mt][nt] = __builtin_amdgcn_mfma_f32_16x16x32_bf16(bfr[nt], af[mt], acc[mt][nt], 0, 0, 0);
            }
#pragma unroll
            for (int mt = 0; mt < 2; ++mt) {
                const int t = (mb + mt) * 16 + fr;
                const float bias = p.b_sgu[(l * 4 + g) * 128 + t];
#pragma unroll
                for (int nt = 0; nt < 4; ++nt) {
                    const int c = g * 64 + nt * 16 + fq * 4;
                    const uint2 ur = *(const uint2*)(PR + (size_t)(row0 + t) * PW + 1024 + c);
                    const float u0 = __uint_as_float(ur.x << 16), u1 = __uint_as_float(ur.x & 0xffff0000u);
                    const float u2 = __uint_as_float(ur.y << 16), u3 = __uint_as_float(ur.y & 0xffff0000u);
                    uint2 o; o.x = cvtpk(u0 * (acc[mt][nt][0] + bias), u1 * (acc[mt][nt][1] + bias)); o.y = cvtpk(u2 * (acc[mt][nt][2] + bias), u3 * (acc[mt][nt][3] + bias));
                    *(uint2*)(p.MIX + (size_t)(row0 + t) * D + 512 + c) = o;
                }
            }
        }
    }
}

__device__ __forceinline__ void ph_router(const P& p, int l, int nrows, char* lds) {
    const int tid = ltid(), wave = tid >> 6, lane = tid & 63;
    float* wl = (float*)lds;
    float* wsc = (float*)(lds + 1024 * 36 * 4) + wave * 64;
    int* lcnt = (int*)(lds + 1024 * 36 * 4 + 8 * 64 * 4);
    __syncthreads();
    {
        const float* wr = p.w_router + (size_t)l * D * NE;
        float4 t[16];
#pragma unroll
        for (int i = 0; i < 16; ++i) t[i] = *(const float4*)(wr + (size_t)(tid + NT * i) * 4);
#pragma unroll
        for (int i = 0; i < 16; ++i) { const int idx = (tid + NT * i) * 4, k = idx >> 5, e = idx & 31; *(float4*)(wl + ((k & 3) * 256 + (k >> 2)) * 36 + e) = t[i]; }
        if (tid < 32) lcnt[tid] = 0;
    }
    __syncthreads();
    const float* g = p.g_ffn + l * D;
    const float brt = p.b_router[l * NE + (lane & 31)];
    for (int pr = blockIdx.x * 8 + wave; pr < nrows / 2; pr += gridDim.x * 8) {
        const int ra = 2 * pr;
        const bf16_t* xa = p.X + (size_t)ra * D; const bf16_t* xb = xa + D;
        float ha[16], hb[16]; float sa = 0.f, sb = 0.f;
#pragma unroll
        for (int i = 0; i < 4; ++i) {
            const uint2 ua = *(const uint2*)(xa + 4 * (lane + 64 * i)), ub = *(const uint2*)(xb + 4 * (lane + 64 * i));
            const float4 va = make_float4(__uint_as_float(ua.x << 16), __uint_as_float(ua.x & 0xffff0000u), __uint_as_float(ua.y << 16), __uint_as_float(ua.y & 0xffff0000u));
            const float4 vb = make_float4(__uint_as_float(ub.x << 16), __uint_as_float(ub.x & 0xffff0000u), __uint_as_float(ub.y << 16), __uint_as_float(ub.y & 0xffff0000u));
            ha[4 * i] = va.x; ha[4 * i + 1] = va.y; ha[4 * i + 2] = va.z; ha[4 * i + 3] = va.w; hb[4 * i] = vb.x; hb[4 * i + 1] = vb.y; hb[4 * i + 2] = vb.z; hb[4 * i + 3] = vb.w;
            sa += va.x * va.x + va.y * va.y + va.z * va.z + va.w * va.w; sb += vb.x * vb.x + vb.y * vb.y + vb.z * vb.z + vb.w * vb.w;
        }
        sa = wave_sum(sa); sb = wave_sum(sb);
        const float rsa = rsqrtf(sa * (1.f / D) + EPS), rsb = rsqrtf(sb * (1.f / D) + EPS);
        const float* m = p.mod + ((size_t)l * 5 + mod_row(ra)) * 6144;
#pragma unroll
        for (int i = 0; i < 4; ++i) {
            const int k = 4 * (lane + 64 * i);
            const float4 gg = *(const float4*)(g + k), sc = *(const float4*)(m + 4 * 1024 + k), sh = *(const float4*)(m + 3 * 1024 + k);
            const float gs[4] = {gg.x * (1.f + sc.x), gg.y * (1.f + sc.y), gg.z * (1.f + sc.z), gg.w * (1.f + sc.w)}, s4[4] = {sh.x, sh.y, sh.z, sh.w};
#pragma unroll
            for (int j = 0; j < 4; ++j) { ha[4 * i + j] = ha[4 * i + j] * rsa * gs[j] + s4[j]; hb[4 * i + j] = hb[4 * i + j] * rsb * gs[j] + s4[j]; }
            uint2 oa, ob; oa.x = cvtpk(ha[4 * i], ha[4 * i + 1]); oa.y = cvtpk(ha[4 * i + 2], ha[4 * i + 3]); ob.x = cvtpk(hb[4 * i], hb[4 * i + 1]); ob.y = cvtpk(hb[4 * i + 2], hb[4 * i + 3]);
            *(uint2*)(p.H + (size_t)ra * D + k) = oa; *(uint2*)(p.H + (size_t)(ra + 1) * D + k) = ob;
        }
        float la[32], lb[32];
#pragma unroll
        for (int e = 0; e < 32; ++e) { la[e] = 0.f; lb[e] = 0.f; }
#pragma unroll
        for (int i = 0; i < 4; ++i)
#pragma unroll
            for (int j = 0; j < 4; ++j) {
                const float* wk = wl + (j * 256 + lane + 64 * i) * 36;
                const float xv = ha[4 * i + j], yv = hb[4 * i + j];
#pragma unroll
                for (int e = 0; e < 32; e += 4) {
                    const float4 w = *(const float4*)(wk + e);
                    la[e] += xv * w.x; la[e + 1] += xv * w.y; la[e + 2] += xv * w.z; la[e + 3] += xv * w.w;
                    lb[e] += yv * w.x; lb[e + 1] += yv * w.y; lb[e + 2] += yv * w.z; lb[e + 3] += yv * w.w;
                }
            }
        float r32v[32];
        {
            const bool up = lane >= 32;
#pragma unroll
            for (int e = 0; e < 32; ++e) { const float keep = up ? lb[e] : la[e], send = up ? la[e] : lb[e]; r32v[e] = keep + __shfl_xor(send, 32); }
        }
        float r16[16], r8[8], r4[4], r2[2];
        { const bool up = (lane & 16) != 0;
#pragma unroll
          for (int e = 0; e < 16; ++e) { const float keep = up ? r32v[e + 16] : r32v[e], send = up ? r32v[e] : r32v[e + 16]; r16[e] = keep + __shfl_xor(send, 16); } }
        { const bool up = (lane & 8) != 0;
#pragma unroll
          for (int e = 0; e < 8; ++e) { const float keep = up ? r16[e + 8] : r16[e], send = up ? r16[e] : r16[e + 8]; r8[e] = keep + __shfl_xor(send, 8); } }
        { const bool up = (lane & 4) != 0;
#pragma unroll
          for (int e = 0; e < 4; ++e) { const float keep = up ? r8[e + 4] : r8[e], send = up ? r8[e] : r8[e + 4]; r4[e] = keep + __shfl_xor(send, 4); } }
        { const bool up = (lane & 2) != 0;
#pragma unroll
          for (int e = 0; e < 2; ++e) { const float keep = up ? r4[e + 2] : r4[e], send = up ? r4[e] : r4[e + 2]; r2[e] = keep + __shfl_xor(send, 2); } }
        float mine;
        { const bool up = (lane & 1) != 0; const float keep = up ? r2[1] : r2[0], send = up ? r2[0] : r2[1]; mine = keep + __shfl_xor(send, 1); }
        wsc[lane] = mine + brt;
        float lg[32];
        {
            const float* wp = wsc + (lane & 32);
#pragma unroll
            for (int e = 0; e < 32; e += 4) { const float4 v = *(const float4*)(wp + e); lg[e] = v.x; lg[e + 1] = v.y; lg[e + 2] = v.z; lg[e + 3] = v.w; }
        }
        unsigned taken = 0u; float tv[4]; int ti[4];
#pragma unroll
        for (int k = 0; k < 4; ++k) {
            float best = -3.0e38f; int bi = 0;
#pragma unroll
            for (int e = 0; e < 32; ++e) { const bool ok = !((taken >> e) & 1u) && (lg[e] > best); best = ok ? lg[e] : best; bi = ok ? e : bi; }
            taken |= 1u << bi; tv[k] = best; ti[k] = bi;
        }
        const float e1 = __expf(tv[1] - tv[0]), e2 = __expf(tv[2] - tv[0]), e3 = __expf(tv[3] - tv[0]);
        const float inv = 1.f / (1.f + e1 + e2 + e3);
        if ((lane & 31) == 0) {
            const int row = ra + (lane >> 5);
            *(int4*)(p.topi + (size_t)row * 4) = make_int4(ti[0], ti[1], ti[2], ti[3]);
            *(float4*)(p.topg + (size_t)row * 4) = make_float4(inv, e1 * inv, e2 * inv, e3 * inv);
            atomicAdd(&lcnt[ti[0]], 1); atomicAdd(&lcnt[ti[1]], 1); atomicAdd(&lcnt[ti[2]], 1); atomicAdd(&lcnt[ti[3]], 1);
        }
    }
    __syncthreads();
    if (tid < 32 && lcnt[tid]) atomicAdd(&p.cnt[l * 64 + tid], lcnt[tid]);
}
__device__ __forceinline__ void ph_assign(const P& p, int l, int nrows, char* lds) {
    int* lcnt = (int*)lds; int* lbase = lcnt + 32; int* pst = lbase + 32; int* slots = pst + 32;
    const int tid = ltid(), wave = tid >> 6, lane = tid & 63;
    int* cnt = p.cnt + l * 64; int* cursor = cnt + 32;
    int* meta = p.moe_meta + l * 512;
    __syncthreads();
    if (tid == 0) { int a = 0; for (int e = 0; e < 32; ++e) { pst[e] = a; a += (cnt[e] + 255) & ~255; } if (blockIdx.x == 0) meta[0] = a >> 8; }
    __syncthreads();
    if (blockIdx.x == 0 && tid < 320) { int e = 0; for (int k = 1; k < 32; ++k) if (tid * 256 >= pst[k]) e = k; meta[1 + tid] = e; }
    const int blk0 = (blockIdx.x + gridDim.x - 64) % gridDim.x;
    for (int it = blk0; it < nrows / 64; it += gridDim.x) {
        __syncthreads();
        if (tid < 32) lcnt[tid] = 0;
        __syncthreads();
        if (wave == 0) {
            const int row = it * 64 + lane;
            const int4 ti = *(const int4*)(p.topi + (size_t)row * 4);
            const int r0 = atomicAdd(&lcnt[ti.x], 1), r1 = atomicAdd(&lcnt[ti.y], 1), r2 = atomicAdd(&lcnt[ti.z], 1), r3 = atomicAdd(&lcnt[ti.w], 1);
            __builtin_amdgcn_s_waitcnt(0xc07f);
            if (lane < 32) lbase[lane] = pst[lane] + (lcnt[lane] ? atomicAdd(&cursor[lane], lcnt[lane]) : 0);
            __builtin_amdgcn_s_waitcnt(0xc07f);
            const int4 sl = make_int4(lbase[ti.x] + r0, lbase[ti.y] + r1, lbase[ti.z] + r2, lbase[ti.w] + r3);
            *(int4*)(p.tok_slot + (size_t)row * 4) = sl;
            *(int4*)(slots + lane * 4) = sl;
        }
        __syncthreads();
        {
            const bf16_t* __restrict__ Hs = p.H; unsigned char* __restrict__ HSd = p.HS;
#define AS_LD(rr, A, B) const uint4 A = *(const uint4*)(Hs + (size_t)(it * 64 + wave * 8 + (rr)) * D + lane * 8), B = *(const uint4*)(Hs + (size_t)(it * 64 + wave * 8 + (rr)) * D + lane * 8 + 512)
#define AS_CV(V) make_uint2(__builtin_amdgcn_cvt_pk_fp8_f32(__uint_as_float(V.y << 16), __uint_as_float(V.y & 0xffff0000u), __builtin_amdgcn_cvt_pk_fp8_f32(__uint_as_float(V.x << 16), __uint_as_float(V.x & 0xffff0000u), 0u, false), true), \
                            __builtin_amdgcn_cvt_pk_fp8_f32(__uint_as_float(V.w << 16), __uint_as_float(V.w & 0xffff0000u), __builtin_amdgcn_cvt_pk_fp8_f32(__uint_as_float(V.z << 16), __uint_as_float(V.z & 0xffff0000u), 0u, false), true))
#define AS_ST(rr, A, B) do { const int4 s4 = *(const int4*)(slots + (wave * 8 + (rr)) * 4); const uint2 fa = AS_CV(A), fb = AS_CV(B); \
            unsigned char* d0 = HSd + (size_t)s4.x * D + lane * 8; *(uint2*)d0 = fa; *(uint2*)(d0 + 512) = fb; \
            unsigned char* d1 = HSd + (size_t)s4.y * D + lane * 8; *(uint2*)d1 = fa; *(uint2*)(d1 + 512) = fb; \
            unsigned char* d2 = HSd + (size_t)s4.z * D + lane * 8; *(uint2*)d2 = fa; *(uint2*)(d2 + 512) = fb; \
            unsigned char* d3 = HSd + (size_t)s4.w * D + lane * 8; *(uint2*)d3 = fa; *(uint2*)(d3 + 512) = fb; } while (0)
            AS_LD(0, a0, b0); AS_LD(1, a1, b1); AS_LD(2, a2, b2); AS_LD(3, a3, b3); AS_LD(4, a4, b4); AS_LD(5, a5, b5); AS_LD(6, a6, b6); AS_LD(7, a7, b7);
            AS_ST(0, a0, b0); AS_ST(1, a1, b1); AS_ST(2, a2, b2); AS_ST(3, a3, b3); AS_ST(4, a4, b4); AS_ST(5, a5, b5); AS_ST(6, a6, b6); AS_ST(7, a7, b7);
#undef AS_CV
#undef AS_LD
#undef AS_ST
        }
    }
}

struct EpiProj {
    static constexpr bool PERM = true, AFTER_DRAIN = false;
    bf16_t* O; const float* rope;
    __device__ __forceinline__ void operator()(const f32x4 (&acc)[2][2][4][2], const pg8::Unit& u, int wr, int wc, int fr, int fq) const {
        const int row0 = u.pm * 256 + wr * 64 + fr, col0 = u.pn * 256 + wc * 32 + 8 * fq;
        const bool do_rope = (u.pn < 2) && (u.pm < T / 256), do_gelu = (u.pn == 4) || (u.pn == 5);
        const float sc = u.pn == 0 ? QSCALE : (u.pn == 6 ? 0.125f * 1.4426950408889634f : 1.f);
        const float sgn = (fq & 1) ? 1.f : -1.f;
#pragma unroll
        for (int ai = 0; ai < 2; ++ai)
#pragma unroll
            for (int m = 0; m < 4; ++m) {
                const int row = row0 + ai * 128 + m * 16;
                bf16_t* rowp = O + (size_t)row * PW + col0;
                f32x4 cs[4];
                if (do_rope) {
                    const int s = row & 4095, pos = (fq >> 1) ? (s & 63) : (s >> 6);
                    const f32x4* rp = (const f32x4*)(rope + pos * 16);
                    cs[0] = rp[0]; cs[1] = rp[1]; cs[2] = rp[2]; cs[3] = rp[3];
                }
#pragma unroll
                for (int bj = 0; bj < 2; ++bj) {
                    f32x4 v0 = acc[ai][bj][m][0], v1 = acc[ai][bj][m][1];
                    if (do_rope) {
                        f32x4 b0, b1;
#pragma unroll
                        for (int j = 0; j < 4; ++j) { b0[j] = __shfl_xor(v0[j], 16); b1[j] = __shfl_xor(v1[j], 16); }
                        v0[0] = v0[0] * cs[0][0] + sgn * b0[0] * cs[0][1]; v0[1] = v0[1] * cs[0][2] + sgn * b0[1] * cs[0][3];
                        v0[2] = v0[2] * cs[1][0] + sgn * b0[2] * cs[1][1]; v0[3] = v0[3] * cs[1][2] + sgn * b0[3] * cs[1][3];
                        v1[0] = v1[0] * cs[2][0] + sgn * b1[0] * cs[2][1]; v1[1] = v1[1] * cs[2][2] + sgn * b1[1] * cs[2][3];
                        v1[2] = v1[2] * cs[3][0] + sgn * b1[2] * cs[3][1]; v1[3] = v1[3] * cs[3][2] + sgn * b1[3] * cs[3][3];
                    }
                    if (do_gelu) {
#pragma unroll
                        for (int j = 0; j < 4; ++j) { v0[j] = gelu_fast(v0[j]); v1[j] = gelu_fast(v1[j]); }
                    }
                    v0 = v0 * sc; v1 = v1 * sc;
                    u32x4 w; w.x = cvtpk(v0[0], v0[1]); w.y = cvtpk(v0[2], v0[3]); w.z = cvtpk(v1[0], v1[1]); w.w = cvtpk(v1[2], v1[3]);
                    *(u32x4*)(rowp + bj * 128) = w;
                }
            }
    }
};
template <bool RES_F32>
struct EpiOut {
    static constexpr bool PERM = true, AFTER_DRAIN = false;
    bf16_t* X; const float* gate; const float* res_lat; const float* res_ctx;
    __device__ __forceinline__ void operator()(const f32x4 (&acc)[2][2][4][2], const pg8::Unit& u, int wr, int wc, int fr, int fq) const {
        const int row0 = u.pm * 256 + wr * 64 + fr, col0 = u.pn * 256 + wc * 32 + 8 * fq;
        const float* g = gate + (size_t)mod_row(u.pm * 256) * 6144 + col0;
        f32x4 gv[2][2];
#pragma unroll
        for (int bj = 0; bj < 2; ++bj)
#pragma unroll
            for (int n = 0; n < 2; ++n) gv[bj][n] = *(const f32x4*)(g + bj * 128 + n * 4);
#pragma unroll
        for (int ai = 0; ai < 2; ++ai)
#pragma unroll
            for (int m = 0; m < 4; ++m) { const size_t off = (size_t)(row0 + ai * 128 + m * 16) * D + col0;
#pragma unroll
                for (int bj = 0; bj < 2; ++bj) {
                    f32x4 r0, r1;
                    if (RES_F32) { const float* rp = (u.pm < T / 256 ? res_lat : res_ctx) + off + bj * 128; r0 = *(const f32x4*)rp; r1 = *(const f32x4*)(rp + 4); }
                    else { const u32x4 w = *(const u32x4*)(X + off + bj * 128);
                        r0 = (f32x4){__uint_as_float(w.x << 16), __uint_as_float(w.x & 0xffff0000u), __uint_as_float(w.y << 16), __uint_as_float(w.y & 0xffff0000u)};
                        r1 = (f32x4){__uint_as_float(w.z << 16), __uint_as_float(w.z & 0xffff0000u), __uint_as_float(w.w << 16), __uint_as_float(w.w & 0xffff0000u)}; }
                    const f32x4 v0 = r0 + gv[bj][0] * acc[ai][bj][m][0], v1 = r1 + gv[bj][1] * acc[ai][bj][m][1];
                    u32x4 o; o.x = cvtpk(v0[0], v0[1]); o.y = cvtpk(v0[2], v0[3]); o.z = cvtpk(v1[0], v1[1]); o.w = cvtpk(v1[2], v1[3]);
                    *(u32x4*)(X + off + bj * 128) = o; } }
    }
};
__device__ __forceinline__ float swiglu(float g, float u) {
    const float gt = fminf(g, 7.0f), up = fminf(fmaxf(u, -7.0f), 7.0f);
    return (up + 1.0f) * gt * __builtin_amdgcn_rcpf(1.0f + __builtin_amdgcn_exp2f(-1.702f * 1.4426950408889634f * gt));
}
struct EpiAct {
    static constexpr bool PERM = true, AFTER_DRAIN = false;
    unsigned char* ACT; const float* bgu;
    __device__ __forceinline__ void operator()(const f32x4 (&acc)[2][2][4][2], const pg8::Unit& u, int wr, int wc, int fr, int fq) const {
        const int row0 = u.pm * 256 + wr * 64 + fr, j0 = u.pn * 128 + wc * 32 + 8 * fq;
        const float* bp = bgu + (size_t)u.e * 2048 + j0;
        const f32x4 bg0 = *(const f32x4*)(bp), bg1 = *(const f32x4*)(bp + 4), bu0 = *(const f32x4*)(bp + 1024), bu1 = *(const f32x4*)(bp + 1028);
#pragma unroll
        for (int ai = 0; ai < 2; ++ai)
#pragma unroll
            for (int m = 0; m < 4; ++m) {
                const f32x4 g0 = acc[ai][0][m][0] + bg0, g1 = acc[ai][0][m][1] + bg1, u0 = acc[ai][1][m][0] + bu0, u1 = acc[ai][1][m][1] + bu1;
                uint2 w;
                w.x = __builtin_amdgcn_cvt_pk_fp8_f32(swiglu(g0[2], u0[2]), swiglu(g0[3], u0[3]), __builtin_amdgcn_cvt_pk_fp8_f32(swiglu(g0[0], u0[0]), swiglu(g0[1], u0[1]), 0u, false), true);
                w.y = __builtin_amdgcn_cvt_pk_fp8_f32(swiglu(g1[2], u1[2]), swiglu(g1[3], u1[3]), __builtin_amdgcn_cvt_pk_fp8_f32(swiglu(g1[0], u1[0]), swiglu(g1[1], u1[1]), 0u, false), true);
                *(uint2*)(ACT + (size_t)(row0 + ai * 128 + m * 16) * FF + j0) = w;
            }
    }
};
struct EpiYB {
    static constexpr bool PERM = true, AFTER_DRAIN = false;
    bf16_t* YB; const float* bdn;
    __device__ __forceinline__ void operator()(const f32x4 (&acc)[2][2][4][2], const pg8::Unit& u, int wr, int wc, int fr, int fq) const {
        const int row0 = u.pm * 256 + wr * 64 + fr, col0 = u.pn * 256 + wc * 32 + 8 * fq;
        const float* bp = bdn + (size_t)u.e * D + col0;
        f32x4 bv[2][2];
#pragma unroll
        for (int bj = 0; bj < 2; ++bj)
#pragma unroll
            for (int n = 0; n < 2; ++n) bv[bj][n] = *(const f32x4*)(bp + bj * 128 + n * 4);
#pragma unroll
        for (int ai = 0; ai < 2; ++ai)
#pragma unroll
            for (int m = 0; m < 4; ++m) { bf16_t* rowp = YB + (size_t)(row0 + ai * 128 + m * 16) * D + col0;
#pragma unroll
                for (int bj = 0; bj < 2; ++bj) { const f32x4 v0 = acc[ai][bj][m][0] + bv[bj][0], v1 = acc[ai][bj][m][1] + bv[bj][1];
                    u32x4 w; w.x = cvtpk(v0[0], v0[1]); w.y = cvtpk(v0[2], v0[3]); w.z = cvtpk(v1[0], v1[1]); w.w = cvtpk(v1[2], v1[3]);
                    *(u32x4*)(rowp + bj * 128) = w; } }
    }
};
struct MoeOrder {
    int nN, nunits, G, v; const int* tile_e;
    __device__ void init(int ntiles, int nN_, int G_, int c, const int* te) { nN = nN_; nunits = ntiles * nN_; G = G_; v = (G_ % 8 == 0) ? (c % 8) * (G_ / 8) + c / 8 : c; tile_e = te; }
    __device__ bool next(int i, pg8::Unit& u) const {
        const int L = i * G + v; if (L >= nunits) return false;
        u.pm = L / nN; u.pn = L % nN; u.e = tile_e[u.pm]; return true;
    }
    __device__ __forceinline__ const bf16_t* bt(const pg8::Gemm& g, const pg8::Unit& u) const { return g.Bt + (size_t)u.e * g.N * g.K; }
    __device__ __forceinline__ void a_ready(const pg8::Unit&) const {}
    __device__ __forceinline__ void done(const pg8::Unit&) const {}
};

__device__ __forceinline__ void ph_gemm_proj(const P& p, int l, char* lds) {
    pg8::Gemm g{p.H, p.WinT + (size_t)l * PW * D, R, PW, D}; pg8::StaticOrder S; S.init(R, PW, (int)gridDim.x, (int)blockIdx.x);
    EpiProj E{p.PROJ, p.rope};
    pg8::gemm_phase<EpiProj, pg8::StaticOrder, true, true>((PG8_LAS unsigned char*)lds, g, S, E);
}
__device__ __forceinline__ void ph_gemm_out(const P& p, int l, int nrows, char* lds) {
    pg8::Gemm g{p.MIX, p.WoutT + (size_t)l * D * D, T, D, D}; pg8::StaticOrder S; S.init(T, D, (int)gridDim.x, (int)blockIdx.x);
    if (l == 0) { EpiOut<true> E{p.X, p.mod + (size_t)l * 5 * 6144 + 2 * 1024, p.x, p.ctx - (size_t)T * D}; pg8::gemm_phase<EpiOut<true>, pg8::StaticOrder, true, true>((PG8_LAS unsigned char*)lds, g, S, E); }
    else { EpiOut<false> E{p.X, p.mod + (size_t)l * 5 * 6144 + 2 * 1024, nullptr, nullptr}; pg8::gemm_phase<EpiOut<false>, pg8::StaticOrder, true, true>((PG8_LAS unsigned char*)lds, g, S, E); }
    if (nrows > T) {
        const int tid = ltid(), lane = tid & 63, wid = tid >> 6, fr = lane & 15, fq = lane >> 4;
        const bf16_t* Wt = p.WoutT + (size_t)l * D * D;
        const float* gate = p.mod + ((size_t)l * 5 + 4) * 6144 + 2 * 1024;
        for (int it = blockIdx.x; it < (TC / 64) * (D / 64); it += gridDim.x) {
            const int m0 = T + (it >> 4) * 64 + (wid & 3) * 16, n0 = (it & 15) * 64 + (wid >> 2) * 32;
            const bf16_t* ap = p.MIX + (size_t)(m0 + fr) * D + fq * 8;
            const bf16_t* bp0 = Wt + (size_t)(n0 + fr) * D + fq * 8;
            const bf16_t* bp1 = bp0 + (size_t)16 * D;
            f32x4 acc0 = (f32x4){0.f, 0.f, 0.f, 0.f}, acc1 = acc0;
#pragma unroll 8
            for (int ks = 0; ks < D / 32; ++ks) {
                const bf16x8 af = *(const bf16x8*)(ap + ks * 32), b0 = *(const bf16x8*)(bp0 + ks * 32), b1 = *(const bf16x8*)(bp1 + ks * 32);
                acc0 = __builtin_amdgcn_mfma_f32_16x16x32_bf16(b0, af, acc0, 0, 0, 0);
                acc1 = __builtin_amdgcn_mfma_f32_16x16x32_bf16(b1, af, acc1, 0, 0, 0);
            }
            const int row = m0 + fr, c0 = n0 + fq * 4;
            const size_t off = (size_t)row * D + c0;
            const float* res = p.ctx - (size_t)T * D;
            const f32x4 v0 = *(const f32x4*)(res + off) + *(const f32x4*)(gate + c0) * acc0, v1 = *(const f32x4*)(res + off + 16) + *(const f32x4*)(gate + c0 + 16) * acc1;
            uint2 o0, o1; o0.x = cvtpk(v0[0], v0[1]); o0.y = cvtpk(v0[2], v0[3]); o1.x = cvtpk(v1[0], v1[1]); o1.y = cvtpk(v1[2], v1[3]);
            *(uint2*)(p.X + off) = o0; *(uint2*)(p.X + off + 16) = o1;
        }
    }
}
__device__ __forceinline__ void ph_moe1(const P& p, int l, char* lds) {
    const int* meta = p.moe_meta + l * 512;
    const int ntiles = meta[0];
    pg8::Gemm g{(const bf16_t*)p.HS, (const bf16_t*)(p.WguT + (size_t)l * NE * 2048 * D), ntiles * 256, 2048, D / 2}; MoeOrder S; S.init(ntiles, 8, (int)gridDim.x, (int)blockIdx.x, meta + 1);
    EpiAct E{p.ACT, p.b_gu + (size_t)l * NE * 2048};
    pg8::gemm_phase<EpiAct, MoeOrder, true, true, true>((PG8_LAS unsigned char*)lds, g, S, E);
}
__device__ __forceinline__ void ph_moe2(const P& p, int l, char* lds) {
    const int* meta = p.moe_meta + l * 512;
    const int ntiles = meta[0];
    pg8::Gemm g{(const bf16_t*)p.ACT, (const bf16_t*)(p.WdnT + (size_t)l * NE * D * FF), ntiles * 256, D, FF / 2}; MoeOrder S; S.init(ntiles, 4, (int)gridDim.x, (int)blockIdx.x, meta + 1);
    EpiYB E{p.YB, p.b_down + (size_t)l * NE * D};
    pg8::gemm_phase<EpiYB, MoeOrder, true, true, true>((PG8_LAS unsigned char*)lds, g, S, E);
}
struct CombRow { uint4 y0[2], y1[2], y2[2], y3[2], xw[2]; float4 g; };
__device__ __forceinline__ void comb_load(CombRow& c, const bf16_t* __restrict__ YB, const bf16_t* __restrict__ X, const int* __restrict__ tok_slot, const float* __restrict__ topg, int row, int lane) {
    const int4 sl = *(const int4*)(tok_slot + (size_t)row * 4);
    c.g = *(const float4*)(topg + (size_t)row * 4);
#pragma unroll
    for (int i = 0; i < 2; ++i) {
        const int k = lane * 8 + 512 * i;
        c.y0[i] = *(const uint4*)(YB + (size_t)sl.x * D + k); c.y1[i] = *(const uint4*)(YB + (size_t)sl.y * D + k);
        c.y2[i] = *(const uint4*)(YB + (size_t)sl.z * D + k); c.y3[i] = *(const uint4*)(YB + (size_t)sl.w * D + k);
        c.xw[i] = *(const uint4*)(X + (size_t)row * D + k);
    }
}
__device__ __forceinline__ void comb_finish(const P& p, const CombRow& c, int l, int row, int lane) {
    const float* m = p.mod + ((size_t)l * 5 + mod_row(row)) * 6144 + 5 * 1024;
    const float4 g = c.g;
    float xv[16]; float ss = 0.f;
#pragma unroll
    for (int i = 0; i < 2; ++i) {
        const int k = lane * 8 + 512 * i;
        const unsigned a0[4] = {c.y0[i].x, c.y0[i].y, c.y0[i].z, c.y0[i].w}, a1[4] = {c.y1[i].x, c.y1[i].y, c.y1[i].z, c.y1[i].w};
        const unsigned a2[4] = {c.y2[i].x, c.y2[i].y, c.y2[i].z, c.y2[i].w}, a3[4] = {c.y3[i].x, c.y3[i].y, c.y3[i].z, c.y3[i].w};
        const unsigned xq[4] = {c.xw[i].x, c.xw[i].y, c.xw[i].z, c.xw[i].w};
        const float4 gta = *(const float4*)(m + k), gtb = *(const float4*)(m + k + 4);
        const float gt[8] = {gta.x, gta.y, gta.z, gta.w, gtb.x, gtb.y, gtb.z, gtb.w};
#pragma unroll
        for (int q = 0; q < 4; ++q) {
            const float ylo = g.x * __uint_as_float(a0[q] << 16) + g.y * __uint_as_float(a1[q] << 16) + g.z * __uint_as_float(a2[q] << 16) + g.w * __uint_as_float(a3[q] << 16);
            const float yhi = g.x * __uint_as_float(a0[q] & 0xffff0000u) + g.y * __uint_as_float(a1[q] & 0xffff0000u) + g.z * __uint_as_float(a2[q] & 0xffff0000u) + g.w * __uint_as_float(a3[q] & 0xffff0000u);
            const float v0 = __uint_as_float(xq[q] << 16) + gt[2 * q] * ylo, v1 = __uint_as_float(xq[q] & 0xffff0000u) + gt[2 * q + 1] * yhi;
            xv[8 * i + 2 * q] = v0; xv[8 * i + 2 * q + 1] = v1; ss += v0 * v0 + v1 * v1;
        }
    }
    ss = wave_sum(ss);
    const float rstd = rsqrtf(ss * (1.f / D) + EPS);
    if (l == 0) {
        const float* m1 = p.mod + ((size_t)5 + mod_row(row)) * 6144;
        const float* g1 = p.g_mix + D;
#pragma unroll
        for (int i = 0; i < 2; ++i) {
            const int k = lane * 8 + 512 * i;
            { u32x4 xo; xo.x = cvtpk(xv[8 * i], xv[8 * i + 1]); xo.y = cvtpk(xv[8 * i + 2], xv[8 * i + 3]); xo.z = cvtpk(xv[8 * i + 4], xv[8 * i + 5]); xo.w = cvtpk(xv[8 * i + 6], xv[8 * i + 7]); *(u32x4*)(p.X + (size_t)row * D + k) = xo; }
            const float4 ga = *(const float4*)(g1 + k), gb = *(const float4*)(g1 + k + 4);
            const float4 sha = *(const float4*)(m1 + k), shb = *(const float4*)(m1 + k + 4);
            const float4 sca = *(const float4*)(m1 + 1024 + k), scb = *(const float4*)(m1 + 1024 + k + 4);
            u32x4 o;
            o.x = cvtpk(xv[8 * i] * rstd * ga.x * (1.f + sca.x) + sha.x, xv[8 * i + 1] * rstd * ga.y * (1.f + sca.y) + sha.y);
            o.y = cvtpk(xv[8 * i + 2] * rstd * ga.z * (1.f + sca.z) + sha.z, xv[8 * i + 3] * rstd * ga.w * (1.f + sca.w) + sha.w);
            o.z = cvtpk(xv[8 * i + 4] * rstd * gb.x * (1.f + scb.x) + shb.x, xv[8 * i + 5] * rstd * gb.y * (1.f + scb.y) + shb.y);
            o.w = cvtpk(xv[8 * i + 6] * rstd * gb.z * (1.f + scb.z) + shb.z, xv[8 * i + 7] * rstd * gb.w * (1.f + scb.w) + shb.w);
            *(u32x4*)(p.H + (size_t)row * D + k) = o;
        }
    } else {
#pragma unroll
        for (int i = 0; i < 2; ++i) {
            const int k = lane * 8 + 512 * i;
            const float4 ga = *(const float4*)(p.g_final + k), gb = *(const float4*)(p.g_final + k + 4);
            float* op = p.out + (size_t)row * D + k;
            *(float4*)op = make_float4(xv[8 * i] * rstd * ga.x, xv[8 * i + 1] * rstd * ga.y, xv[8 * i + 2] * rstd * ga.z, xv[8 * i + 3] * rstd * ga.w);
            *(float4*)(op + 4) = make_float4(xv[8 * i + 4] * rstd * gb.x, xv[8 * i + 5] * rstd * gb.y, xv[8 * i + 6] * rstd * gb.z, xv[8 * i + 7] * rstd * gb.w);
        }
    }
}
__device__ __forceinline__ void ph_combine(const P& p, int l, int nrows) {
    const int wave = ltid() >> 6, lane = ltid() & 63;
    for (int pr = blockIdx.x * 8 + wave; pr < nrows / 2; pr += gridDim.x * 8) {
        CombRow ca, cb;
        comb_load(ca, p.YB, p.X, p.tok_slot, p.topg, 2 * pr, lane);
        comb_load(cb, p.YB, p.X, p.tok_slot, p.topg, 2 * pr + 1, lane);
        comb_finish(p, ca, l, 2 * pr, lane);
        comb_finish(p, cb, l, 2 * pr + 1, lane);
    }
}
extern __shared__ __attribute__((aligned(16))) char smem[];
__global__ void __launch_bounds__(NT, 2) mega(P p) {
    char* lds = smem;
    if (threadIdx.x == 0) *(uint4*)(smem + LDS_MAIN) = make_uint4(0u, 0u, 0u, 0u);
    __syncthreads();
    XcdBarrier bar = xcd_barrier_post(p.bar, (volatile LAS unsigned*)(smem + LDS_MAIN));
    ph_prologue(p, lds, 0);
    xcd_barrier(bar);
    ph_norm1(p, 0);
    ph_prologue(p, lds, 1);
    xcd_barrier(bar);
#pragma unroll
    for (int l = 0; l < 2; ++l) {
        const int nrows = l == 0 ? R : T;
        ph_gemm_proj(p, l, lds);
        xcd_barrier(bar);
        ph_dattn(p, l, nrows, lds);
        ph_na(p, l, nrows, lds);
        ph_pool(p, l, nrows, lds);
        ph_sgu(p, l, nrows, lds);
        xcd_barrier(bar);
        ph_gemm_out(p, l, nrows, lds);
        xcd_barrier(bar);
        ph_router(p, l, nrows, lds);
        xcd_barrier(bar);
        ph_assign(p, l, nrows, lds);
        xcd_barrier(bar);
        ph_moe1(p, l, lds);
        xcd_barrier(bar);
        ph_moe2(p, l, lds);
        xcd_barrier(bar);
        ph_combine(p, l, nrows);
        if (l == 0) xcd_barrier(bar);
    }
}

static inline size_t align_up(size_t v, size_t a) { return (v + a - 1) / a * a; }

extern "C" void kernel_launch(void* const* d_in, const int* in_sizes, int n_in, void* d_out, int out_size, void* d_ws, size_t ws_size, hipStream_t stream) {
    P p{};
    const float** ins = (const float**)&p.x;
    for (int i = 0; i < 28; ++i) ins[i] = (const float*)d_in[i];
    p.out = (float*)d_out;
    char* w = (char*)d_ws; size_t off = 0;
    auto carve = [&](size_t bytes) { void* r = w + off; off = align_up(off + bytes, 256); return r; };
    const size_t ctl_bytes = XCD_BAR_WORDS * 4 + 2 * 64 * 4;
    p.bar = (unsigned*)carve(ctl_bytes);
    p.cnt = (int*)(p.bar + XCD_BAR_WORDS);
    p.mod = (float*)carve((size_t)2 * 5 * 6144 * 4);
    p.rope = (float*)carve(64 * 8 * 2 * 4);
    p.X = (bf16_t*)carve((size_t)R * D * 2);
    p.H = (bf16_t*)carve((size_t)R * D * 2);
    p.PROJ = (bf16_t*)carve((size_t)R * PW * 2);
    p.MIX = (bf16_t*)carve((size_t)R * D * 2);
    p.WinT = (bf16_t*)carve((size_t)2 * PW * D * 2);
    p.WoutT = (bf16_t*)carve((size_t)2 * D * D * 2);
    p.WguT = (unsigned char*)carve((size_t)2 * NE * 2048 * D);
    p.WdnT = (unsigned char*)carve((size_t)2 * NE * D * FF);
    p.WpT = (bf16_t*)carve((size_t)2 * 4 * 64 * 64 * 2);
    p.WsB = (bf16_t*)carve((size_t)2 * 4 * 128 * 128 * 2);
    p.topi = (int*)carve((size_t)R * 4 * 4);
    p.topg = (float*)carve((size_t)R * 4 * 4);
    p.tok_slot = (int*)carve((size_t)R * 4 * 4);
    p.moe_meta = (int*)carve(2 * 512 * 4);
    p.HS = (unsigned char*)carve((size_t)NSLOT * D);
    p.ACT = (unsigned char*)carve((size_t)NSLOT * FF);
    p.YB = (bf16_t*)carve((size_t)NSLOT * D * 2);

    static int grid = 0;
    if (!grid) {
        int dev = 0, cus = 0, per_cu = 0;
        (void)hipGetDevice(&dev);
        (void)hipDeviceGetAttribute(&cus, hipDeviceAttributeMultiprocessorCount, dev);
        (void)hipFuncSetAttribute((const void*)mega, hipFuncAttributeMaxDynamicSharedMemorySize, LDS_BYTES);
        (void)hipOccupancyMaxActiveBlocksPerMultiprocessor(&per_cu, mega, NT, LDS_BYTES);
        grid = cus * (per_cu < 1 ? per_cu : 1);
        if (grid <= 0) { fprintf(stderr, "mega: occupancy query returned %d blocks per CU\n", per_cu); grid = 0; return; }
    }
    (void)hipMemsetAsync(p.bar, 0, ctl_bytes, stream);
    mega<<<grid, NT, LDS_BYTES, stream>>>(p);
}
```

```cpp
#include <hip/hip_runtime.h>
#include <stdint.h>
#include <cstdio>

typedef unsigned short bf16_t;
typedef short bf16x8 __attribute__((ext_vector_type(8)));
typedef float f32x4 __attribute__((ext_vector_type(4)));

constexpr int D = 1024, NB = 4, S = 4096, T = NB * S, CL = 256, TC = NB * CL, R = T + TC;
constexpr int PW = 2304, NE = 32, TOPK = 4, FF = 1024;
constexpr int MAXSLOT = R * TOPK;
constexpr int NSLOT = MAXSLOT + NE * 256;
constexpr float EPS = 1e-6f;
constexpr int NT = 512;
constexpr int LDS_MAIN = 150 * 1024;
constexpr int LDS_BYTES = LDS_MAIN + 1024;

__device__ __forceinline__ bf16_t f2bf(float f) { unsigned u = __float_as_uint(f); return (bf16_t)((u + 0x7fffu + ((u >> 16) & 1u)) >> 16); }
__device__ __forceinline__ float bf2f(bf16_t h) { return __uint_as_float(((unsigned)h) << 16); }
__device__ __forceinline__ float wave_sum(float v) {
#pragma unroll
    for (int o = 32; o >= 1; o >>= 1) v += __shfl_xor(v, o);
    return v;
}
__device__ __forceinline__ int mod_row(int row) { return row < T ? (row >> 12) : 4; }

#define XB_TMO      128
#define XB_XCNT(j)  (256  + 64 * (j))
#define XB_XSUB(j)  (1280 + 64 * (j))
#define XB_XGEN(j)  (2304 + 64 * (j))
#define XB_TOP      3328
#define XB_TOPGEN   3392
#define XCD_BAR_WORDS 3456
#define XB_SPIN_CAP (1u << 18)
#define LAS __attribute__((address_space(3)))

__device__ __forceinline__ unsigned xb_ld(unsigned* p)              { return __hip_atomic_load(p, __ATOMIC_RELAXED, __HIP_MEMORY_SCOPE_AGENT); }
__device__ __forceinline__ unsigned xb_add(unsigned* p, unsigned v) { return __hip_atomic_fetch_add(p, v, __ATOMIC_RELAXED, __HIP_MEMORY_SCOPE_AGENT); }
__device__ __forceinline__ unsigned xb_xcc_id() { return (unsigned)__builtin_amdgcn_s_getreg((3 << 11) | 20) & 0xFu; }
#define XB_SPIN(cond, bar) do { unsigned _sp = 0; while (cond) { __builtin_amdgcn_s_sleep(1); \
    if ((++_sp & 255u) == 0u) { if (xb_ld(&(bar)[XB_TMO])) break; if (_sp > XB_SPIN_CAP) { atomicAdd(&(bar)[XB_TMO], 1u); break; } } } } while (0)

struct XcdBarrier {
    unsigned* bar; unsigned x;
    volatile LAS unsigned* st;
    int wv;
};
__device__ __forceinline__ bool xb_t0(const int wv) { return wv == 0 && __builtin_amdgcn_mbcnt_hi(~0u, __builtin_amdgcn_mbcnt_lo(~0u, 0u)) == 0u; }
__device__ __forceinline__ XcdBarrier xcd_barrier_post(unsigned* bar, volatile LAS unsigned* st, const int wv) {
    XcdBarrier b; b.bar = bar; b.x = xb_xcc_id(); b.st = st; b.wv = wv;
    if (xb_t0(wv)) (void)xb_add(&bar[XB_XCNT(b.x)], 1u);
    return b;
}
__device__ __forceinline__ void xcd_barrier_complete(unsigned* bar, unsigned x, unsigned& nloc, unsigned& nx) {
    const unsigned G = gridDim.x * gridDim.y * gridDim.z;
    unsigned sum, cnt, mine, sp = 0u;
    for (;;) {
        sum = 0u; cnt = 0u; mine = 0u;
#pragma unroll
        for (unsigned j = 0; j < 16; ++j) { const unsigned c = xb_ld(&bar[XB_XCNT(j)]); sum += c; cnt += (c > 0u) ? 1u : 0u; mine = (j == x) ? c : mine; }
        if (sum == G) break;
        __builtin_amdgcn_s_sleep(1);
        if ((++sp & 255u) == 0u) { if (xb_ld(&bar[XB_TMO])) break; if (sp > XB_SPIN_CAP) { atomicAdd(&bar[XB_TMO], 1u); break; } }
    }
    nloc = mine > 0u ? mine : 1u; nx = cnt > 0u ? cnt : 1u;
}
__device__ __forceinline__ void xcd_barrier(const XcdBarrier& b) {
    asm volatile("s_waitcnt vmcnt(0)" ::: "memory");
    __syncthreads();
    if (xb_t0(b.wv)) {
        unsigned* bar = b.bar;
        __builtin_amdgcn_s_waitcnt(0);
        unsigned nloc = b.st[0], nx = b.st[1];
        if (nloc == 0u) { xcd_barrier_complete(bar, b.x, nloc, nx); b.st[0] = nloc; b.st[1] = nx; }
        const unsigned old = xb_add(&bar[XB_XSUB(b.x)], 1u);
        const unsigned gen = old / nloc;
        if (old + 1u == (gen + 1u) * nloc) {
            __builtin_amdgcn_fence(__ATOMIC_RELEASE, "agent");
            asm volatile("s_waitcnt vmcnt(0)" ::: "memory");
            const unsigned og = xb_add(&bar[XB_TOP], 1u);
            const unsigned tg = og / nx;
            if (og + 1u == (tg + 1u) * nx) xb_add(&bar[XB_TOPGEN], 1u);
            else XB_SPIN(xb_ld(&bar[XB_TOPGEN]) == tg, bar);
            __builtin_amdgcn_fence(__ATOMIC_ACQUIRE, "agent");
            xb_add(&bar[XB_XGEN(b.x)], 1u);
            asm volatile("s_waitcnt vmcnt(0)" ::: "memory");
        } else {
            XB_SPIN(xb_ld(&bar[XB_XGEN(b.x)]) == gen, bar);
            __builtin_amdgcn_fence(__ATOMIC_ACQUIRE, "agent");
            asm volatile("s_waitcnt vmcnt(0)" ::: "memory");
        }
    }
    __syncthreads();
}

struct P {
    const float *x, *c, *ctx, *c_ctx, *w_mod, *b_mod, *g_mix, *g_ffn, *w_in, *w_out, *lam_q1, *lam_k1, *lam_q2, *lam_k2, *g_sub,
        *w_pool, *s_pool, *g_sgu, *w_sgu, *b_sgu, *rpb, *w_router, *b_router, *w_gu, *b_gu, *w_down, *b_down, *g_final;
    float* out;
    unsigned* bar;
    int* cnt;
    float* mod;
    float* rope;
    bf16_t* X;
    bf16_t* H;
    bf16_t* PROJ;
    bf16_t* MIX;
    bf16_t* WinT;
    bf16_t* WoutT;
    unsigned char* WguT;
    unsigned char* WdnT;
    bf16_t* WpT;
    bf16_t* WsB;
    int* topi;
    float* topg;
    int* tok_slot;
    int* moe_meta;
    unsigned char* HS;
    unsigned char* ACT;
    bf16_t* YB;
};

__device__ __forceinline__ int ltid(const int wv) { int t; asm volatile("v_mbcnt_lo_u32_b32 %0, -1, 0\n\tv_mbcnt_hi_u32_b32 %0, -1, %0\n\tv_lshl_or_b32 %0, %1, 6, %0" : "=&v"(t) : "s"(wv)); return t; }
typedef float f32x16 __attribute__((ext_vector_type(16)));
typedef short s16x4 __attribute__((ext_vector_type(4)));
typedef short v4i16_t __attribute__((ext_vector_type(4)));
typedef float f32x2_t __attribute__((ext_vector_type(2)));
typedef __bf16 bf16x2_t __attribute__((ext_vector_type(2)));
typedef __attribute__((address_space(3))) const char* lds_cptr;
typedef unsigned u32x4 __attribute__((ext_vector_type(4)));
__device__ __forceinline__ unsigned cvtpk(float lo, float hi) { f32x2_t v = {lo, hi}; bf16x2_t b = __builtin_convertvector(v, bf16x2_t); return __builtin_bit_cast(unsigned, b); }
__device__ __forceinline__ s16x4 vtr(lds_cptr q) { return __builtin_bit_cast(s16x4, __builtin_amdgcn_ds_read_tr16_b64_v4i16((__attribute__((address_space(3))) v4i16_t*)q)); }
__device__ __forceinline__ float xhalf_max(float v) { auto rr = __builtin_amdgcn_permlane32_swap(__float_as_uint(v), __float_as_uint(v), false, false); return fmaxf(__uint_as_float(rr[0]), __uint_as_float(rr[1])); }
__device__ __forceinline__ float xhalf_sum(float v) { auto rr = __builtin_amdgcn_permlane32_swap(__float_as_uint(v), __float_as_uint(v), false, false); return __uint_as_float(rr[0]) + __uint_as_float(rr[1]); }
namespace pg8 {
#define PG8_LAS __attribute__((address_space(3)))
constexpr int BM = 256, BK = 64, HALF = 128, HTB = HALF * BK * 2  , STAGE_BYTES = 8 * HTB, NXCD = 8, WGM = 8;
__host__ __device__ __forceinline__ int lds_byte(int r, int c) { const int st = (r >> 4) * 2 + (c >> 5), rr = r & 15, cc = c & 31, ob = rr * 64 + cc * 2; return st * 1024 + (ob ^ (((ob >> 9) & 1) << 5)); }
__host__ __device__ __forceinline__ void stage_rc(int b, int& R, int& C) { const int st = b / 1024, sb = b % 1024, swz = sb ^ (((sb >> 9) & 1) << 5); R = (st >> 1) * 16 + swz / 64; C = (st & 1) * 32 + (swz % 64) / 2; }
__host__ __device__ __forceinline__ int perm32(int rho) { const int n = rho >> 4, i = rho & 15; return 8 * (i >> 2) + 4 * n + (i & 3); }
struct Unit { int pm, pn, e; };
struct Gemm { const bf16_t* A; const bf16_t* Bt; int M, N, K; };
struct StaticOrder {
    int nM, nN, nwg, G, c;
    __host__ __device__ void init(int M, int N, int G_, int c_) { nM = M / BM; nN = N / BM; nwg = nM * nN; G = G_; c = c_; }
    __host__ __device__ bool next(int i, Unit& u) const {
        const long L = (long)i * G + c; if (L >= nwg) return false;
        int wgid = (int)L; { const int q = nwg / NXCD, r = nwg % NXCD, xcd = wgid % NXCD, off = wgid / NXCD; wgid = (xcd < r ? xcd * (q + 1) : r * (q + 1) + (xcd - r) * q) + off; }
        const int nig = WGM * nN, gid = wgid / nig, fm = gid * WGM, gsz = (nM - fm) < WGM ? (nM - fm) : WGM;
        u.pm = fm + ((wgid % nig) % gsz); u.pn = (wgid % nig) / gsz; u.e = 0; return true;
    }
    __device__ __forceinline__ const bf16_t* bt(const Gemm& g, const Unit&) const { return g.Bt; }
    __device__ __forceinline__ void a_ready(const Unit&) const {}
    __device__ __forceinline__ void done(const Unit&) const {}
};
typedef int v4i_t __attribute__((ext_vector_type(4)));
typedef int v8i_t __attribute__((ext_vector_type(8)));
__device__ __forceinline__ v8i_t cat8(bf16x8 a, bf16x8 b) { const v4i_t x = __builtin_bit_cast(v4i_t, a), y = __builtin_bit_cast(v4i_t, b); return __builtin_shufflevector(x, y, 0, 1, 2, 3, 4, 5, 6, 7); }
template <class Epi, class Sched, bool ALIGN_EPI = false, bool SP2 = false, bool F8 = false>
__device__ __forceinline__ void gemm_phase(PG8_LAS unsigned char* lds, const Gemm g, const Sched& S, const Epi& E, const int wv) {
    const int tid = ltid(wv), wid = __builtin_amdgcn_readfirstlane(tid >> 6), lane = tid & 63, wr = wid >> 2, wc = wid & 3, fr = lane & 15, fq = lane >> 4;
    const int K = g.K, nt = K / BK;
    unsigned voffA[2], voffB[2];
#pragma unroll
    for (int i = 0; i < 2; ++i) { int R, C; stage_rc(tid * 16 + i * 8192, R, C); const int Rb = Epi::PERM ? ((R & ~31) + perm32(R & 31)) : R;
        voffA[i] = (unsigned)(R * K + C) * 2u; voffB[i] = (unsigned)(Rb * K + C) * 2u; }
    const size_t kstep = (size_t)(BK * 2);
    const size_t hstep = (size_t)HALF * K * 2;
    const size_t tstep = 2 * hstep;
    const unsigned ldsw = (unsigned)wid * 1024u;
    const int aoff = lds_byte(wr * 64 + fr, fq * 8), boff = lds_byte(wc * 32 + fr, fq * 8);
#define PG8_SA(b, h) (((b) * 2 + (h)) * HTB)
#define PG8_SB(b, h) ((4 + (b) * 2 + (h)) * HTB)
#define PG8_STAGE(bufoff, gbase, voff) do { _Pragma("unroll") for (int _i = 0; _i < 2; ++_i) \
        __builtin_amdgcn_global_load_lds((const unsigned*)((const char*)(gbase) + (voff)[_i]), (PG8_LAS unsigned*)(lds + (bufoff) + ldsw + _i * 8192), 16, 0, 0); } while (0)
#define PG8_LDA(dst, b, h) do { _Pragma("unroll") for (int m = 0; m < 4; ++m) _Pragma("unroll") for (int k = 0; k < 2; ++k) dst[m][k] = *(const PG8_LAS bf16x8*)(lds + PG8_SA(b, h) + aoff + m * 2048 + k * 1024); \
        if constexpr (F8) { _Pragma("unroll") for (int m = 0; m < 4; ++m) dst##8[m] = cat8(dst[m][0], dst[m][1]); } } while (0)
#define PG8_LDB(dst, b, h) do { _Pragma("unroll") for (int n = 0; n < 2; ++n) _Pragma("unroll") for (int k = 0; k < 2; ++k) dst[n][k] = *(const PG8_LAS bf16x8*)(lds + PG8_SB(b, h) + boff + n * 2048 + k * 1024); \
        if constexpr (F8) { _Pragma("unroll") for (int n = 0; n < 2; ++n) dst##8[n] = cat8(dst[n][0], dst[n][1]); } } while (0)
#define PG8_MMA(ai, bj, At, Bt) do { __builtin_amdgcn_s_setprio(1); \
        if constexpr (F8) { _Pragma("unroll") for (int m = 0; m < 4; ++m) _Pragma("unroll") for (int n = 0; n < 2; ++n) \
            asm volatile("v_mfma_scale_f32_16x16x128_f8f6f4 %0, %1, %2, %0, %3, %4 op_sel_hi:[0,0,0]" : "+v"(acc[ai][bj][m][n]) : "v"(Bt##8[n]), "v"(At##8[m]), "v"(sclW), "v"(sclX)); } \
        else { _Pragma("unroll") for (int m = 0; m < 4; ++m) _Pragma("unroll") for (int n = 0; n < 2; ++n) _Pragma("unroll") for (int k = 0; k < 2; ++k) \
            acc[ai][bj][m][n] = __builtin_amdgcn_mfma_f32_16x16x32_bf16(Bt[n][k], At[m][k], acc[ai][bj][m][n], 0, 0, 0); } \
        __builtin_amdgcn_s_setprio(0); } while (0)
#define PG8_WAIT_V(n) asm volatile("s_waitcnt vmcnt(" #n ")" ::: "memory")
#define PG8_WAIT_L(n) asm volatile("s_waitcnt lgkmcnt(" #n ")" ::: "memory")
#define PG8_BAR __builtin_amdgcn_s_barrier()
#define PG8_SCHED __builtin_amdgcn_sched_barrier(0)
    Unit cur, nxt; int ui = 0;
    if (!S.next(0, cur)) return;
    f32x4 acc[2][2][4][2];
#pragma unroll
    for (int a = 0; a < 2; ++a)
#pragma unroll
        for (int b = 0; b < 2; ++b)
#pragma unroll
            for (int m = 0; m < 4; ++m)
#pragma unroll
                for (int n = 0; n < 2; ++n) { acc[a][b][m][n] = (f32x4){0.f, 0.f, 0.f, 0.f}; }
    bf16x8 At[4][2], B0[2][2], B1[2][2];
    v8i_t At8[4], B08[2], B18[2];
    const int sclW = 0x79797979, sclX = 0x7f7f7f7f;
    const char* cA = (const char*)g.A + (size_t)cur.pm * tstep; const char* cB = (const char*)S.bt(g, cur) + (size_t)cur.pn * tstep;
    S.a_ready(cur);
    if constexpr (SP2) {
        PG8_STAGE(PG8_SB(0, 0), cB, voffB); PG8_STAGE(PG8_SB(0, 1), cB + hstep, voffB); PG8_STAGE(PG8_SA(0, 0), cA, voffA); PG8_STAGE(PG8_SA(0, 1), cA + hstep, voffA);
        if (wr == 1) PG8_BAR;
        PG8_WAIT_V(2); PG8_BAR;
        PG8_STAGE(PG8_SB(1, 0), cB + kstep, voffB); PG8_STAGE(PG8_SA(1, 0), cA + kstep, voffA); PG8_STAGE(PG8_SB(1, 1), cB + hstep + kstep, voffB);
        PG8_WAIT_V(6); PG8_BAR;
    } else {
        PG8_STAGE(PG8_SB(0, 0), cB, voffB); PG8_STAGE(PG8_SA(0, 0), cA, voffA); PG8_STAGE(PG8_SB(0, 1), cB + hstep, voffB); PG8_STAGE(PG8_SA(0, 1), cA + hstep, voffA);
        if (wr == 1) PG8_BAR;
        PG8_WAIT_V(4); PG8_BAR;
        PG8_STAGE(PG8_SB(1, 0), cB + kstep, voffB); PG8_STAGE(PG8_SA(1, 0), cA + kstep, voffA); PG8_STAGE(PG8_SB(1, 1), cB + hstep + kstep, voffB);
        PG8_WAIT_V(6); PG8_BAR;
    }
    for (;;) {
        const bool has_next = S.next(ui + 1, nxt);
        const char* nA = has_next ? (const char*)g.A + (size_t)nxt.pm * tstep : cA; const char* nB = has_next ? (const char*)S.bt(g, nxt) + (size_t)nxt.pn * tstep : cB;
#pragma unroll 1
        for (int t = 0; t < nt; t += 2) {
            const bool last = (t == nt - 2);
            const char* a1 = cA + (size_t)(t + 1) * kstep;
            const char* a2 = last ? nA : cA + (size_t)(t + 2) * kstep; const char* b2 = last ? nB : cB + (size_t)(t + 2) * kstep;
            const char* a3 = a2 + kstep; const char* b3 = b2 + kstep;
            if (last && has_next) S.a_ready(nxt);
            if constexpr (SP2) {
            PG8_LDB(B0, 0, 0); PG8_LDB(B1, 0, 1); PG8_SCHED; PG8_LDA(At, 0, 0); PG8_STAGE(PG8_SA(1, 1), a1 + hstep, voffA);
            PG8_WAIT_V(8); PG8_WAIT_L(0); PG8_BAR; PG8_MMA(0, 0, At, B0); PG8_MMA(0, 1, At, B1); PG8_BAR; PG8_SCHED;
            PG8_LDA(At, 0, 1); PG8_STAGE(PG8_SB(0, 0), b2, voffB); PG8_STAGE(PG8_SB(0, 1), b2 + hstep, voffB); PG8_STAGE(PG8_SA(0, 0), a2, voffA);
            PG8_WAIT_V(8); PG8_WAIT_L(0); PG8_BAR; PG8_MMA(1, 0, At, B0); PG8_MMA(1, 1, At, B1); PG8_BAR; PG8_SCHED;
            PG8_LDB(B0, 1, 0); PG8_LDB(B1, 1, 1); PG8_SCHED; PG8_LDA(At, 1, 0); PG8_STAGE(PG8_SA(0, 1), a2 + hstep, voffA);
            PG8_WAIT_V(8); PG8_WAIT_L(0); PG8_BAR; PG8_MMA(0, 0, At, B0); PG8_MMA(0, 1, At, B1); PG8_BAR; PG8_SCHED;
            PG8_LDA(At, 1, 1); PG8_STAGE(PG8_SB(1, 0), b3, voffB); PG8_STAGE(PG8_SB(1, 1), b3 + hstep, voffB); PG8_STAGE(PG8_SA(1, 0), a3, voffA);
            PG8_WAIT_V(8); PG8_WAIT_L(0); PG8_BAR; PG8_MMA(1, 0, At, B0); PG8_MMA(1, 1, At, B1); PG8_BAR; PG8_SCHED;
            } else {
            PG8_LDB(B0, 0, 0); PG8_SCHED; PG8_LDA(At, 0, 0); PG8_STAGE(PG8_SA(1, 1), a1 + hstep, voffA);
            PG8_WAIT_L(8); PG8_BAR; PG8_WAIT_L(0); PG8_MMA(0, 0, At, B0); PG8_BAR; PG8_SCHED;
            PG8_LDB(B1, 0, 1); PG8_STAGE(PG8_SB(0, 0), b2, voffB);
            PG8_BAR; PG8_WAIT_L(0); PG8_MMA(0, 1, At, B1); PG8_BAR;
            PG8_LDA(At, 0, 1); PG8_STAGE(PG8_SA(0, 0), a2, voffA);
            PG8_BAR; PG8_WAIT_L(0); PG8_MMA(1, 0, At, B0); PG8_BAR; PG8_SCHED;
            PG8_STAGE(PG8_SB(0, 1), b2 + hstep, voffB);
            PG8_WAIT_V(6); PG8_BAR; PG8_MMA(1, 1, At, B1); PG8_BAR;
            PG8_LDB(B0, 1, 0); PG8_SCHED; PG8_LDA(At, 1, 0); PG8_STAGE(PG8_SA(0, 1), a2 + hstep, voffA);
            PG8_WAIT_L(8); PG8_BAR; PG8_WAIT_L(0); PG8_MMA(0, 0, At, B0); PG8_BAR; PG8_SCHED;
            PG8_LDB(B1, 1, 1); PG8_STAGE(PG8_SB(1, 0), b3, voffB);
            PG8_BAR; PG8_WAIT_L(0); PG8_MMA(0, 1, At, B1); PG8_BAR;
            PG8_LDA(At, 1, 1); PG8_STAGE(PG8_SA(1, 0), a3, voffA);
            PG8_BAR; PG8_WAIT_L(0); PG8_MMA(1, 0, At, B0); PG8_BAR; PG8_SCHED;
            PG8_STAGE(PG8_SB(1, 1), b3 + hstep, voffB);
            PG8_WAIT_V(6); PG8_BAR; PG8_MMA(1, 1, At, B1); PG8_BAR;
            }
        }
        if constexpr (ALIGN_EPI) { if (wr == 0) PG8_BAR; }
        if constexpr (F8) asm volatile("s_nop 15\n\ts_nop 15" ::: "memory");
        if constexpr (!Epi::AFTER_DRAIN) { E(acc, cur, wr, wc, fr, fq); S.done(cur); }
        if (!has_next) break;
#pragma unroll
        for (int a = 0; a < 2; ++a)
#pragma unroll
            for (int b = 0; b < 2; ++b)
#pragma unroll
                for (int m = 0; m < 4; ++m)
#pragma unroll
                    for (int n = 0; n < 2; ++n) { acc[a][b][m][n] = (f32x4){0.f, 0.f, 0.f, 0.f}; }
        cur = nxt; cA = nA; cB = nB; ++ui;
        if constexpr (ALIGN_EPI) { if (wr == 1) PG8_BAR; }
    }
    PG8_WAIT_V(0);
    if constexpr (!ALIGN_EPI) { if (wr == 0) PG8_BAR; }
    PG8_BAR;
    if constexpr (Epi::AFTER_DRAIN) { E.fused(acc, cur, wr, wc, fr, fq, lds, wid, lane); S.done(cur); }
#undef PG8_SA
#undef PG8_SB
#undef PG8_STAGE
#undef PG8_LDA
#undef PG8_LDB
#undef PG8_MMA
#undef PG8_WAIT_V
#undef PG8_WAIT_L
#undef PG8_BAR
#undef PG8_SCHED
}
}

__device__ __forceinline__ void ph_prologue(const P& p, char* lds, const int part, const int wv) {
    const int tid = ltid(wv);
    float* fl = (float*)lds;
    if (part == 0) {
    for (int it = blockIdx.x; it < 192; it += gridDim.x) {
        const int l = it / 96, cg = it % 96;
        float* sc = fl;
        float* part = fl + 5 * 1024;
        __syncthreads();
        for (int i = tid; i < 5 * 1024; i += NT) {
            const int r = i >> 10, k = i & 1023;
            const float v = r < 4 ? p.c[r * 1024 + k] : p.c_ctx[k];
            sc[i] = v / (1.f + __expf(-v));
        }
        __syncthreads();
        const int kq = tid >> 6, col = tid & 63, j = cg * 64 + col;
        const float* W = p.w_mod + (size_t)l * 1024 * 6144 + j;
        float a0 = 0, a1 = 0, a2 = 0, a3 = 0, a4 = 0;
#pragma unroll 16
        for (int k = kq * 128; k < kq * 128 + 128; ++k) {
            const float w = W[(size_t)k * 6144];
            a0 += sc[k] * w; a1 += sc[1024 + k] * w; a2 += sc[2048 + k] * w; a3 += sc[3072 + k] * w; a4 += sc[4096 + k] * w;
        }
        part[(kq * 5 + 0) * 64 + col] = a0; part[(kq * 5 + 1) * 64 + col] = a1; part[(kq * 5 + 2) * 64 + col] = a2;
        part[(kq * 5 + 3) * 64 + col] = a3; part[(kq * 5 + 4) * 64 + col] = a4;
        __syncthreads();
        if (tid < 5 * 64) {
            const int r = tid >> 6, cc = tid & 63, jj = cg * 64 + cc;
            float v = 0.f;
#pragma unroll
            for (int q = 0; q < 8; ++q) v += part[(q * 5 + r) * 64 + cc];
            p.mod[((size_t)l * 5 + r) * 6144 + jj] = v + p.b_mod[l * 6144 + jj];
        }
    }
    if (blockIdx.x == gridDim.x - 1) {
        const int pos = tid >> 3, f = tid & 7;
        const float inv = powf(10000.0f, -(float)f / 8.0f);
        const float ang = (float)pos * inv;
        p.rope[tid * 2] = cosf(ang); p.rope[tid * 2 + 1] = sinf(ang);
    }
    for (int i = blockIdx.x * NT + tid; i < 2 * 4 * 64 * 64; i += gridDim.x * NT) { const int ii = i & 63, j = (i >> 6) & 63, lg = i >> 12; p.WpT[i] = f2bf(p.w_pool[(size_t)lg * 4096 + ii * 64 + j]); }
    for (int i = blockIdx.x * NT + tid; i < 2 * 4 * 128 * 128; i += gridDim.x * NT) p.WsB[i] = f2bf(p.w_sgu[i]);
    }
    if (part == 1) {
        const int n_in = 2 * 9 * 16, n_out = 2 * 4 * 16, total = n_in + n_out;
        const int kr = tid >> 6, n4 = tid & 63, kg = tid & 7, nl = tid >> 3;
        for (int it = blockIdx.x; it < total; it += gridDim.x) {
            int i_ = it; const float* W_; bf16_t* Wt_; int N, K;
            if (i_ < n_in) { W_ = p.w_in; Wt_ = p.WinT; N = PW; K = D; } else { i_ -= n_in; W_ = p.w_out; Wt_ = p.WoutT; N = D; K = D; }
            const int ntn = N / 256, per = ntn * (K / 64), m_ = i_ / per, r_ = i_ % per, tn = r_ % ntn, tk = r_ / ntn, n0 = tn * 256;
            const float* src = W_ + (size_t)m_ * K * N + (size_t)(tk * 64) * N + n0; bf16_t* dst = Wt_ + (size_t)m_ * K * N + tk * 64;
            float4 rg[8];
#pragma unroll
            for (int i = 0; i < 8; ++i) rg[i] = *(const float4*)(src + (size_t)(kr + 8 * i) * N + n4 * 4);
            __syncthreads();
#pragma unroll
            for (int i = 0; i < 8; ++i) { float* q = fl + (kr + 8 * i) * 257 + n4 * 4; q[0] = rg[i].x; q[1] = rg[i].y; q[2] = rg[i].z; q[3] = rg[i].w; }
            __syncthreads();
#pragma unroll
            for (int j = 0; j < 4; ++j) {
                const int n = nl + 64 * j;
                const float* q = fl + (8 * kg) * 257 + n;
                u32x4 w;
                w.x = cvtpk(q[0], q[257]); w.y = cvtpk(q[2 * 257], q[3 * 257]); w.z = cvtpk(q[4 * 257], q[5 * 257]); w.w = cvtpk(q[6 * 257], q[7 * 257]);
                *(u32x4*)(dst + (size_t)(n0 + n) * K + 8 * kg) = w;
            }
        }
    }
}

__device__ __forceinline__ void ph_norm1(const P& p, int l, const int wv) {
    const int wave = ltid(wv) >> 6, lane = ltid(wv) & 63;
    for (int row = blockIdx.x * 8 + wave; row < R; row += gridDim.x * 8) {
        const float* xr = row < T ? p.x + (size_t)row * D : p.ctx + (size_t)(row - T) * D;
        float4 v[4]; float ss = 0;
#pragma unroll
        for (int i = 0; i < 4; ++i) { v[i] = *(const float4*)(xr + lane * 4 + 256 * i); ss += v[i].x * v[i].x + v[i].y * v[i].y + v[i].z * v[i].z + v[i].w * v[i].w; }
        ss = wave_sum(ss);
        const float rstd = rsqrtf(ss * (1.f / D) + EPS);
        const float* m = p.mod + ((size_t)l * 5 + mod_row(row)) * 6144;
        const float* g = p.g_mix + l * D;
#pragma unroll
        for (int i = 0; i < 4; ++i) {
            const int k = lane * 4 + 256 * i;
            const float4 gg = *(const float4*)(g + k), sh = *(const float4*)(m + k), sc = *(const float4*)(m + 1024 + k);
            uint2 o;
            o.x = cvtpk(v[i].x * rstd * gg.x * (1.f + sc.x) + sh.x, v[i].y * rstd * gg.y * (1.f + sc.y) + sh.y);
            o.y = cvtpk(v[i].z * rstd * gg.z * (1.f + sc.z) + sh.z, v[i].w * rstd * gg.w * (1.f + sc.w) + sh.w);
            *(uint2*)(p.H + (size_t)row * D + k) = o;
        }
    }
}

constexpr float QSCALE = 0.17677669529663687f * 1.4426950408889634f;
__device__ __forceinline__ void dsoftmax(const f32x16& s, float& m, float& l, f32x16& o0, f32x16& o1, bf16x8& pa, bf16x8& pb) {
    float mx = fmaxf(fmaxf(fmaxf(s[0], s[1]), fmaxf(s[2], s[3])), fmaxf(fmaxf(s[4], s[5]), fmaxf(s[6], s[7])));
    mx = fmaxf(mx, fmaxf(fmaxf(fmaxf(s[8], s[9]), fmaxf(s[10], s[11])), fmaxf(fmaxf(s[12], s[13]), fmaxf(s[14], s[15]))));
    mx = xhalf_max(mx);
    if (__any(mx > m)) {
        const float mn = fmaxf(m, mx), alpha = __builtin_amdgcn_exp2f(m - mn);
        o0 *= alpha; o1 *= alpha; l *= alpha; m = mn;
    }
    float pr[16]; float sum = 0.f;
#pragma unroll
    for (int r = 0; r < 16; ++r) { pr[r] = __builtin_amdgcn_exp2f(s[r] - m); sum += pr[r]; }
    l += sum;
    u32x4 a, b;
    a[0] = cvtpk(pr[0], pr[1]); a[1] = cvtpk(pr[2], pr[3]); a[2] = cvtpk(pr[4], pr[5]); a[3] = cvtpk(pr[6], pr[7]);
    b[0] = cvtpk(pr[8], pr[9]); b[1] = cvtpk(pr[10], pr[11]); b[2] = cvtpk(pr[12], pr[13]); b[3] = cvtpk(pr[14], pr[15]);
    pa = __builtin_bit_cast(bf16x8, a); pb = __builtin_bit_cast(bf16x8, b);
}
#define MX3(a, b, c) __builtin_fmaxf(__builtin_fmaxf((a), (b)), (c))
template <int THR>
__device__ __forceinline__ void dsoftmax2(f32x16& s, float& m, float& l, f32x16& o0, f32x16& o1, bf16x8& pa, bf16x8& pb, const bool first) {
    float a = MX3(s[0], s[1], s[2]), b = MX3(s[3], s[4], s[5]);
    a = MX3(a, s[6], s[7]); b = MX3(b, s[8], s[9]); a = MX3(a, s[10], s[11]); b = MX3(b, s[12], s[13]); a = MX3(a, s[14], s[15]);
    const float mx = xhalf_max(__builtin_fmaxf(a, b));
    if (first || __any(mx > m + (float)THR)) {
        const float mn = first ? mx : __builtin_fmaxf(mx, m), alpha = first ? 1.f : __builtin_amdgcn_exp2f(m - mn);
        m = mn; o0 *= alpha; o1 *= alpha; l *= alpha;
    }
    float sum = 0.f;
#pragma unroll
    for (int r = 0; r < 16; ++r) { s[r] = __builtin_amdgcn_exp2f(s[r] - m); sum += s[r]; }
    l += sum;
    u32x4 wa, wb;
    wa[0] = cvtpk(s[0], s[1]); wa[1] = cvtpk(s[2], s[3]); wa[2] = cvtpk(s[4], s[5]); wa[3] = cvtpk(s[6], s[7]);
    wb[0] = cvtpk(s[8], s[9]); wb[1] = cvtpk(s[10], s[11]); wb[2] = cvtpk(s[12], s[13]); wb[3] = cvtpk(s[14], s[15]);
    pa = __builtin_bit_cast(bf16x8, wa); pb = __builtin_bit_cast(bf16x8, wb);
}
typedef __attribute__((address_space(1))) const float* gcf32_t;
typedef __attribute__((address_space(1))) unsigned char* gu8_t;
struct CvT { gcf32_t src; gu8_t dst; int N, n0, perm; };
__device__ __forceinline__ void glds16(gcf32_t gsrc, unsigned lds_dst) { unsigned keep;
    asm volatile("s_mov_b32 %0, m0\n\ts_mov_b32 m0, %2\n\ts_nop 0\n\tglobal_load_lds_dwordx4 %1, off\n\ts_mov_b32 m0, %0" : "=&s"(keep) : "v"(gsrc), "s"(lds_dst) : "memory"); }
#if defined(__HIP_DEVICE_COMPILE__)
#define KARG_PTR(T_, member) ({ unsigned long long r_; asm volatile("s_load_dwordx2 %0, %1, %2\n\ts_waitcnt lgkmcnt(0)" : "=s"(r_) : "s"(__builtin_amdgcn_kernarg_segment_ptr()), "n"((int)__builtin_offsetof(P, member)) : "memory"); (T_)r_; })
#else
#define KARG_PTR(T_, member) ((T_)(unsigned long long)p.member)
#endif
__device__ __forceinline__ bool cv_decode(const P& p, int l, int j, CvT& c) {
    constexpr int n_gu = NE * 8 * 16, n_dn = NE * 8 * 8;
    const int tile = (int)blockIdx.x + (j >> 1) * (int)gridDim.x, half = j & 1;
    if (tile >= n_gu + n_dn) return false;
    if (tile < n_gu) {
        const int e = tile >> 7, tn = tile & 15, tk = (tile >> 4) & 7;
        c.N = 2048; c.perm = 1; c.n0 = tn * 128;
        c.src = KARG_PTR(gcf32_t, w_gu) + ((size_t)(l * NE + e) * 1024 + tk * 128 + half * 64) * 2048 + c.n0;
        c.dst = KARG_PTR(gu8_t, WguT) + (size_t)(l * NE + e) * 1024 * 2048 + tk * 128 + half * 64;
    } else {
        const int i_ = tile - n_gu, e = i_ >> 6, tn = i_ & 7, tk = (i_ >> 3) & 7;
        c.N = 1024; c.perm = 0; c.n0 = tn * 128;
        c.src = KARG_PTR(gcf32_t, w_down) + ((size_t)(l * NE + e) * 1024 + tk * 128 + half * 64) * 1024 + c.n0;
        c.dst = KARG_PTR(gu8_t, WdnT) + (size_t)(l * NE + e) * 1024 * 1024 + tk * 128 + half * 64;
    }
    return true;
}
__device__ __forceinline__ void cv_dma(const CvT& c, unsigned ldsbuf, int wid, int lane) {
    gcf32_t g = c.src + (size_t)(8 * wid + (lane >> 5)) * c.N + (((lane & 31) ^ (((wid >> 1) & 1) << 2)) * 4);
#pragma unroll
    for (int ii = 0; ii < 4; ++ii) glds16(g + (size_t)(2 * ii) * c.N, (unsigned)__builtin_amdgcn_readfirstlane((int)(ldsbuf + (4 * wid + ii) * 1024)));
}
__device__ __forceinline__ void cv_store(const CvT& c, const char* buf, int wid, int lane) {
    const int kg4 = lane & 3, n = 16 * wid + (lane >> 2);
    const float* q = (const float*)(buf + kg4 * 8192 + (((n >> 2) ^ ((kg4 & 1) << 2)) * 16) + (n & 3) * 4);
    u32x4 w;
#pragma unroll
    for (int d = 0; d < 4; ++d) {
        const unsigned r = __builtin_amdgcn_cvt_pk_fp8_f32(q[(2 * d) * 256] * 64.f, q[(2 * d) * 256 + 128] * 64.f, 0u, false);
        w[d] = __builtin_amdgcn_cvt_pk_fp8_f32(q[(2 * d + 1) * 256] * 64.f, q[(2 * d + 1) * 256 + 128] * 64.f, r, true);
    }
    const int ng = c.n0 + n;
    const int np = c.perm ? ((ng & 1023) >> 7) * 256 + (ng >= 1024 ? 128 : 0) + (ng & 127) : ng;
    *(__attribute__((address_space(1))) u32x4*)(c.dst + (size_t)np * 1024 + 16 * kg4) = w;
}
constexpr int CV_LDS = 32768;
__device__ __forceinline__ void ph_dattn(const P& p, int l, int nrows, char* lds, const int wv) {
    const int tid = ltid(wv), lane = tid & 63, wid = tid >> 6, r32 = lane & 31, hi = lane >> 5;
    float la = lane < 32 ? p.lam_q1[l * 32 + lane] * p.lam_k1[l * 32 + lane] : 0.f;
    float lb = lane < 32 ? p.lam_q2[l * 32 + lane] * p.lam_k2[l * 32 + lane] : 0.f;
    la = wave_sum(la); lb = wave_sum(lb);
    const float lam_init = 0.8f - 0.6f * expf(-0.3f * (float)l);
    const float lam = expf(la) - expf(lb) + lam_init;
    const bf16_t* PR = p.PROJ;
    const int nunits = (nrows == R) ? 256 + 16 : 256;
    const int skey = 8 * wid + (lane & 7), schunk = lane >> 3;
    const int ldsK = schunk * 1024 + skey * 16;
    const int ldsV = 8192 + (schunk >> 2) * 4096 + (skey >> 3) * 512 + (skey & 7) * 64 + (schunk & 3) * 16;
    const int vb = ((lane >> 4) & 1) * 32 + (lane & 3) * 8 + (4 * hi + ((lane & 15) >> 2)) * 64;
    const unsigned lds0 = (unsigned)(uintptr_t)lds;
    int cj = 0;
    CvT cvc; bool cvok;
    __syncthreads();
    cvok = cv_decode(p, l, 0, cvc);
    if (cvok) cv_dma(cvc, lds0 + CV_LDS, wid, lane);
    for (int uu = blockIdx.x; uu < nunits; uu += gridDim.x) {
        int b, h, q0, nt; bool isctx;
        if (uu < 256) { const int u = (uu & 7) * 32 + (uu >> 3); b = u >> 6; h = (u >> 4) & 3; q0 = b * 4096 + (u & 15) * 256; nt = 68; isctx = false; }
        else { const int v = uu - 256; b = v >> 2; h = v & 3; q0 = T + b * 256; nt = 4; isctx = true; }
        bf16x8 qf[4];
        {
            const bf16_t* qp = PR + (size_t)(q0 + wid * 32 + r32) * PW + h * 64 + hi * 8;
#pragma unroll
            for (int ks = 0; ks < 4; ++ks) qf[ks] = *(const bf16x8*)(qp + ks * 16);
        }
        f32x16 O00, O01, O10, O11, zero16;
#pragma unroll
        for (int r = 0; r < 16; ++r) { O00[r] = 0.f; O01[r] = 0.f; O10[r] = 0.f; O11[r] = 0.f; zero16[r] = 0.f; }
        float m1 = 0.f, m2 = 0.f, l1 = 0.f, l2 = 0.f;
        const size_t gK = 256 + h * 64 + schunk * 8, gV = 512 + h * 64 + schunk * 8;
        uint4 rk, rv;
        {
            const int kr = (isctx ? T + b * 256 : b * 4096) + skey;
            rk = *(const uint4*)(PR + (size_t)kr * PW + gK); rv = *(const uint4*)(PR + (size_t)kr * PW + gV);
        }
        __syncthreads();
        *(uint4*)(lds + ldsK) = rk; *(uint4*)(lds + ldsV) = rv;
        asm volatile("" :: "v"(qf[0]), "v"(qf[1]), "v"(qf[2]), "v"(qf[3]));
        __syncthreads();
#pragma unroll 1
        for (int t = 0; t < nt; ++t) {
            char* buf = lds + (t & 1) * 16384;
            if (t + 1 < nt) {
                const int tn = t + 1;
                const int kr = ((isctx || tn >= 64) ? T + b * 256 + (isctx ? tn : tn - 64) * 64 : b * 4096 + tn * 64) + skey;
                rk = *(const uint4*)(PR + (size_t)kr * PW + gK); rv = *(const uint4*)(PR + (size_t)kr * PW + gV);
            }
            {
                typedef const __attribute__((address_space(3))) bf16x8* kfp_t;
                const lds_cptr kp = (lds_cptr)buf + hi * 1024 + r32 * 16;
                const lds_cptr vp = (lds_cptr)buf + 8192 + vb;
                bf16x8 kf0 = *(kfp_t)(kp), kf1 = *(kfp_t)(kp + 2048), kf2 = *(kfp_t)(kp + 4096), kf3 = *(kfp_t)(kp + 6144);
#pragma unroll
                for (int kb = 0; kb < 2; ++kb) {
                    f32x16 s1 = __builtin_amdgcn_mfma_f32_32x32x16_bf16(kf0, qf[0], zero16, 0, 0, 0);
                    f32x16 s2 = __builtin_amdgcn_mfma_f32_32x32x16_bf16(kf2, qf[2], zero16, 0, 0, 0);
                    s1 = __builtin_amdgcn_mfma_f32_32x32x16_bf16(kf1, qf[1], s1, 0, 0, 0);
                    s2 = __builtin_amdgcn_mfma_f32_32x32x16_bf16(kf3, qf[3], s2, 0, 0, 0);
                    s16x4 vlo[4], vhi[4];
#pragma unroll
                    for (int i = 0; i < 4; ++i) { vlo[i] = vtr(vp + kb * 2048 + (i >> 1) * 4096 + (i & 1) * 1024); vhi[i] = vtr(vp + kb * 2048 + (i >> 1) * 4096 + (i & 1) * 1024 + 512); }
                    if (kb == 0) { kf0 = *(kfp_t)(kp + 512); kf1 = *(kfp_t)(kp + 512 + 2048); kf2 = *(kfp_t)(kp + 512 + 4096); kf3 = *(kfp_t)(kp + 512 + 6144); }
                    __builtin_amdgcn_sched_barrier(0);
                    const bool first = (t == 0) && (kb == 0);
                    bf16x8 p1a, p1b, p2a, p2b;
                    dsoftmax2<8>(s1, m1, l1, O00, O01, p1a, p1b, first);
                    dsoftmax2<8>(s2, m2, l2, O10, O11, p2a, p2b, first);
#pragma unroll
                    for (int i = 0; i < 4; ++i) {
                        const bf16x8 va = (bf16x8){vlo[i][0], vlo[i][1], vlo[i][2], vlo[i][3], vhi[i][0], vhi[i][1], vhi[i][2], vhi[i][3]};
                        if (i < 2) { O00 = __builtin_amdgcn_mfma_f32_32x32x16_bf16(va, (i & 1) ? p1b : p1a, O00, 0, 0, 0); O10 = __builtin_amdgcn_mfma_f32_32x32x16_bf16(va, (i & 1) ? p2b : p2a, O10, 0, 0, 0); }
                        else       { O01 = __builtin_amdgcn_mfma_f32_32x32x16_bf16(va, (i & 1) ? p1b : p1a, O01, 0, 0, 0); O11 = __builtin_amdgcn_mfma_f32_32x32x16_bf16(va, (i & 1) ? p2b : p2a, O11, 0, 0, 0); }
                    }
                }
            }
            asm volatile("s_waitcnt vmcnt(0)" ::: "memory");
            if (t + 1 < nt) { char* nb = lds + ((t + 1) & 1) * 16384; *(uint4*)(nb + ldsK) = rk; *(uint4*)(nb + ldsV) = rv; }
            __syncthreads();
            if (cvok) {
                cv_store(cvc, lds + CV_LDS + (cj & 1) * 32768, wid, lane);
                ++cj; cvok = cv_decode(p, l, cj, cvc);
                if (cvok) cv_dma(cvc, lds0 + CV_LDS + (cj & 1) * 32768, wid, lane);
            }
        }
        l1 = xhalf_sum(l1); l2 = xhalf_sum(l2);
        const float i1 = 1.f / l1, i2 = lam / l2;
        float ss = 0.f;
#pragma unroll
        for (int r = 0; r < 16; ++r) { O00[r] = O00[r] * i1 - O10[r] * i2; O01[r] = O01[r] * i1 - O11[r] * i2; ss += O00[r] * O00[r] + O01[r] * O01[r]; }
        ss = xhalf_sum(ss);
        const float rstd = rsqrtf(ss * (1.f / 64.f) + EPS) * (1.f - lam_init);
        const float* gs = p.g_sub + l * 64;
        bf16_t* op = p.MIX + (size_t)(q0 + wid * 32 + r32) * D + h * 64;
#pragma unroll
        for (int g4 = 0; g4 < 4; ++g4) {
            const int d = 8 * g4 + 4 * hi;
            const float4 ga = *(const float4*)(gs + d), gb = *(const float4*)(gs + 32 + d);
            uint2 wa, wb;
            wa.x = cvtpk(O00[4 * g4] * rstd * ga.x, O00[4 * g4 + 1] * rstd * ga.y); wa.y = cvtpk(O00[4 * g4 + 2] * rstd * ga.z, O00[4 * g4 + 3] * rstd * ga.w);
            wb.x = cvtpk(O01[4 * g4] * rstd * gb.x, O01[4 * g4 + 1] * rstd * gb.y); wb.y = cvtpk(O01[4 * g4 + 2] * rstd * gb.z, O01[4 * g4 + 3] * rstd * gb.w);
            *(uint2*)(op + d) = wa; *(uint2*)(op + 32 + d) = wb;
        }
    }
    while (cvok) {
        asm volatile("s_waitcnt vmcnt(0)" ::: "memory");
        __syncthreads();
        cv_store(cvc, lds + CV_LDS + (cj & 1) * 32768, wid, lane);
        ++cj; cvok = cv_decode(p, l, cj, cvc);
        if (cvok) cv_dma(cvc, lds0 + CV_LDS + (cj & 1) * 32768, wid, lane);
    }
}

__device__ __forceinline__ void ph_na(const P& p, int l, int nrows, char* lds, const int wv) {
    const int tid = ltid(wv), lane = tid & 63, wid = tid >> 6, r32 = lane & 31, hi = lane >> 5;
    const bf16_t* PR = p.PROJ;
    const int nunits = (nrows == R) ? 256 + 16 : 256;
    const int skey = 8 * wid + (lane & 7), schunk = lane >> 3;
    const int ldsK = schunk * 1024 + skey * 16;
    const int ldsV = 8192 + (schunk >> 2) * 4096 + (skey >> 3) * 512 + (skey & 7) * 64 + (schunk & 3) * 16;
    const int vb = ((lane >> 4) & 1) * 32 + (lane & 3) * 8 + (4 * hi + ((lane & 15) >> 2)) * 64;
    float* btab = (float*)(lds + 32768);
    constexpr float LOG2E = 1.4426950408889634f;
    for (int uu = (blockIdx.x + gridDim.x - 16) % gridDim.x; uu < nunits; uu += gridDim.x) {
        int b, h, q0, kr_lo, nlat, rs = 0, rq = 0; bool isctx;
        if (uu < 256) {
            const int u = (uu & 7) * 32 + (uu >> 3); b = u >> 6; h = (u >> 4) & 3; const int rg = u & 15;
            rq = 4 * rg + (wid >> 1); q0 = b * 4096 + rq * 64 + (wid & 1) * 32;
            kr_lo = min(max(4 * rg - 4, 0), 56); const int kr_hi = min(max(4 * rg - 1, 0), 56) + 7; nlat = kr_hi - kr_lo + 1;
            rs = min(max(rq - 4, 0), 56); isctx = false;
        } else { const int v = uu - 256; b = v >> 2; h = v & 3; q0 = T + b * 256 + wid * 32; kr_lo = 0; nlat = 0; isctx = true; }
        const int nt = nlat + 4;
        const int cq = (wid & 1) * 32 + r32, wsc = min(max(cq - 8, 0), 48);
        bf16x8 qf[4];
        {
            const bf16_t* qp = PR + (size_t)(q0 + r32) * PW + 1536 + h * 64 + hi * 8;
#pragma unroll
            for (int ks = 0; ks < 4; ++ks) qf[ks] = *(const bf16x8*)(qp + ks * 16);
        }
        f32x16 O0, O1;
#pragma unroll
        for (int r = 0; r < 16; ++r) { O0[r] = 0.f; O1[r] = 0.f; }
        float m1 = -1e30f, l1 = 0.f;
        const size_t gK = 1792 + h * 64 + schunk * 8, gV = 2048 + h * 64 + schunk * 8;
        uint4 rk, rv;
        {
            const int kr = (nlat ? b * 4096 + kr_lo * 64 : T + b * 256) + skey;
            rk = *(const uint4*)(PR + (size_t)kr * PW + gK); rv = *(const uint4*)(PR + (size_t)kr * PW + gV);
        }
        __syncthreads();
        *(uint4*)(lds + ldsK) = rk; *(uint4*)(lds + ldsV) = rv;
        if (tid < 465) btab[tid] = p.rpb[((size_t)l * 4 + h) * 465 + tid] * LOG2E;
        __syncthreads();
        for (int t = 0; t < nt; ++t) {
            char* buf = lds + (t & 1) * 16384;
            if (t + 1 < nt) {
                const int tn = t + 1;
                const int kr = (tn < nlat ? b * 4096 + (kr_lo + tn) * 64 : T + b * 256 + (tn - nlat) * 64) + skey;
                rk = *(const uint4*)(PR + (size_t)kr * PW + gK); rv = *(const uint4*)(PR + (size_t)kr * PW + gV);
            }
            const bool lat = t < nlat;
            const int krow = kr_lo + t;
            const bool active = !lat || (krow >= rs && krow <= rs + 7);
            if (active) {
                const float* brow = btab + (krow - rq + 7) * 31 + 15 - cq;
#pragma unroll
                for (int kb = 0; kb < 2; ++kb) {
                    const lds_cptr kp = (lds_cptr)buf + hi * 1024 + (kb * 32 + r32) * 16;
                    f32x16 s1;
#pragma unroll
                    for (int r = 0; r < 16; ++r) s1[r] = 0.f;
#pragma unroll
                    for (int ks = 0; ks < 4; ++ks) {
                        const bf16x8 kf = *(const __attribute__((address_space(3))) bf16x8*)(kp + ks * 2048);
                        s1 = __builtin_amdgcn_mfma_f32_32x32x16_bf16(kf, qf[ks], s1, 0, 0, 0);
                    }
                    if (lat) {
#pragma unroll
                        for (int r = 0; r < 16; ++r) {
                            const int kc = 32 * kb + (r & 3) + 8 * (r >> 2) + 4 * hi;
                            const bool ok = (unsigned)(kc - wsc) < 16u;
                            const float bv = brow[ok ? kc : cq];
                            s1[r] = ok ? s1[r] + bv : -INFINITY;
                        }
                    }
                    bf16x8 pa, pb;
                    dsoftmax2<8>(s1, m1, l1, O0, O1, pa, pb, false);
                    const lds_cptr vp = (lds_cptr)buf + 8192 + vb + kb * 2048;
#pragma unroll
                    for (int ss = 0; ss < 2; ++ss) {
                        const s16x4 lo0 = vtr(vp + ss * 1024), hh0 = vtr(vp + ss * 1024 + 512);
                        const s16x4 lo1 = vtr(vp + 4096 + ss * 1024), hh1 = vtr(vp + 4096 + ss * 1024 + 512);
                        const bf16x8 va0 = (bf16x8){lo0[0], lo0[1], lo0[2], lo0[3], hh0[0], hh0[1], hh0[2], hh0[3]};
                        const bf16x8 va1 = (bf16x8){lo1[0], lo1[1], lo1[2], lo1[3], hh1[0], hh1[1], hh1[2], hh1[3]};
                        O0 = __builtin_amdgcn_mfma_f32_32x32x16_bf16(va0, ss ? pb : pa, O0, 0, 0, 0);
                        O1 = __builtin_amdgcn_mfma_f32_32x32x16_bf16(va1, ss ? pb : pa, O1, 0, 0, 0);
                    }
                }
            }
            if (t + 1 < nt) { char* nb = lds + ((t + 1) & 1) * 16384; *(uint4*)(nb + ldsK) = rk; *(uint4*)(nb + ldsV) = rv; }
            __syncthreads();
        }
        l1 = xhalf_sum(l1);
        const float il = 1.f / l1;
        bf16_t* op = p.MIX + (size_t)(q0 + r32) * D + 768 + h * 64;
#pragma unroll
        for (int g4 = 0; g4 < 4; ++g4) {
            const int d = 8 * g4 + 4 * hi;
            uint2 wa, wb;
            wa.x = cvtpk(O0[4 * g4] * il, O0[4 * g4 + 1] * il); wa.y = cvtpk(O0[4 * g4 + 2] * il, O0[4 * g4 + 3] * il);
            wb.x = cvtpk(O1[4 * g4] * il, O1[4 * g4 + 1] * il); wb.y = cvtpk(O1[4 * g4 + 2] * il, O1[4 * g4 + 3] * il);
            *(uint2*)(op + d) = wa; *(uint2*)(op + 32 + d) = wb;
        }
    }
}

__device__ __forceinline__ void ph_pool(const P& p, int l, int nrows, char* lds, const int wv) {
    const int tid = ltid(wv), lane = tid & 63, wid = tid >> 6, fr = lane & 15, fq = lane >> 4;
    float* ysh = (float*)lds;
    bf16_t* dsh = (bf16_t*)(lds + 80 * 256 * 4);
    const bf16_t* PR = p.PROJ;
    for (int it = (blockIdx.x + gridDim.x - 32) % gridDim.x; it < nrows / 64; it += gridDim.x) {
        const int row0 = it * 64;
        const int L = row0 < T ? 4096 : 256;
        const int t0 = row0 < T ? (row0 & 4095) : ((row0 - T) & 255);
        const int base = row0 - t0;
        __syncthreads();
        for (int c = tid; c < 80 * 32; c += NT) {
            const int rr = c >> 5, ch = (c & 31) * 8, t = t0 - 8 + rr;
            float4 a = make_float4(0.f, 0.f, 0.f, 0.f), b = a;
            if (t >= 0 && t < L) {
                const uint4 raw = *(const uint4*)(PR + (size_t)(base + t) * PW + 768 + ch);
                a = make_float4(__uint_as_float(raw.x << 16), __uint_as_float(raw.x & 0xffff0000u), __uint_as_float(raw.y << 16), __uint_as_float(raw.y & 0xffff0000u));
                b = make_float4(__uint_as_float(raw.z << 16), __uint_as_float(raw.z & 0xffff0000u), __uint_as_float(raw.w << 16), __uint_as_float(raw.w & 0xffff0000u));
            }
            *(float4*)(ysh + rr * 256 + ch) = a; *(float4*)(ysh + rr * 256 + ch + 4) = b;
        }
        __syncthreads();
        {
            const int r = tid >> 3, cg = tid & 7;
            const int g = cg >> 1, w = 2 << g, t = t0 + r;
            const int lo = max(t - w / 2, 0), hi = min(t + w / 2 - 1, L - 1);
            const float inv = 1.f / (float)(hi - lo + 1);
#pragma unroll
            for (int q = 0; q < 8; ++q) {
                const int ch = cg * 32 + q * 4;
                float4 s = make_float4(0.f, 0.f, 0.f, 0.f);
                for (int tt = lo; tt <= hi; ++tt) { const float4 v = *(const float4*)(ysh + (tt - t0 + 8) * 256 + ch); s.x += v.x; s.y += v.y; s.z += v.z; s.w += v.w; }
                const float4 y = *(const float4*)(ysh + (r + 8) * 256 + ch);
                uint2 o; o.x = cvtpk(s.x * inv - y.x, s.y * inv - y.y); o.y = cvtpk(s.z * inv - y.z, s.w * inv - y.w);
                *(uint2*)(dsh + r * 264 + ch) = o;
            }
        }
        __syncthreads();
        {
            const int g = wid >> 1, mb = (wid & 1) * 2;
            const bf16_t* W = p.WpT + ((size_t)l * 4 + g) * 64 * 64;
            f32x4 acc[2][4];
#pragma unroll
            for (int mt = 0; mt < 2; ++mt)
#pragma unroll
                for (int nt = 0; nt < 4; ++nt) acc[mt][nt] = (f32x4){0.f, 0.f, 0.f, 0.f};
#pragma unroll
            for (int ks = 0; ks < 2; ++ks) {
                bf16x8 af[2], bfr[4];
#pragma unroll
                for (int mt = 0; mt < 2; ++mt) af[mt] = *(const bf16x8*)(dsh + ((mb + mt) * 16 + fr) * 264 + g * 64 + ks * 32 + fq * 8);
#pragma unroll
                for (int nt = 0; nt < 4; ++nt) bfr[nt] = *(const bf16x8*)(W + (nt * 16 + fr) * 64 + ks * 32 + fq * 8);
#pragma unroll
                for (int mt = 0; mt < 2; ++mt)
#pragma unroll
                    for (int nt = 0; nt < 4; ++nt) acc[mt][nt] = __builtin_amdgcn_mfma_f32_16x16x32_bf16(bfr[nt], af[mt], acc[mt][nt], 0, 0, 0);
            }
#pragma unroll
            for (int mt = 0; mt < 2; ++mt)
#pragma unroll
                for (int nt = 0; nt < 4; ++nt) {
                    const int row = row0 + (mb + mt) * 16 + fr, j = g * 64 + nt * 16 + fq * 4;
                    const float4 sp = *(const float4*)(p.s_pool + l * 256 + j);
                    uint2 o; o.x = cvtpk(acc[mt][nt][0] * sp.x, acc[mt][nt][1] * sp.y); o.y = cvtpk(acc[mt][nt][2] * sp.z, acc[mt][nt][3] * sp.w);
                    *(uint2*)(p.MIX + (size_t)row * D + 256 + j) = o;
                }
        }
    }
}

__device__ __forceinline__ float gelu_fast(float x) {
    const float u = 0.7978845608028654f * (x + 0.044715f * x * x * x);
    return x / (1.f + __builtin_amdgcn_exp2f(-2.885390081777927f * u));
}
__device__ __forceinline__ void ph_sgu(const P& p, int l, int nrows, char* lds, const int wv) {
    const int tid = ltid(wv), lane = tid & 63, wid = tid >> 6, fr = lane & 15, fq = lane >> 4;
    bf16_t* vnT = (bf16_t*)lds;
    float* rstd = (float*)(lds + 128 * 136 * 2);
    const bf16_t* PR = p.PROJ;
    for (int it = (blockIdx.x + gridDim.x - 48) % gridDim.x; it < (nrows / 128) * 2; it += gridDim.x) {
        const int chunk = it >> 1, hp = it & 1, row0 = chunk * 128;
        __syncthreads();
        {
            const int t = tid >> 2, qtr = tid & 3;
            const bf16_t* zp = PR + (size_t)(row0 + t) * PW + 1280 + qtr * 64;
            float ss = 0.f;
#pragma unroll
            for (int i = 0; i < 8; ++i) {
                const uint4 raw = *(const uint4*)(zp + i * 8);
                const unsigned w4[4] = {raw.x, raw.y, raw.z, raw.w};
#pragma unroll
                for (int j = 0; j < 4; ++j) { const float a = __uint_as_float(w4[j] << 16), b = __uint_as_float(w4[j] & 0xffff0000u); ss += a * a + b * b; }
            }
            ss += __shfl_xor(ss, 1); ss += __shfl_xor(ss, 2);
            if (qtr == 0) rstd[t] = rsqrtf(ss * (1.f / 256.f) + EPS);
        }
        __syncthreads();
        {
            const int s = tid >> 2, cb = (tid & 3) * 32;
            const bf16_t* zp = PR + (size_t)(row0 + s) * PW + 1280 + hp * 128 + cb;
            const float rs = rstd[s];
            const float* gg = p.g_sgu + l * 256 + hp * 128 + cb;
#pragma unroll
            for (int i = 0; i < 4; ++i) {
                const uint4 raw = *(const uint4*)(zp + i * 8);
                const unsigned w4[4] = {raw.x, raw.y, raw.z, raw.w};
#pragma unroll
                for (int j = 0; j < 4; ++j) {
                    const int c = cb + i * 8 + j * 2;
                    vnT[c * 136 + s] = f2bf(__uint_as_float(w4[j] << 16) * rs * gg[i * 8 + j * 2]);
                    vnT[(c + 1) * 136 + s] = f2bf(__uint_as_float(w4[j] & 0xffff0000u) * rs * gg[i * 8 + j * 2 + 1]);
                }
            }
        }
        __syncthreads();
        {
            const int hl = wid >> 2, g = hp * 2 + hl, mb = (wid & 3) * 2;
            const bf16_t* Wg = p.WsB + ((size_t)l * 4 + g) * 128 * 128;
            f32x4 acc[2][4];
#pragma unroll
            for (int mt = 0; mt < 2; ++mt)
#pragma unroll
                for (int nt = 0; nt < 4; ++nt) acc[mt][nt] = (f32x4){0.f, 0.f, 0.f, 0.f};
#pragma unroll
            for (int ks = 0; ks < 4; ++ks) {
                bf16x8 af[2], bfr[4];
#pragma unroll
                for (int mt = 0; mt < 2; ++mt) af[mt] = *(const bf16x8*)(Wg + ((mb + mt) * 16 + fr) * 128 + ks * 32 + fq * 8);
#pragma unroll
                for (int nt = 0; nt < 4; ++nt) bfr[nt] = *(const bf16x8*)(vnT + (hl * 64 + nt * 16 + fr) * 136 + ks * 32 + fq * 8);
#pragma unroll
                for (int mt = 0; mt < 2; ++mt)
#pragma unroll
                    for (int nt = 0; nt < 4; ++nt) acc[mt][nt] = __builtin_amdgcn_mfma_f32_16x16x32_bf16(bfr[nt], af[mt], acc[mt][nt], 0, 0, 0);
            }
#pragma unroll
            for (int mt = 0; mt < 2; ++mt) {
                const int t = (mb + mt) * 16 + fr;
                const float bias = p.b_sgu[(l * 4 + g) * 128 + t];
#pragma unroll
                for (int nt = 0; nt < 4; ++nt) {
                    const int c = g * 64 + nt * 16 + fq * 4;
                    const uint2 ur = *(const uint2*)(PR + (size_t)(row0 + t) * PW + 1024 + c);
                    const float u0 = __uint_as_float(ur.x << 16), u1 = __uint_as_float(ur.x & 0xffff0000u);
                    const float u2 = __uint_as_float(ur.y << 16), u3 = __uint_as_float(ur.y & 0xffff0000u);
                    uint2 o; o.x = cvtpk(u0 * (acc[mt][nt][0] + bias), u1 * (acc[mt][nt][1] + bias)); o.y = cvtpk(u2 * (acc[mt][nt][2] + bias), u3 * (acc[mt][nt][3] + bias));
                    *(uint2*)(p.MIX + (size_t)(row0 + t) * D + 512 + c) = o;
                }
            }
        }
    }
}

__device__ __forceinline__ void ph_router(const P& p, int l, int nrows, char* lds, const int wv) {
    const int tid = ltid(wv), wave = tid >> 6, lane = tid & 63;
    float* wl = (float*)lds;
    float* wsc = (float*)(lds + 1024 * 36 * 4) + wave * 64;
    int* lcnt = (int*)(lds + 1024 * 36 * 4 + 8 * 64 * 4);
    __syncthreads();
    {
        const float* wr = p.w_router + (size_t)l * D * NE;
        float4 t[16];
#pragma unroll
        for (int i = 0; i < 16; ++i) t[i] = *(const float4*)(wr + (size_t)(tid + NT * i) * 4);
#pragma unroll
        for (int i = 0; i < 16; ++i) { const int idx = (tid + NT * i) * 4, k = idx >> 5, e = idx & 31; *(float4*)(wl + ((k & 3) * 256 + (k >> 2)) * 36 + e) = t[i]; }
        if (tid < 32) lcnt[tid] = 0;
    }
    __syncthreads();
    const float* g = p.g_ffn + l * D;
    const float brt = p.b_router[l * NE + (lane & 31)];
    for (int pr = blockIdx.x * 8 + wave; pr < nrows / 2; pr += gridDim.x * 8) {
        const int ra = 2 * pr;
        const bf16_t* xa = p.X + (size_t)ra * D; const bf16_t* xb = xa + D;
        float ha[16], hb[16]; float sa = 0.f, sb = 0.f;
#pragma unroll
        for (int i = 0; i < 4; ++i) {
            const uint2 ua = *(const uint2*)(xa + 4 * (lane + 64 * i)), ub = *(const uint2*)(xb + 4 * (lane + 64 * i));
            const float4 va = make_float4(__uint_as_float(ua.x << 16), __uint_as_float(ua.x & 0xffff0000u), __uint_as_float(ua.y << 16), __uint_as_float(ua.y & 0xffff0000u));
            const float4 vb = make_float4(__uint_as_float(ub.x << 16), __uint_as_float(ub.x & 0xffff0000u), __uint_as_float(ub.y << 16), __uint_as_float(ub.y & 0xffff0000u));
            ha[4 * i] = va.x; ha[4 * i + 1] = va.y; ha[4 * i + 2] = va.z; ha[4 * i + 3] = va.w; hb[4 * i] = vb.x; hb[4 * i + 1] = vb.y; hb[4 * i + 2] = vb.z; hb[4 * i + 3] = vb.w;
            sa += va.x * va.x + va.y * va.y + va.z * va.z + va.w * va.w; sb += vb.x * vb.x + vb.y * vb.y + vb.z * vb.z + vb.w * vb.w;
        }
        sa = wave_sum(sa); sb = wave_sum(sb);
        const float rsa = rsqrtf(sa * (1.f / D) + EPS), rsb = rsqrtf(sb * (1.f / D) + EPS);
        const float* m = p.mod + ((size_t)l * 5 + mod_row(ra)) * 6144;
#pragma unroll
        for (int i = 0; i < 4; ++i) {
            const int k = 4 * (lane + 64 * i);
            const float4 gg = *(const float4*)(g + k), sc = *(const float4*)(m + 4 * 1024 + k), sh = *(const float4*)(m + 3 * 1024 + k);
            const float gs[4] = {gg.x * (1.f + sc.x), gg.y * (1.f + sc.y), gg.z * (1.f + sc.z), gg.w * (1.f + sc.w)}, s4[4] = {sh.x, sh.y, sh.z, sh.w};
#pragma unroll
            for (int j = 0; j < 4; ++j) { ha[4 * i + j] = ha[4 * i + j] * rsa * gs[j] + s4[j]; hb[4 * i + j] = hb[4 * i + j] * rsb * gs[j] + s4[j]; }
            uint2 oa, ob; oa.x = cvtpk(ha[4 * i], ha[4 * i + 1]); oa.y = cvtpk(ha[4 * i + 2], ha[4 * i + 3]); ob.x = cvtpk(hb[4 * i], hb[4 * i + 1]); ob.y = cvtpk(hb[4 * i + 2], hb[4 * i + 3]);
            *(uint2*)(p.H + (size_t)ra * D + k) = oa; *(uint2*)(p.H + (size_t)(ra + 1) * D + k) = ob;
        }
        float la[32], lb[32];
#pragma unroll
        for (int e = 0; e < 32; ++e) { la[e] = 0.f; lb[e] = 0.f; }
#pragma unroll
        for (int i = 0; i < 4; ++i)
#pragma unroll
            for (int j = 0; j < 4; ++j) {
                const float* wk = wl + (j * 256 + lane + 64 * i) * 36;
                const float xv = ha[4 * i + j], yv = hb[4 * i + j];
#pragma unroll
                for (int e = 0; e < 32; e += 4) {
                    const float4 w = *(const float4*)(wk + e);
                    la[e] += xv * w.x; la[e + 1] += xv * w.y; la[e + 2] += xv * w.z; la[e + 3] += xv * w.w;
                    lb[e] += yv * w.x; lb[e + 1] += yv * w.y; lb[e + 2] += yv * w.z; lb[e + 3] += yv * w.w;
                }
                if (j == 3) __builtin_amdgcn_sched_barrier(0);
            }
        float r32v[32];
        {
            const bool up = lane >= 32;
#pragma unroll
            for (int e = 0; e < 32; ++e) { const float keep = up ? lb[e] : la[e], send = up ? la[e] : lb[e]; r32v[e] = keep + __shfl_xor(send, 32); }
        }
        float r16[16], r8[8], r4[4], r2[2];
        { const bool up = (lane & 16) != 0;
#pragma unroll
          for (int e = 0; e < 16; ++e) { const float keep = up ? r32v[e + 16] : r32v[e], send = up ? r32v[e] : r32v[e + 16]; r16[e] = keep + __shfl_xor(send, 16); } }
        { const bool up = (lane & 8) != 0;
#pragma unroll
          for (int e = 0; e < 8; ++e) { const float keep = up ? r16[e + 8] : r16[e], send = up ? r16[e] : r16[e + 8]; r8[e] = keep + __shfl_xor(send, 8); } }
        { const bool up = (lane & 4) != 0;
#pragma unroll
          for (int e = 0; e < 4; ++e) { const float keep = up ? r8[e + 4] : r8[e], send = up ? r8[e] : r8[e + 4]; r4[e] = keep + __shfl_xor(send, 4); } }
        { const bool up = (lane & 2) != 0;
#pragma unroll
          for (int e = 0; e < 2; ++e) { const float keep = up ? r4[e + 2] : r4[e], send = up ? r4[e] : r4[e + 2]; r2[e] = keep + __shfl_xor(send, 2); } }
        float mine;
        { const bool up = (lane & 1) != 0; const float keep = up ? r2[1] : r2[0], send = up ? r2[0] : r2[1]; mine = keep + __shfl_xor(send, 1); }
        wsc[lane] = mine + brt;
        float lg[32];
        {
            const float* wp = wsc + (lane & 32);
#pragma unroll
            for (int e = 0; e < 32; e += 4) { const float4 v = *(const float4*)(wp + e); lg[e] = v.x; lg[e + 1] = v.y; lg[e + 2] = v.z; lg[e + 3] = v.w; }
        }
        unsigned taken = 0u; float tv[4]; int ti[4];
#pragma unroll
        for (int k = 0; k < 4; ++k) {
            float best = -3.0e38f; int bi = 0;
#pragma unroll
            for (int e = 0; e < 32; ++e) { const bool ok = !((taken >> e) & 1u) && (lg[e] > best); best = ok ? lg[e] : best; bi = ok ? e : bi; }
            taken |= 1u << bi; tv[k] = best; ti[k] = bi;
        }
        const float e1 = __expf(tv[1] - tv[0]), e2 = __expf(tv[2] - tv[0]), e3 = __expf(tv[3] - tv[0]);
        const float inv = 1.f / (1.f + e1 + e2 + e3);
        if ((lane & 31) == 0) {
            const int row = ra + (lane >> 5);
            *(int4*)(p.topi + (size_t)row * 4) = make_int4(ti[0], ti[1], ti[2], ti[3]);
            *(float4*)(p.topg + (size_t)row * 4) = make_float4(inv, e1 * inv, e2 * inv, e3 * inv);
            atomicAdd(&lcnt[ti[0]], 1); atomicAdd(&lcnt[ti[1]], 1); atomicAdd(&lcnt[ti[2]], 1); atomicAdd(&lcnt[ti[3]], 1);
        }
    }
    __syncthreads();
    if (tid < 32 && lcnt[tid]) atomicAdd(&p.cnt[l * 64 + tid], lcnt[tid]);
}
__device__ __forceinline__ void ph_assign(const P& p, int l, int nrows, char* lds, const int wv) {
    int* lcnt = (int*)lds; int* lbase = lcnt + 32; int* pst = lbase + 32; int* slots = pst + 32;
    const int tid = ltid(wv), wave = tid >> 6, lane = tid & 63;
    int* cnt = p.cnt + l * 64; int* cursor = cnt + 32;
    int* meta = p.moe_meta + l * 512;
    __syncthreads();
    if (tid == 0) { int a = 0; for (int e = 0; e < 32; ++e) { pst[e] = a; a += (cnt[e] + 255) & ~255; } if (blockIdx.x == 0) meta[0] = a >> 8; }
    __syncthreads();
    if (blockIdx.x == 0 && tid < 320) { int e = 0; for (int k = 1; k < 32; ++k) if (tid * 256 >= pst[k]) e = k; meta[1 + tid] = e; }
    const int blk0 = (blockIdx.x + gridDim.x - 64) % gridDim.x;
    for (int it = blk0; it < nrows / 64; it += gridDim.x) {
        __syncthreads();
        if (tid < 32) lcnt[tid] = 0;
        __syncthreads();
        if (wave == 0) {
            const int row = it * 64 + lane;
            const int4 ti = *(const int4*)(p.topi + (size_t)row * 4);
            const int r0 = atomicAdd(&lcnt[ti.x], 1), r1 = atomicAdd(&lcnt[ti.y], 1), r2 = atomicAdd(&lcnt[ti.z], 1), r3 = atomicAdd(&lcnt[ti.w], 1);
            __builtin_amdgcn_s_waitcnt(0xc07f);
            if (lane < 32) lbase[lane] = pst[lane] + (lcnt[lane] ? atomicAdd(&cursor[lane], lcnt[lane]) : 0);
            __builtin_amdgcn_s_waitcnt(0xc07f);
            const int4 sl = make_int4(lbase[ti.x] + r0, lbase[ti.y] + r1, lbase[ti.z] + r2, lbase[ti.w] + r3);
            *(int4*)(p.tok_slot + (size_t)row * 4) = sl;
            *(int4*)(slots + lane * 4) = sl;
        }
        __syncthreads();
        {
            const bf16_t* __restrict__ Hs = p.H; unsigned char* __restrict__ HSd = p.HS;
#define AS_LD(rr, A, B) const uint4 A = *(const uint4*)(Hs + (size_t)(it * 64 + wave * 8 + (rr)) * D + lane * 8), B = *(const uint4*)(Hs + (size_t)(it * 64 + wave * 8 + (rr)) * D + lane * 8 + 512)
#define AS_CV(V) make_uint2(__builtin_amdgcn_cvt_pk_fp8_f32(__uint_as_float(V.y << 16), __uint_as_float(V.y & 0xffff0000u), __builtin_amdgcn_cvt_pk_fp8_f32(__uint_as_float(V.x << 16), __uint_as_float(V.x & 0xffff0000u), 0u, false), true), \
                            __builtin_amdgcn_cvt_pk_fp8_f32(__uint_as_float(V.w << 16), __uint_as_float(V.w & 0xffff0000u), __builtin_amdgcn_cvt_pk_fp8_f32(__uint_as_float(V.z << 16), __uint_as_float(V.z & 0xffff0000u), 0u, false), true))
#define AS_ST(rr, A, B) do { const int4 s4 = *(const int4*)(slots + (wave * 8 + (rr)) * 4); const uint2 fa = AS_CV(A), fb = AS_CV(B); \
            unsigned char* d0 = HSd + (size_t)s4.x * D + lane * 8; *(uint2*)d0 = fa; *(uint2*)(d0 + 512) = fb; \
            unsigned char* d1 = HSd + (size_t)s4.y * D + lane * 8; *(uint2*)d1 = fa; *(uint2*)(d1 + 512) = fb; \
            unsigned char* d2 = HSd + (size_t)s4.z * D + lane * 8; *(uint2*)d2 = fa; *(uint2*)(d2 + 512) = fb; \
            unsigned char* d3 = HSd + (size_t)s4.w * D + lane * 8; *(uint2*)d3 = fa; *(uint2*)(d3 + 512) = fb; } while (0)
            AS_LD(0, a0, b0); AS_LD(1, a1, b1); AS_LD(2, a2, b2); AS_LD(3, a3, b3); AS_LD(4, a4, b4); AS_LD(5, a5, b5); AS_LD(6, a6, b6); AS_LD(7, a7, b7);
            AS_ST(0, a0, b0); AS_ST(1, a1, b1); AS_ST(2, a2, b2); AS_ST(3, a3, b3); AS_ST(4, a4, b4); AS_ST(5, a5, b5); AS_ST(6, a6, b6); AS_ST(7, a7, b7);
#undef AS_CV
#undef AS_LD
#undef AS_ST
        }
    }
}

struct EpiProj {
    static constexpr bool PERM = true, AFTER_DRAIN = false;
    bf16_t* O; const float* rope;
    __device__ __forceinline__ void operator()(const f32x4 (&acc)[2][2][4][2], const pg8::Unit& u, int wr, int wc, int fr, int fq) const {
        const int row0 = u.pm * 256 + wr * 64 + fr, col0 = u.pn * 256 + wc * 32 + 8 * fq;
        const bool do_rope = (u.pn < 2) && (u.pm < T / 256), do_gelu = (u.pn == 4) || (u.pn == 5);
        const float sc = u.pn == 0 ? QSCALE : (u.pn == 6 ? 0.125f * 1.4426950408889634f : 1.f);
        const float sgn = (fq & 1) ? 1.f : -1.f;
#pragma unroll
        for (int ai = 0; ai < 2; ++ai)
#pragma unroll
            for (int m = 0; m < 4; ++m) {
                const int row = row0 + ai * 128 + m * 16;
                bf16_t* rowp = O + (size_t)row * PW + col0;
                f32x4 cs[4];
                if (do_rope) {
                    const int s = row & 4095, pos = (fq >> 1) ? (s & 63) : (s >> 6);
                    const f32x4* rp = (const f32x4*)(rope + pos * 16);
                    cs[0] = rp[0]; cs[1] = rp[1]; cs[2] = rp[2]; cs[3] = rp[3];
                }
#pragma unroll
                for (int bj = 0; bj < 2; ++bj) {
                    f32x4 v0 = acc[ai][bj][m][0], v1 = acc[ai][bj][m][1];
                    if (do_rope) {
                        f32x4 b0, b1;
#pragma unroll
                        for (int j = 0; j < 4; ++j) { b0[j] = __shfl_xor(v0[j], 16); b1[j] = __shfl_xor(v1[j], 16); }
                        v0[0] = v0[0] * cs[0][0] + sgn * b0[0] * cs[0][1]; v0[1] = v0[1] * cs[0][2] + sgn * b0[1] * cs[0][3];
                        v0[2] = v0[2] * cs[1][0] + sgn * b0[2] * cs[1][1]; v0[3] = v0[3] * cs[1][2] + sgn * b0[3] * cs[1][3];
                        v1[0] = v1[0] * cs[2][0] + sgn * b1[0] * cs[2][1]; v1[1] = v1[1] * cs[2][2] + sgn * b1[1] * cs[2][3];
                        v1[2] = v1[2] * cs[3][0] + sgn * b1[2] * cs[3][1]; v1[3] = v1[3] * cs[3][2] + sgn * b1[3] * cs[3][3];
                    }
                    if (do_gelu) {
#pragma unroll
                        for (int j = 0; j < 4; ++j) { v0[j] = gelu_fast(v0[j]); v1[j] = gelu_fast(v1[j]); }
                    }
                    v0 = v0 * sc; v1 = v1 * sc;
                    u32x4 w; w.x = cvtpk(v0[0], v0[1]); w.y = cvtpk(v0[2], v0[3]); w.z = cvtpk(v1[0], v1[1]); w.w = cvtpk(v1[2], v1[3]);
                    *(u32x4*)(rowp + bj * 128) = w;
                }
            }
    }
};
template <bool RES_F32>
struct EpiOut {
    static constexpr bool PERM = true, AFTER_DRAIN = false;
    bf16_t* X; const float* gate; const float* res_lat; const float* res_ctx;
    __device__ __forceinline__ void operator()(const f32x4 (&acc)[2][2][4][2], const pg8::Unit& u, int wr, int wc, int fr, int fq) const {
        const int row0 = u.pm * 256 + wr * 64 + fr, col0 = u.pn * 256 + wc * 32 + 8 * fq;
        const float* g = gate + (size_t)mod_row(u.pm * 256) * 6144 + col0;
        f32x4 gv[2][2];
#pragma unroll
        for (int bj = 0; bj < 2; ++bj)
#pragma unroll
            for (int n = 0; n < 2; ++n) gv[bj][n] = *(const f32x4*)(g + bj * 128 + n * 4);
#pragma unroll
        for (int ai = 0; ai < 2; ++ai)
#pragma unroll
            for (int m = 0; m < 4; ++m) { const size_t off = (size_t)(row0 + ai * 128 + m * 16) * D + col0;
#pragma unroll
                for (int bj = 0; bj < 2; ++bj) {
                    f32x4 r0, r1;
                    if (RES_F32) { const float* rp = (u.pm < T / 256 ? res_lat : res_ctx) + off + bj * 128; r0 = *(const f32x4*)rp; r1 = *(const f32x4*)(rp + 4); }
                    else { const u32x4 w = *(const u32x4*)(X + off + bj * 128);
                        r0 = (f32x4){__uint_as_float(w.x << 16), __uint_as_float(w.x & 0xffff0000u), __uint_as_float(w.y << 16), __uint_as_float(w.y & 0xffff0000u)};
                        r1 = (f32x4){__uint_as_float(w.z << 16), __uint_as_float(w.z & 0xffff0000u), __uint_as_float(w.w << 16), __uint_as_float(w.w & 0xffff0000u)}; }
                    const f32x4 v0 = r0 + gv[bj][0] * acc[ai][bj][m][0], v1 = r1 + gv[bj][1] * acc[ai][bj][m][1];
                    u32x4 o; o.x = cvtpk(v0[0], v0[1]); o.y = cvtpk(v0[2], v0[3]); o.z = cvtpk(v1[0], v1[1]); o.w = cvtpk(v1[2], v1[3]);
                    *(u32x4*)(X + off + bj * 128) = o; } }
    }
};
__device__ __forceinline__ float swiglu(float g, float u) {
    const float gt = fminf(g, 7.0f), up = fminf(fmaxf(u, -7.0f), 7.0f);
    return (up + 1.0f) * gt * __builtin_amdgcn_rcpf(1.0f + __builtin_amdgcn_exp2f(-1.702f * 1.4426950408889634f * gt));
}
struct EpiAct {
    static constexpr bool PERM = true, AFTER_DRAIN = false;
    unsigned char* ACT; const float* bgu;
    __device__ __forceinline__ void operator()(const f32x4 (&acc)[2][2][4][2], const pg8::Unit& u, int wr, int wc, int fr, int fq) const {
        const int row0 = u.pm * 256 + wr * 64 + fr, j0 = u.pn * 128 + wc * 32 + 8 * fq;
        const float* bp = bgu + (size_t)u.e * 2048 + j0;
        const f32x4 bg0 = *(const f32x4*)(bp), bg1 = *(const f32x4*)(bp + 4), bu0 = *(const f32x4*)(bp + 1024), bu1 = *(const f32x4*)(bp + 1028);
#pragma unroll
        for (int ai = 0; ai < 2; ++ai)
#pragma unroll
            for (int m = 0; m < 4; ++m) {
                const f32x4 g0 = acc[ai][0][m][0] + bg0, g1 = acc[ai][0][m][1] + bg1, u0 = acc[ai][1][m][0] + bu0, u1 = acc[ai][1][m][1] + bu1;
                uint2 w;
                w.x = __builtin_amdgcn_cvt_pk_fp8_f32(swiglu(g0[2], u0[2]), swiglu(g0[3], u0[3]), __builtin_amdgcn_cvt_pk_fp8_f32(swiglu(g0[0], u0[0]), swiglu(g0[1], u0[1]), 0u, false), true);
                w.y = __builtin_amdgcn_cvt_pk_fp8_f32(swiglu(g1[2], u1[2]), swiglu(g1[3], u1[3]), __builtin_amdgcn_cvt_pk_fp8_f32(swiglu(g1[0], u1[0]), swiglu(g1[1], u1[1]), 0u, false), true);
                *(uint2*)(ACT + (size_t)(row0 + ai * 128 + m * 16) * FF + j0) = w;
            }
    }
};
struct EpiYB {
    static constexpr bool PERM = true, AFTER_DRAIN = false;
    bf16_t* YB; const float* bdn;
    __device__ __forceinline__ void operator()(const f32x4 (&acc)[2][2][4][2], const pg8::Unit& u, int wr, int wc, int fr, int fq) const {
        const int row0 = u.pm * 256 + wr * 64 + fr, col0 = u.pn * 256 + wc * 32 + 8 * fq;
        const float* bp = bdn + (size_t)u.e * D + col0;
        f32x4 bv[2][2];
#pragma unroll
        for (int bj = 0; bj < 2; ++bj)
#pragma unroll
            for (int n = 0; n < 2; ++n) bv[bj][n] = *(const f32x4*)(bp + bj * 128 + n * 4);
#pragma unroll
        for (int ai = 0; ai < 2; ++ai)
#pragma unroll
            for (int m = 0; m < 4; ++m) { bf16_t* rowp = YB + (size_t)(row0 + ai * 128 + m * 16) * D + col0;
#pragma unroll
                for (int bj = 0; bj < 2; ++bj) { const f32x4 v0 = acc[ai][bj][m][0] + bv[bj][0], v1 = acc[ai][bj][m][1] + bv[bj][1];
                    u32x4 w; w.x = cvtpk(v0[0], v0[1]); w.y = cvtpk(v0[2], v0[3]); w.z = cvtpk(v1[0], v1[1]); w.w = cvtpk(v1[2], v1[3]);
                    *(u32x4*)(rowp + bj * 128) = w; } }
    }
};
struct MoeOrder {
    int nN, nunits, G, v; const int* tile_e;
    __device__ void init(int ntiles, int nN_, int G_, int c, const int* te) { nN = nN_; nunits = ntiles * nN_; G = G_; v = (G_ % 8 == 0) ? (c % 8) * (G_ / 8) + c / 8 : c; tile_e = te; }
    __device__ bool next(int i, pg8::Unit& u) const {
        const int L = i * G + v; if (L >= nunits) return false;
        u.pm = L / nN; u.pn = L % nN; u.e = tile_e[u.pm]; return true;
    }
    __device__ __forceinline__ const bf16_t* bt(const pg8::Gemm& g, const pg8::Unit& u) const { return g.Bt + (size_t)u.e * g.N * g.K; }
    __device__ __forceinline__ void a_ready(const pg8::Unit&) const {}
    __device__ __forceinline__ void done(const pg8::Unit&) const {}
};

__device__ __forceinline__ void ph_gemm_proj(const P& p, int l, char* lds, const int wv) {
    pg8::Gemm g{p.H, p.WinT + (size_t)l * PW * D, R, PW, D}; pg8::StaticOrder S; S.init(R, PW, (int)gridDim.x, (int)blockIdx.x);
    EpiProj E{p.PROJ, p.rope};
    pg8::gemm_phase<EpiProj, pg8::StaticOrder, true, true>((PG8_LAS unsigned char*)lds, g, S, E, wv);
}
__device__ __forceinline__ void ph_gemm_out(const P& p, int l, int nrows, char* lds, const int wv) {
    pg8::Gemm g{p.MIX, p.WoutT + (size_t)l * D * D, T, D, D}; pg8::StaticOrder S; S.init(T, D, (int)gridDim.x, (int)blockIdx.x);
    if (l == 0) { EpiOut<true> E{p.X, p.mod + (size_t)l * 5 * 6144 + 2 * 1024, p.x, p.ctx - (size_t)T * D}; pg8::gemm_phase<EpiOut<true>, pg8::StaticOrder, true, true>((PG8_LAS unsigned char*)lds, g, S, E, wv); }
    else { EpiOut<false> E{p.X, p.mod + (size_t)l * 5 * 6144 + 2 * 1024, nullptr, nullptr}; pg8::gemm_phase<EpiOut<false>, pg8::StaticOrder, true, true>((PG8_LAS unsigned char*)lds, g, S, E, wv); }
    if (nrows > T) {
        const int tid = ltid(wv), lane = tid & 63, wid = tid >> 6, fr = lane & 15, fq = lane >> 4;
        const bf16_t* Wt = p.WoutT + (size_t)l * D * D;
        const float* gate = p.mod + ((size_t)l * 5 + 4) * 6144 + 2 * 1024;
        for (int it = blockIdx.x; it < (TC / 64) * (D / 64); it += gridDim.x) {
            const int m0 = T + (it >> 4) * 64 + (wid & 3) * 16, n0 = (it & 15) * 64 + (wid >> 2) * 32;
            const bf16_t* ap = p.MIX + (size_t)(m0 + fr) * D + fq * 8;
            const bf16_t* bp0 = Wt + (size_t)(n0 + fr) * D + fq * 8;
            const bf16_t* bp1 = bp0 + (size_t)16 * D;
            f32x4 acc0 = (f32x4){0.f, 0.f, 0.f, 0.f}, acc1 = acc0;
#pragma unroll 8
            for (int ks = 0; ks < D / 32; ++ks) {
                const bf16x8 af = *(const bf16x8*)(ap + ks * 32), b0 = *(const bf16x8*)(bp0 + ks * 32), b1 = *(const bf16x8*)(bp1 + ks * 32);
                acc0 = __builtin_amdgcn_mfma_f32_16x16x32_bf16(b0, af, acc0, 0, 0, 0);
                acc1 = __builtin_amdgcn_mfma_f32_16x16x32_bf16(b1, af, acc1, 0, 0, 0);
            }
            const int row = m0 + fr, c0 = n0 + fq * 4;
            const size_t off = (size_t)row * D + c0;
            const float* res = p.ctx - (size_t)T * D;
            const f32x4 v0 = *(const f32x4*)(res + off) + *(const f32x4*)(gate + c0) * acc0, v1 = *(const f32x4*)(res + off + 16) + *(const f32x4*)(gate + c0 + 16) * acc1;
            uint2 o0, o1; o0.x = cvtpk(v0[0], v0[1]); o0.y = cvtpk(v0[2], v0[3]); o1.x = cvtpk(v1[0], v1[1]); o1.y = cvtpk(v1[2], v1[3]);
            *(uint2*)(p.X + off) = o0; *(uint2*)(p.X + off + 16) = o1;
        }
    }
}
__device__ __forceinline__ void ph_moe1(const P& p, int l, char* lds, const int wv) {
    const int* meta = p.moe_meta + l * 512;
    const int ntiles = meta[0];
    pg8::Gemm g{(const bf16_t*)p.HS, (const bf16_t*)(p.WguT + (size_t)l * NE * 2048 * D), ntiles * 256, 2048, D / 2}; MoeOrder S; S.init(ntiles, 8, (int)gridDim.x, (int)blockIdx.x, meta + 1);
    EpiAct E{p.ACT, p.b_gu + (size_t)l * NE * 2048};
    pg8::gemm_phase<EpiAct, MoeOrder, true, true, true>((PG8_LAS unsigned char*)lds, g, S, E, wv);
}
__device__ __forceinline__ void ph_moe2(const P& p, int l, char* lds, const int wv) {
    const int* meta = p.moe_meta + l * 512;
    const int ntiles = meta[0];
    pg8::Gemm g{(const bf16_t*)p.ACT, (const bf16_t*)(p.WdnT + (size_t)l * NE * D * FF), ntiles * 256, D, FF / 2}; MoeOrder S; S.init(ntiles, 4, (int)gridDim.x, (int)blockIdx.x, meta + 1);
    EpiYB E{p.YB, p.b_down + (size_t)l * NE * D};
    pg8::gemm_phase<EpiYB, MoeOrder, true, true, true>((PG8_LAS unsigned char*)lds, g, S, E, wv);
}
struct CombRow { uint4 y0[2], y1[2], y2[2], y3[2], xw[2]; float4 g; };
__device__ __forceinline__ void comb_load(CombRow& c, const bf16_t* __restrict__ YB, const bf16_t* __restrict__ X, const int* __restrict__ tok_slot, const float* __restrict__ topg, int row, int lane) {
    const int4 sl = *(const int4*)(tok_slot + (size_t)row * 4);
    c.g = *(const float4*)(topg + (size_t)row * 4);
#pragma unroll
    for (int i = 0; i < 2; ++i) {
        const int k = lane * 8 + 512 * i;
        c.y0[i] = *(const uint4*)(YB + (size_t)sl.x * D + k); c.y1[i] = *(const uint4*)(YB + (size_t)sl.y * D + k);
        c.y2[i] = *(const uint4*)(YB + (size_t)sl.z * D + k); c.y3[i] = *(const uint4*)(YB + (size_t)sl.w * D + k);
        c.xw[i] = *(const uint4*)(X + (size_t)row * D + k);
    }
}
__device__ __forceinline__ void comb_finish(const P& p, const CombRow& c, int l, int row, int lane) {
    const float* m = p.mod + ((size_t)l * 5 + mod_row(row)) * 6144 + 5 * 1024;
    const float4 g = c.g;
    float xv[16]; float ss = 0.f;
#pragma unroll
    for (int i = 0; i < 2; ++i) {
        const int k = lane * 8 + 512 * i;
        const unsigned a0[4] = {c.y0[i].x, c.y0[i].y, c.y0[i].z, c.y0[i].w}, a1[4] = {c.y1[i].x, c.y1[i].y, c.y1[i].z, c.y1[i].w};
        const unsigned a2[4] = {c.y2[i].x, c.y2[i].y, c.y2[i].z, c.y2[i].w}, a3[4] = {c.y3[i].x, c.y3[i].y, c.y3[i].z, c.y3[i].w};
        const unsigned xq[4] = {c.xw[i].x, c.xw[i].y, c.xw[i].z, c.xw[i].w};
        const float4 gta = *(const float4*)(m + k), gtb = *(const float4*)(m + k + 4);
        const float gt[8] = {gta.x, gta.y, gta.z, gta.w, gtb.x, gtb.y, gtb.z, gtb.w};
#pragma unroll
        for (int q = 0; q < 4; ++q) {
            const float ylo = g.x * __uint_as_float(a0[q] << 16) + g.y * __uint_as_float(a1[q] << 16) + g.z * __uint_as_float(a2[q] << 16) + g.w * __uint_as_float(a3[q] << 16);
            const float yhi = g.x * __uint_as_float(a0[q] & 0xffff0000u) + g.y * __uint_as_float(a1[q] & 0xffff0000u) + g.z * __uint_as_float(a2[q] & 0xffff0000u) + g.w * __uint_as_float(a3[q] & 0xffff0000u);
            const float v0 = __uint_as_float(xq[q] << 16) + gt[2 * q] * ylo, v1 = __uint_as_float(xq[q] & 0xffff0000u) + gt[2 * q + 1] * yhi;
            xv[8 * i + 2 * q] = v0; xv[8 * i + 2 * q + 1] = v1; ss += v0 * v0 + v1 * v1;
        }
    }
    ss = wave_sum(ss);
    const float rstd = rsqrtf(ss * (1.f / D) + EPS);
    if (l == 0) {
        const float* m1 = p.mod + ((size_t)5 + mod_row(row)) * 6144;
        const float* g1 = p.g_mix + D;
#pragma unroll
        for (int i = 0; i < 2; ++i) {
            const int k = lane * 8 + 512 * i;
            { u32x4 xo; xo.x = cvtpk(xv[8 * i], xv[8 * i + 1]); xo.y = cvtpk(xv[8 * i + 2], xv[8 * i + 3]); xo.z = cvtpk(xv[8 * i + 4], xv[8 * i + 5]); xo.w = cvtpk(xv[8 * i + 6], xv[8 * i + 7]); *(u32x4*)(p.X + (size_t)row * D + k) = xo; }
            const float4 ga = *(const float4*)(g1 + k), gb = *(const float4*)(g1 + k + 4);
            const float4 sha = *(const float4*)(m1 + k), shb = *(const float4*)(m1 + k + 4);
            const float4 sca = *(const float4*)(m1 + 1024 + k), scb = *(const float4*)(m1 + 1024 + k + 4);
            u32x4 o;
            o.x = cvtpk(xv[8 * i] * rstd * ga.x * (1.f + sca.x) + sha.x, xv[8 * i + 1] * rstd * ga.y * (1.f + sca.y) + sha.y);
            o.y = cvtpk(xv[8 * i + 2] * rstd * ga.z * (1.f + sca.z) + sha.z, xv[8 * i + 3] * rstd * ga.w * (1.f + sca.w) + sha.w);
            o.z = cvtpk(xv[8 * i + 4] * rstd * gb.x * (1.f + scb.x) + shb.x, xv[8 * i + 5] * rstd * gb.y * (1.f + scb.y) + shb.y);
            o.w = cvtpk(xv[8 * i + 6] * rstd * gb.z * (1.f + scb.z) + shb.z, xv[8 * i + 7] * rstd * gb.w * (1.f + scb.w) + shb.w);
            *(u32x4*)(p.H + (size_t)row * D + k) = o;
        }
    } else {
#pragma unroll
        for (int i = 0; i < 2; ++i) {
            const int k = lane * 8 + 512 * i;
            const float4 ga = *(const float4*)(p.g_final + k), gb = *(const float4*)(p.g_final + k + 4);
            float* op = p.out + (size_t)row * D + k;
            *(float4*)op = make_float4(xv[8 * i] * rstd * ga.x, xv[8 * i + 1] * rstd * ga.y, xv[8 * i + 2] * rstd * ga.z, xv[8 * i + 3] * rstd * ga.w);
            *(float4*)(op + 4) = make_float4(xv[8 * i + 4] * rstd * gb.x, xv[8 * i + 5] * rstd * gb.y, xv[8 * i + 6] * rstd * gb.z, xv[8 * i + 7] * rstd * gb.w);
        }
    }
}
__device__ __forceinline__ void ph_combine(const P& p, int l, int nrows, const int wv) {
    const int wave = ltid(wv) >> 6, lane = ltid(wv) & 63;
    for (int pr = blockIdx.x * 8 + wave; pr < nrows / 2; pr += gridDim.x * 8) {
        CombRow ca, cb;
        comb_load(ca, p.YB, p.X, p.tok_slot, p.topg, 2 * pr, lane);
        comb_load(cb, p.YB, p.X, p.tok_slot, p.topg, 2 * pr + 1, lane);
        comb_finish(p, ca, l, 2 * pr, lane);
        comb_finish(p, cb, l, 2 * pr + 1, lane);
    }
}
extern __shared__ __attribute__((aligned(16))) char smem[];
__global__ void __launch_bounds__(NT, 2) mega(P p) {
    char* lds = smem;
    int wv = __builtin_amdgcn_readfirstlane((int)(threadIdx.x >> 6)); asm volatile("" : "+s"(wv));
    if (threadIdx.x == 0) *(uint4*)(smem + LDS_MAIN) = make_uint4(0u, 0u, 0u, 0u);
    __syncthreads();
    XcdBarrier bar = xcd_barrier_post(p.bar, (volatile LAS unsigned*)(smem + LDS_MAIN), wv);
    ph_prologue(p, lds, 0, wv);
    xcd_barrier(bar);
    ph_norm1(p, 0, wv);
    ph_prologue(p, lds, 1, wv);
    xcd_barrier(bar);
#define MEGA_LAYER(l, nrows, LAST) do { \
        ph_gemm_proj(p, l, lds, wv); xcd_barrier(bar); \
        ph_dattn(p, l, nrows, lds, wv); ph_na(p, l, nrows, lds, wv); ph_pool(p, l, nrows, lds, wv); ph_sgu(p, l, nrows, lds, wv); xcd_barrier(bar); \
        ph_gemm_out(p, l, nrows, lds, wv); xcd_barrier(bar); \
        ph_router(p, l, nrows, lds, wv); xcd_barrier(bar); \
        ph_assign(p, l, nrows, lds, wv); xcd_barrier(bar); \
        ph_moe1(p, l, lds, wv); xcd_barrier(bar); \
        ph_moe2(p, l, lds, wv); xcd_barrier(bar); \
        ph_combine(p, l, nrows, wv); if (!(LAST)) xcd_barrier(bar); } while (0)
    MEGA_LAYER(0, R, false);
    MEGA_LAYER(1, T, true);
#undef MEGA_LAYER
}

static inline size_t align_up(size_t v, size_t a) { return (v + a - 1) / a * a; }

extern "C" void kernel_launch(void* const* d_in, const int* in_sizes, int n_in, void* d_out, int out_size, void* d_ws, size_t ws_size, hipStream_t stream) {
    P p{};
    const float** ins = (const float**)&p.x;
    for (int i = 0; i < 28; ++i) ins[i] = (const float*)d_in[i];
    p.out = (float*)d_out;
    char* w = (char*)d_ws; size_t off = 0;
    auto carve = [&](size_t bytes) { void* r = w + off; off = align_up(off + bytes, 256); return r; };
    const size_t ctl_bytes = XCD_BAR_WORDS * 4 + 2 * 64 * 4;
    p.bar = (unsigned*)carve(ctl_bytes);
    p.cnt = (int*)(p.bar + XCD_BAR_WORDS);
    p.mod = (float*)carve((size_t)2 * 5 * 6144 * 4);
    p.rope = (float*)carve(64 * 8 * 2 * 4);
    p.X = (bf16_t*)carve((size_t)R * D * 2);
    p.H = (bf16_t*)carve((size_t)R * D * 2);
    p.PROJ = (bf16_t*)carve((size_t)R * PW * 2);
    p.MIX = (bf16_t*)carve((size_t)R * D * 2);
    p.WinT = (bf16_t*)carve((size_t)2 * PW * D * 2);
    p.WoutT = (bf16_t*)carve((size_t)2 * D * D * 2);
    p.WguT = (unsigned char*)carve((size_t)2 * NE * 2048 * D);
    p.WdnT = (unsigned char*)carve((size_t)2 * NE * D * FF);
    p.WpT = (bf16_t*)carve((size_t)2 * 4 * 64 * 64 * 2);
    p.WsB = (bf16_t*)carve((size_t)2 * 4 * 128 * 128 * 2);
    p.topi = (int*)carve((size_t)R * 4 * 4);
    p.topg = (float*)carve((size_t)R * 4 * 4);
    p.tok_slot = (int*)carve((size_t)R * 4 * 4);
    p.moe_meta = (int*)carve(2 * 512 * 4);
    p.HS = (unsigned char*)carve((size_t)NSLOT * D);
    p.ACT = (unsigned char*)carve((size_t)NSLOT * FF);
    p.YB = (bf16_t*)carve((size_t)NSLOT * D * 2);

    static int grid = 0;
    if (!grid) {
        int dev = 0, cus = 0, per_cu = 0;
        (void)hipGetDevice(&dev);
        (void)hipDeviceGetAttribute(&cus, hipDeviceAttributeMultiprocessorCount, dev);
        (void)hipFuncSetAttribute((const void*)mega, hipFuncAttributeMaxDynamicSharedMemorySize, LDS_BYTES);
        (void)hipOccupancyMaxActiveBlocksPerMultiprocessor(&per_cu, mega, NT, LDS_BYTES);
        grid = cus * (per_cu < 1 ? per_cu : 1);
        if (grid <= 0) { fprintf(stderr, "mega: occupancy query returned %d blocks per CU\n", per_cu); grid = 0; return; }
    }
    (void)hipMemsetAsync(p.bar, 0, ctl_bytes, stream);
    mega<<<grid, NT, LDS_BYTES, stream>>>(p);
}
```

```cpp
#include <hip/hip_runtime.h>
#include <stdint.h>
#include <cstdio>

typedef unsigned short bf16_t;
typedef short bf16x8 __attribute__((ext_vector_type(8)));
typedef float f32x4 __attribute__((ext_vector_type(4)));

constexpr int D = 1024, NB = 4, S = 4096, T = NB * S, CL = 256, TC = NB * CL, R = T + TC;
constexpr int PW = 2304, NE = 32, TOPK = 4, FF = 1024;
constexpr int MAXSLOT = R * TOPK;
constexpr int NSLOT = MAXSLOT + NE * 256;
constexpr float EPS = 1e-6f;
constexpr int NT = 512;
constexpr int LDS_MAIN = 150 * 1024;
constexpr int LDS_BYTES = LDS_MAIN + 1024;

__device__ __forceinline__ bf16_t f2bf(float f) { unsigned u = __float_as_uint(f); return (bf16_t)((u + 0x7fffu + ((u >> 16) & 1u)) >> 16); }
__device__ __forceinline__ float bf2f(bf16_t h) { return __uint_as_float(((unsigned)h) << 16); }
__device__ __forceinline__ float wave_sum(float v) {
#pragma unroll
    for (int o = 32; o >= 1; o >>= 1) v += __shfl_xor(v, o);
    return v;
}
__device__ __forceinline__ int mod_row(int row) { return row < T ? (row >> 12) : 4; }

#define XB_TMO      128
#define XB_XCNT(j)  (256  + 64 * (j))
#define XB_XSUB(j)  (1280 + 64 * (j))
#define XB_XGEN(j)  (2304 + 64 * (j))
#define XB_TOP      3328
#define XB_TOPGEN   3392
#define XCD_BAR_WORDS 3456
#define XB_SPIN_CAP (1u << 18)
#define LAS __attribute__((address_space(3)))

__device__ __forceinline__ unsigned xb_ld(unsigned* p)              { return __hip_atomic_load(p, __ATOMIC_RELAXED, __HIP_MEMORY_SCOPE_AGENT); }
__device__ __forceinline__ unsigned xb_add(unsigned* p, unsigned v) { return __hip_atomic_fetch_add(p, v, __ATOMIC_RELAXED, __HIP_MEMORY_SCOPE_AGENT); }
__device__ __forceinline__ unsigned xb_xcc_id() { return (unsigned)__builtin_amdgcn_s_getreg((3 << 11) | 20) & 0xFu; }
#define XB_SPIN(cond, bar) do { unsigned _sp = 0; while (cond) { __builtin_amdgcn_s_sleep(1); \
    if ((++_sp & 255u) == 0u) { if (xb_ld(&(bar)[XB_TMO])) break; if (_sp > XB_SPIN_CAP) { atomicAdd(&(bar)[XB_TMO], 1u); break; } } } } while (0)

struct XcdBarrier {
    unsigned* bar; unsigned x;
    volatile LAS unsigned* st;
    int wv;
};
__device__ __forceinline__ bool xb_t0(const int wv) { return wv == 0 && __builtin_amdgcn_mbcnt_hi(~0u, __builtin_amdgcn_mbcnt_lo(~0u, 0u)) == 0u; }
__device__ __forceinline__ XcdBarrier xcd_barrier_post(unsigned* bar, volatile LAS unsigned* st, const int wv) {
    XcdBarrier b; b.bar = bar; b.x = xb_xcc_id(); b.st = st; b.wv = wv;
    if (xb_t0(wv)) (void)xb_add(&bar[XB_XCNT(b.x)], 1u);
    return b;
}
__device__ __forceinline__ void xcd_barrier_complete(unsigned* bar, unsigned x, unsigned& nloc, unsigned& nx) {
    const unsigned G = gridDim.x * gridDim.y * gridDim.z;
    unsigned sum, cnt, mine, sp = 0u;
    for (;;) {
        sum = 0u; cnt = 0u; mine = 0u;
#pragma unroll
        for (unsigned j = 0; j < 16; ++j) { const unsigned c = xb_ld(&bar[XB_XCNT(j)]); sum += c; cnt += (c > 0u) ? 1u : 0u; mine = (j == x) ? c : mine; }
        if (sum == G) break;
        __builtin_amdgcn_s_sleep(1);
        if ((++sp & 255u) == 0u) { if (xb_ld(&bar[XB_TMO])) break; if (sp > XB_SPIN_CAP) { atomicAdd(&bar[XB_TMO], 1u); break; } }
    }
    nloc = mine > 0u ? mine : 1u; nx = cnt > 0u ? cnt : 1u;
}
__device__ __forceinline__ void xcd_barrier(const XcdBarrier& b) {
    asm volatile("s_waitcnt vmcnt(0)" ::: "memory");
    __syncthreads();
    if (xb_t0(b.wv)) {
        unsigned* bar = b.bar;
        __builtin_amdgcn_s_waitcnt(0);
        unsigned nloc = b.st[0], nx = b.st[1];
        if (nloc == 0u) { xcd_barrier_complete(bar, b.x, nloc, nx); b.st[0] = nloc; b.st[1] = nx; }
        const unsigned old = xb_add(&bar[XB_XSUB(b.x)], 1u);
        const unsigned gen = old / nloc;
        if (old + 1u == (gen + 1u) * nloc) {
            __builtin_amdgcn_fence(__ATOMIC_RELEASE, "agent");
            asm volatile("s_waitcnt vmcnt(0)" ::: "memory");
            const unsigned og = xb_add(&bar[XB_TOP], 1u);
            const unsigned tg = og / nx;
            if (og + 1u == (tg + 1u) * nx) xb_add(&bar[XB_TOPGEN], 1u);
            else XB_SPIN(xb_ld(&bar[XB_TOPGEN]) == tg, bar);
            __builtin_amdgcn_fence(__ATOMIC_ACQUIRE, "agent");
            xb_add(&bar[XB_XGEN(b.x)], 1u);
            asm volatile("s_waitcnt vmcnt(0)" ::: "memory");
        } else {
            XB_SPIN(xb_ld(&bar[XB_XGEN(b.x)]) == gen, bar);
            __builtin_amdgcn_fence(__ATOMIC_ACQUIRE, "agent");
            asm volatile("s_waitcnt vmcnt(0)" ::: "memory");
        }
    }
    __syncthreads();
}

struct P {
    const float *x, *c, *ctx, *c_ctx, *w_mod, *b_mod, *g_mix, *g_ffn, *w_in, *w_out, *lam_q1, *lam_k1, *lam_q2, *lam_k2, *g_sub,
        *w_pool, *s_pool, *g_sgu, *w_sgu, *b_sgu, *rpb, *w_router, *b_router, *w_gu, *b_gu, *w_down, *b_down, *g_final;
    float* out;
    unsigned* bar;
    int* cnt;
    float* mod;
    float* rope;
    bf16_t* X;
    bf16_t* H;
    bf16_t* PROJ;
    bf16_t* MIX;
    bf16_t* WinT;
    bf16_t* WoutT;
    unsigned char* WguT;
    unsigned char* WdnT;
    bf16_t* WpT;
    bf16_t* WsB;
    int* topi;
    float* topg;
    int* tok_slot;
    int* moe_meta;
    unsigned char* HS;
    unsigned char* ACT;
    bf16_t* YB;
};

__device__ __forceinline__ int ltid(const int wv) { int t; asm volatile("v_mbcnt_lo_u32_b32 %0, -1, 0\n\tv_mbcnt_hi_u32_b32 %0, -1, %0\n\tv_lshl_or_b32 %0, %1, 6, %0" : "=&v"(t) : "s"(wv)); return t; }
typedef float f32x16 __attribute__((ext_vector_type(16)));
typedef short s16x4 __attribute__((ext_vector_type(4)));
typedef short v4i16_t __attribute__((ext_vector_type(4)));
typedef float f32x2_t __attribute__((ext_vector_type(2)));
typedef __bf16 bf16x2_t __attribute__((ext_vector_type(2)));
typedef __attribute__((address_space(3))) const char* lds_cptr;
typedef unsigned u32x4 __attribute__((ext_vector_type(4)));
__device__ __forceinline__ unsigned cvtpk(float lo, float hi) { f32x2_t v = {lo, hi}; bf16x2_t b = __builtin_convertvector(v, bf16x2_t); return __builtin_bit_cast(unsigned, b); }
__device__ __forceinline__ s16x4 vtr(lds_cptr q) { return __builtin_bit_cast(s16x4, __builtin_amdgcn_ds_read_tr16_b64_v4i16((__attribute__((address_space(3))) v4i16_t*)q)); }
__device__ __forceinline__ float xhalf_max(float v) { auto rr = __builtin_amdgcn_permlane32_swap(__float_as_uint(v), __float_as_uint(v), false, false); return fmaxf(__uint_as_float(rr[0]), __uint_as_float(rr[1])); }
__device__ __forceinline__ float xhalf_sum(float v) { auto rr = __builtin_amdgcn_permlane32_swap(__float_as_uint(v), __float_as_uint(v), false, false); return __uint_as_float(rr[0]) + __uint_as_float(rr[1]); }
namespace pg8 {
#define PG8_LAS __attribute__((address_space(3)))
constexpr int BM = 256, BK = 64, HALF = 128, HTB = HALF * BK * 2  , STAGE_BYTES = 8 * HTB, NXCD = 8, WGM = 8;
__host__ __device__ __forceinline__ int lds_byte(int r, int c) { const int st = (r >> 4) * 2 + (c >> 5), rr = r & 15, cc = c & 31, ob = rr * 64 + cc * 2; return st * 1024 + (ob ^ (((ob >> 9) & 1) << 5)); }
__host__ __device__ __forceinline__ void stage_rc(int b, int& R, int& C) { const int st = b / 1024, sb = b % 1024, swz = sb ^ (((sb >> 9) & 1) << 5); R = (st >> 1) * 16 + swz / 64; C = (st & 1) * 32 + (swz % 64) / 2; }
__host__ __device__ __forceinline__ int perm32(int rho) { const int n = rho >> 4, i = rho & 15; return 8 * (i >> 2) + 4 * n + (i & 3); }
struct Unit { int pm, pn, e; };
struct Gemm { const bf16_t* A; const bf16_t* Bt; int M, N, K; };
struct StaticOrder {
    int nM, nN, nwg, G, c;
    __host__ __device__ void init(int M, int N, int G_, int c_) { nM = M / BM; nN = N / BM; nwg = nM * nN; G = G_; c = c_; }
    __host__ __device__ bool next(int i, Unit& u) const {
        const long L = (long)i * G + c; if (L >= nwg) return false;
        int wgid = (int)L; { const int q = nwg / NXCD, r = nwg % NXCD, xcd = wgid % NXCD, off = wgid / NXCD; wgid = (xcd < r ? xcd * (q + 1) : r * (q + 1) + (xcd - r) * q) + off; }
        const int nig = WGM * nN, gid = wgid / nig, fm = gid * WGM, gsz = (nM - fm) < WGM ? (nM - fm) : WGM;
        u.pm = fm + ((wgid % nig) % gsz); u.pn = (wgid % nig) / gsz; u.e = 0; return true;
    }
    __device__ __forceinline__ const bf16_t* bt(const Gemm& g, const Unit&) const { return g.Bt; }
    __device__ __forceinline__ void a_ready(const Unit&) const {}
    __device__ __forceinline__ void done(const Unit&) const {}
};
typedef int v4i_t __attribute__((ext_vector_type(4)));
typedef int v8i_t __attribute__((ext_vector_type(8)));
__device__ __forceinline__ v8i_t cat8(bf16x8 a, bf16x8 b) { const v4i_t x = __builtin_bit_cast(v4i_t, a), y = __builtin_bit_cast(v4i_t, b); return __builtin_shufflevector(x, y, 0, 1, 2, 3, 4, 5, 6, 7); }
template <class Epi, class Sched, bool ALIGN_EPI = false, bool SP2 = false, bool F8 = false>
__device__ __forceinline__ void gemm_phase(PG8_LAS unsigned char* lds, const Gemm g, const Sched& S, const Epi& E, const int wv) {
    const int tid = ltid(wv), wid = __builtin_amdgcn_readfirstlane(tid >> 6), lane = tid & 63, wr = wid >> 2, wc = wid & 3, fr = lane & 15, fq = lane >> 4;
    const int K = g.K, nt = K / BK;
    unsigned voffA[2], voffB[2];
#pragma unroll
    for (int i = 0; i < 2; ++i) { int R, C; stage_rc(tid * 16 + i * 8192, R, C); const int Rb = Epi::WIDE ? ((R >> 5) * 64 + perm32(R & 31)) : Epi::PERM ? ((R & ~31) + perm32(R & 31)) : R;
        voffA[i] = (unsigned)(R * K + C) * 2u; voffB[i] = (unsigned)(Rb * K + C) * 2u; }
    const size_t kstep = (size_t)(BK * 2);
    const size_t hstep = (size_t)HALF * K * 2;
    const size_t tstep = 2 * hstep;
    const size_t bstep = Epi::WIDE ? (size_t)32 * K * 2 : hstep;
    const unsigned ldsw = (unsigned)wid * 1024u;
    const int aoff = lds_byte(wr * 64 + fr, fq * 8), boff = lds_byte(wc * 32 + fr, fq * 8);
#define PG8_SA(b, h) (((b) * 2 + (h)) * HTB)
#define PG8_SB(b, h) ((4 + (b) * 2 + (h)) * HTB)
#define PG8_STAGE(bufoff, gbase, voff) do { _Pragma("unroll") for (int _i = 0; _i < 2; ++_i) \
        __builtin_amdgcn_global_load_lds((const unsigned*)((const char*)(gbase) + (voff)[_i]), (PG8_LAS unsigned*)(lds + (bufoff) + ldsw + _i * 8192), 16, 0, 0); } while (0)
#define PG8_LDA(dst, b, h) do { _Pragma("unroll") for (int m = 0; m < 4; ++m) _Pragma("unroll") for (int k = 0; k < 2; ++k) dst[m][k] = *(const PG8_LAS bf16x8*)(lds + PG8_SA(b, h) + aoff + m * 2048 + k * 1024); \
        if constexpr (F8) { _Pragma("unroll") for (int m = 0; m < 4; ++m) dst##8[m] = cat8(dst[m][0], dst[m][1]); } } while (0)
#define PG8_LDB(dst, b, h) do { _Pragma("unroll") for (int n = 0; n < 2; ++n) _Pragma("unroll") for (int k = 0; k < 2; ++k) dst[n][k] = *(const PG8_LAS bf16x8*)(lds + PG8_SB(b, h) + boff + n * 2048 + k * 1024); \
        if constexpr (F8) { _Pragma("unroll") for (int n = 0; n < 2; ++n) dst##8[n] = cat8(dst[n][0], dst[n][1]); } } while (0)
#define PG8_MMA(ai, bj, At, Bt) do { __builtin_amdgcn_s_setprio(1); \
        if constexpr (F8) { _Pragma("unroll") for (int m = 0; m < 4; ++m) _Pragma("unroll") for (int n = 0; n < 2; ++n) \
            asm volatile("v_mfma_scale_f32_16x16x128_f8f6f4 %0, %1, %2, %0, %3, %4 op_sel_hi:[0,0,0]" : "+v"(acc[ai][bj][m][n]) : "v"(Bt##8[n]), "v"(At##8[m]), "v"(sclW), "v"(sclX)); } \
        else { _Pragma("unroll") for (int m = 0; m < 4; ++m) _Pragma("unroll") for (int n = 0; n < 2; ++n) _Pragma("unroll") for (int k = 0; k < 2; ++k) \
            acc[ai][bj][m][n] = __builtin_amdgcn_mfma_f32_16x16x32_bf16(Bt[n][k], At[m][k], acc[ai][bj][m][n], 0, 0, 0); } \
        __builtin_amdgcn_s_setprio(0); } while (0)
#define PG8_WAIT_V(n) asm volatile("s_waitcnt vmcnt(" #n ")" ::: "memory")
#define PG8_WAIT_L(n) asm volatile("s_waitcnt lgkmcnt(" #n ")" ::: "memory")
#define PG8_BAR __builtin_amdgcn_s_barrier()
#define PG8_SCHED __builtin_amdgcn_sched_barrier(0)
    Unit cur, nxt; int ui = 0;
    typename Epi::Pre pre;
    if (!S.next(0, cur)) return;
    f32x4 acc[2][2][4][2];
#pragma unroll
    for (int a = 0; a < 2; ++a)
#pragma unroll
        for (int b = 0; b < 2; ++b)
#pragma unroll
            for (int m = 0; m < 4; ++m)
#pragma unroll
                for (int n = 0; n < 2; ++n) { acc[a][b][m][n] = (f32x4){0.f, 0.f, 0.f, 0.f}; }
    bf16x8 At[4][2], B0[2][2], B1[2][2];
    v8i_t At8[4], B08[2], B18[2];
    const int sclW = 0x79797979, sclX = 0x7f7f7f7f;
    const char* cA = (const char*)g.A + (size_t)cur.pm * tstep; const char* cB = (const char*)S.bt(g, cur) + (size_t)cur.pn * tstep;
    S.a_ready(cur);
    if constexpr (SP2) {
        PG8_STAGE(PG8_SB(0, 0), cB, voffB); PG8_STAGE(PG8_SB(0, 1), cB + bstep, voffB); PG8_STAGE(PG8_SA(0, 0), cA, voffA); PG8_STAGE(PG8_SA(0, 1), cA + hstep, voffA);
        if (wr == 1) PG8_BAR;
        PG8_WAIT_V(2); PG8_BAR;
        PG8_STAGE(PG8_SB(1, 0), cB + kstep, voffB); PG8_STAGE(PG8_SA(1, 0), cA + kstep, voffA); PG8_STAGE(PG8_SB(1, 1), cB + bstep + kstep, voffB);
        PG8_WAIT_V(6); PG8_BAR;
    } else {
        PG8_STAGE(PG8_SB(0, 0), cB, voffB); PG8_STAGE(PG8_SA(0, 0), cA, voffA); PG8_STAGE(PG8_SB(0, 1), cB + bstep, voffB); PG8_STAGE(PG8_SA(0, 1), cA + hstep, voffA);
        if (wr == 1) PG8_BAR;
        PG8_WAIT_V(4); PG8_BAR;
        PG8_STAGE(PG8_SB(1, 0), cB + kstep, voffB); PG8_STAGE(PG8_SA(1, 0), cA + kstep, voffA); PG8_STAGE(PG8_SB(1, 1), cB + bstep + kstep, voffB);
        PG8_WAIT_V(6); PG8_BAR;
    }
    for (;;) {
        const bool has_next = S.next(ui + 1, nxt);
        const char* nA = has_next ? (const char*)g.A + (size_t)nxt.pm * tstep : cA; const char* nB = has_next ? (const char*)S.bt(g, nxt) + (size_t)nxt.pn * tstep : cB;
#pragma unroll 1
        for (int t = 0; t < nt; t += 2) {
            const bool last = (t == nt - 2);
            const char* a1 = cA + (size_t)(t + 1) * kstep;
            const char* a2 = last ? nA : cA + (size_t)(t + 2) * kstep; const char* b2 = last ? nB : cB + (size_t)(t + 2) * kstep;
            const char* a3 = a2 + kstep; const char* b3 = b2 + kstep;
            if (last && has_next) S.a_ready(nxt);
            if (last) E.prefetch(pre, cur, wr, wc, fr, fq);
            if constexpr (SP2) {
            PG8_LDB(B0, 0, 0); PG8_LDB(B1, 0, 1); PG8_SCHED; PG8_LDA(At, 0, 0); PG8_STAGE(PG8_SA(1, 1), a1 + hstep, voffA);
            PG8_WAIT_V(8); PG8_WAIT_L(0); PG8_BAR; PG8_MMA(0, 0, At, B0); PG8_MMA(0, 1, At, B1); PG8_BAR; PG8_SCHED;
            PG8_LDA(At, 0, 1); PG8_STAGE(PG8_SB(0, 0), b2, voffB); PG8_STAGE(PG8_SB(0, 1), b2 + bstep, voffB); PG8_STAGE(PG8_SA(0, 0), a2, voffA);
            PG8_WAIT_V(8); PG8_WAIT_L(0); PG8_BAR; PG8_MMA(1, 0, At, B0); PG8_MMA(1, 1, At, B1); PG8_BAR; PG8_SCHED;
            PG8_LDB(B0, 1, 0); PG8_LDB(B1, 1, 1); PG8_SCHED; PG8_LDA(At, 1, 0); PG8_STAGE(PG8_SA(0, 1), a2 + hstep, voffA);
            PG8_WAIT_V(8); PG8_WAIT_L(0); PG8_BAR; PG8_MMA(0, 0, At, B0); PG8_MMA(0, 1, At, B1); PG8_BAR; PG8_SCHED;
            PG8_LDA(At, 1, 1); PG8_STAGE(PG8_SB(1, 0), b3, voffB); PG8_STAGE(PG8_SB(1, 1), b3 + bstep, voffB); PG8_STAGE(PG8_SA(1, 0), a3, voffA);
            PG8_WAIT_V(8); PG8_WAIT_L(0); PG8_BAR; PG8_MMA(1, 0, At, B0); PG8_MMA(1, 1, At, B1); PG8_BAR; PG8_SCHED;
            } else {
            PG8_LDB(B0, 0, 0); PG8_SCHED; PG8_LDA(At, 0, 0); PG8_STAGE(PG8_SA(1, 1), a1 + hstep, voffA);
            PG8_WAIT_L(8); PG8_BAR; PG8_WAIT_L(0); PG8_MMA(0, 0, At, B0); PG8_BAR; PG8_SCHED;
            PG8_LDB(B1, 0, 1); PG8_STAGE(PG8_SB(0, 0), b2, voffB);
            PG8_BAR; PG8_WAIT_L(0); PG8_MMA(0, 1, At, B1); PG8_BAR;
            PG8_LDA(At, 0, 1); PG8_STAGE(PG8_SA(0, 0), a2, voffA);
            PG8_BAR; PG8_WAIT_L(0); PG8_MMA(1, 0, At, B0); PG8_BAR; PG8_SCHED;
            PG8_STAGE(PG8_SB(0, 1), b2 + bstep, voffB);
            PG8_WAIT_V(6); PG8_BAR; PG8_MMA(1, 1, At, B1); PG8_BAR;
            PG8_LDB(B0, 1, 0); PG8_SCHED; PG8_LDA(At, 1, 0); PG8_STAGE(PG8_SA(0, 1), a2 + hstep, voffA);
            PG8_WAIT_L(8); PG8_BAR; PG8_WAIT_L(0); PG8_MMA(0, 0, At, B0); PG8_BAR; PG8_SCHED;
            PG8_LDB(B1, 1, 1); PG8_STAGE(PG8_SB(1, 0), b3, voffB);
            PG8_BAR; PG8_WAIT_L(0); PG8_MMA(0, 1, At, B1); PG8_BAR;
            PG8_LDA(At, 1, 1); PG8_STAGE(PG8_SA(1, 0), a3, voffA);
            PG8_BAR; PG8_WAIT_L(0); PG8_MMA(1, 0, At, B0); PG8_BAR; PG8_SCHED;
            PG8_STAGE(PG8_SB(1, 1), b3 + bstep, voffB);
            PG8_WAIT_V(6); PG8_BAR; PG8_MMA(1, 1, At, B1); PG8_BAR;
            }
        }
        if constexpr (ALIGN_EPI) { if (wr == 0) PG8_BAR; }
        if constexpr (F8) asm volatile("s_nop 15\n\ts_nop 15" ::: "memory");
        if constexpr (!Epi::AFTER_DRAIN) { E(acc, cur, wr, wc, fr, fq, pre); S.done(cur); }
        if (!has_next) break;
#pragma unroll
        for (int a = 0; a < 2; ++a)
#pragma unroll
            for (int b = 0; b < 2; ++b)
#pragma unroll
                for (int m = 0; m < 4; ++m)
#pragma unroll
                    for (int n = 0; n < 2; ++n) { acc[a][b][m][n] = (f32x4){0.f, 0.f, 0.f, 0.f}; }
        cur = nxt; cA = nA; cB = nB; ++ui;
        if constexpr (ALIGN_EPI) { if (wr == 1) PG8_BAR; }
    }
    PG8_WAIT_V(0);
    if constexpr (!ALIGN_EPI) { if (wr == 0) PG8_BAR; }
    PG8_BAR;
    if constexpr (Epi::AFTER_DRAIN) { E.fused(acc, cur, wr, wc, fr, fq, lds, wid, lane); S.done(cur); }
#undef PG8_SA
#undef PG8_SB
#undef PG8_STAGE
#undef PG8_LDA
#undef PG8_LDB
#undef PG8_MMA
#undef PG8_WAIT_V
#undef PG8_WAIT_L
#undef PG8_BAR
#undef PG8_SCHED
}
}

__device__ __forceinline__ void ph_prologue(const P& p, char* lds, const int part, const int wv) {
    const int tid = ltid(wv);
    float* fl = (float*)lds;
    if (part == 0) {
    for (int it = blockIdx.x; it < 192; it += gridDim.x) {
        const int l = it / 96, cg = it % 96;
        float* sc = fl;
        float* part = fl + 5 * 1024;
        __syncthreads();
        for (int i = tid; i < 5 * 1024; i += NT) {
            const int r = i >> 10, k = i & 1023;
            const float v = r < 4 ? p.c[r * 1024 + k] : p.c_ctx[k];
            sc[i] = v / (1.f + __expf(-v));
        }
        __syncthreads();
        const int kq = tid >> 6, col = tid & 63, j = cg * 64 + col;
        const float* W = p.w_mod + (size_t)l * 1024 * 6144 + j;
        float a0 = 0, a1 = 0, a2 = 0, a3 = 0, a4 = 0;
#pragma unroll 16
        for (int k = kq * 128; k < kq * 128 + 128; ++k) {
            const float w = W[(size_t)k * 6144];
            a0 += sc[k] * w; a1 += sc[1024 + k] * w; a2 += sc[2048 + k] * w; a3 += sc[3072 + k] * w; a4 += sc[4096 + k] * w;
        }
        part[(kq * 5 + 0) * 64 + col] = a0; part[(kq * 5 + 1) * 64 + col] = a1; part[(kq * 5 + 2) * 64 + col] = a2;
        part[(kq * 5 + 3) * 64 + col] = a3; part[(kq * 5 + 4) * 64 + col] = a4;
        __syncthreads();
        if (tid < 5 * 64) {
            const int r = tid >> 6, cc = tid & 63, jj = cg * 64 + cc;
            float v = 0.f;
#pragma unroll
            for (int q = 0; q < 8; ++q) v += part[(q * 5 + r) * 64 + cc];
            p.mod[((size_t)l * 5 + r) * 6144 + jj] = v + p.b_mod[l * 6144 + jj];
        }
    }
    if (blockIdx.x == gridDim.x - 1) {
        const int pos = tid >> 3, f = tid & 7;
        const float inv = powf(10000.0f, -(float)f / 8.0f);
        const float ang = (float)pos * inv;
        p.rope[tid * 2] = cosf(ang); p.rope[tid * 2 + 1] = sinf(ang);
    }
    for (int i = blockIdx.x * NT + tid; i < 2 * 4 * 64 * 64; i += gridDim.x * NT) { const int ii = i & 63, j = (i >> 6) & 63, lg = i >> 12; p.WpT[i] = f2bf(p.w_pool[(size_t)lg * 4096 + ii * 64 + j]); }
    for (int i = blockIdx.x * NT + tid; i < 2 * 4 * 128 * 128; i += gridDim.x * NT) p.WsB[i] = f2bf(p.w_sgu[i]);
    }
    if (part == 1) {
        const int n_in = 2 * 9 * 16, n_out = 2 * 4 * 16, total = n_in + n_out;
        const int kr = tid >> 6, n4 = tid & 63, kg = tid & 7, nl = tid >> 3;
        for (int it = blockIdx.x; it < total; it += gridDim.x) {
            int i_ = it; const float* W_; bf16_t* Wt_; int N, K;
            if (i_ < n_in) { W_ = p.w_in; Wt_ = p.WinT; N = PW; K = D; } else { i_ -= n_in; W_ = p.w_out; Wt_ = p.WoutT; N = D; K = D; }
            const int ntn = N / 256, per = ntn * (K / 64), m_ = i_ / per, r_ = i_ % per, tn = r_ % ntn, tk = r_ / ntn, n0 = tn * 256;
            const float* src = W_ + (size_t)m_ * K * N + (size_t)(tk * 64) * N + n0; bf16_t* dst = Wt_ + (size_t)m_ * K * N + tk * 64;
            float4 rg[8];
#pragma unroll
            for (int i = 0; i < 8; ++i) rg[i] = *(const float4*)(src + (size_t)(kr + 8 * i) * N + n4 * 4);
            __syncthreads();
#pragma unroll
            for (int i = 0; i < 8; ++i) { float* q = fl + (kr + 8 * i) * 257 + n4 * 4; q[0] = rg[i].x; q[1] = rg[i].y; q[2] = rg[i].z; q[3] = rg[i].w; }
            __syncthreads();
#pragma unroll
            for (int j = 0; j < 4; ++j) {
                const int n = nl + 64 * j;
                const float* q = fl + (8 * kg) * 257 + n;
                u32x4 w;
                w.x = cvtpk(q[0], q[257]); w.y = cvtpk(q[2 * 257], q[3 * 257]); w.z = cvtpk(q[4 * 257], q[5 * 257]); w.w = cvtpk(q[6 * 257], q[7 * 257]);
                *(u32x4*)(dst + (size_t)(n0 + n) * K + 8 * kg) = w;
            }
        }
    }
}

__device__ __forceinline__ void ph_norm1(const P& p, int l, const int wv) {
    const int wave = ltid(wv) >> 6, lane = ltid(wv) & 63;
    for (int row = blockIdx.x * 8 + wave; row < R; row += gridDim.x * 8) {
        const float* xr = row < T ? p.x + (size_t)row * D : p.ctx + (size_t)(row - T) * D;
        float4 v[4]; float ss = 0;
#pragma unroll
        for (int i = 0; i < 4; ++i) { v[i] = *(const float4*)(xr + lane * 4 + 256 * i); ss += v[i].x * v[i].x + v[i].y * v[i].y + v[i].z * v[i].z + v[i].w * v[i].w; }
        ss = wave_sum(ss);
        const float rstd = rsqrtf(ss * (1.f / D) + EPS);
        const float* m = p.mod + ((size_t)l * 5 + mod_row(row)) * 6144;
        const float* g = p.g_mix + l * D;
#pragma unroll
        for (int i = 0; i < 4; ++i) {
            const int k = lane * 4 + 256 * i;
            const float4 gg = *(const float4*)(g + k), sh = *(const float4*)(m + k), sc = *(const float4*)(m + 1024 + k);
            uint2 o;
            o.x = cvtpk(v[i].x * rstd * gg.x * (1.f + sc.x) + sh.x, v[i].y * rstd * gg.y * (1.f + sc.y) + sh.y);
            o.y = cvtpk(v[i].z * rstd * gg.z * (1.f + sc.z) + sh.z, v[i].w * rstd * gg.w * (1.f + sc.w) + sh.w);
            *(uint2*)(p.H + (size_t)row * D + k) = o;
        }
    }
}

constexpr float QSCALE = 0.17677669529663687f * 1.4426950408889634f;
__device__ __forceinline__ void dsoftmax(const f32x16& s, float& m, float& l, f32x16& o0, f32x16& o1, bf16x8& pa, bf16x8& pb) {
    float mx = fmaxf(fmaxf(fmaxf(s[0], s[1]), fmaxf(s[2], s[3])), fmaxf(fmaxf(s[4], s[5]), fmaxf(s[6], s[7])));
    mx = fmaxf(mx, fmaxf(fmaxf(fmaxf(s[8], s[9]), fmaxf(s[10], s[11])), fmaxf(fmaxf(s[12], s[13]), fmaxf(s[14], s[15]))));
    mx = xhalf_max(mx);
    if (__any(mx > m)) {
        const float mn = fmaxf(m, mx), alpha = __builtin_amdgcn_exp2f(m - mn);
        o0 *= alpha; o1 *= alpha; l *= alpha; m = mn;
    }
    float pr[16]; float sum = 0.f;
#pragma unroll
    for (int r = 0; r < 16; ++r) { pr[r] = __builtin_amdgcn_exp2f(s[r] - m); sum += pr[r]; }
    l += sum;
    u32x4 a, b;
    a[0] = cvtpk(pr[0], pr[1]); a[1] = cvtpk(pr[2], pr[3]); a[2] = cvtpk(pr[4], pr[5]); a[3] = cvtpk(pr[6], pr[7]);
    b[0] = cvtpk(pr[8], pr[9]); b[1] = cvtpk(pr[10], pr[11]); b[2] = cvtpk(pr[12], pr[13]); b[3] = cvtpk(pr[14], pr[15]);
    pa = __builtin_bit_cast(bf16x8, a); pb = __builtin_bit_cast(bf16x8, b);
}
#define MX3(a, b, c) __builtin_fmaxf(__builtin_fmaxf((a), (b)), (c))
template <int THR>
__device__ __forceinline__ void dsoftmax2(f32x16& s, float& m, float& l, f32x16& o0, f32x16& o1, bf16x8& pa, bf16x8& pb, const bool first) {
    float a = MX3(s[0], s[1], s[2]), b = MX3(s[3], s[4], s[5]);
    a = MX3(a, s[6], s[7]); b = MX3(b, s[8], s[9]); a = MX3(a, s[10], s[11]); b = MX3(b, s[12], s[13]); a = MX3(a, s[14], s[15]);
    const float mx = xhalf_max(__builtin_fmaxf(a, b));
    if (first || __any(mx > m + (float)THR)) {
        const float mn = first ? mx : __builtin_fmaxf(mx, m), alpha = first ? 1.f : __builtin_amdgcn_exp2f(m - mn);
        m = mn; o0 *= alpha; o1 *= alpha; l *= alpha;
    }
    float sum = 0.f;
#pragma unroll
    for (int r = 0; r < 16; ++r) { s[r] = __builtin_amdgcn_exp2f(s[r] - m); sum += s[r]; }
    l += sum;
    u32x4 wa, wb;
    wa[0] = cvtpk(s[0], s[1]); wa[1] = cvtpk(s[2], s[3]); wa[2] = cvtpk(s[4], s[5]); wa[3] = cvtpk(s[6], s[7]);
    wb[0] = cvtpk(s[8], s[9]); wb[1] = cvtpk(s[10], s[11]); wb[2] = cvtpk(s[12], s[13]); wb[3] = cvtpk(s[14], s[15]);
    pa = __builtin_bit_cast(bf16x8, wa); pb = __builtin_bit_cast(bf16x8, wb);
}
typedef __attribute__((address_space(1))) const float* gcf32_t;
typedef __attribute__((address_space(1))) unsigned char* gu8_t;
typedef __attribute__((address_space(1))) const char* gcc_t;
typedef short v2i16_t __attribute__((ext_vector_type(2)));
struct CvT { gcc_t src; gu8_t dst; int n4; };
struct CvW { gcf32_t gu, dn; gu8_t guT, dnT; int b0, G; };
__device__ __forceinline__ void glds16x2(gcc_t sbase, unsigned voff0, unsigned voff1, unsigned lds_dst) { unsigned keep;
    asm volatile("s_mov_b32 %0, m0\n\ts_mov_b32 m0, %4\n\ts_nop 0\n\tglobal_load_lds_dwordx4 %1, %3\n\ts_add_u32 m0, m0, 0x2000\n\ts_nop 0\n\tglobal_load_lds_dwordx4 %2, %3\n\ts_mov_b32 m0, %0"
                 : "=&s"(keep) : "v"(voff0), "v"(voff1), "s"(sbase), "s"(lds_dst) : "memory", "scc"); }
__device__ __forceinline__ void glds16x4(gcc_t sbase, unsigned voff, unsigned vstride, unsigned lds_dst) { unsigned keep;
    asm volatile("s_mov_b32 %0, m0\n\ts_mov_b32 m0, %4\n\ts_nop 0\n\tglobal_load_lds_dwordx4 %1, %3\n\t"
                 "s_add_u32 m0, m0, 0x400\n\tv_add_u32 %1, %2, %1\n\tglobal_load_lds_dwordx4 %1, %3\n\t"
                 "s_add_u32 m0, m0, 0x400\n\tv_add_u32 %1, %2, %1\n\tglobal_load_lds_dwordx4 %1, %3\n\t"
                 "s_add_u32 m0, m0, 0x400\n\tv_add_u32 %1, %2, %1\n\tglobal_load_lds_dwordx4 %1, %3\n\ts_mov_b32 m0, %0"
                 : "=&s"(keep), "+v"(voff) : "s"(vstride), "s"(sbase), "s"(lds_dst) : "memory", "scc"); }
#if defined(__HIP_DEVICE_COMPILE__)
#define KARG_PTR(T_, member) ({ unsigned long long r_; asm volatile("s_load_dwordx2 %0, %1, %2\n\ts_waitcnt lgkmcnt(0)" : "=s"(r_) : "s"(__builtin_amdgcn_kernarg_segment_ptr()), "n"((int)__builtin_offsetof(P, member)) : "memory"); (T_)r_; })
#else
#define KARG_PTR(T_, member) ((T_)(unsigned long long)p.member)
#endif
__device__ __forceinline__ bool cv_pair(const CvW& w, int q, CvT& c) {
    constexpr int n_gu = NE * 8 * 16, n_dn = NE * 8 * 8;
    const int tile = w.b0 + q * w.G;
    if (tile >= n_gu + n_dn) return false;
    if (tile < n_gu) {
        const int e = tile >> 7, tn = tile & 15, tk = (tile >> 4) & 7, np0 = (tn & 7) * 256 + (tn >> 3) * 128;
        c.n4 = 2048 * 4;
        c.src = (gcc_t)(w.gu + ((size_t)e * 1024 + tk * 128) * 2048 + tn * 128);
        c.dst = w.guT + ((size_t)e * 2048 + np0) * 1024 + tk * 128;
    } else {
        const int i_ = tile - n_gu, e = i_ >> 6, tn = i_ & 7, tk = (i_ >> 3) & 7;
        c.n4 = 1024 * 4;
        c.src = (gcc_t)(w.dn + ((size_t)e * 1024 + tk * 128) * 1024 + tn * 128);
        c.dst = w.dnT + ((size_t)e * 1024 + tn * 128) * 1024 + tk * 128;
    }
    return true;
}
__device__ __forceinline__ void cv_store(gu8_t dst, const char* q0, const unsigned goff) {
    const float* q = (const float*)q0;
    u32x4 w;
#pragma unroll
    for (int d = 0; d < 4; ++d) {
        v2i16_t r = {0, 0};
        r = __builtin_amdgcn_cvt_scalef32_pk_fp8_f32(r, q[(2 * d) * 256], q[(2 * d) * 256 + 128], 0.015625f, false);
        r = __builtin_amdgcn_cvt_scalef32_pk_fp8_f32(r, q[(2 * d + 1) * 256], q[(2 * d + 1) * 256 + 128], 0.015625f, true);
        w[d] = __builtin_bit_cast(unsigned, r);
    }
    *(__attribute__((address_space(1))) u32x4*)(dst + goff) = w;
}
constexpr int CV_LDS = 32768;
__device__ __forceinline__ void ph_dattn(const P& p, int l, int nrows, char* lds, const int wv) {
    const int tid = ltid(wv), lane = tid & 63, wid = wv, r32 = lane & 31, hi = lane >> 5;
    float la = lane < 32 ? p.lam_q1[l * 32 + lane] * p.lam_k1[l * 32 + lane] : 0.f;
    float lb = lane < 32 ? p.lam_q2[l * 32 + lane] * p.lam_k2[l * 32 + lane] : 0.f;
    la = wave_sum(la); lb = wave_sum(lb);
    const float lam_init = 0.8f - 0.6f * expf(-0.3f * (float)l);
    const float lam = expf(la) - expf(lb) + lam_init;
    const bf16_t* PR = p.PROJ;
    const int nunits = (nrows == R) ? 256 + 16 : 256;
    const int vkey = (2 * (wid & 3) + (lane >> 5)) * 8 + ((lane >> 2) & 7), vchunk = (wid >> 2) * 4 + (lane & 3);
    const int vb = ((lane >> 4) & 1) * 32 + (lane & 3) * 8 + (4 * hi + ((lane & 15) >> 2)) * 64;
    const unsigned lds0 = (unsigned)(uintptr_t)lds;
    CvW cw; cw.gu = KARG_PTR(gcf32_t, w_gu) + (size_t)l * NE * 1024 * 2048; cw.guT = KARG_PTR(gu8_t, WguT) + (size_t)l * NE * 2048 * 1024;
    cw.dn = KARG_PTR(gcf32_t, w_down) + (size_t)l * NE * 1024 * 1024; cw.dnT = KARG_PTR(gu8_t, WdnT) + (size_t)l * NE * 1024 * 1024;
    { int b0 = blockIdx.x, G = gridDim.x; asm volatile("" : "+s"(b0), "+s"(G)); cw.b0 = b0; cw.G = G; }
    const unsigned cv_row = 8 * wid + (lane >> 5), cv_sw = (unsigned)(((lane & 31) ^ (((wid >> 1) & 1) << 2)) * 16);
    const int cv_n = 16 * wid + (lane >> 2), cv_kg = lane & 3;
    const int cv_lo = cv_kg * 8192 + (((cv_n >> 2) ^ ((cv_kg & 1) << 2)) * 16) + (cv_n & 3) * 4;
    const unsigned cv_go = (unsigned)(cv_n * 1024 + 16 * cv_kg);
    int cj = 0, cb = 0, ca = 0;
    CvT cp; bool cpok = false;
    gu8_t dstA = nullptr; bool hasA = false;
#define CV_NEXT(hasB_, dstB_) do { \
        if ((cj & 1) == 0) cpok = cv_pair(cw, cj >> 1, cp); else { cp.src += 64 * cp.n4; cp.dst += 64; } \
        hasB_ = cpok; dstB_ = cp.dst; \
        if (cpok) glds16x4(cp.src, cv_row * (unsigned)cp.n4 + cv_sw, 2u * (unsigned)cp.n4, lds0 + CV_LDS + cb * 32768 + wid * 4096); } while (0)
    for (int uu = blockIdx.x; uu < nunits; uu += gridDim.x) {
        int b, h, q0, nt; bool isctx;
        if (uu < 256) { const int u = (uu & 7) * 32 + (uu >> 3); b = u >> 6; h = (u >> 4) & 3; q0 = b * 4096 + (u & 15) * 256; nt = 68; isctx = false; }
        else { const int v = uu - 256; b = v >> 2; h = v & 3; q0 = T + b * 256; nt = 4; isctx = true; }
        const unsigned gKo = (unsigned)(256 + h * 64 + wid * 8 + lane * PW) * 2u;
        const unsigned gVo = (unsigned)(512 + h * 64 + vchunk * 8 + vkey * PW) * 2u;
#define DA_ROW0(t_) ((isctx || (t_) >= 64) ? T + b * 256 + (isctx ? (t_) : (t_) - 64) * 64 : b * 4096 + (t_) * 64)
#define DA_DMA_KV(t_) glds16x2((gcc_t)PR + (size_t)DA_ROW0(t_) * (PW * 2), gKo, gVo, lds0 + ((t_) & 1) * 16384 + wid * 1024)
        __syncthreads();
        DA_DMA_KV(0);
        bf16x8 qf[4];
        {
            const bf16_t* qp = PR + (size_t)(q0 + wid * 32 + r32) * PW + h * 64 + hi * 8;
#pragma unroll
            for (int ks = 0; ks < 4; ++ks) qf[ks] = *(const bf16x8*)(qp + ks * 16);
        }
        f32x16 O00, O01, O10, O11, zero16;
#pragma unroll
        for (int r = 0; r < 16; ++r) { O00[r] = 0.f; O01[r] = 0.f; O10[r] = 0.f; O11[r] = 0.f; zero16[r] = 0.f; }
        float m1 = 0.f, m2 = 0.f, l1 = 0.f, l2 = 0.f;
        asm volatile("" :: "v"(qf[0]), "v"(qf[1]), "v"(qf[2]), "v"(qf[3]));
        asm volatile("s_waitcnt vmcnt(0)" ::: "memory"); __builtin_amdgcn_s_barrier(); asm volatile("" ::: "memory");
#pragma unroll 1
        for (int t = 0; t < nt; ++t) {
            char* buf = lds + (t & 1) * 16384;
            if (t + 1 < nt) DA_DMA_KV(t + 1);
            bool hasB; gu8_t dstB;
            CV_NEXT(hasB, dstB);
            {
                typedef const __attribute__((address_space(3))) bf16x8* kfp_t;
                const lds_cptr kp = (lds_cptr)buf + hi * 1024 + r32 * 16;
                const lds_cptr vp = (lds_cptr)buf + 8192 + vb;
                bf16x8 kf0 = *(kfp_t)(kp), kf1 = *(kfp_t)(kp + 2048), kf2 = *(kfp_t)(kp + 4096), kf3 = *(kfp_t)(kp + 6144);
#pragma unroll
                for (int kb = 0; kb < 2; ++kb) {
                    f32x16 s1 = __builtin_amdgcn_mfma_f32_32x32x16_bf16(kf0, qf[0], zero16, 0, 0, 0);
                    f32x16 s2 = __builtin_amdgcn_mfma_f32_32x32x16_bf16(kf2, qf[2], zero16, 0, 0, 0);
                    s1 = __builtin_amdgcn_mfma_f32_32x32x16_bf16(kf1, qf[1], s1, 0, 0, 0);
                    s2 = __builtin_amdgcn_mfma_f32_32x32x16_bf16(kf3, qf[3], s2, 0, 0, 0);
                    s16x4 vlo[4], vhi[4];
#pragma unroll
                    for (int i = 0; i < 4; ++i) { vlo[i] = vtr(vp + kb * 2048 + (i >> 1) * 4096 + (i & 1) * 1024); vhi[i] = vtr(vp + kb * 2048 + (i >> 1) * 4096 + (i & 1) * 1024 + 512); }
                    if (kb == 0) { kf0 = *(kfp_t)(kp + 512); kf1 = *(kfp_t)(kp + 512 + 2048); kf2 = *(kfp_t)(kp + 512 + 4096); kf3 = *(kfp_t)(kp + 512 + 6144); }
                    __builtin_amdgcn_sched_barrier(0);
                    const bool first = (t == 0) && (kb == 0);
                    bf16x8 p1a, p1b, p2a, p2b;
                    dsoftmax2<8>(s1, m1, l1, O00, O01, p1a, p1b, first);
                    dsoftmax2<8>(s2, m2, l2, O10, O11, p2a, p2b, first);
#pragma unroll
                    for (int i = 0; i < 4; ++i) {
                        const bf16x8 va = (bf16x8){vlo[i][0], vlo[i][1], vlo[i][2], vlo[i][3], vhi[i][0], vhi[i][1], vhi[i][2], vhi[i][3]};
                        if (i < 2) { O00 = __builtin_amdgcn_mfma_f32_32x32x16_bf16(va, (i & 1) ? p1b : p1a, O00, 0, 0, 0); O10 = __builtin_amdgcn_mfma_f32_32x32x16_bf16(va, (i & 1) ? p2b : p2a, O10, 0, 0, 0); }
                        else       { O01 = __builtin_amdgcn_mfma_f32_32x32x16_bf16(va, (i & 1) ? p1b : p1a, O01, 0, 0, 0); O11 = __builtin_amdgcn_mfma_f32_32x32x16_bf16(va, (i & 1) ? p2b : p2a, O11, 0, 0, 0); }
                    }
                }
            }
            if (hasB) asm volatile("s_waitcnt vmcnt(4)" ::: "memory"); else asm volatile("s_waitcnt vmcnt(0)" ::: "memory");
            __builtin_amdgcn_s_barrier(); asm volatile("" ::: "memory");
            if (hasA) cv_store(dstA, lds + CV_LDS + ca * 32768 + cv_lo, cv_go);
            dstA = dstB; hasA = hasB; ca = cb;
            if (hasB) { ++cj; cb = cb == 2 ? 0 : cb + 1; }
        }
#undef DA_ROW0
#undef DA_DMA_KV
        l1 = xhalf_sum(l1); l2 = xhalf_sum(l2);
        const float i1 = 1.f / l1, i2 = lam / l2;
        float ss = 0.f;
#pragma unroll
        for (int r = 0; r < 16; ++r) { O00[r] = O00[r] * i1 - O10[r] * i2; O01[r] = O01[r] * i1 - O11[r] * i2; ss += O00[r] * O00[r] + O01[r] * O01[r]; }
        ss = xhalf_sum(ss);
        const float rstd = rsqrtf(ss * (1.f / 64.f) + EPS) * (1.f - lam_init);
        const float* gs = p.g_sub + l * 64;
        bf16_t* op = p.MIX + (size_t)(q0 + wid * 32 + r32) * D + h * 64;
#pragma unroll
        for (int g4 = 0; g4 < 4; ++g4) {
            const int d = 8 * g4 + 4 * hi;
            const float4 ga = *(const float4*)(gs + d), gb = *(const float4*)(gs + 32 + d);
            uint2 wa, wb;
            wa.x = cvtpk(O00[4 * g4] * rstd * ga.x, O00[4 * g4 + 1] * rstd * ga.y); wa.y = cvtpk(O00[4 * g4 + 2] * rstd * ga.z, O00[4 * g4 + 3] * rstd * ga.w);
            wb.x = cvtpk(O01[4 * g4] * rstd * gb.x, O01[4 * g4 + 1] * rstd * gb.y); wb.y = cvtpk(O01[4 * g4 + 2] * rstd * gb.z, O01[4 * g4 + 3] * rstd * gb.w);
            *(uint2*)(op + d) = wa; *(uint2*)(op + 32 + d) = wb;
        }
    }
    while (hasA) {
        asm volatile("s_waitcnt vmcnt(0)" ::: "memory");
        __syncthreads();
        cv_store(dstA, lds + CV_LDS + ca * 32768 + cv_lo, cv_go);
        bool hasB; gu8_t dstB;
        CV_NEXT(hasB, dstB);
        dstA = dstB; hasA = hasB; ca = cb;
        if (hasB) { ++cj; cb = cb == 2 ? 0 : cb + 1; }
    }
#undef CV_NEXT
}

__device__ __forceinline__ void ph_na(const P& p, int l, int nrows, char* lds, const int wv) {
    const int tid = ltid(wv), lane = tid & 63, wid = wv, r32 = lane & 31, hi = lane >> 5;
    const bf16_t* PR = p.PROJ;
    const int nunits = (nrows == R) ? 256 + 16 : 256;
    const int vkey = (2 * (wid & 3) + (lane >> 5)) * 8 + ((lane >> 2) & 7), vchunk = (wid >> 2) * 4 + (lane & 3);
    const int vb = ((lane >> 4) & 1) * 32 + (lane & 3) * 8 + (4 * hi + ((lane & 15) >> 2)) * 64;
    const unsigned lds0 = (unsigned)(uintptr_t)lds;
    float* btab = (float*)(lds + 49152);
    constexpr float LOG2E = 1.4426950408889634f;
    float pen[2][16];
    {
        const int cq_ = (wid & 1) * 32 + r32, wsc_ = min(max(cq_ - 8, 0), 48);
#pragma unroll
        for (int kb = 0; kb < 2; ++kb)
#pragma unroll
            for (int r = 0; r < 16; ++r) { const int kc = 32 * kb + (r & 3) + 8 * (r >> 2) + 4 * hi; pen[kb][r] = ((unsigned)(kc - wsc_) < 16u) ? 0.f : -INFINITY; }
    }
    for (int uu = (blockIdx.x + gridDim.x - 16) % gridDim.x; uu < nunits; uu += gridDim.x) {
        int b, h, q0, kr_lo, nlat, rs = 0, rq = 0; bool isctx;
        if (uu < 256) {
            const int u = (uu & 7) * 32 + (uu >> 3); b = u >> 6; h = (u >> 4) & 3; const int rg = u & 15;
            rq = 4 * rg + (wid >> 1); q0 = b * 4096 + rq * 64 + (wid & 1) * 32;
            kr_lo = min(max(4 * rg - 4, 0), 56); const int kr_hi = min(max(4 * rg - 1, 0), 56) + 7; nlat = kr_hi - kr_lo + 1;
            rs = min(max(rq - 4, 0), 56); isctx = false;
        } else { const int v = uu - 256; b = v >> 2; h = v & 3; q0 = T + b * 256 + wid * 32; kr_lo = 0; nlat = 0; isctx = true; }
        const int nt = nlat + 4;
        const int cq = (wid & 1) * 32 + r32;
        const unsigned gKo = (unsigned)(1792 + h * 64 + wid * 8 + lane * PW) * 2u;
        const unsigned gVo = (unsigned)(2048 + h * 64 + vchunk * 8 + vkey * PW) * 2u;
#define NA_ROW0(t_) ((t_) < nlat ? b * 4096 + (kr_lo + (t_)) * 64 : T + b * 256 + ((t_) - nlat) * 64)
#define NA_DMA_KV(t_, slot_) glds16x2((gcc_t)PR + (size_t)NA_ROW0(t_) * (PW * 2), gKo, gVo, lds0 + (slot_) * 16384 + wid * 1024)
        __syncthreads();
        NA_DMA_KV(0, 0); NA_DMA_KV(1, 1);
        bf16x8 qf[4];
        {
            const bf16_t* qp = PR + (size_t)(q0 + r32) * PW + 1536 + h * 64 + hi * 8;
#pragma unroll
            for (int ks = 0; ks < 4; ++ks) qf[ks] = *(const bf16x8*)(qp + ks * 16);
        }
        f32x16 O0, O1;
#pragma unroll
        for (int r = 0; r < 16; ++r) { O0[r] = 0.f; O1[r] = 0.f; }
        float m1 = -1e30f, l1 = 0.f;
        for (int i = tid; i < 15 * 128; i += NT) { const int j = (i & 127) - 48; btab[i] = (j >= 0 && j < 31) ? p.rpb[((size_t)l * 4 + h) * 465 + (i >> 7) * 31 + j] * LOG2E : 0.f; }
        asm volatile("" :: "v"(qf[0]), "v"(qf[1]), "v"(qf[2]), "v"(qf[3]));
        asm volatile("s_waitcnt vmcnt(0)" ::: "memory");
        __syncthreads();
        int ks = 0;
#pragma unroll 1
        for (int t = 0; t < nt; ++t) {
            char* buf = lds + ks * 16384;
            const bool kvB = t + 2 < nt;
            if (kvB) NA_DMA_KV(t + 2, ks == 0 ? 2 : ks - 1);
            const bool lat = t < nlat;
            const int krow = kr_lo + t;
            const bool active = !lat || (krow >= rs && krow <= rs + 7);
            if (active) {
                const float* brow = btab + (krow - rq + 7) * 128 + 48 + 15 - cq + 4 * hi;
#pragma unroll
                for (int kb = 0; kb < 2; ++kb) {
                    const lds_cptr kp = (lds_cptr)buf + hi * 1024 + (kb * 32 + r32) * 16;
                    f32x16 s1;
#pragma unroll
                    for (int r = 0; r < 16; ++r) s1[r] = 0.f;
#pragma unroll
                    for (int ks2 = 0; ks2 < 4; ++ks2) {
                        const bf16x8 kf = *(const __attribute__((address_space(3))) bf16x8*)(kp + ks2 * 2048);
                        s1 = __builtin_amdgcn_mfma_f32_32x32x16_bf16(kf, qf[ks2], s1, 0, 0, 0);
                    }
                    if (lat) {
#pragma unroll
                        for (int r = 0; r < 16; ++r) s1[r] = (s1[r] + brow[32 * kb + (r & 3) + 8 * (r >> 2)]) + pen[kb][r];
                    }
                    bf16x8 pa, pb;
                    dsoftmax2<8>(s1, m1, l1, O0, O1, pa, pb, false);
                    const lds_cptr vp = (lds_cptr)buf + 8192 + vb + kb * 2048;
#pragma unroll
                    for (int ss = 0; ss < 2; ++ss) {
                        const s16x4 lo0 = vtr(vp + ss * 1024), hh0 = vtr(vp + ss * 1024 + 512);
                        const s16x4 lo1 = vtr(vp + 4096 + ss * 1024), hh1 = vtr(vp + 4096 + ss * 1024 + 512);
                        const bf16x8 va0 = (bf16x8){lo0[0], lo0[1], lo0[2], lo0[3], hh0[0], hh0[1], hh0[2], hh0[3]};
                        const bf16x8 va1 = (bf16x8){lo1[0], lo1[1], lo1[2], lo1[3], hh1[0], hh1[1], hh1[2], hh1[3]};
                        O0 = __builtin_amdgcn_mfma_f32_32x32x16_bf16(va0, ss ? pb : pa, O0, 0, 0, 0);
                        O1 = __builtin_amdgcn_mfma_f32_32x32x16_bf16(va1, ss ? pb : pa, O1, 0, 0, 0);
                    }
                }
            }
            if (kvB) asm volatile("s_waitcnt vmcnt(2)" ::: "memory"); else asm volatile("s_waitcnt vmcnt(0)" ::: "memory");
            __builtin_amdgcn_s_barrier(); asm volatile("" ::: "memory");
            ks = ks == 2 ? 0 : ks + 1;
        }
#undef NA_ROW0
#undef NA_DMA_KV
        l1 = xhalf_sum(l1);
        const float il = 1.f / l1;
        bf16_t* op = p.MIX + (size_t)(q0 + r32) * D + 768 + h * 64;
#pragma unroll
        for (int g4 = 0; g4 < 4; ++g4) {
            const int d = 8 * g4 + 4 * hi;
            uint2 wa, wb;
            wa.x = cvtpk(O0[4 * g4] * il, O0[4 * g4 + 1] * il); wa.y = cvtpk(O0[4 * g4 + 2] * il, O0[4 * g4 + 3] * il);
            wb.x = cvtpk(O1[4 * g4] * il, O1[4 * g4 + 1] * il); wb.y = cvtpk(O1[4 * g4 + 2] * il, O1[4 * g4 + 3] * il);
            *(uint2*)(op + d) = wa; *(uint2*)(op + 32 + d) = wb;
        }
    }
}

__device__ __forceinline__ void ph_pool(const P& p, int l, int nrows, char* lds, const int wv) {
    const int tid = ltid(wv), lane = tid & 63, wid = tid >> 6, fr = lane & 15, fq = lane >> 4;
    float* ysh = (float*)lds;
    bf16_t* dsh = (bf16_t*)(lds + 80 * 256 * 4);
    const bf16_t* PR = p.PROJ;
    for (int it = (blockIdx.x + gridDim.x - 32) % gridDim.x; it < nrows / 64; it += gridDim.x) {
        const int row0 = it * 64;
        const int L = row0 < T ? 4096 : 256;
        const int t0 = row0 < T ? (row0 & 4095) : ((row0 - T) & 255);
        const int base = row0 - t0;
        __syncthreads();
        for (int c = tid; c < 80 * 32; c += NT) {
            const int rr = c >> 5, ch = (c & 31) * 8, t = t0 - 8 + rr;
            float4 a = make_float4(0.f, 0.f, 0.f, 0.f), b = a;
            if (t >= 0 && t < L) {
                const uint4 raw = *(const uint4*)(PR + (size_t)(base + t) * PW + 768 + ch);
                a = make_float4(__uint_as_float(raw.x << 16), __uint_as_float(raw.x & 0xffff0000u), __uint_as_float(raw.y << 16), __uint_as_float(raw.y & 0xffff0000u));
                b = make_float4(__uint_as_float(raw.z << 16), __uint_as_float(raw.z & 0xffff0000u), __uint_as_float(raw.w << 16), __uint_as_float(raw.w & 0xffff0000u));
            }
            *(float4*)(ysh + rr * 256 + ch) = a; *(float4*)(ysh + rr * 256 + ch + 4) = b;
        }
        __syncthreads();
        {
            const int r = tid >> 3, cg = tid & 7;
            const int g = cg >> 1, w = 2 << g, t = t0 + r;
            const int lo = max(t - w / 2, 0), hi = min(t + w / 2 - 1, L - 1);
            const float inv = 1.f / (float)(hi - lo + 1);
#pragma unroll
            for (int q = 0; q < 8; ++q) {
                const int ch = cg * 32 + q * 4;
                float4 s = make_float4(0.f, 0.f, 0.f, 0.f);
                for (int tt = lo; tt <= hi; ++tt) { const float4 v = *(const float4*)(ysh + (tt - t0 + 8) * 256 + ch); s.x += v.x; s.y += v.y; s.z += v.z; s.w += v.w; }
                const float4 y = *(const float4*)(ysh + (r + 8) * 256 + ch);
                uint2 o; o.x = cvtpk(s.x * inv - y.x, s.y * inv - y.y); o.y = cvtpk(s.z * inv - y.z, s.w * inv - y.w);
                *(uint2*)(dsh + r * 264 + ch) = o;
            }
        }
        __syncthreads();
        {
            const int g = wid >> 1, mb = (wid & 1) * 2;
            const bf16_t* W = p.WpT + ((size_t)l * 4 + g) * 64 * 64;
            f32x4 acc[2][4];
#pragma unroll
            for (int mt = 0; mt < 2; ++mt)
#pragma unroll
                for (int nt = 0; nt < 4; ++nt) acc[mt][nt] = (f32x4){0.f, 0.f, 0.f, 0.f};
#pragma unroll
            for (int ks = 0; ks < 2; ++ks) {
                bf16x8 af[2], bfr[4];
#pragma unroll
                for (int mt = 0; mt < 2; ++mt) af[mt] = *(const bf16x8*)(dsh + ((mb + mt) * 16 + fr) * 264 + g * 64 + ks * 32 + fq * 8);
#pragma unroll
                for (int nt = 0; nt < 4; ++nt) bfr[nt] = *(const bf16x8*)(W + (nt * 16 + fr) * 64 + ks * 32 + fq * 8);
#pragma unroll
                for (int mt = 0; mt < 2; ++mt)
#pragma unroll
                    for (int nt = 0; nt < 4; ++nt) acc[mt][nt] = __builtin_amdgcn_mfma_f32_16x16x32_bf16(bfr[nt], af[mt], acc[mt][nt], 0, 0, 0);
            }
#pragma unroll
            for (int mt = 0; mt < 2; ++mt)
#pragma unroll
                for (int nt = 0; nt < 4; ++nt) {
                    const int row = row0 + (mb + mt) * 16 + fr, j = g * 64 + nt * 16 + fq * 4;
                    const float4 sp = *(const float4*)(p.s_pool + l * 256 + j);
                    uint2 o; o.x = cvtpk(acc[mt][nt][0] * sp.x, acc[mt][nt][1] * sp.y); o.y = cvtpk(acc[mt][nt][2] * sp.z, acc[mt][nt][3] * sp.w);
                    *(uint2*)(p.MIX + (size_t)row * D + 256 + j) = o;
                }
        }
    }
}

__device__ __forceinline__ float gelu_fast(float x) {
    const float u = 0.7978845608028654f * (x + 0.044715f * x * x * x);
    return x / (1.f + __builtin_amdgcn_exp2f(-2.885390081777927f * u));
}
__device__ __forceinline__ void ph_sgu(const P& p, int l, int nrows, char* lds, const int wv) {
    const int tid = ltid(wv), lane = tid & 63, wid = tid >> 6, fr = lane & 15, fq = lane >> 4;
    bf16_t* vnT = (bf16_t*)lds;
    float* rstd = (float*)(lds + 128 * 136 * 2);
    const bf16_t* PR = p.PROJ;
    for (int it = (blockIdx.x + gridDim.x - 48) % gridDim.x; it < (nrows / 128) * 2; it += gridDim.x) {
        const int chunk = it >> 1, hp = it & 1, row0 = chunk * 128;
        __syncthreads();
        {
            const int t = tid >> 2, qtr = tid & 3;
            const bf16_t* zp = PR + (size_t)(row0 + t) * PW + 1280 + qtr * 64;
            float ss = 0.f;
#pragma unroll
            for (int i = 0; i < 8; ++i) {
                const uint4 raw = *(const uint4*)(zp + i * 8);
                const unsigned w4[4] = {raw.x, raw.y, raw.z, raw.w};
#pragma unroll
                for (int j = 0; j < 4; ++j) { const float a = __uint_as_float(w4[j] << 16), b = __uint_as_float(w4[j] & 0xffff0000u); ss += a * a + b * b; }
            }
            ss += __shfl_xor(ss, 1); ss += __shfl_xor(ss, 2);
            if (qtr == 0) rstd[t] = rsqrtf(ss * (1.f / 256.f) + EPS);
        }
        __syncthreads();
        {
            const int s = tid >> 2, cb = (tid & 3) * 32;
            const bf16_t* zp = PR + (size_t)(row0 + s) * PW + 1280 + hp * 128 + cb;
            const float rs = rstd[s];
            const float* gg = p.g_sgu + l * 256 + hp * 128 + cb;
#pragma unroll
            for (int i = 0; i < 4; ++i) {
                const uint4 raw = *(const uint4*)(zp + i * 8);
                const unsigned w4[4] = {raw.x, raw.y, raw.z, raw.w};
#pragma unroll
                for (int j = 0; j < 4; ++j) {
                    const int c = cb + i * 8 + j * 2;
                    vnT[c * 136 + s] = f2bf(__uint_as_float(w4[j] << 16) * rs * gg[i * 8 + j * 2]);
                    vnT[(c + 1) * 136 + s] = f2bf(__uint_as_float(w4[j] & 0xffff0000u) * rs * gg[i * 8 + j * 2 + 1]);
                }
            }
        }
        __syncthreads();
        {
            const int hl = wid >> 2, g = hp * 2 + hl, mb = (wid & 3) * 2;
            const bf16_t* Wg = p.WsB + ((size_t)l * 4 + g) * 128 * 128;
            f32x4 acc[2][4];
#pragma unroll
            for (int mt = 0; mt < 2; ++mt)
#pragma unroll
                for (int nt = 0; nt < 4; ++nt) acc[mt][nt] = (f32x4){0.f, 0.f, 0.f, 0.f};
#pragma unroll
            for (int ks = 0; ks < 4; ++ks) {
                bf16x8 af[2], bfr[4];
#pragma unroll
                for (int mt = 0; mt < 2; ++mt) af[mt] = *(const bf16x8*)(Wg + ((mb + mt) * 16 + fr) * 128 + ks * 32 + fq * 8);
#pragma unroll
                for (int nt = 0; nt < 4; ++nt) bfr[nt] = *(const bf16x8*)(vnT + (hl * 64 + nt * 16 + fr) * 136 + ks * 32 + fq * 8);
#pragma unroll
                for (int mt = 0; mt < 2; ++mt)
#pragma unroll
                    for (int nt = 0; nt < 4; ++nt) acc[mt][nt] = __builtin_amdgcn_mfma_f32_16x16x32_bf16(bfr[nt], af[mt], acc[mt][nt], 0, 0, 0);
            }
#pragma unroll
            for (int mt = 0; mt < 2; ++mt) {
                const int t = (mb + mt) * 16 + fr;
                const float bias = p.b_sgu[(l * 4 + g) * 128 + t];
#pragma unroll
                for (int nt = 0; nt < 4; ++nt) {
                    const int c = g * 64 + nt * 16 + fq * 4;
                    const uint2 ur = *(const uint2*)(PR + (size_t)(row0 + t) * PW + 1024 + c);
                    const float u0 = __uint_as_float(ur.x << 16), u1 = __uint_as_float(ur.x & 0xffff0000u);
                    const float u2 = __uint_as_float(ur.y << 16), u3 = __uint_as_float(ur.y & 0xffff0000u);
                    uint2 o; o.x = cvtpk(u0 * (acc[mt][nt][0] + bias), u1 * (acc[mt][nt][1] + bias)); o.y = cvtpk(u2 * (acc[mt][nt][2] + bias), u3 * (acc[mt][nt][3] + bias));
                    *(uint2*)(p.MIX + (size_t)(row0 + t) * D + 512 + c) = o;
                }
            }
        }
    }
}

__device__ __forceinline__ void ph_router(const P& p, int l, int nrows, char* lds, const int wv) {
    const int tid = ltid(wv), wave = tid >> 6, lane = tid & 63;
    float* wl = (float*)lds;
    float* wsc = (float*)(lds + 1024 * 36 * 4) + wave * 64;
    int* lcnt = (int*)(lds + 1024 * 36 * 4 + 8 * 64 * 4);
    __syncthreads();
    {
        const float* wr = p.w_router + (size_t)l * D * NE;
        float4 t[16];
#pragma unroll
        for (int i = 0; i < 16; ++i) t[i] = *(const float4*)(wr + (size_t)(tid + NT * i) * 4);
#pragma unroll
        for (int i = 0; i < 16; ++i) { const int idx = (tid + NT * i) * 4, k = idx >> 5, e = idx & 31; *(float4*)(wl + ((k & 3) * 256 + (k >> 2)) * 36 + e) = t[i]; }
        if (tid < 32) lcnt[tid] = 0;
    }
    __syncthreads();
    const float* g = p.g_ffn + l * D;
    const float brt = p.b_router[l * NE + (lane & 31)];
    for (int pr = blockIdx.x * 8 + wave; pr < nrows / 2; pr += gridDim.x * 8) {
        const int ra = 2 * pr;
        const bf16_t* xa = p.X + (size_t)ra * D; const bf16_t* xb = xa + D;
        float ha[16], hb[16]; float sa = 0.f, sb = 0.f;
#pragma unroll
        for (int i = 0; i < 4; ++i) {
            const uint2 ua = *(const uint2*)(xa + 4 * (lane + 64 * i)), ub = *(const uint2*)(xb + 4 * (lane + 64 * i));
            const float4 va = make_float4(__uint_as_float(ua.x << 16), __uint_as_float(ua.x & 0xffff0000u), __uint_as_float(ua.y << 16), __uint_as_float(ua.y & 0xffff0000u));
            const float4 vb = make_float4(__uint_as_float(ub.x << 16), __uint_as_float(ub.x & 0xffff0000u), __uint_as_float(ub.y << 16), __uint_as_float(ub.y & 0xffff0000u));
            ha[4 * i] = va.x; ha[4 * i + 1] = va.y; ha[4 * i + 2] = va.z; ha[4 * i + 3] = va.w; hb[4 * i] = vb.x; hb[4 * i + 1] = vb.y; hb[4 * i + 2] = vb.z; hb[4 * i + 3] = vb.w;
            sa += va.x * va.x + va.y * va.y + va.z * va.z + va.w * va.w; sb += vb.x * vb.x + vb.y * vb.y + vb.z * vb.z + vb.w * vb.w;
        }
        sa = wave_sum(sa); sb = wave_sum(sb);
        const float rsa = rsqrtf(sa * (1.f / D) + EPS), rsb = rsqrtf(sb * (1.f / D) + EPS);
        const float* m = p.mod + ((size_t)l * 5 + mod_row(ra)) * 6144;
#pragma unroll
        for (int i = 0; i < 4; ++i) {
            const int k = 4 * (lane + 64 * i);
            const float4 gg = *(const float4*)(g + k), sc = *(const float4*)(m + 4 * 1024 + k), sh = *(const float4*)(m + 3 * 1024 + k);
            const float gs[4] = {gg.x * (1.f + sc.x), gg.y * (1.f + sc.y), gg.z * (1.f + sc.z), gg.w * (1.f + sc.w)}, s4[4] = {sh.x, sh.y, sh.z, sh.w};
#pragma unroll
            for (int j = 0; j < 4; ++j) { ha[4 * i + j] = ha[4 * i + j] * rsa * gs[j] + s4[j]; hb[4 * i + j] = hb[4 * i + j] * rsb * gs[j] + s4[j]; }
            uint2 oa, ob; oa.x = cvtpk(ha[4 * i], ha[4 * i + 1]); oa.y = cvtpk(ha[4 * i + 2], ha[4 * i + 3]); ob.x = cvtpk(hb[4 * i], hb[4 * i + 1]); ob.y = cvtpk(hb[4 * i + 2], hb[4 * i + 3]);
            *(uint2*)(p.H + (size_t)ra * D + k) = oa; *(uint2*)(p.H + (size_t)(ra + 1) * D + k) = ob;
        }
        float la[32], lb[32];
#pragma unroll
        for (int e = 0; e < 32; ++e) { la[e] = 0.f; lb[e] = 0.f; }
#pragma unroll
        for (int i = 0; i < 4; ++i)
#pragma unroll
            for (int j = 0; j < 4; ++j) {
                const float* wk = wl + (j * 256 + lane + 64 * i) * 36;
                const float xv = ha[4 * i + j], yv = hb[4 * i + j];
#pragma unroll
                for (int e = 0; e < 32; e += 4) {
                    const float4 w = *(const float4*)(wk + e);
                    la[e] += xv * w.x; la[e + 1] += xv * w.y; la[e + 2] += xv * w.z; la[e + 3] += xv * w.w;
                    lb[e] += yv * w.x; lb[e + 1] += yv * w.y; lb[e + 2] += yv * w.z; lb[e + 3] += yv * w.w;
                }
                if (j == 3) __builtin_amdgcn_sched_barrier(0);
            }
        float r32v[32];
        {
            const bool up = lane >= 32;
#pragma unroll
            for (int e = 0; e < 32; ++e) { const float keep = up ? lb[e] : la[e], send = up ? la[e] : lb[e]; r32v[e] = keep + __shfl_xor(send, 32); }
        }
        float r16[16], r8[8], r4[4], r2[2];
        { const bool up = (lane & 16) != 0;
#pragma unroll
          for (int e = 0; e < 16; ++e) { const float keep = up ? r32v[e + 16] : r32v[e], send = up ? r32v[e] : r32v[e + 16]; r16[e] = keep + __shfl_xor(send, 16); } }
        { const bool up = (lane & 8) != 0;
#pragma unroll
          for (int e = 0; e < 8; ++e) { const float keep = up ? r16[e + 8] : r16[e], send = up ? r16[e] : r16[e + 8]; r8[e] = keep + __shfl_xor(send, 8); } }
        { const bool up = (lane & 4) != 0;
#pragma unroll
          for (int e = 0; e < 4; ++e) { const float keep = up ? r8[e + 4] : r8[e], send = up ? r8[e] : r8[e + 4]; r4[e] = keep + __shfl_xor(send, 4); } }
        { const bool up = (lane & 2) != 0;
#pragma unroll
          for (int e = 0; e < 2; ++e) { const float keep = up ? r4[e + 2] : r4[e], send = up ? r4[e] : r4[e + 2]; r2[e] = keep + __shfl_xor(send, 2); } }
        float mine;
        { const bool up = (lane & 1) != 0; const float keep = up ? r2[1] : r2[0], send = up ? r2[0] : r2[1]; mine = keep + __shfl_xor(send, 1); }
        wsc[lane] = mine + brt;
        float lg[32];
        {
            const float* wp = wsc + (lane & 32);
#pragma unroll
            for (int e = 0; e < 32; e += 4) { const float4 v = *(const float4*)(wp + e); lg[e] = v.x; lg[e + 1] = v.y; lg[e + 2] = v.z; lg[e + 3] = v.w; }
        }
        unsigned taken = 0u; float tv[4]; int ti[4];
#pragma unroll
        for (int k = 0; k < 4; ++k) {
            float best = -3.0e38f; int bi = 0;
#pragma unroll
            for (int e = 0; e < 32; ++e) { const bool ok = !((taken >> e) & 1u) && (lg[e] > best); best = ok ? lg[e] : best; bi = ok ? e : bi; }
            taken |= 1u << bi; tv[k] = best; ti[k] = bi;
        }
        const float e1 = __expf(tv[1] - tv[0]), e2 = __expf(tv[2] - tv[0]), e3 = __expf(tv[3] - tv[0]);
        const float inv = 1.f / (1.f + e1 + e2 + e3);
        if ((lane & 31) == 0) {
            const int row = ra + (lane >> 5);
            *(int4*)(p.topi + (size_t)row * 4) = make_int4(ti[0], ti[1], ti[2], ti[3]);
            *(float4*)(p.topg + (size_t)row * 4) = make_float4(inv, e1 * inv, e2 * inv, e3 * inv);
            atomicAdd(&lcnt[ti[0]], 1); atomicAdd(&lcnt[ti[1]], 1); atomicAdd(&lcnt[ti[2]], 1); atomicAdd(&lcnt[ti[3]], 1);
        }
    }
    __syncthreads();
    if (tid < 32 && lcnt[tid]) atomicAdd(&p.cnt[l * 64 + tid], lcnt[tid]);
}
__device__ __forceinline__ void ph_assign(const P& p, int l, int nrows, char* lds, const int wv) {
    int* lcnt = (int*)lds; int* lbase = lcnt + 32; int* pst = lbase + 32; int* slots = pst + 32;
    const int tid = ltid(wv), wave = tid >> 6, lane = tid & 63;
    int* cnt = p.cnt + l * 64; int* cursor = cnt + 32;
    int* meta = p.moe_meta + l * 512;
    __syncthreads();
    if (tid == 0) { int a = 0; for (int e = 0; e < 32; ++e) { pst[e] = a; a += (cnt[e] + 255) & ~255; } if (blockIdx.x == 0) meta[0] = a >> 8; }
    __syncthreads();
    if (blockIdx.x == 0 && tid < 320) { int e = 0; for (int k = 1; k < 32; ++k) if (tid * 256 >= pst[k]) e = k; meta[1 + tid] = e; }
    const int blk0 = (blockIdx.x + gridDim.x - 64) % gridDim.x;
    for (int it = blk0; it < nrows / 64; it += gridDim.x) {
        __syncthreads();
        if (tid < 32) lcnt[tid] = 0;
        __syncthreads();
        if (wave == 0) {
            const int row = it * 64 + lane;
            const int4 ti = *(const int4*)(p.topi + (size_t)row * 4);
            const int r0 = atomicAdd(&lcnt[ti.x], 1), r1 = atomicAdd(&lcnt[ti.y], 1), r2 = atomicAdd(&lcnt[ti.z], 1), r3 = atomicAdd(&lcnt[ti.w], 1);
            __builtin_amdgcn_s_waitcnt(0xc07f);
            if (lane < 32) lbase[lane] = pst[lane] + (lcnt[lane] ? atomicAdd(&cursor[lane], lcnt[lane]) : 0);
            __builtin_amdgcn_s_waitcnt(0xc07f);
            const int4 sl = make_int4(lbase[ti.x] + r0, lbase[ti.y] + r1, lbase[ti.z] + r2, lbase[ti.w] + r3);
            *(int4*)(p.tok_slot + (size_t)row * 4) = sl;
            *(int4*)(slots + lane * 4) = sl;
        }
        __syncthreads();
        {
            const bf16_t* __restrict__ Hs = p.H; unsigned char* __restrict__ HSd = p.HS;
#define AS_LD(rr, A, B) const uint4 A = *(const uint4*)(Hs + (size_t)(it * 64 + wave * 8 + (rr)) * D + lane * 8), B = *(const uint4*)(Hs + (size_t)(it * 64 + wave * 8 + (rr)) * D + lane * 8 + 512)
#define AS_CV(V) make_uint2(__builtin_amdgcn_cvt_pk_fp8_f32(__uint_as_float(V.y << 16), __uint_as_float(V.y & 0xffff0000u), __builtin_amdgcn_cvt_pk_fp8_f32(__uint_as_float(V.x << 16), __uint_as_float(V.x & 0xffff0000u), 0u, false), true), \
                            __builtin_amdgcn_cvt_pk_fp8_f32(__uint_as_float(V.w << 16), __uint_as_float(V.w & 0xffff0000u), __builtin_amdgcn_cvt_pk_fp8_f32(__uint_as_float(V.z << 16), __uint_as_float(V.z & 0xffff0000u), 0u, false), true))
#define AS_ST(rr, A, B) do { const int4 s4 = *(const int4*)(slots + (wave * 8 + (rr)) * 4); const uint2 fa = AS_CV(A), fb = AS_CV(B); \
            unsigned char* d0 = HSd + (size_t)s4.x * D + lane * 8; *(uint2*)d0 = fa; *(uint2*)(d0 + 512) = fb; \
            unsigned char* d1 = HSd + (size_t)s4.y * D + lane * 8; *(uint2*)d1 = fa; *(uint2*)(d1 + 512) = fb; \
            unsigned char* d2 = HSd + (size_t)s4.z * D + lane * 8; *(uint2*)d2 = fa; *(uint2*)(d2 + 512) = fb; \
            unsigned char* d3 = HSd + (size_t)s4.w * D + lane * 8; *(uint2*)d3 = fa; *(uint2*)(d3 + 512) = fb; } while (0)
            AS_LD(0, a0, b0); AS_LD(1, a1, b1); AS_LD(2, a2, b2); AS_LD(3, a3, b3); AS_LD(4, a4, b4); AS_LD(5, a5, b5); AS_LD(6, a6, b6); AS_LD(7, a7, b7);
            AS_ST(0, a0, b0); AS_ST(1, a1, b1); AS_ST(2, a2, b2); AS_ST(3, a3, b3); AS_ST(4, a4, b4); AS_ST(5, a5, b5); AS_ST(6, a6, b6); AS_ST(7, a7, b7);
#undef AS_CV
#undef AS_LD
#undef AS_ST
        }
    }
}

struct EpiProj {
    static constexpr bool PERM = true, AFTER_DRAIN = false, WIDE = false;
    struct Pre {}; __device__ __forceinline__ void prefetch(Pre&, const pg8::Unit&, int, int, int, int) const {}
    bf16_t* O; const float* rope;
    __device__ __forceinline__ void operator()(const f32x4 (&acc)[2][2][4][2], const pg8::Unit& u, int wr, int wc, int fr, int fq, const Pre& pre) const {
        const int row0 = u.pm * 256 + wr * 64 + fr, col0 = u.pn * 256 + wc * 32 + 8 * fq;
        const bool do_rope = (u.pn < 2) && (u.pm < T / 256), do_gelu = (u.pn == 4) || (u.pn == 5);
        const float sc = u.pn == 0 ? QSCALE : (u.pn == 6 ? 0.125f * 1.4426950408889634f : 1.f);
        const float sgn = (fq & 1) ? 1.f : -1.f;
#pragma unroll
        for (int ai = 0; ai < 2; ++ai)
#pragma unroll
            for (int m = 0; m < 4; ++m) {
                const int row = row0 + ai * 128 + m * 16;
                bf16_t* rowp = O + (size_t)row * PW + col0;
                f32x4 cs[4];
                if (do_rope) {
                    const int s = row & 4095, pos = (fq >> 1) ? (s & 63) : (s >> 6);
                    const f32x4* rp = (const f32x4*)(rope + pos * 16);
                    cs[0] = rp[0]; cs[1] = rp[1]; cs[2] = rp[2]; cs[3] = rp[3];
                }
#pragma unroll
                for (int bj = 0; bj < 2; ++bj) {
                    f32x4 v0 = acc[ai][bj][m][0], v1 = acc[ai][bj][m][1];
                    if (do_rope) {
                        f32x4 b0, b1;
#pragma unroll
                        for (int j = 0; j < 4; ++j) { b0[j] = __shfl_xor(v0[j], 16); b1[j] = __shfl_xor(v1[j], 16); }
                        v0[0] = v0[0] * cs[0][0] + sgn * b0[0] * cs[0][1]; v0[1] = v0[1] * cs[0][2] + sgn * b0[1] * cs[0][3];
                        v0[2] = v0[2] * cs[1][0] + sgn * b0[2] * cs[1][1]; v0[3] = v0[3] * cs[1][2] + sgn * b0[3] * cs[1][3];
                        v1[0] = v1[0] * cs[2][0] + sgn * b1[0] * cs[2][1]; v1[1] = v1[1] * cs[2][2] + sgn * b1[1] * cs[2][3];
                        v1[2] = v1[2] * cs[3][0] + sgn * b1[2] * cs[3][1]; v1[3] = v1[3] * cs[3][2] + sgn * b1[3] * cs[3][3];
                    }
                    if (do_gelu) {
#pragma unroll
                        for (int j = 0; j < 4; ++j) { v0[j] = gelu_fast(v0[j]); v1[j] = gelu_fast(v1[j]); }
                    }
                    v0 = v0 * sc; v1 = v1 * sc;
                    u32x4 w; w.x = cvtpk(v0[0], v0[1]); w.y = cvtpk(v0[2], v0[3]); w.z = cvtpk(v1[0], v1[1]); w.w = cvtpk(v1[2], v1[3]);
                    *(u32x4*)(rowp + bj * 128) = w;
                }
            }
    }
};
template <bool RES_F32>
struct EpiOut {
    static constexpr bool PERM = true, AFTER_DRAIN = false, WIDE = false;
    struct Pre {}; __device__ __forceinline__ void prefetch(Pre&, const pg8::Unit&, int, int, int, int) const {}
    bf16_t* X; const float* gate; const float* res_lat; const float* res_ctx;
    __device__ __forceinline__ void operator()(const f32x4 (&acc)[2][2][4][2], const pg8::Unit& u, int wr, int wc, int fr, int fq, const Pre& pre) const {
        const int row0 = u.pm * 256 + wr * 64 + fr, col0 = u.pn * 256 + wc * 32 + 8 * fq;
        const float* g = gate + (size_t)mod_row(u.pm * 256) * 6144 + col0;
        f32x4 gv[2][2];
#pragma unroll
        for (int bj = 0; bj < 2; ++bj)
#pragma unroll
            for (int n = 0; n < 2; ++n) gv[bj][n] = *(const f32x4*)(g + bj * 128 + n * 4);
#pragma unroll
        for (int ai = 0; ai < 2; ++ai)
#pragma unroll
            for (int m = 0; m < 4; ++m) { const size_t off = (size_t)(row0 + ai * 128 + m * 16) * D + col0;
#pragma unroll
                for (int bj = 0; bj < 2; ++bj) {
                    f32x4 r0, r1;
                    if (RES_F32) { const float* rp = (u.pm < T / 256 ? res_lat : res_ctx) + off + bj * 128; r0 = *(const f32x4*)rp; r1 = *(const f32x4*)(rp + 4); }
                    else { const u32x4 w = *(const u32x4*)(X + off + bj * 128);
                        r0 = (f32x4){__uint_as_float(w.x << 16), __uint_as_float(w.x & 0xffff0000u), __uint_as_float(w.y << 16), __uint_as_float(w.y & 0xffff0000u)};
                        r1 = (f32x4){__uint_as_float(w.z << 16), __uint_as_float(w.z & 0xffff0000u), __uint_as_float(w.w << 16), __uint_as_float(w.w & 0xffff0000u)}; }
                    const f32x4 v0 = r0 + gv[bj][0] * acc[ai][bj][m][0], v1 = r1 + gv[bj][1] * acc[ai][bj][m][1];
                    u32x4 o; o.x = cvtpk(v0[0], v0[1]); o.y = cvtpk(v0[2], v0[3]); o.z = cvtpk(v1[0], v1[1]); o.w = cvtpk(v1[2], v1[3]);
                    *(u32x4*)(X + off + bj * 128) = o; } }
    }
};
__device__ __forceinline__ float swiglu(float g, float u) {
    const float gt = fminf(g, 7.0f), up = fminf(fmaxf(u, -7.0f), 7.0f);
    return (up + 1.0f) * gt * __builtin_amdgcn_rcpf(1.0f + __builtin_amdgcn_exp2f(-1.702f * 1.4426950408889634f * gt));
}
struct EpiAct {
    static constexpr bool PERM = true, AFTER_DRAIN = false, WIDE = false;
    unsigned char* ACT; const float* bgu;
    struct Pre { f32x4 bg0, bg1, bu0, bu1; };
    __device__ __forceinline__ void prefetch(Pre& q, const pg8::Unit& u, int wr, int wc, int fr, int fq) const {
        const float* bp = bgu + (size_t)u.e * 2048 + u.pn * 128 + wc * 32 + 8 * fq;
        q.bg0 = *(const f32x4*)(bp); q.bg1 = *(const f32x4*)(bp + 4); q.bu0 = *(const f32x4*)(bp + 1024); q.bu1 = *(const f32x4*)(bp + 1028);
    }
    __device__ __forceinline__ void operator()(const f32x4 (&acc)[2][2][4][2], const pg8::Unit& u, int wr, int wc, int fr, int fq, const Pre& pre) const {
        const int row0 = u.pm * 256 + wr * 64 + fr, j0 = u.pn * 128 + wc * 32 + 8 * fq;
        const f32x4 bg0 = pre.bg0, bg1 = pre.bg1, bu0 = pre.bu0, bu1 = pre.bu1;
#pragma unroll
        for (int ai = 0; ai < 2; ++ai)
#pragma unroll
            for (int m = 0; m < 4; ++m) {
                const f32x4 g0 = acc[ai][0][m][0] + bg0, g1 = acc[ai][0][m][1] + bg1, u0 = acc[ai][1][m][0] + bu0, u1 = acc[ai][1][m][1] + bu1;
                uint2 w;
                w.x = __builtin_amdgcn_cvt_pk_fp8_f32(swiglu(g0[2], u0[2]), swiglu(g0[3], u0[3]), __builtin_amdgcn_cvt_pk_fp8_f32(swiglu(g0[0], u0[0]), swiglu(g0[1], u0[1]), 0u, false), true);
                w.y = __builtin_amdgcn_cvt_pk_fp8_f32(swiglu(g1[2], u1[2]), swiglu(g1[3], u1[3]), __builtin_amdgcn_cvt_pk_fp8_f32(swiglu(g1[0], u1[0]), swiglu(g1[1], u1[1]), 0u, false), true);
                *(uint2*)(ACT + (size_t)(row0 + ai * 128 + m * 16) * FF + j0) = w;
            }
    }
};
__device__ __forceinline__ void wide_store16(bf16_t* rowp  , const size_t stride8, const u32x4 w0, const u32x4 w1, const bool lo) {
    u32x4 dA, dB;
#pragma unroll
    for (int q = 0; q < 4; ++q) {
        const unsigned snd = lo ? w1[q] : w0[q];
        const unsigned rcv = (unsigned)__builtin_amdgcn_mov_dpp((int)snd, 0x128, 0xf, 0xf, true);
        dA[q] = lo ? w0[q] : rcv; dB[q] = lo ? rcv : w1[q];
    }
    *(u32x4*)rowp = dA; *(u32x4*)(rowp + stride8) = dB;
}
struct EpiYB {
    static constexpr bool PERM = true, AFTER_DRAIN = false, WIDE = true;
    bf16_t* YB; const float* bdn;
    struct Pre { f32x4 bv[2][2]; };
    __device__ __forceinline__ void prefetch(Pre& q, const pg8::Unit& u, int wr, int wc, int fr, int fq) const {
        const float* bp = bdn + (size_t)u.e * D + u.pn * 256 + wc * 64 + 8 * fq;
#pragma unroll
        for (int bj = 0; bj < 2; ++bj)
#pragma unroll
            for (int n = 0; n < 2; ++n) q.bv[bj][n] = *(const f32x4*)(bp + bj * 32 + n * 4);
    }
    __device__ __forceinline__ void operator()(const f32x4 (&acc)[2][2][4][2], const pg8::Unit& u, int wr, int wc, int fr, int fq, const Pre& pre) const {
        const bool lo = fr < 8;
        const int row0 = u.pm * 256 + wr * 64 + (fr & 7), col0 = u.pn * 256 + wc * 64 + 8 * fq;
#pragma unroll
        for (int ai = 0; ai < 2; ++ai)
#pragma unroll
            for (int m = 0; m < 4; ++m) {
                u32x4 w[2];
#pragma unroll
                for (int bj = 0; bj < 2; ++bj) { const f32x4 v0 = acc[ai][bj][m][0] + pre.bv[bj][0], v1 = acc[ai][bj][m][1] + pre.bv[bj][1];
                    w[bj].x = cvtpk(v0[0], v0[1]); w[bj].y = cvtpk(v0[2], v0[3]); w[bj].z = cvtpk(v1[0], v1[1]); w[bj].w = cvtpk(v1[2], v1[3]); }
                wide_store16(YB + (size_t)(row0 + ai * 128 + m * 16) * D + col0 + (lo ? 0 : 32), (size_t)8 * D, w[0], w[1], lo);
            }
    }
};
struct MoeOrder {
    int nN, nunits, G, v; const int* tile_e;
    __device__ void init(int ntiles, int nN_, int G_, int c, const int* te) { nN = nN_; nunits = ntiles * nN_; G = G_; v = (G_ % 8 == 0) ? (c % 8) * (G_ / 8) + c / 8 : c; tile_e = te; }
    __device__ bool next(int i, pg8::Unit& u) const {
        const int L = i * G + v; if (L >= nunits) return false;
        u.pm = L / nN; u.pn = L % nN; u.e = tile_e[u.pm]; return true;
    }
    __device__ __forceinline__ const bf16_t* bt(const pg8::Gemm& g, const pg8::Unit& u) const { return g.Bt + (size_t)u.e * g.N * g.K; }
    __device__ __forceinline__ void a_ready(const pg8::Unit&) const {}
    __device__ __forceinline__ void done(const pg8::Unit&) const {}
};

__device__ __forceinline__ void ph_gemm_proj(const P& p, int l, char* lds, const int wv) {
    pg8::Gemm g{p.H, p.WinT + (size_t)l * PW * D, R, PW, D}; pg8::StaticOrder S; S.init(R, PW, (int)gridDim.x, (int)blockIdx.x);
    EpiProj E{p.PROJ, p.rope};
    pg8::gemm_phase<EpiProj, pg8::StaticOrder, true, true>((PG8_LAS unsigned char*)lds, g, S, E, wv);
}
__device__ __forceinline__ void ph_gemm_out(const P& p, int l, int nrows, char* lds, const int wv) {
    pg8::Gemm g{p.MIX, p.WoutT + (size_t)l * D * D, T, D, D}; pg8::StaticOrder S; S.init(T, D, (int)gridDim.x, (int)blockIdx.x);
    if (l == 0) { EpiOut<true> E{p.X, p.mod + (size_t)l * 5 * 6144 + 2 * 1024, p.x, p.ctx - (size_t)T * D}; pg8::gemm_phase<EpiOut<true>, pg8::StaticOrder, true, true>((PG8_LAS unsigned char*)lds, g, S, E, wv); }
    else { EpiOut<false> E{p.X, p.mod + (size_t)l * 5 * 6144 + 2 * 1024, nullptr, nullptr}; pg8::gemm_phase<EpiOut<false>, pg8::StaticOrder, true, true>((PG8_LAS unsigned char*)lds, g, S, E, wv); }
    if (nrows > T) {
        const int tid = ltid(wv), lane = tid & 63, wid = tid >> 6, fr = lane & 15, fq = lane >> 4;
        const bf16_t* Wt = p.WoutT + (size_t)l * D * D;
        const float* gate = p.mod + ((size_t)l * 5 + 4) * 6144 + 2 * 1024;
        for (int it = blockIdx.x; it < (TC / 64) * (D / 64); it += gridDim.x) {
            const int m0 = T + (it >> 4) * 64 + (wid & 3) * 16, n0 = (it & 15) * 64 + (wid >> 2) * 32;
            const bf16_t* ap = p.MIX + (size_t)(m0 + fr) * D + fq * 8;
            const bf16_t* bp0 = Wt + (size_t)(n0 + fr) * D + fq * 8;
            const bf16_t* bp1 = bp0 + (size_t)16 * D;
            f32x4 acc0 = (f32x4){0.f, 0.f, 0.f, 0.f}, acc1 = acc0;
#pragma unroll 8
            for (int ks = 0; ks < D / 32; ++ks) {
                const bf16x8 af = *(const bf16x8*)(ap + ks * 32), b0 = *(const bf16x8*)(bp0 + ks * 32), b1 = *(const bf16x8*)(bp1 + ks * 32);
                acc0 = __builtin_amdgcn_mfma_f32_16x16x32_bf16(b0, af, acc0, 0, 0, 0);
                acc1 = __builtin_amdgcn_mfma_f32_16x16x32_bf16(b1, af, acc1, 0, 0, 0);
            }
            const int row = m0 + fr, c0 = n0 + fq * 4;
            const size_t off = (size_t)row * D + c0;
            const float* res = p.ctx - (size_t)T * D;
            const f32x4 v0 = *(const f32x4*)(res + off) + *(const f32x4*)(gate + c0) * acc0, v1 = *(const f32x4*)(res + off + 16) + *(const f32x4*)(gate + c0 + 16) * acc1;
            uint2 o0, o1; o0.x = cvtpk(v0[0], v0[1]); o0.y = cvtpk(v0[2], v0[3]); o1.x = cvtpk(v1[0], v1[1]); o1.y = cvtpk(v1[2], v1[3]);
            *(uint2*)(p.X + off) = o0; *(uint2*)(p.X + off + 16) = o1;
        }
    }
}
__device__ __forceinline__ void ph_moe1(const P& p, int l, char* lds, const int wv) {
    const int* meta = p.moe_meta + l * 512;
    const int ntiles = meta[0];
    pg8::Gemm g{(const bf16_t*)p.HS, (const bf16_t*)(p.WguT + (size_t)l * NE * 2048 * D), ntiles * 256, 2048, D / 2}; MoeOrder S; S.init(ntiles, 8, (int)gridDim.x, (int)blockIdx.x, meta + 1);
    EpiAct E{p.ACT, p.b_gu + (size_t)l * NE * 2048};
    pg8::gemm_phase<EpiAct, MoeOrder, true, true, true>((PG8_LAS unsigned char*)lds, g, S, E, wv);
}
__device__ __forceinline__ void ph_moe2(const P& p, int l, char* lds, const int wv) {
    const int* meta = p.moe_meta + l * 512;
    const int ntiles = meta[0];
    pg8::Gemm g{(const bf16_t*)p.ACT, (const bf16_t*)(p.WdnT + (size_t)l * NE * D * FF), ntiles * 256, D, FF / 2}; MoeOrder S; S.init(ntiles, 4, (int)gridDim.x, (int)blockIdx.x, meta + 1);
    EpiYB E{p.YB, p.b_down + (size_t)l * NE * D};
    pg8::gemm_phase<EpiYB, MoeOrder, true, true, true>((PG8_LAS unsigned char*)lds, g, S, E, wv);
}
struct CombRow { uint4 y0[2], y1[2], y2[2], y3[2], xw[2]; float4 g; };
__device__ __forceinline__ void comb_load(CombRow& c, const bf16_t* __restrict__ YB, const bf16_t* __restrict__ X, const int* __restrict__ tok_slot, const float* __restrict__ topg, int row, int lane) {
    const int4 sl = *(const int4*)(tok_slot + (size_t)row * 4);
    c.g = *(const float4*)(topg + (size_t)row * 4);
#pragma unroll
    for (int i = 0; i < 2; ++i) {
        const int k = lane * 8 + 512 * i;
        c.y0[i] = *(const uint4*)(YB + (size_t)sl.x * D + k); c.y1[i] = *(const uint4*)(YB + (size_t)sl.y * D + k);
        c.y2[i] = *(const uint4*)(YB + (size_t)sl.z * D + k); c.y3[i] = *(const uint4*)(YB + (size_t)sl.w * D + k);
        c.xw[i] = *(const uint4*)(X + (size_t)row * D + k);
    }
}
__device__ __forceinline__ void comb_finish(const P& p, const CombRow& c, int l, int row, int lane) {
    const float* m = p.mod + ((size_t)l * 5 + mod_row(row)) * 6144 + 5 * 1024;
    const float4 g = c.g;
    float xv[16]; float ss = 0.f;
#pragma unroll
    for (int i = 0; i < 2; ++i) {
        const int k = lane * 8 + 512 * i;
        const unsigned a0[4] = {c.y0[i].x, c.y0[i].y, c.y0[i].z, c.y0[i].w}, a1[4] = {c.y1[i].x, c.y1[i].y, c.y1[i].z, c.y1[i].w};
        const unsigned a2[4] = {c.y2[i].x, c.y2[i].y, c.y2[i].z, c.y2[i].w}, a3[4] = {c.y3[i].x, c.y3[i].y, c.y3[i].z, c.y3[i].w};
        const unsigned xq[4] = {c.xw[i].x, c.xw[i].y, c.xw[i].z, c.xw[i].w};
        const float4 gta = *(const float4*)(m + k), gtb = *(const float4*)(m + k + 4);
        const float gt[8] = {gta.x, gta.y, gta.z, gta.w, gtb.x, gtb.y, gtb.z, gtb.w};
#pragma unroll
        for (int q = 0; q < 4; ++q) {
            const float ylo = g.x * __uint_as_float(a0[q] << 16) + g.y * __uint_as_float(a1[q] << 16) + g.z * __uint_as_float(a2[q] << 16) + g.w * __uint_as_float(a3[q] << 16);
            const float yhi = g.x * __uint_as_float(a0[q] & 0xffff0000u) + g.y * __uint_as_float(a1[q] & 0xffff0000u) + g.z * __uint_as_float(a2[q] & 0xffff0000u) + g.w * __uint_as_float(a3[q] & 0xffff0000u);
            const float v0 = __uint_as_float(xq[q] << 16) + gt[2 * q] * ylo, v1 = __uint_as_float(xq[q] & 0xffff0000u) + gt[2 * q + 1] * yhi;
            xv[8 * i + 2 * q] = v0; xv[8 * i + 2 * q + 1] = v1; ss += v0 * v0 + v1 * v1;
        }
    }
    ss = wave_sum(ss);
    const float rstd = rsqrtf(ss * (1.f / D) + EPS);
    if (l == 0) {
        const float* m1 = p.mod + ((size_t)5 + mod_row(row)) * 6144;
        const float* g1 = p.g_mix + D;
#pragma unroll
        for (int i = 0; i < 2; ++i) {
            const int k = lane * 8 + 512 * i;
            { u32x4 xo; xo.x = cvtpk(xv[8 * i], xv[8 * i + 1]); xo.y = cvtpk(xv[8 * i + 2], xv[8 * i + 3]); xo.z = cvtpk(xv[8 * i + 4], xv[8 * i + 5]); xo.w = cvtpk(xv[8 * i + 6], xv[8 * i + 7]); *(u32x4*)(p.X + (size_t)row * D + k) = xo; }
            const float4 ga = *(const float4*)(g1 + k), gb = *(const float4*)(g1 + k + 4);
            const float4 sha = *(const float4*)(m1 + k), shb = *(const float4*)(m1 + k + 4);
            const float4 sca = *(const float4*)(m1 + 1024 + k), scb = *(const float4*)(m1 + 1024 + k + 4);
            u32x4 o;
            o.x = cvtpk(xv[8 * i] * rstd * ga.x * (1.f + sca.x) + sha.x, xv[8 * i + 1] * rstd * ga.y * (1.f + sca.y) + sha.y);
            o.y = cvtpk(xv[8 * i + 2] * rstd * ga.z * (1.f + sca.z) + sha.z, xv[8 * i + 3] * rstd * ga.w * (1.f + sca.w) + sha.w);
            o.z = cvtpk(xv[8 * i + 4] * rstd * gb.x * (1.f + scb.x) + shb.x, xv[8 * i + 5] * rstd * gb.y * (1.f + scb.y) + shb.y);
            o.w = cvtpk(xv[8 * i + 6] * rstd * gb.z * (1.f + scb.z) + shb.z, xv[8 * i + 7] * rstd * gb.w * (1.f + scb.w) + shb.w);
            *(u32x4*)(p.H + (size_t)row * D + k) = o;
        }
    } else {
#pragma unroll
        for (int i = 0; i < 2; ++i) {
            const int k = lane * 8 + 512 * i;
            const float4 ga = *(const float4*)(p.g_final + k), gb = *(const float4*)(p.g_final + k + 4);
            float* op = p.out + (size_t)row * D + k;
            *(float4*)op = make_float4(xv[8 * i] * rstd * ga.x, xv[8 * i + 1] * rstd * ga.y, xv[8 * i + 2] * rstd * ga.z, xv[8 * i + 3] * rstd * ga.w);
            *(float4*)(op + 4) = make_float4(xv[8 * i + 4] * rstd * gb.x, xv[8 * i + 5] * rstd * gb.y, xv[8 * i + 6] * rstd * gb.z, xv[8 * i + 7] * rstd * gb.w);
        }
    }
}
__device__ __forceinline__ void ph_combine(const P& p, int l, int nrows, const int wv) {
    const int wave = ltid(wv) >> 6, lane = ltid(wv) & 63;
    for (int pr = blockIdx.x * 8 + wave; pr < nrows / 2; pr += gridDim.x * 8) {
        CombRow ca, cb;
        comb_load(ca, p.YB, p.X, p.tok_slot, p.topg, 2 * pr, lane);
        comb_load(cb, p.YB, p.X, p.tok_slot, p.topg, 2 * pr + 1, lane);
        comb_finish(p, ca, l, 2 * pr, lane);
        comb_finish(p, cb, l, 2 * pr + 1, lane);
    }
}
extern __shared__ __attribute__((aligned(16))) char smem[];
__global__ void __launch_bounds__(NT, 2) mega(P p) {
    char* lds = smem;
    int wv = __builtin_amdgcn_readfirstlane((int)(threadIdx.x >> 6)); asm volatile("" : "+s"(wv));
    if (threadIdx.x == 0) *(uint4*)(smem + LDS_MAIN) = make_uint4(0u, 0u, 0u, 0u);
    __syncthreads();
    XcdBarrier bar = xcd_barrier_post(p.bar, (volatile LAS unsigned*)(smem + LDS_MAIN), wv);
    ph_prologue(p, lds, 0, wv);
    xcd_barrier(bar);
    ph_norm1(p, 0, wv);
    ph_prologue(p, lds, 1, wv);
    xcd_barrier(bar);
#define MEGA_LAYER(l, nrows, LAST) do { \
        ph_gemm_proj(p, l, lds, wv); xcd_barrier(bar); \
        ph_dattn(p, l, nrows, lds, wv); ph_na(p, l, nrows, lds, wv); ph_pool(p, l, nrows, lds, wv); ph_sgu(p, l, nrows, lds, wv); xcd_barrier(bar); \
        ph_gemm_out(p, l, nrows, lds, wv); xcd_barrier(bar); \
        ph_router(p, l, nrows, lds, wv); xcd_barrier(bar); \
        ph_assign(p, l, nrows, lds, wv); xcd_barrier(bar); \
        ph_moe1(p, l, lds, wv); xcd_barrier(bar); \
        ph_moe2(p, l, lds, wv); xcd_barrier(bar); \
        ph_combine(p, l, nrows, wv); if (!(LAST)) xcd_barrier(bar); } while (0)
    MEGA_LAYER(0, R, false);
    MEGA_LAYER(1, T, true);
#undef MEGA_LAYER
}

static inline size_t align_up(size_t v, size_t a) { return (v + a - 1) / a * a; }

extern "C" void kernel_launch(void* const* d_in, const int* in_sizes, int n_in, void* d_out, int out_size, void* d_ws, size_t ws_size, hipStream_t stream) {
    P p{};
    const float** ins = (const float**)&p.x;
    for (int i = 0; i < 28; ++i) ins[i] = (const float*)d_in[i];
    p.out = (float*)d_out;
    char* w = (char*)d_ws; size_t off = 0;
    auto carve = [&](size_t bytes) { void* r = w + off; off = align_up(off + bytes, 256); return r; };
    const size_t ctl_bytes = XCD_BAR_WORDS * 4 + 2 * 64 * 4;
    p.bar = (unsigned*)carve(ctl_bytes);
    p.cnt = (int*)(p.bar + XCD_BAR_WORDS);
    p.mod = (float*)carve((size_t)2 * 5 * 6144 * 4);
    p.rope = (float*)carve(64 * 8 * 2 * 4);
    p.X = (bf16_t*)carve((size_t)R * D * 2);
    p.H = (bf16_t*)carve((size_t)R * D * 2);
    p.PROJ = (bf16_t*)carve((size_t)R * PW * 2);
    p.MIX = (bf16_t*)carve((size_t)R * D * 2);
    p.WinT = (bf16_t*)carve((size_t)2 * PW * D * 2);
    p.WoutT = (bf16_t*)carve((size_t)2 * D * D * 2);
    p.WguT = (unsigned char*)carve((size_t)2 * NE * 2048 * D);
    p.WdnT = (unsigned char*)carve((size_t)2 * NE * D * FF);
    p.WpT = (bf16_t*)carve((size_t)2 * 4 * 64 * 64 * 2);
    p.WsB = (bf16_t*)carve((size_t)2 * 4 * 128 * 128 * 2);
    p.topi = (int*)carve((size_t)R * 4 * 4);
    p.topg = (float*)carve((size_t)R * 4 * 4);
    p.tok_slot = (int*)carve((size_t)R * 4 * 4);
    p.moe_meta = (int*)carve(2 * 512 * 4);
    p.HS = (unsigned char*)carve((size_t)NSLOT * D);
    p.ACT = (unsigned char*)carve((size_t)NSLOT * FF);
    p.YB = (bf16_t*)carve((size_t)NSLOT * D * 2);

    static int grid = 0;
    if (!grid) {
        int dev = 0, cus = 0, per_cu = 0;
        (void)hipGetDevice(&dev);
        (void)hipDeviceGetAttribute(&cus, hipDeviceAttributeMultiprocessorCount, dev);
        (void)hipFuncSetAttribute((const void*)mega, hipFuncAttributeMaxDynamicSharedMemorySize, LDS_BYTES);
        (void)hipOccupancyMaxActiveBlocksPerMultiprocessor(&per_cu, mega, NT, LDS_BYTES);
        grid = cus * (per_cu < 1 ? per_cu : 1);
        if (grid <= 0) { fprintf(stderr, "mega: occupancy query returned %d blocks per CU\n", per_cu); grid = 0; return; }
    }
    (void)hipMemsetAsync(p.bar, 0, ctl_bytes, stream);
    mega<<<grid, NT, LDS_BYTES, stream>>>(p);
}
```

```cpp
#include <hip/hip_runtime.h>
#include <stdint.h>
#include <cstdio>

typedef unsigned short bf16_t;
typedef short bf16x8 __attribute__((ext_vector_type(8)));
typedef float f32x4 __attribute__((ext_vector_type(4)));

constexpr int D = 1024, NB = 4, S = 4096, T = NB * S, CL = 256, TC = NB * CL, R = T + TC;
constexpr int PW = 2304, NE = 32, TOPK = 4, FF = 1024;
constexpr int MAXSLOT = R * TOPK;
constexpr int NSLOT = MAXSLOT + NE * 256;
constexpr float EPS = 1e-6f;
constexpr int NT = 512;
constexpr int LDS_MAIN = 150 * 1024;
constexpr int LDS_BYTES = LDS_MAIN + 1024;

__device__ __forceinline__ bf16_t f2bf(float f) { unsigned u = __float_as_uint(f); return (bf16_t)((u + 0x7fffu + ((u >> 16) & 1u)) >> 16); }
__device__ __forceinline__ float bf2f(bf16_t h) { return __uint_as_float(((unsigned)h) << 16); }
__device__ __forceinline__ float wave_sum(float v) {
#pragma unroll
    for (int o = 32; o >= 1; o >>= 1) v += __shfl_xor(v, o);
    return v;
}
__device__ __forceinline__ int mod_row(int row) { return row < T ? (row >> 12) : 4; }

#define XB_TMO      128
#define XB_XCNT(j)  (256  + 64 * (j))
#define XB_XSUB(j)  (1280 + 64 * (j))
#define XB_XGEN(j)  (2304 + 64 * (j))
#define XB_TOP      3328
#define XB_TOPGEN   3392
#define XCD_BAR_WORDS 3456
#define XB_SPIN_CAP (1u << 18)
#define LAS __attribute__((address_space(3)))

__device__ __forceinline__ unsigned xb_ld(unsigned* p)              { return __hip_atomic_load(p, __ATOMIC_RELAXED, __HIP_MEMORY_SCOPE_AGENT); }
__device__ __forceinline__ unsigned xb_add(unsigned* p, unsigned v) { return __hip_atomic_fetch_add(p, v, __ATOMIC_RELAXED, __HIP_MEMORY_SCOPE_AGENT); }
__device__ __forceinline__ unsigned xb_xcc_id() { return (unsigned)__builtin_amdgcn_s_getreg((3 << 11) | 20) & 0xFu; }
#define XB_SPIN(cond, bar) do { unsigned _sp = 0; while (cond) { __builtin_amdgcn_s_sleep(1); \
    if ((++_sp & 255u) == 0u) { if (xb_ld(&(bar)[XB_TMO])) break; if (_sp > XB_SPIN_CAP) { atomicAdd(&(bar)[XB_TMO], 1u); break; } } } } while (0)

struct XcdBarrier {
    unsigned* bar; unsigned x;
    volatile LAS unsigned* st;
    int wv;
};
__device__ __forceinline__ bool xb_t0(const int wv) { return wv == 0 && __builtin_amdgcn_mbcnt_hi(~0u, __builtin_amdgcn_mbcnt_lo(~0u, 0u)) == 0u; }
__device__ __forceinline__ XcdBarrier xcd_barrier_post(unsigned* bar, volatile LAS unsigned* st, const int wv) {
    XcdBarrier b; b.bar = bar; b.x = xb_xcc_id(); b.st = st; b.wv = wv;
    if (xb_t0(wv)) (void)xb_add(&bar[XB_XCNT(b.x)], 1u);
    return b;
}
__device__ __forceinline__ void xcd_barrier_complete(unsigned* bar, unsigned x, unsigned& nloc, unsigned& nx) {
    const unsigned G = gridDim.x * gridDim.y * gridDim.z;
    unsigned sum, cnt, mine, sp = 0u;
    for (;;) {
        sum = 0u; cnt = 0u; mine = 0u;
#pragma unroll
        for (unsigned j = 0; j < 16; ++j) { const unsigned c = xb_ld(&bar[XB_XCNT(j)]); sum += c; cnt += (c > 0u) ? 1u : 0u; mine = (j == x) ? c : mine; }
        if (sum == G) break;
        __builtin_amdgcn_s_sleep(1);
        if ((++sp & 255u) == 0u) { if (xb_ld(&bar[XB_TMO])) break; if (sp > XB_SPIN_CAP) { atomicAdd(&bar[XB_TMO], 1u); break; } }
    }
    nloc = mine > 0u ? mine : 1u; nx = cnt > 0u ? cnt : 1u;
}
__device__ __forceinline__ void xcd_barrier(const XcdBarrier& b) {
    asm volatile("s_waitcnt vmcnt(0)" ::: "memory");
    __syncthreads();
    if (xb_t0(b.wv)) {
        unsigned* bar = b.bar;
        __builtin_amdgcn_s_waitcnt(0);
        unsigned nloc = b.st[0], nx = b.st[1];
        if (nloc == 0u) { xcd_barrier_complete(bar, b.x, nloc, nx); b.st[0] = nloc; b.st[1] = nx; }
        const unsigned old = xb_add(&bar[XB_XSUB(b.x)], 1u);
        const unsigned gen = old / nloc;
        if (old + 1u == (gen + 1u) * nloc) {
            __builtin_amdgcn_fence(__ATOMIC_RELEASE, "agent");
            asm volatile("s_waitcnt vmcnt(0)" ::: "memory");
            const unsigned og = xb_add(&bar[XB_TOP], 1u);
            const unsigned tg = og / nx;
            if (og + 1u == (tg + 1u) * nx) xb_add(&bar[XB_TOPGEN], 1u);
            else XB_SPIN(xb_ld(&bar[XB_TOPGEN]) == tg, bar);
            __builtin_amdgcn_fence(__ATOMIC_ACQUIRE, "agent");
            xb_add(&bar[XB_XGEN(b.x)], 1u);
            asm volatile("s_waitcnt vmcnt(0)" ::: "memory");
        } else {
            XB_SPIN(xb_ld(&bar[XB_XGEN(b.x)]) == gen, bar);
            __builtin_amdgcn_fence(__ATOMIC_ACQUIRE, "agent");
            asm volatile("s_waitcnt vmcnt(0)" ::: "memory");
        }
    }
    __syncthreads();
}

struct P {
    const float *x, *c, *ctx, *c_ctx, *w_mod, *b_mod, *g_mix, *g_ffn, *w_in, *w_out, *lam_q1, *lam_k1, *lam_q2, *lam_k2, *g_sub,
        *w_pool, *s_pool, *g_sgu, *w_sgu, *b_sgu, *rpb, *w_router, *b_router, *w_gu, *b_gu, *w_down, *b_down, *g_final;
    float* out;
    unsigned* bar;
    int* cnt;
    float* mod;
    float* rope;
    float* RG;
    float* RB;
    bf16_t* X;
    bf16_t* H;
    bf16_t* PROJ;
    bf16_t* MIX;
    bf16_t* WinT;
    bf16_t* WoutT;
    unsigned char* WguT;
    unsigned char* WdnT;
    bf16_t* WpT;
    bf16_t* WsB;
    int* topi;
    float* topg;
    int* tok_slot;
    int* moe_meta;
    unsigned char* HS;
    unsigned char* ACT;
    bf16_t* YB;
};

__device__ __forceinline__ int ltid(const int wv) { int t; asm volatile("v_mbcnt_lo_u32_b32 %0, -1, 0\n\tv_mbcnt_hi_u32_b32 %0, -1, %0\n\tv_lshl_or_b32 %0, %1, 6, %0" : "=&v"(t) : "s"(wv)); return t; }
typedef float f32x16 __attribute__((ext_vector_type(16)));
typedef short s16x4 __attribute__((ext_vector_type(4)));
typedef short v4i16_t __attribute__((ext_vector_type(4)));
typedef float f32x2_t __attribute__((ext_vector_type(2)));
typedef __bf16 bf16x2_t __attribute__((ext_vector_type(2)));
typedef __attribute__((address_space(3))) const char* lds_cptr;
typedef unsigned u32x4 __attribute__((ext_vector_type(4)));
__device__ __forceinline__ unsigned cvtpk(float lo, float hi) { f32x2_t v = {lo, hi}; bf16x2_t b = __builtin_convertvector(v, bf16x2_t); return __builtin_bit_cast(unsigned, b); }
__device__ __forceinline__ s16x4 vtr(lds_cptr q) { return __builtin_bit_cast(s16x4, __builtin_amdgcn_ds_read_tr16_b64_v4i16((__attribute__((address_space(3))) v4i16_t*)q)); }
__device__ __forceinline__ float xhalf_max(float v) { auto rr = __builtin_amdgcn_permlane32_swap(__float_as_uint(v), __float_as_uint(v), false, false); return fmaxf(__uint_as_float(rr[0]), __uint_as_float(rr[1])); }
__device__ __forceinline__ float xhalf_sum(float v) { auto rr = __builtin_amdgcn_permlane32_swap(__float_as_uint(v), __float_as_uint(v), false, false); return __uint_as_float(rr[0]) + __uint_as_float(rr[1]); }
namespace pg8 {
#define PG8_LAS __attribute__((address_space(3)))
constexpr int BM = 256, BK = 64, HALF = 128, HTB = HALF * BK * 2  , STAGE_BYTES = 8 * HTB, NXCD = 8, WGM = 8;
__host__ __device__ __forceinline__ int lds_byte(int r, int c) { const int st = (r >> 4) * 2 + (c >> 5), rr = r & 15, cc = c & 31, ob = rr * 64 + cc * 2; return st * 1024 + (ob ^ (((ob >> 9) & 1) << 5)); }
__host__ __device__ __forceinline__ void stage_rc(int b, int& R, int& C) { const int st = b / 1024, sb = b % 1024, swz = sb ^ (((sb >> 9) & 1) << 5); R = (st >> 1) * 16 + swz / 64; C = (st & 1) * 32 + (swz % 64) / 2; }
__host__ __device__ __forceinline__ int perm32(int rho) { const int n = rho >> 4, i = rho & 15; return 8 * (i >> 2) + 4 * n + (i & 3); }
struct Unit { int pm, pn, e; };
struct Gemm { const bf16_t* A; const bf16_t* Bt; int M, N, K; };
struct StaticOrder {
    int nM, nN, nwg, G, c;
    __host__ __device__ void init(int M, int N, int G_, int c_) { nM = M / BM; nN = N / BM; nwg = nM * nN; G = G_; c = c_; }
    __host__ __device__ bool next(int i, Unit& u) const {
        const long L = (long)i * G + c; if (L >= nwg) return false;
        int wgid = (int)L; { const int q = nwg / NXCD, r = nwg % NXCD, xcd = wgid % NXCD, off = wgid / NXCD; wgid = (xcd < r ? xcd * (q + 1) : r * (q + 1) + (xcd - r) * q) + off; }
        const int nig = WGM * nN, gid = wgid / nig, fm = gid * WGM, gsz = (nM - fm) < WGM ? (nM - fm) : WGM;
        u.pm = fm + ((wgid % nig) % gsz); u.pn = (wgid % nig) / gsz; u.e = 0; return true;
    }
    __device__ __forceinline__ const bf16_t* bt(const Gemm& g, const Unit&) const { return g.Bt; }
    __device__ __forceinline__ void a_ready(const Unit&) const {}
    __device__ __forceinline__ void done(const Unit&) const {}
};
typedef int v4i_t __attribute__((ext_vector_type(4)));
typedef int v8i_t __attribute__((ext_vector_type(8)));
__device__ __forceinline__ v8i_t cat8(bf16x8 a, bf16x8 b) { const v4i_t x = __builtin_bit_cast(v4i_t, a), y = __builtin_bit_cast(v4i_t, b); return __builtin_shufflevector(x, y, 0, 1, 2, 3, 4, 5, 6, 7); }
template <class Epi, class Sched, bool ALIGN_EPI = false, bool SP2 = false, bool F8 = false>
__device__ __forceinline__ void gemm_phase(PG8_LAS unsigned char* lds, const Gemm g, const Sched& S, const Epi& E, const int wv) {
    const int tid = ltid(wv), wid = __builtin_amdgcn_readfirstlane(tid >> 6), lane = tid & 63, wr = wid >> 2, wc = wid & 3, fr = lane & 15, fq = lane >> 4;
    const int K = g.K, nt = K / BK;
    unsigned voffA[2], voffB[2];
#pragma unroll
    for (int i = 0; i < 2; ++i) { int R, C; stage_rc(tid * 16 + i * 8192, R, C); const int Rb = Epi::WIDE ? ((R >> 5) * 64 + perm32(R & 31)) : Epi::PERM ? ((R & ~31) + perm32(R & 31)) : R;
        voffA[i] = (unsigned)(R * K + C) * 2u; voffB[i] = (unsigned)(Rb * K + C) * 2u; }
    const size_t kstep = (size_t)(BK * 2);
    const size_t hstep = (size_t)HALF * K * 2;
    const size_t tstep = 2 * hstep;
    const size_t bstep = Epi::WIDE ? (size_t)32 * K * 2 : hstep;
    const unsigned ldsw = (unsigned)wid * 1024u;
    const int aoff = lds_byte(wr * 64 + fr, fq * 8), boff = lds_byte(wc * 32 + fr, fq * 8);
#define PG8_SA(b, h) (((b) * 2 + (h)) * HTB)
#define PG8_SB(b, h) ((4 + (b) * 2 + (h)) * HTB)
#define PG8_STAGE(bufoff, gbase, voff) do { _Pragma("unroll") for (int _i = 0; _i < 2; ++_i) \
        __builtin_amdgcn_global_load_lds((const unsigned*)((const char*)(gbase) + (voff)[_i]), (PG8_LAS unsigned*)(lds + (bufoff) + ldsw + _i * 8192), 16, 0, 0); } while (0)
#define PG8_LDA(dst, b, h) do { _Pragma("unroll") for (int m = 0; m < 4; ++m) _Pragma("unroll") for (int k = 0; k < 2; ++k) dst[m][k] = *(const PG8_LAS bf16x8*)(lds + PG8_SA(b, h) + aoff + m * 2048 + k * 1024); \
        if constexpr (F8) { _Pragma("unroll") for (int m = 0; m < 4; ++m) dst##8[m] = cat8(dst[m][0], dst[m][1]); } } while (0)
#define PG8_LDB(dst, b, h) do { _Pragma("unroll") for (int n = 0; n < 2; ++n) _Pragma("unroll") for (int k = 0; k < 2; ++k) dst[n][k] = *(const PG8_LAS bf16x8*)(lds + PG8_SB(b, h) + boff + n * 2048 + k * 1024); \
        if constexpr (F8) { _Pragma("unroll") for (int n = 0; n < 2; ++n) dst##8[n] = cat8(dst[n][0], dst[n][1]); } } while (0)
#define PG8_MMA(ai, bj, At, Bt) do { __builtin_amdgcn_s_setprio(1); \
        if constexpr (F8) { _Pragma("unroll") for (int m = 0; m < 4; ++m) _Pragma("unroll") for (int n = 0; n < 2; ++n) \
            asm volatile("v_mfma_scale_f32_16x16x128_f8f6f4 %0, %1, %2, %0, %3, %4 op_sel_hi:[0,0,0]" : "+v"(acc[ai][bj][m][n]) : "v"(Bt##8[n]), "v"(At##8[m]), "v"(sclW), "v"(sclX)); } \
        else { _Pragma("unroll") for (int m = 0; m < 4; ++m) _Pragma("unroll") for (int n = 0; n < 2; ++n) _Pragma("unroll") for (int k = 0; k < 2; ++k) \
            acc[ai][bj][m][n] = __builtin_amdgcn_mfma_f32_16x16x32_bf16(Bt[n][k], At[m][k], acc[ai][bj][m][n], 0, 0, 0); } \
        __builtin_amdgcn_s_setprio(0); } while (0)
#define PG8_WAIT_V(n) asm volatile("s_waitcnt vmcnt(" #n ")" ::: "memory")
#define PG8_WAIT_L(n) asm volatile("s_waitcnt lgkmcnt(" #n ")" ::: "memory")
#define PG8_BAR __builtin_amdgcn_s_barrier()
#define PG8_SCHED __builtin_amdgcn_sched_barrier(0)
    Unit cur, nxt; int ui = 0;
    typename Epi::Pre pre;
    if (!S.next(0, cur)) return;
    f32x4 acc[2][2][4][2];
#pragma unroll
    for (int a = 0; a < 2; ++a)
#pragma unroll
        for (int b = 0; b < 2; ++b)
#pragma unroll
            for (int m = 0; m < 4; ++m)
#pragma unroll
                for (int n = 0; n < 2; ++n) { acc[a][b][m][n] = (f32x4){0.f, 0.f, 0.f, 0.f}; }
    bf16x8 At[4][2], B0[2][2], B1[2][2];
    v8i_t At8[4], B08[2], B18[2];
    const int sclW = 0x79797979, sclX = 0x7f7f7f7f;
    const char* cA = (const char*)g.A + (size_t)cur.pm * tstep; const char* cB = (const char*)S.bt(g, cur) + (size_t)cur.pn * tstep;
    S.a_ready(cur);
    if constexpr (SP2) {
        PG8_STAGE(PG8_SB(0, 0), cB, voffB); PG8_STAGE(PG8_SB(0, 1), cB + bstep, voffB); PG8_STAGE(PG8_SA(0, 0), cA, voffA); PG8_STAGE(PG8_SA(0, 1), cA + hstep, voffA);
        if (wr == 1) PG8_BAR;
        PG8_WAIT_V(2); PG8_BAR;
        PG8_STAGE(PG8_SB(1, 0), cB + kstep, voffB); PG8_STAGE(PG8_SA(1, 0), cA + kstep, voffA); PG8_STAGE(PG8_SB(1, 1), cB + bstep + kstep, voffB);
        PG8_WAIT_V(6); PG8_BAR;
    } else {
        PG8_STAGE(PG8_SB(0, 0), cB, voffB); PG8_STAGE(PG8_SA(0, 0), cA, voffA); PG8_STAGE(PG8_SB(0, 1), cB + bstep, voffB); PG8_STAGE(PG8_SA(0, 1), cA + hstep, voffA);
        if (wr == 1) PG8_BAR;
        PG8_WAIT_V(4); PG8_BAR;
        PG8_STAGE(PG8_SB(1, 0), cB + kstep, voffB); PG8_STAGE(PG8_SA(1, 0), cA + kstep, voffA); PG8_STAGE(PG8_SB(1, 1), cB + bstep + kstep, voffB);
        PG8_WAIT_V(6); PG8_BAR;
    }
    for (;;) {
        const bool has_next = S.next(ui + 1, nxt);
        const char* nA = has_next ? (const char*)g.A + (size_t)nxt.pm * tstep : cA; const char* nB = has_next ? (const char*)S.bt(g, nxt) + (size_t)nxt.pn * tstep : cB;
#pragma unroll 1
        for (int t = 0; t < nt; t += 2) {
            const bool last = (t == nt - 2);
            const char* a1 = cA + (size_t)(t + 1) * kstep;
            const char* a2 = last ? nA : cA + (size_t)(t + 2) * kstep; const char* b2 = last ? nB : cB + (size_t)(t + 2) * kstep;
            const char* a3 = a2 + kstep; const char* b3 = b2 + kstep;
            if (last && has_next) S.a_ready(nxt);
            if (last) E.prefetch(pre, cur, wr, wc, fr, fq);
            if constexpr (SP2) {
            PG8_LDB(B0, 0, 0); PG8_LDB(B1, 0, 1); PG8_SCHED; PG8_LDA(At, 0, 0); PG8_STAGE(PG8_SA(1, 1), a1 + hstep, voffA);
            PG8_WAIT_V(8); PG8_WAIT_L(0); PG8_BAR; PG8_MMA(0, 0, At, B0); PG8_MMA(0, 1, At, B1); PG8_BAR; PG8_SCHED;
            PG8_LDA(At, 0, 1); PG8_STAGE(PG8_SB(0, 0), b2, voffB); PG8_STAGE(PG8_SB(0, 1), b2 + bstep, voffB); PG8_STAGE(PG8_SA(0, 0), a2, voffA);
            PG8_WAIT_V(8); PG8_WAIT_L(0); PG8_BAR; PG8_MMA(1, 0, At, B0); PG8_MMA(1, 1, At, B1); PG8_BAR; PG8_SCHED;
            PG8_LDB(B0, 1, 0); PG8_LDB(B1, 1, 1); PG8_SCHED; PG8_LDA(At, 1, 0); PG8_STAGE(PG8_SA(0, 1), a2 + hstep, voffA);
            PG8_WAIT_V(8); PG8_WAIT_L(0); PG8_BAR; PG8_MMA(0, 0, At, B0); PG8_MMA(0, 1, At, B1); PG8_BAR; PG8_SCHED;
            PG8_LDA(At, 1, 1); PG8_STAGE(PG8_SB(1, 0), b3, voffB); PG8_STAGE(PG8_SB(1, 1), b3 + bstep, voffB); PG8_STAGE(PG8_SA(1, 0), a3, voffA);
            PG8_WAIT_V(8); PG8_WAIT_L(0); PG8_BAR; PG8_MMA(1, 0, At, B0); PG8_MMA(1, 1, At, B1); PG8_BAR; PG8_SCHED;
            } else {
            PG8_LDB(B0, 0, 0); PG8_SCHED; PG8_LDA(At, 0, 0); PG8_STAGE(PG8_SA(1, 1), a1 + hstep, voffA);
            PG8_WAIT_L(8); PG8_BAR; PG8_WAIT_L(0); PG8_MMA(0, 0, At, B0); PG8_BAR; PG8_SCHED;
            PG8_LDB(B1, 0, 1); PG8_STAGE(PG8_SB(0, 0), b2, voffB);
            PG8_BAR; PG8_WAIT_L(0); PG8_MMA(0, 1, At, B1); PG8_BAR;
            PG8_LDA(At, 0, 1); PG8_STAGE(PG8_SA(0, 0), a2, voffA);
            PG8_BAR; PG8_WAIT_L(0); PG8_MMA(1, 0, At, B0); PG8_BAR; PG8_SCHED;
            PG8_STAGE(PG8_SB(0, 1), b2 + bstep, voffB);
            PG8_WAIT_V(6); PG8_BAR; PG8_MMA(1, 1, At, B1); PG8_BAR;
            PG8_LDB(B0, 1, 0); PG8_SCHED; PG8_LDA(At, 1, 0); PG8_STAGE(PG8_SA(0, 1), a2 + hstep, voffA);
            PG8_WAIT_L(8); PG8_BAR; PG8_WAIT_L(0); PG8_MMA(0, 0, At, B0); PG8_BAR; PG8_SCHED;
            PG8_LDB(B1, 1, 1); PG8_STAGE(PG8_SB(1, 0), b3, voffB);
            PG8_BAR; PG8_WAIT_L(0); PG8_MMA(0, 1, At, B1); PG8_BAR;
            PG8_LDA(At, 1, 1); PG8_STAGE(PG8_SA(1, 0), a3, voffA);
            PG8_BAR; PG8_WAIT_L(0); PG8_MMA(1, 0, At, B0); PG8_BAR; PG8_SCHED;
            PG8_STAGE(PG8_SB(1, 1), b3 + bstep, voffB);
            PG8_WAIT_V(6); PG8_BAR; PG8_MMA(1, 1, At, B1); PG8_BAR;
            }
        }
        if constexpr (ALIGN_EPI) { if (wr == 0) PG8_BAR; }
        if constexpr (F8) asm volatile("s_nop 15\n\ts_nop 15" ::: "memory");
        if constexpr (!Epi::AFTER_DRAIN) { E(acc, cur, wr, wc, fr, fq, pre); S.done(cur); }
        if (!has_next) break;
#pragma unroll
        for (int a = 0; a < 2; ++a)
#pragma unroll
            for (int b = 0; b < 2; ++b)
#pragma unroll
                for (int m = 0; m < 4; ++m)
#pragma unroll
                    for (int n = 0; n < 2; ++n) { acc[a][b][m][n] = (f32x4){0.f, 0.f, 0.f, 0.f}; }
        cur = nxt; cA = nA; cB = nB; ++ui;
        if constexpr (ALIGN_EPI) { if (wr == 1) PG8_BAR; }
    }
    PG8_WAIT_V(0);
    if constexpr (!ALIGN_EPI) { if (wr == 0) PG8_BAR; }
    PG8_BAR;
    if constexpr (Epi::AFTER_DRAIN) { E.fused(acc, cur, wr, wc, fr, fq, lds, wid, lane); S.done(cur); }
#undef PG8_SA
#undef PG8_SB
#undef PG8_STAGE
#undef PG8_LDA
#undef PG8_LDB
#undef PG8_MMA
#undef PG8_WAIT_V
#undef PG8_WAIT_L
#undef PG8_BAR
#undef PG8_SCHED
}
}

__device__ __forceinline__ void ph_prologue(const P& p, char* lds, const int part, const int wv) {
    const int tid = ltid(wv);
    float* fl = (float*)lds;
    if (part == 0) {
    for (int it = blockIdx.x; it < 192; it += gridDim.x) {
        const int l = it / 96, cg = it % 96;
        float* sc = fl;
        float* part = fl + 5 * 1024;
        __syncthreads();
        for (int i = tid; i < 5 * 1024; i += NT) {
            const int r = i >> 10, k = i & 1023;
            const float v = r < 4 ? p.c[r * 1024 + k] : p.c_ctx[k];
            sc[i] = v / (1.f + __expf(-v));
        }
        __syncthreads();
        const int kq = tid >> 6, col = tid & 63, j = cg * 64 + col;
        const float* W = p.w_mod + (size_t)l * 1024 * 6144 + j;
        float a0 = 0, a1 = 0, a2 = 0, a3 = 0, a4 = 0;
#pragma unroll 16
        for (int k = kq * 128; k < kq * 128 + 128; ++k) {
            const float w = W[(size_t)k * 6144];
            a0 += sc[k] * w; a1 += sc[1024 + k] * w; a2 += sc[2048 + k] * w; a3 += sc[3072 + k] * w; a4 += sc[4096 + k] * w;
        }
        part[(kq * 5 + 0) * 64 + col] = a0; part[(kq * 5 + 1) * 64 + col] = a1; part[(kq * 5 + 2) * 64 + col] = a2;
        part[(kq * 5 + 3) * 64 + col] = a3; part[(kq * 5 + 4) * 64 + col] = a4;
        __syncthreads();
        if (tid < 5 * 64) {
            const int r = tid >> 6, cc = tid & 63, jj = cg * 64 + cc;
            float v = 0.f;
#pragma unroll
            for (int q = 0; q < 8; ++q) v += part[(q * 5 + r) * 64 + cc];
            p.mod[((size_t)l * 5 + r) * 6144 + jj] = v + p.b_mod[l * 6144 + jj];
        }
    }
    if (blockIdx.x == gridDim.x - 1) {
        const int pos = tid >> 3, f = tid & 7;
        const float inv = powf(10000.0f, -(float)f / 8.0f);
        const float ang = (float)pos * inv;
        p.rope[tid * 2] = cosf(ang); p.rope[tid * 2 + 1] = sinf(ang);
    }
    for (int i = blockIdx.x * NT + tid; i < 2 * 4 * 64 * 64; i += gridDim.x * NT) { const int ii = i & 63, j = (i >> 6) & 63, lg = i >> 12; p.WpT[i] = f2bf(p.w_pool[(size_t)lg * 4096 + ii * 64 + j]); }
    for (int i = blockIdx.x * NT + tid; i < 2 * 4 * 128 * 128; i += gridDim.x * NT) p.WsB[i] = f2bf(p.w_sgu[i]);
    }
    if (part == 1) {
        for (int i = blockIdx.x * NT + tid; i < 2 * 5 * 1024; i += gridDim.x * NT) { const int k = i & 1023, lb = i >> 10, l_ = lb / 5; p.RG[i] = p.g_ffn[l_ * D + k] * (1.f + p.mod[(size_t)lb * 6144 + 4 * 1024 + k]); }
        for (int o = blockIdx.x * 8 + (tid >> 6); o < 2 * 5 * 32; o += gridDim.x * 8) {
            const int e = o & 31, lb = o >> 5, l_ = lb / 5, ln = tid & 63;
            const float* sh = p.mod + (size_t)lb * 6144 + 3 * 1024; const float* wr = p.w_router + (size_t)l_ * D * NE + e;
            float a = 0.f;
            for (int k = ln; k < 1024; k += 64) a += sh[k] * wr[(size_t)k * NE];
            a = wave_sum(a);
            if (ln == 0) p.RB[o] = a + p.b_router[l_ * NE + e];
        }
        const int n_in = 2 * 9 * 16, n_out = 2 * 4 * 16, total = n_in + n_out;
        const int kr = tid >> 6, n4 = tid & 63, kg = tid & 7, nl = tid >> 3;
        for (int it = blockIdx.x; it < total; it += gridDim.x) {
            int i_ = it; const float* W_; bf16_t* Wt_; int N, K;
            if (i_ < n_in) { W_ = p.w_in; Wt_ = p.WinT; N = PW; K = D; } else { i_ -= n_in; W_ = p.w_out; Wt_ = p.WoutT; N = D; K = D; }
            const int ntn = N / 256, per = ntn * (K / 64), m_ = i_ / per, r_ = i_ % per, tn = r_ % ntn, tk = r_ / ntn, n0 = tn * 256;
            const float* src = W_ + (size_t)m_ * K * N + (size_t)(tk * 64) * N + n0; bf16_t* dst = Wt_ + (size_t)m_ * K * N + tk * 64;
            float4 rg[8];
#pragma unroll
            for (int i = 0; i < 8; ++i) rg[i] = *(const float4*)(src + (size_t)(kr + 8 * i) * N + n4 * 4);
            __syncthreads();
#pragma unroll
            for (int i = 0; i < 8; ++i) { float* q = fl + (kr + 8 * i) * 257 + n4 * 4; q[0] = rg[i].x; q[1] = rg[i].y; q[2] = rg[i].z; q[3] = rg[i].w; }
            __syncthreads();
#pragma unroll
            for (int j = 0; j < 4; ++j) {
                const int n = nl + 64 * j;
                const float* q = fl + (8 * kg) * 257 + n;
                u32x4 w;
                w.x = cvtpk(q[0], q[257]); w.y = cvtpk(q[2 * 257], q[3 * 257]); w.z = cvtpk(q[4 * 257], q[5 * 257]); w.w = cvtpk(q[6 * 257], q[7 * 257]);
                *(u32x4*)(dst + (size_t)(n0 + n) * K + 8 * kg) = w;
            }
        }
    }
}

__device__ __forceinline__ void ph_norm1(const P& p, int l, const int wv) {
    const int wave = ltid(wv) >> 6, lane = ltid(wv) & 63;
    for (int row = blockIdx.x * 8 + wave; row < R; row += gridDim.x * 8) {
        const float* xr = row < T ? p.x + (size_t)row * D : p.ctx + (size_t)(row - T) * D;
        float4 v[4]; float ss = 0;
#pragma unroll
        for (int i = 0; i < 4; ++i) { v[i] = *(const float4*)(xr + lane * 4 + 256 * i); ss += v[i].x * v[i].x + v[i].y * v[i].y + v[i].z * v[i].z + v[i].w * v[i].w; }
        ss = wave_sum(ss);
        const float rstd = rsqrtf(ss * (1.f / D) + EPS);
        const float* m = p.mod + ((size_t)l * 5 + mod_row(row)) * 6144;
        const float* g = p.g_mix + l * D;
#pragma unroll
        for (int i = 0; i < 4; ++i) {
            const int k = lane * 4 + 256 * i;
            const float4 gg = *(const float4*)(g + k), sh = *(const float4*)(m + k), sc = *(const float4*)(m + 1024 + k);
            uint2 o;
            o.x = cvtpk(v[i].x * rstd * gg.x * (1.f + sc.x) + sh.x, v[i].y * rstd * gg.y * (1.f + sc.y) + sh.y);
            o.y = cvtpk(v[i].z * rstd * gg.z * (1.f + sc.z) + sh.z, v[i].w * rstd * gg.w * (1.f + sc.w) + sh.w);
            *(uint2*)(p.H + (size_t)row * D + k) = o;
        }
    }
}

constexpr float QSCALE = 0.17677669529663687f * 1.4426950408889634f;
__device__ __forceinline__ void dsoftmax(const f32x16& s, float& m, float& l, f32x16& o0, f32x16& o1, bf16x8& pa, bf16x8& pb) {
    float mx = fmaxf(fmaxf(fmaxf(s[0], s[1]), fmaxf(s[2], s[3])), fmaxf(fmaxf(s[4], s[5]), fmaxf(s[6], s[7])));
    mx = fmaxf(mx, fmaxf(fmaxf(fmaxf(s[8], s[9]), fmaxf(s[10], s[11])), fmaxf(fmaxf(s[12], s[13]), fmaxf(s[14], s[15]))));
    mx = xhalf_max(mx);
    if (__any(mx > m)) {
        const float mn = fmaxf(m, mx), alpha = __builtin_amdgcn_exp2f(m - mn);
        o0 *= alpha; o1 *= alpha; l *= alpha; m = mn;
    }
    float pr[16]; float sum = 0.f;
#pragma unroll
    for (int r = 0; r < 16; ++r) { pr[r] = __builtin_amdgcn_exp2f(s[r] - m); sum += pr[r]; }
    l += sum;
    u32x4 a, b;
    a[0] = cvtpk(pr[0], pr[1]); a[1] = cvtpk(pr[2], pr[3]); a[2] = cvtpk(pr[4], pr[5]); a[3] = cvtpk(pr[6], pr[7]);
    b[0] = cvtpk(pr[8], pr[9]); b[1] = cvtpk(pr[10], pr[11]); b[2] = cvtpk(pr[12], pr[13]); b[3] = cvtpk(pr[14], pr[15]);
    pa = __builtin_bit_cast(bf16x8, a); pb = __builtin_bit_cast(bf16x8, b);
}
#define MX3(a, b, c) __builtin_fmaxf(__builtin_fmaxf((a), (b)), (c))
template <int THR>
__device__ __forceinline__ void dsoftmax2(f32x16& s, float& m, float& l, f32x16& o0, f32x16& o1, bf16x8& pa, bf16x8& pb, const bool first) {
    float a = MX3(s[0], s[1], s[2]), b = MX3(s[3], s[4], s[5]);
    a = MX3(a, s[6], s[7]); b = MX3(b, s[8], s[9]); a = MX3(a, s[10], s[11]); b = MX3(b, s[12], s[13]); a = MX3(a, s[14], s[15]);
    const float mx = xhalf_max(__builtin_fmaxf(a, b));
    if (first || __any(mx > m + (float)THR)) {
        const float mn = first ? mx : __builtin_fmaxf(mx, m), alpha = first ? 1.f : __builtin_amdgcn_exp2f(m - mn);
        m = mn; o0 *= alpha; o1 *= alpha; l *= alpha;
    }
    float sum = 0.f;
#pragma unroll
    for (int r = 0; r < 16; ++r) { s[r] = __builtin_amdgcn_exp2f(s[r] - m); sum += s[r]; }
    l += sum;
    u32x4 wa, wb;
    wa[0] = cvtpk(s[0], s[1]); wa[1] = cvtpk(s[2], s[3]); wa[2] = cvtpk(s[4], s[5]); wa[3] = cvtpk(s[6], s[7]);
    wb[0] = cvtpk(s[8], s[9]); wb[1] = cvtpk(s[10], s[11]); wb[2] = cvtpk(s[12], s[13]); wb[3] = cvtpk(s[14], s[15]);
    pa = __builtin_bit_cast(bf16x8, wa); pb = __builtin_bit_cast(bf16x8, wb);
}
typedef __attribute__((address_space(1))) const float* gcf32_t;
typedef __attribute__((address_space(1))) unsigned char* gu8_t;
typedef __attribute__((address_space(1))) const char* gcc_t;
typedef short v2i16_t __attribute__((ext_vector_type(2)));
struct CvT { gcc_t src; gu8_t dst; int n4; };
struct CvW { gcf32_t gu, dn; gu8_t guT, dnT; int b0, G; };
__device__ __forceinline__ void glds16x2(gcc_t sbase, unsigned voff0, unsigned voff1, unsigned lds_dst) { unsigned keep;
    asm volatile("s_mov_b32 %0, m0\n\ts_mov_b32 m0, %4\n\ts_nop 0\n\tglobal_load_lds_dwordx4 %1, %3\n\ts_add_u32 m0, m0, 0x2000\n\ts_nop 0\n\tglobal_load_lds_dwordx4 %2, %3\n\ts_mov_b32 m0, %0"
                 : "=&s"(keep) : "v"(voff0), "v"(voff1), "s"(sbase), "s"(lds_dst) : "memory", "scc"); }
__device__ __forceinline__ void glds16x4(gcc_t sbase, unsigned voff, unsigned vstride, unsigned lds_dst) { unsigned keep;
    asm volatile("s_mov_b32 %0, m0\n\ts_mov_b32 m0, %4\n\ts_nop 0\n\tglobal_load_lds_dwordx4 %1, %3\n\t"
                 "s_add_u32 m0, m0, 0x400\n\tv_add_u32 %1, %2, %1\n\tglobal_load_lds_dwordx4 %1, %3\n\t"
                 "s_add_u32 m0, m0, 0x400\n\tv_add_u32 %1, %2, %1\n\tglobal_load_lds_dwordx4 %1, %3\n\t"
                 "s_add_u32 m0, m0, 0x400\n\tv_add_u32 %1, %2, %1\n\tglobal_load_lds_dwordx4 %1, %3\n\ts_mov_b32 m0, %0"
                 : "=&s"(keep), "+v"(voff) : "s"(vstride), "s"(sbase), "s"(lds_dst) : "memory", "scc"); }
#if defined(__HIP_DEVICE_COMPILE__)
#define KARG_PTR(T_, member) ({ unsigned long long r_; asm volatile("s_load_dwordx2 %0, %1, %2\n\ts_waitcnt lgkmcnt(0)" : "=s"(r_) : "s"(__builtin_amdgcn_kernarg_segment_ptr()), "n"((int)__builtin_offsetof(P, member)) : "memory"); (T_)r_; })
#else
#define KARG_PTR(T_, member) ((T_)(unsigned long long)p.member)
#endif
__device__ __forceinline__ bool cv_pair(const CvW& w, int q, CvT& c) {
    constexpr int n_gu = NE * 8 * 16, n_dn = NE * 8 * 8;
    const int tile = w.b0 + q * w.G;
    if (tile >= n_gu + n_dn) return false;
    if (tile < n_gu) {
        const int e = tile >> 7, tn = tile & 15, tk = (tile >> 4) & 7, np0 = (tn & 7) * 256 + (tn >> 3) * 128;
        c.n4 = 2048 * 4;
        c.src = (gcc_t)(w.gu + ((size_t)e * 1024 + tk * 128) * 2048 + tn * 128);
        c.dst = w.guT + ((size_t)e * 2048 + np0) * 1024 + tk * 128;
    } else {
        const int i_ = tile - n_gu, e = i_ >> 6, tn = i_ & 7, tk = (i_ >> 3) & 7;
        c.n4 = 1024 * 4;
        c.src = (gcc_t)(w.dn + ((size_t)e * 1024 + tk * 128) * 1024 + tn * 128);
        c.dst = w.dnT + ((size_t)e * 1024 + tn * 128) * 1024 + tk * 128;
    }
    return true;
}
__device__ __forceinline__ void cv_store(gu8_t dst, const char* q0, const unsigned goff) {
    const float* q = (const float*)q0;
    u32x4 w;
#pragma unroll
    for (int d = 0; d < 4; ++d) {
        v2i16_t r = {0, 0};
        r = __builtin_amdgcn_cvt_scalef32_pk_fp8_f32(r, q[(2 * d) * 256], q[(2 * d) * 256 + 128], 0.015625f, false);
        r = __builtin_amdgcn_cvt_scalef32_pk_fp8_f32(r, q[(2 * d + 1) * 256], q[(2 * d + 1) * 256 + 128], 0.015625f, true);
        w[d] = __builtin_bit_cast(unsigned, r);
    }
    *(__attribute__((address_space(1))) u32x4*)(dst + goff) = w;
}
constexpr int CV_LDS = 32768;
__device__ __forceinline__ void ph_dattn(const P& p, int l, int nrows, char* lds, const int wv) {
    const int tid = ltid(wv), lane = tid & 63, wid = wv, r32 = lane & 31, hi = lane >> 5;
    float la = lane < 32 ? p.lam_q1[l * 32 + lane] * p.lam_k1[l * 32 + lane] : 0.f;
    float lb = lane < 32 ? p.lam_q2[l * 32 + lane] * p.lam_k2[l * 32 + lane] : 0.f;
    la = wave_sum(la); lb = wave_sum(lb);
    const float lam_init = 0.8f - 0.6f * expf(-0.3f * (float)l);
    const float lam = expf(la) - expf(lb) + lam_init;
    const bf16_t* PR = p.PROJ;
    const int nunits = (nrows == R) ? 256 + 16 : 256;
    const int vkey = (2 * (wid & 3) + (lane >> 5)) * 8 + ((lane >> 2) & 7), vchunk = (wid >> 2) * 4 + (lane & 3);
    const int vb = ((lane >> 4) & 1) * 32 + (lane & 3) * 8 + (4 * hi + ((lane & 15) >> 2)) * 64;
    const unsigned lds0 = (unsigned)(uintptr_t)lds;
    CvW cw; cw.gu = KARG_PTR(gcf32_t, w_gu) + (size_t)l * NE * 1024 * 2048; cw.guT = KARG_PTR(gu8_t, WguT) + (size_t)l * NE * 2048 * 1024;
    cw.dn = KARG_PTR(gcf32_t, w_down) + (size_t)l * NE * 1024 * 1024; cw.dnT = KARG_PTR(gu8_t, WdnT) + (size_t)l * NE * 1024 * 1024;
    { int b0 = blockIdx.x, G = gridDim.x; asm volatile("" : "+s"(b0), "+s"(G)); cw.b0 = b0; cw.G = G; }
    const unsigned cv_row = 8 * wid + (lane >> 5), cv_sw = (unsigned)(((lane & 31) ^ (((wid >> 1) & 1) << 2)) * 16);
    const int cv_n = 16 * wid + (lane >> 2), cv_kg = lane & 3;
    const int cv_lo = cv_kg * 8192 + (((cv_n >> 2) ^ ((cv_kg & 1) << 2)) * 16) + (cv_n & 3) * 4;
    const unsigned cv_go = (unsigned)(cv_n * 1024 + 16 * cv_kg);
    int cj = 0, cb = 0, ca = 0;
    CvT cp; bool cpok = false;
    gu8_t dstA = nullptr; bool hasA = false;
#define CV_NEXT(hasB_, dstB_) do { \
        if ((cj & 1) == 0) cpok = cv_pair(cw, cj >> 1, cp); else { cp.src += 64 * cp.n4; cp.dst += 64; } \
        hasB_ = cpok; dstB_ = cp.dst; \
        if (cpok) glds16x4(cp.src, cv_row * (unsigned)cp.n4 + cv_sw, 2u * (unsigned)cp.n4, lds0 + CV_LDS + cb * 32768 + wid * 4096); } while (0)
    for (int uu = blockIdx.x; uu < nunits; uu += gridDim.x) {
        int b, h, q0, nt; bool isctx;
        if (uu < 256) { const int u = (uu & 7) * 32 + (uu >> 3); b = u >> 6; h = (u >> 4) & 3; q0 = b * 4096 + (u & 15) * 256; nt = 68; isctx = false; }
        else { const int v = uu - 256; b = v >> 2; h = v & 3; q0 = T + b * 256; nt = 4; isctx = true; }
        const unsigned gKo = (unsigned)(256 + h * 64 + wid * 8 + lane * PW) * 2u;
        const unsigned gVo = (unsigned)(512 + h * 64 + vchunk * 8 + vkey * PW) * 2u;
#define DA_ROW0(t_) ((isctx || (t_) >= 64) ? T + b * 256 + (isctx ? (t_) : (t_) - 64) * 64 : b * 4096 + (t_) * 64)
#define DA_DMA_KV(t_) glds16x2((gcc_t)PR + (size_t)DA_ROW0(t_) * (PW * 2), gKo, gVo, lds0 + ((t_) & 1) * 16384 + wid * 1024)
        __syncthreads();
        DA_DMA_KV(0);
        bf16x8 qf[4];
        {
            const bf16_t* qp = PR + (size_t)(q0 + wid * 32 + r32) * PW + h * 64 + hi * 8;
#pragma unroll
            for (int ks = 0; ks < 4; ++ks) qf[ks] = *(const bf16x8*)(qp + ks * 16);
        }
        f32x16 O00, O01, O10, O11, zero16;
#pragma unroll
        for (int r = 0; r < 16; ++r) { O00[r] = 0.f; O01[r] = 0.f; O10[r] = 0.f; O11[r] = 0.f; zero16[r] = 0.f; }
        float m1 = 0.f, m2 = 0.f, l1 = 0.f, l2 = 0.f;
        asm volatile("" :: "v"(qf[0]), "v"(qf[1]), "v"(qf[2]), "v"(qf[3]));
        asm volatile("s_waitcnt vmcnt(0)" ::: "memory"); __builtin_amdgcn_s_barrier(); asm volatile("" ::: "memory");
#pragma unroll 1
        for (int t = 0; t < nt; ++t) {
            char* buf = lds + (t & 1) * 16384;
            if (t + 1 < nt) DA_DMA_KV(t + 1);
            bool hasB; gu8_t dstB;
            CV_NEXT(hasB, dstB);
            {
                typedef const __attribute__((address_space(3))) bf16x8* kfp_t;
                const lds_cptr kp = (lds_cptr)buf + hi * 1024 + r32 * 16;
                const lds_cptr vp = (lds_cptr)buf + 8192 + vb;
                bf16x8 kf0 = *(kfp_t)(kp), kf1 = *(kfp_t)(kp + 2048), kf2 = *(kfp_t)(kp + 4096), kf3 = *(kfp_t)(kp + 6144);
#pragma unroll
                for (int kb = 0; kb < 2; ++kb) {
                    f32x16 s1 = __builtin_amdgcn_mfma_f32_32x32x16_bf16(kf0, qf[0], zero16, 0, 0, 0);
                    f32x16 s2 = __builtin_amdgcn_mfma_f32_32x32x16_bf16(kf2, qf[2], zero16, 0, 0, 0);
                    s1 = __builtin_amdgcn_mfma_f32_32x32x16_bf16(kf1, qf[1], s1, 0, 0, 0);
                    s2 = __builtin_amdgcn_mfma_f32_32x32x16_bf16(kf3, qf[3], s2, 0, 0, 0);
                    s16x4 vlo[4], vhi[4];
#pragma unroll
                    for (int i = 0; i < 4; ++i) { vlo[i] = vtr(vp + kb * 2048 + (i >> 1) * 4096 + (i & 1) * 1024); vhi[i] = vtr(vp + kb * 2048 + (i >> 1) * 4096 + (i & 1) * 1024 + 512); }
                    if (kb == 0) { kf0 = *(kfp_t)(kp + 512); kf1 = *(kfp_t)(kp + 512 + 2048); kf2 = *(kfp_t)(kp + 512 + 4096); kf3 = *(kfp_t)(kp + 512 + 6144); }
                    __builtin_amdgcn_sched_barrier(0);
                    const bool first = (t == 0) && (kb == 0);
                    bf16x8 p1a, p1b, p2a, p2b;
                    dsoftmax2<8>(s1, m1, l1, O00, O01, p1a, p1b, first);
                    dsoftmax2<8>(s2, m2, l2, O10, O11, p2a, p2b, first);
#pragma unroll
                    for (int i = 0; i < 4; ++i) {
                        const bf16x8 va = (bf16x8){vlo[i][0], vlo[i][1], vlo[i][2], vlo[i][3], vhi[i][0], vhi[i][1], vhi[i][2], vhi[i][3]};
                        if (i < 2) { O00 = __builtin_amdgcn_mfma_f32_32x32x16_bf16(va, (i & 1) ? p1b : p1a, O00, 0, 0, 0); O10 = __builtin_amdgcn_mfma_f32_32x32x16_bf16(va, (i & 1) ? p2b : p2a, O10, 0, 0, 0); }
                        else       { O01 = __builtin_amdgcn_mfma_f32_32x32x16_bf16(va, (i & 1) ? p1b : p1a, O01, 0, 0, 0); O11 = __builtin_amdgcn_mfma_f32_32x32x16_bf16(va, (i & 1) ? p2b : p2a, O11, 0, 0, 0); }
                    }
                }
            }
            if (hasB) asm volatile("s_waitcnt vmcnt(4)" ::: "memory"); else asm volatile("s_waitcnt vmcnt(0)" ::: "memory");
            __builtin_amdgcn_s_barrier(); asm volatile("" ::: "memory");
            if (hasA) cv_store(dstA, lds + CV_LDS + ca * 32768 + cv_lo, cv_go);
            dstA = dstB; hasA = hasB; ca = cb;
            if (hasB) { ++cj; cb = cb == 2 ? 0 : cb + 1; }
        }
#undef DA_ROW0
#undef DA_DMA_KV
        l1 = xhalf_sum(l1); l2 = xhalf_sum(l2);
        const float i1 = 1.f / l1, i2 = lam / l2;
        float ss = 0.f;
#pragma unroll
        for (int r = 0; r < 16; ++r) { O00[r] = O00[r] * i1 - O10[r] * i2; O01[r] = O01[r] * i1 - O11[r] * i2; ss += O00[r] * O00[r] + O01[r] * O01[r]; }
        ss = xhalf_sum(ss);
        const float rstd = rsqrtf(ss * (1.f / 64.f) + EPS) * (1.f - lam_init);
        const float* gs = p.g_sub + l * 64;
        bf16_t* op = p.MIX + (size_t)(q0 + wid * 32 + r32) * D + h * 64;
#pragma unroll
        for (int g4 = 0; g4 < 4; ++g4) {
            const int d = 8 * g4 + 4 * hi;
            const float4 ga = *(const float4*)(gs + d), gb = *(const float4*)(gs + 32 + d);
            uint2 wa, wb;
            wa.x = cvtpk(O00[4 * g4] * rstd * ga.x, O00[4 * g4 + 1] * rstd * ga.y); wa.y = cvtpk(O00[4 * g4 + 2] * rstd * ga.z, O00[4 * g4 + 3] * rstd * ga.w);
            wb.x = cvtpk(O01[4 * g4] * rstd * gb.x, O01[4 * g4 + 1] * rstd * gb.y); wb.y = cvtpk(O01[4 * g4 + 2] * rstd * gb.z, O01[4 * g4 + 3] * rstd * gb.w);
            *(uint2*)(op + d) = wa; *(uint2*)(op + 32 + d) = wb;
        }
    }
    while (hasA) {
        asm volatile("s_waitcnt vmcnt(0)" ::: "memory");
        __syncthreads();
        cv_store(dstA, lds + CV_LDS + ca * 32768 + cv_lo, cv_go);
        bool hasB; gu8_t dstB;
        CV_NEXT(hasB, dstB);
        dstA = dstB; hasA = hasB; ca = cb;
        if (hasB) { ++cj; cb = cb == 2 ? 0 : cb + 1; }
    }
#undef CV_NEXT
}

__device__ __forceinline__ void ph_na(const P& p, int l, int nrows, char* lds, const int wv) {
    const int tid = ltid(wv), lane = tid & 63, wid = wv, r32 = lane & 31, hi = lane >> 5;
    const bf16_t* PR = p.PROJ;
    const int nunits = (nrows == R) ? 256 + 16 : 256;
    const int vkey = (2 * (wid & 3) + (lane >> 5)) * 8 + ((lane >> 2) & 7), vchunk = (wid >> 2) * 4 + (lane & 3);
    const int vb = ((lane >> 4) & 1) * 32 + (lane & 3) * 8 + (4 * hi + ((lane & 15) >> 2)) * 64;
    const unsigned lds0 = (unsigned)(uintptr_t)lds;
    float* btab = (float*)(lds + 49152);
    constexpr float LOG2E = 1.4426950408889634f;
    float pen[2][16];
    {
        const int cq_ = (wid & 1) * 32 + r32, wsc_ = min(max(cq_ - 8, 0), 48);
#pragma unroll
        for (int kb = 0; kb < 2; ++kb)
#pragma unroll
            for (int r = 0; r < 16; ++r) { const int kc = 32 * kb + (r & 3) + 8 * (r >> 2) + 4 * hi; pen[kb][r] = ((unsigned)(kc - wsc_) < 16u) ? 0.f : -INFINITY; }
    }
    for (int uu = (blockIdx.x + gridDim.x - 16) % gridDim.x; uu < nunits; uu += gridDim.x) {
        int b, h, q0, kr_lo, nlat, rs = 0, rq = 0; bool isctx;
        if (uu < 256) {
            const int u = (uu & 7) * 32 + (uu >> 3); b = u >> 6; h = (u >> 4) & 3; const int rg = u & 15;
            rq = 4 * rg + (wid >> 1); q0 = b * 4096 + rq * 64 + (wid & 1) * 32;
            kr_lo = min(max(4 * rg - 4, 0), 56); const int kr_hi = min(max(4 * rg - 1, 0), 56) + 7; nlat = kr_hi - kr_lo + 1;
            rs = min(max(rq - 4, 0), 56); isctx = false;
        } else { const int v = uu - 256; b = v >> 2; h = v & 3; q0 = T + b * 256 + wid * 32; kr_lo = 0; nlat = 0; isctx = true; }
        const int nt = nlat + 4;
        const int cq = (wid & 1) * 32 + r32;
        const unsigned gKo = (unsigned)(1792 + h * 64 + wid * 8 + lane * PW) * 2u;
        const unsigned gVo = (unsigned)(2048 + h * 64 + vchunk * 8 + vkey * PW) * 2u;
#define NA_ROW0(t_) ((t_) < nlat ? b * 4096 + (kr_lo + (t_)) * 64 : T + b * 256 + ((t_) - nlat) * 64)
#define NA_DMA_KV(t_, slot_) glds16x2((gcc_t)PR + (size_t)NA_ROW0(t_) * (PW * 2), gKo, gVo, lds0 + (slot_) * 16384 + wid * 1024)
        __syncthreads();
        NA_DMA_KV(0, 0); NA_DMA_KV(1, 1);
        bf16x8 qf[4];
        {
            const bf16_t* qp = PR + (size_t)(q0 + r32) * PW + 1536 + h * 64 + hi * 8;
#pragma unroll
            for (int ks = 0; ks < 4; ++ks) qf[ks] = *(const bf16x8*)(qp + ks * 16);
        }
        f32x16 O0, O1;
#pragma unroll
        for (int r = 0; r < 16; ++r) { O0[r] = 0.f; O1[r] = 0.f; }
        float m1 = -1e30f, l1 = 0.f;
        for (int i = tid; i < 15 * 128; i += NT) { const int j = (i & 127) - 48; btab[i] = (j >= 0 && j < 31) ? p.rpb[((size_t)l * 4 + h) * 465 + (i >> 7) * 31 + j] * LOG2E : 0.f; }
        asm volatile("" :: "v"(qf[0]), "v"(qf[1]), "v"(qf[2]), "v"(qf[3]));
        asm volatile("s_waitcnt vmcnt(0)" ::: "memory");
        __syncthreads();
        int ks = 0;
#pragma unroll 1
        for (int t = 0; t < nt; ++t) {
            char* buf = lds + ks * 16384;
            const bool kvB = t + 2 < nt;
            if (kvB) NA_DMA_KV(t + 2, ks == 0 ? 2 : ks - 1);
            const bool lat = t < nlat;
            const int krow = kr_lo + t;
            const bool active = !lat || (krow >= rs && krow <= rs + 7);
            if (active) {
                const float* brow = btab + (krow - rq + 7) * 128 + 48 + 15 - cq + 4 * hi;
#pragma unroll
                for (int kb = 0; kb < 2; ++kb) {
                    const lds_cptr kp = (lds_cptr)buf + hi * 1024 + (kb * 32 + r32) * 16;
                    f32x16 s1;
#pragma unroll
                    for (int r = 0; r < 16; ++r) s1[r] = 0.f;
#pragma unroll
                    for (int ks2 = 0; ks2 < 4; ++ks2) {
                        const bf16x8 kf = *(const __attribute__((address_space(3))) bf16x8*)(kp + ks2 * 2048);
                        s1 = __builtin_amdgcn_mfma_f32_32x32x16_bf16(kf, qf[ks2], s1, 0, 0, 0);
                    }
                    if (lat) {
#pragma unroll
                        for (int r = 0; r < 16; ++r) s1[r] = (s1[r] + brow[32 * kb + (r & 3) + 8 * (r >> 2)]) + pen[kb][r];
                    }
                    bf16x8 pa, pb;
                    dsoftmax2<8>(s1, m1, l1, O0, O1, pa, pb, false);
                    const lds_cptr vp = (lds_cptr)buf + 8192 + vb + kb * 2048;
#pragma unroll
                    for (int ss = 0; ss < 2; ++ss) {
                        const s16x4 lo0 = vtr(vp + ss * 1024), hh0 = vtr(vp + ss * 1024 + 512);
                        const s16x4 lo1 = vtr(vp + 4096 + ss * 1024), hh1 = vtr(vp + 4096 + ss * 1024 + 512);
                        const bf16x8 va0 = (bf16x8){lo0[0], lo0[1], lo0[2], lo0[3], hh0[0], hh0[1], hh0[2], hh0[3]};
                        const bf16x8 va1 = (bf16x8){lo1[0], lo1[1], lo1[2], lo1[3], hh1[0], hh1[1], hh1[2], hh1[3]};
                        O0 = __builtin_amdgcn_mfma_f32_32x32x16_bf16(va0, ss ? pb : pa, O0, 0, 0, 0);
                        O1 = __builtin_amdgcn_mfma_f32_32x32x16_bf16(va1, ss ? pb : pa, O1, 0, 0, 0);
                    }
                }
            }
            if (kvB) asm volatile("s_waitcnt vmcnt(2)" ::: "memory"); else asm volatile("s_waitcnt vmcnt(0)" ::: "memory");
            __builtin_amdgcn_s_barrier(); asm volatile("" ::: "memory");
            ks = ks == 2 ? 0 : ks + 1;
        }
#undef NA_ROW0
#undef NA_DMA_KV
        l1 = xhalf_sum(l1);
        const float il = 1.f / l1;
        bf16_t* op = p.MIX + (size_t)(q0 + r32) * D + 768 + h * 64;
#pragma unroll
        for (int g4 = 0; g4 < 4; ++g4) {
            const int d = 8 * g4 + 4 * hi;
            uint2 wa, wb;
            wa.x = cvtpk(O0[4 * g4] * il, O0[4 * g4 + 1] * il); wa.y = cvtpk(O0[4 * g4 + 2] * il, O0[4 * g4 + 3] * il);
            wb.x = cvtpk(O1[4 * g4] * il, O1[4 * g4 + 1] * il); wb.y = cvtpk(O1[4 * g4 + 2] * il, O1[4 * g4 + 3] * il);
            *(uint2*)(op + d) = wa; *(uint2*)(op + 32 + d) = wb;
        }
    }
}

__device__ __forceinline__ void ph_pool(const P& p, int l, int nrows, char* lds, const int wv) {
    const int tid = ltid(wv), lane = tid & 63, wid = tid >> 6, fr = lane & 15, fq = lane >> 4;
    float* ysh = (float*)lds;
    bf16_t* dsh = (bf16_t*)(lds + 80 * 256 * 4);
    const bf16_t* PR = p.PROJ;
    for (int it = (blockIdx.x + gridDim.x - 32) % gridDim.x; it < nrows / 64; it += gridDim.x) {
        const int row0 = it * 64;
        const int L = row0 < T ? 4096 : 256;
        const int t0 = row0 < T ? (row0 & 4095) : ((row0 - T) & 255);
        const int base = row0 - t0;
        __syncthreads();
        for (int c = tid; c < 80 * 32; c += NT) {
            const int rr = c >> 5, ch = (c & 31) * 8, t = t0 - 8 + rr;
            float4 a = make_float4(0.f, 0.f, 0.f, 0.f), b = a;
            if (t >= 0 && t < L) {
                const uint4 raw = *(const uint4*)(PR + (size_t)(base + t) * PW + 768 + ch);
                a = make_float4(__uint_as_float(raw.x << 16), __uint_as_float(raw.x & 0xffff0000u), __uint_as_float(raw.y << 16), __uint_as_float(raw.y & 0xffff0000u));
                b = make_float4(__uint_as_float(raw.z << 16), __uint_as_float(raw.z & 0xffff0000u), __uint_as_float(raw.w << 16), __uint_as_float(raw.w & 0xffff0000u));
            }
            *(float4*)(ysh + rr * 256 + ch) = a; *(float4*)(ysh + rr * 256 + ch + 4) = b;
        }
        __syncthreads();
        {
            const int r = tid >> 3, cg = tid & 7;
            const int g = cg >> 1, w = 2 << g, t = t0 + r;
            const int lo = max(t - w / 2, 0), hi = min(t + w / 2 - 1, L - 1);
            const float inv = 1.f / (float)(hi - lo + 1);
#pragma unroll
            for (int q = 0; q < 8; ++q) {
                const int ch = cg * 32 + q * 4;
                float4 s = make_float4(0.f, 0.f, 0.f, 0.f);
                for (int tt = lo; tt <= hi; ++tt) { const float4 v = *(const float4*)(ysh + (tt - t0 + 8) * 256 + ch); s.x += v.x; s.y += v.y; s.z += v.z; s.w += v.w; }
                const float4 y = *(const float4*)(ysh + (r + 8) * 256 + ch);
                uint2 o; o.x = cvtpk(s.x * inv - y.x, s.y * inv - y.y); o.y = cvtpk(s.z * inv - y.z, s.w * inv - y.w);
                *(uint2*)(dsh + r * 264 + ch) = o;
            }
        }
        __syncthreads();
        {
            const int g = wid >> 1, mb = (wid & 1) * 2;
            const bf16_t* W = p.WpT + ((size_t)l * 4 + g) * 64 * 64;
            f32x4 acc[2][4];
#pragma unroll
            for (int mt = 0; mt < 2; ++mt)
#pragma unroll
                for (int nt = 0; nt < 4; ++nt) acc[mt][nt] = (f32x4){0.f, 0.f, 0.f, 0.f};
#pragma unroll
            for (int ks = 0; ks < 2; ++ks) {
                bf16x8 af[2], bfr[4];
#pragma unroll
                for (int mt = 0; mt < 2; ++mt) af[mt] = *(const bf16x8*)(dsh + ((mb + mt) * 16 + fr) * 264 + g * 64 + ks * 32 + fq * 8);
#pragma unroll
                for (int nt = 0; nt < 4; ++nt) bfr[nt] = *(const bf16x8*)(W + (nt * 16 + fr) * 64 + ks * 32 + fq * 8);
#pragma unroll
                for (int mt = 0; mt < 2; ++mt)
#pragma unroll
                    for (int nt = 0; nt < 4; ++nt) acc[mt][nt] = __builtin_amdgcn_mfma_f32_16x16x32_bf16(bfr[nt], af[mt], acc[mt][nt], 0, 0, 0);
            }
#pragma unroll
            for (int mt = 0; mt < 2; ++mt)
#pragma unroll
                for (int nt = 0; nt < 4; ++nt) {
                    const int row = row0 + (mb + mt) * 16 + fr, j = g * 64 + nt * 16 + fq * 4;
                    const float4 sp = *(const float4*)(p.s_pool + l * 256 + j);
                    uint2 o; o.x = cvtpk(acc[mt][nt][0] * sp.x, acc[mt][nt][1] * sp.y); o.y = cvtpk(acc[mt][nt][2] * sp.z, acc[mt][nt][3] * sp.w);
                    *(uint2*)(p.MIX + (size_t)row * D + 256 + j) = o;
                }
        }
    }
}

__device__ __forceinline__ float gelu_fast(float x) {
    const float u = 0.7978845608028654f * (x + 0.044715f * x * x * x);
    return x / (1.f + __builtin_amdgcn_exp2f(-2.885390081777927f * u));
}
__device__ __forceinline__ void ph_sgu(const P& p, int l, int nrows, char* lds, const int wv) {
    const int tid = ltid(wv), lane = tid & 63, wid = tid >> 6, fr = lane & 15, fq = lane >> 4;
    bf16_t* vnT = (bf16_t*)lds;
    float* rstd = (float*)(lds + 128 * 136 * 2);
    const bf16_t* PR = p.PROJ;
    for (int it = (blockIdx.x + gridDim.x - 48) % gridDim.x; it < (nrows / 128) * 2; it += gridDim.x) {
        const int chunk = it >> 1, hp = it & 1, row0 = chunk * 128;
        __syncthreads();
        {
            const int t = tid >> 2, qtr = tid & 3;
            const bf16_t* zp = PR + (size_t)(row0 + t) * PW + 1280 + qtr * 64;
            float ss = 0.f;
#pragma unroll
            for (int i = 0; i < 8; ++i) {
                const uint4 raw = *(const uint4*)(zp + i * 8);
                const unsigned w4[4] = {raw.x, raw.y, raw.z, raw.w};
#pragma unroll
                for (int j = 0; j < 4; ++j) { const float a = __uint_as_float(w4[j] << 16), b = __uint_as_float(w4[j] & 0xffff0000u); ss += a * a + b * b; }
            }
            ss += __shfl_xor(ss, 1); ss += __shfl_xor(ss, 2);
            if (qtr == 0) rstd[t] = rsqrtf(ss * (1.f / 256.f) + EPS);
        }
        __syncthreads();
        {
            const int s = tid >> 2, cb = (tid & 3) * 32;
            const bf16_t* zp = PR + (size_t)(row0 + s) * PW + 1280 + hp * 128 + cb;
            const float rs = rstd[s];
            const float* gg = p.g_sgu + l * 256 + hp * 128 + cb;
#pragma unroll
            for (int i = 0; i < 4; ++i) {
                const uint4 raw = *(const uint4*)(zp + i * 8);
                const unsigned w4[4] = {raw.x, raw.y, raw.z, raw.w};
#pragma unroll
                for (int j = 0; j < 4; ++j) {
                    const int c = cb + i * 8 + j * 2;
                    vnT[c * 136 + s] = f2bf(__uint_as_float(w4[j] << 16) * rs * gg[i * 8 + j * 2]);
                    vnT[(c + 1) * 136 + s] = f2bf(__uint_as_float(w4[j] & 0xffff0000u) * rs * gg[i * 8 + j * 2 + 1]);
                }
            }
        }
        __syncthreads();
        {
            const int hl = wid >> 2, g = hp * 2 + hl, mb = (wid & 3) * 2;
            const bf16_t* Wg = p.WsB + ((size_t)l * 4 + g) * 128 * 128;
            f32x4 acc[2][4];
#pragma unroll
            for (int mt = 0; mt < 2; ++mt)
#pragma unroll
                for (int nt = 0; nt < 4; ++nt) acc[mt][nt] = (f32x4){0.f, 0.f, 0.f, 0.f};
#pragma unroll
            for (int ks = 0; ks < 4; ++ks) {
                bf16x8 af[2], bfr[4];
#pragma unroll
                for (int mt = 0; mt < 2; ++mt) af[mt] = *(const bf16x8*)(Wg + ((mb + mt) * 16 + fr) * 128 + ks * 32 + fq * 8);
#pragma unroll
                for (int nt = 0; nt < 4; ++nt) bfr[nt] = *(const bf16x8*)(vnT + (hl * 64 + nt * 16 + fr) * 136 + ks * 32 + fq * 8);
#pragma unroll
                for (int mt = 0; mt < 2; ++mt)
#pragma unroll
                    for (int nt = 0; nt < 4; ++nt) acc[mt][nt] = __builtin_amdgcn_mfma_f32_16x16x32_bf16(bfr[nt], af[mt], acc[mt][nt], 0, 0, 0);
            }
#pragma unroll
            for (int mt = 0; mt < 2; ++mt) {
                const int t = (mb + mt) * 16 + fr;
                const float bias = p.b_sgu[(l * 4 + g) * 128 + t];
#pragma unroll
                for (int nt = 0; nt < 4; ++nt) {
                    const int c = g * 64 + nt * 16 + fq * 4;
                    const uint2 ur = *(const uint2*)(PR + (size_t)(row0 + t) * PW + 1024 + c);
                    const float u0 = __uint_as_float(ur.x << 16), u1 = __uint_as_float(ur.x & 0xffff0000u);
                    const float u2 = __uint_as_float(ur.y << 16), u3 = __uint_as_float(ur.y & 0xffff0000u);
                    uint2 o; o.x = cvtpk(u0 * (acc[mt][nt][0] + bias), u1 * (acc[mt][nt][1] + bias)); o.y = cvtpk(u2 * (acc[mt][nt][2] + bias), u3 * (acc[mt][nt][3] + bias));
                    *(uint2*)(p.MIX + (size_t)(row0 + t) * D + 512 + c) = o;
                }
            }
        }
    }
}

__device__ __forceinline__ void ph_router(const P& p, int l, int nrows, char* lds, const int wv) {
    const int tid = ltid(wv), wave = wv, lane = tid & 63;
    float* wt = (float*)lds;
    float* tsc = (float*)(lds + 32 * 1028 * 4) + wave * (16 * 33);
    int* lcnt = (int*)(lds + 32 * 1028 * 4 + 8 * 16 * 33 * 4);
    __syncthreads();
    {
        const float* wr = p.w_router + (size_t)l * D * NE;
        float4 t[16];
#pragma unroll
        for (int i = 0; i < 16; ++i) t[i] = *(const float4*)(wr + (size_t)(tid + NT * i) * 4);
#pragma unroll
        for (int i = 0; i < 16; ++i) { const int idx = (tid + NT * i) * 4, k = idx >> 5, e = idx & 31; float* q = wt + e * 1028 + k; q[0] = t[i].x; q[1028] = t[i].y; q[2 * 1028] = t[i].z; q[3 * 1028] = t[i].w; }
        if (tid < 32) lcnt[tid] = 0;
    }
    __syncthreads();
    const int i16 = lane & 15, kk = lane >> 4;
    const float* w0 = wt + i16 * 1028 + 8 * kk;
    for (int g = (wave & 3) * (int)gridDim.x + (int)blockIdx.x; g < nrows / 16; g += 4 * (int)gridDim.x) {
        const int row0 = g * 16, mb = mod_row(row0);
        const bf16_t* xr = p.X + (size_t)(row0 + i16) * D + 8 * kk;
        const float* Gt = p.RG + ((size_t)l * 5 + mb) * 1024 + 8 * kk;
        if (wave >= 4) {
            float ss = 0.f;
#pragma unroll 1
            for (int c0 = 0; c0 < 32; c0 += 16) {
                uint4 raw[16];
#pragma unroll
                for (int c = 0; c < 16; ++c) raw[c] = *(const uint4*)(xr + 32 * (c0 + c));
#pragma unroll
                for (int c = 0; c < 16; ++c) {
                    const float x0 = __uint_as_float(raw[c].x << 16), x1 = __uint_as_float(raw[c].x & 0xffff0000u), x2 = __uint_as_float(raw[c].y << 16), x3 = __uint_as_float(raw[c].y & 0xffff0000u);
                    const float x4 = __uint_as_float(raw[c].z << 16), x5 = __uint_as_float(raw[c].z & 0xffff0000u), x6 = __uint_as_float(raw[c].w << 16), x7 = __uint_as_float(raw[c].w & 0xffff0000u);
                    ss += x0 * x0 + x1 * x1 + x2 * x2 + x3 * x3 + x4 * x4 + x5 * x5 + x6 * x6 + x7 * x7;
                }
            }
            ss += __shfl_xor(ss, 16); ss += __shfl_xor(ss, 32);
            const float rstd = rsqrtf(ss * (1.f / D) + EPS);
            const float* St = p.mod + ((size_t)l * 5 + mb) * 6144 + 3 * 1024 + 8 * kk;
            bf16_t* hr = p.H + (size_t)(row0 + i16) * D + 8 * kk;
#pragma unroll 1
            for (int c0 = 0; c0 < 32; c0 += 8) {
#pragma unroll
                for (int c1 = 0; c1 < 8; ++c1) {
                    const int c = c0 + c1;
                    const uint4 raw = *(const uint4*)(xr + 32 * c);
                    const float4 ga = *(const float4*)(Gt + 32 * c), gb = *(const float4*)(Gt + 32 * c + 4), sa = *(const float4*)(St + 32 * c), sb = *(const float4*)(St + 32 * c + 4);
                    u32x4 o;
                    o.x = cvtpk(__uint_as_float(raw.x << 16) * rstd * ga.x + sa.x, __uint_as_float(raw.x & 0xffff0000u) * rstd * ga.y + sa.y);
                    o.y = cvtpk(__uint_as_float(raw.y << 16) * rstd * ga.z + sa.z, __uint_as_float(raw.y & 0xffff0000u) * rstd * ga.w + sa.w);
                    o.z = cvtpk(__uint_as_float(raw.z << 16) * rstd * gb.x + sb.x, __uint_as_float(raw.z & 0xffff0000u) * rstd * gb.y + sb.y);
                    o.w = cvtpk(__uint_as_float(raw.w << 16) * rstd * gb.z + sb.z, __uint_as_float(raw.w & 0xffff0000u) * rstd * gb.w + sb.w);
                    *(u32x4*)(hr + 32 * c) = o;
                }
            }
            continue;
        }
        f32x4 d0 = {0.f, 0.f, 0.f, 0.f}, d1 = d0; float ss = 0.f;
        uint4 rawA[8], rawB[8];
#pragma unroll
        for (int j = 0; j < 8; ++j) rawA[j] = *(const uint4*)(xr + 32 * j);
#define RT_CHUNK(RAW, c_) do { \
            const float4 ga_ = *(const float4*)(Gt + 32 * (c_)), gb_ = *(const float4*)(Gt + 32 * (c_) + 4); \
            const f32x4 ba0_ = *(const f32x4*)(w0 + 32 * (c_)), ba1_ = *(const f32x4*)(w0 + 32 * (c_) + 4), bb0_ = *(const f32x4*)(w0 + 16 * 1028 + 32 * (c_)), bb1_ = *(const f32x4*)(w0 + 16 * 1028 + 32 * (c_) + 4); \
            const float x0_ = __uint_as_float(RAW.x << 16), x1_ = __uint_as_float(RAW.x & 0xffff0000u), x2_ = __uint_as_float(RAW.y << 16), x3_ = __uint_as_float(RAW.y & 0xffff0000u); \
            const float x4_ = __uint_as_float(RAW.z << 16), x5_ = __uint_as_float(RAW.z & 0xffff0000u), x6_ = __uint_as_float(RAW.w << 16), x7_ = __uint_as_float(RAW.w & 0xffff0000u); \
            ss += x0_ * x0_ + x1_ * x1_ + x2_ * x2_ + x3_ * x3_ + x4_ * x4_ + x5_ * x5_ + x6_ * x6_ + x7_ * x7_; \
            d0 = __builtin_amdgcn_mfma_f32_16x16x4f32(x0_ * ga_.x, ba0_[0], d0, 0, 0, 0); d1 = __builtin_amdgcn_mfma_f32_16x16x4f32(x0_ * ga_.x, bb0_[0], d1, 0, 0, 0); \
            d0 = __builtin_amdgcn_mfma_f32_16x16x4f32(x1_ * ga_.y, ba0_[1], d0, 0, 0, 0); d1 = __builtin_amdgcn_mfma_f32_16x16x4f32(x1_ * ga_.y, bb0_[1], d1, 0, 0, 0); \
            d0 = __builtin_amdgcn_mfma_f32_16x16x4f32(x2_ * ga_.z, ba0_[2], d0, 0, 0, 0); d1 = __builtin_amdgcn_mfma_f32_16x16x4f32(x2_ * ga_.z, bb0_[2], d1, 0, 0, 0); \
            d0 = __builtin_amdgcn_mfma_f32_16x16x4f32(x3_ * ga_.w, ba0_[3], d0, 0, 0, 0); d1 = __builtin_amdgcn_mfma_f32_16x16x4f32(x3_ * ga_.w, bb0_[3], d1, 0, 0, 0); \
            d0 = __builtin_amdgcn_mfma_f32_16x16x4f32(x4_ * gb_.x, ba1_[0], d0, 0, 0, 0); d1 = __builtin_amdgcn_mfma_f32_16x16x4f32(x4_ * gb_.x, bb1_[0], d1, 0, 0, 0); \
            d0 = __builtin_amdgcn_mfma_f32_16x16x4f32(x5_ * gb_.y, ba1_[1], d0, 0, 0, 0); d1 = __builtin_amdgcn_mfma_f32_16x16x4f32(x5_ * gb_.y, bb1_[1], d1, 0, 0, 0); \
            d0 = __builtin_amdgcn_mfma_f32_16x16x4f32(x6_ * gb_.z, ba1_[2], d0, 0, 0, 0); d1 = __builtin_amdgcn_mfma_f32_16x16x4f32(x6_ * gb_.z, bb1_[2], d1, 0, 0, 0); \
            d0 = __builtin_amdgcn_mfma_f32_16x16x4f32(x7_ * gb_.w, ba1_[3], d0, 0, 0, 0); d1 = __builtin_amdgcn_mfma_f32_16x16x4f32(x7_ * gb_.w, bb1_[3], d1, 0, 0, 0); } while (0)
#pragma unroll 1
        for (int cc = 0; cc < 4; cc += 2) {
#pragma unroll
            for (int j = 0; j < 8; ++j) rawB[j] = *(const uint4*)(xr + 32 * (8 * cc + 8 + j));
#pragma unroll
            for (int j = 0; j < 8; ++j) RT_CHUNK(rawA[j], 8 * cc + j);
            if (cc + 2 < 4) {
#pragma unroll
                for (int j = 0; j < 8; ++j) rawA[j] = *(const uint4*)(xr + 32 * (8 * cc + 16 + j));
            }
#pragma unroll
            for (int j = 0; j < 8; ++j) RT_CHUNK(rawB[j], 8 * cc + 8 + j);
        }
#undef RT_CHUNK
        ss += __shfl_xor(ss, 16); ss += __shfl_xor(ss, 32);
        const float rstd = rsqrtf(ss * (1.f / D) + EPS);
#pragma unroll
        for (int j = 0; j < 4; ++j) { tsc[(4 * kk + j) * 33 + i16] = d0[j]; tsc[(4 * kk + j) * 33 + 16 + i16] = d1[j]; }
        __builtin_amdgcn_s_waitcnt(0xc07f);
        if (lane < 16) {
            const float* rb = p.RB + ((size_t)l * 5 + mb) * 32;
            float lg[32];
#pragma unroll
            for (int e = 0; e < 32; ++e) lg[e] = tsc[lane * 33 + e] * rstd + rb[e];
            unsigned taken = 0u; float tv[4]; int ti[4];
#pragma unroll
            for (int k = 0; k < 4; ++k) {
                float best = -3.0e38f; int bi = 0;
#pragma unroll
                for (int e = 0; e < 32; ++e) { const bool ok = !((taken >> e) & 1u) && (lg[e] > best); best = ok ? lg[e] : best; bi = ok ? e : bi; }
                taken |= 1u << bi; tv[k] = best; ti[k] = bi;
            }
            const float e1 = __expf(tv[1] - tv[0]), e2 = __expf(tv[2] - tv[0]), e3 = __expf(tv[3] - tv[0]);
            const float inv = 1.f / (1.f + e1 + e2 + e3);
            const int row = row0 + lane;
            *(int4*)(p.topi + (size_t)row * 4) = make_int4(ti[0], ti[1], ti[2], ti[3]);
            *(float4*)(p.topg + (size_t)row * 4) = make_float4(inv, e1 * inv, e2 * inv, e3 * inv);
            atomicAdd(&lcnt[ti[0]], 1); atomicAdd(&lcnt[ti[1]], 1); atomicAdd(&lcnt[ti[2]], 1); atomicAdd(&lcnt[ti[3]], 1);
        }
    }
    __syncthreads();
    if (tid < 32 && lcnt[tid]) atomicAdd(&p.cnt[l * 64 + tid], lcnt[tid]);
}
__device__ __forceinline__ void ph_assign(const P& p, int l, int nrows, char* lds, const int wv) {
    int* lcnt = (int*)lds; int* lbase = lcnt + 32; int* pst = lbase + 32; int* slots = pst + 32;
    const int tid = ltid(wv), wave = tid >> 6, lane = tid & 63;
    int* cnt = p.cnt + l * 64; int* cursor = cnt + 32;
    int* meta = p.moe_meta + l * 512;
    __syncthreads();
    if (tid == 0) { int a = 0; for (int e = 0; e < 32; ++e) { pst[e] = a; a += (cnt[e] + 255) & ~255; } if (blockIdx.x == 0) meta[0] = a >> 8; }
    __syncthreads();
    if (blockIdx.x == 0 && tid < 320) { int e = 0; for (int k = 1; k < 32; ++k) if (tid * 256 >= pst[k]) e = k; meta[1 + tid] = e; }
    const int blk0 = (blockIdx.x + gridDim.x - 64) % gridDim.x;
    for (int it = blk0; it < nrows / 64; it += gridDim.x) {
        __syncthreads();
        if (tid < 32) lcnt[tid] = 0;
        __syncthreads();
        if (wave == 0) {
            const int row = it * 64 + lane;
            const int4 ti = *(const int4*)(p.topi + (size_t)row * 4);
            const int r0 = atomicAdd(&lcnt[ti.x], 1), r1 = atomicAdd(&lcnt[ti.y], 1), r2 = atomicAdd(&lcnt[ti.z], 1), r3 = atomicAdd(&lcnt[ti.w], 1);
            __builtin_amdgcn_s_waitcnt(0xc07f);
            if (lane < 32) lbase[lane] = pst[lane] + (lcnt[lane] ? atomicAdd(&cursor[lane], lcnt[lane]) : 0);
            __builtin_amdgcn_s_waitcnt(0xc07f);
            const int4 sl = make_int4(lbase[ti.x] + r0, lbase[ti.y] + r1, lbase[ti.z] + r2, lbase[ti.w] + r3);
            *(int4*)(p.tok_slot + (size_t)row * 4) = sl;
            *(int4*)(slots + lane * 4) = sl;
        }
        __syncthreads();
        {
            const bf16_t* __restrict__ Hs = p.H; unsigned char* __restrict__ HSd = p.HS;
#define AS_LD(rr, A, B) const uint4 A = *(const uint4*)(Hs + (size_t)(it * 64 + wave * 8 + (rr)) * D + lane * 8), B = *(const uint4*)(Hs + (size_t)(it * 64 + wave * 8 + (rr)) * D + lane * 8 + 512)
#define AS_CV(V) make_uint2(__builtin_amdgcn_cvt_pk_fp8_f32(__uint_as_float(V.y << 16), __uint_as_float(V.y & 0xffff0000u), __builtin_amdgcn_cvt_pk_fp8_f32(__uint_as_float(V.x << 16), __uint_as_float(V.x & 0xffff0000u), 0u, false), true), \
                            __builtin_amdgcn_cvt_pk_fp8_f32(__uint_as_float(V.w << 16), __uint_as_float(V.w & 0xffff0000u), __builtin_amdgcn_cvt_pk_fp8_f32(__uint_as_float(V.z << 16), __uint_as_float(V.z & 0xffff0000u), 0u, false), true))
#define AS_ST(rr, A, B) do { const int4 s4 = *(const int4*)(slots + (wave * 8 + (rr)) * 4); const uint2 fa = AS_CV(A), fb = AS_CV(B); \
            unsigned char* d0 = HSd + (size_t)s4.x * D + lane * 8; *(uint2*)d0 = fa; *(uint2*)(d0 + 512) = fb; \
            unsigned char* d1 = HSd + (size_t)s4.y * D + lane * 8; *(uint2*)d1 = fa; *(uint2*)(d1 + 512) = fb; \
            unsigned char* d2 = HSd + (size_t)s4.z * D + lane * 8; *(uint2*)d2 = fa; *(uint2*)(d2 + 512) = fb; \
            unsigned char* d3 = HSd + (size_t)s4.w * D + lane * 8; *(uint2*)d3 = fa; *(uint2*)(d3 + 512) = fb; } while (0)
            AS_LD(0, a0, b0); AS_LD(1, a1, b1); AS_LD(2, a2, b2); AS_LD(3, a3, b3); AS_LD(4, a4, b4); AS_LD(5, a5, b5); AS_LD(6, a6, b6); AS_LD(7, a7, b7);
            AS_ST(0, a0, b0); AS_ST(1, a1, b1); AS_ST(2, a2, b2); AS_ST(3, a3, b3); AS_ST(4, a4, b4); AS_ST(5, a5, b5); AS_ST(6, a6, b6); AS_ST(7, a7, b7);
#undef AS_CV
#undef AS_LD
#undef AS_ST
        }
    }
}

struct EpiProj {
    static constexpr bool PERM = true, AFTER_DRAIN = false, WIDE = false;
    struct Pre {}; __device__ __forceinline__ void prefetch(Pre&, const pg8::Unit&, int, int, int, int) const {}
    bf16_t* O; const float* rope;
    __device__ __forceinline__ void operator()(const f32x4 (&acc)[2][2][4][2], const pg8::Unit& u, int wr, int wc, int fr, int fq, const Pre& pre) const {
        const int row0 = u.pm * 256 + wr * 64 + fr, col0 = u.pn * 256 + wc * 32 + 8 * fq;
        const bool do_rope = (u.pn < 2) && (u.pm < T / 256), do_gelu = (u.pn == 4) || (u.pn == 5);
        const float sc = u.pn == 0 ? QSCALE : (u.pn == 6 ? 0.125f * 1.4426950408889634f : 1.f);
        const float sgn = (fq & 1) ? 1.f : -1.f;
#pragma unroll
        for (int ai = 0; ai < 2; ++ai)
#pragma unroll
            for (int m = 0; m < 4; ++m) {
                const int row = row0 + ai * 128 + m * 16;
                bf16_t* rowp = O + (size_t)row * PW + col0;
                f32x4 cs[4];
                if (do_rope) {
                    const int s = row & 4095, pos = (fq >> 1) ? (s & 63) : (s >> 6);
                    const f32x4* rp = (const f32x4*)(rope + pos * 16);
                    cs[0] = rp[0]; cs[1] = rp[1]; cs[2] = rp[2]; cs[3] = rp[3];
                }
#pragma unroll
                for (int bj = 0; bj < 2; ++bj) {
                    f32x4 v0 = acc[ai][bj][m][0], v1 = acc[ai][bj][m][1];
                    if (do_rope) {
                        f32x4 b0, b1;
#pragma unroll
                        for (int j = 0; j < 4; ++j) { b0[j] = __shfl_xor(v0[j], 16); b1[j] = __shfl_xor(v1[j], 16); }
                        v0[0] = v0[0] * cs[0][0] + sgn * b0[0] * cs[0][1]; v0[1] = v0[1] * cs[0][2] + sgn * b0[1] * cs[0][3];
                        v0[2] = v0[2] * cs[1][0] + sgn * b0[2] * cs[1][1]; v0[3] = v0[3] * cs[1][2] + sgn * b0[3] * cs[1][3];
                        v1[0] = v1[0] * cs[2][0] + sgn * b1[0] * cs[2][1]; v1[1] = v1[1] * cs[2][2] + sgn * b1[1] * cs[2][3];
                        v1[2] = v1[2] * cs[3][0] + sgn * b1[2] * cs[3][1]; v1[3] = v1[3] * cs[3][2] + sgn * b1[3] * cs[3][3];
                    }
                    if (do_gelu) {
#pragma unroll
                        for (int j = 0; j < 4; ++j) { v0[j] = gelu_fast(v0[j]); v1[j] = gelu_fast(v1[j]); }
                    }
                    v0 = v0 * sc; v1 = v1 * sc;
                    u32x4 w; w.x = cvtpk(v0[0], v0[1]); w.y = cvtpk(v0[2], v0[3]); w.z = cvtpk(v1[0], v1[1]); w.w = cvtpk(v1[2], v1[3]);
                    *(u32x4*)(rowp + bj * 128) = w;
                }
            }
    }
};
template <bool RES_F32>
struct EpiOut {
    static constexpr bool PERM = true, AFTER_DRAIN = false, WIDE = false;
    struct Pre {}; __device__ __forceinline__ void prefetch(Pre&, const pg8::Unit&, int, int, int, int) const {}
    bf16_t* X; const float* gate; const float* res_lat; const float* res_ctx;
    __device__ __forceinline__ void operator()(const f32x4 (&acc)[2][2][4][2], const pg8::Unit& u, int wr, int wc, int fr, int fq, const Pre& pre) const {
        const int row0 = u.pm * 256 + wr * 64 + fr, col0 = u.pn * 256 + wc * 32 + 8 * fq;
        const float* g = gate + (size_t)mod_row(u.pm * 256) * 6144 + col0;
        f32x4 gv[2][2];
#pragma unroll
        for (int bj = 0; bj < 2; ++bj)
#pragma unroll
            for (int n = 0; n < 2; ++n) gv[bj][n] = *(const f32x4*)(g + bj * 128 + n * 4);
#pragma unroll
        for (int ai = 0; ai < 2; ++ai)
#pragma unroll
            for (int m = 0; m < 4; ++m) { const size_t off = (size_t)(row0 + ai * 128 + m * 16) * D + col0;
#pragma unroll
                for (int bj = 0; bj < 2; ++bj) {
                    f32x4 r0, r1;
                    if (RES_F32) { const float* rp = (u.pm < T / 256 ? res_lat : res_ctx) + off + bj * 128; r0 = *(const f32x4*)rp; r1 = *(const f32x4*)(rp + 4); }
                    else { const u32x4 w = *(const u32x4*)(X + off + bj * 128);
                        r0 = (f32x4){__uint_as_float(w.x << 16), __uint_as_float(w.x & 0xffff0000u), __uint_as_float(w.y << 16), __uint_as_float(w.y & 0xffff0000u)};
                        r1 = (f32x4){__uint_as_float(w.z << 16), __uint_as_float(w.z & 0xffff0000u), __uint_as_float(w.w << 16), __uint_as_float(w.w & 0xffff0000u)}; }
                    const f32x4 v0 = r0 + gv[bj][0] * acc[ai][bj][m][0], v1 = r1 + gv[bj][1] * acc[ai][bj][m][1];
                    u32x4 o; o.x = cvtpk(v0[0], v0[1]); o.y = cvtpk(v0[2], v0[3]); o.z = cvtpk(v1[0], v1[1]); o.w = cvtpk(v1[2], v1[3]);
                    *(u32x4*)(X + off + bj * 128) = o; } }
    }
};
__device__ __forceinline__ float swiglu(float g, float u) {
    const float gt = fminf(g, 7.0f), up = fminf(fmaxf(u, -7.0f), 7.0f);
    return (up + 1.0f) * gt * __builtin_amdgcn_rcpf(1.0f + __builtin_amdgcn_exp2f(-1.702f * 1.4426950408889634f * gt));
}
struct EpiAct {
    static constexpr bool PERM = true, AFTER_DRAIN = false, WIDE = false;
    unsigned char* ACT; const float* bgu;
    struct Pre { f32x4 bg0, bg1, bu0, bu1; };
    __device__ __forceinline__ void prefetch(Pre& q, const pg8::Unit& u, int wr, int wc, int fr, int fq) const {
        const float* bp = bgu + (size_t)u.e * 2048 + u.pn * 128 + wc * 32 + 8 * fq;
        q.bg0 = *(const f32x4*)(bp); q.bg1 = *(const f32x4*)(bp + 4); q.bu0 = *(const f32x4*)(bp + 1024); q.bu1 = *(const f32x4*)(bp + 1028);
    }
    __device__ __forceinline__ void operator()(const f32x4 (&acc)[2][2][4][2], const pg8::Unit& u, int wr, int wc, int fr, int fq, const Pre& pre) const {
        const int row0 = u.pm * 256 + wr * 64 + fr, j0 = u.pn * 128 + wc * 32 + 8 * fq;
        const f32x4 bg0 = pre.bg0, bg1 = pre.bg1, bu0 = pre.bu0, bu1 = pre.bu1;
#pragma unroll
        for (int ai = 0; ai < 2; ++ai)
#pragma unroll
            for (int m = 0; m < 4; ++m) {
                const f32x4 g0 = acc[ai][0][m][0] + bg0, g1 = acc[ai][0][m][1] + bg1, u0 = acc[ai][1][m][0] + bu0, u1 = acc[ai][1][m][1] + bu1;
                uint2 w;
                w.x = __builtin_amdgcn_cvt_pk_fp8_f32(swiglu(g0[2], u0[2]), swiglu(g0[3], u0[3]), __builtin_amdgcn_cvt_pk_fp8_f32(swiglu(g0[0], u0[0]), swiglu(g0[1], u0[1]), 0u, false), true);
                w.y = __builtin_amdgcn_cvt_pk_fp8_f32(swiglu(g1[2], u1[2]), swiglu(g1[3], u1[3]), __builtin_amdgcn_cvt_pk_fp8_f32(swiglu(g1[0], u1[0]), swiglu(g1[1], u1[1]), 0u, false), true);
                *(uint2*)(ACT + (size_t)(row0 + ai * 128 + m * 16) * FF + j0) = w;
            }
    }
};
__device__ __forceinline__ void wide_store16(bf16_t* rowp  , const size_t stride8, const u32x4 w0, const u32x4 w1, const bool lo) {
    u32x4 dA, dB;
#pragma unroll
    for (int q = 0; q < 4; ++q) {
        const unsigned snd = lo ? w1[q] : w0[q];
        const unsigned rcv = (unsigned)__builtin_amdgcn_mov_dpp((int)snd, 0x128, 0xf, 0xf, true);
        dA[q] = lo ? w0[q] : rcv; dB[q] = lo ? rcv : w1[q];
    }
    *(u32x4*)rowp = dA; *(u32x4*)(rowp + stride8) = dB;
}
struct EpiYB {
    static constexpr bool PERM = true, AFTER_DRAIN = false, WIDE = true;
    bf16_t* YB; const float* bdn;
    struct Pre { f32x4 bv[2][2]; };
    __device__ __forceinline__ void prefetch(Pre& q, const pg8::Unit& u, int wr, int wc, int fr, int fq) const {
        const float* bp = bdn + (size_t)u.e * D + u.pn * 256 + wc * 64 + 8 * fq;
#pragma unroll
        for (int bj = 0; bj < 2; ++bj)
#pragma unroll
            for (int n = 0; n < 2; ++n) q.bv[bj][n] = *(const f32x4*)(bp + bj * 32 + n * 4);
    }
    __device__ __forceinline__ void operator()(const f32x4 (&acc)[2][2][4][2], const pg8::Unit& u, int wr, int wc, int fr, int fq, const Pre& pre) const {
        const bool lo = fr < 8;
        const int row0 = u.pm * 256 + wr * 64 + (fr & 7), col0 = u.pn * 256 + wc * 64 + 8 * fq;
#pragma unroll
        for (int ai = 0; ai < 2; ++ai)
#pragma unroll
            for (int m = 0; m < 4; ++m) {
                u32x4 w[2];
#pragma unroll
                for (int bj = 0; bj < 2; ++bj) { const f32x4 v0 = acc[ai][bj][m][0] + pre.bv[bj][0], v1 = acc[ai][bj][m][1] + pre.bv[bj][1];
                    w[bj].x = cvtpk(v0[0], v0[1]); w[bj].y = cvtpk(v0[2], v0[3]); w[bj].z = cvtpk(v1[0], v1[1]); w[bj].w = cvtpk(v1[2], v1[3]); }
                wide_store16(YB + (size_t)(row0 + ai * 128 + m * 16) * D + col0 + (lo ? 0 : 32), (size_t)8 * D, w[0], w[1], lo);
            }
    }
};
struct MoeOrder {
    int nN, nunits, G, v; const int* tile_e;
    __device__ void init(int ntiles, int nN_, int G_, int c, const int* te) { nN = nN_; nunits = ntiles * nN_; G = G_; v = (G_ % 8 == 0) ? (c % 8) * (G_ / 8) + c / 8 : c; tile_e = te; }
    __device__ bool next(int i, pg8::Unit& u) const {
        const int L = i * G + v; if (L >= nunits) return false;
        u.pm = L / nN; u.pn = L % nN; u.e = tile_e[u.pm]; return true;
    }
    __device__ __forceinline__ const bf16_t* bt(const pg8::Gemm& g, const pg8::Unit& u) const { return g.Bt + (size_t)u.e * g.N * g.K; }
    __device__ __forceinline__ void a_ready(const pg8::Unit&) const {}
    __device__ __forceinline__ void done(const pg8::Unit&) const {}
};

__device__ __forceinline__ void ph_gemm_proj(const P& p, int l, char* lds, const int wv) {
    pg8::Gemm g{p.H, p.WinT + (size_t)l * PW * D, R, PW, D}; pg8::StaticOrder S; S.init(R, PW, (int)gridDim.x, (int)blockIdx.x);
    EpiProj E{p.PROJ, p.rope};
    pg8::gemm_phase<EpiProj, pg8::StaticOrder, true, true>((PG8_LAS unsigned char*)lds, g, S, E, wv);
}
__device__ __forceinline__ void ph_gemm_out(const P& p, int l, int nrows, char* lds, const int wv) {
    pg8::Gemm g{p.MIX, p.WoutT + (size_t)l * D * D, T, D, D}; pg8::StaticOrder S; S.init(T, D, (int)gridDim.x, (int)blockIdx.x);
    if (l == 0) { EpiOut<true> E{p.X, p.mod + (size_t)l * 5 * 6144 + 2 * 1024, p.x, p.ctx - (size_t)T * D}; pg8::gemm_phase<EpiOut<true>, pg8::StaticOrder, true, true>((PG8_LAS unsigned char*)lds, g, S, E, wv); }
    else { EpiOut<false> E{p.X, p.mod + (size_t)l * 5 * 6144 + 2 * 1024, nullptr, nullptr}; pg8::gemm_phase<EpiOut<false>, pg8::StaticOrder, true, true>((PG8_LAS unsigned char*)lds, g, S, E, wv); }
    if (nrows > T) {
        const int tid = ltid(wv), lane = tid & 63, wid = tid >> 6, fr = lane & 15, fq = lane >> 4;
        const bf16_t* Wt = p.WoutT + (size_t)l * D * D;
        const float* gate = p.mod + ((size_t)l * 5 + 4) * 6144 + 2 * 1024;
        for (int it = blockIdx.x; it < (TC / 64) * (D / 64); it += gridDim.x) {
            const int m0 = T + (it >> 4) * 64 + (wid & 3) * 16, n0 = (it & 15) * 64 + (wid >> 2) * 32;
            const bf16_t* ap = p.MIX + (size_t)(m0 + fr) * D + fq * 8;
            const bf16_t* bp0 = Wt + (size_t)(n0 + fr) * D + fq * 8;
            const bf16_t* bp1 = bp0 + (size_t)16 * D;
            f32x4 acc0 = (f32x4){0.f, 0.f, 0.f, 0.f}, acc1 = acc0;
#pragma unroll 8
            for (int ks = 0; ks < D / 32; ++ks) {
                const bf16x8 af = *(const bf16x8*)(ap + ks * 32), b0 = *(const bf16x8*)(bp0 + ks * 32), b1 = *(const bf16x8*)(bp1 + ks * 32);
                acc0 = __builtin_amdgcn_mfma_f32_16x16x32_bf16(b0, af, acc0, 0, 0, 0);
                acc1 = __builtin_amdgcn_mfma_f32_16x16x32_bf16(b1, af, acc1, 0, 0, 0);
            }
            const int row = m0 + fr, c0 = n0 + fq * 4;
            const size_t off = (size_t)row * D + c0;
            const float* res = p.ctx - (size_t)T * D;
            const f32x4 v0 = *(const f32x4*)(res + off) + *(const f32x4*)(gate + c0) * acc0, v1 = *(const f32x4*)(res + off + 16) + *(const f32x4*)(gate + c0 + 16) * acc1;
            uint2 o0, o1; o0.x = cvtpk(v0[0], v0[1]); o0.y = cvtpk(v0[2], v0[3]); o1.x = cvtpk(v1[0], v1[1]); o1.y = cvtpk(v1[2], v1[3]);
            *(uint2*)(p.X + off) = o0; *(uint2*)(p.X + off + 16) = o1;
        }
    }
}
__device__ __forceinline__ void ph_moe1(const P& p, int l, char* lds, const int wv) {
    const int* meta = p.moe_meta + l * 512;
    const int ntiles = meta[0];
    pg8::Gemm g{(const bf16_t*)p.HS, (const bf16_t*)(p.WguT + (size_t)l * NE * 2048 * D), ntiles * 256, 2048, D / 2}; MoeOrder S; S.init(ntiles, 8, (int)gridDim.x, (int)blockIdx.x, meta + 1);
    EpiAct E{p.ACT, p.b_gu + (size_t)l * NE * 2048};
    pg8::gemm_phase<EpiAct, MoeOrder, true, true, true>((PG8_LAS unsigned char*)lds, g, S, E, wv);
}
__device__ __forceinline__ void ph_moe2(const P& p, int l, char* lds, const int wv) {
    const int* meta = p.moe_meta + l * 512;
    const int ntiles = meta[0];
    pg8::Gemm g{(const bf16_t*)p.ACT, (const bf16_t*)(p.WdnT + (size_t)l * NE * D * FF), ntiles * 256, D, FF / 2}; MoeOrder S; S.init(ntiles, 4, (int)gridDim.x, (int)blockIdx.x, meta + 1);
    EpiYB E{p.YB, p.b_down + (size_t)l * NE * D};
    pg8::gemm_phase<EpiYB, MoeOrder, true, true, true>((PG8_LAS unsigned char*)lds, g, S, E, wv);
}
struct CombRow { uint4 y0[2], y1[2], y2[2], y3[2], xw[2]; float4 g; };
__device__ __forceinline__ void comb_load(CombRow& c, const bf16_t* __restrict__ YB, const bf16_t* __restrict__ X, const int* __restrict__ tok_slot, const float* __restrict__ topg, int row, int lane) {
    const int4 sl = *(const int4*)(tok_slot + (size_t)row * 4);
    c.g = *(const float4*)(topg + (size_t)row * 4);
#pragma unroll
    for (int i = 0; i < 2; ++i) {
        const int k = lane * 8 + 512 * i;
        c.y0[i] = *(const uint4*)(YB + (size_t)sl.x * D + k); c.y1[i] = *(const uint4*)(YB + (size_t)sl.y * D + k);
        c.y2[i] = *(const uint4*)(YB + (size_t)sl.z * D + k); c.y3[i] = *(const uint4*)(YB + (size_t)sl.w * D + k);
        c.xw[i] = *(const uint4*)(X + (size_t)row * D + k);
    }
}
__device__ __forceinline__ void comb_finish(const P& p, const CombRow& c, int l, int row, int lane) {
    const float* m = p.mod + ((size_t)l * 5 + mod_row(row)) * 6144 + 5 * 1024;
    const float4 g = c.g;
    float xv[16]; float ss = 0.f;
#pragma unroll
    for (int i = 0; i < 2; ++i) {
        const int k = lane * 8 + 512 * i;
        const unsigned a0[4] = {c.y0[i].x, c.y0[i].y, c.y0[i].z, c.y0[i].w}, a1[4] = {c.y1[i].x, c.y1[i].y, c.y1[i].z, c.y1[i].w};
        const unsigned a2[4] = {c.y2[i].x, c.y2[i].y, c.y2[i].z, c.y2[i].w}, a3[4] = {c.y3[i].x, c.y3[i].y, c.y3[i].z, c.y3[i].w};
        const unsigned xq[4] = {c.xw[i].x, c.xw[i].y, c.xw[i].z, c.xw[i].w};
        const float4 gta = *(const float4*)(m + k), gtb = *(const float4*)(m + k + 4);
        const float gt[8] = {gta.x, gta.y, gta.z, gta.w, gtb.x, gtb.y, gtb.z, gtb.w};
#pragma unroll
        for (int q = 0; q < 4; ++q) {
            const float ylo = g.x * __uint_as_float(a0[q] << 16) + g.y * __uint_as_float(a1[q] << 16) + g.z * __uint_as_float(a2[q] << 16) + g.w * __uint_as_float(a3[q] << 16);
            const float yhi = g.x * __uint_as_float(a0[q] & 0xffff0000u) + g.y * __uint_as_float(a1[q] & 0xffff0000u) + g.z * __uint_as_float(a2[q] & 0xffff0000u) + g.w * __uint_as_float(a3[q] & 0xffff0000u);
            const float v0 = __uint_as_float(xq[q] << 16) + gt[2 * q] * ylo, v1 = __uint_as_float(xq[q] & 0xffff0000u) + gt[2 * q + 1] * yhi;
            xv[8 * i + 2 * q] = v0; xv[8 * i + 2 * q + 1] = v1; ss += v0 * v0 + v1 * v1;
        }
    }
    ss = wave_sum(ss);
    const float rstd = rsqrtf(ss * (1.f / D) + EPS);
    if (l == 0) {
        const float* m1 = p.mod + ((size_t)5 + mod_row(row)) * 6144;
        const float* g1 = p.g_mix + D;
#pragma unroll
        for (int i = 0; i < 2; ++i) {
            const int k = lane * 8 + 512 * i;
            { u32x4 xo; xo.x = cvtpk(xv[8 * i], xv[8 * i + 1]); xo.y = cvtpk(xv[8 * i + 2], xv[8 * i + 3]); xo.z = cvtpk(xv[8 * i + 4], xv[8 * i + 5]); xo.w = cvtpk(xv[8 * i + 6], xv[8 * i + 7]); *(u32x4*)(p.X + (size_t)row * D + k) = xo; }
            const float4 ga = *(const float4*)(g1 + k), gb = *(const float4*)(g1 + k + 4);
            const float4 sha = *(const float4*)(m1 + k), shb = *(const float4*)(m1 + k + 4);
            const float4 sca = *(const float4*)(m1 + 1024 + k), scb = *(const float4*)(m1 + 1024 + k + 4);
            u32x4 o;
            o.x = cvtpk(xv[8 * i] * rstd * ga.x * (1.f + sca.x) + sha.x, xv[8 * i + 1] * rstd * ga.y * (1.f + sca.y) + sha.y);
            o.y = cvtpk(xv[8 * i + 2] * rstd * ga.z * (1.f + sca.z) + sha.z, xv[8 * i + 3] * rstd * ga.w * (1.f + sca.w) + sha.w);
            o.z = cvtpk(xv[8 * i + 4] * rstd * gb.x * (1.f + scb.x) + shb.x, xv[8 * i + 5] * rstd * gb.y * (1.f + scb.y) + shb.y);
            o.w = cvtpk(xv[8 * i + 6] * rstd * gb.z * (1.f + scb.z) + shb.z, xv[8 * i + 7] * rstd * gb.w * (1.f + scb.w) + shb.w);
            *(u32x4*)(p.H + (size_t)row * D + k) = o;
        }
    } else {
#pragma unroll
        for (int i = 0; i < 2; ++i) {
            const int k = lane * 8 + 512 * i;
            const float4 ga = *(const float4*)(p.g_final + k), gb = *(const float4*)(p.g_final + k + 4);
            float* op = p.out + (size_t)row * D + k;
            *(float4*)op = make_float4(xv[8 * i] * rstd * ga.x, xv[8 * i + 1] * rstd * ga.y, xv[8 * i + 2] * rstd * ga.z, xv[8 * i + 3] * rstd * ga.w);
            *(float4*)(op + 4) = make_float4(xv[8 * i + 4] * rstd * gb.x, xv[8 * i + 5] * rstd * gb.y, xv[8 * i + 6] * rstd * gb.z, xv[8 * i + 7] * rstd * gb.w);
        }
    }
}
__device__ __forceinline__ void ph_combine(const P& p, int l, int nrows, const int wv) {
    const int wave = ltid(wv) >> 6, lane = ltid(wv) & 63;
    for (int pr = blockIdx.x * 8 + wave; pr < nrows / 2; pr += gridDim.x * 8) {
        CombRow ca, cb;
        comb_load(ca, p.YB, p.X, p.tok_slot, p.topg, 2 * pr, lane);
        comb_load(cb, p.YB, p.X, p.tok_slot, p.topg, 2 * pr + 1, lane);
        comb_finish(p, ca, l, 2 * pr, lane);
        comb_finish(p, cb, l, 2 * pr + 1, lane);
    }
}
extern __shared__ __attribute__((aligned(16))) char smem[];
__global__ void __launch_bounds__(NT, 2) mega(P p) {
    char* lds = smem;
    int wv = __builtin_amdgcn_readfirstlane((int)(threadIdx.x >> 6)); asm volatile("" : "+s"(wv));
    if (threadIdx.x == 0) *(uint4*)(smem + LDS_MAIN) = make_uint4(0u, 0u, 0u, 0u);
    __syncthreads();
    XcdBarrier bar = xcd_barrier_post(p.bar, (volatile LAS unsigned*)(smem + LDS_MAIN), wv);
    ph_prologue(p, lds, 0, wv);
    xcd_barrier(bar);
    ph_norm1(p, 0, wv);
    ph_prologue(p, lds, 1, wv);
    xcd_barrier(bar);
#define MEGA_LAYER(l, nrows, LAST) do { \
        ph_gemm_proj(p, l, lds, wv); xcd_barrier(bar); \
        ph_dattn(p, l, nrows, lds, wv); ph_na(p, l, nrows, lds, wv); ph_pool(p, l, nrows, lds, wv); ph_sgu(p, l, nrows, lds, wv); xcd_barrier(bar); \
        ph_gemm_out(p, l, nrows, lds, wv); xcd_barrier(bar); \
        ph_router(p, l, nrows, lds, wv); xcd_barrier(bar); \
        ph_assign(p, l, nrows, lds, wv); xcd_barrier(bar); \
        ph_moe1(p, l, lds, wv); xcd_barrier(bar); \
        ph_moe2(p, l, lds, wv); xcd_barrier(bar); \
        ph_combine(p, l, nrows, wv); if (!(LAST)) xcd_barrier(bar); } while (0)
    MEGA_LAYER(0, R, false);
    MEGA_LAYER(1, T, true);
#undef MEGA_LAYER
}

static inline size_t align_up(size_t v, size_t a) { return (v + a - 1) / a * a; }

extern "C" void kernel_launch(void* const* d_in, const int* in_sizes, int n_in, void* d_out, int out_size, void* d_ws, size_t ws_size, hipStream_t stream) {
    P p{};
    const float** ins = (const float**)&p.x;
    for (int i = 0; i < 28; ++i) ins[i] = (const float*)d_in[i];
    p.out = (float*)d_out;
    char* w = (char*)d_ws; size_t off = 0;
    auto carve = [&](size_t bytes) { void* r = w + off; off = align_up(off + bytes, 256); return r; };
    const size_t ctl_bytes = XCD_BAR_WORDS * 4 + 2 * 64 * 4;
    p.bar = (unsigned*)carve(ctl_bytes);
    p.cnt = (int*)(p.bar + XCD_BAR_WORDS);
    p.mod = (float*)carve((size_t)2 * 5 * 6144 * 4);
    p.rope = (float*)carve(64 * 8 * 2 * 4);
    p.RG = (float*)carve((size_t)2 * 5 * 1024 * 4);
    p.RB = (float*)carve((size_t)2 * 5 * 32 * 4);
    p.X = (bf16_t*)carve((size_t)R * D * 2);
    p.H = (bf16_t*)carve((size_t)R * D * 2);
    p.PROJ = (bf16_t*)carve((size_t)R * PW * 2);
    p.MIX = (bf16_t*)carve((size_t)R * D * 2);
    p.WinT = (bf16_t*)carve((size_t)2 * PW * D * 2);
    p.WoutT = (bf16_t*)carve((size_t)2 * D * D * 2);
    p.WguT = (unsigned char*)carve((size_t)2 * NE * 2048 * D);
    p.WdnT = (unsigned char*)carve((size_t)2 * NE * D * FF);
    p.WpT = (bf16_t*)carve((size_t)2 * 4 * 64 * 64 * 2);
    p.WsB = (bf16_t*)carve((size_t)2 * 4 * 128 * 128 * 2);
    p.topi = (int*)carve((size_t)R * 4 * 4);
    p.topg = (float*)carve((size_t)R * 4 * 4);
    p.tok_slot = (int*)carve((size_t)R * 4 * 4);
    p.moe_meta = (int*)carve(2 * 512 * 4);
    p.HS = (unsigned char*)carve((size_t)NSLOT * D);
    p.ACT = (unsigned char*)carve((size_t)NSLOT * FF);
    p.YB = (bf16_t*)carve((size_t)NSLOT * D * 2);

    static int grid = 0;
    if (!grid) {
        int dev = 0, cus = 0, per_cu = 0;
        (void)hipGetDevice(&dev);
        (void)hipDeviceGetAttribute(&cus, hipDeviceAttributeMultiprocessorCount, dev);
        (void)hipFuncSetAttribute((const void*)mega, hipFuncAttributeMaxDynamicSharedMemorySize, LDS_BYTES);
        (void)hipOccupancyMaxActiveBlocksPerMultiprocessor(&per_cu, mega, NT, LDS_BYTES);
        grid = cus * (per_cu < 1 ? per_cu : 1);
        if (grid <= 0) { fprintf(stderr, "mega: occupancy query returned %d blocks per CU\n", per_cu); grid = 0; return; }
    }
    (void)hipMemsetAsync(p.bar, 0, ctl_bytes, stream);
    mega<<<grid, NT, LDS_BYTES, stream>>>(p);
}
```

```cpp
#include <hip/hip_runtime.h>
#include <stdint.h>
#include <cstdio>

typedef unsigned short bf16_t;
typedef short bf16x8 __attribute__((ext_vector_type(8)));
typedef float f32x4 __attribute__((ext_vector_type(4)));

constexpr int D = 1024, NB = 4, S = 4096, T = NB * S, CL = 256, TC = NB * CL, R = T + TC;
constexpr int PW = 2304, NE = 32, TOPK = 4, FF = 1024;
constexpr int MAXSLOT = R * TOPK;
constexpr int NSLOT = MAXSLOT + NE * 256;
constexpr float EPS = 1e-6f;
constexpr int NT = 512;
constexpr int LDS_MAIN = 150 * 1024;
constexpr int LDS_BYTES = LDS_MAIN + 1024;

__device__ __forceinline__ bf16_t f2bf(float f) { unsigned u = __float_as_uint(f); return (bf16_t)((u + 0x7fffu + ((u >> 16) & 1u)) >> 16); }
__device__ __forceinline__ float bf2f(bf16_t h) { return __uint_as_float(((unsigned)h) << 16); }
__device__ __forceinline__ float wave_sum(float v) {
#pragma unroll
    for (int o = 32; o >= 1; o >>= 1) v += __shfl_xor(v, o);
    return v;
}
__device__ __forceinline__ int mod_row(int row) { return row < T ? (row >> 12) : 4; }

#define XB_TMO      128
#define XB_XCNT(j)  (256  + 64 * (j))
#define XB_XSUB(j)  (1280 + 64 * (j))
#define XB_XGEN(j)  (2304 + 64 * (j))
#define XB_TOP      3328
#define XB_TOPGEN   3392
#define XCD_BAR_WORDS 3456
#define XB_SPIN_CAP (1u << 18)
#define LAS __attribute__((address_space(3)))

__device__ __forceinline__ unsigned xb_ld(unsigned* p)              { return __hip_atomic_load(p, __ATOMIC_RELAXED, __HIP_MEMORY_SCOPE_AGENT); }
__device__ __forceinline__ unsigned xb_add(unsigned* p, unsigned v) { return __hip_atomic_fetch_add(p, v, __ATOMIC_RELAXED, __HIP_MEMORY_SCOPE_AGENT); }
__device__ __forceinline__ unsigned xb_xcc_id() { return (unsigned)__builtin_amdgcn_s_getreg((3 << 11) | 20) & 0xFu; }
#define XB_SPIN(cond, bar) do { unsigned _sp = 0; while (cond) { __builtin_amdgcn_s_sleep(1); \
    if ((++_sp & 255u) == 0u) { if (xb_ld(&(bar)[XB_TMO])) break; if (_sp > XB_SPIN_CAP) { atomicAdd(&(bar)[XB_TMO], 1u); break; } } } } while (0)

struct XcdBarrier {
    unsigned* bar; unsigned x;
    volatile LAS unsigned* st;
    int wv;
};
__device__ __forceinline__ bool xb_t0(const int wv) { return wv == 0 && __builtin_amdgcn_mbcnt_hi(~0u, __builtin_amdgcn_mbcnt_lo(~0u, 0u)) == 0u; }
__device__ __forceinline__ XcdBarrier xcd_barrier_post(unsigned* bar, volatile LAS unsigned* st, const int wv) {
    XcdBarrier b; b.bar = bar; b.x = xb_xcc_id(); b.st = st; b.wv = wv;
    if (xb_t0(wv)) (void)xb_add(&bar[XB_XCNT(b.x)], 1u);
    return b;
}
__device__ __forceinline__ void xcd_barrier_complete(unsigned* bar, unsigned x, unsigned& nloc, unsigned& nx) {
    const unsigned G = gridDim.x * gridDim.y * gridDim.z;
    unsigned sum, cnt, mine, sp = 0u;
    for (;;) {
        sum = 0u; cnt = 0u; mine = 0u;
#pragma unroll
        for (unsigned j = 0; j < 16; ++j) { const unsigned c = xb_ld(&bar[XB_XCNT(j)]); sum += c; cnt += (c > 0u) ? 1u : 0u; mine = (j == x) ? c : mine; }
        if (sum == G) break;
        __builtin_amdgcn_s_sleep(1);
        if ((++sp & 255u) == 0u) { if (xb_ld(&bar[XB_TMO])) break; if (sp > XB_SPIN_CAP) { atomicAdd(&bar[XB_TMO], 1u); break; } }
    }
    nloc = mine > 0u ? mine : 1u; nx = cnt > 0u ? cnt : 1u;
}
__device__ __forceinline__ void xcd_barrier(const XcdBarrier& b) {
    asm volatile("s_waitcnt vmcnt(0)" ::: "memory");
    __syncthreads();
    if (xb_t0(b.wv)) {
        unsigned* bar = b.bar;
        __builtin_amdgcn_s_waitcnt(0);
        unsigned nloc = b.st[0], nx = b.st[1];
        if (nloc == 0u) { xcd_barrier_complete(bar, b.x, nloc, nx); b.st[0] = nloc; b.st[1] = nx; }
        const unsigned old = xb_add(&bar[XB_XSUB(b.x)], 1u);
        const unsigned gen = old / nloc;
        if (old + 1u == (gen + 1u) * nloc) {
            __builtin_amdgcn_fence(__ATOMIC_RELEASE, "agent");
            asm volatile("s_waitcnt vmcnt(0)" ::: "memory");
            const unsigned og = xb_add(&bar[XB_TOP], 1u);
            const unsigned tg = og / nx;
            if (og + 1u == (tg + 1u) * nx) xb_add(&bar[XB_TOPGEN], 1u);
            else XB_SPIN(xb_ld(&bar[XB_TOPGEN]) == tg, bar);
            __builtin_amdgcn_fence(__ATOMIC_ACQUIRE, "agent");
            xb_add(&bar[XB_XGEN(b.x)], 1u);
            asm volatile("s_waitcnt vmcnt(0)" ::: "memory");
        } else {
            XB_SPIN(xb_ld(&bar[XB_XGEN(b.x)]) == gen, bar);
            __builtin_amdgcn_fence(__ATOMIC_ACQUIRE, "agent");
            asm volatile("s_waitcnt vmcnt(0)" ::: "memory");
        }
    }
    __syncthreads();
}

struct P {
    const float *x, *c, *ctx, *c_ctx, *w_mod, *b_mod, *g_mix, *g_ffn, *w_in, *w_out, *lam_q1, *lam_k1, *lam_q2, *lam_k2, *g_sub,
        *w_pool, *s_pool, *g_sgu, *w_sgu, *b_sgu, *rpb, *w_router, *b_router, *w_gu, *b_gu, *w_down, *b_down, *g_final;
    float* out;
    unsigned* bar;
    int* cnt;
    float* mod;
    float* rope;
    float* RG;
    float* RB;
    bf16_t* X;
    bf16_t* H;
    bf16_t* PROJ;
    bf16_t* MIX;
    bf16_t* WinT;
    bf16_t* WoutT;
    unsigned char* WguT;
    unsigned char* WdnT;
    bf16_t* WpT;
    bf16_t* WsB;
    int* topi;
    float* topg;
    int* tok_slot;
    int* moe_meta;
    unsigned char* HS;
    int* slot_tok;
    unsigned char* ACT;
    bf16_t* YB;
};

__device__ __forceinline__ int ltid(const int wv) { int t; asm volatile("v_mbcnt_lo_u32_b32 %0, -1, 0\n\tv_mbcnt_hi_u32_b32 %0, -1, %0\n\tv_lshl_or_b32 %0, %1, 6, %0" : "=&v"(t) : "s"(wv)); return t; }
typedef float f32x16 __attribute__((ext_vector_type(16)));
typedef short s16x4 __attribute__((ext_vector_type(4)));
typedef short v4i16_t __attribute__((ext_vector_type(4)));
typedef float f32x2_t __attribute__((ext_vector_type(2)));
typedef __bf16 bf16x2_t __attribute__((ext_vector_type(2)));
typedef __attribute__((address_space(3))) const char* lds_cptr;
typedef unsigned u32x4 __attribute__((ext_vector_type(4)));
__device__ __forceinline__ unsigned cvtpk(float lo, float hi) { f32x2_t v = {lo, hi}; bf16x2_t b = __builtin_convertvector(v, bf16x2_t); return __builtin_bit_cast(unsigned, b); }
__device__ __forceinline__ s16x4 vtr(lds_cptr q) { return __builtin_bit_cast(s16x4, __builtin_amdgcn_ds_read_tr16_b64_v4i16((__attribute__((address_space(3))) v4i16_t*)q)); }
__device__ __forceinline__ float xhalf_max(float v) { auto rr = __builtin_amdgcn_permlane32_swap(__float_as_uint(v), __float_as_uint(v), false, false); return fmaxf(__uint_as_float(rr[0]), __uint_as_float(rr[1])); }
__device__ __forceinline__ float xhalf_sum(float v) { auto rr = __builtin_amdgcn_permlane32_swap(__float_as_uint(v), __float_as_uint(v), false, false); return __uint_as_float(rr[0]) + __uint_as_float(rr[1]); }
namespace pg8 {
#define PG8_LAS __attribute__((address_space(3)))
constexpr int BM = 256, BK = 64, HALF = 128, HTB = HALF * BK * 2  , STAGE_BYTES = 8 * HTB, NXCD = 8, WGM = 8;
__host__ __device__ __forceinline__ int lds_byte(int r, int c) { const int st = (r >> 4) * 2 + (c >> 5), rr = r & 15, cc = c & 31, ob = rr * 64 + cc * 2; return st * 1024 + (ob ^ (((ob >> 9) & 1) << 5)); }
__host__ __device__ __forceinline__ void stage_rc(int b, int& R, int& C) { const int st = b / 1024, sb = b % 1024, swz = sb ^ (((sb >> 9) & 1) << 5); R = (st >> 1) * 16 + swz / 64; C = (st & 1) * 32 + (swz % 64) / 2; }
__host__ __device__ __forceinline__ int perm32(int rho) { const int n = rho >> 4, i = rho & 15; return 8 * (i >> 2) + 4 * n + (i & 3); }
struct Unit { int pm, pn, e; };
struct Gemm { const bf16_t* A; const bf16_t* Bt; int M, N, K; };
struct StaticOrder {
    int nM, nN, nwg, G, c;
    __host__ __device__ void init(int M, int N, int G_, int c_) { nM = M / BM; nN = N / BM; nwg = nM * nN; G = G_; c = c_; }
    __host__ __device__ bool next(int i, Unit& u) const {
        const long L = (long)i * G + c; if (L >= nwg) return false;
        int wgid = (int)L; { const int q = nwg / NXCD, r = nwg % NXCD, xcd = wgid % NXCD, off = wgid / NXCD; wgid = (xcd < r ? xcd * (q + 1) : r * (q + 1) + (xcd - r) * q) + off; }
        const int nig = WGM * nN, gid = wgid / nig, fm = gid * WGM, gsz = (nM - fm) < WGM ? (nM - fm) : WGM;
        u.pm = fm + ((wgid % nig) % gsz); u.pn = (wgid % nig) / gsz; u.e = 0; return true;
    }
    static constexpr bool GATHER = false;
    __device__ __forceinline__ const bf16_t* bt(const Gemm& g, const Unit&) const { return g.Bt; }
    __device__ __forceinline__ void a_ready(const Unit&) const {}
    __device__ __forceinline__ void done(const Unit&) const {}
};
typedef int v4i_t __attribute__((ext_vector_type(4)));
typedef int v8i_t __attribute__((ext_vector_type(8)));
__device__ __forceinline__ v8i_t cat8(bf16x8 a, bf16x8 b) { const v4i_t x = __builtin_bit_cast(v4i_t, a), y = __builtin_bit_cast(v4i_t, b); return __builtin_shufflevector(x, y, 0, 1, 2, 3, 4, 5, 6, 7); }
template <class Epi, class Sched, bool ALIGN_EPI = false, bool SP2 = false, bool F8 = false>
__device__ __forceinline__ void gemm_phase(PG8_LAS unsigned char* lds, const Gemm g, const Sched& S, const Epi& E, const int wv) {
    const int tid = ltid(wv), wid = __builtin_amdgcn_readfirstlane(tid >> 6), lane = tid & 63, wr = wid >> 2, wc = wid & 3, fr = lane & 15, fq = lane >> 4;
    const int K = g.K, nt = K / BK;
    unsigned voffA[2], voffB[2];
#pragma unroll
    for (int i = 0; i < 2; ++i) { int R, C; stage_rc(tid * 16 + i * 8192, R, C); const int Rb = Epi::WIDE ? ((R >> 5) * 64 + perm32(R & 31)) : Epi::PERM ? ((R & ~31) + perm32(R & 31)) : R;
        voffA[i] = (unsigned)(R * K + C) * 2u; voffB[i] = (unsigned)(Rb * K + C) * 2u; }
    int gR[2] = {0, 0}; unsigned gC[2] = {0u, 0u};
    PG8_LAS int* gtab = (PG8_LAS int*)(lds + STAGE_BYTES);
    if constexpr (Sched::GATHER) {
        static_assert(SP2, "gather is wired into the SP2 pipeline only");
#pragma unroll
        for (int i = 0; i < 2; ++i) { int R, C; stage_rc(tid * 16 + i * 8192, R, C); gR[i] = R; gC[i] = (unsigned)C * 2u; }
    }
#define PG8_GATHER(u_, sel_) do { if (tid < 256) gtab[(sel_) * 256 + tid] = S.tok((u_).pm * 256 + tid); } while (0)
    const size_t kstep = (size_t)(BK * 2);
    const size_t hstep = (size_t)HALF * K * 2;
    const size_t tstep = 2 * hstep;
    const size_t bstep = Epi::WIDE ? (size_t)32 * K * 2 : hstep;
    const unsigned ldsw = (unsigned)wid * 1024u;
    const int aoff = lds_byte(wr * 64 + fr, fq * 8), boff = lds_byte(wc * 32 + fr, fq * 8);
#define PG8_SA(b, h) (((b) * 2 + (h)) * HTB)
#define PG8_SB(b, h) ((4 + (b) * 2 + (h)) * HTB)
#define PG8_STAGE(bufoff, gbase, voff) do { _Pragma("unroll") for (int _i = 0; _i < 2; ++_i) \
        __builtin_amdgcn_global_load_lds((const unsigned*)((const char*)(gbase) + (voff)[_i]), (PG8_LAS unsigned*)(lds + (bufoff) + ldsw + _i * 8192), 16, 0, 0); } while (0)
#define PG8_STAGE_A(bufoff, gbase, h, nx) do { if constexpr (Sched::GATHER) { _Pragma("unroll") for (int _i = 0; _i < 2; ++_i) \
        __builtin_amdgcn_global_load_lds((const unsigned*)((const char*)(gbase) + ((unsigned)gtab[(((ui + ((nx) ? 1 : 0)) & 1)) * 256 + (h) * HALF + gR[_i]] * (unsigned)(K * 2) + gC[_i])), (PG8_LAS unsigned*)(lds + (bufoff) + ldsw + _i * 8192), 16, 0, 0); } \
        else { PG8_STAGE(bufoff, (gbase) + (h) * hstep, voffA); } } while (0)
#define PG8_LDA(dst, b, h) do { _Pragma("unroll") for (int m = 0; m < 4; ++m) _Pragma("unroll") for (int k = 0; k < 2; ++k) dst[m][k] = *(const PG8_LAS bf16x8*)(lds + PG8_SA(b, h) + aoff + m * 2048 + k * 1024); \
        if constexpr (F8) { _Pragma("unroll") for (int m = 0; m < 4; ++m) dst##8[m] = cat8(dst[m][0], dst[m][1]); } } while (0)
#define PG8_LDB(dst, b, h) do { _Pragma("unroll") for (int n = 0; n < 2; ++n) _Pragma("unroll") for (int k = 0; k < 2; ++k) dst[n][k] = *(const PG8_LAS bf16x8*)(lds + PG8_SB(b, h) + boff + n * 2048 + k * 1024); \
        if constexpr (F8) { _Pragma("unroll") for (int n = 0; n < 2; ++n) dst##8[n] = cat8(dst[n][0], dst[n][1]); } } while (0)
#define PG8_MMA(ai, bj, At, Bt) do { __builtin_amdgcn_s_setprio(1); \
        if constexpr (F8) { _Pragma("unroll") for (int m = 0; m < 4; ++m) _Pragma("unroll") for (int n = 0; n < 2; ++n) \
            asm volatile("v_mfma_scale_f32_16x16x128_f8f6f4 %0, %1, %2, %0, %3, %4 op_sel_hi:[0,0,0]" : "+v"(acc[ai][bj][m][n]) : "v"(Bt##8[n]), "v"(At##8[m]), "v"(sclW), "v"(sclX)); } \
        else { _Pragma("unroll") for (int m = 0; m < 4; ++m) _Pragma("unroll") for (int n = 0; n < 2; ++n) _Pragma("unroll") for (int k = 0; k < 2; ++k) \
            acc[ai][bj][m][n] = __builtin_amdgcn_mfma_f32_16x16x32_bf16(Bt[n][k], At[m][k], acc[ai][bj][m][n], 0, 0, 0); } \
        __builtin_amdgcn_s_setprio(0); } while (0)
#define PG8_WAIT_V(n) asm volatile("s_waitcnt vmcnt(" #n ")" ::: "memory")
#define PG8_WAIT_L(n) asm volatile("s_waitcnt lgkmcnt(" #n ")" ::: "memory")
#define PG8_BAR __builtin_amdgcn_s_barrier()
#define PG8_SCHED __builtin_amdgcn_sched_barrier(0)
    Unit cur, nxt; int ui = 0;
    typename Epi::Pre pre;
    if (!S.next(0, cur)) return;
    f32x4 acc[2][2][4][2];
#pragma unroll
    for (int a = 0; a < 2; ++a)
#pragma unroll
        for (int b = 0; b < 2; ++b)
#pragma unroll
            for (int m = 0; m < 4; ++m)
#pragma unroll
                for (int n = 0; n < 2; ++n) { acc[a][b][m][n] = (f32x4){0.f, 0.f, 0.f, 0.f}; }
    bf16x8 At[4][2], B0[2][2], B1[2][2];
    v8i_t At8[4], B08[2], B18[2];
    const int sclW = 0x79797979, sclX = 0x7f7f7f7f;
    const char* cA = (const char*)g.A + (Sched::GATHER ? (size_t)0 : (size_t)cur.pm * tstep); const char* cB = (const char*)S.bt(g, cur) + (size_t)cur.pn * tstep;
    if constexpr (Sched::GATHER) { PG8_GATHER(cur, 0); __syncthreads(); }
    S.a_ready(cur);
    if constexpr (SP2) {
        PG8_STAGE(PG8_SB(0, 0), cB, voffB); PG8_STAGE(PG8_SB(0, 1), cB + bstep, voffB); PG8_STAGE_A(PG8_SA(0, 0), cA, 0, false); PG8_STAGE_A(PG8_SA(0, 1), cA, 1, false);
        if (wr == 1) PG8_BAR;
        PG8_WAIT_V(2); PG8_BAR;
        PG8_STAGE(PG8_SB(1, 0), cB + kstep, voffB); PG8_STAGE_A(PG8_SA(1, 0), cA + kstep, 0, false); PG8_STAGE(PG8_SB(1, 1), cB + bstep + kstep, voffB);
        PG8_WAIT_V(6); PG8_BAR;
    } else {
        PG8_STAGE(PG8_SB(0, 0), cB, voffB); PG8_STAGE(PG8_SA(0, 0), cA, voffA); PG8_STAGE(PG8_SB(0, 1), cB + bstep, voffB); PG8_STAGE(PG8_SA(0, 1), cA + hstep, voffA);
        if (wr == 1) PG8_BAR;
        PG8_WAIT_V(4); PG8_BAR;
        PG8_STAGE(PG8_SB(1, 0), cB + kstep, voffB); PG8_STAGE(PG8_SA(1, 0), cA + kstep, voffA); PG8_STAGE(PG8_SB(1, 1), cB + bstep + kstep, voffB);
        PG8_WAIT_V(6); PG8_BAR;
    }
    for (;;) {
        const bool has_next = S.next(ui + 1, nxt);
        const char* nA = Sched::GATHER ? cA : (has_next ? (const char*)g.A + (size_t)nxt.pm * tstep : cA); const char* nB = has_next ? (const char*)S.bt(g, nxt) + (size_t)nxt.pn * tstep : cB;
        if constexpr (Sched::GATHER) { if (has_next) PG8_GATHER(nxt, (ui + 1) & 1); else if (tid < 256) gtab[((ui + 1) & 1) * 256 + tid] = gtab[(ui & 1) * 256 + tid]; }
#pragma unroll 1
        for (int t = 0; t < nt; t += 2) {
            const bool last = (t == nt - 2);
            const char* a1 = cA + (size_t)(t + 1) * kstep;
            const char* a2 = last ? nA : cA + (size_t)(t + 2) * kstep; const char* b2 = last ? nB : cB + (size_t)(t + 2) * kstep;
            const char* a3 = a2 + kstep; const char* b3 = b2 + kstep;
            if (last && has_next) S.a_ready(nxt);
            if (last) E.prefetch(pre, cur, wr, wc, fr, fq);
            if constexpr (SP2) {
            PG8_LDB(B0, 0, 0); PG8_LDB(B1, 0, 1); PG8_SCHED; PG8_LDA(At, 0, 0); PG8_STAGE_A(PG8_SA(1, 1), a1, 1, false);
            PG8_WAIT_V(8); PG8_WAIT_L(0); PG8_BAR; PG8_MMA(0, 0, At, B0); PG8_MMA(0, 1, At, B1); PG8_BAR; PG8_SCHED;
            PG8_LDA(At, 0, 1); PG8_STAGE(PG8_SB(0, 0), b2, voffB); PG8_STAGE(PG8_SB(0, 1), b2 + bstep, voffB); PG8_STAGE_A(PG8_SA(0, 0), a2, 0, last);
            PG8_WAIT_V(8); PG8_WAIT_L(0); PG8_BAR; PG8_MMA(1, 0, At, B0); PG8_MMA(1, 1, At, B1); PG8_BAR; PG8_SCHED;
            PG8_LDB(B0, 1, 0); PG8_LDB(B1, 1, 1); PG8_SCHED; PG8_LDA(At, 1, 0); PG8_STAGE_A(PG8_SA(0, 1), a2, 1, last);
            PG8_WAIT_V(8); PG8_WAIT_L(0); PG8_BAR; PG8_MMA(0, 0, At, B0); PG8_MMA(0, 1, At, B1); PG8_BAR; PG8_SCHED;
            PG8_LDA(At, 1, 1); PG8_STAGE(PG8_SB(1, 0), b3, voffB); PG8_STAGE(PG8_SB(1, 1), b3 + bstep, voffB); PG8_STAGE_A(PG8_SA(1, 0), a3, 0, last);
            PG8_WAIT_V(8); PG8_WAIT_L(0); PG8_BAR; PG8_MMA(1, 0, At, B0); PG8_MMA(1, 1, At, B1); PG8_BAR; PG8_SCHED;
            } else {
            PG8_LDB(B0, 0, 0); PG8_SCHED; PG8_LDA(At, 0, 0); PG8_STAGE(PG8_SA(1, 1), a1 + hstep, voffA);
            PG8_WAIT_L(8); PG8_BAR; PG8_WAIT_L(0); PG8_MMA(0, 0, At, B0); PG8_BAR; PG8_SCHED;
            PG8_LDB(B1, 0, 1); PG8_STAGE(PG8_SB(0, 0), b2, voffB);
            PG8_BAR; PG8_WAIT_L(0); PG8_MMA(0, 1, At, B1); PG8_BAR;
            PG8_LDA(At, 0, 1); PG8_STAGE(PG8_SA(0, 0), a2, voffA);
            PG8_BAR; PG8_WAIT_L(0); PG8_MMA(1, 0, At, B0); PG8_BAR; PG8_SCHED;
            PG8_STAGE(PG8_SB(0, 1), b2 + bstep, voffB);
            PG8_WAIT_V(6); PG8_BAR; PG8_MMA(1, 1, At, B1); PG8_BAR;
            PG8_LDB(B0, 1, 0); PG8_SCHED; PG8_LDA(At, 1, 0); PG8_STAGE(PG8_SA(0, 1), a2 + hstep, voffA);
            PG8_WAIT_L(8); PG8_BAR; PG8_WAIT_L(0); PG8_MMA(0, 0, At, B0); PG8_BAR; PG8_SCHED;
            PG8_LDB(B1, 1, 1); PG8_STAGE(PG8_SB(1, 0), b3, voffB);
            PG8_BAR; PG8_WAIT_L(0); PG8_MMA(0, 1, At, B1); PG8_BAR;
            PG8_LDA(At, 1, 1); PG8_STAGE(PG8_SA(1, 0), a3, voffA);
            PG8_BAR; PG8_WAIT_L(0); PG8_MMA(1, 0, At, B0); PG8_BAR; PG8_SCHED;
            PG8_STAGE(PG8_SB(1, 1), b3 + bstep, voffB);
            PG8_WAIT_V(6); PG8_BAR; PG8_MMA(1, 1, At, B1); PG8_BAR;
            }
        }
        if constexpr (ALIGN_EPI) { if (wr == 0) PG8_BAR; }
        if constexpr (F8) asm volatile("s_nop 15\n\ts_nop 15" ::: "memory");
        if constexpr (!Epi::AFTER_DRAIN) { E(acc, cur, wr, wc, fr, fq, pre); S.done(cur); }
        if (!has_next) break;
#pragma unroll
        for (int a = 0; a < 2; ++a)
#pragma unroll
            for (int b = 0; b < 2; ++b)
#pragma unroll
                for (int m = 0; m < 4; ++m)
#pragma unroll
                    for (int n = 0; n < 2; ++n) { acc[a][b][m][n] = (f32x4){0.f, 0.f, 0.f, 0.f}; }
        cur = nxt; cA = nA; cB = nB; ++ui;
        if constexpr (ALIGN_EPI) { if (wr == 1) PG8_BAR; }
    }
    PG8_WAIT_V(0);
    if constexpr (!ALIGN_EPI) { if (wr == 0) PG8_BAR; }
    PG8_BAR;
    if constexpr (Epi::AFTER_DRAIN) { E.fused(acc, cur, wr, wc, fr, fq, lds, wid, lane); S.done(cur); }
#undef PG8_SA
#undef PG8_SB
#undef PG8_STAGE
#undef PG8_STAGE_A
#undef PG8_GATHER
#undef PG8_LDA
#undef PG8_LDB
#undef PG8_MMA
#undef PG8_WAIT_V
#undef PG8_WAIT_L
#undef PG8_BAR
#undef PG8_SCHED
}
}

__device__ __forceinline__ void ph_prologue(const P& p, char* lds, const int part, const int wv) {
    const int tid = ltid(wv);
    float* fl = (float*)lds;
    if (part == 0) {
    for (int it = blockIdx.x; it < 192; it += gridDim.x) {
        const int l = it / 96, cg = it % 96;
        float* sc = fl;
        float* part = fl + 5 * 1024;
        __syncthreads();
        for (int i = tid; i < 5 * 1024; i += NT) {
            const int r = i >> 10, k = i & 1023;
            const float v = r < 4 ? p.c[r * 1024 + k] : p.c_ctx[k];
            sc[i] = v / (1.f + __expf(-v));
        }
        __syncthreads();
        const int kq = tid >> 6, col = tid & 63, j = cg * 64 + col;
        const float* W = p.w_mod + (size_t)l * 1024 * 6144 + j;
        float a0 = 0, a1 = 0, a2 = 0, a3 = 0, a4 = 0;
#pragma unroll 16
        for (int k = kq * 128; k < kq * 128 + 128; ++k) {
            const float w = W[(size_t)k * 6144];
            a0 += sc[k] * w; a1 += sc[1024 + k] * w; a2 += sc[2048 + k] * w; a3 += sc[3072 + k] * w; a4 += sc[4096 + k] * w;
        }
        part[(kq * 5 + 0) * 64 + col] = a0; part[(kq * 5 + 1) * 64 + col] = a1; part[(kq * 5 + 2) * 64 + col] = a2;
        part[(kq * 5 + 3) * 64 + col] = a3; part[(kq * 5 + 4) * 64 + col] = a4;
        __syncthreads();
        if (tid < 5 * 64) {
            const int r = tid >> 6, cc = tid & 63, jj = cg * 64 + cc;
            float v = 0.f;
#pragma unroll
            for (int q = 0; q < 8; ++q) v += part[(q * 5 + r) * 64 + cc];
            p.mod[((size_t)l * 5 + r) * 6144 + jj] = v + p.b_mod[l * 6144 + jj];
        }
    }
    if (blockIdx.x == gridDim.x - 1) {
        const int pos = tid >> 3, f = tid & 7;
        const float inv = powf(10000.0f, -(float)f / 8.0f);
        const float ang = (float)pos * inv;
        p.rope[tid * 2] = cosf(ang); p.rope[tid * 2 + 1] = sinf(ang);
    }
    for (int i = blockIdx.x * NT + tid; i < 2 * 4 * 64 * 64; i += gridDim.x * NT) { const int ii = i & 63, j = (i >> 6) & 63, lg = i >> 12; p.WpT[i] = f2bf(p.w_pool[(size_t)lg * 4096 + ii * 64 + j]); }
    for (int i = blockIdx.x * NT + tid; i < 2 * 4 * 128 * 128; i += gridDim.x * NT) p.WsB[i] = f2bf(p.w_sgu[i]);
    }
    if (part == 1) {
        for (int i = blockIdx.x * NT + tid; i < 2 * 5 * 1024; i += gridDim.x * NT) { const int k = i & 1023, lb = i >> 10, l_ = lb / 5; p.RG[i] = p.g_ffn[l_ * D + k] * (1.f + p.mod[(size_t)lb * 6144 + 4 * 1024 + k]); }
        for (int o = blockIdx.x * 8 + (tid >> 6); o < 2 * 5 * 32; o += gridDim.x * 8) {
            const int e = o & 31, lb = o >> 5, l_ = lb / 5, ln = tid & 63;
            const float* sh = p.mod + (size_t)lb * 6144 + 3 * 1024; const float* wr = p.w_router + (size_t)l_ * D * NE + e;
            float a = 0.f;
            for (int k = ln; k < 1024; k += 64) a += sh[k] * wr[(size_t)k * NE];
            a = wave_sum(a);
            if (ln == 0) p.RB[o] = a + p.b_router[l_ * NE + e];
        }
        const int n_in = 2 * 9 * 16, n_out = 2 * 4 * 16, total = n_in + n_out;
        const int kr = tid >> 6, n4 = tid & 63, kg = tid & 7, nl = tid >> 3;
        for (int it = blockIdx.x; it < total; it += gridDim.x) {
            int i_ = it; const float* W_; bf16_t* Wt_; int N, K;
            if (i_ < n_in) { W_ = p.w_in; Wt_ = p.WinT; N = PW; K = D; } else { i_ -= n_in; W_ = p.w_out; Wt_ = p.WoutT; N = D; K = D; }
            const int ntn = N / 256, per = ntn * (K / 64), m_ = i_ / per, r_ = i_ % per, tn = r_ % ntn, tk = r_ / ntn, n0 = tn * 256;
            const float* src = W_ + (size_t)m_ * K * N + (size_t)(tk * 64) * N + n0; bf16_t* dst = Wt_ + (size_t)m_ * K * N + tk * 64;
            float4 rg[8];
#pragma unroll
            for (int i = 0; i < 8; ++i) rg[i] = *(const float4*)(src + (size_t)(kr + 8 * i) * N + n4 * 4);
            __syncthreads();
#pragma unroll
            for (int i = 0; i < 8; ++i) { float* q = fl + (kr + 8 * i) * 257 + n4 * 4; q[0] = rg[i].x; q[1] = rg[i].y; q[2] = rg[i].z; q[3] = rg[i].w; }
            __syncthreads();
#pragma unroll
            for (int j = 0; j < 4; ++j) {
                const int n = nl + 64 * j;
                const float* q = fl + (8 * kg) * 257 + n;
                u32x4 w;
                w.x = cvtpk(q[0], q[257]); w.y = cvtpk(q[2 * 257], q[3 * 257]); w.z = cvtpk(q[4 * 257], q[5 * 257]); w.w = cvtpk(q[6 * 257], q[7 * 257]);
                *(u32x4*)(dst + (size_t)(n0 + n) * K + 8 * kg) = w;
            }
        }
    }
}

__device__ __forceinline__ void ph_norm1(const P& p, int l, const int wv) {
    const int wave = ltid(wv) >> 6, lane = ltid(wv) & 63;
    for (int row = blockIdx.x * 8 + wave; row < R; row += gridDim.x * 8) {
        const float* xr = row < T ? p.x + (size_t)row * D : p.ctx + (size_t)(row - T) * D;
        float4 v[4]; float ss = 0;
#pragma unroll
        for (int i = 0; i < 4; ++i) { v[i] = *(const float4*)(xr + lane * 4 + 256 * i); ss += v[i].x * v[i].x + v[i].y * v[i].y + v[i].z * v[i].z + v[i].w * v[i].w; }
        ss = wave_sum(ss);
        const float rstd = rsqrtf(ss * (1.f / D) + EPS);
        const float* m = p.mod + ((size_t)l * 5 + mod_row(row)) * 6144;
        const float* g = p.g_mix + l * D;
#pragma unroll
        for (int i = 0; i < 4; ++i) {
            const int k = lane * 4 + 256 * i;
            const float4 gg = *(const float4*)(g + k), sh = *(const float4*)(m + k), sc = *(const float4*)(m + 1024 + k);
            uint2 o;
            o.x = cvtpk(v[i].x * rstd * gg.x * (1.f + sc.x) + sh.x, v[i].y * rstd * gg.y * (1.f + sc.y) + sh.y);
            o.y = cvtpk(v[i].z * rstd * gg.z * (1.f + sc.z) + sh.z, v[i].w * rstd * gg.w * (1.f + sc.w) + sh.w);
            *(uint2*)(p.H + (size_t)row * D + k) = o;
        }
    }
}

constexpr float QSCALE = 0.17677669529663687f * 1.4426950408889634f;
__device__ __forceinline__ void dsoftmax(const f32x16& s, float& m, float& l, f32x16& o0, f32x16& o1, bf16x8& pa, bf16x8& pb) {
    float mx = fmaxf(fmaxf(fmaxf(s[0], s[1]), fmaxf(s[2], s[3])), fmaxf(fmaxf(s[4], s[5]), fmaxf(s[6], s[7])));
    mx = fmaxf(mx, fmaxf(fmaxf(fmaxf(s[8], s[9]), fmaxf(s[10], s[11])), fmaxf(fmaxf(s[12], s[13]), fmaxf(s[14], s[15]))));
    mx = xhalf_max(mx);
    if (__any(mx > m)) {
        const float mn = fmaxf(m, mx), alpha = __builtin_amdgcn_exp2f(m - mn);
        o0 *= alpha; o1 *= alpha; l *= alpha; m = mn;
    }
    float pr[16]; float sum = 0.f;
#pragma unroll
    for (int r = 0; r < 16; ++r) { pr[r] = __builtin_amdgcn_exp2f(s[r] - m); sum += pr[r]; }
    l += sum;
    u32x4 a, b;
    a[0] = cvtpk(pr[0], pr[1]); a[1] = cvtpk(pr[2], pr[3]); a[2] = cvtpk(pr[4], pr[5]); a[3] = cvtpk(pr[6], pr[7]);
    b[0] = cvtpk(pr[8], pr[9]); b[1] = cvtpk(pr[10], pr[11]); b[2] = cvtpk(pr[12], pr[13]); b[3] = cvtpk(pr[14], pr[15]);
    pa = __builtin_bit_cast(bf16x8, a); pb = __builtin_bit_cast(bf16x8, b);
}
#define MX3(a, b, c) __builtin_fmaxf(__builtin_fmaxf((a), (b)), (c))
template <int THR>
__device__ __forceinline__ void dsoftmax2(f32x16& s, float& m, float& l, f32x16& o0, f32x16& o1, bf16x8& pa, bf16x8& pb, const bool first) {
    float a = MX3(s[0], s[1], s[2]), b = MX3(s[3], s[4], s[5]);
    a = MX3(a, s[6], s[7]); b = MX3(b, s[8], s[9]); a = MX3(a, s[10], s[11]); b = MX3(b, s[12], s[13]); a = MX3(a, s[14], s[15]);
    const float mx = xhalf_max(__builtin_fmaxf(a, b));
    if (first || __any(mx > m + (float)THR)) {
        const float mn = first ? mx : __builtin_fmaxf(mx, m), alpha = first ? 1.f : __builtin_amdgcn_exp2f(m - mn);
        m = mn; o0 *= alpha; o1 *= alpha; l *= alpha;
    }
    float sum = 0.f;
#pragma unroll
    for (int r = 0; r < 16; ++r) { s[r] = __builtin_amdgcn_exp2f(s[r] - m); sum += s[r]; }
    l += sum;
    u32x4 wa, wb;
    wa[0] = cvtpk(s[0], s[1]); wa[1] = cvtpk(s[2], s[3]); wa[2] = cvtpk(s[4], s[5]); wa[3] = cvtpk(s[6], s[7]);
    wb[0] = cvtpk(s[8], s[9]); wb[1] = cvtpk(s[10], s[11]); wb[2] = cvtpk(s[12], s[13]); wb[3] = cvtpk(s[14], s[15]);
    pa = __builtin_bit_cast(bf16x8, wa); pb = __builtin_bit_cast(bf16x8, wb);
}
template <int THR>
__device__ __forceinline__ void dsoftmax3(f32x16& s, float& m, f32x16& negm, float& l, f32x16& o0, f32x16& o1, bf16x8& pa, bf16x8& pb, const bool first) {
    float a = MX3(s[0], s[1], s[2]), b = MX3(s[3], s[4], s[5]);
    a = MX3(a, s[6], s[7]); b = MX3(b, s[8], s[9]); a = MX3(a, s[10], s[11]); b = MX3(b, s[12], s[13]); a = MX3(a, s[14], s[15]);
    const float mx = xhalf_max(__builtin_fmaxf(a, b));
    if (first || __any(mx > (float)THR)) {
        const float d = first ? mx : __builtin_fmaxf(mx, 0.f), alpha = first ? 1.f : __builtin_amdgcn_exp2f(-d);
        m += d; o0 *= alpha; o1 *= alpha; l *= alpha;
#pragma unroll
        for (int r = 0; r < 16; ++r) { s[r] -= d; negm[r] = -m; }
    }
    float sum = 0.f;
#pragma unroll
    for (int r = 0; r < 16; ++r) { s[r] = __builtin_amdgcn_exp2f(s[r]); sum += s[r]; }
    l += sum;
    u32x4 wa, wb;
    wa[0] = cvtpk(s[0], s[1]); wa[1] = cvtpk(s[2], s[3]); wa[2] = cvtpk(s[4], s[5]); wa[3] = cvtpk(s[6], s[7]);
    wb[0] = cvtpk(s[8], s[9]); wb[1] = cvtpk(s[10], s[11]); wb[2] = cvtpk(s[12], s[13]); wb[3] = cvtpk(s[14], s[15]);
    pa = __builtin_bit_cast(bf16x8, wa); pb = __builtin_bit_cast(bf16x8, wb);
}
typedef __attribute__((address_space(1))) const float* gcf32_t;
typedef __attribute__((address_space(1))) unsigned char* gu8_t;
typedef __attribute__((address_space(1))) const char* gcc_t;
typedef short v2i16_t __attribute__((ext_vector_type(2)));
struct CvT { gcc_t src; gu8_t dst; int n4; };
struct CvW { gcf32_t gu, dn; gu8_t guT, dnT; int b0, G; };
__device__ __forceinline__ void glds16x2(gcc_t sbase, unsigned voff0, unsigned voff1, unsigned lds_dst) { unsigned keep;
    asm volatile("s_mov_b32 %0, m0\n\ts_mov_b32 m0, %4\n\ts_nop 0\n\tglobal_load_lds_dwordx4 %1, %3\n\ts_add_u32 m0, m0, 0x2000\n\ts_nop 0\n\tglobal_load_lds_dwordx4 %2, %3\n\ts_mov_b32 m0, %0"
                 : "=&s"(keep) : "v"(voff0), "v"(voff1), "s"(sbase), "s"(lds_dst) : "memory", "scc"); }
__device__ __forceinline__ void glds16x4(gcc_t sbase, unsigned voff, unsigned vstride, unsigned lds_dst) { unsigned keep;
    asm volatile("s_mov_b32 %0, m0\n\ts_mov_b32 m0, %4\n\ts_nop 0\n\tglobal_load_lds_dwordx4 %1, %3\n\t"
                 "s_add_u32 m0, m0, 0x400\n\tv_add_u32 %1, %2, %1\n\tglobal_load_lds_dwordx4 %1, %3\n\t"
                 "s_add_u32 m0, m0, 0x400\n\tv_add_u32 %1, %2, %1\n\tglobal_load_lds_dwordx4 %1, %3\n\t"
                 "s_add_u32 m0, m0, 0x400\n\tv_add_u32 %1, %2, %1\n\tglobal_load_lds_dwordx4 %1, %3\n\ts_mov_b32 m0, %0"
                 : "=&s"(keep), "+v"(voff) : "s"(vstride), "s"(sbase), "s"(lds_dst) : "memory", "scc"); }
#if defined(__HIP_DEVICE_COMPILE__)
#define KARG_PTR(T_, member) ({ unsigned long long r_; asm volatile("s_load_dwordx2 %0, %1, %2\n\ts_waitcnt lgkmcnt(0)" : "=s"(r_) : "s"(__builtin_amdgcn_kernarg_segment_ptr()), "n"((int)__builtin_offsetof(P, member)) : "memory"); (T_)r_; })
#else
#define KARG_PTR(T_, member) ((T_)(unsigned long long)p.member)
#endif
__device__ __forceinline__ bool cv_pair(const CvW& w, int q, CvT& c) {
    constexpr int n_gu = NE * 8 * 16, n_dn = NE * 8 * 8;
    const int tile = w.b0 + q * w.G;
    if (tile >= n_gu + n_dn) return false;
    if (tile < n_gu) {
        const int e = tile >> 7, tn = tile & 15, tk = (tile >> 4) & 7, np0 = (tn & 7) * 256 + (tn >> 3) * 128;
        c.n4 = 2048 * 4;
        c.src = (gcc_t)(w.gu + ((size_t)e * 1024 + tk * 128) * 2048 + tn * 128);
        c.dst = w.guT + ((size_t)e * 2048 + np0) * 1024 + tk * 128;
    } else {
        const int i_ = tile - n_gu, e = i_ >> 6, tn = i_ & 7, tk = (i_ >> 3) & 7;
        c.n4 = 1024 * 4;
        c.src = (gcc_t)(w.dn + ((size_t)e * 1024 + tk * 128) * 1024 + tn * 128);
        c.dst = w.dnT + ((size_t)e * 1024 + tn * 128) * 1024 + tk * 128;
    }
    return true;
}
__device__ __forceinline__ void cv_store(gu8_t dst, const char* q0, const unsigned goff) {
    const float* q = (const float*)q0;
    u32x4 w;
#pragma unroll
    for (int d = 0; d < 4; ++d) {
        v2i16_t r = {0, 0};
        r = __builtin_amdgcn_cvt_scalef32_pk_fp8_f32(r, q[(2 * d) * 256], q[(2 * d) * 256 + 128], 0.015625f, false);
        r = __builtin_amdgcn_cvt_scalef32_pk_fp8_f32(r, q[(2 * d + 1) * 256], q[(2 * d + 1) * 256 + 128], 0.015625f, true);
        w[d] = __builtin_bit_cast(unsigned, r);
    }
    *(__attribute__((address_space(1))) u32x4*)(dst + goff) = w;
}
constexpr int CV_LDS = 32768;
__device__ __forceinline__ void ph_dattn(const P& p, int l, int nrows, char* lds, const int wv) {
    const int tid = ltid(wv), lane = tid & 63, wid = wv, r32 = lane & 31, hi = lane >> 5;
    float la = lane < 32 ? p.lam_q1[l * 32 + lane] * p.lam_k1[l * 32 + lane] : 0.f;
    float lb = lane < 32 ? p.lam_q2[l * 32 + lane] * p.lam_k2[l * 32 + lane] : 0.f;
    la = wave_sum(la); lb = wave_sum(lb);
    const float lam_init = 0.8f - 0.6f * expf(-0.3f * (float)l);
    const float lam = expf(la) - expf(lb) + lam_init;
    const bf16_t* PR = p.PROJ;
    const int nunits = (nrows == R) ? 256 + 16 : 256;
    const int vkey = (2 * (wid & 3) + (lane >> 5)) * 8 + ((lane >> 2) & 7), vchunk = (wid >> 2) * 4 + (lane & 3);
    const int vb = ((lane >> 4) & 1) * 32 + (lane & 3) * 8 + (4 * hi + ((lane & 15) >> 2)) * 64;
    const unsigned lds0 = (unsigned)(uintptr_t)lds;
    CvW cw; cw.gu = KARG_PTR(gcf32_t, w_gu) + (size_t)l * NE * 1024 * 2048; cw.guT = KARG_PTR(gu8_t, WguT) + (size_t)l * NE * 2048 * 1024;
    cw.dn = KARG_PTR(gcf32_t, w_down) + (size_t)l * NE * 1024 * 1024; cw.dnT = KARG_PTR(gu8_t, WdnT) + (size_t)l * NE * 1024 * 1024;
    { int b0 = blockIdx.x, G = gridDim.x; asm volatile("" : "+s"(b0), "+s"(G)); cw.b0 = b0; cw.G = G; }
    const unsigned cv_row = 8 * wid + (lane >> 5), cv_sw = (unsigned)(((lane & 31) ^ (((wid >> 1) & 1) << 2)) * 16);
    const int cv_n = 16 * wid + (lane >> 2), cv_kg = lane & 3;
    const int cv_lo = cv_kg * 8192 + (((cv_n >> 2) ^ ((cv_kg & 1) << 2)) * 16) + (cv_n & 3) * 4;
    const unsigned cv_go = (unsigned)(cv_n * 1024 + 16 * cv_kg);
    int cj = 0, cb = 0, ca = 0;
    CvT cp; bool cpok = false;
    gu8_t dstA = nullptr; bool hasA = false;
#define CV_NEXT(hasB_, dstB_) do { \
        if ((cj & 1) == 0) cpok = cv_pair(cw, cj >> 1, cp); else { cp.src += 64 * cp.n4; cp.dst += 64; } \
        hasB_ = cpok; dstB_ = cp.dst; \
        if (cpok) glds16x4(cp.src, cv_row * (unsigned)cp.n4 + cv_sw, 2u * (unsigned)cp.n4, lds0 + CV_LDS + cb * 32768 + wid * 4096); } while (0)
    for (int uu = blockIdx.x; uu < nunits; uu += gridDim.x) {
        int b, h, q0, nt; bool isctx;
        if (uu < 256) { const int u = (uu & 7) * 32 + (uu >> 3); b = u >> 6; h = (u >> 4) & 3; q0 = b * 4096 + (u & 15) * 256; nt = 68; isctx = false; }
        else { const int v = uu - 256; b = v >> 2; h = v & 3; q0 = T + b * 256; nt = 4; isctx = true; }
        const unsigned gKo = (unsigned)(256 + h * 64 + wid * 8 + lane * PW) * 2u;
        const unsigned gVo = (unsigned)(512 + h * 64 + vchunk * 8 + vkey * PW) * 2u;
#define DA_ROW0(t_) ((isctx || (t_) >= 64) ? T + b * 256 + (isctx ? (t_) : (t_) - 64) * 64 : b * 4096 + (t_) * 64)
#define DA_DMA_KV(t_) glds16x2((gcc_t)PR + (size_t)DA_ROW0(t_) * (PW * 2), gKo, gVo, lds0 + ((t_) & 1) * 16384 + wid * 1024)
        __syncthreads();
        DA_DMA_KV(0);
        bf16x8 qf[4];
        {
            const bf16_t* qp = PR + (size_t)(q0 + wid * 32 + r32) * PW + h * 64 + hi * 8;
#pragma unroll
            for (int ks = 0; ks < 4; ++ks) qf[ks] = *(const bf16x8*)(qp + ks * 16);
        }
        f32x16 O00, O01, O10, O11, nm1, zero16;
#pragma unroll
        for (int r = 0; r < 16; ++r) { O00[r] = 0.f; O01[r] = 0.f; O10[r] = 0.f; O11[r] = 0.f; nm1[r] = 0.f; zero16[r] = 0.f; }
        float m1 = 0.f, m2 = 0.f, l1 = 0.f, l2 = 0.f;
        asm volatile("" :: "v"(qf[0]), "v"(qf[1]), "v"(qf[2]), "v"(qf[3]));
        asm volatile("s_waitcnt vmcnt(0)" ::: "memory"); __builtin_amdgcn_s_barrier(); asm volatile("" ::: "memory");
#pragma unroll 1
        for (int t = 0; t < nt; ++t) {
            char* buf = lds + (t & 1) * 16384;
            if (t + 1 < nt) DA_DMA_KV(t + 1);
            bool hasB; gu8_t dstB;
            CV_NEXT(hasB, dstB);
            {
                typedef const __attribute__((address_space(3))) bf16x8* kfp_t;
                const lds_cptr kp = (lds_cptr)buf + hi * 1024 + r32 * 16;
                const lds_cptr vp = (lds_cptr)buf + 8192 + vb;
                bf16x8 kf0 = *(kfp_t)(kp), kf1 = *(kfp_t)(kp + 2048), kf2 = *(kfp_t)(kp + 4096), kf3 = *(kfp_t)(kp + 6144);
#pragma unroll
                for (int kb = 0; kb < 2; ++kb) {
                    f32x16 s1 = __builtin_amdgcn_mfma_f32_32x32x16_bf16(kf0, qf[0], nm1, 0, 0, 0);
                    f32x16 s2 = __builtin_amdgcn_mfma_f32_32x32x16_bf16(kf2, qf[2], zero16, 0, 0, 0);
                    s1 = __builtin_amdgcn_mfma_f32_32x32x16_bf16(kf1, qf[1], s1, 0, 0, 0);
                    s2 = __builtin_amdgcn_mfma_f32_32x32x16_bf16(kf3, qf[3], s2, 0, 0, 0);
                    s16x4 vlo[4], vhi[4];
#pragma unroll
                    for (int i = 0; i < 4; ++i) { vlo[i] = vtr(vp + kb * 2048 + (i >> 1) * 4096 + (i & 1) * 1024); vhi[i] = vtr(vp + kb * 2048 + (i >> 1) * 4096 + (i & 1) * 1024 + 512); }
                    __builtin_amdgcn_sched_barrier(0);
                    const bool first = (t == 0) && (kb == 0);
                    bf16x8 p1a, p1b, p2a, p2b;
                    dsoftmax3<8>(s1, m1, nm1, l1, O00, O01, p1a, p1b, first);
                    dsoftmax2<8>(s2, m2, l2, O10, O11, p2a, p2b, first);
                    if (kb == 0) { kf0 = *(kfp_t)(kp + 512); kf1 = *(kfp_t)(kp + 512 + 2048); kf2 = *(kfp_t)(kp + 512 + 4096); kf3 = *(kfp_t)(kp + 512 + 6144); }
#pragma unroll
                    for (int i = 0; i < 4; ++i) {
                        const bf16x8 va = (bf16x8){vlo[i][0], vlo[i][1], vlo[i][2], vlo[i][3], vhi[i][0], vhi[i][1], vhi[i][2], vhi[i][3]};
                        if (i < 2) { O00 = __builtin_amdgcn_mfma_f32_32x32x16_bf16(va, (i & 1) ? p1b : p1a, O00, 0, 0, 0); O10 = __builtin_amdgcn_mfma_f32_32x32x16_bf16(va, (i & 1) ? p2b : p2a, O10, 0, 0, 0); }
                        else       { O01 = __builtin_amdgcn_mfma_f32_32x32x16_bf16(va, (i & 1) ? p1b : p1a, O01, 0, 0, 0); O11 = __builtin_amdgcn_mfma_f32_32x32x16_bf16(va, (i & 1) ? p2b : p2a, O11, 0, 0, 0); }
                    }
                }
            }
            if (hasB) asm volatile("s_waitcnt vmcnt(4)" ::: "memory"); else asm volatile("s_waitcnt vmcnt(0)" ::: "memory");
            __builtin_amdgcn_s_barrier(); asm volatile("" ::: "memory");
            if (hasA) cv_store(dstA, lds + CV_LDS + ca * 32768 + cv_lo, cv_go);
            dstA = dstB; hasA = hasB; ca = cb;
            if (hasB) { ++cj; cb = cb == 2 ? 0 : cb + 1; }
        }
#undef DA_ROW0
#undef DA_DMA_KV
        l1 = xhalf_sum(l1); l2 = xhalf_sum(l2);
        const float i1 = 1.f / l1, i2 = lam / l2;
        float ss = 0.f;
#pragma unroll
        for (int r = 0; r < 16; ++r) { O00[r] = O00[r] * i1 - O10[r] * i2; O01[r] = O01[r] * i1 - O11[r] * i2; ss += O00[r] * O00[r] + O01[r] * O01[r]; }
        ss = xhalf_sum(ss);
        const float rstd = rsqrtf(ss * (1.f / 64.f) + EPS) * (1.f - lam_init);
        const float* gs = p.g_sub + l * 64;
        bf16_t* op = p.MIX + (size_t)(q0 + wid * 32 + r32) * D + h * 64;
#pragma unroll
        for (int g4 = 0; g4 < 4; ++g4) {
            const int d = 8 * g4 + 4 * hi;
            const float4 ga = *(const float4*)(gs + d), gb = *(const float4*)(gs + 32 + d);
            uint2 wa, wb;
            wa.x = cvtpk(O00[4 * g4] * rstd * ga.x, O00[4 * g4 + 1] * rstd * ga.y); wa.y = cvtpk(O00[4 * g4 + 2] * rstd * ga.z, O00[4 * g4 + 3] * rstd * ga.w);
            wb.x = cvtpk(O01[4 * g4] * rstd * gb.x, O01[4 * g4 + 1] * rstd * gb.y); wb.y = cvtpk(O01[4 * g4 + 2] * rstd * gb.z, O01[4 * g4 + 3] * rstd * gb.w);
            *(uint2*)(op + d) = wa; *(uint2*)(op + 32 + d) = wb;
        }
    }
    while (hasA) {
        asm volatile("s_waitcnt vmcnt(0)" ::: "memory");
        __syncthreads();
        cv_store(dstA, lds + CV_LDS + ca * 32768 + cv_lo, cv_go);
        bool hasB; gu8_t dstB;
        CV_NEXT(hasB, dstB);
        dstA = dstB; hasA = hasB; ca = cb;
        if (hasB) { ++cj; cb = cb == 2 ? 0 : cb + 1; }
    }
#undef CV_NEXT
}

__device__ __forceinline__ void ph_na(const P& p, int l, int nrows, char* lds, const int wv) {
    const int tid = ltid(wv), lane = tid & 63, wid = wv, r32 = lane & 31, hi = lane >> 5;
    const bf16_t* PR = p.PROJ;
    const int nunits = (nrows == R) ? 256 + 16 : 256;
    const int vkey = (2 * (wid & 3) + (lane >> 5)) * 8 + ((lane >> 2) & 7), vchunk = (wid >> 2) * 4 + (lane & 3);
    const int vb = ((lane >> 4) & 1) * 32 + (lane & 3) * 8 + (4 * hi + ((lane & 15) >> 2)) * 64;
    const unsigned lds0 = (unsigned)(uintptr_t)lds;
    float* btab = (float*)(lds + 49152);
    constexpr float LOG2E = 1.4426950408889634f;
    float pen[2][16];
    {
        const int cq_ = (wid & 1) * 32 + r32, wsc_ = min(max(cq_ - 8, 0), 48);
#pragma unroll
        for (int kb = 0; kb < 2; ++kb)
#pragma unroll
            for (int r = 0; r < 16; ++r) { const int kc = 32 * kb + (r & 3) + 8 * (r >> 2) + 4 * hi; pen[kb][r] = ((unsigned)(kc - wsc_) < 16u) ? 0.f : -INFINITY; }
    }
    for (int uu = (blockIdx.x + gridDim.x - 16) % gridDim.x; uu < nunits; uu += gridDim.x) {
        int b, h, q0, kr_lo, nlat, rs = 0, rq = 0; bool isctx;
        if (uu < 256) {
            const int u = (uu & 7) * 32 + (uu >> 3); b = u >> 6; h = (u >> 4) & 3; const int rg = u & 15;
            rq = 4 * rg + (wid >> 1); q0 = b * 4096 + rq * 64 + (wid & 1) * 32;
            kr_lo = min(max(4 * rg - 4, 0), 56); const int kr_hi = min(max(4 * rg - 1, 0), 56) + 7; nlat = kr_hi - kr_lo + 1;
            rs = min(max(rq - 4, 0), 56); isctx = false;
        } else { const int v = uu - 256; b = v >> 2; h = v & 3; q0 = T + b * 256 + wid * 32; kr_lo = 0; nlat = 0; isctx = true; }
        const int nt = nlat + 4;
        const int cq = (wid & 1) * 32 + r32;
        const unsigned gKo = (unsigned)(1792 + h * 64 + wid * 8 + lane * PW) * 2u;
        const unsigned gVo = (unsigned)(2048 + h * 64 + vchunk * 8 + vkey * PW) * 2u;
#define NA_ROW0(t_) ((t_) < nlat ? b * 4096 + (kr_lo + (t_)) * 64 : T + b * 256 + ((t_) - nlat) * 64)
#define NA_DMA_KV(t_, slot_) glds16x2((gcc_t)PR + (size_t)NA_ROW0(t_) * (PW * 2), gKo, gVo, lds0 + (slot_) * 16384 + wid * 1024)
        __syncthreads();
        NA_DMA_KV(0, 0); NA_DMA_KV(1, 1);
        bf16x8 qf[4];
        {
            const bf16_t* qp = PR + (size_t)(q0 + r32) * PW + 1536 + h * 64 + hi * 8;
#pragma unroll
            for (int ks = 0; ks < 4; ++ks) qf[ks] = *(const bf16x8*)(qp + ks * 16);
        }
        f32x16 O0, O1;
#pragma unroll
        for (int r = 0; r < 16; ++r) { O0[r] = 0.f; O1[r] = 0.f; }
        float m1 = -1e30f, l1 = 0.f;
        for (int i = tid; i < 15 * 128; i += NT) { const int j = (i & 127) - 48; btab[i] = (j >= 0 && j < 31) ? p.rpb[((size_t)l * 4 + h) * 465 + (i >> 7) * 31 + j] * LOG2E : 0.f; }
        asm volatile("" :: "v"(qf[0]), "v"(qf[1]), "v"(qf[2]), "v"(qf[3]));
        asm volatile("s_waitcnt vmcnt(0)" ::: "memory");
        __syncthreads();
        int ks = 0;
#pragma unroll 1
        for (int t = 0; t < nt; ++t) {
            char* buf = lds + ks * 16384;
            const bool kvB = t + 2 < nt;
            if (kvB) NA_DMA_KV(t + 2, ks == 0 ? 2 : ks - 1);
            const bool lat = t < nlat;
            const int krow = kr_lo + t;
            const bool active = !lat || (krow >= rs && krow <= rs + 7);
            if (active) {
                const float* brow = btab + (krow - rq + 7) * 128 + 48 + 15 - cq + 4 * hi;
#pragma unroll
                for (int kb = 0; kb < 2; ++kb) {
                    const lds_cptr kp = (lds_cptr)buf + hi * 1024 + (kb * 32 + r32) * 16;
                    f32x16 s1;
#pragma unroll
                    for (int r = 0; r < 16; ++r) s1[r] = 0.f;
#pragma unroll
                    for (int ks2 = 0; ks2 < 4; ++ks2) {
                        const bf16x8 kf = *(const __attribute__((address_space(3))) bf16x8*)(kp + ks2 * 2048);
                        s1 = __builtin_amdgcn_mfma_f32_32x32x16_bf16(kf, qf[ks2], s1, 0, 0, 0);
                    }
                    if (lat) {
#pragma unroll
                        for (int r = 0; r < 16; ++r) s1[r] = (s1[r] + brow[32 * kb + (r & 3) + 8 * (r >> 2)]) + pen[kb][r];
                    }
                    bf16x8 pa, pb;
                    dsoftmax2<8>(s1, m1, l1, O0, O1, pa, pb, false);
                    const lds_cptr vp = (lds_cptr)buf + 8192 + vb + kb * 2048;
#pragma unroll
                    for (int ss = 0; ss < 2; ++ss) {
                        const s16x4 lo0 = vtr(vp + ss * 1024), hh0 = vtr(vp + ss * 1024 + 512);
                        const s16x4 lo1 = vtr(vp + 4096 + ss * 1024), hh1 = vtr(vp + 4096 + ss * 1024 + 512);
                        const bf16x8 va0 = (bf16x8){lo0[0], lo0[1], lo0[2], lo0[3], hh0[0], hh0[1], hh0[2], hh0[3]};
                        const bf16x8 va1 = (bf16x8){lo1[0], lo1[1], lo1[2], lo1[3], hh1[0], hh1[1], hh1[2], hh1[3]};
                        O0 = __builtin_amdgcn_mfma_f32_32x32x16_bf16(va0, ss ? pb : pa, O0, 0, 0, 0);
                        O1 = __builtin_amdgcn_mfma_f32_32x32x16_bf16(va1, ss ? pb : pa, O1, 0, 0, 0);
                    }
                }
            }
            if (kvB) asm volatile("s_waitcnt vmcnt(2)" ::: "memory"); else asm volatile("s_waitcnt vmcnt(0)" ::: "memory");
            __builtin_amdgcn_s_barrier(); asm volatile("" ::: "memory");
            ks = ks == 2 ? 0 : ks + 1;
        }
#undef NA_ROW0
#undef NA_DMA_KV
        l1 = xhalf_sum(l1);
        const float il = 1.f / l1;
        bf16_t* op = p.MIX + (size_t)(q0 + r32) * D + 768 + h * 64;
#pragma unroll
        for (int g4 = 0; g4 < 4; ++g4) {
            const int d = 8 * g4 + 4 * hi;
            uint2 wa, wb;
            wa.x = cvtpk(O0[4 * g4] * il, O0[4 * g4 + 1] * il); wa.y = cvtpk(O0[4 * g4 + 2] * il, O0[4 * g4 + 3] * il);
            wb.x = cvtpk(O1[4 * g4] * il, O1[4 * g4 + 1] * il); wb.y = cvtpk(O1[4 * g4 + 2] * il, O1[4 * g4 + 3] * il);
            *(uint2*)(op + d) = wa; *(uint2*)(op + 32 + d) = wb;
        }
    }
}

__device__ __forceinline__ void ph_pool(const P& p, int l, int nrows, char* lds, const int wv) {
    const int tid = ltid(wv), lane = tid & 63, wid = tid >> 6, fr = lane & 15, fq = lane >> 4;
    float* ysh = (float*)lds;
    bf16_t* dsh = (bf16_t*)(lds + 80 * 256 * 4);
    const bf16_t* PR = p.PROJ;
    for (int it = (blockIdx.x + gridDim.x - 32) % gridDim.x; it < nrows / 64; it += gridDim.x) {
        const int row0 = it * 64;
        const int L = row0 < T ? 4096 : 256;
        const int t0 = row0 < T ? (row0 & 4095) : ((row0 - T) & 255);
        const int base = row0 - t0;
        __syncthreads();
        for (int c = tid; c < 80 * 32; c += NT) {
            const int rr = c >> 5, ch = (c & 31) * 8, t = t0 - 8 + rr;
            float4 a = make_float4(0.f, 0.f, 0.f, 0.f), b = a;
            if (t >= 0 && t < L) {
                const uint4 raw = *(const uint4*)(PR + (size_t)(base + t) * PW + 768 + ch);
                a = make_float4(__uint_as_float(raw.x << 16), __uint_as_float(raw.x & 0xffff0000u), __uint_as_float(raw.y << 16), __uint_as_float(raw.y & 0xffff0000u));
                b = make_float4(__uint_as_float(raw.z << 16), __uint_as_float(raw.z & 0xffff0000u), __uint_as_float(raw.w << 16), __uint_as_float(raw.w & 0xffff0000u));
            }
            *(float4*)(ysh + rr * 256 + ch) = a; *(float4*)(ysh + rr * 256 + ch + 4) = b;
        }
        __syncthreads();
        {
            const int r = tid >> 3, cg = tid & 7;
            const int g = cg >> 1, w = 2 << g, t = t0 + r;
            const int lo = max(t - w / 2, 0), hi = min(t + w / 2 - 1, L - 1);
            const float inv = 1.f / (float)(hi - lo + 1);
#pragma unroll
            for (int q = 0; q < 8; ++q) {
                const int ch = cg * 32 + q * 4;
                float4 s = make_float4(0.f, 0.f, 0.f, 0.f);
                for (int tt = lo; tt <= hi; ++tt) { const float4 v = *(const float4*)(ysh + (tt - t0 + 8) * 256 + ch); s.x += v.x; s.y += v.y; s.z += v.z; s.w += v.w; }
                const float4 y = *(const float4*)(ysh + (r + 8) * 256 + ch);
                uint2 o; o.x = cvtpk(s.x * inv - y.x, s.y * inv - y.y); o.y = cvtpk(s.z * inv - y.z, s.w * inv - y.w);
                *(uint2*)(dsh + r * 264 + ch) = o;
            }
        }
        __syncthreads();
        {
            const int g = wid >> 1, mb = (wid & 1) * 2;
            const bf16_t* W = p.WpT + ((size_t)l * 4 + g) * 64 * 64;
            f32x4 acc[2][4];
#pragma unroll
            for (int mt = 0; mt < 2; ++mt)
#pragma unroll
                for (int nt = 0; nt < 4; ++nt) acc[mt][nt] = (f32x4){0.f, 0.f, 0.f, 0.f};
#pragma unroll
            for (int ks = 0; ks < 2; ++ks) {
                bf16x8 af[2], bfr[4];
#pragma unroll
                for (int mt = 0; mt < 2; ++mt) af[mt] = *(const bf16x8*)(dsh + ((mb + mt) * 16 + fr) * 264 + g * 64 + ks * 32 + fq * 8);
#pragma unroll
                for (int nt = 0; nt < 4; ++nt) bfr[nt] = *(const bf16x8*)(W + (nt * 16 + fr) * 64 + ks * 32 + fq * 8);
#pragma unroll
                for (int mt = 0; mt < 2; ++mt)
#pragma unroll
                    for (int nt = 0; nt < 4; ++nt) acc[mt][nt] = __builtin_amdgcn_mfma_f32_16x16x32_bf16(bfr[nt], af[mt], acc[mt][nt], 0, 0, 0);
            }
#pragma unroll
            for (int mt = 0; mt < 2; ++mt)
#pragma unroll
                for (int nt = 0; nt < 4; ++nt) {
                    const int row = row0 + (mb + mt) * 16 + fr, j = g * 64 + nt * 16 + fq * 4;
                    const float4 sp = *(const float4*)(p.s_pool + l * 256 + j);
                    uint2 o; o.x = cvtpk(acc[mt][nt][0] * sp.x, acc[mt][nt][1] * sp.y); o.y = cvtpk(acc[mt][nt][2] * sp.z, acc[mt][nt][3] * sp.w);
                    *(uint2*)(p.MIX + (size_t)row * D + 256 + j) = o;
                }
        }
    }
}

__device__ __forceinline__ float gelu_fast(float x) {
    const float u = 0.7978845608028654f * (x + 0.044715f * x * x * x);
    return x / (1.f + __builtin_amdgcn_exp2f(-2.885390081777927f * u));
}
__device__ __forceinline__ void ph_sgu(const P& p, int l, int nrows, char* lds, const int wv) {
    const int tid = ltid(wv), lane = tid & 63, wid = tid >> 6, fr = lane & 15, fq = lane >> 4;
    bf16_t* vnT = (bf16_t*)lds;
    float* rstd = (float*)(lds + 128 * 136 * 2);
    const bf16_t* PR = p.PROJ;
    for (int it = (blockIdx.x + gridDim.x - 48) % gridDim.x; it < (nrows / 128) * 2; it += gridDim.x) {
        const int chunk = it >> 1, hp = it & 1, row0 = chunk * 128;
        __syncthreads();
        {
            const int t = tid >> 2, qtr = tid & 3;
            const bf16_t* zp = PR + (size_t)(row0 + t) * PW + 1280 + qtr * 64;
            float ss = 0.f;
#pragma unroll
            for (int i = 0; i < 8; ++i) {
                const uint4 raw = *(const uint4*)(zp + i * 8);
                const unsigned w4[4] = {raw.x, raw.y, raw.z, raw.w};
#pragma unroll
                for (int j = 0; j < 4; ++j) { const float a = __uint_as_float(w4[j] << 16), b = __uint_as_float(w4[j] & 0xffff0000u); ss += a * a + b * b; }
            }
            ss += __shfl_xor(ss, 1); ss += __shfl_xor(ss, 2);
            if (qtr == 0) rstd[t] = rsqrtf(ss * (1.f / 256.f) + EPS);
        }
        __syncthreads();
        {
            const int s = tid >> 2, cb = (tid & 3) * 32;
            const bf16_t* zp = PR + (size_t)(row0 + s) * PW + 1280 + hp * 128 + cb;
            const float rs = rstd[s];
            const float* gg = p.g_sgu + l * 256 + hp * 128 + cb;
#pragma unroll
            for (int i = 0; i < 4; ++i) {
                const uint4 raw = *(const uint4*)(zp + i * 8);
                const unsigned w4[4] = {raw.x, raw.y, raw.z, raw.w};
#pragma unroll
                for (int j = 0; j < 4; ++j) {
                    const int c = cb + i * 8 + j * 2;
                    vnT[c * 136 + s] = f2bf(__uint_as_float(w4[j] << 16) * rs * gg[i * 8 + j * 2]);
                    vnT[(c + 1) * 136 + s] = f2bf(__uint_as_float(w4[j] & 0xffff0000u) * rs * gg[i * 8 + j * 2 + 1]);
                }
            }
        }
        __syncthreads();
        {
            const int hl = wid >> 2, g = hp * 2 + hl, mb = (wid & 3) * 2;
            const bf16_t* Wg = p.WsB + ((size_t)l * 4 + g) * 128 * 128;
            f32x4 acc[2][4];
#pragma unroll
            for (int mt = 0; mt < 2; ++mt)
#pragma unroll
                for (int nt = 0; nt < 4; ++nt) acc[mt][nt] = (f32x4){0.f, 0.f, 0.f, 0.f};
#pragma unroll
            for (int ks = 0; ks < 4; ++ks) {
                bf16x8 af[2], bfr[4];
#pragma unroll
                for (int mt = 0; mt < 2; ++mt) af[mt] = *(const bf16x8*)(Wg + ((mb + mt) * 16 + fr) * 128 + ks * 32 + fq * 8);
#pragma unroll
                for (int nt = 0; nt < 4; ++nt) bfr[nt] = *(const bf16x8*)(vnT + (hl * 64 + nt * 16 + fr) * 136 + ks * 32 + fq * 8);
#pragma unroll
                for (int mt = 0; mt < 2; ++mt)
#pragma unroll
                    for (int nt = 0; nt < 4; ++nt) acc[mt][nt] = __builtin_amdgcn_mfma_f32_16x16x32_bf16(bfr[nt], af[mt], acc[mt][nt], 0, 0, 0);
            }
#pragma unroll
            for (int mt = 0; mt < 2; ++mt) {
                const int t = (mb + mt) * 16 + fr;
                const float bias = p.b_sgu[(l * 4 + g) * 128 + t];
#pragma unroll
                for (int nt = 0; nt < 4; ++nt) {
                    const int c = g * 64 + nt * 16 + fq * 4;
                    const uint2 ur = *(const uint2*)(PR + (size_t)(row0 + t) * PW + 1024 + c);
                    const float u0 = __uint_as_float(ur.x << 16), u1 = __uint_as_float(ur.x & 0xffff0000u);
                    const float u2 = __uint_as_float(ur.y << 16), u3 = __uint_as_float(ur.y & 0xffff0000u);
                    uint2 o; o.x = cvtpk(u0 * (acc[mt][nt][0] + bias), u1 * (acc[mt][nt][1] + bias)); o.y = cvtpk(u2 * (acc[mt][nt][2] + bias), u3 * (acc[mt][nt][3] + bias));
                    *(uint2*)(p.MIX + (size_t)(row0 + t) * D + 512 + c) = o;
                }
            }
        }
    }
}

__device__ __forceinline__ void ph_router(const P& p, int l, int nrows, char* lds, const int wv) {
    const int tid = ltid(wv), wave = wv, lane = tid & 63;
    float* wt = (float*)lds;
    float* tsc = (float*)(lds + 32 * 1028 * 4) + wave * (16 * 33);
    int* lcnt = (int*)(lds + 32 * 1028 * 4 + 8 * 16 * 33 * 4);
    __syncthreads();
    {
        const float* wr = p.w_router + (size_t)l * D * NE;
        float4 t[16];
#pragma unroll
        for (int i = 0; i < 16; ++i) t[i] = *(const float4*)(wr + (size_t)(tid + NT * i) * 4);
#pragma unroll
        for (int i = 0; i < 16; ++i) { const int idx = (tid + NT * i) * 4, k = idx >> 5, e = idx & 31; float* q = wt + e * 1028 + k; q[0] = t[i].x; q[1028] = t[i].y; q[2 * 1028] = t[i].z; q[3 * 1028] = t[i].w; }
        if (tid < 32) lcnt[tid] = 0;
    }
    __syncthreads();
    for (int i = blockIdx.x * NT + tid; i < NSLOT; i += gridDim.x * NT) p.slot_tok[i] = 0;
    const int i16 = lane & 15, kk = lane >> 4;
    const float* w0 = wt + i16 * 1028 + 8 * kk;
    for (int g = (wave & 3) * (int)gridDim.x + (int)blockIdx.x; g < nrows / 16; g += 4 * (int)gridDim.x) {
        const int row0 = g * 16, mb = mod_row(row0);
        const bf16_t* xr = p.X + (size_t)(row0 + i16) * D + 8 * kk;
        const float* Gt = p.RG + ((size_t)l * 5 + mb) * 1024 + 8 * kk;
        if (wave >= 4) {
            float ss = 0.f;
#pragma unroll 1
            for (int c0 = 0; c0 < 32; c0 += 16) {
                uint4 raw[16];
#pragma unroll
                for (int c = 0; c < 16; ++c) raw[c] = *(const uint4*)(xr + 32 * (c0 + c));
#pragma unroll
                for (int c = 0; c < 16; ++c) {
                    const float x0 = __uint_as_float(raw[c].x << 16), x1 = __uint_as_float(raw[c].x & 0xffff0000u), x2 = __uint_as_float(raw[c].y << 16), x3 = __uint_as_float(raw[c].y & 0xffff0000u);
                    const float x4 = __uint_as_float(raw[c].z << 16), x5 = __uint_as_float(raw[c].z & 0xffff0000u), x6 = __uint_as_float(raw[c].w << 16), x7 = __uint_as_float(raw[c].w & 0xffff0000u);
                    ss += x0 * x0 + x1 * x1 + x2 * x2 + x3 * x3 + x4 * x4 + x5 * x5 + x6 * x6 + x7 * x7;
                }
            }
            ss += __shfl_xor(ss, 16); ss += __shfl_xor(ss, 32);
            const float rstd = rsqrtf(ss * (1.f / D) + EPS);
            const float* St = p.mod + ((size_t)l * 5 + mb) * 6144 + 3 * 1024 + 8 * kk;
            unsigned char* hr = p.HS + (size_t)(row0 + i16) * D + 8 * kk;
#pragma unroll 1
            for (int c0 = 0; c0 < 32; c0 += 8) {
#pragma unroll
                for (int c1 = 0; c1 < 8; ++c1) {
                    const int c = c0 + c1;
                    const uint4 raw = *(const uint4*)(xr + 32 * c);
                    const float4 ga = *(const float4*)(Gt + 32 * c), gb = *(const float4*)(Gt + 32 * c + 4), sa = *(const float4*)(St + 32 * c), sb = *(const float4*)(St + 32 * c + 4);
                    const float h0 = __uint_as_float(raw.x << 16) * rstd * ga.x + sa.x, h1 = __uint_as_float(raw.x & 0xffff0000u) * rstd * ga.y + sa.y;
                    const float h2 = __uint_as_float(raw.y << 16) * rstd * ga.z + sa.z, h3 = __uint_as_float(raw.y & 0xffff0000u) * rstd * ga.w + sa.w;
                    const float h4 = __uint_as_float(raw.z << 16) * rstd * gb.x + sb.x, h5 = __uint_as_float(raw.z & 0xffff0000u) * rstd * gb.y + sb.y;
                    const float h6 = __uint_as_float(raw.w << 16) * rstd * gb.z + sb.z, h7 = __uint_as_float(raw.w & 0xffff0000u) * rstd * gb.w + sb.w;
                    uint2 o;
                    o.x = __builtin_amdgcn_cvt_pk_fp8_f32(h2, h3, __builtin_amdgcn_cvt_pk_fp8_f32(h0, h1, 0u, false), true);
                    o.y = __builtin_amdgcn_cvt_pk_fp8_f32(h6, h7, __builtin_amdgcn_cvt_pk_fp8_f32(h4, h5, 0u, false), true);
                    *(uint2*)(hr + 32 * c) = o;
                }
            }
            continue;
        }
        f32x4 d0 = {0.f, 0.f, 0.f, 0.f}, d1 = d0; float ss = 0.f;
        uint4 rawA[8], rawB[8];
#pragma unroll
        for (int j = 0; j < 8; ++j) rawA[j] = *(const uint4*)(xr + 32 * j);
#define RT_CHUNK(RAW, c_) do { \
            const float4 ga_ = *(const float4*)(Gt + 32 * (c_)), gb_ = *(const float4*)(Gt + 32 * (c_) + 4); \
            const f32x4 ba0_ = *(const f32x4*)(w0 + 32 * (c_)), ba1_ = *(const f32x4*)(w0 + 32 * (c_) + 4), bb0_ = *(const f32x4*)(w0 + 16 * 1028 + 32 * (c_)), bb1_ = *(const f32x4*)(w0 + 16 * 1028 + 32 * (c_) + 4); \
            const float x0_ = __uint_as_float(RAW.x << 16), x1_ = __uint_as_float(RAW.x & 0xffff0000u), x2_ = __uint_as_float(RAW.y << 16), x3_ = __uint_as_float(RAW.y & 0xffff0000u); \
            const float x4_ = __uint_as_float(RAW.z << 16), x5_ = __uint_as_float(RAW.z & 0xffff0000u), x6_ = __uint_as_float(RAW.w << 16), x7_ = __uint_as_float(RAW.w & 0xffff0000u); \
            ss += x0_ * x0_ + x1_ * x1_ + x2_ * x2_ + x3_ * x3_ + x4_ * x4_ + x5_ * x5_ + x6_ * x6_ + x7_ * x7_; \
            d0 = __builtin_amdgcn_mfma_f32_16x16x4f32(x0_ * ga_.x, ba0_[0], d0, 0, 0, 0); d1 = __builtin_amdgcn_mfma_f32_16x16x4f32(x0_ * ga_.x, bb0_[0], d1, 0, 0, 0); \
            d0 = __builtin_amdgcn_mfma_f32_16x16x4f32(x1_ * ga_.y, ba0_[1], d0, 0, 0, 0); d1 = __builtin_amdgcn_mfma_f32_16x16x4f32(x1_ * ga_.y, bb0_[1], d1, 0, 0, 0); \
            d0 = __builtin_amdgcn_mfma_f32_16x16x4f32(x2_ * ga_.z, ba0_[2], d0, 0, 0, 0); d1 = __builtin_amdgcn_mfma_f32_16x16x4f32(x2_ * ga_.z, bb0_[2], d1, 0, 0, 0); \
            d0 = __builtin_amdgcn_mfma_f32_16x16x4f32(x3_ * ga_.w, ba0_[3], d0, 0, 0, 0); d1 = __builtin_amdgcn_mfma_f32_16x16x4f32(x3_ * ga_.w, bb0_[3], d1, 0, 0, 0); \
            d0 = __builtin_amdgcn_mfma_f32_16x16x4f32(x4_ * gb_.x, ba1_[0], d0, 0, 0, 0); d1 = __builtin_amdgcn_mfma_f32_16x16x4f32(x4_ * gb_.x, bb1_[0], d1, 0, 0, 0); \
            d0 = __builtin_amdgcn_mfma_f32_16x16x4f32(x5_ * gb_.y, ba1_[1], d0, 0, 0, 0); d1 = __builtin_amdgcn_mfma_f32_16x16x4f32(x5_ * gb_.y, bb1_[1], d1, 0, 0, 0); \
            d0 = __builtin_amdgcn_mfma_f32_16x16x4f32(x6_ * gb_.z, ba1_[2], d0, 0, 0, 0); d1 = __builtin_amdgcn_mfma_f32_16x16x4f32(x6_ * gb_.z, bb1_[2], d1, 0, 0, 0); \
            d0 = __builtin_amdgcn_mfma_f32_16x16x4f32(x7_ * gb_.w, ba1_[3], d0, 0, 0, 0); d1 = __builtin_amdgcn_mfma_f32_16x16x4f32(x7_ * gb_.w, bb1_[3], d1, 0, 0, 0); } while (0)
#pragma unroll 1
        for (int cc = 0; cc < 4; cc += 2) {
#pragma unroll
            for (int j = 0; j < 8; ++j) rawB[j] = *(const uint4*)(xr + 32 * (8 * cc + 8 + j));
#pragma unroll
            for (int j = 0; j < 8; ++j) RT_CHUNK(rawA[j], 8 * cc + j);
            if (cc + 2 < 4) {
#pragma unroll
                for (int j = 0; j < 8; ++j) rawA[j] = *(const uint4*)(xr + 32 * (8 * cc + 16 + j));
            }
#pragma unroll
            for (int j = 0; j < 8; ++j) RT_CHUNK(rawB[j], 8 * cc + 8 + j);
        }
#undef RT_CHUNK
        ss += __shfl_xor(ss, 16); ss += __shfl_xor(ss, 32);
        const float rstd = rsqrtf(ss * (1.f / D) + EPS);
#pragma unroll
        for (int j = 0; j < 4; ++j) { tsc[(4 * kk + j) * 33 + i16] = d0[j]; tsc[(4 * kk + j) * 33 + 16 + i16] = d1[j]; }
        __builtin_amdgcn_s_waitcnt(0xc07f);
        if (lane < 16) {
            const float* rb = p.RB + ((size_t)l * 5 + mb) * 32;
            float lg[32];
#pragma unroll
            for (int e = 0; e < 32; ++e) lg[e] = tsc[lane * 33 + e] * rstd + rb[e];
            unsigned taken = 0u; float tv[4]; int ti[4];
#pragma unroll
            for (int k = 0; k < 4; ++k) {
                float best = -3.0e38f; int bi = 0;
#pragma unroll
                for (int e = 0; e < 32; ++e) { const bool ok = !((taken >> e) & 1u) && (lg[e] > best); best = ok ? lg[e] : best; bi = ok ? e : bi; }
                taken |= 1u << bi; tv[k] = best; ti[k] = bi;
            }
            const float e1 = __expf(tv[1] - tv[0]), e2 = __expf(tv[2] - tv[0]), e3 = __expf(tv[3] - tv[0]);
            const float inv = 1.f / (1.f + e1 + e2 + e3);
            const int row = row0 + lane;
            *(int4*)(p.topi + (size_t)row * 4) = make_int4(ti[0], ti[1], ti[2], ti[3]);
            *(float4*)(p.topg + (size_t)row * 4) = make_float4(inv, e1 * inv, e2 * inv, e3 * inv);
            atomicAdd(&lcnt[ti[0]], 1); atomicAdd(&lcnt[ti[1]], 1); atomicAdd(&lcnt[ti[2]], 1); atomicAdd(&lcnt[ti[3]], 1);
        }
    }
    __syncthreads();
    if (tid < 32 && lcnt[tid]) atomicAdd(&p.cnt[l * 64 + tid], lcnt[tid]);
}
__device__ __forceinline__ void ph_assign(const P& p, int l, int nrows, char* lds, const int wv) {
    int* lcnt = (int*)lds; int* lbase = lcnt + 32; int* pst = lbase + 32;
    const int tid = ltid(wv), wave = tid >> 6, lane = tid & 63;
    int* cnt = p.cnt + l * 64; int* cursor = cnt + 32;
    int* meta = p.moe_meta + l * 512;
    __syncthreads();
    if (tid == 0) { int a = 0; for (int e = 0; e < 32; ++e) { pst[e] = a; a += (cnt[e] + 255) & ~255; } if (blockIdx.x == 0) meta[0] = a >> 8; }
    __syncthreads();
    if (blockIdx.x == 0 && tid < 320) { int e = 0; for (int k = 1; k < 32; ++k) if (tid * 256 >= pst[k]) e = k; meta[1 + tid] = e; }
    const int blk0 = (blockIdx.x + gridDim.x - 64) % gridDim.x;
    for (int it = blk0; it < nrows / 64; it += gridDim.x) {
        __syncthreads();
        if (tid < 32) lcnt[tid] = 0;
        __syncthreads();
        if (wave == 0) {
            const int row = it * 64 + lane;
            const int4 ti = *(const int4*)(p.topi + (size_t)row * 4);
            const int r0 = atomicAdd(&lcnt[ti.x], 1), r1 = atomicAdd(&lcnt[ti.y], 1), r2 = atomicAdd(&lcnt[ti.z], 1), r3 = atomicAdd(&lcnt[ti.w], 1);
            __builtin_amdgcn_s_waitcnt(0xc07f);
            if (lane < 32) lbase[lane] = pst[lane] + (lcnt[lane] ? atomicAdd(&cursor[lane], lcnt[lane]) : 0);
            __builtin_amdgcn_s_waitcnt(0xc07f);
            const int4 sl = make_int4(lbase[ti.x] + r0, lbase[ti.y] + r1, lbase[ti.z] + r2, lbase[ti.w] + r3);
            *(int4*)(p.tok_slot + (size_t)row * 4) = sl;
            p.slot_tok[sl.x] = row; p.slot_tok[sl.y] = row; p.slot_tok[sl.z] = row; p.slot_tok[sl.w] = row;
        }
    }
}

struct EpiProj {
    static constexpr bool PERM = true, AFTER_DRAIN = false, WIDE = false;
    struct Pre {}; __device__ __forceinline__ void prefetch(Pre&, const pg8::Unit&, int, int, int, int) const {}
    bf16_t* O; const float* rope;
    __device__ __forceinline__ void operator()(const f32x4 (&acc)[2][2][4][2], const pg8::Unit& u, int wr, int wc, int fr, int fq, const Pre& pre) const {
        const int row0 = u.pm * 256 + wr * 64 + fr, col0 = u.pn * 256 + wc * 32 + 8 * fq;
        const bool do_rope = (u.pn < 2) && (u.pm < T / 256), do_gelu = (u.pn == 4) || (u.pn == 5);
        const float sc = u.pn == 0 ? QSCALE : (u.pn == 6 ? 0.125f * 1.4426950408889634f : 1.f);
        const float sgn = (fq & 1) ? 1.f : -1.f;
#pragma unroll
        for (int ai = 0; ai < 2; ++ai)
#pragma unroll
            for (int m = 0; m < 4; ++m) {
                const int row = row0 + ai * 128 + m * 16;
                bf16_t* rowp = O + (size_t)row * PW + col0;
                f32x4 cs[4];
                if (do_rope) {
                    const int s = row & 4095, pos = (fq >> 1) ? (s & 63) : (s >> 6);
                    const f32x4* rp = (const f32x4*)(rope + pos * 16);
                    cs[0] = rp[0]; cs[1] = rp[1]; cs[2] = rp[2]; cs[3] = rp[3];
                }
#pragma unroll
                for (int bj = 0; bj < 2; ++bj) {
                    f32x4 v0 = acc[ai][bj][m][0], v1 = acc[ai][bj][m][1];
                    if (do_rope) {
                        f32x4 b0, b1;
#pragma unroll
                        for (int j = 0; j < 4; ++j) { b0[j] = __shfl_xor(v0[j], 16); b1[j] = __shfl_xor(v1[j], 16); }
                        v0[0] = v0[0] * cs[0][0] + sgn * b0[0] * cs[0][1]; v0[1] = v0[1] * cs[0][2] + sgn * b0[1] * cs[0][3];
                        v0[2] = v0[2] * cs[1][0] + sgn * b0[2] * cs[1][1]; v0[3] = v0[3] * cs[1][2] + sgn * b0[3] * cs[1][3];
                        v1[0] = v1[0] * cs[2][0] + sgn * b1[0] * cs[2][1]; v1[1] = v1[1] * cs[2][2] + sgn * b1[1] * cs[2][3];
                        v1[2] = v1[2] * cs[3][0] + sgn * b1[2] * cs[3][1]; v1[3] = v1[3] * cs[3][2] + sgn * b1[3] * cs[3][3];
                    }
                    if (do_gelu) {
#pragma unroll
                        for (int j = 0; j < 4; ++j) { v0[j] = gelu_fast(v0[j]); v1[j] = gelu_fast(v1[j]); }
                    }
                    v0 = v0 * sc; v1 = v1 * sc;
                    u32x4 w; w.x = cvtpk(v0[0], v0[1]); w.y = cvtpk(v0[2], v0[3]); w.z = cvtpk(v1[0], v1[1]); w.w = cvtpk(v1[2], v1[3]);
                    *(u32x4*)(rowp + bj * 128) = w;
                }
            }
    }
};
template <bool RES_F32>
struct EpiOut {
    static constexpr bool PERM = true, AFTER_DRAIN = false, WIDE = false;
    struct Pre {}; __device__ __forceinline__ void prefetch(Pre&, const pg8::Unit&, int, int, int, int) const {}
    bf16_t* X; const float* gate; const float* res_lat; const float* res_ctx;
    __device__ __forceinline__ void operator()(const f32x4 (&acc)[2][2][4][2], const pg8::Unit& u, int wr, int wc, int fr, int fq, const Pre& pre) const {
        const int row0 = u.pm * 256 + wr * 64 + fr, col0 = u.pn * 256 + wc * 32 + 8 * fq;
        const float* g = gate + (size_t)mod_row(u.pm * 256) * 6144 + col0;
        f32x4 gv[2][2];
#pragma unroll
        for (int bj = 0; bj < 2; ++bj)
#pragma unroll
            for (int n = 0; n < 2; ++n) gv[bj][n] = *(const f32x4*)(g + bj * 128 + n * 4);
#pragma unroll
        for (int ai = 0; ai < 2; ++ai)
#pragma unroll
            for (int m = 0; m < 4; ++m) { const size_t off = (size_t)(row0 + ai * 128 + m * 16) * D + col0;
#pragma unroll
                for (int bj = 0; bj < 2; ++bj) {
                    f32x4 r0, r1;
                    if (RES_F32) { const float* rp = (u.pm < T / 256 ? res_lat : res_ctx) + off + bj * 128; r0 = *(const f32x4*)rp; r1 = *(const f32x4*)(rp + 4); }
                    else { const u32x4 w = *(const u32x4*)(X + off + bj * 128);
                        r0 = (f32x4){__uint_as_float(w.x << 16), __uint_as_float(w.x & 0xffff0000u), __uint_as_float(w.y << 16), __uint_as_float(w.y & 0xffff0000u)};
                        r1 = (f32x4){__uint_as_float(w.z << 16), __uint_as_float(w.z & 0xffff0000u), __uint_as_float(w.w << 16), __uint_as_float(w.w & 0xffff0000u)}; }
                    const f32x4 v0 = r0 + gv[bj][0] * acc[ai][bj][m][0], v1 = r1 + gv[bj][1] * acc[ai][bj][m][1];
                    u32x4 o; o.x = cvtpk(v0[0], v0[1]); o.y = cvtpk(v0[2], v0[3]); o.z = cvtpk(v1[0], v1[1]); o.w = cvtpk(v1[2], v1[3]);
                    *(u32x4*)(X + off + bj * 128) = o; } }
    }
};
__device__ __forceinline__ float swiglu(float g, float u) {
    const float gt = fminf(g, 7.0f), up = fminf(fmaxf(u, -7.0f), 7.0f);
    return (up + 1.0f) * gt * __builtin_amdgcn_rcpf(1.0f + __builtin_amdgcn_exp2f(-1.702f * 1.4426950408889634f * gt));
}
struct EpiAct {
    static constexpr bool PERM = true, AFTER_DRAIN = false, WIDE = false;
    unsigned char* ACT; const float* bgu;
    struct Pre { f32x4 bg0, bg1, bu0, bu1; };
    __device__ __forceinline__ void prefetch(Pre& q, const pg8::Unit& u, int wr, int wc, int fr, int fq) const {
        const float* bp = bgu + (size_t)u.e * 2048 + u.pn * 128 + wc * 32 + 8 * fq;
        q.bg0 = *(const f32x4*)(bp); q.bg1 = *(const f32x4*)(bp + 4); q.bu0 = *(const f32x4*)(bp + 1024); q.bu1 = *(const f32x4*)(bp + 1028);
    }
    __device__ __forceinline__ void operator()(const f32x4 (&acc)[2][2][4][2], const pg8::Unit& u, int wr, int wc, int fr, int fq, const Pre& pre) const {
        const int row0 = u.pm * 256 + wr * 64 + fr, j0 = u.pn * 128 + wc * 32 + 8 * fq;
        const f32x4 bg0 = pre.bg0, bg1 = pre.bg1, bu0 = pre.bu0, bu1 = pre.bu1;
#pragma unroll
        for (int ai = 0; ai < 2; ++ai)
#pragma unroll
            for (int m = 0; m < 4; ++m) {
                const f32x4 g0 = acc[ai][0][m][0] + bg0, g1 = acc[ai][0][m][1] + bg1, u0 = acc[ai][1][m][0] + bu0, u1 = acc[ai][1][m][1] + bu1;
                uint2 w;
                w.x = __builtin_amdgcn_cvt_pk_fp8_f32(swiglu(g0[2], u0[2]), swiglu(g0[3], u0[3]), __builtin_amdgcn_cvt_pk_fp8_f32(swiglu(g0[0], u0[0]), swiglu(g0[1], u0[1]), 0u, false), true);
                w.y = __builtin_amdgcn_cvt_pk_fp8_f32(swiglu(g1[2], u1[2]), swiglu(g1[3], u1[3]), __builtin_amdgcn_cvt_pk_fp8_f32(swiglu(g1[0], u1[0]), swiglu(g1[1], u1[1]), 0u, false), true);
                *(uint2*)(ACT + (size_t)(row0 + ai * 128 + m * 16) * FF + j0) = w;
            }
    }
};
__device__ __forceinline__ void wide_store16(bf16_t* rowp  , const size_t stride8, const u32x4 w0, const u32x4 w1, const bool lo) {
    u32x4 dA, dB;
#pragma unroll
    for (int q = 0; q < 4; ++q) {
        const unsigned snd = lo ? w1[q] : w0[q];
        const unsigned rcv = (unsigned)__builtin_amdgcn_mov_dpp((int)snd, 0x128, 0xf, 0xf, true);
        dA[q] = lo ? w0[q] : rcv; dB[q] = lo ? rcv : w1[q];
    }
    *(u32x4*)rowp = dA; *(u32x4*)(rowp + stride8) = dB;
}
struct EpiYB {
    static constexpr bool PERM = true, AFTER_DRAIN = false, WIDE = true;
    bf16_t* YB; const float* bdn;
    struct Pre { f32x4 bv[2][2]; };
    __device__ __forceinline__ void prefetch(Pre& q, const pg8::Unit& u, int wr, int wc, int fr, int fq) const {
        const float* bp = bdn + (size_t)u.e * D + u.pn * 256 + wc * 64 + 8 * fq;
#pragma unroll
        for (int bj = 0; bj < 2; ++bj)
#pragma unroll
            for (int n = 0; n < 2; ++n) q.bv[bj][n] = *(const f32x4*)(bp + bj * 32 + n * 4);
    }
    __device__ __forceinline__ void operator()(const f32x4 (&acc)[2][2][4][2], const pg8::Unit& u, int wr, int wc, int fr, int fq, const Pre& pre) const {
        const bool lo = fr < 8;
        const int row0 = u.pm * 256 + wr * 64 + (fr & 7), col0 = u.pn * 256 + wc * 64 + 8 * fq;
#pragma unroll
        for (int ai = 0; ai < 2; ++ai)
#pragma unroll
            for (int m = 0; m < 4; ++m) {
                u32x4 w[2];
#pragma unroll
                for (int bj = 0; bj < 2; ++bj) { const f32x4 v0 = acc[ai][bj][m][0] + pre.bv[bj][0], v1 = acc[ai][bj][m][1] + pre.bv[bj][1];
                    w[bj].x = cvtpk(v0[0], v0[1]); w[bj].y = cvtpk(v0[2], v0[3]); w[bj].z = cvtpk(v1[0], v1[1]); w[bj].w = cvtpk(v1[2], v1[3]); }
                wide_store16(YB + (size_t)(row0 + ai * 128 + m * 16) * D + col0 + (lo ? 0 : 32), (size_t)8 * D, w[0], w[1], lo);
            }
    }
};
template <bool GATHER_>
struct MoeOrderT {
    static constexpr bool GATHER = GATHER_;
    int nN, nunits, G, v; const int* tile_e; const int* slot_tok;
    __device__ __forceinline__ int tok(int slot) const { return slot_tok[slot]; }
    __device__ void init(int ntiles, int nN_, int G_, int c, const int* te, const int* st = nullptr) { nN = nN_; nunits = ntiles * nN_; G = G_; v = (G_ % 8 == 0) ? (c % 8) * (G_ / 8) + c / 8 : c; tile_e = te; slot_tok = st; }
    __device__ bool next(int i, pg8::Unit& u) const {
        const int L = i * G + v; if (L >= nunits) return false;
        u.pm = L / nN; u.pn = L % nN; u.e = tile_e[u.pm]; return true;
    }
    __device__ __forceinline__ const bf16_t* bt(const pg8::Gemm& g, const pg8::Unit& u) const { return g.Bt + (size_t)u.e * g.N * g.K; }
    __device__ __forceinline__ void a_ready(const pg8::Unit&) const {}
    __device__ __forceinline__ void done(const pg8::Unit&) const {}
};
typedef MoeOrderT<false> MoeOrder;
typedef MoeOrderT<true> MoeOrderG;

__device__ __forceinline__ void ph_gemm_proj(const P& p, int l, char* lds, const int wv) {
    pg8::Gemm g{p.H, p.WinT + (size_t)l * PW * D, R, PW, D}; pg8::StaticOrder S; S.init(R, PW, (int)gridDim.x, (int)blockIdx.x);
    EpiProj E{p.PROJ, p.rope};
    pg8::gemm_phase<EpiProj, pg8::StaticOrder, true, true>((PG8_LAS unsigned char*)lds, g, S, E, wv);
}
__device__ __forceinline__ void ph_gemm_out(const P& p, int l, int nrows, char* lds, const int wv) {
    pg8::Gemm g{p.MIX, p.WoutT + (size_t)l * D * D, T, D, D}; pg8::StaticOrder S; S.init(T, D, (int)gridDim.x, (int)blockIdx.x);
    if (l == 0) { EpiOut<true> E{p.X, p.mod + (size_t)l * 5 * 6144 + 2 * 1024, p.x, p.ctx - (size_t)T * D}; pg8::gemm_phase<EpiOut<true>, pg8::StaticOrder, true, true>((PG8_LAS unsigned char*)lds, g, S, E, wv); }
    else { EpiOut<false> E{p.X, p.mod + (size_t)l * 5 * 6144 + 2 * 1024, nullptr, nullptr}; pg8::gemm_phase<EpiOut<false>, pg8::StaticOrder, true, true>((PG8_LAS unsigned char*)lds, g, S, E, wv); }
    if (nrows > T) {
        const int tid = ltid(wv), lane = tid & 63, wid = tid >> 6, fr = lane & 15, fq = lane >> 4;
        const bf16_t* Wt = p.WoutT + (size_t)l * D * D;
        const float* gate = p.mod + ((size_t)l * 5 + 4) * 6144 + 2 * 1024;
        for (int it = blockIdx.x; it < (TC / 64) * (D / 64); it += gridDim.x) {
            const int m0 = T + (it >> 4) * 64 + (wid & 3) * 16, n0 = (it & 15) * 64 + (wid >> 2) * 32;
            const bf16_t* ap = p.MIX + (size_t)(m0 + fr) * D + fq * 8;
            const bf16_t* bp0 = Wt + (size_t)(n0 + fr) * D + fq * 8;
            const bf16_t* bp1 = bp0 + (size_t)16 * D;
            f32x4 acc0 = (f32x4){0.f, 0.f, 0.f, 0.f}, acc1 = acc0;
#pragma unroll 8
            for (int ks = 0; ks < D / 32; ++ks) {
                const bf16x8 af = *(const bf16x8*)(ap + ks * 32), b0 = *(const bf16x8*)(bp0 + ks * 32), b1 = *(const bf16x8*)(bp1 + ks * 32);
                acc0 = __builtin_amdgcn_mfma_f32_16x16x32_bf16(b0, af, acc0, 0, 0, 0);
                acc1 = __builtin_amdgcn_mfma_f32_16x16x32_bf16(b1, af, acc1, 0, 0, 0);
            }
            const int row = m0 + fr, c0 = n0 + fq * 4;
            const size_t off = (size_t)row * D + c0;
            const float* res = p.ctx - (size_t)T * D;
            const f32x4 v0 = *(const f32x4*)(res + off) + *(const f32x4*)(gate + c0) * acc0, v1 = *(const f32x4*)(res + off + 16) + *(const f32x4*)(gate + c0 + 16) * acc1;
            uint2 o0, o1; o0.x = cvtpk(v0[0], v0[1]); o0.y = cvtpk(v0[2], v0[3]); o1.x = cvtpk(v1[0], v1[1]); o1.y = cvtpk(v1[2], v1[3]);
            *(uint2*)(p.X + off) = o0; *(uint2*)(p.X + off + 16) = o1;
        }
    }
}
__device__ __forceinline__ void ph_moe1(const P& p, int l, char* lds, const int wv) {
    const int* meta = p.moe_meta + l * 512;
    const int ntiles = meta[0];
    pg8::Gemm g{(const bf16_t*)p.HS, (const bf16_t*)(p.WguT + (size_t)l * NE * 2048 * D), ntiles * 256, 2048, D / 2}; MoeOrderG S; S.init(ntiles, 8, (int)gridDim.x, (int)blockIdx.x, meta + 1, p.slot_tok);
    EpiAct E{p.ACT, p.b_gu + (size_t)l * NE * 2048};
    pg8::gemm_phase<EpiAct, MoeOrderG, true, true, true>((PG8_LAS unsigned char*)lds, g, S, E, wv);
}
__device__ __forceinline__ void ph_moe2(const P& p, int l, char* lds, const int wv) {
    const int* meta = p.moe_meta + l * 512;
    const int ntiles = meta[0];
    pg8::Gemm g{(const bf16_t*)p.ACT, (const bf16_t*)(p.WdnT + (size_t)l * NE * D * FF), ntiles * 256, D, FF / 2}; MoeOrder S; S.init(ntiles, 4, (int)gridDim.x, (int)blockIdx.x, meta + 1);
    EpiYB E{p.YB, p.b_down + (size_t)l * NE * D};
    pg8::gemm_phase<EpiYB, MoeOrder, true, true, true>((PG8_LAS unsigned char*)lds, g, S, E, wv);
}
struct CombRow { uint4 y0[2], y1[2], y2[2], y3[2], xw[2]; float4 g; };
__device__ __forceinline__ void comb_load(CombRow& c, const bf16_t* __restrict__ YB, const bf16_t* __restrict__ X, const int* __restrict__ tok_slot, const float* __restrict__ topg, int row, int lane) {
    const int4 sl = *(const int4*)(tok_slot + (size_t)row * 4);
    c.g = *(const float4*)(topg + (size_t)row * 4);
#pragma unroll
    for (int i = 0; i < 2; ++i) {
        const int k = lane * 8 + 512 * i;
        c.y0[i] = *(const uint4*)(YB + (size_t)sl.x * D + k); c.y1[i] = *(const uint4*)(YB + (size_t)sl.y * D + k);
        c.y2[i] = *(const uint4*)(YB + (size_t)sl.z * D + k); c.y3[i] = *(const uint4*)(YB + (size_t)sl.w * D + k);
        c.xw[i] = *(const uint4*)(X + (size_t)row * D + k);
    }
}
__device__ __forceinline__ void comb_finish(const P& p, const CombRow& c, int l, int row, int lane) {
    const float* m = p.mod + ((size_t)l * 5 + mod_row(row)) * 6144 + 5 * 1024;
    const float4 g = c.g;
    float xv[16]; float ss = 0.f;
#pragma unroll
    for (int i = 0; i < 2; ++i) {
        const int k = lane * 8 + 512 * i;
        const unsigned a0[4] = {c.y0[i].x, c.y0[i].y, c.y0[i].z, c.y0[i].w}, a1[4] = {c.y1[i].x, c.y1[i].y, c.y1[i].z, c.y1[i].w};
        const unsigned a2[4] = {c.y2[i].x, c.y2[i].y, c.y2[i].z, c.y2[i].w}, a3[4] = {c.y3[i].x, c.y3[i].y, c.y3[i].z, c.y3[i].w};
        const unsigned xq[4] = {c.xw[i].x, c.xw[i].y, c.xw[i].z, c.xw[i].w};
        const float4 gta = *(const float4*)(m + k), gtb = *(const float4*)(m + k + 4);
        const float gt[8] = {gta.x, gta.y, gta.z, gta.w, gtb.x, gtb.y, gtb.z, gtb.w};
#pragma unroll
        for (int q = 0; q < 4; ++q) {
            const float ylo = g.x * __uint_as_float(a0[q] << 16) + g.y * __uint_as_float(a1[q] << 16) + g.z * __uint_as_float(a2[q] << 16) + g.w * __uint_as_float(a3[q] << 16);
            const float yhi = g.x * __uint_as_float(a0[q] & 0xffff0000u) + g.y * __uint_as_float(a1[q] & 0xffff0000u) + g.z * __uint_as_float(a2[q] & 0xffff0000u) + g.w * __uint_as_float(a3[q] & 0xffff0000u);
            const float v0 = __uint_as_float(xq[q] << 16) + gt[2 * q] * ylo, v1 = __uint_as_float(xq[q] & 0xffff0000u) + gt[2 * q + 1] * yhi;
            xv[8 * i + 2 * q] = v0; xv[8 * i + 2 * q + 1] = v1; ss += v0 * v0 + v1 * v1;
        }
    }
    ss = wave_sum(ss);
    const float rstd = rsqrtf(ss * (1.f / D) + EPS);
    if (l == 0) {
        const float* m1 = p.mod + ((size_t)5 + mod_row(row)) * 6144;
        const float* g1 = p.g_mix + D;
#pragma unroll
        for (int i = 0; i < 2; ++i) {
            const int k = lane * 8 + 512 * i;
            { u32x4 xo; xo.x = cvtpk(xv[8 * i], xv[8 * i + 1]); xo.y = cvtpk(xv[8 * i + 2], xv[8 * i + 3]); xo.z = cvtpk(xv[8 * i + 4], xv[8 * i + 5]); xo.w = cvtpk(xv[8 * i + 6], xv[8 * i + 7]); *(u32x4*)(p.X + (size_t)row * D + k) = xo; }
            const float4 ga = *(const float4*)(g1 + k), gb = *(const float4*)(g1 + k + 4);
            const float4 sha = *(const float4*)(m1 + k), shb = *(const float4*)(m1 + k + 4);
            const float4 sca = *(const float4*)(m1 + 1024 + k), scb = *(const float4*)(m1 + 1024 + k + 4);
            u32x4 o;
            o.x = cvtpk(xv[8 * i] * rstd * ga.x * (1.f + sca.x) + sha.x, xv[8 * i + 1] * rstd * ga.y * (1.f + sca.y) + sha.y);
            o.y = cvtpk(xv[8 * i + 2] * rstd * ga.z * (1.f + sca.z) + sha.z, xv[8 * i + 3] * rstd * ga.w * (1.f + sca.w) + sha.w);
            o.z = cvtpk(xv[8 * i + 4] * rstd * gb.x * (1.f + scb.x) + shb.x, xv[8 * i + 5] * rstd * gb.y * (1.f + scb.y) + shb.y);
            o.w = cvtpk(xv[8 * i + 6] * rstd * gb.z * (1.f + scb.z) + shb.z, xv[8 * i + 7] * rstd * gb.w * (1.f + scb.w) + shb.w);
            *(u32x4*)(p.H + (size_t)row * D + k) = o;
        }
    } else {
#pragma unroll
        for (int i = 0; i < 2; ++i) {
            const int k = lane * 8 + 512 * i;
            const float4 ga = *(const float4*)(p.g_final + k), gb = *(const float4*)(p.g_final + k + 4);
            float* op = p.out + (size_t)row * D + k;
            *(float4*)op = make_float4(xv[8 * i] * rstd * ga.x, xv[8 * i + 1] * rstd * ga.y, xv[8 * i + 2] * rstd * ga.z, xv[8 * i + 3] * rstd * ga.w);
            *(float4*)(op + 4) = make_float4(xv[8 * i + 4] * rstd * gb.x, xv[8 * i + 5] * rstd * gb.y, xv[8 * i + 6] * rstd * gb.z, xv[8 * i + 7] * rstd * gb.w);
        }
    }
}
__device__ __forceinline__ void ph_combine(const P& p, int l, int nrows, const int wv) {
    const int wave = ltid(wv) >> 6, lane = ltid(wv) & 63;
    for (int pr = blockIdx.x * 8 + wave; pr < nrows / 2; pr += gridDim.x * 8) {
        CombRow ca, cb;
        comb_load(ca, p.YB, p.X, p.tok_slot, p.topg, 2 * pr, lane);
        comb_load(cb, p.YB, p.X, p.tok_slot, p.topg, 2 * pr + 1, lane);
        comb_finish(p, ca, l, 2 * pr, lane);
        comb_finish(p, cb, l, 2 * pr + 1, lane);
    }
}
extern __shared__ __attribute__((aligned(16))) char smem[];
__global__ void __launch_bounds__(NT, 2) mega(P p) {
    char* lds = smem;
    int wv = __builtin_amdgcn_readfirstlane((int)(threadIdx.x >> 6)); asm volatile("" : "+s"(wv));
    if (threadIdx.x == 0) *(uint4*)(smem + LDS_MAIN) = make_uint4(0u, 0u, 0u, 0u);
    __syncthreads();
    XcdBarrier bar = xcd_barrier_post(p.bar, (volatile LAS unsigned*)(smem + LDS_MAIN), wv);
    ph_prologue(p, lds, 0, wv);
    xcd_barrier(bar);
    ph_norm1(p, 0, wv);
    ph_prologue(p, lds, 1, wv);
    xcd_barrier(bar);
#define MEGA_LAYER(l, nrows, LAST) do { \
        ph_gemm_proj(p, l, lds, wv); xcd_barrier(bar); \
        ph_dattn(p, l, nrows, lds, wv); ph_na(p, l, nrows, lds, wv); ph_pool(p, l, nrows, lds, wv); ph_sgu(p, l, nrows, lds, wv); xcd_barrier(bar); \
        ph_gemm_out(p, l, nrows, lds, wv); xcd_barrier(bar); \
        ph_router(p, l, nrows, lds, wv); xcd_barrier(bar); \
        ph_assign(p, l, nrows, lds, wv); xcd_barrier(bar); \
        ph_moe1(p, l, lds, wv); xcd_barrier(bar); \
        ph_moe2(p, l, lds, wv); xcd_barrier(bar); \
        ph_combine(p, l, nrows, wv); if (!(LAST)) xcd_barrier(bar); } while (0)
    MEGA_LAYER(0, R, false);
    MEGA_LAYER(1, T, true);
#undef MEGA_LAYER
}

static inline size_t align_up(size_t v, size_t a) { return (v + a - 1) / a * a; }

extern "C" void kernel_launch(void* const* d_in, const int* in_sizes, int n_in, void* d_out, int out_size, void* d_ws, size_t ws_size, hipStream_t stream) {
    P p{};
    const float** ins = (const float**)&p.x;
    for (int i = 0; i < 28; ++i) ins[i] = (const float*)d_in[i];
    p.out = (float*)d_out;
    char* w = (char*)d_ws; size_t off = 0;
    auto carve = [&](size_t bytes) { void* r = w + off; off = align_up(off + bytes, 256); return r; };
    const size_t ctl_bytes = XCD_BAR_WORDS * 4 + 2 * 64 * 4;
    p.bar = (unsigned*)carve(ctl_bytes);
    p.cnt = (int*)(p.bar + XCD_BAR_WORDS);
    p.mod = (float*)carve((size_t)2 * 5 * 6144 * 4);
    p.rope = (float*)carve(64 * 8 * 2 * 4);
    p.RG = (float*)carve((size_t)2 * 5 * 1024 * 4);
    p.RB = (float*)carve((size_t)2 * 5 * 32 * 4);
    p.X = (bf16_t*)carve((size_t)R * D * 2);
    p.H = (bf16_t*)carve((size_t)R * D * 2);
    p.PROJ = (bf16_t*)carve((size_t)R * PW * 2);
    p.MIX = (bf16_t*)carve((size_t)R * D * 2);
    p.WinT = (bf16_t*)carve((size_t)2 * PW * D * 2);
    p.WoutT = (bf16_t*)carve((size_t)2 * D * D * 2);
    p.WguT = (unsigned char*)carve((size_t)2 * NE * 2048 * D);
    p.WdnT = (unsigned char*)carve((size_t)2 * NE * D * FF);
    p.WpT = (bf16_t*)carve((size_t)2 * 4 * 64 * 64 * 2);
    p.WsB = (bf16_t*)carve((size_t)2 * 4 * 128 * 128 * 2);
    p.topi = (int*)carve((size_t)R * 4 * 4);
    p.topg = (float*)carve((size_t)R * 4 * 4);
    p.tok_slot = (int*)carve((size_t)R * 4 * 4);
    p.moe_meta = (int*)carve(2 * 512 * 4);
    p.HS = (unsigned char*)carve((size_t)R * D);
    p.slot_tok = (int*)carve((size_t)NSLOT * 4);
    p.ACT = (unsigned char*)carve((size_t)NSLOT * FF);
    p.YB = (bf16_t*)carve((size_t)NSLOT * D * 2);

    static int grid = 0;
    if (!grid) {
        int dev = 0, cus = 0, per_cu = 0;
        (void)hipGetDevice(&dev);
        (void)hipDeviceGetAttribute(&cus, hipDeviceAttributeMultiprocessorCount, dev);
        (void)hipFuncSetAttribute((const void*)mega, hipFuncAttributeMaxDynamicSharedMemorySize, LDS_BYTES);
        (void)hipOccupancyMaxActiveBlocksPerMultiprocessor(&per_cu, mega, NT, LDS_BYTES);
        grid = cus * (per_cu < 1 ? per_cu : 1);
        if (grid <= 0) { fprintf(stderr, "mega: occupancy query returned %d blocks per CU\n", per_cu); grid = 0; return; }
    }
    (void)hipMemsetAsync(p.bar, 0, ctl_bytes, stream);
    mega<<<grid, NT, LDS_BYTES, stream>>>(p);
}
```

```cpp
#include <hip/hip_runtime.h>
#include <stdint.h>
#include <cstdio>

typedef unsigned short bf16_t;
typedef short bf16x8 __attribute__((ext_vector_type(8)));
typedef float f32x4 __attribute__((ext_vector_type(4)));

constexpr int D = 1024, NB = 4, S = 4096, T = NB * S, CL = 256, TC = NB * CL, R = T + TC;
constexpr int PW = 2304, NE = 32, TOPK = 4, FF = 1024;
constexpr int MAXSLOT = R * TOPK;
constexpr int NSLOT = MAXSLOT + NE * 256;
constexpr float EPS = 1e-6f;
constexpr int NT = 512;
constexpr int LDS_MAIN = 150 * 1024;
constexpr int LDS_BYTES = LDS_MAIN + 1024;

__device__ __forceinline__ bf16_t f2bf(float f) { unsigned u = __float_as_uint(f); return (bf16_t)((u + 0x7fffu + ((u >> 16) & 1u)) >> 16); }
__device__ __forceinline__ float bf2f(bf16_t h) { return __uint_as_float(((unsigned)h) << 16); }
__device__ __forceinline__ float wave_sum(float v) {
#pragma unroll
    for (int o = 32; o >= 1; o >>= 1) v += __shfl_xor(v, o);
    return v;
}
__device__ __forceinline__ int mod_row(int row) { return row < T ? (row >> 12) : 4; }

#define XB_TMO      128
#define XB_XCNT(j)  (256  + 64 * (j))
#define XB_XSUB(j)  (1280 + 64 * (j))
#define XB_XGEN(j)  (2304 + 64 * (j))
#define XB_TOP      3328
#define XB_TOPGEN   3392
#define XCD_BAR_WORDS 3456
#define XB_SPIN_CAP (1u << 18)
#define LAS __attribute__((address_space(3)))

__device__ __forceinline__ unsigned xb_ld(unsigned* p)              { return __hip_atomic_load(p, __ATOMIC_RELAXED, __HIP_MEMORY_SCOPE_AGENT); }
__device__ __forceinline__ unsigned xb_add(unsigned* p, unsigned v) { return __hip_atomic_fetch_add(p, v, __ATOMIC_RELAXED, __HIP_MEMORY_SCOPE_AGENT); }
__device__ __forceinline__ unsigned xb_xcc_id() { return (unsigned)__builtin_amdgcn_s_getreg((3 << 11) | 20) & 0xFu; }
#define XB_SPIN(cond, bar) do { unsigned _sp = 0; while (cond) { __builtin_amdgcn_s_sleep(1); \
    if ((++_sp & 255u) == 0u) { if (xb_ld(&(bar)[XB_TMO])) break; if (_sp > XB_SPIN_CAP) { atomicAdd(&(bar)[XB_TMO], 1u); break; } } } } while (0)

struct XcdBarrier {
    unsigned* bar; unsigned x;
    volatile LAS unsigned* st;
    int wv;
};
__device__ __forceinline__ bool xb_t0(const int wv) { return wv == 0 && __builtin_amdgcn_mbcnt_hi(~0u, __builtin_amdgcn_mbcnt_lo(~0u, 0u)) == 0u; }
__device__ __forceinline__ XcdBarrier xcd_barrier_post(unsigned* bar, volatile LAS unsigned* st, const int wv) {
    XcdBarrier b; b.bar = bar; b.x = xb_xcc_id(); b.st = st; b.wv = wv;
    if (xb_t0(wv)) (void)xb_add(&bar[XB_XCNT(b.x)], 1u);
    return b;
}
__device__ __forceinline__ void xcd_barrier_complete(unsigned* bar, unsigned x, unsigned& nloc, unsigned& nx) {
    const unsigned G = gridDim.x * gridDim.y * gridDim.z;
    unsigned sum, cnt, mine, sp = 0u;
    for (;;) {
        sum = 0u; cnt = 0u; mine = 0u;
#pragma unroll
        for (unsigned j = 0; j < 16; ++j) { const unsigned c = xb_ld(&bar[XB_XCNT(j)]); sum += c; cnt += (c > 0u) ? 1u : 0u; mine = (j == x) ? c : mine; }
        if (sum == G) break;
        __builtin_amdgcn_s_sleep(1);
        if ((++sp & 255u) == 0u) { if (xb_ld(&bar[XB_TMO])) break; if (sp > XB_SPIN_CAP) { atomicAdd(&bar[XB_TMO], 1u); break; } }
    }
    nloc = mine > 0u ? mine : 1u; nx = cnt > 0u ? cnt : 1u;
}
__device__ __forceinline__ void xcd_barrier(const XcdBarrier& b) {
    asm volatile("s_waitcnt vmcnt(0)" ::: "memory");
    __syncthreads();
    if (xb_t0(b.wv)) {
        unsigned* bar = b.bar;
        __builtin_amdgcn_s_waitcnt(0);
        unsigned nloc = b.st[0], nx = b.st[1];
        if (nloc == 0u) { xcd_barrier_complete(bar, b.x, nloc, nx); b.st[0] = nloc; b.st[1] = nx; }
        const unsigned old = xb_add(&bar[XB_XSUB(b.x)], 1u);
        const unsigned gen = old / nloc;
        if (old + 1u == (gen + 1u) * nloc) {
            __builtin_amdgcn_fence(__ATOMIC_RELEASE, "agent");
            asm volatile("s_waitcnt vmcnt(0)" ::: "memory");
            const unsigned og = xb_add(&bar[XB_TOP], 1u);
            const unsigned tg = og / nx;
            if (og + 1u == (tg + 1u) * nx) xb_add(&bar[XB_TOPGEN], 1u);
            else XB_SPIN(xb_ld(&bar[XB_TOPGEN]) == tg, bar);
            __builtin_amdgcn_fence(__ATOMIC_ACQUIRE, "agent");
            xb_add(&bar[XB_XGEN(b.x)], 1u);
            asm volatile("s_waitcnt vmcnt(0)" ::: "memory");
        } else {
            XB_SPIN(xb_ld(&bar[XB_XGEN(b.x)]) == gen, bar);
            __builtin_amdgcn_fence(__ATOMIC_ACQUIRE, "agent");
            asm volatile("s_waitcnt vmcnt(0)" ::: "memory");
        }
    }
    __syncthreads();
}

struct P {
    const float *x, *c, *ctx, *c_ctx, *w_mod, *b_mod, *g_mix, *g_ffn, *w_in, *w_out, *lam_q1, *lam_k1, *lam_q2, *lam_k2, *g_sub,
        *w_pool, *s_pool, *g_sgu, *w_sgu, *b_sgu, *rpb, *w_router, *b_router, *w_gu, *b_gu, *w_down, *b_down, *g_final;
    float* out;
    unsigned* bar;
    int* cnt;
    float* mod;
    float* rope;
    float* RG;
    float* RB;
    bf16_t* X;
    bf16_t* H;
    bf16_t* PROJ;
    bf16_t* MIX;
    bf16_t* WinT;
    bf16_t* WoutT;
    unsigned char* WguT;
    unsigned char* WdnT;
    bf16_t* WpT;
    bf16_t* WsB;
    int* topi;
    float* topg;
    int* tok_slot;
    int* moe_meta;
    unsigned char* HS;
    int* slot_tok;
    unsigned char* ACT;
    bf16_t* YB;
};

__device__ __forceinline__ int ltid(const int wv) { int t; asm volatile("v_mbcnt_lo_u32_b32 %0, -1, 0\n\tv_mbcnt_hi_u32_b32 %0, -1, %0\n\tv_lshl_or_b32 %0, %1, 6, %0" : "=&v"(t) : "s"(wv)); return t; }
typedef float f32x16 __attribute__((ext_vector_type(16)));
typedef short s16x4 __attribute__((ext_vector_type(4)));
typedef short v4i16_t __attribute__((ext_vector_type(4)));
typedef float f32x2_t __attribute__((ext_vector_type(2)));
typedef __bf16 bf16x2_t __attribute__((ext_vector_type(2)));
typedef __attribute__((address_space(3))) const char* lds_cptr;
typedef unsigned u32x4 __attribute__((ext_vector_type(4)));
__device__ __forceinline__ unsigned cvtpk(float lo, float hi) { f32x2_t v = {lo, hi}; bf16x2_t b = __builtin_convertvector(v, bf16x2_t); return __builtin_bit_cast(unsigned, b); }
__device__ __forceinline__ s16x4 vtr(lds_cptr q) { return __builtin_bit_cast(s16x4, __builtin_amdgcn_ds_read_tr16_b64_v4i16((__attribute__((address_space(3))) v4i16_t*)q)); }
__device__ __forceinline__ float xhalf_max(float v) { auto rr = __builtin_amdgcn_permlane32_swap(__float_as_uint(v), __float_as_uint(v), false, false); return fmaxf(__uint_as_float(rr[0]), __uint_as_float(rr[1])); }
__device__ __forceinline__ float xhalf_sum(float v) { auto rr = __builtin_amdgcn_permlane32_swap(__float_as_uint(v), __float_as_uint(v), false, false); return __uint_as_float(rr[0]) + __uint_as_float(rr[1]); }
namespace pg8 {
#define PG8_LAS __attribute__((address_space(3)))
constexpr int BM = 256, BK = 64, HALF = 128, HTB = HALF * BK * 2  , STAGE_BYTES = 8 * HTB, NXCD = 8, WGM = 8;
__host__ __device__ __forceinline__ int lds_byte(int r, int c) { const int st = (r >> 4) * 2 + (c >> 5), rr = r & 15, cc = c & 31, ob = rr * 64 + cc * 2; return st * 1024 + (ob ^ (((ob >> 9) & 1) << 5)); }
__host__ __device__ __forceinline__ void stage_rc(int b, int& R, int& C) { const int st = b / 1024, sb = b % 1024, swz = sb ^ (((sb >> 9) & 1) << 5); R = (st >> 1) * 16 + swz / 64; C = (st & 1) * 32 + (swz % 64) / 2; }
__host__ __device__ __forceinline__ int perm32(int rho) { const int n = rho >> 4, i = rho & 15; return 8 * (i >> 2) + 4 * n + (i & 3); }
struct Unit { int pm, pn, e; };
struct Gemm { const bf16_t* A; const bf16_t* Bt; int M, N, K; };
struct StaticOrder {
    int nM, nN, nwg, G, c;
    __host__ __device__ void init(int M, int N, int G_, int c_) { nM = M / BM; nN = N / BM; nwg = nM * nN; G = G_; c = c_; }
    __host__ __device__ bool next(int i, Unit& u) const {
        const long L = (long)i * G + c; if (L >= nwg) return false;
        int wgid = (int)L; { const int q = nwg / NXCD, r = nwg % NXCD, xcd = wgid % NXCD, off = wgid / NXCD; wgid = (xcd < r ? xcd * (q + 1) : r * (q + 1) + (xcd - r) * q) + off; }
        const int nig = WGM * nN, gid = wgid / nig, fm = gid * WGM, gsz = (nM - fm) < WGM ? (nM - fm) : WGM;
        u.pm = fm + ((wgid % nig) % gsz); u.pn = (wgid % nig) / gsz; u.e = 0; return true;
    }
    static constexpr bool GATHER = false;
    __device__ __forceinline__ const bf16_t* bt(const Gemm& g, const Unit&) const { return g.Bt; }
    __device__ __forceinline__ void a_ready(const Unit&) const {}
    __device__ __forceinline__ void done(const Unit&) const {}
};
typedef int v4i_t __attribute__((ext_vector_type(4)));
typedef int v8i_t __attribute__((ext_vector_type(8)));
__device__ __forceinline__ v8i_t cat8(bf16x8 a, bf16x8 b) { const v4i_t x = __builtin_bit_cast(v4i_t, a), y = __builtin_bit_cast(v4i_t, b); return __builtin_shufflevector(x, y, 0, 1, 2, 3, 4, 5, 6, 7); }
template <class Epi, class Sched, bool ALIGN_EPI = false, bool SP2 = false, bool F8 = false>
__device__ __forceinline__ void gemm_phase(PG8_LAS unsigned char* lds, const Gemm g, const Sched& S, const Epi& E, const int wv) {
    const int tid = ltid(wv), wid = __builtin_amdgcn_readfirstlane(tid >> 6), lane = tid & 63, wr = wid >> 2, wc = wid & 3, fr = lane & 15, fq = lane >> 4;
    const int K = g.K, nt = K / BK;
    unsigned voffA[2], voffB[2];
#pragma unroll
    for (int i = 0; i < 2; ++i) { int R, C; stage_rc(tid * 16 + i * 8192, R, C); const int Rb = Epi::WIDE ? ((R >> 5) * 64 + perm32(R & 31)) : Epi::PERM ? ((R & ~31) + perm32(R & 31)) : R;
        voffA[i] = (unsigned)(R * K + C) * 2u; voffB[i] = (unsigned)(Rb * K + C) * 2u; }
    int gR[2] = {0, 0}; unsigned gC[2] = {0u, 0u};
    PG8_LAS int* gtab = (PG8_LAS int*)(lds + STAGE_BYTES);
    if constexpr (Sched::GATHER) {
        static_assert(SP2, "gather is wired into the SP2 pipeline only");
#pragma unroll
        for (int i = 0; i < 2; ++i) { int R, C; stage_rc(tid * 16 + i * 8192, R, C); gR[i] = R; gC[i] = (unsigned)C * 2u; }
    }
#define PG8_GATHER(u_, sel_) do { if (tid < 256) gtab[(sel_) * 256 + tid] = S.tok((u_).pm * 256 + tid); } while (0)
    const size_t kstep = (size_t)(BK * 2);
    const size_t hstep = (size_t)HALF * K * 2;
    const size_t tstep = 2 * hstep;
    const size_t bstep = Epi::WIDE ? (size_t)32 * K * 2 : hstep;
    const unsigned ldsw = (unsigned)wid * 1024u;
    const int aoff = lds_byte(wr * 64 + fr, fq * 8), boff = lds_byte(wc * 32 + fr, fq * 8);
#define PG8_SA(b, h) (((b) * 2 + (h)) * HTB)
#define PG8_SB(b, h) ((4 + (b) * 2 + (h)) * HTB)
#define PG8_STAGE(bufoff, gbase, voff) do { _Pragma("unroll") for (int _i = 0; _i < 2; ++_i) \
        __builtin_amdgcn_global_load_lds((const unsigned*)((const char*)(gbase) + (voff)[_i]), (PG8_LAS unsigned*)(lds + (bufoff) + ldsw + _i * 8192), 16, 0, 0); } while (0)
#define PG8_STAGE_A(bufoff, gbase, h, nx) do { if constexpr (Sched::GATHER) { _Pragma("unroll") for (int _i = 0; _i < 2; ++_i) \
        __builtin_amdgcn_global_load_lds((const unsigned*)((const char*)(gbase) + ((unsigned)gtab[(((ui + ((nx) ? 1 : 0)) & 1)) * 256 + (h) * HALF + gR[_i]] * (unsigned)(K * 2) + gC[_i])), (PG8_LAS unsigned*)(lds + (bufoff) + ldsw + _i * 8192), 16, 0, 0); } \
        else { PG8_STAGE(bufoff, (gbase) + (h) * hstep, voffA); } } while (0)
#define PG8_LDA(dst, b, h) do { _Pragma("unroll") for (int m = 0; m < 4; ++m) _Pragma("unroll") for (int k = 0; k < 2; ++k) dst[m][k] = *(const PG8_LAS bf16x8*)(lds + PG8_SA(b, h) + aoff + m * 2048 + k * 1024); \
        if constexpr (F8) { _Pragma("unroll") for (int m = 0; m < 4; ++m) dst##8[m] = cat8(dst[m][0], dst[m][1]); } } while (0)
#define PG8_LDB(dst, b, h) do { _Pragma("unroll") for (int n = 0; n < 2; ++n) _Pragma("unroll") for (int k = 0; k < 2; ++k) dst[n][k] = *(const PG8_LAS bf16x8*)(lds + PG8_SB(b, h) + boff + n * 2048 + k * 1024); \
        if constexpr (F8) { _Pragma("unroll") for (int n = 0; n < 2; ++n) dst##8[n] = cat8(dst[n][0], dst[n][1]); } } while (0)
#define PG8_MMA(ai, bj, At, Bt) do { __builtin_amdgcn_s_setprio(1); \
        if constexpr (F8) { _Pragma("unroll") for (int m = 0; m < 4; ++m) _Pragma("unroll") for (int n = 0; n < 2; ++n) \
            asm volatile("v_mfma_scale_f32_16x16x128_f8f6f4 %0, %1, %2, %0, %3, %4 op_sel_hi:[0,0,0]" : "+v"(acc[ai][bj][m][n]) : "v"(Bt##8[n]), "v"(At##8[m]), "v"(sclW), "v"(sclX)); } \
        else { _Pragma("unroll") for (int m = 0; m < 4; ++m) _Pragma("unroll") for (int n = 0; n < 2; ++n) _Pragma("unroll") for (int k = 0; k < 2; ++k) \
            acc[ai][bj][m][n] = __builtin_amdgcn_mfma_f32_16x16x32_bf16(Bt[n][k], At[m][k], acc[ai][bj][m][n], 0, 0, 0); } \
        __builtin_amdgcn_s_setprio(0); } while (0)
#define PG8_WAIT_V(n) asm volatile("s_waitcnt vmcnt(" #n ")" ::: "memory")
#define PG8_WAIT_L(n) asm volatile("s_waitcnt lgkmcnt(" #n ")" ::: "memory")
#define PG8_BAR __builtin_amdgcn_s_barrier()
#define PG8_SCHED __builtin_amdgcn_sched_barrier(0)
    Unit cur, nxt; int ui = 0;
    typename Epi::Pre pre;
    if (!S.next(0, cur)) return;
    f32x4 acc[2][2][4][2];
#pragma unroll
    for (int a = 0; a < 2; ++a)
#pragma unroll
        for (int b = 0; b < 2; ++b)
#pragma unroll
            for (int m = 0; m < 4; ++m)
#pragma unroll
                for (int n = 0; n < 2; ++n) { acc[a][b][m][n] = (f32x4){0.f, 0.f, 0.f, 0.f}; }
    bf16x8 At[4][2], B0[2][2], B1[2][2];
    v8i_t At8[4], B08[2], B18[2];
    const int sclW = 0x79797979, sclX = 0x7f7f7f7f;
    const char* cA = (const char*)g.A + (Sched::GATHER ? (size_t)0 : (size_t)cur.pm * tstep); const char* cB = (const char*)S.bt(g, cur) + (size_t)cur.pn * tstep;
    if constexpr (Sched::GATHER) { PG8_GATHER(cur, 0); __syncthreads(); }
    S.a_ready(cur);
    if constexpr (SP2) {
        PG8_STAGE(PG8_SB(0, 0), cB, voffB); PG8_STAGE(PG8_SB(0, 1), cB + bstep, voffB); PG8_STAGE_A(PG8_SA(0, 0), cA, 0, false); PG8_STAGE_A(PG8_SA(0, 1), cA, 1, false);
        if (wr == 1) PG8_BAR;
        PG8_WAIT_V(2); PG8_BAR;
        PG8_STAGE(PG8_SB(1, 0), cB + kstep, voffB); PG8_STAGE_A(PG8_SA(1, 0), cA + kstep, 0, false); PG8_STAGE(PG8_SB(1, 1), cB + bstep + kstep, voffB);
        PG8_WAIT_V(6); PG8_BAR;
    } else {
        PG8_STAGE(PG8_SB(0, 0), cB, voffB); PG8_STAGE(PG8_SA(0, 0), cA, voffA); PG8_STAGE(PG8_SB(0, 1), cB + bstep, voffB); PG8_STAGE(PG8_SA(0, 1), cA + hstep, voffA);
        if (wr == 1) PG8_BAR;
        PG8_WAIT_V(4); PG8_BAR;
        PG8_STAGE(PG8_SB(1, 0), cB + kstep, voffB); PG8_STAGE(PG8_SA(1, 0), cA + kstep, voffA); PG8_STAGE(PG8_SB(1, 1), cB + bstep + kstep, voffB);
        PG8_WAIT_V(6); PG8_BAR;
    }
    for (;;) {
        const bool has_next = S.next(ui + 1, nxt);
        const char* nA = Sched::GATHER ? cA : (has_next ? (const char*)g.A + (size_t)nxt.pm * tstep : cA); const char* nB = has_next ? (const char*)S.bt(g, nxt) + (size_t)nxt.pn * tstep : cB;
        if constexpr (Sched::GATHER) { if (has_next) PG8_GATHER(nxt, (ui + 1) & 1); else if (tid < 256) gtab[((ui + 1) & 1) * 256 + tid] = gtab[(ui & 1) * 256 + tid]; }
        E.prefetch(pre, cur, wr, wc, fr, fq);
#pragma unroll 1
        for (int t = 0; t < nt; t += 2) {
            const bool last = (t == nt - 2);
            const char* a1 = cA + (size_t)(t + 1) * kstep;
            const char* a2 = last ? nA : cA + (size_t)(t + 2) * kstep; const char* b2 = last ? nB : cB + (size_t)(t + 2) * kstep;
            const char* a3 = a2 + kstep; const char* b3 = b2 + kstep;
            if (last && has_next) S.a_ready(nxt);
            if constexpr (SP2) {
            PG8_LDB(B0, 0, 0); PG8_LDB(B1, 0, 1); PG8_SCHED; PG8_LDA(At, 0, 0); PG8_STAGE_A(PG8_SA(1, 1), a1, 1, false);
            PG8_WAIT_V(8); PG8_WAIT_L(0); PG8_BAR; PG8_MMA(0, 0, At, B0); PG8_MMA(0, 1, At, B1); PG8_BAR; PG8_SCHED;
            PG8_LDA(At, 0, 1); PG8_STAGE(PG8_SB(0, 0), b2, voffB); PG8_STAGE(PG8_SB(0, 1), b2 + bstep, voffB); PG8_STAGE_A(PG8_SA(0, 0), a2, 0, last);
            PG8_WAIT_V(8); PG8_WAIT_L(0); PG8_BAR; PG8_MMA(1, 0, At, B0); PG8_MMA(1, 1, At, B1); PG8_BAR; PG8_SCHED;
            PG8_LDB(B0, 1, 0); PG8_LDB(B1, 1, 1); PG8_SCHED; PG8_LDA(At, 1, 0); PG8_STAGE_A(PG8_SA(0, 1), a2, 1, last);
            PG8_WAIT_V(8); PG8_WAIT_L(0); PG8_BAR; PG8_MMA(0, 0, At, B0); PG8_MMA(0, 1, At, B1); PG8_BAR; PG8_SCHED;
            PG8_LDA(At, 1, 1); PG8_STAGE(PG8_SB(1, 0), b3, voffB); PG8_STAGE(PG8_SB(1, 1), b3 + bstep, voffB); PG8_STAGE_A(PG8_SA(1, 0), a3, 0, last);
            PG8_WAIT_V(8); PG8_WAIT_L(0); PG8_BAR; PG8_MMA(1, 0, At, B0); PG8_MMA(1, 1, At, B1); PG8_BAR; PG8_SCHED;
            } else {
            PG8_LDB(B0, 0, 0); PG8_SCHED; PG8_LDA(At, 0, 0); PG8_STAGE(PG8_SA(1, 1), a1 + hstep, voffA);
            PG8_WAIT_L(8); PG8_BAR; PG8_WAIT_L(0); PG8_MMA(0, 0, At, B0); PG8_BAR; PG8_SCHED;
            PG8_LDB(B1, 0, 1); PG8_STAGE(PG8_SB(0, 0), b2, voffB);
            PG8_BAR; PG8_WAIT_L(0); PG8_MMA(0, 1, At, B1); PG8_BAR;
            PG8_LDA(At, 0, 1); PG8_STAGE(PG8_SA(0, 0), a2, voffA);
            PG8_BAR; PG8_WAIT_L(0); PG8_MMA(1, 0, At, B0); PG8_BAR; PG8_SCHED;
            PG8_STAGE(PG8_SB(0, 1), b2 + bstep, voffB);
            PG8_WAIT_V(6); PG8_BAR; PG8_MMA(1, 1, At, B1); PG8_BAR;
            PG8_LDB(B0, 1, 0); PG8_SCHED; PG8_LDA(At, 1, 0); PG8_STAGE(PG8_SA(0, 1), a2 + hstep, voffA);
            PG8_WAIT_L(8); PG8_BAR; PG8_WAIT_L(0); PG8_MMA(0, 0, At, B0); PG8_BAR; PG8_SCHED;
            PG8_LDB(B1, 1, 1); PG8_STAGE(PG8_SB(1, 0), b3, voffB);
            PG8_BAR; PG8_WAIT_L(0); PG8_MMA(0, 1, At, B1); PG8_BAR;
            PG8_LDA(At, 1, 1); PG8_STAGE(PG8_SA(1, 0), a3, voffA);
            PG8_BAR; PG8_WAIT_L(0); PG8_MMA(1, 0, At, B0); PG8_BAR; PG8_SCHED;
            PG8_STAGE(PG8_SB(1, 1), b3 + bstep, voffB);
            PG8_WAIT_V(6); PG8_BAR; PG8_MMA(1, 1, At, B1); PG8_BAR;
            }
        }
        if constexpr (ALIGN_EPI) { if (wr == 0) PG8_BAR; }
        if constexpr (F8) asm volatile("s_nop 15\n\ts_nop 15" ::: "memory");
        if constexpr (!Epi::AFTER_DRAIN) { E(acc, cur, wr, wc, fr, fq, pre); S.done(cur); }
        if (!has_next) break;
#pragma unroll
        for (int a = 0; a < 2; ++a)
#pragma unroll
            for (int b = 0; b < 2; ++b)
#pragma unroll
                for (int m = 0; m < 4; ++m)
#pragma unroll
                    for (int n = 0; n < 2; ++n) { acc[a][b][m][n] = (f32x4){0.f, 0.f, 0.f, 0.f}; }
        cur = nxt; cA = nA; cB = nB; ++ui;
        if constexpr (ALIGN_EPI) { if (wr == 1) PG8_BAR; }
    }
    PG8_WAIT_V(0);
    if constexpr (!ALIGN_EPI) { if (wr == 0) PG8_BAR; }
    PG8_BAR;
    if constexpr (Epi::AFTER_DRAIN) { E.fused(acc, cur, wr, wc, fr, fq, lds, wid, lane); S.done(cur); }
#undef PG8_SA
#undef PG8_SB
#undef PG8_STAGE
#undef PG8_STAGE_A
#undef PG8_GATHER
#undef PG8_LDA
#undef PG8_LDB
#undef PG8_MMA
#undef PG8_WAIT_V
#undef PG8_WAIT_L
#undef PG8_BAR
#undef PG8_SCHED
}
}

__device__ __forceinline__ void ph_prologue(const P& p, char* lds, const int part, const int wv) {
    const int tid = ltid(wv);
    float* fl = (float*)lds;
    if (part == 0) {
    for (int it = blockIdx.x; it < 192; it += gridDim.x) {
        const int l = it / 96, cg = it % 96;
        float* sc = fl;
        float* part = fl + 5 * 1024;
        __syncthreads();
        for (int i = tid; i < 5 * 1024; i += NT) {
            const int r = i >> 10, k = i & 1023;
            const float v = r < 4 ? p.c[r * 1024 + k] : p.c_ctx[k];
            sc[i] = v / (1.f + __expf(-v));
        }
        __syncthreads();
        const int kq = tid >> 6, col = tid & 63, j = cg * 64 + col;
        const float* W = p.w_mod + (size_t)l * 1024 * 6144 + j;
        float a0 = 0, a1 = 0, a2 = 0, a3 = 0, a4 = 0;
#pragma unroll 16
        for (int k = kq * 128; k < kq * 128 + 128; ++k) {
            const float w = W[(size_t)k * 6144];
            a0 += sc[k] * w; a1 += sc[1024 + k] * w; a2 += sc[2048 + k] * w; a3 += sc[3072 + k] * w; a4 += sc[4096 + k] * w;
        }
        part[(kq * 5 + 0) * 64 + col] = a0; part[(kq * 5 + 1) * 64 + col] = a1; part[(kq * 5 + 2) * 64 + col] = a2;
        part[(kq * 5 + 3) * 64 + col] = a3; part[(kq * 5 + 4) * 64 + col] = a4;
        __syncthreads();
        if (tid < 5 * 64) {
            const int r = tid >> 6, cc = tid & 63, jj = cg * 64 + cc;
            float v = 0.f;
#pragma unroll
            for (int q = 0; q < 8; ++q) v += part[(q * 5 + r) * 64 + cc];
            p.mod[((size_t)l * 5 + r) * 6144 + jj] = v + p.b_mod[l * 6144 + jj];
        }
    }
    if (blockIdx.x == gridDim.x - 1) {
        const int pos = tid >> 3, f = tid & 7;
        const float inv = powf(10000.0f, -(float)f / 8.0f);
        const float ang = (float)pos * inv;
        p.rope[tid * 2] = cosf(ang); p.rope[tid * 2 + 1] = sinf(ang);
    }
    for (int i = blockIdx.x * NT + tid; i < 2 * 4 * 64 * 64; i += gridDim.x * NT) { const int ii = i & 63, j = (i >> 6) & 63, lg = i >> 12; p.WpT[i] = f2bf(p.w_pool[(size_t)lg * 4096 + ii * 64 + j]); }
    for (int i = blockIdx.x * NT + tid; i < 2 * 4 * 128 * 128; i += gridDim.x * NT) p.WsB[i] = f2bf(p.w_sgu[i]);
    }
    if (part == 1) {
        for (int i = blockIdx.x * NT + tid; i < 2 * 5 * 1024; i += gridDim.x * NT) { const int k = i & 1023, lb = i >> 10, l_ = lb / 5; p.RG[i] = p.g_ffn[l_ * D + k] * (1.f + p.mod[(size_t)lb * 6144 + 4 * 1024 + k]); }
        for (int o = blockIdx.x * 8 + (tid >> 6); o < 2 * 5 * 32; o += gridDim.x * 8) {
            const int e = o & 31, lb = o >> 5, l_ = lb / 5, ln = tid & 63;
            const float* sh = p.mod + (size_t)lb * 6144 + 3 * 1024; const float* wr = p.w_router + (size_t)l_ * D * NE + e;
            float a = 0.f;
            for (int k = ln; k < 1024; k += 64) a += sh[k] * wr[(size_t)k * NE];
            a = wave_sum(a);
            if (ln == 0) p.RB[o] = a + p.b_router[l_ * NE + e];
        }
        const int n_in = 2 * 9 * 16, n_out = 2 * 4 * 16, total = n_in + n_out;
        const int kr = tid >> 6, n4 = tid & 63, kg = tid & 7, nl = tid >> 3;
        for (int it = blockIdx.x; it < total; it += gridDim.x) {
            int i_ = it; const float* W_; bf16_t* Wt_; int N, K;
            if (i_ < n_in) { W_ = p.w_in; Wt_ = p.WinT; N = PW; K = D; } else { i_ -= n_in; W_ = p.w_out; Wt_ = p.WoutT; N = D; K = D; }
            const int ntn = N / 256, per = ntn * (K / 64), m_ = i_ / per, r_ = i_ % per, tn = r_ % ntn, tk = r_ / ntn, n0 = tn * 256;
            const float* src = W_ + (size_t)m_ * K * N + (size_t)(tk * 64) * N + n0; bf16_t* dst = Wt_ + (size_t)m_ * K * N + tk * 64;
            float4 rg[8];
#pragma unroll
            for (int i = 0; i < 8; ++i) rg[i] = *(const float4*)(src + (size_t)(kr + 8 * i) * N + n4 * 4);
            __syncthreads();
#pragma unroll
            for (int i = 0; i < 8; ++i) { float* q = fl + (kr + 8 * i) * 257 + n4 * 4; q[0] = rg[i].x; q[1] = rg[i].y; q[2] = rg[i].z; q[3] = rg[i].w; }
            __syncthreads();
#pragma unroll
            for (int j = 0; j < 4; ++j) {
                const int n = nl + 64 * j;
                const float* q = fl + (8 * kg) * 257 + n;
                u32x4 w;
                w.x = cvtpk(q[0], q[257]); w.y = cvtpk(q[2 * 257], q[3 * 257]); w.z = cvtpk(q[4 * 257], q[5 * 257]); w.w = cvtpk(q[6 * 257], q[7 * 257]);
                *(u32x4*)(dst + (size_t)(n0 + n) * K + 8 * kg) = w;
            }
        }
    }
}

__device__ __forceinline__ void ph_norm1(const P& p, int l, const int wv) {
    const int wave = ltid(wv) >> 6, lane = ltid(wv) & 63;
    for (int row = blockIdx.x * 8 + wave; row < R; row += gridDim.x * 8) {
        const float* xr = row < T ? p.x + (size_t)row * D : p.ctx + (size_t)(row - T) * D;
        float4 v[4]; float ss = 0;
#pragma unroll
        for (int i = 0; i < 4; ++i) { v[i] = *(const float4*)(xr + lane * 4 + 256 * i); ss += v[i].x * v[i].x + v[i].y * v[i].y + v[i].z * v[i].z + v[i].w * v[i].w; }
        ss = wave_sum(ss);
        const float rstd = rsqrtf(ss * (1.f / D) + EPS);
        const float* m = p.mod + ((size_t)l * 5 + mod_row(row)) * 6144;
        const float* g = p.g_mix + l * D;
#pragma unroll
        for (int i = 0; i < 4; ++i) {
            const int k = lane * 4 + 256 * i;
            const float4 gg = *(const float4*)(g + k), sh = *(const float4*)(m + k), sc = *(const float4*)(m + 1024 + k);
            uint2 o;
            o.x = cvtpk(v[i].x * rstd * gg.x * (1.f + sc.x) + sh.x, v[i].y * rstd * gg.y * (1.f + sc.y) + sh.y);
            o.y = cvtpk(v[i].z * rstd * gg.z * (1.f + sc.z) + sh.z, v[i].w * rstd * gg.w * (1.f + sc.w) + sh.w);
            *(uint2*)(p.H + (size_t)row * D + k) = o;
        }
    }
}

constexpr float QSCALE = 0.17677669529663687f * 1.4426950408889634f;
__device__ __forceinline__ void dsoftmax(const f32x16& s, float& m, float& l, f32x16& o0, f32x16& o1, bf16x8& pa, bf16x8& pb) {
    float mx = fmaxf(fmaxf(fmaxf(s[0], s[1]), fmaxf(s[2], s[3])), fmaxf(fmaxf(s[4], s[5]), fmaxf(s[6], s[7])));
    mx = fmaxf(mx, fmaxf(fmaxf(fmaxf(s[8], s[9]), fmaxf(s[10], s[11])), fmaxf(fmaxf(s[12], s[13]), fmaxf(s[14], s[15]))));
    mx = xhalf_max(mx);
    if (__any(mx > m)) {
        const float mn = fmaxf(m, mx), alpha = __builtin_amdgcn_exp2f(m - mn);
        o0 *= alpha; o1 *= alpha; l *= alpha; m = mn;
    }
    float pr[16]; float sum = 0.f;
#pragma unroll
    for (int r = 0; r < 16; ++r) { pr[r] = __builtin_amdgcn_exp2f(s[r] - m); sum += pr[r]; }
    l += sum;
    u32x4 a, b;
    a[0] = cvtpk(pr[0], pr[1]); a[1] = cvtpk(pr[2], pr[3]); a[2] = cvtpk(pr[4], pr[5]); a[3] = cvtpk(pr[6], pr[7]);
    b[0] = cvtpk(pr[8], pr[9]); b[1] = cvtpk(pr[10], pr[11]); b[2] = cvtpk(pr[12], pr[13]); b[3] = cvtpk(pr[14], pr[15]);
    pa = __builtin_bit_cast(bf16x8, a); pb = __builtin_bit_cast(bf16x8, b);
}
#define MX3(a, b, c) __builtin_fmaxf(__builtin_fmaxf((a), (b)), (c))
template <int THR>
__device__ __forceinline__ void dsoftmax2(f32x16& s, float& m, float& l, f32x16& o0, f32x16& o1, bf16x8& pa, bf16x8& pb, const bool first) {
    float a = MX3(s[0], s[1], s[2]), b = MX3(s[3], s[4], s[5]);
    a = MX3(a, s[6], s[7]); b = MX3(b, s[8], s[9]); a = MX3(a, s[10], s[11]); b = MX3(b, s[12], s[13]); a = MX3(a, s[14], s[15]);
    const float mx = xhalf_max(__builtin_fmaxf(a, b));
    if (first || __any(mx > m + (float)THR)) {
        const float mn = first ? mx : __builtin_fmaxf(mx, m), alpha = first ? 1.f : __builtin_amdgcn_exp2f(m - mn);
        m = mn; o0 *= alpha; o1 *= alpha; l *= alpha;
    }
    float sum = 0.f;
#pragma unroll
    for (int r = 0; r < 16; ++r) { s[r] = __builtin_amdgcn_exp2f(s[r] - m); sum += s[r]; }
    l += sum;
    u32x4 wa, wb;
    wa[0] = cvtpk(s[0], s[1]); wa[1] = cvtpk(s[2], s[3]); wa[2] = cvtpk(s[4], s[5]); wa[3] = cvtpk(s[6], s[7]);
    wb[0] = cvtpk(s[8], s[9]); wb[1] = cvtpk(s[10], s[11]); wb[2] = cvtpk(s[12], s[13]); wb[3] = cvtpk(s[14], s[15]);
    pa = __builtin_bit_cast(bf16x8, wa); pb = __builtin_bit_cast(bf16x8, wb);
}
template <int THR>
__device__ __forceinline__ void dsoftmax3(f32x16& s, float& m, f32x16& negm, float& l, f32x16& o0, f32x16& o1, bf16x8& pa, bf16x8& pb, const bool first) {
    float a = MX3(s[0], s[1], s[2]), b = MX3(s[3], s[4], s[5]);
    a = MX3(a, s[6], s[7]); b = MX3(b, s[8], s[9]); a = MX3(a, s[10], s[11]); b = MX3(b, s[12], s[13]); a = MX3(a, s[14], s[15]);
    const float mx = xhalf_max(__builtin_fmaxf(a, b));
    if (first || __any(mx > (float)THR)) {
        const float d = first ? mx : __builtin_fmaxf(mx, 0.f), alpha = first ? 1.f : __builtin_amdgcn_exp2f(-d);
        m += d; o0 *= alpha; o1 *= alpha; l *= alpha;
#pragma unroll
        for (int r = 0; r < 16; ++r) { s[r] -= d; negm[r] = -m; }
    }
    float sum = 0.f;
#pragma unroll
    for (int r = 0; r < 16; ++r) { s[r] = __builtin_amdgcn_exp2f(s[r]); sum += s[r]; }
    l += sum;
    u32x4 wa, wb;
    wa[0] = cvtpk(s[0], s[1]); wa[1] = cvtpk(s[2], s[3]); wa[2] = cvtpk(s[4], s[5]); wa[3] = cvtpk(s[6], s[7]);
    wb[0] = cvtpk(s[8], s[9]); wb[1] = cvtpk(s[10], s[11]); wb[2] = cvtpk(s[12], s[13]); wb[3] = cvtpk(s[14], s[15]);
    pa = __builtin_bit_cast(bf16x8, wa); pb = __builtin_bit_cast(bf16x8, wb);
}
typedef __attribute__((address_space(1))) const float* gcf32_t;
typedef __attribute__((address_space(1))) unsigned char* gu8_t;
typedef __attribute__((address_space(1))) const char* gcc_t;
typedef short v2i16_t __attribute__((ext_vector_type(2)));
struct CvT { gcc_t src; gu8_t dst; int n4; };
struct CvW { gcf32_t gu, dn; gu8_t guT, dnT; int b0, G; };
__device__ __forceinline__ void glds16x2(gcc_t sbase, unsigned voff0, unsigned voff1, unsigned lds_dst) { unsigned keep;
    asm volatile("s_mov_b32 %0, m0\n\ts_mov_b32 m0, %4\n\ts_nop 0\n\tglobal_load_lds_dwordx4 %1, %3\n\ts_add_u32 m0, m0, 0x2000\n\ts_nop 0\n\tglobal_load_lds_dwordx4 %2, %3\n\ts_mov_b32 m0, %0"
                 : "=&s"(keep) : "v"(voff0), "v"(voff1), "s"(sbase), "s"(lds_dst) : "memory", "scc"); }
__device__ __forceinline__ void glds16x4(gcc_t sbase, unsigned voff, unsigned vstride, unsigned lds_dst) { unsigned keep;
    asm volatile("s_mov_b32 %0, m0\n\ts_mov_b32 m0, %4\n\ts_nop 0\n\tglobal_load_lds_dwordx4 %1, %3 nt\n\t"
                 "s_add_u32 m0, m0, 0x400\n\tv_add_u32 %1, %2, %1\n\tglobal_load_lds_dwordx4 %1, %3 nt\n\t"
                 "s_add_u32 m0, m0, 0x400\n\tv_add_u32 %1, %2, %1\n\tglobal_load_lds_dwordx4 %1, %3 nt\n\t"
                 "s_add_u32 m0, m0, 0x400\n\tv_add_u32 %1, %2, %1\n\tglobal_load_lds_dwordx4 %1, %3 nt\n\ts_mov_b32 m0, %0"
                 : "=&s"(keep), "+v"(voff) : "s"(vstride), "s"(sbase), "s"(lds_dst) : "memory", "scc"); }
#if defined(__HIP_DEVICE_COMPILE__)
#define KARG_PTR(T_, member) ({ unsigned long long r_; asm volatile("s_load_dwordx2 %0, %1, %2\n\ts_waitcnt lgkmcnt(0)" : "=s"(r_) : "s"(__builtin_amdgcn_kernarg_segment_ptr()), "n"((int)__builtin_offsetof(P, member)) : "memory"); (T_)r_; })
#else
#define KARG_PTR(T_, member) ((T_)(unsigned long long)p.member)
#endif
__device__ __forceinline__ bool cv_pair(const CvW& w, int q, CvT& c) {
    constexpr int n_gu = NE * 8 * 16, n_dn = NE * 8 * 8;
    const int tile = w.b0 + q * w.G;
    if (tile >= n_gu + n_dn) return false;
    if (tile < n_gu) {
        const int e = tile >> 7, tn = tile & 15, tk = (tile >> 4) & 7, np0 = (tn & 7) * 256 + (tn >> 3) * 128;
        c.n4 = 2048 * 4;
        c.src = (gcc_t)(w.gu + ((size_t)e * 1024 + tk * 128) * 2048 + tn * 128);
        c.dst = w.guT + ((size_t)e * 2048 + np0) * 1024 + tk * 128;
    } else {
        const int i_ = tile - n_gu, e = i_ >> 6, tn = i_ & 7, tk = (i_ >> 3) & 7;
        c.n4 = 1024 * 4;
        c.src = (gcc_t)(w.dn + ((size_t)e * 1024 + tk * 128) * 1024 + tn * 128);
        c.dst = w.dnT + ((size_t)e * 1024 + tn * 128) * 1024 + tk * 128;
    }
    return true;
}
__device__ __forceinline__ void cv_store(gu8_t dst, const char* q0, const unsigned goff) {
    const float* q = (const float*)q0;
    u32x4 w;
#pragma unroll
    for (int d = 0; d < 4; ++d) {
        v2i16_t r = {0, 0};
        r = __builtin_amdgcn_cvt_scalef32_pk_fp8_f32(r, q[(2 * d) * 256], q[(2 * d) * 256 + 128], 0.015625f, false);
        r = __builtin_amdgcn_cvt_scalef32_pk_fp8_f32(r, q[(2 * d + 1) * 256], q[(2 * d + 1) * 256 + 128], 0.015625f, true);
        w[d] = __builtin_bit_cast(unsigned, r);
    }
    __builtin_nontemporal_store(w, (__attribute__((address_space(1))) u32x4*)(dst + goff));
}
constexpr int CV_LDS = 32768;
__device__ __forceinline__ void ph_dattn(const P& p, int l, int nrows, char* lds, const int wv) {
    const int tid = ltid(wv), lane = tid & 63, wid = wv, r32 = lane & 31, hi = lane >> 5;
    float la = lane < 32 ? p.lam_q1[l * 32 + lane] * p.lam_k1[l * 32 + lane] : 0.f;
    float lb = lane < 32 ? p.lam_q2[l * 32 + lane] * p.lam_k2[l * 32 + lane] : 0.f;
    la = wave_sum(la); lb = wave_sum(lb);
    const float lam_init = 0.8f - 0.6f * expf(-0.3f * (float)l);
    const float lam = expf(la) - expf(lb) + lam_init;
    const bf16_t* PR = p.PROJ;
    const int nunits = (nrows == R) ? 256 + 16 : 256;
    const int vkey = (2 * (wid & 3) + (lane >> 5)) * 8 + ((lane >> 2) & 7), vchunk = (wid >> 2) * 4 + (lane & 3);
    const int vb = ((lane >> 4) & 1) * 32 + (lane & 3) * 8 + (4 * hi + ((lane & 15) >> 2)) * 64;
    const unsigned lds0 = (unsigned)(uintptr_t)lds;
    CvW cw; cw.gu = KARG_PTR(gcf32_t, w_gu) + (size_t)l * NE * 1024 * 2048; cw.guT = KARG_PTR(gu8_t, WguT) + (size_t)l * NE * 2048 * 1024;
    cw.dn = KARG_PTR(gcf32_t, w_down) + (size_t)l * NE * 1024 * 1024; cw.dnT = KARG_PTR(gu8_t, WdnT) + (size_t)l * NE * 1024 * 1024;
    { int b0 = blockIdx.x, G = gridDim.x; asm volatile("" : "+s"(b0), "+s"(G)); cw.b0 = b0; cw.G = G; }
    const unsigned cv_row = 8 * wid + (lane >> 5), cv_sw = (unsigned)(((lane & 31) ^ (((wid >> 1) & 1) << 2)) * 16);
    const int cv_n = 16 * wid + (lane >> 2), cv_kg = lane & 3;
    const int cv_lo = cv_kg * 8192 + (((cv_n >> 2) ^ ((cv_kg & 1) << 2)) * 16) + (cv_n & 3) * 4;
    const unsigned cv_go = (unsigned)(cv_n * 1024 + 16 * cv_kg);
    int cj = 0, cb = 0, ca = 0;
    CvT cp; bool cpok = false;
    gu8_t dstA = nullptr; bool hasA = false;
#define CV_NEXT(hasB_, dstB_) do { \
        if ((cj & 1) == 0) cpok = cv_pair(cw, cj >> 1, cp); else { cp.src += 64 * cp.n4; cp.dst += 64; } \
        hasB_ = cpok; dstB_ = cp.dst; \
        if (cpok) glds16x4(cp.src, cv_row * (unsigned)cp.n4 + cv_sw, 2u * (unsigned)cp.n4, lds0 + CV_LDS + cb * 32768 + wid * 4096); } while (0)
    for (int uu = blockIdx.x; uu < nunits; uu += gridDim.x) {
        int b, h, q0, nt; bool isctx;
        if (uu < 256) { const int u = (uu & 7) * 32 + (uu >> 3); b = u >> 6; h = (u >> 4) & 3; q0 = b * 4096 + (u & 15) * 256; nt = 68; isctx = false; }
        else { const int v = uu - 256; b = v >> 2; h = v & 3; q0 = T + b * 256; nt = 4; isctx = true; }
        const unsigned gKo = (unsigned)(256 + h * 64 + wid * 8 + lane * PW) * 2u;
        const unsigned gVo = (unsigned)(512 + h * 64 + vchunk * 8 + vkey * PW) * 2u;
#define DA_ROW0(t_) ((isctx || (t_) >= 64) ? T + b * 256 + (isctx ? (t_) : (t_) - 64) * 64 : b * 4096 + (t_) * 64)
#define DA_DMA_KV(t_) glds16x2((gcc_t)PR + (size_t)DA_ROW0(t_) * (PW * 2), gKo, gVo, lds0 + ((t_) & 1) * 16384 + wid * 1024)
        __syncthreads();
        DA_DMA_KV(0);
        bf16x8 qf[4];
        {
            const bf16_t* qp = PR + (size_t)(q0 + wid * 32 + r32) * PW + h * 64 + hi * 8;
#pragma unroll
            for (int ks = 0; ks < 4; ++ks) qf[ks] = *(const bf16x8*)(qp + ks * 16);
        }
        f32x16 O00, O01, O10, O11, nm1, zero16;
#pragma unroll
        for (int r = 0; r < 16; ++r) { O00[r] = 0.f; O01[r] = 0.f; O10[r] = 0.f; O11[r] = 0.f; nm1[r] = 0.f; zero16[r] = 0.f; }
        float m1 = 0.f, m2 = 0.f, l1 = 0.f, l2 = 0.f;
        asm volatile("" :: "v"(qf[0]), "v"(qf[1]), "v"(qf[2]), "v"(qf[3]));
        asm volatile("s_waitcnt vmcnt(0)" ::: "memory"); __builtin_amdgcn_s_barrier(); asm volatile("" ::: "memory");
#pragma unroll 1
        for (int t = 0; t < nt; ++t) {
            char* buf = lds + (t & 1) * 16384;
            if (t + 1 < nt) DA_DMA_KV(t + 1);
            bool hasB; gu8_t dstB;
            CV_NEXT(hasB, dstB);
            {
                typedef const __attribute__((address_space(3))) bf16x8* kfp_t;
                const lds_cptr kp = (lds_cptr)buf + hi * 1024 + r32 * 16;
                const lds_cptr vp = (lds_cptr)buf + 8192 + vb;
                bf16x8 kf0 = *(kfp_t)(kp), kf1 = *(kfp_t)(kp + 2048), kf2 = *(kfp_t)(kp + 4096), kf3 = *(kfp_t)(kp + 6144);
#pragma unroll
                for (int kb = 0; kb < 2; ++kb) {
                    f32x16 s1 = __builtin_amdgcn_mfma_f32_32x32x16_bf16(kf0, qf[0], nm1, 0, 0, 0);
                    f32x16 s2 = __builtin_amdgcn_mfma_f32_32x32x16_bf16(kf2, qf[2], zero16, 0, 0, 0);
                    s1 = __builtin_amdgcn_mfma_f32_32x32x16_bf16(kf1, qf[1], s1, 0, 0, 0);
                    s2 = __builtin_amdgcn_mfma_f32_32x32x16_bf16(kf3, qf[3], s2, 0, 0, 0);
                    s16x4 vlo[4], vhi[4];
#pragma unroll
                    for (int i = 0; i < 4; ++i) { vlo[i] = vtr(vp + kb * 2048 + (i >> 1) * 4096 + (i & 1) * 1024); vhi[i] = vtr(vp + kb * 2048 + (i >> 1) * 4096 + (i & 1) * 1024 + 512); }
                    __builtin_amdgcn_sched_barrier(0);
                    const bool first = (t == 0) && (kb == 0);
                    bf16x8 p1a, p1b, p2a, p2b;
                    dsoftmax3<8>(s1, m1, nm1, l1, O00, O01, p1a, p1b, first);
                    dsoftmax2<8>(s2, m2, l2, O10, O11, p2a, p2b, first);
                    if (kb == 0) { kf0 = *(kfp_t)(kp + 512); kf1 = *(kfp_t)(kp + 512 + 2048); kf2 = *(kfp_t)(kp + 512 + 4096); kf3 = *(kfp_t)(kp + 512 + 6144); }
#pragma unroll
                    for (int i = 0; i < 4; ++i) {
                        const bf16x8 va = (bf16x8){vlo[i][0], vlo[i][1], vlo[i][2], vlo[i][3], vhi[i][0], vhi[i][1], vhi[i][2], vhi[i][3]};
                        if (i < 2) { O00 = __builtin_amdgcn_mfma_f32_32x32x16_bf16(va, (i & 1) ? p1b : p1a, O00, 0, 0, 0); O10 = __builtin_amdgcn_mfma_f32_32x32x16_bf16(va, (i & 1) ? p2b : p2a, O10, 0, 0, 0); }
                        else       { O01 = __builtin_amdgcn_mfma_f32_32x32x16_bf16(va, (i & 1) ? p1b : p1a, O01, 0, 0, 0); O11 = __builtin_amdgcn_mfma_f32_32x32x16_bf16(va, (i & 1) ? p2b : p2a, O11, 0, 0, 0); }
                    }
                }
            }
            if (hasB) asm volatile("s_waitcnt vmcnt(4)" ::: "memory"); else asm volatile("s_waitcnt vmcnt(0)" ::: "memory");
            __builtin_amdgcn_s_barrier(); asm volatile("" ::: "memory");
            if (hasA) cv_store(dstA, lds + CV_LDS + ca * 32768 + cv_lo, cv_go);
            dstA = dstB; hasA = hasB; ca = cb;
            if (hasB) { ++cj; cb = cb == 2 ? 0 : cb + 1; }
        }
#undef DA_ROW0
#undef DA_DMA_KV
        l1 = xhalf_sum(l1); l2 = xhalf_sum(l2);
        const float i1 = 1.f / l1, i2 = lam / l2;
        float ss = 0.f;
#pragma unroll
        for (int r = 0; r < 16; ++r) { O00[r] = O00[r] * i1 - O10[r] * i2; O01[r] = O01[r] * i1 - O11[r] * i2; ss += O00[r] * O00[r] + O01[r] * O01[r]; }
        ss = xhalf_sum(ss);
        const float rstd = rsqrtf(ss * (1.f / 64.f) + EPS) * (1.f - lam_init);
        const float* gs = p.g_sub + l * 64;
        bf16_t* op = p.MIX + (size_t)(q0 + wid * 32 + r32) * D + h * 64;
#pragma unroll
        for (int g4 = 0; g4 < 4; ++g4) {
            const int d = 8 * g4 + 4 * hi;
            const float4 ga = *(const float4*)(gs + d), gb = *(const float4*)(gs + 32 + d);
            uint2 wa, wb;
            wa.x = cvtpk(O00[4 * g4] * rstd * ga.x, O00[4 * g4 + 1] * rstd * ga.y); wa.y = cvtpk(O00[4 * g4 + 2] * rstd * ga.z, O00[4 * g4 + 3] * rstd * ga.w);
            wb.x = cvtpk(O01[4 * g4] * rstd * gb.x, O01[4 * g4 + 1] * rstd * gb.y); wb.y = cvtpk(O01[4 * g4 + 2] * rstd * gb.z, O01[4 * g4 + 3] * rstd * gb.w);
            *(uint2*)(op + d) = wa; *(uint2*)(op + 32 + d) = wb;
        }
    }
    while (hasA) {
        asm volatile("s_waitcnt vmcnt(0)" ::: "memory");
        __syncthreads();
        cv_store(dstA, lds + CV_LDS + ca * 32768 + cv_lo, cv_go);
        bool hasB; gu8_t dstB;
        CV_NEXT(hasB, dstB);
        dstA = dstB; hasA = hasB; ca = cb;
        if (hasB) { ++cj; cb = cb == 2 ? 0 : cb + 1; }
    }
#undef CV_NEXT
}

__device__ __forceinline__ void ph_na(const P& p, int l, int nrows, char* lds, const int wv) {
    const int tid = ltid(wv), lane = tid & 63, wid = wv, r32 = lane & 31, hi = lane >> 5;
    const bf16_t* PR = p.PROJ;
    const int nunits = (nrows == R) ? 256 + 16 : 256;
    const int vkey = (2 * (wid & 3) + (lane >> 5)) * 8 + ((lane >> 2) & 7), vchunk = (wid >> 2) * 4 + (lane & 3);
    const int vb = ((lane >> 4) & 1) * 32 + (lane & 3) * 8 + (4 * hi + ((lane & 15) >> 2)) * 64;
    const unsigned lds0 = (unsigned)(uintptr_t)lds;
    float* btab = (float*)(lds + 49152);
    constexpr float LOG2E = 1.4426950408889634f;
    float pen[2][16];
    {
        const int cq_ = (wid & 1) * 32 + r32, wsc_ = min(max(cq_ - 8, 0), 48);
#pragma unroll
        for (int kb = 0; kb < 2; ++kb)
#pragma unroll
            for (int r = 0; r < 16; ++r) { const int kc = 32 * kb + (r & 3) + 8 * (r >> 2) + 4 * hi; pen[kb][r] = ((unsigned)(kc - wsc_) < 16u) ? 0.f : -INFINITY; }
    }
    for (int uu = (blockIdx.x + gridDim.x - 16) % gridDim.x; uu < nunits; uu += gridDim.x) {
        int b, h, q0, kr_lo, nlat, rs = 0, rq = 0; bool isctx;
        if (uu < 256) {
            const int u = (uu & 7) * 32 + (uu >> 3); b = u >> 6; h = (u >> 4) & 3; const int rg = u & 15;
            rq = 4 * rg + (wid >> 1); q0 = b * 4096 + rq * 64 + (wid & 1) * 32;
            kr_lo = min(max(4 * rg - 4, 0), 56); const int kr_hi = min(max(4 * rg - 1, 0), 56) + 7; nlat = kr_hi - kr_lo + 1;
            rs = min(max(rq - 4, 0), 56); isctx = false;
        } else { const int v = uu - 256; b = v >> 2; h = v & 3; q0 = T + b * 256 + wid * 32; kr_lo = 0; nlat = 0; isctx = true; }
        const int nt = nlat + 4;
        const int cq = (wid & 1) * 32 + r32;
        const unsigned gKo = (unsigned)(1792 + h * 64 + wid * 8 + lane * PW) * 2u;
        const unsigned gVo = (unsigned)(2048 + h * 64 + vchunk * 8 + vkey * PW) * 2u;
#define NA_ROW0(t_) ((t_) < nlat ? b * 4096 + (kr_lo + (t_)) * 64 : T + b * 256 + ((t_) - nlat) * 64)
#define NA_DMA_KV(t_, slot_) glds16x2((gcc_t)PR + (size_t)NA_ROW0(t_) * (PW * 2), gKo, gVo, lds0 + (slot_) * 16384 + wid * 1024)
        __syncthreads();
        NA_DMA_KV(0, 0); NA_DMA_KV(1, 1);
        bf16x8 qf[4];
        {
            const bf16_t* qp = PR + (size_t)(q0 + r32) * PW + 1536 + h * 64 + hi * 8;
#pragma unroll
            for (int ks = 0; ks < 4; ++ks) qf[ks] = *(const bf16x8*)(qp + ks * 16);
        }
        f32x16 O0, O1;
#pragma unroll
        for (int r = 0; r < 16; ++r) { O0[r] = 0.f; O1[r] = 0.f; }
        float m1 = -1e30f, l1 = 0.f;
        for (int i = tid; i < 15 * 128; i += NT) { const int j = (i & 127) - 48; btab[i] = (j >= 0 && j < 31) ? p.rpb[((size_t)l * 4 + h) * 465 + (i >> 7) * 31 + j] * LOG2E : 0.f; }
        asm volatile("" :: "v"(qf[0]), "v"(qf[1]), "v"(qf[2]), "v"(qf[3]));
        asm volatile("s_waitcnt vmcnt(0)" ::: "memory");
        __syncthreads();
        int ks = 0;
#pragma unroll 1
        for (int t = 0; t < nt; ++t) {
            char* buf = lds + ks * 16384;
            const bool kvB = t + 2 < nt;
            if (kvB) NA_DMA_KV(t + 2, ks == 0 ? 2 : ks - 1);
            const bool lat = t < nlat;
            const int krow = kr_lo + t;
            const bool active = !lat || (krow >= rs && krow <= rs + 7);
            if (active) {
                const float* brow = btab + (krow - rq + 7) * 128 + 48 + 15 - cq + 4 * hi;
#pragma unroll
                for (int kb = 0; kb < 2; ++kb) {
                    const lds_cptr kp = (lds_cptr)buf + hi * 1024 + (kb * 32 + r32) * 16;
                    f32x16 s1;
#pragma unroll
                    for (int r = 0; r < 16; ++r) s1[r] = 0.f;
#pragma unroll
                    for (int ks2 = 0; ks2 < 4; ++ks2) {
                        const bf16x8 kf = *(const __attribute__((address_space(3))) bf16x8*)(kp + ks2 * 2048);
                        s1 = __builtin_amdgcn_mfma_f32_32x32x16_bf16(kf, qf[ks2], s1, 0, 0, 0);
                    }
                    if (lat) {
#pragma unroll
                        for (int r = 0; r < 16; ++r) s1[r] = (s1[r] + brow[32 * kb + (r & 3) + 8 * (r >> 2)]) + pen[kb][r];
                    }
                    bf16x8 pa, pb;
                    dsoftmax2<8>(s1, m1, l1, O0, O1, pa, pb, false);
                    const lds_cptr vp = (lds_cptr)buf + 8192 + vb + kb * 2048;
#pragma unroll
                    for (int ss = 0; ss < 2; ++ss) {
                        const s16x4 lo0 = vtr(vp + ss * 1024), hh0 = vtr(vp + ss * 1024 + 512);
                        const s16x4 lo1 = vtr(vp + 4096 + ss * 1024), hh1 = vtr(vp + 4096 + ss * 1024 + 512);
                        const bf16x8 va0 = (bf16x8){lo0[0], lo0[1], lo0[2], lo0[3], hh0[0], hh0[1], hh0[2], hh0[3]};
                        const bf16x8 va1 = (bf16x8){lo1[0], lo1[1], lo1[2], lo1[3], hh1[0], hh1[1], hh1[2], hh1[3]};
                        O0 = __builtin_amdgcn_mfma_f32_32x32x16_bf16(va0, ss ? pb : pa, O0, 0, 0, 0);
                        O1 = __builtin_amdgcn_mfma_f32_32x32x16_bf16(va1, ss ? pb : pa, O1, 0, 0, 0);
                    }
                }
            }
            if (kvB) asm volatile("s_waitcnt vmcnt(2)" ::: "memory"); else asm volatile("s_waitcnt vmcnt(0)" ::: "memory");
            __builtin_amdgcn_s_barrier(); asm volatile("" ::: "memory");
            ks = ks == 2 ? 0 : ks + 1;
        }
#undef NA_ROW0
#undef NA_DMA_KV
        l1 = xhalf_sum(l1);
        const float il = 1.f / l1;
        bf16_t* op = p.MIX + (size_t)(q0 + r32) * D + 768 + h * 64;
#pragma unroll
        for (int g4 = 0; g4 < 4; ++g4) {
            const int d = 8 * g4 + 4 * hi;
            uint2 wa, wb;
            wa.x = cvtpk(O0[4 * g4] * il, O0[4 * g4 + 1] * il); wa.y = cvtpk(O0[4 * g4 + 2] * il, O0[4 * g4 + 3] * il);
            wb.x = cvtpk(O1[4 * g4] * il, O1[4 * g4 + 1] * il); wb.y = cvtpk(O1[4 * g4 + 2] * il, O1[4 * g4 + 3] * il);
            *(uint2*)(op + d) = wa; *(uint2*)(op + 32 + d) = wb;
        }
    }
}

__device__ __forceinline__ void ph_pool(const P& p, int l, int nrows, char* lds, const int wv) {
    const int tid = ltid(wv), lane = tid & 63, wid = tid >> 6, fr = lane & 15, fq = lane >> 4;
    float* ysh = (float*)lds;
    bf16_t* dsh = (bf16_t*)(lds + 80 * 256 * 4);
    const bf16_t* PR = p.PROJ;
    for (int it = (blockIdx.x + gridDim.x - 32) % gridDim.x; it < nrows / 64; it += gridDim.x) {
        const int row0 = it * 64;
        const int L = row0 < T ? 4096 : 256;
        const int t0 = row0 < T ? (row0 & 4095) : ((row0 - T) & 255);
        const int base = row0 - t0;
        __syncthreads();
        for (int c = tid; c < 80 * 32; c += NT) {
            const int rr = c >> 5, ch = (c & 31) * 8, t = t0 - 8 + rr;
            float4 a = make_float4(0.f, 0.f, 0.f, 0.f), b = a;
            if (t >= 0 && t < L) {
                const uint4 raw = *(const uint4*)(PR + (size_t)(base + t) * PW + 768 + ch);
                a = make_float4(__uint_as_float(raw.x << 16), __uint_as_float(raw.x & 0xffff0000u), __uint_as_float(raw.y << 16), __uint_as_float(raw.y & 0xffff0000u));
                b = make_float4(__uint_as_float(raw.z << 16), __uint_as_float(raw.z & 0xffff0000u), __uint_as_float(raw.w << 16), __uint_as_float(raw.w & 0xffff0000u));
            }
            *(float4*)(ysh + rr * 256 + ch) = a; *(float4*)(ysh + rr * 256 + ch + 4) = b;
        }
        __syncthreads();
        {
            const int r = tid >> 3, cg = tid & 7;
            const int g = cg >> 1, w = 2 << g, t = t0 + r;
            const int lo = max(t - w / 2, 0), hi = min(t + w / 2 - 1, L - 1);
            const float inv = 1.f / (float)(hi - lo + 1);
#pragma unroll
            for (int q = 0; q < 8; ++q) {
                const int ch = cg * 32 + q * 4;
                float4 s = make_float4(0.f, 0.f, 0.f, 0.f);
                for (int tt = lo; tt <= hi; ++tt) { const float4 v = *(const float4*)(ysh + (tt - t0 + 8) * 256 + ch); s.x += v.x; s.y += v.y; s.z += v.z; s.w += v.w; }
                const float4 y = *(const float4*)(ysh + (r + 8) * 256 + ch);
                uint2 o; o.x = cvtpk(s.x * inv - y.x, s.y * inv - y.y); o.y = cvtpk(s.z * inv - y.z, s.w * inv - y.w);
                *(uint2*)(dsh + r * 264 + ch) = o;
            }
        }
        __syncthreads();
        {
            const int g = wid >> 1, mb = (wid & 1) * 2;
            const bf16_t* W = p.WpT + ((size_t)l * 4 + g) * 64 * 64;
            f32x4 acc[2][4];
#pragma unroll
            for (int mt = 0; mt < 2; ++mt)
#pragma unroll
                for (int nt = 0; nt < 4; ++nt) acc[mt][nt] = (f32x4){0.f, 0.f, 0.f, 0.f};
#pragma unroll
            for (int ks = 0; ks < 2; ++ks) {
                bf16x8 af[2], bfr[4];
#pragma unroll
                for (int mt = 0; mt < 2; ++mt) af[mt] = *(const bf16x8*)(dsh + ((mb + mt) * 16 + fr) * 264 + g * 64 + ks * 32 + fq * 8);
#pragma unroll
                for (int nt = 0; nt < 4; ++nt) bfr[nt] = *(const bf16x8*)(W + (nt * 16 + fr) * 64 + ks * 32 + fq * 8);
#pragma unroll
                for (int mt = 0; mt < 2; ++mt)
#pragma unroll
                    for (int nt = 0; nt < 4; ++nt) acc[mt][nt] = __builtin_amdgcn_mfma_f32_16x16x32_bf16(bfr[nt], af[mt], acc[mt][nt], 0, 0, 0);
            }
#pragma unroll
            for (int mt = 0; mt < 2; ++mt)
#pragma unroll
                for (int nt = 0; nt < 4; ++nt) {
                    const int row = row0 + (mb + mt) * 16 + fr, j = g * 64 + nt * 16 + fq * 4;
                    const float4 sp = *(const float4*)(p.s_pool + l * 256 + j);
                    uint2 o; o.x = cvtpk(acc[mt][nt][0] * sp.x, acc[mt][nt][1] * sp.y); o.y = cvtpk(acc[mt][nt][2] * sp.z, acc[mt][nt][3] * sp.w);
                    *(uint2*)(p.MIX + (size_t)row * D + 256 + j) = o;
                }
        }
    }
}

__device__ __forceinline__ float gelu_fast(float x) {
    const float u = 0.7978845608028654f * (x + 0.044715f * x * x * x);
    return x / (1.f + __builtin_amdgcn_exp2f(-2.885390081777927f * u));
}
__device__ __forceinline__ void ph_sgu(const P& p, int l, int nrows, char* lds, const int wv) {
    const int tid = ltid(wv), lane = tid & 63, wid = tid >> 6, fr = lane & 15, fq = lane >> 4;
    bf16_t* vnT = (bf16_t*)lds;
    float* rstd = (float*)(lds + 128 * 136 * 2);
    const bf16_t* PR = p.PROJ;
    for (int it = (blockIdx.x + gridDim.x - 48) % gridDim.x; it < (nrows / 128) * 2; it += gridDim.x) {
        const int chunk = it >> 1, hp = it & 1, row0 = chunk * 128;
        __syncthreads();
        {
            const int t = tid >> 2, qtr = tid & 3;
            const bf16_t* zp = PR + (size_t)(row0 + t) * PW + 1280 + qtr * 64;
            float ss = 0.f;
#pragma unroll
            for (int i = 0; i < 8; ++i) {
                const uint4 raw = *(const uint4*)(zp + i * 8);
                const unsigned w4[4] = {raw.x, raw.y, raw.z, raw.w};
#pragma unroll
                for (int j = 0; j < 4; ++j) { const float a = __uint_as_float(w4[j] << 16), b = __uint_as_float(w4[j] & 0xffff0000u); ss += a * a + b * b; }
            }
            ss += __shfl_xor(ss, 1); ss += __shfl_xor(ss, 2);
            if (qtr == 0) rstd[t] = rsqrtf(ss * (1.f / 256.f) + EPS);
        }
        __syncthreads();
        {
            const int s = tid >> 2, cb = (tid & 3) * 32;
            const bf16_t* zp = PR + (size_t)(row0 + s) * PW + 1280 + hp * 128 + cb;
            const float rs = rstd[s];
            const float* gg = p.g_sgu + l * 256 + hp * 128 + cb;
#pragma unroll
            for (int i = 0; i < 4; ++i) {
                const uint4 raw = *(const uint4*)(zp + i * 8);
                const unsigned w4[4] = {raw.x, raw.y, raw.z, raw.w};
#pragma unroll
                for (int j = 0; j < 4; ++j) {
                    const int c = cb + i * 8 + j * 2;
                    vnT[c * 136 + s] = f2bf(__uint_as_float(w4[j] << 16) * rs * gg[i * 8 + j * 2]);
                    vnT[(c + 1) * 136 + s] = f2bf(__uint_as_float(w4[j] & 0xffff0000u) * rs * gg[i * 8 + j * 2 + 1]);
                }
            }
        }
        __syncthreads();
        {
            const int hl = wid >> 2, g = hp * 2 + hl, mb = (wid & 3) * 2;
            const bf16_t* Wg = p.WsB + ((size_t)l * 4 + g) * 128 * 128;
            f32x4 acc[2][4];
#pragma unroll
            for (int mt = 0; mt < 2; ++mt)
#pragma unroll
                for (int nt = 0; nt < 4; ++nt) acc[mt][nt] = (f32x4){0.f, 0.f, 0.f, 0.f};
#pragma unroll
            for (int ks = 0; ks < 4; ++ks) {
                bf16x8 af[2], bfr[4];
#pragma unroll
                for (int mt = 0; mt < 2; ++mt) af[mt] = *(const bf16x8*)(Wg + ((mb + mt) * 16 + fr) * 128 + ks * 32 + fq * 8);
#pragma unroll
                for (int nt = 0; nt < 4; ++nt) bfr[nt] = *(const bf16x8*)(vnT + (hl * 64 + nt * 16 + fr) * 136 + ks * 32 + fq * 8);
#pragma unroll
                for (int mt = 0; mt < 2; ++mt)
#pragma unroll
                    for (int nt = 0; nt < 4; ++nt) acc[mt][nt] = __builtin_amdgcn_mfma_f32_16x16x32_bf16(bfr[nt], af[mt], acc[mt][nt], 0, 0, 0);
            }
#pragma unroll
            for (int mt = 0; mt < 2; ++mt) {
                const int t = (mb + mt) * 16 + fr;
                const float bias = p.b_sgu[(l * 4 + g) * 128 + t];
#pragma unroll
                for (int nt = 0; nt < 4; ++nt) {
                    const int c = g * 64 + nt * 16 + fq * 4;
                    const uint2 ur = *(const uint2*)(PR + (size_t)(row0 + t) * PW + 1024 + c);
                    const float u0 = __uint_as_float(ur.x << 16), u1 = __uint_as_float(ur.x & 0xffff0000u);
                    const float u2 = __uint_as_float(ur.y << 16), u3 = __uint_as_float(ur.y & 0xffff0000u);
                    uint2 o; o.x = cvtpk(u0 * (acc[mt][nt][0] + bias), u1 * (acc[mt][nt][1] + bias)); o.y = cvtpk(u2 * (acc[mt][nt][2] + bias), u3 * (acc[mt][nt][3] + bias));
                    *(uint2*)(p.MIX + (size_t)(row0 + t) * D + 512 + c) = o;
                }
            }
        }
    }
}

__device__ __forceinline__ void ph_router(const P& p, int l, int nrows, char* lds, const int wv) {
    const int tid = ltid(wv), wave = wv, lane = tid & 63;
    float* wt = (float*)lds;
    float* tsc = (float*)(lds + 32 * 1028 * 4) + wave * (16 * 33);
    int* lcnt = (int*)(lds + 32 * 1028 * 4 + 8 * 16 * 33 * 4);
    __syncthreads();
    {
        const float* wr = p.w_router + (size_t)l * D * NE;
        float4 t[16];
#pragma unroll
        for (int i = 0; i < 16; ++i) t[i] = *(const float4*)(wr + (size_t)(tid + NT * i) * 4);
#pragma unroll
        for (int i = 0; i < 16; ++i) { const int idx = (tid + NT * i) * 4, k = idx >> 5, e = idx & 31; float* q = wt + e * 1028 + k; q[0] = t[i].x; q[1028] = t[i].y; q[2 * 1028] = t[i].z; q[3 * 1028] = t[i].w; }
        if (tid < 32) lcnt[tid] = 0;
    }
    __syncthreads();
    for (int i = blockIdx.x * NT + tid; i < NSLOT; i += gridDim.x * NT) p.slot_tok[i] = 0;
    const int i16 = lane & 15, kk = lane >> 4;
    const float* w0 = wt + i16 * 1028 + 8 * kk;
    for (int g = (wave & 3) * (int)gridDim.x + (int)blockIdx.x; g < nrows / 16; g += 4 * (int)gridDim.x) {
        const int row0 = g * 16, mb = mod_row(row0);
        const bf16_t* xr = p.X + (size_t)(row0 + i16) * D + 8 * kk;
        const float* Gt = p.RG + ((size_t)l * 5 + mb) * 1024 + 8 * kk;
        if (wave >= 4) {
            float ss = 0.f;
#pragma unroll 1
            for (int c0 = 0; c0 < 32; c0 += 16) {
                uint4 raw[16];
#pragma unroll
                for (int c = 0; c < 16; ++c) raw[c] = *(const uint4*)(xr + 32 * (c0 + c));
#pragma unroll
                for (int c = 0; c < 16; ++c) {
                    const float x0 = __uint_as_float(raw[c].x << 16), x1 = __uint_as_float(raw[c].x & 0xffff0000u), x2 = __uint_as_float(raw[c].y << 16), x3 = __uint_as_float(raw[c].y & 0xffff0000u);
                    const float x4 = __uint_as_float(raw[c].z << 16), x5 = __uint_as_float(raw[c].z & 0xffff0000u), x6 = __uint_as_float(raw[c].w << 16), x7 = __uint_as_float(raw[c].w & 0xffff0000u);
                    ss += x0 * x0 + x1 * x1 + x2 * x2 + x3 * x3 + x4 * x4 + x5 * x5 + x6 * x6 + x7 * x7;
                }
            }
            ss += __shfl_xor(ss, 16); ss += __shfl_xor(ss, 32);
            const float rstd = rsqrtf(ss * (1.f / D) + EPS);
            const float* St = p.mod + ((size_t)l * 5 + mb) * 6144 + 3 * 1024 + 8 * kk;
            unsigned char* hr = p.HS + (size_t)(row0 + i16) * D + 8 * kk;
#pragma unroll 1
            for (int c0 = 0; c0 < 32; c0 += 8) {
#pragma unroll
                for (int c1 = 0; c1 < 8; ++c1) {
                    const int c = c0 + c1;
                    const uint4 raw = *(const uint4*)(xr + 32 * c);
                    const float4 ga = *(const float4*)(Gt + 32 * c), gb = *(const float4*)(Gt + 32 * c + 4), sa = *(const float4*)(St + 32 * c), sb = *(const float4*)(St + 32 * c + 4);
                    const float h0 = __uint_as_float(raw.x << 16) * rstd * ga.x + sa.x, h1 = __uint_as_float(raw.x & 0xffff0000u) * rstd * ga.y + sa.y;
                    const float h2 = __uint_as_float(raw.y << 16) * rstd * ga.z + sa.z, h3 = __uint_as_float(raw.y & 0xffff0000u) * rstd * ga.w + sa.w;
                    const float h4 = __uint_as_float(raw.z << 16) * rstd * gb.x + sb.x, h5 = __uint_as_float(raw.z & 0xffff0000u) * rstd * gb.y + sb.y;
                    const float h6 = __uint_as_float(raw.w << 16) * rstd * gb.z + sb.z, h7 = __uint_as_float(raw.w & 0xffff0000u) * rstd * gb.w + sb.w;
                    uint2 o;
                    o.x = __builtin_amdgcn_cvt_pk_fp8_f32(h2, h3, __builtin_amdgcn_cvt_pk_fp8_f32(h0, h1, 0u, false), true);
                    o.y = __builtin_amdgcn_cvt_pk_fp8_f32(h6, h7, __builtin_amdgcn_cvt_pk_fp8_f32(h4, h5, 0u, false), true);
                    *(uint2*)(hr + 32 * c) = o;
                }
            }
            continue;
        }
        f32x4 d0 = {0.f, 0.f, 0.f, 0.f}, d1 = d0; float ss = 0.f;
        uint4 rawA[8], rawB[8];
#pragma unroll
        for (int j = 0; j < 8; ++j) rawA[j] = *(const uint4*)(xr + 32 * j);
#define RT_CHUNK(RAW, c_) do { \
            const float4 ga_ = *(const float4*)(Gt + 32 * (c_)), gb_ = *(const float4*)(Gt + 32 * (c_) + 4); \
            const f32x4 ba0_ = *(const f32x4*)(w0 + 32 * (c_)), ba1_ = *(const f32x4*)(w0 + 32 * (c_) + 4), bb0_ = *(const f32x4*)(w0 + 16 * 1028 + 32 * (c_)), bb1_ = *(const f32x4*)(w0 + 16 * 1028 + 32 * (c_) + 4); \
            const float x0_ = __uint_as_float(RAW.x << 16), x1_ = __uint_as_float(RAW.x & 0xffff0000u), x2_ = __uint_as_float(RAW.y << 16), x3_ = __uint_as_float(RAW.y & 0xffff0000u); \
            const float x4_ = __uint_as_float(RAW.z << 16), x5_ = __uint_as_float(RAW.z & 0xffff0000u), x6_ = __uint_as_float(RAW.w << 16), x7_ = __uint_as_float(RAW.w & 0xffff0000u); \
            ss += x0_ * x0_ + x1_ * x1_ + x2_ * x2_ + x3_ * x3_ + x4_ * x4_ + x5_ * x5_ + x6_ * x6_ + x7_ * x7_; \
            d0 = __builtin_amdgcn_mfma_f32_16x16x4f32(x0_ * ga_.x, ba0_[0], d0, 0, 0, 0); d1 = __builtin_amdgcn_mfma_f32_16x16x4f32(x0_ * ga_.x, bb0_[0], d1, 0, 0, 0); \
            d0 = __builtin_amdgcn_mfma_f32_16x16x4f32(x1_ * ga_.y, ba0_[1], d0, 0, 0, 0); d1 = __builtin_amdgcn_mfma_f32_16x16x4f32(x1_ * ga_.y, bb0_[1], d1, 0, 0, 0); \
            d0 = __builtin_amdgcn_mfma_f32_16x16x4f32(x2_ * ga_.z, ba0_[2], d0, 0, 0, 0); d1 = __builtin_amdgcn_mfma_f32_16x16x4f32(x2_ * ga_.z, bb0_[2], d1, 0, 0, 0); \
            d0 = __builtin_amdgcn_mfma_f32_16x16x4f32(x3_ * ga_.w, ba0_[3], d0, 0, 0, 0); d1 = __builtin_amdgcn_mfma_f32_16x16x4f32(x3_ * ga_.w, bb0_[3], d1, 0, 0, 0); \
            d0 = __builtin_amdgcn_mfma_f32_16x16x4f32(x4_ * gb_.x, ba1_[0], d0, 0, 0, 0); d1 = __builtin_amdgcn_mfma_f32_16x16x4f32(x4_ * gb_.x, bb1_[0], d1, 0, 0, 0); \
            d0 = __builtin_amdgcn_mfma_f32_16x16x4f32(x5_ * gb_.y, ba1_[1], d0, 0, 0, 0); d1 = __builtin_amdgcn_mfma_f32_16x16x4f32(x5_ * gb_.y, bb1_[1], d1, 0, 0, 0); \
            d0 = __builtin_amdgcn_mfma_f32_16x16x4f32(x6_ * gb_.z, ba1_[2], d0, 0, 0, 0); d1 = __builtin_amdgcn_mfma_f32_16x16x4f32(x6_ * gb_.z, bb1_[2], d1, 0, 0, 0); \
            d0 = __builtin_amdgcn_mfma_f32_16x16x4f32(x7_ * gb_.w, ba1_[3], d0, 0, 0, 0); d1 = __builtin_amdgcn_mfma_f32_16x16x4f32(x7_ * gb_.w, bb1_[3], d1, 0, 0, 0); } while (0)
#pragma unroll 1
        for (int cc = 0; cc < 4; cc += 2) {
#pragma unroll
            for (int j = 0; j < 8; ++j) rawB[j] = *(const uint4*)(xr + 32 * (8 * cc + 8 + j));
#pragma unroll
            for (int j = 0; j < 8; ++j) RT_CHUNK(rawA[j], 8 * cc + j);
            if (cc + 2 < 4) {
#pragma unroll
                for (int j = 0; j < 8; ++j) rawA[j] = *(const uint4*)(xr + 32 * (8 * cc + 16 + j));
            }
#pragma unroll
            for (int j = 0; j < 8; ++j) RT_CHUNK(rawB[j], 8 * cc + 8 + j);
        }
#undef RT_CHUNK
        ss += __shfl_xor(ss, 16); ss += __shfl_xor(ss, 32);
        const float rstd = rsqrtf(ss * (1.f / D) + EPS);
#pragma unroll
        for (int j = 0; j < 4; ++j) { tsc[(4 * kk + j) * 33 + i16] = d0[j]; tsc[(4 * kk + j) * 33 + 16 + i16] = d1[j]; }
        __builtin_amdgcn_s_waitcnt(0xc07f);
        if (lane < 16) {
            const float* rb = p.RB + ((size_t)l * 5 + mb) * 32;
            float lg[32];
#pragma unroll
            for (int e = 0; e < 32; ++e) lg[e] = tsc[lane * 33 + e] * rstd + rb[e];
            unsigned taken = 0u; float tv[4]; int ti[4];
#pragma unroll
            for (int k = 0; k < 4; ++k) {
                float best = -3.0e38f; int bi = 0;
#pragma unroll
                for (int e = 0; e < 32; ++e) { const bool ok = !((taken >> e) & 1u) && (lg[e] > best); best = ok ? lg[e] : best; bi = ok ? e : bi; }
                taken |= 1u << bi; tv[k] = best; ti[k] = bi;
            }
            const float e1 = __expf(tv[1] - tv[0]), e2 = __expf(tv[2] - tv[0]), e3 = __expf(tv[3] - tv[0]);
            const float inv = 1.f / (1.f + e1 + e2 + e3);
            const int row = row0 + lane;
            *(int4*)(p.topi + (size_t)row * 4) = make_int4(ti[0], ti[1], ti[2], ti[3]);
            *(float4*)(p.topg + (size_t)row * 4) = make_float4(inv, e1 * inv, e2 * inv, e3 * inv);
            atomicAdd(&lcnt[ti[0]], 1); atomicAdd(&lcnt[ti[1]], 1); atomicAdd(&lcnt[ti[2]], 1); atomicAdd(&lcnt[ti[3]], 1);
        }
    }
    __syncthreads();
    if (tid < 32 && lcnt[tid]) atomicAdd(&p.cnt[l * 64 + tid], lcnt[tid]);
}
__device__ __forceinline__ void ph_assign(const P& p, int l, int nrows, char* lds, const int wv) {
    int* lcnt = (int*)lds; int* lbase = lcnt + 32; int* pst = lbase + 32;
    const int tid = ltid(wv), wave = tid >> 6, lane = tid & 63;
    int* cnt = p.cnt + l * 64; int* cursor = cnt + 32;
    int* meta = p.moe_meta + l * 512;
    __syncthreads();
    if (tid == 0) { int a = 0; for (int e = 0; e < 32; ++e) { pst[e] = a; a += (cnt[e] + 255) & ~255; } if (blockIdx.x == 0) meta[0] = a >> 8; }
    __syncthreads();
    if (blockIdx.x == 0 && tid < 320) { int e = 0; for (int k = 1; k < 32; ++k) if (tid * 256 >= pst[k]) e = k; meta[1 + tid] = e; }
    const int blk0 = (blockIdx.x + gridDim.x - 64) % gridDim.x;
    for (int it = blk0; it < nrows / 64; it += gridDim.x) {
        __syncthreads();
        if (tid < 32) lcnt[tid] = 0;
        __syncthreads();
        if (wave == 0) {
            const int row = it * 64 + lane;
            const int4 ti = *(const int4*)(p.topi + (size_t)row * 4);
            const int r0 = atomicAdd(&lcnt[ti.x], 1), r1 = atomicAdd(&lcnt[ti.y], 1), r2 = atomicAdd(&lcnt[ti.z], 1), r3 = atomicAdd(&lcnt[ti.w], 1);
            __builtin_amdgcn_s_waitcnt(0xc07f);
            if (lane < 32) lbase[lane] = pst[lane] + (lcnt[lane] ? atomicAdd(&cursor[lane], lcnt[lane]) : 0);
            __builtin_amdgcn_s_waitcnt(0xc07f);
            const int4 sl = make_int4(lbase[ti.x] + r0, lbase[ti.y] + r1, lbase[ti.z] + r2, lbase[ti.w] + r3);
            *(int4*)(p.tok_slot + (size_t)row * 4) = sl;
            p.slot_tok[sl.x] = row; p.slot_tok[sl.y] = row; p.slot_tok[sl.z] = row; p.slot_tok[sl.w] = row;
        }
    }
}

struct EpiProj {
    static constexpr bool PERM = true, AFTER_DRAIN = false, WIDE = false;
    struct Pre {}; __device__ __forceinline__ void prefetch(Pre&, const pg8::Unit&, int, int, int, int) const {}
    bf16_t* O; const float* rope;
    __device__ __forceinline__ void operator()(const f32x4 (&acc)[2][2][4][2], const pg8::Unit& u, int wr, int wc, int fr, int fq, const Pre& pre) const {
        const int row0 = u.pm * 256 + wr * 64 + fr, col0 = u.pn * 256 + wc * 32 + 8 * fq;
        const bool do_rope = (u.pn < 2) && (u.pm < T / 256), do_gelu = (u.pn == 4) || (u.pn == 5);
        const float sc = u.pn == 0 ? QSCALE : (u.pn == 6 ? 0.125f * 1.4426950408889634f : 1.f);
        const float sgn = (fq & 1) ? 1.f : -1.f;
#pragma unroll
        for (int ai = 0; ai < 2; ++ai)
#pragma unroll
            for (int m = 0; m < 4; ++m) {
                const int row = row0 + ai * 128 + m * 16;
                bf16_t* rowp = O + (size_t)row * PW + col0;
                f32x4 cs[4];
                if (do_rope) {
                    const int s = row & 4095, pos = (fq >> 1) ? (s & 63) : (s >> 6);
                    const f32x4* rp = (const f32x4*)(rope + pos * 16);
                    cs[0] = rp[0]; cs[1] = rp[1]; cs[2] = rp[2]; cs[3] = rp[3];
                }
#pragma unroll
                for (int bj = 0; bj < 2; ++bj) {
                    f32x4 v0 = acc[ai][bj][m][0], v1 = acc[ai][bj][m][1];
                    if (do_rope) {
                        f32x4 b0, b1;
#pragma unroll
                        for (int j = 0; j < 4; ++j) { b0[j] = __shfl_xor(v0[j], 16); b1[j] = __shfl_xor(v1[j], 16); }
                        v0[0] = v0[0] * cs[0][0] + sgn * b0[0] * cs[0][1]; v0[1] = v0[1] * cs[0][2] + sgn * b0[1] * cs[0][3];
                        v0[2] = v0[2] * cs[1][0] + sgn * b0[2] * cs[1][1]; v0[3] = v0[3] * cs[1][2] + sgn * b0[3] * cs[1][3];
                        v1[0] = v1[0] * cs[2][0] + sgn * b1[0] * cs[2][1]; v1[1] = v1[1] * cs[2][2] + sgn * b1[1] * cs[2][3];
                        v1[2] = v1[2] * cs[3][0] + sgn * b1[2] * cs[3][1]; v1[3] = v1[3] * cs[3][2] + sgn * b1[3] * cs[3][3];
                    }
                    if (do_gelu) {
#pragma unroll
                        for (int j = 0; j < 4; ++j) { v0[j] = gelu_fast(v0[j]); v1[j] = gelu_fast(v1[j]); }
                    }
                    v0 = v0 * sc; v1 = v1 * sc;
                    u32x4 w; w.x = cvtpk(v0[0], v0[1]); w.y = cvtpk(v0[2], v0[3]); w.z = cvtpk(v1[0], v1[1]); w.w = cvtpk(v1[2], v1[3]);
                    *(u32x4*)(rowp + bj * 128) = w;
                }
            }
    }
};
template <bool RES_F32>
struct EpiOut {
    static constexpr bool PERM = true, AFTER_DRAIN = false, WIDE = false;
    struct Pre {}; __device__ __forceinline__ void prefetch(Pre&, const pg8::Unit&, int, int, int, int) const {}
    bf16_t* X; const float* gate; const float* res_lat; const float* res_ctx;
    __device__ __forceinline__ void operator()(const f32x4 (&acc)[2][2][4][2], const pg8::Unit& u, int wr, int wc, int fr, int fq, const Pre& pre) const {
        const int row0 = u.pm * 256 + wr * 64 + fr, col0 = u.pn * 256 + wc * 32 + 8 * fq;
        const float* g = gate + (size_t)mod_row(u.pm * 256) * 6144 + col0;
        f32x4 gv[2][2];
#pragma unroll
        for (int bj = 0; bj < 2; ++bj)
#pragma unroll
            for (int n = 0; n < 2; ++n) gv[bj][n] = *(const f32x4*)(g + bj * 128 + n * 4);
#pragma unroll
        for (int ai = 0; ai < 2; ++ai)
#pragma unroll
            for (int m = 0; m < 4; ++m) { const size_t off = (size_t)(row0 + ai * 128 + m * 16) * D + col0;
#pragma unroll
                for (int bj = 0; bj < 2; ++bj) {
                    f32x4 r0, r1;
                    if (RES_F32) { const float* rp = (u.pm < T / 256 ? res_lat : res_ctx) + off + bj * 128; r0 = *(const f32x4*)rp; r1 = *(const f32x4*)(rp + 4); }
                    else { const u32x4 w = *(const u32x4*)(X + off + bj * 128);
                        r0 = (f32x4){__uint_as_float(w.x << 16), __uint_as_float(w.x & 0xffff0000u), __uint_as_float(w.y << 16), __uint_as_float(w.y & 0xffff0000u)};
                        r1 = (f32x4){__uint_as_float(w.z << 16), __uint_as_float(w.z & 0xffff0000u), __uint_as_float(w.w << 16), __uint_as_float(w.w & 0xffff0000u)}; }
                    const f32x4 v0 = r0 + gv[bj][0] * acc[ai][bj][m][0], v1 = r1 + gv[bj][1] * acc[ai][bj][m][1];
                    u32x4 o; o.x = cvtpk(v0[0], v0[1]); o.y = cvtpk(v0[2], v0[3]); o.z = cvtpk(v1[0], v1[1]); o.w = cvtpk(v1[2], v1[3]);
                    *(u32x4*)(X + off + bj * 128) = o; } }
    }
};
__device__ __forceinline__ float swiglu(float g, float u) {
    const float gt = fminf(g, 7.0f), up = fminf(fmaxf(u, -7.0f), 7.0f);
    return (up + 1.0f) * gt * __builtin_amdgcn_rcpf(1.0f + __builtin_amdgcn_exp2f(-1.702f * 1.4426950408889634f * gt));
}
struct EpiAct {
    static constexpr bool PERM = true, AFTER_DRAIN = false, WIDE = false;
    unsigned char* ACT; const float* bgu;
    struct Pre { f32x4 bg0, bg1, bu0, bu1; };
    __device__ __forceinline__ void prefetch(Pre& q, const pg8::Unit& u, int wr, int wc, int fr, int fq) const {
        const float* bp = bgu + (size_t)u.e * 2048 + u.pn * 128 + wc * 32 + 8 * fq;
        q.bg0 = *(const f32x4*)(bp); q.bg1 = *(const f32x4*)(bp + 4); q.bu0 = *(const f32x4*)(bp + 1024); q.bu1 = *(const f32x4*)(bp + 1028);
        asm volatile("" : "+v"(q.bg0), "+v"(q.bg1), "+v"(q.bu0), "+v"(q.bu1));
    }
    __device__ __forceinline__ void operator()(const f32x4 (&acc)[2][2][4][2], const pg8::Unit& u, int wr, int wc, int fr, int fq, const Pre& pre) const {
        const int row0 = u.pm * 256 + wr * 64 + fr, j0 = u.pn * 128 + wc * 32 + 8 * fq;
        const f32x4 bg0 = pre.bg0, bg1 = pre.bg1, bu0 = pre.bu0, bu1 = pre.bu1;
#pragma unroll
        for (int ai = 0; ai < 2; ++ai)
#pragma unroll
            for (int m = 0; m < 4; ++m) {
                const f32x4 g0 = acc[ai][0][m][0] + bg0, g1 = acc[ai][0][m][1] + bg1, u0 = acc[ai][1][m][0] + bu0, u1 = acc[ai][1][m][1] + bu1;
                uint2 w;
                w.x = __builtin_amdgcn_cvt_pk_fp8_f32(swiglu(g0[2], u0[2]), swiglu(g0[3], u0[3]), __builtin_amdgcn_cvt_pk_fp8_f32(swiglu(g0[0], u0[0]), swiglu(g0[1], u0[1]), 0u, false), true);
                w.y = __builtin_amdgcn_cvt_pk_fp8_f32(swiglu(g1[2], u1[2]), swiglu(g1[3], u1[3]), __builtin_amdgcn_cvt_pk_fp8_f32(swiglu(g1[0], u1[0]), swiglu(g1[1], u1[1]), 0u, false), true);
                *(uint2*)(ACT + (size_t)(row0 + ai * 128 + m * 16) * FF + j0) = w;
            }
    }
};
__device__ __forceinline__ void wide_store16(bf16_t* rowp  , const size_t stride8, const u32x4 w0, const u32x4 w1, const bool lo) {
    u32x4 dA, dB;
#pragma unroll
    for (int q = 0; q < 4; ++q) {
        const unsigned snd = lo ? w1[q] : w0[q];
        const unsigned rcv = (unsigned)__builtin_amdgcn_mov_dpp((int)snd, 0x128, 0xf, 0xf, true);
        dA[q] = lo ? w0[q] : rcv; dB[q] = lo ? rcv : w1[q];
    }
    __builtin_nontemporal_store(dA, (u32x4*)rowp); __builtin_nontemporal_store(dB, (u32x4*)(rowp + stride8));
}
struct EpiYB {
    static constexpr bool PERM = true, AFTER_DRAIN = false, WIDE = true;
    bf16_t* YB; const float* bdn;
    struct Pre { f32x4 bv[2][2]; };
    __device__ __forceinline__ void prefetch(Pre& q, const pg8::Unit& u, int wr, int wc, int fr, int fq) const {
        const float* bp = bdn + (size_t)u.e * D + u.pn * 256 + wc * 64 + 8 * fq;
#pragma unroll
        for (int bj = 0; bj < 2; ++bj)
#pragma unroll
            for (int n = 0; n < 2; ++n) q.bv[bj][n] = *(const f32x4*)(bp + bj * 32 + n * 4);
        asm volatile("" : "+v"(q.bv[0][0]), "+v"(q.bv[0][1]), "+v"(q.bv[1][0]), "+v"(q.bv[1][1]));
    }
    __device__ __forceinline__ void operator()(const f32x4 (&acc)[2][2][4][2], const pg8::Unit& u, int wr, int wc, int fr, int fq, const Pre& pre) const {
        const bool lo = fr < 8;
        const int trow0 = (u.pm * 4 + u.pn) * 256 + wr * 64 + (fr & 7), tcol0 = wc * 64 + 8 * fq + (lo ? 0 : 32);
#pragma unroll
        for (int ai = 0; ai < 2; ++ai)
#pragma unroll
            for (int m = 0; m < 4; ++m) {
                u32x4 w[2];
#pragma unroll
                for (int bj = 0; bj < 2; ++bj) { const f32x4 v0 = acc[ai][bj][m][0] + pre.bv[bj][0], v1 = acc[ai][bj][m][1] + pre.bv[bj][1];
                    w[bj].x = cvtpk(v0[0], v0[1]); w[bj].y = cvtpk(v0[2], v0[3]); w[bj].z = cvtpk(v1[0], v1[1]); w[bj].w = cvtpk(v1[2], v1[3]); }
                wide_store16(YB + (size_t)(trow0 + ai * 128 + m * 16) * 256 + tcol0, (size_t)8 * 256, w[0], w[1], lo);
            }
    }
};
template <bool GATHER_>
struct MoeOrderT {
    static constexpr bool GATHER = GATHER_;
    int nN, nunits, G, v; const int* tile_e; const int* slot_tok;
    __device__ __forceinline__ int tok(int slot) const { return slot_tok[slot]; }
    __device__ void init(int ntiles, int nN_, int G_, int c, const int* te, const int* st = nullptr) { nN = nN_; nunits = ntiles * nN_; G = G_; v = (G_ % 8 == 0) ? (c % 8) * (G_ / 8) + c / 8 : c; tile_e = te; slot_tok = st; }
    __device__ bool next(int i, pg8::Unit& u) const {
        const int L = i * G + v; if (L >= nunits) return false;
        u.pm = L / nN; u.pn = L % nN; u.e = tile_e[u.pm]; return true;
    }
    __device__ __forceinline__ const bf16_t* bt(const pg8::Gemm& g, const pg8::Unit& u) const { return g.Bt + (size_t)u.e * g.N * g.K; }
    __device__ __forceinline__ void a_ready(const pg8::Unit&) const {}
    __device__ __forceinline__ void done(const pg8::Unit&) const {}
};
typedef MoeOrderT<false> MoeOrder;
typedef MoeOrderT<true> MoeOrderG;

__device__ __forceinline__ void ph_gemm_proj(const P& p, int l, char* lds, const int wv) {
    pg8::Gemm g{p.H, p.WinT + (size_t)l * PW * D, R, PW, D}; pg8::StaticOrder S; S.init(R, PW, (int)gridDim.x, (int)blockIdx.x);
    EpiProj E{p.PROJ, p.rope};
    pg8::gemm_phase<EpiProj, pg8::StaticOrder, true, true>((PG8_LAS unsigned char*)lds, g, S, E, wv);
}
__device__ __forceinline__ void ph_gemm_out(const P& p, int l, int nrows, char* lds, const int wv) {
    pg8::Gemm g{p.MIX, p.WoutT + (size_t)l * D * D, T, D, D}; pg8::StaticOrder S; S.init(T, D, (int)gridDim.x, (int)blockIdx.x);
    if (l == 0) { EpiOut<true> E{p.X, p.mod + (size_t)l * 5 * 6144 + 2 * 1024, p.x, p.ctx - (size_t)T * D}; pg8::gemm_phase<EpiOut<true>, pg8::StaticOrder, true, true>((PG8_LAS unsigned char*)lds, g, S, E, wv); }
    else { EpiOut<false> E{p.X, p.mod + (size_t)l * 5 * 6144 + 2 * 1024, nullptr, nullptr}; pg8::gemm_phase<EpiOut<false>, pg8::StaticOrder, true, true>((PG8_LAS unsigned char*)lds, g, S, E, wv); }
    if (nrows > T) {
        const int tid = ltid(wv), lane = tid & 63, wid = tid >> 6, fr = lane & 15, fq = lane >> 4;
        const bf16_t* Wt = p.WoutT + (size_t)l * D * D;
        const float* gate = p.mod + ((size_t)l * 5 + 4) * 6144 + 2 * 1024;
        for (int it = blockIdx.x; it < (TC / 64) * (D / 64); it += gridDim.x) {
            const int m0 = T + (it >> 4) * 64 + (wid & 3) * 16, n0 = (it & 15) * 64 + (wid >> 2) * 32;
            const bf16_t* ap = p.MIX + (size_t)(m0 + fr) * D + fq * 8;
            const bf16_t* bp0 = Wt + (size_t)(n0 + fr) * D + fq * 8;
            const bf16_t* bp1 = bp0 + (size_t)16 * D;
            f32x4 acc0 = (f32x4){0.f, 0.f, 0.f, 0.f}, acc1 = acc0;
#pragma unroll 8
            for (int ks = 0; ks < D / 32; ++ks) {
                const bf16x8 af = *(const bf16x8*)(ap + ks * 32), b0 = *(const bf16x8*)(bp0 + ks * 32), b1 = *(const bf16x8*)(bp1 + ks * 32);
                acc0 = __builtin_amdgcn_mfma_f32_16x16x32_bf16(b0, af, acc0, 0, 0, 0);
                acc1 = __builtin_amdgcn_mfma_f32_16x16x32_bf16(b1, af, acc1, 0, 0, 0);
            }
            const int row = m0 + fr, c0 = n0 + fq * 4;
            const size_t off = (size_t)row * D + c0;
            const float* res = p.ctx - (size_t)T * D;
            const f32x4 v0 = *(const f32x4*)(res + off) + *(const f32x4*)(gate + c0) * acc0, v1 = *(const f32x4*)(res + off + 16) + *(const f32x4*)(gate + c0 + 16) * acc1;
            uint2 o0, o1; o0.x = cvtpk(v0[0], v0[1]); o0.y = cvtpk(v0[2], v0[3]); o1.x = cvtpk(v1[0], v1[1]); o1.y = cvtpk(v1[2], v1[3]);
            *(uint2*)(p.X + off) = o0; *(uint2*)(p.X + off + 16) = o1;
        }
    }
}
__device__ __forceinline__ void ph_moe1(const P& p, int l, char* lds, const int wv) {
    const int* meta = p.moe_meta + l * 512;
    const int ntiles = meta[0];
    pg8::Gemm g{(const bf16_t*)p.HS, (const bf16_t*)(p.WguT + (size_t)l * NE * 2048 * D), ntiles * 256, 2048, D / 2}; MoeOrderG S; S.init(ntiles, 8, (int)gridDim.x, (int)blockIdx.x, meta + 1, p.slot_tok);
    EpiAct E{p.ACT, p.b_gu + (size_t)l * NE * 2048};
    pg8::gemm_phase<EpiAct, MoeOrderG, true, true, true>((PG8_LAS unsigned char*)lds, g, S, E, wv);
}
__device__ __forceinline__ void ph_moe2(const P& p, int l, char* lds, const int wv) {
    const int* meta = p.moe_meta + l * 512;
    const int ntiles = meta[0];
    pg8::Gemm g{(const bf16_t*)p.ACT, (const bf16_t*)(p.WdnT + (size_t)l * NE * D * FF), ntiles * 256, D, FF / 2}; MoeOrder S; S.init(ntiles, 4, (int)gridDim.x, (int)blockIdx.x, meta + 1);
    EpiYB E{p.YB, p.b_down + (size_t)l * NE * D};
    pg8::gemm_phase<EpiYB, MoeOrder, true, true, true>((PG8_LAS unsigned char*)lds, g, S, E, wv);
}
struct CombRow { uint4 y0[2], y1[2], y2[2], y3[2], xw[2]; float4 g; };
__device__ __forceinline__ void comb_load(CombRow& c, const bf16_t* __restrict__ YB, const bf16_t* __restrict__ X, const int* __restrict__ tok_slot, const float* __restrict__ topg, int row, int lane) {
    const int4 sl = *(const int4*)(tok_slot + (size_t)row * 4);
    c.g = *(const float4*)(topg + (size_t)row * 4);
#pragma unroll
    for (int i = 0; i < 2; ++i) {
        const int k = lane * 8 + 512 * i;
        const size_t ko = (size_t)(k >> 8) * 65536 + (k & 255);
#define YB_AT(s_) (YB + (size_t)((s_) >> 8) * 262144 + (size_t)((s_) & 255) * 256 + ko)
        c.y0[i] = *(const uint4*)YB_AT(sl.x); c.y1[i] = *(const uint4*)YB_AT(sl.y);
        c.y2[i] = *(const uint4*)YB_AT(sl.z); c.y3[i] = *(const uint4*)YB_AT(sl.w);
#undef YB_AT
        c.xw[i] = *(const uint4*)(X + (size_t)row * D + k);
    }
}
__device__ __forceinline__ void comb_finish(const P& p, const CombRow& c, int l, int row, int lane) {
    const float* m = p.mod + ((size_t)l * 5 + mod_row(row)) * 6144 + 5 * 1024;
    const float4 g = c.g;
    float xv[16]; float ss = 0.f;
#pragma unroll
    for (int i = 0; i < 2; ++i) {
        const int k = lane * 8 + 512 * i;
        const unsigned a0[4] = {c.y0[i].x, c.y0[i].y, c.y0[i].z, c.y0[i].w}, a1[4] = {c.y1[i].x, c.y1[i].y, c.y1[i].z, c.y1[i].w};
        const unsigned a2[4] = {c.y2[i].x, c.y2[i].y, c.y2[i].z, c.y2[i].w}, a3[4] = {c.y3[i].x, c.y3[i].y, c.y3[i].z, c.y3[i].w};
        const unsigned xq[4] = {c.xw[i].x, c.xw[i].y, c.xw[i].z, c.xw[i].w};
        const float4 gta = *(const float4*)(m + k), gtb = *(const float4*)(m + k + 4);
        const float gt[8] = {gta.x, gta.y, gta.z, gta.w, gtb.x, gtb.y, gtb.z, gtb.w};
#pragma unroll
        for (int q = 0; q < 4; ++q) {
            const float ylo = g.x * __uint_as_float(a0[q] << 16) + g.y * __uint_as_float(a1[q] << 16) + g.z * __uint_as_float(a2[q] << 16) + g.w * __uint_as_float(a3[q] << 16);
            const float yhi = g.x * __uint_as_float(a0[q] & 0xffff0000u) + g.y * __uint_as_float(a1[q] & 0xffff0000u) + g.z * __uint_as_float(a2[q] & 0xffff0000u) + g.w * __uint_as_float(a3[q] & 0xffff0000u);
            const float v0 = __uint_as_float(xq[q] << 16) + gt[2 * q] * ylo, v1 = __uint_as_float(xq[q] & 0xffff0000u) + gt[2 * q + 1] * yhi;
            xv[8 * i + 2 * q] = v0; xv[8 * i + 2 * q + 1] = v1; ss += v0 * v0 + v1 * v1;
        }
    }
    ss = wave_sum(ss);
    const float rstd = rsqrtf(ss * (1.f / D) + EPS);
    if (l == 0) {
        const float* m1 = p.mod + ((size_t)5 + mod_row(row)) * 6144;
        const float* g1 = p.g_mix + D;
#pragma unroll
        for (int i = 0; i < 2; ++i) {
            const int k = lane * 8 + 512 * i;
            { u32x4 xo; xo.x = cvtpk(xv[8 * i], xv[8 * i + 1]); xo.y = cvtpk(xv[8 * i + 2], xv[8 * i + 3]); xo.z = cvtpk(xv[8 * i + 4], xv[8 * i + 5]); xo.w = cvtpk(xv[8 * i + 6], xv[8 * i + 7]); *(u32x4*)(p.X + (size_t)row * D + k) = xo; }
            const float4 ga = *(const float4*)(g1 + k), gb = *(const float4*)(g1 + k + 4);
            const float4 sha = *(const float4*)(m1 + k), shb = *(const float4*)(m1 + k + 4);
            const float4 sca = *(const float4*)(m1 + 1024 + k), scb = *(const float4*)(m1 + 1024 + k + 4);
            u32x4 o;
            o.x = cvtpk(xv[8 * i] * rstd * ga.x * (1.f + sca.x) + sha.x, xv[8 * i + 1] * rstd * ga.y * (1.f + sca.y) + sha.y);
            o.y = cvtpk(xv[8 * i + 2] * rstd * ga.z * (1.f + sca.z) + sha.z, xv[8 * i + 3] * rstd * ga.w * (1.f + sca.w) + sha.w);
            o.z = cvtpk(xv[8 * i + 4] * rstd * gb.x * (1.f + scb.x) + shb.x, xv[8 * i + 5] * rstd * gb.y * (1.f + scb.y) + shb.y);
            o.w = cvtpk(xv[8 * i + 6] * rstd * gb.z * (1.f + scb.z) + shb.z, xv[8 * i + 7] * rstd * gb.w * (1.f + scb.w) + shb.w);
            *(u32x4*)(p.H + (size_t)row * D + k) = o;
        }
    } else {
#pragma unroll
        for (int i = 0; i < 2; ++i) {
            const int k = lane * 8 + 512 * i;
            const float4 ga = *(const float4*)(p.g_final + k), gb = *(const float4*)(p.g_final + k + 4);
            float* op = p.out + (size_t)row * D + k;
            *(float4*)op = make_float4(xv[8 * i] * rstd * ga.x, xv[8 * i + 1] * rstd * ga.y, xv[8 * i + 2] * rstd * ga.z, xv[8 * i + 3] * rstd * ga.w);
            *(float4*)(op + 4) = make_float4(xv[8 * i + 4] * rstd * gb.x, xv[8 * i + 5] * rstd * gb.y, xv[8 * i + 6] * rstd * gb.z, xv[8 * i + 7] * rstd * gb.w);
        }
    }
}
__device__ __forceinline__ void ph_combine(const P& p, int l, int nrows, const int wv) {
    const int wave = ltid(wv) >> 6, lane = ltid(wv) & 63;
    for (int pr = blockIdx.x * 8 + wave; pr < nrows / 2; pr += gridDim.x * 8) {
        CombRow ca, cb;
        comb_load(ca, p.YB, p.X, p.tok_slot, p.topg, 2 * pr, lane);
        comb_load(cb, p.YB, p.X, p.tok_slot, p.topg, 2 * pr + 1, lane);
        comb_finish(p, ca, l, 2 * pr, lane);
        comb_finish(p, cb, l, 2 * pr + 1, lane);
    }
}
extern __shared__ __attribute__((aligned(16))) char smem[];
__global__ void __launch_bounds__(NT, 2) mega(P p) {
    char* lds = smem;
    int wv = __builtin_amdgcn_readfirstlane((int)(threadIdx.x >> 6)); asm volatile("" : "+s"(wv));
    if (threadIdx.x == 0) *(uint4*)(smem + LDS_MAIN) = make_uint4(0u, 0u, 0u, 0u);
    __syncthreads();
    XcdBarrier bar = xcd_barrier_post(p.bar, (volatile LAS unsigned*)(smem + LDS_MAIN), wv);
    ph_prologue(p, lds, 0, wv);
    xcd_barrier(bar);
    ph_norm1(p, 0, wv);
    ph_prologue(p, lds, 1, wv);
    xcd_barrier(bar);
#define MEGA_LAYER(l, nrows, LAST) do { \
        ph_gemm_proj(p, l, lds, wv); xcd_barrier(bar); \
        ph_dattn(p, l, nrows, lds, wv); ph_na(p, l, nrows, lds, wv); ph_pool(p, l, nrows, lds, wv); ph_sgu(p, l, nrows, lds, wv); xcd_barrier(bar); \
        ph_gemm_out(p, l, nrows, lds, wv); xcd_barrier(bar); \
        ph_router(p, l, nrows, lds, wv); xcd_barrier(bar); \
        ph_assign(p, l, nrows, lds, wv); xcd_barrier(bar); \
        ph_moe1(p, l, lds, wv); xcd_barrier(bar); \
        ph_moe2(p, l, lds, wv); xcd_barrier(bar); \
        ph_combine(p, l, nrows, wv); if (!(LAST)) xcd_barrier(bar); } while (0)
    MEGA_LAYER(0, R, false);
    MEGA_LAYER(1, T, true);
#undef MEGA_LAYER
}

static inline size_t align_up(size_t v, size_t a) { return (v + a - 1) / a * a; }

extern "C" void kernel_launch(void* const* d_in, const int* in_sizes, int n_in, void* d_out, int out_size, void* d_ws, size_t ws_size, hipStream_t stream) {
    P p{};
    const float** ins = (const float**)&p.x;
    for (int i = 0; i < 28; ++i) ins[i] = (const float*)d_in[i];
    p.out = (float*)d_out;
    char* w = (char*)d_ws; size_t off = 0;
    auto carve = [&](size_t bytes) { void* r = w + off; off = align_up(off + bytes, 256); return r; };
    const size_t ctl_bytes = XCD_BAR_WORDS * 4 + 2 * 64 * 4;
    p.bar = (unsigned*)carve(ctl_bytes);
    p.cnt = (int*)(p.bar + XCD_BAR_WORDS);
    p.mod = (float*)carve((size_t)2 * 5 * 6144 * 4);
    p.rope = (float*)carve(64 * 8 * 2 * 4);
    p.RG = (float*)carve((size_t)2 * 5 * 1024 * 4);
    p.RB = (float*)carve((size_t)2 * 5 * 32 * 4);
    p.X = (bf16_t*)carve((size_t)R * D * 2);
    p.H = (bf16_t*)carve((size_t)R * D * 2);
    p.PROJ = (bf16_t*)carve((size_t)R * PW * 2);
    p.MIX = (bf16_t*)carve((size_t)R * D * 2);
    p.WinT = (bf16_t*)carve((size_t)2 * PW * D * 2);
    p.WoutT = (bf16_t*)carve((size_t)2 * D * D * 2);
    p.WguT = (unsigned char*)carve((size_t)2 * NE * 2048 * D);
    p.WdnT = (unsigned char*)carve((size_t)2 * NE * D * FF);
    p.WpT = (bf16_t*)carve((size_t)2 * 4 * 64 * 64 * 2);
    p.WsB = (bf16_t*)carve((size_t)2 * 4 * 128 * 128 * 2);
    p.topi = (int*)carve((size_t)R * 4 * 4);
    p.topg = (float*)carve((size_t)R * 4 * 4);
    p.tok_slot = (int*)carve((size_t)R * 4 * 4);
    p.moe_meta = (int*)carve(2 * 512 * 4);
    p.HS = (unsigned char*)carve((size_t)R * D);
    p.slot_tok = (int*)carve((size_t)NSLOT * 4);
    p.ACT = (unsigned char*)carve((size_t)NSLOT * FF);
    p.YB = (bf16_t*)carve((size_t)NSLOT * D * 2);

    static int grid = 0;
    if (!grid) {
        int dev = 0, cus = 0, per_cu = 0;
        (void)hipGetDevice(&dev);
        (void)hipDeviceGetAttribute(&cus, hipDeviceAttributeMultiprocessorCount, dev);
        (void)hipFuncSetAttribute((const void*)mega, hipFuncAttributeMaxDynamicSharedMemorySize, LDS_BYTES);
        (void)hipOccupancyMaxActiveBlocksPerMultiprocessor(&per_cu, mega, NT, LDS_BYTES);
        grid = cus * (per_cu < 1 ? per_cu : 1);
        if (grid <= 0) { fprintf(stderr, "mega: occupancy query returned %d blocks per CU\n", per_cu); grid = 0; return; }
    }
    (void)hipMemsetAsync(p.bar, 0, ctl_bytes, stream);
    mega<<<grid, NT, LDS_BYTES, stream>>>(p);
}
```

```cpp
#include <hip/hip_runtime.h>
#include <stdint.h>
#include <cstdio>

typedef unsigned short bf16_t;
typedef short bf16x8 __attribute__((ext_vector_type(8)));
typedef float f32x4 __attribute__((ext_vector_type(4)));

constexpr int D = 1024, NB = 4, S = 4096, T = NB * S, CL = 256, TC = NB * CL, R = T + TC;
constexpr int PW = 2304, NE = 32, TOPK = 4, FF = 1024;
constexpr int MAXSLOT = R * TOPK;
constexpr int NSLOT = MAXSLOT + NE * 256;
constexpr float EPS = 1e-6f;
constexpr int NT = 512;
constexpr int LDS_MAIN = 150 * 1024;
constexpr int LDS_BYTES = LDS_MAIN + 1024;
constexpr int MT_TSTART = LDS_MAIN + 64, MT_ECNT = LDS_MAIN + 192, MT_TILE_E = LDS_MAIN + 320;
constexpr int ECAP = R;

__device__ __forceinline__ bf16_t f2bf(float f) { unsigned u = __float_as_uint(f); return (bf16_t)((u + 0x7fffu + ((u >> 16) & 1u)) >> 16); }
__device__ __forceinline__ float bf2f(bf16_t h) { return __uint_as_float(((unsigned)h) << 16); }
__device__ __forceinline__ float wave_sum(float v) {
#pragma unroll
    for (int o = 32; o >= 1; o >>= 1) v += __shfl_xor(v, o);
    return v;
}
__device__ __forceinline__ int mod_row(int row) { return row < T ? (row >> 12) : 4; }

#define XB_TMO      128
#define XB_XCNT(j)  (256  + 64 * (j))
#define XB_XSUB(j)  (1280 + 64 * (j))
#define XB_XGEN(j)  (2304 + 64 * (j))
#define XB_TOP      3328
#define XB_TOPGEN   3392
#define XCD_BAR_WORDS 3456
#define XB_SPIN_CAP (1u << 18)
#define LAS __attribute__((address_space(3)))

__device__ __forceinline__ unsigned xb_ld(unsigned* p)              { return __hip_atomic_load(p, __ATOMIC_RELAXED, __HIP_MEMORY_SCOPE_AGENT); }
__device__ __forceinline__ unsigned xb_add(unsigned* p, unsigned v) { return __hip_atomic_fetch_add(p, v, __ATOMIC_RELAXED, __HIP_MEMORY_SCOPE_AGENT); }
__device__ __forceinline__ unsigned xb_xcc_id() { return (unsigned)__builtin_amdgcn_s_getreg((3 << 11) | 20) & 0xFu; }
#define XB_SPIN(cond, bar) do { unsigned _sp = 0; while (cond) { __builtin_amdgcn_s_sleep(1); \
    if ((++_sp & 255u) == 0u) { if (xb_ld(&(bar)[XB_TMO])) break; if (_sp > XB_SPIN_CAP) { atomicAdd(&(bar)[XB_TMO], 1u); break; } } } } while (0)

struct XcdBarrier {
    unsigned* bar; unsigned x;
    volatile LAS unsigned* st;
    int wv;
};
__device__ __forceinline__ bool xb_t0(const int wv) { return wv == 0 && __builtin_amdgcn_mbcnt_hi(~0u, __builtin_amdgcn_mbcnt_lo(~0u, 0u)) == 0u; }
__device__ __forceinline__ XcdBarrier xcd_barrier_post(unsigned* bar, volatile LAS unsigned* st, const int wv) {
    XcdBarrier b; b.bar = bar; b.x = xb_xcc_id(); b.st = st; b.wv = wv;
    if (xb_t0(wv)) (void)xb_add(&bar[XB_XCNT(b.x)], 1u);
    return b;
}
__device__ __forceinline__ void xcd_barrier_complete(unsigned* bar, unsigned x, unsigned& nloc, unsigned& nx) {
    const unsigned G = gridDim.x * gridDim.y * gridDim.z;
    unsigned sum, cnt, mine, sp = 0u;
    for (;;) {
        sum = 0u; cnt = 0u; mine = 0u;
#pragma unroll
        for (unsigned j = 0; j < 16; ++j) { const unsigned c = xb_ld(&bar[XB_XCNT(j)]); sum += c; cnt += (c > 0u) ? 1u : 0u; mine = (j == x) ? c : mine; }
        if (sum == G) break;
        __builtin_amdgcn_s_sleep(1);
        if ((++sp & 255u) == 0u) { if (xb_ld(&bar[XB_TMO])) break; if (sp > XB_SPIN_CAP) { atomicAdd(&bar[XB_TMO], 1u); break; } }
    }
    nloc = mine > 0u ? mine : 1u; nx = cnt > 0u ? cnt : 1u;
}
__device__ __forceinline__ void xcd_barrier(const XcdBarrier& b) {
    asm volatile("s_waitcnt vmcnt(0)" ::: "memory");
    __syncthreads();
    if (xb_t0(b.wv)) {
        unsigned* bar = b.bar;
        __builtin_amdgcn_s_waitcnt(0);
        unsigned nloc = b.st[0], nx = b.st[1];
        if (nloc == 0u) { xcd_barrier_complete(bar, b.x, nloc, nx); b.st[0] = nloc; b.st[1] = nx; }
        const unsigned old = xb_add(&bar[XB_XSUB(b.x)], 1u);
        const unsigned gen = old / nloc;
        if (old + 1u == (gen + 1u) * nloc) {
            __builtin_amdgcn_fence(__ATOMIC_RELEASE, "agent");
            asm volatile("s_waitcnt vmcnt(0)" ::: "memory");
            const unsigned og = xb_add(&bar[XB_TOP], 1u);
            const unsigned tg = og / nx;
            if (og + 1u == (tg + 1u) * nx) xb_add(&bar[XB_TOPGEN], 1u);
            else XB_SPIN(xb_ld(&bar[XB_TOPGEN]) == tg, bar);
            __builtin_amdgcn_fence(__ATOMIC_ACQUIRE, "agent");
            xb_add(&bar[XB_XGEN(b.x)], 1u);
            asm volatile("s_waitcnt vmcnt(0)" ::: "memory");
        } else {
            XB_SPIN(xb_ld(&bar[XB_XGEN(b.x)]) == gen, bar);
            __builtin_amdgcn_fence(__ATOMIC_ACQUIRE, "agent");
            asm volatile("s_waitcnt vmcnt(0)" ::: "memory");
        }
    }
    __syncthreads();
}

struct P {
    const float *x, *c, *ctx, *c_ctx, *w_mod, *b_mod, *g_mix, *g_ffn, *w_in, *w_out, *lam_q1, *lam_k1, *lam_q2, *lam_k2, *g_sub,
        *w_pool, *s_pool, *g_sgu, *w_sgu, *b_sgu, *rpb, *w_router, *b_router, *w_gu, *b_gu, *w_down, *b_down, *g_final;
    float* out;
    unsigned* bar;
    int* cnt;
    float* mod;
    float* rope;
    float* RG;
    float* RB;
    bf16_t* X;
    bf16_t* H;
    bf16_t* PROJ;
    bf16_t* MIX;
    bf16_t* WinT;
    bf16_t* WoutT;
    unsigned char* WguT;
    unsigned char* WdnT;
    bf16_t* WpT;
    bf16_t* WsB;
    int* topi;
    float* topg;
    int* tok_slot;
    unsigned char* HS;
    int* slot_tok;
    unsigned char* ACT;
    bf16_t* YB;
};

extern __shared__ __attribute__((aligned(16))) char smem[];
__device__ __forceinline__ char* smem_base() { return smem; }
__device__ __forceinline__ int ltid(const int wv) { int t; asm volatile("v_mbcnt_lo_u32_b32 %0, -1, 0\n\tv_mbcnt_hi_u32_b32 %0, -1, %0\n\tv_lshl_or_b32 %0, %1, 6, %0" : "=&v"(t) : "s"(wv)); return t; }
typedef float f32x16 __attribute__((ext_vector_type(16)));
typedef short s16x4 __attribute__((ext_vector_type(4)));
typedef short v4i16_t __attribute__((ext_vector_type(4)));
typedef float f32x2_t __attribute__((ext_vector_type(2)));
typedef __bf16 bf16x2_t __attribute__((ext_vector_type(2)));
typedef __attribute__((address_space(3))) const char* lds_cptr;
typedef unsigned u32x4 __attribute__((ext_vector_type(4)));
__device__ __forceinline__ unsigned cvtpk(float lo, float hi) { f32x2_t v = {lo, hi}; bf16x2_t b = __builtin_convertvector(v, bf16x2_t); return __builtin_bit_cast(unsigned, b); }
__device__ __forceinline__ s16x4 vtr(lds_cptr q) { return __builtin_bit_cast(s16x4, __builtin_amdgcn_ds_read_tr16_b64_v4i16((__attribute__((address_space(3))) v4i16_t*)q)); }
__device__ __forceinline__ float xhalf_max(float v) { auto rr = __builtin_amdgcn_permlane32_swap(__float_as_uint(v), __float_as_uint(v), false, false); return fmaxf(__uint_as_float(rr[0]), __uint_as_float(rr[1])); }
__device__ __forceinline__ float xhalf_sum(float v) { auto rr = __builtin_amdgcn_permlane32_swap(__float_as_uint(v), __float_as_uint(v), false, false); return __uint_as_float(rr[0]) + __uint_as_float(rr[1]); }
namespace pg8 {
#define PG8_LAS __attribute__((address_space(3)))
constexpr int BM = 256, BK = 64, HALF = 128, HTB = HALF * BK * 2  , STAGE_BYTES = 8 * HTB, NXCD = 8, WGM = 8;
__host__ __device__ __forceinline__ int lds_byte(int r, int c) { const int st = (r >> 4) * 2 + (c >> 5), rr = r & 15, cc = c & 31, ob = rr * 64 + cc * 2; return st * 1024 + (ob ^ (((ob >> 9) & 1) << 5)); }
__host__ __device__ __forceinline__ void stage_rc(int b, int& R, int& C) { const int st = b / 1024, sb = b % 1024, swz = sb ^ (((sb >> 9) & 1) << 5); R = (st >> 1) * 16 + swz / 64; C = (st & 1) * 32 + (swz % 64) / 2; }
__host__ __device__ __forceinline__ int perm32(int rho) { const int n = rho >> 4, i = rho & 15; return 8 * (i >> 2) + 4 * n + (i & 3); }
struct Unit { int pm, pn, e; };
struct Gemm { const bf16_t* A; const bf16_t* Bt; int M, N, K; };
struct StaticOrder {
    int nM, nN, nwg, G, c;
    __host__ __device__ void init(int M, int N, int G_, int c_) { nM = M / BM; nN = N / BM; nwg = nM * nN; G = G_; c = c_; }
    __host__ __device__ bool next(int i, Unit& u) const {
        const long L = (long)i * G + c; if (L >= nwg) return false;
        int wgid = (int)L; { const int q = nwg / NXCD, r = nwg % NXCD, xcd = wgid % NXCD, off = wgid / NXCD; wgid = (xcd < r ? xcd * (q + 1) : r * (q + 1) + (xcd - r) * q) + off; }
        const int nig = WGM * nN, gid = wgid / nig, fm = gid * WGM, gsz = (nM - fm) < WGM ? (nM - fm) : WGM;
        u.pm = fm + ((wgid % nig) % gsz); u.pn = (wgid % nig) / gsz; u.e = 0; return true;
    }
    static constexpr bool GATHER = false;
    __device__ __forceinline__ const bf16_t* bt(const Gemm& g, const Unit&) const { return g.Bt; }
    __device__ __forceinline__ void a_ready(const Unit&) const {}
    __device__ __forceinline__ void done(const Unit&) const {}
};
typedef int v4i_t __attribute__((ext_vector_type(4)));
typedef int v8i_t __attribute__((ext_vector_type(8)));
__device__ __forceinline__ v8i_t cat8(bf16x8 a, bf16x8 b) { const v4i_t x = __builtin_bit_cast(v4i_t, a), y = __builtin_bit_cast(v4i_t, b); return __builtin_shufflevector(x, y, 0, 1, 2, 3, 4, 5, 6, 7); }
template <class Epi, class Sched, bool ALIGN_EPI = false, bool SP2 = false, bool F8 = false>
__device__ __forceinline__ void gemm_phase(PG8_LAS unsigned char* lds, const Gemm g, const Sched& S, const Epi& E, const int wv) {
    const int tid = ltid(wv), wid = __builtin_amdgcn_readfirstlane(tid >> 6), lane = tid & 63, wr = wid >> 2, wc = wid & 3, fr = lane & 15, fq = lane >> 4;
    const int K = g.K, nt = K / BK;
    unsigned voffA[2], voffB[2];
#pragma unroll
    for (int i = 0; i < 2; ++i) { int R, C; stage_rc(tid * 16 + i * 8192, R, C); const int Rb = Epi::WIDE ? ((R >> 5) * 64 + perm32(R & 31)) : Epi::PERM ? ((R & ~31) + perm32(R & 31)) : R;
        voffA[i] = (unsigned)(R * K + C) * 2u; voffB[i] = (unsigned)(Rb * K + C) * 2u; }
    int gR[2] = {0, 0}; unsigned gC[2] = {0u, 0u};
    PG8_LAS int* gtab = (PG8_LAS int*)(lds + STAGE_BYTES);
    if constexpr (Sched::GATHER) {
        static_assert(SP2, "gather is wired into the SP2 pipeline only");
#pragma unroll
        for (int i = 0; i < 2; ++i) { int R, C; stage_rc(tid * 16 + i * 8192, R, C); gR[i] = R; gC[i] = (unsigned)C * 2u; }
    }
#define PG8_GATHER(u_, sel_) do { if (tid < 256) gtab[(sel_) * 256 + tid] = S.tok((u_).pm * 256 + tid); } while (0)
    const size_t kstep = (size_t)(BK * 2);
    const size_t hstep = (size_t)HALF * K * 2;
    const size_t tstep = 2 * hstep;
    const size_t bstep = Epi::WIDE ? (size_t)32 * K * 2 : hstep;
    const unsigned ldsw = (unsigned)wid * 1024u;
    const int aoff = lds_byte(wr * 64 + fr, fq * 8), boff = lds_byte(wc * 32 + fr, fq * 8);
#define PG8_SA(b, h) (((b) * 2 + (h)) * HTB)
#define PG8_SB(b, h) ((4 + (b) * 2 + (h)) * HTB)
#define PG8_STAGE(bufoff, gbase, voff) do { _Pragma("unroll") for (int _i = 0; _i < 2; ++_i) \
        __builtin_amdgcn_global_load_lds((const unsigned*)((const char*)(gbase) + (voff)[_i]), (PG8_LAS unsigned*)(lds + (bufoff) + ldsw + _i * 8192), 16, 0, 0); } while (0)
#define PG8_STAGE_A(bufoff, gbase, h, nx) do { if constexpr (Sched::GATHER) { _Pragma("unroll") for (int _i = 0; _i < 2; ++_i) \
        __builtin_amdgcn_global_load_lds((const unsigned*)((const char*)(gbase) + ((unsigned)gtab[(((ui + ((nx) ? 1 : 0)) & 1)) * 256 + (h) * HALF + gR[_i]] * (unsigned)(K * 2) + gC[_i])), (PG8_LAS unsigned*)(lds + (bufoff) + ldsw + _i * 8192), 16, 0, 0); } \
        else { PG8_STAGE(bufoff, (gbase) + (h) * hstep, voffA); } } while (0)
#define PG8_LDA(dst, b, h) do { _Pragma("unroll") for (int m = 0; m < 4; ++m) _Pragma("unroll") for (int k = 0; k < 2; ++k) dst[m][k] = *(const PG8_LAS bf16x8*)(lds + PG8_SA(b, h) + aoff + m * 2048 + k * 1024); \
        if constexpr (F8) { _Pragma("unroll") for (int m = 0; m < 4; ++m) dst##8[m] = cat8(dst[m][0], dst[m][1]); } } while (0)
#define PG8_LDB(dst, b, h) do { _Pragma("unroll") for (int n = 0; n < 2; ++n) _Pragma("unroll") for (int k = 0; k < 2; ++k) dst[n][k] = *(const PG8_LAS bf16x8*)(lds + PG8_SB(b, h) + boff + n * 2048 + k * 1024); \
        if constexpr (F8) { _Pragma("unroll") for (int n = 0; n < 2; ++n) dst##8[n] = cat8(dst[n][0], dst[n][1]); } } while (0)
#define PG8_MMA(ai, bj, At, Bt) do { __builtin_amdgcn_s_setprio(1); \
        if constexpr (F8) { _Pragma("unroll") for (int m = 0; m < 4; ++m) _Pragma("unroll") for (int n = 0; n < 2; ++n) \
            asm volatile("v_mfma_scale_f32_16x16x128_f8f6f4 %0, %1, %2, %0, %3, %4 op_sel_hi:[0,0,0]" : "+v"(acc[ai][bj][m][n]) : "v"(Bt##8[n]), "v"(At##8[m]), "v"(sclW), "v"(sclX)); } \
        else { _Pragma("unroll") for (int m = 0; m < 4; ++m) _Pragma("unroll") for (int n = 0; n < 2; ++n) _Pragma("unroll") for (int k = 0; k < 2; ++k) \
            acc[ai][bj][m][n] = __builtin_amdgcn_mfma_f32_16x16x32_bf16(Bt[n][k], At[m][k], acc[ai][bj][m][n], 0, 0, 0); } \
        __builtin_amdgcn_s_setprio(0); } while (0)
#define PG8_WAIT_V(n) asm volatile("s_waitcnt vmcnt(" #n ")" ::: "memory")
#define PG8_WAIT_L(n) asm volatile("s_waitcnt lgkmcnt(" #n ")" ::: "memory")
#define PG8_BAR __builtin_amdgcn_s_barrier()
#define PG8_SCHED __builtin_amdgcn_sched_barrier(0)
    Unit cur, nxt; int ui = 0;
    typename Epi::Pre pre;
    if (!S.next(0, cur)) return;
    f32x4 acc[2][2][4][2];
#pragma unroll
    for (int a = 0; a < 2; ++a)
#pragma unroll
        for (int b = 0; b < 2; ++b)
#pragma unroll
            for (int m = 0; m < 4; ++m)
#pragma unroll
                for (int n = 0; n < 2; ++n) { acc[a][b][m][n] = (f32x4){0.f, 0.f, 0.f, 0.f}; }
    bf16x8 At[4][2], B0[2][2], B1[2][2];
    v8i_t At8[4], B08[2], B18[2];
    const int sclW = 0x79797979, sclX = 0x7f7f7f7f;
    const char* cA = (const char*)g.A + (Sched::GATHER ? (size_t)0 : (size_t)cur.pm * tstep); const char* cB = (const char*)S.bt(g, cur) + (size_t)cur.pn * tstep;
    if constexpr (Sched::GATHER) { PG8_GATHER(cur, 0); __syncthreads(); }
    S.a_ready(cur);
    if constexpr (SP2) {
        PG8_STAGE(PG8_SB(0, 0), cB, voffB); PG8_STAGE(PG8_SB(0, 1), cB + bstep, voffB); PG8_STAGE_A(PG8_SA(0, 0), cA, 0, false); PG8_STAGE_A(PG8_SA(0, 1), cA, 1, false);
        if (wr == 1) PG8_BAR;
        PG8_WAIT_V(2); PG8_BAR;
        PG8_STAGE(PG8_SB(1, 0), cB + kstep, voffB); PG8_STAGE_A(PG8_SA(1, 0), cA + kstep, 0, false); PG8_STAGE(PG8_SB(1, 1), cB + bstep + kstep, voffB);
        PG8_WAIT_V(6); PG8_BAR;
    } else {
        PG8_STAGE(PG8_SB(0, 0), cB, voffB); PG8_STAGE(PG8_SA(0, 0), cA, voffA); PG8_STAGE(PG8_SB(0, 1), cB + bstep, voffB); PG8_STAGE(PG8_SA(0, 1), cA + hstep, voffA);
        if (wr == 1) PG8_BAR;
        PG8_WAIT_V(4); PG8_BAR;
        PG8_STAGE(PG8_SB(1, 0), cB + kstep, voffB); PG8_STAGE(PG8_SA(1, 0), cA + kstep, voffA); PG8_STAGE(PG8_SB(1, 1), cB + bstep + kstep, voffB);
        PG8_WAIT_V(6); PG8_BAR;
    }
    for (;;) {
        const bool has_next = S.next(ui + 1, nxt);
        const char* nA = Sched::GATHER ? cA : (has_next ? (const char*)g.A + (size_t)nxt.pm * tstep : cA); const char* nB = has_next ? (const char*)S.bt(g, nxt) + (size_t)nxt.pn * tstep : cB;
        if constexpr (Sched::GATHER) { if (has_next) PG8_GATHER(nxt, (ui + 1) & 1); else if (tid < 256) gtab[((ui + 1) & 1) * 256 + tid] = gtab[(ui & 1) * 256 + tid]; }
        E.prefetch(pre, cur, wr, wc, fr, fq);
#pragma unroll 1
        for (int t = 0; t < nt; t += 2) {
            const bool last = (t == nt - 2);
            const char* a1 = cA + (size_t)(t + 1) * kstep;
            const char* a2 = last ? nA : cA + (size_t)(t + 2) * kstep; const char* b2 = last ? nB : cB + (size_t)(t + 2) * kstep;
            const char* a3 = a2 + kstep; const char* b3 = b2 + kstep;
            if (last && has_next) S.a_ready(nxt);
            if constexpr (SP2) {
            PG8_LDB(B0, 0, 0); PG8_LDB(B1, 0, 1); PG8_SCHED; PG8_LDA(At, 0, 0); PG8_STAGE_A(PG8_SA(1, 1), a1, 1, false);
            PG8_WAIT_V(8); PG8_WAIT_L(0); PG8_BAR; PG8_MMA(0, 0, At, B0); PG8_MMA(0, 1, At, B1); PG8_BAR; PG8_SCHED;
            PG8_LDA(At, 0, 1); PG8_STAGE(PG8_SB(0, 0), b2, voffB); PG8_STAGE(PG8_SB(0, 1), b2 + bstep, voffB); PG8_STAGE_A(PG8_SA(0, 0), a2, 0, last);
            PG8_WAIT_V(8); PG8_WAIT_L(0); PG8_BAR; PG8_MMA(1, 0, At, B0); PG8_MMA(1, 1, At, B1); PG8_BAR; PG8_SCHED;
            PG8_LDB(B0, 1, 0); PG8_LDB(B1, 1, 1); PG8_SCHED; PG8_LDA(At, 1, 0); PG8_STAGE_A(PG8_SA(0, 1), a2, 1, last);
            PG8_WAIT_V(8); PG8_WAIT_L(0); PG8_BAR; PG8_MMA(0, 0, At, B0); PG8_MMA(0, 1, At, B1); PG8_BAR; PG8_SCHED;
            PG8_LDA(At, 1, 1); PG8_STAGE(PG8_SB(1, 0), b3, voffB); PG8_STAGE(PG8_SB(1, 1), b3 + bstep, voffB); PG8_STAGE_A(PG8_SA(1, 0), a3, 0, last);
            PG8_WAIT_V(8); PG8_WAIT_L(0); PG8_BAR; PG8_MMA(1, 0, At, B0); PG8_MMA(1, 1, At, B1); PG8_BAR; PG8_SCHED;
            } else {
            PG8_LDB(B0, 0, 0); PG8_SCHED; PG8_LDA(At, 0, 0); PG8_STAGE(PG8_SA(1, 1), a1 + hstep, voffA);
            PG8_WAIT_L(8); PG8_BAR; PG8_WAIT_L(0); PG8_MMA(0, 0, At, B0); PG8_BAR; PG8_SCHED;
            PG8_LDB(B1, 0, 1); PG8_STAGE(PG8_SB(0, 0), b2, voffB);
            PG8_BAR; PG8_WAIT_L(0); PG8_MMA(0, 1, At, B1); PG8_BAR;
            PG8_LDA(At, 0, 1); PG8_STAGE(PG8_SA(0, 0), a2, voffA);
            PG8_BAR; PG8_WAIT_L(0); PG8_MMA(1, 0, At, B0); PG8_BAR; PG8_SCHED;
            PG8_STAGE(PG8_SB(0, 1), b2 + bstep, voffB);
            PG8_WAIT_V(6); PG8_BAR; PG8_MMA(1, 1, At, B1); PG8_BAR;
            PG8_LDB(B0, 1, 0); PG8_SCHED; PG8_LDA(At, 1, 0); PG8_STAGE(PG8_SA(0, 1), a2 + hstep, voffA);
            PG8_WAIT_L(8); PG8_BAR; PG8_WAIT_L(0); PG8_MMA(0, 0, At, B0); PG8_BAR; PG8_SCHED;
            PG8_LDB(B1, 1, 1); PG8_STAGE(PG8_SB(1, 0), b3, voffB);
            PG8_BAR; PG8_WAIT_L(0); PG8_MMA(0, 1, At, B1); PG8_BAR;
            PG8_LDA(At, 1, 1); PG8_STAGE(PG8_SA(1, 0), a3, voffA);
            PG8_BAR; PG8_WAIT_L(0); PG8_MMA(1, 0, At, B0); PG8_BAR; PG8_SCHED;
            PG8_STAGE(PG8_SB(1, 1), b3 + bstep, voffB);
            PG8_WAIT_V(6); PG8_BAR; PG8_MMA(1, 1, At, B1); PG8_BAR;
            }
        }
        if constexpr (ALIGN_EPI) { if (wr == 0) PG8_BAR; }
        if constexpr (F8) asm volatile("s_nop 15\n\ts_nop 15" ::: "memory");
        if constexpr (!Epi::AFTER_DRAIN) { E(acc, cur, wr, wc, fr, fq, pre); S.done(cur); }
        if (!has_next) break;
#pragma unroll
        for (int a = 0; a < 2; ++a)
#pragma unroll
            for (int b = 0; b < 2; ++b)
#pragma unroll
                for (int m = 0; m < 4; ++m)
#pragma unroll
                    for (int n = 0; n < 2; ++n) { acc[a][b][m][n] = (f32x4){0.f, 0.f, 0.f, 0.f}; }
        cur = nxt; cA = nA; cB = nB; ++ui;
        if constexpr (ALIGN_EPI) { if (wr == 1) PG8_BAR; }
    }
    PG8_WAIT_V(0);
    if constexpr (!ALIGN_EPI) { if (wr == 0) PG8_BAR; }
    PG8_BAR;
    if constexpr (Epi::AFTER_DRAIN) { E.fused(acc, cur, wr, wc, fr, fq, lds, wid, lane); S.done(cur); }
#undef PG8_SA
#undef PG8_SB
#undef PG8_STAGE
#undef PG8_STAGE_A
#undef PG8_GATHER
#undef PG8_LDA
#undef PG8_LDB
#undef PG8_MMA
#undef PG8_WAIT_V
#undef PG8_WAIT_L
#undef PG8_BAR
#undef PG8_SCHED
}
}

__device__ __forceinline__ void ph_prologue(const P& p, char* lds, const int part, const int wv) {
    const int tid = ltid(wv);
    float* fl = (float*)lds;
    if (part == 0) {
    for (int it = blockIdx.x; it < 192; it += gridDim.x) {
        const int l = it / 96, cg = it % 96;
        float* sc = fl;
        float* part = fl + 5 * 1024;
        __syncthreads();
        for (int i = tid; i < 5 * 1024; i += NT) {
            const int r = i >> 10, k = i & 1023;
            const float v = r < 4 ? p.c[r * 1024 + k] : p.c_ctx[k];
            sc[i] = v / (1.f + __expf(-v));
        }
        __syncthreads();
        const int kq = tid >> 6, col = tid & 63, j = cg * 64 + col;
        const float* W = p.w_mod + (size_t)l * 1024 * 6144 + j;
        float a0 = 0, a1 = 0, a2 = 0, a3 = 0, a4 = 0;
#pragma unroll 16
        for (int k = kq * 128; k < kq * 128 + 128; ++k) {
            const float w = W[(size_t)k * 6144];
            a0 += sc[k] * w; a1 += sc[1024 + k] * w; a2 += sc[2048 + k] * w; a3 += sc[3072 + k] * w; a4 += sc[4096 + k] * w;
        }
        part[(kq * 5 + 0) * 64 + col] = a0; part[(kq * 5 + 1) * 64 + col] = a1; part[(kq * 5 + 2) * 64 + col] = a2;
        part[(kq * 5 + 3) * 64 + col] = a3; part[(kq * 5 + 4) * 64 + col] = a4;
        __syncthreads();
        if (tid < 5 * 64) {
            const int r = tid >> 6, cc = tid & 63, jj = cg * 64 + cc;
            float v = 0.f;
#pragma unroll
            for (int q = 0; q < 8; ++q) v += part[(q * 5 + r) * 64 + cc];
            p.mod[((size_t)l * 5 + r) * 6144 + jj] = v + p.b_mod[l * 6144 + jj];
        }
    }
    if (blockIdx.x == gridDim.x - 1) {
        const int pos = tid >> 3, f = tid & 7;
        const float inv = powf(10000.0f, -(float)f / 8.0f);
        const float ang = (float)pos * inv;
        p.rope[tid * 2] = cosf(ang); p.rope[tid * 2 + 1] = sinf(ang);
    }
    for (int i = blockIdx.x * NT + tid; i < 2 * 4 * 64 * 64; i += gridDim.x * NT) { const int ii = i & 63, j = (i >> 6) & 63, lg = i >> 12; p.WpT[i] = f2bf(p.w_pool[(size_t)lg * 4096 + ii * 64 + j]); }
    for (int i = blockIdx.x * NT + tid; i < 2 * 4 * 128 * 128; i += gridDim.x * NT) p.WsB[i] = f2bf(p.w_sgu[i]);
    }
    if (part == 1) {
        for (int i = blockIdx.x * NT + tid; i < 2 * 5 * 1024; i += gridDim.x * NT) { const int k = i & 1023, lb = i >> 10, l_ = lb / 5; p.RG[i] = p.g_ffn[l_ * D + k] * (1.f + p.mod[(size_t)lb * 6144 + 4 * 1024 + k]); }
        for (int o = blockIdx.x * 8 + (tid >> 6); o < 2 * 5 * 32; o += gridDim.x * 8) {
            const int e = o & 31, lb = o >> 5, l_ = lb / 5, ln = tid & 63;
            const float* sh = p.mod + (size_t)lb * 6144 + 3 * 1024; const float* wr = p.w_router + (size_t)l_ * D * NE + e;
            float a = 0.f;
            for (int k = ln; k < 1024; k += 64) a += sh[k] * wr[(size_t)k * NE];
            a = wave_sum(a);
            if (ln == 0) p.RB[o] = a + p.b_router[l_ * NE + e];
        }
        const int n_in = 2 * 9 * 16, n_out = 2 * 4 * 16, total = n_in + n_out;
        const int kr = tid >> 6, n4 = tid & 63, kg = tid & 7, nl = tid >> 3;
        for (int it = blockIdx.x; it < total; it += gridDim.x) {
            int i_ = it; const float* W_; bf16_t* Wt_; int N, K;
            if (i_ < n_in) { W_ = p.w_in; Wt_ = p.WinT; N = PW; K = D; } else { i_ -= n_in; W_ = p.w_out; Wt_ = p.WoutT; N = D; K = D; }
            const int ntn = N / 256, per = ntn * (K / 64), m_ = i_ / per, r_ = i_ % per, tn = r_ % ntn, tk = r_ / ntn, n0 = tn * 256;
            const float* src = W_ + (size_t)m_ * K * N + (size_t)(tk * 64) * N + n0; bf16_t* dst = Wt_ + (size_t)m_ * K * N + tk * 64;
            float4 rg[8];
#pragma unroll
            for (int i = 0; i < 8; ++i) rg[i] = *(const float4*)(src + (size_t)(kr + 8 * i) * N + n4 * 4);
            __syncthreads();
#pragma unroll
            for (int i = 0; i < 8; ++i) { float* q = fl + (kr + 8 * i) * 257 + n4 * 4; q[0] = rg[i].x; q[1] = rg[i].y; q[2] = rg[i].z; q[3] = rg[i].w; }
            __syncthreads();
#pragma unroll
            for (int j = 0; j < 4; ++j) {
                const int n = nl + 64 * j;
                const float* q = fl + (8 * kg) * 257 + n;
                u32x4 w;
                w.x = cvtpk(q[0], q[257]); w.y = cvtpk(q[2 * 257], q[3 * 257]); w.z = cvtpk(q[4 * 257], q[5 * 257]); w.w = cvtpk(q[6 * 257], q[7 * 257]);
                *(u32x4*)(dst + (size_t)(n0 + n) * K + 8 * kg) = w;
            }
        }
    }
}

__device__ __forceinline__ void ph_norm1(const P& p, int l, const int wv) {
    const int wave = ltid(wv) >> 6, lane = ltid(wv) & 63;
    for (int row = blockIdx.x * 8 + wave; row < R; row += gridDim.x * 8) {
        const float* xr = row < T ? p.x + (size_t)row * D : p.ctx + (size_t)(row - T) * D;
        float4 v[4]; float ss = 0;
#pragma unroll
        for (int i = 0; i < 4; ++i) { v[i] = *(const float4*)(xr + lane * 4 + 256 * i); ss += v[i].x * v[i].x + v[i].y * v[i].y + v[i].z * v[i].z + v[i].w * v[i].w; }
        ss = wave_sum(ss);
        const float rstd = rsqrtf(ss * (1.f / D) + EPS);
        const float* m = p.mod + ((size_t)l * 5 + mod_row(row)) * 6144;
        const float* g = p.g_mix + l * D;
#pragma unroll
        for (int i = 0; i < 4; ++i) {
            const int k = lane * 4 + 256 * i;
            const float4 gg = *(const float4*)(g + k), sh = *(const float4*)(m + k), sc = *(const float4*)(m + 1024 + k);
            uint2 o;
            o.x = cvtpk(v[i].x * rstd * gg.x * (1.f + sc.x) + sh.x, v[i].y * rstd * gg.y * (1.f + sc.y) + sh.y);
            o.y = cvtpk(v[i].z * rstd * gg.z * (1.f + sc.z) + sh.z, v[i].w * rstd * gg.w * (1.f + sc.w) + sh.w);
            *(uint2*)(p.H + (size_t)row * D + k) = o;
        }
    }
}

constexpr float QSCALE = 0.17677669529663687f * 1.4426950408889634f;
__device__ __forceinline__ void dsoftmax(const f32x16& s, float& m, float& l, f32x16& o0, f32x16& o1, bf16x8& pa, bf16x8& pb) {
    float mx = fmaxf(fmaxf(fmaxf(s[0], s[1]), fmaxf(s[2], s[3])), fmaxf(fmaxf(s[4], s[5]), fmaxf(s[6], s[7])));
    mx = fmaxf(mx, fmaxf(fmaxf(fmaxf(s[8], s[9]), fmaxf(s[10], s[11])), fmaxf(fmaxf(s[12], s[13]), fmaxf(s[14], s[15]))));
    mx = xhalf_max(mx);
    if (__any(mx > m)) {
        const float mn = fmaxf(m, mx), alpha = __builtin_amdgcn_exp2f(m - mn);
        o0 *= alpha; o1 *= alpha; l *= alpha; m = mn;
    }
    float pr[16]; float sum = 0.f;
#pragma unroll
    for (int r = 0; r < 16; ++r) { pr[r] = __builtin_amdgcn_exp2f(s[r] - m); sum += pr[r]; }
    l += sum;
    u32x4 a, b;
    a[0] = cvtpk(pr[0], pr[1]); a[1] = cvtpk(pr[2], pr[3]); a[2] = cvtpk(pr[4], pr[5]); a[3] = cvtpk(pr[6], pr[7]);
    b[0] = cvtpk(pr[8], pr[9]); b[1] = cvtpk(pr[10], pr[11]); b[2] = cvtpk(pr[12], pr[13]); b[3] = cvtpk(pr[14], pr[15]);
    pa = __builtin_bit_cast(bf16x8, a); pb = __builtin_bit_cast(bf16x8, b);
}
#define MX3(a, b, c) __builtin_fmaxf(__builtin_fmaxf((a), (b)), (c))
template <int THR>
__device__ __forceinline__ void dsoftmax2(f32x16& s, float& m, float& l, f32x16& o0, f32x16& o1, bf16x8& pa, bf16x8& pb, const bool first) {
    float a = MX3(s[0], s[1], s[2]), b = MX3(s[3], s[4], s[5]);
    a = MX3(a, s[6], s[7]); b = MX3(b, s[8], s[9]); a = MX3(a, s[10], s[11]); b = MX3(b, s[12], s[13]); a = MX3(a, s[14], s[15]);
    const float mx = xhalf_max(__builtin_fmaxf(a, b));
    if (first || __any(mx > m + (float)THR)) {
        const float mn = first ? mx : __builtin_fmaxf(mx, m), alpha = first ? 1.f : __builtin_amdgcn_exp2f(m - mn);
        m = mn; o0 *= alpha; o1 *= alpha; l *= alpha;
    }
    float sum = 0.f;
#pragma unroll
    for (int r = 0; r < 16; ++r) { s[r] = __builtin_amdgcn_exp2f(s[r] - m); sum += s[r]; }
    l += sum;
    u32x4 wa, wb;
    wa[0] = cvtpk(s[0], s[1]); wa[1] = cvtpk(s[2], s[3]); wa[2] = cvtpk(s[4], s[5]); wa[3] = cvtpk(s[6], s[7]);
    wb[0] = cvtpk(s[8], s[9]); wb[1] = cvtpk(s[10], s[11]); wb[2] = cvtpk(s[12], s[13]); wb[3] = cvtpk(s[14], s[15]);
    pa = __builtin_bit_cast(bf16x8, wa); pb = __builtin_bit_cast(bf16x8, wb);
}
template <int THR>
__device__ __forceinline__ void dsoftmax3(f32x16& s, float& m, f32x16& negm, float& l, f32x16& o0, f32x16& o1, bf16x8& pa, bf16x8& pb, const bool first) {
    float a = MX3(s[0], s[1], s[2]), b = MX3(s[3], s[4], s[5]);
    a = MX3(a, s[6], s[7]); b = MX3(b, s[8], s[9]); a = MX3(a, s[10], s[11]); b = MX3(b, s[12], s[13]); a = MX3(a, s[14], s[15]);
    const float mx = xhalf_max(__builtin_fmaxf(a, b));
    if (first || __any(mx > (float)THR)) {
        const float d = first ? mx : __builtin_fmaxf(mx, 0.f), alpha = first ? 1.f : __builtin_amdgcn_exp2f(-d);
        m += d; o0 *= alpha; o1 *= alpha; l *= alpha;
#pragma unroll
        for (int r = 0; r < 16; ++r) { s[r] -= d; negm[r] = -m; }
    }
    float sum = 0.f;
#pragma unroll
    for (int r = 0; r < 16; ++r) { s[r] = __builtin_amdgcn_exp2f(s[r]); sum += s[r]; }
    l += sum;
    u32x4 wa, wb;
    wa[0] = cvtpk(s[0], s[1]); wa[1] = cvtpk(s[2], s[3]); wa[2] = cvtpk(s[4], s[5]); wa[3] = cvtpk(s[6], s[7]);
    wb[0] = cvtpk(s[8], s[9]); wb[1] = cvtpk(s[10], s[11]); wb[2] = cvtpk(s[12], s[13]); wb[3] = cvtpk(s[14], s[15]);
    pa = __builtin_bit_cast(bf16x8, wa); pb = __builtin_bit_cast(bf16x8, wb);
}
typedef __attribute__((address_space(1))) const float* gcf32_t;
typedef __attribute__((address_space(1))) unsigned char* gu8_t;
typedef __attribute__((address_space(1))) const char* gcc_t;
typedef short v2i16_t __attribute__((ext_vector_type(2)));
struct CvT { gcc_t src; gu8_t dst; int n4; };
struct CvW { gcf32_t gu, dn; gu8_t guT, dnT; int b0, G; };
__device__ __forceinline__ void glds16x2(gcc_t sbase, unsigned voff0, unsigned voff1, unsigned lds_dst) { unsigned keep;
    asm volatile("s_mov_b32 %0, m0\n\ts_mov_b32 m0, %4\n\ts_nop 0\n\tglobal_load_lds_dwordx4 %1, %3\n\ts_add_u32 m0, m0, 0x2000\n\ts_nop 0\n\tglobal_load_lds_dwordx4 %2, %3\n\ts_mov_b32 m0, %0"
                 : "=&s"(keep) : "v"(voff0), "v"(voff1), "s"(sbase), "s"(lds_dst) : "memory", "scc"); }
__device__ __forceinline__ void glds16x4(gcc_t sbase, unsigned voff, unsigned vstride, unsigned lds_dst) { unsigned keep;
    asm volatile("s_mov_b32 %0, m0\n\ts_mov_b32 m0, %4\n\ts_nop 0\n\tglobal_load_lds_dwordx4 %1, %3 nt\n\t"
                 "s_add_u32 m0, m0, 0x400\n\tv_add_u32 %1, %2, %1\n\tglobal_load_lds_dwordx4 %1, %3 nt\n\t"
                 "s_add_u32 m0, m0, 0x400\n\tv_add_u32 %1, %2, %1\n\tglobal_load_lds_dwordx4 %1, %3 nt\n\t"
                 "s_add_u32 m0, m0, 0x400\n\tv_add_u32 %1, %2, %1\n\tglobal_load_lds_dwordx4 %1, %3 nt\n\ts_mov_b32 m0, %0"
                 : "=&s"(keep), "+v"(voff) : "s"(vstride), "s"(sbase), "s"(lds_dst) : "memory", "scc"); }
#if defined(__HIP_DEVICE_COMPILE__)
#define KARG_PTR(T_, member) ({ unsigned long long r_; asm volatile("s_load_dwordx2 %0, %1, %2\n\ts_waitcnt lgkmcnt(0)" : "=s"(r_) : "s"(__builtin_amdgcn_kernarg_segment_ptr()), "n"((int)__builtin_offsetof(P, member)) : "memory"); (T_)r_; })
#else
#define KARG_PTR(T_, member) ((T_)(unsigned long long)p.member)
#endif
__device__ __forceinline__ bool cv_pair(const CvW& w, int q, CvT& c) {
    constexpr int n_gu = NE * 8 * 16, n_dn = NE * 8 * 8;
    const int tile = w.b0 + q * w.G;
    if (tile >= n_gu + n_dn) return false;
    if (tile < n_gu) {
        const int e = tile >> 7, tn = tile & 15, tk = (tile >> 4) & 7, np0 = (tn & 7) * 256 + (tn >> 3) * 128;
        c.n4 = 2048 * 4;
        c.src = (gcc_t)(w.gu + ((size_t)e * 1024 + tk * 128) * 2048 + tn * 128);
        c.dst = w.guT + ((size_t)e * 2048 + np0) * 1024 + tk * 128;
    } else {
        const int i_ = tile - n_gu, e = i_ >> 6, tn = i_ & 7, tk = (i_ >> 3) & 7;
        c.n4 = 1024 * 4;
        c.src = (gcc_t)(w.dn + ((size_t)e * 1024 + tk * 128) * 1024 + tn * 128);
        c.dst = w.dnT + ((size_t)e * 1024 + tn * 128) * 1024 + tk * 128;
    }
    return true;
}
__device__ __forceinline__ void cv_store(gu8_t dst, const char* q0, const unsigned goff) {
    const float* q = (const float*)q0;
    u32x4 w;
#pragma unroll
    for (int d = 0; d < 4; ++d) {
        v2i16_t r = {0, 0};
        r = __builtin_amdgcn_cvt_scalef32_pk_fp8_f32(r, q[(2 * d) * 256], q[(2 * d) * 256 + 128], 0.015625f, false);
        r = __builtin_amdgcn_cvt_scalef32_pk_fp8_f32(r, q[(2 * d + 1) * 256], q[(2 * d + 1) * 256 + 128], 0.015625f, true);
        w[d] = __builtin_bit_cast(unsigned, r);
    }
    __builtin_nontemporal_store(w, (__attribute__((address_space(1))) u32x4*)(dst + goff));
}
constexpr int CV_LDS = 32768;
__device__ __forceinline__ void ph_dattn(const P& p, int l, int nrows, char* lds, const int wv) {
    const int tid = ltid(wv), lane = tid & 63, wid = wv, r32 = lane & 31, hi = lane >> 5;
    float la = lane < 32 ? p.lam_q1[l * 32 + lane] * p.lam_k1[l * 32 + lane] : 0.f;
    float lb = lane < 32 ? p.lam_q2[l * 32 + lane] * p.lam_k2[l * 32 + lane] : 0.f;
    la = wave_sum(la); lb = wave_sum(lb);
    const float lam_init = 0.8f - 0.6f * expf(-0.3f * (float)l);
    const float lam = expf(la) - expf(lb) + lam_init;
    const bf16_t* PR = p.PROJ;
    const int nunits = (nrows == R) ? 256 + 16 : 256;
    const int vkey = (2 * (wid & 3) + (lane >> 5)) * 8 + ((lane >> 2) & 7), vchunk = (wid >> 2) * 4 + (lane & 3);
    const int vb = ((lane >> 4) & 1) * 32 + (lane & 3) * 8 + (4 * hi + ((lane & 15) >> 2)) * 64;
    const unsigned lds0 = (unsigned)(uintptr_t)lds;
    CvW cw; cw.gu = KARG_PTR(gcf32_t, w_gu) + (size_t)l * NE * 1024 * 2048; cw.guT = KARG_PTR(gu8_t, WguT) + (size_t)l * NE * 2048 * 1024;
    cw.dn = KARG_PTR(gcf32_t, w_down) + (size_t)l * NE * 1024 * 1024; cw.dnT = KARG_PTR(gu8_t, WdnT) + (size_t)l * NE * 1024 * 1024;
    { int b0 = blockIdx.x, G = gridDim.x; asm volatile("" : "+s"(b0), "+s"(G)); cw.b0 = b0; cw.G = G; }
    const unsigned cv_row = 8 * wid + (lane >> 5), cv_sw = (unsigned)(((lane & 31) ^ (((wid >> 1) & 1) << 2)) * 16);
    const int cv_n = 16 * wid + (lane >> 2), cv_kg = lane & 3;
    const int cv_lo = cv_kg * 8192 + (((cv_n >> 2) ^ ((cv_kg & 1) << 2)) * 16) + (cv_n & 3) * 4;
    const unsigned cv_go = (unsigned)(cv_n * 1024 + 16 * cv_kg);
    int cj = 0, cb = 0, ca = 0;
    CvT cp; bool cpok = false;
    gu8_t dstA = nullptr; bool hasA = false;
#define CV_NEXT(hasB_, dstB_) do { \
        if ((cj & 1) == 0) cpok = cv_pair(cw, cj >> 1, cp); else { cp.src += 64 * cp.n4; cp.dst += 64; } \
        hasB_ = cpok; dstB_ = cp.dst; \
        if (cpok) glds16x4(cp.src, cv_row * (unsigned)cp.n4 + cv_sw, 2u * (unsigned)cp.n4, lds0 + CV_LDS + cb * 32768 + wid * 4096); } while (0)
    for (int uu = blockIdx.x; uu < nunits; uu += gridDim.x) {
        int b, h, q0, nt; bool isctx;
        if (uu < 256) { const int u = (uu & 7) * 32 + (uu >> 3); b = u >> 6; h = (u >> 4) & 3; q0 = b * 4096 + (u & 15) * 256; nt = 68; isctx = false; }
        else { const int v = uu - 256; b = v >> 2; h = v & 3; q0 = T + b * 256; nt = 4; isctx = true; }
        const unsigned gKo = (unsigned)(256 + h * 64 + wid * 8 + lane * PW) * 2u;
        const unsigned gVo = (unsigned)(512 + h * 64 + vchunk * 8 + vkey * PW) * 2u;
#define DA_ROW0(t_) ((isctx || (t_) >= 64) ? T + b * 256 + (isctx ? (t_) : (t_) - 64) * 64 : b * 4096 + (t_) * 64)
#define DA_DMA_KV(t_) glds16x2((gcc_t)PR + (size_t)DA_ROW0(t_) * (PW * 2), gKo, gVo, lds0 + ((t_) & 1) * 16384 + wid * 1024)
        __syncthreads();
        DA_DMA_KV(0);
        bf16x8 qf[4];
        {
            const bf16_t* qp = PR + (size_t)(q0 + wid * 32 + r32) * PW + h * 64 + hi * 8;
#pragma unroll
            for (int ks = 0; ks < 4; ++ks) qf[ks] = *(const bf16x8*)(qp + ks * 16);
        }
        f32x16 O00, O01, O10, O11, nm1, zero16;
#pragma unroll
        for (int r = 0; r < 16; ++r) { O00[r] = 0.f; O01[r] = 0.f; O10[r] = 0.f; O11[r] = 0.f; nm1[r] = 0.f; zero16[r] = 0.f; }
        float m1 = 0.f, m2 = 0.f, l1 = 0.f, l2 = 0.f;
        asm volatile("" :: "v"(qf[0]), "v"(qf[1]), "v"(qf[2]), "v"(qf[3]));
        asm volatile("s_waitcnt vmcnt(0)" ::: "memory"); __builtin_amdgcn_s_barrier(); asm volatile("" ::: "memory");
#pragma unroll 1
        for (int t = 0; t < nt; ++t) {
            char* buf = lds + (t & 1) * 16384;
            if (t + 1 < nt) DA_DMA_KV(t + 1);
            bool hasB; gu8_t dstB;
            CV_NEXT(hasB, dstB);
            {
                typedef const __attribute__((address_space(3))) bf16x8* kfp_t;
                const lds_cptr kp = (lds_cptr)buf + hi * 1024 + r32 * 16;
                const lds_cptr vp = (lds_cptr)buf + 8192 + vb;
                bf16x8 kf0 = *(kfp_t)(kp), kf1 = *(kfp_t)(kp + 2048), kf2 = *(kfp_t)(kp + 4096), kf3 = *(kfp_t)(kp + 6144);
#pragma unroll
                for (int kb = 0; kb < 2; ++kb) {
                    f32x16 s1 = __builtin_amdgcn_mfma_f32_32x32x16_bf16(kf0, qf[0], nm1, 0, 0, 0);
                    f32x16 s2 = __builtin_amdgcn_mfma_f32_32x32x16_bf16(kf2, qf[2], zero16, 0, 0, 0);
                    s1 = __builtin_amdgcn_mfma_f32_32x32x16_bf16(kf1, qf[1], s1, 0, 0, 0);
                    s2 = __builtin_amdgcn_mfma_f32_32x32x16_bf16(kf3, qf[3], s2, 0, 0, 0);
                    s16x4 vlo[4], vhi[4];
#pragma unroll
                    for (int i = 0; i < 4; ++i) { vlo[i] = vtr(vp + kb * 2048 + (i >> 1) * 4096 + (i & 1) * 1024); vhi[i] = vtr(vp + kb * 2048 + (i >> 1) * 4096 + (i & 1) * 1024 + 512); }
                    __builtin_amdgcn_sched_barrier(0);
                    const bool first = (t == 0) && (kb == 0);
                    bf16x8 p1a, p1b, p2a, p2b;
                    dsoftmax3<8>(s1, m1, nm1, l1, O00, O01, p1a, p1b, first);
                    dsoftmax2<8>(s2, m2, l2, O10, O11, p2a, p2b, first);
                    if (kb == 0) { kf0 = *(kfp_t)(kp + 512); kf1 = *(kfp_t)(kp + 512 + 2048); kf2 = *(kfp_t)(kp + 512 + 4096); kf3 = *(kfp_t)(kp + 512 + 6144); }
#pragma unroll
                    for (int i = 0; i < 4; ++i) {
                        const bf16x8 va = (bf16x8){vlo[i][0], vlo[i][1], vlo[i][2], vlo[i][3], vhi[i][0], vhi[i][1], vhi[i][2], vhi[i][3]};
                        if (i < 2) { O00 = __builtin_amdgcn_mfma_f32_32x32x16_bf16(va, (i & 1) ? p1b : p1a, O00, 0, 0, 0); O10 = __builtin_amdgcn_mfma_f32_32x32x16_bf16(va, (i & 1) ? p2b : p2a, O10, 0, 0, 0); }
                        else       { O01 = __builtin_amdgcn_mfma_f32_32x32x16_bf16(va, (i & 1) ? p1b : p1a, O01, 0, 0, 0); O11 = __builtin_amdgcn_mfma_f32_32x32x16_bf16(va, (i & 1) ? p2b : p2a, O11, 0, 0, 0); }
                    }
                }
            }
            if (hasB) asm volatile("s_waitcnt vmcnt(4)" ::: "memory"); else asm volatile("s_waitcnt vmcnt(0)" ::: "memory");
            __builtin_amdgcn_s_barrier(); asm volatile("" ::: "memory");
            if (hasA) cv_store(dstA, lds + CV_LDS + ca * 32768 + cv_lo, cv_go);
            dstA = dstB; hasA = hasB; ca = cb;
            if (hasB) { ++cj; cb = cb == 2 ? 0 : cb + 1; }
        }
#undef DA_ROW0
#undef DA_DMA_KV
        l1 = xhalf_sum(l1); l2 = xhalf_sum(l2);
        const float i1 = 1.f / l1, i2 = lam / l2;
        float ss = 0.f;
#pragma unroll
        for (int r = 0; r < 16; ++r) { O00[r] = O00[r] * i1 - O10[r] * i2; O01[r] = O01[r] * i1 - O11[r] * i2; ss += O00[r] * O00[r] + O01[r] * O01[r]; }
        ss = xhalf_sum(ss);
        const float rstd = rsqrtf(ss * (1.f / 64.f) + EPS) * (1.f - lam_init);
        const float* gs = p.g_sub + l * 64;
        bf16_t* op = p.MIX + (size_t)(q0 + wid * 32 + r32) * D + h * 64;
#pragma unroll
        for (int g4 = 0; g4 < 4; ++g4) {
            const int d = 8 * g4 + 4 * hi;
            const float4 ga = *(const float4*)(gs + d), gb = *(const float4*)(gs + 32 + d);
            uint2 wa, wb;
            wa.x = cvtpk(O00[4 * g4] * rstd * ga.x, O00[4 * g4 + 1] * rstd * ga.y); wa.y = cvtpk(O00[4 * g4 + 2] * rstd * ga.z, O00[4 * g4 + 3] * rstd * ga.w);
            wb.x = cvtpk(O01[4 * g4] * rstd * gb.x, O01[4 * g4 + 1] * rstd * gb.y); wb.y = cvtpk(O01[4 * g4 + 2] * rstd * gb.z, O01[4 * g4 + 3] * rstd * gb.w);
            *(uint2*)(op + d) = wa; *(uint2*)(op + 32 + d) = wb;
        }
    }
    while (hasA) {
        asm volatile("s_waitcnt vmcnt(0)" ::: "memory");
        __syncthreads();
        cv_store(dstA, lds + CV_LDS + ca * 32768 + cv_lo, cv_go);
        bool hasB; gu8_t dstB;
        CV_NEXT(hasB, dstB);
        dstA = dstB; hasA = hasB; ca = cb;
        if (hasB) { ++cj; cb = cb == 2 ? 0 : cb + 1; }
    }
#undef CV_NEXT
}

__device__ __forceinline__ void ph_na(const P& p, int l, int nrows, char* lds, const int wv) {
    const int tid = ltid(wv), lane = tid & 63, wid = wv, r32 = lane & 31, hi = lane >> 5;
    const bf16_t* PR = p.PROJ;
    const int nunits = (nrows == R) ? 256 + 16 : 256;
    const int vkey = (2 * (wid & 3) + (lane >> 5)) * 8 + ((lane >> 2) & 7), vchunk = (wid >> 2) * 4 + (lane & 3);
    const int vb = ((lane >> 4) & 1) * 32 + (lane & 3) * 8 + (4 * hi + ((lane & 15) >> 2)) * 64;
    const unsigned lds0 = (unsigned)(uintptr_t)lds;
    float* btab = (float*)(lds + 49152);
    constexpr float LOG2E = 1.4426950408889634f;
    float pen[2][16];
    {
        const int cq_ = (wid & 1) * 32 + r32, wsc_ = min(max(cq_ - 8, 0), 48);
#pragma unroll
        for (int kb = 0; kb < 2; ++kb)
#pragma unroll
            for (int r = 0; r < 16; ++r) { const int kc = 32 * kb + (r & 3) + 8 * (r >> 2) + 4 * hi; pen[kb][r] = ((unsigned)(kc - wsc_) < 16u) ? 0.f : -INFINITY; }
    }
    for (int uu = (blockIdx.x + gridDim.x - 16) % gridDim.x; uu < nunits; uu += gridDim.x) {
        int b, h, q0, kr_lo, nlat, rs = 0, rq = 0; bool isctx;
        if (uu < 256) {
            const int u = (uu & 7) * 32 + (uu >> 3); b = u >> 6; h = (u >> 4) & 3; const int rg = u & 15;
            rq = 4 * rg + (wid >> 1); q0 = b * 4096 + rq * 64 + (wid & 1) * 32;
            kr_lo = min(max(4 * rg - 4, 0), 56); const int kr_hi = min(max(4 * rg - 1, 0), 56) + 7; nlat = kr_hi - kr_lo + 1;
            rs = min(max(rq - 4, 0), 56); isctx = false;
        } else { const int v = uu - 256; b = v >> 2; h = v & 3; q0 = T + b * 256 + wid * 32; kr_lo = 0; nlat = 0; isctx = true; }
        const int nt = nlat + 4;
        const int cq = (wid & 1) * 32 + r32;
        const unsigned gKo = (unsigned)(1792 + h * 64 + wid * 8 + lane * PW) * 2u;
        const unsigned gVo = (unsigned)(2048 + h * 64 + vchunk * 8 + vkey * PW) * 2u;
#define NA_ROW0(t_) ((t_) < nlat ? b * 4096 + (kr_lo + (t_)) * 64 : T + b * 256 + ((t_) - nlat) * 64)
#define NA_DMA_KV(t_, slot_) glds16x2((gcc_t)PR + (size_t)NA_ROW0(t_) * (PW * 2), gKo, gVo, lds0 + (slot_) * 16384 + wid * 1024)
        __syncthreads();
        NA_DMA_KV(0, 0); NA_DMA_KV(1, 1);
        bf16x8 qf[4];
        {
            const bf16_t* qp = PR + (size_t)(q0 + r32) * PW + 1536 + h * 64 + hi * 8;
#pragma unroll
            for (int ks = 0; ks < 4; ++ks) qf[ks] = *(const bf16x8*)(qp + ks * 16);
        }
        f32x16 O0, O1;
#pragma unroll
        for (int r = 0; r < 16; ++r) { O0[r] = 0.f; O1[r] = 0.f; }
        float m1 = -1e30f, l1 = 0.f;
        for (int i = tid; i < 15 * 128; i += NT) { const int j = (i & 127) - 48; btab[i] = (j >= 0 && j < 31) ? p.rpb[((size_t)l * 4 + h) * 465 + (i >> 7) * 31 + j] * LOG2E : 0.f; }
        asm volatile("" :: "v"(qf[0]), "v"(qf[1]), "v"(qf[2]), "v"(qf[3]));
        asm volatile("s_waitcnt vmcnt(0)" ::: "memory");
        __syncthreads();
        int ks = 0;
#pragma unroll 1
        for (int t = 0; t < nt; ++t) {
            char* buf = lds + ks * 16384;
            const bool kvB = t + 2 < nt;
            if (kvB) NA_DMA_KV(t + 2, ks == 0 ? 2 : ks - 1);
            const bool lat = t < nlat;
            const int krow = kr_lo + t;
            const bool active = !lat || (krow >= rs && krow <= rs + 7);
            if (active) {
                const float* brow = btab + (krow - rq + 7) * 128 + 48 + 15 - cq + 4 * hi;
#pragma unroll
                for (int kb = 0; kb < 2; ++kb) {
                    const lds_cptr kp = (lds_cptr)buf + hi * 1024 + (kb * 32 + r32) * 16;
                    f32x16 s1;
#pragma unroll
                    for (int r = 0; r < 16; ++r) s1[r] = 0.f;
#pragma unroll
                    for (int ks2 = 0; ks2 < 4; ++ks2) {
                        const bf16x8 kf = *(const __attribute__((address_space(3))) bf16x8*)(kp + ks2 * 2048);
                        s1 = __builtin_amdgcn_mfma_f32_32x32x16_bf16(kf, qf[ks2], s1, 0, 0, 0);
                    }
                    if (lat) {
#pragma unroll
                        for (int r = 0; r < 16; ++r) s1[r] = (s1[r] + brow[32 * kb + (r & 3) + 8 * (r >> 2)]) + pen[kb][r];
                    }
                    bf16x8 pa, pb;
                    dsoftmax2<8>(s1, m1, l1, O0, O1, pa, pb, false);
                    const lds_cptr vp = (lds_cptr)buf + 8192 + vb + kb * 2048;
#pragma unroll
                    for (int ss = 0; ss < 2; ++ss) {
                        const s16x4 lo0 = vtr(vp + ss * 1024), hh0 = vtr(vp + ss * 1024 + 512);
                        const s16x4 lo1 = vtr(vp + 4096 + ss * 1024), hh1 = vtr(vp + 4096 + ss * 1024 + 512);
                        const bf16x8 va0 = (bf16x8){lo0[0], lo0[1], lo0[2], lo0[3], hh0[0], hh0[1], hh0[2], hh0[3]};
                        const bf16x8 va1 = (bf16x8){lo1[0], lo1[1], lo1[2], lo1[3], hh1[0], hh1[1], hh1[2], hh1[3]};
                        O0 = __builtin_amdgcn_mfma_f32_32x32x16_bf16(va0, ss ? pb : pa, O0, 0, 0, 0);
                        O1 = __builtin_amdgcn_mfma_f32_32x32x16_bf16(va1, ss ? pb : pa, O1, 0, 0, 0);
                    }
                }
            }
            if (kvB) asm volatile("s_waitcnt vmcnt(2)" ::: "memory"); else asm volatile("s_waitcnt vmcnt(0)" ::: "memory");
            __builtin_amdgcn_s_barrier(); asm volatile("" ::: "memory");
            ks = ks == 2 ? 0 : ks + 1;
        }
#undef NA_ROW0
#undef NA_DMA_KV
        l1 = xhalf_sum(l1);
        const float il = 1.f / l1;
        bf16_t* op = p.MIX + (size_t)(q0 + r32) * D + 768 + h * 64;
#pragma unroll
        for (int g4 = 0; g4 < 4; ++g4) {
            const int d = 8 * g4 + 4 * hi;
            uint2 wa, wb;
            wa.x = cvtpk(O0[4 * g4] * il, O0[4 * g4 + 1] * il); wa.y = cvtpk(O0[4 * g4 + 2] * il, O0[4 * g4 + 3] * il);
            wb.x = cvtpk(O1[4 * g4] * il, O1[4 * g4 + 1] * il); wb.y = cvtpk(O1[4 * g4 + 2] * il, O1[4 * g4 + 3] * il);
            *(uint2*)(op + d) = wa; *(uint2*)(op + 32 + d) = wb;
        }
    }
}

__device__ __forceinline__ void ph_pool(const P& p, int l, int nrows, char* lds, const int wv) {
    const int tid = ltid(wv), lane = tid & 63, wid = tid >> 6, fr = lane & 15, fq = lane >> 4;
    float* ysh = (float*)lds;
    bf16_t* dsh = (bf16_t*)(lds + 80 * 256 * 4);
    const bf16_t* PR = p.PROJ;
    for (int it = (blockIdx.x + gridDim.x - 32) % gridDim.x; it < nrows / 64; it += gridDim.x) {
        const int row0 = it * 64;
        const int L = row0 < T ? 4096 : 256;
        const int t0 = row0 < T ? (row0 & 4095) : ((row0 - T) & 255);
        const int base = row0 - t0;
        __syncthreads();
        for (int c = tid; c < 80 * 32; c += NT) {
            const int rr = c >> 5, ch = (c & 31) * 8, t = t0 - 8 + rr;
            float4 a = make_float4(0.f, 0.f, 0.f, 0.f), b = a;
            if (t >= 0 && t < L) {
                const uint4 raw = *(const uint4*)(PR + (size_t)(base + t) * PW + 768 + ch);
                a = make_float4(__uint_as_float(raw.x << 16), __uint_as_float(raw.x & 0xffff0000u), __uint_as_float(raw.y << 16), __uint_as_float(raw.y & 0xffff0000u));
                b = make_float4(__uint_as_float(raw.z << 16), __uint_as_float(raw.z & 0xffff0000u), __uint_as_float(raw.w << 16), __uint_as_float(raw.w & 0xffff0000u));
            }
            *(float4*)(ysh + rr * 256 + ch) = a; *(float4*)(ysh + rr * 256 + ch + 4) = b;
        }
        __syncthreads();
        {
            const int r = tid >> 3, cg = tid & 7;
            const int g = cg >> 1, w = 2 << g, t = t0 + r;
            const int lo = max(t - w / 2, 0), hi = min(t + w / 2 - 1, L - 1);
            const float inv = 1.f / (float)(hi - lo + 1);
#pragma unroll
            for (int q = 0; q < 8; ++q) {
                const int ch = cg * 32 + q * 4;
                float4 s = make_float4(0.f, 0.f, 0.f, 0.f);
                for (int tt = lo; tt <= hi; ++tt) { const float4 v = *(const float4*)(ysh + (tt - t0 + 8) * 256 + ch); s.x += v.x; s.y += v.y; s.z += v.z; s.w += v.w; }
                const float4 y = *(const float4*)(ysh + (r + 8) * 256 + ch);
                uint2 o; o.x = cvtpk(s.x * inv - y.x, s.y * inv - y.y); o.y = cvtpk(s.z * inv - y.z, s.w * inv - y.w);
                *(uint2*)(dsh + r * 264 + ch) = o;
            }
        }
        __syncthreads();
        {
            const int g = wid >> 1, mb = (wid & 1) * 2;
            const bf16_t* W = p.WpT + ((size_t)l * 4 + g) * 64 * 64;
            f32x4 acc[2][4];
#pragma unroll
            for (int mt = 0; mt < 2; ++mt)
#pragma unroll
                for (int nt = 0; nt < 4; ++nt) acc[mt][nt] = (f32x4){0.f, 0.f, 0.f, 0.f};
#pragma unroll
            for (int ks = 0; ks < 2; ++ks) {
                bf16x8 af[2], bfr[4];
#pragma unroll
                for (int mt = 0; mt < 2; ++mt) af[mt] = *(const bf16x8*)(dsh + ((mb + mt) * 16 + fr) * 264 + g * 64 + ks * 32 + fq * 8);
#pragma unroll
                for (int nt = 0; nt < 4; ++nt) bfr[nt] = *(const bf16x8*)(W + (nt * 16 + fr) * 64 + ks * 32 + fq * 8);
#pragma unroll
                for (int mt = 0; mt < 2; ++mt)
#pragma unroll
                    for (int nt = 0; nt < 4; ++nt) acc[mt][nt] = __builtin_amdgcn_mfma_f32_16x16x32_bf16(bfr[nt], af[mt], acc[mt][nt], 0, 0, 0);
            }
#pragma unroll
            for (int mt = 0; mt < 2; ++mt)
#pragma unroll
                for (int nt = 0; nt < 4; ++nt) {
                    const int row = row0 + (mb + mt) * 16 + fr, j = g * 64 + nt * 16 + fq * 4;
                    const float4 sp = *(const float4*)(p.s_pool + l * 256 + j);
                    uint2 o; o.x = cvtpk(acc[mt][nt][0] * sp.x, acc[mt][nt][1] * sp.y); o.y = cvtpk(acc[mt][nt][2] * sp.z, acc[mt][nt][3] * sp.w);
                    *(uint2*)(p.MIX + (size_t)row * D + 256 + j) = o;
                }
        }
    }
}

__device__ __forceinline__ float gelu_fast(float x) {
    const float u = 0.7978845608028654f * (x + 0.044715f * x * x * x);
    return x / (1.f + __builtin_amdgcn_exp2f(-2.885390081777927f * u));
}
__device__ __forceinline__ void ph_sgu(const P& p, int l, int nrows, char* lds, const int wv) {
    const int tid = ltid(wv), lane = tid & 63, wid = tid >> 6, fr = lane & 15, fq = lane >> 4;
    bf16_t* vnT = (bf16_t*)lds;
    float* rstd = (float*)(lds + 128 * 136 * 2);
    const bf16_t* PR = p.PROJ;
    for (int it = (blockIdx.x + gridDim.x - 48) % gridDim.x; it < (nrows / 128) * 2; it += gridDim.x) {
        const int chunk = it >> 1, hp = it & 1, row0 = chunk * 128;
        __syncthreads();
        {
            const int t = tid >> 2, qtr = tid & 3;
            const bf16_t* zp = PR + (size_t)(row0 + t) * PW + 1280 + qtr * 64;
            float ss = 0.f;
#pragma unroll
            for (int i = 0; i < 8; ++i) {
                const uint4 raw = *(const uint4*)(zp + i * 8);
                const unsigned w4[4] = {raw.x, raw.y, raw.z, raw.w};
#pragma unroll
                for (int j = 0; j < 4; ++j) { const float a = __uint_as_float(w4[j] << 16), b = __uint_as_float(w4[j] & 0xffff0000u); ss += a * a + b * b; }
            }
            ss += __shfl_xor(ss, 1); ss += __shfl_xor(ss, 2);
            if (qtr == 0) rstd[t] = rsqrtf(ss * (1.f / 256.f) + EPS);
        }
        __syncthreads();
        {
            const int s = tid >> 2, cb = (tid & 3) * 32;
            const bf16_t* zp = PR + (size_t)(row0 + s) * PW + 1280 + hp * 128 + cb;
            const float rs = rstd[s];
            const float* gg = p.g_sgu + l * 256 + hp * 128 + cb;
#pragma unroll
            for (int i = 0; i < 4; ++i) {
                const uint4 raw = *(const uint4*)(zp + i * 8);
                const unsigned w4[4] = {raw.x, raw.y, raw.z, raw.w};
#pragma unroll
                for (int j = 0; j < 4; ++j) {
                    const int c = cb + i * 8 + j * 2;
                    vnT[c * 136 + s] = f2bf(__uint_as_float(w4[j] << 16) * rs * gg[i * 8 + j * 2]);
                    vnT[(c + 1) * 136 + s] = f2bf(__uint_as_float(w4[j] & 0xffff0000u) * rs * gg[i * 8 + j * 2 + 1]);
                }
            }
        }
        __syncthreads();
        {
            const int hl = wid >> 2, g = hp * 2 + hl, mb = (wid & 3) * 2;
            const bf16_t* Wg = p.WsB + ((size_t)l * 4 + g) * 128 * 128;
            f32x4 acc[2][4];
#pragma unroll
            for (int mt = 0; mt < 2; ++mt)
#pragma unroll
                for (int nt = 0; nt < 4; ++nt) acc[mt][nt] = (f32x4){0.f, 0.f, 0.f, 0.f};
#pragma unroll
            for (int ks = 0; ks < 4; ++ks) {
                bf16x8 af[2], bfr[4];
#pragma unroll
                for (int mt = 0; mt < 2; ++mt) af[mt] = *(const bf16x8*)(Wg + ((mb + mt) * 16 + fr) * 128 + ks * 32 + fq * 8);
#pragma unroll
                for (int nt = 0; nt < 4; ++nt) bfr[nt] = *(const bf16x8*)(vnT + (hl * 64 + nt * 16 + fr) * 136 + ks * 32 + fq * 8);
#pragma unroll
                for (int mt = 0; mt < 2; ++mt)
#pragma unroll
                    for (int nt = 0; nt < 4; ++nt) acc[mt][nt] = __builtin_amdgcn_mfma_f32_16x16x32_bf16(bfr[nt], af[mt], acc[mt][nt], 0, 0, 0);
            }
#pragma unroll
            for (int mt = 0; mt < 2; ++mt) {
                const int t = (mb + mt) * 16 + fr;
                const float bias = p.b_sgu[(l * 4 + g) * 128 + t];
#pragma unroll
                for (int nt = 0; nt < 4; ++nt) {
                    const int c = g * 64 + nt * 16 + fq * 4;
                    const uint2 ur = *(const uint2*)(PR + (size_t)(row0 + t) * PW + 1024 + c);
                    const float u0 = __uint_as_float(ur.x << 16), u1 = __uint_as_float(ur.x & 0xffff0000u);
                    const float u2 = __uint_as_float(ur.y << 16), u3 = __uint_as_float(ur.y & 0xffff0000u);
                    uint2 o; o.x = cvtpk(u0 * (acc[mt][nt][0] + bias), u1 * (acc[mt][nt][1] + bias)); o.y = cvtpk(u2 * (acc[mt][nt][2] + bias), u3 * (acc[mt][nt][3] + bias));
                    *(uint2*)(p.MIX + (size_t)(row0 + t) * D + 512 + c) = o;
                }
            }
        }
    }
}

__device__ __forceinline__ void ph_router(const P& p, int l, int nrows, char* lds, const int wv) {
    const int tid = ltid(wv), wave = wv, lane = tid & 63;
    float* wt = (float*)lds;
    float* tsc = (float*)(lds + 32 * 1028 * 4) + wave * (16 * 33);
    int* lcnt = (int*)(lds + 32 * 1028 * 4 + 8 * 16 * 33 * 4);
    int* rinfo = lcnt + 64;
    __syncthreads();
    {
        const float* wr = p.w_router + (size_t)l * D * NE;
        float4 t[16];
#pragma unroll
        for (int i = 0; i < 16; ++i) t[i] = *(const float4*)(wr + (size_t)(tid + NT * i) * 4);
#pragma unroll
        for (int i = 0; i < 16; ++i) { const int idx = (tid + NT * i) * 4, k = idx >> 5, e = idx & 31; float* q = wt + e * 1028 + k; q[0] = t[i].x; q[1028] = t[i].y; q[2 * 1028] = t[i].z; q[3 * 1028] = t[i].w; }
        if (tid < 32) lcnt[tid] = 0;
        if (tid < 128) rinfo[tid * 5] = -1;
    }
    __syncthreads();
    const int i16 = lane & 15, kk = lane >> 4;
    const float* w0 = wt + i16 * 1028 + 8 * kk;
    const bool staged = nrows / 16 <= 8 * (int)gridDim.x;
    int trip = 0;
    for (int g = (wave & 3) * (int)gridDim.x + (int)blockIdx.x; g < nrows / 16; g += 4 * (int)gridDim.x, ++trip) {
        const int row0 = g * 16, mb = mod_row(row0);
        const bf16_t* xr = p.X + (size_t)(row0 + i16) * D + 8 * kk;
        const float* Gt = p.RG + ((size_t)l * 5 + mb) * 1024 + 8 * kk;
        if (wave >= 4) {
            float ss = 0.f;
#pragma unroll 1
            for (int c0 = 0; c0 < 32; c0 += 16) {
                uint4 raw[16];
#pragma unroll
                for (int c = 0; c < 16; ++c) raw[c] = *(const uint4*)(xr + 32 * (c0 + c));
#pragma unroll
                for (int c = 0; c < 16; ++c) {
                    const float x0 = __uint_as_float(raw[c].x << 16), x1 = __uint_as_float(raw[c].x & 0xffff0000u), x2 = __uint_as_float(raw[c].y << 16), x3 = __uint_as_float(raw[c].y & 0xffff0000u);
                    const float x4 = __uint_as_float(raw[c].z << 16), x5 = __uint_as_float(raw[c].z & 0xffff0000u), x6 = __uint_as_float(raw[c].w << 16), x7 = __uint_as_float(raw[c].w & 0xffff0000u);
                    ss += x0 * x0 + x1 * x1 + x2 * x2 + x3 * x3 + x4 * x4 + x5 * x5 + x6 * x6 + x7 * x7;
                }
            }
            ss += __shfl_xor(ss, 16); ss += __shfl_xor(ss, 32);
            const float rstd = rsqrtf(ss * (1.f / D) + EPS);
            const float* St = p.mod + ((size_t)l * 5 + mb) * 6144 + 3 * 1024 + 8 * kk;
            unsigned char* hr = p.HS + (size_t)(row0 + i16) * D + 8 * kk;
#pragma unroll 1
            for (int c0 = 0; c0 < 32; c0 += 8) {
#pragma unroll
                for (int c1 = 0; c1 < 8; ++c1) {
                    const int c = c0 + c1;
                    const uint4 raw = *(const uint4*)(xr + 32 * c);
                    const float4 ga = *(const float4*)(Gt + 32 * c), gb = *(const float4*)(Gt + 32 * c + 4), sa = *(const float4*)(St + 32 * c), sb = *(const float4*)(St + 32 * c + 4);
                    const float h0 = __uint_as_float(raw.x << 16) * rstd * ga.x + sa.x, h1 = __uint_as_float(raw.x & 0xffff0000u) * rstd * ga.y + sa.y;
                    const float h2 = __uint_as_float(raw.y << 16) * rstd * ga.z + sa.z, h3 = __uint_as_float(raw.y & 0xffff0000u) * rstd * ga.w + sa.w;
                    const float h4 = __uint_as_float(raw.z << 16) * rstd * gb.x + sb.x, h5 = __uint_as_float(raw.z & 0xffff0000u) * rstd * gb.y + sb.y;
                    const float h6 = __uint_as_float(raw.w << 16) * rstd * gb.z + sb.z, h7 = __uint_as_float(raw.w & 0xffff0000u) * rstd * gb.w + sb.w;
                    uint2 o;
                    o.x = __builtin_amdgcn_cvt_pk_fp8_f32(h2, h3, __builtin_amdgcn_cvt_pk_fp8_f32(h0, h1, 0u, false), true);
                    o.y = __builtin_amdgcn_cvt_pk_fp8_f32(h6, h7, __builtin_amdgcn_cvt_pk_fp8_f32(h4, h5, 0u, false), true);
                    *(uint2*)(hr + 32 * c) = o;
                }
            }
            continue;
        }
        f32x4 d0 = {0.f, 0.f, 0.f, 0.f}, d1 = d0; float ss = 0.f;
        uint4 rawA[8], rawB[8];
#pragma unroll
        for (int j = 0; j < 8; ++j) rawA[j] = *(const uint4*)(xr + 32 * j);
#define RT_CHUNK(RAW, c_) do { \
            const float4 ga_ = *(const float4*)(Gt + 32 * (c_)), gb_ = *(const float4*)(Gt + 32 * (c_) + 4); \
            const f32x4 ba0_ = *(const f32x4*)(w0 + 32 * (c_)), ba1_ = *(const f32x4*)(w0 + 32 * (c_) + 4), bb0_ = *(const f32x4*)(w0 + 16 * 1028 + 32 * (c_)), bb1_ = *(const f32x4*)(w0 + 16 * 1028 + 32 * (c_) + 4); \
            const float x0_ = __uint_as_float(RAW.x << 16), x1_ = __uint_as_float(RAW.x & 0xffff0000u), x2_ = __uint_as_float(RAW.y << 16), x3_ = __uint_as_float(RAW.y & 0xffff0000u); \
            const float x4_ = __uint_as_float(RAW.z << 16), x5_ = __uint_as_float(RAW.z & 0xffff0000u), x6_ = __uint_as_float(RAW.w << 16), x7_ = __uint_as_float(RAW.w & 0xffff0000u); \
            ss += x0_ * x0_ + x1_ * x1_ + x2_ * x2_ + x3_ * x3_ + x4_ * x4_ + x5_ * x5_ + x6_ * x6_ + x7_ * x7_; \
            d0 = __builtin_amdgcn_mfma_f32_16x16x4f32(x0_ * ga_.x, ba0_[0], d0, 0, 0, 0); d1 = __builtin_amdgcn_mfma_f32_16x16x4f32(x0_ * ga_.x, bb0_[0], d1, 0, 0, 0); \
            d0 = __builtin_amdgcn_mfma_f32_16x16x4f32(x1_ * ga_.y, ba0_[1], d0, 0, 0, 0); d1 = __builtin_amdgcn_mfma_f32_16x16x4f32(x1_ * ga_.y, bb0_[1], d1, 0, 0, 0); \
            d0 = __builtin_amdgcn_mfma_f32_16x16x4f32(x2_ * ga_.z, ba0_[2], d0, 0, 0, 0); d1 = __builtin_amdgcn_mfma_f32_16x16x4f32(x2_ * ga_.z, bb0_[2], d1, 0, 0, 0); \
            d0 = __builtin_amdgcn_mfma_f32_16x16x4f32(x3_ * ga_.w, ba0_[3], d0, 0, 0, 0); d1 = __builtin_amdgcn_mfma_f32_16x16x4f32(x3_ * ga_.w, bb0_[3], d1, 0, 0, 0); \
            d0 = __builtin_amdgcn_mfma_f32_16x16x4f32(x4_ * gb_.x, ba1_[0], d0, 0, 0, 0); d1 = __builtin_amdgcn_mfma_f32_16x16x4f32(x4_ * gb_.x, bb1_[0], d1, 0, 0, 0); \
            d0 = __builtin_amdgcn_mfma_f32_16x16x4f32(x5_ * gb_.y, ba1_[1], d0, 0, 0, 0); d1 = __builtin_amdgcn_mfma_f32_16x16x4f32(x5_ * gb_.y, bb1_[1], d1, 0, 0, 0); \
            d0 = __builtin_amdgcn_mfma_f32_16x16x4f32(x6_ * gb_.z, ba1_[2], d0, 0, 0, 0); d1 = __builtin_amdgcn_mfma_f32_16x16x4f32(x6_ * gb_.z, bb1_[2], d1, 0, 0, 0); \
            d0 = __builtin_amdgcn_mfma_f32_16x16x4f32(x7_ * gb_.w, ba1_[3], d0, 0, 0, 0); d1 = __builtin_amdgcn_mfma_f32_16x16x4f32(x7_ * gb_.w, bb1_[3], d1, 0, 0, 0); } while (0)
#pragma unroll 1
        for (int cc = 0; cc < 4; cc += 2) {
#pragma unroll
            for (int j = 0; j < 8; ++j) rawB[j] = *(const uint4*)(xr + 32 * (8 * cc + 8 + j));
#pragma unroll
            for (int j = 0; j < 8; ++j) RT_CHUNK(rawA[j], 8 * cc + j);
            if (cc + 2 < 4) {
#pragma unroll
                for (int j = 0; j < 8; ++j) rawA[j] = *(const uint4*)(xr + 32 * (8 * cc + 16 + j));
            }
#pragma unroll
            for (int j = 0; j < 8; ++j) RT_CHUNK(rawB[j], 8 * cc + 8 + j);
        }
#undef RT_CHUNK
        ss += __shfl_xor(ss, 16); ss += __shfl_xor(ss, 32);
        const float rstd = rsqrtf(ss * (1.f / D) + EPS);
#pragma unroll
        for (int j = 0; j < 4; ++j) { tsc[(4 * kk + j) * 33 + i16] = d0[j]; tsc[(4 * kk + j) * 33 + 16 + i16] = d1[j]; }
        __builtin_amdgcn_s_waitcnt(0xc07f);
        if (lane < 16) {
            const float* rb = p.RB + ((size_t)l * 5 + mb) * 32;
            float lg[32];
#pragma unroll
            for (int e = 0; e < 32; ++e) lg[e] = tsc[lane * 33 + e] * rstd + rb[e];
            unsigned taken = 0u; float tv[4]; int ti[4];
#pragma unroll
            for (int k = 0; k < 4; ++k) {
                float best = -3.0e38f; int bi = 0;
#pragma unroll
                for (int e = 0; e < 32; ++e) { const bool ok = !((taken >> e) & 1u) && (lg[e] > best); best = ok ? lg[e] : best; bi = ok ? e : bi; }
                taken |= 1u << bi; tv[k] = best; ti[k] = bi;
            }
            const float e1 = __expf(tv[1] - tv[0]), e2 = __expf(tv[2] - tv[0]), e3 = __expf(tv[3] - tv[0]);
            const float inv = 1.f / (1.f + e1 + e2 + e3);
            const int row = row0 + lane;
            *(int4*)(p.topi + (size_t)row * 4) = make_int4(ti[0], ti[1], ti[2], ti[3]);
            *(float4*)(p.topg + (size_t)row * 4) = make_float4(inv, e1 * inv, e2 * inv, e3 * inv);
            if (staged) {
                const int r0 = atomicAdd(&lcnt[ti[0]], 1), r1 = atomicAdd(&lcnt[ti[1]], 1), r2 = atomicAdd(&lcnt[ti[2]], 1), r3 = atomicAdd(&lcnt[ti[3]], 1);
                int* ri = rinfo + ((trip * 4 + wave) * 16 + lane) * 5;
                ri[0] = row; ri[1] = ti[0] | (r0 << 8); ri[2] = ti[1] | (r1 << 8); ri[3] = ti[2] | (r2 << 8); ri[4] = ti[3] | (r3 << 8);
            } else {
                int ps[4];
#pragma unroll
                for (int k = 0; k < 4; ++k) { ps[k] = atomicAdd(&p.cnt[l * 64 + ti[k]], 1); p.slot_tok[(size_t)ti[k] * ECAP + ps[k]] = row; }
                *(int4*)(p.tok_slot + (size_t)row * 4) = make_int4(ps[0], ps[1], ps[2], ps[3]);
            }
        }
    }
    __syncthreads();
    if (tid < 32) lcnt[32 + tid] = lcnt[tid] ? atomicAdd(&p.cnt[l * 64 + tid], lcnt[tid]) : 0;
    __syncthreads();
    if (tid < 128 && rinfo[tid * 5] >= 0) {
        const int row = rinfo[tid * 5]; int ps[4];
#pragma unroll
        for (int k = 0; k < 4; ++k) { const int v = rinfo[tid * 5 + 1 + k], e = v & 255; ps[k] = lcnt[32 + e] + (v >> 8); p.slot_tok[(size_t)e * ECAP + ps[k]] = row; }
        *(int4*)(p.tok_slot + (size_t)row * 4) = make_int4(ps[0], ps[1], ps[2], ps[3]);
    }
}
__device__ __forceinline__ void ph_moe_tables(const P& p, int l, const int wv) {
    const int tid = ltid(wv);
    unsigned short* tstart = (unsigned short*)(smem_base() + MT_TSTART); int* ecnt = (int*)(smem_base() + MT_ECNT); unsigned char* tile_e = (unsigned char*)(smem_base() + MT_TILE_E);
    __syncthreads();
    if (tid < 32) ecnt[tid] = p.cnt[l * 64 + tid];
    __syncthreads();
    if (tid == 0) { int a = 0; for (int e = 0; e < 32; ++e) { tstart[e] = (unsigned short)a; a += (ecnt[e] + 255) >> 8; } tstart[32] = (unsigned short)a; }
    __syncthreads();
    if (tid < 320) { int e = 0; for (int k = 1; k < 32; ++k) if (tid >= (int)tstart[k]) e = k; tile_e[tid] = (unsigned char)e; }
    __syncthreads();
}
struct EpiProj {
    static constexpr bool PERM = true, AFTER_DRAIN = false, WIDE = false;
    struct Pre {}; __device__ __forceinline__ void prefetch(Pre&, const pg8::Unit&, int, int, int, int) const {}
    bf16_t* O; const float* rope;
    __device__ __forceinline__ void operator()(const f32x4 (&acc)[2][2][4][2], const pg8::Unit& u, int wr, int wc, int fr, int fq, const Pre& pre) const {
        const int row0 = u.pm * 256 + wr * 64 + fr, col0 = u.pn * 256 + wc * 32 + 8 * fq;
        const bool do_rope = (u.pn < 2) && (u.pm < T / 256), do_gelu = (u.pn == 4) || (u.pn == 5);
        const float sc = u.pn == 0 ? QSCALE : (u.pn == 6 ? 0.125f * 1.4426950408889634f : 1.f);
        const float sgn = (fq & 1) ? 1.f : -1.f;
#pragma unroll
        for (int ai = 0; ai < 2; ++ai)
#pragma unroll
            for (int m = 0; m < 4; ++m) {
                const int row = row0 + ai * 128 + m * 16;
                bf16_t* rowp = O + (size_t)row * PW + col0;
                f32x4 cs[4];
                if (do_rope) {
                    const int s = row & 4095, pos = (fq >> 1) ? (s & 63) : (s >> 6);
                    const f32x4* rp = (const f32x4*)(rope + pos * 16);
                    cs[0] = rp[0]; cs[1] = rp[1]; cs[2] = rp[2]; cs[3] = rp[3];
                }
#pragma unroll
                for (int bj = 0; bj < 2; ++bj) {
                    f32x4 v0 = acc[ai][bj][m][0], v1 = acc[ai][bj][m][1];
                    if (do_rope) {
                        f32x4 b0, b1;
#pragma unroll
                        for (int j = 0; j < 4; ++j) { b0[j] = __shfl_xor(v0[j], 16); b1[j] = __shfl_xor(v1[j], 16); }
                        v0[0] = v0[0] * cs[0][0] + sgn * b0[0] * cs[0][1]; v0[1] = v0[1] * cs[0][2] + sgn * b0[1] * cs[0][3];
                        v0[2] = v0[2] * cs[1][0] + sgn * b0[2] * cs[1][1]; v0[3] = v0[3] * cs[1][2] + sgn * b0[3] * cs[1][3];
                        v1[0] = v1[0] * cs[2][0] + sgn * b1[0] * cs[2][1]; v1[1] = v1[1] * cs[2][2] + sgn * b1[1] * cs[2][3];
                        v1[2] = v1[2] * cs[3][0] + sgn * b1[2] * cs[3][1]; v1[3] = v1[3] * cs[3][2] + sgn * b1[3] * cs[3][3];
                    }
                    if (do_gelu) {
#pragma unroll
                        for (int j = 0; j < 4; ++j) { v0[j] = gelu_fast(v0[j]); v1[j] = gelu_fast(v1[j]); }
                    }
                    v0 = v0 * sc; v1 = v1 * sc;
                    u32x4 w; w.x = cvtpk(v0[0], v0[1]); w.y = cvtpk(v0[2], v0[3]); w.z = cvtpk(v1[0], v1[1]); w.w = cvtpk(v1[2], v1[3]);
                    *(u32x4*)(rowp + bj * 128) = w;
                }
            }
    }
};
template <bool RES_F32>
struct EpiOut {
    static constexpr bool PERM = true, AFTER_DRAIN = false, WIDE = false;
    struct Pre {}; __device__ __forceinline__ void prefetch(Pre&, const pg8::Unit&, int, int, int, int) const {}
    bf16_t* X; const float* gate; const float* res_lat; const float* res_ctx;
    __device__ __forceinline__ void operator()(const f32x4 (&acc)[2][2][4][2], const pg8::Unit& u, int wr, int wc, int fr, int fq, const Pre& pre) const {
        const int row0 = u.pm * 256 + wr * 64 + fr, col0 = u.pn * 256 + wc * 32 + 8 * fq;
        const float* g = gate + (size_t)mod_row(u.pm * 256) * 6144 + col0;
        f32x4 gv[2][2];
#pragma unroll
        for (int bj = 0; bj < 2; ++bj)
#pragma unroll
            for (int n = 0; n < 2; ++n) gv[bj][n] = *(const f32x4*)(g + bj * 128 + n * 4);
#pragma unroll
        for (int ai = 0; ai < 2; ++ai)
#pragma unroll
            for (int m = 0; m < 4; ++m) { const size_t off = (size_t)(row0 + ai * 128 + m * 16) * D + col0;
#pragma unroll
                for (int bj = 0; bj < 2; ++bj) {
                    f32x4 r0, r1;
                    if (RES_F32) { const float* rp = (u.pm < T / 256 ? res_lat : res_ctx) + off + bj * 128; r0 = *(const f32x4*)rp; r1 = *(const f32x4*)(rp + 4); }
                    else { const u32x4 w = *(const u32x4*)(X + off + bj * 128);
                        r0 = (f32x4){__uint_as_float(w.x << 16), __uint_as_float(w.x & 0xffff0000u), __uint_as_float(w.y << 16), __uint_as_float(w.y & 0xffff0000u)};
                        r1 = (f32x4){__uint_as_float(w.z << 16), __uint_as_float(w.z & 0xffff0000u), __uint_as_float(w.w << 16), __uint_as_float(w.w & 0xffff0000u)}; }
                    const f32x4 v0 = r0 + gv[bj][0] * acc[ai][bj][m][0], v1 = r1 + gv[bj][1] * acc[ai][bj][m][1];
                    u32x4 o; o.x = cvtpk(v0[0], v0[1]); o.y = cvtpk(v0[2], v0[3]); o.z = cvtpk(v1[0], v1[1]); o.w = cvtpk(v1[2], v1[3]);
                    *(u32x4*)(X + off + bj * 128) = o; } }
    }
};
__device__ __forceinline__ float swiglu(float g, float u) {
    const float gt = fminf(g, 7.0f), up = fminf(fmaxf(u, -7.0f), 7.0f);
    return (up + 1.0f) * gt * __builtin_amdgcn_rcpf(1.0f + __builtin_amdgcn_exp2f(-1.702f * 1.4426950408889634f * gt));
}
struct EpiAct {
    static constexpr bool PERM = true, AFTER_DRAIN = false, WIDE = false;
    unsigned char* ACT; const float* bgu;
    struct Pre { f32x4 bg0, bg1, bu0, bu1; };
    __device__ __forceinline__ void prefetch(Pre& q, const pg8::Unit& u, int wr, int wc, int fr, int fq) const {
        const float* bp = bgu + (size_t)u.e * 2048 + u.pn * 128 + wc * 32 + 8 * fq;
        q.bg0 = *(const f32x4*)(bp); q.bg1 = *(const f32x4*)(bp + 4); q.bu0 = *(const f32x4*)(bp + 1024); q.bu1 = *(const f32x4*)(bp + 1028);
        asm volatile("" : "+v"(q.bg0), "+v"(q.bg1), "+v"(q.bu0), "+v"(q.bu1));
    }
    __device__ __forceinline__ void operator()(const f32x4 (&acc)[2][2][4][2], const pg8::Unit& u, int wr, int wc, int fr, int fq, const Pre& pre) const {
        const int row0 = u.pm * 256 + wr * 64 + fr, j0 = u.pn * 128 + wc * 32 + 8 * fq;
        const f32x4 bg0 = pre.bg0, bg1 = pre.bg1, bu0 = pre.bu0, bu1 = pre.bu1;
#pragma unroll
        for (int ai = 0; ai < 2; ++ai)
#pragma unroll
            for (int m = 0; m < 4; ++m) {
                const f32x4 g0 = acc[ai][0][m][0] + bg0, g1 = acc[ai][0][m][1] + bg1, u0 = acc[ai][1][m][0] + bu0, u1 = acc[ai][1][m][1] + bu1;
                uint2 w;
                w.x = __builtin_amdgcn_cvt_pk_fp8_f32(swiglu(g0[2], u0[2]), swiglu(g0[3], u0[3]), __builtin_amdgcn_cvt_pk_fp8_f32(swiglu(g0[0], u0[0]), swiglu(g0[1], u0[1]), 0u, false), true);
                w.y = __builtin_amdgcn_cvt_pk_fp8_f32(swiglu(g1[2], u1[2]), swiglu(g1[3], u1[3]), __builtin_amdgcn_cvt_pk_fp8_f32(swiglu(g1[0], u1[0]), swiglu(g1[1], u1[1]), 0u, false), true);
                *(uint2*)(ACT + (size_t)(row0 + ai * 128 + m * 16) * FF + j0) = w;
            }
    }
};
__device__ __forceinline__ void wide_store16(bf16_t* rowp  , const size_t stride8, const u32x4 w0, const u32x4 w1, const bool lo) {
    u32x4 dA, dB;
#pragma unroll
    for (int q = 0; q < 4; ++q) {
        const unsigned snd = lo ? w1[q] : w0[q];
        const unsigned rcv = (unsigned)__builtin_amdgcn_mov_dpp((int)snd, 0x128, 0xf, 0xf, true);
        dA[q] = lo ? w0[q] : rcv; dB[q] = lo ? rcv : w1[q];
    }
    __builtin_nontemporal_store(dA, (u32x4*)rowp); __builtin_nontemporal_store(dB, (u32x4*)(rowp + stride8));
}
struct EpiYB {
    static constexpr bool PERM = true, AFTER_DRAIN = false, WIDE = true;
    bf16_t* YB; const float* bdn;
    struct Pre { f32x4 bv[2][2]; };
    __device__ __forceinline__ void prefetch(Pre& q, const pg8::Unit& u, int wr, int wc, int fr, int fq) const {
        const float* bp = bdn + (size_t)u.e * D + u.pn * 256 + wc * 64 + 8 * fq;
#pragma unroll
        for (int bj = 0; bj < 2; ++bj)
#pragma unroll
            for (int n = 0; n < 2; ++n) q.bv[bj][n] = *(const f32x4*)(bp + bj * 32 + n * 4);
        asm volatile("" : "+v"(q.bv[0][0]), "+v"(q.bv[0][1]), "+v"(q.bv[1][0]), "+v"(q.bv[1][1]));
    }
    __device__ __forceinline__ void operator()(const f32x4 (&acc)[2][2][4][2], const pg8::Unit& u, int wr, int wc, int fr, int fq, const Pre& pre) const {
        const bool lo = fr < 8;
        const int trow0 = (u.pm * 4 + u.pn) * 256 + wr * 64 + (fr & 7), tcol0 = wc * 64 + 8 * fq + (lo ? 0 : 32);
#pragma unroll
        for (int ai = 0; ai < 2; ++ai)
#pragma unroll
            for (int m = 0; m < 4; ++m) {
                u32x4 w[2];
#pragma unroll
                for (int bj = 0; bj < 2; ++bj) { const f32x4 v0 = acc[ai][bj][m][0] + pre.bv[bj][0], v1 = acc[ai][bj][m][1] + pre.bv[bj][1];
                    w[bj].x = cvtpk(v0[0], v0[1]); w[bj].y = cvtpk(v0[2], v0[3]); w[bj].z = cvtpk(v1[0], v1[1]); w[bj].w = cvtpk(v1[2], v1[3]); }
                wide_store16(YB + (size_t)(trow0 + ai * 128 + m * 16) * 256 + tcol0, (size_t)8 * 256, w[0], w[1], lo);
            }
    }
};
template <bool GATHER_>
struct MoeOrderT {
    static constexpr bool GATHER = GATHER_;
    int nN, nunits, G, v; const unsigned char* tile_e; const unsigned short* tstart; const int* ecnt; const int* list;
    __device__ __forceinline__ int tok(int slot) const { const int pm = slot >> 8, e = tile_e[pm], pos = (pm - (int)tstart[e]) * 256 + (slot & 255); return pos < ecnt[e] ? list[(size_t)e * ECAP + pos] : 0; }
    __device__ void init(int nN_, int G_, int c, const int* list_) {
        tstart = (const unsigned short*)(smem_base() + MT_TSTART); ecnt = (const int*)(smem_base() + MT_ECNT); tile_e = (const unsigned char*)(smem_base() + MT_TILE_E); list = list_;
        nN = nN_; nunits = (int)tstart[32] * nN_; G = G_; v = (G_ % 8 == 0) ? (c % 8) * (G_ / 8) + c / 8 : c; }
    __device__ bool next(int i, pg8::Unit& u) const {
        const int L = i * G + v; if (L >= nunits) return false;
        u.pm = L / nN; u.pn = L % nN; u.e = tile_e[u.pm]; return true;
    }
    __device__ __forceinline__ const bf16_t* bt(const pg8::Gemm& g, const pg8::Unit& u) const { return g.Bt + (size_t)u.e * g.N * g.K; }
    __device__ __forceinline__ void a_ready(const pg8::Unit&) const {}
    __device__ __forceinline__ void done(const pg8::Unit&) const {}
};
typedef MoeOrderT<false> MoeOrder;
typedef MoeOrderT<true> MoeOrderG;

__device__ __forceinline__ void ph_gemm_proj(const P& p, int l, char* lds, const int wv) {
    pg8::Gemm g{p.H, p.WinT + (size_t)l * PW * D, R, PW, D}; pg8::StaticOrder S; S.init(R, PW, (int)gridDim.x, (int)blockIdx.x);
    EpiProj E{p.PROJ, p.rope};
    pg8::gemm_phase<EpiProj, pg8::StaticOrder, true, true>((PG8_LAS unsigned char*)lds, g, S, E, wv);
}
__device__ __forceinline__ void ph_gemm_out(const P& p, int l, int nrows, char* lds, const int wv) {
    pg8::Gemm g{p.MIX, p.WoutT + (size_t)l * D * D, T, D, D}; pg8::StaticOrder S; S.init(T, D, (int)gridDim.x, (int)blockIdx.x);
    if (l == 0) { EpiOut<true> E{p.X, p.mod + (size_t)l * 5 * 6144 + 2 * 1024, p.x, p.ctx - (size_t)T * D}; pg8::gemm_phase<EpiOut<true>, pg8::StaticOrder, true, true>((PG8_LAS unsigned char*)lds, g, S, E, wv); }
    else { EpiOut<false> E{p.X, p.mod + (size_t)l * 5 * 6144 + 2 * 1024, nullptr, nullptr}; pg8::gemm_phase<EpiOut<false>, pg8::StaticOrder, true, true>((PG8_LAS unsigned char*)lds, g, S, E, wv); }
    if (nrows > T) {
        const int tid = ltid(wv), lane = tid & 63, wid = tid >> 6, fr = lane & 15, fq = lane >> 4;
        const bf16_t* Wt = p.WoutT + (size_t)l * D * D;
        const float* gate = p.mod + ((size_t)l * 5 + 4) * 6144 + 2 * 1024;
        for (int it = blockIdx.x; it < (TC / 64) * (D / 64); it += gridDim.x) {
            const int m0 = T + (it >> 4) * 64 + (wid & 3) * 16, n0 = (it & 15) * 64 + (wid >> 2) * 32;
            const bf16_t* ap = p.MIX + (size_t)(m0 + fr) * D + fq * 8;
            const bf16_t* bp0 = Wt + (size_t)(n0 + fr) * D + fq * 8;
            const bf16_t* bp1 = bp0 + (size_t)16 * D;
            f32x4 acc0 = (f32x4){0.f, 0.f, 0.f, 0.f}, acc1 = acc0;
#pragma unroll 8
            for (int ks = 0; ks < D / 32; ++ks) {
                const bf16x8 af = *(const bf16x8*)(ap + ks * 32), b0 = *(const bf16x8*)(bp0 + ks * 32), b1 = *(const bf16x8*)(bp1 + ks * 32);
                acc0 = __builtin_amdgcn_mfma_f32_16x16x32_bf16(b0, af, acc0, 0, 0, 0);
                acc1 = __builtin_amdgcn_mfma_f32_16x16x32_bf16(b1, af, acc1, 0, 0, 0);
            }
            const int row = m0 + fr, c0 = n0 + fq * 4;
            const size_t off = (size_t)row * D + c0;
            const float* res = p.ctx - (size_t)T * D;
            const f32x4 v0 = *(const f32x4*)(res + off) + *(const f32x4*)(gate + c0) * acc0, v1 = *(const f32x4*)(res + off + 16) + *(const f32x4*)(gate + c0 + 16) * acc1;
            uint2 o0, o1; o0.x = cvtpk(v0[0], v0[1]); o0.y = cvtpk(v0[2], v0[3]); o1.x = cvtpk(v1[0], v1[1]); o1.y = cvtpk(v1[2], v1[3]);
            *(uint2*)(p.X + off) = o0; *(uint2*)(p.X + off + 16) = o1;
        }
    }
}
__device__ __forceinline__ void ph_moe1(const P& p, int l, char* lds, const int wv) {
    MoeOrderG S; S.init(8, (int)gridDim.x, (int)blockIdx.x, p.slot_tok);
    pg8::Gemm g{(const bf16_t*)p.HS, (const bf16_t*)(p.WguT + (size_t)l * NE * 2048 * D), S.nunits / 8 * 256, 2048, D / 2};
    EpiAct E{p.ACT, p.b_gu + (size_t)l * NE * 2048};
    pg8::gemm_phase<EpiAct, MoeOrderG, true, true, true>((PG8_LAS unsigned char*)lds, g, S, E, wv);
}
__device__ __forceinline__ void ph_moe2(const P& p, int l, char* lds, const int wv) {
    MoeOrder S; S.init(4, (int)gridDim.x, (int)blockIdx.x, nullptr);
    pg8::Gemm g{(const bf16_t*)p.ACT, (const bf16_t*)(p.WdnT + (size_t)l * NE * D * FF), S.nunits / 4 * 256, D, FF / 2};
    EpiYB E{p.YB, p.b_down + (size_t)l * NE * D};
    pg8::gemm_phase<EpiYB, MoeOrder, true, true, true>((PG8_LAS unsigned char*)lds, g, S, E, wv);
}
struct CombRow { uint4 y0[2], y1[2], y2[2], y3[2], xw[2]; float4 g; };
__device__ __forceinline__ void comb_load(CombRow& c, const bf16_t* __restrict__ YB, const bf16_t* __restrict__ X, const int* __restrict__ tok_slot, const int* __restrict__ topi, const float* __restrict__ topg, int row, int lane) {
    const unsigned short* tstart = (const unsigned short*)(smem_base() + MT_TSTART);
    const int4 ps = *(const int4*)(tok_slot + (size_t)row * 4), ei = *(const int4*)(topi + (size_t)row * 4);
    const int4 sl = make_int4((int)tstart[ei.x] * 256 + ps.x, (int)tstart[ei.y] * 256 + ps.y, (int)tstart[ei.z] * 256 + ps.z, (int)tstart[ei.w] * 256 + ps.w);
    c.g = *(const float4*)(topg + (size_t)row * 4);
#pragma unroll
    for (int i = 0; i < 2; ++i) {
        const int k = lane * 8 + 512 * i;
        const size_t ko = (size_t)(k >> 8) * 65536 + (k & 255);
#define YB_AT(s_) (YB + (size_t)((s_) >> 8) * 262144 + (size_t)((s_) & 255) * 256 + ko)
        c.y0[i] = *(const uint4*)YB_AT(sl.x); c.y1[i] = *(const uint4*)YB_AT(sl.y);
        c.y2[i] = *(const uint4*)YB_AT(sl.z); c.y3[i] = *(const uint4*)YB_AT(sl.w);
#undef YB_AT
        c.xw[i] = *(const uint4*)(X + (size_t)row * D + k);
    }
}
__device__ __forceinline__ void comb_finish(const P& p, const CombRow& c, int l, int row, int lane) {
    const float* m = p.mod + ((size_t)l * 5 + mod_row(row)) * 6144 + 5 * 1024;
    const float4 g = c.g;
    float xv[16]; float ss = 0.f;
#pragma unroll
    for (int i = 0; i < 2; ++i) {
        const int k = lane * 8 + 512 * i;
        const unsigned a0[4] = {c.y0[i].x, c.y0[i].y, c.y0[i].z, c.y0[i].w}, a1[4] = {c.y1[i].x, c.y1[i].y, c.y1[i].z, c.y1[i].w};
        const unsigned a2[4] = {c.y2[i].x, c.y2[i].y, c.y2[i].z, c.y2[i].w}, a3[4] = {c.y3[i].x, c.y3[i].y, c.y3[i].z, c.y3[i].w};
        const unsigned xq[4] = {c.xw[i].x, c.xw[i].y, c.xw[i].z, c.xw[i].w};
        const float4 gta = *(const float4*)(m + k), gtb = *(const float4*)(m + k + 4);
        const float gt[8] = {gta.x, gta.y, gta.z, gta.w, gtb.x, gtb.y, gtb.z, gtb.w};
#pragma unroll
        for (int q = 0; q < 4; ++q) {
            const float ylo = g.x * __uint_as_float(a0[q] << 16) + g.y * __uint_as_float(a1[q] << 16) + g.z * __uint_as_float(a2[q] << 16) + g.w * __uint_as_float(a3[q] << 16);
            const float yhi = g.x * __uint_as_float(a0[q] & 0xffff0000u) + g.y * __uint_as_float(a1[q] & 0xffff0000u) + g.z * __uint_as_float(a2[q] & 0xffff0000u) + g.w * __uint_as_float(a3[q] & 0xffff0000u);
            const float v0 = __uint_as_float(xq[q] << 16) + gt[2 * q] * ylo, v1 = __uint_as_float(xq[q] & 0xffff0000u) + gt[2 * q + 1] * yhi;
            xv[8 * i + 2 * q] = v0; xv[8 * i + 2 * q + 1] = v1; ss += v0 * v0 + v1 * v1;
        }
    }
    ss = wave_sum(ss);
    const float rstd = rsqrtf(ss * (1.f / D) + EPS);
    if (l == 0) {
        const float* m1 = p.mod + ((size_t)5 + mod_row(row)) * 6144;
        const float* g1 = p.g_mix + D;
#pragma unroll
        for (int i = 0; i < 2; ++i) {
            const int k = lane * 8 + 512 * i;
            { u32x4 xo; xo.x = cvtpk(xv[8 * i], xv[8 * i + 1]); xo.y = cvtpk(xv[8 * i + 2], xv[8 * i + 3]); xo.z = cvtpk(xv[8 * i + 4], xv[8 * i + 5]); xo.w = cvtpk(xv[8 * i + 6], xv[8 * i + 7]); *(u32x4*)(p.X + (size_t)row * D + k) = xo; }
            const float4 ga = *(const float4*)(g1 + k), gb = *(const float4*)(g1 + k + 4);
            const float4 sha = *(const float4*)(m1 + k), shb = *(const float4*)(m1 + k + 4);
            const float4 sca = *(const float4*)(m1 + 1024 + k), scb = *(const float4*)(m1 + 1024 + k + 4);
            u32x4 o;
            o.x = cvtpk(xv[8 * i] * rstd * ga.x * (1.f + sca.x) + sha.x, xv[8 * i + 1] * rstd * ga.y * (1.f + sca.y) + sha.y);
            o.y = cvtpk(xv[8 * i + 2] * rstd * ga.z * (1.f + sca.z) + sha.z, xv[8 * i + 3] * rstd * ga.w * (1.f + sca.w) + sha.w);
            o.z = cvtpk(xv[8 * i + 4] * rstd * gb.x * (1.f + scb.x) + shb.x, xv[8 * i + 5] * rstd * gb.y * (1.f + scb.y) + shb.y);
            o.w = cvtpk(xv[8 * i + 6] * rstd * gb.z * (1.f + scb.z) + shb.z, xv[8 * i + 7] * rstd * gb.w * (1.f + scb.w) + shb.w);
            *(u32x4*)(p.H + (size_t)row * D + k) = o;
        }
    } else {
#pragma unroll
        for (int i = 0; i < 2; ++i) {
            const int k = lane * 8 + 512 * i;
            const float4 ga = *(const float4*)(p.g_final + k), gb = *(const float4*)(p.g_final + k + 4);
            float* op = p.out + (size_t)row * D + k;
            *(float4*)op = make_float4(xv[8 * i] * rstd * ga.x, xv[8 * i + 1] * rstd * ga.y, xv[8 * i + 2] * rstd * ga.z, xv[8 * i + 3] * rstd * ga.w);
            *(float4*)(op + 4) = make_float4(xv[8 * i + 4] * rstd * gb.x, xv[8 * i + 5] * rstd * gb.y, xv[8 * i + 6] * rstd * gb.z, xv[8 * i + 7] * rstd * gb.w);
        }
    }
}
__device__ __forceinline__ void ph_combine(const P& p, int l, int nrows, const int wv) {
    const int wave = ltid(wv) >> 6, lane = ltid(wv) & 63;
    for (int pr = blockIdx.x * 8 + wave; pr < nrows / 2; pr += gridDim.x * 8) {
        CombRow ca, cb;
        comb_load(ca, p.YB, p.X, p.tok_slot, p.topi, p.topg, 2 * pr, lane);
        comb_load(cb, p.YB, p.X, p.tok_slot, p.topi, p.topg, 2 * pr + 1, lane);
        comb_finish(p, ca, l, 2 * pr, lane);
        comb_finish(p, cb, l, 2 * pr + 1, lane);
    }
}
__global__ void __launch_bounds__(NT, 2) mega(P p) {
    char* lds = smem;
    int wv = __builtin_amdgcn_readfirstlane((int)(threadIdx.x >> 6)); asm volatile("" : "+s"(wv));
    if (threadIdx.x == 0) *(uint4*)(smem + LDS_MAIN) = make_uint4(0u, 0u, 0u, 0u);
    __syncthreads();
    XcdBarrier bar = xcd_barrier_post(p.bar, (volatile LAS unsigned*)(smem + LDS_MAIN), wv);
    ph_prologue(p, lds, 0, wv);
    xcd_barrier(bar);
    ph_norm1(p, 0, wv);
    ph_prologue(p, lds, 1, wv);
    xcd_barrier(bar);
#define MEGA_LAYER(l, nrows, LAST) do { \
        ph_gemm_proj(p, l, lds, wv); xcd_barrier(bar); \
        ph_dattn(p, l, nrows, lds, wv); ph_na(p, l, nrows, lds, wv); ph_pool(p, l, nrows, lds, wv); ph_sgu(p, l, nrows, lds, wv); xcd_barrier(bar); \
        ph_gemm_out(p, l, nrows, lds, wv); xcd_barrier(bar); \
        ph_router(p, l, nrows, lds, wv); xcd_barrier(bar); \
        ph_moe_tables(p, l, wv); ph_moe1(p, l, lds, wv); xcd_barrier(bar); \
        ph_moe2(p, l, lds, wv); xcd_barrier(bar); \
        ph_combine(p, l, nrows, wv); if (!(LAST)) xcd_barrier(bar); } while (0)
    MEGA_LAYER(0, R, false);
    MEGA_LAYER(1, T, true);
#undef MEGA_LAYER
}

static inline size_t align_up(size_t v, size_t a) { return (v + a - 1) / a * a; }

extern "C" void kernel_launch(void* const* d_in, const int* in_sizes, int n_in, void* d_out, int out_size, void* d_ws, size_t ws_size, hipStream_t stream) {
    P p{};
    const float** ins = (const float**)&p.x;
    for (int i = 0; i < 28; ++i) ins[i] = (const float*)d_in[i];
    p.out = (float*)d_out;
    char* w = (char*)d_ws; size_t off = 0;
    auto carve = [&](size_t bytes) { void* r = w + off; off = align_up(off + bytes, 256); return r; };
    const size_t ctl_bytes = XCD_BAR_WORDS * 4 + 2 * 64 * 4;
    p.bar = (unsigned*)carve(ctl_bytes);
    p.cnt = (int*)(p.bar + XCD_BAR_WORDS);
    p.mod = (float*)carve((size_t)2 * 5 * 6144 * 4);
    p.rope = (float*)carve(64 * 8 * 2 * 4);
    p.RG = (float*)carve((size_t)2 * 5 * 1024 * 4);
    p.RB = (float*)carve((size_t)2 * 5 * 32 * 4);
    p.X = (bf16_t*)carve((size_t)R * D * 2);
    p.H = (bf16_t*)carve((size_t)R * D * 2);
    p.PROJ = (bf16_t*)carve((size_t)R * PW * 2);
    p.MIX = (bf16_t*)carve((size_t)R * D * 2);
    p.WinT = (bf16_t*)carve((size_t)2 * PW * D * 2);
    p.WoutT = (bf16_t*)carve((size_t)2 * D * D * 2);
    p.WguT = (unsigned char*)carve((size_t)2 * NE * 2048 * D);
    p.WdnT = (unsigned char*)carve((size_t)2 * NE * D * FF);
    p.WpT = (bf16_t*)carve((size_t)2 * 4 * 64 * 64 * 2);
    p.WsB = (bf16_t*)carve((size_t)2 * 4 * 128 * 128 * 2);
    p.topi = (int*)carve((size_t)R * 4 * 4);
    p.topg = (float*)carve((size_t)R * 4 * 4);
    p.tok_slot = (int*)carve((size_t)R * 4 * 4);
    p.HS = (unsigned char*)carve((size_t)R * D);
    p.slot_tok = (int*)carve((size_t)NE * ECAP * 4);
    p.ACT = (unsigned char*)carve((size_t)NSLOT * FF);
    p.YB = (bf16_t*)carve((size_t)NSLOT * D * 2);

    static int grid = 0;
    if (!grid) {
        int dev = 0, cus = 0, per_cu = 0;
        (void)hipGetDevice(&dev);
        (void)hipDeviceGetAttribute(&cus, hipDeviceAttributeMultiprocessorCount, dev);
        (void)hipFuncSetAttribute((const void*)mega, hipFuncAttributeMaxDynamicSharedMemorySize, LDS_BYTES);
        (void)hipOccupancyMaxActiveBlocksPerMultiprocessor(&per_cu, mega, NT, LDS_BYTES);
        grid = cus * (per_cu < 1 ? per_cu : 1);
        if (grid <= 0) { fprintf(stderr, "mega: occupancy query returned %d blocks per CU\n", per_cu); grid = 0; return; }
    }
    (void)hipMemsetAsync(p.bar, 0, ctl_bytes, stream);
    mega<<<grid, NT, LDS_BYTES, stream>>>(p);
}
```

```cpp
#include <hip/hip_runtime.h>
#include <stdint.h>
#include <cstdio>
#include <type_traits>

typedef unsigned short bf16_t;
typedef short bf16x8 __attribute__((ext_vector_type(8)));
typedef float f32x4 __attribute__((ext_vector_type(4)));

constexpr int D = 1024, NB = 4, S = 4096, T = NB * S, CL = 256, TC = NB * CL, R = T + TC;
constexpr int PW = 2304, NE = 32, TOPK = 4, FF = 1024;
constexpr int MAXSLOT = R * TOPK;
constexpr int NSLOT = MAXSLOT + NE * 256;
constexpr float EPS = 1e-6f;
constexpr int NT = 512;
constexpr int LDS_MAIN = 150 * 1024;
constexpr int LDS_BYTES = LDS_MAIN + 1024;
constexpr int MT_TSTART = LDS_MAIN + 64, MT_ECNT = LDS_MAIN + 192, MT_TILE_E = LDS_MAIN + 320;
constexpr int ECAP = R;

__device__ __forceinline__ bf16_t f2bf(float f) { unsigned u = __float_as_uint(f); return (bf16_t)((u + 0x7fffu + ((u >> 16) & 1u)) >> 16); }
__device__ __forceinline__ float bf2f(bf16_t h) { return __uint_as_float(((unsigned)h) << 16); }
template <int K>
__device__ __forceinline__ float xshfl(float v) {
    if constexpr (K == 32) { auto rr = __builtin_amdgcn_permlane32_swap(__float_as_uint(v), __float_as_uint(v), false, false); return __uint_as_float(((__builtin_amdgcn_mbcnt_hi(~0u, __builtin_amdgcn_mbcnt_lo(~0u, 0u)) & 32u) ? rr[0] : rr[1])); }
    else return __int_as_float(__builtin_amdgcn_ds_swizzle(__float_as_int(v), (K << 10) | 0x1f));
}
__device__ __forceinline__ float wave_sum(float v) {
    { auto rr = __builtin_amdgcn_permlane32_swap(__float_as_uint(v), __float_as_uint(v), false, false); v = __uint_as_float(rr[0]) + __uint_as_float(rr[1]); }
    v += xshfl<16>(v); v += xshfl<8>(v); v += xshfl<4>(v); v += xshfl<2>(v); v += xshfl<1>(v);
    return v;
}
__device__ __forceinline__ int mod_row(int row) { return row < T ? (row >> 12) : 4; }

#define XB_TMO      128
#define XB_XCNT(j)  (256  + 64 * (j))
#define XB_XSUB(j)  (1280 + 64 * (j))
#define XB_XGEN(j)  (2304 + 64 * (j))
#define XB_TOP      3328
#define XB_TOPGEN   3392
#define XCD_BAR_WORDS 3456
#define XB_SPIN_CAP (1u << 18)
#define LAS __attribute__((address_space(3)))

__device__ __forceinline__ unsigned xb_ld(unsigned* p)              { return __hip_atomic_load(p, __ATOMIC_RELAXED, __HIP_MEMORY_SCOPE_AGENT); }
__device__ __forceinline__ unsigned xb_add(unsigned* p, unsigned v) { return __hip_atomic_fetch_add(p, v, __ATOMIC_RELAXED, __HIP_MEMORY_SCOPE_AGENT); }
__device__ __forceinline__ unsigned xb_xcc_id() { return (unsigned)__builtin_amdgcn_s_getreg((3 << 11) | 20) & 0xFu; }
#define XB_SPIN(cond, bar) do { unsigned _sp = 0; while (cond) { __builtin_amdgcn_s_sleep(1); \
    if ((++_sp & 255u) == 0u) { if (xb_ld(&(bar)[XB_TMO])) break; if (_sp > XB_SPIN_CAP) { atomicAdd(&(bar)[XB_TMO], 1u); break; } } } } while (0)

struct XcdBarrier {
    unsigned* bar; unsigned x;
    volatile LAS unsigned* st;
    int wv;
};
__device__ __forceinline__ bool xb_t0(const int wv) { return wv == 0 && __builtin_amdgcn_mbcnt_hi(~0u, __builtin_amdgcn_mbcnt_lo(~0u, 0u)) == 0u; }
__device__ __forceinline__ XcdBarrier xcd_barrier_post(unsigned* bar, volatile LAS unsigned* st, const int wv) {
    XcdBarrier b; b.bar = bar; b.x = xb_xcc_id(); b.st = st; b.wv = wv;
    if (xb_t0(wv)) (void)xb_add(&bar[XB_XCNT(b.x)], 1u);
    return b;
}
__device__ __forceinline__ void xcd_barrier_complete(unsigned* bar, unsigned x, unsigned& nloc, unsigned& nx) {
    const unsigned G = gridDim.x * gridDim.y * gridDim.z;
    unsigned sum, cnt, mine, sp = 0u;
    for (;;) {
        sum = 0u; cnt = 0u; mine = 0u;
#pragma unroll
        for (unsigned j = 0; j < 16; ++j) { const unsigned c = xb_ld(&bar[XB_XCNT(j)]); sum += c; cnt += (c > 0u) ? 1u : 0u; mine = (j == x) ? c : mine; }
        if (sum == G) break;
        __builtin_amdgcn_s_sleep(1);
        if ((++sp & 255u) == 0u) { if (xb_ld(&bar[XB_TMO])) break; if (sp > XB_SPIN_CAP) { atomicAdd(&bar[XB_TMO], 1u); break; } }
    }
    nloc = mine > 0u ? mine : 1u; nx = cnt > 0u ? cnt : 1u;
}
__device__ __forceinline__ void xcd_barrier(const XcdBarrier& b) {
    asm volatile("s_waitcnt vmcnt(0)" ::: "memory");
    __syncthreads();
    if (xb_t0(b.wv)) {
        unsigned* bar = b.bar;
        __builtin_amdgcn_s_waitcnt(0);
        unsigned nloc = b.st[0], nx = b.st[1];
        if (nloc == 0u) { xcd_barrier_complete(bar, b.x, nloc, nx); b.st[0] = nloc; b.st[1] = nx; }
        const unsigned old = xb_add(&bar[XB_XSUB(b.x)], 1u);
        const unsigned gen = old / nloc;
        if (old + 1u == (gen + 1u) * nloc) {
            __builtin_amdgcn_fence(__ATOMIC_RELEASE, "agent");
            asm volatile("s_waitcnt vmcnt(0)" ::: "memory");
            const unsigned og = xb_add(&bar[XB_TOP], 1u);
            const unsigned tg = og / nx;
            if (og + 1u == (tg + 1u) * nx) xb_add(&bar[XB_TOPGEN], 1u);
            else XB_SPIN(xb_ld(&bar[XB_TOPGEN]) == tg, bar);
            __builtin_amdgcn_fence(__ATOMIC_ACQUIRE, "agent");
            xb_add(&bar[XB_XGEN(b.x)], 1u);
            asm volatile("s_waitcnt vmcnt(0)" ::: "memory");
        } else {
            XB_SPIN(xb_ld(&bar[XB_XGEN(b.x)]) == gen, bar);
            __builtin_amdgcn_fence(__ATOMIC_ACQUIRE, "agent");
            asm volatile("s_waitcnt vmcnt(0)" ::: "memory");
        }
    }
    __syncthreads();
}

struct P {
    const float *x, *c, *ctx, *c_ctx, *w_mod, *b_mod, *g_mix, *g_ffn, *w_in, *w_out, *lam_q1, *lam_k1, *lam_q2, *lam_k2, *g_sub,
        *w_pool, *s_pool, *g_sgu, *w_sgu, *b_sgu, *rpb, *w_router, *b_router, *w_gu, *b_gu, *w_down, *b_down, *g_final;
    float* out;
    unsigned* bar;
    int* cnt;
    float* mod;
    float* rope;
    float* RG;
    float* RB;
    float* BT;
    bf16_t* X;
    bf16_t* H;
    bf16_t* PROJ;
    bf16_t* MIX;
    bf16_t* WinT;
    bf16_t* WoutT;
    unsigned char* WguT;
    unsigned char* WdnT;
    bf16_t* WpT;
    bf16_t* WsB;
    int* topi;
    float* topg;
    int* tok_slot;
    unsigned char* HS;
    int* slot_tok;
    unsigned char* ACT;
    bf16_t* YB;
    unsigned* kmx;
};

extern __shared__ __attribute__((aligned(16))) char smem[];
__device__ __forceinline__ char* smem_base() { return smem; }
__device__ __forceinline__ int ltid(const int wv) { int t; asm volatile("v_mbcnt_lo_u32_b32 %0, -1, 0\n\tv_mbcnt_hi_u32_b32 %0, -1, %0\n\tv_lshl_or_b32 %0, %1, 6, %0" : "=&v"(t) : "s"(wv)); return t; }
typedef float f32x16 __attribute__((ext_vector_type(16)));
typedef short s16x4 __attribute__((ext_vector_type(4)));
typedef short v4i16_t __attribute__((ext_vector_type(4)));
typedef float f32x2_t __attribute__((ext_vector_type(2)));
typedef __bf16 bf16x2_t __attribute__((ext_vector_type(2)));
typedef __attribute__((address_space(3))) const char* lds_cptr;
typedef unsigned u32x4 __attribute__((ext_vector_type(4)));
__device__ __forceinline__ unsigned cvtpk(float lo, float hi) { f32x2_t v = {lo, hi}; bf16x2_t b = __builtin_convertvector(v, bf16x2_t); return __builtin_bit_cast(unsigned, b); }
__device__ __forceinline__ s16x4 vtr(lds_cptr q) { return __builtin_bit_cast(s16x4, __builtin_amdgcn_ds_read_tr16_b64_v4i16((__attribute__((address_space(3))) v4i16_t*)q)); }
__device__ __forceinline__ float xhalf_max(float v) { auto rr = __builtin_amdgcn_permlane32_swap(__float_as_uint(v), __float_as_uint(v), false, false); return fmaxf(__uint_as_float(rr[0]), __uint_as_float(rr[1])); }
__device__ __forceinline__ float xhalf_sum(float v) { auto rr = __builtin_amdgcn_permlane32_swap(__float_as_uint(v), __float_as_uint(v), false, false); return __uint_as_float(rr[0]) + __uint_as_float(rr[1]); }
namespace pg8 {
#define PG8_LAS __attribute__((address_space(3)))
constexpr int BM = 256, BK = 64, HALF = 128, HTB = HALF * BK * 2  , STAGE_BYTES = 8 * HTB, NXCD = 8, WGM = 8;
__host__ __device__ __forceinline__ int lds_byte(int r, int c) { const int st = (r >> 4) * 2 + (c >> 5), rr = r & 15, cc = c & 31, ob = rr * 64 + cc * 2; return st * 1024 + (ob ^ (((ob >> 9) & 1) << 5)); }
__host__ __device__ __forceinline__ void stage_rc(int b, int& R, int& C) { const int st = b / 1024, sb = b % 1024, swz = sb ^ (((sb >> 9) & 1) << 5); R = (st >> 1) * 16 + swz / 64; C = (st & 1) * 32 + (swz % 64) / 2; }
__host__ __device__ __forceinline__ int perm32(int rho) { const int n = rho >> 4, i = rho & 15; return 8 * (i >> 2) + 4 * n + (i & 3); }
struct Unit { int pm, pn, e, half; };
struct Gemm { const bf16_t* A; const bf16_t* Bt; int M, N, K; };
template <bool HALVES>
struct StaticOrderT {
    int nM, nN, nwg, G, c, nfull, nhalf;
    __host__ __device__ void init(int M, int N, int G_, int c_) { nM = M / BM; nN = N / BM; nwg = nM * nN; G = G_; c = c_;
        const int rem = nwg % G_; nfull = nwg; nhalf = 0; if (HALVES && rem > 0 && 2 * rem <= G_ && nwg - rem >= G_) { nfull = nwg - rem; nhalf = 2 * rem; } }
    __host__ __device__ bool next(int i, Unit& u) const {
        const long L = (long)i * G + c; if (L >= nfull + nhalf) return false;
        int wgid = (int)L; u.half = 0;
        if (wgid >= nfull) { const int j = wgid - nfull; wgid = nfull + (j >> 1); u.half = 1 + (j & 1); }
        { const int q = nwg / NXCD, r = nwg % NXCD, xcd = wgid % NXCD, off = wgid / NXCD; wgid = (xcd < r ? xcd * (q + 1) : r * (q + 1) + (xcd - r) * q) + off; }
        const int nig = WGM * nN, gid = wgid / nig, fm = gid * WGM, gsz = (nM - fm) < WGM ? (nM - fm) : WGM;
        u.pm = fm + ((wgid % nig) % gsz); u.pn = (wgid % nig) / gsz; u.e = 0; return true;
    }
    static constexpr bool GATHER = false;
    __device__ __forceinline__ const bf16_t* bt(const Gemm& g, const Unit&) const { return g.Bt; }
    __device__ __forceinline__ void a_ready(const Unit&) const {}
    __device__ __forceinline__ void done(const Unit&) const {}
};
typedef StaticOrderT<false> StaticOrder;
typedef StaticOrderT<true> StaticOrderH;
typedef int v4i_t __attribute__((ext_vector_type(4)));
typedef int v8i_t __attribute__((ext_vector_type(8)));
__device__ __forceinline__ v8i_t cat8(bf16x8 a, bf16x8 b) { const v4i_t x = __builtin_bit_cast(v4i_t, a), y = __builtin_bit_cast(v4i_t, b); return __builtin_shufflevector(x, y, 0, 1, 2, 3, 4, 5, 6, 7); }
template <class Epi, class Sched, bool ALIGN_EPI = false, bool SP2 = false, bool F8 = false>
__device__ __forceinline__ void gemm_phase(PG8_LAS unsigned char* lds, const Gemm g, const Sched& S, const Epi& E, const int wv) {
    const int tid = ltid(wv), wid = __builtin_amdgcn_readfirstlane(tid >> 6), lane = tid & 63, wr = wid >> 2, wc = wid & 3, fr = lane & 15, fq = lane >> 4;
    const int K = g.K, nt = K / BK;
    unsigned voffA[2], voffB[2];
#pragma unroll
    for (int i = 0; i < 2; ++i) { int R, C; stage_rc(tid * 16 + i * 8192, R, C); const int Rb = Epi::WIDE ? ((R >> 5) * 64 + perm32(R & 31)) : Epi::PERM ? ((R & ~31) + perm32(R & 31)) : R;
        voffA[i] = (unsigned)(R * K + C) * 2u; voffB[i] = (unsigned)(Rb * K + C) * 2u; }
    int gR[2] = {0, 0}; unsigned gC[2] = {0u, 0u};
    PG8_LAS int* gtab = (PG8_LAS int*)(lds + STAGE_BYTES);
    if constexpr (Sched::GATHER) {
        static_assert(SP2, "gather is wired into the SP2 pipeline only");
#pragma unroll
        for (int i = 0; i < 2; ++i) { int R, C; stage_rc(tid * 16 + i * 8192, R, C); gR[i] = R; gC[i] = (unsigned)C * 2u; }
    }
#define PG8_GATHER(u_, sel_) do { if (tid < 256) gtab[(sel_) * 256 + tid] = S.tok((u_).pm * 256 + tid); } while (0)
    const size_t kstep = (size_t)(BK * 2);
    const size_t hstep = (size_t)HALF * K * 2;
    const size_t tstep = 2 * hstep;
    const size_t bstep = Epi::WIDE ? (size_t)32 * K * 2 : hstep;
    const unsigned ldsw = (unsigned)wid * 1024u;
    const int aoff = lds_byte(wr * 64 + fr, fq * 8), boff = lds_byte(wc * 32 + fr, fq * 8);
#define PG8_SA(b, h) (((b) * 2 + (h)) * HTB)
#define PG8_SB(b, h) ((4 + (b) * 2 + (h)) * HTB)
#define PG8_STAGE(bufoff, gbase, voff) do { _Pragma("unroll") for (int _i = 0; _i < 2; ++_i) \
        __builtin_amdgcn_global_load_lds((const unsigned*)((const char*)(gbase) + (voff)[_i]), (PG8_LAS unsigned*)(lds + (bufoff) + ldsw + _i * 8192), 16, 0, 0); } while (0)
#define PG8_STAGE_A(bufoff, gbase, h, nx) do { if constexpr (Sched::GATHER) { _Pragma("unroll") for (int _i = 0; _i < 2; ++_i) \
        __builtin_amdgcn_global_load_lds((const unsigned*)((const char*)(gbase) + ((unsigned)gtab[(((ui + ((nx) ? 1 : 0)) & 1)) * 256 + (h) * HALF + gR[_i]] * (unsigned)(K * 2) + gC[_i])), (PG8_LAS unsigned*)(lds + (bufoff) + ldsw + _i * 8192), 16, 0, 0); } \
        else { PG8_STAGE(bufoff, (gbase) + (h) * hstep, voffA); } } while (0)
#define PG8_LDA(dst, b, h) do { _Pragma("unroll") for (int m = 0; m < 4; ++m) _Pragma("unroll") for (int k = 0; k < 2; ++k) dst[m][k] = *(const PG8_LAS bf16x8*)(lds + PG8_SA(b, h) + aoff + m * 2048 + k * 1024); \
        if constexpr (F8) { _Pragma("unroll") for (int m = 0; m < 4; ++m) dst##8[m] = cat8(dst[m][0], dst[m][1]); } } while (0)
#define PG8_LDB(dst, b, h) do { _Pragma("unroll") for (int n = 0; n < 2; ++n) _Pragma("unroll") for (int k = 0; k < 2; ++k) dst[n][k] = *(const PG8_LAS bf16x8*)(lds + PG8_SB(b, h) + boff + n * 2048 + k * 1024); \
        if constexpr (F8) { _Pragma("unroll") for (int n = 0; n < 2; ++n) dst##8[n] = cat8(dst[n][0], dst[n][1]); } } while (0)
#define PG8_MMA(ai, bj, At, Bt) do { __builtin_amdgcn_s_setprio(1); \
        if constexpr (F8) { _Pragma("unroll") for (int m = 0; m < 4; ++m) _Pragma("unroll") for (int n = 0; n < 2; ++n) \
            asm volatile("v_mfma_scale_f32_16x16x128_f8f6f4 %0, %1, %2, %0, %3, %4 op_sel_hi:[0,0,0]" : "+v"(acc[ai][bj][m][n]) : "v"(Bt##8[n]), "v"(At##8[m]), "v"(sclW), "v"(sclX)); } \
        else { _Pragma("unroll") for (int m = 0; m < 4; ++m) _Pragma("unroll") for (int n = 0; n < 2; ++n) _Pragma("unroll") for (int k = 0; k < 2; ++k) \
            acc[ai][bj][m][n] = __builtin_amdgcn_mfma_f32_16x16x32_bf16(Bt[n][k], At[m][k], acc[ai][bj][m][n], 0, 0, 0); } \
        __builtin_amdgcn_s_setprio(0); } while (0)
#define PG8_WAIT_V(n) asm volatile("s_waitcnt vmcnt(" #n ")" ::: "memory")
#define PG8_WAIT_L(n) asm volatile("s_waitcnt lgkmcnt(" #n ")" ::: "memory")
#define PG8_BAR __builtin_amdgcn_s_barrier()
#define PG8_SCHED __builtin_amdgcn_sched_barrier(0)
    Unit cur, nxt; int ui = 0;
    typename Epi::Pre pre;
    if (!S.next(0, cur)) return;
    f32x4 acc[2][2][4][2];
    bf16x8 At[4][2], B0[2][2], B1[2][2];
    v8i_t At8[4], B08[2], B18[2];
    const int sclW = 0x79797979, sclX = 0x7f7f7f7f;
    const char* cA = (const char*)g.A + (Sched::GATHER ? (size_t)0 : (size_t)cur.pm * tstep); const char* cB = (const char*)S.bt(g, cur) + (size_t)cur.pn * tstep + (cur.half == 2 ? (Epi::WIDE ? bstep : hstep) : (size_t)0);
    if constexpr (Sched::GATHER) { PG8_GATHER(cur, 0); __syncthreads(); }
    S.a_ready(cur);
    if constexpr (SP2) {
        PG8_STAGE(PG8_SB(0, 0), cB, voffB); PG8_STAGE(PG8_SB(0, 1), cB + bstep, voffB); PG8_STAGE_A(PG8_SA(0, 0), cA, 0, false); PG8_STAGE_A(PG8_SA(0, 1), cA, 1, false);
        if (wr == 1) PG8_BAR;
        PG8_WAIT_V(2); PG8_BAR;
        PG8_STAGE(PG8_SB(1, 0), cB + kstep, voffB); PG8_STAGE_A(PG8_SA(1, 0), cA + kstep, 0, false); PG8_STAGE(PG8_SB(1, 1), cB + bstep + kstep, voffB);
        PG8_WAIT_V(6); PG8_BAR;
    } else {
        PG8_STAGE(PG8_SB(0, 0), cB, voffB); PG8_STAGE(PG8_SA(0, 0), cA, voffA); PG8_STAGE(PG8_SB(0, 1), cB + bstep, voffB); PG8_STAGE(PG8_SA(0, 1), cA + hstep, voffA);
        if (wr == 1) PG8_BAR;
        PG8_WAIT_V(4); PG8_BAR;
        PG8_STAGE(PG8_SB(1, 0), cB + kstep, voffB); PG8_STAGE(PG8_SA(1, 0), cA + kstep, voffA); PG8_STAGE(PG8_SB(1, 1), cB + bstep + kstep, voffB);
        PG8_WAIT_V(6); PG8_BAR;
    }
    for (;;) {
        const bool has_next = S.next(ui + 1, nxt);
        const char* nA = Sched::GATHER ? cA : (has_next ? (const char*)g.A + (size_t)nxt.pm * tstep : cA); const char* nB = has_next ? (const char*)S.bt(g, nxt) + (size_t)nxt.pn * tstep + (nxt.half == 2 ? (Epi::WIDE ? bstep : hstep) : (size_t)0) : cB;
        if constexpr (Sched::GATHER) { if (has_next) PG8_GATHER(nxt, (ui + 1) & 1); else if (tid < 256) gtab[((ui + 1) & 1) * 256 + tid] = gtab[(ui & 1) * 256 + tid]; }
        E.prefetch(pre, cur, wr, wc, fr, fq);
        E.init_acc(acc, pre);
#pragma unroll 1
        for (int t = 0; t < nt; t += 2) {
            const bool last = (t == nt - 2);
            const char* a1 = cA + (size_t)(t + 1) * kstep;
            const char* a2 = last ? nA : cA + (size_t)(t + 2) * kstep; const char* b2 = last ? nB : cB + (size_t)(t + 2) * kstep;
            const char* a3 = a2 + kstep; const char* b3 = b2 + kstep;
            if (last && has_next) S.a_ready(nxt);
            const bool ch = cur.half != 0, th = (last && has_next) ? (nxt.half != 0) : ch, slow = ch || th;
            if constexpr (SP2) {
            PG8_LDB(B0, 0, 0); if (!ch) PG8_LDB(B1, 0, 1); PG8_SCHED; PG8_LDA(At, 0, 0); PG8_STAGE_A(PG8_SA(1, 1), a1, 1, false);
            if (slow) PG8_WAIT_V(4); else PG8_WAIT_V(8); PG8_WAIT_L(0); PG8_BAR; PG8_MMA(0, 0, At, B0); if (!ch) PG8_MMA(0, 1, At, B1); PG8_BAR; PG8_SCHED;
            PG8_LDA(At, 0, 1); PG8_STAGE(PG8_SB(0, 0), b2, voffB); if (!th) PG8_STAGE(PG8_SB(0, 1), b2 + bstep, voffB); PG8_STAGE_A(PG8_SA(0, 0), a2, 0, last);
            if (slow) PG8_WAIT_V(4); else PG8_WAIT_V(8); PG8_WAIT_L(0); PG8_BAR; PG8_MMA(1, 0, At, B0); if (!ch) PG8_MMA(1, 1, At, B1); PG8_BAR; PG8_SCHED;
            PG8_LDB(B0, 1, 0); if (!ch) PG8_LDB(B1, 1, 1); PG8_SCHED; PG8_LDA(At, 1, 0); PG8_STAGE_A(PG8_SA(0, 1), a2, 1, last);
            if (slow) PG8_WAIT_V(4); else PG8_WAIT_V(8); PG8_WAIT_L(0); PG8_BAR; PG8_MMA(0, 0, At, B0); if (!ch) PG8_MMA(0, 1, At, B1); PG8_BAR; PG8_SCHED;
            PG8_LDA(At, 1, 1); PG8_STAGE(PG8_SB(1, 0), b3, voffB); if (!th) PG8_STAGE(PG8_SB(1, 1), b3 + bstep, voffB); PG8_STAGE_A(PG8_SA(1, 0), a3, 0, last);
            if (slow) PG8_WAIT_V(4); else PG8_WAIT_V(8); PG8_WAIT_L(0); PG8_BAR; PG8_MMA(1, 0, At, B0); if (!ch) PG8_MMA(1, 1, At, B1); PG8_BAR; PG8_SCHED;
            } else {
            PG8_LDB(B0, 0, 0); PG8_SCHED; PG8_LDA(At, 0, 0); PG8_STAGE(PG8_SA(1, 1), a1 + hstep, voffA);
            PG8_WAIT_L(8); PG8_BAR; PG8_WAIT_L(0); PG8_MMA(0, 0, At, B0); PG8_BAR; PG8_SCHED;
            PG8_LDB(B1, 0, 1); PG8_STAGE(PG8_SB(0, 0), b2, voffB);
            PG8_BAR; PG8_WAIT_L(0); PG8_MMA(0, 1, At, B1); PG8_BAR;
            PG8_LDA(At, 0, 1); PG8_STAGE(PG8_SA(0, 0), a2, voffA);
            PG8_BAR; PG8_WAIT_L(0); PG8_MMA(1, 0, At, B0); PG8_BAR; PG8_SCHED;
            PG8_STAGE(PG8_SB(0, 1), b2 + bstep, voffB);
            PG8_WAIT_V(6); PG8_BAR; PG8_MMA(1, 1, At, B1); PG8_BAR;
            PG8_LDB(B0, 1, 0); PG8_SCHED; PG8_LDA(At, 1, 0); PG8_STAGE(PG8_SA(0, 1), a2 + hstep, voffA);
            PG8_WAIT_L(8); PG8_BAR; PG8_WAIT_L(0); PG8_MMA(0, 0, At, B0); PG8_BAR; PG8_SCHED;
            PG8_LDB(B1, 1, 1); PG8_STAGE(PG8_SB(1, 0), b3, voffB);
            PG8_BAR; PG8_WAIT_L(0); PG8_MMA(0, 1, At, B1); PG8_BAR;
            PG8_LDA(At, 1, 1); PG8_STAGE(PG8_SA(1, 0), a3, voffA);
            PG8_BAR; PG8_WAIT_L(0); PG8_MMA(1, 0, At, B0); PG8_BAR; PG8_SCHED;
            PG8_STAGE(PG8_SB(1, 1), b3 + bstep, voffB);
            PG8_WAIT_V(6); PG8_BAR; PG8_MMA(1, 1, At, B1); PG8_BAR;
            }
        }
        if constexpr (ALIGN_EPI) { if (wr == 0) PG8_BAR; }
        if constexpr (F8) asm volatile("s_nop 15\n\ts_nop 15" ::: "memory");
        if constexpr (!Epi::AFTER_DRAIN) { E(acc, cur, wr, wc, fr, fq, pre); S.done(cur); }
        if (!has_next) break;
        cur = nxt; cA = nA; cB = nB; ++ui;
        if constexpr (ALIGN_EPI) { if (wr == 1) PG8_BAR; }
    }
    PG8_WAIT_V(0);
    if constexpr (!ALIGN_EPI) { if (wr == 0) PG8_BAR; }
    PG8_BAR;
    if constexpr (Epi::AFTER_DRAIN) { E.fused(acc, cur, wr, wc, fr, fq, lds, wid, lane); S.done(cur); }
#undef PG8_SA
#undef PG8_SB
#undef PG8_STAGE
#undef PG8_STAGE_A
#undef PG8_GATHER
#undef PG8_LDA
#undef PG8_LDB
#undef PG8_MMA
#undef PG8_WAIT_V
#undef PG8_WAIT_L
#undef PG8_BAR
#undef PG8_SCHED
}
}

__device__ __forceinline__ void ph_prologue(const P& p, char* lds, const int part, const int wv) {
    const int tid = ltid(wv);
    float* fl = (float*)lds;
    if (part == 0) {
    const int gi_ = (int)blockIdx.x * NT + tid;
    const bool one_ = (int)gridDim.x * NT >= 2 * 4 * 128 * 128;
    float pre_bt = 0.f, pre_wp = 0.f, pre_ws = 0.f;
    if (one_) {
        if (gi_ < 2 * 4 * 15 * 128) { const int j = (gi_ & 127) - 48, rw = (gi_ >> 7) % 15, lh = gi_ / (15 * 128); if (j >= 0 && j < 31) pre_bt = p.rpb[(size_t)lh * 465 + rw * 31 + j]; }
        if (gi_ < 2 * 4 * 64 * 64) { const int ii = gi_ & 63, j = (gi_ >> 6) & 63, lg = gi_ >> 12; pre_wp = p.w_pool[(size_t)lg * 4096 + ii * 64 + j]; }
        if (gi_ < 2 * 4 * 128 * 128) pre_ws = p.w_sgu[gi_];
    }
    for (int it = blockIdx.x; it < 192; it += gridDim.x) {
        const int l = it / 96, cg = it % 96;
        float* sc = fl;
        float* part = fl + 5 * 1024;
        __syncthreads();
        {
            float cvv[10];
#pragma unroll
            for (int j = 0; j < 10; ++j) { const int i = tid + NT * j, r = i >> 10, k = i & 1023; const float* src = r < 4 ? p.c + r * 1024 + k : p.c_ctx + k; cvv[j] = *src; }
#pragma unroll
            for (int j = 0; j < 10; ++j) { const float v = cvv[j]; sc[tid + NT * j] = v * __builtin_amdgcn_rcpf(1.f + __expf(-v)); }
        }
        __syncthreads();
        const int kq = tid >> 6, col = tid & 63, j = cg * 64 + col;
        const float* W = p.w_mod + (size_t)l * 1024 * 6144 + j;
        float a0 = 0, a1 = 0, a2 = 0, a3 = 0, a4 = 0;
        {
            const float* Wk = W + (size_t)(kq * 128) * 6144;
            float wb[2][16];
#pragma unroll
            for (int j = 0; j < 16; ++j) wb[0][j] = Wk[(size_t)j * 6144];
#pragma unroll
            for (int bb = 0; bb < 8; ++bb) {
                if (bb + 1 < 8) {
#pragma unroll
                    for (int j = 0; j < 16; ++j) wb[(bb + 1) & 1][j] = Wk[(size_t)((bb + 1) * 16 + j) * 6144];
                }
#pragma unroll
                for (int j = 0; j < 16; ++j) {
                    const int k = kq * 128 + bb * 16 + j; const float w = wb[bb & 1][j];
                    a0 += sc[k] * w; a1 += sc[1024 + k] * w; a2 += sc[2048 + k] * w; a3 += sc[3072 + k] * w; a4 += sc[4096 + k] * w;
                }
            }
        }
        part[(kq * 5 + 0) * 64 + col] = a0; part[(kq * 5 + 1) * 64 + col] = a1; part[(kq * 5 + 2) * 64 + col] = a2;
        part[(kq * 5 + 3) * 64 + col] = a3; part[(kq * 5 + 4) * 64 + col] = a4;
        __syncthreads();
        if (tid < 5 * 64) {
            const int r = tid >> 6, cc = tid & 63, jj = cg * 64 + cc;
            float v = 0.f;
#pragma unroll
            for (int q = 0; q < 8; ++q) v += part[(q * 5 + r) * 64 + cc];
            p.mod[((size_t)l * 5 + r) * 6144 + jj] = v + p.b_mod[l * 6144 + jj];
        }
    }
    if (blockIdx.x == gridDim.x - 1) {
        const int pos = tid >> 3, f = tid & 7;
        const float inv = powf(10000.0f, -(float)f / 8.0f);
        const float ang = (float)pos * inv;
        p.rope[tid * 2] = cosf(ang); p.rope[tid * 2 + 1] = sinf(ang);
    }
    for (int i = blockIdx.x * NT + tid; i < 2 * 4 * 15 * 128; i += gridDim.x * NT) { const int j = (i & 127) - 48, rw = (i >> 7) % 15, lh = i / (15 * 128); const float bv_ = one_ ? pre_bt * 1.4426950408889634f : ((j >= 0 && j < 31) ? p.rpb[(size_t)lh * 465 + rw * 31 + j] * 1.4426950408889634f : 0.f); p.BT[i] = bv_;
        float av_ = fabsf(bv_);
        av_ = fmaxf(av_, xshfl<32>(av_)); av_ = fmaxf(av_, xshfl<16>(av_)); av_ = fmaxf(av_, xshfl<8>(av_)); av_ = fmaxf(av_, xshfl<4>(av_)); av_ = fmaxf(av_, xshfl<2>(av_)); av_ = fmaxf(av_, xshfl<1>(av_));
        if ((tid & 63) == 0 && av_ > 0.f) atomicMax(p.kmx + 128 + lh, __float_as_uint(av_)); }
    for (int i = blockIdx.x * NT + tid; i < 2 * 4 * 64 * 64; i += gridDim.x * NT) { const int ii = i & 63, j = (i >> 6) & 63, lg = i >> 12; p.WpT[i] = f2bf(one_ ? pre_wp : p.w_pool[(size_t)lg * 4096 + ii * 64 + j]); }
    for (int i = blockIdx.x * NT + tid; i < 2 * 4 * 128 * 128; i += gridDim.x * NT) p.WsB[i] = f2bf(one_ ? pre_ws : p.w_sgu[i]);
    }
    if (part == 1) {
        for (int i = blockIdx.x * NT + tid; i < 2 * 5 * 1024; i += gridDim.x * NT) { const int k = i & 1023, lb = i >> 10, l_ = lb / 5; p.RG[i] = p.g_ffn[l_ * D + k] * (1.f + p.mod[(size_t)lb * 6144 + 4 * 1024 + k]); }
        for (int o = blockIdx.x * 8 + (tid >> 6); o < 2 * 5 * 32; o += gridDim.x * 8) {
            const int e = o & 31, lb = o >> 5, l_ = lb / 5, ln = tid & 63;
            const float* sh = p.mod + (size_t)lb * 6144 + 3 * 1024; const float* wr = p.w_router + (size_t)l_ * D * NE + e;
            float a = 0.f;
            for (int k = ln; k < 1024; k += 64) a += sh[k] * wr[(size_t)k * NE];
            a = wave_sum(a);
            if (ln == 0) p.RB[o] = a + p.b_router[l_ * NE + e];
        }
        const int n_in = 2 * 9 * 16, n_out = 2 * 4 * 16, total = n_in + n_out;
        const int kr = tid >> 6, n4 = tid & 63, kg = tid & 7, nl = tid >> 3;
        for (int it = blockIdx.x; it < total; it += gridDim.x) {
            int i_ = it; const float* W_; bf16_t* Wt_; int N, K;
            if (i_ < n_in) { W_ = p.w_in; Wt_ = p.WinT; N = PW; K = D; } else { i_ -= n_in; W_ = p.w_out; Wt_ = p.WoutT; N = D; K = D; }
            const int ntn = N / 256, per = ntn * (K / 64), m_ = i_ / per, r_ = i_ % per, tn = r_ % ntn, tk = r_ / ntn, n0 = tn * 256;
            const float* src = W_ + (size_t)m_ * K * N + (size_t)(tk * 64) * N + n0; bf16_t* dst = Wt_ + (size_t)m_ * K * N + tk * 64;
            float4 rg[8];
#pragma unroll
            for (int i = 0; i < 8; ++i) rg[i] = *(const float4*)(src + (size_t)(kr + 8 * i) * N + n4 * 4);
            __syncthreads();
#pragma unroll
            for (int i = 0; i < 8; ++i) { float* q = fl + (kr + 8 * i) * 257 + n4 * 4; q[0] = rg[i].x; q[1] = rg[i].y; q[2] = rg[i].z; q[3] = rg[i].w; }
            __syncthreads();
            if (it < n_in) {
                unsigned char* d8 = (unsigned char*)p.WinT + (size_t)m_ * K * N + tk * 64;
#pragma unroll
                for (int j = 0; j < 4; ++j) {
                    const int n = nl + 64 * j;
                    const float* q = fl + (8 * kg) * 257 + n;
                    typedef short pv2_t __attribute__((ext_vector_type(2)));
                    uint2 w;
                    { pv2_t r = {0, 0}; r = __builtin_amdgcn_cvt_scalef32_pk_fp8_f32(r, q[0], q[257], 0.015625f, false); r = __builtin_amdgcn_cvt_scalef32_pk_fp8_f32(r, q[2 * 257], q[3 * 257], 0.015625f, true); w.x = __builtin_bit_cast(unsigned, r); }
                    { pv2_t r = {0, 0}; r = __builtin_amdgcn_cvt_scalef32_pk_fp8_f32(r, q[4 * 257], q[5 * 257], 0.015625f, false); r = __builtin_amdgcn_cvt_scalef32_pk_fp8_f32(r, q[6 * 257], q[7 * 257], 0.015625f, true); w.y = __builtin_bit_cast(unsigned, r); }
                    *(uint2*)(d8 + (size_t)(n0 + n) * K + 8 * kg) = w;
                }
            } else {
#pragma unroll
            for (int j = 0; j < 4; ++j) {
                const int n = nl + 64 * j;
                const float* q = fl + (8 * kg) * 257 + n;
                u32x4 w;
                w.x = cvtpk(q[0], q[257]); w.y = cvtpk(q[2 * 257], q[3 * 257]); w.z = cvtpk(q[4 * 257], q[5 * 257]); w.w = cvtpk(q[6 * 257], q[7 * 257]);
                *(u32x4*)(dst + (size_t)(n0 + n) * K + 8 * kg) = w;
            }
            }
        }
    }
}

__device__ __forceinline__ void ph_norm1(const P& p, int l, const int wv) {
    const int wave = ltid(wv) >> 6, lane = ltid(wv) & 63;
    f32x4 gg[4];
#pragma unroll
    for (int i = 0; i < 4; ++i) gg[i] = *(const f32x4*)(p.g_mix + l * D + lane * 4 + 256 * i);
    for (int row = blockIdx.x * 8 + wave; row < R; row += gridDim.x * 8) {
        const float* xr = row < T ? p.x + (size_t)row * D : p.ctx + (size_t)(row - T) * D;
        const float* m = p.mod + ((size_t)l * 5 + mod_row(row)) * 6144;
        f32x4 v[4], sh[4], sc[4]; float ss = 0;
#pragma unroll
        for (int i = 0; i < 4; ++i) { const int k = lane * 4 + 256 * i; v[i] = *(const f32x4*)(xr + k); sh[i] = *(const f32x4*)(m + k); sc[i] = *(const f32x4*)(m + 1024 + k); }
        asm volatile("" : "+v"(v[0]), "+v"(v[1]), "+v"(v[2]), "+v"(v[3]), "+v"(sh[0]), "+v"(sh[1]), "+v"(sh[2]), "+v"(sh[3]), "+v"(sc[0]), "+v"(sc[1]), "+v"(sc[2]), "+v"(sc[3]));
#pragma unroll
        for (int i = 0; i < 4; ++i) ss += v[i][0] * v[i][0] + v[i][1] * v[i][1] + v[i][2] * v[i][2] + v[i][3] * v[i][3];
        ss = wave_sum(ss);
        const float rstd = rsqrtf(ss * (1.f / D) + EPS);
#pragma unroll
        for (int i = 0; i < 4; ++i) {
            const int k = lane * 4 + 256 * i;
            unsigned o = __builtin_amdgcn_cvt_pk_fp8_f32(v[i][0] * rstd * gg[i][0] * (1.f + sc[i][0]) + sh[i][0], v[i][1] * rstd * gg[i][1] * (1.f + sc[i][1]) + sh[i][1], 0u, false);
            o = __builtin_amdgcn_cvt_pk_fp8_f32(v[i][2] * rstd * gg[i][2] * (1.f + sc[i][2]) + sh[i][2], v[i][3] * rstd * gg[i][3] * (1.f + sc[i][3]) + sh[i][3], o, true);
            *(unsigned*)((unsigned char*)p.H + (size_t)row * D + k) = o;
        }
    }
}

constexpr float QSCALE = 0.17677669529663687f * 1.4426950408889634f;
__device__ __forceinline__ void dsoftmax(const f32x16& s, float& m, float& l, f32x16& o0, f32x16& o1, bf16x8& pa, bf16x8& pb) {
    float mx = fmaxf(fmaxf(fmaxf(s[0], s[1]), fmaxf(s[2], s[3])), fmaxf(fmaxf(s[4], s[5]), fmaxf(s[6], s[7])));
    mx = fmaxf(mx, fmaxf(fmaxf(fmaxf(s[8], s[9]), fmaxf(s[10], s[11])), fmaxf(fmaxf(s[12], s[13]), fmaxf(s[14], s[15]))));
    mx = xhalf_max(mx);
    if (__any(mx > m)) {
        const float mn = fmaxf(m, mx), alpha = __builtin_amdgcn_exp2f(m - mn);
        o0 *= alpha; o1 *= alpha; l *= alpha; m = mn;
    }
    float pr[16]; float sum = 0.f;
#pragma unroll
    for (int r = 0; r < 16; ++r) { pr[r] = __builtin_amdgcn_exp2f(s[r] - m); sum += pr[r]; }
    l += sum;
    u32x4 a, b;
    a[0] = cvtpk(pr[0], pr[1]); a[1] = cvtpk(pr[2], pr[3]); a[2] = cvtpk(pr[4], pr[5]); a[3] = cvtpk(pr[6], pr[7]);
    b[0] = cvtpk(pr[8], pr[9]); b[1] = cvtpk(pr[10], pr[11]); b[2] = cvtpk(pr[12], pr[13]); b[3] = cvtpk(pr[14], pr[15]);
    pa = __builtin_bit_cast(bf16x8, a); pb = __builtin_bit_cast(bf16x8, b);
}
__device__ __forceinline__ float max3f(float a, float b, float c) { float r; asm("v_max3_f32 %0, %1, %2, %3" : "=v"(r) : "v"(a), "v"(b), "v"(c)); return r; }
__device__ __forceinline__ float max2f(float a, float b) { float r; asm("v_max_f32_e32 %0, %1, %2" : "=v"(r) : "v"(a), "v"(b)); return r; }
__device__ __forceinline__ float fadd_s(float a, float b) { float r; asm("v_add_f32_e32 %0, %1, %2" : "=v"(r) : "v"(a), "v"(b)); return r; }
__device__ __forceinline__ float fsub_s(float a, float b) { float r; asm("v_sub_f32_e32 %0, %1, %2" : "=v"(r) : "v"(a), "v"(b)); return r; }
__device__ __forceinline__ float xhalf_max_s(float v) { auto rr = __builtin_amdgcn_permlane32_swap(__float_as_uint(v), __float_as_uint(v), false, false); return max2f(__uint_as_float(rr[0]), __uint_as_float(rr[1])); }
#define MX3(a, b, c) max3f((a), (b), (c))
template <int THR>
__device__ __forceinline__ void dsoftmax2(f32x16& s, float& m, float& l, f32x16& o0, f32x16& o1, bf16x8& pa, bf16x8& pb, const bool first) {
    const float s01 = __builtin_fmaxf(s[0], s[1]);
    float a = MX3(s01, s[2], s[3]), b = MX3(s01, s[4], s[5]);
    a = MX3(a, s[6], s[7]); b = MX3(b, s[8], s[9]); a = MX3(a, s[10], s[11]); b = MX3(b, s[12], s[13]); a = MX3(a, s[14], s[15]);
    const float mx = xhalf_max_s(max2f(a, b));
    if (first || __any(mx > m + (float)THR)) {
        const float mn = first ? mx : __builtin_fmaxf(mx, m), alpha = first ? 1.f : __builtin_amdgcn_exp2f(m - mn);
        m = mn; o0 *= alpha; o1 *= alpha; l *= alpha;
    }
    float sum = 0.f;
#pragma unroll
    for (int r = 0; r < 16; ++r) { s[r] = __builtin_amdgcn_exp2f(fsub_s(s[r], m)); sum += s[r]; }
    l += sum;
    u32x4 wa, wb;
    wa[0] = cvtpk(s[0], s[1]); wa[1] = cvtpk(s[2], s[3]); wa[2] = cvtpk(s[4], s[5]); wa[3] = cvtpk(s[6], s[7]);
    wb[0] = cvtpk(s[8], s[9]); wb[1] = cvtpk(s[10], s[11]); wb[2] = cvtpk(s[12], s[13]); wb[3] = cvtpk(s[14], s[15]);
    pa = __builtin_bit_cast(bf16x8, wa); pb = __builtin_bit_cast(bf16x8, wb);
}
__device__ __forceinline__ void dsoftmax_plain(f32x16& s, float& l, bf16x8& pa, bf16x8& pb) {
    float sum = 0.f;
#pragma unroll
    for (int r = 0; r < 16; ++r) { s[r] = __builtin_amdgcn_exp2f(s[r]); sum += s[r]; }
    l += sum;
    u32x4 wa, wb;
    wa[0] = cvtpk(s[0], s[1]); wa[1] = cvtpk(s[2], s[3]); wa[2] = cvtpk(s[4], s[5]); wa[3] = cvtpk(s[6], s[7]);
    wb[0] = cvtpk(s[8], s[9]); wb[1] = cvtpk(s[10], s[11]); wb[2] = cvtpk(s[12], s[13]); wb[3] = cvtpk(s[14], s[15]);
    pa = __builtin_bit_cast(bf16x8, wa); pb = __builtin_bit_cast(bf16x8, wb);
}
template <int LO>
__device__ __forceinline__ void dsoftmax_plain_q(f32x16& s, float& l, unsigned& w0, unsigned& w1) {
    const float e0 = __builtin_amdgcn_exp2f(s[LO]), e1 = __builtin_amdgcn_exp2f(s[LO + 1]), e2 = __builtin_amdgcn_exp2f(s[LO + 2]), e3 = __builtin_amdgcn_exp2f(s[LO + 3]);
    l += (e0 + e1) + (e2 + e3);
    w0 = cvtpk(e0, e1); w1 = cvtpk(e2, e3);
}
template <int THR, int LO>
__device__ __forceinline__ void dsoftmax2_q(f32x16& s, float& m, float& l, f32x16& o0, f32x16& o1, unsigned& w0, unsigned& w1) {
    const float s01 = __builtin_fmaxf(s[LO], s[LO + 1]);
    const float mx = xhalf_max_s(MX3(s01, s[LO + 2], s[LO + 3]));
    if (__any(mx > m + (float)THR)) {
        const float mn = __builtin_fmaxf(mx, m), alpha = __builtin_amdgcn_exp2f(m - mn);
        m = mn; o0 *= alpha; o1 *= alpha; l *= alpha;
    }
    const float e0 = __builtin_amdgcn_exp2f(fsub_s(s[LO], m)), e1 = __builtin_amdgcn_exp2f(fsub_s(s[LO + 1], m)), e2 = __builtin_amdgcn_exp2f(fsub_s(s[LO + 2], m)), e3 = __builtin_amdgcn_exp2f(fsub_s(s[LO + 3], m));
    l += (e0 + e1) + (e2 + e3);
    w0 = cvtpk(e0, e1); w1 = cvtpk(e2, e3);
}
template <int THR>
__device__ __forceinline__ void dsoftmax3(f32x16& s, float& m, f32x16& negm, float& l, f32x16& o0, f32x16& o1, bf16x8& pa, bf16x8& pb, const bool first) {
    const float s01 = __builtin_fmaxf(s[0], s[1]);
    float a = MX3(s01, s[2], s[3]), b = MX3(s01, s[4], s[5]);
    a = MX3(a, s[6], s[7]); b = MX3(b, s[8], s[9]); a = MX3(a, s[10], s[11]); b = MX3(b, s[12], s[13]); a = MX3(a, s[14], s[15]);
    const float mx = xhalf_max_s(max2f(a, b));
    if (first || __any(mx > (float)THR)) {
        const float d = first ? mx : __builtin_fmaxf(mx, 0.f), alpha = first ? 1.f : __builtin_amdgcn_exp2f(-d);
        m += d; o0 *= alpha; o1 *= alpha; l *= alpha;
#pragma unroll
        for (int r = 0; r < 16; ++r) { s[r] -= d; negm[r] = -m; }
    }
    float sum = 0.f;
#pragma unroll
    for (int r = 0; r < 16; ++r) { s[r] = __builtin_amdgcn_exp2f(s[r]); sum += s[r]; }
    l += sum;
    u32x4 wa, wb;
    wa[0] = cvtpk(s[0], s[1]); wa[1] = cvtpk(s[2], s[3]); wa[2] = cvtpk(s[4], s[5]); wa[3] = cvtpk(s[6], s[7]);
    wb[0] = cvtpk(s[8], s[9]); wb[1] = cvtpk(s[10], s[11]); wb[2] = cvtpk(s[12], s[13]); wb[3] = cvtpk(s[14], s[15]);
    pa = __builtin_bit_cast(bf16x8, wa); pb = __builtin_bit_cast(bf16x8, wb);
}
template <int THR>
__device__ __forceinline__ void dsoftmax_pair(f32x16& s1, float& m1, f32x16& negm1, float& l1, f32x16& oa0, f32x16& oa1, bf16x8& p1a, bf16x8& p1b,
                                              f32x16& s2, float& m2, float& l2, f32x16& ob0, f32x16& ob1, bf16x8& p2a, bf16x8& p2b, const bool first) {
    const float t1 = __builtin_fmaxf(s1[0], s1[1]), t2 = __builtin_fmaxf(s2[0], s2[1]);
    float a1 = MX3(t1, s1[2], s1[3]), a2 = MX3(t2, s2[2], s2[3]), b1 = MX3(t1, s1[4], s1[5]), b2 = MX3(t2, s2[4], s2[5]);
    a1 = MX3(a1, s1[6], s1[7]); a2 = MX3(a2, s2[6], s2[7]); b1 = MX3(b1, s1[8], s1[9]); b2 = MX3(b2, s2[8], s2[9]);
    a1 = MX3(a1, s1[10], s1[11]); a2 = MX3(a2, s2[10], s2[11]); b1 = MX3(b1, s1[12], s1[13]); b2 = MX3(b2, s2[12], s2[13]);
    a1 = MX3(a1, s1[14], s1[15]); a2 = MX3(a2, s2[14], s2[15]);
    const float mx1 = xhalf_max_s(max2f(a1, b1)), mx2 = xhalf_max_s(max2f(a2, b2));
    if (first || __any(max2f(mx1, fsub_s(mx2, m2)) > (float)THR)) {
        const float d = first ? mx1 : __builtin_fmaxf(mx1, 0.f), al1 = first ? 1.f : __builtin_amdgcn_exp2f(-d);
        m1 += d; oa0 *= al1; oa1 *= al1; l1 *= al1;
#pragma unroll
        for (int r = 0; r < 16; ++r) { s1[r] -= d; negm1[r] = -m1; }
        const float mn = first ? mx2 : __builtin_fmaxf(mx2, m2), al2 = first ? 1.f : __builtin_amdgcn_exp2f(m2 - mn);
        m2 = mn; ob0 *= al2; ob1 *= al2; l2 *= al2;
    }
    float su1 = 0.f, su2 = 0.f;
#pragma unroll
    for (int r = 0; r < 16; ++r) { s1[r] = __builtin_amdgcn_exp2f(s1[r]); su1 += s1[r]; s2[r] = __builtin_amdgcn_exp2f(fsub_s(s2[r], m2)); su2 += s2[r]; }
    l1 += su1; l2 += su2;
    const u32x4 w1a = {cvtpk(s1[0], s1[1]), cvtpk(s1[2], s1[3]), cvtpk(s1[4], s1[5]), cvtpk(s1[6], s1[7])}, w1b = {cvtpk(s1[8], s1[9]), cvtpk(s1[10], s1[11]), cvtpk(s1[12], s1[13]), cvtpk(s1[14], s1[15])};
    const u32x4 w2a = {cvtpk(s2[0], s2[1]), cvtpk(s2[2], s2[3]), cvtpk(s2[4], s2[5]), cvtpk(s2[6], s2[7])}, w2b = {cvtpk(s2[8], s2[9]), cvtpk(s2[10], s2[11]), cvtpk(s2[12], s2[13]), cvtpk(s2[14], s2[15])};
    p1a = __builtin_bit_cast(bf16x8, w1a); p1b = __builtin_bit_cast(bf16x8, w1b); p2a = __builtin_bit_cast(bf16x8, w2a); p2b = __builtin_bit_cast(bf16x8, w2b);
}
template <int THR>
__device__ __forceinline__ void dsoftmax_quad_max(f32x16& s1a, f32x16& s1b, float& m1, f32x16& negm1, float& l1, f32x16& oa0, f32x16& oa1,
                                                  const f32x16& s2a, const f32x16& s2b, float& m2, float& l2, f32x16& ob0, f32x16& ob1, const bool first) {
    const float t1a = __builtin_fmaxf(s1a[0], s1a[1]), t1b = __builtin_fmaxf(s1b[0], s1b[1]), t2a = __builtin_fmaxf(s2a[0], s2a[1]), t2b = __builtin_fmaxf(s2b[0], s2b[1]);
    float a1 = MX3(t1a, s1a[2], s1a[3]), b1 = MX3(t1b, s1b[2], s1b[3]), a2 = MX3(t2a, s2a[2], s2a[3]), b2 = MX3(t2b, s2b[2], s2b[3]);
#pragma unroll
    for (int r = 4; r < 16; r += 2) { a1 = MX3(a1, s1a[r], s1a[r + 1]); b1 = MX3(b1, s1b[r], s1b[r + 1]); a2 = MX3(a2, s2a[r], s2a[r + 1]); b2 = MX3(b2, s2b[r], s2b[r + 1]); }
    const float mx1 = xhalf_max_s(max2f(a1, b1)), mx2 = xhalf_max_s(max2f(a2, b2));
    if (first || __any(max2f(mx1, fsub_s(mx2, m2)) > (float)THR)) {
        const float d = first ? mx1 : __builtin_fmaxf(mx1, 0.f), al1 = first ? 1.f : __builtin_amdgcn_exp2f(-d);
        m1 += d; oa0 *= al1; oa1 *= al1; l1 *= al1;
#pragma unroll
        for (int r = 0; r < 16; ++r) { s1a[r] -= d; s1b[r] -= d; negm1[r] = -m1; }
        const float mn = first ? mx2 : __builtin_fmaxf(mx2, m2), al2 = first ? 1.f : __builtin_amdgcn_exp2f(m2 - mn);
        m2 = mn; ob0 *= al2; ob1 *= al2; l2 *= al2;
    }
}
template <bool REL2 = false>
__device__ __forceinline__ void dsoftmax_exp2(f32x16& s1, f32x16& s2, const float m2, float& l1, float& l2, bf16x8& p1a, bf16x8& p1b, bf16x8& p2a, bf16x8& p2b) {
    float su1 = 0.f, su2 = 0.f;
#pragma unroll
    for (int r = 0; r < 16; ++r) { s1[r] = __builtin_amdgcn_exp2f(s1[r]); su1 += s1[r]; s2[r] = __builtin_amdgcn_exp2f(REL2 ? s2[r] : fsub_s(s2[r], m2)); su2 += s2[r]; }
    l1 += su1; l2 += su2;
    const u32x4 w1a = {cvtpk(s1[0], s1[1]), cvtpk(s1[2], s1[3]), cvtpk(s1[4], s1[5]), cvtpk(s1[6], s1[7])}, w1b = {cvtpk(s1[8], s1[9]), cvtpk(s1[10], s1[11]), cvtpk(s1[12], s1[13]), cvtpk(s1[14], s1[15])};
    const u32x4 w2a = {cvtpk(s2[0], s2[1]), cvtpk(s2[2], s2[3]), cvtpk(s2[4], s2[5]), cvtpk(s2[6], s2[7])}, w2b = {cvtpk(s2[8], s2[9]), cvtpk(s2[10], s2[11]), cvtpk(s2[12], s2[13]), cvtpk(s2[14], s2[15])};
    p1a = __builtin_bit_cast(bf16x8, w1a); p1b = __builtin_bit_cast(bf16x8, w1b); p2a = __builtin_bit_cast(bf16x8, w2a); p2b = __builtin_bit_cast(bf16x8, w2b);
}
typedef __attribute__((address_space(1))) const float* gcf32_t;
typedef __attribute__((address_space(1))) unsigned char* gu8_t;
typedef __attribute__((address_space(1))) const char* gcc_t;
typedef short v2i16_t __attribute__((ext_vector_type(2)));
struct CvT { gcc_t src; gu8_t dst; int n4; };
struct CvW { gcf32_t gu, dn; gu8_t guT, dnT; int b0, G; };
__device__ __forceinline__ void glds16x2(gcc_t sbase, unsigned voff0, unsigned voff1, unsigned lds_dst) { unsigned keep;
    asm volatile("s_mov_b32 %0, m0\n\ts_mov_b32 m0, %4\n\ts_nop 0\n\tglobal_load_lds_dwordx4 %1, %3\n\ts_add_u32 m0, m0, 0x2000\n\ts_nop 0\n\tglobal_load_lds_dwordx4 %2, %3\n\ts_mov_b32 m0, %0"
                 : "=&s"(keep) : "v"(voff0), "v"(voff1), "s"(sbase), "s"(lds_dst) : "memory", "scc"); }
__device__ __forceinline__ void glds16x4(gcc_t sbase, unsigned voff, unsigned vstride, unsigned lds_dst) { unsigned keep;
    asm volatile("s_mov_b32 %0, m0\n\ts_mov_b32 m0, %4\n\ts_nop 0\n\tglobal_load_lds_dwordx4 %1, %3 nt\n\t"
                 "s_add_u32 m0, m0, 0x400\n\tv_add_u32 %1, %2, %1\n\tglobal_load_lds_dwordx4 %1, %3 nt\n\t"
                 "s_add_u32 m0, m0, 0x400\n\tv_add_u32 %1, %2, %1\n\tglobal_load_lds_dwordx4 %1, %3 nt\n\t"
                 "s_add_u32 m0, m0, 0x400\n\tv_add_u32 %1, %2, %1\n\tglobal_load_lds_dwordx4 %1, %3 nt\n\ts_mov_b32 m0, %0"
                 : "=&s"(keep), "+v"(voff) : "s"(vstride), "s"(sbase), "s"(lds_dst) : "memory", "scc"); }
#if defined(__HIP_DEVICE_COMPILE__)
#define KARG_PTR(T_, member) ({ unsigned long long r_; asm volatile("s_load_dwordx2 %0, %1, %2\n\ts_waitcnt lgkmcnt(0)" : "=s"(r_) : "s"(__builtin_amdgcn_kernarg_segment_ptr()), "n"((int)__builtin_offsetof(P, member)) : "memory"); (T_)r_; })
#else
#define KARG_PTR(T_, member) ((T_)(unsigned long long)p.member)
#endif
__device__ __forceinline__ bool cv_pair(const CvW& w, int q, CvT& c) {
    constexpr int n_gu = NE * 8 * 16, n_dn = NE * 8 * 8;
    const int tile = w.b0 + q * w.G;
    if (tile >= n_gu + n_dn) return false;
    if (tile < n_gu) {
        const int e = tile >> 7, tn = tile & 15, tk = (tile >> 4) & 7, np0 = (tn & 7) * 256 + (tn >> 3) * 128;
        c.n4 = 2048 * 4;
        c.src = (gcc_t)(w.gu + ((size_t)e * 1024 + tk * 128) * 2048 + tn * 128);
        c.dst = w.guT + ((size_t)e * 2048 + np0) * 1024 + tk * 128;
    } else {
        const int i_ = tile - n_gu, e = i_ >> 6, tn = i_ & 7, tk = (i_ >> 3) & 7;
        c.n4 = 1024 * 4;
        c.src = (gcc_t)(w.dn + ((size_t)e * 1024 + tk * 128) * 1024 + tn * 128);
        c.dst = w.dnT + ((size_t)e * 1024 + tn * 128) * 1024 + tk * 128;
    }
    return true;
}
__device__ __forceinline__ void cv_store(gu8_t dst, const char* q0, const unsigned goff) {
    const float* q = (const float*)q0;
    float v[16];
#pragma unroll
    for (int d = 0; d < 4; ++d) { v[4 * d] = q[(2 * d) * 256]; v[4 * d + 1] = q[(2 * d) * 256 + 128]; v[4 * d + 2] = q[(2 * d + 1) * 256]; v[4 * d + 3] = q[(2 * d + 1) * 256 + 128]; }
    asm volatile("" : "+v"(v[0]), "+v"(v[1]), "+v"(v[2]), "+v"(v[3]), "+v"(v[4]), "+v"(v[5]), "+v"(v[6]), "+v"(v[7]), "+v"(v[8]), "+v"(v[9]), "+v"(v[10]), "+v"(v[11]), "+v"(v[12]), "+v"(v[13]), "+v"(v[14]), "+v"(v[15]));
    u32x4 w;
#pragma unroll
    for (int d = 0; d < 4; ++d) {
        v2i16_t r = {0, 0};
        r = __builtin_amdgcn_cvt_scalef32_pk_fp8_f32(r, v[4 * d], v[4 * d + 1], 0.015625f, false);
        r = __builtin_amdgcn_cvt_scalef32_pk_fp8_f32(r, v[4 * d + 2], v[4 * d + 3], 0.015625f, true);
        w[d] = __builtin_bit_cast(unsigned, r);
    }
    __builtin_nontemporal_store(w, (__attribute__((address_space(1))) u32x4*)(dst + goff));
}
constexpr int CV_LDS = 32768;
__device__ __forceinline__ void ph_dattn(const P& p, int l, int nrows, char* lds, const int wv) {
    const int tid = ltid(wv), lane = tid & 63, wid = wv, r32 = lane & 31, hi = lane >> 5;
    float la = lane < 32 ? p.lam_q1[l * 32 + lane] * p.lam_k1[l * 32 + lane] : 0.f;
    float lb = lane < 32 ? p.lam_q2[l * 32 + lane] * p.lam_k2[l * 32 + lane] : 0.f;
    la = wave_sum(la); lb = wave_sum(lb);
    const float lam_init = 0.8f - 0.6f * expf(-0.3f * (float)l);
    const float lam = expf(la) - expf(lb) + lam_init;
    const bf16_t* PR = p.PROJ;
    const int nunits = (nrows == R) ? 256 + 16 : 256;
    const int vkey = (2 * (wid & 3) + (lane >> 5)) * 8 + ((lane >> 2) & 7), vchunk = (wid >> 2) * 4 + (lane & 3);
    const int vb = ((lane >> 4) & 1) * 32 + (lane & 3) * 8 + (4 * hi + ((lane & 15) >> 2)) * 64;
    const unsigned lds0 = (unsigned)(uintptr_t)lds;
    CvW cw; cw.gu = KARG_PTR(gcf32_t, w_gu) + (size_t)l * NE * 1024 * 2048; cw.guT = KARG_PTR(gu8_t, WguT) + (size_t)l * NE * 2048 * 1024;
    cw.dn = KARG_PTR(gcf32_t, w_down) + (size_t)l * NE * 1024 * 1024; cw.dnT = KARG_PTR(gu8_t, WdnT) + (size_t)l * NE * 1024 * 1024;
    { int b0 = blockIdx.x, G = gridDim.x; asm volatile("" : "+s"(b0), "+s"(G)); cw.b0 = b0; cw.G = G; }
    const unsigned cv_row = 8 * wid + (lane >> 5), cv_sw = (unsigned)(((lane & 31) ^ ((((wid >> 1) & 1) << 2) | (((wid >> 2) & 1) << 1))) * 16);
    const int cv_n = 16 * wid + (lane >> 2), cv_kg = lane & 3;
    const int cv_lo = cv_kg * 8192 + (((cv_n >> 2) ^ (((cv_kg & 1) << 2) | ((cv_kg >> 1) << 1))) * 16) + (cv_n & 3) * 4;
    const unsigned cv_go = (unsigned)(cv_n * 1024 + 16 * cv_kg);
    int cj = 0, cb = 0, ca = 0;
    CvT cp; bool cpok = false;
    gu8_t dstA = nullptr; bool hasA = false;
#define CV_NEXT(hasB_, dstB_) do { \
        if ((cj & 1) == 0) cpok = cv_pair(cw, cj >> 1, cp); else { cp.src += 64 * cp.n4; cp.dst += 64; } \
        hasB_ = cpok; dstB_ = cp.dst; \
        if (cpok) glds16x4(cp.src, cv_row * (unsigned)cp.n4 + cv_sw, 2u * (unsigned)cp.n4, lds0 + CV_LDS + cb * 32768 + wid * 4096); } while (0)
    for (int uu = blockIdx.x; uu < nunits; uu += gridDim.x) {
        int b, h, q0, nt; bool isctx;
        if (uu < 256) { const int u = (uu & 7) * 32 + (uu >> 3); b = u >> 6; h = (u >> 4) & 3; q0 = b * 4096 + (u & 15) * 256; nt = 68; isctx = false; }
        else { const int v = uu - 256; b = v >> 2; h = v & 3; q0 = T + b * 256; nt = 4; isctx = true; }
        const unsigned gKo = (unsigned)(256 + h * 64 + wid * 8 + lane * PW) * 2u;
        const unsigned gVo = (unsigned)(512 + h * 64 + vchunk * 8 + vkey * PW) * 2u;
#define DA_ROW0(t_) ((isctx || (t_) >= 64) ? T + b * 256 + (isctx ? (t_) : (t_) - 64) * 64 : b * 4096 + (t_) * 64)
#define DA_DMA_KV(t_) glds16x2((gcc_t)PR + (size_t)DA_ROW0(t_) * (PW * 2), gKo, gVo, lds0 + ((t_) & 1) * 16384 + wid * 1024)
        __syncthreads();
        DA_DMA_KV(0);
        bf16x8 qf[4];
        {
            const bf16_t* qp = PR + (size_t)(q0 + wid * 32 + r32) * PW + h * 64 + hi * 8;
#pragma unroll
            for (int ks = 0; ks < 4; ++ks) qf[ks] = *(const bf16x8*)(qp + ks * 16);
        }
        f32x16 O00, O01, O10, O11, nm1, zero16;
#pragma unroll
        for (int r = 0; r < 16; ++r) { O00[r] = 0.f; O01[r] = 0.f; O10[r] = 0.f; O11[r] = 0.f; nm1[r] = 0.f; zero16[r] = 0.f; }
        float m1 = 0.f, m2 = 0.f, l1 = 0.f, l2 = 0.f;
        const unsigned kmb0 = p.kmx[l * 32 + (b * 4 + h) * 2], kmb1 = p.kmx[l * 32 + (b * 4 + h) * 2 + 1];
        asm volatile("" :: "v"(qf[0]), "v"(qf[1]), "v"(qf[2]), "v"(qf[3]));
        bool fast;
        {
            float n1 = 0.f, n2 = 0.f;
#pragma unroll
            for (int j = 0; j < 8; ++j) { const float a = bf2f((bf16_t)qf[0][j]), b_ = bf2f((bf16_t)qf[1][j]), c = bf2f((bf16_t)qf[2][j]), d = bf2f((bf16_t)qf[3][j]); n1 += a * a + b_ * b_; n2 += c * c + d * d; }
            n1 = xhalf_sum(n1); n2 = xhalf_sum(n2);
            const float b1 = sqrtf(n1 * __uint_as_float(kmb0)) * 1.02f, b2 = sqrtf(n2 * __uint_as_float(kmb1)) * 1.02f;
            fast = __all(b1 <= 60.f && b2 <= 60.f);
            if (fast) {
                m1 = b1; m2 = b2;
#pragma unroll
                for (int r = 0; r < 16; ++r) { nm1[r] = -b1; zero16[r] = -b2; }
            }
        }
        asm volatile("s_waitcnt vmcnt(0)" ::: "memory"); __builtin_amdgcn_s_barrier(); asm volatile("" ::: "memory");
        auto tile_loop = [&](auto fast_c) {
            constexpr bool FAST = decltype(fast_c)::value;
#pragma unroll 1
        for (int t = 0; t < nt; ++t) {
            char* buf = lds + (t & 1) * 16384;
            bool hasB; gu8_t dstB;
            {
                typedef const __attribute__((address_space(3))) bf16x8* kfp_t;
                const lds_cptr kp = (lds_cptr)buf + hi * 1024 + r32 * 16;
                const lds_cptr vp = (lds_cptr)buf + 8192 + vb;
                f32x16 s1[2], s2[2];
#pragma unroll
                for (int kb = 0; kb < 2; ++kb) {
                    const bf16x8 kf0 = *(kfp_t)(kp + kb * 512), kf1 = *(kfp_t)(kp + kb * 512 + 2048), kf2 = *(kfp_t)(kp + kb * 512 + 4096), kf3 = *(kfp_t)(kp + kb * 512 + 6144);
                    s1[kb] = __builtin_amdgcn_mfma_f32_32x32x16_bf16(kf0, qf[0], nm1, 0, 0, 0);
                    s2[kb] = __builtin_amdgcn_mfma_f32_32x32x16_bf16(kf2, qf[2], zero16, 0, 0, 0);
                    s1[kb] = __builtin_amdgcn_mfma_f32_32x32x16_bf16(kf1, qf[1], s1[kb], 0, 0, 0);
                    s2[kb] = __builtin_amdgcn_mfma_f32_32x32x16_bf16(kf3, qf[3], s2[kb], 0, 0, 0);
                    if (kb == 0) {
                        __builtin_amdgcn_sched_barrier(0);
                        if (t + 1 < nt) DA_DMA_KV(t + 1);
                        CV_NEXT(hasB, dstB);
                        __builtin_amdgcn_sched_barrier(0);
                    }
                }
                if constexpr (!FAST) dsoftmax_quad_max<8>(s1[0], s1[1], m1, nm1, l1, O00, O01, s2[0], s2[1], m2, l2, O10, O11, t == 0);
#pragma unroll
                for (int kb = 0; kb < 2; ++kb) {
                    s16x4 vlo[4], vhi[4];
#pragma unroll
                    for (int i = 0; i < 4; ++i) { vlo[i] = vtr(vp + kb * 2048 + (i >> 1) * 4096 + (i & 1) * 1024); vhi[i] = vtr(vp + kb * 2048 + (i >> 1) * 4096 + (i & 1) * 1024 + 512); }
                    bf16x8 p1a, p1b, p2a, p2b;
                    dsoftmax_exp2<FAST>(s1[kb], s2[kb], m2, l1, l2, p1a, p1b, p2a, p2b);
#pragma unroll
                    for (int i = 0; i < 4; ++i) {
                        const bf16x8 va = (bf16x8){vlo[i][0], vlo[i][1], vlo[i][2], vlo[i][3], vhi[i][0], vhi[i][1], vhi[i][2], vhi[i][3]};
                        if (i < 2) { O00 = __builtin_amdgcn_mfma_f32_32x32x16_bf16(va, (i & 1) ? p1b : p1a, O00, 0, 0, 0); O10 = __builtin_amdgcn_mfma_f32_32x32x16_bf16(va, (i & 1) ? p2b : p2a, O10, 0, 0, 0); }
                        else       { O01 = __builtin_amdgcn_mfma_f32_32x32x16_bf16(va, (i & 1) ? p1b : p1a, O01, 0, 0, 0); O11 = __builtin_amdgcn_mfma_f32_32x32x16_bf16(va, (i & 1) ? p2b : p2a, O11, 0, 0, 0); }
                    }
                }
            }
            if (hasB) asm volatile("s_waitcnt vmcnt(4)" ::: "memory"); else asm volatile("s_waitcnt vmcnt(0)" ::: "memory");
            __builtin_amdgcn_s_barrier(); asm volatile("" ::: "memory");
            if (hasA) cv_store(dstA, lds + CV_LDS + ca * 32768 + cv_lo, cv_go);
            dstA = dstB; hasA = hasB; ca = cb;
            if (hasB) { ++cj; cb = cb == 2 ? 0 : cb + 1; }
        }
        };
        if (fast) tile_loop(std::true_type{}); else tile_loop(std::false_type{});
#undef DA_ROW0
#undef DA_DMA_KV
        l1 = xhalf_sum(l1); l2 = xhalf_sum(l2);
        const float i1 = 1.f / l1, i2 = lam / l2;
        float ss = 0.f;
#pragma unroll
        for (int r = 0; r < 16; ++r) { O00[r] = O00[r] * i1 - O10[r] * i2; O01[r] = O01[r] * i1 - O11[r] * i2; ss += O00[r] * O00[r] + O01[r] * O01[r]; }
        ss = xhalf_sum(ss);
        const float rstd = rsqrtf(ss * (1.f / 64.f) + EPS) * (1.f - lam_init);
        const float* gs = p.g_sub + l * 64;
        bf16_t* op = p.MIX + (size_t)(q0 + wid * 32 + r32) * D + h * 64;
        f32x4 gsa[4], gsb[4];
#pragma unroll
        for (int g4 = 0; g4 < 4; ++g4) { gsa[g4] = *(const f32x4*)(gs + 8 * g4 + 4 * hi); gsb[g4] = *(const f32x4*)(gs + 32 + 8 * g4 + 4 * hi); }
        asm volatile("" : "+v"(gsa[0]), "+v"(gsa[1]), "+v"(gsa[2]), "+v"(gsa[3]), "+v"(gsb[0]), "+v"(gsb[1]), "+v"(gsb[2]), "+v"(gsb[3]));
#pragma unroll
        for (int g4 = 0; g4 < 4; ++g4) {
            const int d = 8 * g4 + 4 * hi;
            const float4 ga = make_float4(gsa[g4][0], gsa[g4][1], gsa[g4][2], gsa[g4][3]), gb = make_float4(gsb[g4][0], gsb[g4][1], gsb[g4][2], gsb[g4][3]);
            uint2 wa, wb;
            wa.x = cvtpk(O00[4 * g4] * rstd * ga.x, O00[4 * g4 + 1] * rstd * ga.y); wa.y = cvtpk(O00[4 * g4 + 2] * rstd * ga.z, O00[4 * g4 + 3] * rstd * ga.w);
            wb.x = cvtpk(O01[4 * g4] * rstd * gb.x, O01[4 * g4 + 1] * rstd * gb.y); wb.y = cvtpk(O01[4 * g4 + 2] * rstd * gb.z, O01[4 * g4 + 3] * rstd * gb.w);
            *(uint2*)(op + d) = wa; *(uint2*)(op + 32 + d) = wb;
        }
    }
    while (hasA) {
        asm volatile("s_waitcnt vmcnt(0)" ::: "memory");
        __syncthreads();
        cv_store(dstA, lds + CV_LDS + ca * 32768 + cv_lo, cv_go);
        bool hasB; gu8_t dstB;
        CV_NEXT(hasB, dstB);
        dstA = dstB; hasA = hasB; ca = cb;
        if (hasB) { ++cj; cb = cb == 2 ? 0 : cb + 1; }
    }
#undef CV_NEXT
}

__device__ __forceinline__ void ph_na(const P& p, int l, int nrows, char* lds, const int wv) {
    const int tid = ltid(wv), lane = tid & 63, wid = wv, r32 = lane & 31, hi = lane >> 5;
    const bf16_t* PR = p.PROJ;
    const int nunits = (nrows == R) ? 256 + 16 : 256;
    const int vkey = (2 * (wid & 3) + (lane >> 5)) * 8 + ((lane >> 2) & 7), vchunk = (wid >> 2) * 4 + (lane & 3);
    const int vb = ((lane >> 4) & 1) * 32 + (lane & 3) * 8 + (4 * hi + ((lane & 15) >> 2)) * 64;
    const unsigned lds0 = (unsigned)(uintptr_t)lds;
    float* btab = (float*)(lds + 49152);
    constexpr float LOG2E = 1.4426950408889634f;
    float pen[2][16];
    {
        const int cq_ = (wid & 1) * 32 + r32, wsc_ = min(max(cq_ - 8, 0), 48);
#pragma unroll
        for (int kb = 0; kb < 2; ++kb)
#pragma unroll
            for (int r = 0; r < 16; ++r) { const int kc = 32 * kb + (r & 3) + 8 * (r >> 2) + 4 * hi; pen[kb][r] = ((unsigned)(kc - wsc_) < 16u) ? 0.f : -INFINITY; }
    }
    for (int uu = (blockIdx.x + gridDim.x - 16) % gridDim.x; uu < nunits; uu += gridDim.x) {
        int b, h, q0, kr_lo, nlat, rs = 0, rq = 0; bool isctx;
        if (uu < 256) {
            const int u = (uu & 7) * 32 + (uu >> 3); b = u >> 6; h = (u >> 4) & 3; const int rg = u & 15;
            rq = 4 * rg + (wid >> 1); q0 = b * 4096 + rq * 64 + (wid & 1) * 32;
            kr_lo = min(max(4 * rg - 4, 0), 56); const int kr_hi = min(max(4 * rg - 1, 0), 56) + 7; nlat = kr_hi - kr_lo + 1;
            rs = min(max(rq - 4, 0), 56); isctx = false;
        } else { const int v = uu - 256; b = v >> 2; h = v & 3; q0 = T + b * 256 + wid * 32; kr_lo = 0; nlat = 0; isctx = true; }
        const int nt = nlat + 4;
        const int cq = (wid & 1) * 32 + r32;
        const unsigned gKo = (unsigned)(1792 + h * 64 + wid * 8 + lane * PW) * 2u;
        const unsigned gVo = (unsigned)(2048 + h * 64 + vchunk * 8 + vkey * PW) * 2u;
#define NA_ROW0(t_) ((t_) < nlat ? b * 4096 + (kr_lo + (t_)) * 64 : T + b * 256 + ((t_) - nlat) * 64)
#define NA_DMA_KV(t_, slot_) glds16x2((gcc_t)PR + (size_t)NA_ROW0(t_) * (PW * 2), gKo, gVo, lds0 + (slot_) * 16384 + wid * 1024)
        __syncthreads();
        NA_DMA_KV(0, 0); NA_DMA_KV(1, 1);
        bf16x8 qf[4];
        {
            const bf16_t* qp = PR + (size_t)(q0 + r32) * PW + 1536 + h * 64 + hi * 8;
#pragma unroll
            for (int ks = 0; ks < 4; ++ks) qf[ks] = *(const bf16x8*)(qp + ks * 16);
        }
        f32x16 O0, O1;
#pragma unroll
        for (int r = 0; r < 16; ++r) { O0[r] = 0.f; O1[r] = 0.f; }
        float m1 = -1e30f, l1 = 0.f;
        float mref; bool fast;
        {
            float nq = 0.f;
#pragma unroll
            for (int ks4 = 0; ks4 < 4; ++ks4)
#pragma unroll
                for (int j = 0; j < 8; ++j) { const float a = bf2f((bf16_t)qf[ks4][j]); nq += a * a; }
            nq = xhalf_sum(nq);
            const unsigned* km = p.kmx + 64 + l * 32 + (b * 4 + h) * 2;
            mref = sqrtf(nq * (__uint_as_float(km[0]) + __uint_as_float(km[1]))) * 1.02f + __uint_as_float(p.kmx[128 + l * 4 + h]);
            fast = __all(mref <= 60.f);
        }
        if (tid < 480) *(float4*)(btab + tid * 4) = *(const float4*)(p.BT + ((size_t)l * 4 + h) * (15 * 128) + tid * 4);
        asm volatile("" :: "v"(qf[0]), "v"(qf[1]), "v"(qf[2]), "v"(qf[3]));
        asm volatile("s_waitcnt vmcnt(0)" ::: "memory");
        __syncthreads();
        int ks = 0;
        auto tile_loop = [&](auto fast_c) {
            constexpr bool FAST = decltype(fast_c)::value;
#pragma unroll 1
        for (int t = 0; t < nt; ++t) {
            char* buf = lds + ks * 16384;
            const bool kvB = t + 2 < nt;
            if (kvB) NA_DMA_KV(t + 2, ks == 0 ? 2 : ks - 1);
            const bool lat = t < nlat;
            const int krow = kr_lo + t;
            const bool active = !lat || (krow >= rs && krow <= rs + 7);
            if (active) {
                const float* brow = btab + (krow - rq + 7) * 128 + 48 + 15 - cq + 4 * hi;
                bf16x8 kfr[2][4];
#pragma unroll
                for (int kb = 0; kb < 2; ++kb)
#pragma unroll
                    for (int ks2 = 0; ks2 < 4; ++ks2) kfr[kb][ks2] = *(const __attribute__((address_space(3))) bf16x8*)((lds_cptr)buf + hi * 1024 + (kb * 32 + r32) * 16 + ks2 * 2048);
                asm volatile("" : "+v"(kfr[0][0]), "+v"(kfr[0][1]), "+v"(kfr[0][2]), "+v"(kfr[0][3]), "+v"(kfr[1][0]), "+v"(kfr[1][1]), "+v"(kfr[1][2]), "+v"(kfr[1][3]));
                f32x16 s1;
#define NA_SCORES(kb_) do { _Pragma("unroll") for (int r = 0; r < 16; ++r) s1[r] = FAST ? -mref : 0.f; \
                    _Pragma("unroll") for (int ks2 = 0; ks2 < 4; ++ks2) s1 = __builtin_amdgcn_mfma_f32_32x32x16_bf16(kfr[kb_][ks2], qf[ks2], s1, 0, 0, 0); } while (0)
#define NA_PV(kb_, ss_, P_) do { const lds_cptr vp = (lds_cptr)buf + 8192 + vb + (kb_) * 2048; \
                    const s16x4 lo0 = vtr(vp + (ss_) * 1024), hh0 = vtr(vp + (ss_) * 1024 + 512), lo1 = vtr(vp + 4096 + (ss_) * 1024), hh1 = vtr(vp + 4096 + (ss_) * 1024 + 512); \
                    const bf16x8 va0 = (bf16x8){lo0[0], lo0[1], lo0[2], lo0[3], hh0[0], hh0[1], hh0[2], hh0[3]}; \
                    const bf16x8 va1 = (bf16x8){lo1[0], lo1[1], lo1[2], lo1[3], hh1[0], hh1[1], hh1[2], hh1[3]}; \
                    O0 = __builtin_amdgcn_mfma_f32_32x32x16_bf16(va0, P_, O0, 0, 0, 0); O1 = __builtin_amdgcn_mfma_f32_32x32x16_bf16(va1, P_, O1, 0, 0, 0); } while (0)
#define NA_FULL(kb_, LAT_) do { NA_SCORES(kb_); \
                    if (LAT_) { float bb_[16]; _Pragma("unroll") for (int r = 0; r < 16; ++r) bb_[r] = brow[32 * (kb_) + (r & 3) + 8 * (r >> 2)]; \
                        asm volatile("" : "+v"(bb_[0]), "+v"(bb_[1]), "+v"(bb_[2]), "+v"(bb_[3]), "+v"(bb_[4]), "+v"(bb_[5]), "+v"(bb_[6]), "+v"(bb_[7]), "+v"(bb_[8]), "+v"(bb_[9]), "+v"(bb_[10]), "+v"(bb_[11]), "+v"(bb_[12]), "+v"(bb_[13]), "+v"(bb_[14]), "+v"(bb_[15]));   \
                        _Pragma("unroll") for (int r = 0; r < 16; ++r) s1[r] = (s1[r] + bb_[r]) + pen[kb_][r]; } \
                    bf16x8 pa, pb; if constexpr (FAST) dsoftmax_plain(s1, l1, pa, pb); else dsoftmax2<8>(s1, m1, l1, O0, O1, pa, pb, false); NA_PV(kb_, 0, pa); NA_PV(kb_, 1, pb); } while (0)
#define NA_PART(kb_, LO_) do { NA_SCORES(kb_); \
                    _Pragma("unroll") for (int r = (LO_); r < (LO_) + 4; ++r) s1[r] = (s1[r] + brow[32 * (kb_) + (r & 3) + 8 * (r >> 2)]) + pen[kb_][r]; \
                    unsigned w0_, w1_; if constexpr (FAST) dsoftmax_plain_q<LO_>(s1, l1, w0_, w1_); else dsoftmax2_q<8, LO_>(s1, m1, l1, O0, O1, w0_, w1_); \
                    const u32x4 pw_ = (LO_) == 0 ? (u32x4){w0_, w1_, 0u, 0u} : (u32x4){0u, 0u, w0_, w1_}; \
                    NA_PV(kb_, (LO_) == 0 ? 0 : 1, __builtin_bit_cast(bf16x8, pw_)); } while (0)
                if (!lat) { NA_FULL(0, false); NA_FULL(1, false); }
                else if (wid & 1) { NA_PART(0, 12); NA_FULL(1, true); }
                else { NA_FULL(0, true); NA_PART(1, 0); }
#undef NA_SCORES
#undef NA_PV
#undef NA_FULL
#undef NA_PART
            }
            if (kvB) asm volatile("s_waitcnt vmcnt(2)" ::: "memory"); else asm volatile("s_waitcnt vmcnt(0)" ::: "memory");
            __builtin_amdgcn_s_barrier(); asm volatile("" ::: "memory");
            ks = ks == 2 ? 0 : ks + 1;
        }
        };
        if (fast) tile_loop(std::true_type{}); else tile_loop(std::false_type{});
#undef NA_ROW0
#undef NA_DMA_KV
        l1 = xhalf_sum(l1);
        const float il = 1.f / l1;
        bf16_t* op = p.MIX + (size_t)(q0 + r32) * D + 768 + h * 64;
#pragma unroll
        for (int g4 = 0; g4 < 4; ++g4) {
            const int d = 8 * g4 + 4 * hi;
            uint2 wa, wb;
            wa.x = cvtpk(O0[4 * g4] * il, O0[4 * g4 + 1] * il); wa.y = cvtpk(O0[4 * g4 + 2] * il, O0[4 * g4 + 3] * il);
            wb.x = cvtpk(O1[4 * g4] * il, O1[4 * g4 + 1] * il); wb.y = cvtpk(O1[4 * g4 + 2] * il, O1[4 * g4 + 3] * il);
            *(uint2*)(op + d) = wa; *(uint2*)(op + 32 + d) = wb;
        }
    }
}

__device__ __forceinline__ void ph_pool(const P& p, int l, int nrows, char* lds, const int wv) {
    const int tid = ltid(wv), lane = tid & 63, wid = tid >> 6, fr = lane & 15, fq = lane >> 4;
    constexpr int YSTR = 260;
    float* ysh = (float*)lds;
    bf16_t* dsh = (bf16_t*)(lds + 80 * YSTR * 4);
    const bf16_t* PR = p.PROJ;
    for (int it = (blockIdx.x + gridDim.x - 32) % gridDim.x; it < nrows / 64; it += gridDim.x) {
        const int row0 = it * 64;
        const int L = row0 < T ? 4096 : 256;
        const int t0 = row0 < T ? (row0 & 4095) : ((row0 - T) & 255);
        const int base = row0 - t0;
        __syncthreads();
        uint4 raw5[5];
#pragma unroll
        for (int i = 0; i < 5; ++i) { const int c = tid + NT * i, rr = c >> 5, ch = (c & 31) * 8, t = min(max(t0 - 8 + rr, 0), L - 1); raw5[i] = *(const uint4*)(PR + (size_t)(base + t) * PW + 768 + ch); }
        const int g = wid >> 1, mb = (wid & 1) * 2;
        bf16x8 wfr[2][4]; float4 spv[4];
        {
            const bf16_t* W = p.WpT + ((size_t)l * 4 + g) * 64 * 64;
#pragma unroll
            for (int ks = 0; ks < 2; ++ks)
#pragma unroll
                for (int nt = 0; nt < 4; ++nt) wfr[ks][nt] = *(const bf16x8*)(W + (nt * 16 + fr) * 64 + ks * 32 + fq * 8);
#pragma unroll
            for (int nt = 0; nt < 4; ++nt) spv[nt] = *(const float4*)(p.s_pool + l * 256 + g * 64 + nt * 16 + fq * 4);
        }
#pragma unroll
        for (int i = 0; i < 5; ++i) {
            const int c = tid + NT * i, rr = c >> 5, ch = (c & 31) * 8, t = t0 - 8 + rr;
            const uint4 raw = (t >= 0 && t < L) ? raw5[i] : make_uint4(0u, 0u, 0u, 0u);
            *(float4*)(ysh + rr * YSTR + ch) = make_float4(__uint_as_float(raw.x << 16), __uint_as_float(raw.x & 0xffff0000u), __uint_as_float(raw.y << 16), __uint_as_float(raw.y & 0xffff0000u));
            *(float4*)(ysh + rr * YSTR + ch + 4) = make_float4(__uint_as_float(raw.z << 16), __uint_as_float(raw.z & 0xffff0000u), __uint_as_float(raw.w << 16), __uint_as_float(raw.w & 0xffff0000u));
        }
        __syncthreads();
        {
            const int r = tid >> 3, cg = tid & 7, t = t0 + r;
#pragma unroll
            for (int q = 0; q < 8; ++q) {
                const int g = q >> 1, w = 2 << g, ch = q * 32 + cg * 4;
                const int lo = max(t - w / 2, 0), hi = min(t + w / 2 - 1, L - 1);
                const float inv = 1.f / (float)(hi - lo + 1);
                float4 s = make_float4(0.f, 0.f, 0.f, 0.f);
#pragma unroll
                for (int dd = 0; dd < w; ++dd) { const float4 v = *(const float4*)(ysh + (r + 8 - w / 2 + dd) * YSTR + ch); s.x += v.x; s.y += v.y; s.z += v.z; s.w += v.w; }
                const float4 y = *(const float4*)(ysh + (r + 8) * YSTR + ch);
                uint2 o; o.x = cvtpk(s.x * inv - y.x, s.y * inv - y.y); o.y = cvtpk(s.z * inv - y.z, s.w * inv - y.w);
                *(uint2*)(dsh + r * 264 + ch) = o;
            }
        }
        __syncthreads();
        {
            f32x4 acc[2][4];
#pragma unroll
            for (int mt = 0; mt < 2; ++mt)
#pragma unroll
                for (int nt = 0; nt < 4; ++nt) acc[mt][nt] = (f32x4){0.f, 0.f, 0.f, 0.f};
#pragma unroll
            for (int ks = 0; ks < 2; ++ks) {
                bf16x8 af[2];
#pragma unroll
                for (int mt = 0; mt < 2; ++mt) af[mt] = *(const bf16x8*)(dsh + ((mb + mt) * 16 + fr) * 264 + g * 64 + ks * 32 + fq * 8);
#pragma unroll
                for (int mt = 0; mt < 2; ++mt)
#pragma unroll
                    for (int nt = 0; nt < 4; ++nt) acc[mt][nt] = __builtin_amdgcn_mfma_f32_16x16x32_bf16(wfr[ks][nt], af[mt], acc[mt][nt], 0, 0, 0);
            }
#pragma unroll
            for (int mt = 0; mt < 2; ++mt)
#pragma unroll
                for (int nt = 0; nt < 4; ++nt) {
                    const int row = row0 + (mb + mt) * 16 + fr, j = g * 64 + nt * 16 + fq * 4;
                    const float4 sp = spv[nt];
                    uint2 o; o.x = cvtpk(acc[mt][nt][0] * sp.x, acc[mt][nt][1] * sp.y); o.y = cvtpk(acc[mt][nt][2] * sp.z, acc[mt][nt][3] * sp.w);
                    *(uint2*)(p.MIX + (size_t)row * D + 256 + j) = o;
                }
        }
    }
}

__device__ __forceinline__ float gelu_fast(float x) {
    const float u = 0.7978845608028654f * (x + 0.044715f * x * x * x);
    return x * __builtin_amdgcn_rcpf(1.f + __builtin_amdgcn_exp2f(-2.885390081777927f * u));
}
__device__ __forceinline__ void ph_sgu(const P& p, int l, int nrows, char* lds, const int wv) {
    const int tid = ltid(wv), lane = tid & 63, wid = tid >> 6, fr = lane & 15, fq = lane >> 4;
    bf16_t* vnT = (bf16_t*)lds;
    const bf16_t* PR = p.PROJ;
    for (int it = (blockIdx.x + gridDim.x - 48) % gridDim.x; it < (nrows / 128) * 2; it += gridDim.x) {
        const int chunk = it >> 1, hp = it & 1, row0 = chunk * 128;
        const int hl = wid >> 2, g = hp * 2 + hl, mb = (wid & 3) * 2;
        const bf16_t* Wg = p.WsB + ((size_t)l * 4 + g) * 128 * 128;
        bf16x8 wg[4][2]; uint2 urv[2][4]; float bsv[2];
        __syncthreads();
        {
            const int t = tid >> 2, qtr = tid & 3;
            const bf16_t* zp = PR + (size_t)(row0 + t) * PW + 1280 + qtr * 64;
            uint4 raw[8]; float ss = 0.f;
#pragma unroll
            for (int i = 0; i < 8; ++i) raw[i] = *(const uint4*)(zp + i * 8);
#pragma unroll
            for (int ks = 0; ks < 4; ++ks)
#pragma unroll
                for (int mt = 0; mt < 2; ++mt) wg[ks][mt] = *(const bf16x8*)(Wg + ((mb + mt) * 16 + fr) * 128 + ks * 32 + fq * 8);
#pragma unroll
            for (int mt = 0; mt < 2; ++mt) {
                bsv[mt] = p.b_sgu[(l * 4 + g) * 128 + (mb + mt) * 16 + fr];
#pragma unroll
                for (int nt = 0; nt < 4; ++nt) urv[mt][nt] = *(const uint2*)(PR + (size_t)(row0 + (mb + mt) * 16 + fr) * PW + 1024 + g * 64 + nt * 16 + fq * 4);
            }
#pragma unroll
            for (int i = 0; i < 8; ++i) {
                const unsigned w4[4] = {raw[i].x, raw[i].y, raw[i].z, raw[i].w};
#pragma unroll
                for (int j = 0; j < 4; ++j) { const float a = __uint_as_float(w4[j] << 16), b = __uint_as_float(w4[j] & 0xffff0000u); ss += a * a + b * b; }
            }
            ss += xshfl<1>(ss); ss += xshfl<2>(ss);
            const float rs = rsqrtf(ss * (1.f / 256.f) + EPS);
            if ((qtr >> 1) == hp) {
                const int cb = (qtr & 1) * 64;
                const float* gg = p.g_sgu + l * 256 + hp * 128 + cb;
                f32x4 ggv[16];
#pragma unroll
                for (int i = 0; i < 16; ++i) ggv[i] = *(const f32x4*)(gg + 4 * i);
                asm volatile("" : "+v"(ggv[0]), "+v"(ggv[1]), "+v"(ggv[2]), "+v"(ggv[3]), "+v"(ggv[4]), "+v"(ggv[5]), "+v"(ggv[6]), "+v"(ggv[7]));
                asm volatile("" : "+v"(ggv[8]), "+v"(ggv[9]), "+v"(ggv[10]), "+v"(ggv[11]), "+v"(ggv[12]), "+v"(ggv[13]), "+v"(ggv[14]), "+v"(ggv[15]));
#pragma unroll
                for (int i = 0; i < 8; ++i) {
                    const unsigned w4[4] = {raw[i].x, raw[i].y, raw[i].z, raw[i].w};
#pragma unroll
                    for (int j = 0; j < 4; ++j) {
                        const int c = cb + i * 8 + j * 2;
                        vnT[c * 136 + t] = f2bf(__uint_as_float(w4[j] << 16) * rs * ggv[2 * i + (j >> 1)][(j & 1) * 2]);
                        vnT[(c + 1) * 136 + t] = f2bf(__uint_as_float(w4[j] & 0xffff0000u) * rs * ggv[2 * i + (j >> 1)][(j & 1) * 2 + 1]);
                    }
                }
            }
        }
        __syncthreads();
        {
            f32x4 acc[2][4];
#pragma unroll
            for (int mt = 0; mt < 2; ++mt)
#pragma unroll
                for (int nt = 0; nt < 4; ++nt) acc[mt][nt] = (f32x4){0.f, 0.f, 0.f, 0.f};
#pragma unroll
            for (int ks = 0; ks < 4; ++ks) {
                bf16x8 bfr[4];
#pragma unroll
                for (int nt = 0; nt < 4; ++nt) bfr[nt] = *(const bf16x8*)(vnT + (hl * 64 + nt * 16 + fr) * 136 + ks * 32 + fq * 8);
#pragma unroll
                for (int mt = 0; mt < 2; ++mt)
#pragma unroll
                    for (int nt = 0; nt < 4; ++nt) acc[mt][nt] = __builtin_amdgcn_mfma_f32_16x16x32_bf16(bfr[nt], wg[ks][mt], acc[mt][nt], 0, 0, 0);
            }
#pragma unroll
            for (int mt = 0; mt < 2; ++mt) {
                const int t = (mb + mt) * 16 + fr;
                const float bias = bsv[mt];
#pragma unroll
                for (int nt = 0; nt < 4; ++nt) {
                    const int c = g * 64 + nt * 16 + fq * 4;
                    const uint2 ur = urv[mt][nt];
                    const float u0 = __uint_as_float(ur.x << 16), u1 = __uint_as_float(ur.x & 0xffff0000u);
                    const float u2 = __uint_as_float(ur.y << 16), u3 = __uint_as_float(ur.y & 0xffff0000u);
                    uint2 o; o.x = cvtpk(u0 * (acc[mt][nt][0] + bias), u1 * (acc[mt][nt][1] + bias)); o.y = cvtpk(u2 * (acc[mt][nt][2] + bias), u3 * (acc[mt][nt][3] + bias));
                    *(uint2*)(p.MIX + (size_t)(row0 + t) * D + 512 + c) = o;
                }
            }
        }
    }
}

__device__ __forceinline__ void ph_router(const P& p, int l, int nrows, char* lds, const int wv) {
    const int tid = ltid(wv), wave = wv, lane = tid & 63;
    float* wt = (float*)lds;
    float* tsc = (float*)(lds + 32 * 1028 * 4) + wave * (16 * 33);
    int* lcnt = (int*)(lds + 32 * 1028 * 4 + 8 * 16 * 33 * 4);
    int* rinfo = lcnt + 64;
    __syncthreads();
    {
        const float* wr = p.w_router + (size_t)l * D * NE;
        float4 t[16];
#pragma unroll
        for (int i = 0; i < 16; ++i) t[i] = *(const float4*)(wr + (size_t)(tid + NT * i) * 4);
#pragma unroll
        for (int i = 0; i < 16; ++i) { const int idx = (tid + NT * i) * 4, k = idx >> 5, e = idx & 31; float* q = wt + e * 1028 + k; q[0] = t[i].x; q[1028] = t[i].y; q[2 * 1028] = t[i].z; q[3 * 1028] = t[i].w; }
        if (tid < 32) lcnt[tid] = 0;
        if (tid < 128) rinfo[tid * 5] = -1;
    }
    __syncthreads();
    const int i16 = lane & 15, kk = lane >> 4;
    const float* w0 = wt + i16 * 1028 + 8 * kk;
    const bool staged = nrows / 16 <= 8 * (int)gridDim.x;
    const int ng = nrows / 16, nmain = staged ? (ng / (4 * (int)gridDim.x)) * (4 * (int)gridDim.x) : ng;
    auto norm_rows = [&](const bf16_t* xr, const float* Gt, const int row0, const int mb, const int cb, const int ce) {
        float ss = 0.f;
#pragma unroll 1
        for (int c0 = 0; c0 < 32; c0 += 16) {
            u32x4 raw[16];
#pragma unroll
            for (int c = 0; c < 16; ++c) raw[c] = *(const u32x4*)(xr + 32 * (c0 + c));
            asm volatile("" : "+v"(raw[0]), "+v"(raw[1]), "+v"(raw[2]), "+v"(raw[3]), "+v"(raw[4]), "+v"(raw[5]), "+v"(raw[6]), "+v"(raw[7]));
            asm volatile("" : "+v"(raw[8]), "+v"(raw[9]), "+v"(raw[10]), "+v"(raw[11]), "+v"(raw[12]), "+v"(raw[13]), "+v"(raw[14]), "+v"(raw[15]));
#pragma unroll
            for (int c = 0; c < 16; ++c) {
                const float x0 = __uint_as_float(raw[c].x << 16), x1 = __uint_as_float(raw[c].x & 0xffff0000u), x2 = __uint_as_float(raw[c].y << 16), x3 = __uint_as_float(raw[c].y & 0xffff0000u);
                const float x4 = __uint_as_float(raw[c].z << 16), x5 = __uint_as_float(raw[c].z & 0xffff0000u), x6 = __uint_as_float(raw[c].w << 16), x7 = __uint_as_float(raw[c].w & 0xffff0000u);
                ss += x0 * x0 + x1 * x1 + x2 * x2 + x3 * x3 + x4 * x4 + x5 * x5 + x6 * x6 + x7 * x7;
            }
        }
        ss += xshfl<16>(ss); { auto rr = __builtin_amdgcn_permlane32_swap(__float_as_uint(ss), __float_as_uint(ss), false, false); ss = __uint_as_float(rr[0]) + __uint_as_float(rr[1]); }
        const float rstd = rsqrtf(ss * (1.f / D) + EPS);
        const float* St = p.mod + ((size_t)l * 5 + mb) * 6144 + 3 * 1024 + 8 * kk;
        unsigned char* hr = p.HS + (size_t)(row0 + i16) * D + 8 * kk;
#pragma unroll 1
        for (int c0 = cb; c0 < ce; c0 += 4) {
            u32x4 rw[4]; f32x4 ga[4], gb[4], sa[4], sb[4];
#pragma unroll
            for (int c1 = 0; c1 < 4; ++c1) { const int c = c0 + c1; rw[c1] = *(const u32x4*)(xr + 32 * c); ga[c1] = *(const f32x4*)(Gt + 32 * c); gb[c1] = *(const f32x4*)(Gt + 32 * c + 4); sa[c1] = *(const f32x4*)(St + 32 * c); sb[c1] = *(const f32x4*)(St + 32 * c + 4); }
#pragma unroll
            for (int c1 = 0; c1 < 4; ++c1) asm volatile("" : "+v"(rw[c1]), "+v"(ga[c1]), "+v"(gb[c1]), "+v"(sa[c1]), "+v"(sb[c1]));
#pragma unroll
            for (int c1 = 0; c1 < 4; ++c1) {
                const int c = c0 + c1;
                const u32x4 raw = rw[c1];
                const float h0 = __uint_as_float(raw.x << 16) * rstd * ga[c1][0] + sa[c1][0], h1 = __uint_as_float(raw.x & 0xffff0000u) * rstd * ga[c1][1] + sa[c1][1];
                const float h2 = __uint_as_float(raw.y << 16) * rstd * ga[c1][2] + sa[c1][2], h3 = __uint_as_float(raw.y & 0xffff0000u) * rstd * ga[c1][3] + sa[c1][3];
                const float h4 = __uint_as_float(raw.z << 16) * rstd * gb[c1][0] + sb[c1][0], h5 = __uint_as_float(raw.z & 0xffff0000u) * rstd * gb[c1][1] + sb[c1][1];
                const float h6 = __uint_as_float(raw.w << 16) * rstd * gb[c1][2] + sb[c1][2], h7 = __uint_as_float(raw.w & 0xffff0000u) * rstd * gb[c1][3] + sb[c1][3];
                uint2 o;
                o.x = __builtin_amdgcn_cvt_pk_fp8_f32(h2, h3, __builtin_amdgcn_cvt_pk_fp8_f32(h0, h1, 0u, false), true);
                o.y = __builtin_amdgcn_cvt_pk_fp8_f32(h6, h7, __builtin_amdgcn_cvt_pk_fp8_f32(h4, h5, 0u, false), true);
                *(uint2*)(hr + 32 * c) = o;
            }
        }
    };
    auto route = [&](const float (&lg)[32], const int row, const int slot16) {
        unsigned taken = 0u; float tv[4]; int ti[4];
#pragma unroll
        for (int k = 0; k < 4; ++k) {
            float best = -3.0e38f; int bi = 0;
#pragma unroll
            for (int e = 0; e < 32; ++e) { const bool ok = !((taken >> e) & 1u) && (lg[e] > best); best = ok ? lg[e] : best; bi = ok ? e : bi; }
            taken |= 1u << bi; tv[k] = best; ti[k] = bi;
        }
        const float e1 = __expf(tv[1] - tv[0]), e2 = __expf(tv[2] - tv[0]), e3 = __expf(tv[3] - tv[0]);
        const float inv = 1.f / (1.f + e1 + e2 + e3);
        *(int4*)(p.topi + (size_t)row * 4) = make_int4(ti[0], ti[1], ti[2], ti[3]);
        *(float4*)(p.topg + (size_t)row * 4) = make_float4(inv, e1 * inv, e2 * inv, e3 * inv);
        if (staged) {
            const int r0 = atomicAdd(&lcnt[ti[0]], 1), r1 = atomicAdd(&lcnt[ti[1]], 1), r2 = atomicAdd(&lcnt[ti[2]], 1), r3 = atomicAdd(&lcnt[ti[3]], 1);
            int* ri = rinfo + slot16 * 5;
            ri[0] = row; ri[1] = ti[0] | (r0 << 8); ri[2] = ti[1] | (r1 << 8); ri[3] = ti[2] | (r2 << 8); ri[4] = ti[3] | (r3 << 8);
        } else {
            int ps[4];
#pragma unroll
            for (int k = 0; k < 4; ++k) { ps[k] = atomicAdd(&p.cnt[l * 64 + ti[k]], 1); p.slot_tok[(size_t)ti[k] * ECAP + ps[k]] = row; }
            *(int4*)(p.tok_slot + (size_t)row * 4) = make_int4(ps[0], ps[1], ps[2], ps[3]);
        }
    };
#define RT_CHUNK(RAW, GA_, GB_, c_) do { \
            const f32x4 ga_ = (GA_), gb_ = (GB_); \
            const f32x4 ba0_ = *(const f32x4*)(w0 + 32 * (c_)), ba1_ = *(const f32x4*)(w0 + 32 * (c_) + 4), bb0_ = *(const f32x4*)(w0 + 16 * 1028 + 32 * (c_)), bb1_ = *(const f32x4*)(w0 + 16 * 1028 + 32 * (c_) + 4); \
            const float x0_ = __uint_as_float(RAW.x << 16), x1_ = __uint_as_float(RAW.x & 0xffff0000u), x2_ = __uint_as_float(RAW.y << 16), x3_ = __uint_as_float(RAW.y & 0xffff0000u); \
            const float x4_ = __uint_as_float(RAW.z << 16), x5_ = __uint_as_float(RAW.z & 0xffff0000u), x6_ = __uint_as_float(RAW.w << 16), x7_ = __uint_as_float(RAW.w & 0xffff0000u); \
            ss += x0_ * x0_ + x1_ * x1_ + x2_ * x2_ + x3_ * x3_ + x4_ * x4_ + x5_ * x5_ + x6_ * x6_ + x7_ * x7_; \
            d0 = __builtin_amdgcn_mfma_f32_16x16x4f32(x0_ * ga_[0], ba0_[0], d0, 0, 0, 0); d1 = __builtin_amdgcn_mfma_f32_16x16x4f32(x0_ * ga_[0], bb0_[0], d1, 0, 0, 0); \
            d0 = __builtin_amdgcn_mfma_f32_16x16x4f32(x1_ * ga_[1], ba0_[1], d0, 0, 0, 0); d1 = __builtin_amdgcn_mfma_f32_16x16x4f32(x1_ * ga_[1], bb0_[1], d1, 0, 0, 0); \
            d0 = __builtin_amdgcn_mfma_f32_16x16x4f32(x2_ * ga_[2], ba0_[2], d0, 0, 0, 0); d1 = __builtin_amdgcn_mfma_f32_16x16x4f32(x2_ * ga_[2], bb0_[2], d1, 0, 0, 0); \
            d0 = __builtin_amdgcn_mfma_f32_16x16x4f32(x3_ * ga_[3], ba0_[3], d0, 0, 0, 0); d1 = __builtin_amdgcn_mfma_f32_16x16x4f32(x3_ * ga_[3], bb0_[3], d1, 0, 0, 0); \
            d0 = __builtin_amdgcn_mfma_f32_16x16x4f32(x4_ * gb_[0], ba1_[0], d0, 0, 0, 0); d1 = __builtin_amdgcn_mfma_f32_16x16x4f32(x4_ * gb_[0], bb1_[0], d1, 0, 0, 0); \
            d0 = __builtin_amdgcn_mfma_f32_16x16x4f32(x5_ * gb_[1], ba1_[1], d0, 0, 0, 0); d1 = __builtin_amdgcn_mfma_f32_16x16x4f32(x5_ * gb_[1], bb1_[1], d1, 0, 0, 0); \
            d0 = __builtin_amdgcn_mfma_f32_16x16x4f32(x6_ * gb_[2], ba1_[2], d0, 0, 0, 0); d1 = __builtin_amdgcn_mfma_f32_16x16x4f32(x6_ * gb_[2], bb1_[2], d1, 0, 0, 0); \
            d0 = __builtin_amdgcn_mfma_f32_16x16x4f32(x7_ * gb_[3], ba1_[3], d0, 0, 0, 0); d1 = __builtin_amdgcn_mfma_f32_16x16x4f32(x7_ * gb_[3], bb1_[3], d1, 0, 0, 0); } while (0)
    for (int g = (wave & 3) * (int)gridDim.x + (int)blockIdx.x; g < nmain; g += 4 * (int)gridDim.x) {
        const int row0 = g * 16, mb = mod_row(row0);
        const bf16_t* xr = p.X + (size_t)(row0 + i16) * D + 8 * kk;
        const float* Gt = p.RG + ((size_t)l * 5 + mb) * 1024 + 8 * kk;
        if (wave >= 4) { norm_rows(xr, Gt, row0, mb, 0, 32); continue; }
        f32x4 d0 = {0.f, 0.f, 0.f, 0.f}, d1 = d0; float ss = 0.f;
        uint4 rawA[8], rawB[8];
#pragma unroll
        for (int j = 0; j < 8; ++j) rawA[j] = *(const uint4*)(xr + 32 * j);
        f32x4 gq[4][2];
#define RT_GISSUE(c4_) do { _Pragma("unroll") for (int j = 0; j < 4; ++j) { gq[j][0] = *(const f32x4*)(Gt + 32 * ((c4_) + j)); gq[j][1] = *(const f32x4*)(Gt + 32 * ((c4_) + j) + 4); } } while (0)
#define RT_GPIN do { _Pragma("unroll") for (int j = 0; j < 4; ++j) asm volatile("" : "+v"(gq[j][0]), "+v"(gq[j][1])); } while (0)
#define RT_GLOAD(c4_) do { RT_GISSUE(c4_); RT_GPIN; } while (0)
#pragma unroll 1
        for (int cc = 0; cc < 4; cc += 2) {
            RT_GLOAD(8 * cc);
#pragma unroll
            for (int j = 0; j < 4; ++j) RT_CHUNK(rawA[j], gq[j][0], gq[j][1], 8 * cc + j);
            RT_GISSUE(8 * cc + 4);
#pragma unroll
            for (int j = 0; j < 8; ++j) rawB[j] = *(const uint4*)(xr + 32 * (8 * cc + 8 + j));
            RT_GPIN;
#pragma unroll
            for (int j = 0; j < 4; ++j) RT_CHUNK(rawA[4 + j], gq[j][0], gq[j][1], 8 * cc + 4 + j);
            RT_GLOAD(8 * cc + 8);
#pragma unroll
            for (int j = 0; j < 4; ++j) RT_CHUNK(rawB[j], gq[j][0], gq[j][1], 8 * cc + 8 + j);
            RT_GISSUE(8 * cc + 12);
            if (cc + 2 < 4) {
#pragma unroll
                for (int j = 0; j < 8; ++j) rawA[j] = *(const uint4*)(xr + 32 * (8 * cc + 16 + j));
            }
            RT_GPIN;
#pragma unroll
            for (int j = 0; j < 4; ++j) RT_CHUNK(rawB[4 + j], gq[j][0], gq[j][1], 8 * cc + 12 + j);
        }
        ss += xshfl<16>(ss); { auto rr = __builtin_amdgcn_permlane32_swap(__float_as_uint(ss), __float_as_uint(ss), false, false); ss = __uint_as_float(rr[0]) + __uint_as_float(rr[1]); }
        const float rstd = rsqrtf(ss * (1.f / D) + EPS);
#pragma unroll
        for (int j = 0; j < 4; ++j) { tsc[(4 * kk + j) * 33 + i16] = d0[j]; tsc[(4 * kk + j) * 33 + 16 + i16] = d1[j]; }
        __builtin_amdgcn_s_waitcnt(0xc07f);
        if (lane < 16) {
            const float* rb = p.RB + ((size_t)l * 5 + mb) * 32;
            float lg[32];
#pragma unroll
            for (int e = 0; e < 32; ++e) lg[e] = tsc[lane * 33 + e];
            asm volatile("" : "+v"(lg[0]), "+v"(lg[1]), "+v"(lg[2]), "+v"(lg[3]), "+v"(lg[4]), "+v"(lg[5]), "+v"(lg[6]), "+v"(lg[7]), "+v"(lg[8]), "+v"(lg[9]), "+v"(lg[10]), "+v"(lg[11]), "+v"(lg[12]), "+v"(lg[13]), "+v"(lg[14]), "+v"(lg[15]));
            asm volatile("" : "+v"(lg[16]), "+v"(lg[17]), "+v"(lg[18]), "+v"(lg[19]), "+v"(lg[20]), "+v"(lg[21]), "+v"(lg[22]), "+v"(lg[23]), "+v"(lg[24]), "+v"(lg[25]), "+v"(lg[26]), "+v"(lg[27]), "+v"(lg[28]), "+v"(lg[29]), "+v"(lg[30]), "+v"(lg[31]));
#pragma unroll
            for (int e = 0; e < 32; ++e) lg[e] = lg[e] * rstd + rb[e];
            route(lg, row0 + lane, wave * 16 + lane);
        }
    }
    { int rit = 0;
    for (int g = nmain + (int)blockIdx.x; g < ng; g += (int)gridDim.x, ++rit) {
        const int row0 = g * 16, mb = mod_row(row0), q = wave & 3;
        const bf16_t* xr = p.X + (size_t)(row0 + i16) * D + 8 * kk;
        const float* Gt = p.RG + ((size_t)l * 5 + mb) * 1024 + 8 * kk;
        if (wave >= 4) norm_rows(xr, Gt, row0, mb, 8 * q, 8 * q + 8);
        else {
            f32x4 d0 = {0.f, 0.f, 0.f, 0.f}, d1 = d0; float ss = 0.f;
            u32x4 rawA[8];
#pragma unroll
            for (int j = 0; j < 8; ++j) rawA[j] = *(const u32x4*)(xr + 32 * (8 * q + j));
            f32x4 gq[8][2];
#pragma unroll
            for (int j = 0; j < 8; ++j) { gq[j][0] = *(const f32x4*)(Gt + 32 * (8 * q + j)); gq[j][1] = *(const f32x4*)(Gt + 32 * (8 * q + j) + 4); }
            asm volatile("" : "+v"(rawA[0]), "+v"(rawA[1]), "+v"(rawA[2]), "+v"(rawA[3]), "+v"(rawA[4]), "+v"(rawA[5]), "+v"(rawA[6]), "+v"(rawA[7]));
#pragma unroll
            for (int j = 0; j < 8; ++j) asm volatile("" : "+v"(gq[j][0]), "+v"(gq[j][1]));
#pragma unroll
            for (int j = 0; j < 8; ++j) RT_CHUNK(rawA[j], gq[j][0], gq[j][1], 8 * q + j);
            ss += xshfl<16>(ss); { auto rr = __builtin_amdgcn_permlane32_swap(__float_as_uint(ss), __float_as_uint(ss), false, false); ss = __uint_as_float(rr[0]) + __uint_as_float(rr[1]); }
#pragma unroll
            for (int j = 0; j < 4; ++j) { tsc[(4 * kk + j) * 33 + i16] = d0[j]; tsc[(4 * kk + j) * 33 + 16 + i16] = d1[j]; }
            if (kk == 0) tsc[i16 * 33 + 32] = ss;
        }
        __syncthreads();
        if (wave == 0 && lane < 16) {
            const float* rb = p.RB + ((size_t)l * 5 + mb) * 32;
            const float* t0 = tsc + lane * 33;
            const float rstd = rsqrtf((t0[32] + t0[16 * 33 + 32] + t0[2 * 16 * 33 + 32] + t0[3 * 16 * 33 + 32]) * (1.f / D) + EPS);
            float lg[32];
#pragma unroll
            for (int e = 0; e < 32; ++e) lg[e] = ((t0[e] + t0[16 * 33 + e]) + (t0[2 * 16 * 33 + e] + t0[3 * 16 * 33 + e])) * rstd + rb[e];
            route(lg, row0 + lane, (4 + rit) * 16 + lane);
        }
        __syncthreads();
    } }
#undef RT_CHUNK
#undef RT_GLOAD
#undef RT_GISSUE
#undef RT_GPIN
    __syncthreads();
    if (tid < 32) lcnt[32 + tid] = lcnt[tid] ? atomicAdd(&p.cnt[l * 64 + tid], lcnt[tid]) : 0;
    __syncthreads();
    if (tid < 128 && rinfo[tid * 5] >= 0) {
        const int row = rinfo[tid * 5]; int ps[4];
#pragma unroll
        for (int k = 0; k < 4; ++k) { const int v = rinfo[tid * 5 + 1 + k], e = v & 255; ps[k] = lcnt[32 + e] + (v >> 8); p.slot_tok[(size_t)e * ECAP + ps[k]] = row; }
        *(int4*)(p.tok_slot + (size_t)row * 4) = make_int4(ps[0], ps[1], ps[2], ps[3]);
    }
}
__device__ __forceinline__ void ph_moe_tables(const P& p, int l, const int wv) {
    const int tid = ltid(wv);
    unsigned short* tstart = (unsigned short*)(smem_base() + MT_TSTART); int* ecnt = (int*)(smem_base() + MT_ECNT); unsigned char* tile_e = (unsigned char*)(smem_base() + MT_TILE_E);
    __syncthreads();
    if (wv == 0) {
        const int lane = tid;
        const int c = lane < 32 ? p.cnt[l * 64 + lane] : 0;
        const int nt_ = (c + 255) >> 8;
        int incl = nt_;
        incl += __builtin_amdgcn_update_dpp(0, incl, 0x111, 0xf, 0xf, false);
        incl += __builtin_amdgcn_update_dpp(0, incl, 0x112, 0xf, 0xf, false);
        incl += __builtin_amdgcn_update_dpp(0, incl, 0x114, 0xf, 0xf, false);
        incl += __builtin_amdgcn_update_dpp(0, incl, 0x118, 0xf, 0xf, false);
        const int r0 = __builtin_amdgcn_readlane(incl, 15);
        if (lane >= 16) incl += r0;
        const int total = __builtin_amdgcn_readlane(incl, 31);
        if (lane < 32) {
            const int ex = incl - nt_;
            tstart[lane] = (unsigned short)ex; ecnt[lane] = c;
            for (int i = 0; i < nt_; ++i) tile_e[ex + i] = (unsigned char)lane;
        }
        if (lane == 0) tstart[32] = (unsigned short)total;
    }
    __syncthreads();
}
struct EpiProj {
    static constexpr bool PERM = true, AFTER_DRAIN = false, WIDE = false;
    struct Pre {}; __device__ __forceinline__ void prefetch(Pre&, const pg8::Unit&, int, int, int, int) const {}
    __device__ __forceinline__ void init_acc(f32x4 (&acc)[2][2][4][2], const Pre&) const {
#pragma unroll
        for (int a = 0; a < 2; ++a)
#pragma unroll
            for (int b = 0; b < 2; ++b)
#pragma unroll
                for (int m = 0; m < 4; ++m)
#pragma unroll
                    for (int n = 0; n < 2; ++n) acc[a][b][m][n] = (f32x4){0.f, 0.f, 0.f, 0.f};
    }
    bf16_t* O; const float* rope; unsigned* kmx;
    __device__ __forceinline__ void operator()(const f32x4 (&acc)[2][2][4][2], const pg8::Unit& u, int wr, int wc, int fr, int fq, const Pre& pre) const {
        const int row0 = u.pm * 256 + wr * 64 + fr, col0 = u.pn * 256 + wc * 32 + 8 * fq + (u.half == 2 ? 128 : 0);
        const int nbj = u.half ? 1 : 2;
        const bool do_rope = (u.pn < 2) && (u.pm < T / 256), do_gelu = (u.pn == 4) || (u.pn == 5);
        const float sc = u.pn == 0 ? QSCALE : (u.pn == 6 ? 0.125f * 1.4426950408889634f : 1.f);
        const float sgn = (fq & 1) ? 1.f : -1.f;
        const bool do_kn = u.pn == 1 || u.pn == 7;
        float kn[2] = {0.f, 0.f};
#pragma unroll
        for (int ai = 0; ai < 2; ++ai)
#pragma unroll
            for (int m = 0; m < 4; ++m) {
                const int row = row0 + ai * 128 + m * 16;
                bf16_t* rowp = O + (size_t)row * PW + col0;
                f32x4 cs[4];
                if (do_rope) {
                    const int s = row & 4095, pos = (fq >> 1) ? (s & 63) : (s >> 6);
                    const PG8_LAS f32x4* rp = (const PG8_LAS f32x4*)(smem + pg8::STAGE_BYTES + 4096 + pos * 64);
                    cs[0] = rp[0]; cs[1] = rp[1]; cs[2] = rp[2]; cs[3] = rp[3];
                }
#pragma unroll
                for (int bj = 0; bj < 2; ++bj) {
                    if (bj < nbj) {
                    f32x4 v0 = acc[ai][bj][m][0], v1 = acc[ai][bj][m][1];
                    if (do_rope) {
                        f32x4 b0, b1;
#pragma unroll
                        for (int j = 0; j < 4; ++j) { b0[j] = xshfl<16>(v0[j]); b1[j] = xshfl<16>(v1[j]); }
                        v0[0] = v0[0] * cs[0][0] + sgn * b0[0] * cs[0][1]; v0[1] = v0[1] * cs[0][2] + sgn * b0[1] * cs[0][3];
                        v0[2] = v0[2] * cs[1][0] + sgn * b0[2] * cs[1][1]; v0[3] = v0[3] * cs[1][2] + sgn * b0[3] * cs[1][3];
                        v1[0] = v1[0] * cs[2][0] + sgn * b1[0] * cs[2][1]; v1[1] = v1[1] * cs[2][2] + sgn * b1[1] * cs[2][3];
                        v1[2] = v1[2] * cs[3][0] + sgn * b1[2] * cs[3][1]; v1[3] = v1[3] * cs[3][2] + sgn * b1[3] * cs[3][3];
                    }
                    if (do_gelu) {
#pragma unroll
                        for (int j = 0; j < 4; ++j) { v0[j] = gelu_fast(v0[j]); v1[j] = gelu_fast(v1[j]); }
                    }
                    if (sc != 1.f) { v0 = v0 * sc; v1 = v1 * sc; }
                    if (do_kn) {
                        float sq = (v0[0] * v0[0] + v0[1] * v0[1]) + (v0[2] * v0[2] + v0[3] * v0[3]) + (v1[0] * v1[0] + v1[1] * v1[1]) + (v1[2] * v1[2] + v1[3] * v1[3]);
                        sq += xshfl<16>(sq); sq += xshfl<32>(sq);
                        kn[bj] = fmaxf(kn[bj], sq);
                    }
                    u32x4 w; w.x = cvtpk(v0[0], v0[1]); w.y = cvtpk(v0[2], v0[3]); w.z = cvtpk(v1[0], v1[1]); w.w = cvtpk(v1[2], v1[3]);
                    *(u32x4*)(rowp + bj * 128) = w;
                    }
                }
            }
        if (do_kn) {
            const int bidx = u.pm < T / 256 ? (u.pm >> 4) : (u.pm - T / 256);
#pragma unroll
            for (int bj = 0; bj < 2; ++bj) {
                if (bj < nbj) {
                    float v = kn[bj];
                    v = fmaxf(v, xshfl<8>(v)); v = fmaxf(v, xshfl<4>(v)); v = fmaxf(v, xshfl<2>(v)); v = fmaxf(v, xshfl<1>(v));
                    const int cb = wc * 32 + bj * 128 + (u.half == 2 ? 128 : 0);
                    if (fr == 0 && fq == 0) atomicMax(kmx + (u.pn == 7 ? 64 : 0) + (bidx * 4 + (cb >> 6)) * 2 + ((cb >> 5) & 1), __float_as_uint(v));
                }
            }
        }
    }
};
template <bool RES_F32>
struct EpiOut {
    static constexpr bool PERM = true, AFTER_DRAIN = false, WIDE = false;
    struct Pre {}; __device__ __forceinline__ void prefetch(Pre&, const pg8::Unit&, int, int, int, int) const {}
    __device__ __forceinline__ void init_acc(f32x4 (&acc)[2][2][4][2], const Pre&) const {
#pragma unroll
        for (int a = 0; a < 2; ++a)
#pragma unroll
            for (int b = 0; b < 2; ++b)
#pragma unroll
                for (int m = 0; m < 4; ++m)
#pragma unroll
                    for (int n = 0; n < 2; ++n) acc[a][b][m][n] = (f32x4){0.f, 0.f, 0.f, 0.f};
    }
    bf16_t* X; const float* gate; const float* res_lat; const float* res_ctx;
    __device__ __forceinline__ void operator()(const f32x4 (&acc)[2][2][4][2], const pg8::Unit& u, int wr, int wc, int fr, int fq, const Pre& pre) const {
        const int row0 = u.pm * 256 + wr * 64 + fr, col0 = u.pn * 256 + wc * 32 + 8 * fq;
        const float* g = gate + (size_t)mod_row(u.pm * 256) * 6144 + col0;
        f32x4 gv[2][2];
#pragma unroll
        for (int bj = 0; bj < 2; ++bj)
#pragma unroll
            for (int n = 0; n < 2; ++n) gv[bj][n] = *(const f32x4*)(g + bj * 128 + n * 4);
        constexpr int MB = RES_F32 ? 2 : 4;
#pragma unroll
        for (int ai = 0; ai < 2; ++ai)
#pragma unroll
            for (int m0 = 0; m0 < 4; m0 += MB) {
                f32x4 rf[MB][2][2]; u32x4 rb[MB][2];
#pragma unroll
                for (int mm = 0; mm < MB; ++mm) { const size_t off = (size_t)(row0 + ai * 128 + (m0 + mm) * 16) * D + col0;
#pragma unroll
                    for (int bj = 0; bj < 2; ++bj) {
                        if (RES_F32) { const float* rp = (u.pm < T / 256 ? res_lat : res_ctx) + off + bj * 128; rf[mm][bj][0] = *(const f32x4*)rp; rf[mm][bj][1] = *(const f32x4*)(rp + 4); }
                        else rb[mm][bj] = *(const u32x4*)(X + off + bj * 128); } }
#pragma unroll
                for (int mm = 0; mm < MB; ++mm) { if (RES_F32) asm volatile("" : "+v"(rf[mm][0][0]), "+v"(rf[mm][0][1]), "+v"(rf[mm][1][0]), "+v"(rf[mm][1][1])); else asm volatile("" : "+v"(rb[mm][0]), "+v"(rb[mm][1])); }
#pragma unroll
                for (int mm = 0; mm < MB; ++mm) { const int m = m0 + mm; const size_t off = (size_t)(row0 + ai * 128 + m * 16) * D + col0;
#pragma unroll
                    for (int bj = 0; bj < 2; ++bj) {
                        f32x4 r0, r1;
                        if (RES_F32) { r0 = rf[mm][bj][0]; r1 = rf[mm][bj][1]; }
                        else { const u32x4 w = rb[mm][bj];
                            r0 = (f32x4){__uint_as_float(w.x << 16), __uint_as_float(w.x & 0xffff0000u), __uint_as_float(w.y << 16), __uint_as_float(w.y & 0xffff0000u)};
                            r1 = (f32x4){__uint_as_float(w.z << 16), __uint_as_float(w.z & 0xffff0000u), __uint_as_float(w.w << 16), __uint_as_float(w.w & 0xffff0000u)}; }
                        const f32x4 v0 = r0 + gv[bj][0] * acc[ai][bj][m][0], v1 = r1 + gv[bj][1] * acc[ai][bj][m][1];
                        u32x4 o; o.x = cvtpk(v0[0], v0[1]); o.y = cvtpk(v0[2], v0[3]); o.z = cvtpk(v1[0], v1[1]); o.w = cvtpk(v1[2], v1[3]);
                        *(u32x4*)(X + off + bj * 128) = o; } }
            }
    }
};
__device__ __forceinline__ float swiglu(float g, float u) {
    const float gt = fminf(g, 7.0f), up = fminf(fmaxf(u, -7.0f), 7.0f);
    return (up + 1.0f) * gt * __builtin_amdgcn_rcpf(1.0f + __builtin_amdgcn_exp2f(-1.702f * 1.4426950408889634f * gt));
}
__device__ __forceinline__ f32x2_t swiglu2(float ga, float gb, float ua, float ub) {
    const f32x2_t gt = {fminf(ga, 7.0f), fminf(gb, 7.0f)}, up = {fminf(fmaxf(ua, -7.0f), 7.0f), fminf(fmaxf(ub, -7.0f), 7.0f)};
    const f32x2_t a = gt * (f32x2_t){-1.702f * 1.4426950408889634f, -1.702f * 1.4426950408889634f};
    const f32x2_t d = (f32x2_t){__builtin_amdgcn_exp2f(a[0]), __builtin_amdgcn_exp2f(a[1])} + (f32x2_t){1.0f, 1.0f};
    const f32x2_t r = {__builtin_amdgcn_rcpf(d[0]), __builtin_amdgcn_rcpf(d[1])};
    return __builtin_elementwise_fma(up, gt, gt) * r;
}
struct EpiAct {
    static constexpr bool PERM = true, AFTER_DRAIN = false, WIDE = false;
    unsigned char* ACT; const float* bgu;
    struct Pre { f32x4 bg0, bg1, bu0, bu1; };
    __device__ __forceinline__ void prefetch(Pre& q, const pg8::Unit& u, int wr, int wc, int fr, int fq) const {
        const float* bp = bgu + (size_t)u.e * 2048 + u.pn * 128 + wc * 32 + 8 * fq;
        q.bg0 = *(const f32x4*)(bp); q.bg1 = *(const f32x4*)(bp + 4); q.bu0 = *(const f32x4*)(bp + 1024); q.bu1 = *(const f32x4*)(bp + 1028);
        asm volatile("" : "+v"(q.bg0), "+v"(q.bg1), "+v"(q.bu0), "+v"(q.bu1));
    }
    __device__ __forceinline__ void init_acc(f32x4 (&acc)[2][2][4][2], const Pre& q) const {
#pragma unroll
        for (int a = 0; a < 2; ++a)
#pragma unroll
            for (int m = 0; m < 4; ++m) { acc[a][0][m][0] = q.bg0; acc[a][0][m][1] = q.bg1; acc[a][1][m][0] = q.bu0; acc[a][1][m][1] = q.bu1; }
    }
    __device__ __forceinline__ void operator()(const f32x4 (&acc)[2][2][4][2], const pg8::Unit& u, int wr, int wc, int fr, int fq, const Pre& pre) const {
        const int row0 = u.pm * 256 + wr * 64 + fr, j0 = u.pn * 128 + wc * 32 + 8 * fq;
#pragma unroll
        for (int ai = 0; ai < 2; ++ai)
#pragma unroll
            for (int m = 0; m < 4; ++m) {
                const f32x4 g0 = acc[ai][0][m][0], g1 = acc[ai][0][m][1], u0 = acc[ai][1][m][0], u1 = acc[ai][1][m][1];
                uint2 w;
                const f32x2_t a0 = swiglu2(g0[0], g0[1], u0[0], u0[1]), a1 = swiglu2(g0[2], g0[3], u0[2], u0[3]), a2 = swiglu2(g1[0], g1[1], u1[0], u1[1]), a3 = swiglu2(g1[2], g1[3], u1[2], u1[3]);
                w.x = __builtin_amdgcn_cvt_pk_fp8_f32(a1[0], a1[1], __builtin_amdgcn_cvt_pk_fp8_f32(a0[0], a0[1], 0u, false), true);
                w.y = __builtin_amdgcn_cvt_pk_fp8_f32(a3[0], a3[1], __builtin_amdgcn_cvt_pk_fp8_f32(a2[0], a2[1], 0u, false), true);
                *(uint2*)(ACT + (size_t)(row0 + ai * 128 + m * 16) * FF + j0) = w;
            }
    }
};
__device__ __forceinline__ void wide_store16(bf16_t* rowp  , const size_t stride8, const u32x4 w0, const u32x4 w1, const bool lo) {
    u32x4 dA, dB;
#pragma unroll
    for (int q = 0; q < 4; ++q) {
        const unsigned snd = lo ? w1[q] : w0[q];
        const unsigned rcv = (unsigned)__builtin_amdgcn_mov_dpp((int)snd, 0x128, 0xf, 0xf, true);
        dA[q] = lo ? w0[q] : rcv; dB[q] = lo ? rcv : w1[q];
    }
    __builtin_nontemporal_store(dA, (u32x4*)rowp); __builtin_nontemporal_store(dB, (u32x4*)(rowp + stride8));
}
struct EpiYB {
    static constexpr bool PERM = true, AFTER_DRAIN = false, WIDE = true;
    bf16_t* YB; const float* bdn;
    struct Pre { f32x4 bv[2][2]; };
    __device__ __forceinline__ void prefetch(Pre& q, const pg8::Unit& u, int wr, int wc, int fr, int fq) const {
        const float* bp = bdn + (size_t)u.e * D + u.pn * 256 + wc * 64 + 8 * fq + (u.half == 2 ? 32 : 0);
#pragma unroll
        for (int bj = 0; bj < 2; ++bj)
#pragma unroll
            for (int n = 0; n < 2; ++n) q.bv[bj][n] = *(const f32x4*)(bp + (u.half ? 0 : bj * 32) + n * 4);
        asm volatile("" : "+v"(q.bv[0][0]), "+v"(q.bv[0][1]), "+v"(q.bv[1][0]), "+v"(q.bv[1][1]));
    }
    __device__ __forceinline__ void init_acc(f32x4 (&acc)[2][2][4][2], const Pre& q) const {
#pragma unroll
        for (int a = 0; a < 2; ++a)
#pragma unroll
            for (int b = 0; b < 2; ++b)
#pragma unroll
                for (int m = 0; m < 4; ++m) { acc[a][b][m][0] = q.bv[b][0]; acc[a][b][m][1] = q.bv[b][1]; }
    }
    __device__ __forceinline__ void operator()(const f32x4 (&acc)[2][2][4][2], const pg8::Unit& u, int wr, int wc, int fr, int fq, const Pre& pre) const {
        const bool lo = fr < 8;
        if (u.half) {
            bf16_t* hp = YB + (size_t)((u.pm * 4 + u.pn) * 256 + wr * 64 + fr) * 256 + wc * 64 + (u.half == 2 ? 32 : 0) + 8 * fq;
#pragma unroll
            for (int ai = 0; ai < 2; ++ai)
#pragma unroll
                for (int m = 0; m < 4; ++m) { const f32x4 v0 = acc[ai][0][m][0], v1 = acc[ai][0][m][1];
                    u32x4 w; w.x = cvtpk(v0[0], v0[1]); w.y = cvtpk(v0[2], v0[3]); w.z = cvtpk(v1[0], v1[1]); w.w = cvtpk(v1[2], v1[3]);
                    *(u32x4*)(hp + (size_t)(ai * 128 + m * 16) * 256) = w; }
            return;
        }
        const int trow0 = (u.pm * 4 + u.pn) * 256 + wr * 64 + (fr & 7), tcol0 = wc * 64 + 8 * fq + (lo ? 0 : 32);
#pragma unroll
        for (int ai = 0; ai < 2; ++ai)
#pragma unroll
            for (int m = 0; m < 4; ++m) {
                u32x4 w[2];
#pragma unroll
                for (int bj = 0; bj < 2; ++bj) { const f32x4 v0 = acc[ai][bj][m][0], v1 = acc[ai][bj][m][1];
                    w[bj].x = cvtpk(v0[0], v0[1]); w[bj].y = cvtpk(v0[2], v0[3]); w[bj].z = cvtpk(v1[0], v1[1]); w[bj].w = cvtpk(v1[2], v1[3]); }
                wide_store16(YB + (size_t)(trow0 + ai * 128 + m * 16) * 256 + tcol0, (size_t)8 * 256, w[0], w[1], lo);
            }
    }
};
template <bool GATHER_, bool HALVES_ = false>
struct MoeOrderT {
    static constexpr bool GATHER = GATHER_;
    int nN, nunits, G, v, nfull, nhalf; const unsigned char* tile_e; const unsigned short* tstart; const int* ecnt; const int* list;
    __device__ __forceinline__ int tok(int slot) const { const int pm = slot >> 8, e = tile_e[pm], pos = (pm - (int)tstart[e]) * 256 + (slot & 255); return pos < ecnt[e] ? list[(size_t)e * ECAP + pos] : 0; }
    __device__ void init(int nN_, int G_, int c, const int* list_) {
        tstart = (const unsigned short*)(smem_base() + MT_TSTART); ecnt = (const int*)(smem_base() + MT_ECNT); tile_e = (const unsigned char*)(smem_base() + MT_TILE_E); list = list_;
        nN = nN_; nunits = (int)tstart[32] * nN_; G = G_; v = (G_ % 8 == 0) ? (c % 8) * (G_ / 8) + c / 8 : c;
        const int rem = nunits % G_; nfull = nunits; nhalf = 0; if (HALVES_ && rem > 0 && 2 * rem <= G_ && nunits - rem >= G_) { nfull = nunits - rem; nhalf = 2 * rem; } }
    __device__ bool next(int i, pg8::Unit& u) const {
        int L = i * G + v; if (L >= nfull + nhalf) return false;
        u.half = 0;
        if (HALVES_ && L >= nfull) { const int j = L - nfull; L = nfull + (j >> 1); u.half = 1 + (j & 1); }
        u.pm = L / nN; u.pn = L % nN; u.e = tile_e[u.pm]; return true;
    }
    __device__ __forceinline__ const bf16_t* bt(const pg8::Gemm& g, const pg8::Unit& u) const { return g.Bt + (size_t)u.e * g.N * g.K; }
    __device__ __forceinline__ void a_ready(const pg8::Unit&) const {}
    __device__ __forceinline__ void done(const pg8::Unit&) const {}
};
typedef MoeOrderT<false, true> MoeOrder;
typedef MoeOrderT<true> MoeOrderG;

__device__ __forceinline__ void ph_gemm_proj(const P& p, int l, char* lds, const int wv) {
    pg8::Gemm g{p.H, (const bf16_t*)((const unsigned char*)p.WinT + (size_t)l * PW * D), R, PW, D / 2}; pg8::StaticOrderH S;   S.init(R, PW, (int)gridDim.x, (int)blockIdx.x);
    EpiProj E{p.PROJ, p.rope, p.kmx + l * 32};
    { const int tid = ltid(wv); if (tid < 256) *(float4*)(lds + pg8::STAGE_BYTES + 4096 + tid * 16) = *(const float4*)(p.rope + tid * 4); __syncthreads(); }
    pg8::gemm_phase<EpiProj, pg8::StaticOrderH, true, true, true>((PG8_LAS unsigned char*)lds, g, S, E, wv);
}
__device__ __forceinline__ void ph_gemm_out(const P& p, int l, int nrows, char* lds, const int wv) {
    pg8::Gemm g{p.MIX, p.WoutT + (size_t)l * D * D, T, D, D}; pg8::StaticOrder S; S.init(T, D, (int)gridDim.x, (int)blockIdx.x);
    if (l == 0) { EpiOut<true> E{p.X, p.mod + (size_t)l * 5 * 6144 + 2 * 1024, p.x, p.ctx - (size_t)T * D}; pg8::gemm_phase<EpiOut<true>, pg8::StaticOrder, true, true>((PG8_LAS unsigned char*)lds, g, S, E, wv); }
    else { EpiOut<false> E{p.X, p.mod + (size_t)l * 5 * 6144 + 2 * 1024, nullptr, nullptr}; pg8::gemm_phase<EpiOut<false>, pg8::StaticOrder, true, true>((PG8_LAS unsigned char*)lds, g, S, E, wv); }
    if (nrows > T) {
        const int tid = ltid(wv), lane = tid & 63, wid = tid >> 6, fr = lane & 15, fq = lane >> 4;
        const bf16_t* Wt = p.WoutT + (size_t)l * D * D;
        const float* gate = p.mod + ((size_t)l * 5 + 4) * 6144 + 2 * 1024;
        for (int it = blockIdx.x; it < (TC / 64) * (D / 64); it += gridDim.x) {
            const int m0 = T + (it >> 4) * 64 + (wid & 3) * 16, n0 = (it & 15) * 64 + (wid >> 2) * 32;
            const bf16_t* ap = p.MIX + (size_t)(m0 + fr) * D + fq * 8;
            const bf16_t* bp0 = Wt + (size_t)(n0 + fr) * D + fq * 8;
            const bf16_t* bp1 = bp0 + (size_t)16 * D;
            f32x4 acc0 = (f32x4){0.f, 0.f, 0.f, 0.f}, acc1 = acc0;
#pragma unroll 1
            for (int kc = 0; kc < D / 32; kc += 8) {
                bf16x8 af[8], b0[8], b1[8];
#pragma unroll
                for (int ks = 0; ks < 8; ++ks) { af[ks] = *(const bf16x8*)(ap + (kc + ks) * 32); b0[ks] = *(const bf16x8*)(bp0 + (kc + ks) * 32); b1[ks] = *(const bf16x8*)(bp1 + (kc + ks) * 32); }
                asm volatile("" : "+v"(af[0]), "+v"(af[1]), "+v"(af[2]), "+v"(af[3]), "+v"(af[4]), "+v"(af[5]), "+v"(af[6]), "+v"(af[7]));
                asm volatile("" : "+v"(b0[0]), "+v"(b0[1]), "+v"(b0[2]), "+v"(b0[3]), "+v"(b0[4]), "+v"(b0[5]), "+v"(b0[6]), "+v"(b0[7]));
                asm volatile("" : "+v"(b1[0]), "+v"(b1[1]), "+v"(b1[2]), "+v"(b1[3]), "+v"(b1[4]), "+v"(b1[5]), "+v"(b1[6]), "+v"(b1[7]));
#pragma unroll
                for (int ks = 0; ks < 8; ++ks) {
                    acc0 = __builtin_amdgcn_mfma_f32_16x16x32_bf16(b0[ks], af[ks], acc0, 0, 0, 0);
                    acc1 = __builtin_amdgcn_mfma_f32_16x16x32_bf16(b1[ks], af[ks], acc1, 0, 0, 0);
                }
            }
            const int row = m0 + fr, c0 = n0 + fq * 4;
            const size_t off = (size_t)row * D + c0;
            const float* res = p.ctx - (size_t)T * D;
            const f32x4 v0 = *(const f32x4*)(res + off) + *(const f32x4*)(gate + c0) * acc0, v1 = *(const f32x4*)(res + off + 16) + *(const f32x4*)(gate + c0 + 16) * acc1;
            uint2 o0, o1; o0.x = cvtpk(v0[0], v0[1]); o0.y = cvtpk(v0[2], v0[3]); o1.x = cvtpk(v1[0], v1[1]); o1.y = cvtpk(v1[2], v1[3]);
            *(uint2*)(p.X + off) = o0; *(uint2*)(p.X + off + 16) = o1;
        }
    }
}
__device__ __forceinline__ void ph_moe1(const P& p, int l, char* lds, const int wv) {
    MoeOrderG S; S.init(8, (int)gridDim.x, (int)blockIdx.x, p.slot_tok);
    pg8::Gemm g{(const bf16_t*)p.HS, (const bf16_t*)(KARG_PTR(const unsigned char*, WguT) + (size_t)l * NE * 2048 * D), S.nunits / 8 * 256, 2048, D / 2};
    EpiAct E{KARG_PTR(unsigned char*, ACT), KARG_PTR(const float*, b_gu) + (size_t)l * NE * 2048};
    pg8::gemm_phase<EpiAct, MoeOrderG, true, true, true>((PG8_LAS unsigned char*)lds, g, S, E, wv);
}
__device__ __forceinline__ void ph_moe2(const P& p, int l, char* lds, const int wv) {
    MoeOrder S; S.init(4, (int)gridDim.x, (int)blockIdx.x, nullptr);
    pg8::Gemm g{(const bf16_t*)KARG_PTR(const unsigned char*, ACT), (const bf16_t*)(KARG_PTR(const unsigned char*, WdnT) + (size_t)l * NE * D * FF), S.nunits / 4 * 256, D, FF / 2};
    EpiYB E{p.YB, KARG_PTR(const float*, b_down) + (size_t)l * NE * D};
    pg8::gemm_phase<EpiYB, MoeOrder, true, true, true>((PG8_LAS unsigned char*)lds, g, S, E, wv);
}
struct CombRow { uint4 y0[2], y1[2], y2[2], y3[2], xw[2]; float4 g; };
__device__ __forceinline__ void comb_load(CombRow& c, const bf16_t* __restrict__ YB, const bf16_t* __restrict__ X, const int* __restrict__ tok_slot, const int* __restrict__ topi, const float* __restrict__ topg, int row, int lane) {
    const unsigned short* tstart = (const unsigned short*)(smem_base() + MT_TSTART);
    const int4 ps = *(const int4*)(tok_slot + (size_t)row * 4), ei = *(const int4*)(topi + (size_t)row * 4);
    int ts_[4] = {(int)tstart[ei.x], (int)tstart[ei.y], (int)tstart[ei.z], (int)tstart[ei.w]};
    asm volatile("" : "+v"(ts_[0]), "+v"(ts_[1]), "+v"(ts_[2]), "+v"(ts_[3]));
    const int4 sl = make_int4(ts_[0] * 256 + ps.x, ts_[1] * 256 + ps.y, ts_[2] * 256 + ps.z, ts_[3] * 256 + ps.w);
    c.g = *(const float4*)(topg + (size_t)row * 4);
#pragma unroll
    for (int i = 0; i < 2; ++i) {
        const int k = lane * 8 + 512 * i;
        const size_t ko = (size_t)(k >> 8) * 65536 + (k & 255);
#define YB_AT(s_) (YB + (size_t)((s_) >> 8) * 262144 + (size_t)((s_) & 255) * 256 + ko)
        c.y0[i] = *(const uint4*)YB_AT(sl.x); c.y1[i] = *(const uint4*)YB_AT(sl.y);
        c.y2[i] = *(const uint4*)YB_AT(sl.z); c.y3[i] = *(const uint4*)YB_AT(sl.w);
#undef YB_AT
        c.xw[i] = *(const uint4*)(X + (size_t)row * D + k);
    }
}
struct CombMod { f32x4 gt[2][2], ga[2][2], sh[2][2], sc[2][2]; };
__device__ __forceinline__ void comb_mod_load(CombMod& q, const P& p, int l, int row, int lane) {
    const float* m = p.mod + ((size_t)l * 5 + mod_row(row)) * 6144 + 5 * 1024;
    const float* m1 = p.mod + ((size_t)5 + mod_row(row)) * 6144;
    const float* g1 = l == 0 ? p.g_mix + D : p.g_final;
#pragma unroll
    for (int i = 0; i < 2; ++i) {
        const int k = lane * 8 + 512 * i;
        q.gt[i][0] = *(const f32x4*)(m + k); q.gt[i][1] = *(const f32x4*)(m + k + 4);
        q.ga[i][0] = *(const f32x4*)(g1 + k); q.ga[i][1] = *(const f32x4*)(g1 + k + 4);
        if (l == 0) { q.sh[i][0] = *(const f32x4*)(m1 + k); q.sh[i][1] = *(const f32x4*)(m1 + k + 4); q.sc[i][0] = *(const f32x4*)(m1 + 1024 + k); q.sc[i][1] = *(const f32x4*)(m1 + 1024 + k + 4); }
    }
}
__device__ __forceinline__ void comb_finish(const P& p, const CombRow& c, const CombMod& cm, int l, int row, int lane) {
    const float4 g = c.g;
    float xv[16]; float ss = 0.f;
#pragma unroll
    for (int i = 0; i < 2; ++i) {
        const int k = lane * 8 + 512 * i;
        const unsigned a0[4] = {c.y0[i].x, c.y0[i].y, c.y0[i].z, c.y0[i].w}, a1[4] = {c.y1[i].x, c.y1[i].y, c.y1[i].z, c.y1[i].w};
        const unsigned a2[4] = {c.y2[i].x, c.y2[i].y, c.y2[i].z, c.y2[i].w}, a3[4] = {c.y3[i].x, c.y3[i].y, c.y3[i].z, c.y3[i].w};
        const unsigned xq[4] = {c.xw[i].x, c.xw[i].y, c.xw[i].z, c.xw[i].w};
        const float gt[8] = {cm.gt[i][0][0], cm.gt[i][0][1], cm.gt[i][0][2], cm.gt[i][0][3], cm.gt[i][1][0], cm.gt[i][1][1], cm.gt[i][1][2], cm.gt[i][1][3]};
#pragma unroll
        for (int q = 0; q < 4; ++q) {
            const float ylo = g.x * __uint_as_float(a0[q] << 16) + g.y * __uint_as_float(a1[q] << 16) + g.z * __uint_as_float(a2[q] << 16) + g.w * __uint_as_float(a3[q] << 16);
            const float yhi = g.x * __uint_as_float(a0[q] & 0xffff0000u) + g.y * __uint_as_float(a1[q] & 0xffff0000u) + g.z * __uint_as_float(a2[q] & 0xffff0000u) + g.w * __uint_as_float(a3[q] & 0xffff0000u);
            const float v0 = __uint_as_float(xq[q] << 16) + gt[2 * q] * ylo, v1 = __uint_as_float(xq[q] & 0xffff0000u) + gt[2 * q + 1] * yhi;
            xv[8 * i + 2 * q] = v0; xv[8 * i + 2 * q + 1] = v1; ss += v0 * v0 + v1 * v1;
        }
    }
    ss = wave_sum(ss);
    const float rstd = rsqrtf(ss * (1.f / D) + EPS);
    if (l == 0) {
#pragma unroll
        for (int i = 0; i < 2; ++i) {
            const int k = lane * 8 + 512 * i;
            { u32x4 xo; xo.x = cvtpk(xv[8 * i], xv[8 * i + 1]); xo.y = cvtpk(xv[8 * i + 2], xv[8 * i + 3]); xo.z = cvtpk(xv[8 * i + 4], xv[8 * i + 5]); xo.w = cvtpk(xv[8 * i + 6], xv[8 * i + 7]); *(u32x4*)(p.X + (size_t)row * D + k) = xo; }
            const float4 ga = make_float4(cm.ga[i][0][0], cm.ga[i][0][1], cm.ga[i][0][2], cm.ga[i][0][3]), gb = make_float4(cm.ga[i][1][0], cm.ga[i][1][1], cm.ga[i][1][2], cm.ga[i][1][3]);
            const float4 sha = make_float4(cm.sh[i][0][0], cm.sh[i][0][1], cm.sh[i][0][2], cm.sh[i][0][3]), shb = make_float4(cm.sh[i][1][0], cm.sh[i][1][1], cm.sh[i][1][2], cm.sh[i][1][3]);
            const float4 sca = make_float4(cm.sc[i][0][0], cm.sc[i][0][1], cm.sc[i][0][2], cm.sc[i][0][3]), scb = make_float4(cm.sc[i][1][0], cm.sc[i][1][1], cm.sc[i][1][2], cm.sc[i][1][3]);
            uint2 o;
            o.x = __builtin_amdgcn_cvt_pk_fp8_f32(xv[8 * i] * rstd * ga.x * (1.f + sca.x) + sha.x, xv[8 * i + 1] * rstd * ga.y * (1.f + sca.y) + sha.y, 0u, false);
            o.x = __builtin_amdgcn_cvt_pk_fp8_f32(xv[8 * i + 2] * rstd * ga.z * (1.f + sca.z) + sha.z, xv[8 * i + 3] * rstd * ga.w * (1.f + sca.w) + sha.w, o.x, true);
            o.y = __builtin_amdgcn_cvt_pk_fp8_f32(xv[8 * i + 4] * rstd * gb.x * (1.f + scb.x) + shb.x, xv[8 * i + 5] * rstd * gb.y * (1.f + scb.y) + shb.y, 0u, false);
            o.y = __builtin_amdgcn_cvt_pk_fp8_f32(xv[8 * i + 6] * rstd * gb.z * (1.f + scb.z) + shb.z, xv[8 * i + 7] * rstd * gb.w * (1.f + scb.w) + shb.w, o.y, true);
            *(uint2*)((unsigned char*)p.H + (size_t)row * D + k) = o;
        }
    } else {
#pragma unroll
        for (int i = 0; i < 2; ++i) {
            const int k = lane * 8 + 512 * i;
            const float4 ga = make_float4(cm.ga[i][0][0], cm.ga[i][0][1], cm.ga[i][0][2], cm.ga[i][0][3]), gb = make_float4(cm.ga[i][1][0], cm.ga[i][1][1], cm.ga[i][1][2], cm.ga[i][1][3]);
            float* op = p.out + (size_t)row * D + k;
            *(float4*)op = make_float4(xv[8 * i] * rstd * ga.x, xv[8 * i + 1] * rstd * ga.y, xv[8 * i + 2] * rstd * ga.z, xv[8 * i + 3] * rstd * ga.w);
            *(float4*)(op + 4) = make_float4(xv[8 * i + 4] * rstd * gb.x, xv[8 * i + 5] * rstd * gb.y, xv[8 * i + 6] * rstd * gb.z, xv[8 * i + 7] * rstd * gb.w);
        }
    }
}
__device__ __forceinline__ void ph_combine(const P& p, int l, int nrows, const int wv) {
    const int wave = ltid(wv) >> 6, lane = ltid(wv) & 63;
    const int W = (int)gridDim.x * 8, gw = (int)blockIdx.x * 8 + wave, nfull = ((nrows / 2) / W) * W;
    for (int pr = gw; pr < nfull; pr += W) {
        CombRow ca, cb; CombMod cm;
        comb_mod_load(cm, p, l, 2 * pr, lane);
        comb_load(ca, p.YB, p.X, p.tok_slot, p.topi, p.topg, 2 * pr, lane);
        comb_load(cb, p.YB, p.X, p.tok_slot, p.topi, p.topg, 2 * pr + 1, lane);
        comb_finish(p, ca, cm, l, 2 * pr, lane);
        comb_finish(p, cb, cm, l, 2 * pr + 1, lane);
    }
    for (int row = 2 * nfull + gw; row < nrows; row += W) {
        CombRow ca; CombMod cm;
        comb_mod_load(cm, p, l, row, lane);
        comb_load(ca, p.YB, p.X, p.tok_slot, p.topi, p.topg, row, lane);
        comb_finish(p, ca, cm, l, row, lane);
    }
}
__global__ void __launch_bounds__(NT, 2) mega(P p) {
    char* lds = smem;
    int wv = __builtin_amdgcn_readfirstlane((int)(threadIdx.x >> 6)); asm volatile("" : "+s"(wv));
    if (threadIdx.x == 0) *(uint4*)(smem + LDS_MAIN) = make_uint4(0u, 0u, 0u, 0u);
    __syncthreads();
    XcdBarrier bar = xcd_barrier_post(p.bar, (volatile LAS unsigned*)(smem + LDS_MAIN), wv);
    ph_prologue(p, lds, 0, wv);
    xcd_barrier(bar);
    ph_norm1(p, 0, wv);
    ph_prologue(p, lds, 1, wv);
    xcd_barrier(bar);
#define MEGA_LAYER(l, nrows, LAST) do { \
        ph_gemm_proj(p, l, lds, wv); xcd_barrier(bar); \
        ph_dattn(p, l, nrows, lds, wv); ph_na(p, l, nrows, lds, wv); ph_pool(p, l, nrows, lds, wv); ph_sgu(p, l, nrows, lds, wv); xcd_barrier(bar); \
        ph_gemm_out(p, l, nrows, lds, wv); xcd_barrier(bar); \
        ph_router(p, l, nrows, lds, wv); xcd_barrier(bar); \
        ph_moe_tables(p, l, wv); ph_moe1(p, l, lds, wv); xcd_barrier(bar); \
        ph_moe2(p, l, lds, wv); xcd_barrier(bar); \
        ph_combine(p, l, nrows, wv); if (!(LAST)) xcd_barrier(bar); } while (0)
    MEGA_LAYER(0, R, false);
    MEGA_LAYER(1, T, true);
#undef MEGA_LAYER
}

static inline size_t align_up(size_t v, size_t a) { return (v + a - 1) / a * a; }

extern "C" void kernel_launch(void* const* d_in, const int* in_sizes, int n_in, void* d_out, int out_size, void* d_ws, size_t ws_size, hipStream_t stream) {
    P p{};
    const float** ins = (const float**)&p.x;
    for (int i = 0; i < 28; ++i) ins[i] = (const float*)d_in[i];
    p.out = (float*)d_out;
    char* w = (char*)d_ws; size_t off = 0;
    auto carve = [&](size_t bytes) { void* r = w + off; off = align_up(off + bytes, 256); return r; };
    const size_t ctl_bytes = XCD_BAR_WORDS * 4 + 2 * 64 * 4 + 144 * 4;
    p.bar = (unsigned*)carve(ctl_bytes);
    p.cnt = (int*)(p.bar + XCD_BAR_WORDS);
    p.kmx = (unsigned*)(p.cnt + 128);
    p.mod = (float*)carve((size_t)2 * 5 * 6144 * 4);
    p.rope = (float*)carve(64 * 8 * 2 * 4);
    p.RG = (float*)carve((size_t)2 * 5 * 1024 * 4);
    p.RB = (float*)carve((size_t)2 * 5 * 32 * 4);
    p.BT = (float*)carve((size_t)2 * 4 * 15 * 128 * 4);
    p.X = (bf16_t*)carve((size_t)R * D * 2);
    p.H = (bf16_t*)carve((size_t)R * D * 2);
    p.PROJ = (bf16_t*)carve((size_t)R * PW * 2);
    p.MIX = (bf16_t*)carve((size_t)R * D * 2);
    p.WinT = (bf16_t*)carve((size_t)2 * PW * D * 2);
    p.WoutT = (bf16_t*)carve((size_t)2 * D * D * 2);
    p.WguT = (unsigned char*)carve((size_t)2 * NE * 2048 * D);
    p.WdnT = (unsigned char*)carve((size_t)2 * NE * D * FF);
    p.WpT = (bf16_t*)carve((size_t)2 * 4 * 64 * 64 * 2);
    p.WsB = (bf16_t*)carve((size_t)2 * 4 * 128 * 128 * 2);
    p.topi = (int*)carve((size_t)R * 4 * 4);
    p.topg = (float*)carve((size_t)R * 4 * 4);
    p.tok_slot = (int*)carve((size_t)R * 4 * 4);
    p.HS = (unsigned char*)carve((size_t)R * D);
    p.slot_tok = (int*)carve((size_t)NE * ECAP * 4);
    p.ACT = (unsigned char*)carve((size_t)NSLOT * FF);
    p.YB = (bf16_t*)carve((size_t)NSLOT * D * 2);

    static int grid = 0;
    if (!grid) {
        int dev = 0, cus = 0, per_cu = 0;
        (void)hipGetDevice(&dev);
        (void)hipDeviceGetAttribute(&cus, hipDeviceAttributeMultiprocessorCount, dev);
        (void)hipFuncSetAttribute((const void*)mega, hipFuncAttributeMaxDynamicSharedMemorySize, LDS_BYTES);
        (void)hipOccupancyMaxActiveBlocksPerMultiprocessor(&per_cu, mega, NT, LDS_BYTES);
        grid = cus * (per_cu < 1 ? per_cu : 1);
        if (grid <= 0) { fprintf(stderr, "mega: occupancy query returned %d blocks per CU\n", per_cu); grid = 0; return; }
    }
    (void)hipMemsetAsync(p.bar, 0, ctl_bytes, stream);
    mega<<<grid, NT, LDS_BYTES, stream>>>(p);
}
```
